# Optimizing an MI355X kernel written in HIP

```python
import jax, jax.numpy as jnp
from jax import lax
import numpy as np

D_MODEL = 2048
BATCH = 1
SEQ = 8192
DEPTH = 1

MEM_LEN = 256
CHUNK = 64
RET_HEADS = 4
RET_DK = 256
RET_DV = 256
GLA_HEADS = 4
GLA_DK = 128
GLA_DV = 256
GLA_LOWRANK = 16
GLA_TAU = 16.0
MIX_WIDTH = RET_HEADS * RET_DV + GLA_HEADS * GLA_DV
ROPE_BASE = 10000.0
MEM_HEADS = 4
MEM_HEAD_DIM = D_MODEL // MEM_HEADS
N_GROUPS = 4
EXPERTS_PER_GROUP = 8
N_EXPERTS = N_GROUPS * EXPERTS_PER_GROUP
EXPERT_FF = 512
FINE_TOP_K = 2
MOE_BLOCK = 128
LN_EPS = 1e-5
DEEPNORM_ALPHA = (2 * DEPTH) ** 0.25
DEEPNORM_BETA = (8 * DEPTH) ** -0.25
IN_SIZES = (RET_HEADS * RET_DK, RET_HEADS * RET_DK, RET_HEADS * RET_DV, RET_HEADS * RET_DV,
            GLA_HEADS * GLA_DK, GLA_HEADS * GLA_DK, GLA_HEADS * GLA_DV, GLA_HEADS * GLA_DV,
            GLA_LOWRANK)
IN_WIDTH = sum(IN_SIZES)

kernel_name = "hymba_retnet_gla_hmoe_deepnorm"


def layer_norm(x, g, b):
    xf = x.astype(jnp.float32)
    mu = xf.mean(-1, keepdims=True)
    var = jnp.mean(jnp.square(xf - mu), -1, keepdims=True)
    y = (xf - mu) * lax.rsqrt(var + LN_EPS) * g.astype(jnp.float32) + b.astype(jnp.float32)
    return y.astype(x.dtype)


def head_group_norm(t):
    mu = t.mean(-1, keepdims=True)
    var = jnp.mean(jnp.square(t - mu), -1, keepdims=True)
    return (t - mu) * lax.rsqrt(var + LN_EPS)


def head_rms_norm(t, g):
    return t * lax.rsqrt(jnp.mean(jnp.square(t), -1, keepdims=True) + LN_EPS) * g.astype(jnp.float32)


def rotary(t, positions):
    half = t.shape[-1] // 2
    inv_freq = ROPE_BASE ** (-jnp.arange(half, dtype=jnp.float32) / half)
    ang = positions.astype(jnp.float32)[:, :, None, None] * inv_freq
    cos, sin = jnp.cos(ang), jnp.sin(ang)
    t1, t2 = t[..., :half], t[..., half:]
    return jnp.concatenate([t1 * cos - t2 * sin, t1 * sin + t2 * cos], axis=-1)


def to_chunks(t):
    B, S, H, d = t.shape
    return t.reshape(B, S // CHUNK, CHUNK, H, d).transpose(1, 0, 3, 2, 4)


def from_chunks(t):
    N, B, H, C, d = t.shape
    return t.transpose(1, 0, 3, 2, 4).reshape(B, N * C, H, d)


def retention_chunkwise(q, k, v):
    B, S, H, dk = q.shape
    dv = v.shape[-1]
    log_gamma = jnp.log1p(-jnp.exp2(-5.0 - jnp.arange(H, dtype=jnp.float32)))
    n = jnp.arange(CHUNK, dtype=jnp.float32)
    rel = n[:, None] - n[None, :]
    causal = rel >= 0
    decay_intra = jnp.where(causal, jnp.exp(log_gamma[:, None, None] * jnp.maximum(rel, 0.0)), 0.0)
    decay_q = jnp.exp(log_gamma[:, None] * (n + 1.0))[..., None]
    decay_k = jnp.exp(log_gamma[:, None] * (CHUNK - 1.0 - n))[..., None]
    decay_chunk = jnp.exp(log_gamma * CHUNK)[:, None, None]

    def step(R, inp):
        qc, kc, vc = inp
        scores = jnp.einsum('bhid,bhjd->bhij', qc, kc) * decay_intra
        o = (jnp.einsum('bhij,bhje->bhie', scores, vc)
             + jnp.einsum('bhid,bhde->bhie', qc * decay_q, R))
        R = decay_chunk * R + jnp.einsum('bhjd,bhje->bhde', kc * decay_k, vc)
        return R, o

    R0 = jnp.zeros((B, H, dk, dv), jnp.float32)
    _, o = lax.scan(step, R0, (to_chunks(q), to_chunks(k), to_chunks(v)))
    return from_chunks(o)


def gla_chunkwise(q, k, v, log_a):
    B, S, H, dk = q.shape
    dv = v.shape[-1]
    causal = jnp.tril(jnp.ones((CHUNK, CHUNK), bool))[:, :, None]

    def step(St, inp):
        qc, kc, vc, ac = inp
        b = jnp.cumsum(ac, axis=-2)
        diff = b[:, :, :, None, :] - b[:, :, None, :, :]
        gate = jnp.where(causal, jnp.exp(jnp.where(causal, diff, 0.0)), 0.0)
        scores = jnp.einsum('bhid,bhjd,bhijd->bhij', qc, kc, gate)
        o = (jnp.einsum('bhij,bhje->bhie', scores, vc)
             + jnp.einsum('bhid,bhde->bhie', qc * jnp.exp(b), St))
        b_last = b[:, :, -1:, :]
        St = (jnp.exp(b_last[:, :, 0, :])[..., None] * St
              + jnp.einsum('bhjd,bhje->bhde', kc * jnp.exp(b_last - b), vc))
        return St, o

    S0 = jnp.zeros((B, H, dk, dv), jnp.float32)
    _, o = lax.scan(step, S0, (to_chunks(q), to_chunks(k), to_chunks(v), to_chunks(log_a)))
    return from_chunks(o)


def hybrid_mixer(x, positions, w_in, w_gla_a2, b_gla_a, g_gla_norm, w_mix_out):
    B, S, _ = x.shape
    h = x @ w_in
    split_at = [int(i) for i in np.cumsum(IN_SIZES)[:-1]]
    rq, rk, rv, rg, gq, gk, gv, gg, glr = jnp.split(h, split_at, axis=-1)
    f32 = jnp.float32
    rq = rotary(rq.astype(f32).reshape(B, S, RET_HEADS, RET_DK), positions)
    rk = rotary(rk.astype(f32).reshape(B, S, RET_HEADS, RET_DK), positions) * RET_DK ** -0.5
    rv = rv.astype(f32).reshape(B, S, RET_HEADS, RET_DV)
    ret = head_group_norm(retention_chunkwise(rq, rk, rv)).reshape(B, S, RET_HEADS * RET_DV)
    ret = jax.nn.silu(rg.astype(f32)) * ret
    gq = gq.astype(f32).reshape(B, S, GLA_HEADS, GLA_DK) * GLA_DK ** -0.5
    gk = gk.astype(f32).reshape(B, S, GLA_HEADS, GLA_DK)
    gv = gv.astype(f32).reshape(B, S, GLA_HEADS, GLA_DV)
    log_a = (jax.nn.log_sigmoid((glr @ w_gla_a2 + b_gla_a).astype(f32)) / GLA_TAU
             ).reshape(B, S, GLA_HEADS, GLA_DK)
    gla = head_rms_norm(gla_chunkwise(gq, gk, gv, log_a), g_gla_norm).reshape(B, S, GLA_HEADS * GLA_DV)
    gla = jax.nn.silu(gg.astype(f32)) * gla
    mixed = jnp.concatenate([ret, gla], axis=-1).astype(x.dtype)
    return mixed @ w_mix_out


def memory_cross_attention(x, mem, w_mq, w_mk, w_mv, w_mo):
    B, S, _ = x.shape
    M = mem.shape[1]
    q = (x @ w_mq).reshape(B, S, MEM_HEADS, MEM_HEAD_DIM)
    k = (mem @ w_mk).reshape(B, M, MEM_HEADS, MEM_HEAD_DIM)
    v = (mem @ w_mv).reshape(B, M, MEM_HEADS, MEM_HEAD_DIM)
    s = jnp.einsum('bshd,bmhd->bhsm', q, k).astype(jnp.float32) * MEM_HEAD_DIM ** -0.5
    p = jax.nn.softmax(s, axis=-1).astype(v.dtype)
    o = jnp.einsum('bhsm,bmhd->bshd', p, v).reshape(B, S, D_MODEL)
    return o @ w_mo


def hierarchical_moe(x, w_route_group, b_route_group, w_route_expert, b_route_expert,
                     w_exp_gate, w_exp_up, w_exp_down):
    B, S, D = x.shape
    T = B * S
    xf = x.reshape(T, D)
    f32 = jnp.float32
    pg = jax.nn.softmax((xf @ w_route_group + b_route_group).astype(f32), axis=-1)
    grp = jnp.argmax(pg, axis=-1)
    pg_sel = jnp.take_along_axis(pg, grp[:, None], axis=-1)
    fine = (xf @ w_route_expert).reshape(T, N_GROUPS, EXPERTS_PER_GROUP) + b_route_expert
    fine_sel = jnp.take_along_axis(fine, grp[:, None, None], axis=1)[:, 0].astype(f32)
    top_p, top_i = lax.top_k(jax.nn.softmax(fine_sel, axis=-1), FINE_TOP_K)
    gate = pg_sel * top_p / jnp.sum(top_p, axis=-1, keepdims=True)
    expert = grp[:, None] * EXPERTS_PER_GROUP + top_i
    A = T * FINE_TOP_K
    flat_e = expert.reshape(A)
    flat_t = jnp.repeat(jnp.arange(T, dtype=jnp.int32), FINE_TOP_K)
    flat_w = gate.reshape(A)
    order = jnp.argsort(flat_e)
    se = flat_e[order]
    counts = jnp.bincount(flat_e, length=N_EXPERTS)
    padded = (counts + MOE_BLOCK - 1) // MOE_BLOCK * MOE_BLOCK
    ends = jnp.cumsum(padded)
    pstart = ends - padded
    start = jnp.cumsum(counts) - counts
    dest = pstart[se] + jnp.arange(A) - start[se]
    P = A + N_EXPERTS * MOE_BLOCK
    nb = P // MOE_BLOCK
    buf_t = jnp.full((P,), T, jnp.int32).at[dest].set(flat_t[order])
    buf_w = jnp.zeros((P,), xf.dtype).at[dest].set(flat_w[order].astype(xf.dtype))
    block_e = jnp.minimum(jnp.searchsorted(ends, jnp.arange(nb) * MOE_BLOCK, side='right'),
                          N_EXPERTS - 1)
    x_pad = jnp.concatenate([xf, jnp.zeros((1, D), xf.dtype)], axis=0)
    xb = x_pad[buf_t].reshape(nb, MOE_BLOCK, D)

    def expert_block(args):
        xblk, e = args
        hid = jax.nn.silu(xblk @ w_exp_gate[e]) * (xblk @ w_exp_up[e])
        return hid @ w_exp_down[e]

    yb = lax.map(expert_block, (xb, block_e)).reshape(P, D)
    out = jnp.zeros((T + 1, D), xf.dtype).at[buf_t].add(yb * buf_w[:, None])[:T]
    return out.reshape(B, S, D)


def setup_inputs(seed: int = 0) -> dict:
    key = jax.random.key(seed)
    ks = jax.random.split(key, 26)
    nrm = jax.random.normal
    L, D = DEPTH, D_MODEL
    offset = jax.random.randint(ks[2], (BATCH, 1), 0, 1024, dtype=jnp.int32)
    positions = offset + jnp.arange(SEQ, dtype=jnp.int32)[None, :]
    return {
        "x": nrm(ks[0], (BATCH, SEQ, D), jnp.float32),
        "mem": nrm(ks[1], (BATCH, MEM_LEN, D), jnp.float32),
        "positions": positions,
        "w_in": nrm(ks[3], (L, D, IN_WIDTH)) * D ** -0.5,
        "w_gla_a2": nrm(ks[4], (L, GLA_LOWRANK, GLA_HEADS * GLA_DK)) * GLA_LOWRANK ** -0.5,
        "b_gla_a": 0.1 * nrm(ks[5], (L, GLA_HEADS * GLA_DK)),
        "g_gla_norm": 1.0 + 0.02 * nrm(ks[6], (L, GLA_DV)),
        "w_mix_out": nrm(ks[7], (L, MIX_WIDTH, D)) * MIX_WIDTH ** -0.5 * DEEPNORM_BETA,
        "ln1_g": 1.0 + 0.02 * nrm(ks[8], (L, D)),
        "ln1_b": 0.02 * nrm(ks[9], (L, D)),
        "w_mq": nrm(ks[10], (L, D, D)) * D ** -0.5,
        "w_mk": nrm(ks[11], (L, D, D)) * D ** -0.5,
        "w_mv": nrm(ks[12], (L, D, D)) * D ** -0.5,
        "w_mo": nrm(ks[13], (L, D, D)) * D ** -0.5 * DEEPNORM_BETA,
        "ln2_g": 1.0 + 0.02 * nrm(ks[14], (L, D)),
        "ln2_b": 0.02 * nrm(ks[15], (L, D)),
        "w_route_group": nrm(ks[16], (L, D, N_GROUPS)) * D ** -0.5,
        "b_route_group": 0.01 * nrm(ks[17], (L, N_GROUPS)),
        "w_route_expert": nrm(ks[18], (L, D, N_EXPERTS)) * D ** -0.5,
        "b_route_expert": 0.01 * nrm(ks[19], (L, N_GROUPS, EXPERTS_PER_GROUP)),
        "w_exp_gate": nrm(ks[20], (L, N_EXPERTS, D, EXPERT_FF)) * D ** -0.5,
        "w_exp_up": nrm(ks[21], (L, N_EXPERTS, D, EXPERT_FF)) * D ** -0.5,
        "w_exp_down": nrm(ks[22], (L, N_EXPERTS, EXPERT_FF, D)) * EXPERT_FF ** -0.5 * DEEPNORM_BETA,
        "ln3_g": 1.0 + 0.02 * nrm(ks[23], (L, D)),
        "ln3_b": 0.02 * nrm(ks[24], (L, D)),
    }


def reference(x, mem, positions, w_in, w_gla_a2, b_gla_a, g_gla_norm, w_mix_out, ln1_g, ln1_b,
              w_mq, w_mk, w_mv, w_mo, ln2_g, ln2_b, w_route_group, b_route_group,
              w_route_expert, b_route_expert, w_exp_gate, w_exp_up, w_exp_down, ln3_g, ln3_b):
    h = x
    for l in range(DEPTH):
        mix = hybrid_mixer(h, positions, w_in[l], w_gla_a2[l], b_gla_a[l], g_gla_norm[l], w_mix_out[l])
        h = layer_norm(DEEPNORM_ALPHA * h + mix, ln1_g[l], ln1_b[l])
        cross = memory_cross_attention(h, mem, w_mq[l], w_mk[l], w_mv[l], w_mo[l])
        h = layer_norm(DEEPNORM_ALPHA * h + cross, ln2_g[l], ln2_b[l])
        ffn = hierarchical_moe(h, w_route_group[l], b_route_group[l], w_route_expert[l],
                               b_route_expert[l], w_exp_gate[l], w_exp_up[l], w_exp_down[l])
        h = layer_norm(DEEPNORM_ALPHA * h + ffn, ln3_g[l], ln3_b[l])
    return h
```

```cpp
#include <hip/hip_runtime.h>
#include <hip/hip_cooperative_groups.h>
#include <cstdio>
#include <cstdint>
#include <cmath>
#ifndef MK_ONE_LAUNCH
#define MK_ONE_LAUNCH 1
#endif
#ifndef MK_CG_SYNC
#define MK_CG_SYNC 1
#endif
namespace pg8 {
#define PG8_LAS __attribute__((address_space(3)))
typedef unsigned short bf16_t;
typedef short bf16x8 __attribute__((ext_vector_type(8)));
typedef float f32x4 __attribute__((ext_vector_type(4)));
typedef unsigned u32x4 __attribute__((ext_vector_type(4)));
constexpr int BM = 256, BK = 64, HALF = 128, HTB = HALF * BK * 2  , STAGE_BYTES = 8 * HTB, NXCD = 8, WGM = 8;

__host__ __device__ __forceinline__ int lds_byte(int r, int c) { const int st = (r >> 4) * 2 + (c >> 5), rr = r & 15, cc = c & 31, ob = rr * 64 + cc * 2; return st * 1024 + (ob ^ (((ob >> 9) & 1) << 5)); }
__host__ __device__ __forceinline__ void stage_rc(int b, int& R, int& C) { const int st = b / 1024, sb = b % 1024, swz = sb ^ (((sb >> 9) & 1) << 5); R = (st >> 1) * 16 + swz / 64; C = (st & 1) * 32 + (swz % 64) / 2; }
__host__ __device__ __forceinline__ int perm32(int rho) { const int n = rho >> 4, i = rho & 15; return 8 * (i >> 2) + 4 * n + (i & 3); }

struct Unit { int pm, pn; };
struct Gemm { const bf16_t* A; const bf16_t* Bt; int M, N, K; };

struct StaticOrder {
    int nM, nN, nwg, G, c;
    __host__ __device__ void init(int M, int N, int G_, int c_) { nM = M / BM; nN = N / BM; nwg = nM * nN; G = G_; c = c_; }
    __host__ __device__ bool next(int i, Unit& u) const {
        const long L = (long)i * G + c; if (L >= nwg) return false;
        int wgid = (int)L; { const int q = nwg / NXCD, r = nwg % NXCD, xcd = wgid % NXCD, off = wgid / NXCD; wgid = (xcd < r ? xcd * (q + 1) : r * (q + 1) + (xcd - r) * q) + off; }
        const int nig = WGM * nN, gid = wgid / nig, fm = gid * WGM, gsz = (nM - fm) < WGM ? (nM - fm) : WGM;
        u.pm = fm + ((wgid % nig) % gsz); u.pn = (wgid % nig) / gsz; return true;
    }
    __device__ __forceinline__ void a_ready(const Unit&) const {}
    __device__ __forceinline__ void done(const Unit&) const {}
};


__device__ __forceinline__ unsigned cvt_pk_bf16(float lo, float hi) { unsigned r; asm volatile("v_cvt_pk_bf16_f32 %0, %1, %2" : "=v"(r) : "v"(lo), "v"(hi)); return r; }
__device__ __forceinline__ u32x4 pack8(const f32x4 a, const f32x4 b) { u32x4 w; w.x = cvt_pk_bf16(a[0], a[1]); w.y = cvt_pk_bf16(a[2], a[3]); w.z = cvt_pk_bf16(b[0], b[1]); w.w = cvt_pk_bf16(b[2], b[3]); return w; }
__device__ __forceinline__ float silu_f(float x) { return x * __builtin_amdgcn_rcpf(1.0f + __builtin_amdgcn_exp2f(-1.4426950408889634f * x)); }

struct EpiH {
    static constexpr bool PERM = true, AFTER_DRAIN = false;
    bf16_t* H; bf16_t* KVM; const float* rc; const float* rs;
    __device__ __forceinline__ void operator()(const f32x4 (&acc)[2][2][4][2], const Unit& u, int wr, int wc, int fr, int fq) const {
        const int cb = wc * 32 + 8 * fq;
        if (u.pm >= 32) {
#pragma unroll
            for (int ai = 0; ai < 2; ++ai)
#pragma unroll
                for (int m = 0; m < 4; ++m) { bf16_t* rowp = KVM + (size_t)(wr * 64 + fr + ai * HALF + m * 16) * 4096 + (u.pn - 28) * BM + cb;
#pragma unroll
                    for (int bj = 0; bj < 2; ++bj) *(u32x4*)(rowp + bj * HALF) = pack8(acc[ai][bj][m][0], acc[ai][bj][m][1]); }
            return;
        }
        const int row0 = u.pm * BM + wr * 64 + fr;
        if (u.pn < 8) {
            const float sc = u.pn >= 4 ? 0.0625f : 1.0f;
#pragma unroll
            for (int ai = 0; ai < 2; ++ai)
#pragma unroll
                for (int m = 0; m < 4; ++m) { const int row = row0 + ai * HALF + m * 16;
                    const float* cr = rc + (size_t)row * 128 + cb; const float* sr = rs + (size_t)row * 128 + cb;
                    const f32x4 c0 = *(const f32x4*)cr * sc, c1 = *(const f32x4*)(cr + 4) * sc, s0 = *(const f32x4*)sr * sc, s1 = *(const f32x4*)(sr + 4) * sc;
                    const f32x4 t1a = acc[ai][0][m][0], t1b = acc[ai][0][m][1], t2a = acc[ai][1][m][0], t2b = acc[ai][1][m][1];
                    bf16_t* rowp = H + (size_t)row * 7168 + u.pn * BM + cb;
                    *(u32x4*)(rowp) = pack8(t1a * c0 - t2a * s0, t1b * c1 - t2b * s1);
                    *(u32x4*)(rowp + HALF) = pack8(t1a * s0 + t2a * c0, t1b * s1 + t2b * c1); }
        } else {
            const float sc = (u.pn == 16 || u.pn == 17) ? 0.08838834764831845f : 1.0f;
#pragma unroll
            for (int ai = 0; ai < 2; ++ai)
#pragma unroll
                for (int m = 0; m < 4; ++m) { bf16_t* rowp = H + (size_t)(row0 + ai * HALF + m * 16) * 7168 + u.pn * BM + cb;
#pragma unroll
                    for (int bj = 0; bj < 2; ++bj) *(u32x4*)(rowp + bj * HALF) = pack8(acc[ai][bj][m][0] * sc, acc[ai][bj][m][1] * sc); }
        }
    }
};
struct EpiB {
    static constexpr bool PERM = true, AFTER_DRAIN = false;
    bf16_t* O; int ldc; int pmask;
    __device__ __forceinline__ void operator()(const f32x4 (&acc)[2][2][4][2], const Unit& u, int wr, int wc, int fr, int fq) const {
        const int row0 = u.pm * BM + wr * 64 + fr, col0 = (u.pn & pmask) * BM + wc * 32 + 8 * fq;
#pragma unroll
        for (int ai = 0; ai < 2; ++ai)
#pragma unroll
            for (int m = 0; m < 4; ++m) { bf16_t* rowp = O + (size_t)(row0 + ai * HALF + m * 16) * ldc + col0;
#pragma unroll
                for (int bj = 0; bj < 2; ++bj) *(u32x4*)(rowp + bj * HALF) = pack8(acc[ai][bj][m][0], acc[ai][bj][m][1]); }
    }
};
struct EpiSwi {
    static constexpr bool PERM = true, AFTER_DRAIN = false;
    bf16_t* O;
    __device__ __forceinline__ void operator()(const f32x4 (&acc)[2][2][4][2], const Unit& u, int wr, int wc, int fr, int fq) const {
        const int row0 = u.pm * BM + wr * 64 + fr, col0 = (u.pn & 3) * HALF + wc * 32 + 8 * fq;
#pragma unroll
        for (int ai = 0; ai < 2; ++ai)
#pragma unroll
            for (int m = 0; m < 4; ++m) { bf16_t* rowp = O + (size_t)(row0 + ai * HALF + m * 16) * 512 + col0;
                f32x4 h0, h1;
#pragma unroll
                for (int i = 0; i < 4; ++i) { h0[i] = silu_f(acc[ai][0][m][0][i]) * acc[ai][1][m][0][i]; h1[i] = silu_f(acc[ai][0][m][1][i]) * acc[ai][1][m][1][i]; }
                *(u32x4*)rowp = pack8(h0, h1); }
    }
};
struct EpiResX {
    static constexpr bool PERM = false, AFTER_DRAIN = false;
    const float* X; float* Y; float alpha;
    __device__ __forceinline__ void operator()(const f32x4 (&acc)[2][2][4][2], const Unit& u, int wr, int wc, int fr, int fq) const {
        const int row0 = u.pm * BM + wr * 64 + fr, col0 = u.pn * BM + wc * 32 + 4 * fq;
#pragma unroll
        for (int ai = 0; ai < 2; ++ai)
#pragma unroll
            for (int m = 0; m < 4; ++m) { const size_t off = (size_t)(row0 + ai * HALF + m * 16) * 2048 + col0;
#pragma unroll
                for (int bj = 0; bj < 2; ++bj)
#pragma unroll
                    for (int n = 0; n < 2; ++n) { const f32x4 xv = *(const f32x4*)(X + off + bj * HALF + n * 16); *(f32x4*)(Y + off + bj * HALF + n * 16) = xv * alpha + acc[ai][bj][m][n]; } }
    }
};
struct EpiResLN {
    static constexpr bool PERM = false, AFTER_DRAIN = false;
    const float* Yin; const float* st; const float* g; const float* b; float* Y; float alpha;
    __device__ __forceinline__ void operator()(const f32x4 (&acc)[2][2][4][2], const Unit& u, int wr, int wc, int fr, int fq) const {
        const int row0 = u.pm * BM + wr * 64 + fr, col0 = u.pn * BM + wc * 32 + 4 * fq;
        f32x4 gv[2][2], bv[2][2];
#pragma unroll
        for (int bj = 0; bj < 2; ++bj)
#pragma unroll
            for (int n = 0; n < 2; ++n) { gv[bj][n] = *(const f32x4*)(g + col0 + bj * HALF + n * 16) * alpha; bv[bj][n] = *(const f32x4*)(b + col0 + bj * HALF + n * 16) * alpha; }
#pragma unroll
        for (int ai = 0; ai < 2; ++ai)
#pragma unroll
            for (int m = 0; m < 4; ++m) { const int row = row0 + ai * HALF + m * 16; const size_t off = (size_t)row * 2048 + col0;
                const float mu = st[2 * row], rstd = st[2 * row + 1];
#pragma unroll
                for (int bj = 0; bj < 2; ++bj)
#pragma unroll
                    for (int n = 0; n < 2; ++n) { const f32x4 yv = *(const f32x4*)(Yin + off + bj * HALF + n * 16);
                        *(f32x4*)(Y + off + bj * HALF + n * 16) = ((yv - mu) * rstd) * gv[bj][n] + bv[bj][n] + acc[ai][bj][m][n]; } }
    }
};

struct OrderG1 {
    StaticOrder so; int G, c;
    __device__ void init(int G_, int c_) { so.init(8192, 7168, G_, c_); G = G_; c = c_; }
    __device__ bool next(int i, Unit& u) const {
        const int L = i * G + c;
        if (L < 896) return so.next(i, u);
        if (L >= 912) return false;
        u.pm = 32; u.pn = 28 + (L - 896); return true;
    }
    __device__ __forceinline__ void a_ready(const Unit&) const {}
    __device__ __forceinline__ void done(const Unit&) const {}
};
struct MoeOrder {
    const PG8_LAS int* ts; int G, c, npn, total;
    __device__ bool next(int i, Unit& u) const {
        const int L = i * G + c; if (L >= total) return false;
        const int rt = L / npn, pl = L - rt * npn; int e = 0;
        for (int j = 1; j < 32; ++j) e += (ts[j] <= rt) ? 1 : 0;
        u.pm = rt; u.pn = e * npn + pl; return true;
    }
    __device__ __forceinline__ void a_ready(const Unit&) const {}
    __device__ __forceinline__ void done(const Unit&) const {}
};

template <class Epi, class Sched, bool ALIGN_EPI = false, bool SP2 = false>
__device__ __forceinline__ void gemm_phase(PG8_LAS unsigned char* lds, const Gemm g, const Sched& S, const Epi& E) {
    const int tid = threadIdx.x, wid = __builtin_amdgcn_readfirstlane(tid >> 6), lane = tid & 63, wr = wid >> 2, wc = wid & 3, fr = lane & 15, fq = lane >> 4;
    const int K = g.K, nt = K / BK;
    unsigned voffA[2], voffB[2];
#pragma unroll
    for (int i = 0; i < 2; ++i) { int R, C; stage_rc(tid * 16 + i * 8192, R, C); const int Rb = Epi::PERM ? ((R & ~31) + perm32(R & 31)) : R;
        voffA[i] = (unsigned)(R * K + C) * 2u; voffB[i] = (unsigned)(Rb * K + C) * 2u; }
    const size_t kstep = (size_t)(BK * 2);
    const size_t hstep = (size_t)HALF * K * 2;
    const size_t tstep = 2 * hstep;
    const unsigned ldsw = (unsigned)wid * 1024u;
    const int aoff = lds_byte(wr * 64 + fr, fq * 8), boff = lds_byte(wc * 32 + fr, fq * 8);
#define PG8_SA(b, h) (((b) * 2 + (h)) * HTB)
#define PG8_SB(b, h) ((4 + (b) * 2 + (h)) * HTB)
#define PG8_STAGE(bufoff, gbase, voff) do { _Pragma("unroll") for (int _i = 0; _i < 2; ++_i) \
        __builtin_amdgcn_global_load_lds((const unsigned*)((const char*)(gbase) + (voff)[_i]), (PG8_LAS unsigned*)(lds + (bufoff) + ldsw + _i * 8192), 16, 0, 0); } while (0)
#define PG8_LDA(dst, b, h) do { _Pragma("unroll") for (int m = 0; m < 4; ++m) _Pragma("unroll") for (int k = 0; k < 2; ++k) dst[m][k] = *(const PG8_LAS bf16x8*)(lds + PG8_SA(b, h) + aoff + m * 2048 + k * 1024); } while (0)
#define PG8_LDB(dst, b, h) do { _Pragma("unroll") for (int n = 0; n < 2; ++n) _Pragma("unroll") for (int k = 0; k < 2; ++k) dst[n][k] = *(const PG8_LAS bf16x8*)(lds + PG8_SB(b, h) + boff + n * 2048 + k * 1024); } while (0)
#define PG8_MMA(ai, bj, At, Bt) do { __builtin_amdgcn_s_setprio(1); _Pragma("unroll") for (int m = 0; m < 4; ++m) _Pragma("unroll") for (int n = 0; n < 2; ++n) _Pragma("unroll") for (int k = 0; k < 2; ++k) \
        acc[ai][bj][m][n] = __builtin_amdgcn_mfma_f32_16x16x32_bf16(Bt[n][k], At[m][k], acc[ai][bj][m][n], 0, 0, 0); __builtin_amdgcn_s_setprio(0); } while (0)
#define PG8_WAIT_V(n) asm volatile("s_waitcnt vmcnt(" #n ")" ::: "memory")
#define PG8_WAIT_L(n) asm volatile("s_waitcnt lgkmcnt(" #n ")" ::: "memory")
#define PG8_BAR __builtin_amdgcn_s_barrier()
#define PG8_SCHED __builtin_amdgcn_sched_barrier(0)
    Unit cur, nxt; int ui = 0;
    if (!S.next(0, cur)) return;
    f32x4 acc[2][2][4][2];
#pragma unroll
    for (int a = 0; a < 2; ++a)
#pragma unroll
        for (int b = 0; b < 2; ++b)
#pragma unroll
            for (int m = 0; m < 4; ++m)
#pragma unroll
                for (int n = 0; n < 2; ++n) acc[a][b][m][n] = (f32x4){0.f, 0.f, 0.f, 0.f};
    bf16x8 At[4][2], B0[2][2], B1[2][2];
    const char* cA = (const char*)g.A + (size_t)cur.pm * tstep; const char* cB = (const char*)g.Bt + (size_t)cur.pn * tstep;
    S.a_ready(cur);
    if constexpr (SP2) {
        PG8_STAGE(PG8_SB(0, 0), cB, voffB); PG8_STAGE(PG8_SB(0, 1), cB + hstep, voffB); PG8_STAGE(PG8_SA(0, 0), cA, voffA); PG8_STAGE(PG8_SA(0, 1), cA + hstep, voffA);
        if (wr == 1) PG8_BAR;
        PG8_WAIT_V(2); PG8_BAR;
        PG8_STAGE(PG8_SB(1, 0), cB + kstep, voffB); PG8_STAGE(PG8_SA(1, 0), cA + kstep, voffA); PG8_STAGE(PG8_SB(1, 1), cB + hstep + kstep, voffB);
        PG8_WAIT_V(6); PG8_BAR;
    } else {
        PG8_STAGE(PG8_SB(0, 0), cB, voffB); PG8_STAGE(PG8_SA(0, 0), cA, voffA); PG8_STAGE(PG8_SB(0, 1), cB + hstep, voffB); PG8_STAGE(PG8_SA(0, 1), cA + hstep, voffA);
        if (wr == 1) PG8_BAR;
        PG8_WAIT_V(4); PG8_BAR;
        PG8_STAGE(PG8_SB(1, 0), cB + kstep, voffB); PG8_STAGE(PG8_SA(1, 0), cA + kstep, voffA); PG8_STAGE(PG8_SB(1, 1), cB + hstep + kstep, voffB);
        PG8_WAIT_V(6); PG8_BAR;
    }
    for (;;) {
        const bool has_next = S.next(ui + 1, nxt);
        const char* nA = has_next ? (const char*)g.A + (size_t)nxt.pm * tstep : cA; const char* nB = has_next ? (const char*)g.Bt + (size_t)nxt.pn * tstep : cB;
        for (int t = 0; t < nt; t += 2) {
            const bool last = (t == nt - 2);
            const char* a1 = cA + (size_t)(t + 1) * kstep;
            const char* a2 = last ? nA : cA + (size_t)(t + 2) * kstep; const char* b2 = last ? nB : cB + (size_t)(t + 2) * kstep;
            const char* a3 = a2 + kstep; const char* b3 = b2 + kstep;
            if (last && has_next) S.a_ready(nxt);
            if constexpr (SP2) {
            PG8_LDB(B0, 0, 0); PG8_LDB(B1, 0, 1); PG8_SCHED; PG8_LDA(At, 0, 0); PG8_STAGE(PG8_SA(1, 1), a1 + hstep, voffA);
            PG8_WAIT_V(8); PG8_WAIT_L(0); PG8_BAR; PG8_MMA(0, 0, At, B0); PG8_MMA(0, 1, At, B1); PG8_BAR; PG8_SCHED;
            PG8_LDA(At, 0, 1); PG8_STAGE(PG8_SB(0, 0), b2, voffB); PG8_STAGE(PG8_SB(0, 1), b2 + hstep, voffB); PG8_STAGE(PG8_SA(0, 0), a2, voffA);
            PG8_WAIT_V(8); PG8_WAIT_L(0); PG8_BAR; PG8_MMA(1, 0, At, B0); PG8_MMA(1, 1, At, B1); PG8_BAR; PG8_SCHED;
            PG8_LDB(B0, 1, 0); PG8_LDB(B1, 1, 1); PG8_SCHED; PG8_LDA(At, 1, 0); PG8_STAGE(PG8_SA(0, 1), a2 + hstep, voffA);
            PG8_WAIT_V(8); PG8_WAIT_L(0); PG8_BAR; PG8_MMA(0, 0, At, B0); PG8_MMA(0, 1, At, B1); PG8_BAR; PG8_SCHED;
            PG8_LDA(At, 1, 1); PG8_STAGE(PG8_SB(1, 0), b3, voffB); PG8_STAGE(PG8_SB(1, 1), b3 + hstep, voffB); PG8_STAGE(PG8_SA(1, 0), a3, voffA);
            PG8_WAIT_V(8); PG8_WAIT_L(0); PG8_BAR; PG8_MMA(1, 0, At, B0); PG8_MMA(1, 1, At, B1); PG8_BAR; PG8_SCHED;
            } else {
            PG8_LDB(B0, 0, 0); PG8_SCHED; PG8_LDA(At, 0, 0); PG8_STAGE(PG8_SA(1, 1), a1 + hstep, voffA);
            PG8_WAIT_L(8); PG8_BAR; PG8_WAIT_L(0); PG8_MMA(0, 0, At, B0); PG8_BAR; PG8_SCHED;
            PG8_LDB(B1, 0, 1); PG8_STAGE(PG8_SB(0, 0), b2, voffB);
            PG8_BAR; PG8_WAIT_L(0); PG8_MMA(0, 1, At, B1); PG8_BAR;
            PG8_LDA(At, 0, 1); PG8_STAGE(PG8_SA(0, 0), a2, voffA);
            PG8_BAR; PG8_WAIT_L(0); PG8_MMA(1, 0, At, B0); PG8_BAR; PG8_SCHED;
            PG8_STAGE(PG8_SB(0, 1), b2 + hstep, voffB);
            PG8_WAIT_V(6); PG8_BAR; PG8_MMA(1, 1, At, B1); PG8_BAR;
            PG8_LDB(B0, 1, 0); PG8_SCHED; PG8_LDA(At, 1, 0); PG8_STAGE(PG8_SA(0, 1), a2 + hstep, voffA);
            PG8_WAIT_L(8); PG8_BAR; PG8_WAIT_L(0); PG8_MMA(0, 0, At, B0); PG8_BAR; PG8_SCHED;
            PG8_LDB(B1, 1, 1); PG8_STAGE(PG8_SB(1, 0), b3, voffB);
            PG8_BAR; PG8_WAIT_L(0); PG8_MMA(0, 1, At, B1); PG8_BAR;
            PG8_LDA(At, 1, 1); PG8_STAGE(PG8_SA(1, 0), a3, voffA);
            PG8_BAR; PG8_WAIT_L(0); PG8_MMA(1, 0, At, B0); PG8_BAR; PG8_SCHED;
            PG8_STAGE(PG8_SB(1, 1), b3 + hstep, voffB);
            PG8_WAIT_V(6); PG8_BAR; PG8_MMA(1, 1, At, B1); PG8_BAR;
            }
        }
        if constexpr (ALIGN_EPI) { if (wr == 0) PG8_BAR; }
        if constexpr (!Epi::AFTER_DRAIN) { E(acc, cur, wr, wc, fr, fq); S.done(cur); }
        if (!has_next) break;
#pragma unroll
        for (int a = 0; a < 2; ++a)
#pragma unroll
            for (int b = 0; b < 2; ++b)
#pragma unroll
                for (int m = 0; m < 4; ++m)
#pragma unroll
                    for (int n = 0; n < 2; ++n) acc[a][b][m][n] = (f32x4){0.f, 0.f, 0.f, 0.f};
        cur = nxt; cA = nA; cB = nB; ++ui;
        if constexpr (ALIGN_EPI) { if (wr == 1) PG8_BAR; }
    }
    PG8_WAIT_V(0);
    if constexpr (!ALIGN_EPI) { if (wr == 0) PG8_BAR; }
    PG8_BAR;
    if constexpr (Epi::AFTER_DRAIN) { E.fused(acc, cur, wr, wc, fr, fq, lds, wid, lane); S.done(cur); }
#undef PG8_SA
#undef PG8_SB
#undef PG8_STAGE
#undef PG8_LDA
#undef PG8_LDB
#undef PG8_MMA
#undef PG8_WAIT_V
#undef PG8_WAIT_L
#undef PG8_BAR
#undef PG8_SCHED
}
}

constexpr int NWAVES = 8, NTHR = 512;
constexpr int T = 8192, D = 2048, HW = 7168, INW = 7184, MEMN = 256;
constexpr float LN_EPS = 1e-5f;
constexpr float ALPHA = 1.189207115002721f;
constexpr int NPH = 14;
constexpr int PMAX = 24576;

constexpr size_t MiB = 1u << 20;
constexpr size_t WS_CTL = 0, CTL_ZERO_BYTES = 1 * MiB;
constexpr size_t WS_WMIX = 2 * MiB, WS_WMQ = 10 * MiB, WS_WIN = 18 * MiB, WS_WKV = 46 * MiB, WS_WMO = 62 * MiB, WS_WGU = 70 * MiB, WS_WD = 198 * MiB;
constexpr size_t WS_XB = 262 * MiB, WS_MEMB = 294 * MiB;
constexpr size_t WS_H = 296 * MiB;
constexpr size_t WS_KVM = 408 * MiB;
constexpr size_t WS_ORAW = 410 * MiB;
constexpr size_t WS_MIXED = WS_XB;
constexpr size_t WS_Y1 = WS_ORAW;
constexpr size_t WS_H1B = WS_H;
constexpr size_t WS_QB = 328 * MiB, WS_ATT = 360 * MiB;
constexpr size_t WS_Y2 = 474 * MiB;
constexpr size_t WS_H2B = WS_H;
constexpr size_t WS_XS = 328 * MiB;
constexpr size_t WS_HID = 424 * MiB;
constexpr size_t WS_YS = WS_XS;
constexpr size_t WS_SMALL = 540 * MiB;
constexpr size_t WS_GLR = WS_SMALL;
constexpr size_t WS_RC = WS_SMALL + 1 * MiB, WS_RS = WS_SMALL + 5 * MiB;
constexpr size_t WS_ST1 = WS_SMALL + 9 * MiB, WS_ST2 = WS_ST1 + 65536;
constexpr size_t WS_EXP = WS_ST2 + 65536, WS_GATE = WS_EXP + 65536, WS_POS = WS_GATE + 65536;
constexpr size_t WS_END = 552 * MiB;
constexpr int CW_CNT = 64, CW_CUR = 128;
constexpr int CW_BAR = 4096;

constexpr int RING_BYTES = 131072, LDSCTL_OFF = RING_BYTES, MISC_OFF = LDSCTL_OFF + 320, LDS_BYTES = 147456;

#define GAS __attribute__((address_space(1)))
#define LAS __attribute__((address_space(3)))
typedef unsigned short bf16;
typedef unsigned v4u __attribute__((ext_vector_type(4)));
typedef unsigned v2u __attribute__((ext_vector_type(2)));
typedef float f32x4 __attribute__((ext_vector_type(4)));
typedef GAS unsigned gu32;
#define RLX_AGENT __ATOMIC_RELAXED, __HIP_MEMORY_SCOPE_AGENT
#define LDS_WAIT() asm volatile("s_waitcnt lgkmcnt(0)" ::: "memory")
__device__ __forceinline__ unsigned f2bf(float f) { unsigned u = __builtin_bit_cast(unsigned, f); return (u + 0x7fffu + ((u >> 16) & 1u)) >> 16; }
__device__ __forceinline__ unsigned pk2(float lo, float hi) { return f2bf(lo) | (f2bf(hi) << 16); }
__device__ __forceinline__ float bf2f(unsigned h) { return __builtin_bit_cast(float, h << 16); }
__device__ __forceinline__ float bflo(unsigned w) { return __builtin_bit_cast(float, w << 16); }
__device__ __forceinline__ float bfhi(unsigned w) { return __builtin_bit_cast(float, w & 0xffff0000u); }
__device__ __forceinline__ float wave_sum(float v) {
#pragma unroll
    for (int o = 1; o < 64; o <<= 1) v += __shfl_xor(v, o);
    return v;
}
__device__ __forceinline__ float wave_max(float v) {
#pragma unroll
    for (int o = 1; o < 64; o <<= 1) v = fmaxf(v, __shfl_xor(v, o));
    return v;
}

struct Frame {
    LAS unsigned char* lds;
    volatile LAS unsigned* MISC;
    gu32* ctl;
    int tid, lane, wave, G, bid;
    unsigned char* ws;
    const float* in[25];
    float* out;
};
#define WSP(T_, off) ((T_*)(F.ws + (off)))

__device__ __forceinline__ void transpose_item(const float* W, int ldw, bf16* WTr, int ldt, LAS float* scr, int lane) {
#pragma unroll 8
    for (int i = 0; i < 32; ++i) { const int kk = 2 * i + (lane >> 5); scr[kk * 33 + (lane & 31)] = W[(size_t)kk * ldw + (lane & 31)]; }
    LDS_WAIT(); asm volatile("" ::: "memory");
    const int c = lane & 7;
#pragma unroll
    for (int j = 0; j < 4; ++j) { const int n = (lane >> 3) + 8 * j; const LAS float* s = scr + (8 * c) * 33 + n;
        v4u o; o.x = pk2(s[0 * 33], s[1 * 33]); o.y = pk2(s[2 * 33], s[3 * 33]); o.z = pk2(s[4 * 33], s[5 * 33]); o.w = pk2(s[6 * 33], s[7 * 33]);
        *(GAS v4u*)(WTr + (size_t)n * ldt + 8 * c) = o; }
    LDS_WAIT(); asm volatile("" ::: "memory");
}
__device__ __forceinline__ void p0_prologue(Frame& F) {
    LAS float* scr = (LAS float*)(F.lds + F.wave * 16384);
    const int gw = F.bid * NWAVES + F.wave, NGW = F.G * NWAVES;
    const float* w_in = F.in[3];
    constexpr int I_IN = 32 * 224, I_SQ = 32 * 64, I_E = 512;
    constexpr int NIT = I_IN + 5 * I_SQ + 3 * 32 * I_E;
    for (int it = gw; it < NIT; it += NGW) {
        int r = it;
        if (r < I_IN) { const int kb = r / 224, nb = r % 224; transpose_item(w_in + (size_t)(64 * kb) * INW + 32 * nb, INW, WSP(bf16, WS_WIN) + (size_t)(32 * nb) * 2048 + 64 * kb, 2048, scr, F.lane); continue; }
        r -= I_IN;
        if (r < 5 * I_SQ) { const int w = r / I_SQ, q = r % I_SQ, kb = q / 64, nb = q % 64;
            const float* src = w == 0 ? F.in[7] : w == 1 ? F.in[10] : w == 2 ? F.in[11] : w == 3 ? F.in[12] : F.in[13];
            bf16* dst = w == 0 ? WSP(bf16, WS_WMIX) : w == 1 ? WSP(bf16, WS_WMQ) : w == 2 ? WSP(bf16, WS_WKV) : w == 3 ? (WSP(bf16, WS_WKV) + (size_t)2048 * 2048) : WSP(bf16, WS_WMO);
            transpose_item(src + (size_t)(64 * kb) * 2048 + 32 * nb, 2048, dst + (size_t)(32 * nb) * 2048 + 64 * kb, 2048, scr, F.lane); continue; }
        r -= 5 * I_SQ;
        if (r < 2 * 32 * I_E) {
            const int up = r / (32 * I_E), q = r % (32 * I_E), e = q / I_E, q2 = q % I_E, kb = q2 / 16, nb = q2 % 16, n0 = 32 * nb;
            const float* src = (up ? F.in[21] : F.in[20]) + (size_t)e * 2048 * 512 + (size_t)(64 * kb) * 512 + n0;
            bf16* dst = WSP(bf16, WS_WGU) + (size_t)(e * 1024 + (n0 >> 7) * 256 + up * 128 + (n0 & 127)) * 2048 + 64 * kb;
            transpose_item(src, 512, dst, 2048, scr, F.lane); continue; }
        r -= 2 * 32 * I_E;
        {
            const int e = r / I_E, q2 = r % I_E, kb = q2 / 64, nb = q2 % 64;
            const float* src = F.in[22] + (size_t)e * 512 * 2048 + (size_t)(64 * kb) * 2048 + 32 * nb;
            bf16* dst = WSP(bf16, WS_WD) + (size_t)(e * 2048 + 32 * nb) * 512 + 64 * kb;
            transpose_item(src, 2048, dst, 512, scr, F.lane); }
    }
    const int gt = F.bid * NTHR + F.tid, NGT = F.G * NTHR;
    {
        const float* x = F.in[0]; bf16* xb = WSP(bf16, WS_XB);
        for (int i = gt; i < T * D / 8; i += NGT) { const f32x4 a = *(const GAS f32x4*)(x + (size_t)i * 8), b = *(const GAS f32x4*)(x + (size_t)i * 8 + 4);
            v4u o; o.x = pk2(a[0], a[1]); o.y = pk2(a[2], a[3]); o.z = pk2(b[0], b[1]); o.w = pk2(b[2], b[3]); *(GAS v4u*)(xb + (size_t)i * 8) = o; }
        const float* mm = F.in[1]; bf16* mb = WSP(bf16, WS_MEMB);
        for (int i = gt; i < MEMN * D / 8; i += NGT) { const f32x4 a = *(const GAS f32x4*)(mm + (size_t)i * 8), b = *(const GAS f32x4*)(mm + (size_t)i * 8 + 4);
            v4u o; o.x = pk2(a[0], a[1]); o.y = pk2(a[2], a[3]); o.z = pk2(b[0], b[1]); o.w = pk2(b[2], b[3]); *(GAS v4u*)(mb + (size_t)i * 8) = o; }
    }
    {
        const int* pos = (const int*)F.in[2]; float* rc = WSP(float, WS_RC); float* rs = WSP(float, WS_RS);
        for (int i = gt; i < T * 128; i += NGT) { const int t = i >> 7, f = i & 127;
            const float inv = exp2f(-(float)f * (13.287712379549449f / 128.0f));
            const float ang = (float)pos[t] * inv;
            double rev = (double)ang * 0.15915494309189535; rev -= floor(rev);
            const float rf = (float)rev;
            rc[i] = __builtin_amdgcn_cosf(rf); rs[i] = __builtin_amdgcn_sinf(rf); }
    }
    {
        const float* x = F.in[0]; float* glr = WSP(float, WS_GLR);
        const int r16 = F.lane & 15, g4 = F.lane >> 4;
        for (int tile = gw; tile < T / 16; tile += NGW) {
            f32x4 acc = {0.f, 0.f, 0.f, 0.f};
            const float* xr = x + (size_t)(tile * 16 + r16) * D + 4 * g4;
            const float* wr = w_in + (size_t)(4 * g4) * INW + HW + r16;
#pragma unroll 4
            for (int k0 = 0; k0 < D; k0 += 16) {
                const f32x4 a = *(const GAS f32x4*)(xr + k0);
                const float b0 = wr[(size_t)(k0 + 0) * INW], b1 = wr[(size_t)(k0 + 1) * INW], b2 = wr[(size_t)(k0 + 2) * INW], b3 = wr[(size_t)(k0 + 3) * INW];
                acc = __builtin_amdgcn_mfma_f32_16x16x4f32(a[0], b0, acc, 0, 0, 0);
                acc = __builtin_amdgcn_mfma_f32_16x16x4f32(a[1], b1, acc, 0, 0, 0);
                acc = __builtin_amdgcn_mfma_f32_16x16x4f32(a[2], b2, acc, 0, 0, 0);
                acc = __builtin_amdgcn_mfma_f32_16x16x4f32(a[3], b3, acc, 0, 0, 0);
            }
#pragma unroll
            for (int j = 0; j < 4; ++j) glr[(size_t)(tile * 16 + 4 * g4 + j) * 16 + r16] = acc[j];
        }
    }
}

__device__ __forceinline__ float log_sigmoid_f(float z) { return fminf(z, 0.f) - log1pf(expf(-fabsf(z))); }
template <bool GLA>
__device__ __forceinline__ void mixer_naive_item(Frame& F, int hh, int eg) {
    constexpr int ND = GLA ? 4 : 8;
    const bf16* H = WSP(bf16, WS_H); float* oraw = WSP(float, WS_ORAW);
    const int ei = F.tid & 15, dp = F.tid >> 4, e = eg * 16 + ei;
    const int qcol = GLA ? 4096 + hh * 128 : hh * 256, kcol = GLA ? 4608 + hh * 128 : 1024 + hh * 256, vcol = (GLA ? 5120 : 2048) + hh * 256 + e;
    const int ocol = (GLA ? 1024 : 0) + hh * 256 + eg * 16;
    LAS float* red = (LAS float*)F.lds;
    float S[ND];
#pragma unroll
    for (int i = 0; i < ND; ++i) S[i] = 0.f;
    float wa[GLA ? 4 : 1][16]; float ba[GLA ? 4 : 1];
    if (GLA) {
#pragma unroll
        for (int i = 0; i < 4; ++i) { const int d = dp + 32 * i; ba[i] = F.in[5][hh * 128 + d];
#pragma unroll
            for (int r = 0; r < 16; ++r) wa[i][r] = F.in[4][r * 512 + hh * 128 + d]; }
    }
    const float gamma = 1.0f - exp2f(-5.0f - (float)hh);
    const float* glr = WSP(float, WS_GLR);
    for (int t0 = 0; t0 < T; t0 += 8) {
        float part[8];
#pragma unroll
        for (int tt = 0; tt < 8; ++tt) {
            const int t = t0 + tt; const bf16* hr = H + (size_t)t * HW;
            const float v = bf2f(hr[vcol]);
            float g16[16];
            if (GLA) {
#pragma unroll
                for (int r = 0; r < 16; ++r) g16[r] = glr[t * 16 + r];
            }
            float p = 0.f;
#pragma unroll
            for (int i = 0; i < ND; ++i) { const int d = dp + 32 * i;
                const float q = bf2f(hr[qcol + d]), k = bf2f(hr[kcol + d]);
                float a = gamma;
                if (GLA) { float z = ba[i];
#pragma unroll
                    for (int r = 0; r < 16; ++r) z += g16[r] * wa[i][r];
                    a = expf(log_sigmoid_f(z) * 0.0625f); }
                S[i] = a * S[i] + k * v; p += q * S[i]; }
            p += __shfl_xor(p, 16); p += __shfl_xor(p, 32);
            part[tt] = p;
        }
        if (F.lane < 16) {
#pragma unroll
            for (int tt = 0; tt < 8; ++tt) red[(F.wave * 8 + tt) * 16 + F.lane] = part[tt];
        }
        __syncthreads();
        if (F.tid < 128) { const int tt = F.tid >> 4, e2 = F.tid & 15; float s = 0.f;
#pragma unroll
            for (int w = 0; w < 8; ++w) s += red[(w * 8 + tt) * 16 + e2];
            oraw[(size_t)(t0 + tt) * D + ocol + e2] = s; }
        __syncthreads();
    }
}
__device__ __forceinline__ void p2_mixer_naive(Frame& F) {
    for (int item = F.bid; item < 128; item += F.G) {
        const int h8 = item >> 4, eg = item & 15;
        if (h8 < 4) mixer_naive_item<false>(F, h8, eg); else mixer_naive_item<true>(F, h8 - 4, eg);
    }
}
__device__ __forceinline__ void p3_normgate(Frame& F) {
    const bf16* H = WSP(bf16, WS_H); const float* oraw = WSP(float, WS_ORAW); bf16* mixed = WSP(bf16, WS_MIXED);
    const int gw = F.bid * NWAVES + F.wave, NGW = F.G * NWAVES;
    const f32x4 gn = *(const f32x4*)(F.in[6] + 4 * F.lane);
    for (int t = gw; t < T; t += NGW) {
#pragma unroll
        for (int h8 = 0; h8 < 8; ++h8) {
            const f32x4 o = *(const GAS f32x4*)(oraw + (size_t)t * D + h8 * 256 + 4 * F.lane);
            const int gcol = (h8 < 4 ? 3072 : 6144) + (h8 & 3) * 256 + 4 * F.lane;
            const v2u gw2 = *(const GAS v2u*)(H + (size_t)t * HW + gcol);
            const f32x4 gt = {bflo(gw2.x), bfhi(gw2.x), bflo(gw2.y), bfhi(gw2.y)};
            f32x4 y;
            if (h8 < 4) {
                const float mu = wave_sum((o[0] + o[1]) + (o[2] + o[3])) * (1.f / 256.f);
                const f32x4 dd = o - mu;
                const float var = wave_sum((dd[0] * dd[0] + dd[1] * dd[1]) + (dd[2] * dd[2] + dd[3] * dd[3])) * (1.f / 256.f);
                y = dd * (1.0f / sqrtf(var + LN_EPS));
            } else {
                const float ms = wave_sum((o[0] * o[0] + o[1] * o[1]) + (o[2] * o[2] + o[3] * o[3])) * (1.f / 256.f);
                y = o * (1.0f / sqrtf(ms + LN_EPS)) * gn;
            }
            float r[4];
#pragma unroll
            for (int i = 0; i < 4; ++i) { const float g = gt[i]; r[i] = g / (1.0f + expf(-g)) * y[i]; }
            v2u w; w.x = pk2(r[0], r[1]); w.y = pk2(r[2], r[3]);
            *(GAS v2u*)(mixed + (size_t)t * D + h8 * 256 + 4 * F.lane) = w;
        }
    }
}
template <bool ROUTER>
__device__ __forceinline__ void ln_apply(Frame& F, const float* Y, const float* g, const float* b, bf16* HB, float* st) {
    const int gw = F.bid * NWAVES + F.wave, NGW = F.G * NWAVES;
    for (int t = gw; t < T; t += NGW) {
        const GAS f32x4* yr = (const GAS f32x4*)(Y + (size_t)t * D) + F.lane;
        f32x4 v[8]; float s = 0.f;
#pragma unroll
        for (int j = 0; j < 8; ++j) { v[j] = yr[64 * j]; s += (v[j][0] + v[j][1]) + (v[j][2] + v[j][3]); }
        const float mean = wave_sum(s) * (1.f / D); float s2 = 0.f;
#pragma unroll
        for (int j = 0; j < 8; ++j) { v[j] = v[j] - mean; s2 += (v[j][0] * v[j][0] + v[j][1] * v[j][1]) + (v[j][2] * v[j][2] + v[j][3] * v[j][3]); }
        const float rstd = 1.f / sqrtf(wave_sum(s2) * (1.f / D) + LN_EPS);
        if (F.lane == 0) { st[2 * t] = mean; st[2 * t + 1] = rstd; }
        GAS v2u* o8 = (GAS v2u*)(HB + (size_t)t * D) + F.lane;
#pragma unroll
        for (int j = 0; j < 8; ++j) { const f32x4 gv = *(const f32x4*)(g + 4 * F.lane + 256 * j), bv = *(const f32x4*)(b + 4 * F.lane + 256 * j);
            v[j] = v[j] * rstd * gv + bv;
            v2u w; w.x = pk2(v[j][0], v[j][1]); w.y = pk2(v[j][2], v[j][3]); o8[64 * j] = w; }
        if (ROUTER) {
            const float* Wg = F.in[16]; const float* We = F.in[18];
            float lg[4], le[32];
#pragma unroll
            for (int i = 0; i < 4; ++i) lg[i] = 0.f;
#pragma unroll
            for (int i = 0; i < 32; ++i) le[i] = 0.f;
#pragma unroll
            for (int j = 0; j < 8; ++j) {
#pragma unroll
                for (int i = 0; i < 4; ++i) { const int c = 4 * F.lane + 256 * j + i; const float hv = v[j][i];
                    const f32x4 wg = *(const GAS f32x4*)(Wg + (size_t)c * 4);
#pragma unroll
                    for (int q = 0; q < 4; ++q) lg[q] += hv * wg[q];
#pragma unroll
                    for (int q8 = 0; q8 < 8; ++q8) { const f32x4 we = *(const GAS f32x4*)(We + (size_t)c * 32 + 4 * q8);
#pragma unroll
                        for (int q = 0; q < 4; ++q) le[4 * q8 + q] += hv * we[q]; } }
            }
#pragma unroll
            for (int i = 0; i < 4; ++i) lg[i] = wave_sum(lg[i]) + F.in[17][i];
#pragma unroll
            for (int i = 0; i < 32; ++i) le[i] = wave_sum(le[i]);
            int grp = 0; float gm = lg[0];
#pragma unroll
            for (int i = 1; i < 4; ++i) if (lg[i] > gm) { gm = lg[i]; grp = i; }
            float gs = 0.f;
#pragma unroll
            for (int i = 0; i < 4; ++i) gs += expf(lg[i] - gm);
            const float pg_sel = 1.0f / gs;
            float fe[8];
#pragma unroll
            for (int j = 0; j < 8; ++j) { const float a = grp == 0 ? le[j] : grp == 1 ? le[8 + j] : grp == 2 ? le[16 + j] : le[24 + j]; fe[j] = a + F.in[19][grp * 8 + j]; }
            int i1 = 0; float m1 = fe[0];
#pragma unroll
            for (int j = 1; j < 8; ++j) if (fe[j] > m1) { m1 = fe[j]; i1 = j; }
            int i2 = -1; float m2 = -3.0e38f;
#pragma unroll
            for (int j = 0; j < 8; ++j) if (j != i1 && fe[j] > m2) { m2 = fe[j]; i2 = j; }
            const float p2 = expf(m2 - m1), den = 1.0f / (1.0f + p2);
            if (F.lane == 0) {
                int* ex = WSP(int, WS_EXP); float* gt = WSP(float, WS_GATE);
                const int e1 = grp * 8 + i1, e2 = grp * 8 + i2;
                ex[2 * t] = e1; ex[2 * t + 1] = e2; gt[2 * t] = pg_sel * den; gt[2 * t + 1] = pg_sel * p2 * den;
                atomicAdd((unsigned*)(F.ctl + CW_CNT) + e1, 1u); atomicAdd((unsigned*)(F.ctl + CW_CNT) + e2, 1u);
            }
        }
    }
}
__device__ __forceinline__ void p7_attn_naive(Frame& F) {
    const bf16* Q = WSP(bf16, WS_QB); const bf16* KVM = WSP(bf16, WS_KVM); bf16* att = WSP(bf16, WS_ATT);
    LAS float* qs = (LAS float*)F.lds;
    LAS float* sc = (LAS float*)(F.lds + 16384);
    for (int item = F.bid; item < (T / 8) * 4; item += F.G) {
        const int h = item & 3, t0 = (item >> 2) * 8;
        for (int i = F.tid; i < 8 * 512; i += NTHR) { const int tt = i >> 9, d = i & 511; qs[i] = bf2f(Q[(size_t)(t0 + tt) * D + h * 512 + d]); }
        __syncthreads();
        {
            const int j = F.tid & 255, th = F.tid >> 8;
            const bf16* kr = KVM + (size_t)j * 4096 + h * 512;
            float a0 = 0.f, a1 = 0.f, a2 = 0.f, a3 = 0.f;
            for (int d = 0; d < 512; d += 8) {
                const v4u kw = *(const GAS v4u*)(kr + d);
                const float kf[8] = {bflo(kw.x), bfhi(kw.x), bflo(kw.y), bfhi(kw.y), bflo(kw.z), bfhi(kw.z), bflo(kw.w), bfhi(kw.w)};
#pragma unroll
                for (int i = 0; i < 8; ++i) { a0 += kf[i] * qs[(th * 4 + 0) * 512 + d + i]; a1 += kf[i] * qs[(th * 4 + 1) * 512 + d + i]; a2 += kf[i] * qs[(th * 4 + 2) * 512 + d + i]; a3 += kf[i] * qs[(th * 4 + 3) * 512 + d + i]; }
            }
            const float scl = 0.04419417382415922f;
            sc[(th * 4 + 0) * 256 + j] = a0 * scl; sc[(th * 4 + 1) * 256 + j] = a1 * scl; sc[(th * 4 + 2) * 256 + j] = a2 * scl; sc[(th * 4 + 3) * 256 + j] = a3 * scl;
        }
        __syncthreads();
        {
            float v[4]; float mx = -3.0e38f;
#pragma unroll
            for (int i = 0; i < 4; ++i) { v[i] = sc[F.wave * 256 + F.lane + 64 * i]; mx = fmaxf(mx, v[i]); }
            mx = wave_max(mx); float sm = 0.f;
#pragma unroll
            for (int i = 0; i < 4; ++i) { v[i] = expf(v[i] - mx); sm += v[i]; }
            sm = 1.0f / wave_sum(sm);
#pragma unroll
            for (int i = 0; i < 4; ++i) sc[F.wave * 256 + F.lane + 64 * i] = v[i] * sm;
        }
        __syncthreads();
        {
            const int d = F.tid; const bf16* vr = KVM + 2048 + h * 512 + d;
            float o[8];
#pragma unroll
            for (int i = 0; i < 8; ++i) o[i] = 0.f;
            for (int j = 0; j < 256; ++j) { const float vv = bf2f(vr[(size_t)j * 4096]);
#pragma unroll
                for (int i = 0; i < 8; ++i) o[i] += sc[i * 256 + j] * vv; }
#pragma unroll
            for (int i = 0; i < 8; ++i) att[(size_t)(t0 + i) * D + h * 512 + d] = (bf16)f2bf(o[i]);
        }
        __syncthreads();
    }
}
__device__ __forceinline__ void moe_tile_starts(Frame& F, LAS int* ts) {
    if (F.tid == 0) { int acc = 0;
        for (int e = 0; e < 32; ++e) { ts[e] = acc; const unsigned c = __hip_atomic_load(F.ctl + CW_CNT + e, RLX_AGENT); acc += (int)((c + 255u) >> 8); }
        ts[32] = acc; }
    __syncthreads();
}
__device__ __forceinline__ void p10_dispatch(Frame& F, LAS int* ts) {
    const int gw = F.bid * NWAVES + F.wave, NGW = F.G * NWAVES;
    const int* ex = WSP(int, WS_EXP); int* pos = WSP(int, WS_POS); const bf16* h2 = WSP(bf16, WS_H2B); bf16* xs = WSP(bf16, WS_XS);
    for (int a = gw; a < 2 * T; a += NGW) {
        const int e = ex[a]; unsigned slot = 0;
        if (F.lane == 0) slot = atomicAdd((unsigned*)(F.ctl + CW_CUR) + e, 1u);
        slot = __builtin_amdgcn_readfirstlane(slot);
        const int p = ts[e] * 256 + (int)slot;
        if (F.lane == 0) pos[a] = p;
        const GAS v4u* src = (const GAS v4u*)(h2 + (size_t)(a >> 1) * D) + F.lane; GAS v4u* dst = (GAS v4u*)(xs + (size_t)p * D) + F.lane;
#pragma unroll
        for (int j = 0; j < 4; ++j) dst[64 * j] = src[64 * j];
    }
}
__device__ __forceinline__ void p13_combine(Frame& F) {
    const int gw = F.bid * NWAVES + F.wave, NGW = F.G * NWAVES;
    const float* Y2 = WSP(float, WS_Y2); const float* st2 = WSP(float, WS_ST2); const bf16* ys = WSP(bf16, WS_YS);
    const int* pos = WSP(int, WS_POS); const float* gt = WSP(float, WS_GATE);
    const float* g2 = F.in[14]; const float* b2 = F.in[15]; const float* g3 = F.in[23]; const float* b3 = F.in[24];
    for (int t = gw; t < T; t += NGW) {
        const float mu2 = st2[2 * t], rs2 = st2[2 * t + 1];
        const int p0 = pos[2 * t], p1 = pos[2 * t + 1]; const float w0 = gt[2 * t], w1 = gt[2 * t + 1];
        const GAS f32x4* yr = (const GAS f32x4*)(Y2 + (size_t)t * D) + F.lane;
        const GAS v2u* y0 = (const GAS v2u*)(ys + (size_t)p0 * D) + F.lane; const GAS v2u* y1 = (const GAS v2u*)(ys + (size_t)p1 * D) + F.lane;
        f32x4 v[8]; float s = 0.f;
#pragma unroll
        for (int j = 0; j < 8; ++j) { const f32x4 gv = *(const f32x4*)(g2 + 4 * F.lane + 256 * j), bv = *(const f32x4*)(b2 + 4 * F.lane + 256 * j);
            const f32x4 h = (yr[64 * j] - mu2) * rs2 * gv + bv;
            const v2u a = y0[64 * j], c = y1[64 * j];
            const f32x4 fa = {bflo(a.x), bfhi(a.x), bflo(a.y), bfhi(a.y)}, fc = {bflo(c.x), bfhi(c.x), bflo(c.y), bfhi(c.y)};
            v[j] = h * ALPHA + fa * w0 + fc * w1; s += (v[j][0] + v[j][1]) + (v[j][2] + v[j][3]); }
        const float mean = wave_sum(s) * (1.f / D); float s2 = 0.f;
#pragma unroll
        for (int j = 0; j < 8; ++j) { v[j] = v[j] - mean; s2 += (v[j][0] * v[j][0] + v[j][1] * v[j][1]) + (v[j][2] * v[j][2] + v[j][3] * v[j][3]); }
        const float rstd = 1.f / sqrtf(wave_sum(s2) * (1.f / D) + LN_EPS);
        GAS f32x4* orow = (GAS f32x4*)(F.out + (size_t)t * D) + F.lane;
#pragma unroll
        for (int j = 0; j < 8; ++j) { const f32x4 gv = *(const f32x4*)(g3 + 4 * F.lane + 256 * j), bv = *(const f32x4*)(b3 + 4 * F.lane + 256 * j);
            orow[64 * j] = v[j] * rstd * gv + bv; }
    }
}

#define XB_TMO      128
#define XB_XCNT(j)  (256  + 64 * (j))
#define XB_XSUB(j)  (1280 + 64 * (j))
#define XB_XGEN(j)  (2304 + 64 * (j))
#define XB_TOP      3328
#define XB_TOPGEN   3392
#define XCD_BAR_WORDS 3456
#define XB_SPIN_CAP (1u << 22)
__device__ __forceinline__ unsigned xb_ld(unsigned* p)              { return __hip_atomic_load(p, __ATOMIC_RELAXED, __HIP_MEMORY_SCOPE_AGENT); }
__device__ __forceinline__ unsigned xb_add(unsigned* p, unsigned v) { return __hip_atomic_fetch_add(p, v, __ATOMIC_RELAXED, __HIP_MEMORY_SCOPE_AGENT); }
__device__ __forceinline__ unsigned xb_xcc_id() { return (unsigned)__builtin_amdgcn_s_getreg((3 << 11) | 20) & 0xFu; }
#define XB_SPIN(cond, bar) do { unsigned _sp = 0; while (cond) { __builtin_amdgcn_s_sleep(1); \
    if ((++_sp & 255u) == 0u) { if (xb_ld(&(bar)[XB_TMO])) break; if (_sp > XB_SPIN_CAP) { atomicAdd(&(bar)[XB_TMO], 1u); break; } } } } while (0)
struct XcdBarrier { unsigned* bar; unsigned x; volatile LAS unsigned* st; };
__device__ __forceinline__ XcdBarrier xcd_barrier_post(unsigned* bar, volatile LAS unsigned* st) {
    XcdBarrier b; b.bar = bar; b.x = xb_xcc_id(); b.st = st;
    if (threadIdx.x == 0) (void)xb_add(&bar[XB_XCNT(b.x)], 1u);
    return b;
}
__device__ __forceinline__ void xcd_barrier_complete(unsigned* bar, unsigned x, unsigned& nloc, unsigned& nx) {
    const unsigned G = gridDim.x * gridDim.y * gridDim.z;
    unsigned sum, cnt, mine, sp = 0u;
    for (;;) {
        sum = 0u; cnt = 0u; mine = 0u;
#pragma unroll
        for (unsigned j = 0; j < 16; ++j) { const unsigned c = xb_ld(&bar[XB_XCNT(j)]); sum += c; cnt += (c > 0u) ? 1u : 0u; mine = (j == x) ? c : mine; }
        if (sum == G) break;
        __builtin_amdgcn_s_sleep(1);
        if ((++sp & 255u) == 0u) { if (xb_ld(&bar[XB_TMO])) break; if (sp > XB_SPIN_CAP) { atomicAdd(&bar[XB_TMO], 1u); break; } }
    }
    nloc = mine > 0u ? mine : 1u; nx = cnt > 0u ? cnt : 1u;
}
__device__ __forceinline__ void xcd_barrier(const XcdBarrier& b) {
    asm volatile("s_waitcnt vmcnt(0)" ::: "memory");
    __syncthreads();
    if (threadIdx.x == 0) {
        unsigned* bar = b.bar;
        __builtin_amdgcn_s_waitcnt(0);
        unsigned nloc = b.st[0], nx = b.st[1];
        if (nloc == 0u) { xcd_barrier_complete(bar, b.x, nloc, nx); b.st[0] = nloc; b.st[1] = nx; }
        const unsigned old = xb_add(&bar[XB_XSUB(b.x)], 1u);
        const unsigned gen = old / nloc;
        if (old + 1u == (gen + 1u) * nloc) {
            __builtin_amdgcn_fence(__ATOMIC_RELEASE, "agent");
            asm volatile("s_waitcnt vmcnt(0)" ::: "memory");
            const unsigned og = xb_add(&bar[XB_TOP], 1u);
            const unsigned tg = og / nx;
            if (og + 1u == (tg + 1u) * nx) xb_add(&bar[XB_TOPGEN], 1u);
            else XB_SPIN(xb_ld(&bar[XB_TOPGEN]) == tg, bar);
            __builtin_amdgcn_fence(__ATOMIC_ACQUIRE, "agent");
            xb_add(&bar[XB_XGEN(b.x)], 1u);
            asm volatile("s_waitcnt vmcnt(0)" ::: "memory");
        } else {
            XB_SPIN(xb_ld(&bar[XB_XGEN(b.x)]) == gen, bar);
            __builtin_amdgcn_fence(__ATOMIC_ACQUIRE, "agent");
            asm volatile("s_waitcnt vmcnt(0)" ::: "memory");
        }
    }
    __syncthreads();
}

struct Args { const float* in[25]; float* out; unsigned char* ws; int ph_lo, ph_hi, use_bar, pad; };
__global__ void __launch_bounds__(NTHR, 2) mega(Args args) {
    extern __shared__ __attribute__((aligned(16))) unsigned char lds[];
    Frame F;
    F.lds = (LAS unsigned char*)lds;
    F.MISC = (volatile LAS unsigned*)(F.lds + MISC_OFF);
    F.tid = threadIdx.x; F.lane = F.tid & 63; F.wave = __builtin_amdgcn_readfirstlane(F.tid >> 6);
    F.G = gridDim.x; F.bid = blockIdx.x;
    F.ws = args.ws; F.ctl = (gu32*)(args.ws + WS_CTL);
#pragma unroll
    for (int i = 0; i < 25; ++i) F.in[i] = args.in[i];
    F.out = args.out;
    for (int u = F.tid; u < (LDS_BYTES - LDSCTL_OFF) / 4; u += NTHR) ((LAS unsigned*)(F.lds + LDSCTL_OFF))[u] = 0u;
    __syncthreads();
    LAS int* ts = (LAS int*)(F.lds + MISC_OFF + 64);
    XcdBarrier bar; bar.bar = (unsigned*)(F.ctl + CW_BAR); bar.x = 0; bar.st = nullptr;
    if (args.use_bar) bar = xcd_barrier_post((unsigned*)(F.ctl + CW_BAR), F.MISC + 8);
    const int lo = args.ph_lo, hi = args.ph_hi;
#define IN(k) (lo <= (k) && (k) < hi)
#define SEAM(k) do { if (IN(k) && IN((k) + 1)) { if (MK_CG_SYNC && (k) == 0) cooperative_groups::this_grid().sync(); else xcd_barrier(bar); } } while (0)

    if (IN(0)) { p0_prologue(F); SEAM(0); }
    if (IN(1)) {
        pg8::Gemm g{WSP(pg8::bf16_t, WS_XB), WSP(pg8::bf16_t, WS_WIN), T + MEMN, HW + 4096, D}; pg8::OrderG1 S; S.init(F.G, F.bid);
        pg8::EpiH E{WSP(pg8::bf16_t, WS_H), WSP(pg8::bf16_t, WS_KVM), WSP(float, WS_RC), WSP(float, WS_RS)};
        pg8::gemm_phase<pg8::EpiH, pg8::OrderG1, true, true>(F.lds, g, S, E);
        SEAM(1);
    }
    if (IN(2)) { p2_mixer_naive(F); SEAM(2); }
    if (IN(3)) { p3_normgate(F); SEAM(3); }
    if (IN(4)) {
        pg8::Gemm g{WSP(pg8::bf16_t, WS_MIXED), WSP(pg8::bf16_t, WS_WMIX), T, D, D}; pg8::StaticOrder S; S.init(T, D, F.G, F.bid);
        pg8::EpiResX E{F.in[0], WSP(float, WS_Y1), ALPHA};
        pg8::gemm_phase<pg8::EpiResX, pg8::StaticOrder, true, true>(F.lds, g, S, E);
        SEAM(4);
    }
    if (IN(5)) { ln_apply<false>(F, WSP(float, WS_Y1), F.in[8], F.in[9], WSP(bf16, WS_H1B), WSP(float, WS_ST1)); SEAM(5); }
    if (IN(6)) {
        pg8::Gemm g{WSP(pg8::bf16_t, WS_H1B), WSP(pg8::bf16_t, WS_WMQ), T, D, D}; pg8::StaticOrder S; S.init(T, D, F.G, F.bid);
        pg8::EpiB E{WSP(pg8::bf16_t, WS_QB), D, -1};
        pg8::gemm_phase<pg8::EpiB, pg8::StaticOrder, true, true>(F.lds, g, S, E);
        SEAM(6);
    }
    if (IN(7)) { p7_attn_naive(F); SEAM(7); }
    if (IN(8)) {
        pg8::Gemm g{WSP(pg8::bf16_t, WS_ATT), WSP(pg8::bf16_t, WS_WMO), T, D, D}; pg8::StaticOrder S; S.init(T, D, F.G, F.bid);
        pg8::EpiResLN E{WSP(float, WS_Y1), WSP(float, WS_ST1), F.in[8], F.in[9], WSP(float, WS_Y2), ALPHA};
        pg8::gemm_phase<pg8::EpiResLN, pg8::StaticOrder, true, true>(F.lds, g, S, E);
        SEAM(8);
    }
    if (IN(9)) { ln_apply<true>(F, WSP(float, WS_Y2), F.in[14], F.in[15], WSP(bf16, WS_H2B), WSP(float, WS_ST2)); SEAM(9); }
    if (IN(10)) { moe_tile_starts(F, ts); p10_dispatch(F, ts); SEAM(10); }
    if (IN(11)) {
        moe_tile_starts(F, ts);
        pg8::Gemm g{WSP(pg8::bf16_t, WS_XS), WSP(pg8::bf16_t, WS_WGU), PMAX, 32 * 1024, D};
        pg8::MoeOrder S{(const PG8_LAS int*)ts, F.G, F.bid, 4, ts[32] * 4};
        pg8::EpiSwi E{WSP(pg8::bf16_t, WS_HID)};
        pg8::gemm_phase<pg8::EpiSwi, pg8::MoeOrder, true, true>(F.lds, g, S, E);
        SEAM(11);
    }
    if (IN(12)) {
        moe_tile_starts(F, ts);
        pg8::Gemm g{WSP(pg8::bf16_t, WS_HID), WSP(pg8::bf16_t, WS_WD), PMAX, 32 * 2048, 512};
        pg8::MoeOrder S{(const PG8_LAS int*)ts, F.G, F.bid, 8, ts[32] * 8};
        pg8::EpiB E{WSP(pg8::bf16_t, WS_YS), D, 7};
        pg8::gemm_phase<pg8::EpiB, pg8::MoeOrder, true, true>(F.lds, g, S, E);
        SEAM(12);
    }
    if (IN(13)) { p13_combine(F); }
#undef IN
#undef SEAM
}

extern "C" void kernel_launch(void* const* d_in, const int* in_sizes, int n_in, void* d_out, int out_size, void* d_ws, size_t ws_size, hipStream_t stream) {
    static int grid = 0;
    if (grid == 0) {
        if (n_in != 25 || in_sizes[0] != T * D || out_size != T * D || ws_size < WS_END) { fprintf(stderr, "kernel_launch: unexpected shapes / workspace (%d inputs, ws %zu)\n", n_in, ws_size); grid = -1; return; }
        int dev = 0, cus = 0;
        if (hipGetDevice(&dev) != hipSuccess || hipDeviceGetAttribute(&cus, hipDeviceAttributeMultiprocessorCount, dev) != hipSuccess) { grid = -1; return; }
        if (hipFuncSetAttribute((const void*)mega, hipFuncAttributeMaxDynamicSharedMemorySize, LDS_BYTES) != hipSuccess) { fprintf(stderr, "kernel_launch: hipFuncSetAttribute failed\n"); grid = -1; return; }
        int per_cu = 0;
        if (hipOccupancyMaxActiveBlocksPerMultiprocessor(&per_cu, (const void*)mega, NTHR, LDS_BYTES) != hipSuccess || per_cu < 1) { fprintf(stderr, "kernel_launch: occupancy query failed / 0 blocks per CU\n"); grid = -1; return; }
        (void)hipGetLastError();
        grid = cus;
    }
    if (grid < 0) return;
    if (hipMemsetAsync((char*)d_ws + WS_CTL, 0, CTL_ZERO_BYTES, stream) != hipSuccess) return;
    Args a{};
    for (int i = 0; i < 25; ++i) a.in[i] = (const float*)d_in[i];
    a.out = (float*)d_out; a.ws = (unsigned char*)d_ws;
#if MK_ONE_LAUNCH
    a.ph_lo = 0; a.ph_hi = NPH; a.use_bar = 1;
#if MK_CG_SYNC
    { void* kargs[] = {(void*)&a};
      hipError_t e = hipLaunchCooperativeKernel((const void*)mega, dim3(grid), dim3(NTHR), kargs, LDS_BYTES, stream);
      if (e != hipSuccess) fprintf(stderr, "cooperative launch failed: %s (grid %d)\n", hipGetErrorString(e), grid); }
#else
    hipLaunchKernelGGL(mega, dim3(grid), dim3(NTHR), LDS_BYTES, stream, a);
#endif
#else
    for (int p = 0; p < NPH; ++p) { a.ph_lo = p; a.ph_hi = p + 1; a.use_bar = 0;
        hipLaunchKernelGGL(mega, dim3(grid), dim3(NTHR), LDS_BYTES, stream, a); }
#endif
}
```

```cpp
#include <hip/hip_runtime.h>
#include <hip/hip_cooperative_groups.h>
#include <cstdio>
#include <cstdint>
#include <cmath>
#ifndef MK_ONE_LAUNCH
#define MK_ONE_LAUNCH 1
#endif
#ifndef MK_CG_SYNC
#define MK_CG_SYNC 1
#endif
namespace pg8 {
#define PG8_LAS __attribute__((address_space(3)))
typedef unsigned short bf16_t;
typedef short bf16x8 __attribute__((ext_vector_type(8)));
typedef float f32x4 __attribute__((ext_vector_type(4)));
typedef unsigned u32x4 __attribute__((ext_vector_type(4)));
constexpr int BM = 256, BK = 64, HALF = 128, HTB = HALF * BK * 2  , STAGE_BYTES = 8 * HTB, NXCD = 8, WGM = 8;

__host__ __device__ __forceinline__ int lds_byte(int r, int c) { const int st = (r >> 4) * 2 + (c >> 5), rr = r & 15, cc = c & 31, ob = rr * 64 + cc * 2; return st * 1024 + (ob ^ (((ob >> 9) & 1) << 5)); }
__host__ __device__ __forceinline__ void stage_rc(int b, int& R, int& C) { const int st = b / 1024, sb = b % 1024, swz = sb ^ (((sb >> 9) & 1) << 5); R = (st >> 1) * 16 + swz / 64; C = (st & 1) * 32 + (swz % 64) / 2; }
__host__ __device__ __forceinline__ int perm32(int rho) { const int n = rho >> 4, i = rho & 15; return 8 * (i >> 2) + 4 * n + (i & 3); }

struct Unit { int pm, pn; };
struct Gemm { const bf16_t* A; const bf16_t* Bt; int M, N, K; };

struct StaticOrder {
    int nM, nN, nwg, G, c;
    __host__ __device__ void init(int M, int N, int G_, int c_) { nM = M / BM; nN = N / BM; nwg = nM * nN; G = G_; c = c_; }
    __host__ __device__ bool next(int i, Unit& u) const {
        const long L = (long)i * G + c; if (L >= nwg) return false;
        int wgid = (int)L; { const int q = nwg / NXCD, r = nwg % NXCD, xcd = wgid % NXCD, off = wgid / NXCD; wgid = (xcd < r ? xcd * (q + 1) : r * (q + 1) + (xcd - r) * q) + off; }
        const int nig = WGM * nN, gid = wgid / nig, fm = gid * WGM, gsz = (nM - fm) < WGM ? (nM - fm) : WGM;
        u.pm = fm + ((wgid % nig) % gsz); u.pn = (wgid % nig) / gsz; return true;
    }
    __device__ __forceinline__ void a_ready(const Unit&) const {}
    __device__ __forceinline__ void done(const Unit&) const {}
};


__device__ __forceinline__ unsigned cvt_pk_bf16(float lo, float hi) { unsigned r; asm volatile("v_cvt_pk_bf16_f32 %0, %1, %2" : "=v"(r) : "v"(lo), "v"(hi)); return r; }
__device__ __forceinline__ u32x4 pack8(const f32x4 a, const f32x4 b) { u32x4 w; w.x = cvt_pk_bf16(a[0], a[1]); w.y = cvt_pk_bf16(a[2], a[3]); w.z = cvt_pk_bf16(b[0], b[1]); w.w = cvt_pk_bf16(b[2], b[3]); return w; }
__device__ __forceinline__ float silu_f(float x) { return x * __builtin_amdgcn_rcpf(1.0f + __builtin_amdgcn_exp2f(-1.4426950408889634f * x)); }

struct EpiH {
    static constexpr bool PERM = true, AFTER_DRAIN = false;
    bf16_t* H; bf16_t* KVM; const float* rc; const float* rs;
    __device__ __forceinline__ void operator()(const f32x4 (&acc)[2][2][4][2], const Unit& u, int wr, int wc, int fr, int fq) const {
        const int cb = wc * 32 + 8 * fq;
        if (u.pm >= 32) {
#pragma unroll
            for (int ai = 0; ai < 2; ++ai)
#pragma unroll
                for (int m = 0; m < 4; ++m) { bf16_t* rowp = KVM + (size_t)(wr * 64 + fr + ai * HALF + m * 16) * 4096 + (u.pn - 28) * BM + cb;
#pragma unroll
                    for (int bj = 0; bj < 2; ++bj) *(u32x4*)(rowp + bj * HALF) = pack8(acc[ai][bj][m][0], acc[ai][bj][m][1]); }
            return;
        }
        const int row0 = u.pm * BM + wr * 64 + fr;
        if (u.pn < 8) {
            const float sc = u.pn >= 4 ? 0.0625f : 1.0f;
#pragma unroll
            for (int ai = 0; ai < 2; ++ai)
#pragma unroll
                for (int m = 0; m < 4; ++m) { const int row = row0 + ai * HALF + m * 16;
                    const float* cr = rc + (size_t)row * 128 + cb; const float* sr = rs + (size_t)row * 128 + cb;
                    const f32x4 c0 = *(const f32x4*)cr * sc, c1 = *(const f32x4*)(cr + 4) * sc, s0 = *(const f32x4*)sr * sc, s1 = *(const f32x4*)(sr + 4) * sc;
                    const f32x4 t1a = acc[ai][0][m][0], t1b = acc[ai][0][m][1], t2a = acc[ai][1][m][0], t2b = acc[ai][1][m][1];
                    bf16_t* rowp = H + (size_t)row * 7168 + u.pn * BM + cb;
                    *(u32x4*)(rowp) = pack8(t1a * c0 - t2a * s0, t1b * c1 - t2b * s1);
                    *(u32x4*)(rowp + HALF) = pack8(t1a * s0 + t2a * c0, t1b * s1 + t2b * c1); }
        } else {
            const float sc = (u.pn == 16 || u.pn == 17) ? 0.08838834764831845f : 1.0f;
#pragma unroll
            for (int ai = 0; ai < 2; ++ai)
#pragma unroll
                for (int m = 0; m < 4; ++m) { bf16_t* rowp = H + (size_t)(row0 + ai * HALF + m * 16) * 7168 + u.pn * BM + cb;
#pragma unroll
                    for (int bj = 0; bj < 2; ++bj) *(u32x4*)(rowp + bj * HALF) = pack8(acc[ai][bj][m][0] * sc, acc[ai][bj][m][1] * sc); }
        }
    }
};
struct EpiB {
    static constexpr bool PERM = true, AFTER_DRAIN = false;
    bf16_t* O; int ldc; int pmask;
    __device__ __forceinline__ void operator()(const f32x4 (&acc)[2][2][4][2], const Unit& u, int wr, int wc, int fr, int fq) const {
        const int row0 = u.pm * BM + wr * 64 + fr, col0 = (u.pn & pmask) * BM + wc * 32 + 8 * fq;
#pragma unroll
        for (int ai = 0; ai < 2; ++ai)
#pragma unroll
            for (int m = 0; m < 4; ++m) { bf16_t* rowp = O + (size_t)(row0 + ai * HALF + m * 16) * ldc + col0;
#pragma unroll
                for (int bj = 0; bj < 2; ++bj) *(u32x4*)(rowp + bj * HALF) = pack8(acc[ai][bj][m][0], acc[ai][bj][m][1]); }
    }
};
struct EpiSwi {
    static constexpr bool PERM = true, AFTER_DRAIN = false;
    bf16_t* O;
    __device__ __forceinline__ void operator()(const f32x4 (&acc)[2][2][4][2], const Unit& u, int wr, int wc, int fr, int fq) const {
        const int row0 = u.pm * BM + wr * 64 + fr, col0 = (u.pn & 3) * HALF + wc * 32 + 8 * fq;
#pragma unroll
        for (int ai = 0; ai < 2; ++ai)
#pragma unroll
            for (int m = 0; m < 4; ++m) { bf16_t* rowp = O + (size_t)(row0 + ai * HALF + m * 16) * 512 + col0;
                f32x4 h0, h1;
#pragma unroll
                for (int i = 0; i < 4; ++i) { h0[i] = silu_f(acc[ai][0][m][0][i]) * acc[ai][1][m][0][i]; h1[i] = silu_f(acc[ai][0][m][1][i]) * acc[ai][1][m][1][i]; }
                *(u32x4*)rowp = pack8(h0, h1); }
    }
};
struct EpiResX {
    static constexpr bool PERM = false, AFTER_DRAIN = false;
    const float* X; float* Y; float alpha;
    __device__ __forceinline__ void operator()(const f32x4 (&acc)[2][2][4][2], const Unit& u, int wr, int wc, int fr, int fq) const {
        const int row0 = u.pm * BM + wr * 64 + fr, col0 = u.pn * BM + wc * 32 + 4 * fq;
#pragma unroll
        for (int ai = 0; ai < 2; ++ai)
#pragma unroll
            for (int m = 0; m < 4; ++m) { const size_t off = (size_t)(row0 + ai * HALF + m * 16) * 2048 + col0;
#pragma unroll
                for (int bj = 0; bj < 2; ++bj)
#pragma unroll
                    for (int n = 0; n < 2; ++n) { const f32x4 xv = *(const f32x4*)(X + off + bj * HALF + n * 16); *(f32x4*)(Y + off + bj * HALF + n * 16) = xv * alpha + acc[ai][bj][m][n]; } }
    }
};
struct EpiResLN {
    static constexpr bool PERM = false, AFTER_DRAIN = false;
    const float* Yin; const float* st; const float* g; const float* b; float* Y; float alpha;
    __device__ __forceinline__ void operator()(const f32x4 (&acc)[2][2][4][2], const Unit& u, int wr, int wc, int fr, int fq) const {
        const int row0 = u.pm * BM + wr * 64 + fr, col0 = u.pn * BM + wc * 32 + 4 * fq;
        f32x4 gv[2][2], bv[2][2];
#pragma unroll
        for (int bj = 0; bj < 2; ++bj)
#pragma unroll
            for (int n = 0; n < 2; ++n) { gv[bj][n] = *(const f32x4*)(g + col0 + bj * HALF + n * 16) * alpha; bv[bj][n] = *(const f32x4*)(b + col0 + bj * HALF + n * 16) * alpha; }
#pragma unroll
        for (int ai = 0; ai < 2; ++ai)
#pragma unroll
            for (int m = 0; m < 4; ++m) { const int row = row0 + ai * HALF + m * 16; const size_t off = (size_t)row * 2048 + col0;
                const float mu = st[2 * row], rstd = st[2 * row + 1];
#pragma unroll
                for (int bj = 0; bj < 2; ++bj)
#pragma unroll
                    for (int n = 0; n < 2; ++n) { const f32x4 yv = *(const f32x4*)(Yin + off + bj * HALF + n * 16);
                        *(f32x4*)(Y + off + bj * HALF + n * 16) = ((yv - mu) * rstd) * gv[bj][n] + bv[bj][n] + acc[ai][bj][m][n]; } }
    }
};

struct OrderG1 {
    StaticOrder so; int G, c;
    __device__ void init(int G_, int c_) { so.init(8192, 7168, G_, c_); G = G_; c = c_; }
    __device__ bool next(int i, Unit& u) const {
        const int L = i * G + c;
        if (L < 896) return so.next(i, u);
        if (L >= 912) return false;
        u.pm = 32; u.pn = 28 + (L - 896); return true;
    }
    __device__ __forceinline__ void a_ready(const Unit&) const {}
    __device__ __forceinline__ void done(const Unit&) const {}
};
struct MoeOrder {
    const PG8_LAS int* ts; int G, c, npn, total;
    __device__ bool next(int i, Unit& u) const {
        const int L = i * G + c; if (L >= total) return false;
        const int rt = L / npn, pl = L - rt * npn; int e = 0;
        for (int j = 1; j < 32; ++j) e += (ts[j] <= rt) ? 1 : 0;
        u.pm = rt; u.pn = e * npn + pl; return true;
    }
    __device__ __forceinline__ void a_ready(const Unit&) const {}
    __device__ __forceinline__ void done(const Unit&) const {}
};

template <class Epi, class Sched, bool ALIGN_EPI = false, bool SP2 = false>
__device__ __forceinline__ void gemm_phase(PG8_LAS unsigned char* lds, const Gemm g, const Sched& S, const Epi& E) {
    const int tid = threadIdx.x, wid = __builtin_amdgcn_readfirstlane(tid >> 6), lane = tid & 63, wr = wid >> 2, wc = wid & 3, fr = lane & 15, fq = lane >> 4;
    const int K = g.K, nt = K / BK;
    unsigned voffA[2], voffB[2];
#pragma unroll
    for (int i = 0; i < 2; ++i) { int R, C; stage_rc(tid * 16 + i * 8192, R, C); const int Rb = Epi::PERM ? ((R & ~31) + perm32(R & 31)) : R;
        voffA[i] = (unsigned)(R * K + C) * 2u; voffB[i] = (unsigned)(Rb * K + C) * 2u; }
    const size_t kstep = (size_t)(BK * 2);
    const size_t hstep = (size_t)HALF * K * 2;
    const size_t tstep = 2 * hstep;
    const unsigned ldsw = (unsigned)wid * 1024u;
    const int aoff = lds_byte(wr * 64 + fr, fq * 8), boff = lds_byte(wc * 32 + fr, fq * 8);
#define PG8_SA(b, h) (((b) * 2 + (h)) * HTB)
#define PG8_SB(b, h) ((4 + (b) * 2 + (h)) * HTB)
#define PG8_STAGE(bufoff, gbase, voff) do { _Pragma("unroll") for (int _i = 0; _i < 2; ++_i) \
        __builtin_amdgcn_global_load_lds((const unsigned*)((const char*)(gbase) + (voff)[_i]), (PG8_LAS unsigned*)(lds + (bufoff) + ldsw + _i * 8192), 16, 0, 0); } while (0)
#define PG8_LDA(dst, b, h) do { _Pragma("unroll") for (int m = 0; m < 4; ++m) _Pragma("unroll") for (int k = 0; k < 2; ++k) dst[m][k] = *(const PG8_LAS bf16x8*)(lds + PG8_SA(b, h) + aoff + m * 2048 + k * 1024); } while (0)
#define PG8_LDB(dst, b, h) do { _Pragma("unroll") for (int n = 0; n < 2; ++n) _Pragma("unroll") for (int k = 0; k < 2; ++k) dst[n][k] = *(const PG8_LAS bf16x8*)(lds + PG8_SB(b, h) + boff + n * 2048 + k * 1024); } while (0)
#define PG8_MMA(ai, bj, At, Bt) do { __builtin_amdgcn_s_setprio(1); _Pragma("unroll") for (int m = 0; m < 4; ++m) _Pragma("unroll") for (int n = 0; n < 2; ++n) _Pragma("unroll") for (int k = 0; k < 2; ++k) \
        acc[ai][bj][m][n] = __builtin_amdgcn_mfma_f32_16x16x32_bf16(Bt[n][k], At[m][k], acc[ai][bj][m][n], 0, 0, 0); __builtin_amdgcn_s_setprio(0); } while (0)
#define PG8_WAIT_V(n) asm volatile("s_waitcnt vmcnt(" #n ")" ::: "memory")
#define PG8_WAIT_L(n) asm volatile("s_waitcnt lgkmcnt(" #n ")" ::: "memory")
#define PG8_BAR __builtin_amdgcn_s_barrier()
#define PG8_SCHED __builtin_amdgcn_sched_barrier(0)
    Unit cur, nxt; int ui = 0;
    if (!S.next(0, cur)) return;
    f32x4 acc[2][2][4][2];
#pragma unroll
    for (int a = 0; a < 2; ++a)
#pragma unroll
        for (int b = 0; b < 2; ++b)
#pragma unroll
            for (int m = 0; m < 4; ++m)
#pragma unroll
                for (int n = 0; n < 2; ++n) acc[a][b][m][n] = (f32x4){0.f, 0.f, 0.f, 0.f};
    bf16x8 At[4][2], B0[2][2], B1[2][2];
    const char* cA = (const char*)g.A + (size_t)cur.pm * tstep; const char* cB = (const char*)g.Bt + (size_t)cur.pn * tstep;
    S.a_ready(cur);
    if constexpr (SP2) {
        PG8_STAGE(PG8_SB(0, 0), cB, voffB); PG8_STAGE(PG8_SB(0, 1), cB + hstep, voffB); PG8_STAGE(PG8_SA(0, 0), cA, voffA); PG8_STAGE(PG8_SA(0, 1), cA + hstep, voffA);
        if (wr == 1) PG8_BAR;
        PG8_WAIT_V(2); PG8_BAR;
        PG8_STAGE(PG8_SB(1, 0), cB + kstep, voffB); PG8_STAGE(PG8_SA(1, 0), cA + kstep, voffA); PG8_STAGE(PG8_SB(1, 1), cB + hstep + kstep, voffB);
        PG8_WAIT_V(6); PG8_BAR;
    } else {
        PG8_STAGE(PG8_SB(0, 0), cB, voffB); PG8_STAGE(PG8_SA(0, 0), cA, voffA); PG8_STAGE(PG8_SB(0, 1), cB + hstep, voffB); PG8_STAGE(PG8_SA(0, 1), cA + hstep, voffA);
        if (wr == 1) PG8_BAR;
        PG8_WAIT_V(4); PG8_BAR;
        PG8_STAGE(PG8_SB(1, 0), cB + kstep, voffB); PG8_STAGE(PG8_SA(1, 0), cA + kstep, voffA); PG8_STAGE(PG8_SB(1, 1), cB + hstep + kstep, voffB);
        PG8_WAIT_V(6); PG8_BAR;
    }
    for (;;) {
        const bool has_next = S.next(ui + 1, nxt);
        const char* nA = has_next ? (const char*)g.A + (size_t)nxt.pm * tstep : cA; const char* nB = has_next ? (const char*)g.Bt + (size_t)nxt.pn * tstep : cB;
        for (int t = 0; t < nt; t += 2) {
            const bool last = (t == nt - 2);
            const char* a1 = cA + (size_t)(t + 1) * kstep;
            const char* a2 = last ? nA : cA + (size_t)(t + 2) * kstep; const char* b2 = last ? nB : cB + (size_t)(t + 2) * kstep;
            const char* a3 = a2 + kstep; const char* b3 = b2 + kstep;
            if (last && has_next) S.a_ready(nxt);
            if constexpr (SP2) {
            PG8_LDB(B0, 0, 0); PG8_LDB(B1, 0, 1); PG8_SCHED; PG8_LDA(At, 0, 0); PG8_STAGE(PG8_SA(1, 1), a1 + hstep, voffA);
            PG8_WAIT_V(8); PG8_WAIT_L(0); PG8_BAR; PG8_MMA(0, 0, At, B0); PG8_MMA(0, 1, At, B1); PG8_BAR; PG8_SCHED;
            PG8_LDA(At, 0, 1); PG8_STAGE(PG8_SB(0, 0), b2, voffB); PG8_STAGE(PG8_SB(0, 1), b2 + hstep, voffB); PG8_STAGE(PG8_SA(0, 0), a2, voffA);
            PG8_WAIT_V(8); PG8_WAIT_L(0); PG8_BAR; PG8_MMA(1, 0, At, B0); PG8_MMA(1, 1, At, B1); PG8_BAR; PG8_SCHED;
            PG8_LDB(B0, 1, 0); PG8_LDB(B1, 1, 1); PG8_SCHED; PG8_LDA(At, 1, 0); PG8_STAGE(PG8_SA(0, 1), a2 + hstep, voffA);
            PG8_WAIT_V(8); PG8_WAIT_L(0); PG8_BAR; PG8_MMA(0, 0, At, B0); PG8_MMA(0, 1, At, B1); PG8_BAR; PG8_SCHED;
            PG8_LDA(At, 1, 1); PG8_STAGE(PG8_SB(1, 0), b3, voffB); PG8_STAGE(PG8_SB(1, 1), b3 + hstep, voffB); PG8_STAGE(PG8_SA(1, 0), a3, voffA);
            PG8_WAIT_V(8); PG8_WAIT_L(0); PG8_BAR; PG8_MMA(1, 0, At, B0); PG8_MMA(1, 1, At, B1); PG8_BAR; PG8_SCHED;
            } else {
            PG8_LDB(B0, 0, 0); PG8_SCHED; PG8_LDA(At, 0, 0); PG8_STAGE(PG8_SA(1, 1), a1 + hstep, voffA);
            PG8_WAIT_L(8); PG8_BAR; PG8_WAIT_L(0); PG8_MMA(0, 0, At, B0); PG8_BAR; PG8_SCHED;
            PG8_LDB(B1, 0, 1); PG8_STAGE(PG8_SB(0, 0), b2, voffB);
            PG8_BAR; PG8_WAIT_L(0); PG8_MMA(0, 1, At, B1); PG8_BAR;
            PG8_LDA(At, 0, 1); PG8_STAGE(PG8_SA(0, 0), a2, voffA);
            PG8_BAR; PG8_WAIT_L(0); PG8_MMA(1, 0, At, B0); PG8_BAR; PG8_SCHED;
            PG8_STAGE(PG8_SB(0, 1), b2 + hstep, voffB);
            PG8_WAIT_V(6); PG8_BAR; PG8_MMA(1, 1, At, B1); PG8_BAR;
            PG8_LDB(B0, 1, 0); PG8_SCHED; PG8_LDA(At, 1, 0); PG8_STAGE(PG8_SA(0, 1), a2 + hstep, voffA);
            PG8_WAIT_L(8); PG8_BAR; PG8_WAIT_L(0); PG8_MMA(0, 0, At, B0); PG8_BAR; PG8_SCHED;
            PG8_LDB(B1, 1, 1); PG8_STAGE(PG8_SB(1, 0), b3, voffB);
            PG8_BAR; PG8_WAIT_L(0); PG8_MMA(0, 1, At, B1); PG8_BAR;
            PG8_LDA(At, 1, 1); PG8_STAGE(PG8_SA(1, 0), a3, voffA);
            PG8_BAR; PG8_WAIT_L(0); PG8_MMA(1, 0, At, B0); PG8_BAR; PG8_SCHED;
            PG8_STAGE(PG8_SB(1, 1), b3 + hstep, voffB);
            PG8_WAIT_V(6); PG8_BAR; PG8_MMA(1, 1, At, B1); PG8_BAR;
            }
        }
        if constexpr (ALIGN_EPI) { if (wr == 0) PG8_BAR; }
        if constexpr (!Epi::AFTER_DRAIN) { E(acc, cur, wr, wc, fr, fq); S.done(cur); }
        if (!has_next) break;
#pragma unroll
        for (int a = 0; a < 2; ++a)
#pragma unroll
            for (int b = 0; b < 2; ++b)
#pragma unroll
                for (int m = 0; m < 4; ++m)
#pragma unroll
                    for (int n = 0; n < 2; ++n) acc[a][b][m][n] = (f32x4){0.f, 0.f, 0.f, 0.f};
        cur = nxt; cA = nA; cB = nB; ++ui;
        if constexpr (ALIGN_EPI) { if (wr == 1) PG8_BAR; }
    }
    PG8_WAIT_V(0);
    if constexpr (!ALIGN_EPI) { if (wr == 0) PG8_BAR; }
    PG8_BAR;
    if constexpr (Epi::AFTER_DRAIN) { E.fused(acc, cur, wr, wc, fr, fq, lds, wid, lane); S.done(cur); }
#undef PG8_SA
#undef PG8_SB
#undef PG8_STAGE
#undef PG8_LDA
#undef PG8_LDB
#undef PG8_MMA
#undef PG8_WAIT_V
#undef PG8_WAIT_L
#undef PG8_BAR
#undef PG8_SCHED
}
}

constexpr int NWAVES = 8, NTHR = 512;
constexpr int T = 8192, D = 2048, HW = 7168, INW = 7184, MEMN = 256;
constexpr float LN_EPS = 1e-5f;
constexpr float ALPHA = 1.189207115002721f;
constexpr int NPH = 15;
constexpr int PMAX = 24576;

constexpr size_t MiB = 1u << 20;
constexpr size_t WS_CTL = 0, CTL_ZERO_BYTES = 1 * MiB;
constexpr size_t WS_WMIX = 2 * MiB, WS_WMQ = 10 * MiB, WS_WIN = 18 * MiB, WS_WKV = 46 * MiB, WS_WMO = 62 * MiB, WS_WGU = 70 * MiB, WS_WD = 198 * MiB;
constexpr size_t WS_XB = 262 * MiB, WS_MEMB = 294 * MiB;
constexpr size_t WS_H = 296 * MiB;
constexpr size_t WS_KVM = 408 * MiB;
constexpr size_t WS_ORAW = 410 * MiB;
constexpr size_t WS_MIXED = WS_XB;
constexpr size_t WS_Y1 = WS_ORAW;
constexpr size_t WS_H1B = WS_H;
constexpr size_t WS_QB = 328 * MiB, WS_ATT = 360 * MiB;
constexpr size_t WS_Y2 = 474 * MiB;
constexpr size_t WS_H2B = WS_H;
constexpr size_t WS_XS = 328 * MiB;
constexpr size_t WS_HID = 424 * MiB;
constexpr size_t WS_YS = WS_XS;
constexpr size_t WS_SMALL = 540 * MiB;
constexpr size_t WS_GLR = WS_SMALL;
constexpr size_t WS_RC = WS_SMALL + 1 * MiB, WS_RS = WS_SMALL + 5 * MiB;
constexpr size_t WS_ST1 = WS_SMALL + 9 * MiB, WS_ST2 = WS_ST1 + 65536;
constexpr size_t WS_EXP = WS_ST2 + 65536, WS_GATE = WS_EXP + 65536, WS_POS = WS_GATE + 65536;
constexpr size_t WS_END = 552 * MiB;
constexpr int CW_CNT = 64, CW_CUR = 128;
constexpr int CW_BAR = 4096;

constexpr int RING_BYTES = 131072, LDSCTL_OFF = RING_BYTES, MISC_OFF = LDSCTL_OFF + 320, LDS_BYTES = 147456;

#define GAS __attribute__((address_space(1)))
#define LAS __attribute__((address_space(3)))
typedef unsigned short bf16;
typedef unsigned v4u __attribute__((ext_vector_type(4)));
typedef unsigned v2u __attribute__((ext_vector_type(2)));
typedef float f32x4 __attribute__((ext_vector_type(4)));
typedef GAS unsigned gu32;
#define RLX_AGENT __ATOMIC_RELAXED, __HIP_MEMORY_SCOPE_AGENT
#define LDS_WAIT() asm volatile("s_waitcnt lgkmcnt(0)" ::: "memory")
__device__ __forceinline__ unsigned f2bf(float f) { unsigned u = __builtin_bit_cast(unsigned, f); return (u + 0x7fffu + ((u >> 16) & 1u)) >> 16; }
__device__ __forceinline__ unsigned pk2(float lo, float hi) { return f2bf(lo) | (f2bf(hi) << 16); }
__device__ __forceinline__ float bf2f(unsigned h) { return __builtin_bit_cast(float, h << 16); }
__device__ __forceinline__ float bflo(unsigned w) { return __builtin_bit_cast(float, w << 16); }
__device__ __forceinline__ float bfhi(unsigned w) { return __builtin_bit_cast(float, w & 0xffff0000u); }
__device__ __forceinline__ float wave_sum(float v) {
#pragma unroll
    for (int o = 1; o < 64; o <<= 1) v += __shfl_xor(v, o);
    return v;
}
__device__ __forceinline__ float wave_max(float v) {
#pragma unroll
    for (int o = 1; o < 64; o <<= 1) v = fmaxf(v, __shfl_xor(v, o));
    return v;
}

struct Frame {
    LAS unsigned char* lds;
    volatile LAS unsigned* MISC;
    gu32* ctl;
    int tid, lane, wave, G, bid;
    unsigned char* ws;
    const float* in[25];
    float* out;
};
#define WSP(T_, off) ((T_*)(F.ws + (off)))

__device__ __forceinline__ void transpose_item(const float* W, int ldw, bf16* WTr, int ldt, LAS float* scr, int lane) {
#pragma unroll 8
    for (int i = 0; i < 32; ++i) { const int kk = 2 * i + (lane >> 5); scr[kk * 33 + (lane & 31)] = W[(size_t)kk * ldw + (lane & 31)]; }
    LDS_WAIT(); asm volatile("" ::: "memory");
    const int c = lane & 7;
#pragma unroll
    for (int j = 0; j < 4; ++j) { const int n = (lane >> 3) + 8 * j; const LAS float* s = scr + (8 * c) * 33 + n;
        v4u o; o.x = pk2(s[0 * 33], s[1 * 33]); o.y = pk2(s[2 * 33], s[3 * 33]); o.z = pk2(s[4 * 33], s[5 * 33]); o.w = pk2(s[6 * 33], s[7 * 33]);
        *(GAS v4u*)(WTr + (size_t)n * ldt + 8 * c) = o; }
    LDS_WAIT(); asm volatile("" ::: "memory");
}
__device__ __forceinline__ void p0_prologue(Frame& F) {
    LAS float* scr = (LAS float*)(F.lds + F.wave * 16384);
    const int gw = F.bid * NWAVES + F.wave, NGW = F.G * NWAVES;
    const float* w_in = F.in[3];
    constexpr int I_IN = 32 * 224, I_SQ = 32 * 64, I_E = 512;
    constexpr int NIT = I_IN + 5 * I_SQ + 3 * 32 * I_E;
    for (int it = gw; it < NIT; it += NGW) {
        int r = it;
        if (r < I_IN) { const int kb = r / 224, nb = r % 224; transpose_item(w_in + (size_t)(64 * kb) * INW + 32 * nb, INW, WSP(bf16, WS_WIN) + (size_t)(32 * nb) * 2048 + 64 * kb, 2048, scr, F.lane); continue; }
        r -= I_IN;
        if (r < 5 * I_SQ) { const int w = r / I_SQ, q = r % I_SQ, kb = q / 64, nb = q % 64;
            const float* src = w == 0 ? F.in[7] : w == 1 ? F.in[10] : w == 2 ? F.in[11] : w == 3 ? F.in[12] : F.in[13];
            bf16* dst = w == 0 ? WSP(bf16, WS_WMIX) : w == 1 ? WSP(bf16, WS_WMQ) : w == 2 ? WSP(bf16, WS_WKV) : w == 3 ? (WSP(bf16, WS_WKV) + (size_t)2048 * 2048) : WSP(bf16, WS_WMO);
            transpose_item(src + (size_t)(64 * kb) * 2048 + 32 * nb, 2048, dst + (size_t)(32 * nb) * 2048 + 64 * kb, 2048, scr, F.lane); continue; }
        r -= 5 * I_SQ;
        if (r < 2 * 32 * I_E) {
            const int up = r / (32 * I_E), q = r % (32 * I_E), e = q / I_E, q2 = q % I_E, kb = q2 / 16, nb = q2 % 16, n0 = 32 * nb;
            const float* src = (up ? F.in[21] : F.in[20]) + (size_t)e * 2048 * 512 + (size_t)(64 * kb) * 512 + n0;
            bf16* dst = WSP(bf16, WS_WGU) + (size_t)(e * 1024 + (n0 >> 7) * 256 + up * 128 + (n0 & 127)) * 2048 + 64 * kb;
            transpose_item(src, 512, dst, 2048, scr, F.lane); continue; }
        r -= 2 * 32 * I_E;
        {
            const int e = r / I_E, q2 = r % I_E, kb = q2 / 64, nb = q2 % 64;
            const float* src = F.in[22] + (size_t)e * 512 * 2048 + (size_t)(64 * kb) * 2048 + 32 * nb;
            bf16* dst = WSP(bf16, WS_WD) + (size_t)(e * 2048 + 32 * nb) * 512 + 64 * kb;
            transpose_item(src, 2048, dst, 512, scr, F.lane); }
    }
    const int gt = F.bid * NTHR + F.tid, NGT = F.G * NTHR;
    {
        const float* x = F.in[0]; bf16* xb = WSP(bf16, WS_XB);
        for (int i = gt; i < T * D / 8; i += NGT) { const f32x4 a = *(const GAS f32x4*)(x + (size_t)i * 8), b = *(const GAS f32x4*)(x + (size_t)i * 8 + 4);
            v4u o; o.x = pk2(a[0], a[1]); o.y = pk2(a[2], a[3]); o.z = pk2(b[0], b[1]); o.w = pk2(b[2], b[3]); *(GAS v4u*)(xb + (size_t)i * 8) = o; }
        const float* mm = F.in[1]; bf16* mb = WSP(bf16, WS_MEMB);
        for (int i = gt; i < MEMN * D / 8; i += NGT) { const f32x4 a = *(const GAS f32x4*)(mm + (size_t)i * 8), b = *(const GAS f32x4*)(mm + (size_t)i * 8 + 4);
            v4u o; o.x = pk2(a[0], a[1]); o.y = pk2(a[2], a[3]); o.z = pk2(b[0], b[1]); o.w = pk2(b[2], b[3]); *(GAS v4u*)(mb + (size_t)i * 8) = o; }
    }
    {
        const int* pos = (const int*)F.in[2]; float* rc = WSP(float, WS_RC); float* rs = WSP(float, WS_RS);
        for (int i = gt; i < T * 128; i += NGT) { const int t = i >> 7, f = i & 127;
            const float inv = exp2f(-(float)f * (13.287712379549449f / 128.0f));
            const float ang = (float)pos[t] * inv;
            double rev = (double)ang * 0.15915494309189535; rev -= floor(rev);
            const float rf = (float)rev;
            rc[i] = __builtin_amdgcn_cosf(rf); rs[i] = __builtin_amdgcn_sinf(rf); }
    }
    {
        const float* x = F.in[0]; float* glr = WSP(float, WS_GLR);
        const int r16 = F.lane & 15, g4 = F.lane >> 4;
        for (int tile = gw; tile < T / 16; tile += NGW) {
            f32x4 acc = {0.f, 0.f, 0.f, 0.f};
            const float* xr = x + (size_t)(tile * 16 + r16) * D + 4 * g4;
            const float* wr = w_in + (size_t)(4 * g4) * INW + HW + r16;
#pragma unroll 4
            for (int k0 = 0; k0 < D; k0 += 16) {
                const f32x4 a = *(const GAS f32x4*)(xr + k0);
                const float b0 = wr[(size_t)(k0 + 0) * INW], b1 = wr[(size_t)(k0 + 1) * INW], b2 = wr[(size_t)(k0 + 2) * INW], b3 = wr[(size_t)(k0 + 3) * INW];
                acc = __builtin_amdgcn_mfma_f32_16x16x4f32(a[0], b0, acc, 0, 0, 0);
                acc = __builtin_amdgcn_mfma_f32_16x16x4f32(a[1], b1, acc, 0, 0, 0);
                acc = __builtin_amdgcn_mfma_f32_16x16x4f32(a[2], b2, acc, 0, 0, 0);
                acc = __builtin_amdgcn_mfma_f32_16x16x4f32(a[3], b3, acc, 0, 0, 0);
            }
#pragma unroll
            for (int j = 0; j < 4; ++j) glr[(size_t)(tile * 16 + 4 * g4 + j) * 16 + r16] = acc[j];
        }
    }
}

__device__ __forceinline__ float log_sigmoid_f(float z) { return fminf(z, 0.f) - log1pf(expf(-fabsf(z))); }
template <bool GLA>
__device__ __forceinline__ void mixer_naive_item(Frame& F, int hh, int eg) {
    constexpr int ND = GLA ? 4 : 8;
    const bf16* H = WSP(bf16, WS_H); float* oraw = WSP(float, WS_ORAW);
    const int ei = F.tid & 15, dp = F.tid >> 4, e = eg * 16 + ei;
    const int qcol = GLA ? 4096 + hh * 128 : hh * 256, kcol = GLA ? 4608 + hh * 128 : 1024 + hh * 256, vcol = (GLA ? 5120 : 2048) + hh * 256 + e;
    const int ocol = (GLA ? 1024 : 0) + hh * 256 + eg * 16;
    LAS float* red = (LAS float*)F.lds;
    float S[ND];
#pragma unroll
    for (int i = 0; i < ND; ++i) S[i] = 0.f;
    float wa[GLA ? 4 : 1][16]; float ba[GLA ? 4 : 1];
    if (GLA) {
#pragma unroll
        for (int i = 0; i < 4; ++i) { const int d = dp + 32 * i; ba[i] = F.in[5][hh * 128 + d];
#pragma unroll
            for (int r = 0; r < 16; ++r) wa[i][r] = F.in[4][r * 512 + hh * 128 + d]; }
    }
    const float gamma = 1.0f - exp2f(-5.0f - (float)hh);
    const float* glr = WSP(float, WS_GLR);
    for (int t0 = 0; t0 < T; t0 += 8) {
        float part[8];
#pragma unroll
        for (int tt = 0; tt < 8; ++tt) {
            const int t = t0 + tt; const bf16* hr = H + (size_t)t * HW;
            const float v = bf2f(hr[vcol]);
            float g16[16];
            if (GLA) {
#pragma unroll
                for (int r = 0; r < 16; ++r) g16[r] = glr[t * 16 + r];
            }
            float p = 0.f;
#pragma unroll
            for (int i = 0; i < ND; ++i) { const int d = dp + 32 * i;
                const float q = bf2f(hr[qcol + d]), k = bf2f(hr[kcol + d]);
                float a = gamma;
                if (GLA) { float z = ba[i];
#pragma unroll
                    for (int r = 0; r < 16; ++r) z += g16[r] * wa[i][r];
                    a = expf(log_sigmoid_f(z) * 0.0625f); }
                S[i] = a * S[i] + k * v; p += q * S[i]; }
            p += __shfl_xor(p, 16); p += __shfl_xor(p, 32);
            part[tt] = p;
        }
        if (F.lane < 16) {
#pragma unroll
            for (int tt = 0; tt < 8; ++tt) red[(F.wave * 8 + tt) * 16 + F.lane] = part[tt];
        }
        __syncthreads();
        if (F.tid < 128) { const int tt = F.tid >> 4, e2 = F.tid & 15; float s = 0.f;
#pragma unroll
            for (int w = 0; w < 8; ++w) s += red[(w * 8 + tt) * 16 + e2];
            oraw[(size_t)(t0 + tt) * D + ocol + e2] = s; }
        __syncthreads();
    }
}
__device__ __forceinline__ void p2_mixer_naive(Frame& F) {
    for (int item = F.bid; item < 128; item += F.G) {
        const int h8 = item >> 4, eg = item & 15;
        if (h8 < 4) mixer_naive_item<false>(F, h8, eg); else mixer_naive_item<true>(F, h8 - 4, eg);
    }
}
__device__ __forceinline__ void p3_normgate(Frame& F) {
    const bf16* H = WSP(bf16, WS_H); const float* oraw = WSP(float, WS_ORAW); bf16* mixed = WSP(bf16, WS_MIXED);
    const int gw = F.bid * NWAVES + F.wave, NGW = F.G * NWAVES;
    const f32x4 gn = *(const f32x4*)(F.in[6] + 4 * F.lane);
    for (int t = gw; t < T; t += NGW) {
#pragma unroll
        for (int h8 = 0; h8 < 8; ++h8) {
            const f32x4 o = *(const GAS f32x4*)(oraw + (size_t)t * D + h8 * 256 + 4 * F.lane);
            const int gcol = (h8 < 4 ? 3072 : 6144) + (h8 & 3) * 256 + 4 * F.lane;
            const v2u gw2 = *(const GAS v2u*)(H + (size_t)t * HW + gcol);
            const f32x4 gt = {bflo(gw2.x), bfhi(gw2.x), bflo(gw2.y), bfhi(gw2.y)};
            f32x4 y;
            if (h8 < 4) {
                const float mu = wave_sum((o[0] + o[1]) + (o[2] + o[3])) * (1.f / 256.f);
                const f32x4 dd = o - mu;
                const float var = wave_sum((dd[0] * dd[0] + dd[1] * dd[1]) + (dd[2] * dd[2] + dd[3] * dd[3])) * (1.f / 256.f);
                y = dd * (1.0f / sqrtf(var + LN_EPS));
            } else {
                const float ms = wave_sum((o[0] * o[0] + o[1] * o[1]) + (o[2] * o[2] + o[3] * o[3])) * (1.f / 256.f);
                y = o * (1.0f / sqrtf(ms + LN_EPS)) * gn;
            }
            float r[4];
#pragma unroll
            for (int i = 0; i < 4; ++i) { const float g = gt[i]; r[i] = g / (1.0f + expf(-g)) * y[i]; }
            v2u w; w.x = pk2(r[0], r[1]); w.y = pk2(r[2], r[3]);
            *(GAS v2u*)(mixed + (size_t)t * D + h8 * 256 + 4 * F.lane) = w;
        }
    }
}
template <bool ROUTER>
__device__ __forceinline__ void ln_apply(Frame& F, const float* Y, const float* g, const float* b, bf16* HB, float* st) {
    const int gw = F.bid * NWAVES + F.wave, NGW = F.G * NWAVES;
    for (int t = gw; t < T; t += NGW) {
        const GAS f32x4* yr = (const GAS f32x4*)(Y + (size_t)t * D) + F.lane;
        f32x4 v[8]; float s = 0.f;
#pragma unroll
        for (int j = 0; j < 8; ++j) { v[j] = yr[64 * j]; s += (v[j][0] + v[j][1]) + (v[j][2] + v[j][3]); }
        const float mean = wave_sum(s) * (1.f / D); float s2 = 0.f;
#pragma unroll
        for (int j = 0; j < 8; ++j) { v[j] = v[j] - mean; s2 += (v[j][0] * v[j][0] + v[j][1] * v[j][1]) + (v[j][2] * v[j][2] + v[j][3] * v[j][3]); }
        const float rstd = 1.f / sqrtf(wave_sum(s2) * (1.f / D) + LN_EPS);
        if (F.lane == 0) { st[2 * t] = mean; st[2 * t + 1] = rstd; }
        GAS v2u* o8 = (GAS v2u*)(HB + (size_t)t * D) + F.lane;
#pragma unroll
        for (int j = 0; j < 8; ++j) { const f32x4 gv = *(const f32x4*)(g + 4 * F.lane + 256 * j), bv = *(const f32x4*)(b + 4 * F.lane + 256 * j);
            v[j] = v[j] * rstd * gv + bv;
            v2u w; w.x = pk2(v[j][0], v[j][1]); w.y = pk2(v[j][2], v[j][3]); o8[64 * j] = w; }
        if (ROUTER) {
            const float* Wg = F.in[16]; const float* We = F.in[18];
            float lg[4], le[32];
#pragma unroll
            for (int i = 0; i < 4; ++i) lg[i] = 0.f;
#pragma unroll
            for (int i = 0; i < 32; ++i) le[i] = 0.f;
#pragma unroll
            for (int j = 0; j < 8; ++j) {
#pragma unroll
                for (int i = 0; i < 4; ++i) { const int c = 4 * F.lane + 256 * j + i; const float hv = v[j][i];
                    const f32x4 wg = *(const GAS f32x4*)(Wg + (size_t)c * 4);
#pragma unroll
                    for (int q = 0; q < 4; ++q) lg[q] += hv * wg[q];
#pragma unroll
                    for (int q8 = 0; q8 < 8; ++q8) { const f32x4 we = *(const GAS f32x4*)(We + (size_t)c * 32 + 4 * q8);
#pragma unroll
                        for (int q = 0; q < 4; ++q) le[4 * q8 + q] += hv * we[q]; } }
            }
#pragma unroll
            for (int i = 0; i < 4; ++i) lg[i] = wave_sum(lg[i]) + F.in[17][i];
#pragma unroll
            for (int i = 0; i < 32; ++i) le[i] = wave_sum(le[i]);
            int grp = 0; float gm = lg[0];
#pragma unroll
            for (int i = 1; i < 4; ++i) if (lg[i] > gm) { gm = lg[i]; grp = i; }
            float gs = 0.f;
#pragma unroll
            for (int i = 0; i < 4; ++i) gs += expf(lg[i] - gm);
            const float pg_sel = 1.0f / gs;
            float fe[8];
#pragma unroll
            for (int j = 0; j < 8; ++j) { const float a = grp == 0 ? le[j] : grp == 1 ? le[8 + j] : grp == 2 ? le[16 + j] : le[24 + j]; fe[j] = a + F.in[19][grp * 8 + j]; }
            int i1 = 0; float m1 = fe[0];
#pragma unroll
            for (int j = 1; j < 8; ++j) if (fe[j] > m1) { m1 = fe[j]; i1 = j; }
            int i2 = -1; float m2 = -3.0e38f;
#pragma unroll
            for (int j = 0; j < 8; ++j) if (j != i1 && fe[j] > m2) { m2 = fe[j]; i2 = j; }
            const float p2 = expf(m2 - m1), den = 1.0f / (1.0f + p2);
            if (F.lane == 0) {
                int* ex = WSP(int, WS_EXP); float* gt = WSP(float, WS_GATE);
                const int e1 = grp * 8 + i1, e2 = grp * 8 + i2;
                ex[2 * t] = e1; ex[2 * t + 1] = e2; gt[2 * t] = pg_sel * den; gt[2 * t + 1] = pg_sel * p2 * den;
                atomicAdd((unsigned*)(F.ctl + CW_CNT) + e1, 1u); atomicAdd((unsigned*)(F.ctl + CW_CNT) + e2, 1u);
            }
        }
    }
}
__device__ __forceinline__ void p7_attn_naive(Frame& F) {
    const bf16* Q = WSP(bf16, WS_QB); const bf16* KVM = WSP(bf16, WS_KVM); bf16* att = WSP(bf16, WS_ATT);
    LAS float* qs = (LAS float*)F.lds;
    LAS float* sc = (LAS float*)(F.lds + 16384);
    for (int item = F.bid; item < (T / 8) * 4; item += F.G) {
        const int h = item & 3, t0 = (item >> 2) * 8;
        for (int i = F.tid; i < 8 * 512; i += NTHR) { const int tt = i >> 9, d = i & 511; qs[i] = bf2f(Q[(size_t)(t0 + tt) * D + h * 512 + d]); }
        __syncthreads();
        {
            const int j = F.tid & 255, th = F.tid >> 8;
            const bf16* kr = KVM + (size_t)j * 4096 + h * 512;
            float a0 = 0.f, a1 = 0.f, a2 = 0.f, a3 = 0.f;
            for (int d = 0; d < 512; d += 8) {
                const v4u kw = *(const GAS v4u*)(kr + d);
                const float kf[8] = {bflo(kw.x), bfhi(kw.x), bflo(kw.y), bfhi(kw.y), bflo(kw.z), bfhi(kw.z), bflo(kw.w), bfhi(kw.w)};
#pragma unroll
                for (int i = 0; i < 8; ++i) { a0 += kf[i] * qs[(th * 4 + 0) * 512 + d + i]; a1 += kf[i] * qs[(th * 4 + 1) * 512 + d + i]; a2 += kf[i] * qs[(th * 4 + 2) * 512 + d + i]; a3 += kf[i] * qs[(th * 4 + 3) * 512 + d + i]; }
            }
            const float scl = 0.04419417382415922f;
            sc[(th * 4 + 0) * 256 + j] = a0 * scl; sc[(th * 4 + 1) * 256 + j] = a1 * scl; sc[(th * 4 + 2) * 256 + j] = a2 * scl; sc[(th * 4 + 3) * 256 + j] = a3 * scl;
        }
        __syncthreads();
        {
            float v[4]; float mx = -3.0e38f;
#pragma unroll
            for (int i = 0; i < 4; ++i) { v[i] = sc[F.wave * 256 + F.lane + 64 * i]; mx = fmaxf(mx, v[i]); }
            mx = wave_max(mx); float sm = 0.f;
#pragma unroll
            for (int i = 0; i < 4; ++i) { v[i] = expf(v[i] - mx); sm += v[i]; }
            sm = 1.0f / wave_sum(sm);
#pragma unroll
            for (int i = 0; i < 4; ++i) sc[F.wave * 256 + F.lane + 64 * i] = v[i] * sm;
        }
        __syncthreads();
        {
            const int d = F.tid; const bf16* vr = KVM + 2048 + h * 512 + d;
            float o[8];
#pragma unroll
            for (int i = 0; i < 8; ++i) o[i] = 0.f;
            for (int j = 0; j < 256; ++j) { const float vv = bf2f(vr[(size_t)j * 4096]);
#pragma unroll
                for (int i = 0; i < 8; ++i) o[i] += sc[i * 256 + j] * vv; }
#pragma unroll
            for (int i = 0; i < 8; ++i) att[(size_t)(t0 + i) * D + h * 512 + d] = (bf16)f2bf(o[i]);
        }
        __syncthreads();
    }
}
__device__ __forceinline__ void moe_tile_starts(Frame& F, LAS int* ts) {
    if (F.tid == 0) { int acc = 0;
        for (int e = 0; e < 32; ++e) { ts[e] = acc; const unsigned c = __hip_atomic_load(F.ctl + CW_CNT + e, RLX_AGENT); acc += (int)((c + 255u) >> 8); }
        ts[32] = acc; }
    __syncthreads();
}
__device__ __forceinline__ void p10_dispatch(Frame& F, LAS int* ts) {
    const int gw = F.bid * NWAVES + F.wave, NGW = F.G * NWAVES;
    const int* ex = WSP(int, WS_EXP); int* pos = WSP(int, WS_POS); const bf16* h2 = WSP(bf16, WS_H2B); bf16* xs = WSP(bf16, WS_XS);
    for (int a = gw; a < 2 * T; a += NGW) {
        const int e = ex[a]; unsigned slot = 0;
        if (F.lane == 0) slot = atomicAdd((unsigned*)(F.ctl + CW_CUR) + e, 1u);
        slot = __builtin_amdgcn_readfirstlane(slot);
        const int p = ts[e] * 256 + (int)slot;
        if (F.lane == 0) pos[a] = p;
        const GAS v4u* src = (const GAS v4u*)(h2 + (size_t)(a >> 1) * D) + F.lane; GAS v4u* dst = (GAS v4u*)(xs + (size_t)p * D) + F.lane;
#pragma unroll
        for (int j = 0; j < 4; ++j) dst[64 * j] = src[64 * j];
    }
}
__device__ __forceinline__ void p13_combine(Frame& F) {
    const int gw = F.bid * NWAVES + F.wave, NGW = F.G * NWAVES;
    const float* Y2 = WSP(float, WS_Y2); const float* st2 = WSP(float, WS_ST2); const bf16* ys = WSP(bf16, WS_YS);
    const int* pos = WSP(int, WS_POS); const float* gt = WSP(float, WS_GATE);
    const float* g2 = F.in[14]; const float* b2 = F.in[15]; const float* g3 = F.in[23]; const float* b3 = F.in[24];
    for (int t = gw; t < T; t += NGW) {
        const float mu2 = st2[2 * t], rs2 = st2[2 * t + 1];
        const int p0 = pos[2 * t], p1 = pos[2 * t + 1]; const float w0 = gt[2 * t], w1 = gt[2 * t + 1];
        const GAS f32x4* yr = (const GAS f32x4*)(Y2 + (size_t)t * D) + F.lane;
        const GAS v2u* y0 = (const GAS v2u*)(ys + (size_t)p0 * D) + F.lane; const GAS v2u* y1 = (const GAS v2u*)(ys + (size_t)p1 * D) + F.lane;
        f32x4 v[8]; float s = 0.f;
#pragma unroll
        for (int j = 0; j < 8; ++j) { const f32x4 gv = *(const f32x4*)(g2 + 4 * F.lane + 256 * j), bv = *(const f32x4*)(b2 + 4 * F.lane + 256 * j);
            const f32x4 h = (yr[64 * j] - mu2) * rs2 * gv + bv;
            const v2u a = y0[64 * j], c = y1[64 * j];
            const f32x4 fa = {bflo(a.x), bfhi(a.x), bflo(a.y), bfhi(a.y)}, fc = {bflo(c.x), bfhi(c.x), bflo(c.y), bfhi(c.y)};
            v[j] = h * ALPHA + fa * w0 + fc * w1; s += (v[j][0] + v[j][1]) + (v[j][2] + v[j][3]); }
        const float mean = wave_sum(s) * (1.f / D); float s2 = 0.f;
#pragma unroll
        for (int j = 0; j < 8; ++j) { v[j] = v[j] - mean; s2 += (v[j][0] * v[j][0] + v[j][1] * v[j][1]) + (v[j][2] * v[j][2] + v[j][3] * v[j][3]); }
        const float rstd = 1.f / sqrtf(wave_sum(s2) * (1.f / D) + LN_EPS);
        GAS f32x4* orow = (GAS f32x4*)(F.out + (size_t)t * D) + F.lane;
#pragma unroll
        for (int j = 0; j < 8; ++j) { const f32x4 gv = *(const f32x4*)(g3 + 4 * F.lane + 256 * j), bv = *(const f32x4*)(b3 + 4 * F.lane + 256 * j);
            orow[64 * j] = v[j] * rstd * gv + bv; }
    }
}

constexpr int CS = 128, NB = CS / 64, NS = T / CS;
constexpr size_t WS_BCUM = WS_ORAW;
constexpr size_t WS_KVR = WS_ORAW + 16 * MiB;
constexpr size_t WS_KVG = WS_KVR + 32 * MiB;
typedef short bf16x8_t __attribute__((ext_vector_type(8)));
typedef short s16x4_t __attribute__((ext_vector_type(4)));
__device__ __forceinline__ s16x4_t lds_tr(const LAS unsigned char* p) { return __builtin_bit_cast(s16x4_t, __builtin_amdgcn_ds_read_tr16_b64_v4i16((LAS s16x4_t*)p)); }
__device__ __forceinline__ bf16x8_t frag_tr(const LAS unsigned char* X, int pitch, int k0, int n0, int lane) {
    const int fq = lane >> 4, q = (lane >> 2) & 3, p = lane & 3;
    const LAS unsigned char* a = X + ((k0 + 8 * fq + q) * pitch + n0 + 4 * p) * 2;
    const s16x4_t lo = lds_tr(a), hi = lds_tr(a + 4 * pitch * 2);
    return __builtin_shufflevector(lo, hi, 0, 1, 2, 3, 4, 5, 6, 7);
}
__device__ __forceinline__ bf16x8_t frag_row(const LAS unsigned char* X, int pitch, int r0, int k0, int lane) {
    return *(const LAS bf16x8_t*)(X + ((r0 + (lane & 15)) * pitch + k0 + 8 * (lane >> 4)) * 2);
}
#define MFMA16(a, b, c) __builtin_amdgcn_mfma_f32_16x16x32_bf16((a), (b), (c), 0, 0, 0)
__device__ __forceinline__ float fexp(float x) { return __builtin_amdgcn_exp2f(x * 1.4426950408889634f); }
__device__ __forceinline__ float silu_g(float g) { return g * __builtin_amdgcn_rcpf(1.0f + __builtin_amdgcn_exp2f(-1.4426950408889634f * g)); }

__device__ __forceinline__ void bcum_item(Frame& F, int s, int h) {
    const int c = F.tid & 127, tq = F.tid >> 7;
    LAS float* tot = (LAS float*)F.lds;
    const float* glr = WSP(float, WS_GLR); float* bc = WSP(float, WS_BCUM);
    float w[16];
#pragma unroll
    for (int r = 0; r < 16; ++r) w[r] = F.in[4][r * 512 + h * 128 + c];
    const float bias = F.in[5][h * 128 + c];
    float vals[32]; float run = 0.f;
    const int tb = s * CS + tq * 32;
#pragma unroll
    for (int i = 0; i < 32; ++i) { const float* gr = glr + (size_t)(tb + i) * 16; float z = bias;
#pragma unroll
        for (int r = 0; r < 16; ++r) z += gr[r] * w[r];
        run += log_sigmoid_f(z) * 0.0625f; vals[i] = run; }
    __syncthreads();
    tot[tq * 128 + c] = run;
    __syncthreads();
    float off = 0.f;
#pragma unroll
    for (int q = 0; q < 3; ++q) off += (q < tq) ? tot[q * 128 + c] : 0.f;
#pragma unroll
    for (int i = 0; i < 32; ++i) bc[(size_t)(tb + i) * 512 + h * 128 + c] = vals[i] + off;
}
__device__ __forceinline__ void p1_bcum(Frame& F) { for (int it = F.bid; it < NS * 4; it += F.G) bcum_item(F, it >> 2, it & 3); __syncthreads(); }

__device__ __forceinline__ void unit_sh(int u, int& s, int& h8) { s = (u >> 3) & (NS - 1); h8 = ((u & 7) + 4 * (u >> 8)) & 7; }

template <bool GLA, int MODE>
__device__ __forceinline__ void stage_qk(Frame& F, LAS unsigned char* dst, int s, int jb, int hh, int col0, float lg2gamma) {
    constexpr int DK = GLA ? 128 : 256, PK = DK + 8, CPR = DK / 8, NIT = 64 * CPR / NTHR;
    const bf16* H = WSP(bf16, WS_H); const float* bc = WSP(float, WS_BCUM);
#pragma unroll
    for (int it = 0; it < NIT; ++it) {
        const int ch = F.tid + NTHR * it, r = ch / CPR, cc = ch % CPR, tl = jb * 64 + r, t = s * CS + tl;
        const v4u w = *(const GAS v4u*)(H + (size_t)t * HW + col0 + 8 * cc);
        float f[8] = {bflo(w.x), bfhi(w.x), bflo(w.y), bfhi(w.y), bflo(w.z), bfhi(w.z), bflo(w.w), bfhi(w.w)};
        if (GLA) {
            const f32x4 b0 = *(const GAS f32x4*)(bc + (size_t)t * 512 + hh * 128 + 8 * cc), b1 = *(const GAS f32x4*)(bc + (size_t)t * 512 + hh * 128 + 8 * cc + 4);
            float e[8] = {b0[0], b0[1], b0[2], b0[3], b1[0], b1[1], b1[2], b1[3]};
            if (MODE == 2) { const size_t tl_ = (size_t)(s * CS + CS - 1) * 512 + hh * 128 + 8 * cc; const f32x4 l0 = *(const GAS f32x4*)(bc + tl_), l1 = *(const GAS f32x4*)(bc + tl_ + 4);
                const float l[8] = {l0[0], l0[1], l0[2], l0[3], l1[0], l1[1], l1[2], l1[3]};
#pragma unroll
                for (int i = 0; i < 8; ++i) e[i] = l[i] - e[i]; }
            else if (MODE == 1) {
#pragma unroll
                for (int i = 0; i < 8; ++i) e[i] = -e[i]; }
#pragma unroll
            for (int i = 0; i < 8; ++i) f[i] *= fexp(e[i]);
        } else {
            const float ex = MODE == 0 ? (float)(tl + 1) : MODE == 1 ? -(float)(tl + 1) : (float)(CS - 1 - tl);
            const float fac = __builtin_amdgcn_exp2f(ex * lg2gamma);
#pragma unroll
            for (int i = 0; i < 8; ++i) f[i] *= fac;
        }
        v4u o; o.x = pk2(f[0], f[1]); o.y = pk2(f[2], f[3]); o.z = pk2(f[4], f[5]); o.w = pk2(f[6], f[7]);
        *(LAS v4u*)(dst + (r * PK + 8 * cc) * 2) = o;
    }
}
__device__ __forceinline__ void stage_v(Frame& F, LAS unsigned char* dst, int s, int jb, int col0) {
    const bf16* H = WSP(bf16, WS_H);
#pragma unroll
    for (int it = 0; it < 4; ++it) { const int ch = F.tid + NTHR * it, r = ch >> 5, cc = ch & 31, t = s * CS + jb * 64 + r;
        *(LAS v4u*)(dst + (r * 264 + 8 * cc) * 2) = *(const GAS v4u*)(H + (size_t)t * HW + col0 + 8 * cc); }
}

template <bool GLA>
__device__ __forceinline__ void kv_unit(Frame& F, int s, int hh) {
    constexpr int DK = GLA ? 128 : 256, PK = DK + 8, NDT = DK / 16;
    LAS unsigned char* Ks = F.lds; LAS unsigned char* Vs = F.lds + 34816;
    const int kcol = GLA ? 4608 + hh * 128 : 1024 + hh * 256, vcol = (GLA ? 5120 : 2048) + hh * 256;
    const float lg2g = log2f(1.0f - exp2f(-5.0f - (float)hh));
    f32x4 acc[2][NDT];
#pragma unroll
    for (int a = 0; a < 2; ++a)
#pragma unroll
        for (int d = 0; d < NDT; ++d) acc[a][d] = (f32x4){0.f, 0.f, 0.f, 0.f};
    for (int jb = 0; jb < NB; ++jb) {
        __syncthreads();
        stage_qk<GLA, 2>(F, Ks, s, jb, hh, kcol, lg2g);
        stage_v(F, Vs, s, jb, vcol);
        __syncthreads();
#pragma unroll
        for (int ks = 0; ks < 2; ++ks) {
            bf16x8_t vf[2];
#pragma unroll
            for (int et = 0; et < 2; ++et) vf[et] = frag_tr(Vs, 264, 32 * ks, 32 * F.wave + 16 * et, F.lane);
#pragma unroll
            for (int dt = 0; dt < NDT; ++dt) { const bf16x8_t kf = frag_tr(Ks, PK, 32 * ks, 16 * dt, F.lane);
#pragma unroll
                for (int et = 0; et < 2; ++et) acc[et][dt] = MFMA16(kf, vf[et], acc[et][dt]); }
        }
    }
    bf16* kv = GLA ? (WSP(bf16, WS_KVG) + (size_t)(s * 4 + hh) * 256 * 128) : (WSP(bf16, WS_KVR) + (size_t)(s * 4 + hh) * 256 * 256);
    const int fr = F.lane & 15, fq = F.lane >> 4;
#pragma unroll
    for (int et = 0; et < 2; ++et)
#pragma unroll
        for (int dt = 0; dt < NDT; ++dt) { v2u w; w.x = pk2(acc[et][dt][0], acc[et][dt][1]); w.y = pk2(acc[et][dt][2], acc[et][dt][3]);
            *(GAS v2u*)(kv + (size_t)(32 * F.wave + 16 * et + fr) * DK + 16 * dt + 4 * fq) = w; }
}
__device__ __forceinline__ void p2_kv(Frame& F) {
    for (int u = F.bid; u < 8 * NS; u += F.G) { int s, h8; unit_sh(u, s, h8);
        if (s == NS - 1) continue;
        if (h8 < 4) kv_unit<false>(F, s, h8); else kv_unit<true>(F, s, h8 - 4); }
    __syncthreads();
}
__device__ __forceinline__ void p3_scan(Frame& F) {
    const int gt = F.bid * NTHR + F.tid, NGT = F.G * NTHR;
    constexpr int NR = 4 * 256 * 32, NG = 4 * 256 * 16;
    const float* bc = WSP(float, WS_BCUM);
    for (int it = gt; it < NR + NG; it += NGT) {
        const bool gla = it >= NR; const int r = gla ? it - NR : it;
        const int sh = gla ? 4 : 5, dk = gla ? 128 : 256;
        const int cc = r & ((1 << sh) - 1), e = (r >> sh) & 255, hh = r >> (sh + 8);
        bf16* base = (gla ? WSP(bf16, WS_KVG) : WSP(bf16, WS_KVR)) + ((size_t)hh * 256 + e) * dk + 8 * cc;
        const size_t sstride = (size_t)4 * 256 * dk;
        const float dret = __builtin_amdgcn_exp2f((float)CS * log2f(1.0f - exp2f(-5.0f - (float)hh)));
        float S[8];
#pragma unroll
        for (int i = 0; i < 8; ++i) S[i] = 0.f;
#pragma unroll 4
        for (int s = 0; s < NS - 1; ++s) {
            GAS v4u* p = (GAS v4u*)(base + (size_t)s * sstride);
            const v4u w = *p;
            v4u o; o.x = pk2(S[0], S[1]); o.y = pk2(S[2], S[3]); o.z = pk2(S[4], S[5]); o.w = pk2(S[6], S[7]);
            *p = o;
            const float f[8] = {bflo(w.x), bfhi(w.x), bflo(w.y), bfhi(w.y), bflo(w.z), bfhi(w.z), bflo(w.w), bfhi(w.w)};
            float dec[8];
            if (gla) { const size_t o_ = (size_t)(s * CS + CS - 1) * 512 + hh * 128 + 8 * cc; const f32x4 l0 = *(const GAS f32x4*)(bc + o_), l1 = *(const GAS f32x4*)(bc + o_ + 4);
                dec[0] = fexp(l0[0]); dec[1] = fexp(l0[1]); dec[2] = fexp(l0[2]); dec[3] = fexp(l0[3]); dec[4] = fexp(l1[0]); dec[5] = fexp(l1[1]); dec[6] = fexp(l1[2]); dec[7] = fexp(l1[3]); }
            else {
#pragma unroll
                for (int i = 0; i < 8; ++i) dec[i] = dret; }
#pragma unroll
            for (int i = 0; i < 8; ++i) S[i] = dec[i] * S[i] + f[i];
        }
        { GAS v4u* p = (GAS v4u*)(base + (size_t)(NS - 1) * sstride);
          v4u o; o.x = pk2(S[0], S[1]); o.y = pk2(S[2], S[3]); o.z = pk2(S[4], S[5]); o.w = pk2(S[6], S[7]); *p = o; }
    }
}
template <bool GLA>
__device__ __forceinline__ void out_unit(Frame& F, int s, int hh) {
    constexpr int DK = GLA ? 128 : 256, PK = DK + 8, NKS = DK / 32;
    LAS unsigned char* Qs = F.lds; LAS unsigned char* Ks = F.lds + 33792; LAS unsigned char* Vs = F.lds + 67584; LAS unsigned char* Ps = F.lds + 101376;
    LAS float* red = (LAS float*)(F.lds + 110592);
    const int qcol = GLA ? 4096 + hh * 128 : hh * 256, kcol = GLA ? 4608 + hh * 128 : 1024 + hh * 256, vcol = (GLA ? 5120 : 2048) + hh * 256;
    const int gcol = (GLA ? 6144 : 3072) + hh * 256, ocol = (GLA ? 1024 : 0) + hh * 256;
    const float lg2g = log2f(1.0f - exp2f(-5.0f - (float)hh));
    const bf16* H = WSP(bf16, WS_H); bf16* mixed = WSP(bf16, WS_MIXED);
    const bf16* st = GLA ? (WSP(bf16, WS_KVG) + (size_t)(s * 4 + hh) * 256 * 128) : (WSP(bf16, WS_KVR) + (size_t)(s * 4 + hh) * 256 * 256);
    const int fr = F.lane & 15, fq = F.lane >> 4, w = F.wave, mt = w >> 1, nt0 = 2 * (w & 1);
    for (int i = 0; i < NB; ++i) {
        __syncthreads();
        stage_qk<GLA, 0>(F, Qs, s, i, hh, qcol, lg2g);
        f32x4 accO[4][2];
#pragma unroll
        for (int m = 0; m < 4; ++m)
#pragma unroll
            for (int n = 0; n < 2; ++n) accO[m][n] = (f32x4){0.f, 0.f, 0.f, 0.f};
        for (int j = 0; j <= i; ++j) {
            __syncthreads();
            stage_qk<GLA, 1>(F, Ks, s, j, hh, kcol, lg2g);
            stage_v(F, Vs, s, j, vcol);
            __syncthreads();
            f32x4 accS[2] = {(f32x4){0.f, 0.f, 0.f, 0.f}, (f32x4){0.f, 0.f, 0.f, 0.f}};
#pragma unroll
            for (int ks = 0; ks < NKS; ++ks) { const bf16x8_t qf = frag_row(Qs, PK, 16 * mt, 32 * ks, F.lane);
#pragma unroll
                for (int n2 = 0; n2 < 2; ++n2) { const bf16x8_t kf = frag_row(Ks, PK, 16 * (nt0 + n2), 32 * ks, F.lane); accS[n2] = MFMA16(kf, qf, accS[n2]); } }
#pragma unroll
            for (int n2 = 0; n2 < 2; ++n2) { const int row = 16 * mt + fr, c0 = 16 * (nt0 + n2) + 4 * fq; float pv[4];
#pragma unroll
                for (int jj = 0; jj < 4; ++jj) pv[jj] = (i == j && c0 + jj > row) ? 0.f : accS[n2][jj];
                v2u pw; pw.x = pk2(pv[0], pv[1]); pw.y = pk2(pv[2], pv[3]);
                *(LAS v2u*)(Ps + (row * 72 + c0) * 2) = pw; }
            __syncthreads();
#pragma unroll
            for (int ks = 0; ks < 2; ++ks) {
                bf16x8_t vf[2];
#pragma unroll
                for (int n = 0; n < 2; ++n) vf[n] = frag_tr(Vs, 264, 32 * ks, 32 * w + 16 * n, F.lane);
#pragma unroll
                for (int m = 0; m < 4; ++m) { const bf16x8_t pf = frag_row(Ps, 72, 16 * m, 32 * ks, F.lane);
#pragma unroll
                    for (int n = 0; n < 2; ++n) accO[m][n] = MFMA16(vf[n], pf, accO[m][n]); }
            }
        }
        if (s > 0) {
#pragma unroll
            for (int ks = 0; ks < NKS; ++ks) {
                bf16x8_t sf[2];
#pragma unroll
                for (int n = 0; n < 2; ++n) sf[n] = *(const GAS bf16x8_t*)(st + (size_t)(32 * w + 16 * n + fr) * DK + 32 * ks + 8 * fq);
#pragma unroll
                for (int m = 0; m < 4; ++m) { const bf16x8_t qf = frag_row(Qs, PK, 16 * m, 32 * ks, F.lane);
#pragma unroll
                    for (int n = 0; n < 2; ++n) accO[m][n] = MFMA16(sf[n], qf, accO[m][n]); }
            }
        }
#pragma unroll
        for (int m = 0; m < 4; ++m) { float s1 = 0.f, s2 = 0.f;
#pragma unroll
            for (int n = 0; n < 2; ++n)
#pragma unroll
                for (int jj = 0; jj < 4; ++jj) { const float v = accO[m][n][jj]; s1 += v; s2 += v * v; }
            s1 += __shfl_xor(s1, 16); s1 += __shfl_xor(s1, 32); s2 += __shfl_xor(s2, 16); s2 += __shfl_xor(s2, 32);
            if (fq == 0) { red[(w * 64 + 16 * m + fr) * 2] = s1; red[(w * 64 + 16 * m + fr) * 2 + 1] = s2; } }
        __syncthreads();
#pragma unroll
        for (int m = 0; m < 4; ++m) { const int row = 16 * m + fr; float s1 = 0.f, s2 = 0.f;
#pragma unroll
            for (int ww = 0; ww < 8; ++ww) { s1 += red[(ww * 64 + row) * 2]; s2 += red[(ww * 64 + row) * 2 + 1]; }
            const float mean = s1 * (1.f / 256.f), ex2 = s2 * (1.f / 256.f);
            const float mu = GLA ? 0.f : mean, var = GLA ? ex2 : fmaxf(ex2 - mean * mean, 0.f);
            const float rstd = 1.0f / sqrtf(var + LN_EPS);
            const int t = s * CS + i * 64 + row;
#pragma unroll
            for (int n = 0; n < 2; ++n) { const int e = 32 * w + 16 * n + 4 * fq;
                const v2u gw2 = *(const GAS v2u*)(H + (size_t)t * HW + gcol + e);
                const float gt[4] = {bflo(gw2.x), bfhi(gw2.x), bflo(gw2.y), bfhi(gw2.y)};
                f32x4 gn = {1.f, 1.f, 1.f, 1.f}; if (GLA) gn = *(const f32x4*)(F.in[6] + e);
                float r4[4];
#pragma unroll
                for (int jj = 0; jj < 4; ++jj) { const float y = (accO[m][n][jj] - mu) * rstd * gn[jj]; r4[jj] = silu_g(gt[jj]) * y; }
                v2u ow; ow.x = pk2(r4[0], r4[1]); ow.y = pk2(r4[2], r4[3]);
                *(GAS v2u*)(mixed + (size_t)t * D + ocol + e) = ow; } }
    }
}
__device__ __forceinline__ void p4_out(Frame& F) {
    for (int u = F.bid; u < 8 * NS; u += F.G) { int s, h8; unit_sh(u, s, h8);
        if (h8 < 4) out_unit<false>(F, s, h8); else out_unit<true>(F, s, h8 - 4); }
    __syncthreads();
}

#define XB_TMO      128
#define XB_XCNT(j)  (256  + 64 * (j))
#define XB_XSUB(j)  (1280 + 64 * (j))
#define XB_XGEN(j)  (2304 + 64 * (j))
#define XB_TOP      3328
#define XB_TOPGEN   3392
#define XCD_BAR_WORDS 3456
#define XB_SPIN_CAP (1u << 22)
__device__ __forceinline__ unsigned xb_ld(unsigned* p)              { return __hip_atomic_load(p, __ATOMIC_RELAXED, __HIP_MEMORY_SCOPE_AGENT); }
__device__ __forceinline__ unsigned xb_add(unsigned* p, unsigned v) { return __hip_atomic_fetch_add(p, v, __ATOMIC_RELAXED, __HIP_MEMORY_SCOPE_AGENT); }
__device__ __forceinline__ unsigned xb_xcc_id() { return (unsigned)__builtin_amdgcn_s_getreg((3 << 11) | 20) & 0xFu; }
#define XB_SPIN(cond, bar) do { unsigned _sp = 0; while (cond) { __builtin_amdgcn_s_sleep(1); \
    if ((++_sp & 255u) == 0u) { if (xb_ld(&(bar)[XB_TMO])) break; if (_sp > XB_SPIN_CAP) { atomicAdd(&(bar)[XB_TMO], 1u); break; } } } } while (0)
struct XcdBarrier { unsigned* bar; unsigned x; volatile LAS unsigned* st; };
__device__ __forceinline__ XcdBarrier xcd_barrier_post(unsigned* bar, volatile LAS unsigned* st) {
    XcdBarrier b; b.bar = bar; b.x = xb_xcc_id(); b.st = st;
    if (threadIdx.x == 0) (void)xb_add(&bar[XB_XCNT(b.x)], 1u);
    return b;
}
__device__ __forceinline__ void xcd_barrier_complete(unsigned* bar, unsigned x, unsigned& nloc, unsigned& nx) {
    const unsigned G = gridDim.x * gridDim.y * gridDim.z;
    unsigned sum, cnt, mine, sp = 0u;
    for (;;) {
        sum = 0u; cnt = 0u; mine = 0u;
#pragma unroll
        for (unsigned j = 0; j < 16; ++j) { const unsigned c = xb_ld(&bar[XB_XCNT(j)]); sum += c; cnt += (c > 0u) ? 1u : 0u; mine = (j == x) ? c : mine; }
        if (sum == G) break;
        __builtin_amdgcn_s_sleep(1);
        if ((++sp & 255u) == 0u) { if (xb_ld(&bar[XB_TMO])) break; if (sp > XB_SPIN_CAP) { atomicAdd(&bar[XB_TMO], 1u); break; } }
    }
    nloc = mine > 0u ? mine : 1u; nx = cnt > 0u ? cnt : 1u;
}
__device__ __forceinline__ void xcd_barrier(const XcdBarrier& b) {
    asm volatile("s_waitcnt vmcnt(0)" ::: "memory");
    __syncthreads();
    if (threadIdx.x == 0) {
        unsigned* bar = b.bar;
        __builtin_amdgcn_s_waitcnt(0);
        unsigned nloc = b.st[0], nx = b.st[1];
        if (nloc == 0u) { xcd_barrier_complete(bar, b.x, nloc, nx); b.st[0] = nloc; b.st[1] = nx; }
        const unsigned old = xb_add(&bar[XB_XSUB(b.x)], 1u);
        const unsigned gen = old / nloc;
        if (old + 1u == (gen + 1u) * nloc) {
            __builtin_amdgcn_fence(__ATOMIC_RELEASE, "agent");
            asm volatile("s_waitcnt vmcnt(0)" ::: "memory");
            const unsigned og = xb_add(&bar[XB_TOP], 1u);
            const unsigned tg = og / nx;
            if (og + 1u == (tg + 1u) * nx) xb_add(&bar[XB_TOPGEN], 1u);
            else XB_SPIN(xb_ld(&bar[XB_TOPGEN]) == tg, bar);
            __builtin_amdgcn_fence(__ATOMIC_ACQUIRE, "agent");
            xb_add(&bar[XB_XGEN(b.x)], 1u);
            asm volatile("s_waitcnt vmcnt(0)" ::: "memory");
        } else {
            XB_SPIN(xb_ld(&bar[XB_XGEN(b.x)]) == gen, bar);
            __builtin_amdgcn_fence(__ATOMIC_ACQUIRE, "agent");
            asm volatile("s_waitcnt vmcnt(0)" ::: "memory");
        }
    }
    __syncthreads();
}

struct Args { const float* in[25]; float* out; unsigned char* ws; int ph_lo, ph_hi, use_bar, pad; };
__global__ void __launch_bounds__(NTHR, 2) mega(Args args) {
    extern __shared__ __attribute__((aligned(16))) unsigned char lds[];
    Frame F;
    F.lds = (LAS unsigned char*)lds;
    F.MISC = (volatile LAS unsigned*)(F.lds + MISC_OFF);
    F.tid = threadIdx.x; F.lane = F.tid & 63; F.wave = __builtin_amdgcn_readfirstlane(F.tid >> 6);
    F.G = gridDim.x; F.bid = blockIdx.x;
    F.ws = args.ws; F.ctl = (gu32*)(args.ws + WS_CTL);
#pragma unroll
    for (int i = 0; i < 25; ++i) F.in[i] = args.in[i];
    F.out = args.out;
    for (int u = F.tid; u < (LDS_BYTES - LDSCTL_OFF) / 4; u += NTHR) ((LAS unsigned*)(F.lds + LDSCTL_OFF))[u] = 0u;
    __syncthreads();
    LAS int* ts = (LAS int*)(F.lds + MISC_OFF + 64);
    XcdBarrier bar; bar.bar = (unsigned*)(F.ctl + CW_BAR); bar.x = 0; bar.st = nullptr;
    if (args.use_bar) bar = xcd_barrier_post((unsigned*)(F.ctl + CW_BAR), F.MISC + 8);
    const int lo = args.ph_lo, hi = args.ph_hi;
#define IN(k) (lo <= (k) && (k) < hi)
#define SEAM(k) do { if (IN(k) && IN((k) + 1)) { if (MK_CG_SYNC && (k) == 0) cooperative_groups::this_grid().sync(); else xcd_barrier(bar); } } while (0)

    if (IN(0)) { p0_prologue(F); SEAM(0); }
    if (IN(1)) {
        p1_bcum(F);
        pg8::Gemm g{WSP(pg8::bf16_t, WS_XB), WSP(pg8::bf16_t, WS_WIN), T + MEMN, HW + 4096, D}; pg8::OrderG1 S; S.init(F.G, F.bid);
        pg8::EpiH E{WSP(pg8::bf16_t, WS_H), WSP(pg8::bf16_t, WS_KVM), WSP(float, WS_RC), WSP(float, WS_RS)};
        pg8::gemm_phase<pg8::EpiH, pg8::OrderG1, true, true>(F.lds, g, S, E);
        SEAM(1);
    }
    if (IN(2)) { p2_kv(F); SEAM(2); }
    if (IN(3)) { p3_scan(F); SEAM(3); }
    if (IN(4)) { p4_out(F); SEAM(4); }
    if (IN(5)) {
        pg8::Gemm g{WSP(pg8::bf16_t, WS_MIXED), WSP(pg8::bf16_t, WS_WMIX), T, D, D}; pg8::StaticOrder S; S.init(T, D, F.G, F.bid);
        pg8::EpiResX E{F.in[0], WSP(float, WS_Y1), ALPHA};
        pg8::gemm_phase<pg8::EpiResX, pg8::StaticOrder, true, true>(F.lds, g, S, E);
        SEAM(5);
    }
    if (IN(6)) { ln_apply<false>(F, WSP(float, WS_Y1), F.in[8], F.in[9], WSP(bf16, WS_H1B), WSP(float, WS_ST1)); SEAM(6); }
    if (IN(7)) {
        pg8::Gemm g{WSP(pg8::bf16_t, WS_H1B), WSP(pg8::bf16_t, WS_WMQ), T, D, D}; pg8::StaticOrder S; S.init(T, D, F.G, F.bid);
        pg8::EpiB E{WSP(pg8::bf16_t, WS_QB), D, -1};
        pg8::gemm_phase<pg8::EpiB, pg8::StaticOrder, true, true>(F.lds, g, S, E);
        SEAM(7);
    }
    if (IN(8)) { p7_attn_naive(F); SEAM(8); }
    if (IN(9)) {
        pg8::Gemm g{WSP(pg8::bf16_t, WS_ATT), WSP(pg8::bf16_t, WS_WMO), T, D, D}; pg8::StaticOrder S; S.init(T, D, F.G, F.bid);
        pg8::EpiResLN E{WSP(float, WS_Y1), WSP(float, WS_ST1), F.in[8], F.in[9], WSP(float, WS_Y2), ALPHA};
        pg8::gemm_phase<pg8::EpiResLN, pg8::StaticOrder, true, true>(F.lds, g, S, E);
        SEAM(9);
    }
    if (IN(10)) { ln_apply<true>(F, WSP(float, WS_Y2), F.in[14], F.in[15], WSP(bf16, WS_H2B), WSP(float, WS_ST2)); SEAM(10); }
    if (IN(11)) { moe_tile_starts(F, ts); p10_dispatch(F, ts); SEAM(11); }
    if (IN(12)) {
        moe_tile_starts(F, ts);
        pg8::Gemm g{WSP(pg8::bf16_t, WS_XS), WSP(pg8::bf16_t, WS_WGU), PMAX, 32 * 1024, D};
        pg8::MoeOrder S{(const PG8_LAS int*)ts, F.G, F.bid, 4, ts[32] * 4};
        pg8::EpiSwi E{WSP(pg8::bf16_t, WS_HID)};
        pg8::gemm_phase<pg8::EpiSwi, pg8::MoeOrder, true, true>(F.lds, g, S, E);
        SEAM(12);
    }
    if (IN(13)) {
        moe_tile_starts(F, ts);
        pg8::Gemm g{WSP(pg8::bf16_t, WS_HID), WSP(pg8::bf16_t, WS_WD), PMAX, 32 * 2048, 512};
        pg8::MoeOrder S{(const PG8_LAS int*)ts, F.G, F.bid, 8, ts[32] * 8};
        pg8::EpiB E{WSP(pg8::bf16_t, WS_YS), D, 7};
        pg8::gemm_phase<pg8::EpiB, pg8::MoeOrder, true, true>(F.lds, g, S, E);
        SEAM(13);
    }
    if (IN(14)) { p13_combine(F); }
#undef IN
#undef SEAM
}

extern "C" void kernel_launch(void* const* d_in, const int* in_sizes, int n_in, void* d_out, int out_size, void* d_ws, size_t ws_size, hipStream_t stream) {
    static int grid = 0;
    if (grid == 0) {
        if (n_in != 25 || in_sizes[0] != T * D || out_size != T * D || ws_size < WS_END) { fprintf(stderr, "kernel_launch: unexpected shapes / workspace (%d inputs, ws %zu)\n", n_in, ws_size); grid = -1; return; }
        int dev = 0, cus = 0;
        if (hipGetDevice(&dev) != hipSuccess || hipDeviceGetAttribute(&cus, hipDeviceAttributeMultiprocessorCount, dev) != hipSuccess) { grid = -1; return; }
        if (hipFuncSetAttribute((const void*)mega, hipFuncAttributeMaxDynamicSharedMemorySize, LDS_BYTES) != hipSuccess) { fprintf(stderr, "kernel_launch: hipFuncSetAttribute failed\n"); grid = -1; return; }
        int per_cu = 0;
        if (hipOccupancyMaxActiveBlocksPerMultiprocessor(&per_cu, (const void*)mega, NTHR, LDS_BYTES) != hipSuccess || per_cu < 1) { fprintf(stderr, "kernel_launch: occupancy query failed / 0 blocks per CU\n"); grid = -1; return; }
        (void)hipGetLastError();
        grid = cus;
    }
    if (grid < 0) return;
    if (hipMemsetAsync((char*)d_ws + WS_CTL, 0, CTL_ZERO_BYTES, stream) != hipSuccess) return;
    Args a{};
    for (int i = 0; i < 25; ++i) a.in[i] = (const float*)d_in[i];
    a.out = (float*)d_out; a.ws = (unsigned char*)d_ws;
#if MK_ONE_LAUNCH
    a.ph_lo = 0; a.ph_hi = NPH; a.use_bar = 1;
#if MK_CG_SYNC
    { void* kargs[] = {(void*)&a};
      hipError_t e = hipLaunchCooperativeKernel((const void*)mega, dim3(grid), dim3(NTHR), kargs, LDS_BYTES, stream);
      if (e != hipSuccess) fprintf(stderr, "cooperative launch failed: %s (grid %d)\n", hipGetErrorString(e), grid); }
#else
    hipLaunchKernelGGL(mega, dim3(grid), dim3(NTHR), LDS_BYTES, stream, a);
#endif
#else
    for (int p = 0; p < NPH; ++p) { a.ph_lo = p; a.ph_hi = p + 1; a.use_bar = 0;
        hipLaunchKernelGGL(mega, dim3(grid), dim3(NTHR), LDS_BYTES, stream, a); }
#endif
}
```

```cpp
#include <hip/hip_runtime.h>
#include <hip/hip_cooperative_groups.h>
#include <cstdio>
#include <cstdint>
#include <cmath>
#ifndef MK_ONE_LAUNCH
#define MK_ONE_LAUNCH 1
#endif
#ifndef MK_CG_SYNC
#define MK_CG_SYNC 1
#endif
namespace pg8 {
#define PG8_LAS __attribute__((address_space(3)))
typedef unsigned short bf16_t;
typedef short bf16x8 __attribute__((ext_vector_type(8)));
typedef float f32x4 __attribute__((ext_vector_type(4)));
typedef unsigned u32x4 __attribute__((ext_vector_type(4)));
constexpr int BM = 256, BK = 64, HALF = 128, HTB = HALF * BK * 2  , STAGE_BYTES = 8 * HTB, NXCD = 8, WGM = 8;

__host__ __device__ __forceinline__ int lds_byte(int r, int c) { const int st = (r >> 4) * 2 + (c >> 5), rr = r & 15, cc = c & 31, ob = rr * 64 + cc * 2; return st * 1024 + (ob ^ (((ob >> 9) & 1) << 5)); }
__host__ __device__ __forceinline__ void stage_rc(int b, int& R, int& C) { const int st = b / 1024, sb = b % 1024, swz = sb ^ (((sb >> 9) & 1) << 5); R = (st >> 1) * 16 + swz / 64; C = (st & 1) * 32 + (swz % 64) / 2; }
__host__ __device__ __forceinline__ int perm32(int rho) { const int n = rho >> 4, i = rho & 15; return 8 * (i >> 2) + 4 * n + (i & 3); }

struct Unit { int pm, pn; };
struct Gemm { const bf16_t* A; const bf16_t* Bt; int M, N, K; };

struct StaticOrder {
    int nM, nN, nwg, G, c;
    __host__ __device__ void init(int M, int N, int G_, int c_) { nM = M / BM; nN = N / BM; nwg = nM * nN; G = G_; c = c_; }
    __host__ __device__ bool next(int i, Unit& u) const {
        const long L = (long)i * G + c; if (L >= nwg) return false;
        int wgid = (int)L; { const int q = nwg / NXCD, r = nwg % NXCD, xcd = wgid % NXCD, off = wgid / NXCD; wgid = (xcd < r ? xcd * (q + 1) : r * (q + 1) + (xcd - r) * q) + off; }
        const int nig = WGM * nN, gid = wgid / nig, fm = gid * WGM, gsz = (nM - fm) < WGM ? (nM - fm) : WGM;
        u.pm = fm + ((wgid % nig) % gsz); u.pn = (wgid % nig) / gsz; return true;
    }
    __device__ __forceinline__ void a_ready(const Unit&) const {}
    __device__ __forceinline__ void done(const Unit&) const {}
};


__device__ __forceinline__ unsigned cvt_pk_bf16(float lo, float hi) { unsigned r; asm volatile("v_cvt_pk_bf16_f32 %0, %1, %2" : "=v"(r) : "v"(lo), "v"(hi)); return r; }
__device__ __forceinline__ u32x4 pack8(const f32x4 a, const f32x4 b) { u32x4 w; w.x = cvt_pk_bf16(a[0], a[1]); w.y = cvt_pk_bf16(a[2], a[3]); w.z = cvt_pk_bf16(b[0], b[1]); w.w = cvt_pk_bf16(b[2], b[3]); return w; }
__device__ __forceinline__ float silu_f(float x) { return x * __builtin_amdgcn_rcpf(1.0f + __builtin_amdgcn_exp2f(-1.4426950408889634f * x)); }

struct EpiH {
    static constexpr bool PERM = true, AFTER_DRAIN = false;
    bf16_t* H; bf16_t* KVM; const float* rc; const float* rs;
    __device__ __forceinline__ void operator()(const f32x4 (&acc)[2][2][4][2], const Unit& u, int wr, int wc, int fr, int fq) const {
        const int cb = wc * 32 + 8 * fq;
        if (u.pm >= 32) {
#pragma unroll
            for (int ai = 0; ai < 2; ++ai)
#pragma unroll
                for (int m = 0; m < 4; ++m) { bf16_t* rowp = KVM + (size_t)(wr * 64 + fr + ai * HALF + m * 16) * 4096 + (u.pn - 28) * BM + cb;
#pragma unroll
                    for (int bj = 0; bj < 2; ++bj) *(u32x4*)(rowp + bj * HALF) = pack8(acc[ai][bj][m][0], acc[ai][bj][m][1]); }
            return;
        }
        const int row0 = u.pm * BM + wr * 64 + fr;
        if (u.pn < 8) {
            const float sc = u.pn >= 4 ? 0.0625f : 1.0f;
#pragma unroll
            for (int ai = 0; ai < 2; ++ai)
#pragma unroll
                for (int m = 0; m < 4; ++m) { const int row = row0 + ai * HALF + m * 16;
                    const float* cr = rc + (size_t)row * 128 + cb; const float* sr = rs + (size_t)row * 128 + cb;
                    const f32x4 c0 = *(const f32x4*)cr * sc, c1 = *(const f32x4*)(cr + 4) * sc, s0 = *(const f32x4*)sr * sc, s1 = *(const f32x4*)(sr + 4) * sc;
                    const f32x4 t1a = acc[ai][0][m][0], t1b = acc[ai][0][m][1], t2a = acc[ai][1][m][0], t2b = acc[ai][1][m][1];
                    bf16_t* rowp = H + (size_t)row * 7168 + u.pn * BM + cb;
                    *(u32x4*)(rowp) = pack8(t1a * c0 - t2a * s0, t1b * c1 - t2b * s1);
                    *(u32x4*)(rowp + HALF) = pack8(t1a * s0 + t2a * c0, t1b * s1 + t2b * c1); }
        } else {
            const float sc = (u.pn == 16 || u.pn == 17) ? 0.08838834764831845f : 1.0f;
#pragma unroll
            for (int ai = 0; ai < 2; ++ai)
#pragma unroll
                for (int m = 0; m < 4; ++m) { bf16_t* rowp = H + (size_t)(row0 + ai * HALF + m * 16) * 7168 + u.pn * BM + cb;
#pragma unroll
                    for (int bj = 0; bj < 2; ++bj) *(u32x4*)(rowp + bj * HALF) = pack8(acc[ai][bj][m][0] * sc, acc[ai][bj][m][1] * sc); }
        }
    }
};
struct EpiB {
    static constexpr bool PERM = true, AFTER_DRAIN = false;
    bf16_t* O; int ldc; int pmask;
    __device__ __forceinline__ void operator()(const f32x4 (&acc)[2][2][4][2], const Unit& u, int wr, int wc, int fr, int fq) const {
        const int row0 = u.pm * BM + wr * 64 + fr, col0 = (u.pn & pmask) * BM + wc * 32 + 8 * fq;
#pragma unroll
        for (int ai = 0; ai < 2; ++ai)
#pragma unroll
            for (int m = 0; m < 4; ++m) { bf16_t* rowp = O + (size_t)(row0 + ai * HALF + m * 16) * ldc + col0;
#pragma unroll
                for (int bj = 0; bj < 2; ++bj) *(u32x4*)(rowp + bj * HALF) = pack8(acc[ai][bj][m][0], acc[ai][bj][m][1]); }
    }
};
struct EpiSwi {
    static constexpr bool PERM = true, AFTER_DRAIN = false;
    bf16_t* O;
    __device__ __forceinline__ void operator()(const f32x4 (&acc)[2][2][4][2], const Unit& u, int wr, int wc, int fr, int fq) const {
        const int row0 = u.pm * BM + wr * 64 + fr, col0 = (u.pn & 3) * HALF + wc * 32 + 8 * fq;
#pragma unroll
        for (int ai = 0; ai < 2; ++ai)
#pragma unroll
            for (int m = 0; m < 4; ++m) { bf16_t* rowp = O + (size_t)(row0 + ai * HALF + m * 16) * 512 + col0;
                f32x4 h0, h1;
#pragma unroll
                for (int i = 0; i < 4; ++i) { h0[i] = silu_f(acc[ai][0][m][0][i]) * acc[ai][1][m][0][i]; h1[i] = silu_f(acc[ai][0][m][1][i]) * acc[ai][1][m][1][i]; }
                *(u32x4*)rowp = pack8(h0, h1); }
    }
};
struct EpiResX {
    static constexpr bool PERM = false, AFTER_DRAIN = false;
    const float* X; float* Y; float alpha;
    __device__ __forceinline__ void operator()(const f32x4 (&acc)[2][2][4][2], const Unit& u, int wr, int wc, int fr, int fq) const {
        const int row0 = u.pm * BM + wr * 64 + fr, col0 = u.pn * BM + wc * 32 + 4 * fq;
#pragma unroll
        for (int ai = 0; ai < 2; ++ai)
#pragma unroll
            for (int m = 0; m < 4; ++m) { const size_t off = (size_t)(row0 + ai * HALF + m * 16) * 2048 + col0;
#pragma unroll
                for (int bj = 0; bj < 2; ++bj)
#pragma unroll
                    for (int n = 0; n < 2; ++n) { const f32x4 xv = *(const f32x4*)(X + off + bj * HALF + n * 16); *(f32x4*)(Y + off + bj * HALF + n * 16) = xv * alpha + acc[ai][bj][m][n]; } }
    }
};
struct EpiResLN {
    static constexpr bool PERM = false, AFTER_DRAIN = false;
    const float* Yin; const float* st; const float* g; const float* b; float* Y; float alpha;
    __device__ __forceinline__ void operator()(const f32x4 (&acc)[2][2][4][2], const Unit& u, int wr, int wc, int fr, int fq) const {
        const int row0 = u.pm * BM + wr * 64 + fr, col0 = u.pn * BM + wc * 32 + 4 * fq;
        f32x4 gv[2][2], bv[2][2];
#pragma unroll
        for (int bj = 0; bj < 2; ++bj)
#pragma unroll
            for (int n = 0; n < 2; ++n) { gv[bj][n] = *(const f32x4*)(g + col0 + bj * HALF + n * 16) * alpha; bv[bj][n] = *(const f32x4*)(b + col0 + bj * HALF + n * 16) * alpha; }
#pragma unroll
        for (int ai = 0; ai < 2; ++ai)
#pragma unroll
            for (int m = 0; m < 4; ++m) { const int row = row0 + ai * HALF + m * 16; const size_t off = (size_t)row * 2048 + col0;
                const float mu = st[2 * row], rstd = st[2 * row + 1];
#pragma unroll
                for (int bj = 0; bj < 2; ++bj)
#pragma unroll
                    for (int n = 0; n < 2; ++n) { const f32x4 yv = *(const f32x4*)(Yin + off + bj * HALF + n * 16);
                        *(f32x4*)(Y + off + bj * HALF + n * 16) = ((yv - mu) * rstd) * gv[bj][n] + bv[bj][n] + acc[ai][bj][m][n]; } }
    }
};

struct OrderG1 {
    StaticOrder so; int G, c;
    __device__ void init(int G_, int c_) { so.init(8192, 7168, G_, c_); G = G_; c = c_; }
    __device__ bool next(int i, Unit& u) const {
        const int L = i * G + c;
        if (L < 896) return so.next(i, u);
        if (L >= 912) return false;
        u.pm = 32; u.pn = 28 + (L - 896); return true;
    }
    __device__ __forceinline__ void a_ready(const Unit&) const {}
    __device__ __forceinline__ void done(const Unit&) const {}
};
struct MoeOrder {
    const PG8_LAS int* ts; int G, c, npn, total;
    __device__ bool next(int i, Unit& u) const {
        const int L = i * G + c; if (L >= total) return false;
        const int rt = L / npn, pl = L - rt * npn; int e = 0;
        for (int j = 1; j < 32; ++j) e += (ts[j] <= rt) ? 1 : 0;
        u.pm = rt; u.pn = e * npn + pl; return true;
    }
    __device__ __forceinline__ void a_ready(const Unit&) const {}
    __device__ __forceinline__ void done(const Unit&) const {}
};

template <class Epi, class Sched, bool ALIGN_EPI = false, bool SP2 = false>
__device__ __forceinline__ void gemm_phase(PG8_LAS unsigned char* lds, const Gemm g, const Sched& S, const Epi& E) {
    const int tid = threadIdx.x, wid = __builtin_amdgcn_readfirstlane(tid >> 6), lane = tid & 63, wr = wid >> 2, wc = wid & 3, fr = lane & 15, fq = lane >> 4;
    const int K = g.K, nt = K / BK;
    unsigned voffA[2], voffB[2];
#pragma unroll
    for (int i = 0; i < 2; ++i) { int R, C; stage_rc(tid * 16 + i * 8192, R, C); const int Rb = Epi::PERM ? ((R & ~31) + perm32(R & 31)) : R;
        voffA[i] = (unsigned)(R * K + C) * 2u; voffB[i] = (unsigned)(Rb * K + C) * 2u; }
    const size_t kstep = (size_t)(BK * 2);
    const size_t hstep = (size_t)HALF * K * 2;
    const size_t tstep = 2 * hstep;
    const unsigned ldsw = (unsigned)wid * 1024u;
    const int aoff = lds_byte(wr * 64 + fr, fq * 8), boff = lds_byte(wc * 32 + fr, fq * 8);
#define PG8_SA(b, h) (((b) * 2 + (h)) * HTB)
#define PG8_SB(b, h) ((4 + (b) * 2 + (h)) * HTB)
#define PG8_STAGE(bufoff, gbase, voff) do { _Pragma("unroll") for (int _i = 0; _i < 2; ++_i) \
        __builtin_amdgcn_global_load_lds((const unsigned*)((const char*)(gbase) + (voff)[_i]), (PG8_LAS unsigned*)(lds + (bufoff) + ldsw + _i * 8192), 16, 0, 0); } while (0)
#define PG8_LDA(dst, b, h) do { _Pragma("unroll") for (int m = 0; m < 4; ++m) _Pragma("unroll") for (int k = 0; k < 2; ++k) dst[m][k] = *(const PG8_LAS bf16x8*)(lds + PG8_SA(b, h) + aoff + m * 2048 + k * 1024); } while (0)
#define PG8_LDB(dst, b, h) do { _Pragma("unroll") for (int n = 0; n < 2; ++n) _Pragma("unroll") for (int k = 0; k < 2; ++k) dst[n][k] = *(const PG8_LAS bf16x8*)(lds + PG8_SB(b, h) + boff + n * 2048 + k * 1024); } while (0)
#define PG8_MMA(ai, bj, At, Bt) do { __builtin_amdgcn_s_setprio(1); _Pragma("unroll") for (int m = 0; m < 4; ++m) _Pragma("unroll") for (int n = 0; n < 2; ++n) _Pragma("unroll") for (int k = 0; k < 2; ++k) \
        acc[ai][bj][m][n] = __builtin_amdgcn_mfma_f32_16x16x32_bf16(Bt[n][k], At[m][k], acc[ai][bj][m][n], 0, 0, 0); __builtin_amdgcn_s_setprio(0); } while (0)
#define PG8_WAIT_V(n) asm volatile("s_waitcnt vmcnt(" #n ")" ::: "memory")
#define PG8_WAIT_L(n) asm volatile("s_waitcnt lgkmcnt(" #n ")" ::: "memory")
#define PG8_BAR __builtin_amdgcn_s_barrier()
#define PG8_SCHED __builtin_amdgcn_sched_barrier(0)
    Unit cur, nxt; int ui = 0;
    if (!S.next(0, cur)) return;
    f32x4 acc[2][2][4][2];
#pragma unroll
    for (int a = 0; a < 2; ++a)
#pragma unroll
        for (int b = 0; b < 2; ++b)
#pragma unroll
            for (int m = 0; m < 4; ++m)
#pragma unroll
                for (int n = 0; n < 2; ++n) acc[a][b][m][n] = (f32x4){0.f, 0.f, 0.f, 0.f};
    bf16x8 At[4][2], B0[2][2], B1[2][2];
    const char* cA = (const char*)g.A + (size_t)cur.pm * tstep; const char* cB = (const char*)g.Bt + (size_t)cur.pn * tstep;
    S.a_ready(cur);
    if constexpr (SP2) {
        PG8_STAGE(PG8_SB(0, 0), cB, voffB); PG8_STAGE(PG8_SB(0, 1), cB + hstep, voffB); PG8_STAGE(PG8_SA(0, 0), cA, voffA); PG8_STAGE(PG8_SA(0, 1), cA + hstep, voffA);
        if (wr == 1) PG8_BAR;
        PG8_WAIT_V(2); PG8_BAR;
        PG8_STAGE(PG8_SB(1, 0), cB + kstep, voffB); PG8_STAGE(PG8_SA(1, 0), cA + kstep, voffA); PG8_STAGE(PG8_SB(1, 1), cB + hstep + kstep, voffB);
        PG8_WAIT_V(6); PG8_BAR;
    } else {
        PG8_STAGE(PG8_SB(0, 0), cB, voffB); PG8_STAGE(PG8_SA(0, 0), cA, voffA); PG8_STAGE(PG8_SB(0, 1), cB + hstep, voffB); PG8_STAGE(PG8_SA(0, 1), cA + hstep, voffA);
        if (wr == 1) PG8_BAR;
        PG8_WAIT_V(4); PG8_BAR;
        PG8_STAGE(PG8_SB(1, 0), cB + kstep, voffB); PG8_STAGE(PG8_SA(1, 0), cA + kstep, voffA); PG8_STAGE(PG8_SB(1, 1), cB + hstep + kstep, voffB);
        PG8_WAIT_V(6); PG8_BAR;
    }
    for (;;) {
        const bool has_next = S.next(ui + 1, nxt);
        const char* nA = has_next ? (const char*)g.A + (size_t)nxt.pm * tstep : cA; const char* nB = has_next ? (const char*)g.Bt + (size_t)nxt.pn * tstep : cB;
        for (int t = 0; t < nt; t += 2) {
            const bool last = (t == nt - 2);
            const char* a1 = cA + (size_t)(t + 1) * kstep;
            const char* a2 = last ? nA : cA + (size_t)(t + 2) * kstep; const char* b2 = last ? nB : cB + (size_t)(t + 2) * kstep;
            const char* a3 = a2 + kstep; const char* b3 = b2 + kstep;
            if (last && has_next) S.a_ready(nxt);
            if constexpr (SP2) {
            PG8_LDB(B0, 0, 0); PG8_LDB(B1, 0, 1); PG8_SCHED; PG8_LDA(At, 0, 0); PG8_STAGE(PG8_SA(1, 1), a1 + hstep, voffA);
            PG8_WAIT_V(8); PG8_WAIT_L(0); PG8_BAR; PG8_MMA(0, 0, At, B0); PG8_MMA(0, 1, At, B1); PG8_BAR; PG8_SCHED;
            PG8_LDA(At, 0, 1); PG8_STAGE(PG8_SB(0, 0), b2, voffB); PG8_STAGE(PG8_SB(0, 1), b2 + hstep, voffB); PG8_STAGE(PG8_SA(0, 0), a2, voffA);
            PG8_WAIT_V(8); PG8_WAIT_L(0); PG8_BAR; PG8_MMA(1, 0, At, B0); PG8_MMA(1, 1, At, B1); PG8_BAR; PG8_SCHED;
            PG8_LDB(B0, 1, 0); PG8_LDB(B1, 1, 1); PG8_SCHED; PG8_LDA(At, 1, 0); PG8_STAGE(PG8_SA(0, 1), a2 + hstep, voffA);
            PG8_WAIT_V(8); PG8_WAIT_L(0); PG8_BAR; PG8_MMA(0, 0, At, B0); PG8_MMA(0, 1, At, B1); PG8_BAR; PG8_SCHED;
            PG8_LDA(At, 1, 1); PG8_STAGE(PG8_SB(1, 0), b3, voffB); PG8_STAGE(PG8_SB(1, 1), b3 + hstep, voffB); PG8_STAGE(PG8_SA(1, 0), a3, voffA);
            PG8_WAIT_V(8); PG8_WAIT_L(0); PG8_BAR; PG8_MMA(1, 0, At, B0); PG8_MMA(1, 1, At, B1); PG8_BAR; PG8_SCHED;
            } else {
            PG8_LDB(B0, 0, 0); PG8_SCHED; PG8_LDA(At, 0, 0); PG8_STAGE(PG8_SA(1, 1), a1 + hstep, voffA);
            PG8_WAIT_L(8); PG8_BAR; PG8_WAIT_L(0); PG8_MMA(0, 0, At, B0); PG8_BAR; PG8_SCHED;
            PG8_LDB(B1, 0, 1); PG8_STAGE(PG8_SB(0, 0), b2, voffB);
            PG8_BAR; PG8_WAIT_L(0); PG8_MMA(0, 1, At, B1); PG8_BAR;
            PG8_LDA(At, 0, 1); PG8_STAGE(PG8_SA(0, 0), a2, voffA);
            PG8_BAR; PG8_WAIT_L(0); PG8_MMA(1, 0, At, B0); PG8_BAR; PG8_SCHED;
            PG8_STAGE(PG8_SB(0, 1), b2 + hstep, voffB);
            PG8_WAIT_V(6); PG8_BAR; PG8_MMA(1, 1, At, B1); PG8_BAR;
            PG8_LDB(B0, 1, 0); PG8_SCHED; PG8_LDA(At, 1, 0); PG8_STAGE(PG8_SA(0, 1), a2 + hstep, voffA);
            PG8_WAIT_L(8); PG8_BAR; PG8_WAIT_L(0); PG8_MMA(0, 0, At, B0); PG8_BAR; PG8_SCHED;
            PG8_LDB(B1, 1, 1); PG8_STAGE(PG8_SB(1, 0), b3, voffB);
            PG8_BAR; PG8_WAIT_L(0); PG8_MMA(0, 1, At, B1); PG8_BAR;
            PG8_LDA(At, 1, 1); PG8_STAGE(PG8_SA(1, 0), a3, voffA);
            PG8_BAR; PG8_WAIT_L(0); PG8_MMA(1, 0, At, B0); PG8_BAR; PG8_SCHED;
            PG8_STAGE(PG8_SB(1, 1), b3 + hstep, voffB);
            PG8_WAIT_V(6); PG8_BAR; PG8_MMA(1, 1, At, B1); PG8_BAR;
            }
        }
        if constexpr (ALIGN_EPI) { if (wr == 0) PG8_BAR; }
        if constexpr (!Epi::AFTER_DRAIN) { E(acc, cur, wr, wc, fr, fq); S.done(cur); }
        if (!has_next) break;
#pragma unroll
        for (int a = 0; a < 2; ++a)
#pragma unroll
            for (int b = 0; b < 2; ++b)
#pragma unroll
                for (int m = 0; m < 4; ++m)
#pragma unroll
                    for (int n = 0; n < 2; ++n) acc[a][b][m][n] = (f32x4){0.f, 0.f, 0.f, 0.f};
        cur = nxt; cA = nA; cB = nB; ++ui;
        if constexpr (ALIGN_EPI) { if (wr == 1) PG8_BAR; }
    }
    PG8_WAIT_V(0);
    if constexpr (!ALIGN_EPI) { if (wr == 0) PG8_BAR; }
    PG8_BAR;
    if constexpr (Epi::AFTER_DRAIN) { E.fused(acc, cur, wr, wc, fr, fq, lds, wid, lane); S.done(cur); }
#undef PG8_SA
#undef PG8_SB
#undef PG8_STAGE
#undef PG8_LDA
#undef PG8_LDB
#undef PG8_MMA
#undef PG8_WAIT_V
#undef PG8_WAIT_L
#undef PG8_BAR
#undef PG8_SCHED
}
}

constexpr int NWAVES = 8, NTHR = 512;
constexpr int T = 8192, D = 2048, HW = 7168, INW = 7184, MEMN = 256;
constexpr float LN_EPS = 1e-5f;
constexpr float ALPHA = 1.189207115002721f;
constexpr int NPH = 15;
constexpr int PMAX = 24576;

constexpr size_t MiB = 1u << 20;
constexpr size_t WS_CTL = 0, CTL_ZERO_BYTES = 1 * MiB;
constexpr size_t WS_WMIX = 2 * MiB, WS_WMQ = 10 * MiB, WS_WIN = 18 * MiB, WS_WKV = 46 * MiB, WS_WMO = 62 * MiB, WS_WGU = 70 * MiB, WS_WD = 198 * MiB;
constexpr size_t WS_XB = 262 * MiB, WS_MEMB = 294 * MiB;
constexpr size_t WS_H = 296 * MiB;
constexpr size_t WS_KVM = 408 * MiB;
constexpr size_t WS_ORAW = 410 * MiB;
constexpr size_t WS_MIXED = WS_XB;
constexpr size_t WS_Y1 = WS_ORAW;
constexpr size_t WS_H1B = WS_H;
constexpr size_t WS_QB = 328 * MiB, WS_ATT = 360 * MiB;
constexpr size_t WS_Y2 = 474 * MiB;
constexpr size_t WS_H2B = WS_H;
constexpr size_t WS_XS = 328 * MiB;
constexpr size_t WS_HID = 424 * MiB;
constexpr size_t WS_YS = WS_XS;
constexpr size_t WS_SMALL = 540 * MiB;
constexpr size_t WS_GLR = WS_SMALL;
constexpr size_t WS_RC = WS_SMALL + 1 * MiB, WS_RS = WS_SMALL + 5 * MiB;
constexpr size_t WS_ST1 = WS_SMALL + 9 * MiB, WS_ST2 = WS_ST1 + 65536;
constexpr size_t WS_EXP = WS_ST2 + 65536, WS_GATE = WS_EXP + 65536, WS_POS = WS_GATE + 65536;
constexpr size_t WS_END = 552 * MiB;
constexpr int CW_CNT = 64, CW_CUR = 128;
constexpr int CW_BAR = 4096;

constexpr int RING_BYTES = 131072, LDSCTL_OFF = RING_BYTES, MISC_OFF = LDSCTL_OFF + 320, LDS_BYTES = 147456;

#define GAS __attribute__((address_space(1)))
#define LAS __attribute__((address_space(3)))
typedef unsigned short bf16;
typedef unsigned v4u __attribute__((ext_vector_type(4)));
typedef unsigned v2u __attribute__((ext_vector_type(2)));
typedef float f32x4 __attribute__((ext_vector_type(4)));
typedef GAS unsigned gu32;
#define RLX_AGENT __ATOMIC_RELAXED, __HIP_MEMORY_SCOPE_AGENT
#define LDS_WAIT() asm volatile("s_waitcnt lgkmcnt(0)" ::: "memory")
__device__ __forceinline__ unsigned f2bf(float f) { unsigned u = __builtin_bit_cast(unsigned, f); return (u + 0x7fffu + ((u >> 16) & 1u)) >> 16; }
__device__ __forceinline__ unsigned pk2(float lo, float hi) { return f2bf(lo) | (f2bf(hi) << 16); }
__device__ __forceinline__ float bf2f(unsigned h) { return __builtin_bit_cast(float, h << 16); }
__device__ __forceinline__ float bflo(unsigned w) { return __builtin_bit_cast(float, w << 16); }
__device__ __forceinline__ float bfhi(unsigned w) { return __builtin_bit_cast(float, w & 0xffff0000u); }
__device__ __forceinline__ float wave_sum(float v) {
#pragma unroll
    for (int o = 1; o < 64; o <<= 1) v += __shfl_xor(v, o);
    return v;
}
__device__ __forceinline__ float wave_max(float v) {
#pragma unroll
    for (int o = 1; o < 64; o <<= 1) v = fmaxf(v, __shfl_xor(v, o));
    return v;
}

struct Frame {
    LAS unsigned char* lds;
    volatile LAS unsigned* MISC;
    gu32* ctl;
    int tid, lane, wave, G, bid;
    unsigned char* ws;
    const float* in[25];
    float* out;
};
#define WSP(T_, off) ((T_*)(F.ws + (off)))

__device__ __forceinline__ void transpose_item(const float* W, int ldw, bf16* WTr, int ldt, LAS float* scr, int lane) {
#pragma unroll 8
    for (int i = 0; i < 32; ++i) { const int kk = 2 * i + (lane >> 5); scr[kk * 33 + (lane & 31)] = W[(size_t)kk * ldw + (lane & 31)]; }
    LDS_WAIT(); asm volatile("" ::: "memory");
    const int c = lane & 7;
#pragma unroll
    for (int j = 0; j < 4; ++j) { const int n = (lane >> 3) + 8 * j; const LAS float* s = scr + (8 * c) * 33 + n;
        v4u o; o.x = pk2(s[0 * 33], s[1 * 33]); o.y = pk2(s[2 * 33], s[3 * 33]); o.z = pk2(s[4 * 33], s[5 * 33]); o.w = pk2(s[6 * 33], s[7 * 33]);
        *(GAS v4u*)(WTr + (size_t)n * ldt + 8 * c) = o; }
    LDS_WAIT(); asm volatile("" ::: "memory");
}
__device__ __forceinline__ void p0_prologue(Frame& F) {
    LAS float* scr = (LAS float*)(F.lds + F.wave * 16384);
    const int gw = F.bid * NWAVES + F.wave, NGW = F.G * NWAVES;
    const float* w_in = F.in[3];
    constexpr int I_IN = 32 * 224, I_SQ = 32 * 64, I_E = 512;
    constexpr int NIT = I_IN + 5 * I_SQ + 3 * 32 * I_E;
    for (int it = gw; it < NIT; it += NGW) {
        int r = it;
        if (r < I_IN) { const int kb = r / 224, nb = r % 224; transpose_item(w_in + (size_t)(64 * kb) * INW + 32 * nb, INW, WSP(bf16, WS_WIN) + (size_t)(32 * nb) * 2048 + 64 * kb, 2048, scr, F.lane); continue; }
        r -= I_IN;
        if (r < 5 * I_SQ) { const int w = r / I_SQ, q = r % I_SQ, kb = q / 64, nb = q % 64;
            const float* src = w == 0 ? F.in[7] : w == 1 ? F.in[10] : w == 2 ? F.in[11] : w == 3 ? F.in[12] : F.in[13];
            bf16* dst = w == 0 ? WSP(bf16, WS_WMIX) : w == 1 ? WSP(bf16, WS_WMQ) : w == 2 ? WSP(bf16, WS_WKV) : w == 3 ? (WSP(bf16, WS_WKV) + (size_t)2048 * 2048) : WSP(bf16, WS_WMO);
            transpose_item(src + (size_t)(64 * kb) * 2048 + 32 * nb, 2048, dst + (size_t)(32 * nb) * 2048 + 64 * kb, 2048, scr, F.lane); continue; }
        r -= 5 * I_SQ;
        if (r < 2 * 32 * I_E) {
            const int up = r / (32 * I_E), q = r % (32 * I_E), e = q / I_E, q2 = q % I_E, kb = q2 / 16, nb = q2 % 16, n0 = 32 * nb;
            const float* src = (up ? F.in[21] : F.in[20]) + (size_t)e * 2048 * 512 + (size_t)(64 * kb) * 512 + n0;
            bf16* dst = WSP(bf16, WS_WGU) + (size_t)(e * 1024 + (n0 >> 7) * 256 + up * 128 + (n0 & 127)) * 2048 + 64 * kb;
            transpose_item(src, 512, dst, 2048, scr, F.lane); continue; }
        r -= 2 * 32 * I_E;
        {
            const int e = r / I_E, q2 = r % I_E, kb = q2 / 64, nb = q2 % 64;
            const float* src = F.in[22] + (size_t)e * 512 * 2048 + (size_t)(64 * kb) * 2048 + 32 * nb;
            bf16* dst = WSP(bf16, WS_WD) + (size_t)(e * 2048 + 32 * nb) * 512 + 64 * kb;
            transpose_item(src, 2048, dst, 512, scr, F.lane); }
    }
    const int gt = F.bid * NTHR + F.tid, NGT = F.G * NTHR;
    {
        const float* x = F.in[0]; bf16* xb = WSP(bf16, WS_XB);
        for (int i = gt; i < T * D / 8; i += NGT) { const f32x4 a = *(const GAS f32x4*)(x + (size_t)i * 8), b = *(const GAS f32x4*)(x + (size_t)i * 8 + 4);
            v4u o; o.x = pk2(a[0], a[1]); o.y = pk2(a[2], a[3]); o.z = pk2(b[0], b[1]); o.w = pk2(b[2], b[3]); *(GAS v4u*)(xb + (size_t)i * 8) = o; }
        const float* mm = F.in[1]; bf16* mb = WSP(bf16, WS_MEMB);
        for (int i = gt; i < MEMN * D / 8; i += NGT) { const f32x4 a = *(const GAS f32x4*)(mm + (size_t)i * 8), b = *(const GAS f32x4*)(mm + (size_t)i * 8 + 4);
            v4u o; o.x = pk2(a[0], a[1]); o.y = pk2(a[2], a[3]); o.z = pk2(b[0], b[1]); o.w = pk2(b[2], b[3]); *(GAS v4u*)(mb + (size_t)i * 8) = o; }
    }
    {
        const int* pos = (const int*)F.in[2]; float* rc = WSP(float, WS_RC); float* rs = WSP(float, WS_RS);
        for (int i = gt; i < T * 128; i += NGT) { const int t = i >> 7, f = i & 127;
            const float inv = exp2f(-(float)f * (13.287712379549449f / 128.0f));
            const float ang = (float)pos[t] * inv;
            double rev = (double)ang * 0.15915494309189535; rev -= floor(rev);
            const float rf = (float)rev;
            rc[i] = __builtin_amdgcn_cosf(rf); rs[i] = __builtin_amdgcn_sinf(rf); }
    }
    {
        const float* x = F.in[0]; float* glr = WSP(float, WS_GLR);
        const int r16 = F.lane & 15, g4 = F.lane >> 4;
        for (int tile = gw; tile < T / 16; tile += NGW) {
            f32x4 acc = {0.f, 0.f, 0.f, 0.f};
            const float* xr = x + (size_t)(tile * 16 + r16) * D + 4 * g4;
            const float* wr = w_in + (size_t)(4 * g4) * INW + HW + r16;
#pragma unroll 4
            for (int k0 = 0; k0 < D; k0 += 16) {
                const f32x4 a = *(const GAS f32x4*)(xr + k0);
                const float b0 = wr[(size_t)(k0 + 0) * INW], b1 = wr[(size_t)(k0 + 1) * INW], b2 = wr[(size_t)(k0 + 2) * INW], b3 = wr[(size_t)(k0 + 3) * INW];
                acc = __builtin_amdgcn_mfma_f32_16x16x4f32(a[0], b0, acc, 0, 0, 0);
                acc = __builtin_amdgcn_mfma_f32_16x16x4f32(a[1], b1, acc, 0, 0, 0);
                acc = __builtin_amdgcn_mfma_f32_16x16x4f32(a[2], b2, acc, 0, 0, 0);
                acc = __builtin_amdgcn_mfma_f32_16x16x4f32(a[3], b3, acc, 0, 0, 0);
            }
#pragma unroll
            for (int j = 0; j < 4; ++j) glr[(size_t)(tile * 16 + 4 * g4 + j) * 16 + r16] = acc[j];
        }
    }
}

__device__ __forceinline__ float log_sigmoid_f(float z) { return fminf(z, 0.f) - log1pf(expf(-fabsf(z))); }
template <bool GLA>
__device__ __forceinline__ void mixer_naive_item(Frame& F, int hh, int eg) {
    constexpr int ND = GLA ? 4 : 8;
    const bf16* H = WSP(bf16, WS_H); float* oraw = WSP(float, WS_ORAW);
    const int ei = F.tid & 15, dp = F.tid >> 4, e = eg * 16 + ei;
    const int qcol = GLA ? 4096 + hh * 128 : hh * 256, kcol = GLA ? 4608 + hh * 128 : 1024 + hh * 256, vcol = (GLA ? 5120 : 2048) + hh * 256 + e;
    const int ocol = (GLA ? 1024 : 0) + hh * 256 + eg * 16;
    LAS float* red = (LAS float*)F.lds;
    float S[ND];
#pragma unroll
    for (int i = 0; i < ND; ++i) S[i] = 0.f;
    float wa[GLA ? 4 : 1][16]; float ba[GLA ? 4 : 1];
    if (GLA) {
#pragma unroll
        for (int i = 0; i < 4; ++i) { const int d = dp + 32 * i; ba[i] = F.in[5][hh * 128 + d];
#pragma unroll
            for (int r = 0; r < 16; ++r) wa[i][r] = F.in[4][r * 512 + hh * 128 + d]; }
    }
    const float gamma = 1.0f - exp2f(-5.0f - (float)hh);
    const float* glr = WSP(float, WS_GLR);
    for (int t0 = 0; t0 < T; t0 += 8) {
        float part[8];
#pragma unroll
        for (int tt = 0; tt < 8; ++tt) {
            const int t = t0 + tt; const bf16* hr = H + (size_t)t * HW;
            const float v = bf2f(hr[vcol]);
            float g16[16];
            if (GLA) {
#pragma unroll
                for (int r = 0; r < 16; ++r) g16[r] = glr[t * 16 + r];
            }
            float p = 0.f;
#pragma unroll
            for (int i = 0; i < ND; ++i) { const int d = dp + 32 * i;
                const float q = bf2f(hr[qcol + d]), k = bf2f(hr[kcol + d]);
                float a = gamma;
                if (GLA) { float z = ba[i];
#pragma unroll
                    for (int r = 0; r < 16; ++r) z += g16[r] * wa[i][r];
                    a = expf(log_sigmoid_f(z) * 0.0625f); }
                S[i] = a * S[i] + k * v; p += q * S[i]; }
            p += __shfl_xor(p, 16); p += __shfl_xor(p, 32);
            part[tt] = p;
        }
        if (F.lane < 16) {
#pragma unroll
            for (int tt = 0; tt < 8; ++tt) red[(F.wave * 8 + tt) * 16 + F.lane] = part[tt];
        }
        __syncthreads();
        if (F.tid < 128) { const int tt = F.tid >> 4, e2 = F.tid & 15; float s = 0.f;
#pragma unroll
            for (int w = 0; w < 8; ++w) s += red[(w * 8 + tt) * 16 + e2];
            oraw[(size_t)(t0 + tt) * D + ocol + e2] = s; }
        __syncthreads();
    }
}
__device__ __forceinline__ void p2_mixer_naive(Frame& F) {
    for (int item = F.bid; item < 128; item += F.G) {
        const int h8 = item >> 4, eg = item & 15;
        if (h8 < 4) mixer_naive_item<false>(F, h8, eg); else mixer_naive_item<true>(F, h8 - 4, eg);
    }
}
__device__ __forceinline__ void p3_normgate(Frame& F) {
    const bf16* H = WSP(bf16, WS_H); const float* oraw = WSP(float, WS_ORAW); bf16* mixed = WSP(bf16, WS_MIXED);
    const int gw = F.bid * NWAVES + F.wave, NGW = F.G * NWAVES;
    const f32x4 gn = *(const f32x4*)(F.in[6] + 4 * F.lane);
    for (int t = gw; t < T; t += NGW) {
#pragma unroll
        for (int h8 = 0; h8 < 8; ++h8) {
            const f32x4 o = *(const GAS f32x4*)(oraw + (size_t)t * D + h8 * 256 + 4 * F.lane);
            const int gcol = (h8 < 4 ? 3072 : 6144) + (h8 & 3) * 256 + 4 * F.lane;
            const v2u gw2 = *(const GAS v2u*)(H + (size_t)t * HW + gcol);
            const f32x4 gt = {bflo(gw2.x), bfhi(gw2.x), bflo(gw2.y), bfhi(gw2.y)};
            f32x4 y;
            if (h8 < 4) {
                const float mu = wave_sum((o[0] + o[1]) + (o[2] + o[3])) * (1.f / 256.f);
                const f32x4 dd = o - mu;
                const float var = wave_sum((dd[0] * dd[0] + dd[1] * dd[1]) + (dd[2] * dd[2] + dd[3] * dd[3])) * (1.f / 256.f);
                y = dd * (1.0f / sqrtf(var + LN_EPS));
            } else {
                const float ms = wave_sum((o[0] * o[0] + o[1] * o[1]) + (o[2] * o[2] + o[3] * o[3])) * (1.f / 256.f);
                y = o * (1.0f / sqrtf(ms + LN_EPS)) * gn;
            }
            float r[4];
#pragma unroll
            for (int i = 0; i < 4; ++i) { const float g = gt[i]; r[i] = g / (1.0f + expf(-g)) * y[i]; }
            v2u w; w.x = pk2(r[0], r[1]); w.y = pk2(r[2], r[3]);
            *(GAS v2u*)(mixed + (size_t)t * D + h8 * 256 + 4 * F.lane) = w;
        }
    }
}
template <bool ROUTER>
__device__ __forceinline__ void ln_apply(Frame& F, const float* Y, const float* g, const float* b, bf16* HB, float* st) {
    const int gw = F.bid * NWAVES + F.wave, NGW = F.G * NWAVES;
    for (int t = gw; t < T; t += NGW) {
        const GAS f32x4* yr = (const GAS f32x4*)(Y + (size_t)t * D) + F.lane;
        f32x4 v[8]; float s = 0.f;
#pragma unroll
        for (int j = 0; j < 8; ++j) { v[j] = yr[64 * j]; s += (v[j][0] + v[j][1]) + (v[j][2] + v[j][3]); }
        const float mean = wave_sum(s) * (1.f / D); float s2 = 0.f;
#pragma unroll
        for (int j = 0; j < 8; ++j) { v[j] = v[j] - mean; s2 += (v[j][0] * v[j][0] + v[j][1] * v[j][1]) + (v[j][2] * v[j][2] + v[j][3] * v[j][3]); }
        const float rstd = 1.f / sqrtf(wave_sum(s2) * (1.f / D) + LN_EPS);
        if (F.lane == 0) { st[2 * t] = mean; st[2 * t + 1] = rstd; }
        GAS v2u* o8 = (GAS v2u*)(HB + (size_t)t * D) + F.lane;
#pragma unroll
        for (int j = 0; j < 8; ++j) { const f32x4 gv = *(const f32x4*)(g + 4 * F.lane + 256 * j), bv = *(const f32x4*)(b + 4 * F.lane + 256 * j);
            v[j] = v[j] * rstd * gv + bv;
            v2u w; w.x = pk2(v[j][0], v[j][1]); w.y = pk2(v[j][2], v[j][3]); o8[64 * j] = w; }
        if (ROUTER) {
            const float* Wg = F.in[16]; const float* We = F.in[18];
            float lg[4], le[32];
#pragma unroll
            for (int i = 0; i < 4; ++i) lg[i] = 0.f;
#pragma unroll
            for (int i = 0; i < 32; ++i) le[i] = 0.f;
#pragma unroll
            for (int j = 0; j < 8; ++j) {
#pragma unroll
                for (int i = 0; i < 4; ++i) { const int c = 4 * F.lane + 256 * j + i; const float hv = v[j][i];
                    const f32x4 wg = *(const GAS f32x4*)(Wg + (size_t)c * 4);
#pragma unroll
                    for (int q = 0; q < 4; ++q) lg[q] += hv * wg[q];
#pragma unroll
                    for (int q8 = 0; q8 < 8; ++q8) { const f32x4 we = *(const GAS f32x4*)(We + (size_t)c * 32 + 4 * q8);
#pragma unroll
                        for (int q = 0; q < 4; ++q) le[4 * q8 + q] += hv * we[q]; } }
            }
#pragma unroll
            for (int i = 0; i < 4; ++i) lg[i] = wave_sum(lg[i]) + F.in[17][i];
#pragma unroll
            for (int i = 0; i < 32; ++i) le[i] = wave_sum(le[i]);
            int grp = 0; float gm = lg[0];
#pragma unroll
            for (int i = 1; i < 4; ++i) if (lg[i] > gm) { gm = lg[i]; grp = i; }
            float gs = 0.f;
#pragma unroll
            for (int i = 0; i < 4; ++i) gs += expf(lg[i] - gm);
            const float pg_sel = 1.0f / gs;
            float fe[8];
#pragma unroll
            for (int j = 0; j < 8; ++j) { const float a = grp == 0 ? le[j] : grp == 1 ? le[8 + j] : grp == 2 ? le[16 + j] : le[24 + j]; fe[j] = a + F.in[19][grp * 8 + j]; }
            int i1 = 0; float m1 = fe[0];
#pragma unroll
            for (int j = 1; j < 8; ++j) if (fe[j] > m1) { m1 = fe[j]; i1 = j; }
            int i2 = -1; float m2 = -3.0e38f;
#pragma unroll
            for (int j = 0; j < 8; ++j) if (j != i1 && fe[j] > m2) { m2 = fe[j]; i2 = j; }
            const float p2 = expf(m2 - m1), den = 1.0f / (1.0f + p2);
            if (F.lane == 0) {
                int* ex = WSP(int, WS_EXP); float* gt = WSP(float, WS_GATE);
                const int e1 = grp * 8 + i1, e2 = grp * 8 + i2;
                ex[2 * t] = e1; ex[2 * t + 1] = e2; gt[2 * t] = pg_sel * den; gt[2 * t + 1] = pg_sel * p2 * den;
                atomicAdd((unsigned*)(F.ctl + CW_CNT) + e1, 1u); atomicAdd((unsigned*)(F.ctl + CW_CNT) + e2, 1u);
            }
        }
    }
}
__device__ __forceinline__ void p7_attn_naive(Frame& F) {
    const bf16* Q = WSP(bf16, WS_QB); const bf16* KVM = WSP(bf16, WS_KVM); bf16* att = WSP(bf16, WS_ATT);
    LAS float* qs = (LAS float*)F.lds;
    LAS float* sc = (LAS float*)(F.lds + 16384);
    for (int item = F.bid; item < (T / 8) * 4; item += F.G) {
        const int h = item & 3, t0 = (item >> 2) * 8;
        for (int i = F.tid; i < 8 * 512; i += NTHR) { const int tt = i >> 9, d = i & 511; qs[i] = bf2f(Q[(size_t)(t0 + tt) * D + h * 512 + d]); }
        __syncthreads();
        {
            const int j = F.tid & 255, th = F.tid >> 8;
            const bf16* kr = KVM + (size_t)j * 4096 + h * 512;
            float a0 = 0.f, a1 = 0.f, a2 = 0.f, a3 = 0.f;
            for (int d = 0; d < 512; d += 8) {
                const v4u kw = *(const GAS v4u*)(kr + d);
                const float kf[8] = {bflo(kw.x), bfhi(kw.x), bflo(kw.y), bfhi(kw.y), bflo(kw.z), bfhi(kw.z), bflo(kw.w), bfhi(kw.w)};
#pragma unroll
                for (int i = 0; i < 8; ++i) { a0 += kf[i] * qs[(th * 4 + 0) * 512 + d + i]; a1 += kf[i] * qs[(th * 4 + 1) * 512 + d + i]; a2 += kf[i] * qs[(th * 4 + 2) * 512 + d + i]; a3 += kf[i] * qs[(th * 4 + 3) * 512 + d + i]; }
            }
            const float scl = 0.04419417382415922f;
            sc[(th * 4 + 0) * 256 + j] = a0 * scl; sc[(th * 4 + 1) * 256 + j] = a1 * scl; sc[(th * 4 + 2) * 256 + j] = a2 * scl; sc[(th * 4 + 3) * 256 + j] = a3 * scl;
        }
        __syncthreads();
        {
            float v[4]; float mx = -3.0e38f;
#pragma unroll
            for (int i = 0; i < 4; ++i) { v[i] = sc[F.wave * 256 + F.lane + 64 * i]; mx = fmaxf(mx, v[i]); }
            mx = wave_max(mx); float sm = 0.f;
#pragma unroll
            for (int i = 0; i < 4; ++i) { v[i] = expf(v[i] - mx); sm += v[i]; }
            sm = 1.0f / wave_sum(sm);
#pragma unroll
            for (int i = 0; i < 4; ++i) sc[F.wave * 256 + F.lane + 64 * i] = v[i] * sm;
        }
        __syncthreads();
        {
            const int d = F.tid; const bf16* vr = KVM + 2048 + h * 512 + d;
            float o[8];
#pragma unroll
            for (int i = 0; i < 8; ++i) o[i] = 0.f;
            for (int j = 0; j < 256; ++j) { const float vv = bf2f(vr[(size_t)j * 4096]);
#pragma unroll
                for (int i = 0; i < 8; ++i) o[i] += sc[i * 256 + j] * vv; }
#pragma unroll
            for (int i = 0; i < 8; ++i) att[(size_t)(t0 + i) * D + h * 512 + d] = (bf16)f2bf(o[i]);
        }
        __syncthreads();
    }
}
__device__ __forceinline__ void moe_tile_starts(Frame& F, LAS int* ts) {
    if (F.tid == 0) { int acc = 0;
        for (int e = 0; e < 32; ++e) { ts[e] = acc; const unsigned c = __hip_atomic_load(F.ctl + CW_CNT + e, RLX_AGENT); acc += (int)((c + 255u) >> 8); }
        ts[32] = acc; }
    __syncthreads();
}
__device__ __forceinline__ void p10_dispatch(Frame& F, LAS int* ts) {
    const int gw = F.bid * NWAVES + F.wave, NGW = F.G * NWAVES;
    const int* ex = WSP(int, WS_EXP); int* pos = WSP(int, WS_POS); const bf16* h2 = WSP(bf16, WS_H2B); bf16* xs = WSP(bf16, WS_XS);
    for (int a = gw; a < 2 * T; a += NGW) {
        const int e = ex[a]; unsigned slot = 0;
        if (F.lane == 0) slot = atomicAdd((unsigned*)(F.ctl + CW_CUR) + e, 1u);
        slot = __builtin_amdgcn_readfirstlane(slot);
        const int p = ts[e] * 256 + (int)slot;
        if (F.lane == 0) pos[a] = p;
        const GAS v4u* src = (const GAS v4u*)(h2 + (size_t)(a >> 1) * D) + F.lane; GAS v4u* dst = (GAS v4u*)(xs + (size_t)p * D) + F.lane;
#pragma unroll
        for (int j = 0; j < 4; ++j) dst[64 * j] = src[64 * j];
    }
}
__device__ __forceinline__ void p13_combine(Frame& F) {
    const int gw = F.bid * NWAVES + F.wave, NGW = F.G * NWAVES;
    const float* Y2 = WSP(float, WS_Y2); const float* st2 = WSP(float, WS_ST2); const bf16* ys = WSP(bf16, WS_YS);
    const int* pos = WSP(int, WS_POS); const float* gt = WSP(float, WS_GATE);
    const float* g2 = F.in[14]; const float* b2 = F.in[15]; const float* g3 = F.in[23]; const float* b3 = F.in[24];
    for (int t = gw; t < T; t += NGW) {
        const float mu2 = st2[2 * t], rs2 = st2[2 * t + 1];
        const int p0 = pos[2 * t], p1 = pos[2 * t + 1]; const float w0 = gt[2 * t], w1 = gt[2 * t + 1];
        const GAS f32x4* yr = (const GAS f32x4*)(Y2 + (size_t)t * D) + F.lane;
        const GAS v2u* y0 = (const GAS v2u*)(ys + (size_t)p0 * D) + F.lane; const GAS v2u* y1 = (const GAS v2u*)(ys + (size_t)p1 * D) + F.lane;
        f32x4 v[8]; float s = 0.f;
#pragma unroll
        for (int j = 0; j < 8; ++j) { const f32x4 gv = *(const f32x4*)(g2 + 4 * F.lane + 256 * j), bv = *(const f32x4*)(b2 + 4 * F.lane + 256 * j);
            const f32x4 h = (yr[64 * j] - mu2) * rs2 * gv + bv;
            const v2u a = y0[64 * j], c = y1[64 * j];
            const f32x4 fa = {bflo(a.x), bfhi(a.x), bflo(a.y), bfhi(a.y)}, fc = {bflo(c.x), bfhi(c.x), bflo(c.y), bfhi(c.y)};
            v[j] = h * ALPHA + fa * w0 + fc * w1; s += (v[j][0] + v[j][1]) + (v[j][2] + v[j][3]); }
        const float mean = wave_sum(s) * (1.f / D); float s2 = 0.f;
#pragma unroll
        for (int j = 0; j < 8; ++j) { v[j] = v[j] - mean; s2 += (v[j][0] * v[j][0] + v[j][1] * v[j][1]) + (v[j][2] * v[j][2] + v[j][3] * v[j][3]); }
        const float rstd = 1.f / sqrtf(wave_sum(s2) * (1.f / D) + LN_EPS);
        GAS f32x4* orow = (GAS f32x4*)(F.out + (size_t)t * D) + F.lane;
#pragma unroll
        for (int j = 0; j < 8; ++j) { const f32x4 gv = *(const f32x4*)(g3 + 4 * F.lane + 256 * j), bv = *(const f32x4*)(b3 + 4 * F.lane + 256 * j);
            orow[64 * j] = v[j] * rstd * gv + bv; }
    }
}

constexpr int CS = 128, NB = CS / 64, NS = T / CS;
constexpr size_t WS_BCUM = WS_ORAW;
constexpr size_t WS_KVR = WS_ORAW + 16 * MiB;
constexpr size_t WS_KVG = WS_KVR + 32 * MiB;
typedef short bf16x8_t __attribute__((ext_vector_type(8)));
typedef short s16x4_t __attribute__((ext_vector_type(4)));
__device__ __forceinline__ s16x4_t lds_tr(const LAS unsigned char* p) { return __builtin_bit_cast(s16x4_t, __builtin_amdgcn_ds_read_tr16_b64_v4i16((LAS s16x4_t*)p)); }
__device__ __forceinline__ bf16x8_t frag_tr(const LAS unsigned char* X, int pitch, int k0, int n0, int lane) {
    const int fq = lane >> 4, q = (lane >> 2) & 3, p = lane & 3;
    const LAS unsigned char* a = X + ((k0 + 8 * fq + q) * pitch + n0 + 4 * p) * 2;
    const s16x4_t lo = lds_tr(a), hi = lds_tr(a + 4 * pitch * 2);
    return __builtin_shufflevector(lo, hi, 0, 1, 2, 3, 4, 5, 6, 7);
}
__device__ __forceinline__ bf16x8_t frag_row(const LAS unsigned char* X, int pitch, int r0, int k0, int lane) {
    return *(const LAS bf16x8_t*)(X + ((r0 + (lane & 15)) * pitch + k0 + 8 * (lane >> 4)) * 2);
}
#define MFMA16(a, b, c) __builtin_amdgcn_mfma_f32_16x16x32_bf16((a), (b), (c), 0, 0, 0)
__device__ __forceinline__ float fexp(float x) { return __builtin_amdgcn_exp2f(x * 1.4426950408889634f); }
__device__ __forceinline__ float silu_g(float g) { return g * __builtin_amdgcn_rcpf(1.0f + __builtin_amdgcn_exp2f(-1.4426950408889634f * g)); }

__device__ __forceinline__ void bcum_item(Frame& F, int s, int h) {
    const int c = F.tid & 127, tq = F.tid >> 7;
    LAS float* tot = (LAS float*)F.lds;
    const float* glr = WSP(float, WS_GLR); float* bc = WSP(float, WS_BCUM);
    float w[16];
#pragma unroll
    for (int r = 0; r < 16; ++r) w[r] = F.in[4][r * 512 + h * 128 + c];
    const float bias = F.in[5][h * 128 + c];
    float vals[32]; float run = 0.f;
    const int tb = s * CS + tq * 32;
#pragma unroll
    for (int i = 0; i < 32; ++i) { const float* gr = glr + (size_t)(tb + i) * 16; float z = bias;
#pragma unroll
        for (int r = 0; r < 16; ++r) z += gr[r] * w[r];
        run += log_sigmoid_f(z) * 0.0625f; vals[i] = run; }
    __syncthreads();
    tot[tq * 128 + c] = run;
    __syncthreads();
    float off = 0.f;
#pragma unroll
    for (int q = 0; q < 3; ++q) off += (q < tq) ? tot[q * 128 + c] : 0.f;
#pragma unroll
    for (int i = 0; i < 32; ++i) bc[(size_t)(tb + i) * 512 + h * 128 + c] = vals[i] + off;
}
__device__ __forceinline__ void p1_bcum(Frame& F) { for (int it = F.bid; it < NS * 4; it += F.G) bcum_item(F, it >> 2, it & 3); __syncthreads(); }

__device__ __forceinline__ void unit_sh(int u, int& s, int& h8) { s = (u >> 3) & (NS - 1); h8 = ((u & 7) + 4 * (u >> 8)) & 7; }

template <bool GLA, int MODE>
__device__ __forceinline__ void stage_qk(Frame& F, LAS unsigned char* dst, int s, int jb, int hh, int col0, float lg2gamma) {
    constexpr int DK = GLA ? 128 : 256, PK = DK + 8, CPR = DK / 8, NIT = 64 * CPR / NTHR;
    const bf16* H = WSP(bf16, WS_H); const float* bc = WSP(float, WS_BCUM);
#pragma unroll
    for (int it = 0; it < NIT; ++it) {
        const int ch = F.tid + NTHR * it, r = ch / CPR, cc = ch % CPR, tl = jb * 64 + r, t = s * CS + tl;
        const v4u w = *(const GAS v4u*)(H + (size_t)t * HW + col0 + 8 * cc);
        float f[8] = {bflo(w.x), bfhi(w.x), bflo(w.y), bfhi(w.y), bflo(w.z), bfhi(w.z), bflo(w.w), bfhi(w.w)};
        if (GLA) {
            const f32x4 b0 = *(const GAS f32x4*)(bc + (size_t)t * 512 + hh * 128 + 8 * cc), b1 = *(const GAS f32x4*)(bc + (size_t)t * 512 + hh * 128 + 8 * cc + 4);
            float e[8] = {b0[0], b0[1], b0[2], b0[3], b1[0], b1[1], b1[2], b1[3]};
            if (MODE == 2) { const size_t tl_ = (size_t)(s * CS + CS - 1) * 512 + hh * 128 + 8 * cc; const f32x4 l0 = *(const GAS f32x4*)(bc + tl_), l1 = *(const GAS f32x4*)(bc + tl_ + 4);
                const float l[8] = {l0[0], l0[1], l0[2], l0[3], l1[0], l1[1], l1[2], l1[3]};
#pragma unroll
                for (int i = 0; i < 8; ++i) e[i] = l[i] - e[i]; }
            else if (MODE == 1) {
#pragma unroll
                for (int i = 0; i < 8; ++i) e[i] = -e[i]; }
#pragma unroll
            for (int i = 0; i < 8; ++i) f[i] *= fexp(e[i]);
        } else {
            const float ex = MODE == 0 ? (float)(tl + 1) : MODE == 1 ? -(float)(tl + 1) : (float)(CS - 1 - tl);
            const float fac = __builtin_amdgcn_exp2f(ex * lg2gamma);
#pragma unroll
            for (int i = 0; i < 8; ++i) f[i] *= fac;
        }
        v4u o; o.x = pk2(f[0], f[1]); o.y = pk2(f[2], f[3]); o.z = pk2(f[4], f[5]); o.w = pk2(f[6], f[7]);
        *(LAS v4u*)(dst + (r * PK + 8 * cc) * 2) = o;
    }
}
__device__ __forceinline__ void stage_v(Frame& F, LAS unsigned char* dst, int s, int jb, int col0) {
    const bf16* H = WSP(bf16, WS_H);
#pragma unroll
    for (int it = 0; it < 4; ++it) { const int ch = F.tid + NTHR * it, r = ch >> 5, cc = ch & 31, t = s * CS + jb * 64 + r;
        *(LAS v4u*)(dst + (r * 264 + 8 * cc) * 2) = *(const GAS v4u*)(H + (size_t)t * HW + col0 + 8 * cc); }
}

template <bool GLA>
__device__ __forceinline__ void kv_unit(Frame& F, int s, int hh) {
    constexpr int DK = GLA ? 128 : 256, PK = DK + 8, NDT = DK / 16;
    LAS unsigned char* Ks = F.lds; LAS unsigned char* Vs = F.lds + 34816;
    const int kcol = GLA ? 4608 + hh * 128 : 1024 + hh * 256, vcol = (GLA ? 5120 : 2048) + hh * 256;
    const float lg2g = log2f(1.0f - exp2f(-5.0f - (float)hh));
    f32x4 acc[2][NDT];
#pragma unroll
    for (int a = 0; a < 2; ++a)
#pragma unroll
        for (int d = 0; d < NDT; ++d) acc[a][d] = (f32x4){0.f, 0.f, 0.f, 0.f};
    for (int jb = 0; jb < NB; ++jb) {
        __syncthreads();
        stage_qk<GLA, 2>(F, Ks, s, jb, hh, kcol, lg2g);
        stage_v(F, Vs, s, jb, vcol);
        __syncthreads();
#pragma unroll
        for (int ks = 0; ks < 2; ++ks) {
            bf16x8_t vf[2];
#pragma unroll
            for (int et = 0; et < 2; ++et) vf[et] = frag_tr(Vs, 264, 32 * ks, 32 * F.wave + 16 * et, F.lane);
#pragma unroll
            for (int dt = 0; dt < NDT; ++dt) { const bf16x8_t kf = frag_tr(Ks, PK, 32 * ks, 16 * dt, F.lane);
#pragma unroll
                for (int et = 0; et < 2; ++et) acc[et][dt] = MFMA16(kf, vf[et], acc[et][dt]); }
        }
    }
    bf16* kv = GLA ? (WSP(bf16, WS_KVG) + (size_t)(s * 4 + hh) * 256 * 128) : (WSP(bf16, WS_KVR) + (size_t)(s * 4 + hh) * 256 * 256);
    const int fr = F.lane & 15, fq = F.lane >> 4;
#pragma unroll
    for (int et = 0; et < 2; ++et)
#pragma unroll
        for (int dt = 0; dt < NDT; ++dt) { v2u w; w.x = pk2(acc[et][dt][0], acc[et][dt][1]); w.y = pk2(acc[et][dt][2], acc[et][dt][3]);
            *(GAS v2u*)(kv + (size_t)(32 * F.wave + 16 * et + fr) * DK + 16 * dt + 4 * fq) = w; }
}
__device__ __forceinline__ void p2_kv(Frame& F) {
    for (int u = F.bid; u < 8 * NS; u += F.G) { int s, h8; unit_sh(u, s, h8);
        if (s == NS - 1) continue;
        if (h8 < 4) kv_unit<false>(F, s, h8); else kv_unit<true>(F, s, h8 - 4); }
    __syncthreads();
}
__device__ __forceinline__ void p3_scan(Frame& F) {
    const int gt = F.bid * NTHR + F.tid, NGT = F.G * NTHR;
    constexpr int NR = 4 * 256 * 32, NG = 4 * 256 * 16;
    const float* bc = WSP(float, WS_BCUM);
    for (int it = gt; it < NR + NG; it += NGT) {
        const bool gla = it >= NR; const int r = gla ? it - NR : it;
        const int sh = gla ? 4 : 5, dk = gla ? 128 : 256;
        const int cc = r & ((1 << sh) - 1), e = (r >> sh) & 255, hh = r >> (sh + 8);
        bf16* base = (gla ? WSP(bf16, WS_KVG) : WSP(bf16, WS_KVR)) + ((size_t)hh * 256 + e) * dk + 8 * cc;
        const size_t sstride = (size_t)4 * 256 * dk;
        const float dret = __builtin_amdgcn_exp2f((float)CS * log2f(1.0f - exp2f(-5.0f - (float)hh)));
        float S[8];
#pragma unroll
        for (int i = 0; i < 8; ++i) S[i] = 0.f;
#pragma unroll 4
        for (int s = 0; s < NS - 1; ++s) {
            GAS v4u* p = (GAS v4u*)(base + (size_t)s * sstride);
            const v4u w = *p;
            v4u o; o.x = pk2(S[0], S[1]); o.y = pk2(S[2], S[3]); o.z = pk2(S[4], S[5]); o.w = pk2(S[6], S[7]);
            *p = o;
            const float f[8] = {bflo(w.x), bfhi(w.x), bflo(w.y), bfhi(w.y), bflo(w.z), bfhi(w.z), bflo(w.w), bfhi(w.w)};
            float dec[8];
            if (gla) { const size_t o_ = (size_t)(s * CS + CS - 1) * 512 + hh * 128 + 8 * cc; const f32x4 l0 = *(const GAS f32x4*)(bc + o_), l1 = *(const GAS f32x4*)(bc + o_ + 4);
                dec[0] = fexp(l0[0]); dec[1] = fexp(l0[1]); dec[2] = fexp(l0[2]); dec[3] = fexp(l0[3]); dec[4] = fexp(l1[0]); dec[5] = fexp(l1[1]); dec[6] = fexp(l1[2]); dec[7] = fexp(l1[3]); }
            else {
#pragma unroll
                for (int i = 0; i < 8; ++i) dec[i] = dret; }
#pragma unroll
            for (int i = 0; i < 8; ++i) S[i] = dec[i] * S[i] + f[i];
        }
        { GAS v4u* p = (GAS v4u*)(base + (size_t)(NS - 1) * sstride);
          v4u o; o.x = pk2(S[0], S[1]); o.y = pk2(S[2], S[3]); o.z = pk2(S[4], S[5]); o.w = pk2(S[6], S[7]); *p = o; }
    }
}
template <bool GLA>
__device__ __forceinline__ void out_unit(Frame& F, int s, int hh) {
    constexpr int DK = GLA ? 128 : 256, PK = DK + 8, NKS = DK / 32;
    LAS unsigned char* Qs = F.lds; LAS unsigned char* Ks = F.lds + 33792; LAS unsigned char* Vs = F.lds + 67584; LAS unsigned char* Ps = F.lds + 101376;
    LAS float* red = (LAS float*)(F.lds + 110592);
    const int qcol = GLA ? 4096 + hh * 128 : hh * 256, kcol = GLA ? 4608 + hh * 128 : 1024 + hh * 256, vcol = (GLA ? 5120 : 2048) + hh * 256;
    const int gcol = (GLA ? 6144 : 3072) + hh * 256, ocol = (GLA ? 1024 : 0) + hh * 256;
    const float lg2g = log2f(1.0f - exp2f(-5.0f - (float)hh));
    const bf16* H = WSP(bf16, WS_H); bf16* mixed = WSP(bf16, WS_MIXED);
    const bf16* st = GLA ? (WSP(bf16, WS_KVG) + (size_t)(s * 4 + hh) * 256 * 128) : (WSP(bf16, WS_KVR) + (size_t)(s * 4 + hh) * 256 * 256);
    const int fr = F.lane & 15, fq = F.lane >> 4, w = F.wave, mt = w >> 1, nt0 = 2 * (w & 1);
    for (int i = 0; i < NB; ++i) {
        __syncthreads();
        stage_qk<GLA, 0>(F, Qs, s, i, hh, qcol, lg2g);
        f32x4 accO[4][2];
#pragma unroll
        for (int m = 0; m < 4; ++m)
#pragma unroll
            for (int n = 0; n < 2; ++n) accO[m][n] = (f32x4){0.f, 0.f, 0.f, 0.f};
        for (int j = 0; j <= i; ++j) {
            __syncthreads();
            stage_qk<GLA, 1>(F, Ks, s, j, hh, kcol, lg2g);
            stage_v(F, Vs, s, j, vcol);
            __syncthreads();
            f32x4 accS[2] = {(f32x4){0.f, 0.f, 0.f, 0.f}, (f32x4){0.f, 0.f, 0.f, 0.f}};
#pragma unroll
            for (int ks = 0; ks < NKS; ++ks) { const bf16x8_t qf = frag_row(Qs, PK, 16 * mt, 32 * ks, F.lane);
#pragma unroll
                for (int n2 = 0; n2 < 2; ++n2) { const bf16x8_t kf = frag_row(Ks, PK, 16 * (nt0 + n2), 32 * ks, F.lane); accS[n2] = MFMA16(kf, qf, accS[n2]); } }
#pragma unroll
            for (int n2 = 0; n2 < 2; ++n2) { const int row = 16 * mt + fr, c0 = 16 * (nt0 + n2) + 4 * fq; float pv[4];
#pragma unroll
                for (int jj = 0; jj < 4; ++jj) pv[jj] = (i == j && c0 + jj > row) ? 0.f : accS[n2][jj];
                v2u pw; pw.x = pk2(pv[0], pv[1]); pw.y = pk2(pv[2], pv[3]);
                *(LAS v2u*)(Ps + (row * 72 + c0) * 2) = pw; }
            __syncthreads();
#pragma unroll
            for (int ks = 0; ks < 2; ++ks) {
                bf16x8_t vf[2];
#pragma unroll
                for (int n = 0; n < 2; ++n) vf[n] = frag_tr(Vs, 264, 32 * ks, 32 * w + 16 * n, F.lane);
#pragma unroll
                for (int m = 0; m < 4; ++m) { const bf16x8_t pf = frag_row(Ps, 72, 16 * m, 32 * ks, F.lane);
#pragma unroll
                    for (int n = 0; n < 2; ++n) accO[m][n] = MFMA16(vf[n], pf, accO[m][n]); }
            }
        }
        if (s > 0) {
#pragma unroll
            for (int ks = 0; ks < NKS; ++ks) {
                bf16x8_t sf[2];
#pragma unroll
                for (int n = 0; n < 2; ++n) sf[n] = *(const GAS bf16x8_t*)(st + (size_t)(32 * w + 16 * n + fr) * DK + 32 * ks + 8 * fq);
#pragma unroll
                for (int m = 0; m < 4; ++m) { const bf16x8_t qf = frag_row(Qs, PK, 16 * m, 32 * ks, F.lane);
#pragma unroll
                    for (int n = 0; n < 2; ++n) accO[m][n] = MFMA16(sf[n], qf, accO[m][n]); }
            }
        }
#pragma unroll
        for (int m = 0; m < 4; ++m) { float s1 = 0.f, s2 = 0.f;
#pragma unroll
            for (int n = 0; n < 2; ++n)
#pragma unroll
                for (int jj = 0; jj < 4; ++jj) { const float v = accO[m][n][jj]; s1 += v; s2 += v * v; }
            s1 += __shfl_xor(s1, 16); s1 += __shfl_xor(s1, 32); s2 += __shfl_xor(s2, 16); s2 += __shfl_xor(s2, 32);
            if (fq == 0) { red[(w * 64 + 16 * m + fr) * 2] = s1; red[(w * 64 + 16 * m + fr) * 2 + 1] = s2; } }
        __syncthreads();
#pragma unroll
        for (int m = 0; m < 4; ++m) { const int row = 16 * m + fr; float s1 = 0.f, s2 = 0.f;
#pragma unroll
            for (int ww = 0; ww < 8; ++ww) { s1 += red[(ww * 64 + row) * 2]; s2 += red[(ww * 64 + row) * 2 + 1]; }
            const float mean = s1 * (1.f / 256.f), ex2 = s2 * (1.f / 256.f);
            const float mu = GLA ? 0.f : mean, var = GLA ? ex2 : fmaxf(ex2 - mean * mean, 0.f);
            const float rstd = 1.0f / sqrtf(var + LN_EPS);
            const int t = s * CS + i * 64 + row;
#pragma unroll
            for (int n = 0; n < 2; ++n) { const int e = 32 * w + 16 * n + 4 * fq;
                const v2u gw2 = *(const GAS v2u*)(H + (size_t)t * HW + gcol + e);
                const float gt[4] = {bflo(gw2.x), bfhi(gw2.x), bflo(gw2.y), bfhi(gw2.y)};
                f32x4 gn = {1.f, 1.f, 1.f, 1.f}; if (GLA) gn = *(const f32x4*)(F.in[6] + e);
                float r4[4];
#pragma unroll
                for (int jj = 0; jj < 4; ++jj) { const float y = (accO[m][n][jj] - mu) * rstd * gn[jj]; r4[jj] = silu_g(gt[jj]) * y; }
                v2u ow; ow.x = pk2(r4[0], r4[1]); ow.y = pk2(r4[2], r4[3]);
                *(GAS v2u*)(mixed + (size_t)t * D + ocol + e) = ow; } }
    }
}
__device__ __forceinline__ void p4_out(Frame& F) {
    for (int u = F.bid; u < 8 * NS; u += F.G) { int s, h8; unit_sh(u, s, h8);
        if (h8 < 4) out_unit<false>(F, s, h8); else out_unit<true>(F, s, h8 - 4); }
    __syncthreads();
}

__device__ __forceinline__ void stage_kv_chunk(Frame& F, LAS unsigned char* dst, const bf16* src  ) {
#pragma unroll
    for (int it = 0; it < 8; ++it) { const int ch = F.tid + NTHR * it, r = ch >> 4, cc = ch & 15;
        *(LAS v4u*)(dst + (r * 136 + 8 * cc) * 2) = *(const GAS v4u*)(src + (size_t)r * 4096 + 8 * cc); }
}
__device__ __forceinline__ void p8_attn(Frame& F) {
    const bf16* Q = WSP(bf16, WS_QB); const bf16* KVM = WSP(bf16, WS_KVM); bf16* att = WSP(bf16, WS_ATT);
    LAS unsigned char* Cs = F.lds;
    const int fr = F.lane & 15, fq = F.lane >> 4, q4 = (F.lane >> 2) & 3, p4 = F.lane & 3;
    for (int u = F.bid; u < (T / 128) * 4; u += F.G) {
        const int h = u & 3, r0 = (u >> 2) * 128 + 16 * F.wave;
        f32x4 accS[16];
#pragma unroll
        for (int i = 0; i < 16; ++i) accS[i] = (f32x4){0.f, 0.f, 0.f, 0.f};
        for (int dc = 0; dc < 4; ++dc) {
            __syncthreads();
            stage_kv_chunk(F, Cs, KVM + h * 512 + dc * 128);
            bf16x8_t qf[4];
#pragma unroll
            for (int ks = 0; ks < 4; ++ks) qf[ks] = *(const GAS bf16x8_t*)(Q + (size_t)(r0 + fr) * D + h * 512 + dc * 128 + 32 * ks + 8 * fq);
            __syncthreads();
#pragma unroll
            for (int ks = 0; ks < 4; ++ks)
#pragma unroll
                for (int nt = 0; nt < 16; ++nt) accS[nt] = MFMA16(frag_row(Cs, 136, 16 * nt, 32 * ks, F.lane), qf[ks], accS[nt]);
        }
        float mx = -3.0e38f;
#pragma unroll
        for (int nt = 0; nt < 16; ++nt)
#pragma unroll
            for (int jj = 0; jj < 4; ++jj) mx = fmaxf(mx, accS[nt][jj]);
        mx = fmaxf(mx, __shfl_xor(mx, 16)); mx = fmaxf(mx, __shfl_xor(mx, 32));
        const float sl2 = 0.04419417382415922f * 1.4426950408889634f;
        float sm = 0.f;
#pragma unroll
        for (int nt = 0; nt < 16; ++nt)
#pragma unroll
            for (int jj = 0; jj < 4; ++jj) { const float p = __builtin_amdgcn_exp2f((accS[nt][jj] - mx) * sl2); accS[nt][jj] = p; sm += p; }
        sm += __shfl_xor(sm, 16); sm += __shfl_xor(sm, 32);
        const float inv = 1.0f / sm;
        bf16x8_t pf[8];
#pragma unroll
        for (int ks2 = 0; ks2 < 8; ++ks2) { v4u w; w.x = pk2(accS[2 * ks2][0] * inv, accS[2 * ks2][1] * inv); w.y = pk2(accS[2 * ks2][2] * inv, accS[2 * ks2][3] * inv);
            w.z = pk2(accS[2 * ks2 + 1][0] * inv, accS[2 * ks2 + 1][1] * inv); w.w = pk2(accS[2 * ks2 + 1][2] * inv, accS[2 * ks2 + 1][3] * inv); pf[ks2] = __builtin_bit_cast(bf16x8_t, w); }
        for (int ec = 0; ec < 4; ++ec) {
            __syncthreads();
            stage_kv_chunk(F, Cs, KVM + 2048 + h * 512 + ec * 128);
            __syncthreads();
            f32x4 accO[8];
#pragma unroll
            for (int i = 0; i < 8; ++i) accO[i] = (f32x4){0.f, 0.f, 0.f, 0.f};
#pragma unroll
            for (int ks2 = 0; ks2 < 8; ++ks2)
#pragma unroll
                for (int et = 0; et < 8; ++et) { const LAS unsigned char* a = Cs + ((32 * ks2 + 4 * fq + q4) * 136 + 16 * et + 4 * p4) * 2;
                    const s16x4_t lo = lds_tr(a), hi = lds_tr(a + 16 * 136 * 2);
                    accO[et] = MFMA16(__builtin_shufflevector(lo, hi, 0, 1, 2, 3, 4, 5, 6, 7), pf[ks2], accO[et]); }
#pragma unroll
            for (int et = 0; et < 8; ++et) { v2u w; w.x = pk2(accO[et][0], accO[et][1]); w.y = pk2(accO[et][2], accO[et][3]);
                *(GAS v2u*)(att + (size_t)(r0 + fr) * D + h * 512 + ec * 128 + 16 * et + 4 * fq) = w; }
        }
    }
    __syncthreads();
}

#define XB_TMO      128
#define XB_XCNT(j)  (256  + 64 * (j))
#define XB_XSUB(j)  (1280 + 64 * (j))
#define XB_XGEN(j)  (2304 + 64 * (j))
#define XB_TOP      3328
#define XB_TOPGEN   3392
#define XCD_BAR_WORDS 3456
#define XB_SPIN_CAP (1u << 22)
__device__ __forceinline__ unsigned xb_ld(unsigned* p)              { return __hip_atomic_load(p, __ATOMIC_RELAXED, __HIP_MEMORY_SCOPE_AGENT); }
__device__ __forceinline__ unsigned xb_add(unsigned* p, unsigned v) { return __hip_atomic_fetch_add(p, v, __ATOMIC_RELAXED, __HIP_MEMORY_SCOPE_AGENT); }
__device__ __forceinline__ unsigned xb_xcc_id() { return (unsigned)__builtin_amdgcn_s_getreg((3 << 11) | 20) & 0xFu; }
#define XB_SPIN(cond, bar) do { unsigned _sp = 0; while (cond) { __builtin_amdgcn_s_sleep(1); \
    if ((++_sp & 255u) == 0u) { if (xb_ld(&(bar)[XB_TMO])) break; if (_sp > XB_SPIN_CAP) { atomicAdd(&(bar)[XB_TMO], 1u); break; } } } } while (0)
struct XcdBarrier { unsigned* bar; unsigned x; volatile LAS unsigned* st; };
__device__ __forceinline__ XcdBarrier xcd_barrier_post(unsigned* bar, volatile LAS unsigned* st) {
    XcdBarrier b; b.bar = bar; b.x = xb_xcc_id(); b.st = st;
    if (threadIdx.x == 0) (void)xb_add(&bar[XB_XCNT(b.x)], 1u);
    return b;
}
__device__ __forceinline__ void xcd_barrier_complete(unsigned* bar, unsigned x, unsigned& nloc, unsigned& nx) {
    const unsigned G = gridDim.x * gridDim.y * gridDim.z;
    unsigned sum, cnt, mine, sp = 0u;
    for (;;) {
        sum = 0u; cnt = 0u; mine = 0u;
#pragma unroll
        for (unsigned j = 0; j < 16; ++j) { const unsigned c = xb_ld(&bar[XB_XCNT(j)]); sum += c; cnt += (c > 0u) ? 1u : 0u; mine = (j == x) ? c : mine; }
        if (sum == G) break;
        __builtin_amdgcn_s_sleep(1);
        if ((++sp & 255u) == 0u) { if (xb_ld(&bar[XB_TMO])) break; if (sp > XB_SPIN_CAP) { atomicAdd(&bar[XB_TMO], 1u); break; } }
    }
    nloc = mine > 0u ? mine : 1u; nx = cnt > 0u ? cnt : 1u;
}
__device__ __forceinline__ void xcd_barrier(const XcdBarrier& b) {
    asm volatile("s_waitcnt vmcnt(0)" ::: "memory");
    __syncthreads();
    if (threadIdx.x == 0) {
        unsigned* bar = b.bar;
        __builtin_amdgcn_s_waitcnt(0);
        unsigned nloc = b.st[0], nx = b.st[1];
        if (nloc == 0u) { xcd_barrier_complete(bar, b.x, nloc, nx); b.st[0] = nloc; b.st[1] = nx; }
        const unsigned old = xb_add(&bar[XB_XSUB(b.x)], 1u);
        const unsigned gen = old / nloc;
        if (old + 1u == (gen + 1u) * nloc) {
            __builtin_amdgcn_fence(__ATOMIC_RELEASE, "agent");
            asm volatile("s_waitcnt vmcnt(0)" ::: "memory");
            const unsigned og = xb_add(&bar[XB_TOP], 1u);
            const unsigned tg = og / nx;
            if (og + 1u == (tg + 1u) * nx) xb_add(&bar[XB_TOPGEN], 1u);
            else XB_SPIN(xb_ld(&bar[XB_TOPGEN]) == tg, bar);
            __builtin_amdgcn_fence(__ATOMIC_ACQUIRE, "agent");
            xb_add(&bar[XB_XGEN(b.x)], 1u);
            asm volatile("s_waitcnt vmcnt(0)" ::: "memory");
        } else {
            XB_SPIN(xb_ld(&bar[XB_XGEN(b.x)]) == gen, bar);
            __builtin_amdgcn_fence(__ATOMIC_ACQUIRE, "agent");
            asm volatile("s_waitcnt vmcnt(0)" ::: "memory");
        }
    }
    __syncthreads();
}

struct Args { const float* in[25]; float* out; unsigned char* ws; int ph_lo, ph_hi, use_bar, pad; };
__global__ void __launch_bounds__(NTHR, 2) mega(Args args) {
    extern __shared__ __attribute__((aligned(16))) unsigned char lds[];
    Frame F;
    F.lds = (LAS unsigned char*)lds;
    F.MISC = (volatile LAS unsigned*)(F.lds + MISC_OFF);
    F.tid = threadIdx.x; F.lane = F.tid & 63; F.wave = __builtin_amdgcn_readfirstlane(F.tid >> 6);
    F.G = gridDim.x; F.bid = blockIdx.x;
    F.ws = args.ws; F.ctl = (gu32*)(args.ws + WS_CTL);
#pragma unroll
    for (int i = 0; i < 25; ++i) F.in[i] = args.in[i];
    F.out = args.out;
    for (int u = F.tid; u < (LDS_BYTES - LDSCTL_OFF) / 4; u += NTHR) ((LAS unsigned*)(F.lds + LDSCTL_OFF))[u] = 0u;
    __syncthreads();
    LAS int* ts = (LAS int*)(F.lds + MISC_OFF + 64);
    XcdBarrier bar; bar.bar = (unsigned*)(F.ctl + CW_BAR); bar.x = 0; bar.st = nullptr;
    if (args.use_bar) bar = xcd_barrier_post((unsigned*)(F.ctl + CW_BAR), F.MISC + 8);
    const int lo = args.ph_lo, hi = args.ph_hi;
#define IN(k) (lo <= (k) && (k) < hi)
#define SEAM(k) do { if (IN(k) && IN((k) + 1)) { if (MK_CG_SYNC && (k) == 0) cooperative_groups::this_grid().sync(); else xcd_barrier(bar); } } while (0)

    if (IN(0)) { p0_prologue(F); SEAM(0); }
    if (IN(1)) {
        p1_bcum(F);
        pg8::Gemm g{WSP(pg8::bf16_t, WS_XB), WSP(pg8::bf16_t, WS_WIN), T + MEMN, HW + 4096, D}; pg8::OrderG1 S; S.init(F.G, F.bid);
        pg8::EpiH E{WSP(pg8::bf16_t, WS_H), WSP(pg8::bf16_t, WS_KVM), WSP(float, WS_RC), WSP(float, WS_RS)};
        pg8::gemm_phase<pg8::EpiH, pg8::OrderG1, true, true>(F.lds, g, S, E);
        SEAM(1);
    }
    if (IN(2)) { p2_kv(F); SEAM(2); }
    if (IN(3)) { p3_scan(F); SEAM(3); }
    if (IN(4)) { p4_out(F); SEAM(4); }
    if (IN(5)) {
        pg8::Gemm g{WSP(pg8::bf16_t, WS_MIXED), WSP(pg8::bf16_t, WS_WMIX), T, D, D}; pg8::StaticOrder S; S.init(T, D, F.G, F.bid);
        pg8::EpiResX E{F.in[0], WSP(float, WS_Y1), ALPHA};
        pg8::gemm_phase<pg8::EpiResX, pg8::StaticOrder, true, true>(F.lds, g, S, E);
        SEAM(5);
    }
    if (IN(6)) { ln_apply<false>(F, WSP(float, WS_Y1), F.in[8], F.in[9], WSP(bf16, WS_H1B), WSP(float, WS_ST1)); SEAM(6); }
    if (IN(7)) {
        pg8::Gemm g{WSP(pg8::bf16_t, WS_H1B), WSP(pg8::bf16_t, WS_WMQ), T, D, D}; pg8::StaticOrder S; S.init(T, D, F.G, F.bid);
        pg8::EpiB E{WSP(pg8::bf16_t, WS_QB), D, -1};
        pg8::gemm_phase<pg8::EpiB, pg8::StaticOrder, true, true>(F.lds, g, S, E);
        SEAM(7);
    }
    if (IN(8)) { p8_attn(F); SEAM(8); }
    if (IN(9)) {
        pg8::Gemm g{WSP(pg8::bf16_t, WS_ATT), WSP(pg8::bf16_t, WS_WMO), T, D, D}; pg8::StaticOrder S; S.init(T, D, F.G, F.bid);
        pg8::EpiResLN E{WSP(float, WS_Y1), WSP(float, WS_ST1), F.in[8], F.in[9], WSP(float, WS_Y2), ALPHA};
        pg8::gemm_phase<pg8::EpiResLN, pg8::StaticOrder, true, true>(F.lds, g, S, E);
        SEAM(9);
    }
    if (IN(10)) { ln_apply<true>(F, WSP(float, WS_Y2), F.in[14], F.in[15], WSP(bf16, WS_H2B), WSP(float, WS_ST2)); SEAM(10); }
    if (IN(11)) { moe_tile_starts(F, ts); p10_dispatch(F, ts); SEAM(11); }
    if (IN(12)) {
        moe_tile_starts(F, ts);
        pg8::Gemm g{WSP(pg8::bf16_t, WS_XS), WSP(pg8::bf16_t, WS_WGU), PMAX, 32 * 1024, D};
        pg8::MoeOrder S{(const PG8_LAS int*)ts, F.G, F.bid, 4, ts[32] * 4};
        pg8::EpiSwi E{WSP(pg8::bf16_t, WS_HID)};
        pg8::gemm_phase<pg8::EpiSwi, pg8::MoeOrder, true, true>(F.lds, g, S, E);
        SEAM(12);
    }
    if (IN(13)) {
        moe_tile_starts(F, ts);
        pg8::Gemm g{WSP(pg8::bf16_t, WS_HID), WSP(pg8::bf16_t, WS_WD), PMAX, 32 * 2048, 512};
        pg8::MoeOrder S{(const PG8_LAS int*)ts, F.G, F.bid, 8, ts[32] * 8};
        pg8::EpiB E{WSP(pg8::bf16_t, WS_YS), D, 7};
        pg8::gemm_phase<pg8::EpiB, pg8::MoeOrder, true, true>(F.lds, g, S, E);
        SEAM(13);
    }
    if (IN(14)) { p13_combine(F); }
#undef IN
#undef SEAM
}

extern "C" void kernel_launch(void* const* d_in, const int* in_sizes, int n_in, void* d_out, int out_size, void* d_ws, size_t ws_size, hipStream_t stream) {
    static int grid = 0;
    if (grid == 0) {
        if (n_in != 25 || in_sizes[0] != T * D || out_size != T * D || ws_size < WS_END) { fprintf(stderr, "kernel_launch: unexpected shapes / workspace (%d inputs, ws %zu)\n", n_in, ws_size); grid = -1; return; }
        int dev = 0, cus = 0;
        if (hipGetDevice(&dev) != hipSuccess || hipDeviceGetAttribute(&cus, hipDeviceAttributeMultiprocessorCount, dev) != hipSuccess) { grid = -1; return; }
        if (hipFuncSetAttribute((const void*)mega, hipFuncAttributeMaxDynamicSharedMemorySize, LDS_BYTES) != hipSuccess) { fprintf(stderr, "kernel_launch: hipFuncSetAttribute failed\n"); grid = -1; return; }
        int per_cu = 0;
        if (hipOccupancyMaxActiveBlocksPerMultiprocessor(&per_cu, (const void*)mega, NTHR, LDS_BYTES) != hipSuccess || per_cu < 1) { fprintf(stderr, "kernel_launch: occupancy query failed / 0 blocks per CU\n"); grid = -1; return; }
        (void)hipGetLastError();
        grid = cus;
    }
    if (grid < 0) return;
    if (hipMemsetAsync((char*)d_ws + WS_CTL, 0, CTL_ZERO_BYTES, stream) != hipSuccess) return;
    Args a{};
    for (int i = 0; i < 25; ++i) a.in[i] = (const float*)d_in[i];
    a.out = (float*)d_out; a.ws = (unsigned char*)d_ws;
#if MK_ONE_LAUNCH
    a.ph_lo = 0; a.ph_hi = NPH; a.use_bar = 1;
#if MK_CG_SYNC
    { void* kargs[] = {(void*)&a};
      hipError_t e = hipLaunchCooperativeKernel((const void*)mega, dim3(grid), dim3(NTHR), kargs, LDS_BYTES, stream);
      if (e != hipSuccess) fprintf(stderr, "cooperative launch failed: %s (grid %d)\n", hipGetErrorString(e), grid); }
#else
    hipLaunchKernelGGL(mega, dim3(grid), dim3(NTHR), LDS_BYTES, stream, a);
#endif
#else
    for (int p = 0; p < NPH; ++p) { a.ph_lo = p; a.ph_hi = p + 1; a.use_bar = 0;
        hipLaunchKernelGGL(mega, dim3(grid), dim3(NTHR), LDS_BYTES, stream, a); }
#endif
}
```

```cpp
#include <hip/hip_runtime.h>
#include <hip/hip_cooperative_groups.h>
#include <cstdio>
#include <cstdint>
#include <cmath>
#ifndef MK_ONE_LAUNCH
#define MK_ONE_LAUNCH 1
#endif
#ifndef MK_CG_SYNC
#define MK_CG_SYNC 1
#endif
#define PROBE_PH -1
#define PROBE_N 1
namespace pg8 {
#define PG8_LAS __attribute__((address_space(3)))
typedef unsigned short bf16_t;
typedef short bf16x8 __attribute__((ext_vector_type(8)));
typedef float f32x4 __attribute__((ext_vector_type(4)));
typedef unsigned u32x4 __attribute__((ext_vector_type(4)));
constexpr int BM = 256, BK = 64, HALF = 128, HTB = HALF * BK * 2  , STAGE_BYTES = 8 * HTB, NXCD = 8, WGM = 8;

__host__ __device__ __forceinline__ int lds_byte(int r, int c) { const int st = (r >> 4) * 2 + (c >> 5), rr = r & 15, cc = c & 31, ob = rr * 64 + cc * 2; return st * 1024 + (ob ^ (((ob >> 9) & 1) << 5)); }
__host__ __device__ __forceinline__ void stage_rc(int b, int& R, int& C) { const int st = b / 1024, sb = b % 1024, swz = sb ^ (((sb >> 9) & 1) << 5); R = (st >> 1) * 16 + swz / 64; C = (st & 1) * 32 + (swz % 64) / 2; }
__host__ __device__ __forceinline__ int perm32(int rho) { const int n = rho >> 4, i = rho & 15; return 8 * (i >> 2) + 4 * n + (i & 3); }

struct Unit { int pm, pn; };
struct Gemm { const bf16_t* A; const bf16_t* Bt; int M, N, K; };

struct StaticOrder {
    int nM, nN, nwg, G, c;
    __host__ __device__ void init(int M, int N, int G_, int c_) { nM = M / BM; nN = N / BM; nwg = nM * nN; G = G_; c = c_; }
    __host__ __device__ bool next(int i, Unit& u) const {
        const long L = (long)i * G + c; if (L >= nwg) return false;
        int wgid = (int)L; { const int q = nwg / NXCD, r = nwg % NXCD, xcd = wgid % NXCD, off = wgid / NXCD; wgid = (xcd < r ? xcd * (q + 1) : r * (q + 1) + (xcd - r) * q) + off; }
        const int nig = WGM * nN, gid = wgid / nig, fm = gid * WGM, gsz = (nM - fm) < WGM ? (nM - fm) : WGM;
        u.pm = fm + ((wgid % nig) % gsz); u.pn = (wgid % nig) / gsz; return true;
    }
    __device__ __forceinline__ void a_ready(const Unit&) const {}
    __device__ __forceinline__ void done(const Unit&) const {}
};


__device__ __forceinline__ unsigned cvt_pk_bf16(float lo, float hi) { unsigned r; asm volatile("v_cvt_pk_bf16_f32 %0, %1, %2" : "=v"(r) : "v"(lo), "v"(hi)); return r; }
__device__ __forceinline__ u32x4 pack8(const f32x4 a, const f32x4 b) { u32x4 w; w.x = cvt_pk_bf16(a[0], a[1]); w.y = cvt_pk_bf16(a[2], a[3]); w.z = cvt_pk_bf16(b[0], b[1]); w.w = cvt_pk_bf16(b[2], b[3]); return w; }
__device__ __forceinline__ float silu_f(float x) { return x * __builtin_amdgcn_rcpf(1.0f + __builtin_amdgcn_exp2f(-1.4426950408889634f * x)); }

struct EpiH {
    static constexpr bool PERM = true, AFTER_DRAIN = false;
    bf16_t* H; bf16_t* KVM; const float* rc; const float* rs;
    __device__ __forceinline__ void operator()(const f32x4 (&acc)[2][2][4][2], const Unit& u, int wr, int wc, int fr, int fq) const {
        const int cb = wc * 32 + 8 * fq;
        if (u.pm >= 32) {
#pragma unroll
            for (int ai = 0; ai < 2; ++ai)
#pragma unroll
                for (int m = 0; m < 4; ++m) { bf16_t* rowp = KVM + (size_t)(wr * 64 + fr + ai * HALF + m * 16) * 4096 + (u.pn - 28) * BM + cb;
#pragma unroll
                    for (int bj = 0; bj < 2; ++bj) *(u32x4*)(rowp + bj * HALF) = pack8(acc[ai][bj][m][0], acc[ai][bj][m][1]); }
            return;
        }
        const int row0 = u.pm * BM + wr * 64 + fr;
        if (u.pn < 8) {
            const float sc = u.pn >= 4 ? 0.0625f : 1.0f;
#pragma unroll
            for (int ai = 0; ai < 2; ++ai)
#pragma unroll
                for (int m = 0; m < 4; ++m) { const int row = row0 + ai * HALF + m * 16;
                    const float* cr = rc + (size_t)row * 128 + cb; const float* sr = rs + (size_t)row * 128 + cb;
                    const f32x4 c0 = *(const f32x4*)cr * sc, c1 = *(const f32x4*)(cr + 4) * sc, s0 = *(const f32x4*)sr * sc, s1 = *(const f32x4*)(sr + 4) * sc;
                    const f32x4 t1a = acc[ai][0][m][0], t1b = acc[ai][0][m][1], t2a = acc[ai][1][m][0], t2b = acc[ai][1][m][1];
                    bf16_t* rowp = H + (size_t)row * 7168 + u.pn * BM + cb;
                    *(u32x4*)(rowp) = pack8(t1a * c0 - t2a * s0, t1b * c1 - t2b * s1);
                    *(u32x4*)(rowp + HALF) = pack8(t1a * s0 + t2a * c0, t1b * s1 + t2b * c1); }
        } else {
            const float sc = (u.pn == 16 || u.pn == 17) ? 0.08838834764831845f : 1.0f;
#pragma unroll
            for (int ai = 0; ai < 2; ++ai)
#pragma unroll
                for (int m = 0; m < 4; ++m) { bf16_t* rowp = H + (size_t)(row0 + ai * HALF + m * 16) * 7168 + u.pn * BM + cb;
#pragma unroll
                    for (int bj = 0; bj < 2; ++bj) *(u32x4*)(rowp + bj * HALF) = pack8(acc[ai][bj][m][0] * sc, acc[ai][bj][m][1] * sc); }
        }
    }
};
struct EpiB {
    static constexpr bool PERM = true, AFTER_DRAIN = false;
    bf16_t* O; int ldc; int pmask;
    __device__ __forceinline__ void operator()(const f32x4 (&acc)[2][2][4][2], const Unit& u, int wr, int wc, int fr, int fq) const {
        const int row0 = u.pm * BM + wr * 64 + fr, col0 = (u.pn & pmask) * BM + wc * 32 + 8 * fq;
#pragma unroll
        for (int ai = 0; ai < 2; ++ai)
#pragma unroll
            for (int m = 0; m < 4; ++m) { bf16_t* rowp = O + (size_t)(row0 + ai * HALF + m * 16) * ldc + col0;
#pragma unroll
                for (int bj = 0; bj < 2; ++bj) *(u32x4*)(rowp + bj * HALF) = pack8(acc[ai][bj][m][0], acc[ai][bj][m][1]); }
    }
};
struct EpiSwi {
    static constexpr bool PERM = true, AFTER_DRAIN = false;
    bf16_t* O;
    __device__ __forceinline__ void operator()(const f32x4 (&acc)[2][2][4][2], const Unit& u, int wr, int wc, int fr, int fq) const {
        const int row0 = u.pm * BM + wr * 64 + fr, col0 = (u.pn & 3) * HALF + wc * 32 + 8 * fq;
#pragma unroll
        for (int ai = 0; ai < 2; ++ai)
#pragma unroll
            for (int m = 0; m < 4; ++m) { bf16_t* rowp = O + (size_t)(row0 + ai * HALF + m * 16) * 512 + col0;
                f32x4 h0, h1;
#pragma unroll
                for (int i = 0; i < 4; ++i) { h0[i] = silu_f(acc[ai][0][m][0][i]) * acc[ai][1][m][0][i]; h1[i] = silu_f(acc[ai][0][m][1][i]) * acc[ai][1][m][1][i]; }
                *(u32x4*)rowp = pack8(h0, h1); }
    }
};
struct EpiResX {
    static constexpr bool PERM = false, AFTER_DRAIN = false;
    const float* X; float* Y; float alpha;
    __device__ __forceinline__ void operator()(const f32x4 (&acc)[2][2][4][2], const Unit& u, int wr, int wc, int fr, int fq) const {
        const int row0 = u.pm * BM + wr * 64 + fr, col0 = u.pn * BM + wc * 32 + 4 * fq;
#pragma unroll
        for (int ai = 0; ai < 2; ++ai)
#pragma unroll
            for (int m = 0; m < 4; ++m) { const size_t off = (size_t)(row0 + ai * HALF + m * 16) * 2048 + col0;
#pragma unroll
                for (int bj = 0; bj < 2; ++bj)
#pragma unroll
                    for (int n = 0; n < 2; ++n) { const f32x4 xv = *(const f32x4*)(X + off + bj * HALF + n * 16); *(f32x4*)(Y + off + bj * HALF + n * 16) = xv * alpha + acc[ai][bj][m][n]; } }
    }
};
struct EpiResLN {
    static constexpr bool PERM = false, AFTER_DRAIN = false;
    const float* Yin; const float* st; const float* g; const float* b; float* Y; float alpha;
    __device__ __forceinline__ void operator()(const f32x4 (&acc)[2][2][4][2], const Unit& u, int wr, int wc, int fr, int fq) const {
        const int row0 = u.pm * BM + wr * 64 + fr, col0 = u.pn * BM + wc * 32 + 4 * fq;
        f32x4 gv[2][2], bv[2][2];
#pragma unroll
        for (int bj = 0; bj < 2; ++bj)
#pragma unroll
            for (int n = 0; n < 2; ++n) { gv[bj][n] = *(const f32x4*)(g + col0 + bj * HALF + n * 16) * alpha; bv[bj][n] = *(const f32x4*)(b + col0 + bj * HALF + n * 16) * alpha; }
#pragma unroll
        for (int ai = 0; ai < 2; ++ai)
#pragma unroll
            for (int m = 0; m < 4; ++m) { const int row = row0 + ai * HALF + m * 16; const size_t off = (size_t)row * 2048 + col0;
                const float mu = st[2 * row], rstd = st[2 * row + 1];
#pragma unroll
                for (int bj = 0; bj < 2; ++bj)
#pragma unroll
                    for (int n = 0; n < 2; ++n) { const f32x4 yv = *(const f32x4*)(Yin + off + bj * HALF + n * 16);
                        *(f32x4*)(Y + off + bj * HALF + n * 16) = ((yv - mu) * rstd) * gv[bj][n] + bv[bj][n] + acc[ai][bj][m][n]; } }
    }
};

struct OrderG1 {
    StaticOrder so; int G, c;
    __device__ void init(int G_, int c_) { so.init(8192, 7168, G_, c_); G = G_; c = c_; }
    __device__ bool next(int i, Unit& u) const {
        const int L = i * G + c;
        if (L < 896) return so.next(i, u);
        if (L >= 912) return false;
        u.pm = 32; u.pn = 28 + (L - 896); return true;
    }
    __device__ __forceinline__ void a_ready(const Unit&) const {}
    __device__ __forceinline__ void done(const Unit&) const {}
};
struct MoeOrder {
    const PG8_LAS int* ts; int G, c, npn, total;
    __device__ bool next(int i, Unit& u) const {
        const int L = i * G + c; if (L >= total) return false;
        const int rt = L / npn, pl = L - rt * npn; int e = 0;
        for (int j = 1; j < 32; ++j) e += (ts[j] <= rt) ? 1 : 0;
        u.pm = rt; u.pn = e * npn + pl; return true;
    }
    __device__ __forceinline__ void a_ready(const Unit&) const {}
    __device__ __forceinline__ void done(const Unit&) const {}
};

template <class Epi, class Sched, bool ALIGN_EPI = false, bool SP2 = false>
__device__ __forceinline__ void gemm_phase(PG8_LAS unsigned char* lds, const Gemm g, const Sched& S, const Epi& E) {
    const int tid = threadIdx.x, wid = __builtin_amdgcn_readfirstlane(tid >> 6), lane = tid & 63, wr = wid >> 2, wc = wid & 3, fr = lane & 15, fq = lane >> 4;
    const int K = g.K, nt = K / BK;
    unsigned voffA[2], voffB[2];
#pragma unroll
    for (int i = 0; i < 2; ++i) { int R, C; stage_rc(tid * 16 + i * 8192, R, C); const int Rb = Epi::PERM ? ((R & ~31) + perm32(R & 31)) : R;
        voffA[i] = (unsigned)(R * K + C) * 2u; voffB[i] = (unsigned)(Rb * K + C) * 2u; }
    const size_t kstep = (size_t)(BK * 2);
    const size_t hstep = (size_t)HALF * K * 2;
    const size_t tstep = 2 * hstep;
    const unsigned ldsw = (unsigned)wid * 1024u;
    const int aoff = lds_byte(wr * 64 + fr, fq * 8), boff = lds_byte(wc * 32 + fr, fq * 8);
#define PG8_SA(b, h) (((b) * 2 + (h)) * HTB)
#define PG8_SB(b, h) ((4 + (b) * 2 + (h)) * HTB)
#define PG8_STAGE(bufoff, gbase, voff) do { _Pragma("unroll") for (int _i = 0; _i < 2; ++_i) \
        __builtin_amdgcn_global_load_lds((const unsigned*)((const char*)(gbase) + (voff)[_i]), (PG8_LAS unsigned*)(lds + (bufoff) + ldsw + _i * 8192), 16, 0, 0); } while (0)
#define PG8_LDA(dst, b, h) do { _Pragma("unroll") for (int m = 0; m < 4; ++m) _Pragma("unroll") for (int k = 0; k < 2; ++k) dst[m][k] = *(const PG8_LAS bf16x8*)(lds + PG8_SA(b, h) + aoff + m * 2048 + k * 1024); } while (0)
#define PG8_LDB(dst, b, h) do { _Pragma("unroll") for (int n = 0; n < 2; ++n) _Pragma("unroll") for (int k = 0; k < 2; ++k) dst[n][k] = *(const PG8_LAS bf16x8*)(lds + PG8_SB(b, h) + boff + n * 2048 + k * 1024); } while (0)
#define PG8_MMA(ai, bj, At, Bt) do { __builtin_amdgcn_s_setprio(1); _Pragma("unroll") for (int m = 0; m < 4; ++m) _Pragma("unroll") for (int n = 0; n < 2; ++n) _Pragma("unroll") for (int k = 0; k < 2; ++k) \
        acc[ai][bj][m][n] = __builtin_amdgcn_mfma_f32_16x16x32_bf16(Bt[n][k], At[m][k], acc[ai][bj][m][n], 0, 0, 0); __builtin_amdgcn_s_setprio(0); } while (0)
#define PG8_WAIT_V(n) asm volatile("s_waitcnt vmcnt(" #n ")" ::: "memory")
#define PG8_WAIT_L(n) asm volatile("s_waitcnt lgkmcnt(" #n ")" ::: "memory")
#define PG8_BAR __builtin_amdgcn_s_barrier()
#define PG8_SCHED __builtin_amdgcn_sched_barrier(0)
    Unit cur, nxt; int ui = 0;
    if (!S.next(0, cur)) return;
    f32x4 acc[2][2][4][2];
#pragma unroll
    for (int a = 0; a < 2; ++a)
#pragma unroll
        for (int b = 0; b < 2; ++b)
#pragma unroll
            for (int m = 0; m < 4; ++m)
#pragma unroll
                for (int n = 0; n < 2; ++n) acc[a][b][m][n] = (f32x4){0.f, 0.f, 0.f, 0.f};
    bf16x8 At[4][2], B0[2][2], B1[2][2];
    const char* cA = (const char*)g.A + (size_t)cur.pm * tstep; const char* cB = (const char*)g.Bt + (size_t)cur.pn * tstep;
    S.a_ready(cur);
    if constexpr (SP2) {
        PG8_STAGE(PG8_SB(0, 0), cB, voffB); PG8_STAGE(PG8_SB(0, 1), cB + hstep, voffB); PG8_STAGE(PG8_SA(0, 0), cA, voffA); PG8_STAGE(PG8_SA(0, 1), cA + hstep, voffA);
        if (wr == 1) PG8_BAR;
        PG8_WAIT_V(2); PG8_BAR;
        PG8_STAGE(PG8_SB(1, 0), cB + kstep, voffB); PG8_STAGE(PG8_SA(1, 0), cA + kstep, voffA); PG8_STAGE(PG8_SB(1, 1), cB + hstep + kstep, voffB);
        PG8_WAIT_V(6); PG8_BAR;
    } else {
        PG8_STAGE(PG8_SB(0, 0), cB, voffB); PG8_STAGE(PG8_SA(0, 0), cA, voffA); PG8_STAGE(PG8_SB(0, 1), cB + hstep, voffB); PG8_STAGE(PG8_SA(0, 1), cA + hstep, voffA);
        if (wr == 1) PG8_BAR;
        PG8_WAIT_V(4); PG8_BAR;
        PG8_STAGE(PG8_SB(1, 0), cB + kstep, voffB); PG8_STAGE(PG8_SA(1, 0), cA + kstep, voffA); PG8_STAGE(PG8_SB(1, 1), cB + hstep + kstep, voffB);
        PG8_WAIT_V(6); PG8_BAR;
    }
    for (;;) {
        const bool has_next = S.next(ui + 1, nxt);
        const char* nA = has_next ? (const char*)g.A + (size_t)nxt.pm * tstep : cA; const char* nB = has_next ? (const char*)g.Bt + (size_t)nxt.pn * tstep : cB;
        for (int t = 0; t < nt; t += 2) {
            const bool last = (t == nt - 2);
            const char* a1 = cA + (size_t)(t + 1) * kstep;
            const char* a2 = last ? nA : cA + (size_t)(t + 2) * kstep; const char* b2 = last ? nB : cB + (size_t)(t + 2) * kstep;
            const char* a3 = a2 + kstep; const char* b3 = b2 + kstep;
            if (last && has_next) S.a_ready(nxt);
            if constexpr (SP2) {
            PG8_LDB(B0, 0, 0); PG8_LDB(B1, 0, 1); PG8_SCHED; PG8_LDA(At, 0, 0); PG8_STAGE(PG8_SA(1, 1), a1 + hstep, voffA);
            PG8_WAIT_V(8); PG8_WAIT_L(0); PG8_BAR; PG8_MMA(0, 0, At, B0); PG8_MMA(0, 1, At, B1); PG8_BAR; PG8_SCHED;
            PG8_LDA(At, 0, 1); PG8_STAGE(PG8_SB(0, 0), b2, voffB); PG8_STAGE(PG8_SB(0, 1), b2 + hstep, voffB); PG8_STAGE(PG8_SA(0, 0), a2, voffA);
            PG8_WAIT_V(8); PG8_WAIT_L(0); PG8_BAR; PG8_MMA(1, 0, At, B0); PG8_MMA(1, 1, At, B1); PG8_BAR; PG8_SCHED;
            PG8_LDB(B0, 1, 0); PG8_LDB(B1, 1, 1); PG8_SCHED; PG8_LDA(At, 1, 0); PG8_STAGE(PG8_SA(0, 1), a2 + hstep, voffA);
            PG8_WAIT_V(8); PG8_WAIT_L(0); PG8_BAR; PG8_MMA(0, 0, At, B0); PG8_MMA(0, 1, At, B1); PG8_BAR; PG8_SCHED;
            PG8_LDA(At, 1, 1); PG8_STAGE(PG8_SB(1, 0), b3, voffB); PG8_STAGE(PG8_SB(1, 1), b3 + hstep, voffB); PG8_STAGE(PG8_SA(1, 0), a3, voffA);
            PG8_WAIT_V(8); PG8_WAIT_L(0); PG8_BAR; PG8_MMA(1, 0, At, B0); PG8_MMA(1, 1, At, B1); PG8_BAR; PG8_SCHED;
            } else {
            PG8_LDB(B0, 0, 0); PG8_SCHED; PG8_LDA(At, 0, 0); PG8_STAGE(PG8_SA(1, 1), a1 + hstep, voffA);
            PG8_WAIT_L(8); PG8_BAR; PG8_WAIT_L(0); PG8_MMA(0, 0, At, B0); PG8_BAR; PG8_SCHED;
            PG8_LDB(B1, 0, 1); PG8_STAGE(PG8_SB(0, 0), b2, voffB);
            PG8_BAR; PG8_WAIT_L(0); PG8_MMA(0, 1, At, B1); PG8_BAR;
            PG8_LDA(At, 0, 1); PG8_STAGE(PG8_SA(0, 0), a2, voffA);
            PG8_BAR; PG8_WAIT_L(0); PG8_MMA(1, 0, At, B0); PG8_BAR; PG8_SCHED;
            PG8_STAGE(PG8_SB(0, 1), b2 + hstep, voffB);
            PG8_WAIT_V(6); PG8_BAR; PG8_MMA(1, 1, At, B1); PG8_BAR;
            PG8_LDB(B0, 1, 0); PG8_SCHED; PG8_LDA(At, 1, 0); PG8_STAGE(PG8_SA(0, 1), a2 + hstep, voffA);
            PG8_WAIT_L(8); PG8_BAR; PG8_WAIT_L(0); PG8_MMA(0, 0, At, B0); PG8_BAR; PG8_SCHED;
            PG8_LDB(B1, 1, 1); PG8_STAGE(PG8_SB(1, 0), b3, voffB);
            PG8_BAR; PG8_WAIT_L(0); PG8_MMA(0, 1, At, B1); PG8_BAR;
            PG8_LDA(At, 1, 1); PG8_STAGE(PG8_SA(1, 0), a3, voffA);
            PG8_BAR; PG8_WAIT_L(0); PG8_MMA(1, 0, At, B0); PG8_BAR; PG8_SCHED;
            PG8_STAGE(PG8_SB(1, 1), b3 + hstep, voffB);
            PG8_WAIT_V(6); PG8_BAR; PG8_MMA(1, 1, At, B1); PG8_BAR;
            }
        }
        if constexpr (ALIGN_EPI) { if (wr == 0) PG8_BAR; }
        if constexpr (!Epi::AFTER_DRAIN) { E(acc, cur, wr, wc, fr, fq); S.done(cur); }
        if (!has_next) break;
#pragma unroll
        for (int a = 0; a < 2; ++a)
#pragma unroll
            for (int b = 0; b < 2; ++b)
#pragma unroll
                for (int m = 0; m < 4; ++m)
#pragma unroll
                    for (int n = 0; n < 2; ++n) acc[a][b][m][n] = (f32x4){0.f, 0.f, 0.f, 0.f};
        cur = nxt; cA = nA; cB = nB; ++ui;
        if constexpr (ALIGN_EPI) { if (wr == 1) PG8_BAR; }
    }
    PG8_WAIT_V(0);
    if constexpr (!ALIGN_EPI) { if (wr == 0) PG8_BAR; }
    PG8_BAR;
    if constexpr (Epi::AFTER_DRAIN) { E.fused(acc, cur, wr, wc, fr, fq, lds, wid, lane); S.done(cur); }
#undef PG8_SA
#undef PG8_SB
#undef PG8_STAGE
#undef PG8_LDA
#undef PG8_LDB
#undef PG8_MMA
#undef PG8_WAIT_V
#undef PG8_WAIT_L
#undef PG8_BAR
#undef PG8_SCHED
}
}

constexpr int NWAVES = 8, NTHR = 512;
constexpr int T = 8192, D = 2048, HW = 7168, INW = 7184, MEMN = 256;
constexpr float LN_EPS = 1e-5f;
constexpr float ALPHA = 1.189207115002721f;
constexpr int NPH = 15;
constexpr int PMAX = 24576;

constexpr size_t MiB = 1u << 20;
constexpr size_t WS_CTL = 0, CTL_ZERO_BYTES = 1 * MiB;
constexpr size_t WS_WMIX = 2 * MiB, WS_WMQ = 10 * MiB, WS_WIN = 18 * MiB, WS_WKV = 46 * MiB, WS_WMO = 62 * MiB, WS_WGU = 70 * MiB, WS_WD = 198 * MiB;
constexpr size_t WS_XB = 262 * MiB, WS_MEMB = 294 * MiB;
constexpr size_t WS_H = 296 * MiB;
constexpr size_t WS_KVM = 408 * MiB;
constexpr size_t WS_ORAW = 410 * MiB;
constexpr size_t WS_MIXED = WS_XB;
constexpr size_t WS_Y1 = WS_ORAW;
constexpr size_t WS_H1B = WS_H;
constexpr size_t WS_QB = 328 * MiB, WS_ATT = 360 * MiB;
constexpr size_t WS_Y2 = 474 * MiB;
constexpr size_t WS_H2B = WS_H;
constexpr size_t WS_XS = 328 * MiB;
constexpr size_t WS_HID = 424 * MiB;
constexpr size_t WS_YS = WS_XS;
constexpr size_t WS_SMALL = 540 * MiB;
constexpr size_t WS_GLR = WS_SMALL;
constexpr size_t WS_RC = WS_SMALL + 1 * MiB, WS_RS = WS_SMALL + 5 * MiB;
constexpr size_t WS_ST1 = WS_SMALL + 9 * MiB, WS_ST2 = WS_ST1 + 65536;
constexpr size_t WS_EXP = WS_ST2 + 65536, WS_GATE = WS_EXP + 65536, WS_POS = WS_GATE + 65536;
constexpr size_t WS_END = 552 * MiB;
constexpr int CW_CNT = 64, CW_CUR = 128;
constexpr int CW_BAR = 4096;

constexpr int RING_BYTES = 131072, LDSCTL_OFF = RING_BYTES, MISC_OFF = LDSCTL_OFF + 320, LDS_BYTES = 147456;

#define GAS __attribute__((address_space(1)))
#define LAS __attribute__((address_space(3)))
typedef unsigned short bf16;
typedef unsigned v4u __attribute__((ext_vector_type(4)));
typedef unsigned v2u __attribute__((ext_vector_type(2)));
typedef float f32x4 __attribute__((ext_vector_type(4)));
typedef GAS unsigned gu32;
#define RLX_AGENT __ATOMIC_RELAXED, __HIP_MEMORY_SCOPE_AGENT
#define LDS_WAIT() asm volatile("s_waitcnt lgkmcnt(0)" ::: "memory")
__device__ __forceinline__ unsigned f2bf(float f) { unsigned u = __builtin_bit_cast(unsigned, f); return (u + 0x7fffu + ((u >> 16) & 1u)) >> 16; }
__device__ __forceinline__ unsigned pk2(float lo, float hi) { return f2bf(lo) | (f2bf(hi) << 16); }
__device__ __forceinline__ float bf2f(unsigned h) { return __builtin_bit_cast(float, h << 16); }
__device__ __forceinline__ float bflo(unsigned w) { return __builtin_bit_cast(float, w << 16); }
__device__ __forceinline__ float bfhi(unsigned w) { return __builtin_bit_cast(float, w & 0xffff0000u); }
__device__ __forceinline__ float wave_sum(float v) {
#pragma unroll
    for (int o = 1; o < 64; o <<= 1) v += __shfl_xor(v, o);
    return v;
}
__device__ __forceinline__ float wave_max(float v) {
#pragma unroll
    for (int o = 1; o < 64; o <<= 1) v = fmaxf(v, __shfl_xor(v, o));
    return v;
}

struct Frame {
    LAS unsigned char* lds;
    volatile LAS unsigned* MISC;
    gu32* ctl;
    int tid, lane, wave, G, bid;
    unsigned char* ws;
    const float* in[25];
    float* out;
};
#define WSP(T_, off) ((T_*)(F.ws + (off)))

__device__ __forceinline__ void transpose_item(const float* W, int ldw, bf16* WTr, int ldt, LAS float* scr, int lane) {
#pragma unroll 8
    for (int i = 0; i < 32; ++i) { const int kk = 2 * i + (lane >> 5); scr[kk * 33 + (lane & 31)] = W[(size_t)kk * ldw + (lane & 31)]; }
    LDS_WAIT(); asm volatile("" ::: "memory");
    const int c = lane & 7;
#pragma unroll
    for (int j = 0; j < 4; ++j) { const int n = (lane >> 3) + 8 * j; const LAS float* s = scr + (8 * c) * 33 + n;
        v4u o; o.x = pk2(s[0 * 33], s[1 * 33]); o.y = pk2(s[2 * 33], s[3 * 33]); o.z = pk2(s[4 * 33], s[5 * 33]); o.w = pk2(s[6 * 33], s[7 * 33]);
        *(GAS v4u*)(WTr + (size_t)n * ldt + 8 * c) = o; }
    LDS_WAIT(); asm volatile("" ::: "memory");
}
__device__ __forceinline__ void p0_prologue(Frame& F) {
    LAS float* scr = (LAS float*)(F.lds + F.wave * 16384);
    const int gw = F.bid * NWAVES + F.wave, NGW = F.G * NWAVES;
    const float* w_in = F.in[3];
    constexpr int I_IN = 32 * 224, I_SQ = 32 * 64, I_E = 512;
    constexpr int NIT = I_IN + 5 * I_SQ + 3 * 32 * I_E;
    for (int it = gw; it < NIT; it += NGW) {
        int r = it;
        if (r < I_IN) { const int kb = r / 224, nb = r % 224; transpose_item(w_in + (size_t)(64 * kb) * INW + 32 * nb, INW, WSP(bf16, WS_WIN) + (size_t)(32 * nb) * 2048 + 64 * kb, 2048, scr, F.lane); continue; }
        r -= I_IN;
        if (r < 5 * I_SQ) { const int w = r / I_SQ, q = r % I_SQ, kb = q / 64, nb = q % 64;
            const float* src = w == 0 ? F.in[7] : w == 1 ? F.in[10] : w == 2 ? F.in[11] : w == 3 ? F.in[12] : F.in[13];
            bf16* dst = w == 0 ? WSP(bf16, WS_WMIX) : w == 1 ? WSP(bf16, WS_WMQ) : w == 2 ? WSP(bf16, WS_WKV) : w == 3 ? (WSP(bf16, WS_WKV) + (size_t)2048 * 2048) : WSP(bf16, WS_WMO);
            transpose_item(src + (size_t)(64 * kb) * 2048 + 32 * nb, 2048, dst + (size_t)(32 * nb) * 2048 + 64 * kb, 2048, scr, F.lane); continue; }
        r -= 5 * I_SQ;
        if (r < 2 * 32 * I_E) {
            const int up = r / (32 * I_E), q = r % (32 * I_E), e = q / I_E, q2 = q % I_E, kb = q2 / 16, nb = q2 % 16, n0 = 32 * nb;
            const float* src = (up ? F.in[21] : F.in[20]) + (size_t)e * 2048 * 512 + (size_t)(64 * kb) * 512 + n0;
            bf16* dst = WSP(bf16, WS_WGU) + (size_t)(e * 1024 + (n0 >> 7) * 256 + up * 128 + (n0 & 127)) * 2048 + 64 * kb;
            transpose_item(src, 512, dst, 2048, scr, F.lane); continue; }
        r -= 2 * 32 * I_E;
        {
            const int e = r / I_E, q2 = r % I_E, kb = q2 / 64, nb = q2 % 64;
            const float* src = F.in[22] + (size_t)e * 512 * 2048 + (size_t)(64 * kb) * 2048 + 32 * nb;
            bf16* dst = WSP(bf16, WS_WD) + (size_t)(e * 2048 + 32 * nb) * 512 + 64 * kb;
            transpose_item(src, 2048, dst, 512, scr, F.lane); }
    }
    const int gt = F.bid * NTHR + F.tid, NGT = F.G * NTHR;
    {
        const float* x = F.in[0]; bf16* xb = WSP(bf16, WS_XB);
        for (int i = gt; i < T * D / 8; i += NGT) { const f32x4 a = *(const GAS f32x4*)(x + (size_t)i * 8), b = *(const GAS f32x4*)(x + (size_t)i * 8 + 4);
            v4u o; o.x = pk2(a[0], a[1]); o.y = pk2(a[2], a[3]); o.z = pk2(b[0], b[1]); o.w = pk2(b[2], b[3]); *(GAS v4u*)(xb + (size_t)i * 8) = o; }
        const float* mm = F.in[1]; bf16* mb = WSP(bf16, WS_MEMB);
        for (int i = gt; i < MEMN * D / 8; i += NGT) { const f32x4 a = *(const GAS f32x4*)(mm + (size_t)i * 8), b = *(const GAS f32x4*)(mm + (size_t)i * 8 + 4);
            v4u o; o.x = pk2(a[0], a[1]); o.y = pk2(a[2], a[3]); o.z = pk2(b[0], b[1]); o.w = pk2(b[2], b[3]); *(GAS v4u*)(mb + (size_t)i * 8) = o; }
    }
    {
        const int* pos = (const int*)F.in[2]; float* rc = WSP(float, WS_RC); float* rs = WSP(float, WS_RS);
        for (int i = gt; i < T * 128; i += NGT) { const int t = i >> 7, f = i & 127;
            const float inv = exp2f(-(float)f * (13.287712379549449f / 128.0f));
            const float ang = (float)pos[t] * inv;
            double rev = (double)ang * 0.15915494309189535; rev -= floor(rev);
            const float rf = (float)rev;
            rc[i] = __builtin_amdgcn_cosf(rf); rs[i] = __builtin_amdgcn_sinf(rf); }
    }
    {
        const float* x = F.in[0]; float* glr = WSP(float, WS_GLR);
        const int r16 = F.lane & 15, g4 = F.lane >> 4;
        for (int tile = gw; tile < T / 16; tile += NGW) {
            f32x4 acc = {0.f, 0.f, 0.f, 0.f};
            const float* xr = x + (size_t)(tile * 16 + r16) * D + 4 * g4;
            const float* wr = w_in + (size_t)(4 * g4) * INW + HW + r16;
#pragma unroll 4
            for (int k0 = 0; k0 < D; k0 += 16) {
                const f32x4 a = *(const GAS f32x4*)(xr + k0);
                const float b0 = wr[(size_t)(k0 + 0) * INW], b1 = wr[(size_t)(k0 + 1) * INW], b2 = wr[(size_t)(k0 + 2) * INW], b3 = wr[(size_t)(k0 + 3) * INW];
                acc = __builtin_amdgcn_mfma_f32_16x16x4f32(a[0], b0, acc, 0, 0, 0);
                acc = __builtin_amdgcn_mfma_f32_16x16x4f32(a[1], b1, acc, 0, 0, 0);
                acc = __builtin_amdgcn_mfma_f32_16x16x4f32(a[2], b2, acc, 0, 0, 0);
                acc = __builtin_amdgcn_mfma_f32_16x16x4f32(a[3], b3, acc, 0, 0, 0);
            }
#pragma unroll
            for (int j = 0; j < 4; ++j) glr[(size_t)(tile * 16 + 4 * g4 + j) * 16 + r16] = acc[j];
        }
    }
}

__device__ __forceinline__ float log_sigmoid_f(float z) { return fminf(z, 0.f) - log1pf(expf(-fabsf(z))); }
template <bool GLA>
__device__ __forceinline__ void mixer_naive_item(Frame& F, int hh, int eg) {
    constexpr int ND = GLA ? 4 : 8;
    const bf16* H = WSP(bf16, WS_H); float* oraw = WSP(float, WS_ORAW);
    const int ei = F.tid & 15, dp = F.tid >> 4, e = eg * 16 + ei;
    const int qcol = GLA ? 4096 + hh * 128 : hh * 256, kcol = GLA ? 4608 + hh * 128 : 1024 + hh * 256, vcol = (GLA ? 5120 : 2048) + hh * 256 + e;
    const int ocol = (GLA ? 1024 : 0) + hh * 256 + eg * 16;
    LAS float* red = (LAS float*)F.lds;
    float S[ND];
#pragma unroll
    for (int i = 0; i < ND; ++i) S[i] = 0.f;
    float wa[GLA ? 4 : 1][16]; float ba[GLA ? 4 : 1];
    if (GLA) {
#pragma unroll
        for (int i = 0; i < 4; ++i) { const int d = dp + 32 * i; ba[i] = F.in[5][hh * 128 + d];
#pragma unroll
            for (int r = 0; r < 16; ++r) wa[i][r] = F.in[4][r * 512 + hh * 128 + d]; }
    }
    const float gamma = 1.0f - exp2f(-5.0f - (float)hh);
    const float* glr = WSP(float, WS_GLR);
    for (int t0 = 0; t0 < T; t0 += 8) {
        float part[8];
#pragma unroll
        for (int tt = 0; tt < 8; ++tt) {
            const int t = t0 + tt; const bf16* hr = H + (size_t)t * HW;
            const float v = bf2f(hr[vcol]);
            float g16[16];
            if (GLA) {
#pragma unroll
                for (int r = 0; r < 16; ++r) g16[r] = glr[t * 16 + r];
            }
            float p = 0.f;
#pragma unroll
            for (int i = 0; i < ND; ++i) { const int d = dp + 32 * i;
                const float q = bf2f(hr[qcol + d]), k = bf2f(hr[kcol + d]);
                float a = gamma;
                if (GLA) { float z = ba[i];
#pragma unroll
                    for (int r = 0; r < 16; ++r) z += g16[r] * wa[i][r];
                    a = expf(log_sigmoid_f(z) * 0.0625f); }
                S[i] = a * S[i] + k * v; p += q * S[i]; }
            p += __shfl_xor(p, 16); p += __shfl_xor(p, 32);
            part[tt] = p;
        }
        if (F.lane < 16) {
#pragma unroll
            for (int tt = 0; tt < 8; ++tt) red[(F.wave * 8 + tt) * 16 + F.lane] = part[tt];
        }
        __syncthreads();
        if (F.tid < 128) { const int tt = F.tid >> 4, e2 = F.tid & 15; float s = 0.f;
#pragma unroll
            for (int w = 0; w < 8; ++w) s += red[(w * 8 + tt) * 16 + e2];
            oraw[(size_t)(t0 + tt) * D + ocol + e2] = s; }
        __syncthreads();
    }
}
__device__ __forceinline__ void p2_mixer_naive(Frame& F) {
    for (int item = F.bid; item < 128; item += F.G) {
        const int h8 = item >> 4, eg = item & 15;
        if (h8 < 4) mixer_naive_item<false>(F, h8, eg); else mixer_naive_item<true>(F, h8 - 4, eg);
    }
}
__device__ __forceinline__ void p3_normgate(Frame& F) {
    const bf16* H = WSP(bf16, WS_H); const float* oraw = WSP(float, WS_ORAW); bf16* mixed = WSP(bf16, WS_MIXED);
    const int gw = F.bid * NWAVES + F.wave, NGW = F.G * NWAVES;
    const f32x4 gn = *(const f32x4*)(F.in[6] + 4 * F.lane);
    for (int t = gw; t < T; t += NGW) {
#pragma unroll
        for (int h8 = 0; h8 < 8; ++h8) {
            const f32x4 o = *(const GAS f32x4*)(oraw + (size_t)t * D + h8 * 256 + 4 * F.lane);
            const int gcol = (h8 < 4 ? 3072 : 6144) + (h8 & 3) * 256 + 4 * F.lane;
            const v2u gw2 = *(const GAS v2u*)(H + (size_t)t * HW + gcol);
            const f32x4 gt = {bflo(gw2.x), bfhi(gw2.x), bflo(gw2.y), bfhi(gw2.y)};
            f32x4 y;
            if (h8 < 4) {
                const float mu = wave_sum((o[0] + o[1]) + (o[2] + o[3])) * (1.f / 256.f);
                const f32x4 dd = o - mu;
                const float var = wave_sum((dd[0] * dd[0] + dd[1] * dd[1]) + (dd[2] * dd[2] + dd[3] * dd[3])) * (1.f / 256.f);
                y = dd * (1.0f / sqrtf(var + LN_EPS));
            } else {
                const float ms = wave_sum((o[0] * o[0] + o[1] * o[1]) + (o[2] * o[2] + o[3] * o[3])) * (1.f / 256.f);
                y = o * (1.0f / sqrtf(ms + LN_EPS)) * gn;
            }
            float r[4];
#pragma unroll
            for (int i = 0; i < 4; ++i) { const float g = gt[i]; r[i] = g / (1.0f + expf(-g)) * y[i]; }
            v2u w; w.x = pk2(r[0], r[1]); w.y = pk2(r[2], r[3]);
            *(GAS v2u*)(mixed + (size_t)t * D + h8 * 256 + 4 * F.lane) = w;
        }
    }
}
template <bool ROUTER>
__device__ __forceinline__ void ln_apply(Frame& F, const float* Y, const float* g, const float* b, bf16* HB, float* st, bool count = true) {
    const int gw = F.bid * NWAVES + F.wave, NGW = F.G * NWAVES;
    for (int t = gw; t < T; t += NGW) {
        const GAS f32x4* yr = (const GAS f32x4*)(Y + (size_t)t * D) + F.lane;
        f32x4 v[8]; float s = 0.f;
#pragma unroll
        for (int j = 0; j < 8; ++j) { v[j] = yr[64 * j]; s += (v[j][0] + v[j][1]) + (v[j][2] + v[j][3]); }
        const float mean = wave_sum(s) * (1.f / D); float s2 = 0.f;
#pragma unroll
        for (int j = 0; j < 8; ++j) { v[j] = v[j] - mean; s2 += (v[j][0] * v[j][0] + v[j][1] * v[j][1]) + (v[j][2] * v[j][2] + v[j][3] * v[j][3]); }
        const float rstd = 1.f / sqrtf(wave_sum(s2) * (1.f / D) + LN_EPS);
        if (F.lane == 0) { st[2 * t] = mean; st[2 * t + 1] = rstd; }
        GAS v2u* o8 = (GAS v2u*)(HB + (size_t)t * D) + F.lane;
#pragma unroll
        for (int j = 0; j < 8; ++j) { const f32x4 gv = *(const f32x4*)(g + 4 * F.lane + 256 * j), bv = *(const f32x4*)(b + 4 * F.lane + 256 * j);
            v[j] = v[j] * rstd * gv + bv;
            v2u w; w.x = pk2(v[j][0], v[j][1]); w.y = pk2(v[j][2], v[j][3]); o8[64 * j] = w; }
        if (ROUTER) {
            const float* Wg = F.in[16]; const float* We = F.in[18];
            float lg[4], le[32];
#pragma unroll
            for (int i = 0; i < 4; ++i) lg[i] = 0.f;
#pragma unroll
            for (int i = 0; i < 32; ++i) le[i] = 0.f;
#pragma unroll
            for (int j = 0; j < 8; ++j) {
#pragma unroll
                for (int i = 0; i < 4; ++i) { const int c = 4 * F.lane + 256 * j + i; const float hv = v[j][i];
                    const f32x4 wg = *(const GAS f32x4*)(Wg + (size_t)c * 4);
#pragma unroll
                    for (int q = 0; q < 4; ++q) lg[q] += hv * wg[q];
#pragma unroll
                    for (int q8 = 0; q8 < 8; ++q8) { const f32x4 we = *(const GAS f32x4*)(We + (size_t)c * 32 + 4 * q8);
#pragma unroll
                        for (int q = 0; q < 4; ++q) le[4 * q8 + q] += hv * we[q]; } }
            }
#pragma unroll
            for (int i = 0; i < 4; ++i) lg[i] = wave_sum(lg[i]) + F.in[17][i];
#pragma unroll
            for (int i = 0; i < 32; ++i) le[i] = wave_sum(le[i]);
            int grp = 0; float gm = lg[0];
#pragma unroll
            for (int i = 1; i < 4; ++i) if (lg[i] > gm) { gm = lg[i]; grp = i; }
            float gs = 0.f;
#pragma unroll
            for (int i = 0; i < 4; ++i) gs += expf(lg[i] - gm);
            const float pg_sel = 1.0f / gs;
            float fe[8];
#pragma unroll
            for (int j = 0; j < 8; ++j) { const float a = grp == 0 ? le[j] : grp == 1 ? le[8 + j] : grp == 2 ? le[16 + j] : le[24 + j]; fe[j] = a + F.in[19][grp * 8 + j]; }
            int i1 = 0; float m1 = fe[0];
#pragma unroll
            for (int j = 1; j < 8; ++j) if (fe[j] > m1) { m1 = fe[j]; i1 = j; }
            int i2 = -1; float m2 = -3.0e38f;
#pragma unroll
            for (int j = 0; j < 8; ++j) if (j != i1 && fe[j] > m2) { m2 = fe[j]; i2 = j; }
            const float p2 = expf(m2 - m1), den = 1.0f / (1.0f + p2);
            if (F.lane == 0) {
                int* ex = WSP(int, WS_EXP); float* gt = WSP(float, WS_GATE);
                const int e1 = grp * 8 + i1, e2 = grp * 8 + i2;
                ex[2 * t] = e1; ex[2 * t + 1] = e2; gt[2 * t] = pg_sel * den; gt[2 * t + 1] = pg_sel * p2 * den;
                if (count) { atomicAdd((unsigned*)(F.ctl + CW_CNT) + e1, 1u); atomicAdd((unsigned*)(F.ctl + CW_CNT) + e2, 1u); }
            }
        }
    }
}
__device__ __forceinline__ void p7_attn_naive(Frame& F) {
    const bf16* Q = WSP(bf16, WS_QB); const bf16* KVM = WSP(bf16, WS_KVM); bf16* att = WSP(bf16, WS_ATT);
    LAS float* qs = (LAS float*)F.lds;
    LAS float* sc = (LAS float*)(F.lds + 16384);
    for (int item = F.bid; item < (T / 8) * 4; item += F.G) {
        const int h = item & 3, t0 = (item >> 2) * 8;
        for (int i = F.tid; i < 8 * 512; i += NTHR) { const int tt = i >> 9, d = i & 511; qs[i] = bf2f(Q[(size_t)(t0 + tt) * D + h * 512 + d]); }
        __syncthreads();
        {
            const int j = F.tid & 255, th = F.tid >> 8;
            const bf16* kr = KVM + (size_t)j * 4096 + h * 512;
            float a0 = 0.f, a1 = 0.f, a2 = 0.f, a3 = 0.f;
            for (int d = 0; d < 512; d += 8) {
                const v4u kw = *(const GAS v4u*)(kr + d);
                const float kf[8] = {bflo(kw.x), bfhi(kw.x), bflo(kw.y), bfhi(kw.y), bflo(kw.z), bfhi(kw.z), bflo(kw.w), bfhi(kw.w)};
#pragma unroll
                for (int i = 0; i < 8; ++i) { a0 += kf[i] * qs[(th * 4 + 0) * 512 + d + i]; a1 += kf[i] * qs[(th * 4 + 1) * 512 + d + i]; a2 += kf[i] * qs[(th * 4 + 2) * 512 + d + i]; a3 += kf[i] * qs[(th * 4 + 3) * 512 + d + i]; }
            }
            const float scl = 0.04419417382415922f;
            sc[(th * 4 + 0) * 256 + j] = a0 * scl; sc[(th * 4 + 1) * 256 + j] = a1 * scl; sc[(th * 4 + 2) * 256 + j] = a2 * scl; sc[(th * 4 + 3) * 256 + j] = a3 * scl;
        }
        __syncthreads();
        {
            float v[4]; float mx = -3.0e38f;
#pragma unroll
            for (int i = 0; i < 4; ++i) { v[i] = sc[F.wave * 256 + F.lane + 64 * i]; mx = fmaxf(mx, v[i]); }
            mx = wave_max(mx); float sm = 0.f;
#pragma unroll
            for (int i = 0; i < 4; ++i) { v[i] = expf(v[i] - mx); sm += v[i]; }
            sm = 1.0f / wave_sum(sm);
#pragma unroll
            for (int i = 0; i < 4; ++i) sc[F.wave * 256 + F.lane + 64 * i] = v[i] * sm;
        }
        __syncthreads();
        {
            const int d = F.tid; const bf16* vr = KVM + 2048 + h * 512 + d;
            float o[8];
#pragma unroll
            for (int i = 0; i < 8; ++i) o[i] = 0.f;
            for (int j = 0; j < 256; ++j) { const float vv = bf2f(vr[(size_t)j * 4096]);
#pragma unroll
                for (int i = 0; i < 8; ++i) o[i] += sc[i * 256 + j] * vv; }
#pragma unroll
            for (int i = 0; i < 8; ++i) att[(size_t)(t0 + i) * D + h * 512 + d] = (bf16)f2bf(o[i]);
        }
        __syncthreads();
    }
}
__device__ __forceinline__ void moe_tile_starts(Frame& F, LAS int* ts) {
    if (F.tid == 0) { int acc = 0;
        for (int e = 0; e < 32; ++e) { ts[e] = acc; const unsigned c = __hip_atomic_load(F.ctl + CW_CNT + e, RLX_AGENT); acc += (int)((c + 255u) >> 8); }
        ts[32] = acc; }
    __syncthreads();
}
__device__ __forceinline__ void p10_dispatch(Frame& F, LAS int* ts) {
    const int gw = F.bid * NWAVES + F.wave, NGW = F.G * NWAVES;
    const int* ex = WSP(int, WS_EXP); int* pos = WSP(int, WS_POS); const bf16* h2 = WSP(bf16, WS_H2B); bf16* xs = WSP(bf16, WS_XS);
    for (int a = gw; a < 2 * T; a += NGW) {
        const int e = ex[a]; unsigned slot = 0;
        if (F.lane == 0) slot = atomicAdd((unsigned*)(F.ctl + CW_CUR) + e, 1u);
        slot = __builtin_amdgcn_readfirstlane(slot);
        const int p = ts[e] * 256 + (int)slot;
        if (F.lane == 0) pos[a] = p;
        const GAS v4u* src = (const GAS v4u*)(h2 + (size_t)(a >> 1) * D) + F.lane; GAS v4u* dst = (GAS v4u*)(xs + (size_t)p * D) + F.lane;
#pragma unroll
        for (int j = 0; j < 4; ++j) dst[64 * j] = src[64 * j];
    }
}
__device__ __forceinline__ void p13_combine(Frame& F) {
    const int gw = F.bid * NWAVES + F.wave, NGW = F.G * NWAVES;
    const float* Y2 = WSP(float, WS_Y2); const float* st2 = WSP(float, WS_ST2); const bf16* ys = WSP(bf16, WS_YS);
    const int* pos = WSP(int, WS_POS); const float* gt = WSP(float, WS_GATE);
    const float* g2 = F.in[14]; const float* b2 = F.in[15]; const float* g3 = F.in[23]; const float* b3 = F.in[24];
    for (int t = gw; t < T; t += NGW) {
        const float mu2 = st2[2 * t], rs2 = st2[2 * t + 1];
        const int p0 = pos[2 * t], p1 = pos[2 * t + 1]; const float w0 = gt[2 * t], w1 = gt[2 * t + 1];
        const GAS f32x4* yr = (const GAS f32x4*)(Y2 + (size_t)t * D) + F.lane;
        const GAS v2u* y0 = (const GAS v2u*)(ys + (size_t)p0 * D) + F.lane; const GAS v2u* y1 = (const GAS v2u*)(ys + (size_t)p1 * D) + F.lane;
        f32x4 v[8]; float s = 0.f;
#pragma unroll
        for (int j = 0; j < 8; ++j) { const f32x4 gv = *(const f32x4*)(g2 + 4 * F.lane + 256 * j), bv = *(const f32x4*)(b2 + 4 * F.lane + 256 * j);
            const f32x4 h = (yr[64 * j] - mu2) * rs2 * gv + bv;
            const v2u a = y0[64 * j], c = y1[64 * j];
            const f32x4 fa = {bflo(a.x), bfhi(a.x), bflo(a.y), bfhi(a.y)}, fc = {bflo(c.x), bfhi(c.x), bflo(c.y), bfhi(c.y)};
            v[j] = h * ALPHA + fa * w0 + fc * w1; s += (v[j][0] + v[j][1]) + (v[j][2] + v[j][3]); }
        const float mean = wave_sum(s) * (1.f / D); float s2 = 0.f;
#pragma unroll
        for (int j = 0; j < 8; ++j) { v[j] = v[j] - mean; s2 += (v[j][0] * v[j][0] + v[j][1] * v[j][1]) + (v[j][2] * v[j][2] + v[j][3] * v[j][3]); }
        const float rstd = 1.f / sqrtf(wave_sum(s2) * (1.f / D) + LN_EPS);
        GAS f32x4* orow = (GAS f32x4*)(F.out + (size_t)t * D) + F.lane;
#pragma unroll
        for (int j = 0; j < 8; ++j) { const f32x4 gv = *(const f32x4*)(g3 + 4 * F.lane + 256 * j), bv = *(const f32x4*)(b3 + 4 * F.lane + 256 * j);
            orow[64 * j] = v[j] * rstd * gv + bv; }
    }
}

constexpr int CS = 128, NB = CS / 64, NS = T / CS;
constexpr size_t WS_BCUM = WS_ORAW;
constexpr size_t WS_KVR = WS_ORAW + 16 * MiB;
constexpr size_t WS_KVG = WS_KVR + 32 * MiB;
typedef short bf16x8_t __attribute__((ext_vector_type(8)));
typedef short s16x4_t __attribute__((ext_vector_type(4)));
__device__ __forceinline__ s16x4_t lds_tr(const LAS unsigned char* p) { return __builtin_bit_cast(s16x4_t, __builtin_amdgcn_ds_read_tr16_b64_v4i16((LAS s16x4_t*)p)); }
__device__ __forceinline__ bf16x8_t frag_tr(const LAS unsigned char* X, int pitch, int k0, int n0, int lane) {
    const int fq = lane >> 4, q = (lane >> 2) & 3, p = lane & 3;
    const LAS unsigned char* a = X + ((k0 + 8 * fq + q) * pitch + n0 + 4 * p) * 2;
    const s16x4_t lo = lds_tr(a), hi = lds_tr(a + 4 * pitch * 2);
    return __builtin_shufflevector(lo, hi, 0, 1, 2, 3, 4, 5, 6, 7);
}
__device__ __forceinline__ bf16x8_t frag_row(const LAS unsigned char* X, int pitch, int r0, int k0, int lane) {
    return *(const LAS bf16x8_t*)(X + ((r0 + (lane & 15)) * pitch + k0 + 8 * (lane >> 4)) * 2);
}
#define MFMA16(a, b, c) __builtin_amdgcn_mfma_f32_16x16x32_bf16((a), (b), (c), 0, 0, 0)
__device__ __forceinline__ float fexp(float x) { return __builtin_amdgcn_exp2f(x * 1.4426950408889634f); }
__device__ __forceinline__ float silu_g(float g) { return g * __builtin_amdgcn_rcpf(1.0f + __builtin_amdgcn_exp2f(-1.4426950408889634f * g)); }

__device__ __forceinline__ void bcum_item(Frame& F, int s, int h) {
    const int c = F.tid & 127, tq = F.tid >> 7;
    LAS float* tot = (LAS float*)F.lds;
    const float* glr = WSP(float, WS_GLR); float* bc = WSP(float, WS_BCUM);
    float w[16];
#pragma unroll
    for (int r = 0; r < 16; ++r) w[r] = F.in[4][r * 512 + h * 128 + c];
    const float bias = F.in[5][h * 128 + c];
    float vals[32]; float run = 0.f;
    const int tb = s * CS + tq * 32;
#pragma unroll
    for (int i = 0; i < 32; ++i) { const float* gr = glr + (size_t)(tb + i) * 16; float z = bias;
#pragma unroll
        for (int r = 0; r < 16; ++r) z += gr[r] * w[r];
        run += log_sigmoid_f(z) * 0.0625f; vals[i] = run; }
    __syncthreads();
    tot[tq * 128 + c] = run;
    __syncthreads();
    float off = 0.f;
#pragma unroll
    for (int q = 0; q < 3; ++q) off += (q < tq) ? tot[q * 128 + c] : 0.f;
#pragma unroll
    for (int i = 0; i < 32; ++i) bc[(size_t)(tb + i) * 512 + h * 128 + c] = vals[i] + off;
}
__device__ __forceinline__ void p1_bcum(Frame& F) { for (int it = F.bid; it < NS * 4; it += F.G) bcum_item(F, it >> 2, it & 3); __syncthreads(); }

__device__ __forceinline__ void unit_sh(int u, int& s, int& h8) { s = (u >> 3) & (NS - 1); h8 = ((u & 7) + 4 * (u >> 8)) & 7; }

template <bool GLA, int MODE>
__device__ __forceinline__ void stage_qk(Frame& F, LAS unsigned char* dst, int s, int jb, int hh, int col0, float lg2gamma) {
    constexpr int DK = GLA ? 128 : 256, PK = DK + 8, CPR = DK / 8, NIT = 64 * CPR / NTHR;
    const bf16* H = WSP(bf16, WS_H); const float* bc = WSP(float, WS_BCUM);
#pragma unroll
    for (int it = 0; it < NIT; ++it) {
        const int ch = F.tid + NTHR * it, r = ch / CPR, cc = ch % CPR, tl = jb * 64 + r, t = s * CS + tl;
        const v4u w = *(const GAS v4u*)(H + (size_t)t * HW + col0 + 8 * cc);
        float f[8] = {bflo(w.x), bfhi(w.x), bflo(w.y), bfhi(w.y), bflo(w.z), bfhi(w.z), bflo(w.w), bfhi(w.w)};
        if (GLA) {
            const f32x4 b0 = *(const GAS f32x4*)(bc + (size_t)t * 512 + hh * 128 + 8 * cc), b1 = *(const GAS f32x4*)(bc + (size_t)t * 512 + hh * 128 + 8 * cc + 4);
            float e[8] = {b0[0], b0[1], b0[2], b0[3], b1[0], b1[1], b1[2], b1[3]};
            if (MODE == 2) { const size_t tl_ = (size_t)(s * CS + CS - 1) * 512 + hh * 128 + 8 * cc; const f32x4 l0 = *(const GAS f32x4*)(bc + tl_), l1 = *(const GAS f32x4*)(bc + tl_ + 4);
                const float l[8] = {l0[0], l0[1], l0[2], l0[3], l1[0], l1[1], l1[2], l1[3]};
#pragma unroll
                for (int i = 0; i < 8; ++i) e[i] = l[i] - e[i]; }
            else if (MODE == 1) {
#pragma unroll
                for (int i = 0; i < 8; ++i) e[i] = -e[i]; }
#pragma unroll
            for (int i = 0; i < 8; ++i) f[i] *= fexp(e[i]);
        } else {
            const float ex = MODE == 0 ? (float)(tl + 1) : MODE == 1 ? -(float)(tl + 1) : (float)(CS - 1 - tl);
            const float fac = __builtin_amdgcn_exp2f(ex * lg2gamma);
#pragma unroll
            for (int i = 0; i < 8; ++i) f[i] *= fac;
        }
        v4u o; o.x = pk2(f[0], f[1]); o.y = pk2(f[2], f[3]); o.z = pk2(f[4], f[5]); o.w = pk2(f[6], f[7]);
        *(LAS v4u*)(dst + (r * PK + 8 * cc) * 2) = o;
    }
}
__device__ __forceinline__ void stage_v(Frame& F, LAS unsigned char* dst, int s, int jb, int col0) {
    const bf16* H = WSP(bf16, WS_H);
#pragma unroll
    for (int it = 0; it < 4; ++it) { const int ch = F.tid + NTHR * it, r = ch >> 5, cc = ch & 31, t = s * CS + jb * 64 + r;
        *(LAS v4u*)(dst + (r * 264 + 8 * cc) * 2) = *(const GAS v4u*)(H + (size_t)t * HW + col0 + 8 * cc); }
}

template <bool GLA>
__device__ __forceinline__ void kv_unit(Frame& F, int s, int hh) {
    constexpr int DK = GLA ? 128 : 256, PK = DK + 8, NDT = DK / 16;
    LAS unsigned char* Ks = F.lds; LAS unsigned char* Vs = F.lds + 34816;
    const int kcol = GLA ? 4608 + hh * 128 : 1024 + hh * 256, vcol = (GLA ? 5120 : 2048) + hh * 256;
    const float lg2g = log2f(1.0f - exp2f(-5.0f - (float)hh));
    f32x4 acc[2][NDT];
#pragma unroll
    for (int a = 0; a < 2; ++a)
#pragma unroll
        for (int d = 0; d < NDT; ++d) acc[a][d] = (f32x4){0.f, 0.f, 0.f, 0.f};
    for (int jb = 0; jb < NB; ++jb) {
        __syncthreads();
        stage_qk<GLA, 2>(F, Ks, s, jb, hh, kcol, lg2g);
        stage_v(F, Vs, s, jb, vcol);
        __syncthreads();
#pragma unroll
        for (int ks = 0; ks < 2; ++ks) {
            bf16x8_t vf[2];
#pragma unroll
            for (int et = 0; et < 2; ++et) vf[et] = frag_tr(Vs, 264, 32 * ks, 32 * F.wave + 16 * et, F.lane);
#pragma unroll
            for (int dt = 0; dt < NDT; ++dt) { const bf16x8_t kf = frag_tr(Ks, PK, 32 * ks, 16 * dt, F.lane);
#pragma unroll
                for (int et = 0; et < 2; ++et) acc[et][dt] = MFMA16(kf, vf[et], acc[et][dt]); }
        }
    }
    bf16* kv = GLA ? (WSP(bf16, WS_KVG) + (size_t)(s * 4 + hh) * 256 * 128) : (WSP(bf16, WS_KVR) + (size_t)(s * 4 + hh) * 256 * 256);
    const int fr = F.lane & 15, fq = F.lane >> 4;
#pragma unroll
    for (int et = 0; et < 2; ++et)
#pragma unroll
        for (int dt = 0; dt < NDT; ++dt) { v2u w; w.x = pk2(acc[et][dt][0], acc[et][dt][1]); w.y = pk2(acc[et][dt][2], acc[et][dt][3]);
            *(GAS v2u*)(kv + (size_t)(32 * F.wave + 16 * et + fr) * DK + 16 * dt + 4 * fq) = w; }
}
__device__ __forceinline__ void p2_kv(Frame& F) {
    for (int u = F.bid; u < 8 * NS; u += F.G) { int s, h8; unit_sh(u, s, h8);
        if (s == NS - 1) continue;
        if (h8 < 4) kv_unit<false>(F, s, h8); else kv_unit<true>(F, s, h8 - 4); }
    __syncthreads();
}
__device__ __forceinline__ void p3_scan(Frame& F) {
    const int gt = F.bid * NTHR + F.tid, NGT = F.G * NTHR;
    constexpr int NR = 4 * 256 * 32, NG = 4 * 256 * 16;
    const float* bc = WSP(float, WS_BCUM);
    for (int it = gt; it < NR + NG; it += NGT) {
        const bool gla = it >= NR; const int r = gla ? it - NR : it;
        const int sh = gla ? 4 : 5, dk = gla ? 128 : 256;
        const int cc = r & ((1 << sh) - 1), e = (r >> sh) & 255, hh = r >> (sh + 8);
        bf16* base = (gla ? WSP(bf16, WS_KVG) : WSP(bf16, WS_KVR)) + ((size_t)hh * 256 + e) * dk + 8 * cc;
        const size_t sstride = (size_t)4 * 256 * dk;
        const float dret = __builtin_amdgcn_exp2f((float)CS * log2f(1.0f - exp2f(-5.0f - (float)hh)));
        float S[8];
#pragma unroll
        for (int i = 0; i < 8; ++i) S[i] = 0.f;
#pragma unroll 4
        for (int s = 0; s < NS - 1; ++s) {
            GAS v4u* p = (GAS v4u*)(base + (size_t)s * sstride);
            const v4u w = *p;
            v4u o; o.x = pk2(S[0], S[1]); o.y = pk2(S[2], S[3]); o.z = pk2(S[4], S[5]); o.w = pk2(S[6], S[7]);
            *p = o;
            const float f[8] = {bflo(w.x), bfhi(w.x), bflo(w.y), bfhi(w.y), bflo(w.z), bfhi(w.z), bflo(w.w), bfhi(w.w)};
            float dec[8];
            if (gla) { const size_t o_ = (size_t)(s * CS + CS - 1) * 512 + hh * 128 + 8 * cc; const f32x4 l0 = *(const GAS f32x4*)(bc + o_), l1 = *(const GAS f32x4*)(bc + o_ + 4);
                dec[0] = fexp(l0[0]); dec[1] = fexp(l0[1]); dec[2] = fexp(l0[2]); dec[3] = fexp(l0[3]); dec[4] = fexp(l1[0]); dec[5] = fexp(l1[1]); dec[6] = fexp(l1[2]); dec[7] = fexp(l1[3]); }
            else {
#pragma unroll
                for (int i = 0; i < 8; ++i) dec[i] = dret; }
#pragma unroll
            for (int i = 0; i < 8; ++i) S[i] = dec[i] * S[i] + f[i];
        }
        { GAS v4u* p = (GAS v4u*)(base + (size_t)(NS - 1) * sstride);
          v4u o; o.x = pk2(S[0], S[1]); o.y = pk2(S[2], S[3]); o.z = pk2(S[4], S[5]); o.w = pk2(S[6], S[7]); *p = o; }
    }
}
template <bool GLA>
__device__ __forceinline__ void out_unit(Frame& F, int s, int hh) {
    constexpr int DK = GLA ? 128 : 256, PK = DK + 8, NKS = DK / 32;
    LAS unsigned char* Qs = F.lds; LAS unsigned char* Ks = F.lds + 33792; LAS unsigned char* Vs = F.lds + 67584; LAS unsigned char* Ps = F.lds + 101376;
    LAS float* red = (LAS float*)(F.lds + 110592);
    const int qcol = GLA ? 4096 + hh * 128 : hh * 256, kcol = GLA ? 4608 + hh * 128 : 1024 + hh * 256, vcol = (GLA ? 5120 : 2048) + hh * 256;
    const int gcol = (GLA ? 6144 : 3072) + hh * 256, ocol = (GLA ? 1024 : 0) + hh * 256;
    const float lg2g = log2f(1.0f - exp2f(-5.0f - (float)hh));
    const bf16* H = WSP(bf16, WS_H); bf16* mixed = WSP(bf16, WS_MIXED);
    const bf16* st = GLA ? (WSP(bf16, WS_KVG) + (size_t)(s * 4 + hh) * 256 * 128) : (WSP(bf16, WS_KVR) + (size_t)(s * 4 + hh) * 256 * 256);
    const int fr = F.lane & 15, fq = F.lane >> 4, w = F.wave, mt = w >> 1, nt0 = 2 * (w & 1);
    for (int i = 0; i < NB; ++i) {
        __syncthreads();
        stage_qk<GLA, 0>(F, Qs, s, i, hh, qcol, lg2g);
        f32x4 accO[4][2];
#pragma unroll
        for (int m = 0; m < 4; ++m)
#pragma unroll
            for (int n = 0; n < 2; ++n) accO[m][n] = (f32x4){0.f, 0.f, 0.f, 0.f};
        for (int j = 0; j <= i; ++j) {
            __syncthreads();
            stage_qk<GLA, 1>(F, Ks, s, j, hh, kcol, lg2g);
            stage_v(F, Vs, s, j, vcol);
            __syncthreads();
            f32x4 accS[2] = {(f32x4){0.f, 0.f, 0.f, 0.f}, (f32x4){0.f, 0.f, 0.f, 0.f}};
#pragma unroll
            for (int ks = 0; ks < NKS; ++ks) { const bf16x8_t qf = frag_row(Qs, PK, 16 * mt, 32 * ks, F.lane);
#pragma unroll
                for (int n2 = 0; n2 < 2; ++n2) { const bf16x8_t kf = frag_row(Ks, PK, 16 * (nt0 + n2), 32 * ks, F.lane); accS[n2] = MFMA16(kf, qf, accS[n2]); } }
#pragma unroll
            for (int n2 = 0; n2 < 2; ++n2) { const int row = 16 * mt + fr, c0 = 16 * (nt0 + n2) + 4 * fq; float pv[4];
#pragma unroll
                for (int jj = 0; jj < 4; ++jj) pv[jj] = (i == j && c0 + jj > row) ? 0.f : accS[n2][jj];
                v2u pw; pw.x = pk2(pv[0], pv[1]); pw.y = pk2(pv[2], pv[3]);
                *(LAS v2u*)(Ps + (row * 72 + c0) * 2) = pw; }
            __syncthreads();
#pragma unroll
            for (int ks = 0; ks < 2; ++ks) {
                bf16x8_t vf[2];
#pragma unroll
                for (int n = 0; n < 2; ++n) vf[n] = frag_tr(Vs, 264, 32 * ks, 32 * w + 16 * n, F.lane);
#pragma unroll
                for (int m = 0; m < 4; ++m) { const bf16x8_t pf = frag_row(Ps, 72, 16 * m, 32 * ks, F.lane);
#pragma unroll
                    for (int n = 0; n < 2; ++n) accO[m][n] = MFMA16(vf[n], pf, accO[m][n]); }
            }
        }
        if (s > 0) {
#pragma unroll
            for (int ks = 0; ks < NKS; ++ks) {
                bf16x8_t sf[2];
#pragma unroll
                for (int n = 0; n < 2; ++n) sf[n] = *(const GAS bf16x8_t*)(st + (size_t)(32 * w + 16 * n + fr) * DK + 32 * ks + 8 * fq);
#pragma unroll
                for (int m = 0; m < 4; ++m) { const bf16x8_t qf = frag_row(Qs, PK, 16 * m, 32 * ks, F.lane);
#pragma unroll
                    for (int n = 0; n < 2; ++n) accO[m][n] = MFMA16(sf[n], qf, accO[m][n]); }
            }
        }
#pragma unroll
        for (int m = 0; m < 4; ++m) { float s1 = 0.f, s2 = 0.f;
#pragma unroll
            for (int n = 0; n < 2; ++n)
#pragma unroll
                for (int jj = 0; jj < 4; ++jj) { const float v = accO[m][n][jj]; s1 += v; s2 += v * v; }
            s1 += __shfl_xor(s1, 16); s1 += __shfl_xor(s1, 32); s2 += __shfl_xor(s2, 16); s2 += __shfl_xor(s2, 32);
            if (fq == 0) { red[(w * 64 + 16 * m + fr) * 2] = s1; red[(w * 64 + 16 * m + fr) * 2 + 1] = s2; } }
        __syncthreads();
#pragma unroll
        for (int m = 0; m < 4; ++m) { const int row = 16 * m + fr; float s1 = 0.f, s2 = 0.f;
#pragma unroll
            for (int ww = 0; ww < 8; ++ww) { s1 += red[(ww * 64 + row) * 2]; s2 += red[(ww * 64 + row) * 2 + 1]; }
            const float mean = s1 * (1.f / 256.f), ex2 = s2 * (1.f / 256.f);
            const float mu = GLA ? 0.f : mean, var = GLA ? ex2 : fmaxf(ex2 - mean * mean, 0.f);
            const float rstd = 1.0f / sqrtf(var + LN_EPS);
            const int t = s * CS + i * 64 + row;
#pragma unroll
            for (int n = 0; n < 2; ++n) { const int e = 32 * w + 16 * n + 4 * fq;
                const v2u gw2 = *(const GAS v2u*)(H + (size_t)t * HW + gcol + e);
                const float gt[4] = {bflo(gw2.x), bfhi(gw2.x), bflo(gw2.y), bfhi(gw2.y)};
                f32x4 gn = {1.f, 1.f, 1.f, 1.f}; if (GLA) gn = *(const f32x4*)(F.in[6] + e);
                float r4[4];
#pragma unroll
                for (int jj = 0; jj < 4; ++jj) { const float y = (accO[m][n][jj] - mu) * rstd * gn[jj]; r4[jj] = silu_g(gt[jj]) * y; }
                v2u ow; ow.x = pk2(r4[0], r4[1]); ow.y = pk2(r4[2], r4[3]);
                *(GAS v2u*)(mixed + (size_t)t * D + ocol + e) = ow; } }
    }
}
__device__ __forceinline__ void p4_out(Frame& F) {
    for (int u = F.bid; u < 8 * NS; u += F.G) { int s, h8; unit_sh(u, s, h8);
        if (h8 < 4) out_unit<false>(F, s, h8); else out_unit<true>(F, s, h8 - 4); }
    __syncthreads();
}

__device__ __forceinline__ void stage_kv_chunk(Frame& F, LAS unsigned char* dst, const bf16* src  ) {
#pragma unroll
    for (int it = 0; it < 8; ++it) { const int ch = F.tid + NTHR * it, r = ch >> 4, cc = ch & 15;
        *(LAS v4u*)(dst + (r * 136 + 8 * cc) * 2) = *(const GAS v4u*)(src + (size_t)r * 4096 + 8 * cc); }
}
__device__ __forceinline__ void p8_attn(Frame& F) {
    const bf16* Q = WSP(bf16, WS_QB); const bf16* KVM = WSP(bf16, WS_KVM); bf16* att = WSP(bf16, WS_ATT);
    LAS unsigned char* Cs = F.lds;
    const int fr = F.lane & 15, fq = F.lane >> 4, q4 = (F.lane >> 2) & 3, p4 = F.lane & 3;
    for (int u = F.bid; u < (T / 128) * 4; u += F.G) {
        const int h = u & 3, r0 = (u >> 2) * 128 + 16 * F.wave;
        f32x4 accS[16];
#pragma unroll
        for (int i = 0; i < 16; ++i) accS[i] = (f32x4){0.f, 0.f, 0.f, 0.f};
        for (int dc = 0; dc < 4; ++dc) {
            __syncthreads();
            stage_kv_chunk(F, Cs, KVM + h * 512 + dc * 128);
            bf16x8_t qf[4];
#pragma unroll
            for (int ks = 0; ks < 4; ++ks) qf[ks] = *(const GAS bf16x8_t*)(Q + (size_t)(r0 + fr) * D + h * 512 + dc * 128 + 32 * ks + 8 * fq);
            __syncthreads();
#pragma unroll
            for (int ks = 0; ks < 4; ++ks)
#pragma unroll
                for (int nt = 0; nt < 16; ++nt) accS[nt] = MFMA16(frag_row(Cs, 136, 16 * nt, 32 * ks, F.lane), qf[ks], accS[nt]);
        }
        float mx = -3.0e38f;
#pragma unroll
        for (int nt = 0; nt < 16; ++nt)
#pragma unroll
            for (int jj = 0; jj < 4; ++jj) mx = fmaxf(mx, accS[nt][jj]);
        mx = fmaxf(mx, __shfl_xor(mx, 16)); mx = fmaxf(mx, __shfl_xor(mx, 32));
        const float sl2 = 0.04419417382415922f * 1.4426950408889634f;
        float sm = 0.f;
#pragma unroll
        for (int nt = 0; nt < 16; ++nt)
#pragma unroll
            for (int jj = 0; jj < 4; ++jj) { const float p = __builtin_amdgcn_exp2f((accS[nt][jj] - mx) * sl2); accS[nt][jj] = p; sm += p; }
        sm += __shfl_xor(sm, 16); sm += __shfl_xor(sm, 32);
        const float inv = 1.0f / sm;
        bf16x8_t pf[8];
#pragma unroll
        for (int ks2 = 0; ks2 < 8; ++ks2) { v4u w; w.x = pk2(accS[2 * ks2][0] * inv, accS[2 * ks2][1] * inv); w.y = pk2(accS[2 * ks2][2] * inv, accS[2 * ks2][3] * inv);
            w.z = pk2(accS[2 * ks2 + 1][0] * inv, accS[2 * ks2 + 1][1] * inv); w.w = pk2(accS[2 * ks2 + 1][2] * inv, accS[2 * ks2 + 1][3] * inv); pf[ks2] = __builtin_bit_cast(bf16x8_t, w); }
        for (int ec = 0; ec < 4; ++ec) {
            __syncthreads();
            stage_kv_chunk(F, Cs, KVM + 2048 + h * 512 + ec * 128);
            __syncthreads();
            f32x4 accO[8];
#pragma unroll
            for (int i = 0; i < 8; ++i) accO[i] = (f32x4){0.f, 0.f, 0.f, 0.f};
#pragma unroll
            for (int ks2 = 0; ks2 < 8; ++ks2)
#pragma unroll
                for (int et = 0; et < 8; ++et) { const LAS unsigned char* a = Cs + ((32 * ks2 + 4 * fq + q4) * 136 + 16 * et + 4 * p4) * 2;
                    const s16x4_t lo = lds_tr(a), hi = lds_tr(a + 16 * 136 * 2);
                    accO[et] = MFMA16(__builtin_shufflevector(lo, hi, 0, 1, 2, 3, 4, 5, 6, 7), pf[ks2], accO[et]); }
#pragma unroll
            for (int et = 0; et < 8; ++et) { v2u w; w.x = pk2(accO[et][0], accO[et][1]); w.y = pk2(accO[et][2], accO[et][3]);
                *(GAS v2u*)(att + (size_t)(r0 + fr) * D + h * 512 + ec * 128 + 16 * et + 4 * fq) = w; }
        }
    }
    __syncthreads();
}

__device__ __forceinline__ void p10_ln_router(Frame& F) {
    const float* Y = WSP(float, WS_Y2); const float* g = F.in[14]; const float* b = F.in[15]; bf16* HB = WSP(bf16, WS_H2B); float* st = WSP(float, WS_ST2);
    const float* Wg = F.in[16]; const float* We = F.in[18];
    LAS float* stl = (LAS float*)F.lds;
    LAS float* part = (LAS float*)(F.lds + 1024);
    const int fr = F.lane & 15, fq = F.lane >> 4;
    for (int item = F.bid; item < T / 32; item += F.G) {
        const int row0 = item * 32;
#pragma unroll 1
        for (int i = 0; i < 4; ++i) {
            const int t = row0 + 4 * F.wave + i;
            const GAS f32x4* yr = (const GAS f32x4*)(Y + (size_t)t * D) + F.lane;
            f32x4 v[8]; float s = 0.f;
#pragma unroll
            for (int j = 0; j < 8; ++j) { v[j] = yr[64 * j]; s += (v[j][0] + v[j][1]) + (v[j][2] + v[j][3]); }
            const float mean = wave_sum(s) * (1.f / D); float s2 = 0.f;
#pragma unroll
            for (int j = 0; j < 8; ++j) { v[j] = v[j] - mean; s2 += (v[j][0] * v[j][0] + v[j][1] * v[j][1]) + (v[j][2] * v[j][2] + v[j][3] * v[j][3]); }
            const float rstd = 1.f / sqrtf(wave_sum(s2) * (1.f / D) + LN_EPS);
            if (F.lane == 0) { st[2 * t] = mean; st[2 * t + 1] = rstd; stl[2 * (4 * F.wave + i)] = mean; stl[2 * (4 * F.wave + i) + 1] = rstd; }
            GAS v2u* o8 = (GAS v2u*)(HB + (size_t)t * D) + F.lane;
#pragma unroll
            for (int j = 0; j < 8; ++j) { const f32x4 gv = *(const f32x4*)(g + 4 * F.lane + 256 * j), bv = *(const f32x4*)(b + 4 * F.lane + 256 * j);
                const f32x4 hv = v[j] * rstd * gv + bv;
                v2u w; w.x = pk2(hv[0], hv[1]); w.y = pk2(hv[2], hv[3]); o8[64 * j] = w; }
        }
        __syncthreads();
        {
            const int rt = F.wave >> 2, kq = F.wave & 3;
            const int r = row0 + 16 * rt + fr;
            const float mu = stl[2 * (16 * rt + fr)], rstd = stl[2 * (16 * rt + fr) + 1];
            f32x4 acc0 = {0.f, 0.f, 0.f, 0.f}, acc1 = acc0, acc2 = acc0;
            const float* yp = Y + (size_t)r * D + 512 * kq + 4 * fq;
            const float* wep = We + (size_t)(512 * kq + 4 * fq) * 32 + fr;
            const float* wgp = Wg + (size_t)(512 * kq + 4 * fq) * 4 + (fr & 3);
            const float gm = fr < 4 ? 1.f : 0.f;
#pragma unroll 2
            for (int it = 0; it < 32; ++it) {
                const int k0 = 16 * it;
                const f32x4 y4 = *(const GAS f32x4*)(yp + k0), g4 = *(const f32x4*)(g + 512 * kq + 4 * fq + k0), b4 = *(const f32x4*)(b + 512 * kq + 4 * fq + k0);
                const f32x4 a = (y4 - mu) * rstd * g4 + b4;
#pragma unroll
                for (int s = 0; s < 4; ++s) {
                    const float b0 = wep[(size_t)(k0 + s) * 32], b1 = wep[(size_t)(k0 + s) * 32 + 16], b2 = wgp[(size_t)(k0 + s) * 4] * gm;
                    acc0 = __builtin_amdgcn_mfma_f32_16x16x4f32(a[s], b0, acc0, 0, 0, 0);
                    acc1 = __builtin_amdgcn_mfma_f32_16x16x4f32(a[s], b1, acc1, 0, 0, 0);
                    acc2 = __builtin_amdgcn_mfma_f32_16x16x4f32(a[s], b2, acc2, 0, 0, 0);
                }
            }
            LAS float* pw = part + F.wave * 768;
#pragma unroll
            for (int jj = 0; jj < 4; ++jj) { pw[(4 * fq + jj) * 48 + fr] = acc0[jj]; pw[(4 * fq + jj) * 48 + 16 + fr] = acc1[jj]; pw[(4 * fq + jj) * 48 + 32 + fr] = acc2[jj]; }
        }
        __syncthreads();
        if (F.tid < 32) {
            const int rt = F.tid >> 4, rr = F.tid & 15, t = row0 + F.tid;
            float le[32], lg[4];
#pragma unroll
            for (int c = 0; c < 32; ++c) { float s = 0.f;
#pragma unroll
                for (int kq = 0; kq < 4; ++kq) s += part[(rt * 4 + kq) * 768 + rr * 48 + c]; le[c] = s; }
#pragma unroll
            for (int c = 0; c < 4; ++c) { float s = 0.f;
#pragma unroll
                for (int kq = 0; kq < 4; ++kq) s += part[(rt * 4 + kq) * 768 + rr * 48 + 32 + c]; lg[c] = s + F.in[17][c]; }
            int grp = 0; float gmx = lg[0];
#pragma unroll
            for (int i = 1; i < 4; ++i) if (lg[i] > gmx) { gmx = lg[i]; grp = i; }
            float gs = 0.f;
#pragma unroll
            for (int i = 0; i < 4; ++i) gs += expf(lg[i] - gmx);
            const float pg_sel = 1.0f / gs;
            float fe[8];
#pragma unroll
            for (int j = 0; j < 8; ++j) { const float a = grp == 0 ? le[j] : grp == 1 ? le[8 + j] : grp == 2 ? le[16 + j] : le[24 + j]; fe[j] = a + F.in[19][grp * 8 + j]; }
            int i1 = 0; float m1 = fe[0];
#pragma unroll
            for (int j = 1; j < 8; ++j) if (fe[j] > m1) { m1 = fe[j]; i1 = j; }
            int i2 = -1; float m2 = -3.0e38f;
#pragma unroll
            for (int j = 0; j < 8; ++j) if (j != i1 && fe[j] > m2) { m2 = fe[j]; i2 = j; }
            const float p2 = expf(m2 - m1), den = 1.0f / (1.0f + p2);
            int* ex = WSP(int, WS_EXP); float* gt = WSP(float, WS_GATE);
            const int e1 = grp * 8 + i1, e2 = grp * 8 + i2;
            ex[2 * t] = e1; ex[2 * t + 1] = e2; gt[2 * t] = pg_sel * den; gt[2 * t + 1] = pg_sel * p2 * den;
            atomicAdd((unsigned*)(F.ctl + CW_CNT) + e1, 1u); atomicAdd((unsigned*)(F.ctl + CW_CNT) + e2, 1u);
        }
        __syncthreads();
    }
}

#define XB_TMO      128
#define XB_XCNT(j)  (256  + 64 * (j))
#define XB_XSUB(j)  (1280 + 64 * (j))
#define XB_XGEN(j)  (2304 + 64 * (j))
#define XB_TOP      3328
#define XB_TOPGEN   3392
#define XCD_BAR_WORDS 3456
#define XB_SPIN_CAP (1u << 22)
__device__ __forceinline__ unsigned xb_ld(unsigned* p)              { return __hip_atomic_load(p, __ATOMIC_RELAXED, __HIP_MEMORY_SCOPE_AGENT); }
__device__ __forceinline__ unsigned xb_add(unsigned* p, unsigned v) { return __hip_atomic_fetch_add(p, v, __ATOMIC_RELAXED, __HIP_MEMORY_SCOPE_AGENT); }
__device__ __forceinline__ unsigned xb_xcc_id() { return (unsigned)__builtin_amdgcn_s_getreg((3 << 11) | 20) & 0xFu; }
#define XB_SPIN(cond, bar) do { unsigned _sp = 0; while (cond) { __builtin_amdgcn_s_sleep(1); \
    if ((++_sp & 255u) == 0u) { if (xb_ld(&(bar)[XB_TMO])) break; if (_sp > XB_SPIN_CAP) { atomicAdd(&(bar)[XB_TMO], 1u); break; } } } } while (0)
struct XcdBarrier { unsigned* bar; unsigned x; volatile LAS unsigned* st; };
__device__ __forceinline__ XcdBarrier xcd_barrier_post(unsigned* bar, volatile LAS unsigned* st) {
    XcdBarrier b; b.bar = bar; b.x = xb_xcc_id(); b.st = st;
    if (threadIdx.x == 0) (void)xb_add(&bar[XB_XCNT(b.x)], 1u);
    return b;
}
__device__ __forceinline__ void xcd_barrier_complete(unsigned* bar, unsigned x, unsigned& nloc, unsigned& nx) {
    const unsigned G = gridDim.x * gridDim.y * gridDim.z;
    unsigned sum, cnt, mine, sp = 0u;
    for (;;) {
        sum = 0u; cnt = 0u; mine = 0u;
#pragma unroll
        for (unsigned j = 0; j < 16; ++j) { const unsigned c = xb_ld(&bar[XB_XCNT(j)]); sum += c; cnt += (c > 0u) ? 1u : 0u; mine = (j == x) ? c : mine; }
        if (sum == G) break;
        __builtin_amdgcn_s_sleep(1);
        if ((++sp & 255u) == 0u) { if (xb_ld(&bar[XB_TMO])) break; if (sp > XB_SPIN_CAP) { atomicAdd(&bar[XB_TMO], 1u); break; } }
    }
    nloc = mine > 0u ? mine : 1u; nx = cnt > 0u ? cnt : 1u;
}
__device__ __forceinline__ void xcd_barrier(const XcdBarrier& b) {
    asm volatile("s_waitcnt vmcnt(0)" ::: "memory");
    __syncthreads();
    if (threadIdx.x == 0) {
        unsigned* bar = b.bar;
        __builtin_amdgcn_s_waitcnt(0);
        unsigned nloc = b.st[0], nx = b.st[1];
        if (nloc == 0u) { xcd_barrier_complete(bar, b.x, nloc, nx); b.st[0] = nloc; b.st[1] = nx; }
        const unsigned old = xb_add(&bar[XB_XSUB(b.x)], 1u);
        const unsigned gen = old / nloc;
        if (old + 1u == (gen + 1u) * nloc) {
            __builtin_amdgcn_fence(__ATOMIC_RELEASE, "agent");
            asm volatile("s_waitcnt vmcnt(0)" ::: "memory");
            const unsigned og = xb_add(&bar[XB_TOP], 1u);
            const unsigned tg = og / nx;
            if (og + 1u == (tg + 1u) * nx) xb_add(&bar[XB_TOPGEN], 1u);
            else XB_SPIN(xb_ld(&bar[XB_TOPGEN]) == tg, bar);
            __builtin_amdgcn_fence(__ATOMIC_ACQUIRE, "agent");
            xb_add(&bar[XB_XGEN(b.x)], 1u);
            asm volatile("s_waitcnt vmcnt(0)" ::: "memory");
        } else {
            XB_SPIN(xb_ld(&bar[XB_XGEN(b.x)]) == gen, bar);
            __builtin_amdgcn_fence(__ATOMIC_ACQUIRE, "agent");
            asm volatile("s_waitcnt vmcnt(0)" ::: "memory");
        }
    }
    __syncthreads();
}

struct Args { const float* in[25]; float* out; unsigned char* ws; int ph_lo, ph_hi, use_bar, pad; };
__global__ void __launch_bounds__(NTHR, 2) mega(Args args) {
    extern __shared__ __attribute__((aligned(16))) unsigned char lds[];
    Frame F;
    F.lds = (LAS unsigned char*)lds;
    F.MISC = (volatile LAS unsigned*)(F.lds + MISC_OFF);
    F.tid = threadIdx.x; F.lane = F.tid & 63; F.wave = __builtin_amdgcn_readfirstlane(F.tid >> 6);
    F.G = gridDim.x; F.bid = blockIdx.x;
    F.ws = args.ws; F.ctl = (gu32*)(args.ws + WS_CTL);
#pragma unroll
    for (int i = 0; i < 25; ++i) F.in[i] = args.in[i];
    F.out = args.out;
    for (int u = F.tid; u < (LDS_BYTES - LDSCTL_OFF) / 4; u += NTHR) ((LAS unsigned*)(F.lds + LDSCTL_OFF))[u] = 0u;
    __syncthreads();
    LAS int* ts = (LAS int*)(F.lds + MISC_OFF + 64);
    XcdBarrier bar; bar.bar = (unsigned*)(F.ctl + CW_BAR); bar.x = 0; bar.st = nullptr;
    if (args.use_bar) bar = xcd_barrier_post((unsigned*)(F.ctl + CW_BAR), F.MISC + 8);
    const int lo = args.ph_lo, hi = args.ph_hi;
#define IN(k) (lo <= (k) && (k) < hi)
#define REPS(k) for (int _r = 0; _r < ((k) == PROBE_PH ? PROBE_N : 1); ++_r)
#define SEAM(k) do { if (IN(k) && IN((k) + 1)) { if (MK_CG_SYNC && (k) == 0) cooperative_groups::this_grid().sync(); else xcd_barrier(bar); } } while (0)

    if (IN(0)) { REPS(0) p0_prologue(F); SEAM(0); }
    if (IN(1)) {
        p1_bcum(F);
        pg8::Gemm g{WSP(pg8::bf16_t, WS_XB), WSP(pg8::bf16_t, WS_WIN), T + MEMN, HW + 4096, D}; pg8::OrderG1 S; S.init(F.G, F.bid);
        pg8::EpiH E{WSP(pg8::bf16_t, WS_H), WSP(pg8::bf16_t, WS_KVM), WSP(float, WS_RC), WSP(float, WS_RS)};
        REPS(1) pg8::gemm_phase<pg8::EpiH, pg8::OrderG1, true, true>(F.lds, g, S, E);
        SEAM(1);
    }
    if (IN(2)) { REPS(2) p2_kv(F); SEAM(2); }
    if (IN(3)) { p3_scan(F); SEAM(3); }
    if (IN(4)) { REPS(4) p4_out(F); SEAM(4); }
    if (IN(5)) {
        pg8::Gemm g{WSP(pg8::bf16_t, WS_MIXED), WSP(pg8::bf16_t, WS_WMIX), T, D, D}; pg8::StaticOrder S; S.init(T, D, F.G, F.bid);
        pg8::EpiResX E{F.in[0], WSP(float, WS_Y1), ALPHA};
        REPS(5) pg8::gemm_phase<pg8::EpiResX, pg8::StaticOrder, true, true>(F.lds, g, S, E);
        SEAM(5);
    }
    if (IN(6)) { REPS(6) ln_apply<false>(F, WSP(float, WS_Y1), F.in[8], F.in[9], WSP(bf16, WS_H1B), WSP(float, WS_ST1)); SEAM(6); }
    if (IN(7)) {
        pg8::Gemm g{WSP(pg8::bf16_t, WS_H1B), WSP(pg8::bf16_t, WS_WMQ), T, D, D}; pg8::StaticOrder S; S.init(T, D, F.G, F.bid);
        pg8::EpiB E{WSP(pg8::bf16_t, WS_QB), D, -1};
        REPS(7) pg8::gemm_phase<pg8::EpiB, pg8::StaticOrder, true, true>(F.lds, g, S, E);
        SEAM(7);
    }
    if (IN(8)) { REPS(8) p8_attn(F); SEAM(8); }
    if (IN(9)) {
        pg8::Gemm g{WSP(pg8::bf16_t, WS_ATT), WSP(pg8::bf16_t, WS_WMO), T, D, D}; pg8::StaticOrder S; S.init(T, D, F.G, F.bid);
        pg8::EpiResLN E{WSP(float, WS_Y1), WSP(float, WS_ST1), F.in[8], F.in[9], WSP(float, WS_Y2), ALPHA};
        REPS(9) pg8::gemm_phase<pg8::EpiResLN, pg8::StaticOrder, true, true>(F.lds, g, S, E);
        SEAM(9);
    }
    if (IN(10)) { p10_ln_router(F); SEAM(10); }
    if (IN(11)) { moe_tile_starts(F, ts); p10_dispatch(F, ts); SEAM(11); }
    if (IN(12)) {
        moe_tile_starts(F, ts);
        pg8::Gemm g{WSP(pg8::bf16_t, WS_XS), WSP(pg8::bf16_t, WS_WGU), PMAX, 32 * 1024, D};
        pg8::MoeOrder S{(const PG8_LAS int*)ts, F.G, F.bid, 4, ts[32] * 4};
        pg8::EpiSwi E{WSP(pg8::bf16_t, WS_HID)};
        REPS(12) pg8::gemm_phase<pg8::EpiSwi, pg8::MoeOrder, true, true>(F.lds, g, S, E);
        SEAM(12);
    }
    if (IN(13)) {
        moe_tile_starts(F, ts);
        pg8::Gemm g{WSP(pg8::bf16_t, WS_HID), WSP(pg8::bf16_t, WS_WD), PMAX, 32 * 2048, 512};
        pg8::MoeOrder S{(const PG8_LAS int*)ts, F.G, F.bid, 8, ts[32] * 8};
        pg8::EpiB E{WSP(pg8::bf16_t, WS_YS), D, 7};
        REPS(13) pg8::gemm_phase<pg8::EpiB, pg8::MoeOrder, true, true>(F.lds, g, S, E);
        SEAM(13);
    }
    if (IN(14)) { REPS(14) p13_combine(F); }
#undef IN
#undef SEAM
#undef REPS
}

extern "C" void kernel_launch(void* const* d_in, const int* in_sizes, int n_in, void* d_out, int out_size, void* d_ws, size_t ws_size, hipStream_t stream) {
    static int grid = 0;
    if (grid == 0) {
        if (n_in != 25 || in_sizes[0] != T * D || out_size != T * D || ws_size < WS_END) { fprintf(stderr, "kernel_launch: unexpected shapes / workspace (%d inputs, ws %zu)\n", n_in, ws_size); grid = -1; return; }
        int dev = 0, cus = 0;
        if (hipGetDevice(&dev) != hipSuccess || hipDeviceGetAttribute(&cus, hipDeviceAttributeMultiprocessorCount, dev) != hipSuccess) { grid = -1; return; }
        if (hipFuncSetAttribute((const void*)mega, hipFuncAttributeMaxDynamicSharedMemorySize, LDS_BYTES) != hipSuccess) { fprintf(stderr, "kernel_launch: hipFuncSetAttribute failed\n"); grid = -1; return; }
        int per_cu = 0;
        if (hipOccupancyMaxActiveBlocksPerMultiprocessor(&per_cu, (const void*)mega, NTHR, LDS_BYTES) != hipSuccess || per_cu < 1) { fprintf(stderr, "kernel_launch: occupancy query failed / 0 blocks per CU\n"); grid = -1; return; }
        (void)hipGetLastError();
        grid = cus;
    }
    if (grid < 0) return;
    if (hipMemsetAsync((char*)d_ws + WS_CTL, 0, CTL_ZERO_BYTES, stream) != hipSuccess) return;
    Args a{};
    for (int i = 0; i < 25; ++i) a.in[i] = (const float*)d_in[i];
    a.out = (float*)d_out; a.ws = (unsigned char*)d_ws;
#if MK_ONE_LAUNCH
    a.ph_lo = 0; a.ph_hi = NPH; a.use_bar = 1;
#if MK_CG_SYNC
    { void* kargs[] = {(void*)&a};
      hipError_t e = hipLaunchCooperativeKernel((const void*)mega, dim3(grid), dim3(NTHR), kargs, LDS_BYTES, stream);
      if (e != hipSuccess) fprintf(stderr, "cooperative launch failed: %s (grid %d)\n", hipGetErrorString(e), grid); }
#else
    hipLaunchKernelGGL(mega, dim3(grid), dim3(NTHR), LDS_BYTES, stream, a);
#endif
#else
    for (int p = 0; p < NPH; ++p) { a.ph_lo = p; a.ph_hi = p + 1; a.use_bar = 0;
        hipLaunchKernelGGL(mega, dim3(grid), dim3(NTHR), LDS_BYTES, stream, a); }
#endif
}
```

```cpp
#include <hip/hip_runtime.h>
#include <hip/hip_cooperative_groups.h>
#include <cstdio>
#include <cstdint>
#include <cmath>
#ifndef MK_ONE_LAUNCH
#define MK_ONE_LAUNCH 1
#endif
#ifndef MK_CG_SYNC
#define MK_CG_SYNC 2
#endif
#define PROBE_PH -1
#define PROBE_N 1
namespace pg8 {
#define PG8_LAS __attribute__((address_space(3)))
typedef unsigned short bf16_t;
typedef short bf16x8 __attribute__((ext_vector_type(8)));
typedef float f32x4 __attribute__((ext_vector_type(4)));
typedef unsigned u32x4 __attribute__((ext_vector_type(4)));
constexpr int BM = 256, BK = 64, HALF = 128, HTB = HALF * BK * 2  , STAGE_BYTES = 8 * HTB, NXCD = 8, WGM = 8;

__host__ __device__ __forceinline__ int lds_byte(int r, int c) { const int st = (r >> 4) * 2 + (c >> 5), rr = r & 15, cc = c & 31, ob = rr * 64 + cc * 2; return st * 1024 + (ob ^ (((ob >> 9) & 1) << 5)); }
__host__ __device__ __forceinline__ void stage_rc(int b, int& R, int& C) { const int st = b / 1024, sb = b % 1024, swz = sb ^ (((sb >> 9) & 1) << 5); R = (st >> 1) * 16 + swz / 64; C = (st & 1) * 32 + (swz % 64) / 2; }
__host__ __device__ __forceinline__ int perm32(int rho) { const int n = rho >> 4, i = rho & 15; return 8 * (i >> 2) + 4 * n + (i & 3); }

struct Unit { int pm, pn; };
struct Gemm { const bf16_t* A; const bf16_t* Bt; int M, N, K; };

struct StaticOrder {
    int nM, nN, nwg, G, c;
    __host__ __device__ void init(int M, int N, int G_, int c_) { nM = M / BM; nN = N / BM; nwg = nM * nN; G = G_; c = c_; }
    __host__ __device__ bool next(int i, Unit& u) const {
        const long L = (long)i * G + c; if (L >= nwg) return false;
        int wgid = (int)L; { const int q = nwg / NXCD, r = nwg % NXCD, xcd = wgid % NXCD, off = wgid / NXCD; wgid = (xcd < r ? xcd * (q + 1) : r * (q + 1) + (xcd - r) * q) + off; }
        const int nig = WGM * nN, gid = wgid / nig, fm = gid * WGM, gsz = (nM - fm) < WGM ? (nM - fm) : WGM;
        u.pm = fm + ((wgid % nig) % gsz); u.pn = (wgid % nig) / gsz; return true;
    }
    __device__ __forceinline__ void a_ready(const Unit&) const {}
    __device__ __forceinline__ void done(const Unit&) const {}
};


__device__ __forceinline__ unsigned cvt_pk_bf16(float lo, float hi) { unsigned r; asm volatile("v_cvt_pk_bf16_f32 %0, %1, %2" : "=v"(r) : "v"(lo), "v"(hi)); return r; }
__device__ __forceinline__ u32x4 pack8(const f32x4 a, const f32x4 b) { u32x4 w; w.x = cvt_pk_bf16(a[0], a[1]); w.y = cvt_pk_bf16(a[2], a[3]); w.z = cvt_pk_bf16(b[0], b[1]); w.w = cvt_pk_bf16(b[2], b[3]); return w; }
__device__ __forceinline__ float silu_f(float x) { return x * __builtin_amdgcn_rcpf(1.0f + __builtin_amdgcn_exp2f(-1.4426950408889634f * x)); }

struct EpiH {
    static constexpr bool PERM = true, AFTER_DRAIN = false;
    bf16_t* H; bf16_t* KVM; const float* rc; const float* rs;
    __device__ __forceinline__ void operator()(const f32x4 (&acc)[2][2][4][2], const Unit& u, int wr, int wc, int fr, int fq) const {
        const int cb = wc * 32 + 8 * fq;
        if (u.pm >= 32) {
#pragma unroll
            for (int ai = 0; ai < 2; ++ai)
#pragma unroll
                for (int m = 0; m < 4; ++m) { bf16_t* rowp = KVM + (size_t)(wr * 64 + fr + ai * HALF + m * 16) * 4096 + (u.pn - 28) * BM + cb;
#pragma unroll
                    for (int bj = 0; bj < 2; ++bj) *(u32x4*)(rowp + bj * HALF) = pack8(acc[ai][bj][m][0], acc[ai][bj][m][1]); }
            return;
        }
        const int row0 = u.pm * BM + wr * 64 + fr;
        if (u.pn < 8) {
            const float sc = u.pn >= 4 ? 0.0625f : 1.0f;
#pragma unroll
            for (int ai = 0; ai < 2; ++ai)
#pragma unroll
                for (int m = 0; m < 4; ++m) { const int row = row0 + ai * HALF + m * 16;
                    const float* cr = rc + (size_t)row * 128 + cb; const float* sr = rs + (size_t)row * 128 + cb;
                    const f32x4 c0 = *(const f32x4*)cr * sc, c1 = *(const f32x4*)(cr + 4) * sc, s0 = *(const f32x4*)sr * sc, s1 = *(const f32x4*)(sr + 4) * sc;
                    const f32x4 t1a = acc[ai][0][m][0], t1b = acc[ai][0][m][1], t2a = acc[ai][1][m][0], t2b = acc[ai][1][m][1];
                    bf16_t* rowp = H + (size_t)row * 7168 + u.pn * BM + cb;
                    *(u32x4*)(rowp) = pack8(t1a * c0 - t2a * s0, t1b * c1 - t2b * s1);
                    *(u32x4*)(rowp + HALF) = pack8(t1a * s0 + t2a * c0, t1b * s1 + t2b * c1); }
        } else {
            const float sc = (u.pn == 16 || u.pn == 17) ? 0.08838834764831845f : 1.0f;
#pragma unroll
            for (int ai = 0; ai < 2; ++ai)
#pragma unroll
                for (int m = 0; m < 4; ++m) { bf16_t* rowp = H + (size_t)(row0 + ai * HALF + m * 16) * 7168 + u.pn * BM + cb;
#pragma unroll
                    for (int bj = 0; bj < 2; ++bj) *(u32x4*)(rowp + bj * HALF) = pack8(acc[ai][bj][m][0] * sc, acc[ai][bj][m][1] * sc); }
        }
    }
};
struct EpiB {
    static constexpr bool PERM = true, AFTER_DRAIN = false;
    bf16_t* O; int ldc; int pmask;
    __device__ __forceinline__ void operator()(const f32x4 (&acc)[2][2][4][2], const Unit& u, int wr, int wc, int fr, int fq) const {
        const int row0 = u.pm * BM + wr * 64 + fr, col0 = (u.pn & pmask) * BM + wc * 32 + 8 * fq;
#pragma unroll
        for (int ai = 0; ai < 2; ++ai)
#pragma unroll
            for (int m = 0; m < 4; ++m) { bf16_t* rowp = O + (size_t)(row0 + ai * HALF + m * 16) * ldc + col0;
#pragma unroll
                for (int bj = 0; bj < 2; ++bj) *(u32x4*)(rowp + bj * HALF) = pack8(acc[ai][bj][m][0], acc[ai][bj][m][1]); }
    }
};
struct EpiSwi {
    static constexpr bool PERM = true, AFTER_DRAIN = false;
    bf16_t* O;
    __device__ __forceinline__ void operator()(const f32x4 (&acc)[2][2][4][2], const Unit& u, int wr, int wc, int fr, int fq) const {
        const int row0 = u.pm * BM + wr * 64 + fr, col0 = (u.pn & 3) * HALF + wc * 32 + 8 * fq;
#pragma unroll
        for (int ai = 0; ai < 2; ++ai)
#pragma unroll
            for (int m = 0; m < 4; ++m) { bf16_t* rowp = O + (size_t)(row0 + ai * HALF + m * 16) * 512 + col0;
                f32x4 h0, h1;
#pragma unroll
                for (int i = 0; i < 4; ++i) { h0[i] = silu_f(acc[ai][0][m][0][i]) * acc[ai][1][m][0][i]; h1[i] = silu_f(acc[ai][0][m][1][i]) * acc[ai][1][m][1][i]; }
                *(u32x4*)rowp = pack8(h0, h1); }
    }
};
struct EpiResX {
    static constexpr bool PERM = false, AFTER_DRAIN = false;
    const float* X; float* Y; float alpha;
    __device__ __forceinline__ void operator()(const f32x4 (&acc)[2][2][4][2], const Unit& u, int wr, int wc, int fr, int fq) const {
        const int row0 = u.pm * BM + wr * 64 + fr, col0 = u.pn * BM + wc * 32 + 4 * fq;
#pragma unroll
        for (int ai = 0; ai < 2; ++ai)
#pragma unroll
            for (int m = 0; m < 4; ++m) { const size_t off = (size_t)(row0 + ai * HALF + m * 16) * 2048 + col0;
#pragma unroll
                for (int bj = 0; bj < 2; ++bj)
#pragma unroll
                    for (int n = 0; n < 2; ++n) { const f32x4 xv = *(const f32x4*)(X + off + bj * HALF + n * 16); *(f32x4*)(Y + off + bj * HALF + n * 16) = xv * alpha + acc[ai][bj][m][n]; } }
    }
};
struct EpiResLN {
    static constexpr bool PERM = false, AFTER_DRAIN = false;
    const float* Yin; const float* st; const float* g; const float* b; float* Y; float alpha;
    __device__ __forceinline__ void operator()(const f32x4 (&acc)[2][2][4][2], const Unit& u, int wr, int wc, int fr, int fq) const {
        const int row0 = u.pm * BM + wr * 64 + fr, col0 = u.pn * BM + wc * 32 + 4 * fq;
        f32x4 gv[2][2], bv[2][2];
#pragma unroll
        for (int bj = 0; bj < 2; ++bj)
#pragma unroll
            for (int n = 0; n < 2; ++n) { gv[bj][n] = *(const f32x4*)(g + col0 + bj * HALF + n * 16) * alpha; bv[bj][n] = *(const f32x4*)(b + col0 + bj * HALF + n * 16) * alpha; }
#pragma unroll
        for (int ai = 0; ai < 2; ++ai)
#pragma unroll
            for (int m = 0; m < 4; ++m) { const int row = row0 + ai * HALF + m * 16; const size_t off = (size_t)row * 2048 + col0;
                const float mu = st[2 * row], rstd = st[2 * row + 1];
#pragma unroll
                for (int bj = 0; bj < 2; ++bj)
#pragma unroll
                    for (int n = 0; n < 2; ++n) { const f32x4 yv = *(const f32x4*)(Yin + off + bj * HALF + n * 16);
                        *(f32x4*)(Y + off + bj * HALF + n * 16) = ((yv - mu) * rstd) * gv[bj][n] + bv[bj][n] + acc[ai][bj][m][n]; } }
    }
};

struct OrderG1 {
    StaticOrder so; int G, c;
    __device__ void init(int G_, int c_) { so.init(8192, 7168, G_, c_); G = G_; c = c_; }
    __device__ bool next(int i, Unit& u) const {
        const int L = i * G + c;
        if (L < 896) return so.next(i, u);
        if (L >= 912) return false;
        u.pm = 32; u.pn = 28 + (L - 896); return true;
    }
    __device__ __forceinline__ void a_ready(const Unit&) const {}
    __device__ __forceinline__ void done(const Unit&) const {}
};
struct MoeOrder {
    const PG8_LAS int* ts; int G, c, npn, total;
    __device__ bool next(int i, Unit& u) const {
        const int L = i * G + c; if (L >= total) return false;
        const int rt = L / npn, pl = L - rt * npn; int e = 0;
        for (int j = 1; j < 32; ++j) e += (ts[j] <= rt) ? 1 : 0;
        u.pm = rt; u.pn = e * npn + pl; return true;
    }
    __device__ __forceinline__ void a_ready(const Unit&) const {}
    __device__ __forceinline__ void done(const Unit&) const {}
};

template <class Epi, class Sched, bool ALIGN_EPI = false, bool SP2 = false>
__device__ __forceinline__ void gemm_phase(PG8_LAS unsigned char* lds, const Gemm g, const Sched& S, const Epi& E) {
    const int tid = threadIdx.x, wid = __builtin_amdgcn_readfirstlane(tid >> 6), lane = tid & 63, wr = wid >> 2, wc = wid & 3, fr = lane & 15, fq = lane >> 4;
    const int K = g.K, nt = K / BK;
    unsigned voffA[2], voffB[2];
#pragma unroll
    for (int i = 0; i < 2; ++i) { int R, C; stage_rc(tid * 16 + i * 8192, R, C); const int Rb = Epi::PERM ? ((R & ~31) + perm32(R & 31)) : R;
        voffA[i] = (unsigned)(R * K + C) * 2u; voffB[i] = (unsigned)(Rb * K + C) * 2u; }
    const size_t kstep = (size_t)(BK * 2);
    const size_t hstep = (size_t)HALF * K * 2;
    const size_t tstep = 2 * hstep;
    const unsigned ldsw = (unsigned)wid * 1024u;
    const int aoff = lds_byte(wr * 64 + fr, fq * 8), boff = lds_byte(wc * 32 + fr, fq * 8);
#define PG8_SA(b, h) (((b) * 2 + (h)) * HTB)
#define PG8_SB(b, h) ((4 + (b) * 2 + (h)) * HTB)
#define PG8_STAGE(bufoff, gbase, voff) do { _Pragma("unroll") for (int _i = 0; _i < 2; ++_i) \
        __builtin_amdgcn_global_load_lds((const unsigned*)((const char*)(gbase) + (voff)[_i]), (PG8_LAS unsigned*)(lds + (bufoff) + ldsw + _i * 8192), 16, 0, 0); } while (0)
#define PG8_LDA(dst, b, h) do { _Pragma("unroll") for (int m = 0; m < 4; ++m) _Pragma("unroll") for (int k = 0; k < 2; ++k) dst[m][k] = *(const PG8_LAS bf16x8*)(lds + PG8_SA(b, h) + aoff + m * 2048 + k * 1024); } while (0)
#define PG8_LDB(dst, b, h) do { _Pragma("unroll") for (int n = 0; n < 2; ++n) _Pragma("unroll") for (int k = 0; k < 2; ++k) dst[n][k] = *(const PG8_LAS bf16x8*)(lds + PG8_SB(b, h) + boff + n * 2048 + k * 1024); } while (0)
#define PG8_MMA(ai, bj, At, Bt) do { __builtin_amdgcn_s_setprio(1); _Pragma("unroll") for (int m = 0; m < 4; ++m) _Pragma("unroll") for (int n = 0; n < 2; ++n) _Pragma("unroll") for (int k = 0; k < 2; ++k) \
        acc[ai][bj][m][n] = __builtin_amdgcn_mfma_f32_16x16x32_bf16(Bt[n][k], At[m][k], acc[ai][bj][m][n], 0, 0, 0); __builtin_amdgcn_s_setprio(0); } while (0)
#define PG8_WAIT_V(n) asm volatile("s_waitcnt vmcnt(" #n ")" ::: "memory")
#define PG8_WAIT_L(n) asm volatile("s_waitcnt lgkmcnt(" #n ")" ::: "memory")
#define PG8_BAR __builtin_amdgcn_s_barrier()
#define PG8_SCHED __builtin_amdgcn_sched_barrier(0)
    Unit cur, nxt; int ui = 0;
    if (!S.next(0, cur)) return;
    f32x4 acc[2][2][4][2];
#pragma unroll
    for (int a = 0; a < 2; ++a)
#pragma unroll
        for (int b = 0; b < 2; ++b)
#pragma unroll
            for (int m = 0; m < 4; ++m)
#pragma unroll
                for (int n = 0; n < 2; ++n) acc[a][b][m][n] = (f32x4){0.f, 0.f, 0.f, 0.f};
    bf16x8 At[4][2], B0[2][2], B1[2][2];
    const char* cA = (const char*)g.A + (size_t)cur.pm * tstep; const char* cB = (const char*)g.Bt + (size_t)cur.pn * tstep;
    S.a_ready(cur);
    if constexpr (SP2) {
        PG8_STAGE(PG8_SB(0, 0), cB, voffB); PG8_STAGE(PG8_SB(0, 1), cB + hstep, voffB); PG8_STAGE(PG8_SA(0, 0), cA, voffA); PG8_STAGE(PG8_SA(0, 1), cA + hstep, voffA);
        if (wr == 1) PG8_BAR;
        PG8_WAIT_V(2); PG8_BAR;
        PG8_STAGE(PG8_SB(1, 0), cB + kstep, voffB); PG8_STAGE(PG8_SA(1, 0), cA + kstep, voffA); PG8_STAGE(PG8_SB(1, 1), cB + hstep + kstep, voffB);
        PG8_WAIT_V(6); PG8_BAR;
    } else {
        PG8_STAGE(PG8_SB(0, 0), cB, voffB); PG8_STAGE(PG8_SA(0, 0), cA, voffA); PG8_STAGE(PG8_SB(0, 1), cB + hstep, voffB); PG8_STAGE(PG8_SA(0, 1), cA + hstep, voffA);
        if (wr == 1) PG8_BAR;
        PG8_WAIT_V(4); PG8_BAR;
        PG8_STAGE(PG8_SB(1, 0), cB + kstep, voffB); PG8_STAGE(PG8_SA(1, 0), cA + kstep, voffA); PG8_STAGE(PG8_SB(1, 1), cB + hstep + kstep, voffB);
        PG8_WAIT_V(6); PG8_BAR;
    }
    for (;;) {
        const bool has_next = S.next(ui + 1, nxt);
        const char* nA = has_next ? (const char*)g.A + (size_t)nxt.pm * tstep : cA; const char* nB = has_next ? (const char*)g.Bt + (size_t)nxt.pn * tstep : cB;
        for (int t = 0; t < nt; t += 2) {
            const bool last = (t == nt - 2);
            const char* a1 = cA + (size_t)(t + 1) * kstep;
            const char* a2 = last ? nA : cA + (size_t)(t + 2) * kstep; const char* b2 = last ? nB : cB + (size_t)(t + 2) * kstep;
            const char* a3 = a2 + kstep; const char* b3 = b2 + kstep;
            if (last && has_next) S.a_ready(nxt);
            if constexpr (SP2) {
            PG8_LDB(B0, 0, 0); PG8_LDB(B1, 0, 1); PG8_SCHED; PG8_LDA(At, 0, 0); PG8_STAGE(PG8_SA(1, 1), a1 + hstep, voffA);
            PG8_WAIT_V(8); PG8_WAIT_L(0); PG8_BAR; PG8_MMA(0, 0, At, B0); PG8_MMA(0, 1, At, B1); PG8_BAR; PG8_SCHED;
            PG8_LDA(At, 0, 1); PG8_STAGE(PG8_SB(0, 0), b2, voffB); PG8_STAGE(PG8_SB(0, 1), b2 + hstep, voffB); PG8_STAGE(PG8_SA(0, 0), a2, voffA);
            PG8_WAIT_V(8); PG8_WAIT_L(0); PG8_BAR; PG8_MMA(1, 0, At, B0); PG8_MMA(1, 1, At, B1); PG8_BAR; PG8_SCHED;
            PG8_LDB(B0, 1, 0); PG8_LDB(B1, 1, 1); PG8_SCHED; PG8_LDA(At, 1, 0); PG8_STAGE(PG8_SA(0, 1), a2 + hstep, voffA);
            PG8_WAIT_V(8); PG8_WAIT_L(0); PG8_BAR; PG8_MMA(0, 0, At, B0); PG8_MMA(0, 1, At, B1); PG8_BAR; PG8_SCHED;
            PG8_LDA(At, 1, 1); PG8_STAGE(PG8_SB(1, 0), b3, voffB); PG8_STAGE(PG8_SB(1, 1), b3 + hstep, voffB); PG8_STAGE(PG8_SA(1, 0), a3, voffA);
            PG8_WAIT_V(8); PG8_WAIT_L(0); PG8_BAR; PG8_MMA(1, 0, At, B0); PG8_MMA(1, 1, At, B1); PG8_BAR; PG8_SCHED;
            } else {
            PG8_LDB(B0, 0, 0); PG8_SCHED; PG8_LDA(At, 0, 0); PG8_STAGE(PG8_SA(1, 1), a1 + hstep, voffA);
            PG8_WAIT_L(8); PG8_BAR; PG8_WAIT_L(0); PG8_MMA(0, 0, At, B0); PG8_BAR; PG8_SCHED;
            PG8_LDB(B1, 0, 1); PG8_STAGE(PG8_SB(0, 0), b2, voffB);
            PG8_BAR; PG8_WAIT_L(0); PG8_MMA(0, 1, At, B1); PG8_BAR;
            PG8_LDA(At, 0, 1); PG8_STAGE(PG8_SA(0, 0), a2, voffA);
            PG8_BAR; PG8_WAIT_L(0); PG8_MMA(1, 0, At, B0); PG8_BAR; PG8_SCHED;
            PG8_STAGE(PG8_SB(0, 1), b2 + hstep, voffB);
            PG8_WAIT_V(6); PG8_BAR; PG8_MMA(1, 1, At, B1); PG8_BAR;
            PG8_LDB(B0, 1, 0); PG8_SCHED; PG8_LDA(At, 1, 0); PG8_STAGE(PG8_SA(0, 1), a2 + hstep, voffA);
            PG8_WAIT_L(8); PG8_BAR; PG8_WAIT_L(0); PG8_MMA(0, 0, At, B0); PG8_BAR; PG8_SCHED;
            PG8_LDB(B1, 1, 1); PG8_STAGE(PG8_SB(1, 0), b3, voffB);
            PG8_BAR; PG8_WAIT_L(0); PG8_MMA(0, 1, At, B1); PG8_BAR;
            PG8_LDA(At, 1, 1); PG8_STAGE(PG8_SA(1, 0), a3, voffA);
            PG8_BAR; PG8_WAIT_L(0); PG8_MMA(1, 0, At, B0); PG8_BAR; PG8_SCHED;
            PG8_STAGE(PG8_SB(1, 1), b3 + hstep, voffB);
            PG8_WAIT_V(6); PG8_BAR; PG8_MMA(1, 1, At, B1); PG8_BAR;
            }
        }
        if constexpr (ALIGN_EPI) { if (wr == 0) PG8_BAR; }
        if constexpr (!Epi::AFTER_DRAIN) { E(acc, cur, wr, wc, fr, fq); S.done(cur); }
        if (!has_next) break;
#pragma unroll
        for (int a = 0; a < 2; ++a)
#pragma unroll
            for (int b = 0; b < 2; ++b)
#pragma unroll
                for (int m = 0; m < 4; ++m)
#pragma unroll
                    for (int n = 0; n < 2; ++n) acc[a][b][m][n] = (f32x4){0.f, 0.f, 0.f, 0.f};
        cur = nxt; cA = nA; cB = nB; ++ui;
        if constexpr (ALIGN_EPI) { if (wr == 1) PG8_BAR; }
    }
    PG8_WAIT_V(0);
    if constexpr (!ALIGN_EPI) { if (wr == 0) PG8_BAR; }
    PG8_BAR;
    if constexpr (Epi::AFTER_DRAIN) { E.fused(acc, cur, wr, wc, fr, fq, lds, wid, lane); S.done(cur); }
#undef PG8_SA
#undef PG8_SB
#undef PG8_STAGE
#undef PG8_LDA
#undef PG8_LDB
#undef PG8_MMA
#undef PG8_WAIT_V
#undef PG8_WAIT_L
#undef PG8_BAR
#undef PG8_SCHED
}
}

constexpr int NWAVES = 8, NTHR = 512;
constexpr int T = 8192, D = 2048, HW = 7168, INW = 7184, MEMN = 256;
constexpr float LN_EPS = 1e-5f;
constexpr float ALPHA = 1.189207115002721f;
constexpr int NPH = 15;
constexpr int PMAX = 24576;

constexpr size_t MiB = 1u << 20;
constexpr size_t WS_CTL = 0, CTL_ZERO_BYTES = 1 * MiB;
constexpr size_t WS_WMIX = 2 * MiB, WS_WMQ = 10 * MiB, WS_WIN = 18 * MiB, WS_WKV = 46 * MiB, WS_WMO = 62 * MiB, WS_WGU = 70 * MiB, WS_WD = 198 * MiB;
constexpr size_t WS_XB = 262 * MiB, WS_MEMB = 294 * MiB;
constexpr size_t WS_H = 296 * MiB;
constexpr size_t WS_KVM = 408 * MiB;
constexpr size_t WS_ORAW = 410 * MiB;
constexpr size_t WS_MIXED = WS_XB;
constexpr size_t WS_Y1 = WS_ORAW;
constexpr size_t WS_H1B = WS_H;
constexpr size_t WS_QB = 328 * MiB, WS_ATT = 360 * MiB;
constexpr size_t WS_Y2 = 474 * MiB;
constexpr size_t WS_H2B = WS_H;
constexpr size_t WS_XS = 328 * MiB;
constexpr size_t WS_HID = 424 * MiB;
constexpr size_t WS_YS = WS_XS;
constexpr size_t WS_SMALL = 540 * MiB;
constexpr size_t WS_GLR = WS_SMALL;
constexpr size_t WS_RC = WS_SMALL + 1 * MiB, WS_RS = WS_SMALL + 5 * MiB;
constexpr size_t WS_ST1 = WS_SMALL + 9 * MiB, WS_ST2 = WS_ST1 + 65536;
constexpr size_t WS_EXP = WS_ST2 + 65536, WS_GATE = WS_EXP + 65536, WS_POS = WS_GATE + 65536;
constexpr size_t WS_END = 552 * MiB;
constexpr int CW_CNT = 64, CW_CUR = 128;
constexpr int CW_BAR = 4096;

constexpr int RING_BYTES = 131072, LDSCTL_OFF = RING_BYTES, MISC_OFF = LDSCTL_OFF + 320, LDS_BYTES = 147456;

#define GAS __attribute__((address_space(1)))
#define LAS __attribute__((address_space(3)))
typedef unsigned short bf16;
typedef unsigned v4u __attribute__((ext_vector_type(4)));
typedef unsigned v2u __attribute__((ext_vector_type(2)));
typedef float f32x4 __attribute__((ext_vector_type(4)));
typedef GAS unsigned gu32;
#define RLX_AGENT __ATOMIC_RELAXED, __HIP_MEMORY_SCOPE_AGENT
#define LDS_WAIT() asm volatile("s_waitcnt lgkmcnt(0)" ::: "memory")
__device__ __forceinline__ unsigned f2bf(float f) { unsigned u = __builtin_bit_cast(unsigned, f); return (u + 0x7fffu + ((u >> 16) & 1u)) >> 16; }
__device__ __forceinline__ unsigned pk2(float lo, float hi) { return f2bf(lo) | (f2bf(hi) << 16); }
__device__ __forceinline__ float bf2f(unsigned h) { return __builtin_bit_cast(float, h << 16); }
__device__ __forceinline__ float bflo(unsigned w) { return __builtin_bit_cast(float, w << 16); }
__device__ __forceinline__ float bfhi(unsigned w) { return __builtin_bit_cast(float, w & 0xffff0000u); }
__device__ __forceinline__ float wave_sum(float v) {
#pragma unroll
    for (int o = 1; o < 64; o <<= 1) v += __shfl_xor(v, o);
    return v;
}
__device__ __forceinline__ float wave_max(float v) {
#pragma unroll
    for (int o = 1; o < 64; o <<= 1) v = fmaxf(v, __shfl_xor(v, o));
    return v;
}

struct Frame {
    LAS unsigned char* lds;
    volatile LAS unsigned* MISC;
    gu32* ctl;
    int tid, lane, wave, G, bid;
    unsigned char* ws;
    const float* in[25];
    float* out;
};
#define WSP(T_, off) ((T_*)(F.ws + (off)))

__device__ __forceinline__ void transpose_item(const float* W, int ldw, bf16* WTr, int ldt, LAS float* scr, int lane) {
#pragma unroll 8
    for (int i = 0; i < 32; ++i) { const int kk = 2 * i + (lane >> 5); scr[kk * 33 + (lane & 31)] = W[(size_t)kk * ldw + (lane & 31)]; }
    LDS_WAIT(); asm volatile("" ::: "memory");
    const int c = lane & 7;
#pragma unroll
    for (int j = 0; j < 4; ++j) { const int n = (lane >> 3) + 8 * j; const LAS float* s = scr + (8 * c) * 33 + n;
        v4u o; o.x = pk2(s[0 * 33], s[1 * 33]); o.y = pk2(s[2 * 33], s[3 * 33]); o.z = pk2(s[4 * 33], s[5 * 33]); o.w = pk2(s[6 * 33], s[7 * 33]);
        *(GAS v4u*)(WTr + (size_t)n * ldt + 8 * c) = o; }
    LDS_WAIT(); asm volatile("" ::: "memory");
}
__device__ __forceinline__ void p0_prologue(Frame& F) {
    LAS float* scr = (LAS float*)(F.lds + F.wave * 16384);
    const int gw = F.bid * NWAVES + F.wave, NGW = F.G * NWAVES;
    const float* w_in = F.in[3];
    constexpr int I_IN = 32 * 224, I_SQ = 32 * 64, I_E = 512;
    constexpr int NIT = I_IN + 5 * I_SQ + 3 * 32 * I_E;
    for (int it = gw; it < NIT; it += NGW) {
        int r = it;
        if (r < I_IN) { const int kb = r / 224, nb = r % 224; transpose_item(w_in + (size_t)(64 * kb) * INW + 32 * nb, INW, WSP(bf16, WS_WIN) + (size_t)(32 * nb) * 2048 + 64 * kb, 2048, scr, F.lane); continue; }
        r -= I_IN;
        if (r < 5 * I_SQ) { const int w = r / I_SQ, q = r % I_SQ, kb = q / 64, nb = q % 64;
            const float* src = w == 0 ? F.in[7] : w == 1 ? F.in[10] : w == 2 ? F.in[11] : w == 3 ? F.in[12] : F.in[13];
            bf16* dst = w == 0 ? WSP(bf16, WS_WMIX) : w == 1 ? WSP(bf16, WS_WMQ) : w == 2 ? WSP(bf16, WS_WKV) : w == 3 ? (WSP(bf16, WS_WKV) + (size_t)2048 * 2048) : WSP(bf16, WS_WMO);
            transpose_item(src + (size_t)(64 * kb) * 2048 + 32 * nb, 2048, dst + (size_t)(32 * nb) * 2048 + 64 * kb, 2048, scr, F.lane); continue; }
        r -= 5 * I_SQ;
        if (r < 2 * 32 * I_E) {
            const int up = r / (32 * I_E), q = r % (32 * I_E), e = q / I_E, q2 = q % I_E, kb = q2 / 16, nb = q2 % 16, n0 = 32 * nb;
            const float* src = (up ? F.in[21] : F.in[20]) + (size_t)e * 2048 * 512 + (size_t)(64 * kb) * 512 + n0;
            bf16* dst = WSP(bf16, WS_WGU) + (size_t)(e * 1024 + (n0 >> 7) * 256 + up * 128 + (n0 & 127)) * 2048 + 64 * kb;
            transpose_item(src, 512, dst, 2048, scr, F.lane); continue; }
        r -= 2 * 32 * I_E;
        {
            const int e = r / I_E, q2 = r % I_E, kb = q2 / 64, nb = q2 % 64;
            const float* src = F.in[22] + (size_t)e * 512 * 2048 + (size_t)(64 * kb) * 2048 + 32 * nb;
            bf16* dst = WSP(bf16, WS_WD) + (size_t)(e * 2048 + 32 * nb) * 512 + 64 * kb;
            transpose_item(src, 2048, dst, 512, scr, F.lane); }
    }
    const int gt = F.bid * NTHR + F.tid, NGT = F.G * NTHR;
    {
        const float* x = F.in[0]; bf16* xb = WSP(bf16, WS_XB);
        for (int i = gt; i < T * D / 8; i += NGT) { const f32x4 a = *(const GAS f32x4*)(x + (size_t)i * 8), b = *(const GAS f32x4*)(x + (size_t)i * 8 + 4);
            v4u o; o.x = pk2(a[0], a[1]); o.y = pk2(a[2], a[3]); o.z = pk2(b[0], b[1]); o.w = pk2(b[2], b[3]); *(GAS v4u*)(xb + (size_t)i * 8) = o; }
        const float* mm = F.in[1]; bf16* mb = WSP(bf16, WS_MEMB);
        for (int i = gt; i < MEMN * D / 8; i += NGT) { const f32x4 a = *(const GAS f32x4*)(mm + (size_t)i * 8), b = *(const GAS f32x4*)(mm + (size_t)i * 8 + 4);
            v4u o; o.x = pk2(a[0], a[1]); o.y = pk2(a[2], a[3]); o.z = pk2(b[0], b[1]); o.w = pk2(b[2], b[3]); *(GAS v4u*)(mb + (size_t)i * 8) = o; }
    }
    {
        const int* pos = (const int*)F.in[2]; float* rc = WSP(float, WS_RC); float* rs = WSP(float, WS_RS);
        for (int i = gt; i < T * 128; i += NGT) { const int t = i >> 7, f = i & 127;
            const float inv = exp2f(-(float)f * (13.287712379549449f / 128.0f));
            const float ang = (float)pos[t] * inv;
            double rev = (double)ang * 0.15915494309189535; rev -= floor(rev);
            const float rf = (float)rev;
            rc[i] = __builtin_amdgcn_cosf(rf); rs[i] = __builtin_amdgcn_sinf(rf); }
    }
    {
        const float* x = F.in[0]; float* glr = WSP(float, WS_GLR);
        const int r16 = F.lane & 15, g4 = F.lane >> 4;
        for (int tile = gw; tile < T / 16; tile += NGW) {
            f32x4 acc = {0.f, 0.f, 0.f, 0.f};
            const float* xr = x + (size_t)(tile * 16 + r16) * D + 4 * g4;
            const float* wr = w_in + (size_t)(4 * g4) * INW + HW + r16;
#pragma unroll 4
            for (int k0 = 0; k0 < D; k0 += 16) {
                const f32x4 a = *(const GAS f32x4*)(xr + k0);
                const float b0 = wr[(size_t)(k0 + 0) * INW], b1 = wr[(size_t)(k0 + 1) * INW], b2 = wr[(size_t)(k0 + 2) * INW], b3 = wr[(size_t)(k0 + 3) * INW];
                acc = __builtin_amdgcn_mfma_f32_16x16x4f32(a[0], b0, acc, 0, 0, 0);
                acc = __builtin_amdgcn_mfma_f32_16x16x4f32(a[1], b1, acc, 0, 0, 0);
                acc = __builtin_amdgcn_mfma_f32_16x16x4f32(a[2], b2, acc, 0, 0, 0);
                acc = __builtin_amdgcn_mfma_f32_16x16x4f32(a[3], b3, acc, 0, 0, 0);
            }
#pragma unroll
            for (int j = 0; j < 4; ++j) glr[(size_t)(tile * 16 + 4 * g4 + j) * 16 + r16] = acc[j];
        }
    }
}

__device__ __forceinline__ float log_sigmoid_f(float z) { return fminf(z, 0.f) - log1pf(expf(-fabsf(z))); }
template <bool GLA>
__device__ __forceinline__ void mixer_naive_item(Frame& F, int hh, int eg) {
    constexpr int ND = GLA ? 4 : 8;
    const bf16* H = WSP(bf16, WS_H); float* oraw = WSP(float, WS_ORAW);
    const int ei = F.tid & 15, dp = F.tid >> 4, e = eg * 16 + ei;
    const int qcol = GLA ? 4096 + hh * 128 : hh * 256, kcol = GLA ? 4608 + hh * 128 : 1024 + hh * 256, vcol = (GLA ? 5120 : 2048) + hh * 256 + e;
    const int ocol = (GLA ? 1024 : 0) + hh * 256 + eg * 16;
    LAS float* red = (LAS float*)F.lds;
    float S[ND];
#pragma unroll
    for (int i = 0; i < ND; ++i) S[i] = 0.f;
    float wa[GLA ? 4 : 1][16]; float ba[GLA ? 4 : 1];
    if (GLA) {
#pragma unroll
        for (int i = 0; i < 4; ++i) { const int d = dp + 32 * i; ba[i] = F.in[5][hh * 128 + d];
#pragma unroll
            for (int r = 0; r < 16; ++r) wa[i][r] = F.in[4][r * 512 + hh * 128 + d]; }
    }
    const float gamma = 1.0f - exp2f(-5.0f - (float)hh);
    const float* glr = WSP(float, WS_GLR);
    for (int t0 = 0; t0 < T; t0 += 8) {
        float part[8];
#pragma unroll
        for (int tt = 0; tt < 8; ++tt) {
            const int t = t0 + tt; const bf16* hr = H + (size_t)t * HW;
            const float v = bf2f(hr[vcol]);
            float g16[16];
            if (GLA) {
#pragma unroll
                for (int r = 0; r < 16; ++r) g16[r] = glr[t * 16 + r];
            }
            float p = 0.f;
#pragma unroll
            for (int i = 0; i < ND; ++i) { const int d = dp + 32 * i;
                const float q = bf2f(hr[qcol + d]), k = bf2f(hr[kcol + d]);
                float a = gamma;
                if (GLA) { float z = ba[i];
#pragma unroll
                    for (int r = 0; r < 16; ++r) z += g16[r] * wa[i][r];
                    a = expf(log_sigmoid_f(z) * 0.0625f); }
                S[i] = a * S[i] + k * v; p += q * S[i]; }
            p += __shfl_xor(p, 16); p += __shfl_xor(p, 32);
            part[tt] = p;
        }
        if (F.lane < 16) {
#pragma unroll
            for (int tt = 0; tt < 8; ++tt) red[(F.wave * 8 + tt) * 16 + F.lane] = part[tt];
        }
        __syncthreads();
        if (F.tid < 128) { const int tt = F.tid >> 4, e2 = F.tid & 15; float s = 0.f;
#pragma unroll
            for (int w = 0; w < 8; ++w) s += red[(w * 8 + tt) * 16 + e2];
            oraw[(size_t)(t0 + tt) * D + ocol + e2] = s; }
        __syncthreads();
    }
}
__device__ __forceinline__ void p2_mixer_naive(Frame& F) {
    for (int item = F.bid; item < 128; item += F.G) {
        const int h8 = item >> 4, eg = item & 15;
        if (h8 < 4) mixer_naive_item<false>(F, h8, eg); else mixer_naive_item<true>(F, h8 - 4, eg);
    }
}
__device__ __forceinline__ void p3_normgate(Frame& F) {
    const bf16* H = WSP(bf16, WS_H); const float* oraw = WSP(float, WS_ORAW); bf16* mixed = WSP(bf16, WS_MIXED);
    const int gw = F.bid * NWAVES + F.wave, NGW = F.G * NWAVES;
    const f32x4 gn = *(const f32x4*)(F.in[6] + 4 * F.lane);
    for (int t = gw; t < T; t += NGW) {
#pragma unroll
        for (int h8 = 0; h8 < 8; ++h8) {
            const f32x4 o = *(const GAS f32x4*)(oraw + (size_t)t * D + h8 * 256 + 4 * F.lane);
            const int gcol = (h8 < 4 ? 3072 : 6144) + (h8 & 3) * 256 + 4 * F.lane;
            const v2u gw2 = *(const GAS v2u*)(H + (size_t)t * HW + gcol);
            const f32x4 gt = {bflo(gw2.x), bfhi(gw2.x), bflo(gw2.y), bfhi(gw2.y)};
            f32x4 y;
            if (h8 < 4) {
                const float mu = wave_sum((o[0] + o[1]) + (o[2] + o[3])) * (1.f / 256.f);
                const f32x4 dd = o - mu;
                const float var = wave_sum((dd[0] * dd[0] + dd[1] * dd[1]) + (dd[2] * dd[2] + dd[3] * dd[3])) * (1.f / 256.f);
                y = dd * (1.0f / sqrtf(var + LN_EPS));
            } else {
                const float ms = wave_sum((o[0] * o[0] + o[1] * o[1]) + (o[2] * o[2] + o[3] * o[3])) * (1.f / 256.f);
                y = o * (1.0f / sqrtf(ms + LN_EPS)) * gn;
            }
            float r[4];
#pragma unroll
            for (int i = 0; i < 4; ++i) { const float g = gt[i]; r[i] = g / (1.0f + expf(-g)) * y[i]; }
            v2u w; w.x = pk2(r[0], r[1]); w.y = pk2(r[2], r[3]);
            *(GAS v2u*)(mixed + (size_t)t * D + h8 * 256 + 4 * F.lane) = w;
        }
    }
}
template <bool ROUTER>
__device__ __forceinline__ void ln_apply(Frame& F, const float* Y, const float* g, const float* b, bf16* HB, float* st, bool count = true) {
    const int gw = F.bid * NWAVES + F.wave, NGW = F.G * NWAVES;
    for (int t = gw; t < T; t += NGW) {
        const GAS f32x4* yr = (const GAS f32x4*)(Y + (size_t)t * D) + F.lane;
        f32x4 v[8]; float s = 0.f;
#pragma unroll
        for (int j = 0; j < 8; ++j) { v[j] = yr[64 * j]; s += (v[j][0] + v[j][1]) + (v[j][2] + v[j][3]); }
        const float mean = wave_sum(s) * (1.f / D); float s2 = 0.f;
#pragma unroll
        for (int j = 0; j < 8; ++j) { v[j] = v[j] - mean; s2 += (v[j][0] * v[j][0] + v[j][1] * v[j][1]) + (v[j][2] * v[j][2] + v[j][3] * v[j][3]); }
        const float rstd = 1.f / sqrtf(wave_sum(s2) * (1.f / D) + LN_EPS);
        if (F.lane == 0) { st[2 * t] = mean; st[2 * t + 1] = rstd; }
        GAS v2u* o8 = (GAS v2u*)(HB + (size_t)t * D) + F.lane;
#pragma unroll
        for (int j = 0; j < 8; ++j) { const f32x4 gv = *(const f32x4*)(g + 4 * F.lane + 256 * j), bv = *(const f32x4*)(b + 4 * F.lane + 256 * j);
            v[j] = v[j] * rstd * gv + bv;
            v2u w; w.x = pk2(v[j][0], v[j][1]); w.y = pk2(v[j][2], v[j][3]); o8[64 * j] = w; }
        if (ROUTER) {
            const float* Wg = F.in[16]; const float* We = F.in[18];
            float lg[4], le[32];
#pragma unroll
            for (int i = 0; i < 4; ++i) lg[i] = 0.f;
#pragma unroll
            for (int i = 0; i < 32; ++i) le[i] = 0.f;
#pragma unroll
            for (int j = 0; j < 8; ++j) {
#pragma unroll
                for (int i = 0; i < 4; ++i) { const int c = 4 * F.lane + 256 * j + i; const float hv = v[j][i];
                    const f32x4 wg = *(const GAS f32x4*)(Wg + (size_t)c * 4);
#pragma unroll
                    for (int q = 0; q < 4; ++q) lg[q] += hv * wg[q];
#pragma unroll
                    for (int q8 = 0; q8 < 8; ++q8) { const f32x4 we = *(const GAS f32x4*)(We + (size_t)c * 32 + 4 * q8);
#pragma unroll
                        for (int q = 0; q < 4; ++q) le[4 * q8 + q] += hv * we[q]; } }
            }
#pragma unroll
            for (int i = 0; i < 4; ++i) lg[i] = wave_sum(lg[i]) + F.in[17][i];
#pragma unroll
            for (int i = 0; i < 32; ++i) le[i] = wave_sum(le[i]);
            int grp = 0; float gm = lg[0];
#pragma unroll
            for (int i = 1; i < 4; ++i) if (lg[i] > gm) { gm = lg[i]; grp = i; }
            float gs = 0.f;
#pragma unroll
            for (int i = 0; i < 4; ++i) gs += expf(lg[i] - gm);
            const float pg_sel = 1.0f / gs;
            float fe[8];
#pragma unroll
            for (int j = 0; j < 8; ++j) { const float a = grp == 0 ? le[j] : grp == 1 ? le[8 + j] : grp == 2 ? le[16 + j] : le[24 + j]; fe[j] = a + F.in[19][grp * 8 + j]; }
            int i1 = 0; float m1 = fe[0];
#pragma unroll
            for (int j = 1; j < 8; ++j) if (fe[j] > m1) { m1 = fe[j]; i1 = j; }
            int i2 = -1; float m2 = -3.0e38f;
#pragma unroll
            for (int j = 0; j < 8; ++j) if (j != i1 && fe[j] > m2) { m2 = fe[j]; i2 = j; }
            const float p2 = expf(m2 - m1), den = 1.0f / (1.0f + p2);
            if (F.lane == 0) {
                int* ex = WSP(int, WS_EXP); float* gt = WSP(float, WS_GATE);
                const int e1 = grp * 8 + i1, e2 = grp * 8 + i2;
                ex[2 * t] = e1; ex[2 * t + 1] = e2; gt[2 * t] = pg_sel * den; gt[2 * t + 1] = pg_sel * p2 * den;
                if (count) { atomicAdd((unsigned*)(F.ctl + CW_CNT) + e1, 1u); atomicAdd((unsigned*)(F.ctl + CW_CNT) + e2, 1u); }
            }
        }
    }
}
__device__ __forceinline__ void p7_attn_naive(Frame& F) {
    const bf16* Q = WSP(bf16, WS_QB); const bf16* KVM = WSP(bf16, WS_KVM); bf16* att = WSP(bf16, WS_ATT);
    LAS float* qs = (LAS float*)F.lds;
    LAS float* sc = (LAS float*)(F.lds + 16384);
    for (int item = F.bid; item < (T / 8) * 4; item += F.G) {
        const int h = item & 3, t0 = (item >> 2) * 8;
        for (int i = F.tid; i < 8 * 512; i += NTHR) { const int tt = i >> 9, d = i & 511; qs[i] = bf2f(Q[(size_t)(t0 + tt) * D + h * 512 + d]); }
        __syncthreads();
        {
            const int j = F.tid & 255, th = F.tid >> 8;
            const bf16* kr = KVM + (size_t)j * 4096 + h * 512;
            float a0 = 0.f, a1 = 0.f, a2 = 0.f, a3 = 0.f;
            for (int d = 0; d < 512; d += 8) {
                const v4u kw = *(const GAS v4u*)(kr + d);
                const float kf[8] = {bflo(kw.x), bfhi(kw.x), bflo(kw.y), bfhi(kw.y), bflo(kw.z), bfhi(kw.z), bflo(kw.w), bfhi(kw.w)};
#pragma unroll
                for (int i = 0; i < 8; ++i) { a0 += kf[i] * qs[(th * 4 + 0) * 512 + d + i]; a1 += kf[i] * qs[(th * 4 + 1) * 512 + d + i]; a2 += kf[i] * qs[(th * 4 + 2) * 512 + d + i]; a3 += kf[i] * qs[(th * 4 + 3) * 512 + d + i]; }
            }
            const float scl = 0.04419417382415922f;
            sc[(th * 4 + 0) * 256 + j] = a0 * scl; sc[(th * 4 + 1) * 256 + j] = a1 * scl; sc[(th * 4 + 2) * 256 + j] = a2 * scl; sc[(th * 4 + 3) * 256 + j] = a3 * scl;
        }
        __syncthreads();
        {
            float v[4]; float mx = -3.0e38f;
#pragma unroll
            for (int i = 0; i < 4; ++i) { v[i] = sc[F.wave * 256 + F.lane + 64 * i]; mx = fmaxf(mx, v[i]); }
            mx = wave_max(mx); float sm = 0.f;
#pragma unroll
            for (int i = 0; i < 4; ++i) { v[i] = expf(v[i] - mx); sm += v[i]; }
            sm = 1.0f / wave_sum(sm);
#pragma unroll
            for (int i = 0; i < 4; ++i) sc[F.wave * 256 + F.lane + 64 * i] = v[i] * sm;
        }
        __syncthreads();
        {
            const int d = F.tid; const bf16* vr = KVM + 2048 + h * 512 + d;
            float o[8];
#pragma unroll
            for (int i = 0; i < 8; ++i) o[i] = 0.f;
            for (int j = 0; j < 256; ++j) { const float vv = bf2f(vr[(size_t)j * 4096]);
#pragma unroll
                for (int i = 0; i < 8; ++i) o[i] += sc[i * 256 + j] * vv; }
#pragma unroll
            for (int i = 0; i < 8; ++i) att[(size_t)(t0 + i) * D + h * 512 + d] = (bf16)f2bf(o[i]);
        }
        __syncthreads();
    }
}
__device__ __forceinline__ void moe_tile_starts(Frame& F, LAS int* ts) {
    if (F.tid == 0) { int acc = 0;
        for (int e = 0; e < 32; ++e) { ts[e] = acc; const unsigned c = __hip_atomic_load(F.ctl + CW_CNT + e, RLX_AGENT); acc += (int)((c + 255u) >> 8); }
        ts[32] = acc; }
    __syncthreads();
}
__device__ __forceinline__ void p10_dispatch(Frame& F, LAS int* ts) {
    const int gw = F.bid * NWAVES + F.wave, NGW = F.G * NWAVES;
    const int* ex = WSP(int, WS_EXP); int* pos = WSP(int, WS_POS); const bf16* h2 = WSP(bf16, WS_H2B); bf16* xs = WSP(bf16, WS_XS);
    for (int a = gw; a < 2 * T; a += NGW) {
        const int e = ex[a]; unsigned slot = 0;
        if (F.lane == 0) slot = atomicAdd((unsigned*)(F.ctl + CW_CUR) + e, 1u);
        slot = __builtin_amdgcn_readfirstlane(slot);
        const int p = ts[e] * 256 + (int)slot;
        if (F.lane == 0) pos[a] = p;
        const GAS v4u* src = (const GAS v4u*)(h2 + (size_t)(a >> 1) * D) + F.lane; GAS v4u* dst = (GAS v4u*)(xs + (size_t)p * D) + F.lane;
#pragma unroll
        for (int j = 0; j < 4; ++j) dst[64 * j] = src[64 * j];
    }
}
__device__ __forceinline__ void p13_combine(Frame& F) {
    const int gw = F.bid * NWAVES + F.wave, NGW = F.G * NWAVES;
    const float* Y2 = WSP(float, WS_Y2); const float* st2 = WSP(float, WS_ST2); const bf16* ys = WSP(bf16, WS_YS);
    const int* pos = WSP(int, WS_POS); const float* gt = WSP(float, WS_GATE);
    const float* g2 = F.in[14]; const float* b2 = F.in[15]; const float* g3 = F.in[23]; const float* b3 = F.in[24];
    for (int t = gw; t < T; t += NGW) {
        const float mu2 = st2[2 * t], rs2 = st2[2 * t + 1];
        const int p0 = pos[2 * t], p1 = pos[2 * t + 1]; const float w0 = gt[2 * t], w1 = gt[2 * t + 1];
        const GAS f32x4* yr = (const GAS f32x4*)(Y2 + (size_t)t * D) + F.lane;
        const GAS v2u* y0 = (const GAS v2u*)(ys + (size_t)p0 * D) + F.lane; const GAS v2u* y1 = (const GAS v2u*)(ys + (size_t)p1 * D) + F.lane;
        f32x4 v[8]; float s = 0.f;
#pragma unroll
        for (int j = 0; j < 8; ++j) { const f32x4 gv = *(const f32x4*)(g2 + 4 * F.lane + 256 * j), bv = *(const f32x4*)(b2 + 4 * F.lane + 256 * j);
            const f32x4 h = (yr[64 * j] - mu2) * rs2 * gv + bv;
            const v2u a = y0[64 * j], c = y1[64 * j];
            const f32x4 fa = {bflo(a.x), bfhi(a.x), bflo(a.y), bfhi(a.y)}, fc = {bflo(c.x), bfhi(c.x), bflo(c.y), bfhi(c.y)};
            v[j] = h * ALPHA + fa * w0 + fc * w1; s += (v[j][0] + v[j][1]) + (v[j][2] + v[j][3]); }
        const float mean = wave_sum(s) * (1.f / D); float s2 = 0.f;
#pragma unroll
        for (int j = 0; j < 8; ++j) { v[j] = v[j] - mean; s2 += (v[j][0] * v[j][0] + v[j][1] * v[j][1]) + (v[j][2] * v[j][2] + v[j][3] * v[j][3]); }
        const float rstd = 1.f / sqrtf(wave_sum(s2) * (1.f / D) + LN_EPS);
        GAS f32x4* orow = (GAS f32x4*)(F.out + (size_t)t * D) + F.lane;
#pragma unroll
        for (int j = 0; j < 8; ++j) { const f32x4 gv = *(const f32x4*)(g3 + 4 * F.lane + 256 * j), bv = *(const f32x4*)(b3 + 4 * F.lane + 256 * j);
            orow[64 * j] = v[j] * rstd * gv + bv; }
    }
}

constexpr int CS = 128, NB = CS / 64, NS = T / CS;
constexpr size_t WS_BCUM = WS_ORAW;
constexpr size_t WS_KVR = WS_ORAW + 16 * MiB;
constexpr size_t WS_KVG = WS_KVR + 32 * MiB;
typedef short bf16x8_t __attribute__((ext_vector_type(8)));
typedef short s16x4_t __attribute__((ext_vector_type(4)));
__device__ __forceinline__ s16x4_t lds_tr(const LAS unsigned char* p) { return __builtin_bit_cast(s16x4_t, __builtin_amdgcn_ds_read_tr16_b64_v4i16((LAS s16x4_t*)p)); }
__device__ __forceinline__ bf16x8_t frag_tr(const LAS unsigned char* X, int pitch, int k0, int n0, int lane) {
    const int fq = lane >> 4, q = (lane >> 2) & 3, p = lane & 3;
    const LAS unsigned char* a = X + ((k0 + 8 * fq + q) * pitch + n0 + 4 * p) * 2;
    const s16x4_t lo = lds_tr(a), hi = lds_tr(a + 4 * pitch * 2);
    return __builtin_shufflevector(lo, hi, 0, 1, 2, 3, 4, 5, 6, 7);
}
__device__ __forceinline__ bf16x8_t frag_row(const LAS unsigned char* X, int pitch, int r0, int k0, int lane) {
    return *(const LAS bf16x8_t*)(X + ((r0 + (lane & 15)) * pitch + k0 + 8 * (lane >> 4)) * 2);
}
#define MFMA16(a, b, c) __builtin_amdgcn_mfma_f32_16x16x32_bf16((a), (b), (c), 0, 0, 0)
__device__ __forceinline__ float fexp(float x) { return __builtin_amdgcn_exp2f(x * 1.4426950408889634f); }
__device__ __forceinline__ float silu_g(float g) { return g * __builtin_amdgcn_rcpf(1.0f + __builtin_amdgcn_exp2f(-1.4426950408889634f * g)); }

__device__ __forceinline__ void bcum_item(Frame& F, int s, int h) {
    const int c = F.tid & 127, tq = F.tid >> 7;
    LAS float* tot = (LAS float*)F.lds;
    const float* glr = WSP(float, WS_GLR); float* bc = WSP(float, WS_BCUM);
    float w[16];
#pragma unroll
    for (int r = 0; r < 16; ++r) w[r] = F.in[4][r * 512 + h * 128 + c];
    const float bias = F.in[5][h * 128 + c];
    float vals[32]; float run = 0.f;
    const int tb = s * CS + tq * 32;
#pragma unroll
    for (int i = 0; i < 32; ++i) { const float* gr = glr + (size_t)(tb + i) * 16; float z = bias;
#pragma unroll
        for (int r = 0; r < 16; ++r) z += gr[r] * w[r];
        run += log_sigmoid_f(z) * 0.0625f; vals[i] = run; }
    __syncthreads();
    tot[tq * 128 + c] = run;
    __syncthreads();
    float off = 0.f;
#pragma unroll
    for (int q = 0; q < 3; ++q) off += (q < tq) ? tot[q * 128 + c] : 0.f;
#pragma unroll
    for (int i = 0; i < 32; ++i) bc[(size_t)(tb + i) * 512 + h * 128 + c] = vals[i] + off;
}
__device__ __forceinline__ void p1_bcum(Frame& F) { for (int it = F.bid; it < NS * 4; it += F.G) bcum_item(F, it >> 2, it & 3); __syncthreads(); }

__device__ __forceinline__ void unit_sh(int u, int& s, int& h8) { s = (u >> 3) & (NS - 1); h8 = ((u & 7) + 4 * (u >> 8)) & 7; }

template <bool GLA, int MODE>
__device__ __forceinline__ void stage_qk(Frame& F, LAS unsigned char* dst, int s, int jb, int hh, int col0, float lg2gamma) {
    constexpr int DK = GLA ? 128 : 256, PK = DK + 8, CPR = DK / 8, NIT = 64 * CPR / NTHR;
    const bf16* H = WSP(bf16, WS_H); const float* bc = WSP(float, WS_BCUM);
#pragma unroll
    for (int it = 0; it < NIT; ++it) {
        const int ch = F.tid + NTHR * it, r = ch / CPR, cc = ch % CPR, tl = jb * 64 + r, t = s * CS + tl;
        const v4u w = *(const GAS v4u*)(H + (size_t)t * HW + col0 + 8 * cc);
        float f[8] = {bflo(w.x), bfhi(w.x), bflo(w.y), bfhi(w.y), bflo(w.z), bfhi(w.z), bflo(w.w), bfhi(w.w)};
        if (GLA) {
            const f32x4 b0 = *(const GAS f32x4*)(bc + (size_t)t * 512 + hh * 128 + 8 * cc), b1 = *(const GAS f32x4*)(bc + (size_t)t * 512 + hh * 128 + 8 * cc + 4);
            float e[8] = {b0[0], b0[1], b0[2], b0[3], b1[0], b1[1], b1[2], b1[3]};
            if (MODE == 2) { const size_t tl_ = (size_t)(s * CS + CS - 1) * 512 + hh * 128 + 8 * cc; const f32x4 l0 = *(const GAS f32x4*)(bc + tl_), l1 = *(const GAS f32x4*)(bc + tl_ + 4);
                const float l[8] = {l0[0], l0[1], l0[2], l0[3], l1[0], l1[1], l1[2], l1[3]};
#pragma unroll
                for (int i = 0; i < 8; ++i) e[i] = l[i] - e[i]; }
            else if (MODE == 1) {
#pragma unroll
                for (int i = 0; i < 8; ++i) e[i] = -e[i]; }
#pragma unroll
            for (int i = 0; i < 8; ++i) f[i] *= fexp(e[i]);
        } else {
            const float ex = MODE == 0 ? (float)(tl + 1) : MODE == 1 ? -(float)(tl + 1) : (float)(CS - 1 - tl);
            const float fac = __builtin_amdgcn_exp2f(ex * lg2gamma);
#pragma unroll
            for (int i = 0; i < 8; ++i) f[i] *= fac;
        }
        v4u o; o.x = pk2(f[0], f[1]); o.y = pk2(f[2], f[3]); o.z = pk2(f[4], f[5]); o.w = pk2(f[6], f[7]);
        *(LAS v4u*)(dst + (r * PK + 8 * cc) * 2) = o;
    }
}
__device__ __forceinline__ void stage_v(Frame& F, LAS unsigned char* dst, int s, int jb, int col0) {
    const bf16* H = WSP(bf16, WS_H);
#pragma unroll
    for (int it = 0; it < 4; ++it) { const int ch = F.tid + NTHR * it, r = ch >> 5, cc = ch & 31, t = s * CS + jb * 64 + r;
        *(LAS v4u*)(dst + (r * 264 + 8 * cc) * 2) = *(const GAS v4u*)(H + (size_t)t * HW + col0 + 8 * cc); }
}

template <bool GLA>
__device__ __forceinline__ void kv_unit(Frame& F, int s, int hh) {
    constexpr int DK = GLA ? 128 : 256, PK = DK + 8, NDT = DK / 16;
    LAS unsigned char* Ks = F.lds; LAS unsigned char* Vs = F.lds + 34816;
    const int kcol = GLA ? 4608 + hh * 128 : 1024 + hh * 256, vcol = (GLA ? 5120 : 2048) + hh * 256;
    const float lg2g = log2f(1.0f - exp2f(-5.0f - (float)hh));
    f32x4 acc[2][NDT];
#pragma unroll
    for (int a = 0; a < 2; ++a)
#pragma unroll
        for (int d = 0; d < NDT; ++d) acc[a][d] = (f32x4){0.f, 0.f, 0.f, 0.f};
    for (int jb = 0; jb < NB; ++jb) {
        __syncthreads();
        stage_qk<GLA, 2>(F, Ks, s, jb, hh, kcol, lg2g);
        stage_v(F, Vs, s, jb, vcol);
        __syncthreads();
#pragma unroll
        for (int ks = 0; ks < 2; ++ks) {
            bf16x8_t vf[2];
#pragma unroll
            for (int et = 0; et < 2; ++et) vf[et] = frag_tr(Vs, 264, 32 * ks, 32 * F.wave + 16 * et, F.lane);
#pragma unroll
            for (int dt = 0; dt < NDT; ++dt) { const bf16x8_t kf = frag_tr(Ks, PK, 32 * ks, 16 * dt, F.lane);
#pragma unroll
                for (int et = 0; et < 2; ++et) acc[et][dt] = MFMA16(kf, vf[et], acc[et][dt]); }
        }
    }
    bf16* kv = GLA ? (WSP(bf16, WS_KVG) + (size_t)(s * 4 + hh) * 256 * 128) : (WSP(bf16, WS_KVR) + (size_t)(s * 4 + hh) * 256 * 256);
    const int fr = F.lane & 15, fq = F.lane >> 4;
#pragma unroll
    for (int et = 0; et < 2; ++et)
#pragma unroll
        for (int dt = 0; dt < NDT; ++dt) { v2u w; w.x = pk2(acc[et][dt][0], acc[et][dt][1]); w.y = pk2(acc[et][dt][2], acc[et][dt][3]);
            *(GAS v2u*)(kv + (size_t)(32 * F.wave + 16 * et + fr) * DK + 16 * dt + 4 * fq) = w; }
}
__device__ __forceinline__ void p2_kv(Frame& F) {
    for (int u = F.bid; u < 8 * NS; u += F.G) { int s, h8; unit_sh(u, s, h8);
        if (s == NS - 1) continue;
        if (h8 < 4) kv_unit<false>(F, s, h8); else kv_unit<true>(F, s, h8 - 4); }
    __syncthreads();
}
__device__ __forceinline__ void p3_scan(Frame& F) {
    const int gt = F.bid * NTHR + F.tid, NGT = F.G * NTHR;
    constexpr int NR = 4 * 256 * 32, NG = 4 * 256 * 16;
    const float* bc = WSP(float, WS_BCUM);
    for (int it = gt; it < NR + NG; it += NGT) {
        const bool gla = it >= NR; const int r = gla ? it - NR : it;
        const int sh = gla ? 4 : 5, dk = gla ? 128 : 256;
        const int cc = r & ((1 << sh) - 1), e = (r >> sh) & 255, hh = r >> (sh + 8);
        bf16* base = (gla ? WSP(bf16, WS_KVG) : WSP(bf16, WS_KVR)) + ((size_t)hh * 256 + e) * dk + 8 * cc;
        const size_t sstride = (size_t)4 * 256 * dk;
        const float dret = __builtin_amdgcn_exp2f((float)CS * log2f(1.0f - exp2f(-5.0f - (float)hh)));
        float S[8];
#pragma unroll
        for (int i = 0; i < 8; ++i) S[i] = 0.f;
#pragma unroll 4
        for (int s = 0; s < NS - 1; ++s) {
            GAS v4u* p = (GAS v4u*)(base + (size_t)s * sstride);
            const v4u w = *p;
            v4u o; o.x = pk2(S[0], S[1]); o.y = pk2(S[2], S[3]); o.z = pk2(S[4], S[5]); o.w = pk2(S[6], S[7]);
            *p = o;
            const float f[8] = {bflo(w.x), bfhi(w.x), bflo(w.y), bfhi(w.y), bflo(w.z), bfhi(w.z), bflo(w.w), bfhi(w.w)};
            float dec[8];
            if (gla) { const size_t o_ = (size_t)(s * CS + CS - 1) * 512 + hh * 128 + 8 * cc; const f32x4 l0 = *(const GAS f32x4*)(bc + o_), l1 = *(const GAS f32x4*)(bc + o_ + 4);
                dec[0] = fexp(l0[0]); dec[1] = fexp(l0[1]); dec[2] = fexp(l0[2]); dec[3] = fexp(l0[3]); dec[4] = fexp(l1[0]); dec[5] = fexp(l1[1]); dec[6] = fexp(l1[2]); dec[7] = fexp(l1[3]); }
            else {
#pragma unroll
                for (int i = 0; i < 8; ++i) dec[i] = dret; }
#pragma unroll
            for (int i = 0; i < 8; ++i) S[i] = dec[i] * S[i] + f[i];
        }
        { GAS v4u* p = (GAS v4u*)(base + (size_t)(NS - 1) * sstride);
          v4u o; o.x = pk2(S[0], S[1]); o.y = pk2(S[2], S[3]); o.z = pk2(S[4], S[5]); o.w = pk2(S[6], S[7]); *p = o; }
    }
}
template <bool GLA>
__device__ __forceinline__ void out_unit(Frame& F, int s, int hh) {
    constexpr int DK = GLA ? 128 : 256, PK = DK + 8, NKS = DK / 32;
    LAS unsigned char* Qs = F.lds; LAS unsigned char* Ks = F.lds + 33792; LAS unsigned char* Vs = F.lds + 67584; LAS unsigned char* Ps = F.lds + 101376;
    LAS float* red = (LAS float*)(F.lds + 110592);
    const int qcol = GLA ? 4096 + hh * 128 : hh * 256, kcol = GLA ? 4608 + hh * 128 : 1024 + hh * 256, vcol = (GLA ? 5120 : 2048) + hh * 256;
    const int gcol = (GLA ? 6144 : 3072) + hh * 256, ocol = (GLA ? 1024 : 0) + hh * 256;
    const float lg2g = log2f(1.0f - exp2f(-5.0f - (float)hh));
    const bf16* H = WSP(bf16, WS_H); bf16* mixed = WSP(bf16, WS_MIXED);
    const bf16* st = GLA ? (WSP(bf16, WS_KVG) + (size_t)(s * 4 + hh) * 256 * 128) : (WSP(bf16, WS_KVR) + (size_t)(s * 4 + hh) * 256 * 256);
    const int fr = F.lane & 15, fq = F.lane >> 4, w = F.wave, mt = w >> 1, nt0 = 2 * (w & 1);
    for (int i = 0; i < NB; ++i) {
        __syncthreads();
        stage_qk<GLA, 0>(F, Qs, s, i, hh, qcol, lg2g);
        f32x4 accO[4][2];
#pragma unroll
        for (int m = 0; m < 4; ++m)
#pragma unroll
            for (int n = 0; n < 2; ++n) accO[m][n] = (f32x4){0.f, 0.f, 0.f, 0.f};
        for (int j = 0; j <= i; ++j) {
            __syncthreads();
            stage_qk<GLA, 1>(F, Ks, s, j, hh, kcol, lg2g);
            stage_v(F, Vs, s, j, vcol);
            __syncthreads();
            f32x4 accS[2] = {(f32x4){0.f, 0.f, 0.f, 0.f}, (f32x4){0.f, 0.f, 0.f, 0.f}};
#pragma unroll
            for (int ks = 0; ks < NKS; ++ks) { const bf16x8_t qf = frag_row(Qs, PK, 16 * mt, 32 * ks, F.lane);
#pragma unroll
                for (int n2 = 0; n2 < 2; ++n2) { const bf16x8_t kf = frag_row(Ks, PK, 16 * (nt0 + n2), 32 * ks, F.lane); accS[n2] = MFMA16(kf, qf, accS[n2]); } }
#pragma unroll
            for (int n2 = 0; n2 < 2; ++n2) { const int row = 16 * mt + fr, c0 = 16 * (nt0 + n2) + 4 * fq; float pv[4];
#pragma unroll
                for (int jj = 0; jj < 4; ++jj) pv[jj] = (i == j && c0 + jj > row) ? 0.f : accS[n2][jj];
                v2u pw; pw.x = pk2(pv[0], pv[1]); pw.y = pk2(pv[2], pv[3]);
                *(LAS v2u*)(Ps + (row * 72 + c0) * 2) = pw; }
            __syncthreads();
#pragma unroll
            for (int ks = 0; ks < 2; ++ks) {
                bf16x8_t vf[2];
#pragma unroll
                for (int n = 0; n < 2; ++n) vf[n] = frag_tr(Vs, 264, 32 * ks, 32 * w + 16 * n, F.lane);
#pragma unroll
                for (int m = 0; m < 4; ++m) { const bf16x8_t pf = frag_row(Ps, 72, 16 * m, 32 * ks, F.lane);
#pragma unroll
                    for (int n = 0; n < 2; ++n) accO[m][n] = MFMA16(vf[n], pf, accO[m][n]); }
            }
        }
        if (s > 0) {
#pragma unroll
            for (int ks = 0; ks < NKS; ++ks) {
                bf16x8_t sf[2];
#pragma unroll
                for (int n = 0; n < 2; ++n) sf[n] = *(const GAS bf16x8_t*)(st + (size_t)(32 * w + 16 * n + fr) * DK + 32 * ks + 8 * fq);
#pragma unroll
                for (int m = 0; m < 4; ++m) { const bf16x8_t qf = frag_row(Qs, PK, 16 * m, 32 * ks, F.lane);
#pragma unroll
                    for (int n = 0; n < 2; ++n) accO[m][n] = MFMA16(sf[n], qf, accO[m][n]); }
            }
        }
#pragma unroll
        for (int m = 0; m < 4; ++m) { float s1 = 0.f, s2 = 0.f;
#pragma unroll
            for (int n = 0; n < 2; ++n)
#pragma unroll
                for (int jj = 0; jj < 4; ++jj) { const float v = accO[m][n][jj]; s1 += v; s2 += v * v; }
            s1 += __shfl_xor(s1, 16); s1 += __shfl_xor(s1, 32); s2 += __shfl_xor(s2, 16); s2 += __shfl_xor(s2, 32);
            if (fq == 0) { red[(w * 64 + 16 * m + fr) * 2] = s1; red[(w * 64 + 16 * m + fr) * 2 + 1] = s2; } }
        __syncthreads();
#pragma unroll
        for (int m = 0; m < 4; ++m) { const int row = 16 * m + fr; float s1 = 0.f, s2 = 0.f;
#pragma unroll
            for (int ww = 0; ww < 8; ++ww) { s1 += red[(ww * 64 + row) * 2]; s2 += red[(ww * 64 + row) * 2 + 1]; }
            const float mean = s1 * (1.f / 256.f), ex2 = s2 * (1.f / 256.f);
            const float mu = GLA ? 0.f : mean, var = GLA ? ex2 : fmaxf(ex2 - mean * mean, 0.f);
            const float rstd = 1.0f / sqrtf(var + LN_EPS);
            const int t = s * CS + i * 64 + row;
#pragma unroll
            for (int n = 0; n < 2; ++n) { const int e = 32 * w + 16 * n + 4 * fq;
                const v2u gw2 = *(const GAS v2u*)(H + (size_t)t * HW + gcol + e);
                const float gt[4] = {bflo(gw2.x), bfhi(gw2.x), bflo(gw2.y), bfhi(gw2.y)};
                f32x4 gn = {1.f, 1.f, 1.f, 1.f}; if (GLA) gn = *(const f32x4*)(F.in[6] + e);
                float r4[4];
#pragma unroll
                for (int jj = 0; jj < 4; ++jj) { const float y = (accO[m][n][jj] - mu) * rstd * gn[jj]; r4[jj] = silu_g(gt[jj]) * y; }
                v2u ow; ow.x = pk2(r4[0], r4[1]); ow.y = pk2(r4[2], r4[3]);
                *(GAS v2u*)(mixed + (size_t)t * D + ocol + e) = ow; } }
    }
}
__device__ __forceinline__ void p4_out(Frame& F) {
    for (int u = F.bid; u < 8 * NS; u += F.G) { int s, h8; unit_sh(u, s, h8);
        if (h8 < 4) out_unit<false>(F, s, h8); else out_unit<true>(F, s, h8 - 4); }
    __syncthreads();
}

__device__ __forceinline__ void stage_kv_chunk(Frame& F, LAS unsigned char* dst, const bf16* src  ) {
#pragma unroll
    for (int it = 0; it < 8; ++it) { const int ch = F.tid + NTHR * it, r = ch >> 4, cc = ch & 15;
        *(LAS v4u*)(dst + (r * 136 + 8 * cc) * 2) = *(const GAS v4u*)(src + (size_t)r * 4096 + 8 * cc); }
}
__device__ __forceinline__ void p8_attn(Frame& F) {
    const bf16* Q = WSP(bf16, WS_QB); const bf16* KVM = WSP(bf16, WS_KVM); bf16* att = WSP(bf16, WS_ATT);
    LAS unsigned char* Cs = F.lds;
    const int fr = F.lane & 15, fq = F.lane >> 4, q4 = (F.lane >> 2) & 3, p4 = F.lane & 3;
    for (int u = F.bid; u < (T / 128) * 4; u += F.G) {
        const int h = u & 3, r0 = (u >> 2) * 128 + 16 * F.wave;
        f32x4 accS[16];
#pragma unroll
        for (int i = 0; i < 16; ++i) accS[i] = (f32x4){0.f, 0.f, 0.f, 0.f};
        for (int dc = 0; dc < 4; ++dc) {
            __syncthreads();
            stage_kv_chunk(F, Cs, KVM + h * 512 + dc * 128);
            bf16x8_t qf[4];
#pragma unroll
            for (int ks = 0; ks < 4; ++ks) qf[ks] = *(const GAS bf16x8_t*)(Q + (size_t)(r0 + fr) * D + h * 512 + dc * 128 + 32 * ks + 8 * fq);
            __syncthreads();
#pragma unroll
            for (int ks = 0; ks < 4; ++ks)
#pragma unroll
                for (int nt = 0; nt < 16; ++nt) accS[nt] = MFMA16(frag_row(Cs, 136, 16 * nt, 32 * ks, F.lane), qf[ks], accS[nt]);
        }
        float mx = -3.0e38f;
#pragma unroll
        for (int nt = 0; nt < 16; ++nt)
#pragma unroll
            for (int jj = 0; jj < 4; ++jj) mx = fmaxf(mx, accS[nt][jj]);
        mx = fmaxf(mx, __shfl_xor(mx, 16)); mx = fmaxf(mx, __shfl_xor(mx, 32));
        const float sl2 = 0.04419417382415922f * 1.4426950408889634f;
        float sm = 0.f;
#pragma unroll
        for (int nt = 0; nt < 16; ++nt)
#pragma unroll
            for (int jj = 0; jj < 4; ++jj) { const float p = __builtin_amdgcn_exp2f((accS[nt][jj] - mx) * sl2); accS[nt][jj] = p; sm += p; }
        sm += __shfl_xor(sm, 16); sm += __shfl_xor(sm, 32);
        const float inv = 1.0f / sm;
        bf16x8_t pf[8];
#pragma unroll
        for (int ks2 = 0; ks2 < 8; ++ks2) { v4u w; w.x = pk2(accS[2 * ks2][0] * inv, accS[2 * ks2][1] * inv); w.y = pk2(accS[2 * ks2][2] * inv, accS[2 * ks2][3] * inv);
            w.z = pk2(accS[2 * ks2 + 1][0] * inv, accS[2 * ks2 + 1][1] * inv); w.w = pk2(accS[2 * ks2 + 1][2] * inv, accS[2 * ks2 + 1][3] * inv); pf[ks2] = __builtin_bit_cast(bf16x8_t, w); }
        for (int ec = 0; ec < 4; ++ec) {
            __syncthreads();
            stage_kv_chunk(F, Cs, KVM + 2048 + h * 512 + ec * 128);
            __syncthreads();
            f32x4 accO[8];
#pragma unroll
            for (int i = 0; i < 8; ++i) accO[i] = (f32x4){0.f, 0.f, 0.f, 0.f};
#pragma unroll
            for (int ks2 = 0; ks2 < 8; ++ks2)
#pragma unroll
                for (int et = 0; et < 8; ++et) { const LAS unsigned char* a = Cs + ((32 * ks2 + 4 * fq + q4) * 136 + 16 * et + 4 * p4) * 2;
                    const s16x4_t lo = lds_tr(a), hi = lds_tr(a + 16 * 136 * 2);
                    accO[et] = MFMA16(__builtin_shufflevector(lo, hi, 0, 1, 2, 3, 4, 5, 6, 7), pf[ks2], accO[et]); }
#pragma unroll
            for (int et = 0; et < 8; ++et) { v2u w; w.x = pk2(accO[et][0], accO[et][1]); w.y = pk2(accO[et][2], accO[et][3]);
                *(GAS v2u*)(att + (size_t)(r0 + fr) * D + h * 512 + ec * 128 + 16 * et + 4 * fq) = w; }
        }
    }
    __syncthreads();
}

__device__ __forceinline__ void p10_ln_router(Frame& F) {
    const float* Y = WSP(float, WS_Y2); const float* g = F.in[14]; const float* b = F.in[15]; bf16* HB = WSP(bf16, WS_H2B); float* st = WSP(float, WS_ST2);
    const float* Wg = F.in[16]; const float* We = F.in[18];
    LAS float* stl = (LAS float*)F.lds;
    LAS float* part = (LAS float*)(F.lds + 1024);
    const int fr = F.lane & 15, fq = F.lane >> 4;
    for (int item = F.bid; item < T / 32; item += F.G) {
        const int row0 = item * 32;
#pragma unroll 1
        for (int i = 0; i < 4; ++i) {
            const int t = row0 + 4 * F.wave + i;
            const GAS f32x4* yr = (const GAS f32x4*)(Y + (size_t)t * D) + F.lane;
            f32x4 v[8]; float s = 0.f;
#pragma unroll
            for (int j = 0; j < 8; ++j) { v[j] = yr[64 * j]; s += (v[j][0] + v[j][1]) + (v[j][2] + v[j][3]); }
            const float mean = wave_sum(s) * (1.f / D); float s2 = 0.f;
#pragma unroll
            for (int j = 0; j < 8; ++j) { v[j] = v[j] - mean; s2 += (v[j][0] * v[j][0] + v[j][1] * v[j][1]) + (v[j][2] * v[j][2] + v[j][3] * v[j][3]); }
            const float rstd = 1.f / sqrtf(wave_sum(s2) * (1.f / D) + LN_EPS);
            if (F.lane == 0) { st[2 * t] = mean; st[2 * t + 1] = rstd; stl[2 * (4 * F.wave + i)] = mean; stl[2 * (4 * F.wave + i) + 1] = rstd; }
            GAS v2u* o8 = (GAS v2u*)(HB + (size_t)t * D) + F.lane;
#pragma unroll
            for (int j = 0; j < 8; ++j) { const f32x4 gv = *(const f32x4*)(g + 4 * F.lane + 256 * j), bv = *(const f32x4*)(b + 4 * F.lane + 256 * j);
                const f32x4 hv = v[j] * rstd * gv + bv;
                v2u w; w.x = pk2(hv[0], hv[1]); w.y = pk2(hv[2], hv[3]); o8[64 * j] = w; }
        }
        __syncthreads();
        {
            const int rt = F.wave >> 2, kq = F.wave & 3;
            const int r = row0 + 16 * rt + fr;
            const float mu = stl[2 * (16 * rt + fr)], rstd = stl[2 * (16 * rt + fr) + 1];
            f32x4 acc0 = {0.f, 0.f, 0.f, 0.f}, acc1 = acc0, acc2 = acc0;
            const float* yp = Y + (size_t)r * D + 512 * kq + 4 * fq;
            const float* wep = We + (size_t)(512 * kq + 4 * fq) * 32 + fr;
            const float* wgp = Wg + (size_t)(512 * kq + 4 * fq) * 4 + (fr & 3);
            const float gm = fr < 4 ? 1.f : 0.f;
#pragma unroll 2
            for (int it = 0; it < 32; ++it) {
                const int k0 = 16 * it;
                const f32x4 y4 = *(const GAS f32x4*)(yp + k0), g4 = *(const f32x4*)(g + 512 * kq + 4 * fq + k0), b4 = *(const f32x4*)(b + 512 * kq + 4 * fq + k0);
                const f32x4 a = (y4 - mu) * rstd * g4 + b4;
#pragma unroll
                for (int s = 0; s < 4; ++s) {
                    const float b0 = wep[(size_t)(k0 + s) * 32], b1 = wep[(size_t)(k0 + s) * 32 + 16], b2 = wgp[(size_t)(k0 + s) * 4] * gm;
                    acc0 = __builtin_amdgcn_mfma_f32_16x16x4f32(a[s], b0, acc0, 0, 0, 0);
                    acc1 = __builtin_amdgcn_mfma_f32_16x16x4f32(a[s], b1, acc1, 0, 0, 0);
                    acc2 = __builtin_amdgcn_mfma_f32_16x16x4f32(a[s], b2, acc2, 0, 0, 0);
                }
            }
            LAS float* pw = part + F.wave * 768;
#pragma unroll
            for (int jj = 0; jj < 4; ++jj) { pw[(4 * fq + jj) * 48 + fr] = acc0[jj]; pw[(4 * fq + jj) * 48 + 16 + fr] = acc1[jj]; pw[(4 * fq + jj) * 48 + 32 + fr] = acc2[jj]; }
        }
        __syncthreads();
        if (F.tid < 32) {
            const int rt = F.tid >> 4, rr = F.tid & 15, t = row0 + F.tid;
            float le[32], lg[4];
#pragma unroll
            for (int c = 0; c < 32; ++c) { float s = 0.f;
#pragma unroll
                for (int kq = 0; kq < 4; ++kq) s += part[(rt * 4 + kq) * 768 + rr * 48 + c]; le[c] = s; }
#pragma unroll
            for (int c = 0; c < 4; ++c) { float s = 0.f;
#pragma unroll
                for (int kq = 0; kq < 4; ++kq) s += part[(rt * 4 + kq) * 768 + rr * 48 + 32 + c]; lg[c] = s + F.in[17][c]; }
            int grp = 0; float gmx = lg[0];
#pragma unroll
            for (int i = 1; i < 4; ++i) if (lg[i] > gmx) { gmx = lg[i]; grp = i; }
            float gs = 0.f;
#pragma unroll
            for (int i = 0; i < 4; ++i) gs += expf(lg[i] - gmx);
            const float pg_sel = 1.0f / gs;
            float fe[8];
#pragma unroll
            for (int j = 0; j < 8; ++j) { const float a = grp == 0 ? le[j] : grp == 1 ? le[8 + j] : grp == 2 ? le[16 + j] : le[24 + j]; fe[j] = a + F.in[19][grp * 8 + j]; }
            int i1 = 0; float m1 = fe[0];
#pragma unroll
            for (int j = 1; j < 8; ++j) if (fe[j] > m1) { m1 = fe[j]; i1 = j; }
            int i2 = -1; float m2 = -3.0e38f;
#pragma unroll
            for (int j = 0; j < 8; ++j) if (j != i1 && fe[j] > m2) { m2 = fe[j]; i2 = j; }
            const float p2 = expf(m2 - m1), den = 1.0f / (1.0f + p2);
            int* ex = WSP(int, WS_EXP); float* gt = WSP(float, WS_GATE);
            const int e1 = grp * 8 + i1, e2 = grp * 8 + i2;
            ex[2 * t] = e1; ex[2 * t + 1] = e2; gt[2 * t] = pg_sel * den; gt[2 * t + 1] = pg_sel * p2 * den;
            atomicAdd((unsigned*)(F.ctl + CW_CNT) + e1, 1u); atomicAdd((unsigned*)(F.ctl + CW_CNT) + e2, 1u);
        }
        __syncthreads();
    }
}

#define XB_TMO      128
#define XB_XCNT(j)  (256  + 64 * (j))
#define XB_XSUB(j)  (1280 + 64 * (j))
#define XB_XGEN(j)  (2304 + 64 * (j))
#define XB_TOP      3328
#define XB_TOPGEN   3392
#define XCD_BAR_WORDS 3456
#define XB_SPIN_CAP (1u << 22)
__device__ __forceinline__ unsigned xb_ld(unsigned* p)              { return __hip_atomic_load(p, __ATOMIC_RELAXED, __HIP_MEMORY_SCOPE_AGENT); }
__device__ __forceinline__ unsigned xb_add(unsigned* p, unsigned v) { return __hip_atomic_fetch_add(p, v, __ATOMIC_RELAXED, __HIP_MEMORY_SCOPE_AGENT); }
__device__ __forceinline__ unsigned xb_xcc_id() { return (unsigned)__builtin_amdgcn_s_getreg((3 << 11) | 20) & 0xFu; }
#define XB_SPIN(cond, bar) do { unsigned _sp = 0; while (cond) { __builtin_amdgcn_s_sleep(1); \
    if ((++_sp & 255u) == 0u) { if (xb_ld(&(bar)[XB_TMO])) break; if (_sp > XB_SPIN_CAP) { atomicAdd(&(bar)[XB_TMO], 1u); break; } } } } while (0)
struct XcdBarrier { unsigned* bar; unsigned x; volatile LAS unsigned* st; };
__device__ __forceinline__ XcdBarrier xcd_barrier_post(unsigned* bar, volatile LAS unsigned* st) {
    XcdBarrier b; b.bar = bar; b.x = xb_xcc_id(); b.st = st;
    if (threadIdx.x == 0) (void)xb_add(&bar[XB_XCNT(b.x)], 1u);
    return b;
}
__device__ __forceinline__ void xcd_barrier_complete(unsigned* bar, unsigned x, unsigned& nloc, unsigned& nx) {
    const unsigned G = gridDim.x * gridDim.y * gridDim.z;
    unsigned sum, cnt, mine, sp = 0u;
    for (;;) {
        sum = 0u; cnt = 0u; mine = 0u;
#pragma unroll
        for (unsigned j = 0; j < 16; ++j) { const unsigned c = xb_ld(&bar[XB_XCNT(j)]); sum += c; cnt += (c > 0u) ? 1u : 0u; mine = (j == x) ? c : mine; }
        if (sum == G) break;
        __builtin_amdgcn_s_sleep(1);
        if ((++sp & 255u) == 0u) { if (xb_ld(&bar[XB_TMO])) break; if (sp > XB_SPIN_CAP) { atomicAdd(&bar[XB_TMO], 1u); break; } }
    }
    nloc = mine > 0u ? mine : 1u; nx = cnt > 0u ? cnt : 1u;
}
__device__ __forceinline__ void xcd_barrier(const XcdBarrier& b) {
    asm volatile("s_waitcnt vmcnt(0)" ::: "memory");
    __syncthreads();
    if (threadIdx.x == 0) {
        unsigned* bar = b.bar;
        __builtin_amdgcn_s_waitcnt(0);
        unsigned nloc = b.st[0], nx = b.st[1];
        if (nloc == 0u) { xcd_barrier_complete(bar, b.x, nloc, nx); b.st[0] = nloc; b.st[1] = nx; }
        const unsigned old = xb_add(&bar[XB_XSUB(b.x)], 1u);
        const unsigned gen = old / nloc;
        if (old + 1u == (gen + 1u) * nloc) {
            __builtin_amdgcn_fence(__ATOMIC_RELEASE, "agent");
            asm volatile("s_waitcnt vmcnt(0)" ::: "memory");
            const unsigned og = xb_add(&bar[XB_TOP], 1u);
            const unsigned tg = og / nx;
            if (og + 1u == (tg + 1u) * nx) xb_add(&bar[XB_TOPGEN], 1u);
            else XB_SPIN(xb_ld(&bar[XB_TOPGEN]) == tg, bar);
            __builtin_amdgcn_fence(__ATOMIC_ACQUIRE, "agent");
            xb_add(&bar[XB_XGEN(b.x)], 1u);
            asm volatile("s_waitcnt vmcnt(0)" ::: "memory");
        } else {
            XB_SPIN(xb_ld(&bar[XB_XGEN(b.x)]) == gen, bar);
            __builtin_amdgcn_fence(__ATOMIC_ACQUIRE, "agent");
            asm volatile("s_waitcnt vmcnt(0)" ::: "memory");
        }
    }
    __syncthreads();
}

struct Args { const float* in[25]; float* out; unsigned char* ws; int ph_lo, ph_hi, use_bar, pad; };
__global__ void __launch_bounds__(NTHR, 2) mega(Args args) {
    extern __shared__ __attribute__((aligned(16))) unsigned char lds[];
    Frame F;
    F.lds = (LAS unsigned char*)lds;
    F.MISC = (volatile LAS unsigned*)(F.lds + MISC_OFF);
    F.tid = threadIdx.x; F.lane = F.tid & 63; F.wave = __builtin_amdgcn_readfirstlane(F.tid >> 6);
    F.G = gridDim.x; F.bid = blockIdx.x;
    F.ws = args.ws; F.ctl = (gu32*)(args.ws + WS_CTL);
#pragma unroll
    for (int i = 0; i < 25; ++i) F.in[i] = args.in[i];
    F.out = args.out;
    for (int u = F.tid; u < (LDS_BYTES - LDSCTL_OFF) / 4; u += NTHR) ((LAS unsigned*)(F.lds + LDSCTL_OFF))[u] = 0u;
    __syncthreads();
    LAS int* ts = (LAS int*)(F.lds + MISC_OFF + 64);
    XcdBarrier bar; bar.bar = (unsigned*)(F.ctl + CW_BAR); bar.x = 0; bar.st = nullptr;
    if (args.use_bar) bar = xcd_barrier_post((unsigned*)(F.ctl + CW_BAR), F.MISC + 8);
    const int lo = args.ph_lo, hi = args.ph_hi;
#if MK_CG_SYNC == 2
    if (args.use_bar == 2) cooperative_groups::this_grid().sync();
#endif
#define IN(k) (lo <= (k) && (k) < hi)
#define REPS(k) for (int _r = 0; _r < ((k) == PROBE_PH ? PROBE_N : 1); ++_r)
#define SEAM(k) do { if (IN(k) && IN((k) + 1)) { if (MK_CG_SYNC == 1 && (k) == 0) cooperative_groups::this_grid().sync(); else xcd_barrier(bar); } } while (0)

    if (IN(0)) { REPS(0) p0_prologue(F); SEAM(0); }
    if (IN(1)) {
        p1_bcum(F);
        pg8::Gemm g{WSP(pg8::bf16_t, WS_XB), WSP(pg8::bf16_t, WS_WIN), T + MEMN, HW + 4096, D}; pg8::OrderG1 S; S.init(F.G, F.bid);
        pg8::EpiH E{WSP(pg8::bf16_t, WS_H), WSP(pg8::bf16_t, WS_KVM), WSP(float, WS_RC), WSP(float, WS_RS)};
        REPS(1) pg8::gemm_phase<pg8::EpiH, pg8::OrderG1, true, true>(F.lds, g, S, E);
        SEAM(1);
    }
    if (IN(2)) { REPS(2) p2_kv(F); SEAM(2); }
    if (IN(3)) { p3_scan(F); SEAM(3); }
    if (IN(4)) { REPS(4) p4_out(F); SEAM(4); }
    if (IN(5)) {
        pg8::Gemm g{WSP(pg8::bf16_t, WS_MIXED), WSP(pg8::bf16_t, WS_WMIX), T, D, D}; pg8::StaticOrder S; S.init(T, D, F.G, F.bid);
        pg8::EpiResX E{F.in[0], WSP(float, WS_Y1), ALPHA};
        REPS(5) pg8::gemm_phase<pg8::EpiResX, pg8::StaticOrder, true, true>(F.lds, g, S, E);
        SEAM(5);
    }
    if (IN(6)) { REPS(6) ln_apply<false>(F, WSP(float, WS_Y1), F.in[8], F.in[9], WSP(bf16, WS_H1B), WSP(float, WS_ST1)); SEAM(6); }
    if (IN(7)) {
        pg8::Gemm g{WSP(pg8::bf16_t, WS_H1B), WSP(pg8::bf16_t, WS_WMQ), T, D, D}; pg8::StaticOrder S; S.init(T, D, F.G, F.bid);
        pg8::EpiB E{WSP(pg8::bf16_t, WS_QB), D, -1};
        REPS(7) pg8::gemm_phase<pg8::EpiB, pg8::StaticOrder, true, true>(F.lds, g, S, E);
        SEAM(7);
    }
    if (IN(8)) { REPS(8) p8_attn(F); SEAM(8); }
    if (IN(9)) {
        pg8::Gemm g{WSP(pg8::bf16_t, WS_ATT), WSP(pg8::bf16_t, WS_WMO), T, D, D}; pg8::StaticOrder S; S.init(T, D, F.G, F.bid);
        pg8::EpiResLN E{WSP(float, WS_Y1), WSP(float, WS_ST1), F.in[8], F.in[9], WSP(float, WS_Y2), ALPHA};
        REPS(9) pg8::gemm_phase<pg8::EpiResLN, pg8::StaticOrder, true, true>(F.lds, g, S, E);
        SEAM(9);
    }
    if (IN(10)) { p10_ln_router(F); SEAM(10); }
    if (IN(11)) { moe_tile_starts(F, ts); p10_dispatch(F, ts); SEAM(11); }
    if (IN(12)) {
        moe_tile_starts(F, ts);
        pg8::Gemm g{WSP(pg8::bf16_t, WS_XS), WSP(pg8::bf16_t, WS_WGU), PMAX, 32 * 1024, D};
        pg8::MoeOrder S{(const PG8_LAS int*)ts, F.G, F.bid, 4, ts[32] * 4};
        pg8::EpiSwi E{WSP(pg8::bf16_t, WS_HID)};
        REPS(12) pg8::gemm_phase<pg8::EpiSwi, pg8::MoeOrder, true, true>(F.lds, g, S, E);
        SEAM(12);
    }
    if (IN(13)) {
        moe_tile_starts(F, ts);
        pg8::Gemm g{WSP(pg8::bf16_t, WS_HID), WSP(pg8::bf16_t, WS_WD), PMAX, 32 * 2048, 512};
        pg8::MoeOrder S{(const PG8_LAS int*)ts, F.G, F.bid, 8, ts[32] * 8};
        pg8::EpiB E{WSP(pg8::bf16_t, WS_YS), D, 7};
        REPS(13) pg8::gemm_phase<pg8::EpiB, pg8::MoeOrder, true, true>(F.lds, g, S, E);
        SEAM(13);
    }
    if (IN(14)) { REPS(14) p13_combine(F); }
#undef IN
#undef SEAM
#undef REPS
}

extern "C" void kernel_launch(void* const* d_in, const int* in_sizes, int n_in, void* d_out, int out_size, void* d_ws, size_t ws_size, hipStream_t stream) {
    static int grid = 0;
    if (grid == 0) {
        if (n_in != 25 || in_sizes[0] != T * D || out_size != T * D || ws_size < WS_END) { fprintf(stderr, "kernel_launch: unexpected shapes / workspace (%d inputs, ws %zu)\n", n_in, ws_size); grid = -1; return; }
        int dev = 0, cus = 0;
        if (hipGetDevice(&dev) != hipSuccess || hipDeviceGetAttribute(&cus, hipDeviceAttributeMultiprocessorCount, dev) != hipSuccess) { grid = -1; return; }
        if (hipFuncSetAttribute((const void*)mega, hipFuncAttributeMaxDynamicSharedMemorySize, LDS_BYTES) != hipSuccess) { fprintf(stderr, "kernel_launch: hipFuncSetAttribute failed\n"); grid = -1; return; }
        int per_cu = 0;
        if (hipOccupancyMaxActiveBlocksPerMultiprocessor(&per_cu, (const void*)mega, NTHR, LDS_BYTES) != hipSuccess || per_cu < 1) { fprintf(stderr, "kernel_launch: occupancy query failed / 0 blocks per CU\n"); grid = -1; return; }
        (void)hipGetLastError();
        grid = cus;
    }
    if (grid < 0) return;
    if (hipMemsetAsync((char*)d_ws + WS_CTL, 0, CTL_ZERO_BYTES, stream) != hipSuccess) return;
    Args a{};
    for (int i = 0; i < 25; ++i) a.in[i] = (const float*)d_in[i];
    a.out = (float*)d_out; a.ws = (unsigned char*)d_ws;
#if MK_ONE_LAUNCH
    a.ph_lo = 0; a.ph_hi = NPH; a.use_bar = 1;
#if MK_CG_SYNC
    { void* kargs[] = {(void*)&a};
      hipError_t e = hipLaunchCooperativeKernel((const void*)mega, dim3(grid), dim3(NTHR), kargs, LDS_BYTES, stream);
      if (e != hipSuccess) fprintf(stderr, "cooperative launch failed: %s (grid %d)\n", hipGetErrorString(e), grid); }
#else
    hipLaunchKernelGGL(mega, dim3(grid), dim3(NTHR), LDS_BYTES, stream, a);
#endif
#else
    for (int p = 0; p < NPH; ++p) { a.ph_lo = p; a.ph_hi = p + 1; a.use_bar = 0;
        hipLaunchKernelGGL(mega, dim3(grid), dim3(NTHR), LDS_BYTES, stream, a); }
#endif
}
```

```cpp
#include <hip/hip_runtime.h>
#include <hip/hip_cooperative_groups.h>
#include <cstdio>
#include <cstdint>
#include <cmath>
#ifndef MK_ONE_LAUNCH
#define MK_ONE_LAUNCH 1
#endif
#ifndef MK_CG_SYNC
#define MK_CG_SYNC 2
#endif
#ifndef MK_MOE_F32
#define MK_MOE_F32 0
#endif
#define PROBE_PH -1
#define PROBE_N 1
namespace pg8 {
#define PG8_LAS __attribute__((address_space(3)))
typedef unsigned short bf16_t;
typedef short bf16x8 __attribute__((ext_vector_type(8)));
typedef float f32x4 __attribute__((ext_vector_type(4)));
typedef unsigned u32x4 __attribute__((ext_vector_type(4)));
constexpr int BM = 256, BK = 64, HALF = 128, HTB = HALF * BK * 2  , STAGE_BYTES = 8 * HTB, NXCD = 8, WGM = 8;

__host__ __device__ __forceinline__ int lds_byte(int r, int c) { const int st = (r >> 4) * 2 + (c >> 5), rr = r & 15, cc = c & 31, ob = rr * 64 + cc * 2; return st * 1024 + (ob ^ (((ob >> 9) & 1) << 5)); }
__host__ __device__ __forceinline__ void stage_rc(int b, int& R, int& C) { const int st = b / 1024, sb = b % 1024, swz = sb ^ (((sb >> 9) & 1) << 5); R = (st >> 1) * 16 + swz / 64; C = (st & 1) * 32 + (swz % 64) / 2; }
__host__ __device__ __forceinline__ int perm32(int rho) { const int n = rho >> 4, i = rho & 15; return 8 * (i >> 2) + 4 * n + (i & 3); }

struct Unit { int pm, pn; };
struct Gemm { const bf16_t* A; const bf16_t* Bt; int M, N, K; };

struct StaticOrder {
    int nM, nN, nwg, G, c;
    __host__ __device__ void init(int M, int N, int G_, int c_) { nM = M / BM; nN = N / BM; nwg = nM * nN; G = G_; c = c_; }
    __host__ __device__ bool next(int i, Unit& u) const {
        const long L = (long)i * G + c; if (L >= nwg) return false;
        int wgid = (int)L; { const int q = nwg / NXCD, r = nwg % NXCD, xcd = wgid % NXCD, off = wgid / NXCD; wgid = (xcd < r ? xcd * (q + 1) : r * (q + 1) + (xcd - r) * q) + off; }
        const int nig = WGM * nN, gid = wgid / nig, fm = gid * WGM, gsz = (nM - fm) < WGM ? (nM - fm) : WGM;
        u.pm = fm + ((wgid % nig) % gsz); u.pn = (wgid % nig) / gsz; return true;
    }
    __device__ __forceinline__ void a_ready(const Unit&) const {}
    __device__ __forceinline__ void done(const Unit&) const {}
};


__device__ __forceinline__ unsigned cvt_pk_bf16(float lo, float hi) { unsigned r; asm volatile("v_cvt_pk_bf16_f32 %0, %1, %2" : "=v"(r) : "v"(lo), "v"(hi)); return r; }
__device__ __forceinline__ u32x4 pack8(const f32x4 a, const f32x4 b) { u32x4 w; w.x = cvt_pk_bf16(a[0], a[1]); w.y = cvt_pk_bf16(a[2], a[3]); w.z = cvt_pk_bf16(b[0], b[1]); w.w = cvt_pk_bf16(b[2], b[3]); return w; }
__device__ __forceinline__ float silu_f(float x) { return x * __builtin_amdgcn_rcpf(1.0f + __builtin_amdgcn_exp2f(-1.4426950408889634f * x)); }

struct EpiH {
    static constexpr bool PERM = true, AFTER_DRAIN = false;
    bf16_t* H; bf16_t* KVM; const float* rc; const float* rs;
    __device__ __forceinline__ void operator()(const f32x4 (&acc)[2][2][4][2], const Unit& u, int wr, int wc, int fr, int fq) const {
        const int cb = wc * 32 + 8 * fq;
        if (u.pm >= 32) {
#pragma unroll
            for (int ai = 0; ai < 2; ++ai)
#pragma unroll
                for (int m = 0; m < 4; ++m) { bf16_t* rowp = KVM + (size_t)(wr * 64 + fr + ai * HALF + m * 16) * 4096 + (u.pn - 28) * BM + cb;
#pragma unroll
                    for (int bj = 0; bj < 2; ++bj) *(u32x4*)(rowp + bj * HALF) = pack8(acc[ai][bj][m][0], acc[ai][bj][m][1]); }
            return;
        }
        const int row0 = u.pm * BM + wr * 64 + fr;
        if (u.pn < 8) {
            const float sc = u.pn >= 4 ? 0.0625f : 1.0f;
#pragma unroll
            for (int ai = 0; ai < 2; ++ai)
#pragma unroll
                for (int m = 0; m < 4; ++m) { const int row = row0 + ai * HALF + m * 16;
                    const float* cr = rc + (size_t)row * 128 + cb; const float* sr = rs + (size_t)row * 128 + cb;
                    const f32x4 c0 = *(const f32x4*)cr * sc, c1 = *(const f32x4*)(cr + 4) * sc, s0 = *(const f32x4*)sr * sc, s1 = *(const f32x4*)(sr + 4) * sc;
                    const f32x4 t1a = acc[ai][0][m][0], t1b = acc[ai][0][m][1], t2a = acc[ai][1][m][0], t2b = acc[ai][1][m][1];
                    bf16_t* rowp = H + (size_t)row * 7168 + u.pn * BM + cb;
                    *(u32x4*)(rowp) = pack8(t1a * c0 - t2a * s0, t1b * c1 - t2b * s1);
                    *(u32x4*)(rowp + HALF) = pack8(t1a * s0 + t2a * c0, t1b * s1 + t2b * c1); }
        } else {
            const float sc = (u.pn == 16 || u.pn == 17) ? 0.08838834764831845f : 1.0f;
#pragma unroll
            for (int ai = 0; ai < 2; ++ai)
#pragma unroll
                for (int m = 0; m < 4; ++m) { bf16_t* rowp = H + (size_t)(row0 + ai * HALF + m * 16) * 7168 + u.pn * BM + cb;
#pragma unroll
                    for (int bj = 0; bj < 2; ++bj) *(u32x4*)(rowp + bj * HALF) = pack8(acc[ai][bj][m][0] * sc, acc[ai][bj][m][1] * sc); }
        }
    }
};
struct EpiB {
    static constexpr bool PERM = true, AFTER_DRAIN = false;
    bf16_t* O; int ldc; int pmask;
    __device__ __forceinline__ void operator()(const f32x4 (&acc)[2][2][4][2], const Unit& u, int wr, int wc, int fr, int fq) const {
        const int row0 = u.pm * BM + wr * 64 + fr, col0 = (u.pn & pmask) * BM + wc * 32 + 8 * fq;
#pragma unroll
        for (int ai = 0; ai < 2; ++ai)
#pragma unroll
            for (int m = 0; m < 4; ++m) { bf16_t* rowp = O + (size_t)(row0 + ai * HALF + m * 16) * ldc + col0;
#pragma unroll
                for (int bj = 0; bj < 2; ++bj) *(u32x4*)(rowp + bj * HALF) = pack8(acc[ai][bj][m][0], acc[ai][bj][m][1]); }
    }
};
struct EpiSwi {
    static constexpr bool PERM = true, AFTER_DRAIN = false;
    bf16_t* O;
    __device__ __forceinline__ void operator()(const f32x4 (&acc)[2][2][4][2], const Unit& u, int wr, int wc, int fr, int fq) const {
        const int row0 = u.pm * BM + wr * 64 + fr, col0 = (u.pn & 3) * HALF + wc * 32 + 8 * fq;
#pragma unroll
        for (int ai = 0; ai < 2; ++ai)
#pragma unroll
            for (int m = 0; m < 4; ++m) { bf16_t* rowp = O + (size_t)(row0 + ai * HALF + m * 16) * 512 + col0;
                f32x4 h0, h1;
#pragma unroll
                for (int i = 0; i < 4; ++i) { h0[i] = silu_f(acc[ai][0][m][0][i]) * acc[ai][1][m][0][i]; h1[i] = silu_f(acc[ai][0][m][1][i]) * acc[ai][1][m][1][i]; }
                *(u32x4*)rowp = pack8(h0, h1); }
    }
};
struct EpiResX {
    static constexpr bool PERM = false, AFTER_DRAIN = false;
    const float* X; float* Y; float alpha;
    __device__ __forceinline__ void operator()(const f32x4 (&acc)[2][2][4][2], const Unit& u, int wr, int wc, int fr, int fq) const {
        const int row0 = u.pm * BM + wr * 64 + fr, col0 = u.pn * BM + wc * 32 + 4 * fq;
#pragma unroll
        for (int ai = 0; ai < 2; ++ai)
#pragma unroll
            for (int m = 0; m < 4; ++m) { const size_t off = (size_t)(row0 + ai * HALF + m * 16) * 2048 + col0;
#pragma unroll
                for (int bj = 0; bj < 2; ++bj)
#pragma unroll
                    for (int n = 0; n < 2; ++n) { const f32x4 xv = *(const f32x4*)(X + off + bj * HALF + n * 16); *(f32x4*)(Y + off + bj * HALF + n * 16) = xv * alpha + acc[ai][bj][m][n]; } }
    }
};
struct EpiResLN {
    static constexpr bool PERM = false, AFTER_DRAIN = false;
    const float* Yin; const float* st; const float* g; const float* b; float* Y; float alpha;
    __device__ __forceinline__ void operator()(const f32x4 (&acc)[2][2][4][2], const Unit& u, int wr, int wc, int fr, int fq) const {
        const int row0 = u.pm * BM + wr * 64 + fr, col0 = u.pn * BM + wc * 32 + 4 * fq;
        f32x4 gv[2][2], bv[2][2];
#pragma unroll
        for (int bj = 0; bj < 2; ++bj)
#pragma unroll
            for (int n = 0; n < 2; ++n) { gv[bj][n] = *(const f32x4*)(g + col0 + bj * HALF + n * 16) * alpha; bv[bj][n] = *(const f32x4*)(b + col0 + bj * HALF + n * 16) * alpha; }
#pragma unroll
        for (int ai = 0; ai < 2; ++ai)
#pragma unroll
            for (int m = 0; m < 4; ++m) { const int row = row0 + ai * HALF + m * 16; const size_t off = (size_t)row * 2048 + col0;
                const float mu = st[2 * row], rstd = st[2 * row + 1];
#pragma unroll
                for (int bj = 0; bj < 2; ++bj)
#pragma unroll
                    for (int n = 0; n < 2; ++n) { const f32x4 yv = *(const f32x4*)(Yin + off + bj * HALF + n * 16);
                        *(f32x4*)(Y + off + bj * HALF + n * 16) = ((yv - mu) * rstd) * gv[bj][n] + bv[bj][n] + acc[ai][bj][m][n]; } }
    }
};

struct OrderG1 {
    StaticOrder so; int G, c;
    __device__ void init(int G_, int c_) { so.init(8192, 7168, G_, c_); G = G_; c = c_; }
    __device__ bool next(int i, Unit& u) const {
        const int L = i * G + c;
        if (L < 896) return so.next(i, u);
        if (L >= 912) return false;
        u.pm = 32; u.pn = 28 + (L - 896); return true;
    }
    __device__ __forceinline__ void a_ready(const Unit&) const {}
    __device__ __forceinline__ void done(const Unit&) const {}
};
struct MoeOrder {
    const PG8_LAS int* ts; int G, c, npn, total; const float* W0; const float* W1; int kdim, ncols;
    __device__ bool next(int i, Unit& u) const {
        const int L = i * G + c; if (L >= total) return false;
        const int rt = L / npn, pl = L - rt * npn; int e = 0;
        for (int j = 1; j < 32; ++j) e += (ts[j] <= rt) ? 1 : 0;
        u.pm = rt; u.pn = e * npn + pl; return true;
    }
    __device__ __forceinline__ int ldb() const { return ncols; }
    __device__ __forceinline__ const float* bptr(const Unit& u, int lane) const {
        const int e = u.pn / npn, pl = u.pn - e * npn; const size_t eo = (size_t)e * kdim * ncols;
        if (W1) return (lane < 32 ? W0 : W1) + eo + 128 * pl + 4 * (lane & 31);
        return W0 + eo + 256 * pl + 4 * lane;
    }
    __device__ __forceinline__ void a_ready(const Unit&) const {}
    __device__ __forceinline__ void done(const Unit&) const {}
};

template <class Epi, class Sched, bool ALIGN_EPI = false, bool SP2 = false>
__device__ __forceinline__ void gemm_phase(PG8_LAS unsigned char* lds, const Gemm g, const Sched& S, const Epi& E) {
    const int tid = threadIdx.x, wid = __builtin_amdgcn_readfirstlane(tid >> 6), lane = tid & 63, wr = wid >> 2, wc = wid & 3, fr = lane & 15, fq = lane >> 4;
    const int K = g.K, nt = K / BK;
    unsigned voffA[2], voffB[2];
#pragma unroll
    for (int i = 0; i < 2; ++i) { int R, C; stage_rc(tid * 16 + i * 8192, R, C); const int Rb = Epi::PERM ? ((R & ~31) + perm32(R & 31)) : R;
        voffA[i] = (unsigned)(R * K + C) * 2u; voffB[i] = (unsigned)(Rb * K + C) * 2u; }
    const size_t kstep = (size_t)(BK * 2);
    const size_t hstep = (size_t)HALF * K * 2;
    const size_t tstep = 2 * hstep;
    const unsigned ldsw = (unsigned)wid * 1024u;
    const int aoff = lds_byte(wr * 64 + fr, fq * 8), boff = lds_byte(wc * 32 + fr, fq * 8);
#define PG8_SA(b, h) (((b) * 2 + (h)) * HTB)
#define PG8_SB(b, h) ((4 + (b) * 2 + (h)) * HTB)
#define PG8_STAGE(bufoff, gbase, voff) do { _Pragma("unroll") for (int _i = 0; _i < 2; ++_i) \
        __builtin_amdgcn_global_load_lds((const unsigned*)((const char*)(gbase) + (voff)[_i]), (PG8_LAS unsigned*)(lds + (bufoff) + ldsw + _i * 8192), 16, 0, 0); } while (0)
#define PG8_LDA(dst, b, h) do { _Pragma("unroll") for (int m = 0; m < 4; ++m) _Pragma("unroll") for (int k = 0; k < 2; ++k) dst[m][k] = *(const PG8_LAS bf16x8*)(lds + PG8_SA(b, h) + aoff + m * 2048 + k * 1024); } while (0)
#define PG8_LDB(dst, b, h) do { _Pragma("unroll") for (int n = 0; n < 2; ++n) _Pragma("unroll") for (int k = 0; k < 2; ++k) dst[n][k] = *(const PG8_LAS bf16x8*)(lds + PG8_SB(b, h) + boff + n * 2048 + k * 1024); } while (0)
#define PG8_MMA(ai, bj, At, Bt) do { __builtin_amdgcn_s_setprio(1); _Pragma("unroll") for (int m = 0; m < 4; ++m) _Pragma("unroll") for (int n = 0; n < 2; ++n) _Pragma("unroll") for (int k = 0; k < 2; ++k) \
        acc[ai][bj][m][n] = __builtin_amdgcn_mfma_f32_16x16x32_bf16(Bt[n][k], At[m][k], acc[ai][bj][m][n], 0, 0, 0); __builtin_amdgcn_s_setprio(0); } while (0)
#define PG8_WAIT_V(n) asm volatile("s_waitcnt vmcnt(" #n ")" ::: "memory")
#define PG8_WAIT_L(n) asm volatile("s_waitcnt lgkmcnt(" #n ")" ::: "memory")
#define PG8_BAR __builtin_amdgcn_s_barrier()
#define PG8_SCHED __builtin_amdgcn_sched_barrier(0)
    Unit cur, nxt; int ui = 0;
    if (!S.next(0, cur)) return;
    f32x4 acc[2][2][4][2];
#pragma unroll
    for (int a = 0; a < 2; ++a)
#pragma unroll
        for (int b = 0; b < 2; ++b)
#pragma unroll
            for (int m = 0; m < 4; ++m)
#pragma unroll
                for (int n = 0; n < 2; ++n) acc[a][b][m][n] = (f32x4){0.f, 0.f, 0.f, 0.f};
    bf16x8 At[4][2], B0[2][2], B1[2][2];
    const char* cA = (const char*)g.A + (size_t)cur.pm * tstep; const char* cB = (const char*)g.Bt + (size_t)cur.pn * tstep;
    S.a_ready(cur);
    if constexpr (SP2) {
        PG8_STAGE(PG8_SB(0, 0), cB, voffB); PG8_STAGE(PG8_SB(0, 1), cB + hstep, voffB); PG8_STAGE(PG8_SA(0, 0), cA, voffA); PG8_STAGE(PG8_SA(0, 1), cA + hstep, voffA);
        if (wr == 1) PG8_BAR;
        PG8_WAIT_V(2); PG8_BAR;
        PG8_STAGE(PG8_SB(1, 0), cB + kstep, voffB); PG8_STAGE(PG8_SA(1, 0), cA + kstep, voffA); PG8_STAGE(PG8_SB(1, 1), cB + hstep + kstep, voffB);
        PG8_WAIT_V(6); PG8_BAR;
    } else {
        PG8_STAGE(PG8_SB(0, 0), cB, voffB); PG8_STAGE(PG8_SA(0, 0), cA, voffA); PG8_STAGE(PG8_SB(0, 1), cB + hstep, voffB); PG8_STAGE(PG8_SA(0, 1), cA + hstep, voffA);
        if (wr == 1) PG8_BAR;
        PG8_WAIT_V(4); PG8_BAR;
        PG8_STAGE(PG8_SB(1, 0), cB + kstep, voffB); PG8_STAGE(PG8_SA(1, 0), cA + kstep, voffA); PG8_STAGE(PG8_SB(1, 1), cB + hstep + kstep, voffB);
        PG8_WAIT_V(6); PG8_BAR;
    }
    for (;;) {
        const bool has_next = S.next(ui + 1, nxt);
        const char* nA = has_next ? (const char*)g.A + (size_t)nxt.pm * tstep : cA; const char* nB = has_next ? (const char*)g.Bt + (size_t)nxt.pn * tstep : cB;
        for (int t = 0; t < nt; t += 2) {
            const bool last = (t == nt - 2);
            const char* a1 = cA + (size_t)(t + 1) * kstep;
            const char* a2 = last ? nA : cA + (size_t)(t + 2) * kstep; const char* b2 = last ? nB : cB + (size_t)(t + 2) * kstep;
            const char* a3 = a2 + kstep; const char* b3 = b2 + kstep;
            if (last && has_next) S.a_ready(nxt);
            if constexpr (SP2) {
            PG8_LDB(B0, 0, 0); PG8_LDB(B1, 0, 1); PG8_SCHED; PG8_LDA(At, 0, 0); PG8_STAGE(PG8_SA(1, 1), a1 + hstep, voffA);
            PG8_WAIT_V(8); PG8_WAIT_L(0); PG8_BAR; PG8_MMA(0, 0, At, B0); PG8_MMA(0, 1, At, B1); PG8_BAR; PG8_SCHED;
            PG8_LDA(At, 0, 1); PG8_STAGE(PG8_SB(0, 0), b2, voffB); PG8_STAGE(PG8_SB(0, 1), b2 + hstep, voffB); PG8_STAGE(PG8_SA(0, 0), a2, voffA);
            PG8_WAIT_V(8); PG8_WAIT_L(0); PG8_BAR; PG8_MMA(1, 0, At, B0); PG8_MMA(1, 1, At, B1); PG8_BAR; PG8_SCHED;
            PG8_LDB(B0, 1, 0); PG8_LDB(B1, 1, 1); PG8_SCHED; PG8_LDA(At, 1, 0); PG8_STAGE(PG8_SA(0, 1), a2 + hstep, voffA);
            PG8_WAIT_V(8); PG8_WAIT_L(0); PG8_BAR; PG8_MMA(0, 0, At, B0); PG8_MMA(0, 1, At, B1); PG8_BAR; PG8_SCHED;
            PG8_LDA(At, 1, 1); PG8_STAGE(PG8_SB(1, 0), b3, voffB); PG8_STAGE(PG8_SB(1, 1), b3 + hstep, voffB); PG8_STAGE(PG8_SA(1, 0), a3, voffA);
            PG8_WAIT_V(8); PG8_WAIT_L(0); PG8_BAR; PG8_MMA(1, 0, At, B0); PG8_MMA(1, 1, At, B1); PG8_BAR; PG8_SCHED;
            } else {
            PG8_LDB(B0, 0, 0); PG8_SCHED; PG8_LDA(At, 0, 0); PG8_STAGE(PG8_SA(1, 1), a1 + hstep, voffA);
            PG8_WAIT_L(8); PG8_BAR; PG8_WAIT_L(0); PG8_MMA(0, 0, At, B0); PG8_BAR; PG8_SCHED;
            PG8_LDB(B1, 0, 1); PG8_STAGE(PG8_SB(0, 0), b2, voffB);
            PG8_BAR; PG8_WAIT_L(0); PG8_MMA(0, 1, At, B1); PG8_BAR;
            PG8_LDA(At, 0, 1); PG8_STAGE(PG8_SA(0, 0), a2, voffA);
            PG8_BAR; PG8_WAIT_L(0); PG8_MMA(1, 0, At, B0); PG8_BAR; PG8_SCHED;
            PG8_STAGE(PG8_SB(0, 1), b2 + hstep, voffB);
            PG8_WAIT_V(6); PG8_BAR; PG8_MMA(1, 1, At, B1); PG8_BAR;
            PG8_LDB(B0, 1, 0); PG8_SCHED; PG8_LDA(At, 1, 0); PG8_STAGE(PG8_SA(0, 1), a2 + hstep, voffA);
            PG8_WAIT_L(8); PG8_BAR; PG8_WAIT_L(0); PG8_MMA(0, 0, At, B0); PG8_BAR; PG8_SCHED;
            PG8_LDB(B1, 1, 1); PG8_STAGE(PG8_SB(1, 0), b3, voffB);
            PG8_BAR; PG8_WAIT_L(0); PG8_MMA(0, 1, At, B1); PG8_BAR;
            PG8_LDA(At, 1, 1); PG8_STAGE(PG8_SA(1, 0), a3, voffA);
            PG8_BAR; PG8_WAIT_L(0); PG8_MMA(1, 0, At, B0); PG8_BAR; PG8_SCHED;
            PG8_STAGE(PG8_SB(1, 1), b3 + hstep, voffB);
            PG8_WAIT_V(6); PG8_BAR; PG8_MMA(1, 1, At, B1); PG8_BAR;
            }
        }
        if constexpr (ALIGN_EPI) { if (wr == 0) PG8_BAR; }
        if constexpr (!Epi::AFTER_DRAIN) { E(acc, cur, wr, wc, fr, fq); S.done(cur); }
        if (!has_next) break;
#pragma unroll
        for (int a = 0; a < 2; ++a)
#pragma unroll
            for (int b = 0; b < 2; ++b)
#pragma unroll
                for (int m = 0; m < 4; ++m)
#pragma unroll
                    for (int n = 0; n < 2; ++n) acc[a][b][m][n] = (f32x4){0.f, 0.f, 0.f, 0.f};
        cur = nxt; cA = nA; cB = nB; ++ui;
        if constexpr (ALIGN_EPI) { if (wr == 1) PG8_BAR; }
    }
    PG8_WAIT_V(0);
    if constexpr (!ALIGN_EPI) { if (wr == 0) PG8_BAR; }
    PG8_BAR;
    if constexpr (Epi::AFTER_DRAIN) { E.fused(acc, cur, wr, wc, fr, fq, lds, wid, lane); S.done(cur); }
#undef PG8_SA
#undef PG8_SB
#undef PG8_STAGE
#undef PG8_LDA
#undef PG8_LDB
#undef PG8_MMA
#undef PG8_WAIT_V
#undef PG8_WAIT_L
#undef PG8_BAR
#undef PG8_SCHED
}
constexpr int PBI = 544, SBI_BYTES = 64 * PBI;
template <class Epi, class Sched, bool ALIGN_EPI = false>
__device__ __forceinline__ void gemm_phase_bf32(PG8_LAS unsigned char* lds, const Gemm g, const Sched& S, const Epi& E) {
    const int tid = threadIdx.x, wid = __builtin_amdgcn_readfirstlane(tid >> 6), lane = tid & 63, wr = wid >> 2, wc = wid & 3, fr = lane & 15, fq = lane >> 4;
    const int K = g.K, nt = K / BK;
    unsigned voffA[2];
#pragma unroll
    for (int i = 0; i < 2; ++i) { int R, C; stage_rc(tid * 16 + i * 8192, R, C); voffA[i] = (unsigned)(R * K + C) * 2u; }
    const size_t kstep = (size_t)(BK * 2), hstep = (size_t)HALF * K * 2, tstep = 2 * hstep;
    const unsigned ldsw = (unsigned)wid * 1024u;
    const int aoff = lds_byte(wr * 64 + fr, fq * 8);
    const int ldb = S.ldb();
    const size_t bkstep = (size_t)BK * ldb;
    const int q4 = (lane >> 2) & 3, p4 = lane & 3;
    const unsigned bwoff = (unsigned)(8 * wid) * PBI + (unsigned)(((4 * lane) ^ ((wid & 1) << 6)) * 2);
    unsigned broff[2][2];
#pragma unroll
    for (int n = 0; n < 2; ++n)
#pragma unroll
        for (int k = 0; k < 2; ++k) { const int row = 32 * k + 8 * fq + q4, col = 32 * wc + (Epi::PERM ? 8 * p4 + 4 * n : 16 * n + 4 * p4);
            broff[n][k] = (unsigned)row * PBI + (unsigned)((col ^ ((row & 8) << 3)) * 2); }
#define PG8_SA(b, h) (((b) * 2 + (h)) * HTB)
#define PG8_SBI(b) (4 * HTB + (b) * SBI_BYTES)
#define PG8_STAGE(bufoff, gbase, voff) do { _Pragma("unroll") for (int _i = 0; _i < 2; ++_i) \
        __builtin_amdgcn_global_load_lds((const unsigned*)((const char*)(gbase) + (voff)[_i]), (PG8_LAS unsigned*)(lds + (bufoff) + ldsw + _i * 8192), 16, 0, 0); } while (0)
#define PG8_LDA(dst, b, h) do { _Pragma("unroll") for (int m = 0; m < 4; ++m) _Pragma("unroll") for (int k = 0; k < 2; ++k) dst[m][k] = *(const PG8_LAS bf16x8*)(lds + PG8_SA(b, h) + aoff + m * 2048 + k * 1024); } while (0)
#define PG8_LDBT(dst, b, h) do { _Pragma("unroll") for (int n = 0; n < 2; ++n) _Pragma("unroll") for (int k = 0; k < 2; ++k) { \
        const PG8_LAS unsigned char* _a = lds + PG8_SBI(b) + broff[n][k] + (h) * 256; \
        const s16x4 _lo = __builtin_bit_cast(s16x4, __builtin_amdgcn_ds_read_tr16_b64_v4i16((PG8_LAS s16x4*)_a)), _hi = __builtin_bit_cast(s16x4, __builtin_amdgcn_ds_read_tr16_b64_v4i16((PG8_LAS s16x4*)(_a + 4 * PBI))); \
        dst[n][k] = __builtin_shufflevector(_lo, _hi, 0, 1, 2, 3, 4, 5, 6, 7); } } while (0)
#define PG8_BLOAD(bp) do { _Pragma("unroll") for (int _i = 0; _i < 8; ++_i) breg[_i] = *(const __attribute__((address_space(1))) f32x4*)((bp) + (size_t)(8 * wid + _i) * ldb); } while (0)
#define PG8_BWRITE(b) do { _Pragma("unroll") for (int _i = 0; _i < 8; ++_i) { u32x2 _w; _w.x = cvt_pk_bf16(breg[_i][0], breg[_i][1]); _w.y = cvt_pk_bf16(breg[_i][2], breg[_i][3]); \
        *(PG8_LAS u32x2*)(lds + PG8_SBI(b) + bwoff + _i * PBI) = _w; } } while (0)
#define PG8_MMA(ai, bj, At, Bt) do { __builtin_amdgcn_s_setprio(1); _Pragma("unroll") for (int m = 0; m < 4; ++m) _Pragma("unroll") for (int n = 0; n < 2; ++n) _Pragma("unroll") for (int k = 0; k < 2; ++k) \
        acc[ai][bj][m][n] = __builtin_amdgcn_mfma_f32_16x16x32_bf16(Bt[n][k], At[m][k], acc[ai][bj][m][n], 0, 0, 0); __builtin_amdgcn_s_setprio(0); } while (0)
#define PG8_WAIT_V(n) asm volatile("s_waitcnt vmcnt(" #n ")" ::: "memory")
#define PG8_WAIT_L(n) asm volatile("s_waitcnt lgkmcnt(" #n ")" ::: "memory")
#define PG8_BAR __builtin_amdgcn_s_barrier()
#define PG8_SCHED __builtin_amdgcn_sched_barrier(0)
    typedef short s16x4 __attribute__((ext_vector_type(4)));
    typedef unsigned u32x2 __attribute__((ext_vector_type(2)));
    Unit cur, nxt; int ui = 0;
    if (!S.next(0, cur)) return;
    f32x4 acc[2][2][4][2];
#pragma unroll
    for (int a = 0; a < 2; ++a)
#pragma unroll
        for (int b = 0; b < 2; ++b)
#pragma unroll
            for (int m = 0; m < 4; ++m)
#pragma unroll
                for (int n = 0; n < 2; ++n) acc[a][b][m][n] = (f32x4){0.f, 0.f, 0.f, 0.f};
    bf16x8 At[4][2], B0[2][2], B1[2][2];
    f32x4 breg[8];
    const char* cA = (const char*)g.A + (size_t)cur.pm * tstep; const float* cB = S.bptr(cur, lane);
    PG8_BLOAD(cB); PG8_STAGE(PG8_SA(0, 0), cA, voffA); PG8_STAGE(PG8_SA(0, 1), cA + hstep, voffA);
    PG8_BWRITE(0); PG8_SCHED;
    if (wr == 1) PG8_BAR;
    PG8_WAIT_V(2); PG8_WAIT_L(0); PG8_BAR;
    PG8_BLOAD(cB + bkstep); PG8_STAGE(PG8_SA(1, 0), cA + kstep, voffA); PG8_SCHED;
    PG8_WAIT_V(10); PG8_BAR;
    for (;;) {
        const bool has_next = S.next(ui + 1, nxt);
        const char* nA = has_next ? (const char*)g.A + (size_t)nxt.pm * tstep : cA; const float* nB = has_next ? S.bptr(nxt, lane) : cB;
        for (int t = 0; t < nt; t += 2) {
            const bool last = (t == nt - 2);
            const char* a1 = cA + (size_t)(t + 1) * kstep;
            const char* a2 = last ? nA : cA + (size_t)(t + 2) * kstep; const float* b2 = last ? nB : cB + (size_t)(t + 2) * bkstep;
            const char* a3 = a2 + kstep; const float* b3 = b2 + bkstep;
            PG8_LDBT(B0, 0, 0); PG8_LDBT(B1, 0, 1); PG8_SCHED; PG8_LDA(At, 0, 0); PG8_STAGE(PG8_SA(1, 1), a1 + hstep, voffA);
            PG8_WAIT_V(12); PG8_WAIT_L(0); PG8_BAR; PG8_MMA(0, 0, At, B0); PG8_MMA(0, 1, At, B1); PG8_BAR; PG8_SCHED;
            PG8_BWRITE(1); PG8_BLOAD(b2); PG8_SCHED; PG8_LDA(At, 0, 1); PG8_STAGE(PG8_SA(0, 0), a2, voffA);
            PG8_WAIT_V(12); PG8_WAIT_L(0); PG8_BAR; PG8_MMA(1, 0, At, B0); PG8_MMA(1, 1, At, B1); PG8_BAR; PG8_SCHED;
            PG8_LDBT(B0, 1, 0); PG8_LDBT(B1, 1, 1); PG8_SCHED; PG8_LDA(At, 1, 0); PG8_STAGE(PG8_SA(0, 1), a2 + hstep, voffA);
            PG8_WAIT_V(12); PG8_WAIT_L(0); PG8_BAR; PG8_MMA(0, 0, At, B0); PG8_MMA(0, 1, At, B1); PG8_BAR; PG8_SCHED;
            PG8_BWRITE(0); PG8_BLOAD(b3); PG8_SCHED; PG8_LDA(At, 1, 1); PG8_STAGE(PG8_SA(1, 0), a3, voffA);
            PG8_WAIT_V(12); PG8_WAIT_L(0); PG8_BAR; PG8_MMA(1, 0, At, B0); PG8_MMA(1, 1, At, B1); PG8_BAR; PG8_SCHED;
        }
        if constexpr (ALIGN_EPI) { if (wr == 0) PG8_BAR; }
        E(acc, cur, wr, wc, fr, fq); S.done(cur);
        if (!has_next) break;
#pragma unroll
        for (int a = 0; a < 2; ++a)
#pragma unroll
            for (int b = 0; b < 2; ++b)
#pragma unroll
                for (int m = 0; m < 4; ++m)
#pragma unroll
                    for (int n = 0; n < 2; ++n) acc[a][b][m][n] = (f32x4){0.f, 0.f, 0.f, 0.f};
        cur = nxt; cA = nA; cB = nB; ++ui;
        if constexpr (ALIGN_EPI) { if (wr == 1) PG8_BAR; }
    }
    PG8_WAIT_V(0);
    asm volatile("" :: "v"(breg[0]), "v"(breg[1]), "v"(breg[2]), "v"(breg[3]), "v"(breg[4]), "v"(breg[5]), "v"(breg[6]), "v"(breg[7]));
    if constexpr (!ALIGN_EPI) { if (wr == 0) PG8_BAR; }
    PG8_BAR;
#undef PG8_SA
#undef PG8_SBI
#undef PG8_STAGE
#undef PG8_LDA
#undef PG8_LDBT
#undef PG8_BLOAD
#undef PG8_BWRITE
#undef PG8_MMA
#undef PG8_WAIT_V
#undef PG8_WAIT_L
#undef PG8_BAR
#undef PG8_SCHED
}
}

constexpr int NWAVES = 8, NTHR = 512;
constexpr int T = 8192, D = 2048, HW = 7168, INW = 7184, MEMN = 256;
constexpr float LN_EPS = 1e-5f;
constexpr float ALPHA = 1.189207115002721f;
constexpr int NPH = 15;
constexpr int PMAX = 24576;

constexpr size_t MiB = 1u << 20;
constexpr size_t WS_CTL = 0, CTL_ZERO_BYTES = 1 * MiB;
constexpr size_t WS_WMIX = 2 * MiB, WS_WMQ = 10 * MiB, WS_WIN = 18 * MiB, WS_WKV = 46 * MiB, WS_WMO = 62 * MiB, WS_WGU = 70 * MiB, WS_WD = 198 * MiB;
constexpr size_t WS_XB = 262 * MiB, WS_MEMB = 294 * MiB;
constexpr size_t WS_H = 296 * MiB;
constexpr size_t WS_KVM = 408 * MiB;
constexpr size_t WS_ORAW = 410 * MiB;
constexpr size_t WS_MIXED = WS_XB;
constexpr size_t WS_Y1 = WS_ORAW;
constexpr size_t WS_H1B = WS_H;
constexpr size_t WS_QB = 328 * MiB, WS_ATT = 360 * MiB;
constexpr size_t WS_Y2 = 474 * MiB;
constexpr size_t WS_H2B = WS_H;
constexpr size_t WS_XS = 328 * MiB;
constexpr size_t WS_HID = 424 * MiB;
constexpr size_t WS_YS = WS_XS;
constexpr size_t WS_SMALL = 540 * MiB;
constexpr size_t WS_GLR = WS_SMALL;
constexpr size_t WS_RC = WS_SMALL + 1 * MiB, WS_RS = WS_SMALL + 5 * MiB;
constexpr size_t WS_ST1 = WS_SMALL + 9 * MiB, WS_ST2 = WS_ST1 + 65536;
constexpr size_t WS_EXP = WS_ST2 + 65536, WS_GATE = WS_EXP + 65536, WS_POS = WS_GATE + 65536;
constexpr size_t WS_END = 552 * MiB;
constexpr int CW_CNT = 64, CW_CUR = 128, CW_Q = 192;
constexpr int CW_BAR = 4096;

constexpr int RING_BYTES = 139264, LDSCTL_OFF = RING_BYTES, MISC_OFF = LDSCTL_OFF + 320, LDS_BYTES = 147456;

#define GAS __attribute__((address_space(1)))
#define LAS __attribute__((address_space(3)))
typedef unsigned short bf16;
typedef unsigned v4u __attribute__((ext_vector_type(4)));
typedef unsigned v2u __attribute__((ext_vector_type(2)));
typedef float f32x4 __attribute__((ext_vector_type(4)));
typedef GAS unsigned gu32;
#define RLX_AGENT __ATOMIC_RELAXED, __HIP_MEMORY_SCOPE_AGENT
#define LDS_WAIT() asm volatile("s_waitcnt lgkmcnt(0)" ::: "memory")
__device__ __forceinline__ unsigned f2bf(float f) { unsigned u = __builtin_bit_cast(unsigned, f); return (u + 0x7fffu + ((u >> 16) & 1u)) >> 16; }
__device__ __forceinline__ unsigned pk2(float lo, float hi) { return f2bf(lo) | (f2bf(hi) << 16); }
__device__ __forceinline__ float bf2f(unsigned h) { return __builtin_bit_cast(float, h << 16); }
__device__ __forceinline__ float bflo(unsigned w) { return __builtin_bit_cast(float, w << 16); }
__device__ __forceinline__ float bfhi(unsigned w) { return __builtin_bit_cast(float, w & 0xffff0000u); }
__device__ __forceinline__ float wave_sum(float v) {
#pragma unroll
    for (int o = 1; o < 64; o <<= 1) v += __shfl_xor(v, o);
    return v;
}
__device__ __forceinline__ float wave_max(float v) {
#pragma unroll
    for (int o = 1; o < 64; o <<= 1) v = fmaxf(v, __shfl_xor(v, o));
    return v;
}

struct Frame {
    LAS unsigned char* lds;
    volatile LAS unsigned* MISC;
    gu32* ctl;
    int tid, lane, wave, G, bid;
    unsigned char* ws;
    const float* in[25];
    float* out;
};
#define WSP(T_, off) ((T_*)(F.ws + (off)))

__device__ __forceinline__ void transpose_item(const float* W, int ldw, bf16* WTr, int ldt, LAS float* scr, int lane) {
    float tv[32];
#pragma unroll
    for (int i = 0; i < 32; ++i) tv[i] = W[(size_t)(2 * i + (lane >> 5)) * ldw + (lane & 31)];
#pragma unroll
    for (int i = 0; i < 32; ++i) scr[(2 * i + (lane >> 5)) * 33 + (lane & 31)] = tv[i];
    LDS_WAIT(); asm volatile("" ::: "memory");
    const int c = lane & 7;
#pragma unroll
    for (int j = 0; j < 4; ++j) { const int n = (lane >> 3) + 8 * j; const LAS float* s = scr + (8 * c) * 33 + n;
        v4u o; o.x = pk2(s[0 * 33], s[1 * 33]); o.y = pk2(s[2 * 33], s[3 * 33]); o.z = pk2(s[4 * 33], s[5 * 33]); o.w = pk2(s[6 * 33], s[7 * 33]);
        *(GAS v4u*)(WTr + (size_t)n * ldt + 8 * c) = o; }
    LDS_WAIT(); asm volatile("" ::: "memory");
}
__device__ __forceinline__ void p0_prologue(Frame& F) {
    LAS float* scr = (LAS float*)(F.lds + F.wave * 16384);
    const int gw = F.bid * NWAVES + F.wave, NGW = F.G * NWAVES;
    const float* w_in = F.in[3];
    constexpr int I_IN = 32 * 224, I_SQ = 32 * 64;
    for (int it = gw; it < I_IN + 2 * I_SQ; it += NGW) {
        int r = it;
        if (r < I_IN) { const int kb = r / 224, nb = r % 224; transpose_item(w_in + (size_t)(64 * kb) * INW + 32 * nb, INW, WSP(bf16, WS_WIN) + (size_t)(32 * nb) * 2048 + 64 * kb, 2048, scr, F.lane); continue; }
        r -= I_IN;
        { const int w = r / I_SQ, q = r % I_SQ, kb = q / 64, nb = q % 64;
          const float* src = F.in[11]; if (w) src = F.in[12];
          bf16* dst = WSP(bf16, WS_WKV) + (size_t)w * 2048 * 2048;
          transpose_item(src + (size_t)(64 * kb) * 2048 + 32 * nb, 2048, dst + (size_t)(32 * nb) * 2048 + 64 * kb, 2048, scr, F.lane); }
    }
    const int gt = F.bid * NTHR + F.tid, NGT = F.G * NTHR;
    {
        const float* x = F.in[0]; bf16* xb = WSP(bf16, WS_XB);
        for (int i0 = gt; i0 < T * D / 8; i0 += 4 * NGT) { f32x4 a[4], b[4];
#pragma unroll
            for (int u = 0; u < 4; ++u) { const size_t i = (size_t)i0 + (size_t)u * NGT; a[u] = *(const GAS f32x4*)(x + i * 8); b[u] = *(const GAS f32x4*)(x + i * 8 + 4); }
#pragma unroll
            for (int u = 0; u < 4; ++u) { const size_t i = (size_t)i0 + (size_t)u * NGT;
                v4u o; o.x = pk2(a[u][0], a[u][1]); o.y = pk2(a[u][2], a[u][3]); o.z = pk2(b[u][0], b[u][1]); o.w = pk2(b[u][2], b[u][3]); *(GAS v4u*)(xb + i * 8) = o; } }
        const float* mm = F.in[1]; bf16* mb = WSP(bf16, WS_MEMB);
        for (int i = gt; i < MEMN * D / 8; i += NGT) { const f32x4 a = *(const GAS f32x4*)(mm + (size_t)i * 8), b = *(const GAS f32x4*)(mm + (size_t)i * 8 + 4);
            v4u o; o.x = pk2(a[0], a[1]); o.y = pk2(a[2], a[3]); o.z = pk2(b[0], b[1]); o.w = pk2(b[2], b[3]); *(GAS v4u*)(mb + (size_t)i * 8) = o; }
    }
    {
        const int* pos = (const int*)F.in[2]; float* rc = WSP(float, WS_RC); float* rs = WSP(float, WS_RS);
        for (int i = gt; i < T * 128; i += NGT) { const int t = i >> 7, f = i & 127;
            const float inv = exp2f(-(float)f * (13.287712379549449f / 128.0f));
            const float ang = (float)pos[t] * inv;
            double rev = (double)ang * 0.15915494309189535; rev -= floor(rev);
            const float rf = (float)rev;
            rc[i] = __builtin_amdgcn_cosf(rf); rs[i] = __builtin_amdgcn_sinf(rf); }
    }
    {
        const float* x = F.in[0]; float* glr = WSP(float, WS_GLR);
        const int r16 = F.lane & 15, g4 = F.lane >> 4;
        for (int tile = gw; tile < T / 16; tile += NGW) {
            f32x4 acc = {0.f, 0.f, 0.f, 0.f};
            const float* xr = x + (size_t)(tile * 16 + r16) * D + 4 * g4;
            const float* wr = w_in + (size_t)(4 * g4) * INW + HW + r16;
#pragma unroll 4
            for (int k0 = 0; k0 < D; k0 += 16) {
                const f32x4 a = *(const GAS f32x4*)(xr + k0);
                const float b0 = wr[(size_t)(k0 + 0) * INW], b1 = wr[(size_t)(k0 + 1) * INW], b2 = wr[(size_t)(k0 + 2) * INW], b3 = wr[(size_t)(k0 + 3) * INW];
                acc = __builtin_amdgcn_mfma_f32_16x16x4f32(a[0], b0, acc, 0, 0, 0);
                acc = __builtin_amdgcn_mfma_f32_16x16x4f32(a[1], b1, acc, 0, 0, 0);
                acc = __builtin_amdgcn_mfma_f32_16x16x4f32(a[2], b2, acc, 0, 0, 0);
                acc = __builtin_amdgcn_mfma_f32_16x16x4f32(a[3], b3, acc, 0, 0, 0);
            }
#pragma unroll
            for (int j = 0; j < 4; ++j) glr[(size_t)(tile * 16 + 4 * g4 + j) * 16 + r16] = acc[j];
        }
    }
}
__device__ __forceinline__ void transpose_queue(Frame& F, int qsel = 0) {
    LAS float* scr = (LAS float*)(F.lds + F.wave * 16384);
    const float* const i7 = F.in[7]; const float* const i10 = F.in[10]; const float* const i13 = F.in[13]; const float* const i20 = F.in[20]; const float* const i21 = F.in[21]; const float* const i22 = F.in[22];
    constexpr int I_SQ = 32 * 64, I_E = 512, NQ = 3 * I_SQ + 3 * 32 * I_E;
    for (;;) {
        unsigned b0 = 0;
        if (F.lane == 0) b0 = __hip_atomic_fetch_add((unsigned*)(F.ctl + CW_Q + 64 * qsel), 16u, __ATOMIC_RELAXED, __HIP_MEMORY_SCOPE_AGENT);
        b0 = __builtin_amdgcn_readfirstlane(b0);
        if (b0 >= (unsigned)NQ) break;
        for (int it = (int)b0; it < (int)b0 + 16 && it < NQ; ++it) {
            int r = it;
            if (r < 3 * I_SQ) { const int w = r / I_SQ, q = r % I_SQ, kb = q / 64, nb = q % 64;
                const float* src = i7; size_t doff = WS_WMIX; if (w == 1) { src = i10; doff = WS_WMQ; } if (w == 2) { src = i13; doff = WS_WMO; }
                bf16* dst = (bf16*)(F.ws + doff);
                transpose_item(src + (size_t)(64 * kb) * 2048 + 32 * nb, 2048, dst + (size_t)(32 * nb) * 2048 + 64 * kb, 2048, scr, F.lane); continue; }
            r -= 3 * I_SQ;
            if (r < 2 * 32 * I_E) {
                const int up = r / (32 * I_E), q = r % (32 * I_E), e = q / I_E, q2 = q % I_E, kb = q2 / 16, nb = q2 % 16, n0 = 32 * nb;
                const float* sb = i20; if (up) sb = i21;
                const float* src = sb + (size_t)e * 2048 * 512 + (size_t)(64 * kb) * 512 + n0;
                bf16* dst = WSP(bf16, WS_WGU) + (size_t)(e * 1024 + (n0 >> 7) * 256 + up * 128 + (n0 & 127)) * 2048 + 64 * kb;
                transpose_item(src, 512, dst, 2048, scr, F.lane); continue; }
            r -= 2 * 32 * I_E;
            {
                const int e = r / I_E, q2 = r % I_E, kb = q2 / 64, nb = q2 % 64;
                const float* src = i22 + (size_t)e * 512 * 2048 + (size_t)(64 * kb) * 2048 + 32 * nb;
                bf16* dst = WSP(bf16, WS_WD) + (size_t)(e * 2048 + 32 * nb) * 512 + 64 * kb;
                transpose_item(src, 2048, dst, 512, scr, F.lane); }
        }
    }
}

__device__ __forceinline__ float log_sigmoid_f(float z) { return fminf(z, 0.f) - log1pf(expf(-fabsf(z))); }
template <bool GLA>
__device__ __forceinline__ void mixer_naive_item(Frame& F, int hh, int eg) {
    constexpr int ND = GLA ? 4 : 8;
    const bf16* H = WSP(bf16, WS_H); float* oraw = WSP(float, WS_ORAW);
    const int ei = F.tid & 15, dp = F.tid >> 4, e = eg * 16 + ei;
    const int qcol = GLA ? 4096 + hh * 128 : hh * 256, kcol = GLA ? 4608 + hh * 128 : 1024 + hh * 256, vcol = (GLA ? 5120 : 2048) + hh * 256 + e;
    const int ocol = (GLA ? 1024 : 0) + hh * 256 + eg * 16;
    LAS float* red = (LAS float*)F.lds;
    float S[ND];
#pragma unroll
    for (int i = 0; i < ND; ++i) S[i] = 0.f;
    float wa[GLA ? 4 : 1][16]; float ba[GLA ? 4 : 1];
    if (GLA) {
#pragma unroll
        for (int i = 0; i < 4; ++i) { const int d = dp + 32 * i; ba[i] = F.in[5][hh * 128 + d];
#pragma unroll
            for (int r = 0; r < 16; ++r) wa[i][r] = F.in[4][r * 512 + hh * 128 + d]; }
    }
    const float gamma = 1.0f - exp2f(-5.0f - (float)hh);
    const float* glr = WSP(float, WS_GLR);
    for (int t0 = 0; t0 < T; t0 += 8) {
        float part[8];
#pragma unroll
        for (int tt = 0; tt < 8; ++tt) {
            const int t = t0 + tt; const bf16* hr = H + (size_t)t * HW;
            const float v = bf2f(hr[vcol]);
            float g16[16];
            if (GLA) {
#pragma unroll
                for (int r = 0; r < 16; ++r) g16[r] = glr[t * 16 + r];
            }
            float p = 0.f;
#pragma unroll
            for (int i = 0; i < ND; ++i) { const int d = dp + 32 * i;
                const float q = bf2f(hr[qcol + d]), k = bf2f(hr[kcol + d]);
                float a = gamma;
                if (GLA) { float z = ba[i];
#pragma unroll
                    for (int r = 0; r < 16; ++r) z += g16[r] * wa[i][r];
                    a = expf(log_sigmoid_f(z) * 0.0625f); }
                S[i] = a * S[i] + k * v; p += q * S[i]; }
            p += __shfl_xor(p, 16); p += __shfl_xor(p, 32);
            part[tt] = p;
        }
        if (F.lane < 16) {
#pragma unroll
            for (int tt = 0; tt < 8; ++tt) red[(F.wave * 8 + tt) * 16 + F.lane] = part[tt];
        }
        __syncthreads();
        if (F.tid < 128) { const int tt = F.tid >> 4, e2 = F.tid & 15; float s = 0.f;
#pragma unroll
            for (int w = 0; w < 8; ++w) s += red[(w * 8 + tt) * 16 + e2];
            oraw[(size_t)(t0 + tt) * D + ocol + e2] = s; }
        __syncthreads();
    }
}
__device__ __forceinline__ void p2_mixer_naive(Frame& F) {
    for (int item = F.bid; item < 128; item += F.G) {
        const int h8 = item >> 4, eg = item & 15;
        if (h8 < 4) mixer_naive_item<false>(F, h8, eg); else mixer_naive_item<true>(F, h8 - 4, eg);
    }
}
__device__ __forceinline__ void p3_normgate(Frame& F) {
    const bf16* H = WSP(bf16, WS_H); const float* oraw = WSP(float, WS_ORAW); bf16* mixed = WSP(bf16, WS_MIXED);
    const int gw = F.bid * NWAVES + F.wave, NGW = F.G * NWAVES;
    const f32x4 gn = *(const f32x4*)(F.in[6] + 4 * F.lane);
    for (int t = gw; t < T; t += NGW) {
#pragma unroll
        for (int h8 = 0; h8 < 8; ++h8) {
            const f32x4 o = *(const GAS f32x4*)(oraw + (size_t)t * D + h8 * 256 + 4 * F.lane);
            const int gcol = (h8 < 4 ? 3072 : 6144) + (h8 & 3) * 256 + 4 * F.lane;
            const v2u gw2 = *(const GAS v2u*)(H + (size_t)t * HW + gcol);
            const f32x4 gt = {bflo(gw2.x), bfhi(gw2.x), bflo(gw2.y), bfhi(gw2.y)};
            f32x4 y;
            if (h8 < 4) {
                const float mu = wave_sum((o[0] + o[1]) + (o[2] + o[3])) * (1.f / 256.f);
                const f32x4 dd = o - mu;
                const float var = wave_sum((dd[0] * dd[0] + dd[1] * dd[1]) + (dd[2] * dd[2] + dd[3] * dd[3])) * (1.f / 256.f);
                y = dd * (1.0f / sqrtf(var + LN_EPS));
            } else {
                const float ms = wave_sum((o[0] * o[0] + o[1] * o[1]) + (o[2] * o[2] + o[3] * o[3])) * (1.f / 256.f);
                y = o * (1.0f / sqrtf(ms + LN_EPS)) * gn;
            }
            float r[4];
#pragma unroll
            for (int i = 0; i < 4; ++i) { const float g = gt[i]; r[i] = g / (1.0f + expf(-g)) * y[i]; }
            v2u w; w.x = pk2(r[0], r[1]); w.y = pk2(r[2], r[3]);
            *(GAS v2u*)(mixed + (size_t)t * D + h8 * 256 + 4 * F.lane) = w;
        }
    }
}
template <bool ROUTER>
__device__ __forceinline__ void ln_apply(Frame& F, const float* Y, const float* g, const float* b, bf16* HB, float* st, bool count = true) {
    const int gw = F.bid * NWAVES + F.wave, NGW = F.G * NWAVES;
    for (int t = gw; t < T; t += NGW) {
        const GAS f32x4* yr = (const GAS f32x4*)(Y + (size_t)t * D) + F.lane;
        f32x4 v[8]; float s = 0.f;
#pragma unroll
        for (int j = 0; j < 8; ++j) { v[j] = yr[64 * j]; s += (v[j][0] + v[j][1]) + (v[j][2] + v[j][3]); }
        const float mean = wave_sum(s) * (1.f / D); float s2 = 0.f;
#pragma unroll
        for (int j = 0; j < 8; ++j) { v[j] = v[j] - mean; s2 += (v[j][0] * v[j][0] + v[j][1] * v[j][1]) + (v[j][2] * v[j][2] + v[j][3] * v[j][3]); }
        const float rstd = 1.f / sqrtf(wave_sum(s2) * (1.f / D) + LN_EPS);
        if (F.lane == 0) { st[2 * t] = mean; st[2 * t + 1] = rstd; }
        GAS v2u* o8 = (GAS v2u*)(HB + (size_t)t * D) + F.lane;
#pragma unroll
        for (int j = 0; j < 8; ++j) { const f32x4 gv = *(const f32x4*)(g + 4 * F.lane + 256 * j), bv = *(const f32x4*)(b + 4 * F.lane + 256 * j);
            v[j] = v[j] * rstd * gv + bv;
            v2u w; w.x = pk2(v[j][0], v[j][1]); w.y = pk2(v[j][2], v[j][3]); o8[64 * j] = w; }
        if (ROUTER) {
            const float* Wg = F.in[16]; const float* We = F.in[18];
            float lg[4], le[32];
#pragma unroll
            for (int i = 0; i < 4; ++i) lg[i] = 0.f;
#pragma unroll
            for (int i = 0; i < 32; ++i) le[i] = 0.f;
#pragma unroll
            for (int j = 0; j < 8; ++j) {
#pragma unroll
                for (int i = 0; i < 4; ++i) { const int c = 4 * F.lane + 256 * j + i; const float hv = v[j][i];
                    const f32x4 wg = *(const GAS f32x4*)(Wg + (size_t)c * 4);
#pragma unroll
                    for (int q = 0; q < 4; ++q) lg[q] += hv * wg[q];
#pragma unroll
                    for (int q8 = 0; q8 < 8; ++q8) { const f32x4 we = *(const GAS f32x4*)(We + (size_t)c * 32 + 4 * q8);
#pragma unroll
                        for (int q = 0; q < 4; ++q) le[4 * q8 + q] += hv * we[q]; } }
            }
#pragma unroll
            for (int i = 0; i < 4; ++i) lg[i] = wave_sum(lg[i]) + F.in[17][i];
#pragma unroll
            for (int i = 0; i < 32; ++i) le[i] = wave_sum(le[i]);
            int grp = 0; float gm = lg[0];
#pragma unroll
            for (int i = 1; i < 4; ++i) if (lg[i] > gm) { gm = lg[i]; grp = i; }
            float gs = 0.f;
#pragma unroll
            for (int i = 0; i < 4; ++i) gs += expf(lg[i] - gm);
            const float pg_sel = 1.0f / gs;
            float fe[8];
#pragma unroll
            for (int j = 0; j < 8; ++j) { const float a = grp == 0 ? le[j] : grp == 1 ? le[8 + j] : grp == 2 ? le[16 + j] : le[24 + j]; fe[j] = a + F.in[19][grp * 8 + j]; }
            int i1 = 0; float m1 = fe[0];
#pragma unroll
            for (int j = 1; j < 8; ++j) if (fe[j] > m1) { m1 = fe[j]; i1 = j; }
            int i2 = -1; float m2 = -3.0e38f;
#pragma unroll
            for (int j = 0; j < 8; ++j) if (j != i1 && fe[j] > m2) { m2 = fe[j]; i2 = j; }
            const float p2 = expf(m2 - m1), den = 1.0f / (1.0f + p2);
            if (F.lane == 0) {
                int* ex = WSP(int, WS_EXP); float* gt = WSP(float, WS_GATE);
                const int e1 = grp * 8 + i1, e2 = grp * 8 + i2;
                ex[2 * t] = e1; ex[2 * t + 1] = e2; gt[2 * t] = pg_sel * den; gt[2 * t + 1] = pg_sel * p2 * den;
                if (count) { atomicAdd((unsigned*)(F.ctl + CW_CNT) + e1, 1u); atomicAdd((unsigned*)(F.ctl + CW_CNT) + e2, 1u); }
            }
        }
    }
}
__device__ __forceinline__ void p7_attn_naive(Frame& F) {
    const bf16* Q = WSP(bf16, WS_QB); const bf16* KVM = WSP(bf16, WS_KVM); bf16* att = WSP(bf16, WS_ATT);
    LAS float* qs = (LAS float*)F.lds;
    LAS float* sc = (LAS float*)(F.lds + 16384);
    for (int item = F.bid; item < (T / 8) * 4; item += F.G) {
        const int h = item & 3, t0 = (item >> 2) * 8;
        for (int i = F.tid; i < 8 * 512; i += NTHR) { const int tt = i >> 9, d = i & 511; qs[i] = bf2f(Q[(size_t)(t0 + tt) * D + h * 512 + d]); }
        __syncthreads();
        {
            const int j = F.tid & 255, th = F.tid >> 8;
            const bf16* kr = KVM + (size_t)j * 4096 + h * 512;
            float a0 = 0.f, a1 = 0.f, a2 = 0.f, a3 = 0.f;
            for (int d = 0; d < 512; d += 8) {
                const v4u kw = *(const GAS v4u*)(kr + d);
                const float kf[8] = {bflo(kw.x), bfhi(kw.x), bflo(kw.y), bfhi(kw.y), bflo(kw.z), bfhi(kw.z), bflo(kw.w), bfhi(kw.w)};
#pragma unroll
                for (int i = 0; i < 8; ++i) { a0 += kf[i] * qs[(th * 4 + 0) * 512 + d + i]; a1 += kf[i] * qs[(th * 4 + 1) * 512 + d + i]; a2 += kf[i] * qs[(th * 4 + 2) * 512 + d + i]; a3 += kf[i] * qs[(th * 4 + 3) * 512 + d + i]; }
            }
            const float scl = 0.04419417382415922f;
            sc[(th * 4 + 0) * 256 + j] = a0 * scl; sc[(th * 4 + 1) * 256 + j] = a1 * scl; sc[(th * 4 + 2) * 256 + j] = a2 * scl; sc[(th * 4 + 3) * 256 + j] = a3 * scl;
        }
        __syncthreads();
        {
            float v[4]; float mx = -3.0e38f;
#pragma unroll
            for (int i = 0; i < 4; ++i) { v[i] = sc[F.wave * 256 + F.lane + 64 * i]; mx = fmaxf(mx, v[i]); }
            mx = wave_max(mx); float sm = 0.f;
#pragma unroll
            for (int i = 0; i < 4; ++i) { v[i] = expf(v[i] - mx); sm += v[i]; }
            sm = 1.0f / wave_sum(sm);
#pragma unroll
            for (int i = 0; i < 4; ++i) sc[F.wave * 256 + F.lane + 64 * i] = v[i] * sm;
        }
        __syncthreads();
        {
            const int d = F.tid; const bf16* vr = KVM + 2048 + h * 512 + d;
            float o[8];
#pragma unroll
            for (int i = 0; i < 8; ++i) o[i] = 0.f;
            for (int j = 0; j < 256; ++j) { const float vv = bf2f(vr[(size_t)j * 4096]);
#pragma unroll
                for (int i = 0; i < 8; ++i) o[i] += sc[i * 256 + j] * vv; }
#pragma unroll
            for (int i = 0; i < 8; ++i) att[(size_t)(t0 + i) * D + h * 512 + d] = (bf16)f2bf(o[i]);
        }
        __syncthreads();
    }
}
__device__ __forceinline__ void moe_tile_starts(Frame& F, LAS int* ts) {
    if (F.tid < 64) {
        const unsigned c = F.lane < 32 ? __hip_atomic_load(F.ctl + CW_CNT + (F.lane & 31), RLX_AGENT) : 0u;
        int v = (int)((c + 255u) >> 8);
#pragma unroll
        for (int o = 1; o < 32; o <<= 1) { const int n = __shfl_up(v, o); if (F.lane >= o) v += n; }
        if (F.lane < 32) ts[F.lane + 1] = v;
        if (F.lane == 0) ts[0] = 0;
    }
    __syncthreads();
}
__device__ __forceinline__ void p10_dispatch(Frame& F, LAS int* ts) {
    const int gw = F.bid * NWAVES + F.wave, NGW = F.G * NWAVES;
    const int* ex = WSP(int, WS_EXP); int* pos = WSP(int, WS_POS); const bf16* h2 = WSP(bf16, WS_H2B); bf16* xs = WSP(bf16, WS_XS);
    for (int a = gw; a < 2 * T; a += NGW) {
        const int e = ex[a]; unsigned slot = 0;
        if (F.lane == 0) slot = atomicAdd((unsigned*)(F.ctl + CW_CUR) + e, 1u);
        slot = __builtin_amdgcn_readfirstlane(slot);
        const int p = ts[e] * 256 + (int)slot;
        if (F.lane == 0) pos[a] = p;
        const GAS v4u* src = (const GAS v4u*)(h2 + (size_t)(a >> 1) * D) + F.lane; GAS v4u* dst = (GAS v4u*)(xs + (size_t)p * D) + F.lane;
#pragma unroll
        for (int j = 0; j < 4; ++j) dst[64 * j] = src[64 * j];
    }
}
__device__ __forceinline__ void p13_combine(Frame& F) {
    const int gw = F.bid * NWAVES + F.wave, NGW = F.G * NWAVES;
    const float* Y2 = WSP(float, WS_Y2); const float* st2 = WSP(float, WS_ST2); const bf16* ys = WSP(bf16, WS_YS);
    const int* pos = WSP(int, WS_POS); const float* gt = WSP(float, WS_GATE);
    const float* g2 = F.in[14]; const float* b2 = F.in[15]; const float* g3 = F.in[23]; const float* b3 = F.in[24];
    for (int t = gw; t < T; t += NGW) {
        const float mu2 = st2[2 * t], rs2 = st2[2 * t + 1];
        const int p0 = pos[2 * t], p1 = pos[2 * t + 1]; const float w0 = gt[2 * t], w1 = gt[2 * t + 1];
        const GAS f32x4* yr = (const GAS f32x4*)(Y2 + (size_t)t * D) + F.lane;
        const GAS v2u* y0 = (const GAS v2u*)(ys + (size_t)p0 * D) + F.lane; const GAS v2u* y1 = (const GAS v2u*)(ys + (size_t)p1 * D) + F.lane;
        f32x4 v[8]; float s = 0.f;
#pragma unroll
        for (int j = 0; j < 8; ++j) { const f32x4 gv = *(const f32x4*)(g2 + 4 * F.lane + 256 * j), bv = *(const f32x4*)(b2 + 4 * F.lane + 256 * j);
            const f32x4 h = (yr[64 * j] - mu2) * rs2 * gv + bv;
            const v2u a = y0[64 * j], c = y1[64 * j];
            const f32x4 fa = {bflo(a.x), bfhi(a.x), bflo(a.y), bfhi(a.y)}, fc = {bflo(c.x), bfhi(c.x), bflo(c.y), bfhi(c.y)};
            v[j] = h * ALPHA + fa * w0 + fc * w1; s += (v[j][0] + v[j][1]) + (v[j][2] + v[j][3]); }
        const float mean = wave_sum(s) * (1.f / D); float s2 = 0.f;
#pragma unroll
        for (int j = 0; j < 8; ++j) { v[j] = v[j] - mean; s2 += (v[j][0] * v[j][0] + v[j][1] * v[j][1]) + (v[j][2] * v[j][2] + v[j][3] * v[j][3]); }
        const float rstd = 1.f / sqrtf(wave_sum(s2) * (1.f / D) + LN_EPS);
        GAS f32x4* orow = (GAS f32x4*)(F.out + (size_t)t * D) + F.lane;
#pragma unroll
        for (int j = 0; j < 8; ++j) { const f32x4 gv = *(const f32x4*)(g3 + 4 * F.lane + 256 * j), bv = *(const f32x4*)(b3 + 4 * F.lane + 256 * j);
            orow[64 * j] = v[j] * rstd * gv + bv; }
    }
}

constexpr int CS = 128, NB = CS / 64, NS = T / CS;
constexpr size_t WS_BCUM = WS_ORAW;
constexpr size_t WS_KVR = WS_ORAW + 16 * MiB;
constexpr size_t WS_KVG = WS_KVR + 32 * MiB;
typedef short bf16x8_t __attribute__((ext_vector_type(8)));
typedef short s16x4_t __attribute__((ext_vector_type(4)));
__device__ __forceinline__ s16x4_t lds_tr(const LAS unsigned char* p) { return __builtin_bit_cast(s16x4_t, __builtin_amdgcn_ds_read_tr16_b64_v4i16((LAS s16x4_t*)p)); }
__device__ __forceinline__ bf16x8_t frag_tr(const LAS unsigned char* X, int pitch, int k0, int n0, int lane) {
    const int fq = lane >> 4, q = (lane >> 2) & 3, p = lane & 3;
    const LAS unsigned char* a = X + ((k0 + 8 * fq + q) * pitch + n0 + 4 * p) * 2;
    const s16x4_t lo = lds_tr(a), hi = lds_tr(a + 4 * pitch * 2);
    return __builtin_shufflevector(lo, hi, 0, 1, 2, 3, 4, 5, 6, 7);
}
__device__ __forceinline__ bf16x8_t frag_row(const LAS unsigned char* X, int pitch, int r0, int k0, int lane) {
    return *(const LAS bf16x8_t*)(X + ((r0 + (lane & 15)) * pitch + k0 + 8 * (lane >> 4)) * 2);
}
#define MFMA16(a, b, c) __builtin_amdgcn_mfma_f32_16x16x32_bf16((a), (b), (c), 0, 0, 0)
__device__ __forceinline__ float fexp(float x) { return __builtin_amdgcn_exp2f(x * 1.4426950408889634f); }
__device__ __forceinline__ float silu_g(float g) { return g * __builtin_amdgcn_rcpf(1.0f + __builtin_amdgcn_exp2f(-1.4426950408889634f * g)); }

__device__ __forceinline__ void bcum_item(Frame& F, int s, int h) {
    const int c = F.tid & 127, tq = F.tid >> 7;
    LAS float* tot = (LAS float*)F.lds;
    const float* glr = WSP(float, WS_GLR); float* bc = WSP(float, WS_BCUM);
    float w[16];
#pragma unroll
    for (int r = 0; r < 16; ++r) w[r] = F.in[4][r * 512 + h * 128 + c];
    const float bias = F.in[5][h * 128 + c];
    float vals[32]; float run = 0.f;
    const int tb = s * CS + tq * 32;
#pragma unroll
    for (int i = 0; i < 32; ++i) { const float* gr = glr + (size_t)(tb + i) * 16; float z = bias;
#pragma unroll
        for (int r = 0; r < 16; ++r) z += gr[r] * w[r];
        run += log_sigmoid_f(z) * 0.0625f; vals[i] = run; }
    __syncthreads();
    tot[tq * 128 + c] = run;
    __syncthreads();
    float off = 0.f;
#pragma unroll
    for (int q = 0; q < 3; ++q) off += (q < tq) ? tot[q * 128 + c] : 0.f;
#pragma unroll
    for (int i = 0; i < 32; ++i) bc[(size_t)(tb + i) * 512 + h * 128 + c] = vals[i] + off;
}
__device__ __forceinline__ void p1_bcum(Frame& F) { for (int it = F.bid; it < NS * 4; it += F.G) bcum_item(F, it >> 2, it & 3); __syncthreads(); }

__device__ __forceinline__ void unit_sh(int u, int& s, int& h8) { s = (u >> 3) & (NS - 1); h8 = ((u & 7) + 4 * (u >> 8)) & 7; }

template <bool GLA, int MODE>
__device__ __forceinline__ void stage_qk(Frame& F, LAS unsigned char* dst, int s, int jb, int hh, int col0, float lg2gamma) {
    constexpr int DK = GLA ? 128 : 256, PK = DK + 8, CPR = DK / 8, NIT = 64 * CPR / NTHR;
    const bf16* H = WSP(bf16, WS_H); const float* bc = WSP(float, WS_BCUM);
#pragma unroll
    for (int it = 0; it < NIT; ++it) {
        const int ch = F.tid + NTHR * it, r = ch / CPR, cc = ch % CPR, tl = jb * 64 + r, t = s * CS + tl;
        const v4u w = *(const GAS v4u*)(H + (size_t)t * HW + col0 + 8 * cc);
        float f[8] = {bflo(w.x), bfhi(w.x), bflo(w.y), bfhi(w.y), bflo(w.z), bfhi(w.z), bflo(w.w), bfhi(w.w)};
        if (GLA) {
            const f32x4 b0 = *(const GAS f32x4*)(bc + (size_t)t * 512 + hh * 128 + 8 * cc), b1 = *(const GAS f32x4*)(bc + (size_t)t * 512 + hh * 128 + 8 * cc + 4);
            float e[8] = {b0[0], b0[1], b0[2], b0[3], b1[0], b1[1], b1[2], b1[3]};
            if (MODE == 2) { const size_t tl_ = (size_t)(s * CS + CS - 1) * 512 + hh * 128 + 8 * cc; const f32x4 l0 = *(const GAS f32x4*)(bc + tl_), l1 = *(const GAS f32x4*)(bc + tl_ + 4);
                const float l[8] = {l0[0], l0[1], l0[2], l0[3], l1[0], l1[1], l1[2], l1[3]};
#pragma unroll
                for (int i = 0; i < 8; ++i) e[i] = l[i] - e[i]; }
            else if (MODE == 1) {
#pragma unroll
                for (int i = 0; i < 8; ++i) e[i] = -e[i]; }
#pragma unroll
            for (int i = 0; i < 8; ++i) f[i] *= fexp(e[i]);
        } else {
            const float ex = MODE == 0 ? (float)(tl + 1) : MODE == 1 ? -(float)(tl + 1) : (float)(CS - 1 - tl);
            const float fac = __builtin_amdgcn_exp2f(ex * lg2gamma);
#pragma unroll
            for (int i = 0; i < 8; ++i) f[i] *= fac;
        }
        v4u o; o.x = pk2(f[0], f[1]); o.y = pk2(f[2], f[3]); o.z = pk2(f[4], f[5]); o.w = pk2(f[6], f[7]);
        *(LAS v4u*)(dst + (r * PK + 8 * cc) * 2) = o;
    }
}
__device__ __forceinline__ void stage_v(Frame& F, LAS unsigned char* dst, int s, int jb, int col0) {
    const bf16* H = WSP(bf16, WS_H);
#pragma unroll
    for (int it = 0; it < 4; ++it) { const int ch = F.tid + NTHR * it, r = ch >> 5, cc = ch & 31, t = s * CS + jb * 64 + r;
        *(LAS v4u*)(dst + (r * 264 + 8 * cc) * 2) = *(const GAS v4u*)(H + (size_t)t * HW + col0 + 8 * cc); }
}

template <bool GLA>
__device__ __forceinline__ void kv_unit(Frame& F, int s, int hh) {
    constexpr int DK = GLA ? 128 : 256, PK = DK + 8, NDT = DK / 16;
    LAS unsigned char* Ks = F.lds; LAS unsigned char* Vs = F.lds + 34816;
    const int kcol = GLA ? 4608 + hh * 128 : 1024 + hh * 256, vcol = (GLA ? 5120 : 2048) + hh * 256;
    const float lg2g = log2f(1.0f - exp2f(-5.0f - (float)hh));
    f32x4 acc[2][NDT];
#pragma unroll
    for (int a = 0; a < 2; ++a)
#pragma unroll
        for (int d = 0; d < NDT; ++d) acc[a][d] = (f32x4){0.f, 0.f, 0.f, 0.f};
    for (int jb = 0; jb < NB; ++jb) {
        __syncthreads();
        stage_qk<GLA, 2>(F, Ks, s, jb, hh, kcol, lg2g);
        stage_v(F, Vs, s, jb, vcol);
        __syncthreads();
#pragma unroll
        for (int ks = 0; ks < 2; ++ks) {
            bf16x8_t vf[2];
#pragma unroll
            for (int et = 0; et < 2; ++et) vf[et] = frag_tr(Vs, 264, 32 * ks, 32 * F.wave + 16 * et, F.lane);
#pragma unroll
            for (int dt = 0; dt < NDT; ++dt) { const bf16x8_t kf = frag_tr(Ks, PK, 32 * ks, 16 * dt, F.lane);
#pragma unroll
                for (int et = 0; et < 2; ++et) acc[et][dt] = MFMA16(kf, vf[et], acc[et][dt]); }
        }
    }
    bf16* kv = GLA ? (WSP(bf16, WS_KVG) + (size_t)(s * 4 + hh) * 256 * 128) : (WSP(bf16, WS_KVR) + (size_t)(s * 4 + hh) * 256 * 256);
    const int fr = F.lane & 15, fq = F.lane >> 4;
#pragma unroll
    for (int et = 0; et < 2; ++et)
#pragma unroll
        for (int dt = 0; dt < NDT; ++dt) { v2u w; w.x = pk2(acc[et][dt][0], acc[et][dt][1]); w.y = pk2(acc[et][dt][2], acc[et][dt][3]);
            *(GAS v2u*)(kv + (size_t)(32 * F.wave + 16 * et + fr) * DK + 16 * dt + 4 * fq) = w; }
}
__device__ __forceinline__ void p2_kv(Frame& F) {
    for (int u = F.bid; u < 8 * NS; u += F.G) { int s, h8; unit_sh(u, s, h8);
        if (s == NS - 1) continue;
        if (h8 < 4) kv_unit<false>(F, s, h8); else kv_unit<true>(F, s, h8 - 4); }
    __syncthreads();
}
__device__ __forceinline__ void p3_scan(Frame& F) {
    constexpr int NR = 4 * 256 * 64, NG = 4 * 256 * 32, NITEM = NR + NG;
    const float* bc = WSP(float, WS_BCUM);
    const int per = (NITEM + F.G - 1) / F.G;
    for (int k0 = F.tid; k0 < per; k0 += NTHR) {
      const int it = F.bid * per + k0;
      if (it < NITEM) {
        const bool gla = it >= NR; const int r = gla ? it - NR : it;
        const int sh = gla ? 5 : 6, dk = gla ? 128 : 256;
        const int cc = r & ((1 << sh) - 1), e = (r >> sh) & 255, hh = r >> (sh + 8);
        bf16* base = (gla ? WSP(bf16, WS_KVG) : WSP(bf16, WS_KVR)) + ((size_t)hh * 256 + e) * dk + 4 * cc;
        const size_t sstride = (size_t)4 * 256 * dk;
        const float dret = __builtin_amdgcn_exp2f((float)CS * log2f(1.0f - exp2f(-5.0f - (float)hh)));
        float S[4] = {0.f, 0.f, 0.f, 0.f};
#pragma unroll 8
        for (int s = 0; s < NS - 1; ++s) {
            GAS v2u* p = (GAS v2u*)(base + (size_t)s * sstride);
            const v2u w = *p;
            v2u o; o.x = pk2(S[0], S[1]); o.y = pk2(S[2], S[3]);
            *p = o;
            const float f[4] = {bflo(w.x), bfhi(w.x), bflo(w.y), bfhi(w.y)};
            float dec[4] = {dret, dret, dret, dret};
            if (gla) { const f32x4 l0 = *(const GAS f32x4*)(bc + (size_t)(s * CS + CS - 1) * 512 + hh * 128 + 4 * cc);
                dec[0] = fexp(l0[0]); dec[1] = fexp(l0[1]); dec[2] = fexp(l0[2]); dec[3] = fexp(l0[3]); }
#pragma unroll
            for (int i = 0; i < 4; ++i) S[i] = dec[i] * S[i] + f[i];
        }
        { GAS v2u* p = (GAS v2u*)(base + (size_t)(NS - 1) * sstride); v2u o; o.x = pk2(S[0], S[1]); o.y = pk2(S[2], S[3]); *p = o; }
      }
    }
}
template <bool GLA>
__device__ __forceinline__ void out_unit(Frame& F, int s, int hh) {
    constexpr int DK = GLA ? 128 : 256, PK = DK + 8, NKS = DK / 32;
    LAS unsigned char* Qs = F.lds; LAS unsigned char* Ks = F.lds + 33792; LAS unsigned char* Vs = F.lds + 67584; LAS unsigned char* Ps = F.lds + 101376;
    LAS float* red = (LAS float*)(F.lds + 110592);
    const int qcol = GLA ? 4096 + hh * 128 : hh * 256, kcol = GLA ? 4608 + hh * 128 : 1024 + hh * 256, vcol = (GLA ? 5120 : 2048) + hh * 256;
    const int gcol = (GLA ? 6144 : 3072) + hh * 256, ocol = (GLA ? 1024 : 0) + hh * 256;
    const float lg2g = log2f(1.0f - exp2f(-5.0f - (float)hh));
    const bf16* H = WSP(bf16, WS_H); bf16* mixed = WSP(bf16, WS_MIXED);
    const bf16* st = GLA ? (WSP(bf16, WS_KVG) + (size_t)(s * 4 + hh) * 256 * 128) : (WSP(bf16, WS_KVR) + (size_t)(s * 4 + hh) * 256 * 256);
    const int fr = F.lane & 15, fq = F.lane >> 4, w = F.wave, mt = w >> 1, nt0 = 2 * (w & 1);
    for (int i = 0; i < NB; ++i) {
        __syncthreads();
        stage_qk<GLA, 0>(F, Qs, s, i, hh, qcol, lg2g);
        f32x4 accO[4][2];
#pragma unroll
        for (int m = 0; m < 4; ++m)
#pragma unroll
            for (int n = 0; n < 2; ++n) accO[m][n] = (f32x4){0.f, 0.f, 0.f, 0.f};
        for (int j = 0; j <= i; ++j) {
            __syncthreads();
            stage_qk<GLA, 1>(F, Ks, s, j, hh, kcol, lg2g);
            stage_v(F, Vs, s, j, vcol);
            __syncthreads();
            f32x4 accS[2] = {(f32x4){0.f, 0.f, 0.f, 0.f}, (f32x4){0.f, 0.f, 0.f, 0.f}};
#pragma unroll
            for (int ks = 0; ks < NKS; ++ks) { const bf16x8_t qf = frag_row(Qs, PK, 16 * mt, 32 * ks, F.lane);
#pragma unroll
                for (int n2 = 0; n2 < 2; ++n2) { const bf16x8_t kf = frag_row(Ks, PK, 16 * (nt0 + n2), 32 * ks, F.lane); accS[n2] = MFMA16(kf, qf, accS[n2]); } }
#pragma unroll
            for (int n2 = 0; n2 < 2; ++n2) { const int row = 16 * mt + fr, c0 = 16 * (nt0 + n2) + 4 * fq; float pv[4];
#pragma unroll
                for (int jj = 0; jj < 4; ++jj) pv[jj] = (i == j && c0 + jj > row) ? 0.f : accS[n2][jj];
                v2u pw; pw.x = pk2(pv[0], pv[1]); pw.y = pk2(pv[2], pv[3]);
                *(LAS v2u*)(Ps + (row * 72 + c0) * 2) = pw; }
            __syncthreads();
#pragma unroll
            for (int ks = 0; ks < 2; ++ks) {
                bf16x8_t vf[2];
#pragma unroll
                for (int n = 0; n < 2; ++n) vf[n] = frag_tr(Vs, 264, 32 * ks, 32 * w + 16 * n, F.lane);
#pragma unroll
                for (int m = 0; m < 4; ++m) { const bf16x8_t pf = frag_row(Ps, 72, 16 * m, 32 * ks, F.lane);
#pragma unroll
                    for (int n = 0; n < 2; ++n) accO[m][n] = MFMA16(vf[n], pf, accO[m][n]); }
            }
        }
        if (s > 0) {
#pragma unroll
            for (int ks = 0; ks < NKS; ++ks) {
                bf16x8_t sf[2];
#pragma unroll
                for (int n = 0; n < 2; ++n) sf[n] = *(const GAS bf16x8_t*)(st + (size_t)(32 * w + 16 * n + fr) * DK + 32 * ks + 8 * fq);
#pragma unroll
                for (int m = 0; m < 4; ++m) { const bf16x8_t qf = frag_row(Qs, PK, 16 * m, 32 * ks, F.lane);
#pragma unroll
                    for (int n = 0; n < 2; ++n) accO[m][n] = MFMA16(sf[n], qf, accO[m][n]); }
            }
        }
#pragma unroll
        for (int m = 0; m < 4; ++m) { float s1 = 0.f, s2 = 0.f;
#pragma unroll
            for (int n = 0; n < 2; ++n)
#pragma unroll
                for (int jj = 0; jj < 4; ++jj) { const float v = accO[m][n][jj]; s1 += v; s2 += v * v; }
            s1 += __shfl_xor(s1, 16); s1 += __shfl_xor(s1, 32); s2 += __shfl_xor(s2, 16); s2 += __shfl_xor(s2, 32);
            if (fq == 0) { red[(w * 64 + 16 * m + fr) * 2] = s1; red[(w * 64 + 16 * m + fr) * 2 + 1] = s2; } }
        __syncthreads();
#pragma unroll
        for (int m = 0; m < 4; ++m) { const int row = 16 * m + fr; float s1 = 0.f, s2 = 0.f;
#pragma unroll
            for (int ww = 0; ww < 8; ++ww) { s1 += red[(ww * 64 + row) * 2]; s2 += red[(ww * 64 + row) * 2 + 1]; }
            const float mean = s1 * (1.f / 256.f), ex2 = s2 * (1.f / 256.f);
            const float mu = GLA ? 0.f : mean, var = GLA ? ex2 : fmaxf(ex2 - mean * mean, 0.f);
            const float rstd = 1.0f / sqrtf(var + LN_EPS);
            const int t = s * CS + i * 64 + row;
#pragma unroll
            for (int n = 0; n < 2; ++n) { const int e = 32 * w + 16 * n + 4 * fq;
                const v2u gw2 = *(const GAS v2u*)(H + (size_t)t * HW + gcol + e);
                const float gt[4] = {bflo(gw2.x), bfhi(gw2.x), bflo(gw2.y), bfhi(gw2.y)};
                f32x4 gn = {1.f, 1.f, 1.f, 1.f}; if (GLA) gn = *(const f32x4*)(F.in[6] + e);
                float r4[4];
#pragma unroll
                for (int jj = 0; jj < 4; ++jj) { const float y = (accO[m][n][jj] - mu) * rstd * gn[jj]; r4[jj] = silu_g(gt[jj]) * y; }
                v2u ow; ow.x = pk2(r4[0], r4[1]); ow.y = pk2(r4[2], r4[3]);
                *(GAS v2u*)(mixed + (size_t)t * D + ocol + e) = ow; } }
    }
}
__device__ __forceinline__ void p4_out(Frame& F) {
    for (int u = F.bid; u < 8 * NS; u += F.G) { int s, h8; unit_sh(u, s, h8);
        if (h8 < 4) out_unit<false>(F, s, h8); else out_unit<true>(F, s, h8 - 4); }
    __syncthreads();
}

__device__ __forceinline__ void stage_kv_chunk(Frame& F, LAS unsigned char* dst, const bf16* src  ) {
#pragma unroll
    for (int it = 0; it < 8; ++it) { const int ch = F.tid + NTHR * it, r = ch >> 4, cc = ch & 15;
        *(LAS v4u*)(dst + (r * 136 + 8 * cc) * 2) = *(const GAS v4u*)(src + (size_t)r * 4096 + 8 * cc); }
}
__device__ __forceinline__ void p8_attn(Frame& F) {
    const bf16* Q = WSP(bf16, WS_QB); const bf16* KVM = WSP(bf16, WS_KVM); bf16* att = WSP(bf16, WS_ATT);
    LAS unsigned char* Cs = F.lds;
    const int fr = F.lane & 15, fq = F.lane >> 4, q4 = (F.lane >> 2) & 3, p4 = F.lane & 3;
    for (int u = F.bid; u < (T / 128) * 4; u += F.G) {
        const int h = u & 3, r0 = (u >> 2) * 128 + 16 * F.wave;
        f32x4 accS[16];
#pragma unroll
        for (int i = 0; i < 16; ++i) accS[i] = (f32x4){0.f, 0.f, 0.f, 0.f};
        for (int dc = 0; dc < 4; ++dc) {
            __syncthreads();
            stage_kv_chunk(F, Cs, KVM + h * 512 + dc * 128);
            bf16x8_t qf[4];
#pragma unroll
            for (int ks = 0; ks < 4; ++ks) qf[ks] = *(const GAS bf16x8_t*)(Q + (size_t)(r0 + fr) * D + h * 512 + dc * 128 + 32 * ks + 8 * fq);
            __syncthreads();
#pragma unroll
            for (int ks = 0; ks < 4; ++ks)
#pragma unroll
                for (int nt = 0; nt < 16; ++nt) accS[nt] = MFMA16(frag_row(Cs, 136, 16 * nt, 32 * ks, F.lane), qf[ks], accS[nt]);
        }
        float mx = -3.0e38f;
#pragma unroll
        for (int nt = 0; nt < 16; ++nt)
#pragma unroll
            for (int jj = 0; jj < 4; ++jj) mx = fmaxf(mx, accS[nt][jj]);
        mx = fmaxf(mx, __shfl_xor(mx, 16)); mx = fmaxf(mx, __shfl_xor(mx, 32));
        const float sl2 = 0.04419417382415922f * 1.4426950408889634f;
        float sm = 0.f;
#pragma unroll
        for (int nt = 0; nt < 16; ++nt)
#pragma unroll
            for (int jj = 0; jj < 4; ++jj) { const float p = __builtin_amdgcn_exp2f((accS[nt][jj] - mx) * sl2); accS[nt][jj] = p; sm += p; }
        sm += __shfl_xor(sm, 16); sm += __shfl_xor(sm, 32);
        const float inv = 1.0f / sm;
        bf16x8_t pf[8];
#pragma unroll
        for (int ks2 = 0; ks2 < 8; ++ks2) { v4u w; w.x = pk2(accS[2 * ks2][0] * inv, accS[2 * ks2][1] * inv); w.y = pk2(accS[2 * ks2][2] * inv, accS[2 * ks2][3] * inv);
            w.z = pk2(accS[2 * ks2 + 1][0] * inv, accS[2 * ks2 + 1][1] * inv); w.w = pk2(accS[2 * ks2 + 1][2] * inv, accS[2 * ks2 + 1][3] * inv); pf[ks2] = __builtin_bit_cast(bf16x8_t, w); }
        for (int ec = 0; ec < 4; ++ec) {
            __syncthreads();
            stage_kv_chunk(F, Cs, KVM + 2048 + h * 512 + ec * 128);
            __syncthreads();
            f32x4 accO[8];
#pragma unroll
            for (int i = 0; i < 8; ++i) accO[i] = (f32x4){0.f, 0.f, 0.f, 0.f};
#pragma unroll
            for (int ks2 = 0; ks2 < 8; ++ks2)
#pragma unroll
                for (int et = 0; et < 8; ++et) { const LAS unsigned char* a = Cs + ((32 * ks2 + 4 * fq + q4) * 136 + 16 * et + 4 * p4) * 2;
                    const s16x4_t lo = lds_tr(a), hi = lds_tr(a + 16 * 136 * 2);
                    accO[et] = MFMA16(__builtin_shufflevector(lo, hi, 0, 1, 2, 3, 4, 5, 6, 7), pf[ks2], accO[et]); }
#pragma unroll
            for (int et = 0; et < 8; ++et) { v2u w; w.x = pk2(accO[et][0], accO[et][1]); w.y = pk2(accO[et][2], accO[et][3]);
                *(GAS v2u*)(att + (size_t)(r0 + fr) * D + h * 512 + ec * 128 + 16 * et + 4 * fq) = w; }
        }
    }
    __syncthreads();
}

__device__ __forceinline__ void p10_ln_router(Frame& F) {
    const float* Y = WSP(float, WS_Y2); const float* g = F.in[14]; const float* b = F.in[15]; bf16* HB = WSP(bf16, WS_H2B); float* st = WSP(float, WS_ST2);
    const float* Wg = F.in[16]; const float* We = F.in[18];
    LAS float* stl = (LAS float*)F.lds;
    LAS float* part = (LAS float*)(F.lds + 1024);
    const int fr = F.lane & 15, fq = F.lane >> 4;
    for (int item = F.bid; item < T / 32; item += F.G) {
        const int row0 = item * 32;
#pragma unroll 1
        for (int i = 0; i < 4; ++i) {
            const int t = row0 + 4 * F.wave + i;
            const GAS f32x4* yr = (const GAS f32x4*)(Y + (size_t)t * D) + F.lane;
            f32x4 v[8]; float s = 0.f;
#pragma unroll
            for (int j = 0; j < 8; ++j) { v[j] = yr[64 * j]; s += (v[j][0] + v[j][1]) + (v[j][2] + v[j][3]); }
            const float mean = wave_sum(s) * (1.f / D); float s2 = 0.f;
#pragma unroll
            for (int j = 0; j < 8; ++j) { v[j] = v[j] - mean; s2 += (v[j][0] * v[j][0] + v[j][1] * v[j][1]) + (v[j][2] * v[j][2] + v[j][3] * v[j][3]); }
            const float rstd = 1.f / sqrtf(wave_sum(s2) * (1.f / D) + LN_EPS);
            if (F.lane == 0) { st[2 * t] = mean; st[2 * t + 1] = rstd; stl[2 * (4 * F.wave + i)] = mean; stl[2 * (4 * F.wave + i) + 1] = rstd; }
            GAS v2u* o8 = (GAS v2u*)(HB + (size_t)t * D) + F.lane;
#pragma unroll
            for (int j = 0; j < 8; ++j) { const f32x4 gv = *(const f32x4*)(g + 4 * F.lane + 256 * j), bv = *(const f32x4*)(b + 4 * F.lane + 256 * j);
                const f32x4 hv = v[j] * rstd * gv + bv;
                v2u w; w.x = pk2(hv[0], hv[1]); w.y = pk2(hv[2], hv[3]); o8[64 * j] = w; }
        }
        __syncthreads();
        {
            const int rt = F.wave >> 2, kq = F.wave & 3;
            const int r = row0 + 16 * rt + fr;
            const float mu = stl[2 * (16 * rt + fr)], rstd = stl[2 * (16 * rt + fr) + 1];
            f32x4 acc0 = {0.f, 0.f, 0.f, 0.f}, acc1 = acc0, acc2 = acc0;
            const float* yp = Y + (size_t)r * D + 512 * kq + 4 * fq;
            const float* wep = We + (size_t)(512 * kq + 4 * fq) * 32 + fr;
            const float* wgp = Wg + (size_t)(512 * kq + 4 * fq) * 4 + (fr & 3);
            const float gm = fr < 4 ? 1.f : 0.f;
#pragma unroll 8
            for (int it = 0; it < 32; ++it) {
                const int k0 = 16 * it;
                const f32x4 y4 = *(const GAS f32x4*)(yp + k0), g4 = *(const f32x4*)(g + 512 * kq + 4 * fq + k0), b4 = *(const f32x4*)(b + 512 * kq + 4 * fq + k0);
                const f32x4 a = (y4 - mu) * rstd * g4 + b4;
#pragma unroll
                for (int s = 0; s < 4; ++s) {
                    const float b0 = wep[(size_t)(k0 + s) * 32], b1 = wep[(size_t)(k0 + s) * 32 + 16], b2 = wgp[(size_t)(k0 + s) * 4] * gm;
                    acc0 = __builtin_amdgcn_mfma_f32_16x16x4f32(a[s], b0, acc0, 0, 0, 0);
                    acc1 = __builtin_amdgcn_mfma_f32_16x16x4f32(a[s], b1, acc1, 0, 0, 0);
                    acc2 = __builtin_amdgcn_mfma_f32_16x16x4f32(a[s], b2, acc2, 0, 0, 0);
                }
            }
            LAS float* pw = part + F.wave * 768;
#pragma unroll
            for (int jj = 0; jj < 4; ++jj) { pw[(4 * fq + jj) * 48 + fr] = acc0[jj]; pw[(4 * fq + jj) * 48 + 16 + fr] = acc1[jj]; pw[(4 * fq + jj) * 48 + 32 + fr] = acc2[jj]; }
        }
        __syncthreads();
        if (F.tid < 32) {
            const int rt = F.tid >> 4, rr = F.tid & 15, t = row0 + F.tid;
            float le[32], lg[4];
#pragma unroll
            for (int c = 0; c < 32; ++c) { float s = 0.f;
#pragma unroll
                for (int kq = 0; kq < 4; ++kq) s += part[(rt * 4 + kq) * 768 + rr * 48 + c]; le[c] = s; }
#pragma unroll
            for (int c = 0; c < 4; ++c) { float s = 0.f;
#pragma unroll
                for (int kq = 0; kq < 4; ++kq) s += part[(rt * 4 + kq) * 768 + rr * 48 + 32 + c]; lg[c] = s + F.in[17][c]; }
            int grp = 0; float gmx = lg[0];
#pragma unroll
            for (int i = 1; i < 4; ++i) if (lg[i] > gmx) { gmx = lg[i]; grp = i; }
            float gs = 0.f;
#pragma unroll
            for (int i = 0; i < 4; ++i) gs += expf(lg[i] - gmx);
            const float pg_sel = 1.0f / gs;
            float fe[8];
#pragma unroll
            for (int j = 0; j < 8; ++j) { const float a = grp == 0 ? le[j] : grp == 1 ? le[8 + j] : grp == 2 ? le[16 + j] : le[24 + j]; fe[j] = a + F.in[19][grp * 8 + j]; }
            int i1 = 0; float m1 = fe[0];
#pragma unroll
            for (int j = 1; j < 8; ++j) if (fe[j] > m1) { m1 = fe[j]; i1 = j; }
            int i2 = -1; float m2 = -3.0e38f;
#pragma unroll
            for (int j = 0; j < 8; ++j) if (j != i1 && fe[j] > m2) { m2 = fe[j]; i2 = j; }
            const float p2 = expf(m2 - m1), den = 1.0f / (1.0f + p2);
            int* ex = WSP(int, WS_EXP); float* gt = WSP(float, WS_GATE);
            const int e1 = grp * 8 + i1, e2 = grp * 8 + i2;
            ex[2 * t] = e1; ex[2 * t + 1] = e2; gt[2 * t] = pg_sel * den; gt[2 * t + 1] = pg_sel * p2 * den;
            atomicAdd((unsigned*)(F.ctl + CW_CNT) + e1, 1u); atomicAdd((unsigned*)(F.ctl + CW_CNT) + e2, 1u);
        }
        __syncthreads();
    }
}

#define XB_TMO      128
#define XB_XCNT(j)  (256  + 64 * (j))
#define XB_XSUB(j)  (1280 + 64 * (j))
#define XB_XGEN(j)  (2304 + 64 * (j))
#define XB_TOP      3328
#define XB_TOPGEN   3392
#define XCD_BAR_WORDS 3456
#define XB_SPIN_CAP (1u << 22)
__device__ __forceinline__ unsigned xb_ld(unsigned* p)              { return __hip_atomic_load(p, __ATOMIC_RELAXED, __HIP_MEMORY_SCOPE_AGENT); }
__device__ __forceinline__ unsigned xb_add(unsigned* p, unsigned v) { return __hip_atomic_fetch_add(p, v, __ATOMIC_RELAXED, __HIP_MEMORY_SCOPE_AGENT); }
__device__ __forceinline__ unsigned xb_xcc_id() { return (unsigned)__builtin_amdgcn_s_getreg((3 << 11) | 20) & 0xFu; }
#define XB_SPIN(cond, bar) do { unsigned _sp = 0; while (cond) { __builtin_amdgcn_s_sleep(1); \
    if ((++_sp & 255u) == 0u) { if (xb_ld(&(bar)[XB_TMO])) break; if (_sp > XB_SPIN_CAP) { atomicAdd(&(bar)[XB_TMO], 1u); break; } } } } while (0)
struct XcdBarrier { unsigned* bar; unsigned x; volatile LAS unsigned* st; };
__device__ __forceinline__ XcdBarrier xcd_barrier_post(unsigned* bar, volatile LAS unsigned* st) {
    XcdBarrier b; b.bar = bar; b.x = xb_xcc_id(); b.st = st;
    if (threadIdx.x == 0) (void)xb_add(&bar[XB_XCNT(b.x)], 1u);
    return b;
}
__device__ __forceinline__ void xcd_barrier_complete(unsigned* bar, unsigned x, unsigned& nloc, unsigned& nx) {
    const unsigned G = gridDim.x * gridDim.y * gridDim.z;
    unsigned sum, cnt, mine, sp = 0u;
    for (;;) {
        sum = 0u; cnt = 0u; mine = 0u;
#pragma unroll
        for (unsigned j = 0; j < 16; ++j) { const unsigned c = xb_ld(&bar[XB_XCNT(j)]); sum += c; cnt += (c > 0u) ? 1u : 0u; mine = (j == x) ? c : mine; }
        if (sum == G) break;
        __builtin_amdgcn_s_sleep(1);
        if ((++sp & 255u) == 0u) { if (xb_ld(&bar[XB_TMO])) break; if (sp > XB_SPIN_CAP) { atomicAdd(&bar[XB_TMO], 1u); break; } }
    }
    nloc = mine > 0u ? mine : 1u; nx = cnt > 0u ? cnt : 1u;
}
__device__ __forceinline__ void xcd_barrier(const XcdBarrier& b) {
    asm volatile("s_waitcnt vmcnt(0)" ::: "memory");
    __syncthreads();
    if (threadIdx.x == 0) {
        unsigned* bar = b.bar;
        __builtin_amdgcn_s_waitcnt(0);
        unsigned nloc = b.st[0], nx = b.st[1];
        if (nloc == 0u) { xcd_barrier_complete(bar, b.x, nloc, nx); b.st[0] = nloc; b.st[1] = nx; }
        const unsigned old = xb_add(&bar[XB_XSUB(b.x)], 1u);
        const unsigned gen = old / nloc;
        if (old + 1u == (gen + 1u) * nloc) {
            __builtin_amdgcn_fence(__ATOMIC_RELEASE, "agent");
            asm volatile("s_waitcnt vmcnt(0)" ::: "memory");
            const unsigned og = xb_add(&bar[XB_TOP], 1u);
            const unsigned tg = og / nx;
            if (og + 1u == (tg + 1u) * nx) xb_add(&bar[XB_TOPGEN], 1u);
            else XB_SPIN(xb_ld(&bar[XB_TOPGEN]) == tg, bar);
            __builtin_amdgcn_fence(__ATOMIC_ACQUIRE, "agent");
            xb_add(&bar[XB_XGEN(b.x)], 1u);
            asm volatile("s_waitcnt vmcnt(0)" ::: "memory");
        } else {
            XB_SPIN(xb_ld(&bar[XB_XGEN(b.x)]) == gen, bar);
            __builtin_amdgcn_fence(__ATOMIC_ACQUIRE, "agent");
            asm volatile("s_waitcnt vmcnt(0)" ::: "memory");
        }
    }
    __syncthreads();
}

struct Args { const float* in[25]; float* out; unsigned char* ws; int ph_lo, ph_hi, use_bar, pad; };
__global__ void __launch_bounds__(NTHR, 2) mega(Args args) {
    extern __shared__ __attribute__((aligned(16))) unsigned char lds[];
    Frame F;
    F.lds = (LAS unsigned char*)lds;
    F.MISC = (volatile LAS unsigned*)(F.lds + MISC_OFF);
    F.tid = threadIdx.x; F.lane = F.tid & 63; F.wave = __builtin_amdgcn_readfirstlane(F.tid >> 6);
    F.G = gridDim.x; F.bid = blockIdx.x;
    F.ws = args.ws; F.ctl = (gu32*)(args.ws + WS_CTL);
#pragma unroll
    for (int i = 0; i < 25; ++i) F.in[i] = args.in[i];
    F.out = args.out;
    for (int u = F.tid; u < (LDS_BYTES - LDSCTL_OFF) / 4; u += NTHR) ((LAS unsigned*)(F.lds + LDSCTL_OFF))[u] = 0u;
    __syncthreads();
    LAS int* ts = (LAS int*)(F.lds + MISC_OFF + 64);
    XcdBarrier bar; bar.bar = (unsigned*)(F.ctl + CW_BAR); bar.x = 0; bar.st = nullptr;
    if (args.use_bar) bar = xcd_barrier_post((unsigned*)(F.ctl + CW_BAR), F.MISC + 8);
    const int lo = args.ph_lo, hi = args.ph_hi;
#if MK_CG_SYNC == 2
    if (args.use_bar == 2) cooperative_groups::this_grid().sync();
#endif
#define IN(k) (lo <= (k) && (k) < hi)
#define REPS(k) for (int _r = 0; _r < ((k) == PROBE_PH ? PROBE_N : 1); ++_r)
#define SEAM(k) do { if (IN(k) && IN((k) + 1)) { if (MK_CG_SYNC == 1 && (k) == 0) cooperative_groups::this_grid().sync(); else { xcd_barrier(bar); if (PROBE_PH == 100) for (int _b = 1; _b < PROBE_N; ++_b) xcd_barrier(bar); } } } while (0)

    if (IN(0)) { REPS(0) p0_prologue(F); SEAM(0); }
    if (IN(1)) {
        p1_bcum(F);
        pg8::Gemm g{WSP(pg8::bf16_t, WS_XB), WSP(pg8::bf16_t, WS_WIN), T + MEMN, HW + 4096, D}; pg8::OrderG1 S; S.init(F.G, F.bid);
        pg8::EpiH E{WSP(pg8::bf16_t, WS_H), WSP(pg8::bf16_t, WS_KVM), WSP(float, WS_RC), WSP(float, WS_RS)};
        REPS(1) pg8::gemm_phase<pg8::EpiH, pg8::OrderG1, true, true>(F.lds, g, S, E);
        transpose_queue(F);
        if (PROBE_PH == 102) for (int _q = 1; _q < PROBE_N; ++_q) transpose_queue(F, _q);
        SEAM(1);
    }
#if PROBE_PH == 101
    if (IN(1)) {
        pg8::Gemm g{WSP(pg8::bf16_t, WS_XB), WSP(pg8::bf16_t, WS_WIN), T + MEMN, HW + 4096, D}; pg8::OrderG1 S; S.init(F.G, F.bid);
        pg8::EpiH E{WSP(pg8::bf16_t, WS_H), WSP(pg8::bf16_t, WS_KVM), WSP(float, WS_RC), WSP(float, WS_RS)};
        pg8::gemm_phase<pg8::EpiH, pg8::OrderG1, true, true>(F.lds, g, S, E);
        xcd_barrier(bar);
    }
#endif
    if (IN(2)) { REPS(2) p2_kv(F); SEAM(2); }
    if (IN(3)) { p3_scan(F); SEAM(3); }
#if PROBE_PH == 103
    if (IN(3)) { p2_kv(F); xcd_barrier(bar); p3_scan(F); xcd_barrier(bar); }
#endif
    if (IN(4)) { REPS(4) p4_out(F); SEAM(4); }
    if (IN(5)) {
        pg8::Gemm g{WSP(pg8::bf16_t, WS_MIXED), WSP(pg8::bf16_t, WS_WMIX), T, D, D}; pg8::StaticOrder S; S.init(T, D, F.G, F.bid);
        pg8::EpiResX E{F.in[0], WSP(float, WS_Y1), ALPHA};
        REPS(5) pg8::gemm_phase<pg8::EpiResX, pg8::StaticOrder, true, true>(F.lds, g, S, E);
        SEAM(5);
    }
    if (IN(6)) { REPS(6) ln_apply<false>(F, WSP(float, WS_Y1), F.in[8], F.in[9], WSP(bf16, WS_H1B), WSP(float, WS_ST1)); SEAM(6); }
    if (IN(7)) {
        pg8::Gemm g{WSP(pg8::bf16_t, WS_H1B), WSP(pg8::bf16_t, WS_WMQ), T, D, D}; pg8::StaticOrder S; S.init(T, D, F.G, F.bid);
        pg8::EpiB E{WSP(pg8::bf16_t, WS_QB), D, -1};
        REPS(7) pg8::gemm_phase<pg8::EpiB, pg8::StaticOrder, true, true>(F.lds, g, S, E);
        SEAM(7);
    }
    if (IN(8)) { REPS(8) p8_attn(F); SEAM(8); }
    if (IN(9)) {
        pg8::Gemm g{WSP(pg8::bf16_t, WS_ATT), WSP(pg8::bf16_t, WS_WMO), T, D, D}; pg8::StaticOrder S; S.init(T, D, F.G, F.bid);
        pg8::EpiResLN E{WSP(float, WS_Y1), WSP(float, WS_ST1), F.in[8], F.in[9], WSP(float, WS_Y2), ALPHA};
        REPS(9) pg8::gemm_phase<pg8::EpiResLN, pg8::StaticOrder, true, true>(F.lds, g, S, E);
        SEAM(9);
    }
    if (IN(10)) { p10_ln_router(F); SEAM(10); }
    if (IN(11)) { moe_tile_starts(F, ts); p10_dispatch(F, ts); SEAM(11); }
    if (IN(12)) {
        moe_tile_starts(F, ts);
        pg8::Gemm g{WSP(pg8::bf16_t, WS_XS), WSP(pg8::bf16_t, WS_WGU), PMAX, 32 * 1024, D};
        pg8::MoeOrder S{(const PG8_LAS int*)ts, F.G, F.bid, 4, ts[32] * 4, F.in[20], F.in[21], 2048, 512};
        pg8::EpiSwi E{WSP(pg8::bf16_t, WS_HID)};
#if MK_MOE_F32
        REPS(12) pg8::gemm_phase_bf32<pg8::EpiSwi, pg8::MoeOrder, true>(F.lds, g, S, E);
#else
        REPS(12) pg8::gemm_phase<pg8::EpiSwi, pg8::MoeOrder, true, true>(F.lds, g, S, E);
#endif
        SEAM(12);
    }
    if (IN(13)) {
        moe_tile_starts(F, ts);
        pg8::Gemm g{WSP(pg8::bf16_t, WS_HID), WSP(pg8::bf16_t, WS_WD), PMAX, 32 * 2048, 512};
        pg8::MoeOrder S{(const PG8_LAS int*)ts, F.G, F.bid, 8, ts[32] * 8, F.in[22], nullptr, 512, 2048};
        pg8::EpiB E{WSP(pg8::bf16_t, WS_YS), D, 7};
#if MK_MOE_F32
        REPS(13) pg8::gemm_phase_bf32<pg8::EpiB, pg8::MoeOrder, true>(F.lds, g, S, E);
#else
        REPS(13) pg8::gemm_phase<pg8::EpiB, pg8::MoeOrder, true, true>(F.lds, g, S, E);
#endif
        SEAM(13);
    }
    if (IN(14)) { REPS(14) p13_combine(F); }
#undef IN
#undef SEAM
#undef REPS
}

extern "C" void kernel_launch(void* const* d_in, const int* in_sizes, int n_in, void* d_out, int out_size, void* d_ws, size_t ws_size, hipStream_t stream) {
    static int grid = 0;
    if (grid == 0) {
        if (n_in != 25 || in_sizes[0] != T * D || out_size != T * D || ws_size < WS_END) { fprintf(stderr, "kernel_launch: unexpected shapes / workspace (%d inputs, ws %zu)\n", n_in, ws_size); grid = -1; return; }
        int dev = 0, cus = 0;
        if (hipGetDevice(&dev) != hipSuccess || hipDeviceGetAttribute(&cus, hipDeviceAttributeMultiprocessorCount, dev) != hipSuccess) { grid = -1; return; }
        if (hipFuncSetAttribute((const void*)mega, hipFuncAttributeMaxDynamicSharedMemorySize, LDS_BYTES) != hipSuccess) { fprintf(stderr, "kernel_launch: hipFuncSetAttribute failed\n"); grid = -1; return; }
        int per_cu = 0;
        if (hipOccupancyMaxActiveBlocksPerMultiprocessor(&per_cu, (const void*)mega, NTHR, LDS_BYTES) != hipSuccess || per_cu < 1) { fprintf(stderr, "kernel_launch: occupancy query failed / 0 blocks per CU\n"); grid = -1; return; }
        (void)hipGetLastError();
        grid = cus;
    }
    if (grid < 0) return;
    if (hipMemsetAsync((char*)d_ws + WS_CTL, 0, CTL_ZERO_BYTES, stream) != hipSuccess) return;
    Args a{};
    for (int i = 0; i < 25; ++i) a.in[i] = (const float*)d_in[i];
    a.out = (float*)d_out; a.ws = (unsigned char*)d_ws;
#if MK_ONE_LAUNCH
    a.ph_lo = 0; a.ph_hi = NPH; a.use_bar = 1;
#if MK_CG_SYNC
    { void* kargs[] = {(void*)&a};
      hipError_t e = hipLaunchCooperativeKernel((const void*)mega, dim3(grid), dim3(NTHR), kargs, LDS_BYTES, stream);
      if (e != hipSuccess) fprintf(stderr, "cooperative launch failed: %s (grid %d)\n", hipGetErrorString(e), grid); }
#else
    hipLaunchKernelGGL(mega, dim3(grid), dim3(NTHR), LDS_BYTES, stream, a);
#endif
#else
    for (int p = 0; p < NPH; ++p) { a.ph_lo = p; a.ph_hi = p + 1; a.use_bar = 0;
        hipLaunchKernelGGL(mega, dim3(grid), dim3(NTHR), LDS_BYTES, stream, a); }
#endif
}
```

```cpp
#include <hip/hip_runtime.h>
#include <hip/hip_cooperative_groups.h>
#include <cstdio>
#include <cstdint>
#include <cmath>
#ifndef MK_ONE_LAUNCH
#define MK_ONE_LAUNCH 1
#endif
#ifndef MK_CG_SYNC
#define MK_CG_SYNC 2
#endif
#ifndef MK_MOE_F32
#define MK_MOE_F32 0
#endif
#define PROBE_PH -1
#define PROBE_N 1
namespace pg8 {
#define PG8_LAS __attribute__((address_space(3)))
typedef unsigned short bf16_t;
typedef short bf16x8 __attribute__((ext_vector_type(8)));
typedef float f32x4 __attribute__((ext_vector_type(4)));
typedef unsigned u32x4 __attribute__((ext_vector_type(4)));
constexpr int BM = 256, BK = 64, HALF = 128, HTB = HALF * BK * 2  , STAGE_BYTES = 8 * HTB, NXCD = 8, WGM = 8;

__host__ __device__ __forceinline__ int lds_byte(int r, int c) { const int st = (r >> 4) * 2 + (c >> 5), rr = r & 15, cc = c & 31, ob = rr * 64 + cc * 2; return st * 1024 + (ob ^ (((ob >> 9) & 1) << 5)); }
__host__ __device__ __forceinline__ void stage_rc(int b, int& R, int& C) { const int st = b / 1024, sb = b % 1024, swz = sb ^ (((sb >> 9) & 1) << 5); R = (st >> 1) * 16 + swz / 64; C = (st & 1) * 32 + (swz % 64) / 2; }
__host__ __device__ __forceinline__ int perm32(int rho) { const int n = rho >> 4, i = rho & 15; return 8 * (i >> 2) + 4 * n + (i & 3); }

struct Unit { int pm, pn; };
struct Gemm { const bf16_t* A; const bf16_t* Bt; int M, N, K; };

struct StaticOrder {
    int nM, nN, nwg, G, c;
    __host__ __device__ void init(int M, int N, int G_, int c_) { nM = M / BM; nN = N / BM; nwg = nM * nN; G = G_; c = c_; }
    __host__ __device__ bool next(int i, Unit& u) const {
        const long L = (long)i * G + c; if (L >= nwg) return false;
        int wgid = (int)L; { const int q = nwg / NXCD, r = nwg % NXCD, xcd = wgid % NXCD, off = wgid / NXCD; wgid = (xcd < r ? xcd * (q + 1) : r * (q + 1) + (xcd - r) * q) + off; }
        const int nig = WGM * nN, gid = wgid / nig, fm = gid * WGM, gsz = (nM - fm) < WGM ? (nM - fm) : WGM;
        u.pm = fm + ((wgid % nig) % gsz); u.pn = (wgid % nig) / gsz; return true;
    }
    __device__ __forceinline__ void a_ready(const Unit&) const {}
    __device__ __forceinline__ void done(const Unit&) const {}
};


__device__ __forceinline__ unsigned cvt_pk_bf16(float lo, float hi) { unsigned r; asm volatile("v_cvt_pk_bf16_f32 %0, %1, %2" : "=v"(r) : "v"(lo), "v"(hi)); return r; }
__device__ __forceinline__ u32x4 pack8(const f32x4 a, const f32x4 b) { u32x4 w; w.x = cvt_pk_bf16(a[0], a[1]); w.y = cvt_pk_bf16(a[2], a[3]); w.z = cvt_pk_bf16(b[0], b[1]); w.w = cvt_pk_bf16(b[2], b[3]); return w; }
__device__ __forceinline__ float silu_f(float x) { return x * __builtin_amdgcn_rcpf(1.0f + __builtin_amdgcn_exp2f(-1.4426950408889634f * x)); }

struct EpiH {
    static constexpr bool PERM = true, AFTER_DRAIN = false;
    bf16_t* H; bf16_t* KVM; const float* rc; const float* rs;
    __device__ __forceinline__ void operator()(const f32x4 (&acc)[2][2][4][2], const Unit& u, int wr, int wc, int fr, int fq) const {
        const int cb = wc * 32 + 8 * fq;
        if (u.pm >= 32) {
#pragma unroll
            for (int ai = 0; ai < 2; ++ai)
#pragma unroll
                for (int m = 0; m < 4; ++m) { bf16_t* rowp = KVM + (size_t)(wr * 64 + fr + ai * HALF + m * 16) * 4096 + (u.pn - 28) * BM + cb;
#pragma unroll
                    for (int bj = 0; bj < 2; ++bj) *(u32x4*)(rowp + bj * HALF) = pack8(acc[ai][bj][m][0], acc[ai][bj][m][1]); }
            return;
        }
        const int row0 = u.pm * BM + wr * 64 + fr;
        if (u.pn < 8) {
            const float sc = u.pn >= 4 ? 0.0625f : 1.0f;
#pragma unroll
            for (int ai = 0; ai < 2; ++ai)
#pragma unroll
                for (int m = 0; m < 4; ++m) { const int row = row0 + ai * HALF + m * 16;
                    const float* cr = rc + (size_t)row * 128 + cb; const float* sr = rs + (size_t)row * 128 + cb;
                    const f32x4 c0 = *(const f32x4*)cr * sc, c1 = *(const f32x4*)(cr + 4) * sc, s0 = *(const f32x4*)sr * sc, s1 = *(const f32x4*)(sr + 4) * sc;
                    const f32x4 t1a = acc[ai][0][m][0], t1b = acc[ai][0][m][1], t2a = acc[ai][1][m][0], t2b = acc[ai][1][m][1];
                    bf16_t* rowp = H + (size_t)row * 7168 + u.pn * BM + cb;
                    *(u32x4*)(rowp) = pack8(t1a * c0 - t2a * s0, t1b * c1 - t2b * s1);
                    *(u32x4*)(rowp + HALF) = pack8(t1a * s0 + t2a * c0, t1b * s1 + t2b * c1); }
        } else {
            const float sc = (u.pn == 16 || u.pn == 17) ? 0.08838834764831845f : 1.0f;
#pragma unroll
            for (int ai = 0; ai < 2; ++ai)
#pragma unroll
                for (int m = 0; m < 4; ++m) { bf16_t* rowp = H + (size_t)(row0 + ai * HALF + m * 16) * 7168 + u.pn * BM + cb;
#pragma unroll
                    for (int bj = 0; bj < 2; ++bj) *(u32x4*)(rowp + bj * HALF) = pack8(acc[ai][bj][m][0] * sc, acc[ai][bj][m][1] * sc); }
        }
    }
};
struct EpiB {
    static constexpr bool PERM = true, AFTER_DRAIN = false;
    bf16_t* O; int ldc; int pmask;
    __device__ __forceinline__ void operator()(const f32x4 (&acc)[2][2][4][2], const Unit& u, int wr, int wc, int fr, int fq) const {
        const int row0 = u.pm * BM + wr * 64 + fr, col0 = (u.pn & pmask) * BM + wc * 32 + 8 * fq;
#pragma unroll
        for (int ai = 0; ai < 2; ++ai)
#pragma unroll
            for (int m = 0; m < 4; ++m) { bf16_t* rowp = O + (size_t)(row0 + ai * HALF + m * 16) * ldc + col0;
#pragma unroll
                for (int bj = 0; bj < 2; ++bj) *(u32x4*)(rowp + bj * HALF) = pack8(acc[ai][bj][m][0], acc[ai][bj][m][1]); }
    }
};
struct EpiSwi {
    static constexpr bool PERM = true, AFTER_DRAIN = false;
    bf16_t* O;
    __device__ __forceinline__ void operator()(const f32x4 (&acc)[2][2][4][2], const Unit& u, int wr, int wc, int fr, int fq) const {
        const int row0 = u.pm * BM + wr * 64 + fr, col0 = (u.pn & 3) * HALF + wc * 32 + 8 * fq;
#pragma unroll
        for (int ai = 0; ai < 2; ++ai)
#pragma unroll
            for (int m = 0; m < 4; ++m) { bf16_t* rowp = O + (size_t)(row0 + ai * HALF + m * 16) * 512 + col0;
                f32x4 h0, h1;
#pragma unroll
                for (int i = 0; i < 4; ++i) { h0[i] = silu_f(acc[ai][0][m][0][i]) * acc[ai][1][m][0][i]; h1[i] = silu_f(acc[ai][0][m][1][i]) * acc[ai][1][m][1][i]; }
                *(u32x4*)rowp = pack8(h0, h1); }
    }
};
struct EpiResX {
    static constexpr bool PERM = false, AFTER_DRAIN = false;
    const float* X; float* Y; float alpha;
    __device__ __forceinline__ void operator()(const f32x4 (&acc)[2][2][4][2], const Unit& u, int wr, int wc, int fr, int fq) const {
        const int row0 = u.pm * BM + wr * 64 + fr, col0 = u.pn * BM + wc * 32 + 4 * fq;
#pragma unroll
        for (int ai = 0; ai < 2; ++ai)
#pragma unroll
            for (int m = 0; m < 4; ++m) { const size_t off = (size_t)(row0 + ai * HALF + m * 16) * 2048 + col0;
#pragma unroll
                for (int bj = 0; bj < 2; ++bj)
#pragma unroll
                    for (int n = 0; n < 2; ++n) { const f32x4 xv = *(const f32x4*)(X + off + bj * HALF + n * 16); *(f32x4*)(Y + off + bj * HALF + n * 16) = xv * alpha + acc[ai][bj][m][n]; } }
    }
};
struct EpiResLN {
    static constexpr bool PERM = false, AFTER_DRAIN = false;
    const float* Yin; const float* st; const float* g; const float* b; float* Y; float alpha;
    __device__ __forceinline__ void operator()(const f32x4 (&acc)[2][2][4][2], const Unit& u, int wr, int wc, int fr, int fq) const {
        const int row0 = u.pm * BM + wr * 64 + fr, col0 = u.pn * BM + wc * 32 + 4 * fq;
        f32x4 gv[2][2], bv[2][2];
#pragma unroll
        for (int bj = 0; bj < 2; ++bj)
#pragma unroll
            for (int n = 0; n < 2; ++n) { gv[bj][n] = *(const f32x4*)(g + col0 + bj * HALF + n * 16) * alpha; bv[bj][n] = *(const f32x4*)(b + col0 + bj * HALF + n * 16) * alpha; }
#pragma unroll
        for (int ai = 0; ai < 2; ++ai)
#pragma unroll
            for (int m = 0; m < 4; ++m) { const int row = row0 + ai * HALF + m * 16; const size_t off = (size_t)row * 2048 + col0;
                const float mu = st[2 * row], rstd = st[2 * row + 1];
#pragma unroll
                for (int bj = 0; bj < 2; ++bj)
#pragma unroll
                    for (int n = 0; n < 2; ++n) { const f32x4 yv = *(const f32x4*)(Yin + off + bj * HALF + n * 16);
                        *(f32x4*)(Y + off + bj * HALF + n * 16) = ((yv - mu) * rstd) * gv[bj][n] + bv[bj][n] + acc[ai][bj][m][n]; } }
    }
};

struct OrderG1 {
    StaticOrder so; int G, c;
    __device__ void init(int G_, int c_) { so.init(8192, 7168, G_, c_); G = G_; c = c_; }
    __device__ bool next(int i, Unit& u) const {
        const int L = i * G + c;
        if (L < 896) return so.next(i, u);
        if (L >= 912) return false;
        u.pm = 32; u.pn = 28 + (L - 896); return true;
    }
    __device__ __forceinline__ void a_ready(const Unit&) const {}
    __device__ __forceinline__ void done(const Unit&) const {}
};
struct MoeOrder {
    const PG8_LAS int* ts; int G, c, npn, total; const float* W0; const float* W1; int kdim, ncols;
    __device__ bool next(int i, Unit& u) const {
        const int L = i * G + c; if (L >= total) return false;
        const int rt = L / npn, pl = L - rt * npn; int e = 0;
        for (int j = 1; j < 32; ++j) e += (ts[j] <= rt) ? 1 : 0;
        u.pm = rt; u.pn = e * npn + pl; return true;
    }
    __device__ __forceinline__ int ldb() const { return ncols; }
    __device__ __forceinline__ const float* bptr(const Unit& u, int lane) const {
        const int e = u.pn / npn, pl = u.pn - e * npn; const size_t eo = (size_t)e * kdim * ncols;
        if (W1) return (lane < 32 ? W0 : W1) + eo + 128 * pl + 4 * (lane & 31);
        return W0 + eo + 256 * pl + 4 * lane;
    }
    __device__ __forceinline__ void a_ready(const Unit&) const {}
    __device__ __forceinline__ void done(const Unit&) const {}
};

template <class Epi, class Sched, bool ALIGN_EPI = false, bool SP2 = false>
__device__ __forceinline__ void gemm_phase(PG8_LAS unsigned char* lds, const Gemm g, const Sched& S, const Epi& E) {
    const int tid = threadIdx.x, wid = __builtin_amdgcn_readfirstlane(tid >> 6), lane = tid & 63, wr = wid >> 2, wc = wid & 3, fr = lane & 15, fq = lane >> 4;
    const int K = g.K, nt = K / BK;
    unsigned voffA[2], voffB[2];
#pragma unroll
    for (int i = 0; i < 2; ++i) { int R, C; stage_rc(tid * 16 + i * 8192, R, C); const int Rb = Epi::PERM ? ((R & ~31) + perm32(R & 31)) : R;
        voffA[i] = (unsigned)(R * K + C) * 2u; voffB[i] = (unsigned)(Rb * K + C) * 2u; }
    const size_t kstep = (size_t)(BK * 2);
    const size_t hstep = (size_t)HALF * K * 2;
    const size_t tstep = 2 * hstep;
    const unsigned ldsw = (unsigned)wid * 1024u;
    const int aoff = lds_byte(wr * 64 + fr, fq * 8), boff = lds_byte(wc * 32 + fr, fq * 8);
#define PG8_SA(b, h) (((b) * 2 + (h)) * HTB)
#define PG8_SB(b, h) ((4 + (b) * 2 + (h)) * HTB)
#define PG8_STAGE(bufoff, gbase, voff) do { _Pragma("unroll") for (int _i = 0; _i < 2; ++_i) \
        __builtin_amdgcn_global_load_lds((const unsigned*)((const char*)(gbase) + (voff)[_i]), (PG8_LAS unsigned*)(lds + (bufoff) + ldsw + _i * 8192), 16, 0, 0); } while (0)
#define PG8_LDA(dst, b, h) do { _Pragma("unroll") for (int m = 0; m < 4; ++m) _Pragma("unroll") for (int k = 0; k < 2; ++k) dst[m][k] = *(const PG8_LAS bf16x8*)(lds + PG8_SA(b, h) + aoff + m * 2048 + k * 1024); } while (0)
#define PG8_LDB(dst, b, h) do { _Pragma("unroll") for (int n = 0; n < 2; ++n) _Pragma("unroll") for (int k = 0; k < 2; ++k) dst[n][k] = *(const PG8_LAS bf16x8*)(lds + PG8_SB(b, h) + boff + n * 2048 + k * 1024); } while (0)
#define PG8_MMA(ai, bj, At, Bt) do { __builtin_amdgcn_s_setprio(1); _Pragma("unroll") for (int m = 0; m < 4; ++m) _Pragma("unroll") for (int n = 0; n < 2; ++n) _Pragma("unroll") for (int k = 0; k < 2; ++k) \
        acc[ai][bj][m][n] = __builtin_amdgcn_mfma_f32_16x16x32_bf16(Bt[n][k], At[m][k], acc[ai][bj][m][n], 0, 0, 0); __builtin_amdgcn_s_setprio(0); } while (0)
#define PG8_WAIT_V(n) asm volatile("s_waitcnt vmcnt(" #n ")" ::: "memory")
#define PG8_WAIT_L(n) asm volatile("s_waitcnt lgkmcnt(" #n ")" ::: "memory")
#define PG8_BAR __builtin_amdgcn_s_barrier()
#define PG8_SCHED __builtin_amdgcn_sched_barrier(0)
    Unit cur, nxt; int ui = 0;
    if (!S.next(0, cur)) return;
    f32x4 acc[2][2][4][2];
#pragma unroll
    for (int a = 0; a < 2; ++a)
#pragma unroll
        for (int b = 0; b < 2; ++b)
#pragma unroll
            for (int m = 0; m < 4; ++m)
#pragma unroll
                for (int n = 0; n < 2; ++n) acc[a][b][m][n] = (f32x4){0.f, 0.f, 0.f, 0.f};
    bf16x8 At[4][2], B0[2][2], B1[2][2];
    const char* cA = (const char*)g.A + (size_t)cur.pm * tstep; const char* cB = (const char*)g.Bt + (size_t)cur.pn * tstep;
    S.a_ready(cur);
    if constexpr (SP2) {
        PG8_STAGE(PG8_SB(0, 0), cB, voffB); PG8_STAGE(PG8_SB(0, 1), cB + hstep, voffB); PG8_STAGE(PG8_SA(0, 0), cA, voffA); PG8_STAGE(PG8_SA(0, 1), cA + hstep, voffA);
        if (wr == 1) PG8_BAR;
        PG8_WAIT_V(2); PG8_BAR;
        PG8_STAGE(PG8_SB(1, 0), cB + kstep, voffB); PG8_STAGE(PG8_SA(1, 0), cA + kstep, voffA); PG8_STAGE(PG8_SB(1, 1), cB + hstep + kstep, voffB);
        PG8_WAIT_V(6); PG8_BAR;
    } else {
        PG8_STAGE(PG8_SB(0, 0), cB, voffB); PG8_STAGE(PG8_SA(0, 0), cA, voffA); PG8_STAGE(PG8_SB(0, 1), cB + hstep, voffB); PG8_STAGE(PG8_SA(0, 1), cA + hstep, voffA);
        if (wr == 1) PG8_BAR;
        PG8_WAIT_V(4); PG8_BAR;
        PG8_STAGE(PG8_SB(1, 0), cB + kstep, voffB); PG8_STAGE(PG8_SA(1, 0), cA + kstep, voffA); PG8_STAGE(PG8_SB(1, 1), cB + hstep + kstep, voffB);
        PG8_WAIT_V(6); PG8_BAR;
    }
    for (;;) {
        const bool has_next = S.next(ui + 1, nxt);
        const char* nA = has_next ? (const char*)g.A + (size_t)nxt.pm * tstep : cA; const char* nB = has_next ? (const char*)g.Bt + (size_t)nxt.pn * tstep : cB;
        for (int t = 0; t < nt; t += 2) {
            const bool last = (t == nt - 2);
            const char* a1 = cA + (size_t)(t + 1) * kstep;
            const char* a2 = last ? nA : cA + (size_t)(t + 2) * kstep; const char* b2 = last ? nB : cB + (size_t)(t + 2) * kstep;
            const char* a3 = a2 + kstep; const char* b3 = b2 + kstep;
            if (last && has_next) S.a_ready(nxt);
            if constexpr (SP2) {
            PG8_LDB(B0, 0, 0); PG8_LDB(B1, 0, 1); PG8_SCHED; PG8_LDA(At, 0, 0); PG8_STAGE(PG8_SA(1, 1), a1 + hstep, voffA);
            PG8_WAIT_V(8); PG8_WAIT_L(0); PG8_BAR; PG8_MMA(0, 0, At, B0); PG8_MMA(0, 1, At, B1); PG8_BAR; PG8_SCHED;
            PG8_LDA(At, 0, 1); PG8_STAGE(PG8_SB(0, 0), b2, voffB); PG8_STAGE(PG8_SB(0, 1), b2 + hstep, voffB); PG8_STAGE(PG8_SA(0, 0), a2, voffA);
            PG8_WAIT_V(8); PG8_WAIT_L(0); PG8_BAR; PG8_MMA(1, 0, At, B0); PG8_MMA(1, 1, At, B1); PG8_BAR; PG8_SCHED;
            PG8_LDB(B0, 1, 0); PG8_LDB(B1, 1, 1); PG8_SCHED; PG8_LDA(At, 1, 0); PG8_STAGE(PG8_SA(0, 1), a2 + hstep, voffA);
            PG8_WAIT_V(8); PG8_WAIT_L(0); PG8_BAR; PG8_MMA(0, 0, At, B0); PG8_MMA(0, 1, At, B1); PG8_BAR; PG8_SCHED;
            PG8_LDA(At, 1, 1); PG8_STAGE(PG8_SB(1, 0), b3, voffB); PG8_STAGE(PG8_SB(1, 1), b3 + hstep, voffB); PG8_STAGE(PG8_SA(1, 0), a3, voffA);
            PG8_WAIT_V(8); PG8_WAIT_L(0); PG8_BAR; PG8_MMA(1, 0, At, B0); PG8_MMA(1, 1, At, B1); PG8_BAR; PG8_SCHED;
            } else {
            PG8_LDB(B0, 0, 0); PG8_SCHED; PG8_LDA(At, 0, 0); PG8_STAGE(PG8_SA(1, 1), a1 + hstep, voffA);
            PG8_WAIT_L(8); PG8_BAR; PG8_WAIT_L(0); PG8_MMA(0, 0, At, B0); PG8_BAR; PG8_SCHED;
            PG8_LDB(B1, 0, 1); PG8_STAGE(PG8_SB(0, 0), b2, voffB);
            PG8_BAR; PG8_WAIT_L(0); PG8_MMA(0, 1, At, B1); PG8_BAR;
            PG8_LDA(At, 0, 1); PG8_STAGE(PG8_SA(0, 0), a2, voffA);
            PG8_BAR; PG8_WAIT_L(0); PG8_MMA(1, 0, At, B0); PG8_BAR; PG8_SCHED;
            PG8_STAGE(PG8_SB(0, 1), b2 + hstep, voffB);
            PG8_WAIT_V(6); PG8_BAR; PG8_MMA(1, 1, At, B1); PG8_BAR;
            PG8_LDB(B0, 1, 0); PG8_SCHED; PG8_LDA(At, 1, 0); PG8_STAGE(PG8_SA(0, 1), a2 + hstep, voffA);
            PG8_WAIT_L(8); PG8_BAR; PG8_WAIT_L(0); PG8_MMA(0, 0, At, B0); PG8_BAR; PG8_SCHED;
            PG8_LDB(B1, 1, 1); PG8_STAGE(PG8_SB(1, 0), b3, voffB);
            PG8_BAR; PG8_WAIT_L(0); PG8_MMA(0, 1, At, B1); PG8_BAR;
            PG8_LDA(At, 1, 1); PG8_STAGE(PG8_SA(1, 0), a3, voffA);
            PG8_BAR; PG8_WAIT_L(0); PG8_MMA(1, 0, At, B0); PG8_BAR; PG8_SCHED;
            PG8_STAGE(PG8_SB(1, 1), b3 + hstep, voffB);
            PG8_WAIT_V(6); PG8_BAR; PG8_MMA(1, 1, At, B1); PG8_BAR;
            }
        }
        if constexpr (ALIGN_EPI) { if (wr == 0) PG8_BAR; }
        if constexpr (!Epi::AFTER_DRAIN) { E(acc, cur, wr, wc, fr, fq); S.done(cur); }
        if (!has_next) break;
#pragma unroll
        for (int a = 0; a < 2; ++a)
#pragma unroll
            for (int b = 0; b < 2; ++b)
#pragma unroll
                for (int m = 0; m < 4; ++m)
#pragma unroll
                    for (int n = 0; n < 2; ++n) acc[a][b][m][n] = (f32x4){0.f, 0.f, 0.f, 0.f};
        cur = nxt; cA = nA; cB = nB; ++ui;
        if constexpr (ALIGN_EPI) { if (wr == 1) PG8_BAR; }
    }
    PG8_WAIT_V(0);
    if constexpr (!ALIGN_EPI) { if (wr == 0) PG8_BAR; }
    PG8_BAR;
    if constexpr (Epi::AFTER_DRAIN) { E.fused(acc, cur, wr, wc, fr, fq, lds, wid, lane); S.done(cur); }
#undef PG8_SA
#undef PG8_SB
#undef PG8_STAGE
#undef PG8_LDA
#undef PG8_LDB
#undef PG8_MMA
#undef PG8_WAIT_V
#undef PG8_WAIT_L
#undef PG8_BAR
#undef PG8_SCHED
}
constexpr int PBI = 544, SBI_BYTES = 64 * PBI;
template <class Epi, class Sched, bool ALIGN_EPI = false>
__device__ __forceinline__ void gemm_phase_bf32(PG8_LAS unsigned char* lds, const Gemm g, const Sched& S, const Epi& E) {
    const int tid = threadIdx.x, wid = __builtin_amdgcn_readfirstlane(tid >> 6), lane = tid & 63, wr = wid >> 2, wc = wid & 3, fr = lane & 15, fq = lane >> 4;
    const int K = g.K, nt = K / BK;
    unsigned voffA[2];
#pragma unroll
    for (int i = 0; i < 2; ++i) { int R, C; stage_rc(tid * 16 + i * 8192, R, C); voffA[i] = (unsigned)(R * K + C) * 2u; }
    const size_t kstep = (size_t)(BK * 2), hstep = (size_t)HALF * K * 2, tstep = 2 * hstep;
    const unsigned ldsw = (unsigned)wid * 1024u;
    const int aoff = lds_byte(wr * 64 + fr, fq * 8);
    const int ldb = S.ldb();
    const size_t bkstep = (size_t)BK * ldb;
    const int q4 = (lane >> 2) & 3, p4 = lane & 3;
    const unsigned bwoff = (unsigned)(8 * wid) * PBI + (unsigned)(((4 * lane) ^ ((wid & 1) << 6)) * 2);
    unsigned broff[2][2];
#pragma unroll
    for (int n = 0; n < 2; ++n)
#pragma unroll
        for (int k = 0; k < 2; ++k) { const int row = 32 * k + 8 * fq + q4, col = 32 * wc + (Epi::PERM ? 8 * p4 + 4 * n : 16 * n + 4 * p4);
            broff[n][k] = (unsigned)row * PBI + (unsigned)((col ^ ((row & 8) << 3)) * 2); }
#define PG8_SA(b, h) (((b) * 2 + (h)) * HTB)
#define PG8_SBI(b) (4 * HTB + (b) * SBI_BYTES)
#define PG8_STAGE(bufoff, gbase, voff) do { _Pragma("unroll") for (int _i = 0; _i < 2; ++_i) \
        __builtin_amdgcn_global_load_lds((const unsigned*)((const char*)(gbase) + (voff)[_i]), (PG8_LAS unsigned*)(lds + (bufoff) + ldsw + _i * 8192), 16, 0, 0); } while (0)
#define PG8_LDA(dst, b, h) do { _Pragma("unroll") for (int m = 0; m < 4; ++m) _Pragma("unroll") for (int k = 0; k < 2; ++k) dst[m][k] = *(const PG8_LAS bf16x8*)(lds + PG8_SA(b, h) + aoff + m * 2048 + k * 1024); } while (0)
#define PG8_LDBT(dst, b, h) do { _Pragma("unroll") for (int n = 0; n < 2; ++n) _Pragma("unroll") for (int k = 0; k < 2; ++k) { \
        const PG8_LAS unsigned char* _a = lds + PG8_SBI(b) + broff[n][k] + (h) * 256; \
        const s16x4 _lo = __builtin_bit_cast(s16x4, __builtin_amdgcn_ds_read_tr16_b64_v4i16((PG8_LAS s16x4*)_a)), _hi = __builtin_bit_cast(s16x4, __builtin_amdgcn_ds_read_tr16_b64_v4i16((PG8_LAS s16x4*)(_a + 4 * PBI))); \
        dst[n][k] = __builtin_shufflevector(_lo, _hi, 0, 1, 2, 3, 4, 5, 6, 7); } } while (0)
#define PG8_BLOAD(bp) do { _Pragma("unroll") for (int _i = 0; _i < 8; ++_i) breg[_i] = *(const __attribute__((address_space(1))) f32x4*)((bp) + (size_t)(8 * wid + _i) * ldb); } while (0)
#define PG8_BWRITE(b) do { _Pragma("unroll") for (int _i = 0; _i < 8; ++_i) { u32x2 _w; _w.x = cvt_pk_bf16(breg[_i][0], breg[_i][1]); _w.y = cvt_pk_bf16(breg[_i][2], breg[_i][3]); \
        *(PG8_LAS u32x2*)(lds + PG8_SBI(b) + bwoff + _i * PBI) = _w; } } while (0)
#define PG8_MMA(ai, bj, At, Bt) do { __builtin_amdgcn_s_setprio(1); _Pragma("unroll") for (int m = 0; m < 4; ++m) _Pragma("unroll") for (int n = 0; n < 2; ++n) _Pragma("unroll") for (int k = 0; k < 2; ++k) \
        acc[ai][bj][m][n] = __builtin_amdgcn_mfma_f32_16x16x32_bf16(Bt[n][k], At[m][k], acc[ai][bj][m][n], 0, 0, 0); __builtin_amdgcn_s_setprio(0); } while (0)
#define PG8_WAIT_V(n) asm volatile("s_waitcnt vmcnt(" #n ")" ::: "memory")
#define PG8_WAIT_L(n) asm volatile("s_waitcnt lgkmcnt(" #n ")" ::: "memory")
#define PG8_BAR __builtin_amdgcn_s_barrier()
#define PG8_SCHED __builtin_amdgcn_sched_barrier(0)
    typedef short s16x4 __attribute__((ext_vector_type(4)));
    typedef unsigned u32x2 __attribute__((ext_vector_type(2)));
    Unit cur, nxt; int ui = 0;
    if (!S.next(0, cur)) return;
    f32x4 acc[2][2][4][2];
#pragma unroll
    for (int a = 0; a < 2; ++a)
#pragma unroll
        for (int b = 0; b < 2; ++b)
#pragma unroll
            for (int m = 0; m < 4; ++m)
#pragma unroll
                for (int n = 0; n < 2; ++n) acc[a][b][m][n] = (f32x4){0.f, 0.f, 0.f, 0.f};
    bf16x8 At[4][2], B0[2][2], B1[2][2];
    f32x4 breg[8];
    const char* cA = (const char*)g.A + (size_t)cur.pm * tstep; const float* cB = S.bptr(cur, lane);
    PG8_BLOAD(cB); PG8_STAGE(PG8_SA(0, 0), cA, voffA); PG8_STAGE(PG8_SA(0, 1), cA + hstep, voffA);
    PG8_BWRITE(0); PG8_SCHED;
    if (wr == 1) PG8_BAR;
    PG8_WAIT_V(2); PG8_WAIT_L(0); PG8_BAR;
    PG8_BLOAD(cB + bkstep); PG8_STAGE(PG8_SA(1, 0), cA + kstep, voffA); PG8_SCHED;
    PG8_WAIT_V(10); PG8_BAR;
    for (;;) {
        const bool has_next = S.next(ui + 1, nxt);
        const char* nA = has_next ? (const char*)g.A + (size_t)nxt.pm * tstep : cA; const float* nB = has_next ? S.bptr(nxt, lane) : cB;
        for (int t = 0; t < nt; t += 2) {
            const bool last = (t == nt - 2);
            const char* a1 = cA + (size_t)(t + 1) * kstep;
            const char* a2 = last ? nA : cA + (size_t)(t + 2) * kstep; const float* b2 = last ? nB : cB + (size_t)(t + 2) * bkstep;
            const char* a3 = a2 + kstep; const float* b3 = b2 + bkstep;
            PG8_LDBT(B0, 0, 0); PG8_LDBT(B1, 0, 1); PG8_SCHED; PG8_LDA(At, 0, 0); PG8_STAGE(PG8_SA(1, 1), a1 + hstep, voffA);
            PG8_WAIT_V(12); PG8_WAIT_L(0); PG8_BAR; PG8_MMA(0, 0, At, B0); PG8_MMA(0, 1, At, B1); PG8_BAR; PG8_SCHED;
            PG8_BWRITE(1); PG8_BLOAD(b2); PG8_SCHED; PG8_LDA(At, 0, 1); PG8_STAGE(PG8_SA(0, 0), a2, voffA);
            PG8_WAIT_V(12); PG8_WAIT_L(0); PG8_BAR; PG8_MMA(1, 0, At, B0); PG8_MMA(1, 1, At, B1); PG8_BAR; PG8_SCHED;
            PG8_LDBT(B0, 1, 0); PG8_LDBT(B1, 1, 1); PG8_SCHED; PG8_LDA(At, 1, 0); PG8_STAGE(PG8_SA(0, 1), a2 + hstep, voffA);
            PG8_WAIT_V(12); PG8_WAIT_L(0); PG8_BAR; PG8_MMA(0, 0, At, B0); PG8_MMA(0, 1, At, B1); PG8_BAR; PG8_SCHED;
            PG8_BWRITE(0); PG8_BLOAD(b3); PG8_SCHED; PG8_LDA(At, 1, 1); PG8_STAGE(PG8_SA(1, 0), a3, voffA);
            PG8_WAIT_V(12); PG8_WAIT_L(0); PG8_BAR; PG8_MMA(1, 0, At, B0); PG8_MMA(1, 1, At, B1); PG8_BAR; PG8_SCHED;
        }
        if constexpr (ALIGN_EPI) { if (wr == 0) PG8_BAR; }
        E(acc, cur, wr, wc, fr, fq); S.done(cur);
        if (!has_next) break;
#pragma unroll
        for (int a = 0; a < 2; ++a)
#pragma unroll
            for (int b = 0; b < 2; ++b)
#pragma unroll
                for (int m = 0; m < 4; ++m)
#pragma unroll
                    for (int n = 0; n < 2; ++n) acc[a][b][m][n] = (f32x4){0.f, 0.f, 0.f, 0.f};
        cur = nxt; cA = nA; cB = nB; ++ui;
        if constexpr (ALIGN_EPI) { if (wr == 1) PG8_BAR; }
    }
    PG8_WAIT_V(0);
    asm volatile("" :: "v"(breg[0]), "v"(breg[1]), "v"(breg[2]), "v"(breg[3]), "v"(breg[4]), "v"(breg[5]), "v"(breg[6]), "v"(breg[7]));
    if constexpr (!ALIGN_EPI) { if (wr == 0) PG8_BAR; }
    PG8_BAR;
#undef PG8_SA
#undef PG8_SBI
#undef PG8_STAGE
#undef PG8_LDA
#undef PG8_LDBT
#undef PG8_BLOAD
#undef PG8_BWRITE
#undef PG8_MMA
#undef PG8_WAIT_V
#undef PG8_WAIT_L
#undef PG8_BAR
#undef PG8_SCHED
}
}

constexpr int NWAVES = 8, NTHR = 512;
constexpr int T = 8192, D = 2048, HW = 7168, INW = 7184, MEMN = 256;
constexpr float LN_EPS = 1e-5f;
constexpr float ALPHA = 1.189207115002721f;
constexpr int NPH = 15;
constexpr int PMAX = 24576;

constexpr size_t MiB = 1u << 20;
constexpr size_t WS_CTL = 0, CTL_ZERO_BYTES = 1 * MiB;
constexpr size_t WS_WMIX = 2 * MiB, WS_WMQ = 10 * MiB, WS_WIN = 18 * MiB, WS_WKV = 46 * MiB, WS_WMO = 62 * MiB, WS_WGU = 70 * MiB, WS_WD = 198 * MiB;
constexpr size_t WS_XB = 262 * MiB, WS_MEMB = 294 * MiB;
constexpr size_t WS_H = 296 * MiB;
constexpr size_t WS_KVM = 408 * MiB;
constexpr size_t WS_ORAW = 410 * MiB;
constexpr size_t WS_MIXED = WS_XB;
constexpr size_t WS_Y1 = WS_ORAW;
constexpr size_t WS_H1B = WS_H;
constexpr size_t WS_QB = 328 * MiB, WS_ATT = 360 * MiB;
constexpr size_t WS_Y2 = 474 * MiB;
constexpr size_t WS_H2B = WS_H;
constexpr size_t WS_XS = 328 * MiB;
constexpr size_t WS_HID = 424 * MiB;
constexpr size_t WS_YS = WS_XS;
constexpr size_t WS_SMALL = 540 * MiB;
constexpr size_t WS_GLR = WS_SMALL;
constexpr size_t WS_RC = WS_SMALL + 1 * MiB, WS_RS = WS_SMALL + 5 * MiB;
constexpr size_t WS_ST1 = WS_SMALL + 9 * MiB, WS_ST2 = WS_ST1 + 65536;
constexpr size_t WS_EXP = WS_ST2 + 65536, WS_GATE = WS_EXP + 65536, WS_POS = WS_GATE + 65536, WS_SLOT = WS_POS + 65536;
constexpr size_t WS_END = 552 * MiB;
constexpr int CW_CNT = 64, CW_CUR = 128, CW_Q = 192;
constexpr int CW_BAR = 4096;

constexpr int RING_BYTES = 139264, LDSCTL_OFF = RING_BYTES, MISC_OFF = LDSCTL_OFF + 320, LDS_BYTES = 147456;

#define GAS __attribute__((address_space(1)))
#define LAS __attribute__((address_space(3)))
typedef unsigned short bf16;
typedef unsigned v4u __attribute__((ext_vector_type(4)));
typedef unsigned v2u __attribute__((ext_vector_type(2)));
typedef float f32x4 __attribute__((ext_vector_type(4)));
typedef GAS unsigned gu32;
#define RLX_AGENT __ATOMIC_RELAXED, __HIP_MEMORY_SCOPE_AGENT
#define LDS_WAIT() asm volatile("s_waitcnt lgkmcnt(0)" ::: "memory")
__device__ __forceinline__ unsigned f2bf(float f) { unsigned u = __builtin_bit_cast(unsigned, f); return (u + 0x7fffu + ((u >> 16) & 1u)) >> 16; }
__device__ __forceinline__ unsigned pk2(float lo, float hi) { return f2bf(lo) | (f2bf(hi) << 16); }
__device__ __forceinline__ float bf2f(unsigned h) { return __builtin_bit_cast(float, h << 16); }
__device__ __forceinline__ float bflo(unsigned w) { return __builtin_bit_cast(float, w << 16); }
__device__ __forceinline__ float bfhi(unsigned w) { return __builtin_bit_cast(float, w & 0xffff0000u); }
__device__ __forceinline__ float wave_sum(float v) {
#pragma unroll
    for (int o = 1; o < 64; o <<= 1) v += __shfl_xor(v, o);
    return v;
}
__device__ __forceinline__ float wave_max(float v) {
#pragma unroll
    for (int o = 1; o < 64; o <<= 1) v = fmaxf(v, __shfl_xor(v, o));
    return v;
}

struct Frame {
    LAS unsigned char* lds;
    volatile LAS unsigned* MISC;
    gu32* ctl;
    int tid, lane, wave, G, bid;
    unsigned char* ws;
    const float* in[25];
    float* out;
};
#define WSP(T_, off) ((T_*)(F.ws + (off)))

__device__ __forceinline__ void transpose_item(const float* W, int ldw, bf16* WTr, int ldt, LAS float* scr, int lane) {
    float tv[32];
#pragma unroll
    for (int i = 0; i < 32; ++i) tv[i] = W[(size_t)(2 * i + (lane >> 5)) * ldw + (lane & 31)];
#pragma unroll
    for (int i = 0; i < 32; ++i) scr[(2 * i + (lane >> 5)) * 33 + (lane & 31)] = tv[i];
    LDS_WAIT(); asm volatile("" ::: "memory");
    const int c = lane & 7;
#pragma unroll
    for (int j = 0; j < 4; ++j) { const int n = (lane >> 3) + 8 * j; const LAS float* s = scr + (8 * c) * 33 + n;
        v4u o; o.x = pk2(s[0 * 33], s[1 * 33]); o.y = pk2(s[2 * 33], s[3 * 33]); o.z = pk2(s[4 * 33], s[5 * 33]); o.w = pk2(s[6 * 33], s[7 * 33]);
        *(GAS v4u*)(WTr + (size_t)n * ldt + 8 * c) = o; }
    LDS_WAIT(); asm volatile("" ::: "memory");
}
__device__ __forceinline__ void p0_prologue(Frame& F) {
    LAS float* scr = (LAS float*)(F.lds + F.wave * 16384);
    const int gw = F.bid * NWAVES + F.wave, NGW = F.G * NWAVES;
    const float* w_in = F.in[3];
    constexpr int I_IN = 32 * 224, I_SQ = 32 * 64;
    for (int it = gw; it < I_IN + 2 * I_SQ; it += NGW) {
        int r = it;
        if (r < I_IN) { const int kb = r / 224, nb = r % 224; transpose_item(w_in + (size_t)(64 * kb) * INW + 32 * nb, INW, WSP(bf16, WS_WIN) + (size_t)(32 * nb) * 2048 + 64 * kb, 2048, scr, F.lane); continue; }
        r -= I_IN;
        { const int w = r / I_SQ, q = r % I_SQ, kb = q / 64, nb = q % 64;
          const float* src = F.in[11]; if (w) src = F.in[12];
          bf16* dst = WSP(bf16, WS_WKV) + (size_t)w * 2048 * 2048;
          transpose_item(src + (size_t)(64 * kb) * 2048 + 32 * nb, 2048, dst + (size_t)(32 * nb) * 2048 + 64 * kb, 2048, scr, F.lane); }
    }
    const int gt = F.bid * NTHR + F.tid, NGT = F.G * NTHR;
    {
        const float* x = F.in[0]; bf16* xb = WSP(bf16, WS_XB);
        for (int i0 = gt; i0 < T * D / 8; i0 += 4 * NGT) { f32x4 a[4], b[4];
#pragma unroll
            for (int u = 0; u < 4; ++u) { const size_t i = (size_t)i0 + (size_t)u * NGT; a[u] = *(const GAS f32x4*)(x + i * 8); b[u] = *(const GAS f32x4*)(x + i * 8 + 4); }
#pragma unroll
            for (int u = 0; u < 4; ++u) { const size_t i = (size_t)i0 + (size_t)u * NGT;
                v4u o; o.x = pk2(a[u][0], a[u][1]); o.y = pk2(a[u][2], a[u][3]); o.z = pk2(b[u][0], b[u][1]); o.w = pk2(b[u][2], b[u][3]); *(GAS v4u*)(xb + i * 8) = o; } }
        const float* mm = F.in[1]; bf16* mb = WSP(bf16, WS_MEMB);
        for (int i = gt; i < MEMN * D / 8; i += NGT) { const f32x4 a = *(const GAS f32x4*)(mm + (size_t)i * 8), b = *(const GAS f32x4*)(mm + (size_t)i * 8 + 4);
            v4u o; o.x = pk2(a[0], a[1]); o.y = pk2(a[2], a[3]); o.z = pk2(b[0], b[1]); o.w = pk2(b[2], b[3]); *(GAS v4u*)(mb + (size_t)i * 8) = o; }
    }
    {
        const int* pos = (const int*)F.in[2]; float* rc = WSP(float, WS_RC); float* rs = WSP(float, WS_RS);
        for (int i = gt; i < T * 128; i += NGT) { const int t = i >> 7, f = i & 127;
            const float inv = exp2f(-(float)f * (13.287712379549449f / 128.0f));
            const float ang = (float)pos[t] * inv;
            double rev = (double)ang * 0.15915494309189535; rev -= floor(rev);
            const float rf = (float)rev;
            rc[i] = __builtin_amdgcn_cosf(rf); rs[i] = __builtin_amdgcn_sinf(rf); }
    }
    {
        const float* x = F.in[0]; float* glr = WSP(float, WS_GLR);
        const int r16 = F.lane & 15, g4 = F.lane >> 4;
        for (int tile = gw; tile < T / 16; tile += NGW) {
            f32x4 acc = {0.f, 0.f, 0.f, 0.f};
            const float* xr = x + (size_t)(tile * 16 + r16) * D + 4 * g4;
            const float* wr = w_in + (size_t)(4 * g4) * INW + HW + r16;
#pragma unroll 4
            for (int k0 = 0; k0 < D; k0 += 16) {
                const f32x4 a = *(const GAS f32x4*)(xr + k0);
                const float b0 = wr[(size_t)(k0 + 0) * INW], b1 = wr[(size_t)(k0 + 1) * INW], b2 = wr[(size_t)(k0 + 2) * INW], b3 = wr[(size_t)(k0 + 3) * INW];
                acc = __builtin_amdgcn_mfma_f32_16x16x4f32(a[0], b0, acc, 0, 0, 0);
                acc = __builtin_amdgcn_mfma_f32_16x16x4f32(a[1], b1, acc, 0, 0, 0);
                acc = __builtin_amdgcn_mfma_f32_16x16x4f32(a[2], b2, acc, 0, 0, 0);
                acc = __builtin_amdgcn_mfma_f32_16x16x4f32(a[3], b3, acc, 0, 0, 0);
            }
#pragma unroll
            for (int j = 0; j < 4; ++j) glr[(size_t)(tile * 16 + 4 * g4 + j) * 16 + r16] = acc[j];
        }
    }
}
__device__ __forceinline__ void transpose_queue(Frame& F, int qsel = 0) {
    LAS float* scr = (LAS float*)(F.lds + F.wave * 16384);
    const float* const i7 = F.in[7]; const float* const i10 = F.in[10]; const float* const i13 = F.in[13]; const float* const i20 = F.in[20]; const float* const i21 = F.in[21]; const float* const i22 = F.in[22];
    constexpr int I_SQ = 32 * 64, I_E = 512, NQ = 3 * I_SQ + 3 * 32 * I_E;
    for (;;) {
        unsigned b0 = 0;
        if (F.lane == 0) b0 = __hip_atomic_fetch_add((unsigned*)(F.ctl + CW_Q + 64 * qsel), 16u, __ATOMIC_RELAXED, __HIP_MEMORY_SCOPE_AGENT);
        b0 = __builtin_amdgcn_readfirstlane(b0);
        if (b0 >= (unsigned)NQ) break;
        for (int it = (int)b0; it < (int)b0 + 16 && it < NQ; ++it) {
            int r = it;
            if (r < 3 * I_SQ) { const int w = r / I_SQ, q = r % I_SQ, kb = q / 64, nb = q % 64;
                const float* src = i7; size_t doff = WS_WMIX; if (w == 1) { src = i10; doff = WS_WMQ; } if (w == 2) { src = i13; doff = WS_WMO; }
                bf16* dst = (bf16*)(F.ws + doff);
                transpose_item(src + (size_t)(64 * kb) * 2048 + 32 * nb, 2048, dst + (size_t)(32 * nb) * 2048 + 64 * kb, 2048, scr, F.lane); continue; }
            r -= 3 * I_SQ;
            if (r < 2 * 32 * I_E) {
                const int up = r / (32 * I_E), q = r % (32 * I_E), e = q / I_E, q2 = q % I_E, kb = q2 / 16, nb = q2 % 16, n0 = 32 * nb;
                const float* sb = i20; if (up) sb = i21;
                const float* src = sb + (size_t)e * 2048 * 512 + (size_t)(64 * kb) * 512 + n0;
                bf16* dst = WSP(bf16, WS_WGU) + (size_t)(e * 1024 + (n0 >> 7) * 256 + up * 128 + (n0 & 127)) * 2048 + 64 * kb;
                transpose_item(src, 512, dst, 2048, scr, F.lane); continue; }
            r -= 2 * 32 * I_E;
            {
                const int e = r / I_E, q2 = r % I_E, kb = q2 / 64, nb = q2 % 64;
                const float* src = i22 + (size_t)e * 512 * 2048 + (size_t)(64 * kb) * 2048 + 32 * nb;
                bf16* dst = WSP(bf16, WS_WD) + (size_t)(e * 2048 + 32 * nb) * 512 + 64 * kb;
                transpose_item(src, 2048, dst, 512, scr, F.lane); }
        }
    }
}

__device__ __forceinline__ float log_sigmoid_f(float z) { return fminf(z, 0.f) - log1pf(expf(-fabsf(z))); }
template <bool GLA>
__device__ __forceinline__ void mixer_naive_item(Frame& F, int hh, int eg) {
    constexpr int ND = GLA ? 4 : 8;
    const bf16* H = WSP(bf16, WS_H); float* oraw = WSP(float, WS_ORAW);
    const int ei = F.tid & 15, dp = F.tid >> 4, e = eg * 16 + ei;
    const int qcol = GLA ? 4096 + hh * 128 : hh * 256, kcol = GLA ? 4608 + hh * 128 : 1024 + hh * 256, vcol = (GLA ? 5120 : 2048) + hh * 256 + e;
    const int ocol = (GLA ? 1024 : 0) + hh * 256 + eg * 16;
    LAS float* red = (LAS float*)F.lds;
    float S[ND];
#pragma unroll
    for (int i = 0; i < ND; ++i) S[i] = 0.f;
    float wa[GLA ? 4 : 1][16]; float ba[GLA ? 4 : 1];
    if (GLA) {
#pragma unroll
        for (int i = 0; i < 4; ++i) { const int d = dp + 32 * i; ba[i] = F.in[5][hh * 128 + d];
#pragma unroll
            for (int r = 0; r < 16; ++r) wa[i][r] = F.in[4][r * 512 + hh * 128 + d]; }
    }
    const float gamma = 1.0f - exp2f(-5.0f - (float)hh);
    const float* glr = WSP(float, WS_GLR);
    for (int t0 = 0; t0 < T; t0 += 8) {
        float part[8];
#pragma unroll
        for (int tt = 0; tt < 8; ++tt) {
            const int t = t0 + tt; const bf16* hr = H + (size_t)t * HW;
            const float v = bf2f(hr[vcol]);
            float g16[16];
            if (GLA) {
#pragma unroll
                for (int r = 0; r < 16; ++r) g16[r] = glr[t * 16 + r];
            }
            float p = 0.f;
#pragma unroll
            for (int i = 0; i < ND; ++i) { const int d = dp + 32 * i;
                const float q = bf2f(hr[qcol + d]), k = bf2f(hr[kcol + d]);
                float a = gamma;
                if (GLA) { float z = ba[i];
#pragma unroll
                    for (int r = 0; r < 16; ++r) z += g16[r] * wa[i][r];
                    a = expf(log_sigmoid_f(z) * 0.0625f); }
                S[i] = a * S[i] + k * v; p += q * S[i]; }
            p += __shfl_xor(p, 16); p += __shfl_xor(p, 32);
            part[tt] = p;
        }
        if (F.lane < 16) {
#pragma unroll
            for (int tt = 0; tt < 8; ++tt) red[(F.wave * 8 + tt) * 16 + F.lane] = part[tt];
        }
        __syncthreads();
        if (F.tid < 128) { const int tt = F.tid >> 4, e2 = F.tid & 15; float s = 0.f;
#pragma unroll
            for (int w = 0; w < 8; ++w) s += red[(w * 8 + tt) * 16 + e2];
            oraw[(size_t)(t0 + tt) * D + ocol + e2] = s; }
        __syncthreads();
    }
}
__device__ __forceinline__ void p2_mixer_naive(Frame& F) {
    for (int item = F.bid; item < 128; item += F.G) {
        const int h8 = item >> 4, eg = item & 15;
        if (h8 < 4) mixer_naive_item<false>(F, h8, eg); else mixer_naive_item<true>(F, h8 - 4, eg);
    }
}
__device__ __forceinline__ void p3_normgate(Frame& F) {
    const bf16* H = WSP(bf16, WS_H); const float* oraw = WSP(float, WS_ORAW); bf16* mixed = WSP(bf16, WS_MIXED);
    const int gw = F.bid * NWAVES + F.wave, NGW = F.G * NWAVES;
    const f32x4 gn = *(const f32x4*)(F.in[6] + 4 * F.lane);
    for (int t = gw; t < T; t += NGW) {
#pragma unroll
        for (int h8 = 0; h8 < 8; ++h8) {
            const f32x4 o = *(const GAS f32x4*)(oraw + (size_t)t * D + h8 * 256 + 4 * F.lane);
            const int gcol = (h8 < 4 ? 3072 : 6144) + (h8 & 3) * 256 + 4 * F.lane;
            const v2u gw2 = *(const GAS v2u*)(H + (size_t)t * HW + gcol);
            const f32x4 gt = {bflo(gw2.x), bfhi(gw2.x), bflo(gw2.y), bfhi(gw2.y)};
            f32x4 y;
            if (h8 < 4) {
                const float mu = wave_sum((o[0] + o[1]) + (o[2] + o[3])) * (1.f / 256.f);
                const f32x4 dd = o - mu;
                const float var = wave_sum((dd[0] * dd[0] + dd[1] * dd[1]) + (dd[2] * dd[2] + dd[3] * dd[3])) * (1.f / 256.f);
                y = dd * (1.0f / sqrtf(var + LN_EPS));
            } else {
                const float ms = wave_sum((o[0] * o[0] + o[1] * o[1]) + (o[2] * o[2] + o[3] * o[3])) * (1.f / 256.f);
                y = o * (1.0f / sqrtf(ms + LN_EPS)) * gn;
            }
            float r[4];
#pragma unroll
            for (int i = 0; i < 4; ++i) { const float g = gt[i]; r[i] = g / (1.0f + expf(-g)) * y[i]; }
            v2u w; w.x = pk2(r[0], r[1]); w.y = pk2(r[2], r[3]);
            *(GAS v2u*)(mixed + (size_t)t * D + h8 * 256 + 4 * F.lane) = w;
        }
    }
}
template <bool ROUTER>
__device__ __forceinline__ void ln_apply(Frame& F, const float* Y, const float* g, const float* b, bf16* HB, float* st, bool count = true) {
    const int gw = F.bid * NWAVES + F.wave, NGW = F.G * NWAVES;
    for (int t = gw; t < T; t += NGW) {
        const GAS f32x4* yr = (const GAS f32x4*)(Y + (size_t)t * D) + F.lane;
        f32x4 v[8]; float s = 0.f;
#pragma unroll
        for (int j = 0; j < 8; ++j) { v[j] = yr[64 * j]; s += (v[j][0] + v[j][1]) + (v[j][2] + v[j][3]); }
        const float mean = wave_sum(s) * (1.f / D); float s2 = 0.f;
#pragma unroll
        for (int j = 0; j < 8; ++j) { v[j] = v[j] - mean; s2 += (v[j][0] * v[j][0] + v[j][1] * v[j][1]) + (v[j][2] * v[j][2] + v[j][3] * v[j][3]); }
        const float rstd = 1.f / sqrtf(wave_sum(s2) * (1.f / D) + LN_EPS);
        if (F.lane == 0) { st[2 * t] = mean; st[2 * t + 1] = rstd; }
        GAS v2u* o8 = (GAS v2u*)(HB + (size_t)t * D) + F.lane;
#pragma unroll
        for (int j = 0; j < 8; ++j) { const f32x4 gv = *(const f32x4*)(g + 4 * F.lane + 256 * j), bv = *(const f32x4*)(b + 4 * F.lane + 256 * j);
            v[j] = v[j] * rstd * gv + bv;
            v2u w; w.x = pk2(v[j][0], v[j][1]); w.y = pk2(v[j][2], v[j][3]); o8[64 * j] = w; }
        if (ROUTER) {
            const float* Wg = F.in[16]; const float* We = F.in[18];
            float lg[4], le[32];
#pragma unroll
            for (int i = 0; i < 4; ++i) lg[i] = 0.f;
#pragma unroll
            for (int i = 0; i < 32; ++i) le[i] = 0.f;
#pragma unroll
            for (int j = 0; j < 8; ++j) {
#pragma unroll
                for (int i = 0; i < 4; ++i) { const int c = 4 * F.lane + 256 * j + i; const float hv = v[j][i];
                    const f32x4 wg = *(const GAS f32x4*)(Wg + (size_t)c * 4);
#pragma unroll
                    for (int q = 0; q < 4; ++q) lg[q] += hv * wg[q];
#pragma unroll
                    for (int q8 = 0; q8 < 8; ++q8) { const f32x4 we = *(const GAS f32x4*)(We + (size_t)c * 32 + 4 * q8);
#pragma unroll
                        for (int q = 0; q < 4; ++q) le[4 * q8 + q] += hv * we[q]; } }
            }
#pragma unroll
            for (int i = 0; i < 4; ++i) lg[i] = wave_sum(lg[i]) + F.in[17][i];
#pragma unroll
            for (int i = 0; i < 32; ++i) le[i] = wave_sum(le[i]);
            int grp = 0; float gm = lg[0];
#pragma unroll
            for (int i = 1; i < 4; ++i) if (lg[i] > gm) { gm = lg[i]; grp = i; }
            float gs = 0.f;
#pragma unroll
            for (int i = 0; i < 4; ++i) gs += expf(lg[i] - gm);
            const float pg_sel = 1.0f / gs;
            float fe[8];
#pragma unroll
            for (int j = 0; j < 8; ++j) { const float a = grp == 0 ? le[j] : grp == 1 ? le[8 + j] : grp == 2 ? le[16 + j] : le[24 + j]; fe[j] = a + F.in[19][grp * 8 + j]; }
            int i1 = 0; float m1 = fe[0];
#pragma unroll
            for (int j = 1; j < 8; ++j) if (fe[j] > m1) { m1 = fe[j]; i1 = j; }
            int i2 = -1; float m2 = -3.0e38f;
#pragma unroll
            for (int j = 0; j < 8; ++j) if (j != i1 && fe[j] > m2) { m2 = fe[j]; i2 = j; }
            const float p2 = expf(m2 - m1), den = 1.0f / (1.0f + p2);
            if (F.lane == 0) {
                int* ex = WSP(int, WS_EXP); float* gt = WSP(float, WS_GATE);
                const int e1 = grp * 8 + i1, e2 = grp * 8 + i2;
                ex[2 * t] = e1; ex[2 * t + 1] = e2; gt[2 * t] = pg_sel * den; gt[2 * t + 1] = pg_sel * p2 * den;
                if (count) { atomicAdd((unsigned*)(F.ctl + CW_CNT) + e1, 1u); atomicAdd((unsigned*)(F.ctl + CW_CNT) + e2, 1u); }
            }
        }
    }
}
__device__ __forceinline__ void p7_attn_naive(Frame& F) {
    const bf16* Q = WSP(bf16, WS_QB); const bf16* KVM = WSP(bf16, WS_KVM); bf16* att = WSP(bf16, WS_ATT);
    LAS float* qs = (LAS float*)F.lds;
    LAS float* sc = (LAS float*)(F.lds + 16384);
    for (int item = F.bid; item < (T / 8) * 4; item += F.G) {
        const int h = item & 3, t0 = (item >> 2) * 8;
        for (int i = F.tid; i < 8 * 512; i += NTHR) { const int tt = i >> 9, d = i & 511; qs[i] = bf2f(Q[(size_t)(t0 + tt) * D + h * 512 + d]); }
        __syncthreads();
        {
            const int j = F.tid & 255, th = F.tid >> 8;
            const bf16* kr = KVM + (size_t)j * 4096 + h * 512;
            float a0 = 0.f, a1 = 0.f, a2 = 0.f, a3 = 0.f;
            for (int d = 0; d < 512; d += 8) {
                const v4u kw = *(const GAS v4u*)(kr + d);
                const float kf[8] = {bflo(kw.x), bfhi(kw.x), bflo(kw.y), bfhi(kw.y), bflo(kw.z), bfhi(kw.z), bflo(kw.w), bfhi(kw.w)};
#pragma unroll
                for (int i = 0; i < 8; ++i) { a0 += kf[i] * qs[(th * 4 + 0) * 512 + d + i]; a1 += kf[i] * qs[(th * 4 + 1) * 512 + d + i]; a2 += kf[i] * qs[(th * 4 + 2) * 512 + d + i]; a3 += kf[i] * qs[(th * 4 + 3) * 512 + d + i]; }
            }
            const float scl = 0.04419417382415922f;
            sc[(th * 4 + 0) * 256 + j] = a0 * scl; sc[(th * 4 + 1) * 256 + j] = a1 * scl; sc[(th * 4 + 2) * 256 + j] = a2 * scl; sc[(th * 4 + 3) * 256 + j] = a3 * scl;
        }
        __syncthreads();
        {
            float v[4]; float mx = -3.0e38f;
#pragma unroll
            for (int i = 0; i < 4; ++i) { v[i] = sc[F.wave * 256 + F.lane + 64 * i]; mx = fmaxf(mx, v[i]); }
            mx = wave_max(mx); float sm = 0.f;
#pragma unroll
            for (int i = 0; i < 4; ++i) { v[i] = expf(v[i] - mx); sm += v[i]; }
            sm = 1.0f / wave_sum(sm);
#pragma unroll
            for (int i = 0; i < 4; ++i) sc[F.wave * 256 + F.lane + 64 * i] = v[i] * sm;
        }
        __syncthreads();
        {
            const int d = F.tid; const bf16* vr = KVM + 2048 + h * 512 + d;
            float o[8];
#pragma unroll
            for (int i = 0; i < 8; ++i) o[i] = 0.f;
            for (int j = 0; j < 256; ++j) { const float vv = bf2f(vr[(size_t)j * 4096]);
#pragma unroll
                for (int i = 0; i < 8; ++i) o[i] += sc[i * 256 + j] * vv; }
#pragma unroll
            for (int i = 0; i < 8; ++i) att[(size_t)(t0 + i) * D + h * 512 + d] = (bf16)f2bf(o[i]);
        }
        __syncthreads();
    }
}
__device__ __forceinline__ void moe_tile_starts(Frame& F, LAS int* ts) {
    if (F.tid < 64) {
        const unsigned c = F.lane < 32 ? __hip_atomic_load(F.ctl + CW_CUR + (F.lane & 31), RLX_AGENT) : 0u;
        int v = (int)((c + 255u) >> 8);
#pragma unroll
        for (int o = 1; o < 32; o <<= 1) { const int n = __shfl_up(v, o); if (F.lane >= o) v += n; }
        if (F.lane < 32) ts[F.lane + 1] = v;
        if (F.lane == 0) ts[0] = 0;
    }
    __syncthreads();
}
__device__ __forceinline__ void p10_dispatch(Frame& F, LAS int* ts) {
    const int gw = F.bid * NWAVES + F.wave, NGW = F.G * NWAVES;
    const int* ex = WSP(int, WS_EXP); int* pos = WSP(int, WS_POS); const bf16* h2 = WSP(bf16, WS_H2B); bf16* xs = WSP(bf16, WS_XS);
    for (int a = gw; a < 2 * T; a += NGW) {
        const int e = ex[a]; const int slot = WSP(int, WS_SLOT)[a];
        const int p = ts[e] * 256 + slot;
        if (F.lane == 0) pos[a] = p;
        const GAS v4u* src = (const GAS v4u*)(h2 + (size_t)(a >> 1) * D) + F.lane; GAS v4u* dst = (GAS v4u*)(xs + (size_t)p * D) + F.lane;
#pragma unroll
        for (int j = 0; j < 4; ++j) dst[64 * j] = src[64 * j];
    }
}
__device__ __forceinline__ void p13_combine(Frame& F) {
    const int gw = F.bid * NWAVES + F.wave, NGW = F.G * NWAVES;
    const float* Y2 = WSP(float, WS_Y2); const float* st2 = WSP(float, WS_ST2); const bf16* ys = WSP(bf16, WS_YS);
    const int* pos = WSP(int, WS_POS); const float* gt = WSP(float, WS_GATE);
    const float* g2 = F.in[14]; const float* b2 = F.in[15]; const float* g3 = F.in[23]; const float* b3 = F.in[24];
    for (int t = gw; t < T; t += NGW) {
        const float mu2 = st2[2 * t], rs2 = st2[2 * t + 1];
        const int p0 = pos[2 * t], p1 = pos[2 * t + 1]; const float w0 = gt[2 * t], w1 = gt[2 * t + 1];
        const GAS f32x4* yr = (const GAS f32x4*)(Y2 + (size_t)t * D) + F.lane;
        const GAS v2u* y0 = (const GAS v2u*)(ys + (size_t)p0 * D) + F.lane; const GAS v2u* y1 = (const GAS v2u*)(ys + (size_t)p1 * D) + F.lane;
        f32x4 v[8]; float s = 0.f;
#pragma unroll
        for (int j = 0; j < 8; ++j) { const f32x4 gv = *(const f32x4*)(g2 + 4 * F.lane + 256 * j), bv = *(const f32x4*)(b2 + 4 * F.lane + 256 * j);
            const f32x4 h = (yr[64 * j] - mu2) * rs2 * gv + bv;
            const v2u a = y0[64 * j], c = y1[64 * j];
            const f32x4 fa = {bflo(a.x), bfhi(a.x), bflo(a.y), bfhi(a.y)}, fc = {bflo(c.x), bfhi(c.x), bflo(c.y), bfhi(c.y)};
            v[j] = h * ALPHA + fa * w0 + fc * w1; s += (v[j][0] + v[j][1]) + (v[j][2] + v[j][3]); }
        const float mean = wave_sum(s) * (1.f / D); float s2 = 0.f;
#pragma unroll
        for (int j = 0; j < 8; ++j) { v[j] = v[j] - mean; s2 += (v[j][0] * v[j][0] + v[j][1] * v[j][1]) + (v[j][2] * v[j][2] + v[j][3] * v[j][3]); }
        const float rstd = 1.f / sqrtf(wave_sum(s2) * (1.f / D) + LN_EPS);
        GAS f32x4* orow = (GAS f32x4*)(F.out + (size_t)t * D) + F.lane;
#pragma unroll
        for (int j = 0; j < 8; ++j) { const f32x4 gv = *(const f32x4*)(g3 + 4 * F.lane + 256 * j), bv = *(const f32x4*)(b3 + 4 * F.lane + 256 * j);
            orow[64 * j] = v[j] * rstd * gv + bv; }
    }
}

constexpr int CS = 128, NB = CS / 64, NS = T / CS;
constexpr size_t WS_BCUM = WS_ORAW;
constexpr size_t WS_KVR = WS_ORAW + 16 * MiB;
constexpr size_t WS_KVG = WS_KVR + 32 * MiB;
typedef short bf16x8_t __attribute__((ext_vector_type(8)));
typedef short s16x4_t __attribute__((ext_vector_type(4)));
__device__ __forceinline__ s16x4_t lds_tr(const LAS unsigned char* p) { return __builtin_bit_cast(s16x4_t, __builtin_amdgcn_ds_read_tr16_b64_v4i16((LAS s16x4_t*)p)); }
__device__ __forceinline__ bf16x8_t frag_tr(const LAS unsigned char* X, int pitch, int k0, int n0, int lane) {
    const int fq = lane >> 4, q = (lane >> 2) & 3, p = lane & 3;
    const LAS unsigned char* a = X + ((k0 + 8 * fq + q) * pitch + n0 + 4 * p) * 2;
    const s16x4_t lo = lds_tr(a), hi = lds_tr(a + 4 * pitch * 2);
    return __builtin_shufflevector(lo, hi, 0, 1, 2, 3, 4, 5, 6, 7);
}
__device__ __forceinline__ bf16x8_t frag_row(const LAS unsigned char* X, int pitch, int r0, int k0, int lane) {
    return *(const LAS bf16x8_t*)(X + ((r0 + (lane & 15)) * pitch + k0 + 8 * (lane >> 4)) * 2);
}
#define MFMA16(a, b, c) __builtin_amdgcn_mfma_f32_16x16x32_bf16((a), (b), (c), 0, 0, 0)
__device__ __forceinline__ float fexp(float x) { return __builtin_amdgcn_exp2f(x * 1.4426950408889634f); }
__device__ __forceinline__ float silu_g(float g) { return g * __builtin_amdgcn_rcpf(1.0f + __builtin_amdgcn_exp2f(-1.4426950408889634f * g)); }

__device__ __forceinline__ void bcum_item(Frame& F, int s, int h) {
    const int c = F.tid & 127, tq = F.tid >> 7;
    LAS float* tot = (LAS float*)F.lds;
    const float* glr = WSP(float, WS_GLR); float* bc = WSP(float, WS_BCUM);
    float w[16];
#pragma unroll
    for (int r = 0; r < 16; ++r) w[r] = F.in[4][r * 512 + h * 128 + c];
    const float bias = F.in[5][h * 128 + c];
    float vals[32]; float run = 0.f;
    const int tb = s * CS + tq * 32;
#pragma unroll
    for (int i = 0; i < 32; ++i) { const float* gr = glr + (size_t)(tb + i) * 16; float z = bias;
#pragma unroll
        for (int r = 0; r < 16; ++r) z += gr[r] * w[r];
        run += log_sigmoid_f(z) * 0.0625f; vals[i] = run; }
    __syncthreads();
    tot[tq * 128 + c] = run;
    __syncthreads();
    float off = 0.f;
#pragma unroll
    for (int q = 0; q < 3; ++q) off += (q < tq) ? tot[q * 128 + c] : 0.f;
#pragma unroll
    for (int i = 0; i < 32; ++i) bc[(size_t)(tb + i) * 512 + h * 128 + c] = vals[i] + off;
}
__device__ __forceinline__ void p1_bcum(Frame& F) { for (int it = F.bid; it < NS * 4; it += F.G) bcum_item(F, it >> 2, it & 3); __syncthreads(); }

__device__ __forceinline__ void unit_sh(int u, int& s, int& h8) { s = (u >> 3) & (NS - 1); h8 = ((u & 7) + 4 * (u >> 8)) & 7; }

template <bool GLA, int MODE>
__device__ __forceinline__ void stage_qk(Frame& F, LAS unsigned char* dst, int s, int jb, int hh, int col0, float lg2gamma) {
    constexpr int DK = GLA ? 128 : 256, PK = DK + 8, CPR = DK / 8, NIT = 64 * CPR / NTHR;
    const bf16* H = WSP(bf16, WS_H); const float* bc = WSP(float, WS_BCUM);
#pragma unroll
    for (int it = 0; it < NIT; ++it) {
        const int ch = F.tid + NTHR * it, r = ch / CPR, cc = ch % CPR, tl = jb * 64 + r, t = s * CS + tl;
        const v4u w = *(const GAS v4u*)(H + (size_t)t * HW + col0 + 8 * cc);
        float f[8] = {bflo(w.x), bfhi(w.x), bflo(w.y), bfhi(w.y), bflo(w.z), bfhi(w.z), bflo(w.w), bfhi(w.w)};
        if (GLA) {
            const f32x4 b0 = *(const GAS f32x4*)(bc + (size_t)t * 512 + hh * 128 + 8 * cc), b1 = *(const GAS f32x4*)(bc + (size_t)t * 512 + hh * 128 + 8 * cc + 4);
            float e[8] = {b0[0], b0[1], b0[2], b0[3], b1[0], b1[1], b1[2], b1[3]};
            if (MODE == 2) { const size_t tl_ = (size_t)(s * CS + CS - 1) * 512 + hh * 128 + 8 * cc; const f32x4 l0 = *(const GAS f32x4*)(bc + tl_), l1 = *(const GAS f32x4*)(bc + tl_ + 4);
                const float l[8] = {l0[0], l0[1], l0[2], l0[3], l1[0], l1[1], l1[2], l1[3]};
#pragma unroll
                for (int i = 0; i < 8; ++i) e[i] = l[i] - e[i]; }
            else if (MODE == 1) {
#pragma unroll
                for (int i = 0; i < 8; ++i) e[i] = -e[i]; }
#pragma unroll
            for (int i = 0; i < 8; ++i) f[i] *= fexp(e[i]);
        } else {
            const float ex = MODE == 0 ? (float)(tl + 1) : MODE == 1 ? -(float)(tl + 1) : (float)(CS - 1 - tl);
            const float fac = __builtin_amdgcn_exp2f(ex * lg2gamma);
#pragma unroll
            for (int i = 0; i < 8; ++i) f[i] *= fac;
        }
        v4u o; o.x = pk2(f[0], f[1]); o.y = pk2(f[2], f[3]); o.z = pk2(f[4], f[5]); o.w = pk2(f[6], f[7]);
        *(LAS v4u*)(dst + (r * PK + 8 * cc) * 2) = o;
    }
}
__device__ __forceinline__ void stage_v(Frame& F, LAS unsigned char* dst, int s, int jb, int col0) {
    const bf16* H = WSP(bf16, WS_H);
#pragma unroll
    for (int it = 0; it < 4; ++it) { const int ch = F.tid + NTHR * it, r = ch >> 5, cc = ch & 31, t = s * CS + jb * 64 + r;
        *(LAS v4u*)(dst + (r * 264 + 8 * cc) * 2) = *(const GAS v4u*)(H + (size_t)t * HW + col0 + 8 * cc); }
}

template <bool GLA>
__device__ __forceinline__ void kv_unit(Frame& F, int s, int hh) {
    constexpr int DK = GLA ? 128 : 256, PK = DK + 8, NDT = DK / 16;
    LAS unsigned char* Ks = F.lds; LAS unsigned char* Vs = F.lds + 34816;
    const int kcol = GLA ? 4608 + hh * 128 : 1024 + hh * 256, vcol = (GLA ? 5120 : 2048) + hh * 256;
    const float lg2g = log2f(1.0f - exp2f(-5.0f - (float)hh));
    f32x4 acc[2][NDT];
#pragma unroll
    for (int a = 0; a < 2; ++a)
#pragma unroll
        for (int d = 0; d < NDT; ++d) acc[a][d] = (f32x4){0.f, 0.f, 0.f, 0.f};
    for (int jb = 0; jb < NB; ++jb) {
        __syncthreads();
        stage_qk<GLA, 2>(F, Ks, s, jb, hh, kcol, lg2g);
        stage_v(F, Vs, s, jb, vcol);
        __syncthreads();
#pragma unroll
        for (int ks = 0; ks < 2; ++ks) {
            bf16x8_t vf[2];
#pragma unroll
            for (int et = 0; et < 2; ++et) vf[et] = frag_tr(Vs, 264, 32 * ks, 32 * F.wave + 16 * et, F.lane);
#pragma unroll
            for (int dt = 0; dt < NDT; ++dt) { const bf16x8_t kf = frag_tr(Ks, PK, 32 * ks, 16 * dt, F.lane);
#pragma unroll
                for (int et = 0; et < 2; ++et) acc[et][dt] = MFMA16(kf, vf[et], acc[et][dt]); }
        }
    }
    bf16* kv = GLA ? (WSP(bf16, WS_KVG) + (size_t)(s * 4 + hh) * 256 * 128) : (WSP(bf16, WS_KVR) + (size_t)(s * 4 + hh) * 256 * 256);
    const int fr = F.lane & 15, fq = F.lane >> 4;
#pragma unroll
    for (int et = 0; et < 2; ++et)
#pragma unroll
        for (int dt = 0; dt < NDT; ++dt) { v2u w; w.x = pk2(acc[et][dt][0], acc[et][dt][1]); w.y = pk2(acc[et][dt][2], acc[et][dt][3]);
            *(GAS v2u*)(kv + (size_t)(32 * F.wave + 16 * et + fr) * DK + 16 * dt + 4 * fq) = w; }
}
__device__ __forceinline__ void p2_kv(Frame& F) {
    for (int u = F.bid; u < 8 * NS; u += F.G) { int s, h8; unit_sh(u, s, h8);
        if (s == NS - 1) continue;
        if (h8 < 4) kv_unit<false>(F, s, h8); else kv_unit<true>(F, s, h8 - 4); }
    __syncthreads();
}
__device__ __forceinline__ void p3_scan(Frame& F) {
    constexpr int NR = 4 * 256 * 64, NG = 4 * 256 * 32, NITEM = NR + NG;
    const float* bc = WSP(float, WS_BCUM);
    const int per = (NITEM + F.G - 1) / F.G;
    for (int k0 = F.tid; k0 < per; k0 += NTHR) {
      const int it = F.bid * per + k0;
      if (it < NITEM) {
        const bool gla = it >= NR; const int r = gla ? it - NR : it;
        const int sh = gla ? 5 : 6, dk = gla ? 128 : 256;
        const int cc = r & ((1 << sh) - 1), e = (r >> sh) & 255, hh = r >> (sh + 8);
        bf16* base = (gla ? WSP(bf16, WS_KVG) : WSP(bf16, WS_KVR)) + ((size_t)hh * 256 + e) * dk + 4 * cc;
        const size_t sstride = (size_t)4 * 256 * dk;
        const float dret = __builtin_amdgcn_exp2f((float)CS * log2f(1.0f - exp2f(-5.0f - (float)hh)));
        float S[4] = {0.f, 0.f, 0.f, 0.f};
#pragma unroll 8
        for (int s = 0; s < NS - 1; ++s) {
            GAS v2u* p = (GAS v2u*)(base + (size_t)s * sstride);
            const v2u w = *p;
            v2u o; o.x = pk2(S[0], S[1]); o.y = pk2(S[2], S[3]);
            *p = o;
            const float f[4] = {bflo(w.x), bfhi(w.x), bflo(w.y), bfhi(w.y)};
            float dec[4] = {dret, dret, dret, dret};
            if (gla) { const f32x4 l0 = *(const GAS f32x4*)(bc + (size_t)(s * CS + CS - 1) * 512 + hh * 128 + 4 * cc);
                dec[0] = fexp(l0[0]); dec[1] = fexp(l0[1]); dec[2] = fexp(l0[2]); dec[3] = fexp(l0[3]); }
#pragma unroll
            for (int i = 0; i < 4; ++i) S[i] = dec[i] * S[i] + f[i];
        }
        { GAS v2u* p = (GAS v2u*)(base + (size_t)(NS - 1) * sstride); v2u o; o.x = pk2(S[0], S[1]); o.y = pk2(S[2], S[3]); *p = o; }
      }
    }
}
template <bool GLA>
__device__ __forceinline__ void out_unit(Frame& F, int s, int hh) {
    constexpr int DK = GLA ? 128 : 256, PK = DK + 8, NKS = DK / 32;
    LAS unsigned char* Qs = F.lds; LAS unsigned char* Ks = F.lds + 33792; LAS unsigned char* Vs = F.lds + 67584; LAS unsigned char* Ps = F.lds + 101376;
    LAS float* red = (LAS float*)(F.lds + 110592);
    const int qcol = GLA ? 4096 + hh * 128 : hh * 256, kcol = GLA ? 4608 + hh * 128 : 1024 + hh * 256, vcol = (GLA ? 5120 : 2048) + hh * 256;
    const int gcol = (GLA ? 6144 : 3072) + hh * 256, ocol = (GLA ? 1024 : 0) + hh * 256;
    const float lg2g = log2f(1.0f - exp2f(-5.0f - (float)hh));
    const bf16* H = WSP(bf16, WS_H); bf16* mixed = WSP(bf16, WS_MIXED);
    const bf16* st = GLA ? (WSP(bf16, WS_KVG) + (size_t)(s * 4 + hh) * 256 * 128) : (WSP(bf16, WS_KVR) + (size_t)(s * 4 + hh) * 256 * 256);
    const int fr = F.lane & 15, fq = F.lane >> 4, w = F.wave, mt = w >> 1, nt0 = 2 * (w & 1);
    for (int i = 0; i < NB; ++i) {
        __syncthreads();
        stage_qk<GLA, 0>(F, Qs, s, i, hh, qcol, lg2g);
        f32x4 accO[4][2];
#pragma unroll
        for (int m = 0; m < 4; ++m)
#pragma unroll
            for (int n = 0; n < 2; ++n) accO[m][n] = (f32x4){0.f, 0.f, 0.f, 0.f};
        for (int j = 0; j <= i; ++j) {
            __syncthreads();
            stage_qk<GLA, 1>(F, Ks, s, j, hh, kcol, lg2g);
            stage_v(F, Vs, s, j, vcol);
            __syncthreads();
            f32x4 accS[2] = {(f32x4){0.f, 0.f, 0.f, 0.f}, (f32x4){0.f, 0.f, 0.f, 0.f}};
#pragma unroll
            for (int ks = 0; ks < NKS; ++ks) { const bf16x8_t qf = frag_row(Qs, PK, 16 * mt, 32 * ks, F.lane);
#pragma unroll
                for (int n2 = 0; n2 < 2; ++n2) { const bf16x8_t kf = frag_row(Ks, PK, 16 * (nt0 + n2), 32 * ks, F.lane); accS[n2] = MFMA16(kf, qf, accS[n2]); } }
#pragma unroll
            for (int n2 = 0; n2 < 2; ++n2) { const int row = 16 * mt + fr, c0 = 16 * (nt0 + n2) + 4 * fq; float pv[4];
#pragma unroll
                for (int jj = 0; jj < 4; ++jj) pv[jj] = (i == j && c0 + jj > row) ? 0.f : accS[n2][jj];
                v2u pw; pw.x = pk2(pv[0], pv[1]); pw.y = pk2(pv[2], pv[3]);
                *(LAS v2u*)(Ps + (row * 72 + c0) * 2) = pw; }
            __syncthreads();
#pragma unroll
            for (int ks = 0; ks < 2; ++ks) {
                bf16x8_t vf[2];
#pragma unroll
                for (int n = 0; n < 2; ++n) vf[n] = frag_tr(Vs, 264, 32 * ks, 32 * w + 16 * n, F.lane);
#pragma unroll
                for (int m = 0; m < 4; ++m) { const bf16x8_t pf = frag_row(Ps, 72, 16 * m, 32 * ks, F.lane);
#pragma unroll
                    for (int n = 0; n < 2; ++n) accO[m][n] = MFMA16(vf[n], pf, accO[m][n]); }
            }
        }
        if (s > 0) {
#pragma unroll
            for (int ks = 0; ks < NKS; ++ks) {
                bf16x8_t sf[2];
#pragma unroll
                for (int n = 0; n < 2; ++n) sf[n] = *(const GAS bf16x8_t*)(st + (size_t)(32 * w + 16 * n + fr) * DK + 32 * ks + 8 * fq);
#pragma unroll
                for (int m = 0; m < 4; ++m) { const bf16x8_t qf = frag_row(Qs, PK, 16 * m, 32 * ks, F.lane);
#pragma unroll
                    for (int n = 0; n < 2; ++n) accO[m][n] = MFMA16(sf[n], qf, accO[m][n]); }
            }
        }
#pragma unroll
        for (int m = 0; m < 4; ++m) { float s1 = 0.f, s2 = 0.f;
#pragma unroll
            for (int n = 0; n < 2; ++n)
#pragma unroll
                for (int jj = 0; jj < 4; ++jj) { const float v = accO[m][n][jj]; s1 += v; s2 += v * v; }
            s1 += __shfl_xor(s1, 16); s1 += __shfl_xor(s1, 32); s2 += __shfl_xor(s2, 16); s2 += __shfl_xor(s2, 32);
            if (fq == 0) { red[(w * 64 + 16 * m + fr) * 2] = s1; red[(w * 64 + 16 * m + fr) * 2 + 1] = s2; } }
        __syncthreads();
#pragma unroll
        for (int m = 0; m < 4; ++m) { const int row = 16 * m + fr; float s1 = 0.f, s2 = 0.f;
#pragma unroll
            for (int ww = 0; ww < 8; ++ww) { s1 += red[(ww * 64 + row) * 2]; s2 += red[(ww * 64 + row) * 2 + 1]; }
            const float mean = s1 * (1.f / 256.f), ex2 = s2 * (1.f / 256.f);
            const float mu = GLA ? 0.f : mean, var = GLA ? ex2 : fmaxf(ex2 - mean * mean, 0.f);
            const float rstd = 1.0f / sqrtf(var + LN_EPS);
            const int t = s * CS + i * 64 + row;
#pragma unroll
            for (int n = 0; n < 2; ++n) { const int e = 32 * w + 16 * n + 4 * fq;
                const v2u gw2 = *(const GAS v2u*)(H + (size_t)t * HW + gcol + e);
                const float gt[4] = {bflo(gw2.x), bfhi(gw2.x), bflo(gw2.y), bfhi(gw2.y)};
                f32x4 gn = {1.f, 1.f, 1.f, 1.f}; if (GLA) gn = *(const f32x4*)(F.in[6] + e);
                float r4[4];
#pragma unroll
                for (int jj = 0; jj < 4; ++jj) { const float y = (accO[m][n][jj] - mu) * rstd * gn[jj]; r4[jj] = silu_g(gt[jj]) * y; }
                v2u ow; ow.x = pk2(r4[0], r4[1]); ow.y = pk2(r4[2], r4[3]);
                *(GAS v2u*)(mixed + (size_t)t * D + ocol + e) = ow; } }
    }
}
__device__ __forceinline__ void p4_out(Frame& F) {
    for (int u = F.bid; u < 8 * NS; u += F.G) { int s, h8; unit_sh(u, s, h8);
        if (h8 < 4) out_unit<false>(F, s, h8); else out_unit<true>(F, s, h8 - 4); }
    __syncthreads();
}

__device__ __forceinline__ void stage_kv_chunk(Frame& F, LAS unsigned char* dst, const bf16* src  ) {
#pragma unroll
    for (int it = 0; it < 8; ++it) { const int ch = F.tid + NTHR * it, r = ch >> 4, cc = ch & 15;
        *(LAS v4u*)(dst + (r * 136 + 8 * cc) * 2) = *(const GAS v4u*)(src + (size_t)r * 4096 + 8 * cc); }
}
__device__ __forceinline__ void p8_attn(Frame& F) {
    const bf16* Q = WSP(bf16, WS_QB); const bf16* KVM = WSP(bf16, WS_KVM); bf16* att = WSP(bf16, WS_ATT);
    LAS unsigned char* Cs = F.lds;
    const int fr = F.lane & 15, fq = F.lane >> 4, q4 = (F.lane >> 2) & 3, p4 = F.lane & 3;
    for (int u = F.bid; u < (T / 128) * 4; u += F.G) {
        const int h = u & 3, r0 = (u >> 2) * 128 + 16 * F.wave;
        f32x4 accS[16];
#pragma unroll
        for (int i = 0; i < 16; ++i) accS[i] = (f32x4){0.f, 0.f, 0.f, 0.f};
        for (int dc = 0; dc < 4; ++dc) {
            __syncthreads();
            stage_kv_chunk(F, Cs, KVM + h * 512 + dc * 128);
            bf16x8_t qf[4];
#pragma unroll
            for (int ks = 0; ks < 4; ++ks) qf[ks] = *(const GAS bf16x8_t*)(Q + (size_t)(r0 + fr) * D + h * 512 + dc * 128 + 32 * ks + 8 * fq);
            __syncthreads();
#pragma unroll
            for (int ks = 0; ks < 4; ++ks)
#pragma unroll
                for (int nt = 0; nt < 16; ++nt) accS[nt] = MFMA16(frag_row(Cs, 136, 16 * nt, 32 * ks, F.lane), qf[ks], accS[nt]);
        }
        float mx = -3.0e38f;
#pragma unroll
        for (int nt = 0; nt < 16; ++nt)
#pragma unroll
            for (int jj = 0; jj < 4; ++jj) mx = fmaxf(mx, accS[nt][jj]);
        mx = fmaxf(mx, __shfl_xor(mx, 16)); mx = fmaxf(mx, __shfl_xor(mx, 32));
        const float sl2 = 0.04419417382415922f * 1.4426950408889634f;
        float sm = 0.f;
#pragma unroll
        for (int nt = 0; nt < 16; ++nt)
#pragma unroll
            for (int jj = 0; jj < 4; ++jj) { const float p = __builtin_amdgcn_exp2f((accS[nt][jj] - mx) * sl2); accS[nt][jj] = p; sm += p; }
        sm += __shfl_xor(sm, 16); sm += __shfl_xor(sm, 32);
        const float inv = 1.0f / sm;
        bf16x8_t pf[8];
#pragma unroll
        for (int ks2 = 0; ks2 < 8; ++ks2) { v4u w; w.x = pk2(accS[2 * ks2][0] * inv, accS[2 * ks2][1] * inv); w.y = pk2(accS[2 * ks2][2] * inv, accS[2 * ks2][3] * inv);
            w.z = pk2(accS[2 * ks2 + 1][0] * inv, accS[2 * ks2 + 1][1] * inv); w.w = pk2(accS[2 * ks2 + 1][2] * inv, accS[2 * ks2 + 1][3] * inv); pf[ks2] = __builtin_bit_cast(bf16x8_t, w); }
        for (int ec = 0; ec < 4; ++ec) {
            __syncthreads();
            stage_kv_chunk(F, Cs, KVM + 2048 + h * 512 + ec * 128);
            __syncthreads();
            f32x4 accO[8];
#pragma unroll
            for (int i = 0; i < 8; ++i) accO[i] = (f32x4){0.f, 0.f, 0.f, 0.f};
#pragma unroll
            for (int ks2 = 0; ks2 < 8; ++ks2)
#pragma unroll
                for (int et = 0; et < 8; ++et) { const LAS unsigned char* a = Cs + ((32 * ks2 + 4 * fq + q4) * 136 + 16 * et + 4 * p4) * 2;
                    const s16x4_t lo = lds_tr(a), hi = lds_tr(a + 16 * 136 * 2);
                    accO[et] = MFMA16(__builtin_shufflevector(lo, hi, 0, 1, 2, 3, 4, 5, 6, 7), pf[ks2], accO[et]); }
#pragma unroll
            for (int et = 0; et < 8; ++et) { v2u w; w.x = pk2(accO[et][0], accO[et][1]); w.y = pk2(accO[et][2], accO[et][3]);
                *(GAS v2u*)(att + (size_t)(r0 + fr) * D + h * 512 + ec * 128 + 16 * et + 4 * fq) = w; }
        }
    }
    __syncthreads();
}

__device__ __forceinline__ void p10_ln_router(Frame& F) {
    const float* Y = WSP(float, WS_Y2); const float* g = F.in[14]; const float* b = F.in[15]; bf16* HB = WSP(bf16, WS_H2B); float* st = WSP(float, WS_ST2);
    const float* Wg = F.in[16]; const float* We = F.in[18];
    LAS float* stl = (LAS float*)F.lds;
    LAS float* part = (LAS float*)(F.lds + 1024);
    LAS int* lcnt = (LAS int*)(F.lds + 1024 + 24576);
    LAS int* lbase = lcnt + 32;
    if (F.tid < 32) lcnt[F.tid] = 0;
    __syncthreads();
    const int fr = F.lane & 15, fq = F.lane >> 4;
    for (int item = F.bid; item < T / 32; item += F.G) {
        const int row0 = item * 32;
#pragma unroll 1
        for (int i = 0; i < 4; ++i) {
            const int t = row0 + 4 * F.wave + i;
            const GAS f32x4* yr = (const GAS f32x4*)(Y + (size_t)t * D) + F.lane;
            f32x4 v[8]; float s = 0.f;
#pragma unroll
            for (int j = 0; j < 8; ++j) { v[j] = yr[64 * j]; s += (v[j][0] + v[j][1]) + (v[j][2] + v[j][3]); }
            const float mean = wave_sum(s) * (1.f / D); float s2 = 0.f;
#pragma unroll
            for (int j = 0; j < 8; ++j) { v[j] = v[j] - mean; s2 += (v[j][0] * v[j][0] + v[j][1] * v[j][1]) + (v[j][2] * v[j][2] + v[j][3] * v[j][3]); }
            const float rstd = 1.f / sqrtf(wave_sum(s2) * (1.f / D) + LN_EPS);
            if (F.lane == 0) { st[2 * t] = mean; st[2 * t + 1] = rstd; stl[2 * (4 * F.wave + i)] = mean; stl[2 * (4 * F.wave + i) + 1] = rstd; }
            GAS v2u* o8 = (GAS v2u*)(HB + (size_t)t * D) + F.lane;
#pragma unroll
            for (int j = 0; j < 8; ++j) { const f32x4 gv = *(const f32x4*)(g + 4 * F.lane + 256 * j), bv = *(const f32x4*)(b + 4 * F.lane + 256 * j);
                const f32x4 hv = v[j] * rstd * gv + bv;
                v2u w; w.x = pk2(hv[0], hv[1]); w.y = pk2(hv[2], hv[3]); o8[64 * j] = w; }
        }
        __syncthreads();
        {
            const int rt = F.wave >> 2, kq = F.wave & 3;
            const int r = row0 + 16 * rt + fr;
            const float mu = stl[2 * (16 * rt + fr)], rstd = stl[2 * (16 * rt + fr) + 1];
            f32x4 acc0 = {0.f, 0.f, 0.f, 0.f}, acc1 = acc0, acc2 = acc0;
            const float* yp = Y + (size_t)r * D + 512 * kq + 4 * fq;
            const float* wep = We + (size_t)(512 * kq + 4 * fq) * 32 + fr;
            const float* wgp = Wg + (size_t)(512 * kq + 4 * fq) * 4 + (fr & 3);
            const float gm = fr < 4 ? 1.f : 0.f;
#pragma unroll 8
            for (int it = 0; it < 32; ++it) {
                const int k0 = 16 * it;
                const f32x4 y4 = *(const GAS f32x4*)(yp + k0), g4 = *(const f32x4*)(g + 512 * kq + 4 * fq + k0), b4 = *(const f32x4*)(b + 512 * kq + 4 * fq + k0);
                const f32x4 a = (y4 - mu) * rstd * g4 + b4;
#pragma unroll
                for (int s = 0; s < 4; ++s) {
                    const float b0 = wep[(size_t)(k0 + s) * 32], b1 = wep[(size_t)(k0 + s) * 32 + 16], b2 = wgp[(size_t)(k0 + s) * 4] * gm;
                    acc0 = __builtin_amdgcn_mfma_f32_16x16x4f32(a[s], b0, acc0, 0, 0, 0);
                    acc1 = __builtin_amdgcn_mfma_f32_16x16x4f32(a[s], b1, acc1, 0, 0, 0);
                    acc2 = __builtin_amdgcn_mfma_f32_16x16x4f32(a[s], b2, acc2, 0, 0, 0);
                }
            }
            LAS float* pw = part + F.wave * 768;
#pragma unroll
            for (int jj = 0; jj < 4; ++jj) { pw[(4 * fq + jj) * 48 + fr] = acc0[jj]; pw[(4 * fq + jj) * 48 + 16 + fr] = acc1[jj]; pw[(4 * fq + jj) * 48 + 32 + fr] = acc2[jj]; }
        }
        __syncthreads();
        int e1 = 0, e2 = 0, r1 = 0, r2 = 0; float g1 = 0.f, g2 = 0.f;
        if (F.tid < 32) {
            const int rt = F.tid >> 4, rr = F.tid & 15;
            float le[32], lg[4];
#pragma unroll
            for (int c = 0; c < 32; ++c) { float s = 0.f;
#pragma unroll
                for (int kq = 0; kq < 4; ++kq) s += part[(rt * 4 + kq) * 768 + rr * 48 + c]; le[c] = s; }
#pragma unroll
            for (int c = 0; c < 4; ++c) { float s = 0.f;
#pragma unroll
                for (int kq = 0; kq < 4; ++kq) s += part[(rt * 4 + kq) * 768 + rr * 48 + 32 + c]; lg[c] = s + F.in[17][c]; }
            int grp = 0; float gmx = lg[0];
#pragma unroll
            for (int i = 1; i < 4; ++i) if (lg[i] > gmx) { gmx = lg[i]; grp = i; }
            float gs = 0.f;
#pragma unroll
            for (int i = 0; i < 4; ++i) gs += expf(lg[i] - gmx);
            const float pg_sel = 1.0f / gs;
            float fe[8];
#pragma unroll
            for (int j = 0; j < 8; ++j) { const float a = grp == 0 ? le[j] : grp == 1 ? le[8 + j] : grp == 2 ? le[16 + j] : le[24 + j]; fe[j] = a + F.in[19][grp * 8 + j]; }
            int i1 = 0; float m1 = fe[0];
#pragma unroll
            for (int j = 1; j < 8; ++j) if (fe[j] > m1) { m1 = fe[j]; i1 = j; }
            int i2 = -1; float m2 = -3.0e38f;
#pragma unroll
            for (int j = 0; j < 8; ++j) if (j != i1 && fe[j] > m2) { m2 = fe[j]; i2 = j; }
            const float p2 = expf(m2 - m1), den = 1.0f / (1.0f + p2);
            e1 = grp * 8 + i1; e2 = grp * 8 + i2; g1 = pg_sel * den; g2 = pg_sel * p2 * den;
            r1 = __hip_atomic_fetch_add((int*)(lcnt + e1), 1, __ATOMIC_RELAXED, __HIP_MEMORY_SCOPE_WORKGROUP); r2 = __hip_atomic_fetch_add((int*)(lcnt + e2), 1, __ATOMIC_RELAXED, __HIP_MEMORY_SCOPE_WORKGROUP);
        }
        __syncthreads();
        if (F.tid < 32) { const int c = lcnt[F.tid];
            lbase[F.tid] = c ? (int)__hip_atomic_fetch_add((unsigned*)(F.ctl + CW_CUR) + F.tid, (unsigned)c, __ATOMIC_RELAXED, __HIP_MEMORY_SCOPE_AGENT) : 0; }
        __syncthreads();
        if (F.tid < 32) {
            const int t = row0 + F.tid;
            int* ex = WSP(int, WS_EXP); float* gt = WSP(float, WS_GATE); int* sl = WSP(int, WS_SLOT);
            ex[2 * t] = e1; ex[2 * t + 1] = e2; gt[2 * t] = g1; gt[2 * t + 1] = g2;
            sl[2 * t] = lbase[e1] + r1; sl[2 * t + 1] = lbase[e2] + r2;
            lcnt[F.tid] = 0;
        }
        __syncthreads();
    }
}

#define XB_TMO      128
#define XB_XCNT(j)  (256  + 64 * (j))
#define XB_XSUB(j)  (1280 + 64 * (j))
#define XB_XGEN(j)  (2304 + 64 * (j))
#define XB_TOP      3328
#define XB_TOPGEN   3392
#define XCD_BAR_WORDS 3456
#define XB_SPIN_CAP (1u << 22)
__device__ __forceinline__ unsigned xb_ld(unsigned* p)              { return __hip_atomic_load(p, __ATOMIC_RELAXED, __HIP_MEMORY_SCOPE_AGENT); }
__device__ __forceinline__ unsigned xb_add(unsigned* p, unsigned v) { return __hip_atomic_fetch_add(p, v, __ATOMIC_RELAXED, __HIP_MEMORY_SCOPE_AGENT); }
__device__ __forceinline__ unsigned xb_xcc_id() { return (unsigned)__builtin_amdgcn_s_getreg((3 << 11) | 20) & 0xFu; }
#define XB_SPIN(cond, bar) do { unsigned _sp = 0; while (cond) { __builtin_amdgcn_s_sleep(1); \
    if ((++_sp & 255u) == 0u) { if (xb_ld(&(bar)[XB_TMO])) break; if (_sp > XB_SPIN_CAP) { atomicAdd(&(bar)[XB_TMO], 1u); break; } } } } while (0)
struct XcdBarrier { unsigned* bar; unsigned x; volatile LAS unsigned* st; };
__device__ __forceinline__ XcdBarrier xcd_barrier_post(unsigned* bar, volatile LAS unsigned* st) {
    XcdBarrier b; b.bar = bar; b.x = xb_xcc_id(); b.st = st;
    if (threadIdx.x == 0) (void)xb_add(&bar[XB_XCNT(b.x)], 1u);
    return b;
}
__device__ __forceinline__ void xcd_barrier_complete(unsigned* bar, unsigned x, unsigned& nloc, unsigned& nx) {
    const unsigned G = gridDim.x * gridDim.y * gridDim.z;
    unsigned sum, cnt, mine, sp = 0u;
    for (;;) {
        sum = 0u; cnt = 0u; mine = 0u;
#pragma unroll
        for (unsigned j = 0; j < 16; ++j) { const unsigned c = xb_ld(&bar[XB_XCNT(j)]); sum += c; cnt += (c > 0u) ? 1u : 0u; mine = (j == x) ? c : mine; }
        if (sum == G) break;
        __builtin_amdgcn_s_sleep(1);
        if ((++sp & 255u) == 0u) { if (xb_ld(&bar[XB_TMO])) break; if (sp > XB_SPIN_CAP) { atomicAdd(&bar[XB_TMO], 1u); break; } }
    }
    nloc = mine > 0u ? mine : 1u; nx = cnt > 0u ? cnt : 1u;
}
__device__ __forceinline__ void xcd_barrier(const XcdBarrier& b) {
    asm volatile("s_waitcnt vmcnt(0)" ::: "memory");
    __syncthreads();
    if (threadIdx.x == 0) {
        unsigned* bar = b.bar;
        __builtin_amdgcn_s_waitcnt(0);
        unsigned nloc = b.st[0], nx = b.st[1];
        if (nloc == 0u) { xcd_barrier_complete(bar, b.x, nloc, nx); b.st[0] = nloc; b.st[1] = nx; }
        const unsigned old = xb_add(&bar[XB_XSUB(b.x)], 1u);
        const unsigned gen = old / nloc;
        if (old + 1u == (gen + 1u) * nloc) {
            __builtin_amdgcn_fence(__ATOMIC_RELEASE, "agent");
            asm volatile("s_waitcnt vmcnt(0)" ::: "memory");
            const unsigned og = xb_add(&bar[XB_TOP], 1u);
            const unsigned tg = og / nx;
            if (og + 1u == (tg + 1u) * nx) xb_add(&bar[XB_TOPGEN], 1u);
            else XB_SPIN(xb_ld(&bar[XB_TOPGEN]) == tg, bar);
            __builtin_amdgcn_fence(__ATOMIC_ACQUIRE, "agent");
            xb_add(&bar[XB_XGEN(b.x)], 1u);
            asm volatile("s_waitcnt vmcnt(0)" ::: "memory");
        } else {
            XB_SPIN(xb_ld(&bar[XB_XGEN(b.x)]) == gen, bar);
            __builtin_amdgcn_fence(__ATOMIC_ACQUIRE, "agent");
            asm volatile("s_waitcnt vmcnt(0)" ::: "memory");
        }
    }
    __syncthreads();
}

struct Args { const float* in[25]; float* out; unsigned char* ws; int ph_lo, ph_hi, use_bar, pad; };
__global__ void __launch_bounds__(NTHR, 2) mega(Args args) {
    extern __shared__ __attribute__((aligned(16))) unsigned char lds[];
    Frame F;
    F.lds = (LAS unsigned char*)lds;
    F.MISC = (volatile LAS unsigned*)(F.lds + MISC_OFF);
    F.tid = threadIdx.x; F.lane = F.tid & 63; F.wave = __builtin_amdgcn_readfirstlane(F.tid >> 6);
    F.G = gridDim.x; F.bid = blockIdx.x;
    F.ws = args.ws; F.ctl = (gu32*)(args.ws + WS_CTL);
#pragma unroll
    for (int i = 0; i < 25; ++i) F.in[i] = args.in[i];
    F.out = args.out;
    for (int u = F.tid; u < (LDS_BYTES - LDSCTL_OFF) / 4; u += NTHR) ((LAS unsigned*)(F.lds + LDSCTL_OFF))[u] = 0u;
    __syncthreads();
    LAS int* ts = (LAS int*)(F.lds + MISC_OFF + 64);
    XcdBarrier bar; bar.bar = (unsigned*)(F.ctl + CW_BAR); bar.x = 0; bar.st = nullptr;
    if (args.use_bar) bar = xcd_barrier_post((unsigned*)(F.ctl + CW_BAR), F.MISC + 8);
    const int lo = args.ph_lo, hi = args.ph_hi;
#if MK_CG_SYNC == 2
    if (args.use_bar == 2) cooperative_groups::this_grid().sync();
#endif
#define IN(k) (lo <= (k) && (k) < hi)
#define REPS(k) for (int _r = 0; _r < ((k) == PROBE_PH ? PROBE_N : 1); ++_r)
#define SEAM(k) do { if (IN(k) && IN((k) + 1)) { if (MK_CG_SYNC == 1 && (k) == 0) cooperative_groups::this_grid().sync(); else { xcd_barrier(bar); if (PROBE_PH == 100) for (int _b = 1; _b < PROBE_N; ++_b) xcd_barrier(bar); } } } while (0)

    if (IN(0)) { REPS(0) p0_prologue(F); SEAM(0); }
    if (IN(1)) {
        p1_bcum(F);
        if (PROBE_PH == 104) for (int _q = 1; _q < PROBE_N; ++_q) p1_bcum(F);
        pg8::Gemm g{WSP(pg8::bf16_t, WS_XB), WSP(pg8::bf16_t, WS_WIN), T + MEMN, HW + 4096, D}; pg8::OrderG1 S; S.init(F.G, F.bid);
        pg8::EpiH E{WSP(pg8::bf16_t, WS_H), WSP(pg8::bf16_t, WS_KVM), WSP(float, WS_RC), WSP(float, WS_RS)};
        REPS(1) pg8::gemm_phase<pg8::EpiH, pg8::OrderG1, true, true>(F.lds, g, S, E);
        transpose_queue(F);
        if (PROBE_PH == 102) for (int _q = 1; _q < PROBE_N; ++_q) transpose_queue(F, _q);
        SEAM(1);
    }
#if PROBE_PH == 101
    if (IN(1)) {
        pg8::Gemm g{WSP(pg8::bf16_t, WS_XB), WSP(pg8::bf16_t, WS_WIN), T + MEMN, HW + 4096, D}; pg8::OrderG1 S; S.init(F.G, F.bid);
        pg8::EpiH E{WSP(pg8::bf16_t, WS_H), WSP(pg8::bf16_t, WS_KVM), WSP(float, WS_RC), WSP(float, WS_RS)};
        pg8::gemm_phase<pg8::EpiH, pg8::OrderG1, true, true>(F.lds, g, S, E);
        xcd_barrier(bar);
    }
#endif
    if (IN(2)) { REPS(2) p2_kv(F); SEAM(2); }
    if (IN(3)) { p3_scan(F); SEAM(3); }
#if PROBE_PH == 103
    if (IN(3)) { p2_kv(F); xcd_barrier(bar); p3_scan(F); xcd_barrier(bar); }
#endif
    if (IN(4)) { REPS(4) p4_out(F); SEAM(4); }
    if (IN(5)) {
        pg8::Gemm g{WSP(pg8::bf16_t, WS_MIXED), WSP(pg8::bf16_t, WS_WMIX), T, D, D}; pg8::StaticOrder S; S.init(T, D, F.G, F.bid);
        pg8::EpiResX E{F.in[0], WSP(float, WS_Y1), ALPHA};
        REPS(5) pg8::gemm_phase<pg8::EpiResX, pg8::StaticOrder, true, true>(F.lds, g, S, E);
        SEAM(5);
    }
    if (IN(6)) { REPS(6) ln_apply<false>(F, WSP(float, WS_Y1), F.in[8], F.in[9], WSP(bf16, WS_H1B), WSP(float, WS_ST1)); SEAM(6); }
    if (IN(7)) {
        pg8::Gemm g{WSP(pg8::bf16_t, WS_H1B), WSP(pg8::bf16_t, WS_WMQ), T, D, D}; pg8::StaticOrder S; S.init(T, D, F.G, F.bid);
        pg8::EpiB E{WSP(pg8::bf16_t, WS_QB), D, -1};
        REPS(7) pg8::gemm_phase<pg8::EpiB, pg8::StaticOrder, true, true>(F.lds, g, S, E);
        SEAM(7);
    }
    if (IN(8)) { REPS(8) p8_attn(F); SEAM(8); }
    if (IN(9)) {
        pg8::Gemm g{WSP(pg8::bf16_t, WS_ATT), WSP(pg8::bf16_t, WS_WMO), T, D, D}; pg8::StaticOrder S; S.init(T, D, F.G, F.bid);
        pg8::EpiResLN E{WSP(float, WS_Y1), WSP(float, WS_ST1), F.in[8], F.in[9], WSP(float, WS_Y2), ALPHA};
        REPS(9) pg8::gemm_phase<pg8::EpiResLN, pg8::StaticOrder, true, true>(F.lds, g, S, E);
        SEAM(9);
    }
    if (IN(10)) { p10_ln_router(F); SEAM(10); }
    if (IN(11)) { moe_tile_starts(F, ts); p10_dispatch(F, ts); SEAM(11); }
    if (IN(12)) {
        moe_tile_starts(F, ts);
        pg8::Gemm g{WSP(pg8::bf16_t, WS_XS), WSP(pg8::bf16_t, WS_WGU), PMAX, 32 * 1024, D};
        pg8::MoeOrder S{(const PG8_LAS int*)ts, F.G, F.bid, 4, ts[32] * 4, F.in[20], F.in[21], 2048, 512};
        pg8::EpiSwi E{WSP(pg8::bf16_t, WS_HID)};
#if MK_MOE_F32
        REPS(12) pg8::gemm_phase_bf32<pg8::EpiSwi, pg8::MoeOrder, true>(F.lds, g, S, E);
#else
        REPS(12) pg8::gemm_phase<pg8::EpiSwi, pg8::MoeOrder, true, true>(F.lds, g, S, E);
#endif
        SEAM(12);
    }
    if (IN(13)) {
        moe_tile_starts(F, ts);
        pg8::Gemm g{WSP(pg8::bf16_t, WS_HID), WSP(pg8::bf16_t, WS_WD), PMAX, 32 * 2048, 512};
        pg8::MoeOrder S{(const PG8_LAS int*)ts, F.G, F.bid, 8, ts[32] * 8, F.in[22], nullptr, 512, 2048};
        pg8::EpiB E{WSP(pg8::bf16_t, WS_YS), D, 7};
#if MK_MOE_F32
        REPS(13) pg8::gemm_phase_bf32<pg8::EpiB, pg8::MoeOrder, true>(F.lds, g, S, E);
#else
        REPS(13) pg8::gemm_phase<pg8::EpiB, pg8::MoeOrder, true, true>(F.lds, g, S, E);
#endif
        SEAM(13);
    }
    if (IN(14)) { REPS(14) p13_combine(F); }
#undef IN
#undef SEAM
#undef REPS
}

extern "C" void kernel_launch(void* const* d_in, const int* in_sizes, int n_in, void* d_out, int out_size, void* d_ws, size_t ws_size, hipStream_t stream) {
    static int grid = 0;
    if (grid == 0) {
        if (n_in != 25 || in_sizes[0] != T * D || out_size != T * D || ws_size < WS_END) { fprintf(stderr, "kernel_launch: unexpected shapes / workspace (%d inputs, ws %zu)\n", n_in, ws_size); grid = -1; return; }
        int dev = 0, cus = 0;
        if (hipGetDevice(&dev) != hipSuccess || hipDeviceGetAttribute(&cus, hipDeviceAttributeMultiprocessorCount, dev) != hipSuccess) { grid = -1; return; }
        if (hipFuncSetAttribute((const void*)mega, hipFuncAttributeMaxDynamicSharedMemorySize, LDS_BYTES) != hipSuccess) { fprintf(stderr, "kernel_launch: hipFuncSetAttribute failed\n"); grid = -1; return; }
        int per_cu = 0;
        if (hipOccupancyMaxActiveBlocksPerMultiprocessor(&per_cu, (const void*)mega, NTHR, LDS_BYTES) != hipSuccess || per_cu < 1) { fprintf(stderr, "kernel_launch: occupancy query failed / 0 blocks per CU\n"); grid = -1; return; }
        (void)hipGetLastError();
        grid = cus;
    }
    if (grid < 0) return;
    if (hipMemsetAsync((char*)d_ws + WS_CTL, 0, CTL_ZERO_BYTES, stream) != hipSuccess) return;
    Args a{};
    for (int i = 0; i < 25; ++i) a.in[i] = (const float*)d_in[i];
    a.out = (float*)d_out; a.ws = (unsigned char*)d_ws;
#if MK_ONE_LAUNCH
    a.ph_lo = 0; a.ph_hi = NPH; a.use_bar = 1;
#if MK_CG_SYNC
    { void* kargs[] = {(void*)&a};
      hipError_t e = hipLaunchCooperativeKernel((const void*)mega, dim3(grid), dim3(NTHR), kargs, LDS_BYTES, stream);
      if (e != hipSuccess) fprintf(stderr, "cooperative launch failed: %s (grid %d)\n", hipGetErrorString(e), grid); }
#else
    hipLaunchKernelGGL(mega, dim3(grid), dim3(NTHR), LDS_BYTES, stream, a);
#endif
#else
    for (int p = 0; p < NPH; ++p) { a.ph_lo = p; a.ph_hi = p + 1; a.use_bar = 0;
        hipLaunchKernelGGL(mega, dim3(grid), dim3(NTHR), LDS_BYTES, stream, a); }
#endif
}
```

```cpp
#include <hip/hip_runtime.h>
#include <hip/hip_cooperative_groups.h>
#include <cstdio>
#include <cstdint>
#include <cmath>
#ifndef MK_ONE_LAUNCH
#define MK_ONE_LAUNCH 1
#endif
#ifndef MK_CG_SYNC
#define MK_CG_SYNC 2
#endif
#ifndef MK_MOE_F32
#define MK_MOE_F32 0
#endif
#define PROBE_PH -1
#define PROBE_N 1
namespace pg8 {
#define PG8_LAS __attribute__((address_space(3)))
typedef unsigned short bf16_t;
typedef short bf16x8 __attribute__((ext_vector_type(8)));
typedef float f32x4 __attribute__((ext_vector_type(4)));
typedef unsigned u32x4 __attribute__((ext_vector_type(4)));
constexpr int BM = 256, BK = 64, HALF = 128, HTB = HALF * BK * 2  , STAGE_BYTES = 8 * HTB, NXCD = 8, WGM = 8;

__host__ __device__ __forceinline__ int lds_byte(int r, int c) { const int st = (r >> 4) * 2 + (c >> 5), rr = r & 15, cc = c & 31, ob = rr * 64 + cc * 2; return st * 1024 + (ob ^ (((ob >> 9) & 1) << 5)); }
__host__ __device__ __forceinline__ void stage_rc(int b, int& R, int& C) { const int st = b / 1024, sb = b % 1024, swz = sb ^ (((sb >> 9) & 1) << 5); R = (st >> 1) * 16 + swz / 64; C = (st & 1) * 32 + (swz % 64) / 2; }
__host__ __device__ __forceinline__ int perm32(int rho) { const int n = rho >> 4, i = rho & 15; return 8 * (i >> 2) + 4 * n + (i & 3); }

struct Unit { int pm, pn; };
struct Gemm { const bf16_t* A; const bf16_t* Bt; int M, N, K; const int* tok; };

struct StaticOrder {
    int nM, nN, nwg, G, c;
    __host__ __device__ void init(int M, int N, int G_, int c_) { nM = M / BM; nN = N / BM; nwg = nM * nN; G = G_; c = c_; }
    __host__ __device__ bool next(int i, Unit& u) const {
        const long L = (long)i * G + c; if (L >= nwg) return false;
        int wgid = (int)L; { const int q = nwg / NXCD, r = nwg % NXCD, xcd = wgid % NXCD, off = wgid / NXCD; wgid = (xcd < r ? xcd * (q + 1) : r * (q + 1) + (xcd - r) * q) + off; }
        const int nig = WGM * nN, gid = wgid / nig, fm = gid * WGM, gsz = (nM - fm) < WGM ? (nM - fm) : WGM;
        u.pm = fm + ((wgid % nig) % gsz); u.pn = (wgid % nig) / gsz; return true;
    }
    __device__ __forceinline__ void a_ready(const Unit&) const {}
    __device__ __forceinline__ void done(const Unit&) const {}
};


__device__ __forceinline__ unsigned cvt_pk_bf16(float lo, float hi) { unsigned r; asm volatile("v_cvt_pk_bf16_f32 %0, %1, %2" : "=v"(r) : "v"(lo), "v"(hi)); return r; }
__device__ __forceinline__ u32x4 pack8(const f32x4 a, const f32x4 b) { u32x4 w; w.x = cvt_pk_bf16(a[0], a[1]); w.y = cvt_pk_bf16(a[2], a[3]); w.z = cvt_pk_bf16(b[0], b[1]); w.w = cvt_pk_bf16(b[2], b[3]); return w; }
__device__ __forceinline__ float silu_f(float x) { return x * __builtin_amdgcn_rcpf(1.0f + __builtin_amdgcn_exp2f(-1.4426950408889634f * x)); }

struct EpiH {
    static constexpr bool PERM = true, AFTER_DRAIN = false;
    bf16_t* H; bf16_t* KVM; const float* rc; const float* rs;
    __device__ __forceinline__ void operator()(const f32x4 (&acc)[2][2][4][2], const Unit& u, int wr, int wc, int fr, int fq) const {
        const int cb = wc * 32 + 8 * fq;
        if (u.pm >= 32) {
#pragma unroll
            for (int ai = 0; ai < 2; ++ai)
#pragma unroll
                for (int m = 0; m < 4; ++m) { bf16_t* rowp = KVM + (size_t)(wr * 64 + fr + ai * HALF + m * 16) * 4096 + (u.pn - 28) * BM + cb;
#pragma unroll
                    for (int bj = 0; bj < 2; ++bj) *(u32x4*)(rowp + bj * HALF) = pack8(acc[ai][bj][m][0], acc[ai][bj][m][1]); }
            return;
        }
        const int row0 = u.pm * BM + wr * 64 + fr;
        if (u.pn < 8) {
            const float sc = u.pn >= 4 ? 0.0625f : 1.0f;
#pragma unroll
            for (int ai = 0; ai < 2; ++ai)
#pragma unroll
                for (int m = 0; m < 4; ++m) { const int row = row0 + ai * HALF + m * 16;
                    const float* cr = rc + (size_t)row * 128 + cb; const float* sr = rs + (size_t)row * 128 + cb;
                    const f32x4 c0 = *(const f32x4*)cr * sc, c1 = *(const f32x4*)(cr + 4) * sc, s0 = *(const f32x4*)sr * sc, s1 = *(const f32x4*)(sr + 4) * sc;
                    const f32x4 t1a = acc[ai][0][m][0], t1b = acc[ai][0][m][1], t2a = acc[ai][1][m][0], t2b = acc[ai][1][m][1];
                    bf16_t* rowp = H + (size_t)row * 7168 + u.pn * BM + cb;
                    *(u32x4*)(rowp) = pack8(t1a * c0 - t2a * s0, t1b * c1 - t2b * s1);
                    *(u32x4*)(rowp + HALF) = pack8(t1a * s0 + t2a * c0, t1b * s1 + t2b * c1); }
        } else {
            const float sc = (u.pn == 16 || u.pn == 17) ? 0.08838834764831845f : 1.0f;
#pragma unroll
            for (int ai = 0; ai < 2; ++ai)
#pragma unroll
                for (int m = 0; m < 4; ++m) { bf16_t* rowp = H + (size_t)(row0 + ai * HALF + m * 16) * 7168 + u.pn * BM + cb;
#pragma unroll
                    for (int bj = 0; bj < 2; ++bj) *(u32x4*)(rowp + bj * HALF) = pack8(acc[ai][bj][m][0] * sc, acc[ai][bj][m][1] * sc); }
        }
    }
};
struct EpiB {
    static constexpr bool PERM = true, AFTER_DRAIN = false;
    bf16_t* O; int ldc; int pmask;
    __device__ __forceinline__ void operator()(const f32x4 (&acc)[2][2][4][2], const Unit& u, int wr, int wc, int fr, int fq) const {
        const int row0 = u.pm * BM + wr * 64 + fr, col0 = (u.pn & pmask) * BM + wc * 32 + 8 * fq;
#pragma unroll
        for (int ai = 0; ai < 2; ++ai)
#pragma unroll
            for (int m = 0; m < 4; ++m) { bf16_t* rowp = O + (size_t)(row0 + ai * HALF + m * 16) * ldc + col0;
#pragma unroll
                for (int bj = 0; bj < 2; ++bj) *(u32x4*)(rowp + bj * HALF) = pack8(acc[ai][bj][m][0], acc[ai][bj][m][1]); }
    }
};
struct EpiSwi {
    static constexpr bool PERM = true, AFTER_DRAIN = false;
    bf16_t* O;
    __device__ __forceinline__ void operator()(const f32x4 (&acc)[2][2][4][2], const Unit& u, int wr, int wc, int fr, int fq) const {
        const int row0 = u.pm * BM + wr * 64 + fr, col0 = (u.pn & 3) * HALF + wc * 32 + 8 * fq;
#pragma unroll
        for (int ai = 0; ai < 2; ++ai)
#pragma unroll
            for (int m = 0; m < 4; ++m) { bf16_t* rowp = O + (size_t)(row0 + ai * HALF + m * 16) * 512 + col0;
                f32x4 h0, h1;
#pragma unroll
                for (int i = 0; i < 4; ++i) { h0[i] = silu_f(acc[ai][0][m][0][i]) * acc[ai][1][m][0][i]; h1[i] = silu_f(acc[ai][0][m][1][i]) * acc[ai][1][m][1][i]; }
                *(u32x4*)rowp = pack8(h0, h1); }
    }
};
struct EpiResX {
    static constexpr bool PERM = false, AFTER_DRAIN = false;
    const float* X; float* Y; float alpha;
    __device__ __forceinline__ void operator()(const f32x4 (&acc)[2][2][4][2], const Unit& u, int wr, int wc, int fr, int fq) const {
        const int row0 = u.pm * BM + wr * 64 + fr, col0 = u.pn * BM + wc * 32 + 4 * fq;
#pragma unroll
        for (int ai = 0; ai < 2; ++ai)
#pragma unroll
            for (int m = 0; m < 4; ++m) { const size_t off = (size_t)(row0 + ai * HALF + m * 16) * 2048 + col0;
#pragma unroll
                for (int bj = 0; bj < 2; ++bj)
#pragma unroll
                    for (int n = 0; n < 2; ++n) { const f32x4 xv = *(const f32x4*)(X + off + bj * HALF + n * 16); *(f32x4*)(Y + off + bj * HALF + n * 16) = xv * alpha + acc[ai][bj][m][n]; } }
    }
};
struct EpiResLN {
    static constexpr bool PERM = false, AFTER_DRAIN = false;
    const float* Yin; const float* st; const float* g; const float* b; float* Y; float alpha;
    __device__ __forceinline__ void operator()(const f32x4 (&acc)[2][2][4][2], const Unit& u, int wr, int wc, int fr, int fq) const {
        const int row0 = u.pm * BM + wr * 64 + fr, col0 = u.pn * BM + wc * 32 + 4 * fq;
        f32x4 gv[2][2], bv[2][2];
#pragma unroll
        for (int bj = 0; bj < 2; ++bj)
#pragma unroll
            for (int n = 0; n < 2; ++n) { gv[bj][n] = *(const f32x4*)(g + col0 + bj * HALF + n * 16) * alpha; bv[bj][n] = *(const f32x4*)(b + col0 + bj * HALF + n * 16) * alpha; }
#pragma unroll
        for (int ai = 0; ai < 2; ++ai)
#pragma unroll
            for (int m = 0; m < 4; ++m) { const int row = row0 + ai * HALF + m * 16; const size_t off = (size_t)row * 2048 + col0;
                const float mu = st[2 * row], rstd = st[2 * row + 1];
#pragma unroll
                for (int bj = 0; bj < 2; ++bj)
#pragma unroll
                    for (int n = 0; n < 2; ++n) { const f32x4 yv = *(const f32x4*)(Yin + off + bj * HALF + n * 16);
                        *(f32x4*)(Y + off + bj * HALF + n * 16) = ((yv - mu) * rstd) * gv[bj][n] + bv[bj][n] + acc[ai][bj][m][n]; } }
    }
};

struct OrderG1 {
    StaticOrder so; int G, c;
    __device__ void init(int G_, int c_) { so.init(8192, 7168, G_, c_); G = G_; c = c_; }
    __device__ bool next(int i, Unit& u) const {
        const int L = i * G + c;
        if (L < 896) return so.next(i, u);
        if (L >= 912) return false;
        u.pm = 32; u.pn = 28 + (L - 896); return true;
    }
    __device__ __forceinline__ void a_ready(const Unit&) const {}
    __device__ __forceinline__ void done(const Unit&) const {}
};
struct MoeOrder {
    const PG8_LAS int* ts; int G, c, npn, total; const float* W0; const float* W1; int kdim, ncols;
    __device__ bool next(int i, Unit& u) const {
        const int L = i * G + c; if (L >= total) return false;
        const int rt = L / npn, pl = L - rt * npn; int e = 0;
        for (int j = 1; j < 32; ++j) e += (ts[j] <= rt) ? 1 : 0;
        u.pm = rt; u.pn = e * npn + pl; return true;
    }
    __device__ __forceinline__ int ldb() const { return ncols; }
    __device__ __forceinline__ const float* bptr(const Unit& u, int lane) const {
        const int e = u.pn / npn, pl = u.pn - e * npn; const size_t eo = (size_t)e * kdim * ncols;
        if (W1) return (lane < 32 ? W0 : W1) + eo + 128 * pl + 4 * (lane & 31);
        return W0 + eo + 256 * pl + 4 * lane;
    }
    __device__ __forceinline__ void a_ready(const Unit&) const {}
    __device__ __forceinline__ void done(const Unit&) const {}
};

template <class Epi, class Sched, bool ALIGN_EPI = false, bool SP2 = false, bool GATHER = false>
__device__ __forceinline__ void gemm_phase(PG8_LAS unsigned char* lds, const Gemm g, const Sched& S, const Epi& E) {
    const int tid = threadIdx.x, wid = __builtin_amdgcn_readfirstlane(tid >> 6), lane = tid & 63, wr = wid >> 2, wc = wid & 3, fr = lane & 15, fq = lane >> 4;
    const int K = g.K, nt = K / BK;
    unsigned voffA[2], voffB[2];
#pragma unroll
    for (int i = 0; i < 2; ++i) { int R, C; stage_rc(tid * 16 + i * 8192, R, C); const int Rb = Epi::PERM ? ((R & ~31) + perm32(R & 31)) : R;
        voffA[i] = (unsigned)(R * K + C) * 2u; voffB[i] = (unsigned)(Rb * K + C) * 2u; }
    unsigned coff[2][2], noff[2][2]; int gR[2], gC[2];
#pragma unroll
    for (int i = 0; i < 2; ++i) { int R, C; stage_rc(tid * 16 + i * 8192, R, C); gR[i] = R; gC[i] = C; coff[0][i] = coff[1][i] = noff[0][i] = noff[1][i] = 0u; }
#define PG8_GOFF(dst, pm_) do { if constexpr (GATHER) { _Pragma("unroll") for (int _h = 0; _h < 2; ++_h) _Pragma("unroll") for (int _i = 0; _i < 2; ++_i) \
        dst[_h][_i] = ((unsigned)g.tok[(pm_) * BM + _h * HALF + gR[_i]] * (unsigned)K + (unsigned)gC[_i]) * 2u; } } while (0)
    const size_t kstep = (size_t)(BK * 2);
    const size_t hstep = (size_t)HALF * K * 2;
    const size_t tstep = 2 * hstep;
    const unsigned ldsw = (unsigned)wid * 1024u;
    const int aoff = lds_byte(wr * 64 + fr, fq * 8), boff = lds_byte(wc * 32 + fr, fq * 8);
#define PG8_SA(b, h) (((b) * 2 + (h)) * HTB)
#define PG8_SB(b, h) ((4 + (b) * 2 + (h)) * HTB)
#define PG8_STAGE(bufoff, gbase, voff) do { _Pragma("unroll") for (int _i = 0; _i < 2; ++_i) \
        __builtin_amdgcn_global_load_lds((const unsigned*)((const char*)(gbase) + (voff)[_i]), (PG8_LAS unsigned*)(lds + (bufoff) + ldsw + _i * 8192), 16, 0, 0); } while (0)
#define PG8_STAGEA(bufoff, gptr, hh, kbytes, usenext) do { if constexpr (GATHER) { _Pragma("unroll") for (int _i = 0; _i < 2; ++_i) { const unsigned _o = (usenext) ? noff[hh][_i] : coff[hh][_i]; \
        __builtin_amdgcn_global_load_lds((const unsigned*)((const char*)g.A + (size_t)(kbytes) + _o), (PG8_LAS unsigned*)(lds + (bufoff) + ldsw + _i * 8192), 16, 0, 0); } } else { PG8_STAGE(bufoff, gptr, voffA); } } while (0)
#define PG8_LDA(dst, b, h) do { _Pragma("unroll") for (int m = 0; m < 4; ++m) _Pragma("unroll") for (int k = 0; k < 2; ++k) dst[m][k] = *(const PG8_LAS bf16x8*)(lds + PG8_SA(b, h) + aoff + m * 2048 + k * 1024); } while (0)
#define PG8_LDB(dst, b, h) do { _Pragma("unroll") for (int n = 0; n < 2; ++n) _Pragma("unroll") for (int k = 0; k < 2; ++k) dst[n][k] = *(const PG8_LAS bf16x8*)(lds + PG8_SB(b, h) + boff + n * 2048 + k * 1024); } while (0)
#define PG8_MMA(ai, bj, At, Bt) do { __builtin_amdgcn_s_setprio(1); _Pragma("unroll") for (int m = 0; m < 4; ++m) _Pragma("unroll") for (int n = 0; n < 2; ++n) _Pragma("unroll") for (int k = 0; k < 2; ++k) \
        acc[ai][bj][m][n] = __builtin_amdgcn_mfma_f32_16x16x32_bf16(Bt[n][k], At[m][k], acc[ai][bj][m][n], 0, 0, 0); __builtin_amdgcn_s_setprio(0); } while (0)
#define PG8_WAIT_V(n) asm volatile("s_waitcnt vmcnt(" #n ")" ::: "memory")
#define PG8_WAIT_L(n) asm volatile("s_waitcnt lgkmcnt(" #n ")" ::: "memory")
#define PG8_BAR __builtin_amdgcn_s_barrier()
#define PG8_SCHED __builtin_amdgcn_sched_barrier(0)
    Unit cur, nxt; int ui = 0;
    if (!S.next(0, cur)) return;
    f32x4 acc[2][2][4][2];
#pragma unroll
    for (int a = 0; a < 2; ++a)
#pragma unroll
        for (int b = 0; b < 2; ++b)
#pragma unroll
            for (int m = 0; m < 4; ++m)
#pragma unroll
                for (int n = 0; n < 2; ++n) acc[a][b][m][n] = (f32x4){0.f, 0.f, 0.f, 0.f};
    bf16x8 At[4][2], B0[2][2], B1[2][2];
    const char* cA = (const char*)g.A + (size_t)cur.pm * tstep; const char* cB = (const char*)g.Bt + (size_t)cur.pn * tstep;
    PG8_GOFF(coff, cur.pm);
    S.a_ready(cur);
    if constexpr (SP2) {
        PG8_STAGE(PG8_SB(0, 0), cB, voffB); PG8_STAGE(PG8_SB(0, 1), cB + hstep, voffB); PG8_STAGEA(PG8_SA(0, 0), cA, 0, 0, false); PG8_STAGEA(PG8_SA(0, 1), cA + hstep, 1, 0, false);
        if (wr == 1) PG8_BAR;
        PG8_WAIT_V(2); PG8_BAR;
        PG8_STAGE(PG8_SB(1, 0), cB + kstep, voffB); PG8_STAGEA(PG8_SA(1, 0), cA + kstep, 0, kstep, false); PG8_STAGE(PG8_SB(1, 1), cB + hstep + kstep, voffB);
        PG8_WAIT_V(6); PG8_BAR;
    } else {
        PG8_STAGE(PG8_SB(0, 0), cB, voffB); PG8_STAGE(PG8_SA(0, 0), cA, voffA); PG8_STAGE(PG8_SB(0, 1), cB + hstep, voffB); PG8_STAGE(PG8_SA(0, 1), cA + hstep, voffA);
        if (wr == 1) PG8_BAR;
        PG8_WAIT_V(4); PG8_BAR;
        PG8_STAGE(PG8_SB(1, 0), cB + kstep, voffB); PG8_STAGE(PG8_SA(1, 0), cA + kstep, voffA); PG8_STAGE(PG8_SB(1, 1), cB + hstep + kstep, voffB);
        PG8_WAIT_V(6); PG8_BAR;
    }
    for (;;) {
        const bool has_next = S.next(ui + 1, nxt);
        const char* nA = has_next ? (const char*)g.A + (size_t)nxt.pm * tstep : cA; const char* nB = has_next ? (const char*)g.Bt + (size_t)nxt.pn * tstep : cB;
        if constexpr (GATHER) { if (has_next) { PG8_GOFF(noff, nxt.pm); } else { _Pragma("unroll") for (int _h = 0; _h < 2; ++_h) _Pragma("unroll") for (int _i = 0; _i < 2; ++_i) noff[_h][_i] = coff[_h][_i]; } }
        for (int t = 0; t < nt; t += 2) {
            const bool last = (t == nt - 2);
            const char* a1 = cA + (size_t)(t + 1) * kstep;
            const char* a2 = last ? nA : cA + (size_t)(t + 2) * kstep; const char* b2 = last ? nB : cB + (size_t)(t + 2) * kstep;
            const char* a3 = a2 + kstep; const char* b3 = b2 + kstep;
            const size_t k1 = (size_t)(t + 1) * kstep, k2 = last ? 0 : (size_t)(t + 2) * kstep, k3 = k2 + kstep;
            if (last && has_next) S.a_ready(nxt);
            if constexpr (SP2) {
            PG8_LDB(B0, 0, 0); PG8_LDB(B1, 0, 1); PG8_SCHED; PG8_LDA(At, 0, 0); PG8_STAGEA(PG8_SA(1, 1), a1 + hstep, 1, k1, false);
            PG8_WAIT_V(8); PG8_WAIT_L(0); PG8_BAR; PG8_MMA(0, 0, At, B0); PG8_MMA(0, 1, At, B1); PG8_BAR; PG8_SCHED;
            PG8_LDA(At, 0, 1); PG8_STAGE(PG8_SB(0, 0), b2, voffB); PG8_STAGE(PG8_SB(0, 1), b2 + hstep, voffB); PG8_STAGEA(PG8_SA(0, 0), a2, 0, k2, last);
            PG8_WAIT_V(8); PG8_WAIT_L(0); PG8_BAR; PG8_MMA(1, 0, At, B0); PG8_MMA(1, 1, At, B1); PG8_BAR; PG8_SCHED;
            PG8_LDB(B0, 1, 0); PG8_LDB(B1, 1, 1); PG8_SCHED; PG8_LDA(At, 1, 0); PG8_STAGEA(PG8_SA(0, 1), a2 + hstep, 1, k2, last);
            PG8_WAIT_V(8); PG8_WAIT_L(0); PG8_BAR; PG8_MMA(0, 0, At, B0); PG8_MMA(0, 1, At, B1); PG8_BAR; PG8_SCHED;
            PG8_LDA(At, 1, 1); PG8_STAGE(PG8_SB(1, 0), b3, voffB); PG8_STAGE(PG8_SB(1, 1), b3 + hstep, voffB); PG8_STAGEA(PG8_SA(1, 0), a3, 0, k3, last);
            PG8_WAIT_V(8); PG8_WAIT_L(0); PG8_BAR; PG8_MMA(1, 0, At, B0); PG8_MMA(1, 1, At, B1); PG8_BAR; PG8_SCHED;
            } else {
            PG8_LDB(B0, 0, 0); PG8_SCHED; PG8_LDA(At, 0, 0); PG8_STAGE(PG8_SA(1, 1), a1 + hstep, voffA);
            PG8_WAIT_L(8); PG8_BAR; PG8_WAIT_L(0); PG8_MMA(0, 0, At, B0); PG8_BAR; PG8_SCHED;
            PG8_LDB(B1, 0, 1); PG8_STAGE(PG8_SB(0, 0), b2, voffB);
            PG8_BAR; PG8_WAIT_L(0); PG8_MMA(0, 1, At, B1); PG8_BAR;
            PG8_LDA(At, 0, 1); PG8_STAGE(PG8_SA(0, 0), a2, voffA);
            PG8_BAR; PG8_WAIT_L(0); PG8_MMA(1, 0, At, B0); PG8_BAR; PG8_SCHED;
            PG8_STAGE(PG8_SB(0, 1), b2 + hstep, voffB);
            PG8_WAIT_V(6); PG8_BAR; PG8_MMA(1, 1, At, B1); PG8_BAR;
            PG8_LDB(B0, 1, 0); PG8_SCHED; PG8_LDA(At, 1, 0); PG8_STAGE(PG8_SA(0, 1), a2 + hstep, voffA);
            PG8_WAIT_L(8); PG8_BAR; PG8_WAIT_L(0); PG8_MMA(0, 0, At, B0); PG8_BAR; PG8_SCHED;
            PG8_LDB(B1, 1, 1); PG8_STAGE(PG8_SB(1, 0), b3, voffB);
            PG8_BAR; PG8_WAIT_L(0); PG8_MMA(0, 1, At, B1); PG8_BAR;
            PG8_LDA(At, 1, 1); PG8_STAGE(PG8_SA(1, 0), a3, voffA);
            PG8_BAR; PG8_WAIT_L(0); PG8_MMA(1, 0, At, B0); PG8_BAR; PG8_SCHED;
            PG8_STAGE(PG8_SB(1, 1), b3 + hstep, voffB);
            PG8_WAIT_V(6); PG8_BAR; PG8_MMA(1, 1, At, B1); PG8_BAR;
            }
        }
        if constexpr (ALIGN_EPI) { if (wr == 0) PG8_BAR; }
        if constexpr (!Epi::AFTER_DRAIN) { E(acc, cur, wr, wc, fr, fq); S.done(cur); }
        if (!has_next) break;
#pragma unroll
        for (int a = 0; a < 2; ++a)
#pragma unroll
            for (int b = 0; b < 2; ++b)
#pragma unroll
                for (int m = 0; m < 4; ++m)
#pragma unroll
                    for (int n = 0; n < 2; ++n) acc[a][b][m][n] = (f32x4){0.f, 0.f, 0.f, 0.f};
        cur = nxt; cA = nA; cB = nB; ++ui;
        if constexpr (GATHER) { _Pragma("unroll") for (int _h = 0; _h < 2; ++_h) _Pragma("unroll") for (int _i = 0; _i < 2; ++_i) coff[_h][_i] = noff[_h][_i]; }
        if constexpr (ALIGN_EPI) { if (wr == 1) PG8_BAR; }
    }
    PG8_WAIT_V(0);
    if constexpr (!ALIGN_EPI) { if (wr == 0) PG8_BAR; }
    PG8_BAR;
    if constexpr (Epi::AFTER_DRAIN) { E.fused(acc, cur, wr, wc, fr, fq, lds, wid, lane); S.done(cur); }
#undef PG8_SA
#undef PG8_SB
#undef PG8_STAGE
#undef PG8_STAGEA
#undef PG8_GOFF
#undef PG8_LDA
#undef PG8_LDB
#undef PG8_MMA
#undef PG8_WAIT_V
#undef PG8_WAIT_L
#undef PG8_BAR
#undef PG8_SCHED
}
constexpr int PBI = 544, SBI_BYTES = 64 * PBI;
template <class Epi, class Sched, bool ALIGN_EPI = false>
__device__ __forceinline__ void gemm_phase_bf32(PG8_LAS unsigned char* lds, const Gemm g, const Sched& S, const Epi& E) {
    const int tid = threadIdx.x, wid = __builtin_amdgcn_readfirstlane(tid >> 6), lane = tid & 63, wr = wid >> 2, wc = wid & 3, fr = lane & 15, fq = lane >> 4;
    const int K = g.K, nt = K / BK;
    unsigned voffA[2];
#pragma unroll
    for (int i = 0; i < 2; ++i) { int R, C; stage_rc(tid * 16 + i * 8192, R, C); voffA[i] = (unsigned)(R * K + C) * 2u; }
    const size_t kstep = (size_t)(BK * 2), hstep = (size_t)HALF * K * 2, tstep = 2 * hstep;
    const unsigned ldsw = (unsigned)wid * 1024u;
    const int aoff = lds_byte(wr * 64 + fr, fq * 8);
    const int ldb = S.ldb();
    const size_t bkstep = (size_t)BK * ldb;
    const int q4 = (lane >> 2) & 3, p4 = lane & 3;
    const unsigned bwoff = (unsigned)(8 * wid) * PBI + (unsigned)(((4 * lane) ^ ((wid & 1) << 6)) * 2);
    unsigned broff[2][2];
#pragma unroll
    for (int n = 0; n < 2; ++n)
#pragma unroll
        for (int k = 0; k < 2; ++k) { const int row = 32 * k + 8 * fq + q4, col = 32 * wc + (Epi::PERM ? 8 * p4 + 4 * n : 16 * n + 4 * p4);
            broff[n][k] = (unsigned)row * PBI + (unsigned)((col ^ ((row & 8) << 3)) * 2); }
#define PG8_SA(b, h) (((b) * 2 + (h)) * HTB)
#define PG8_SBI(b) (4 * HTB + (b) * SBI_BYTES)
#define PG8_STAGE(bufoff, gbase, voff) do { _Pragma("unroll") for (int _i = 0; _i < 2; ++_i) \
        __builtin_amdgcn_global_load_lds((const unsigned*)((const char*)(gbase) + (voff)[_i]), (PG8_LAS unsigned*)(lds + (bufoff) + ldsw + _i * 8192), 16, 0, 0); } while (0)
#define PG8_LDA(dst, b, h) do { _Pragma("unroll") for (int m = 0; m < 4; ++m) _Pragma("unroll") for (int k = 0; k < 2; ++k) dst[m][k] = *(const PG8_LAS bf16x8*)(lds + PG8_SA(b, h) + aoff + m * 2048 + k * 1024); } while (0)
#define PG8_LDBT(dst, b, h) do { _Pragma("unroll") for (int n = 0; n < 2; ++n) _Pragma("unroll") for (int k = 0; k < 2; ++k) { \
        const PG8_LAS unsigned char* _a = lds + PG8_SBI(b) + broff[n][k] + (h) * 256; \
        const s16x4 _lo = __builtin_bit_cast(s16x4, __builtin_amdgcn_ds_read_tr16_b64_v4i16((PG8_LAS s16x4*)_a)), _hi = __builtin_bit_cast(s16x4, __builtin_amdgcn_ds_read_tr16_b64_v4i16((PG8_LAS s16x4*)(_a + 4 * PBI))); \
        dst[n][k] = __builtin_shufflevector(_lo, _hi, 0, 1, 2, 3, 4, 5, 6, 7); } } while (0)
#define PG8_BLOAD(bp) do { _Pragma("unroll") for (int _i = 0; _i < 8; ++_i) breg[_i] = *(const __attribute__((address_space(1))) f32x4*)((bp) + (size_t)(8 * wid + _i) * ldb); } while (0)
#define PG8_BWRITE(b) do { _Pragma("unroll") for (int _i = 0; _i < 8; ++_i) { u32x2 _w; _w.x = cvt_pk_bf16(breg[_i][0], breg[_i][1]); _w.y = cvt_pk_bf16(breg[_i][2], breg[_i][3]); \
        *(PG8_LAS u32x2*)(lds + PG8_SBI(b) + bwoff + _i * PBI) = _w; } } while (0)
#define PG8_MMA(ai, bj, At, Bt) do { __builtin_amdgcn_s_setprio(1); _Pragma("unroll") for (int m = 0; m < 4; ++m) _Pragma("unroll") for (int n = 0; n < 2; ++n) _Pragma("unroll") for (int k = 0; k < 2; ++k) \
        acc[ai][bj][m][n] = __builtin_amdgcn_mfma_f32_16x16x32_bf16(Bt[n][k], At[m][k], acc[ai][bj][m][n], 0, 0, 0); __builtin_amdgcn_s_setprio(0); } while (0)
#define PG8_WAIT_V(n) asm volatile("s_waitcnt vmcnt(" #n ")" ::: "memory")
#define PG8_WAIT_L(n) asm volatile("s_waitcnt lgkmcnt(" #n ")" ::: "memory")
#define PG8_BAR __builtin_amdgcn_s_barrier()
#define PG8_SCHED __builtin_amdgcn_sched_barrier(0)
    typedef short s16x4 __attribute__((ext_vector_type(4)));
    typedef unsigned u32x2 __attribute__((ext_vector_type(2)));
    Unit cur, nxt; int ui = 0;
    if (!S.next(0, cur)) return;
    f32x4 acc[2][2][4][2];
#pragma unroll
    for (int a = 0; a < 2; ++a)
#pragma unroll
        for (int b = 0; b < 2; ++b)
#pragma unroll
            for (int m = 0; m < 4; ++m)
#pragma unroll
                for (int n = 0; n < 2; ++n) acc[a][b][m][n] = (f32x4){0.f, 0.f, 0.f, 0.f};
    bf16x8 At[4][2], B0[2][2], B1[2][2];
    f32x4 breg[8];
    const char* cA = (const char*)g.A + (size_t)cur.pm * tstep; const float* cB = S.bptr(cur, lane);
    PG8_BLOAD(cB); PG8_STAGE(PG8_SA(0, 0), cA, voffA); PG8_STAGE(PG8_SA(0, 1), cA + hstep, voffA);
    PG8_BWRITE(0); PG8_SCHED;
    if (wr == 1) PG8_BAR;
    PG8_WAIT_V(2); PG8_WAIT_L(0); PG8_BAR;
    PG8_BLOAD(cB + bkstep); PG8_STAGE(PG8_SA(1, 0), cA + kstep, voffA); PG8_SCHED;
    PG8_WAIT_V(10); PG8_BAR;
    for (;;) {
        const bool has_next = S.next(ui + 1, nxt);
        const char* nA = has_next ? (const char*)g.A + (size_t)nxt.pm * tstep : cA; const float* nB = has_next ? S.bptr(nxt, lane) : cB;
        for (int t = 0; t < nt; t += 2) {
            const bool last = (t == nt - 2);
            const char* a1 = cA + (size_t)(t + 1) * kstep;
            const char* a2 = last ? nA : cA + (size_t)(t + 2) * kstep; const float* b2 = last ? nB : cB + (size_t)(t + 2) * bkstep;
            const char* a3 = a2 + kstep; const float* b3 = b2 + bkstep;
            PG8_LDBT(B0, 0, 0); PG8_LDBT(B1, 0, 1); PG8_SCHED; PG8_LDA(At, 0, 0); PG8_STAGE(PG8_SA(1, 1), a1 + hstep, voffA);
            PG8_WAIT_V(12); PG8_WAIT_L(0); PG8_BAR; PG8_MMA(0, 0, At, B0); PG8_MMA(0, 1, At, B1); PG8_BAR; PG8_SCHED;
            PG8_BWRITE(1); PG8_BLOAD(b2); PG8_SCHED; PG8_LDA(At, 0, 1); PG8_STAGE(PG8_SA(0, 0), a2, voffA);
            PG8_WAIT_V(12); PG8_WAIT_L(0); PG8_BAR; PG8_MMA(1, 0, At, B0); PG8_MMA(1, 1, At, B1); PG8_BAR; PG8_SCHED;
            PG8_LDBT(B0, 1, 0); PG8_LDBT(B1, 1, 1); PG8_SCHED; PG8_LDA(At, 1, 0); PG8_STAGE(PG8_SA(0, 1), a2 + hstep, voffA);
            PG8_WAIT_V(12); PG8_WAIT_L(0); PG8_BAR; PG8_MMA(0, 0, At, B0); PG8_MMA(0, 1, At, B1); PG8_BAR; PG8_SCHED;
            PG8_BWRITE(0); PG8_BLOAD(b3); PG8_SCHED; PG8_LDA(At, 1, 1); PG8_STAGE(PG8_SA(1, 0), a3, voffA);
            PG8_WAIT_V(12); PG8_WAIT_L(0); PG8_BAR; PG8_MMA(1, 0, At, B0); PG8_MMA(1, 1, At, B1); PG8_BAR; PG8_SCHED;
        }
        if constexpr (ALIGN_EPI) { if (wr == 0) PG8_BAR; }
        E(acc, cur, wr, wc, fr, fq); S.done(cur);
        if (!has_next) break;
#pragma unroll
        for (int a = 0; a < 2; ++a)
#pragma unroll
            for (int b = 0; b < 2; ++b)
#pragma unroll
                for (int m = 0; m < 4; ++m)
#pragma unroll
                    for (int n = 0; n < 2; ++n) acc[a][b][m][n] = (f32x4){0.f, 0.f, 0.f, 0.f};
        cur = nxt; cA = nA; cB = nB; ++ui;
        if constexpr (ALIGN_EPI) { if (wr == 1) PG8_BAR; }
    }
    PG8_WAIT_V(0);
    asm volatile("" :: "v"(breg[0]), "v"(breg[1]), "v"(breg[2]), "v"(breg[3]), "v"(breg[4]), "v"(breg[5]), "v"(breg[6]), "v"(breg[7]));
    if constexpr (!ALIGN_EPI) { if (wr == 0) PG8_BAR; }
    PG8_BAR;
#undef PG8_SA
#undef PG8_SBI
#undef PG8_STAGE
#undef PG8_LDA
#undef PG8_LDBT
#undef PG8_BLOAD
#undef PG8_BWRITE
#undef PG8_MMA
#undef PG8_WAIT_V
#undef PG8_WAIT_L
#undef PG8_BAR
#undef PG8_SCHED
}
}

constexpr int NWAVES = 8, NTHR = 512;
constexpr int T = 8192, D = 2048, HW = 7168, INW = 7184, MEMN = 256;
constexpr float LN_EPS = 1e-5f;
constexpr float ALPHA = 1.189207115002721f;
constexpr int NPH = 15;
constexpr int PMAX = 24576;

constexpr size_t MiB = 1u << 20;
constexpr size_t WS_CTL = 0, CTL_ZERO_BYTES = 1 * MiB;
constexpr size_t WS_WMIX = 2 * MiB, WS_WMQ = 10 * MiB, WS_WIN = 18 * MiB, WS_WKV = 46 * MiB, WS_WMO = 62 * MiB, WS_WGU = 70 * MiB, WS_WD = 198 * MiB;
constexpr size_t WS_XB = 262 * MiB, WS_MEMB = 294 * MiB;
constexpr size_t WS_H = 296 * MiB;
constexpr size_t WS_KVM = 408 * MiB;
constexpr size_t WS_ORAW = 410 * MiB;
constexpr size_t WS_MIXED = WS_XB;
constexpr size_t WS_Y1 = WS_ORAW;
constexpr size_t WS_H1B = WS_H;
constexpr size_t WS_QB = 328 * MiB, WS_ATT = 360 * MiB;
constexpr size_t WS_Y2 = 474 * MiB;
constexpr size_t WS_H2B = WS_H;
constexpr size_t WS_XS = 328 * MiB;
constexpr size_t WS_HID = 424 * MiB;
constexpr size_t WS_YS = WS_XS;
constexpr size_t WS_SMALL = 540 * MiB;
constexpr size_t WS_GLR = WS_SMALL;
constexpr size_t WS_RC = WS_SMALL + 1 * MiB, WS_RS = WS_SMALL + 5 * MiB;
constexpr size_t WS_ST1 = WS_SMALL + 9 * MiB, WS_ST2 = WS_ST1 + 65536;
constexpr size_t WS_EXP = WS_ST2 + 65536, WS_GATE = WS_EXP + 65536, WS_POS = WS_GATE + 65536, WS_SLOT = WS_POS + 65536, WS_TOK = WS_SLOT + 65536;
constexpr size_t WS_END = 552 * MiB;
constexpr int CW_CNT = 64, CW_CUR = 128, CW_Q = 192;
constexpr int CW_BAR = 4096;

constexpr int RING_BYTES = 139264, LDSCTL_OFF = RING_BYTES, MISC_OFF = LDSCTL_OFF + 320, LDS_BYTES = 147456;

#define GAS __attribute__((address_space(1)))
#define LAS __attribute__((address_space(3)))
typedef unsigned short bf16;
typedef unsigned v4u __attribute__((ext_vector_type(4)));
typedef unsigned v2u __attribute__((ext_vector_type(2)));
typedef float f32x4 __attribute__((ext_vector_type(4)));
typedef GAS unsigned gu32;
#define RLX_AGENT __ATOMIC_RELAXED, __HIP_MEMORY_SCOPE_AGENT
#define LDS_WAIT() asm volatile("s_waitcnt lgkmcnt(0)" ::: "memory")
__device__ __forceinline__ unsigned f2bf(float f) { unsigned u = __builtin_bit_cast(unsigned, f); return (u + 0x7fffu + ((u >> 16) & 1u)) >> 16; }
__device__ __forceinline__ unsigned pk2(float lo, float hi) { return f2bf(lo) | (f2bf(hi) << 16); }
__device__ __forceinline__ float bf2f(unsigned h) { return __builtin_bit_cast(float, h << 16); }
__device__ __forceinline__ float bflo(unsigned w) { return __builtin_bit_cast(float, w << 16); }
__device__ __forceinline__ float bfhi(unsigned w) { return __builtin_bit_cast(float, w & 0xffff0000u); }
__device__ __forceinline__ float wave_sum(float v) {
#pragma unroll
    for (int o = 1; o < 64; o <<= 1) v += __shfl_xor(v, o);
    return v;
}
__device__ __forceinline__ float wave_max(float v) {
#pragma unroll
    for (int o = 1; o < 64; o <<= 1) v = fmaxf(v, __shfl_xor(v, o));
    return v;
}

struct Frame {
    LAS unsigned char* lds;
    volatile LAS unsigned* MISC;
    gu32* ctl;
    int tid, lane, wave, G, bid;
    unsigned char* ws;
    const float* in[25];
    float* out;
};
#define WSP(T_, off) ((T_*)(F.ws + (off)))

__device__ __forceinline__ void transpose_item(const float* W, int ldw, bf16* WTr, int ldt, LAS float* scr, int lane) {
    float tv[32];
#pragma unroll
    for (int i = 0; i < 32; ++i) tv[i] = W[(size_t)(2 * i + (lane >> 5)) * ldw + (lane & 31)];
#pragma unroll
    for (int i = 0; i < 32; ++i) scr[(2 * i + (lane >> 5)) * 33 + (lane & 31)] = tv[i];
    LDS_WAIT(); asm volatile("" ::: "memory");
    const int c = lane & 7;
#pragma unroll
    for (int j = 0; j < 4; ++j) { const int n = (lane >> 3) + 8 * j; const LAS float* s = scr + (8 * c) * 33 + n;
        v4u o; o.x = pk2(s[0 * 33], s[1 * 33]); o.y = pk2(s[2 * 33], s[3 * 33]); o.z = pk2(s[4 * 33], s[5 * 33]); o.w = pk2(s[6 * 33], s[7 * 33]);
        *(GAS v4u*)(WTr + (size_t)n * ldt + 8 * c) = o; }
    LDS_WAIT(); asm volatile("" ::: "memory");
}
__device__ __forceinline__ void p0_prologue(Frame& F) {
    LAS float* scr = (LAS float*)(F.lds + F.wave * 16384);
    const int gw = F.bid * NWAVES + F.wave, NGW = F.G * NWAVES;
    const float* w_in = F.in[3];
    constexpr int I_IN = 32 * 224, I_SQ = 32 * 64;
    for (int it = gw; it < I_IN + 2 * I_SQ; it += NGW) {
        int r = it;
        if (r < I_IN) { const int kb = r / 224, nb = r % 224; transpose_item(w_in + (size_t)(64 * kb) * INW + 32 * nb, INW, WSP(bf16, WS_WIN) + (size_t)(32 * nb) * 2048 + 64 * kb, 2048, scr, F.lane); continue; }
        r -= I_IN;
        { const int w = r / I_SQ, q = r % I_SQ, kb = q / 64, nb = q % 64;
          const float* src = F.in[11]; if (w) src = F.in[12];
          bf16* dst = WSP(bf16, WS_WKV) + (size_t)w * 2048 * 2048;
          transpose_item(src + (size_t)(64 * kb) * 2048 + 32 * nb, 2048, dst + (size_t)(32 * nb) * 2048 + 64 * kb, 2048, scr, F.lane); }
    }
    const int gt = F.bid * NTHR + F.tid, NGT = F.G * NTHR;
    {
        const float* x = F.in[0]; bf16* xb = WSP(bf16, WS_XB);
        for (int i0 = gt; i0 < T * D / 8; i0 += 4 * NGT) { f32x4 a[4], b[4];
#pragma unroll
            for (int u = 0; u < 4; ++u) { const size_t i = (size_t)i0 + (size_t)u * NGT; a[u] = *(const GAS f32x4*)(x + i * 8); b[u] = *(const GAS f32x4*)(x + i * 8 + 4); }
#pragma unroll
            for (int u = 0; u < 4; ++u) { const size_t i = (size_t)i0 + (size_t)u * NGT;
                v4u o; o.x = pk2(a[u][0], a[u][1]); o.y = pk2(a[u][2], a[u][3]); o.z = pk2(b[u][0], b[u][1]); o.w = pk2(b[u][2], b[u][3]); *(GAS v4u*)(xb + i * 8) = o; } }
        const float* mm = F.in[1]; bf16* mb = WSP(bf16, WS_MEMB);
        for (int i = gt; i < MEMN * D / 8; i += NGT) { const f32x4 a = *(const GAS f32x4*)(mm + (size_t)i * 8), b = *(const GAS f32x4*)(mm + (size_t)i * 8 + 4);
            v4u o; o.x = pk2(a[0], a[1]); o.y = pk2(a[2], a[3]); o.z = pk2(b[0], b[1]); o.w = pk2(b[2], b[3]); *(GAS v4u*)(mb + (size_t)i * 8) = o; }
    }
    {
        const int* pos = (const int*)F.in[2]; float* rc = WSP(float, WS_RC); float* rs = WSP(float, WS_RS);
        for (int i = gt; i < T * 128; i += NGT) { const int t = i >> 7, f = i & 127;
            const float inv = exp2f(-(float)f * (13.287712379549449f / 128.0f));
            const float ang = (float)pos[t] * inv;
            double rev = (double)ang * 0.15915494309189535; rev -= floor(rev);
            const float rf = (float)rev;
            rc[i] = __builtin_amdgcn_cosf(rf); rs[i] = __builtin_amdgcn_sinf(rf); }
    }
    {
        const float* x = F.in[0]; float* glr = WSP(float, WS_GLR);
        const int r16 = F.lane & 15, g4 = F.lane >> 4;
        for (int tile = gw; tile < T / 16; tile += NGW) {
            f32x4 acc = {0.f, 0.f, 0.f, 0.f};
            const float* xr = x + (size_t)(tile * 16 + r16) * D + 4 * g4;
            const float* wr = w_in + (size_t)(4 * g4) * INW + HW + r16;
#pragma unroll 4
            for (int k0 = 0; k0 < D; k0 += 16) {
                const f32x4 a = *(const GAS f32x4*)(xr + k0);
                const float b0 = wr[(size_t)(k0 + 0) * INW], b1 = wr[(size_t)(k0 + 1) * INW], b2 = wr[(size_t)(k0 + 2) * INW], b3 = wr[(size_t)(k0 + 3) * INW];
                acc = __builtin_amdgcn_mfma_f32_16x16x4f32(a[0], b0, acc, 0, 0, 0);
                acc = __builtin_amdgcn_mfma_f32_16x16x4f32(a[1], b1, acc, 0, 0, 0);
                acc = __builtin_amdgcn_mfma_f32_16x16x4f32(a[2], b2, acc, 0, 0, 0);
                acc = __builtin_amdgcn_mfma_f32_16x16x4f32(a[3], b3, acc, 0, 0, 0);
            }
#pragma unroll
            for (int j = 0; j < 4; ++j) glr[(size_t)(tile * 16 + 4 * g4 + j) * 16 + r16] = acc[j];
        }
    }
}
__device__ __forceinline__ void transpose_queue(Frame& F, int qsel = 0) {
    LAS float* scr = (LAS float*)(F.lds + F.wave * 16384);
    const float* const i7 = F.in[7]; const float* const i10 = F.in[10]; const float* const i13 = F.in[13]; const float* const i20 = F.in[20]; const float* const i21 = F.in[21]; const float* const i22 = F.in[22];
    constexpr int I_SQ = 32 * 64, I_E = 512, NQ = 3 * I_SQ + 3 * 32 * I_E;
    for (;;) {
        unsigned b0 = 0;
        if (F.lane == 0) b0 = __hip_atomic_fetch_add((unsigned*)(F.ctl + CW_Q + 64 * qsel), 16u, __ATOMIC_RELAXED, __HIP_MEMORY_SCOPE_AGENT);
        b0 = __builtin_amdgcn_readfirstlane(b0);
        if (b0 >= (unsigned)NQ) break;
        for (int it = (int)b0; it < (int)b0 + 16 && it < NQ; ++it) {
            int r = it;
            if (r < 3 * I_SQ) { const int w = r / I_SQ, q = r % I_SQ, kb = q / 64, nb = q % 64;
                const float* src = i7; size_t doff = WS_WMIX; if (w == 1) { src = i10; doff = WS_WMQ; } if (w == 2) { src = i13; doff = WS_WMO; }
                bf16* dst = (bf16*)(F.ws + doff);
                transpose_item(src + (size_t)(64 * kb) * 2048 + 32 * nb, 2048, dst + (size_t)(32 * nb) * 2048 + 64 * kb, 2048, scr, F.lane); continue; }
            r -= 3 * I_SQ;
            if (r < 2 * 32 * I_E) {
                const int up = r / (32 * I_E), q = r % (32 * I_E), e = q / I_E, q2 = q % I_E, kb = q2 / 16, nb = q2 % 16, n0 = 32 * nb;
                const float* sb = i20; if (up) sb = i21;
                const float* src = sb + (size_t)e * 2048 * 512 + (size_t)(64 * kb) * 512 + n0;
                bf16* dst = WSP(bf16, WS_WGU) + (size_t)(e * 1024 + (n0 >> 7) * 256 + up * 128 + (n0 & 127)) * 2048 + 64 * kb;
                transpose_item(src, 512, dst, 2048, scr, F.lane); continue; }
            r -= 2 * 32 * I_E;
            {
                const int e = r / I_E, q2 = r % I_E, kb = q2 / 64, nb = q2 % 64;
                const float* src = i22 + (size_t)e * 512 * 2048 + (size_t)(64 * kb) * 2048 + 32 * nb;
                bf16* dst = WSP(bf16, WS_WD) + (size_t)(e * 2048 + 32 * nb) * 512 + 64 * kb;
                transpose_item(src, 2048, dst, 512, scr, F.lane); }
        }
    }
}

__device__ __forceinline__ float log_sigmoid_f(float z) { return fminf(z, 0.f) - log1pf(expf(-fabsf(z))); }
template <bool GLA>
__device__ __forceinline__ void mixer_naive_item(Frame& F, int hh, int eg) {
    constexpr int ND = GLA ? 4 : 8;
    const bf16* H = WSP(bf16, WS_H); float* oraw = WSP(float, WS_ORAW);
    const int ei = F.tid & 15, dp = F.tid >> 4, e = eg * 16 + ei;
    const int qcol = GLA ? 4096 + hh * 128 : hh * 256, kcol = GLA ? 4608 + hh * 128 : 1024 + hh * 256, vcol = (GLA ? 5120 : 2048) + hh * 256 + e;
    const int ocol = (GLA ? 1024 : 0) + hh * 256 + eg * 16;
    LAS float* red = (LAS float*)F.lds;
    float S[ND];
#pragma unroll
    for (int i = 0; i < ND; ++i) S[i] = 0.f;
    float wa[GLA ? 4 : 1][16]; float ba[GLA ? 4 : 1];
    if (GLA) {
#pragma unroll
        for (int i = 0; i < 4; ++i) { const int d = dp + 32 * i; ba[i] = F.in[5][hh * 128 + d];
#pragma unroll
            for (int r = 0; r < 16; ++r) wa[i][r] = F.in[4][r * 512 + hh * 128 + d]; }
    }
    const float gamma = 1.0f - exp2f(-5.0f - (float)hh);
    const float* glr = WSP(float, WS_GLR);
    for (int t0 = 0; t0 < T; t0 += 8) {
        float part[8];
#pragma unroll
        for (int tt = 0; tt < 8; ++tt) {
            const int t = t0 + tt; const bf16* hr = H + (size_t)t * HW;
            const float v = bf2f(hr[vcol]);
            float g16[16];
            if (GLA) {
#pragma unroll
                for (int r = 0; r < 16; ++r) g16[r] = glr[t * 16 + r];
            }
            float p = 0.f;
#pragma unroll
            for (int i = 0; i < ND; ++i) { const int d = dp + 32 * i;
                const float q = bf2f(hr[qcol + d]), k = bf2f(hr[kcol + d]);
                float a = gamma;
                if (GLA) { float z = ba[i];
#pragma unroll
                    for (int r = 0; r < 16; ++r) z += g16[r] * wa[i][r];
                    a = expf(log_sigmoid_f(z) * 0.0625f); }
                S[i] = a * S[i] + k * v; p += q * S[i]; }
            p += __shfl_xor(p, 16); p += __shfl_xor(p, 32);
            part[tt] = p;
        }
        if (F.lane < 16) {
#pragma unroll
            for (int tt = 0; tt < 8; ++tt) red[(F.wave * 8 + tt) * 16 + F.lane] = part[tt];
        }
        __syncthreads();
        if (F.tid < 128) { const int tt = F.tid >> 4, e2 = F.tid & 15; float s = 0.f;
#pragma unroll
            for (int w = 0; w < 8; ++w) s += red[(w * 8 + tt) * 16 + e2];
            oraw[(size_t)(t0 + tt) * D + ocol + e2] = s; }
        __syncthreads();
    }
}
__device__ __forceinline__ void p2_mixer_naive(Frame& F) {
    for (int item = F.bid; item < 128; item += F.G) {
        const int h8 = item >> 4, eg = item & 15;
        if (h8 < 4) mixer_naive_item<false>(F, h8, eg); else mixer_naive_item<true>(F, h8 - 4, eg);
    }
}
__device__ __forceinline__ void p3_normgate(Frame& F) {
    const bf16* H = WSP(bf16, WS_H); const float* oraw = WSP(float, WS_ORAW); bf16* mixed = WSP(bf16, WS_MIXED);
    const int gw = F.bid * NWAVES + F.wave, NGW = F.G * NWAVES;
    const f32x4 gn = *(const f32x4*)(F.in[6] + 4 * F.lane);
    for (int t = gw; t < T; t += NGW) {
#pragma unroll
        for (int h8 = 0; h8 < 8; ++h8) {
            const f32x4 o = *(const GAS f32x4*)(oraw + (size_t)t * D + h8 * 256 + 4 * F.lane);
            const int gcol = (h8 < 4 ? 3072 : 6144) + (h8 & 3) * 256 + 4 * F.lane;
            const v2u gw2 = *(const GAS v2u*)(H + (size_t)t * HW + gcol);
            const f32x4 gt = {bflo(gw2.x), bfhi(gw2.x), bflo(gw2.y), bfhi(gw2.y)};
            f32x4 y;
            if (h8 < 4) {
                const float mu = wave_sum((o[0] + o[1]) + (o[2] + o[3])) * (1.f / 256.f);
                const f32x4 dd = o - mu;
                const float var = wave_sum((dd[0] * dd[0] + dd[1] * dd[1]) + (dd[2] * dd[2] + dd[3] * dd[3])) * (1.f / 256.f);
                y = dd * (1.0f / sqrtf(var + LN_EPS));
            } else {
                const float ms = wave_sum((o[0] * o[0] + o[1] * o[1]) + (o[2] * o[2] + o[3] * o[3])) * (1.f / 256.f);
                y = o * (1.0f / sqrtf(ms + LN_EPS)) * gn;
            }
            float r[4];
#pragma unroll
            for (int i = 0; i < 4; ++i) { const float g = gt[i]; r[i] = g / (1.0f + expf(-g)) * y[i]; }
            v2u w; w.x = pk2(r[0], r[1]); w.y = pk2(r[2], r[3]);
            *(GAS v2u*)(mixed + (size_t)t * D + h8 * 256 + 4 * F.lane) = w;
        }
    }
}
template <bool ROUTER>
__device__ __forceinline__ void ln_apply(Frame& F, const float* Y, const float* g, const float* b, bf16* HB, float* st, bool count = true) {
    const int gw = F.bid * NWAVES + F.wave, NGW = F.G * NWAVES;
    for (int t = gw; t < T; t += NGW) {
        const GAS f32x4* yr = (const GAS f32x4*)(Y + (size_t)t * D) + F.lane;
        f32x4 v[8]; float s = 0.f;
#pragma unroll
        for (int j = 0; j < 8; ++j) { v[j] = yr[64 * j]; s += (v[j][0] + v[j][1]) + (v[j][2] + v[j][3]); }
        const float mean = wave_sum(s) * (1.f / D); float s2 = 0.f;
#pragma unroll
        for (int j = 0; j < 8; ++j) { v[j] = v[j] - mean; s2 += (v[j][0] * v[j][0] + v[j][1] * v[j][1]) + (v[j][2] * v[j][2] + v[j][3] * v[j][3]); }
        const float rstd = 1.f / sqrtf(wave_sum(s2) * (1.f / D) + LN_EPS);
        if (F.lane == 0) { st[2 * t] = mean; st[2 * t + 1] = rstd; }
        GAS v2u* o8 = (GAS v2u*)(HB + (size_t)t * D) + F.lane;
#pragma unroll
        for (int j = 0; j < 8; ++j) { const f32x4 gv = *(const f32x4*)(g + 4 * F.lane + 256 * j), bv = *(const f32x4*)(b + 4 * F.lane + 256 * j);
            v[j] = v[j] * rstd * gv + bv;
            v2u w; w.x = pk2(v[j][0], v[j][1]); w.y = pk2(v[j][2], v[j][3]); o8[64 * j] = w; }
        if (ROUTER) {
            const float* Wg = F.in[16]; const float* We = F.in[18];
            float lg[4], le[32];
#pragma unroll
            for (int i = 0; i < 4; ++i) lg[i] = 0.f;
#pragma unroll
            for (int i = 0; i < 32; ++i) le[i] = 0.f;
#pragma unroll
            for (int j = 0; j < 8; ++j) {
#pragma unroll
                for (int i = 0; i < 4; ++i) { const int c = 4 * F.lane + 256 * j + i; const float hv = v[j][i];
                    const f32x4 wg = *(const GAS f32x4*)(Wg + (size_t)c * 4);
#pragma unroll
                    for (int q = 0; q < 4; ++q) lg[q] += hv * wg[q];
#pragma unroll
                    for (int q8 = 0; q8 < 8; ++q8) { const f32x4 we = *(const GAS f32x4*)(We + (size_t)c * 32 + 4 * q8);
#pragma unroll
                        for (int q = 0; q < 4; ++q) le[4 * q8 + q] += hv * we[q]; } }
            }
#pragma unroll
            for (int i = 0; i < 4; ++i) lg[i] = wave_sum(lg[i]) + F.in[17][i];
#pragma unroll
            for (int i = 0; i < 32; ++i) le[i] = wave_sum(le[i]);
            int grp = 0; float gm = lg[0];
#pragma unroll
            for (int i = 1; i < 4; ++i) if (lg[i] > gm) { gm = lg[i]; grp = i; }
            float gs = 0.f;
#pragma unroll
            for (int i = 0; i < 4; ++i) gs += expf(lg[i] - gm);
            const float pg_sel = 1.0f / gs;
            float fe[8];
#pragma unroll
            for (int j = 0; j < 8; ++j) { const float a = grp == 0 ? le[j] : grp == 1 ? le[8 + j] : grp == 2 ? le[16 + j] : le[24 + j]; fe[j] = a + F.in[19][grp * 8 + j]; }
            int i1 = 0; float m1 = fe[0];
#pragma unroll
            for (int j = 1; j < 8; ++j) if (fe[j] > m1) { m1 = fe[j]; i1 = j; }
            int i2 = -1; float m2 = -3.0e38f;
#pragma unroll
            for (int j = 0; j < 8; ++j) if (j != i1 && fe[j] > m2) { m2 = fe[j]; i2 = j; }
            const float p2 = expf(m2 - m1), den = 1.0f / (1.0f + p2);
            if (F.lane == 0) {
                int* ex = WSP(int, WS_EXP); float* gt = WSP(float, WS_GATE);
                const int e1 = grp * 8 + i1, e2 = grp * 8 + i2;
                ex[2 * t] = e1; ex[2 * t + 1] = e2; gt[2 * t] = pg_sel * den; gt[2 * t + 1] = pg_sel * p2 * den;
                if (count) { atomicAdd((unsigned*)(F.ctl + CW_CNT) + e1, 1u); atomicAdd((unsigned*)(F.ctl + CW_CNT) + e2, 1u); }
            }
        }
    }
}
__device__ __forceinline__ void p7_attn_naive(Frame& F) {
    const bf16* Q = WSP(bf16, WS_QB); const bf16* KVM = WSP(bf16, WS_KVM); bf16* att = WSP(bf16, WS_ATT);
    LAS float* qs = (LAS float*)F.lds;
    LAS float* sc = (LAS float*)(F.lds + 16384);
    for (int item = F.bid; item < (T / 8) * 4; item += F.G) {
        const int h = item & 3, t0 = (item >> 2) * 8;
        for (int i = F.tid; i < 8 * 512; i += NTHR) { const int tt = i >> 9, d = i & 511; qs[i] = bf2f(Q[(size_t)(t0 + tt) * D + h * 512 + d]); }
        __syncthreads();
        {
            const int j = F.tid & 255, th = F.tid >> 8;
            const bf16* kr = KVM + (size_t)j * 4096 + h * 512;
            float a0 = 0.f, a1 = 0.f, a2 = 0.f, a3 = 0.f;
            for (int d = 0; d < 512; d += 8) {
                const v4u kw = *(const GAS v4u*)(kr + d);
                const float kf[8] = {bflo(kw.x), bfhi(kw.x), bflo(kw.y), bfhi(kw.y), bflo(kw.z), bfhi(kw.z), bflo(kw.w), bfhi(kw.w)};
#pragma unroll
                for (int i = 0; i < 8; ++i) { a0 += kf[i] * qs[(th * 4 + 0) * 512 + d + i]; a1 += kf[i] * qs[(th * 4 + 1) * 512 + d + i]; a2 += kf[i] * qs[(th * 4 + 2) * 512 + d + i]; a3 += kf[i] * qs[(th * 4 + 3) * 512 + d + i]; }
            }
            const float scl = 0.04419417382415922f;
            sc[(th * 4 + 0) * 256 + j] = a0 * scl; sc[(th * 4 + 1) * 256 + j] = a1 * scl; sc[(th * 4 + 2) * 256 + j] = a2 * scl; sc[(th * 4 + 3) * 256 + j] = a3 * scl;
        }
        __syncthreads();
        {
            float v[4]; float mx = -3.0e38f;
#pragma unroll
            for (int i = 0; i < 4; ++i) { v[i] = sc[F.wave * 256 + F.lane + 64 * i]; mx = fmaxf(mx, v[i]); }
            mx = wave_max(mx); float sm = 0.f;
#pragma unroll
            for (int i = 0; i < 4; ++i) { v[i] = expf(v[i] - mx); sm += v[i]; }
            sm = 1.0f / wave_sum(sm);
#pragma unroll
            for (int i = 0; i < 4; ++i) sc[F.wave * 256 + F.lane + 64 * i] = v[i] * sm;
        }
        __syncthreads();
        {
            const int d = F.tid; const bf16* vr = KVM + 2048 + h * 512 + d;
            float o[8];
#pragma unroll
            for (int i = 0; i < 8; ++i) o[i] = 0.f;
            for (int j = 0; j < 256; ++j) { const float vv = bf2f(vr[(size_t)j * 4096]);
#pragma unroll
                for (int i = 0; i < 8; ++i) o[i] += sc[i * 256 + j] * vv; }
#pragma unroll
            for (int i = 0; i < 8; ++i) att[(size_t)(t0 + i) * D + h * 512 + d] = (bf16)f2bf(o[i]);
        }
        __syncthreads();
    }
}
__device__ __forceinline__ void moe_tile_starts(Frame& F, LAS int* ts) {
    if (F.tid < 64) {
        const unsigned c = F.lane < 32 ? __hip_atomic_load(F.ctl + CW_CUR + (F.lane & 31), RLX_AGENT) : 0u;
        int v = (int)((c + 255u) >> 8);
#pragma unroll
        for (int o = 1; o < 32; o <<= 1) { const int n = __shfl_up(v, o); if (F.lane >= o) v += n; }
        if (F.lane < 32) ts[F.lane + 1] = v;
        if (F.lane == 0) ts[0] = 0;
    }
    __syncthreads();
}
__device__ __forceinline__ void p10_dispatch(Frame& F, LAS int* ts) {
    const int gt = F.bid * NTHR + F.tid, NGT = F.G * NTHR;
    const int* ex = WSP(int, WS_EXP); const int* sl = WSP(int, WS_SLOT); int* pos = WSP(int, WS_POS); int* tok = WSP(int, WS_TOK);
    for (int a = gt; a < 2 * T; a += NGT) { const int p = ts[ex[a]] * 256 + sl[a]; pos[a] = p; tok[p] = a >> 1; }
}
__device__ __forceinline__ void p13_combine(Frame& F) {
    const int gw = F.bid * NWAVES + F.wave, NGW = F.G * NWAVES;
    const float* Y2 = WSP(float, WS_Y2); const float* st2 = WSP(float, WS_ST2); const bf16* ys = WSP(bf16, WS_YS);
    const int* pos = WSP(int, WS_POS); const float* gt = WSP(float, WS_GATE);
    const float* g2 = F.in[14]; const float* b2 = F.in[15]; const float* g3 = F.in[23]; const float* b3 = F.in[24];
    for (int t = gw; t < T; t += NGW) {
        const float mu2 = st2[2 * t], rs2 = st2[2 * t + 1];
        const int p0 = pos[2 * t], p1 = pos[2 * t + 1]; const float w0 = gt[2 * t], w1 = gt[2 * t + 1];
        const GAS f32x4* yr = (const GAS f32x4*)(Y2 + (size_t)t * D) + F.lane;
        const GAS v2u* y0 = (const GAS v2u*)(ys + (size_t)p0 * D) + F.lane; const GAS v2u* y1 = (const GAS v2u*)(ys + (size_t)p1 * D) + F.lane;
        f32x4 v[8]; float s = 0.f;
#pragma unroll
        for (int j = 0; j < 8; ++j) { const f32x4 gv = *(const f32x4*)(g2 + 4 * F.lane + 256 * j), bv = *(const f32x4*)(b2 + 4 * F.lane + 256 * j);
            const f32x4 h = (yr[64 * j] - mu2) * rs2 * gv + bv;
            const v2u a = y0[64 * j], c = y1[64 * j];
            const f32x4 fa = {bflo(a.x), bfhi(a.x), bflo(a.y), bfhi(a.y)}, fc = {bflo(c.x), bfhi(c.x), bflo(c.y), bfhi(c.y)};
            v[j] = h * ALPHA + fa * w0 + fc * w1; s += (v[j][0] + v[j][1]) + (v[j][2] + v[j][3]); }
        const float mean = wave_sum(s) * (1.f / D); float s2 = 0.f;
#pragma unroll
        for (int j = 0; j < 8; ++j) { v[j] = v[j] - mean; s2 += (v[j][0] * v[j][0] + v[j][1] * v[j][1]) + (v[j][2] * v[j][2] + v[j][3] * v[j][3]); }
        const float rstd = 1.f / sqrtf(wave_sum(s2) * (1.f / D) + LN_EPS);
        GAS f32x4* orow = (GAS f32x4*)(F.out + (size_t)t * D) + F.lane;
#pragma unroll
        for (int j = 0; j < 8; ++j) { const f32x4 gv = *(const f32x4*)(g3 + 4 * F.lane + 256 * j), bv = *(const f32x4*)(b3 + 4 * F.lane + 256 * j);
            orow[64 * j] = v[j] * rstd * gv + bv; }
    }
}

constexpr int CS = 128, NB = CS / 64, NS = T / CS;
constexpr size_t WS_BCUM = WS_ORAW;
constexpr size_t WS_KVR = WS_ORAW + 16 * MiB;
constexpr size_t WS_KVG = WS_KVR + 32 * MiB;
typedef short bf16x8_t __attribute__((ext_vector_type(8)));
typedef short s16x4_t __attribute__((ext_vector_type(4)));
__device__ __forceinline__ s16x4_t lds_tr(const LAS unsigned char* p) { return __builtin_bit_cast(s16x4_t, __builtin_amdgcn_ds_read_tr16_b64_v4i16((LAS s16x4_t*)p)); }
__device__ __forceinline__ bf16x8_t frag_tr(const LAS unsigned char* X, int pitch, int k0, int n0, int lane) {
    const int fq = lane >> 4, q = (lane >> 2) & 3, p = lane & 3;
    const LAS unsigned char* a = X + ((k0 + 8 * fq + q) * pitch + n0 + 4 * p) * 2;
    const s16x4_t lo = lds_tr(a), hi = lds_tr(a + 4 * pitch * 2);
    return __builtin_shufflevector(lo, hi, 0, 1, 2, 3, 4, 5, 6, 7);
}
__device__ __forceinline__ bf16x8_t frag_row(const LAS unsigned char* X, int pitch, int r0, int k0, int lane) {
    return *(const LAS bf16x8_t*)(X + ((r0 + (lane & 15)) * pitch + k0 + 8 * (lane >> 4)) * 2);
}
#define MFMA16(a, b, c) __builtin_amdgcn_mfma_f32_16x16x32_bf16((a), (b), (c), 0, 0, 0)
__device__ __forceinline__ float fexp(float x) { return __builtin_amdgcn_exp2f(x * 1.4426950408889634f); }
__device__ __forceinline__ float silu_g(float g) { return g * __builtin_amdgcn_rcpf(1.0f + __builtin_amdgcn_exp2f(-1.4426950408889634f * g)); }

__device__ __forceinline__ void bcum_item(Frame& F, int s, int h) {
    const int c = F.tid & 127, tq = F.tid >> 7;
    LAS float* tot = (LAS float*)F.lds;
    const float* glr = WSP(float, WS_GLR); float* bc = WSP(float, WS_BCUM);
    float w[16];
#pragma unroll
    for (int r = 0; r < 16; ++r) w[r] = F.in[4][r * 512 + h * 128 + c];
    const float bias = F.in[5][h * 128 + c];
    float vals[32]; float run = 0.f;
    const int tb = s * CS + tq * 32;
#pragma unroll
    for (int i = 0; i < 32; ++i) { const float* gr = glr + (size_t)(tb + i) * 16; float z = bias;
#pragma unroll
        for (int r = 0; r < 16; ++r) z += gr[r] * w[r];
        run += log_sigmoid_f(z) * 0.0625f; vals[i] = run; }
    __syncthreads();
    tot[tq * 128 + c] = run;
    __syncthreads();
    float off = 0.f;
#pragma unroll
    for (int q = 0; q < 3; ++q) off += (q < tq) ? tot[q * 128 + c] : 0.f;
#pragma unroll
    for (int i = 0; i < 32; ++i) bc[(size_t)(tb + i) * 512 + h * 128 + c] = vals[i] + off;
}
__device__ __forceinline__ void p1_bcum(Frame& F) { for (int it = F.bid; it < NS * 4; it += F.G) bcum_item(F, it >> 2, it & 3); __syncthreads(); }

__device__ __forceinline__ void unit_sh(int u, int& s, int& h8) { s = (u >> 3) & (NS - 1); h8 = ((u & 7) + 4 * (u >> 8)) & 7; }

template <bool GLA, int MODE>
__device__ __forceinline__ void stage_qk(Frame& F, LAS unsigned char* dst, int s, int jb, int hh, int col0, float lg2gamma) {
    constexpr int DK = GLA ? 128 : 256, PK = DK + 8, CPR = DK / 8, NIT = 64 * CPR / NTHR;
    const bf16* H = WSP(bf16, WS_H); const float* bc = WSP(float, WS_BCUM);
#pragma unroll
    for (int it = 0; it < NIT; ++it) {
        const int ch = F.tid + NTHR * it, r = ch / CPR, cc = ch % CPR, tl = jb * 64 + r, t = s * CS + tl;
        const v4u w = *(const GAS v4u*)(H + (size_t)t * HW + col0 + 8 * cc);
        float f[8] = {bflo(w.x), bfhi(w.x), bflo(w.y), bfhi(w.y), bflo(w.z), bfhi(w.z), bflo(w.w), bfhi(w.w)};
        if (GLA) {
            const f32x4 b0 = *(const GAS f32x4*)(bc + (size_t)t * 512 + hh * 128 + 8 * cc), b1 = *(const GAS f32x4*)(bc + (size_t)t * 512 + hh * 128 + 8 * cc + 4);
            float e[8] = {b0[0], b0[1], b0[2], b0[3], b1[0], b1[1], b1[2], b1[3]};
            if (MODE == 2) { const size_t tl_ = (size_t)(s * CS + CS - 1) * 512 + hh * 128 + 8 * cc; const f32x4 l0 = *(const GAS f32x4*)(bc + tl_), l1 = *(const GAS f32x4*)(bc + tl_ + 4);
                const float l[8] = {l0[0], l0[1], l0[2], l0[3], l1[0], l1[1], l1[2], l1[3]};
#pragma unroll
                for (int i = 0; i < 8; ++i) e[i] = l[i] - e[i]; }
            else if (MODE == 1) {
#pragma unroll
                for (int i = 0; i < 8; ++i) e[i] = -e[i]; }
#pragma unroll
            for (int i = 0; i < 8; ++i) f[i] *= fexp(e[i]);
        } else {
            const float ex = MODE == 0 ? (float)(tl + 1) : MODE == 1 ? -(float)(tl + 1) : (float)(CS - 1 - tl);
            const float fac = __builtin_amdgcn_exp2f(ex * lg2gamma);
#pragma unroll
            for (int i = 0; i < 8; ++i) f[i] *= fac;
        }
        v4u o; o.x = pk2(f[0], f[1]); o.y = pk2(f[2], f[3]); o.z = pk2(f[4], f[5]); o.w = pk2(f[6], f[7]);
        *(LAS v4u*)(dst + (r * PK + 8 * cc) * 2) = o;
    }
}
__device__ __forceinline__ void stage_v(Frame& F, LAS unsigned char* dst, int s, int jb, int col0) {
    const bf16* H = WSP(bf16, WS_H);
#pragma unroll
    for (int it = 0; it < 4; ++it) { const int ch = F.tid + NTHR * it, r = ch >> 5, cc = ch & 31, t = s * CS + jb * 64 + r;
        *(LAS v4u*)(dst + (r * 264 + 8 * cc) * 2) = *(const GAS v4u*)(H + (size_t)t * HW + col0 + 8 * cc); }
}

template <bool GLA>
__device__ __forceinline__ void kv_unit(Frame& F, int s, int hh) {
    constexpr int DK = GLA ? 128 : 256, PK = DK + 8, NDT = DK / 16;
    LAS unsigned char* Ks = F.lds; LAS unsigned char* Vs = F.lds + 34816;
    const int kcol = GLA ? 4608 + hh * 128 : 1024 + hh * 256, vcol = (GLA ? 5120 : 2048) + hh * 256;
    const float lg2g = log2f(1.0f - exp2f(-5.0f - (float)hh));
    f32x4 acc[2][NDT];
#pragma unroll
    for (int a = 0; a < 2; ++a)
#pragma unroll
        for (int d = 0; d < NDT; ++d) acc[a][d] = (f32x4){0.f, 0.f, 0.f, 0.f};
    for (int jb = 0; jb < NB; ++jb) {
        __syncthreads();
        stage_qk<GLA, 2>(F, Ks, s, jb, hh, kcol, lg2g);
        stage_v(F, Vs, s, jb, vcol);
        __syncthreads();
#pragma unroll
        for (int ks = 0; ks < 2; ++ks) {
            bf16x8_t vf[2];
#pragma unroll
            for (int et = 0; et < 2; ++et) vf[et] = frag_tr(Vs, 264, 32 * ks, 32 * F.wave + 16 * et, F.lane);
#pragma unroll
            for (int dt = 0; dt < NDT; ++dt) { const bf16x8_t kf = frag_tr(Ks, PK, 32 * ks, 16 * dt, F.lane);
#pragma unroll
                for (int et = 0; et < 2; ++et) acc[et][dt] = MFMA16(kf, vf[et], acc[et][dt]); }
        }
    }
    bf16* kv = GLA ? (WSP(bf16, WS_KVG) + (size_t)(s * 4 + hh) * 256 * 128) : (WSP(bf16, WS_KVR) + (size_t)(s * 4 + hh) * 256 * 256);
    const int fr = F.lane & 15, fq = F.lane >> 4;
#pragma unroll
    for (int et = 0; et < 2; ++et)
#pragma unroll
        for (int dt = 0; dt < NDT; ++dt) { v2u w; w.x = pk2(acc[et][dt][0], acc[et][dt][1]); w.y = pk2(acc[et][dt][2], acc[et][dt][3]);
            *(GAS v2u*)(kv + (size_t)(32 * F.wave + 16 * et + fr) * DK + 16 * dt + 4 * fq) = w; }
}
__device__ __forceinline__ void p2_kv(Frame& F) {
    for (int u = F.bid; u < 8 * NS; u += F.G) { int s, h8; unit_sh(u, s, h8);
        if (s == NS - 1) continue;
        if (h8 < 4) kv_unit<false>(F, s, h8); else kv_unit<true>(F, s, h8 - 4); }
    __syncthreads();
}
__device__ __forceinline__ void p3_scan(Frame& F) {
    constexpr int NR = 4 * 256 * 64, NG = 4 * 256 * 32, NITEM = NR + NG;
    const float* bc = WSP(float, WS_BCUM);
    const int per = (NITEM + F.G - 1) / F.G;
    for (int k0 = F.tid; k0 < per; k0 += NTHR) {
      const int it = F.bid * per + k0;
      if (it < NITEM) {
        const bool gla = it >= NR; const int r = gla ? it - NR : it;
        const int sh = gla ? 5 : 6, dk = gla ? 128 : 256;
        const int cc = r & ((1 << sh) - 1), e = (r >> sh) & 255, hh = r >> (sh + 8);
        bf16* base = (gla ? WSP(bf16, WS_KVG) : WSP(bf16, WS_KVR)) + ((size_t)hh * 256 + e) * dk + 4 * cc;
        const size_t sstride = (size_t)4 * 256 * dk;
        const float dret = __builtin_amdgcn_exp2f((float)CS * log2f(1.0f - exp2f(-5.0f - (float)hh)));
        float S[4] = {0.f, 0.f, 0.f, 0.f};
#pragma unroll 8
        for (int s = 0; s < NS - 1; ++s) {
            GAS v2u* p = (GAS v2u*)(base + (size_t)s * sstride);
            const v2u w = *p;
            v2u o; o.x = pk2(S[0], S[1]); o.y = pk2(S[2], S[3]);
            *p = o;
            const float f[4] = {bflo(w.x), bfhi(w.x), bflo(w.y), bfhi(w.y)};
            float dec[4] = {dret, dret, dret, dret};
            if (gla) { const f32x4 l0 = *(const GAS f32x4*)(bc + (size_t)(s * CS + CS - 1) * 512 + hh * 128 + 4 * cc);
                dec[0] = fexp(l0[0]); dec[1] = fexp(l0[1]); dec[2] = fexp(l0[2]); dec[3] = fexp(l0[3]); }
#pragma unroll
            for (int i = 0; i < 4; ++i) S[i] = dec[i] * S[i] + f[i];
        }
        { GAS v2u* p = (GAS v2u*)(base + (size_t)(NS - 1) * sstride); v2u o; o.x = pk2(S[0], S[1]); o.y = pk2(S[2], S[3]); *p = o; }
      }
    }
}
template <bool GLA>
__device__ __forceinline__ void out_unit(Frame& F, int s, int hh) {
    constexpr int DK = GLA ? 128 : 256, PK = DK + 8, NKS = DK / 32;
    LAS unsigned char* Qs = F.lds; LAS unsigned char* Ks = F.lds + 33792; LAS unsigned char* Vs = F.lds + 67584; LAS unsigned char* Ps = F.lds + 101376;
    LAS float* red = (LAS float*)(F.lds + 110592);
    const int qcol = GLA ? 4096 + hh * 128 : hh * 256, kcol = GLA ? 4608 + hh * 128 : 1024 + hh * 256, vcol = (GLA ? 5120 : 2048) + hh * 256;
    const int gcol = (GLA ? 6144 : 3072) + hh * 256, ocol = (GLA ? 1024 : 0) + hh * 256;
    const float lg2g = log2f(1.0f - exp2f(-5.0f - (float)hh));
    const bf16* H = WSP(bf16, WS_H); bf16* mixed = WSP(bf16, WS_MIXED);
    const bf16* st = GLA ? (WSP(bf16, WS_KVG) + (size_t)(s * 4 + hh) * 256 * 128) : (WSP(bf16, WS_KVR) + (size_t)(s * 4 + hh) * 256 * 256);
    const int fr = F.lane & 15, fq = F.lane >> 4, w = F.wave, mt = w >> 1, nt0 = 2 * (w & 1);
    for (int i = 0; i < NB; ++i) {
        __syncthreads();
        stage_qk<GLA, 0>(F, Qs, s, i, hh, qcol, lg2g);
        f32x4 accO[4][2];
#pragma unroll
        for (int m = 0; m < 4; ++m)
#pragma unroll
            for (int n = 0; n < 2; ++n) accO[m][n] = (f32x4){0.f, 0.f, 0.f, 0.f};
        for (int j = 0; j <= i; ++j) {
            __syncthreads();
            stage_qk<GLA, 1>(F, Ks, s, j, hh, kcol, lg2g);
            stage_v(F, Vs, s, j, vcol);
            __syncthreads();
            f32x4 accS[2] = {(f32x4){0.f, 0.f, 0.f, 0.f}, (f32x4){0.f, 0.f, 0.f, 0.f}};
#pragma unroll
            for (int ks = 0; ks < NKS; ++ks) { const bf16x8_t qf = frag_row(Qs, PK, 16 * mt, 32 * ks, F.lane);
#pragma unroll
                for (int n2 = 0; n2 < 2; ++n2) { const bf16x8_t kf = frag_row(Ks, PK, 16 * (nt0 + n2), 32 * ks, F.lane); accS[n2] = MFMA16(kf, qf, accS[n2]); } }
#pragma unroll
            for (int n2 = 0; n2 < 2; ++n2) { const int row = 16 * mt + fr, c0 = 16 * (nt0 + n2) + 4 * fq; float pv[4];
#pragma unroll
                for (int jj = 0; jj < 4; ++jj) pv[jj] = (i == j && c0 + jj > row) ? 0.f : accS[n2][jj];
                v2u pw; pw.x = pk2(pv[0], pv[1]); pw.y = pk2(pv[2], pv[3]);
                *(LAS v2u*)(Ps + (row * 72 + c0) * 2) = pw; }
            __syncthreads();
#pragma unroll
            for (int ks = 0; ks < 2; ++ks) {
                bf16x8_t vf[2];
#pragma unroll
                for (int n = 0; n < 2; ++n) vf[n] = frag_tr(Vs, 264, 32 * ks, 32 * w + 16 * n, F.lane);
#pragma unroll
                for (int m = 0; m < 4; ++m) { const bf16x8_t pf = frag_row(Ps, 72, 16 * m, 32 * ks, F.lane);
#pragma unroll
                    for (int n = 0; n < 2; ++n) accO[m][n] = MFMA16(vf[n], pf, accO[m][n]); }
            }
        }
        if (s > 0) {
#pragma unroll
            for (int ks = 0; ks < NKS; ++ks) {
                bf16x8_t sf[2];
#pragma unroll
                for (int n = 0; n < 2; ++n) sf[n] = *(const GAS bf16x8_t*)(st + (size_t)(32 * w + 16 * n + fr) * DK + 32 * ks + 8 * fq);
#pragma unroll
                for (int m = 0; m < 4; ++m) { const bf16x8_t qf = frag_row(Qs, PK, 16 * m, 32 * ks, F.lane);
#pragma unroll
                    for (int n = 0; n < 2; ++n) accO[m][n] = MFMA16(sf[n], qf, accO[m][n]); }
            }
        }
#pragma unroll
        for (int m = 0; m < 4; ++m) { float s1 = 0.f, s2 = 0.f;
#pragma unroll
            for (int n = 0; n < 2; ++n)
#pragma unroll
                for (int jj = 0; jj < 4; ++jj) { const float v = accO[m][n][jj]; s1 += v; s2 += v * v; }
            s1 += __shfl_xor(s1, 16); s1 += __shfl_xor(s1, 32); s2 += __shfl_xor(s2, 16); s2 += __shfl_xor(s2, 32);
            if (fq == 0) { red[(w * 64 + 16 * m + fr) * 2] = s1; red[(w * 64 + 16 * m + fr) * 2 + 1] = s2; } }
        __syncthreads();
#pragma unroll
        for (int m = 0; m < 4; ++m) { const int row = 16 * m + fr; float s1 = 0.f, s2 = 0.f;
#pragma unroll
            for (int ww = 0; ww < 8; ++ww) { s1 += red[(ww * 64 + row) * 2]; s2 += red[(ww * 64 + row) * 2 + 1]; }
            const float mean = s1 * (1.f / 256.f), ex2 = s2 * (1.f / 256.f);
            const float mu = GLA ? 0.f : mean, var = GLA ? ex2 : fmaxf(ex2 - mean * mean, 0.f);
            const float rstd = 1.0f / sqrtf(var + LN_EPS);
            const int t = s * CS + i * 64 + row;
#pragma unroll
            for (int n = 0; n < 2; ++n) { const int e = 32 * w + 16 * n + 4 * fq;
                const v2u gw2 = *(const GAS v2u*)(H + (size_t)t * HW + gcol + e);
                const float gt[4] = {bflo(gw2.x), bfhi(gw2.x), bflo(gw2.y), bfhi(gw2.y)};
                f32x4 gn = {1.f, 1.f, 1.f, 1.f}; if (GLA) gn = *(const f32x4*)(F.in[6] + e);
                float r4[4];
#pragma unroll
                for (int jj = 0; jj < 4; ++jj) { const float y = (accO[m][n][jj] - mu) * rstd * gn[jj]; r4[jj] = silu_g(gt[jj]) * y; }
                v2u ow; ow.x = pk2(r4[0], r4[1]); ow.y = pk2(r4[2], r4[3]);
                *(GAS v2u*)(mixed + (size_t)t * D + ocol + e) = ow; } }
    }
}
__device__ __forceinline__ void p4_out(Frame& F) {
    for (int u = F.bid; u < 8 * NS; u += F.G) { int s, h8; unit_sh(u, s, h8);
        if (h8 < 4) out_unit<false>(F, s, h8); else out_unit<true>(F, s, h8 - 4); }
    __syncthreads();
}

__device__ __forceinline__ void stage_kv_chunk(Frame& F, LAS unsigned char* dst, const bf16* src  ) {
#pragma unroll
    for (int it = 0; it < 8; ++it) { const int ch = F.tid + NTHR * it, r = ch >> 4, cc = ch & 15;
        *(LAS v4u*)(dst + (r * 136 + 8 * cc) * 2) = *(const GAS v4u*)(src + (size_t)r * 4096 + 8 * cc); }
}
__device__ __forceinline__ void p8_attn(Frame& F) {
    const bf16* Q = WSP(bf16, WS_QB); const bf16* KVM = WSP(bf16, WS_KVM); bf16* att = WSP(bf16, WS_ATT);
    LAS unsigned char* Cs = F.lds;
    const int fr = F.lane & 15, fq = F.lane >> 4, q4 = (F.lane >> 2) & 3, p4 = F.lane & 3;
    for (int u = F.bid; u < (T / 128) * 4; u += F.G) {
        const int h = u & 3, r0 = (u >> 2) * 128 + 16 * F.wave;
        f32x4 accS[16];
#pragma unroll
        for (int i = 0; i < 16; ++i) accS[i] = (f32x4){0.f, 0.f, 0.f, 0.f};
        for (int dc = 0; dc < 4; ++dc) {
            __syncthreads();
            stage_kv_chunk(F, Cs, KVM + h * 512 + dc * 128);
            bf16x8_t qf[4];
#pragma unroll
            for (int ks = 0; ks < 4; ++ks) qf[ks] = *(const GAS bf16x8_t*)(Q + (size_t)(r0 + fr) * D + h * 512 + dc * 128 + 32 * ks + 8 * fq);
            __syncthreads();
#pragma unroll
            for (int ks = 0; ks < 4; ++ks)
#pragma unroll
                for (int nt = 0; nt < 16; ++nt) accS[nt] = MFMA16(frag_row(Cs, 136, 16 * nt, 32 * ks, F.lane), qf[ks], accS[nt]);
        }
        float mx = -3.0e38f;
#pragma unroll
        for (int nt = 0; nt < 16; ++nt)
#pragma unroll
            for (int jj = 0; jj < 4; ++jj) mx = fmaxf(mx, accS[nt][jj]);
        mx = fmaxf(mx, __shfl_xor(mx, 16)); mx = fmaxf(mx, __shfl_xor(mx, 32));
        const float sl2 = 0.04419417382415922f * 1.4426950408889634f;
        float sm = 0.f;
#pragma unroll
        for (int nt = 0; nt < 16; ++nt)
#pragma unroll
            for (int jj = 0; jj < 4; ++jj) { const float p = __builtin_amdgcn_exp2f((accS[nt][jj] - mx) * sl2); accS[nt][jj] = p; sm += p; }
        sm += __shfl_xor(sm, 16); sm += __shfl_xor(sm, 32);
        const float inv = 1.0f / sm;
        bf16x8_t pf[8];
#pragma unroll
        for (int ks2 = 0; ks2 < 8; ++ks2) { v4u w; w.x = pk2(accS[2 * ks2][0] * inv, accS[2 * ks2][1] * inv); w.y = pk2(accS[2 * ks2][2] * inv, accS[2 * ks2][3] * inv);
            w.z = pk2(accS[2 * ks2 + 1][0] * inv, accS[2 * ks2 + 1][1] * inv); w.w = pk2(accS[2 * ks2 + 1][2] * inv, accS[2 * ks2 + 1][3] * inv); pf[ks2] = __builtin_bit_cast(bf16x8_t, w); }
        for (int ec = 0; ec < 4; ++ec) {
            __syncthreads();
            stage_kv_chunk(F, Cs, KVM + 2048 + h * 512 + ec * 128);
            __syncthreads();
            f32x4 accO[8];
#pragma unroll
            for (int i = 0; i < 8; ++i) accO[i] = (f32x4){0.f, 0.f, 0.f, 0.f};
#pragma unroll
            for (int ks2 = 0; ks2 < 8; ++ks2)
#pragma unroll
                for (int et = 0; et < 8; ++et) { const LAS unsigned char* a = Cs + ((32 * ks2 + 4 * fq + q4) * 136 + 16 * et + 4 * p4) * 2;
                    const s16x4_t lo = lds_tr(a), hi = lds_tr(a + 16 * 136 * 2);
                    accO[et] = MFMA16(__builtin_shufflevector(lo, hi, 0, 1, 2, 3, 4, 5, 6, 7), pf[ks2], accO[et]); }
#pragma unroll
            for (int et = 0; et < 8; ++et) { v2u w; w.x = pk2(accO[et][0], accO[et][1]); w.y = pk2(accO[et][2], accO[et][3]);
                *(GAS v2u*)(att + (size_t)(r0 + fr) * D + h * 512 + ec * 128 + 16 * et + 4 * fq) = w; }
        }
    }
    __syncthreads();
}

__device__ __forceinline__ void p10_ln_router(Frame& F) {
    const float* Y = WSP(float, WS_Y2); const float* g = F.in[14]; const float* b = F.in[15]; bf16* HB = WSP(bf16, WS_H2B); float* st = WSP(float, WS_ST2);
    const float* Wg = F.in[16]; const float* We = F.in[18];
    LAS float* stl = (LAS float*)F.lds;
    LAS float* part = (LAS float*)(F.lds + 1024);
    LAS int* lcnt = (LAS int*)(F.lds + 1024 + 24576);
    LAS int* lbase = lcnt + 32;
    if (F.tid < 32) lcnt[F.tid] = 0;
    { int* tok = WSP(int, WS_TOK); for (int i = F.bid * NTHR + F.tid; i < PMAX; i += F.G * NTHR) tok[i] = 0; }
    __syncthreads();
    const int fr = F.lane & 15, fq = F.lane >> 4;
    for (int item = F.bid; item < T / 32; item += F.G) {
        const int row0 = item * 32;
#pragma unroll 1
        for (int i = 0; i < 4; ++i) {
            const int t = row0 + 4 * F.wave + i;
            const GAS f32x4* yr = (const GAS f32x4*)(Y + (size_t)t * D) + F.lane;
            f32x4 v[8]; float s = 0.f;
#pragma unroll
            for (int j = 0; j < 8; ++j) { v[j] = yr[64 * j]; s += (v[j][0] + v[j][1]) + (v[j][2] + v[j][3]); }
            const float mean = wave_sum(s) * (1.f / D); float s2 = 0.f;
#pragma unroll
            for (int j = 0; j < 8; ++j) { v[j] = v[j] - mean; s2 += (v[j][0] * v[j][0] + v[j][1] * v[j][1]) + (v[j][2] * v[j][2] + v[j][3] * v[j][3]); }
            const float rstd = 1.f / sqrtf(wave_sum(s2) * (1.f / D) + LN_EPS);
            if (F.lane == 0) { st[2 * t] = mean; st[2 * t + 1] = rstd; stl[2 * (4 * F.wave + i)] = mean; stl[2 * (4 * F.wave + i) + 1] = rstd; }
            GAS v2u* o8 = (GAS v2u*)(HB + (size_t)t * D) + F.lane;
#pragma unroll
            for (int j = 0; j < 8; ++j) { const f32x4 gv = *(const f32x4*)(g + 4 * F.lane + 256 * j), bv = *(const f32x4*)(b + 4 * F.lane + 256 * j);
                const f32x4 hv = v[j] * rstd * gv + bv;
                v2u w; w.x = pk2(hv[0], hv[1]); w.y = pk2(hv[2], hv[3]); o8[64 * j] = w; }
        }
        __syncthreads();
        {
            const int rt = F.wave >> 2, kq = F.wave & 3;
            const int r = row0 + 16 * rt + fr;
            const float mu = stl[2 * (16 * rt + fr)], rstd = stl[2 * (16 * rt + fr) + 1];
            f32x4 acc0 = {0.f, 0.f, 0.f, 0.f}, acc1 = acc0, acc2 = acc0;
            const float* yp = Y + (size_t)r * D + 512 * kq + 4 * fq;
            const float* wep = We + (size_t)(512 * kq + 4 * fq) * 32 + fr;
            const float* wgp = Wg + (size_t)(512 * kq + 4 * fq) * 4 + (fr & 3);
            const float gm = fr < 4 ? 1.f : 0.f;
#pragma unroll 8
            for (int it = 0; it < 32; ++it) {
                const int k0 = 16 * it;
                const f32x4 y4 = *(const GAS f32x4*)(yp + k0), g4 = *(const f32x4*)(g + 512 * kq + 4 * fq + k0), b4 = *(const f32x4*)(b + 512 * kq + 4 * fq + k0);
                const f32x4 a = (y4 - mu) * rstd * g4 + b4;
#pragma unroll
                for (int s = 0; s < 4; ++s) {
                    const float b0 = wep[(size_t)(k0 + s) * 32], b1 = wep[(size_t)(k0 + s) * 32 + 16], b2 = wgp[(size_t)(k0 + s) * 4] * gm;
                    acc0 = __builtin_amdgcn_mfma_f32_16x16x4f32(a[s], b0, acc0, 0, 0, 0);
                    acc1 = __builtin_amdgcn_mfma_f32_16x16x4f32(a[s], b1, acc1, 0, 0, 0);
                    acc2 = __builtin_amdgcn_mfma_f32_16x16x4f32(a[s], b2, acc2, 0, 0, 0);
                }
            }
            LAS float* pw = part + F.wave * 768;
#pragma unroll
            for (int jj = 0; jj < 4; ++jj) { pw[(4 * fq + jj) * 48 + fr] = acc0[jj]; pw[(4 * fq + jj) * 48 + 16 + fr] = acc1[jj]; pw[(4 * fq + jj) * 48 + 32 + fr] = acc2[jj]; }
        }
        __syncthreads();
        int e1 = 0, e2 = 0, r1 = 0, r2 = 0; float g1 = 0.f, g2 = 0.f;
        if (F.tid < 32) {
            const int rt = F.tid >> 4, rr = F.tid & 15;
            float le[32], lg[4];
#pragma unroll
            for (int c = 0; c < 32; ++c) { float s = 0.f;
#pragma unroll
                for (int kq = 0; kq < 4; ++kq) s += part[(rt * 4 + kq) * 768 + rr * 48 + c]; le[c] = s; }
#pragma unroll
            for (int c = 0; c < 4; ++c) { float s = 0.f;
#pragma unroll
                for (int kq = 0; kq < 4; ++kq) s += part[(rt * 4 + kq) * 768 + rr * 48 + 32 + c]; lg[c] = s + F.in[17][c]; }
            int grp = 0; float gmx = lg[0];
#pragma unroll
            for (int i = 1; i < 4; ++i) if (lg[i] > gmx) { gmx = lg[i]; grp = i; }
            float gs = 0.f;
#pragma unroll
            for (int i = 0; i < 4; ++i) gs += expf(lg[i] - gmx);
            const float pg_sel = 1.0f / gs;
            float fe[8];
#pragma unroll
            for (int j = 0; j < 8; ++j) { const float a = grp == 0 ? le[j] : grp == 1 ? le[8 + j] : grp == 2 ? le[16 + j] : le[24 + j]; fe[j] = a + F.in[19][grp * 8 + j]; }
            int i1 = 0; float m1 = fe[0];
#pragma unroll
            for (int j = 1; j < 8; ++j) if (fe[j] > m1) { m1 = fe[j]; i1 = j; }
            int i2 = -1; float m2 = -3.0e38f;
#pragma unroll
            for (int j = 0; j < 8; ++j) if (j != i1 && fe[j] > m2) { m2 = fe[j]; i2 = j; }
            const float p2 = expf(m2 - m1), den = 1.0f / (1.0f + p2);
            e1 = grp * 8 + i1; e2 = grp * 8 + i2; g1 = pg_sel * den; g2 = pg_sel * p2 * den;
            r1 = __hip_atomic_fetch_add((int*)(lcnt + e1), 1, __ATOMIC_RELAXED, __HIP_MEMORY_SCOPE_WORKGROUP); r2 = __hip_atomic_fetch_add((int*)(lcnt + e2), 1, __ATOMIC_RELAXED, __HIP_MEMORY_SCOPE_WORKGROUP);
        }
        __syncthreads();
        if (F.tid < 32) { const int c = lcnt[F.tid];
            lbase[F.tid] = c ? (int)__hip_atomic_fetch_add((unsigned*)(F.ctl + CW_CUR) + F.tid, (unsigned)c, __ATOMIC_RELAXED, __HIP_MEMORY_SCOPE_AGENT) : 0; }
        __syncthreads();
        if (F.tid < 32) {
            const int t = row0 + F.tid;
            int* ex = WSP(int, WS_EXP); float* gt = WSP(float, WS_GATE); int* sl = WSP(int, WS_SLOT);
            ex[2 * t] = e1; ex[2 * t + 1] = e2; gt[2 * t] = g1; gt[2 * t + 1] = g2;
            sl[2 * t] = lbase[e1] + r1; sl[2 * t + 1] = lbase[e2] + r2;
            lcnt[F.tid] = 0;
        }
        __syncthreads();
    }
}

#define XB_TMO      128
#define XB_XCNT(j)  (256  + 64 * (j))
#define XB_XSUB(j)  (1280 + 64 * (j))
#define XB_XGEN(j)  (2304 + 64 * (j))
#define XB_TOP      3328
#define XB_TOPGEN   3392
#define XCD_BAR_WORDS 3456
#define XB_SPIN_CAP (1u << 22)
__device__ __forceinline__ unsigned xb_ld(unsigned* p)              { return __hip_atomic_load(p, __ATOMIC_RELAXED, __HIP_MEMORY_SCOPE_AGENT); }
__device__ __forceinline__ unsigned xb_add(unsigned* p, unsigned v) { return __hip_atomic_fetch_add(p, v, __ATOMIC_RELAXED, __HIP_MEMORY_SCOPE_AGENT); }
__device__ __forceinline__ unsigned xb_xcc_id() { return (unsigned)__builtin_amdgcn_s_getreg((3 << 11) | 20) & 0xFu; }
#define XB_SPIN(cond, bar) do { unsigned _sp = 0; while (cond) { __builtin_amdgcn_s_sleep(1); \
    if ((++_sp & 255u) == 0u) { if (xb_ld(&(bar)[XB_TMO])) break; if (_sp > XB_SPIN_CAP) { atomicAdd(&(bar)[XB_TMO], 1u); break; } } } } while (0)
struct XcdBarrier { unsigned* bar; unsigned x; volatile LAS unsigned* st; };
__device__ __forceinline__ XcdBarrier xcd_barrier_post(unsigned* bar, volatile LAS unsigned* st) {
    XcdBarrier b; b.bar = bar; b.x = xb_xcc_id(); b.st = st;
    if (threadIdx.x == 0) (void)xb_add(&bar[XB_XCNT(b.x)], 1u);
    return b;
}
__device__ __forceinline__ void xcd_barrier_complete(unsigned* bar, unsigned x, unsigned& nloc, unsigned& nx) {
    const unsigned G = gridDim.x * gridDim.y * gridDim.z;
    unsigned sum, cnt, mine, sp = 0u;
    for (;;) {
        sum = 0u; cnt = 0u; mine = 0u;
#pragma unroll
        for (unsigned j = 0; j < 16; ++j) { const unsigned c = xb_ld(&bar[XB_XCNT(j)]); sum += c; cnt += (c > 0u) ? 1u : 0u; mine = (j == x) ? c : mine; }
        if (sum == G) break;
        __builtin_amdgcn_s_sleep(1);
        if ((++sp & 255u) == 0u) { if (xb_ld(&bar[XB_TMO])) break; if (sp > XB_SPIN_CAP) { atomicAdd(&bar[XB_TMO], 1u); break; } }
    }
    nloc = mine > 0u ? mine : 1u; nx = cnt > 0u ? cnt : 1u;
}
__device__ __forceinline__ void xcd_barrier(const XcdBarrier& b) {
    asm volatile("s_waitcnt vmcnt(0)" ::: "memory");
    __syncthreads();
    if (threadIdx.x == 0) {
        unsigned* bar = b.bar;
        __builtin_amdgcn_s_waitcnt(0);
        unsigned nloc = b.st[0], nx = b.st[1];
        if (nloc == 0u) { xcd_barrier_complete(bar, b.x, nloc, nx); b.st[0] = nloc; b.st[1] = nx; }
        const unsigned old = xb_add(&bar[XB_XSUB(b.x)], 1u);
        const unsigned gen = old / nloc;
        if (old + 1u == (gen + 1u) * nloc) {
            __builtin_amdgcn_fence(__ATOMIC_RELEASE, "agent");
            asm volatile("s_waitcnt vmcnt(0)" ::: "memory");
            const unsigned og = xb_add(&bar[XB_TOP], 1u);
            const unsigned tg = og / nx;
            if (og + 1u == (tg + 1u) * nx) xb_add(&bar[XB_TOPGEN], 1u);
            else XB_SPIN(xb_ld(&bar[XB_TOPGEN]) == tg, bar);
            __builtin_amdgcn_fence(__ATOMIC_ACQUIRE, "agent");
            xb_add(&bar[XB_XGEN(b.x)], 1u);
            asm volatile("s_waitcnt vmcnt(0)" ::: "memory");
        } else {
            XB_SPIN(xb_ld(&bar[XB_XGEN(b.x)]) == gen, bar);
            __builtin_amdgcn_fence(__ATOMIC_ACQUIRE, "agent");
            asm volatile("s_waitcnt vmcnt(0)" ::: "memory");
        }
    }
    __syncthreads();
}

struct Args { const float* in[25]; float* out; unsigned char* ws; int ph_lo, ph_hi, use_bar, pad; };
__global__ void __launch_bounds__(NTHR, 2) mega(Args args) {
    extern __shared__ __attribute__((aligned(16))) unsigned char lds[];
    Frame F;
    F.lds = (LAS unsigned char*)lds;
    F.MISC = (volatile LAS unsigned*)(F.lds + MISC_OFF);
    F.tid = threadIdx.x; F.lane = F.tid & 63; F.wave = __builtin_amdgcn_readfirstlane(F.tid >> 6);
    F.G = gridDim.x; F.bid = blockIdx.x;
    F.ws = args.ws; F.ctl = (gu32*)(args.ws + WS_CTL);
#pragma unroll
    for (int i = 0; i < 25; ++i) F.in[i] = args.in[i];
    F.out = args.out;
    for (int u = F.tid; u < (LDS_BYTES - LDSCTL_OFF) / 4; u += NTHR) ((LAS unsigned*)(F.lds + LDSCTL_OFF))[u] = 0u;
    __syncthreads();
    LAS int* ts = (LAS int*)(F.lds + MISC_OFF + 64);
    XcdBarrier bar; bar.bar = (unsigned*)(F.ctl + CW_BAR); bar.x = 0; bar.st = nullptr;
    if (args.use_bar) bar = xcd_barrier_post((unsigned*)(F.ctl + CW_BAR), F.MISC + 8);
    const int lo = args.ph_lo, hi = args.ph_hi;
#if MK_CG_SYNC == 2
    if (args.use_bar == 2) cooperative_groups::this_grid().sync();
#endif
#define IN(k) (lo <= (k) && (k) < hi)
#define REPS(k) for (int _r = 0; _r < ((k) == PROBE_PH ? PROBE_N : 1); ++_r)
#define SEAM(k) do { if (IN(k) && IN((k) + 1)) { if (MK_CG_SYNC == 1 && (k) == 0) cooperative_groups::this_grid().sync(); else { xcd_barrier(bar); if (PROBE_PH == 100) for (int _b = 1; _b < PROBE_N; ++_b) xcd_barrier(bar); } } } while (0)

    if (IN(0)) { REPS(0) p0_prologue(F); SEAM(0); }
    if (IN(1)) {
        p1_bcum(F);
        if (PROBE_PH == 104) for (int _q = 1; _q < PROBE_N; ++_q) p1_bcum(F);
        pg8::Gemm g{WSP(pg8::bf16_t, WS_XB), WSP(pg8::bf16_t, WS_WIN), T + MEMN, HW + 4096, D}; pg8::OrderG1 S; S.init(F.G, F.bid);
        pg8::EpiH E{WSP(pg8::bf16_t, WS_H), WSP(pg8::bf16_t, WS_KVM), WSP(float, WS_RC), WSP(float, WS_RS)};
        REPS(1) pg8::gemm_phase<pg8::EpiH, pg8::OrderG1, true, true>(F.lds, g, S, E);
        transpose_queue(F);
        if (PROBE_PH == 102) for (int _q = 1; _q < PROBE_N; ++_q) transpose_queue(F, _q);
        SEAM(1);
    }
#if PROBE_PH == 101
    if (IN(1)) {
        pg8::Gemm g{WSP(pg8::bf16_t, WS_XB), WSP(pg8::bf16_t, WS_WIN), T + MEMN, HW + 4096, D}; pg8::OrderG1 S; S.init(F.G, F.bid);
        pg8::EpiH E{WSP(pg8::bf16_t, WS_H), WSP(pg8::bf16_t, WS_KVM), WSP(float, WS_RC), WSP(float, WS_RS)};
        pg8::gemm_phase<pg8::EpiH, pg8::OrderG1, true, true>(F.lds, g, S, E);
        xcd_barrier(bar);
    }
#endif
    if (IN(2)) { REPS(2) p2_kv(F); SEAM(2); }
    if (IN(3)) { p3_scan(F); SEAM(3); }
#if PROBE_PH == 103
    if (IN(3)) { p2_kv(F); xcd_barrier(bar); p3_scan(F); xcd_barrier(bar); }
#endif
    if (IN(4)) { REPS(4) p4_out(F); SEAM(4); }
    if (IN(5)) {
        pg8::Gemm g{WSP(pg8::bf16_t, WS_MIXED), WSP(pg8::bf16_t, WS_WMIX), T, D, D}; pg8::StaticOrder S; S.init(T, D, F.G, F.bid);
        pg8::EpiResX E{F.in[0], WSP(float, WS_Y1), ALPHA};
        REPS(5) pg8::gemm_phase<pg8::EpiResX, pg8::StaticOrder, true, true>(F.lds, g, S, E);
        SEAM(5);
    }
    if (IN(6)) { REPS(6) ln_apply<false>(F, WSP(float, WS_Y1), F.in[8], F.in[9], WSP(bf16, WS_H1B), WSP(float, WS_ST1)); SEAM(6); }
    if (IN(7)) {
        pg8::Gemm g{WSP(pg8::bf16_t, WS_H1B), WSP(pg8::bf16_t, WS_WMQ), T, D, D}; pg8::StaticOrder S; S.init(T, D, F.G, F.bid);
        pg8::EpiB E{WSP(pg8::bf16_t, WS_QB), D, -1};
        REPS(7) pg8::gemm_phase<pg8::EpiB, pg8::StaticOrder, true, true>(F.lds, g, S, E);
        SEAM(7);
    }
    if (IN(8)) { REPS(8) p8_attn(F); SEAM(8); }
    if (IN(9)) {
        pg8::Gemm g{WSP(pg8::bf16_t, WS_ATT), WSP(pg8::bf16_t, WS_WMO), T, D, D}; pg8::StaticOrder S; S.init(T, D, F.G, F.bid);
        pg8::EpiResLN E{WSP(float, WS_Y1), WSP(float, WS_ST1), F.in[8], F.in[9], WSP(float, WS_Y2), ALPHA};
        REPS(9) pg8::gemm_phase<pg8::EpiResLN, pg8::StaticOrder, true, true>(F.lds, g, S, E);
        SEAM(9);
    }
    if (IN(10)) { p10_ln_router(F); SEAM(10); }
    if (IN(11)) { moe_tile_starts(F, ts); p10_dispatch(F, ts); SEAM(11); }
    if (IN(12)) {
        moe_tile_starts(F, ts);
        pg8::Gemm g{WSP(pg8::bf16_t, WS_H2B), WSP(pg8::bf16_t, WS_WGU), PMAX, 32 * 1024, D, WSP(int, WS_TOK)};
        pg8::MoeOrder S{(const PG8_LAS int*)ts, F.G, F.bid, 4, ts[32] * 4, F.in[20], F.in[21], 2048, 512};
        pg8::EpiSwi E{WSP(pg8::bf16_t, WS_HID)};
#if MK_MOE_F32
        REPS(12) pg8::gemm_phase_bf32<pg8::EpiSwi, pg8::MoeOrder, true>(F.lds, g, S, E);
#else
        REPS(12) pg8::gemm_phase<pg8::EpiSwi, pg8::MoeOrder, true, true, true>(F.lds, g, S, E);
#endif
        SEAM(12);
    }
    if (IN(13)) {
        moe_tile_starts(F, ts);
        pg8::Gemm g{WSP(pg8::bf16_t, WS_HID), WSP(pg8::bf16_t, WS_WD), PMAX, 32 * 2048, 512};
        pg8::MoeOrder S{(const PG8_LAS int*)ts, F.G, F.bid, 8, ts[32] * 8, F.in[22], nullptr, 512, 2048};
        pg8::EpiB E{WSP(pg8::bf16_t, WS_YS), D, 7};
#if MK_MOE_F32
        REPS(13) pg8::gemm_phase_bf32<pg8::EpiB, pg8::MoeOrder, true>(F.lds, g, S, E);
#else
        REPS(13) pg8::gemm_phase<pg8::EpiB, pg8::MoeOrder, true, true>(F.lds, g, S, E);
#endif
        SEAM(13);
    }
    if (IN(14)) { REPS(14) p13_combine(F); }
#undef IN
#undef SEAM
#undef REPS
}

extern "C" void kernel_launch(void* const* d_in, const int* in_sizes, int n_in, void* d_out, int out_size, void* d_ws, size_t ws_size, hipStream_t stream) {
    static int grid = 0;
    if (grid == 0) {
        if (n_in != 25 || in_sizes[0] != T * D || out_size != T * D || ws_size < WS_END) { fprintf(stderr, "kernel_launch: unexpected shapes / workspace (%d inputs, ws %zu)\n", n_in, ws_size); grid = -1; return; }
        int dev = 0, cus = 0;
        if (hipGetDevice(&dev) != hipSuccess || hipDeviceGetAttribute(&cus, hipDeviceAttributeMultiprocessorCount, dev) != hipSuccess) { grid = -1; return; }
        if (hipFuncSetAttribute((const void*)mega, hipFuncAttributeMaxDynamicSharedMemorySize, LDS_BYTES) != hipSuccess) { fprintf(stderr, "kernel_launch: hipFuncSetAttribute failed\n"); grid = -1; return; }
        int per_cu = 0;
        if (hipOccupancyMaxActiveBlocksPerMultiprocessor(&per_cu, (const void*)mega, NTHR, LDS_BYTES) != hipSuccess || per_cu < 1) { fprintf(stderr, "kernel_launch: occupancy query failed / 0 blocks per CU\n"); grid = -1; return; }
        (void)hipGetLastError();
        grid = cus;
    }
    if (grid < 0) return;
    if (hipMemsetAsync((char*)d_ws + WS_CTL, 0, CTL_ZERO_BYTES, stream) != hipSuccess) return;
    Args a{};
    for (int i = 0; i < 25; ++i) a.in[i] = (const float*)d_in[i];
    a.out = (float*)d_out; a.ws = (unsigned char*)d_ws;
#if MK_ONE_LAUNCH
    a.ph_lo = 0; a.ph_hi = NPH; a.use_bar = 1;
#if MK_CG_SYNC
    { void* kargs[] = {(void*)&a};
      hipError_t e = hipLaunchCooperativeKernel((const void*)mega, dim3(grid), dim3(NTHR), kargs, LDS_BYTES, stream);
      if (e != hipSuccess) fprintf(stderr, "cooperative launch failed: %s (grid %d)\n", hipGetErrorString(e), grid); }
#else
    hipLaunchKernelGGL(mega, dim3(grid), dim3(NTHR), LDS_BYTES, stream, a);
#endif
#else
    for (int p = 0; p < NPH; ++p) { a.ph_lo = p; a.ph_hi = p + 1; a.use_bar = 0;
        hipLaunchKernelGGL(mega, dim3(grid), dim3(NTHR), LDS_BYTES, stream, a); }
#endif
}
```

```cpp
#include <hip/hip_runtime.h>
#include <hip/hip_cooperative_groups.h>
#include <cstdio>
#include <cstdint>
#include <cmath>
#ifndef MK_ONE_LAUNCH
#define MK_ONE_LAUNCH 1
#endif
#ifndef MK_CG_SYNC
#define MK_CG_SYNC 2
#endif
#ifndef MK_WT_STORES
#define MK_WT_STORES 0
#endif
#ifndef MK_MOE_F32
#define MK_MOE_F32 0
#endif
#define PROBE_PH -1
#define PROBE_N 1
namespace pg8 {
#define PG8_LAS __attribute__((address_space(3)))
typedef unsigned short bf16_t;
typedef short bf16x8 __attribute__((ext_vector_type(8)));
typedef float f32x4 __attribute__((ext_vector_type(4)));
typedef unsigned u32x4 __attribute__((ext_vector_type(4)));
constexpr int BM = 256, BK = 64, HALF = 128, HTB = HALF * BK * 2  , STAGE_BYTES = 8 * HTB, NXCD = 8, WGM = 8;

__host__ __device__ __forceinline__ int lds_byte(int r, int c) { const int st = (r >> 4) * 2 + (c >> 5), rr = r & 15, cc = c & 31, ob = rr * 64 + cc * 2; return st * 1024 + (ob ^ (((ob >> 9) & 1) << 5)); }
__host__ __device__ __forceinline__ void stage_rc(int b, int& R, int& C) { const int st = b / 1024, sb = b % 1024, swz = sb ^ (((sb >> 9) & 1) << 5); R = (st >> 1) * 16 + swz / 64; C = (st & 1) * 32 + (swz % 64) / 2; }
__host__ __device__ __forceinline__ int perm32(int rho) { const int n = rho >> 4, i = rho & 15; return 8 * (i >> 2) + 4 * n + (i & 3); }

struct Unit { int pm, pn; };
struct Gemm { const bf16_t* A; const bf16_t* Bt; int M, N, K; const int* tok; };

struct StaticOrder {
    int nM, nN, nwg, G, c;
    __host__ __device__ void init(int M, int N, int G_, int c_) { nM = M / BM; nN = N / BM; nwg = nM * nN; G = G_; c = c_; }
    __host__ __device__ bool next(int i, Unit& u) const {
        const long L = (long)i * G + c; if (L >= nwg) return false;
        int wgid = (int)L; { const int q = nwg / NXCD, r = nwg % NXCD, xcd = wgid % NXCD, off = wgid / NXCD; wgid = (xcd < r ? xcd * (q + 1) : r * (q + 1) + (xcd - r) * q) + off; }
        const int nig = WGM * nN, gid = wgid / nig, fm = gid * WGM, gsz = (nM - fm) < WGM ? (nM - fm) : WGM;
        u.pm = fm + ((wgid % nig) % gsz); u.pn = (wgid % nig) / gsz; return true;
    }
    __device__ __forceinline__ void a_ready(const Unit&) const {}
    __device__ __forceinline__ void done(const Unit&) const {}
};


typedef unsigned u32x2 __attribute__((ext_vector_type(2)));
__device__ __forceinline__ unsigned cvt_pk_bf16(float lo, float hi) { unsigned r; asm volatile("v_cvt_pk_bf16_f32 %0, %1, %2" : "=v"(r) : "v"(lo), "v"(hi)); return r; }
__device__ __forceinline__ u32x4 pack8(const f32x4 a, const f32x4 b) { u32x4 w; w.x = cvt_pk_bf16(a[0], a[1]); w.y = cvt_pk_bf16(a[2], a[3]); w.z = cvt_pk_bf16(b[0], b[1]); w.w = cvt_pk_bf16(b[2], b[3]); return w; }
#if MK_WT_STORES
#define PG8_RSRC(base, bytes) __builtin_amdgcn_make_buffer_rsrc((void*)(base), 0, (int)(bytes), 0x00020000)
#define PG8_ST16(rs, base, byteoff, val) __builtin_amdgcn_raw_buffer_store_b128(__builtin_bit_cast(u32x4, (val)), (rs), (unsigned)(byteoff), 0, 16)
#else
#define PG8_RSRC(base, bytes) 0
#define PG8_ST16(rs, base, byteoff, val) (*(u32x4*)((char*)(base) + (size_t)(byteoff)) = __builtin_bit_cast(u32x4, (val)))
#endif
__device__ __forceinline__ float silu_f(float x) { return x * __builtin_amdgcn_rcpf(1.0f + __builtin_amdgcn_exp2f(-1.4426950408889634f * x)); }

struct EpiH {
    static constexpr bool PERM = true, AFTER_DRAIN = false;
    bf16_t* H; bf16_t* KVM; const float* rc; const float* rs;
    __device__ __forceinline__ void operator()(const f32x4 (&acc)[2][2][4][2], const Unit& u, int wr, int wc, int fr, int fq) const {
        const int cb = wc * 32 + 8 * fq;
        const auto rsH = PG8_RSRC(H, 8192u * 7168u * 2u); (void)rsH;
        if (u.pm >= 32) {
#pragma unroll
            for (int ai = 0; ai < 2; ++ai)
#pragma unroll
                for (int m = 0; m < 4; ++m) { bf16_t* rowp = KVM + (size_t)(wr * 64 + fr + ai * HALF + m * 16) * 4096 + (u.pn - 28) * BM + cb;
#pragma unroll
                    for (int bj = 0; bj < 2; ++bj) *(u32x4*)(rowp + bj * HALF) = pack8(acc[ai][bj][m][0], acc[ai][bj][m][1]); }
            return;
        }
        const int row0 = u.pm * BM + wr * 64 + fr;
        if (u.pn < 8) {
            const float sc = u.pn >= 4 ? 0.0625f : 1.0f;
#pragma unroll
            for (int ai = 0; ai < 2; ++ai)
#pragma unroll
                for (int m = 0; m < 4; ++m) { const int row = row0 + ai * HALF + m * 16;
                    const float* cr = rc + (size_t)row * 128 + cb; const float* sr = rs + (size_t)row * 128 + cb;
                    const f32x4 c0 = *(const f32x4*)cr * sc, c1 = *(const f32x4*)(cr + 4) * sc, s0 = *(const f32x4*)sr * sc, s1 = *(const f32x4*)(sr + 4) * sc;
                    const f32x4 t1a = acc[ai][0][m][0], t1b = acc[ai][0][m][1], t2a = acc[ai][1][m][0], t2b = acc[ai][1][m][1];
                    bf16_t* rowp = H + (size_t)row * 7168 + u.pn * BM + cb;
                    const unsigned bo = (unsigned)((size_t)row * 7168 + u.pn * BM + cb) * 2u; (void)rowp;
                    PG8_ST16(rsH, H, bo, pack8(t1a * c0 - t2a * s0, t1b * c1 - t2b * s1));
                    PG8_ST16(rsH, H, bo + 2 * HALF, pack8(t1a * s0 + t2a * c0, t1b * s1 + t2b * c1)); }
        } else {
            const float sc = (u.pn == 16 || u.pn == 17) ? 0.08838834764831845f : 1.0f;
#pragma unroll
            for (int ai = 0; ai < 2; ++ai)
#pragma unroll
                for (int m = 0; m < 4; ++m) { const unsigned bo = (unsigned)((size_t)(row0 + ai * HALF + m * 16) * 7168 + u.pn * BM + cb) * 2u;
#pragma unroll
                    for (int bj = 0; bj < 2; ++bj) PG8_ST16(rsH, H, bo + bj * 2 * HALF, pack8(acc[ai][bj][m][0] * sc, acc[ai][bj][m][1] * sc)); }
        }
    }
};
struct EpiB {
    static constexpr bool PERM = true, AFTER_DRAIN = false;
    bf16_t* O; int ldc; int pmask; unsigned obytes;
    __device__ __forceinline__ void operator()(const f32x4 (&acc)[2][2][4][2], const Unit& u, int wr, int wc, int fr, int fq) const {
        const int row0 = u.pm * BM + wr * 64 + fr, col0 = (u.pn & pmask) * BM + wc * 32 + 8 * fq;
        const auto rsO = PG8_RSRC(O, obytes); (void)rsO;
#pragma unroll
        for (int ai = 0; ai < 2; ++ai)
#pragma unroll
            for (int m = 0; m < 4; ++m) { const unsigned bo = (unsigned)((size_t)(row0 + ai * HALF + m * 16) * ldc + col0) * 2u;
#pragma unroll
                for (int bj = 0; bj < 2; ++bj) PG8_ST16(rsO, O, bo + bj * 2 * HALF, pack8(acc[ai][bj][m][0], acc[ai][bj][m][1])); }
    }
};
struct EpiSwi {
    static constexpr bool PERM = true, AFTER_DRAIN = false;
    bf16_t* O;
    __device__ __forceinline__ void operator()(const f32x4 (&acc)[2][2][4][2], const Unit& u, int wr, int wc, int fr, int fq) const {
        const int row0 = u.pm * BM + wr * 64 + fr, col0 = (u.pn & 3) * HALF + wc * 32 + 8 * fq;
        const auto rsO = PG8_RSRC(O, 24576u * 512u * 2u); (void)rsO;
#pragma unroll
        for (int ai = 0; ai < 2; ++ai)
#pragma unroll
            for (int m = 0; m < 4; ++m) { const unsigned bo = (unsigned)((size_t)(row0 + ai * HALF + m * 16) * 512 + col0) * 2u;
                f32x4 h0, h1;
#pragma unroll
                for (int i = 0; i < 4; ++i) { h0[i] = silu_f(acc[ai][0][m][0][i]) * acc[ai][1][m][0][i]; h1[i] = silu_f(acc[ai][0][m][1][i]) * acc[ai][1][m][1][i]; }
                PG8_ST16(rsO, O, bo, pack8(h0, h1)); }
    }
};
struct EpiResX {
    static constexpr bool PERM = false, AFTER_DRAIN = false;
    const float* X; float* Y; float alpha;
    __device__ __forceinline__ void operator()(const f32x4 (&acc)[2][2][4][2], const Unit& u, int wr, int wc, int fr, int fq) const {
        const int row0 = u.pm * BM + wr * 64 + fr, col0 = u.pn * BM + wc * 32 + 4 * fq;
        const auto rsY = PG8_RSRC(Y, 8192u * 2048u * 4u); (void)rsY;
#pragma unroll
        for (int ai = 0; ai < 2; ++ai)
#pragma unroll
            for (int m = 0; m < 4; ++m) { const size_t off = (size_t)(row0 + ai * HALF + m * 16) * 2048 + col0;
#pragma unroll
                for (int bj = 0; bj < 2; ++bj)
#pragma unroll
                    for (int n = 0; n < 2; ++n) { const f32x4 xv = *(const f32x4*)(X + off + bj * HALF + n * 16); const f32x4 yv = xv * alpha + acc[ai][bj][m][n]; PG8_ST16(rsY, Y, (off + bj * HALF + n * 16) * 4, yv); } }
    }
};
struct EpiResLN {
    static constexpr bool PERM = false, AFTER_DRAIN = false;
    const float* Yin; const float* st; const float* g; const float* b; float* Y; float alpha;
    __device__ __forceinline__ void operator()(const f32x4 (&acc)[2][2][4][2], const Unit& u, int wr, int wc, int fr, int fq) const {
        const int row0 = u.pm * BM + wr * 64 + fr, col0 = u.pn * BM + wc * 32 + 4 * fq;
        const auto rsY = PG8_RSRC(Y, 8192u * 2048u * 4u); (void)rsY;
        f32x4 gv[2][2], bv[2][2];
#pragma unroll
        for (int bj = 0; bj < 2; ++bj)
#pragma unroll
            for (int n = 0; n < 2; ++n) { gv[bj][n] = *(const f32x4*)(g + col0 + bj * HALF + n * 16) * alpha; bv[bj][n] = *(const f32x4*)(b + col0 + bj * HALF + n * 16) * alpha; }
#pragma unroll
        for (int ai = 0; ai < 2; ++ai)
#pragma unroll
            for (int m = 0; m < 4; ++m) { const int row = row0 + ai * HALF + m * 16; const size_t off = (size_t)row * 2048 + col0;
                const float mu = st[2 * row], rstd = st[2 * row + 1];
#pragma unroll
                for (int bj = 0; bj < 2; ++bj)
#pragma unroll
                    for (int n = 0; n < 2; ++n) { const f32x4 yv = *(const f32x4*)(Yin + off + bj * HALF + n * 16);
                        const f32x4 yo = ((yv - mu) * rstd) * gv[bj][n] + bv[bj][n] + acc[ai][bj][m][n]; PG8_ST16(rsY, Y, (off + bj * HALF + n * 16) * 4, yo); } }
    }
};

struct OrderG1 {
    StaticOrder so; int G, c;
    __device__ void init(int G_, int c_) { so.init(8192, 7168, G_, c_); G = G_; c = c_; }
    __device__ bool next(int i, Unit& u) const {
        const int L = i * G + c;
        if (L < 896) return so.next(i, u);
        if (L >= 912) return false;
        u.pm = 32; u.pn = 28 + (L - 896); return true;
    }
    __device__ __forceinline__ void a_ready(const Unit&) const {}
    __device__ __forceinline__ void done(const Unit&) const {}
};
struct MoeOrder {
    const PG8_LAS int* ts; int G, c, npn, total; const float* W0; const float* W1; int kdim, ncols; int L0;
    __device__ bool next(int i, Unit& u) const {
        if (c < 0) return false;
        const int L = L0 + i * G + c; if (L >= total) return false;
        const int rt = L / npn, pl = L - rt * npn; int e = 0;
        for (int j = 1; j < 32; ++j) e += (ts[j] <= rt) ? 1 : 0;
        u.pm = rt; u.pn = e * npn + pl; return true;
    }
    __device__ __forceinline__ int ldb() const { return ncols; }
    __device__ __forceinline__ const float* bbase(const Unit& u, int which) const {
        const int e = u.pn / npn, pl = u.pn - e * npn; const size_t eo = (size_t)e * kdim * ncols;
        if (W1) return (which ? W1 : W0) + eo + 128 * pl;
        return W0 + eo + 256 * pl;
    }
    __device__ __forceinline__ void a_ready(const Unit&) const {}
    __device__ __forceinline__ void done(const Unit&) const {}
};

template <int MODE>
struct EpiLN {
    static constexpr bool PERM = false, AFTER_DRAIN = true;
    const float* X; const float* stin; const float* gin; const float* bin;
    float* Yout; float* stout; bf16_t* HB; const float* g; const float* b;
    unsigned long long* xbuf;
    unsigned* cnt;
    __device__ __forceinline__ void operator()(const f32x4 (&)[2][2][4][2], const Unit&, int, int, int, int) const {}
    __device__ __forceinline__ void fused(f32x4 (&acc)[2][2][4][2], const Unit& u, int wr, int wc, int fr, int fq, PG8_LAS unsigned char* lds, int wid, int lane) const {
        typedef float f32x2v __attribute__((ext_vector_type(2)));
        PG8_LAS f32x2v* P = (PG8_LAS f32x2v*)lds;
        PG8_LAS f32x2v* MS = (PG8_LAS f32x2v*)(lds + 8192);
        const int row0 = u.pm * BM + wr * 64 + fr, col0 = u.pn * BM + wc * 32 + 4 * fq;
        float s1[2][4], s2[2][4], mu[2][4], rs[2][4];
#pragma unroll
        for (int ai = 0; ai < 2; ++ai)
#pragma unroll
            for (int m = 0; m < 4; ++m) { s1[ai][m] = 0.f; s2[ai][m] = 0.f; mu[ai][m] = 0.f; rs[ai][m] = 0.f;
                if (MODE == 1) { const int row = row0 + ai * HALF + m * 16; mu[ai][m] = stin[2 * row]; rs[ai][m] = stin[2 * row + 1]; } }
#pragma unroll
        for (int bj = 0; bj < 2; ++bj)
#pragma unroll
            for (int n = 0; n < 2; ++n) {
                f32x4 gvv = {0.f, 0.f, 0.f, 0.f}, bvv = gvv;
                if (MODE == 1) { gvv = *(const f32x4*)(gin + col0 + bj * HALF + n * 16) * 1.189207115002721f; bvv = *(const f32x4*)(bin + col0 + bj * HALF + n * 16) * 1.189207115002721f; }
#pragma unroll
                for (int ai = 0; ai < 2; ++ai)
#pragma unroll
                    for (int m = 0; m < 4; ++m) { const size_t off = (size_t)(row0 + ai * HALF + m * 16) * 2048 + col0 + bj * HALF + n * 16;
                        const f32x4 xv = *(const f32x4*)(X + off);
                        const f32x4 y = (MODE == 1 ? ((xv - mu[ai][m]) * rs[ai][m]) * gvv + bvv : xv * 1.189207115002721f) + acc[ai][bj][m][n];
                        acc[ai][bj][m][n] = y; *(f32x4*)(Yout + off) = y;
                        s1[ai][m] += (y[0] + y[1]) + (y[2] + y[3]); s2[ai][m] += (y[0] * y[0] + y[1] * y[1]) + (y[2] * y[2] + y[3] * y[3]); }
            }
#pragma unroll
        for (int ai = 0; ai < 2; ++ai)
#pragma unroll
            for (int m = 0; m < 4; ++m) { float a1 = s1[ai][m], a2 = s2[ai][m];
                a1 += __shfl_xor(a1, 16); a1 += __shfl_xor(a1, 32); a2 += __shfl_xor(a2, 16); a2 += __shfl_xor(a2, 32);
                if (fq == 0) P[(ai * HALF + wr * 64 + m * 16 + fr) * 4 + wc] = (f32x2v){a1, a2}; }
        asm volatile("s_waitcnt lgkmcnt(0)" ::: "memory"); __builtin_amdgcn_s_barrier(); asm volatile("" ::: "memory");
        const int t = wid * 64 + lane;
        if (t < 256) { const f32x2v a = P[t * 4 + 0], b2 = P[t * 4 + 1], c = P[t * 4 + 2], d = P[t * 4 + 3];
            const float S1 = (a.x + b2.x) + (c.x + d.x), S2 = (a.y + b2.y) + (c.y + d.y);
            __hip_atomic_store(xbuf + ((size_t)(u.pm * 8 + u.pn) * 256 + t), ((unsigned long long)__float_as_uint(S2) << 32) | __float_as_uint(S1), __ATOMIC_RELAXED, __HIP_MEMORY_SCOPE_AGENT);
            asm volatile("s_waitcnt vmcnt(0)" ::: "memory");
            if (lane == 0) __hip_atomic_fetch_add(cnt + 64 * u.pm, 1u, __ATOMIC_RELAXED, __HIP_MEMORY_SCOPE_AGENT); }
        if (wid == 0) {
            const unsigned long long t0 = __builtin_amdgcn_s_memrealtime();
            while ((unsigned)__builtin_amdgcn_readfirstlane(__hip_atomic_load(cnt + 64 * u.pm, __ATOMIC_RELAXED, __HIP_MEMORY_SCOPE_AGENT)) < 32u) {
                if (__builtin_amdgcn_s_memrealtime() - t0 > 2000000ull) break;
                __builtin_amdgcn_s_sleep(2); }
            __builtin_amdgcn_fence(__ATOMIC_ACQUIRE, "agent");
        }
        asm volatile("s_waitcnt vmcnt(0) lgkmcnt(0)" ::: "memory"); __builtin_amdgcn_s_barrier(); asm volatile("" ::: "memory");
        if (t < 256) { float S1 = 0.f, S2 = 0.f;
#pragma unroll
            for (int j = 0; j < 8; ++j) { const unsigned long long w = __hip_atomic_load(xbuf + ((size_t)(u.pm * 8 + j) * 256 + t), __ATOMIC_RELAXED, __HIP_MEMORY_SCOPE_AGENT); S1 += __uint_as_float((unsigned)w); S2 += __uint_as_float((unsigned)(w >> 32)); }
            const float mean = S1 * (1.f / 2048.f), var = fmaxf(S2 * (1.f / 2048.f) - mean * mean, 0.f), rstd = 1.0f / sqrtf(var + 1e-5f);
            MS[t] = (f32x2v){mean, rstd};
            if (u.pn == 0) { stout[2 * (u.pm * BM + t)] = mean; stout[2 * (u.pm * BM + t) + 1] = rstd; } }
        asm volatile("s_waitcnt lgkmcnt(0)" ::: "memory"); __builtin_amdgcn_s_barrier(); asm volatile("" ::: "memory");
#pragma unroll
        for (int bj = 0; bj < 2; ++bj)
#pragma unroll
            for (int n = 0; n < 2; ++n) { const f32x4 gN = *(const f32x4*)(g + col0 + bj * HALF + n * 16), bN = *(const f32x4*)(b + col0 + bj * HALF + n * 16);
#pragma unroll
                for (int ai = 0; ai < 2; ++ai)
#pragma unroll
                    for (int m = 0; m < 4; ++m) { const int rl = ai * HALF + wr * 64 + m * 16 + fr; const f32x2v ms = MS[rl]; const size_t off = (size_t)(u.pm * BM + rl) * 2048 + col0 + bj * HALF + n * 16;
                        const f32x4 h = ((acc[ai][bj][m][n] - ms.x) * ms.y) * gN + bN;
                        u32x2 w; w.x = cvt_pk_bf16(h[0], h[1]); w.y = cvt_pk_bf16(h[2], h[3]); *(u32x2*)(HB + off) = w; } }
    }
};
template <class Epi, class Sched, bool ALIGN_EPI = false, bool SP2 = false, bool GATHER = false>
__device__ __forceinline__ void gemm_phase(PG8_LAS unsigned char* lds, const Gemm g, const Sched& S, const Epi& E) {
    const int tid = threadIdx.x, wid = __builtin_amdgcn_readfirstlane(tid >> 6), lane = tid & 63, wr = wid >> 2, wc = wid & 3, fr = lane & 15, fq = lane >> 4;
    const int K = g.K, nt = K / BK;
    unsigned voffA[2], voffB[2];
#pragma unroll
    for (int i = 0; i < 2; ++i) { int R, C; stage_rc(tid * 16 + i * 8192, R, C); const int Rb = Epi::PERM ? ((R & ~31) + perm32(R & 31)) : R;
        voffA[i] = (unsigned)(R * K + C) * 2u; voffB[i] = (unsigned)(Rb * K + C) * 2u; }
    unsigned coff[2][2], noff[2][2]; int gR[2], gC[2];
#pragma unroll
    for (int i = 0; i < 2; ++i) { int R, C; stage_rc(tid * 16 + i * 8192, R, C); gR[i] = R; gC[i] = C; coff[0][i] = coff[1][i] = noff[0][i] = noff[1][i] = 0u; }
#define PG8_GOFF(dst, pm_) do { if constexpr (GATHER) { _Pragma("unroll") for (int _h = 0; _h < 2; ++_h) _Pragma("unroll") for (int _i = 0; _i < 2; ++_i) \
        dst[_h][_i] = ((unsigned)g.tok[(pm_) * BM + _h * HALF + gR[_i]] * (unsigned)K + (unsigned)gC[_i]) * 2u; } } while (0)
    const size_t kstep = (size_t)(BK * 2);
    const size_t hstep = (size_t)HALF * K * 2;
    const size_t tstep = 2 * hstep;
    const unsigned ldsw = (unsigned)wid * 1024u;
    const int aoff = lds_byte(wr * 64 + fr, fq * 8), boff = lds_byte(wc * 32 + fr, fq * 8);
#define PG8_SA(b, h) (((b) * 2 + (h)) * HTB)
#define PG8_SB(b, h) ((4 + (b) * 2 + (h)) * HTB)
#define PG8_STAGE(bufoff, gbase, voff) do { _Pragma("unroll") for (int _i = 0; _i < 2; ++_i) \
        __builtin_amdgcn_global_load_lds((const unsigned*)((const char*)(gbase) + (voff)[_i]), (PG8_LAS unsigned*)(lds + (bufoff) + ldsw + _i * 8192), 16, 0, 0); } while (0)
#define PG8_STAGEA(bufoff, gptr, hh, kbytes, usenext) do { if constexpr (GATHER) { _Pragma("unroll") for (int _i = 0; _i < 2; ++_i) { const unsigned _o = (usenext) ? noff[hh][_i] : coff[hh][_i]; \
        __builtin_amdgcn_global_load_lds((const unsigned*)((const char*)g.A + (size_t)(kbytes) + _o), (PG8_LAS unsigned*)(lds + (bufoff) + ldsw + _i * 8192), 16, 0, 0); } } else { PG8_STAGE(bufoff, gptr, voffA); } } while (0)
#define PG8_LDA(dst, b, h) do { _Pragma("unroll") for (int m = 0; m < 4; ++m) _Pragma("unroll") for (int k = 0; k < 2; ++k) dst[m][k] = *(const PG8_LAS bf16x8*)(lds + PG8_SA(b, h) + aoff + m * 2048 + k * 1024); } while (0)
#define PG8_LDB(dst, b, h) do { _Pragma("unroll") for (int n = 0; n < 2; ++n) _Pragma("unroll") for (int k = 0; k < 2; ++k) dst[n][k] = *(const PG8_LAS bf16x8*)(lds + PG8_SB(b, h) + boff + n * 2048 + k * 1024); } while (0)
#define PG8_MMA(ai, bj, At, Bt) do { __builtin_amdgcn_s_setprio(1); _Pragma("unroll") for (int m = 0; m < 4; ++m) _Pragma("unroll") for (int n = 0; n < 2; ++n) _Pragma("unroll") for (int k = 0; k < 2; ++k) \
        acc[ai][bj][m][n] = __builtin_amdgcn_mfma_f32_16x16x32_bf16(Bt[n][k], At[m][k], acc[ai][bj][m][n], 0, 0, 0); __builtin_amdgcn_s_setprio(0); } while (0)
#define PG8_WAIT_V(n) asm volatile("s_waitcnt vmcnt(" #n ")" ::: "memory")
#define PG8_WAIT_L(n) asm volatile("s_waitcnt lgkmcnt(" #n ")" ::: "memory")
#define PG8_BAR __builtin_amdgcn_s_barrier()
#define PG8_SCHED __builtin_amdgcn_sched_barrier(0)
    Unit cur, nxt; int ui = 0;
    if (!S.next(0, cur)) return;
    f32x4 acc[2][2][4][2];
#pragma unroll
    for (int a = 0; a < 2; ++a)
#pragma unroll
        for (int b = 0; b < 2; ++b)
#pragma unroll
            for (int m = 0; m < 4; ++m)
#pragma unroll
                for (int n = 0; n < 2; ++n) acc[a][b][m][n] = (f32x4){0.f, 0.f, 0.f, 0.f};
    bf16x8 At[4][2], B0[2][2], B1[2][2];
    const char* cA = (const char*)g.A + (size_t)cur.pm * tstep; const char* cB = (const char*)g.Bt + (size_t)cur.pn * tstep;
    PG8_GOFF(coff, cur.pm);
    S.a_ready(cur);
    if constexpr (SP2) {
        PG8_STAGE(PG8_SB(0, 0), cB, voffB); PG8_STAGE(PG8_SB(0, 1), cB + hstep, voffB); PG8_STAGEA(PG8_SA(0, 0), cA, 0, 0, false); PG8_STAGEA(PG8_SA(0, 1), cA + hstep, 1, 0, false);
        if (wr == 1) PG8_BAR;
        PG8_WAIT_V(2); PG8_BAR;
        PG8_STAGE(PG8_SB(1, 0), cB + kstep, voffB); PG8_STAGEA(PG8_SA(1, 0), cA + kstep, 0, kstep, false); PG8_STAGE(PG8_SB(1, 1), cB + hstep + kstep, voffB);
        PG8_WAIT_V(6); PG8_BAR;
    } else {
        PG8_STAGE(PG8_SB(0, 0), cB, voffB); PG8_STAGE(PG8_SA(0, 0), cA, voffA); PG8_STAGE(PG8_SB(0, 1), cB + hstep, voffB); PG8_STAGE(PG8_SA(0, 1), cA + hstep, voffA);
        if (wr == 1) PG8_BAR;
        PG8_WAIT_V(4); PG8_BAR;
        PG8_STAGE(PG8_SB(1, 0), cB + kstep, voffB); PG8_STAGE(PG8_SA(1, 0), cA + kstep, voffA); PG8_STAGE(PG8_SB(1, 1), cB + hstep + kstep, voffB);
        PG8_WAIT_V(6); PG8_BAR;
    }
    for (;;) {
        const bool has_next = S.next(ui + 1, nxt);
        const char* nA = has_next ? (const char*)g.A + (size_t)nxt.pm * tstep : cA; const char* nB = has_next ? (const char*)g.Bt + (size_t)nxt.pn * tstep : cB;
        if constexpr (GATHER) { if (has_next) { PG8_GOFF(noff, nxt.pm); } else { _Pragma("unroll") for (int _h = 0; _h < 2; ++_h) _Pragma("unroll") for (int _i = 0; _i < 2; ++_i) noff[_h][_i] = coff[_h][_i]; } }
        for (int t = 0; t < nt; t += 2) {
            const bool last = (t == nt - 2);
            const char* a1 = cA + (size_t)(t + 1) * kstep;
            const char* a2 = last ? nA : cA + (size_t)(t + 2) * kstep; const char* b2 = last ? nB : cB + (size_t)(t + 2) * kstep;
            const char* a3 = a2 + kstep; const char* b3 = b2 + kstep;
            const size_t k1 = (size_t)(t + 1) * kstep, k2 = last ? 0 : (size_t)(t + 2) * kstep, k3 = k2 + kstep;
            if (last && has_next) S.a_ready(nxt);
            if constexpr (SP2) {
            PG8_LDB(B0, 0, 0); PG8_LDB(B1, 0, 1); PG8_SCHED; PG8_LDA(At, 0, 0); PG8_STAGEA(PG8_SA(1, 1), a1 + hstep, 1, k1, false);
            PG8_WAIT_V(8); PG8_WAIT_L(0); PG8_BAR; PG8_MMA(0, 0, At, B0); PG8_MMA(0, 1, At, B1); PG8_BAR; PG8_SCHED;
            PG8_LDA(At, 0, 1); PG8_STAGE(PG8_SB(0, 0), b2, voffB); PG8_STAGE(PG8_SB(0, 1), b2 + hstep, voffB); PG8_STAGEA(PG8_SA(0, 0), a2, 0, k2, last);
            PG8_WAIT_V(8); PG8_WAIT_L(0); PG8_BAR; PG8_MMA(1, 0, At, B0); PG8_MMA(1, 1, At, B1); PG8_BAR; PG8_SCHED;
            PG8_LDB(B0, 1, 0); PG8_LDB(B1, 1, 1); PG8_SCHED; PG8_LDA(At, 1, 0); PG8_STAGEA(PG8_SA(0, 1), a2 + hstep, 1, k2, last);
            PG8_WAIT_V(8); PG8_WAIT_L(0); PG8_BAR; PG8_MMA(0, 0, At, B0); PG8_MMA(0, 1, At, B1); PG8_BAR; PG8_SCHED;
            PG8_LDA(At, 1, 1); PG8_STAGE(PG8_SB(1, 0), b3, voffB); PG8_STAGE(PG8_SB(1, 1), b3 + hstep, voffB); PG8_STAGEA(PG8_SA(1, 0), a3, 0, k3, last);
            PG8_WAIT_V(8); PG8_WAIT_L(0); PG8_BAR; PG8_MMA(1, 0, At, B0); PG8_MMA(1, 1, At, B1); PG8_BAR; PG8_SCHED;
            } else {
            PG8_LDB(B0, 0, 0); PG8_SCHED; PG8_LDA(At, 0, 0); PG8_STAGE(PG8_SA(1, 1), a1 + hstep, voffA);
            PG8_WAIT_L(8); PG8_BAR; PG8_WAIT_L(0); PG8_MMA(0, 0, At, B0); PG8_BAR; PG8_SCHED;
            PG8_LDB(B1, 0, 1); PG8_STAGE(PG8_SB(0, 0), b2, voffB);
            PG8_BAR; PG8_WAIT_L(0); PG8_MMA(0, 1, At, B1); PG8_BAR;
            PG8_LDA(At, 0, 1); PG8_STAGE(PG8_SA(0, 0), a2, voffA);
            PG8_BAR; PG8_WAIT_L(0); PG8_MMA(1, 0, At, B0); PG8_BAR; PG8_SCHED;
            PG8_STAGE(PG8_SB(0, 1), b2 + hstep, voffB);
            PG8_WAIT_V(6); PG8_BAR; PG8_MMA(1, 1, At, B1); PG8_BAR;
            PG8_LDB(B0, 1, 0); PG8_SCHED; PG8_LDA(At, 1, 0); PG8_STAGE(PG8_SA(0, 1), a2 + hstep, voffA);
            PG8_WAIT_L(8); PG8_BAR; PG8_WAIT_L(0); PG8_MMA(0, 0, At, B0); PG8_BAR; PG8_SCHED;
            PG8_LDB(B1, 1, 1); PG8_STAGE(PG8_SB(1, 0), b3, voffB);
            PG8_BAR; PG8_WAIT_L(0); PG8_MMA(0, 1, At, B1); PG8_BAR;
            PG8_LDA(At, 1, 1); PG8_STAGE(PG8_SA(1, 0), a3, voffA);
            PG8_BAR; PG8_WAIT_L(0); PG8_MMA(1, 0, At, B0); PG8_BAR; PG8_SCHED;
            PG8_STAGE(PG8_SB(1, 1), b3 + hstep, voffB);
            PG8_WAIT_V(6); PG8_BAR; PG8_MMA(1, 1, At, B1); PG8_BAR;
            }
        }
        if constexpr (ALIGN_EPI) { if (wr == 0) PG8_BAR; }
        if constexpr (!Epi::AFTER_DRAIN) { E(acc, cur, wr, wc, fr, fq); S.done(cur); }
        if (!has_next) break;
#pragma unroll
        for (int a = 0; a < 2; ++a)
#pragma unroll
            for (int b = 0; b < 2; ++b)
#pragma unroll
                for (int m = 0; m < 4; ++m)
#pragma unroll
                    for (int n = 0; n < 2; ++n) acc[a][b][m][n] = (f32x4){0.f, 0.f, 0.f, 0.f};
        cur = nxt; cA = nA; cB = nB; ++ui;
        if constexpr (GATHER) { _Pragma("unroll") for (int _h = 0; _h < 2; ++_h) _Pragma("unroll") for (int _i = 0; _i < 2; ++_i) coff[_h][_i] = noff[_h][_i]; }
        if constexpr (ALIGN_EPI) { if (wr == 1) PG8_BAR; }
    }
    PG8_WAIT_V(0);
    if constexpr (!ALIGN_EPI) { if (wr == 0) PG8_BAR; }
    PG8_BAR;
    if constexpr (Epi::AFTER_DRAIN) { E.fused(acc, cur, wr, wc, fr, fq, lds, wid, lane); S.done(cur); }
#undef PG8_SA
#undef PG8_SB
#undef PG8_STAGE
#undef PG8_STAGEA
#undef PG8_GOFF
#undef PG8_LDA
#undef PG8_LDB
#undef PG8_MMA
#undef PG8_WAIT_V
#undef PG8_WAIT_L
#undef PG8_BAR
#undef PG8_SCHED
}
constexpr int PBI = 544, SBI_BYTES = 64 * PBI;
template <class Epi, class Sched, bool ALIGN_EPI = false, bool GATHER = false, bool SPLIT = false>
__device__ __forceinline__ void gemm_phase_bf32(PG8_LAS unsigned char* lds, const Gemm g, const Sched& S, const Epi& E) {
    const int tid = threadIdx.x, wid = __builtin_amdgcn_readfirstlane(tid >> 6), lane = tid & 63, wr = wid >> 2, wc = wid & 3, fr = lane & 15, fq = lane >> 4;
    const int K = g.K, nt = K / BK;
    unsigned voffA[2];
#pragma unroll
    for (int i = 0; i < 2; ++i) { int R, C; stage_rc(tid * 16 + i * 8192, R, C); voffA[i] = (unsigned)(R * K + C) * 2u; }
    unsigned coff[2][2], noff[2][2]; int gR[2], gC[2];
#pragma unroll
    for (int i = 0; i < 2; ++i) { int R, C; stage_rc(tid * 16 + i * 8192, R, C); gR[i] = R; gC[i] = C; coff[0][i] = coff[1][i] = noff[0][i] = noff[1][i] = 0u; }
#define PG8_GOFF(dst, pm_) do { if constexpr (GATHER) { _Pragma("unroll") for (int _h = 0; _h < 2; ++_h) _Pragma("unroll") for (int _i = 0; _i < 2; ++_i) \
        dst[_h][_i] = ((unsigned)g.tok[(pm_) * BM + _h * HALF + gR[_i]] * (unsigned)K + (unsigned)gC[_i]) * 2u; } } while (0)
    const size_t kstep = (size_t)(BK * 2), hstep = (size_t)HALF * K * 2, tstep = 2 * hstep;
    const unsigned ldsw = (unsigned)wid * 1024u;
    const int aoff = lds_byte(wr * 64 + fr, fq * 8);
    const int ldb = S.ldb();
    const size_t bkstep = (size_t)BK * ldb;
    const int q4 = (lane >> 2) & 3, p4 = lane & 3;
    const unsigned lo = SPLIT ? (unsigned)((lane >> 5) * ldb + 4 * (lane & 31)) * 4u : (unsigned)lane * 16u;
    const unsigned bwoff = SPLIT ? (unsigned)(8 * wid + (lane >> 5)) * PBI + (unsigned)(((4 * (lane & 31)) ^ ((wid & 1) << 6)) * 2)
                                 : (unsigned)(8 * wid) * PBI + (unsigned)(((4 * lane) ^ ((wid & 1) << 6)) * 2);
    unsigned broff[2][2];
#pragma unroll
    for (int n = 0; n < 2; ++n)
#pragma unroll
        for (int k = 0; k < 2; ++k) { const int row = 32 * k + 8 * fq + q4, col = 32 * wc + (Epi::PERM ? 8 * p4 + 4 * n : 16 * n + 4 * p4);
            broff[n][k] = (unsigned)row * PBI + (unsigned)((col ^ ((row & 8) << 3)) * 2); }
#define PG8_SA(b, h) (((b) * 2 + (h)) * HTB)
#define PG8_SBI(b) (4 * HTB + (b) * SBI_BYTES)
#define PG8_STAGE(bufoff, gbase, voff) do { _Pragma("unroll") for (int _i = 0; _i < 2; ++_i) \
        __builtin_amdgcn_global_load_lds((const unsigned*)((const char*)(gbase) + (voff)[_i]), (PG8_LAS unsigned*)(lds + (bufoff) + ldsw + _i * 8192), 16, 0, 0); } while (0)
#define PG8_STAGEA(bufoff, gptr, hh, kbytes, usenext) do { if constexpr (GATHER) { _Pragma("unroll") for (int _i = 0; _i < 2; ++_i) { const unsigned _o = (usenext) ? noff[hh][_i] : coff[hh][_i]; \
        __builtin_amdgcn_global_load_lds((const unsigned*)((const char*)g.A + (size_t)(kbytes) + _o), (PG8_LAS unsigned*)(lds + (bufoff) + ldsw + _i * 8192), 16, 0, 0); } } else { PG8_STAGE(bufoff, gptr, voffA); } } while (0)
#define PG8_LDA(dst, b, h) do { _Pragma("unroll") for (int m = 0; m < 4; ++m) _Pragma("unroll") for (int k = 0; k < 2; ++k) dst[m][k] = *(const PG8_LAS bf16x8*)(lds + PG8_SA(b, h) + aoff + m * 2048 + k * 1024); } while (0)
#define PG8_LDBT(dst, b, h) do { _Pragma("unroll") for (int n = 0; n < 2; ++n) _Pragma("unroll") for (int k = 0; k < 2; ++k) { \
        const PG8_LAS unsigned char* _a = lds + PG8_SBI(b) + broff[n][k] + (h) * 256; \
        const s16x4 _lo = __builtin_bit_cast(s16x4, __builtin_amdgcn_ds_read_tr16_b64_v4i16((PG8_LAS s16x4*)_a)), _hi = __builtin_bit_cast(s16x4, __builtin_amdgcn_ds_read_tr16_b64_v4i16((PG8_LAS s16x4*)(_a + 4 * PBI))); \
        dst[n][k] = __builtin_shufflevector(_lo, _hi, 0, 1, 2, 3, 4, 5, 6, 7); } } while (0)
#define PG8_BLOAD(p0, p1) do { _Pragma("unroll") for (int _i = 0; _i < 8; ++_i) { \
        const float* _u = SPLIT ? ((_i < 4 ? (p0) : (p1)) + (size_t)(8 * wid + 2 * (_i & 3)) * ldb) : ((p0) + (size_t)(8 * wid + _i) * ldb); \
        breg[_i] = *(const __attribute__((address_space(1))) f32x4*)((const char*)_u + lo); } } while (0)
#define PG8_BWRITE(b) do { _Pragma("unroll") for (int _i = 0; _i < 8; ++_i) { u32x2 _w; _w.x = cvt_pk_bf16(breg[_i][0], breg[_i][1]); _w.y = cvt_pk_bf16(breg[_i][2], breg[_i][3]); \
        *(PG8_LAS u32x2*)(lds + PG8_SBI(b) + bwoff + (SPLIT ? (2 * (_i & 3)) * PBI + (_i >> 2) * 256 : _i * PBI)) = _w; } } while (0)
#define PG8_MMA(ai, bj, At, Bt) do { __builtin_amdgcn_s_setprio(1); _Pragma("unroll") for (int m = 0; m < 4; ++m) _Pragma("unroll") for (int n = 0; n < 2; ++n) _Pragma("unroll") for (int k = 0; k < 2; ++k) \
        acc[ai][bj][m][n] = __builtin_amdgcn_mfma_f32_16x16x32_bf16(Bt[n][k], At[m][k], acc[ai][bj][m][n], 0, 0, 0); __builtin_amdgcn_s_setprio(0); } while (0)
#define PG8_WAIT_V(n) asm volatile("s_waitcnt vmcnt(" #n ")" ::: "memory")
#define PG8_WAIT_L(n) asm volatile("s_waitcnt lgkmcnt(" #n ")" ::: "memory")
#define PG8_BAR __builtin_amdgcn_s_barrier()
#define PG8_SCHED __builtin_amdgcn_sched_barrier(0)
    typedef short s16x4 __attribute__((ext_vector_type(4)));
    typedef unsigned u32x2 __attribute__((ext_vector_type(2)));
    Unit cur, nxt; int ui = 0;
    if (!S.next(0, cur)) return;
    f32x4 acc[2][2][4][2];
#pragma unroll
    for (int a = 0; a < 2; ++a)
#pragma unroll
        for (int b = 0; b < 2; ++b)
#pragma unroll
            for (int m = 0; m < 4; ++m)
#pragma unroll
                for (int n = 0; n < 2; ++n) acc[a][b][m][n] = (f32x4){0.f, 0.f, 0.f, 0.f};
    bf16x8 At[4][2], B0[2][2];
    f32x4 breg[8];
    const char* cA = (const char*)g.A + (size_t)cur.pm * tstep; const float* cB0 = S.bbase(cur, 0); const float* cB1 = S.bbase(cur, 1);
    PG8_GOFF(coff, cur.pm);
    PG8_BLOAD(cB0, cB1); PG8_STAGEA(PG8_SA(0, 0), cA, 0, 0, false); PG8_STAGEA(PG8_SA(0, 1), cA + hstep, 1, 0, false);
    PG8_BWRITE(0); PG8_SCHED;
    if (wr == 1) PG8_BAR;
    PG8_WAIT_V(2); PG8_WAIT_L(0); PG8_BAR;
    PG8_BLOAD(cB0 + bkstep, cB1 + bkstep); PG8_STAGEA(PG8_SA(1, 0), cA + kstep, 0, kstep, false); PG8_SCHED;
    PG8_WAIT_V(10); PG8_BAR;
    for (;;) {
        const bool has_next = S.next(ui + 1, nxt);
        const char* nA = has_next ? (const char*)g.A + (size_t)nxt.pm * tstep : cA; const float* nB0 = has_next ? S.bbase(nxt, 0) : cB0; const float* nB1 = has_next ? S.bbase(nxt, 1) : cB1;
        if constexpr (GATHER) { if (has_next) { PG8_GOFF(noff, nxt.pm); } else { _Pragma("unroll") for (int _h = 0; _h < 2; ++_h) _Pragma("unroll") for (int _i = 0; _i < 2; ++_i) noff[_h][_i] = coff[_h][_i]; } }
        for (int t = 0; t < nt; t += 2) {
            const bool last = (t == nt - 2);
            const char* a1 = cA + (size_t)(t + 1) * kstep;
            const char* a2 = last ? nA : cA + (size_t)(t + 2) * kstep; const float* b20 = last ? nB0 : cB0 + (size_t)(t + 2) * bkstep; const float* b21 = last ? nB1 : cB1 + (size_t)(t + 2) * bkstep;
            const char* a3 = a2 + kstep; const float* b30 = b20 + bkstep; const float* b31 = b21 + bkstep;
            const size_t k1 = (size_t)(t + 1) * kstep, k2 = last ? 0 : (size_t)(t + 2) * kstep, k3 = k2 + kstep;
            PG8_LDBT(B0, 0, 0); PG8_SCHED; PG8_LDA(At, 0, 0); PG8_STAGEA(PG8_SA(1, 1), a1 + hstep, 1, k1, false);
            PG8_WAIT_V(12); PG8_WAIT_L(0); PG8_BAR; PG8_MMA(0, 0, At, B0); PG8_LDBT(B0, 0, 1); PG8_WAIT_L(0); PG8_SCHED; PG8_MMA(0, 1, At, B0); PG8_BAR; PG8_SCHED;
            PG8_BWRITE(1); PG8_BLOAD(b20, b21); PG8_SCHED; PG8_LDBT(B0, 0, 0); PG8_LDA(At, 0, 1); PG8_STAGEA(PG8_SA(0, 0), a2, 0, k2, last);
            PG8_WAIT_V(12); PG8_WAIT_L(0); PG8_BAR; PG8_MMA(1, 0, At, B0); PG8_LDBT(B0, 0, 1); PG8_WAIT_L(0); PG8_SCHED; PG8_MMA(1, 1, At, B0); PG8_BAR; PG8_SCHED;
            PG8_LDBT(B0, 1, 0); PG8_SCHED; PG8_LDA(At, 1, 0); PG8_STAGEA(PG8_SA(0, 1), a2 + hstep, 1, k2, last);
            PG8_WAIT_V(12); PG8_WAIT_L(0); PG8_BAR; PG8_MMA(0, 0, At, B0); PG8_LDBT(B0, 1, 1); PG8_WAIT_L(0); PG8_SCHED; PG8_MMA(0, 1, At, B0); PG8_BAR; PG8_SCHED;
            PG8_BWRITE(0); PG8_BLOAD(b30, b31); PG8_SCHED; PG8_LDBT(B0, 1, 0); PG8_LDA(At, 1, 1); PG8_STAGEA(PG8_SA(1, 0), a3, 0, k3, last);
            PG8_WAIT_V(12); PG8_WAIT_L(0); PG8_BAR; PG8_MMA(1, 0, At, B0); PG8_LDBT(B0, 1, 1); PG8_WAIT_L(0); PG8_SCHED; PG8_MMA(1, 1, At, B0); PG8_BAR; PG8_SCHED;
        }
        if constexpr (ALIGN_EPI) { if (wr == 0) PG8_BAR; }
        E(acc, cur, wr, wc, fr, fq); S.done(cur);
        if (!has_next) break;
#pragma unroll
        for (int a = 0; a < 2; ++a)
#pragma unroll
            for (int b = 0; b < 2; ++b)
#pragma unroll
                for (int m = 0; m < 4; ++m)
#pragma unroll
                    for (int n = 0; n < 2; ++n) acc[a][b][m][n] = (f32x4){0.f, 0.f, 0.f, 0.f};
        cur = nxt; cA = nA; cB0 = nB0; cB1 = nB1; ++ui;
        if constexpr (GATHER) { _Pragma("unroll") for (int _h = 0; _h < 2; ++_h) _Pragma("unroll") for (int _i = 0; _i < 2; ++_i) coff[_h][_i] = noff[_h][_i]; }
        if constexpr (ALIGN_EPI) { if (wr == 1) PG8_BAR; }
    }
    PG8_WAIT_V(0);
    asm volatile("" :: "v"(breg[0]), "v"(breg[1]), "v"(breg[2]), "v"(breg[3]), "v"(breg[4]), "v"(breg[5]), "v"(breg[6]), "v"(breg[7]));
    if constexpr (!ALIGN_EPI) { if (wr == 0) PG8_BAR; }
    PG8_BAR;
#undef PG8_SA
#undef PG8_SBI
#undef PG8_STAGE
#undef PG8_STAGEA
#undef PG8_GOFF
#undef PG8_LDA
#undef PG8_LDBT
#undef PG8_BLOAD
#undef PG8_BWRITE
#undef PG8_MMA
#undef PG8_WAIT_V
#undef PG8_WAIT_L
#undef PG8_BAR
#undef PG8_SCHED
}
}

constexpr int NWAVES = 8, NTHR = 512;
constexpr int T = 8192, D = 2048, HW = 7168, INW = 7184, MEMN = 256;
constexpr float LN_EPS = 1e-5f;
constexpr float ALPHA = 1.189207115002721f;
constexpr int NPH = 16;
constexpr int PMAX = 24576;

constexpr size_t MiB = 1u << 20;
constexpr size_t WS_CTL = 0, CTL_ZERO_BYTES = 1 * MiB;
constexpr size_t WS_WMIX = 2 * MiB, WS_WMQ = 10 * MiB, WS_WIN = 18 * MiB, WS_WKV = 46 * MiB, WS_WMO = 62 * MiB, WS_WGU = 70 * MiB, WS_WD = 198 * MiB;
constexpr size_t WS_XB = 262 * MiB, WS_MEMB = 294 * MiB;
constexpr size_t WS_H = 296 * MiB;
constexpr size_t WS_KVM = 408 * MiB;
constexpr size_t WS_ORAW = 410 * MiB;
constexpr size_t WS_MIXED = WS_XB;
constexpr size_t WS_Y1 = WS_ORAW;
constexpr size_t WS_H1B = WS_H;
constexpr size_t WS_QB = 328 * MiB, WS_ATT = 360 * MiB;
constexpr size_t WS_Y2 = 474 * MiB;
constexpr size_t WS_H2B = WS_H;
constexpr size_t WS_XS = 328 * MiB;
constexpr size_t WS_HID = 424 * MiB;
constexpr size_t WS_YS = WS_XS;
constexpr size_t WS_SMALL = 540 * MiB;
constexpr size_t WS_GLR = WS_SMALL;
constexpr size_t WS_RC = WS_SMALL + 1 * MiB, WS_RS = WS_SMALL + 5 * MiB;
constexpr size_t WS_ST1 = WS_SMALL + 9 * MiB, WS_ST2 = WS_ST1 + 65536;
constexpr size_t WS_EXP = WS_ST2 + 65536, WS_GATE = WS_EXP + 65536, WS_POS = WS_GATE + 65536, WS_SLOT = WS_POS + 65536, WS_TOK = WS_SLOT + 65536;
constexpr size_t WS_XCH1 = WS_SMALL + 10 * MiB, WS_XCH2 = WS_XCH1 + 512 * 1024;
constexpr size_t WS_END = 552 * MiB;
constexpr int CW_CNT = 64, CW_CUR = 128, CW_Q = 192;
constexpr int CW_BAR = 4096;
constexpr int CW_LN1 = 8192, CW_LN2 = 10240;

constexpr int RING_BYTES = 139264, LDSCTL_OFF = RING_BYTES, MISC_OFF = LDSCTL_OFF + 320, LDS_BYTES = 147456;

#define GAS __attribute__((address_space(1)))
#define LAS __attribute__((address_space(3)))
typedef unsigned short bf16;
typedef unsigned v4u __attribute__((ext_vector_type(4)));
typedef unsigned v2u __attribute__((ext_vector_type(2)));
typedef float f32x4 __attribute__((ext_vector_type(4)));
typedef GAS unsigned gu32;
#define RLX_AGENT __ATOMIC_RELAXED, __HIP_MEMORY_SCOPE_AGENT
#define LDS_WAIT() asm volatile("s_waitcnt lgkmcnt(0)" ::: "memory")
__device__ __forceinline__ unsigned f2bf(float f) { unsigned u = __builtin_bit_cast(unsigned, f); return (u + 0x7fffu + ((u >> 16) & 1u)) >> 16; }
__device__ __forceinline__ unsigned pk2(float lo, float hi) { return f2bf(lo) | (f2bf(hi) << 16); }
__device__ __forceinline__ float bf2f(unsigned h) { return __builtin_bit_cast(float, h << 16); }
__device__ __forceinline__ float bflo(unsigned w) { return __builtin_bit_cast(float, w << 16); }
__device__ __forceinline__ float bfhi(unsigned w) { return __builtin_bit_cast(float, w & 0xffff0000u); }
__device__ __forceinline__ float wave_sum(float v) {
#pragma unroll
    for (int o = 1; o < 64; o <<= 1) v += __shfl_xor(v, o);
    return v;
}
__device__ __forceinline__ float wave_max(float v) {
#pragma unroll
    for (int o = 1; o < 64; o <<= 1) v = fmaxf(v, __shfl_xor(v, o));
    return v;
}

struct Frame {
    LAS unsigned char* lds;
    volatile LAS unsigned* MISC;
    gu32* ctl;
    int tid, lane, wave, G, bid;
    unsigned char* ws;
    const float* in[25];
    float* out;
};
#define WSP(T_, off) ((T_*)(F.ws + (off)))

__device__ __forceinline__ void transpose_item(const float* W, int ldw, bf16* WTr, int ldt, LAS float* scr, int lane) {
    float tv[32];
#pragma unroll
    for (int i = 0; i < 32; ++i) tv[i] = W[(size_t)(2 * i + (lane >> 5)) * ldw + (lane & 31)];
#pragma unroll
    for (int i = 0; i < 32; ++i) scr[(2 * i + (lane >> 5)) * 33 + (lane & 31)] = tv[i];
    LDS_WAIT(); asm volatile("" ::: "memory");
    const int c = lane & 7;
#pragma unroll
    for (int j = 0; j < 4; ++j) { const int n = (lane >> 3) + 8 * j; const LAS float* s = scr + (8 * c) * 33 + n;
        v4u o; o.x = pk2(s[0 * 33], s[1 * 33]); o.y = pk2(s[2 * 33], s[3 * 33]); o.z = pk2(s[4 * 33], s[5 * 33]); o.w = pk2(s[6 * 33], s[7 * 33]);
        *(GAS v4u*)(WTr + (size_t)n * ldt + 8 * c) = o; }
    LDS_WAIT(); asm volatile("" ::: "memory");
}
__device__ __forceinline__ void p0_prologue(Frame& F) {
    LAS float* scr = (LAS float*)(F.lds + F.wave * 16384);
    const int gw = F.bid * NWAVES + F.wave, NGW = F.G * NWAVES;
    const float* w_in = F.in[3];
    constexpr int I_IN = 32 * 224, I_SQ = 32 * 64;
    for (int it = gw; it < I_IN + 2 * I_SQ; it += NGW) {
        int r = it;
        if (r < I_IN) { const int kb = r / 224, nb = r % 224; transpose_item(w_in + (size_t)(64 * kb) * INW + 32 * nb, INW, WSP(bf16, WS_WIN) + (size_t)(32 * nb) * 2048 + 64 * kb, 2048, scr, F.lane); continue; }
        r -= I_IN;
        { const int w = r / I_SQ, q = r % I_SQ, kb = q / 64, nb = q % 64;
          const float* src = F.in[11]; if (w) src = F.in[12];
          bf16* dst = WSP(bf16, WS_WKV) + (size_t)w * 2048 * 2048;
          transpose_item(src + (size_t)(64 * kb) * 2048 + 32 * nb, 2048, dst + (size_t)(32 * nb) * 2048 + 64 * kb, 2048, scr, F.lane); }
    }
    const int gt = F.bid * NTHR + F.tid, NGT = F.G * NTHR;
    {
        const float* x = F.in[0]; bf16* xb = WSP(bf16, WS_XB);
        for (int i0 = gt; i0 < T * D / 8; i0 += 4 * NGT) { f32x4 a[4], b[4];
#pragma unroll
            for (int u = 0; u < 4; ++u) { const size_t i = (size_t)i0 + (size_t)u * NGT; a[u] = *(const GAS f32x4*)(x + i * 8); b[u] = *(const GAS f32x4*)(x + i * 8 + 4); }
#pragma unroll
            for (int u = 0; u < 4; ++u) { const size_t i = (size_t)i0 + (size_t)u * NGT;
                v4u o; o.x = pk2(a[u][0], a[u][1]); o.y = pk2(a[u][2], a[u][3]); o.z = pk2(b[u][0], b[u][1]); o.w = pk2(b[u][2], b[u][3]); *(GAS v4u*)(xb + i * 8) = o; } }
        const float* mm = F.in[1]; bf16* mb = WSP(bf16, WS_MEMB);
        for (int i = gt; i < MEMN * D / 8; i += NGT) { const f32x4 a = *(const GAS f32x4*)(mm + (size_t)i * 8), b = *(const GAS f32x4*)(mm + (size_t)i * 8 + 4);
            v4u o; o.x = pk2(a[0], a[1]); o.y = pk2(a[2], a[3]); o.z = pk2(b[0], b[1]); o.w = pk2(b[2], b[3]); *(GAS v4u*)(mb + (size_t)i * 8) = o; }
    }
    {
        const int* pos = (const int*)F.in[2]; float* rc = WSP(float, WS_RC); float* rs = WSP(float, WS_RS);
        for (int i = gt; i < T * 128; i += NGT) { const int t = i >> 7, f = i & 127;
            const float inv = exp2f(-(float)f * (13.287712379549449f / 128.0f));
            const float ang = (float)pos[t] * inv;
            double rev = (double)ang * 0.15915494309189535; rev -= floor(rev);
            const float rf = (float)rev;
            rc[i] = __builtin_amdgcn_cosf(rf); rs[i] = __builtin_amdgcn_sinf(rf); }
    }
    {
        const float* x = F.in[0]; float* glr = WSP(float, WS_GLR);
        const int r16 = F.lane & 15, g4 = F.lane >> 4;
        LAS float* part = (LAS float*)F.lds;
        for (int item = F.bid; item < T / 32; item += F.G) {
            const int tile = 2 * item + (F.wave >> 2), kq = F.wave & 3;
            f32x4 acc = {0.f, 0.f, 0.f, 0.f};
            const float* xr = x + (size_t)(tile * 16 + r16) * D + 512 * kq + 4 * g4;
            const float* wr = w_in + (size_t)(512 * kq + 4 * g4) * INW + HW + r16;
#pragma unroll 8
            for (int k0 = 0; k0 < 512; k0 += 16) {
                const f32x4 a = *(const GAS f32x4*)(xr + k0);
                const float b0 = wr[(size_t)(k0 + 0) * INW], b1 = wr[(size_t)(k0 + 1) * INW], b2 = wr[(size_t)(k0 + 2) * INW], b3 = wr[(size_t)(k0 + 3) * INW];
                acc = __builtin_amdgcn_mfma_f32_16x16x4f32(a[0], b0, acc, 0, 0, 0);
                acc = __builtin_amdgcn_mfma_f32_16x16x4f32(a[1], b1, acc, 0, 0, 0);
                acc = __builtin_amdgcn_mfma_f32_16x16x4f32(a[2], b2, acc, 0, 0, 0);
                acc = __builtin_amdgcn_mfma_f32_16x16x4f32(a[3], b3, acc, 0, 0, 0);
            }
            __syncthreads();
            *(LAS f32x4*)(part + (F.wave * 64 + F.lane) * 4) = acc;
            __syncthreads();
            if (F.tid < 128) { const int tl = F.tid >> 6, ln = F.tid & 63;
                f32x4 s = *(const LAS f32x4*)(part + ((tl * 4 + 0) * 64 + ln) * 4);
#pragma unroll
                for (int q = 1; q < 4; ++q) s += *(const LAS f32x4*)(part + ((tl * 4 + q) * 64 + ln) * 4);
#pragma unroll
                for (int j = 0; j < 4; ++j) glr[(size_t)((2 * item + tl) * 16 + 4 * (ln >> 4) + j) * 16 + (ln & 15)] = s[j]; }
        }
        __syncthreads();
    }
}
__device__ __forceinline__ void transpose_queue(Frame& F, int qsel = 0) {
    LAS float* scr = (LAS float*)(F.lds + F.wave * 16384);
    const float* const i7 = F.in[7]; const float* const i10 = F.in[10]; const float* const i13 = F.in[13]; const float* const i20 = F.in[20]; const float* const i21 = F.in[21]; const float* const i22 = F.in[22];
    constexpr int I_SQ = 32 * 64, I_E = 512, NQ = 3 * I_SQ + (MK_MOE_F32 ? 0 : 3 * 32 * I_E);
    for (;;) {
        unsigned b0 = 0;
        if (F.lane == 0) b0 = __hip_atomic_fetch_add((unsigned*)(F.ctl + CW_Q + 64 * qsel), 16u, __ATOMIC_RELAXED, __HIP_MEMORY_SCOPE_AGENT);
        b0 = __builtin_amdgcn_readfirstlane(b0);
        if (b0 >= (unsigned)NQ) break;
        for (int it = (int)b0; it < (int)b0 + 16 && it < NQ; ++it) {
            int r = it;
            if (r < 3 * I_SQ) { const int w = r / I_SQ, q = r % I_SQ, kb = q / 64, nb = q % 64;
                const float* src = i7; size_t doff = WS_WMIX; if (w == 1) { src = i10; doff = WS_WMQ; } if (w == 2) { src = i13; doff = WS_WMO; }
                bf16* dst = (bf16*)(F.ws + doff);
                transpose_item(src + (size_t)(64 * kb) * 2048 + 32 * nb, 2048, dst + (size_t)(32 * nb) * 2048 + 64 * kb, 2048, scr, F.lane); continue; }
            r -= 3 * I_SQ;
            if (r < 2 * 32 * I_E) {
                const int up = r / (32 * I_E), q = r % (32 * I_E), e = q / I_E, q2 = q % I_E, kb = q2 / 16, nb = q2 % 16, n0 = 32 * nb;
                const float* sb = i20; if (up) sb = i21;
                const float* src = sb + (size_t)e * 2048 * 512 + (size_t)(64 * kb) * 512 + n0;
                bf16* dst = WSP(bf16, WS_WGU) + (size_t)(e * 1024 + (n0 >> 7) * 256 + up * 128 + (n0 & 127)) * 2048 + 64 * kb;
                transpose_item(src, 512, dst, 2048, scr, F.lane); continue; }
            r -= 2 * 32 * I_E;
            {
                const int e = r / I_E, q2 = r % I_E, kb = q2 / 64, nb = q2 % 64;
                const float* src = i22 + (size_t)e * 512 * 2048 + (size_t)(64 * kb) * 2048 + 32 * nb;
                bf16* dst = WSP(bf16, WS_WD) + (size_t)(e * 2048 + 32 * nb) * 512 + 64 * kb;
                transpose_item(src, 2048, dst, 512, scr, F.lane); }
        }
    }
}

__device__ __forceinline__ float log_sigmoid_f(float z) { return fminf(z, 0.f) - log1pf(expf(-fabsf(z))); }
template <bool GLA>
__device__ __forceinline__ void mixer_naive_item(Frame& F, int hh, int eg) {
    constexpr int ND = GLA ? 4 : 8;
    const bf16* H = WSP(bf16, WS_H); float* oraw = WSP(float, WS_ORAW);
    const int ei = F.tid & 15, dp = F.tid >> 4, e = eg * 16 + ei;
    const int qcol = GLA ? 4096 + hh * 128 : hh * 256, kcol = GLA ? 4608 + hh * 128 : 1024 + hh * 256, vcol = (GLA ? 5120 : 2048) + hh * 256 + e;
    const int ocol = (GLA ? 1024 : 0) + hh * 256 + eg * 16;
    LAS float* red = (LAS float*)F.lds;
    float S[ND];
#pragma unroll
    for (int i = 0; i < ND; ++i) S[i] = 0.f;
    float wa[GLA ? 4 : 1][16]; float ba[GLA ? 4 : 1];
    if (GLA) {
#pragma unroll
        for (int i = 0; i < 4; ++i) { const int d = dp + 32 * i; ba[i] = F.in[5][hh * 128 + d];
#pragma unroll
            for (int r = 0; r < 16; ++r) wa[i][r] = F.in[4][r * 512 + hh * 128 + d]; }
    }
    const float gamma = 1.0f - exp2f(-5.0f - (float)hh);
    const float* glr = WSP(float, WS_GLR);
    for (int t0 = 0; t0 < T; t0 += 8) {
        float part[8];
#pragma unroll
        for (int tt = 0; tt < 8; ++tt) {
            const int t = t0 + tt; const bf16* hr = H + (size_t)t * HW;
            const float v = bf2f(hr[vcol]);
            float g16[16];
            if (GLA) {
#pragma unroll
                for (int r = 0; r < 16; ++r) g16[r] = glr[t * 16 + r];
            }
            float p = 0.f;
#pragma unroll
            for (int i = 0; i < ND; ++i) { const int d = dp + 32 * i;
                const float q = bf2f(hr[qcol + d]), k = bf2f(hr[kcol + d]);
                float a = gamma;
                if (GLA) { float z = ba[i];
#pragma unroll
                    for (int r = 0; r < 16; ++r) z += g16[r] * wa[i][r];
                    a = expf(log_sigmoid_f(z) * 0.0625f); }
                S[i] = a * S[i] + k * v; p += q * S[i]; }
            p += __shfl_xor(p, 16); p += __shfl_xor(p, 32);
            part[tt] = p;
        }
        if (F.lane < 16) {
#pragma unroll
            for (int tt = 0; tt < 8; ++tt) red[(F.wave * 8 + tt) * 16 + F.lane] = part[tt];
        }
        __syncthreads();
        if (F.tid < 128) { const int tt = F.tid >> 4, e2 = F.tid & 15; float s = 0.f;
#pragma unroll
            for (int w = 0; w < 8; ++w) s += red[(w * 8 + tt) * 16 + e2];
            oraw[(size_t)(t0 + tt) * D + ocol + e2] = s; }
        __syncthreads();
    }
}
__device__ __forceinline__ void p2_mixer_naive(Frame& F) {
    for (int item = F.bid; item < 128; item += F.G) {
        const int h8 = item >> 4, eg = item & 15;
        if (h8 < 4) mixer_naive_item<false>(F, h8, eg); else mixer_naive_item<true>(F, h8 - 4, eg);
    }
}
__device__ __forceinline__ void p3_normgate(Frame& F) {
    const bf16* H = WSP(bf16, WS_H); const float* oraw = WSP(float, WS_ORAW); bf16* mixed = WSP(bf16, WS_MIXED);
    const int gw = F.bid * NWAVES + F.wave, NGW = F.G * NWAVES;
    const f32x4 gn = *(const f32x4*)(F.in[6] + 4 * F.lane);
    for (int t = gw; t < T; t += NGW) {
#pragma unroll
        for (int h8 = 0; h8 < 8; ++h8) {
            const f32x4 o = *(const GAS f32x4*)(oraw + (size_t)t * D + h8 * 256 + 4 * F.lane);
            const int gcol = (h8 < 4 ? 3072 : 6144) + (h8 & 3) * 256 + 4 * F.lane;
            const v2u gw2 = *(const GAS v2u*)(H + (size_t)t * HW + gcol);
            const f32x4 gt = {bflo(gw2.x), bfhi(gw2.x), bflo(gw2.y), bfhi(gw2.y)};
            f32x4 y;
            if (h8 < 4) {
                const float mu = wave_sum((o[0] + o[1]) + (o[2] + o[3])) * (1.f / 256.f);
                const f32x4 dd = o - mu;
                const float var = wave_sum((dd[0] * dd[0] + dd[1] * dd[1]) + (dd[2] * dd[2] + dd[3] * dd[3])) * (1.f / 256.f);
                y = dd * (1.0f / sqrtf(var + LN_EPS));
            } else {
                const float ms = wave_sum((o[0] * o[0] + o[1] * o[1]) + (o[2] * o[2] + o[3] * o[3])) * (1.f / 256.f);
                y = o * (1.0f / sqrtf(ms + LN_EPS)) * gn;
            }
            float r[4];
#pragma unroll
            for (int i = 0; i < 4; ++i) { const float g = gt[i]; r[i] = g / (1.0f + expf(-g)) * y[i]; }
            v2u w; w.x = pk2(r[0], r[1]); w.y = pk2(r[2], r[3]);
            *(GAS v2u*)(mixed + (size_t)t * D + h8 * 256 + 4 * F.lane) = w;
        }
    }
}
__device__ __forceinline__ void ln_apply_plain(Frame& F, const float* Y, const float* g, const float* b, bf16* HB, float* st) {
    const int gw = F.bid * NWAVES + F.wave, NGW = F.G * NWAVES;
    f32x4 cur[8];
    if (gw < T) { const GAS f32x4* yr = (const GAS f32x4*)(Y + (size_t)gw * D) + F.lane;
#pragma unroll
        for (int j = 0; j < 8; ++j) cur[j] = yr[64 * j]; }
    for (int t = gw; t < T; t += NGW) {
        f32x4 nxt[8];
        { const int tn = t + NGW < T ? t + NGW : t; const GAS f32x4* yr = (const GAS f32x4*)(Y + (size_t)tn * D) + F.lane;
#pragma unroll
          for (int j = 0; j < 8; ++j) nxt[j] = yr[64 * j]; }
        f32x4 v[8]; float s = 0.f;
#pragma unroll
        for (int j = 0; j < 8; ++j) { v[j] = cur[j]; s += (v[j][0] + v[j][1]) + (v[j][2] + v[j][3]); }
        const float mean = wave_sum(s) * (1.f / D); float s2 = 0.f;
#pragma unroll
        for (int j = 0; j < 8; ++j) { v[j] = v[j] - mean; s2 += (v[j][0] * v[j][0] + v[j][1] * v[j][1]) + (v[j][2] * v[j][2] + v[j][3] * v[j][3]); }
        const float rstd = 1.f / sqrtf(wave_sum(s2) * (1.f / D) + LN_EPS);
        if (F.lane == 0) { st[2 * t] = mean; st[2 * t + 1] = rstd; }
        GAS v2u* o8 = (GAS v2u*)(HB + (size_t)t * D) + F.lane;
#pragma unroll
        for (int j = 0; j < 8; ++j) { const f32x4 gv = *(const f32x4*)(g + 4 * F.lane + 256 * j), bv = *(const f32x4*)(b + 4 * F.lane + 256 * j);
            v[j] = v[j] * rstd * gv + bv;
            v2u w; w.x = pk2(v[j][0], v[j][1]); w.y = pk2(v[j][2], v[j][3]); o8[64 * j] = w; }
#pragma unroll
        for (int j = 0; j < 8; ++j) cur[j] = nxt[j];
    }
}
template <bool ROUTER>
__device__ __forceinline__ void ln_apply(Frame& F, const float* Y, const float* g, const float* b, bf16* HB, float* st, bool count = true) {
    const int gw = F.bid * NWAVES + F.wave, NGW = F.G * NWAVES;
    for (int t = gw; t < T; t += NGW) {
        const GAS f32x4* yr = (const GAS f32x4*)(Y + (size_t)t * D) + F.lane;
        f32x4 v[8]; float s = 0.f;
#pragma unroll
        for (int j = 0; j < 8; ++j) { v[j] = yr[64 * j]; s += (v[j][0] + v[j][1]) + (v[j][2] + v[j][3]); }
        const float mean = wave_sum(s) * (1.f / D); float s2 = 0.f;
#pragma unroll
        for (int j = 0; j < 8; ++j) { v[j] = v[j] - mean; s2 += (v[j][0] * v[j][0] + v[j][1] * v[j][1]) + (v[j][2] * v[j][2] + v[j][3] * v[j][3]); }
        const float rstd = 1.f / sqrtf(wave_sum(s2) * (1.f / D) + LN_EPS);
        if (F.lane == 0) { st[2 * t] = mean; st[2 * t + 1] = rstd; }
        GAS v2u* o8 = (GAS v2u*)(HB + (size_t)t * D) + F.lane;
#pragma unroll
        for (int j = 0; j < 8; ++j) { const f32x4 gv = *(const f32x4*)(g + 4 * F.lane + 256 * j), bv = *(const f32x4*)(b + 4 * F.lane + 256 * j);
            v[j] = v[j] * rstd * gv + bv;
            v2u w; w.x = pk2(v[j][0], v[j][1]); w.y = pk2(v[j][2], v[j][3]); o8[64 * j] = w; }
        if (ROUTER) {
            const float* Wg = F.in[16]; const float* We = F.in[18];
            float lg[4], le[32];
#pragma unroll
            for (int i = 0; i < 4; ++i) lg[i] = 0.f;
#pragma unroll
            for (int i = 0; i < 32; ++i) le[i] = 0.f;
#pragma unroll
            for (int j = 0; j < 8; ++j) {
#pragma unroll
                for (int i = 0; i < 4; ++i) { const int c = 4 * F.lane + 256 * j + i; const float hv = v[j][i];
                    const f32x4 wg = *(const GAS f32x4*)(Wg + (size_t)c * 4);
#pragma unroll
                    for (int q = 0; q < 4; ++q) lg[q] += hv * wg[q];
#pragma unroll
                    for (int q8 = 0; q8 < 8; ++q8) { const f32x4 we = *(const GAS f32x4*)(We + (size_t)c * 32 + 4 * q8);
#pragma unroll
                        for (int q = 0; q < 4; ++q) le[4 * q8 + q] += hv * we[q]; } }
            }
#pragma unroll
            for (int i = 0; i < 4; ++i) lg[i] = wave_sum(lg[i]) + F.in[17][i];
#pragma unroll
            for (int i = 0; i < 32; ++i) le[i] = wave_sum(le[i]);
            int grp = 0; float gm = lg[0];
#pragma unroll
            for (int i = 1; i < 4; ++i) if (lg[i] > gm) { gm = lg[i]; grp = i; }
            float gs = 0.f;
#pragma unroll
            for (int i = 0; i < 4; ++i) gs += expf(lg[i] - gm);
            const float pg_sel = 1.0f / gs;
            float fe[8];
#pragma unroll
            for (int j = 0; j < 8; ++j) { const float a = grp == 0 ? le[j] : grp == 1 ? le[8 + j] : grp == 2 ? le[16 + j] : le[24 + j]; fe[j] = a + F.in[19][grp * 8 + j]; }
            int i1 = 0; float m1 = fe[0];
#pragma unroll
            for (int j = 1; j < 8; ++j) if (fe[j] > m1) { m1 = fe[j]; i1 = j; }
            int i2 = -1; float m2 = -3.0e38f;
#pragma unroll
            for (int j = 0; j < 8; ++j) if (j != i1 && fe[j] > m2) { m2 = fe[j]; i2 = j; }
            const float p2 = expf(m2 - m1), den = 1.0f / (1.0f + p2);
            if (F.lane == 0) {
                int* ex = WSP(int, WS_EXP); float* gt = WSP(float, WS_GATE);
                const int e1 = grp * 8 + i1, e2 = grp * 8 + i2;
                ex[2 * t] = e1; ex[2 * t + 1] = e2; gt[2 * t] = pg_sel * den; gt[2 * t + 1] = pg_sel * p2 * den;
                if (count) { atomicAdd((unsigned*)(F.ctl + CW_CNT) + e1, 1u); atomicAdd((unsigned*)(F.ctl + CW_CNT) + e2, 1u); }
            }
        }
    }
}
__device__ __forceinline__ void p7_attn_naive(Frame& F) {
    const bf16* Q = WSP(bf16, WS_QB); const bf16* KVM = WSP(bf16, WS_KVM); bf16* att = WSP(bf16, WS_ATT);
    LAS float* qs = (LAS float*)F.lds;
    LAS float* sc = (LAS float*)(F.lds + 16384);
    for (int item = F.bid; item < (T / 8) * 4; item += F.G) {
        const int h = item & 3, t0 = (item >> 2) * 8;
        for (int i = F.tid; i < 8 * 512; i += NTHR) { const int tt = i >> 9, d = i & 511; qs[i] = bf2f(Q[(size_t)(t0 + tt) * D + h * 512 + d]); }
        __syncthreads();
        {
            const int j = F.tid & 255, th = F.tid >> 8;
            const bf16* kr = KVM + (size_t)j * 4096 + h * 512;
            float a0 = 0.f, a1 = 0.f, a2 = 0.f, a3 = 0.f;
            for (int d = 0; d < 512; d += 8) {
                const v4u kw = *(const GAS v4u*)(kr + d);
                const float kf[8] = {bflo(kw.x), bfhi(kw.x), bflo(kw.y), bfhi(kw.y), bflo(kw.z), bfhi(kw.z), bflo(kw.w), bfhi(kw.w)};
#pragma unroll
                for (int i = 0; i < 8; ++i) { a0 += kf[i] * qs[(th * 4 + 0) * 512 + d + i]; a1 += kf[i] * qs[(th * 4 + 1) * 512 + d + i]; a2 += kf[i] * qs[(th * 4 + 2) * 512 + d + i]; a3 += kf[i] * qs[(th * 4 + 3) * 512 + d + i]; }
            }
            const float scl = 0.04419417382415922f;
            sc[(th * 4 + 0) * 256 + j] = a0 * scl; sc[(th * 4 + 1) * 256 + j] = a1 * scl; sc[(th * 4 + 2) * 256 + j] = a2 * scl; sc[(th * 4 + 3) * 256 + j] = a3 * scl;
        }
        __syncthreads();
        {
            float v[4]; float mx = -3.0e38f;
#pragma unroll
            for (int i = 0; i < 4; ++i) { v[i] = sc[F.wave * 256 + F.lane + 64 * i]; mx = fmaxf(mx, v[i]); }
            mx = wave_max(mx); float sm = 0.f;
#pragma unroll
            for (int i = 0; i < 4; ++i) { v[i] = expf(v[i] - mx); sm += v[i]; }
            sm = 1.0f / wave_sum(sm);
#pragma unroll
            for (int i = 0; i < 4; ++i) sc[F.wave * 256 + F.lane + 64 * i] = v[i] * sm;
        }
        __syncthreads();
        {
            const int d = F.tid; const bf16* vr = KVM + 2048 + h * 512 + d;
            float o[8];
#pragma unroll
            for (int i = 0; i < 8; ++i) o[i] = 0.f;
            for (int j = 0; j < 256; ++j) { const float vv = bf2f(vr[(size_t)j * 4096]);
#pragma unroll
                for (int i = 0; i < 8; ++i) o[i] += sc[i * 256 + j] * vv; }
#pragma unroll
            for (int i = 0; i < 8; ++i) att[(size_t)(t0 + i) * D + h * 512 + d] = (bf16)f2bf(o[i]);
        }
        __syncthreads();
    }
}
__device__ __forceinline__ void moe_tile_starts(Frame& F, LAS int* ts) {
    if (F.tid < 64) {
        const unsigned c = F.lane < 32 ? __hip_atomic_load(F.ctl + CW_CUR + (F.lane & 31), RLX_AGENT) : 0u;
        int v = (int)((c + 255u) >> 8);
#pragma unroll
        for (int o = 1; o < 32; o <<= 1) { const int n = __shfl_up(v, o); if (F.lane >= o) v += n; }
        if (F.lane < 32) ts[F.lane + 1] = v;
        if (F.lane == 0) ts[0] = 0;
    }
    __syncthreads();
}
__device__ __forceinline__ void p10_dispatch(Frame& F, LAS int* ts) {
    const int gt = F.bid * NTHR + F.tid, NGT = F.G * NTHR;
    const int* ex = WSP(int, WS_EXP); const int* sl = WSP(int, WS_SLOT); int* pos = WSP(int, WS_POS); int* tok = WSP(int, WS_TOK);
    for (int a = gt; a < 2 * T; a += NGT) { const int p = ts[ex[a]] * 256 + sl[a]; pos[a] = p; tok[p] = a >> 1; }
}
__device__ __forceinline__ void p13_combine(Frame& F) {
    const int gw = F.bid * NWAVES + F.wave, NGW = F.G * NWAVES;
    const float* Y2 = WSP(float, WS_Y2); const float* st2 = WSP(float, WS_ST2); const bf16* ys = WSP(bf16, WS_YS);
    const int* pos = WSP(int, WS_POS); const float* gt = WSP(float, WS_GATE);
    const float* g2 = F.in[14]; const float* b2 = F.in[15]; const float* g3 = F.in[23]; const float* b3 = F.in[24];
    constexpr int R = 2;
    for (int t0 = gw; t0 < T; t0 += R * NGW) {
        f32x4 yv[R][8]; v2u ya[R][8], yc[R][8]; float mu2[R], rs2[R], w0[R], w1[R];
#pragma unroll
        for (int r = 0; r < R; ++r) { const int t = (t0 + r * NGW < T) ? t0 + r * NGW : t0;
            mu2[r] = st2[2 * t]; rs2[r] = st2[2 * t + 1]; w0[r] = gt[2 * t]; w1[r] = gt[2 * t + 1];
            const int p0 = pos[2 * t], p1 = pos[2 * t + 1];
            const GAS f32x4* yr = (const GAS f32x4*)(Y2 + (size_t)t * D) + F.lane;
            const GAS v2u* y0 = (const GAS v2u*)(ys + (size_t)p0 * D) + F.lane; const GAS v2u* y1 = (const GAS v2u*)(ys + (size_t)p1 * D) + F.lane;
#pragma unroll
            for (int j = 0; j < 8; ++j) { yv[r][j] = yr[64 * j]; ya[r][j] = y0[64 * j]; yc[r][j] = y1[64 * j]; } }
#pragma unroll
        for (int r = 0; r < R; ++r) { const int t = t0 + r * NGW; if (t >= T) break;
            f32x4 v[8]; float s = 0.f;
#pragma unroll
            for (int j = 0; j < 8; ++j) { const f32x4 gv = *(const f32x4*)(g2 + 4 * F.lane + 256 * j), bv = *(const f32x4*)(b2 + 4 * F.lane + 256 * j);
                const f32x4 h = (yv[r][j] - mu2[r]) * rs2[r] * gv + bv;
                const v2u a = ya[r][j], c = yc[r][j];
                const f32x4 fa = {bflo(a.x), bfhi(a.x), bflo(a.y), bfhi(a.y)}, fc = {bflo(c.x), bfhi(c.x), bflo(c.y), bfhi(c.y)};
                v[j] = h * ALPHA + fa * w0[r] + fc * w1[r]; s += (v[j][0] + v[j][1]) + (v[j][2] + v[j][3]); }
            const float mean = wave_sum(s) * (1.f / D); float s2 = 0.f;
#pragma unroll
            for (int j = 0; j < 8; ++j) { v[j] = v[j] - mean; s2 += (v[j][0] * v[j][0] + v[j][1] * v[j][1]) + (v[j][2] * v[j][2] + v[j][3] * v[j][3]); }
            const float rstd = 1.f / sqrtf(wave_sum(s2) * (1.f / D) + LN_EPS);
            GAS f32x4* orow = (GAS f32x4*)(F.out + (size_t)t * D) + F.lane;
#pragma unroll
            for (int j = 0; j < 8; ++j) { const f32x4 gv = *(const f32x4*)(g3 + 4 * F.lane + 256 * j), bv = *(const f32x4*)(b3 + 4 * F.lane + 256 * j);
                orow[64 * j] = v[j] * rstd * gv + bv; }
        }
    }
}

constexpr int CS = 128, NB = CS / 64, NS = T / CS;
constexpr size_t WS_BCUM = WS_ORAW;
constexpr size_t WS_KVR = WS_ORAW + 16 * MiB;
constexpr size_t WS_KVG = WS_KVR + 32 * MiB;
typedef short bf16x8_t __attribute__((ext_vector_type(8)));
typedef short s16x4_t __attribute__((ext_vector_type(4)));
__device__ __forceinline__ s16x4_t lds_tr(const LAS unsigned char* p) { return __builtin_bit_cast(s16x4_t, __builtin_amdgcn_ds_read_tr16_b64_v4i16((LAS s16x4_t*)p)); }
__device__ __forceinline__ bf16x8_t frag_tr(const LAS unsigned char* X, int pitch, int k0, int n0, int lane) {
    const int fq = lane >> 4, q = (lane >> 2) & 3, p = lane & 3;
    const LAS unsigned char* a = X + ((k0 + 8 * fq + q) * pitch + n0 + 4 * p) * 2;
    const s16x4_t lo = lds_tr(a), hi = lds_tr(a + 4 * pitch * 2);
    return __builtin_shufflevector(lo, hi, 0, 1, 2, 3, 4, 5, 6, 7);
}
__device__ __forceinline__ bf16x8_t frag_row(const LAS unsigned char* X, int pitch, int r0, int k0, int lane) {
    return *(const LAS bf16x8_t*)(X + ((r0 + (lane & 15)) * pitch + k0 + 8 * (lane >> 4)) * 2);
}
#define MFMA16(a, b, c) __builtin_amdgcn_mfma_f32_16x16x32_bf16((a), (b), (c), 0, 0, 0)
__device__ __forceinline__ float fexp(float x) { return __builtin_amdgcn_exp2f(x * 1.4426950408889634f); }
__device__ __forceinline__ float silu_g(float g) { return g * __builtin_amdgcn_rcpf(1.0f + __builtin_amdgcn_exp2f(-1.4426950408889634f * g)); }

__device__ __forceinline__ void bcum_item(Frame& F, int s, int h) {
    const int c = F.tid & 127, tq = F.tid >> 7;
    LAS float* tot = (LAS float*)F.lds;
    LAS float* gl = (LAS float*)(F.lds + 2048);
    const float* glr = WSP(float, WS_GLR); float* bc = WSP(float, WS_BCUM);
    __syncthreads();
    *(LAS f32x4*)(gl + 4 * F.tid) = *(const GAS f32x4*)(glr + (size_t)s * CS * 16 + 4 * F.tid);
    float w[16];
#pragma unroll
    for (int r = 0; r < 16; ++r) w[r] = F.in[4][r * 512 + h * 128 + c];
    const float bias = F.in[5][h * 128 + c];
    __syncthreads();
    float vals[32]; float run = 0.f;
    const int tb = s * CS + tq * 32;
#pragma unroll
    for (int i = 0; i < 32; ++i) { const LAS float* gr = gl + (tq * 32 + i) * 16; float z = bias;
#pragma unroll
        for (int r = 0; r < 16; ++r) z += gr[r] * w[r];
        run += log_sigmoid_f(z) * 0.0625f; vals[i] = run; }
    tot[tq * 128 + c] = run;
    __syncthreads();
    float off = 0.f;
#pragma unroll
    for (int q = 0; q < 3; ++q) off += (q < tq) ? tot[q * 128 + c] : 0.f;
#pragma unroll
    for (int i = 0; i < 32; ++i) bc[(size_t)(tb + i) * 512 + h * 128 + c] = vals[i] + off;
}
__device__ __forceinline__ void p1_bcum(Frame& F, int first, int stride) { for (int it = first; it < NS * 4; it += stride) bcum_item(F, it >> 2, it & 3); __syncthreads(); }

__device__ __forceinline__ void unit_sh(int u, int& s, int& h8) { s = (u >> 3) & (NS - 1); h8 = ((u & 7) + 4 * (u >> 8)) & 7; }

template <bool GLA, int MODE>
__device__ __forceinline__ void stage_qk(Frame& F, LAS unsigned char* dst, int s, int jb, int hh, int col0, float lg2gamma) {
    constexpr int DK = GLA ? 128 : 256, PK = DK + 8, CPR = DK / 8, NIT = 64 * CPR / NTHR;
    const bf16* H = WSP(bf16, WS_H); const float* bc = WSP(float, WS_BCUM);
    v4u wv[NIT]; f32x4 b0[GLA ? NIT : 1], b1[GLA ? NIT : 1], l0[(GLA && MODE == 2) ? NIT : 1], l1[(GLA && MODE == 2) ? NIT : 1];
#pragma unroll
    for (int it = 0; it < NIT; ++it) {
        const int ch = F.tid + NTHR * it, r = ch / CPR, cc = ch % CPR, t = s * CS + jb * 64 + r;
        wv[it] = *(const GAS v4u*)(H + (size_t)t * HW + col0 + 8 * cc);
        if (GLA) { b0[it] = *(const GAS f32x4*)(bc + (size_t)t * 512 + hh * 128 + 8 * cc); b1[it] = *(const GAS f32x4*)(bc + (size_t)t * 512 + hh * 128 + 8 * cc + 4);
            if (MODE == 2) { const size_t tl_ = (size_t)(s * CS + CS - 1) * 512 + hh * 128 + 8 * cc; l0[it] = *(const GAS f32x4*)(bc + tl_); l1[it] = *(const GAS f32x4*)(bc + tl_ + 4); } }
    }
#pragma unroll
    for (int it = 0; it < NIT; ++it) {
        const int ch = F.tid + NTHR * it, r = ch / CPR, cc = ch % CPR, tl = jb * 64 + r;
        const v4u w = wv[it];
        float f[8] = {bflo(w.x), bfhi(w.x), bflo(w.y), bfhi(w.y), bflo(w.z), bfhi(w.z), bflo(w.w), bfhi(w.w)};
        if (GLA) {
            float e[8] = {b0[it][0], b0[it][1], b0[it][2], b0[it][3], b1[it][0], b1[it][1], b1[it][2], b1[it][3]};
            if (MODE == 2) { const float l[8] = {l0[it][0], l0[it][1], l0[it][2], l0[it][3], l1[it][0], l1[it][1], l1[it][2], l1[it][3]};
#pragma unroll
                for (int i = 0; i < 8; ++i) e[i] = l[i] - e[i]; }
            else if (MODE == 1) {
#pragma unroll
                for (int i = 0; i < 8; ++i) e[i] = -e[i]; }
#pragma unroll
            for (int i = 0; i < 8; ++i) f[i] *= fexp(e[i]);
        } else {
            const float ex = MODE == 0 ? (float)(tl + 1) : MODE == 1 ? -(float)(tl + 1) : (float)(CS - 1 - tl);
            const float fac = __builtin_amdgcn_exp2f(ex * lg2gamma);
#pragma unroll
            for (int i = 0; i < 8; ++i) f[i] *= fac;
        }
        v4u o; o.x = pk2(f[0], f[1]); o.y = pk2(f[2], f[3]); o.z = pk2(f[4], f[5]); o.w = pk2(f[6], f[7]);
        *(LAS v4u*)(dst + (r * PK + 8 * cc) * 2) = o;
    }
}
__device__ __forceinline__ void stage_v(Frame& F, LAS unsigned char* dst, int s, int jb, int col0) {
    const bf16* H = WSP(bf16, WS_H);
    v4u wv[4];
#pragma unroll
    for (int it = 0; it < 4; ++it) { const int ch = F.tid + NTHR * it, r = ch >> 5, cc = ch & 31, t = s * CS + jb * 64 + r; wv[it] = *(const GAS v4u*)(H + (size_t)t * HW + col0 + 8 * cc); }
#pragma unroll
    for (int it = 0; it < 4; ++it) { const int ch = F.tid + NTHR * it, r = ch >> 5, cc = ch & 31; *(LAS v4u*)(dst + (r * 264 + 8 * cc) * 2) = wv[it]; }
}

template <bool GLA>
__device__ __forceinline__ void kv_unit(Frame& F, int s, int hh) {
    constexpr int DK = GLA ? 128 : 256, PK = DK + 8, NDT = DK / 16;
    LAS unsigned char* Ks = F.lds; LAS unsigned char* Vs = F.lds + 34816;
    const int kcol = GLA ? 4608 + hh * 128 : 1024 + hh * 256, vcol = (GLA ? 5120 : 2048) + hh * 256;
    const float lg2g = log2f(1.0f - exp2f(-5.0f - (float)hh));
    f32x4 acc[2][NDT];
#pragma unroll
    for (int a = 0; a < 2; ++a)
#pragma unroll
        for (int d = 0; d < NDT; ++d) acc[a][d] = (f32x4){0.f, 0.f, 0.f, 0.f};
    for (int jb = 0; jb < NB; ++jb) {
        __syncthreads();
        stage_qk<GLA, 2>(F, Ks, s, jb, hh, kcol, lg2g);
        stage_v(F, Vs, s, jb, vcol);
        __syncthreads();
#pragma unroll
        for (int ks = 0; ks < 2; ++ks) {
            bf16x8_t vf[2];
#pragma unroll
            for (int et = 0; et < 2; ++et) vf[et] = frag_tr(Vs, 264, 32 * ks, 32 * F.wave + 16 * et, F.lane);
#pragma unroll
            for (int dt = 0; dt < NDT; ++dt) { const bf16x8_t kf = frag_tr(Ks, PK, 32 * ks, 16 * dt, F.lane);
#pragma unroll
                for (int et = 0; et < 2; ++et) acc[et][dt] = MFMA16(kf, vf[et], acc[et][dt]); }
        }
    }
    bf16* kv = GLA ? (WSP(bf16, WS_KVG) + (size_t)(s * 4 + hh) * 256 * 128) : (WSP(bf16, WS_KVR) + (size_t)(s * 4 + hh) * 256 * 256);
    const int fr = F.lane & 15, fq = F.lane >> 4;
#pragma unroll
    for (int et = 0; et < 2; ++et)
#pragma unroll
        for (int dt = 0; dt < NDT; ++dt) { v2u w; w.x = pk2(acc[et][dt][0], acc[et][dt][1]); w.y = pk2(acc[et][dt][2], acc[et][dt][3]);
            *(GAS v2u*)(kv + (size_t)(32 * F.wave + 16 * et + fr) * DK + 16 * dt + 4 * fq) = w; }
}
__device__ __forceinline__ void p2_kv(Frame& F) {
    for (int u = F.bid; u < 8 * NS; u += F.G) { int s, h8; unit_sh(u, s, h8);
        if (s == NS - 1) continue;
        if (h8 < 4) kv_unit<false>(F, s, h8); else kv_unit<true>(F, s, h8 - 4); }
    __syncthreads();
}
__device__ __forceinline__ void p3_scan(Frame& F) {
    constexpr int NR = 4 * 256 * 64, NG = 4 * 256 * 32, NITEM = NR + NG;
    const float* bc = WSP(float, WS_BCUM);
    const int per = (NITEM + F.G - 1) / F.G;
    for (int k0 = F.tid; k0 < per; k0 += NTHR) {
      const int it = F.bid * per + k0;
      if (it < NITEM) {
        const bool gla = it >= NR; const int r = gla ? it - NR : it;
        const int sh = gla ? 5 : 6, dk = gla ? 128 : 256;
        const int cc = r & ((1 << sh) - 1), e = (r >> sh) & 255, hh = r >> (sh + 8);
        bf16* base = (gla ? WSP(bf16, WS_KVG) : WSP(bf16, WS_KVR)) + ((size_t)hh * 256 + e) * dk + 4 * cc;
        const size_t sstride = (size_t)4 * 256 * dk;
        const float dret = __builtin_amdgcn_exp2f((float)CS * log2f(1.0f - exp2f(-5.0f - (float)hh)));
        float S[4] = {0.f, 0.f, 0.f, 0.f};
#pragma unroll 16
        for (int s = 0; s < NS - 1; ++s) {
            GAS v2u* p = (GAS v2u*)(base + (size_t)s * sstride);
            const v2u w = *p;
            v2u o; o.x = pk2(S[0], S[1]); o.y = pk2(S[2], S[3]);
            *p = o;
            const float f[4] = {bflo(w.x), bfhi(w.x), bflo(w.y), bfhi(w.y)};
            float dec[4] = {dret, dret, dret, dret};
            if (gla) { const f32x4 l0 = *(const GAS f32x4*)(bc + (size_t)(s * CS + CS - 1) * 512 + hh * 128 + 4 * cc);
                dec[0] = fexp(l0[0]); dec[1] = fexp(l0[1]); dec[2] = fexp(l0[2]); dec[3] = fexp(l0[3]); }
#pragma unroll
            for (int i = 0; i < 4; ++i) S[i] = dec[i] * S[i] + f[i];
        }
        { GAS v2u* p = (GAS v2u*)(base + (size_t)(NS - 1) * sstride); v2u o; o.x = pk2(S[0], S[1]); o.y = pk2(S[2], S[3]); *p = o; }
      }
    }
}
template <bool GLA>
__device__ __forceinline__ void out_unit(Frame& F, int s, int hh) {
    constexpr int DK = GLA ? 128 : 256, PK = DK + 8, NKS = DK / 32;
    LAS unsigned char* Qs = F.lds; LAS unsigned char* Ks = F.lds + 33792; LAS unsigned char* Vs = F.lds + 67584; LAS unsigned char* Ps = F.lds + 101376;
    LAS float* red = (LAS float*)(F.lds + 110592);
    const int qcol = GLA ? 4096 + hh * 128 : hh * 256, kcol = GLA ? 4608 + hh * 128 : 1024 + hh * 256, vcol = (GLA ? 5120 : 2048) + hh * 256;
    const int gcol = (GLA ? 6144 : 3072) + hh * 256, ocol = (GLA ? 1024 : 0) + hh * 256;
    const float lg2g = log2f(1.0f - exp2f(-5.0f - (float)hh));
    const bf16* H = WSP(bf16, WS_H); bf16* mixed = WSP(bf16, WS_MIXED);
    const bf16* st = GLA ? (WSP(bf16, WS_KVG) + (size_t)(s * 4 + hh) * 256 * 128) : (WSP(bf16, WS_KVR) + (size_t)(s * 4 + hh) * 256 * 256);
    const int fr = F.lane & 15, fq = F.lane >> 4, w = F.wave, mt = w >> 1, nt0 = 2 * (w & 1);
    static_assert(NB == 2, "the step program below is written for two 64-token sub-blocks");
    f32x4 accO[4][2]; bf16x8_t sfa[NKS][2]; v2u gpre[4][2];
#pragma unroll 1
    for (int step = 0; step < 3; ++step) {
        const int i = step > 0 ? 1 : 0, j = step > 1 ? 1 : 0;
        {
            __syncthreads();
            if (step < 2) stage_qk<GLA, 0>(F, Qs, s, i, hh, qcol, lg2g);
            if (step != 1) { stage_qk<GLA, 1>(F, Ks, s, j, hh, kcol, lg2g); stage_v(F, Vs, s, j, vcol); }
            if (step < 2) {
#pragma unroll
                for (int m = 0; m < 4; ++m)
#pragma unroll
                    for (int n = 0; n < 2; ++n) accO[m][n] = (f32x4){0.f, 0.f, 0.f, 0.f};
            }
            if (step != 1) {
                if (s > 0) {
#pragma unroll
                    for (int ks = 0; ks < NKS; ++ks)
#pragma unroll
                        for (int n = 0; n < 2; ++n) sfa[ks][n] = *(const GAS bf16x8_t*)(st + (size_t)(32 * w + 16 * n + fr) * DK + 32 * ks + 8 * fq);
                }
#pragma unroll
                for (int m2 = 0; m2 < 4; ++m2)
#pragma unroll
                    for (int n = 0; n < 2; ++n) gpre[m2][n] = *(const GAS v2u*)(H + (size_t)(s * CS + i * 64 + 16 * m2 + fr) * HW + gcol + 32 * w + 16 * n + 4 * fq);
            }
            __syncthreads();
            f32x4 accS[2] = {(f32x4){0.f, 0.f, 0.f, 0.f}, (f32x4){0.f, 0.f, 0.f, 0.f}};
#pragma unroll
            for (int ks = 0; ks < NKS; ++ks) { const bf16x8_t qf = frag_row(Qs, PK, 16 * mt, 32 * ks, F.lane);
#pragma unroll
                for (int n2 = 0; n2 < 2; ++n2) { const bf16x8_t kf = frag_row(Ks, PK, 16 * (nt0 + n2), 32 * ks, F.lane); accS[n2] = MFMA16(kf, qf, accS[n2]); } }
#pragma unroll
            for (int n2 = 0; n2 < 2; ++n2) { const int row = 16 * mt + fr, c0 = 16 * (nt0 + n2) + 4 * fq; float pv[4];
#pragma unroll
                for (int jj = 0; jj < 4; ++jj) pv[jj] = (i == j && c0 + jj > row) ? 0.f : accS[n2][jj];
                v2u pw; pw.x = pk2(pv[0], pv[1]); pw.y = pk2(pv[2], pv[3]);
                *(LAS v2u*)(Ps + (row * 72 + c0) * 2) = pw; }
            __syncthreads();
#pragma unroll
            for (int ks = 0; ks < 2; ++ks) {
                bf16x8_t vf[2];
#pragma unroll
                for (int n = 0; n < 2; ++n) vf[n] = frag_tr(Vs, 264, 32 * ks, 32 * w + 16 * n, F.lane);
#pragma unroll
                for (int m = 0; m < 4; ++m) { const bf16x8_t pf = frag_row(Ps, 72, 16 * m, 32 * ks, F.lane);
#pragma unroll
                    for (int n = 0; n < 2; ++n) accO[m][n] = MFMA16(vf[n], pf, accO[m][n]); }
            }
        }
        if (step == 1) continue;
        if (s > 0) {
#pragma unroll
            for (int ks = 0; ks < NKS; ++ks) {
#pragma unroll
                for (int m = 0; m < 4; ++m) { const bf16x8_t qf = frag_row(Qs, PK, 16 * m, 32 * ks, F.lane);
#pragma unroll
                    for (int n = 0; n < 2; ++n) accO[m][n] = MFMA16(sfa[ks][n], qf, accO[m][n]); }
            }
        }
#pragma unroll
        for (int m = 0; m < 4; ++m) { float s1 = 0.f, s2 = 0.f;
#pragma unroll
            for (int n = 0; n < 2; ++n)
#pragma unroll
                for (int jj = 0; jj < 4; ++jj) { const float v = accO[m][n][jj]; s1 += v; s2 += v * v; }
            s1 += __shfl_xor(s1, 16); s1 += __shfl_xor(s1, 32); s2 += __shfl_xor(s2, 16); s2 += __shfl_xor(s2, 32);
            if (fq == 0) { red[(w * 64 + 16 * m + fr) * 2] = s1; red[(w * 64 + 16 * m + fr) * 2 + 1] = s2; } }
        __syncthreads();
#pragma unroll
        for (int m = 0; m < 4; ++m) { const int row = 16 * m + fr; float s1 = 0.f, s2 = 0.f;
#pragma unroll
            for (int ww = 0; ww < 8; ++ww) { s1 += red[(ww * 64 + row) * 2]; s2 += red[(ww * 64 + row) * 2 + 1]; }
            const float mean = s1 * (1.f / 256.f), ex2 = s2 * (1.f / 256.f);
            const float mu = GLA ? 0.f : mean, var = GLA ? ex2 : fmaxf(ex2 - mean * mean, 0.f);
            const float rstd = 1.0f / sqrtf(var + LN_EPS);
            const int t = s * CS + i * 64 + row;
#pragma unroll
            for (int n = 0; n < 2; ++n) { const int e = 32 * w + 16 * n + 4 * fq;
                const v2u gw2 = gpre[m][n];
                const float gt[4] = {bflo(gw2.x), bfhi(gw2.x), bflo(gw2.y), bfhi(gw2.y)};
                f32x4 gn = {1.f, 1.f, 1.f, 1.f}; if (GLA) gn = *(const f32x4*)(F.in[6] + e);
                float r4[4];
#pragma unroll
                for (int jj = 0; jj < 4; ++jj) { const float y = (accO[m][n][jj] - mu) * rstd * gn[jj]; r4[jj] = silu_g(gt[jj]) * y; }
                v2u ow; ow.x = pk2(r4[0], r4[1]); ow.y = pk2(r4[2], r4[3]);
                *(GAS v2u*)(mixed + (size_t)t * D + ocol + e) = ow; } }
    }
}
__device__ __forceinline__ void p4_out(Frame& F) {
    for (int u = F.bid; u < 8 * NS; u += F.G) { int s, h8; unit_sh(u, s, h8);
        if (h8 < 4) out_unit<false>(F, s, h8); else out_unit<true>(F, s, h8 - 4); }
    __syncthreads();
}

__device__ __forceinline__ void kv_chunk_load(Frame& F, v4u (&R)[8], const bf16* src  ) {
#pragma unroll
    for (int it = 0; it < 8; ++it) { const int ch = F.tid + NTHR * it, r = ch >> 4, cc = ch & 15; R[it] = *(const GAS v4u*)(src + (size_t)r * 4096 + 8 * cc); }
}
__device__ __forceinline__ void kv_chunk_store(Frame& F, const v4u (&R)[8], LAS unsigned char* dst) {
#pragma unroll
    for (int it = 0; it < 8; ++it) { const int ch = F.tid + NTHR * it, r = ch >> 4, cc = ch & 15; *(LAS v4u*)(dst + (r * 136 + 8 * cc) * 2) = R[it]; }
}
__device__ __forceinline__ void p8_attn(Frame& F) {
    const bf16* Q = WSP(bf16, WS_QB); const bf16* KVM = WSP(bf16, WS_KVM); bf16* att = WSP(bf16, WS_ATT);
    constexpr int CB = 256 * 136 * 2;
    const int fr = F.lane & 15, fq = F.lane >> 4, q4 = (F.lane >> 2) & 3, p4 = F.lane & 3;
    for (int u = F.bid; u < (T / 128) * 4; u += F.G) {
        const int h = u & 3, r0 = (u >> 2) * 128 + 16 * F.wave;
        v4u R[8];
        __syncthreads();
        kv_chunk_load(F, R, KVM + h * 512); kv_chunk_store(F, R, F.lds);
        __syncthreads();
        f32x4 accS[16];
#pragma unroll
        for (int i = 0; i < 16; ++i) accS[i] = (f32x4){0.f, 0.f, 0.f, 0.f};
#pragma unroll 1
        for (int dc = 0; dc < 4; ++dc) {
            kv_chunk_load(F, R, dc < 3 ? KVM + h * 512 + (dc + 1) * 128 : KVM + 2048 + h * 512);
            const LAS unsigned char* Cs = F.lds + (dc & 1) * CB;
            bf16x8_t qf[4];
#pragma unroll
            for (int ks = 0; ks < 4; ++ks) qf[ks] = *(const GAS bf16x8_t*)(Q + (size_t)(r0 + fr) * D + h * 512 + dc * 128 + 32 * ks + 8 * fq);
#pragma unroll
            for (int ks = 0; ks < 4; ++ks)
#pragma unroll
                for (int nt = 0; nt < 16; ++nt) accS[nt] = MFMA16(frag_row(Cs, 136, 16 * nt, 32 * ks, F.lane), qf[ks], accS[nt]);
            kv_chunk_store(F, R, F.lds + ((dc + 1) & 1) * CB);
            __syncthreads();
        }
        float mx = -3.0e38f;
#pragma unroll
        for (int nt = 0; nt < 16; ++nt)
#pragma unroll
            for (int jj = 0; jj < 4; ++jj) mx = fmaxf(mx, accS[nt][jj]);
        mx = fmaxf(mx, __shfl_xor(mx, 16)); mx = fmaxf(mx, __shfl_xor(mx, 32));
        const float sl2 = 0.04419417382415922f * 1.4426950408889634f;
        float sm = 0.f;
#pragma unroll
        for (int nt = 0; nt < 16; ++nt)
#pragma unroll
            for (int jj = 0; jj < 4; ++jj) { const float p = __builtin_amdgcn_exp2f((accS[nt][jj] - mx) * sl2); accS[nt][jj] = p; sm += p; }
        sm += __shfl_xor(sm, 16); sm += __shfl_xor(sm, 32);
        const float inv = 1.0f / sm;
        bf16x8_t pf[8];
#pragma unroll
        for (int ks2 = 0; ks2 < 8; ++ks2) { v4u w; w.x = pk2(accS[2 * ks2][0] * inv, accS[2 * ks2][1] * inv); w.y = pk2(accS[2 * ks2][2] * inv, accS[2 * ks2][3] * inv);
            w.z = pk2(accS[2 * ks2 + 1][0] * inv, accS[2 * ks2 + 1][1] * inv); w.w = pk2(accS[2 * ks2 + 1][2] * inv, accS[2 * ks2 + 1][3] * inv); pf[ks2] = __builtin_bit_cast(bf16x8_t, w); }
#pragma unroll 1
        for (int ec = 0; ec < 4; ++ec) {
            if (ec < 3) kv_chunk_load(F, R, KVM + 2048 + h * 512 + (ec + 1) * 128);
            const LAS unsigned char* Cs = F.lds + (ec & 1) * CB;
            f32x4 accO[8];
#pragma unroll
            for (int i = 0; i < 8; ++i) accO[i] = (f32x4){0.f, 0.f, 0.f, 0.f};
#pragma unroll
            for (int ks2 = 0; ks2 < 8; ++ks2)
#pragma unroll
                for (int et = 0; et < 8; ++et) { const LAS unsigned char* a = Cs + ((32 * ks2 + 4 * fq + q4) * 136 + 16 * et + 4 * p4) * 2;
                    const s16x4_t lo = lds_tr(a), hi = lds_tr(a + 16 * 136 * 2);
                    accO[et] = MFMA16(__builtin_shufflevector(lo, hi, 0, 1, 2, 3, 4, 5, 6, 7), pf[ks2], accO[et]); }
#pragma unroll
            for (int et = 0; et < 8; ++et) { v2u w; w.x = pk2(accO[et][0], accO[et][1]); w.y = pk2(accO[et][2], accO[et][3]);
                *(GAS v2u*)(att + (size_t)(r0 + fr) * D + h * 512 + ec * 128 + 16 * et + 4 * fq) = w; }
            if (ec < 3) kv_chunk_store(F, R, F.lds + ((ec + 1) & 1) * CB);
            __syncthreads();
        }
    }
}

__device__ __forceinline__ void p10_ln_router(Frame& F) {
    const float* Y = WSP(float, WS_Y2); const float* g = F.in[14]; const float* b = F.in[15]; bf16* HB = WSP(bf16, WS_H2B); float* st = WSP(float, WS_ST2);
    const float* Wg = F.in[16]; const float* We = F.in[18];
    LAS float* stl = (LAS float*)F.lds;
    LAS float* part = (LAS float*)(F.lds + 1024);
    LAS int* lcnt = (LAS int*)(F.lds + 1024 + 24576);
    LAS int* lbase = lcnt + 32;
    if (F.tid < 32) lcnt[F.tid] = 0;
    { int* tok = WSP(int, WS_TOK); for (int i = F.bid * NTHR + F.tid; i < PMAX; i += F.G * NTHR) tok[i] = 0; }
    __syncthreads();
    const int fr = F.lane & 15, fq = F.lane >> 4;
    for (int item = F.bid; item < T / 32; item += F.G) {
        const int row0 = item * 32;
#pragma unroll
        for (int i = 0; i < 4; ++i) {
            const int t = row0 + 4 * F.wave + i;
            const GAS f32x4* yr = (const GAS f32x4*)(Y + (size_t)t * D) + F.lane;
            f32x4 v[8]; float s = 0.f;
#pragma unroll
            for (int j = 0; j < 8; ++j) { v[j] = yr[64 * j]; s += (v[j][0] + v[j][1]) + (v[j][2] + v[j][3]); }
            const float mean = wave_sum(s) * (1.f / D); float s2 = 0.f;
#pragma unroll
            for (int j = 0; j < 8; ++j) { v[j] = v[j] - mean; s2 += (v[j][0] * v[j][0] + v[j][1] * v[j][1]) + (v[j][2] * v[j][2] + v[j][3] * v[j][3]); }
            const float rstd = 1.f / sqrtf(wave_sum(s2) * (1.f / D) + LN_EPS);
            if (F.lane == 0) { st[2 * t] = mean; st[2 * t + 1] = rstd; stl[2 * (4 * F.wave + i)] = mean; stl[2 * (4 * F.wave + i) + 1] = rstd; }
            GAS v2u* o8 = (GAS v2u*)(HB + (size_t)t * D) + F.lane;
#pragma unroll
            for (int j = 0; j < 8; ++j) { const f32x4 gv = *(const f32x4*)(g + 4 * F.lane + 256 * j), bv = *(const f32x4*)(b + 4 * F.lane + 256 * j);
                const f32x4 hv = v[j] * rstd * gv + bv;
                v2u w; w.x = pk2(hv[0], hv[1]); w.y = pk2(hv[2], hv[3]); o8[64 * j] = w; }
        }
        __syncthreads();
        {
            const int rt = F.wave >> 2, kq = F.wave & 3;
            const int r = row0 + 16 * rt + fr;
            const float mu = stl[2 * (16 * rt + fr)], rstd = stl[2 * (16 * rt + fr) + 1];
            f32x4 acc0 = {0.f, 0.f, 0.f, 0.f}, acc1 = acc0, acc2 = acc0;
            const float* yp = Y + (size_t)r * D + 512 * kq + 4 * fq;
            const float* wep = We + (size_t)(512 * kq + 4 * fq) * 32 + fr;
            const float* wgp = Wg + (size_t)(512 * kq + 4 * fq) * 4 + (fr & 3);
            const float gm = fr < 4 ? 1.f : 0.f;
#pragma unroll 8
            for (int it = 0; it < 32; ++it) {
                const int k0 = 16 * it;
                const f32x4 y4 = *(const GAS f32x4*)(yp + k0), g4 = *(const f32x4*)(g + 512 * kq + 4 * fq + k0), b4 = *(const f32x4*)(b + 512 * kq + 4 * fq + k0);
                const f32x4 a = (y4 - mu) * rstd * g4 + b4;
#pragma unroll
                for (int s = 0; s < 4; ++s) {
                    const float b0 = wep[(size_t)(k0 + s) * 32], b1 = wep[(size_t)(k0 + s) * 32 + 16], b2 = wgp[(size_t)(k0 + s) * 4] * gm;
                    acc0 = __builtin_amdgcn_mfma_f32_16x16x4f32(a[s], b0, acc0, 0, 0, 0);
                    acc1 = __builtin_amdgcn_mfma_f32_16x16x4f32(a[s], b1, acc1, 0, 0, 0);
                    acc2 = __builtin_amdgcn_mfma_f32_16x16x4f32(a[s], b2, acc2, 0, 0, 0);
                }
            }
            LAS float* pw = part + F.wave * 768;
#pragma unroll
            for (int jj = 0; jj < 4; ++jj) { pw[(4 * fq + jj) * 48 + fr] = acc0[jj]; pw[(4 * fq + jj) * 48 + 16 + fr] = acc1[jj]; pw[(4 * fq + jj) * 48 + 32 + fr] = acc2[jj]; }
        }
        __syncthreads();
        int e1 = 0, e2 = 0, r1 = 0, r2 = 0; float g1 = 0.f, g2 = 0.f;
        if (F.tid < 32) {
            const int rt = F.tid >> 4, rr = F.tid & 15;
            float le[32], lg[4];
#pragma unroll
            for (int c = 0; c < 32; ++c) { float s = 0.f;
#pragma unroll
                for (int kq = 0; kq < 4; ++kq) s += part[(rt * 4 + kq) * 768 + rr * 48 + c]; le[c] = s; }
#pragma unroll
            for (int c = 0; c < 4; ++c) { float s = 0.f;
#pragma unroll
                for (int kq = 0; kq < 4; ++kq) s += part[(rt * 4 + kq) * 768 + rr * 48 + 32 + c]; lg[c] = s + F.in[17][c]; }
            int grp = 0; float gmx = lg[0];
#pragma unroll
            for (int i = 1; i < 4; ++i) if (lg[i] > gmx) { gmx = lg[i]; grp = i; }
            float gs = 0.f;
#pragma unroll
            for (int i = 0; i < 4; ++i) gs += expf(lg[i] - gmx);
            const float pg_sel = 1.0f / gs;
            float fe[8];
#pragma unroll
            for (int j = 0; j < 8; ++j) { const float a = grp == 0 ? le[j] : grp == 1 ? le[8 + j] : grp == 2 ? le[16 + j] : le[24 + j]; fe[j] = a + F.in[19][grp * 8 + j]; }
            int i1 = 0; float m1 = fe[0];
#pragma unroll
            for (int j = 1; j < 8; ++j) if (fe[j] > m1) { m1 = fe[j]; i1 = j; }
            int i2 = -1; float m2 = -3.0e38f;
#pragma unroll
            for (int j = 0; j < 8; ++j) if (j != i1 && fe[j] > m2) { m2 = fe[j]; i2 = j; }
            const float p2 = expf(m2 - m1), den = 1.0f / (1.0f + p2);
            e1 = grp * 8 + i1; e2 = grp * 8 + i2; g1 = pg_sel * den; g2 = pg_sel * p2 * den;
            r1 = __hip_atomic_fetch_add((int*)(lcnt + e1), 1, __ATOMIC_RELAXED, __HIP_MEMORY_SCOPE_WORKGROUP); r2 = __hip_atomic_fetch_add((int*)(lcnt + e2), 1, __ATOMIC_RELAXED, __HIP_MEMORY_SCOPE_WORKGROUP);
        }
        __syncthreads();
        if (F.tid < 32) { const int c = lcnt[F.tid];
            lbase[F.tid] = c ? (int)__hip_atomic_fetch_add((unsigned*)(F.ctl + CW_CUR) + F.tid, (unsigned)c, __ATOMIC_RELAXED, __HIP_MEMORY_SCOPE_AGENT) : 0; }
        __syncthreads();
        if (F.tid < 32) {
            const int t = row0 + F.tid;
            int* ex = WSP(int, WS_EXP); float* gt = WSP(float, WS_GATE); int* sl = WSP(int, WS_SLOT);
            ex[2 * t] = e1; ex[2 * t + 1] = e2; gt[2 * t] = g1; gt[2 * t + 1] = g2;
            sl[2 * t] = lbase[e1] + r1; sl[2 * t + 1] = lbase[e2] + r2;
            lcnt[F.tid] = 0;
        }
        __syncthreads();
    }
}


#define XB_TMO      128
#define XB_XCNT(j)  (256  + 64 * (j))
#define XB_XSUB(j)  (1280 + 64 * (j))
#define XB_XGEN(j)  (2304 + 64 * (j))
#define XB_TOP      3328
#define XB_TOPGEN   3392
#define XCD_BAR_WORDS 3456
#define XB_SPIN_CAP (1u << 22)
__device__ __forceinline__ unsigned xb_ld(unsigned* p)              { return __hip_atomic_load(p, __ATOMIC_RELAXED, __HIP_MEMORY_SCOPE_AGENT); }
__device__ __forceinline__ unsigned xb_add(unsigned* p, unsigned v) { return __hip_atomic_fetch_add(p, v, __ATOMIC_RELAXED, __HIP_MEMORY_SCOPE_AGENT); }
__device__ __forceinline__ unsigned xb_xcc_id() { return (unsigned)__builtin_amdgcn_s_getreg((3 << 11) | 20) & 0xFu; }
#define XB_SPIN(cond, bar) do { unsigned _sp = 0; while (cond) { __builtin_amdgcn_s_sleep(1); \
    if ((++_sp & 255u) == 0u) { if (xb_ld(&(bar)[XB_TMO])) break; if (_sp > XB_SPIN_CAP) { atomicAdd(&(bar)[XB_TMO], 1u); break; } } } } while (0)
struct XcdBarrier { unsigned* bar; unsigned x; volatile LAS unsigned* st; };
__device__ __forceinline__ XcdBarrier xcd_barrier_post(unsigned* bar, volatile LAS unsigned* st) {
    XcdBarrier b; b.bar = bar; b.x = xb_xcc_id(); b.st = st;
    if (threadIdx.x == 0) (void)xb_add(&bar[XB_XCNT(b.x)], 1u);
    return b;
}
__device__ __forceinline__ void xcd_barrier_complete(unsigned* bar, unsigned x, unsigned& nloc, unsigned& nx) {
    const unsigned G = gridDim.x * gridDim.y * gridDim.z;
    unsigned sum, cnt, mine, sp = 0u;
    for (;;) {
        sum = 0u; cnt = 0u; mine = 0u;
#pragma unroll
        for (unsigned j = 0; j < 16; ++j) { const unsigned c = xb_ld(&bar[XB_XCNT(j)]); sum += c; cnt += (c > 0u) ? 1u : 0u; mine = (j == x) ? c : mine; }
        if (sum == G) break;
        __builtin_amdgcn_s_sleep(1);
        if ((++sp & 255u) == 0u) { if (xb_ld(&bar[XB_TMO])) break; if (sp > XB_SPIN_CAP) { atomicAdd(&bar[XB_TMO], 1u); break; } }
    }
    nloc = mine > 0u ? mine : 1u; nx = cnt > 0u ? cnt : 1u;
}
__device__ __forceinline__ void xcd_barrier(const XcdBarrier& b) {
    asm volatile("s_waitcnt vmcnt(0)" ::: "memory");
    __syncthreads();
    if (threadIdx.x == 0) {
        unsigned* bar = b.bar;
        __builtin_amdgcn_s_waitcnt(0);
        unsigned nloc = b.st[0], nx = b.st[1];
        if (nloc == 0u) { xcd_barrier_complete(bar, b.x, nloc, nx); b.st[0] = nloc; b.st[1] = nx; }
        const unsigned old = xb_add(&bar[XB_XSUB(b.x)], 1u);
        const unsigned gen = old / nloc;
        if (old + 1u == (gen + 1u) * nloc) {
            __builtin_amdgcn_fence(__ATOMIC_RELEASE, "agent");
            asm volatile("s_waitcnt vmcnt(0)" ::: "memory");
            const unsigned og = xb_add(&bar[XB_TOP], 1u);
            const unsigned tg = og / nx;
            if (og + 1u == (tg + 1u) * nx) xb_add(&bar[XB_TOPGEN], 1u);
            else XB_SPIN(xb_ld(&bar[XB_TOPGEN]) == tg, bar);
            __builtin_amdgcn_fence(__ATOMIC_ACQUIRE, "agent");
            xb_add(&bar[XB_XGEN(b.x)], 1u);
            asm volatile("s_waitcnt vmcnt(0)" ::: "memory");
        } else {
            XB_SPIN(xb_ld(&bar[XB_XGEN(b.x)]) == gen, bar);
            __builtin_amdgcn_fence(__ATOMIC_ACQUIRE, "agent");
            asm volatile("s_waitcnt vmcnt(0)" ::: "memory");
        }
    }
    __syncthreads();
}

struct Args { const float* in[25]; float* out; unsigned char* ws; int ph_lo, ph_hi, use_bar, pad; };
__global__ void __launch_bounds__(NTHR, 2) mega(Args args) {
    extern __shared__ __attribute__((aligned(16))) unsigned char lds[];
    Frame F;
    F.lds = (LAS unsigned char*)lds;
    F.MISC = (volatile LAS unsigned*)(F.lds + MISC_OFF);
    F.tid = threadIdx.x; F.lane = F.tid & 63; F.wave = __builtin_amdgcn_readfirstlane(F.tid >> 6);
    F.G = gridDim.x; F.bid = blockIdx.x;
    F.ws = args.ws; F.ctl = (gu32*)(args.ws + WS_CTL);
#pragma unroll
    for (int i = 0; i < 25; ++i) F.in[i] = args.in[i];
    F.out = args.out;
    for (int u = F.tid; u < (LDS_BYTES - LDSCTL_OFF) / 4; u += NTHR) ((LAS unsigned*)(F.lds + LDSCTL_OFF))[u] = 0u;
    __syncthreads();
    LAS int* ts = (LAS int*)(F.lds + MISC_OFF + 64);
    XcdBarrier bar; bar.bar = (unsigned*)(F.ctl + CW_BAR); bar.x = 0; bar.st = nullptr;
    if (args.use_bar) bar = xcd_barrier_post((unsigned*)(F.ctl + CW_BAR), F.MISC + 8);
    const int lo = args.ph_lo, hi = args.ph_hi;
#if MK_CG_SYNC == 2
    if (args.use_bar == 2) cooperative_groups::this_grid().sync();
#endif
#define IN(k) (lo <= (k) && (k) < hi)
#define REPS(k) for (int _r = 0; _r < ((k) == PROBE_PH ? PROBE_N : 1); ++_r)
#define SEAM(k) do { if (IN(k) && IN((k) + 1)) { if (MK_CG_SYNC == 1 && (k) == 0) cooperative_groups::this_grid().sync(); else { xcd_barrier(bar); if (PROBE_PH == 100) for (int _b = 1; _b < PROBE_N; ++_b) xcd_barrier(bar); } } } while (0)

    if (IN(0)) { REPS(0) p0_prologue(F); SEAM(0); }
    if (IN(1)) {
        p1_bcum(F, F.bid, F.G);
        const int g8 = F.bid >> 3, nsb = (g8 * 9) >> 5; const bool streamer = (F.G == 256) && ((((g8 + 1) * 9) >> 5) != nsb);
        if (!streamer) {
            pg8::Gemm g{WSP(pg8::bf16_t, WS_XB), WSP(pg8::bf16_t, WS_WIN), T + MEMN, HW + 4096, D}; pg8::OrderG1 S;
            if (F.G == 256) S.init(F.G - 72, F.bid - 8 * nsb); else S.init(F.G, F.bid);
            pg8::EpiH E{WSP(pg8::bf16_t, WS_H), WSP(pg8::bf16_t, WS_KVM), WSP(float, WS_RC), WSP(float, WS_RS)};
            pg8::gemm_phase<pg8::EpiH, pg8::OrderG1, true, true>(F.lds, g, S, E);
        }
        transpose_queue(F);
        if (PROBE_PH == 102) for (int _q = 1; _q < PROBE_N; ++_q) transpose_queue(F, _q);
        SEAM(1);
    }
#if PROBE_PH == 101
    if (IN(1)) {
        pg8::Gemm g{WSP(pg8::bf16_t, WS_XB), WSP(pg8::bf16_t, WS_WIN), T + MEMN, HW + 4096, D}; pg8::OrderG1 S; S.init(F.G, F.bid);
        pg8::EpiH E{WSP(pg8::bf16_t, WS_H), WSP(pg8::bf16_t, WS_KVM), WSP(float, WS_RC), WSP(float, WS_RS)};
        pg8::gemm_phase<pg8::EpiH, pg8::OrderG1, true, true>(F.lds, g, S, E);
        xcd_barrier(bar);
    }
#endif
    if (IN(2)) { REPS(2) p2_kv(F); SEAM(2); }
    if (IN(3)) { p3_scan(F); SEAM(3); }
#if PROBE_PH == 103
    if (IN(3)) { p2_kv(F); xcd_barrier(bar); p3_scan(F); xcd_barrier(bar); }
#endif
    if (IN(4)) { REPS(4) p4_out(F); SEAM(4); }
    if (IN(5)) {
        pg8::Gemm g{WSP(pg8::bf16_t, WS_MIXED), WSP(pg8::bf16_t, WS_WMIX), T, D, D}; pg8::StaticOrder S; S.init(T, D, F.G, F.bid);
        pg8::EpiResX E{F.in[0], WSP(float, WS_Y1), ALPHA};
        REPS(5) pg8::gemm_phase<pg8::EpiResX, pg8::StaticOrder, true, true>(F.lds, g, S, E);
        SEAM(5);
    }
    if (IN(6)) { REPS(6) ln_apply_plain(F, WSP(float, WS_Y1), F.in[8], F.in[9], WSP(bf16, WS_H1B), WSP(float, WS_ST1)); SEAM(6); }
    if (IN(7)) {
        pg8::Gemm g{WSP(pg8::bf16_t, WS_H1B), WSP(pg8::bf16_t, WS_WMQ), T, D, D}; pg8::StaticOrder S; S.init(T, D, F.G, F.bid);
        pg8::EpiB E{WSP(pg8::bf16_t, WS_QB), D, -1, 8192u * 2048u * 2u};
        REPS(7) pg8::gemm_phase<pg8::EpiB, pg8::StaticOrder, true, true>(F.lds, g, S, E);
        SEAM(7);
    }
    if (IN(8)) { REPS(8) p8_attn(F); SEAM(8); }
    if (IN(9)) {
        pg8::Gemm g{WSP(pg8::bf16_t, WS_ATT), WSP(pg8::bf16_t, WS_WMO), T, D, D}; pg8::StaticOrder S; S.init(T, D, F.G, F.bid);
        pg8::EpiResLN E{WSP(float, WS_Y1), WSP(float, WS_ST1), F.in[8], F.in[9], WSP(float, WS_Y2), ALPHA};
        REPS(9) pg8::gemm_phase<pg8::EpiResLN, pg8::StaticOrder, true, true>(F.lds, g, S, E);
        SEAM(9);
    }
    if (IN(10)) { p10_ln_router(F); SEAM(10); }
    if (IN(11)) { moe_tile_starts(F, ts); p10_dispatch(F, ts); SEAM(11); }
#if MK_MOE_F32
#define MOE_GEMM_GU(l, g, S, E) pg8::gemm_phase_bf32<pg8::EpiSwi, pg8::MoeOrder, true, true, true>(l, g, S, E)
#define MOE_GEMM_DN(l, g, S, E) pg8::gemm_phase_bf32<pg8::EpiB, pg8::MoeOrder, true, false, false>(l, g, S, E)
#else
#define MOE_GEMM_GU(l, g, S, E) pg8::gemm_phase<pg8::EpiSwi, pg8::MoeOrder, true, true, true>(l, g, S, E)
#define MOE_GEMM_DN(l, g, S, E) pg8::gemm_phase<pg8::EpiB, pg8::MoeOrder, true, true>(l, g, S, E)
#endif
    if (IN(12)) {
        moe_tile_starts(F, ts);
        const int U = ts[32] * 4;
        pg8::Gemm g{WSP(pg8::bf16_t, WS_H2B), WSP(pg8::bf16_t, WS_WGU), PMAX, 32 * 1024, D, WSP(int, WS_TOK)};
        pg8::MoeOrder S{(const PG8_LAS int*)ts, F.G, F.bid, 4, U < F.G ? U : F.G, F.in[20], F.in[21], 2048, 512, 0};
        pg8::EpiSwi E{WSP(pg8::bf16_t, WS_HID)};
        MOE_GEMM_GU(F.lds, g, S, E);
        SEAM(12);
    }
    if (IN(13)) {
        moe_tile_starts(F, ts);
        const int RT = ts[32], U = RT * 4, nbg = U > F.G ? U - F.G : 0, R1 = (F.G / 4) < RT ? (F.G / 4) : RT;
        {
            pg8::Gemm g{WSP(pg8::bf16_t, WS_H2B), WSP(pg8::bf16_t, WS_WGU), PMAX, 32 * 1024, D, WSP(int, WS_TOK)};
            pg8::MoeOrder S{(const PG8_LAS int*)ts, F.G, F.bid, 4, U, F.in[20], F.in[21], 2048, 512, F.G};
            pg8::EpiSwi E{WSP(pg8::bf16_t, WS_HID)};
            MOE_GEMM_GU(F.lds, g, S, E);
        }
        {
            pg8::Gemm g{WSP(pg8::bf16_t, WS_HID), WSP(pg8::bf16_t, WS_WD), PMAX, 32 * 2048, 512};
            pg8::MoeOrder S{(const PG8_LAS int*)ts, F.G - nbg, F.bid >= nbg ? F.bid - nbg : -1, 8, R1 * 8, F.in[22], nullptr, 512, 2048, 0};
            pg8::EpiB E{WSP(pg8::bf16_t, WS_YS), D, 7, 24576u * 2048u * 2u};
            MOE_GEMM_DN(F.lds, g, S, E);
        }
        SEAM(13);
    }
    if (IN(14)) {
        moe_tile_starts(F, ts);
        const int RT = ts[32], R1 = (F.G / 4) < RT ? (F.G / 4) : RT;
        pg8::Gemm g{WSP(pg8::bf16_t, WS_HID), WSP(pg8::bf16_t, WS_WD), PMAX, 32 * 2048, 512};
        pg8::MoeOrder S{(const PG8_LAS int*)ts, F.G, F.bid, 8, RT * 8, F.in[22], nullptr, 512, 2048, R1 * 8};
        pg8::EpiB E{WSP(pg8::bf16_t, WS_YS), D, 7, 24576u * 2048u * 2u};
        MOE_GEMM_DN(F.lds, g, S, E);
        SEAM(14);
    }
    if (IN(15)) { REPS(15) p13_combine(F); }
#undef IN
#undef SEAM
#undef REPS
}

extern "C" void kernel_launch(void* const* d_in, const int* in_sizes, int n_in, void* d_out, int out_size, void* d_ws, size_t ws_size, hipStream_t stream) {
    static int grid = 0;
    if (grid == 0) {
        if (n_in != 25 || in_sizes[0] != T * D || out_size != T * D || ws_size < WS_END) { fprintf(stderr, "kernel_launch: unexpected shapes / workspace (%d inputs, ws %zu)\n", n_in, ws_size); grid = -1; return; }
        int dev = 0, cus = 0;
        if (hipGetDevice(&dev) != hipSuccess || hipDeviceGetAttribute(&cus, hipDeviceAttributeMultiprocessorCount, dev) != hipSuccess) { grid = -1; return; }
        if (hipFuncSetAttribute((const void*)mega, hipFuncAttributeMaxDynamicSharedMemorySize, LDS_BYTES) != hipSuccess) { fprintf(stderr, "kernel_launch: hipFuncSetAttribute failed\n"); grid = -1; return; }
        int per_cu = 0;
        if (hipOccupancyMaxActiveBlocksPerMultiprocessor(&per_cu, (const void*)mega, NTHR, LDS_BYTES) != hipSuccess || per_cu < 1) { fprintf(stderr, "kernel_launch: occupancy query failed / 0 blocks per CU\n"); grid = -1; return; }
        (void)hipGetLastError();
        grid = cus;
    }
    if (grid < 0) return;
    if (hipMemsetAsync((char*)d_ws + WS_CTL, 0, CTL_ZERO_BYTES, stream) != hipSuccess) return;
    Args a{};
    for (int i = 0; i < 25; ++i) a.in[i] = (const float*)d_in[i];
    a.out = (float*)d_out; a.ws = (unsigned char*)d_ws;
#if MK_ONE_LAUNCH
    a.ph_lo = 0; a.ph_hi = NPH; a.use_bar = 1;
#if MK_CG_SYNC
    { void* kargs[] = {(void*)&a};
      hipError_t e = hipLaunchCooperativeKernel((const void*)mega, dim3(grid), dim3(NTHR), kargs, LDS_BYTES, stream);
      if (e != hipSuccess) fprintf(stderr, "cooperative launch failed: %s (grid %d)\n", hipGetErrorString(e), grid); }
#else
    hipLaunchKernelGGL(mega, dim3(grid), dim3(NTHR), LDS_BYTES, stream, a);
#endif
#else
    for (int p = 0; p < NPH; ++p) { a.ph_lo = p; a.ph_hi = p + 1; a.use_bar = 0;
        hipLaunchKernelGGL(mega, dim3(grid), dim3(NTHR), LDS_BYTES, stream, a); }
#endif
}
```

```cpp
#include <hip/hip_runtime.h>
#include <hip/hip_cooperative_groups.h>
#include <cstdio>
#include <cstdint>
#include <cmath>
#ifndef MK_ONE_LAUNCH
#define MK_ONE_LAUNCH 1
#endif
#ifndef MK_CG_SYNC
#define MK_CG_SYNC 2
#endif
#ifndef MK_WT_STORES
#define MK_WT_STORES 0
#endif
#ifndef MK_MOE_F32
#define MK_MOE_F32 0
#endif
#define PROBE_PH -1
#define PROBE_N 1
namespace pg8 {
#define PG8_LAS __attribute__((address_space(3)))
typedef unsigned short bf16_t;
typedef short bf16x8 __attribute__((ext_vector_type(8)));
typedef float f32x4 __attribute__((ext_vector_type(4)));
typedef unsigned u32x4 __attribute__((ext_vector_type(4)));
constexpr int BM = 256, BK = 64, HALF = 128, HTB = HALF * BK * 2  , STAGE_BYTES = 8 * HTB, NXCD = 8, WGM = 8;

__host__ __device__ __forceinline__ int lds_byte(int r, int c) { const int st = (r >> 4) * 2 + (c >> 5), rr = r & 15, cc = c & 31, ob = rr * 64 + cc * 2; return st * 1024 + (ob ^ (((ob >> 9) & 1) << 5)); }
__host__ __device__ __forceinline__ void stage_rc(int b, int& R, int& C) { const int st = b / 1024, sb = b % 1024, swz = sb ^ (((sb >> 9) & 1) << 5); R = (st >> 1) * 16 + swz / 64; C = (st & 1) * 32 + (swz % 64) / 2; }
__host__ __device__ __forceinline__ int perm32(int rho) { const int n = rho >> 4, i = rho & 15; return 8 * (i >> 2) + 4 * n + (i & 3); }

struct Unit { int pm, pn; };
struct Gemm { const bf16_t* A; const bf16_t* Bt; int M, N, K; const int* tok; };

struct StaticOrder {
    int nM, nN, nwg, G, c;
    __host__ __device__ void init(int M, int N, int G_, int c_) { nM = M / BM; nN = N / BM; nwg = nM * nN; G = G_; c = c_; }
    __host__ __device__ bool next(int i, Unit& u) const {
        const long L = (long)i * G + c; if (L >= nwg) return false;
        int wgid = (int)L; { const int q = nwg / NXCD, r = nwg % NXCD, xcd = wgid % NXCD, off = wgid / NXCD; wgid = (xcd < r ? xcd * (q + 1) : r * (q + 1) + (xcd - r) * q) + off; }
        const int nig = WGM * nN, gid = wgid / nig, fm = gid * WGM, gsz = (nM - fm) < WGM ? (nM - fm) : WGM;
        u.pm = fm + ((wgid % nig) % gsz); u.pn = (wgid % nig) / gsz; return true;
    }
    __device__ __forceinline__ void a_ready(const Unit&) const {}
    __device__ __forceinline__ void done(const Unit&) const {}
};


typedef unsigned u32x2 __attribute__((ext_vector_type(2)));
__device__ __forceinline__ unsigned cvt_pk_bf16(float lo, float hi) { unsigned r; asm volatile("v_cvt_pk_bf16_f32 %0, %1, %2" : "=v"(r) : "v"(lo), "v"(hi)); return r; }
__device__ __forceinline__ u32x4 pack8(const f32x4 a, const f32x4 b) { u32x4 w; w.x = cvt_pk_bf16(a[0], a[1]); w.y = cvt_pk_bf16(a[2], a[3]); w.z = cvt_pk_bf16(b[0], b[1]); w.w = cvt_pk_bf16(b[2], b[3]); return w; }
#if MK_WT_STORES
#define PG8_RSRC(base, bytes) __builtin_amdgcn_make_buffer_rsrc((void*)(base), 0, (int)(bytes), 0x00020000)
#define PG8_ST16(rs, base, byteoff, val) __builtin_amdgcn_raw_buffer_store_b128(__builtin_bit_cast(u32x4, (val)), (rs), (unsigned)(byteoff), 0, 16)
#else
#define PG8_RSRC(base, bytes) 0
#define PG8_ST16(rs, base, byteoff, val) (*(u32x4*)((char*)(base) + (size_t)(byteoff)) = __builtin_bit_cast(u32x4, (val)))
#endif
__device__ __forceinline__ float silu_f(float x) { return x * __builtin_amdgcn_rcpf(1.0f + __builtin_amdgcn_exp2f(-1.4426950408889634f * x)); }

struct EpiH {
    static constexpr bool PERM = true, AFTER_DRAIN = false;
    bf16_t* H; bf16_t* KVM; const float* rc; const float* rs;
    __device__ __forceinline__ void operator()(const f32x4 (&acc)[2][2][4][2], const Unit& u, int wr, int wc, int fr, int fq) const {
        const int cb = wc * 32 + 8 * fq;
        const auto rsH = PG8_RSRC(H, 8192u * 7168u * 2u); (void)rsH;
        if (u.pm >= 32) {
#pragma unroll
            for (int ai = 0; ai < 2; ++ai)
#pragma unroll
                for (int m = 0; m < 4; ++m) { bf16_t* rowp = KVM + (size_t)(wr * 64 + fr + ai * HALF + m * 16) * 4096 + (u.pn - 28) * BM + cb;
#pragma unroll
                    for (int bj = 0; bj < 2; ++bj) *(u32x4*)(rowp + bj * HALF) = pack8(acc[ai][bj][m][0], acc[ai][bj][m][1]); }
            return;
        }
        const int row0 = u.pm * BM + wr * 64 + fr;
        if (u.pn < 8) {
            const float sc = u.pn >= 4 ? 0.0625f : 1.0f;
#pragma unroll
            for (int ai = 0; ai < 2; ++ai)
#pragma unroll
                for (int m = 0; m < 4; ++m) { const int row = row0 + ai * HALF + m * 16;
                    const float* cr = rc + (size_t)row * 128 + cb; const float* sr = rs + (size_t)row * 128 + cb;
                    const f32x4 c0 = *(const f32x4*)cr * sc, c1 = *(const f32x4*)(cr + 4) * sc, s0 = *(const f32x4*)sr * sc, s1 = *(const f32x4*)(sr + 4) * sc;
                    const f32x4 t1a = acc[ai][0][m][0], t1b = acc[ai][0][m][1], t2a = acc[ai][1][m][0], t2b = acc[ai][1][m][1];
                    bf16_t* rowp = H + (size_t)row * 7168 + u.pn * BM + cb;
                    const unsigned bo = (unsigned)((size_t)row * 7168 + u.pn * BM + cb) * 2u; (void)rowp;
                    PG8_ST16(rsH, H, bo, pack8(t1a * c0 - t2a * s0, t1b * c1 - t2b * s1));
                    PG8_ST16(rsH, H, bo + 2 * HALF, pack8(t1a * s0 + t2a * c0, t1b * s1 + t2b * c1)); }
        } else {
            const float sc = (u.pn == 16 || u.pn == 17) ? 0.08838834764831845f : 1.0f;
#pragma unroll
            for (int ai = 0; ai < 2; ++ai)
#pragma unroll
                for (int m = 0; m < 4; ++m) { const unsigned bo = (unsigned)((size_t)(row0 + ai * HALF + m * 16) * 7168 + u.pn * BM + cb) * 2u;
#pragma unroll
                    for (int bj = 0; bj < 2; ++bj) PG8_ST16(rsH, H, bo + bj * 2 * HALF, pack8(acc[ai][bj][m][0] * sc, acc[ai][bj][m][1] * sc)); }
        }
    }
};
struct EpiB {
    static constexpr bool PERM = true, AFTER_DRAIN = false;
    bf16_t* O; int ldc; int pmask; unsigned obytes;
    __device__ __forceinline__ void operator()(const f32x4 (&acc)[2][2][4][2], const Unit& u, int wr, int wc, int fr, int fq) const {
        const int row0 = u.pm * BM + wr * 64 + fr, col0 = (u.pn & pmask) * BM + wc * 32 + 8 * fq;
        const auto rsO = PG8_RSRC(O, obytes); (void)rsO;
#pragma unroll
        for (int ai = 0; ai < 2; ++ai)
#pragma unroll
            for (int m = 0; m < 4; ++m) { const unsigned bo = (unsigned)((size_t)(row0 + ai * HALF + m * 16) * ldc + col0) * 2u;
#pragma unroll
                for (int bj = 0; bj < 2; ++bj) PG8_ST16(rsO, O, bo + bj * 2 * HALF, pack8(acc[ai][bj][m][0], acc[ai][bj][m][1])); }
    }
};
struct EpiSwi {
    static constexpr bool PERM = true, AFTER_DRAIN = false;
    bf16_t* O;
    __device__ __forceinline__ void operator()(const f32x4 (&acc)[2][2][4][2], const Unit& u, int wr, int wc, int fr, int fq) const {
        const int row0 = u.pm * BM + wr * 64 + fr, col0 = (u.pn & 3) * HALF + wc * 32 + 8 * fq;
        const auto rsO = PG8_RSRC(O, 24576u * 512u * 2u); (void)rsO;
#pragma unroll
        for (int ai = 0; ai < 2; ++ai)
#pragma unroll
            for (int m = 0; m < 4; ++m) { const unsigned bo = (unsigned)((size_t)(row0 + ai * HALF + m * 16) * 512 + col0) * 2u;
                f32x4 h0, h1;
#pragma unroll
                for (int i = 0; i < 4; ++i) { h0[i] = silu_f(acc[ai][0][m][0][i]) * acc[ai][1][m][0][i]; h1[i] = silu_f(acc[ai][0][m][1][i]) * acc[ai][1][m][1][i]; }
                PG8_ST16(rsO, O, bo, pack8(h0, h1)); }
    }
};
struct EpiResX {
    static constexpr bool PERM = false, AFTER_DRAIN = false;
    const float* X; float* Y; float alpha;
    __device__ __forceinline__ void operator()(const f32x4 (&acc)[2][2][4][2], const Unit& u, int wr, int wc, int fr, int fq) const {
        const int row0 = u.pm * BM + wr * 64 + fr, col0 = u.pn * BM + wc * 32 + 4 * fq;
        const auto rsY = PG8_RSRC(Y, 8192u * 2048u * 4u); (void)rsY;
#pragma unroll
        for (int ai = 0; ai < 2; ++ai)
#pragma unroll
            for (int m = 0; m < 4; ++m) { const size_t off = (size_t)(row0 + ai * HALF + m * 16) * 2048 + col0;
#pragma unroll
                for (int bj = 0; bj < 2; ++bj)
#pragma unroll
                    for (int n = 0; n < 2; ++n) { const f32x4 xv = *(const f32x4*)(X + off + bj * HALF + n * 16); const f32x4 yv = xv * alpha + acc[ai][bj][m][n]; PG8_ST16(rsY, Y, (off + bj * HALF + n * 16) * 4, yv); } }
    }
};
struct EpiResLN {
    static constexpr bool PERM = false, AFTER_DRAIN = false;
    const float* Yin; const float* st; const float* g; const float* b; float* Y; float alpha;
    __device__ __forceinline__ void operator()(const f32x4 (&acc)[2][2][4][2], const Unit& u, int wr, int wc, int fr, int fq) const {
        const int row0 = u.pm * BM + wr * 64 + fr, col0 = u.pn * BM + wc * 32 + 4 * fq;
        const auto rsY = PG8_RSRC(Y, 8192u * 2048u * 4u); (void)rsY;
        f32x4 gv[2][2], bv[2][2];
#pragma unroll
        for (int bj = 0; bj < 2; ++bj)
#pragma unroll
            for (int n = 0; n < 2; ++n) { gv[bj][n] = *(const f32x4*)(g + col0 + bj * HALF + n * 16) * alpha; bv[bj][n] = *(const f32x4*)(b + col0 + bj * HALF + n * 16) * alpha; }
#pragma unroll
        for (int ai = 0; ai < 2; ++ai)
#pragma unroll
            for (int m = 0; m < 4; ++m) { const int row = row0 + ai * HALF + m * 16; const size_t off = (size_t)row * 2048 + col0;
                const float mu = st[2 * row], rstd = st[2 * row + 1];
#pragma unroll
                for (int bj = 0; bj < 2; ++bj)
#pragma unroll
                    for (int n = 0; n < 2; ++n) { const f32x4 yv = *(const f32x4*)(Yin + off + bj * HALF + n * 16);
                        const f32x4 yo = ((yv - mu) * rstd) * gv[bj][n] + bv[bj][n] + acc[ai][bj][m][n]; PG8_ST16(rsY, Y, (off + bj * HALF + n * 16) * 4, yo); } }
    }
};

struct OrderG1 {
    StaticOrder so; int G, c;
    __device__ void init(int G_, int c_) { so.init(8192, 7168, G_, c_); G = G_; c = c_; }
    __device__ bool next(int i, Unit& u) const {
        const int L = i * G + c;
        if (L < 896) return so.next(i, u);
        if (L >= 912) return false;
        u.pm = 32; u.pn = 28 + (L - 896); return true;
    }
    __device__ __forceinline__ void a_ready(const Unit&) const {}
    __device__ __forceinline__ void done(const Unit&) const {}
};
struct MoeOrder {
    const PG8_LAS int* ts; int G, c, npn, total; const float* W0; const float* W1; int kdim, ncols; int L0;
    __device__ bool next(int i, Unit& u) const {
        if (c < 0) return false;
        const int L = L0 + i * G + c; if (L >= total) return false;
        const int rt = L / npn, pl = L - rt * npn; int e = 0;
        for (int j = 1; j < 32; ++j) e += (ts[j] <= rt) ? 1 : 0;
        u.pm = rt; u.pn = e * npn + pl; return true;
    }
    __device__ __forceinline__ int ldb() const { return ncols; }
    __device__ __forceinline__ const float* bbase(const Unit& u, int which) const {
        const int e = u.pn / npn, pl = u.pn - e * npn; const size_t eo = (size_t)e * kdim * ncols;
        if (W1) return (which ? W1 : W0) + eo + 128 * pl;
        return W0 + eo + 256 * pl;
    }
    __device__ __forceinline__ void a_ready(const Unit&) const {}
    __device__ __forceinline__ void done(const Unit&) const {}
};

template <int MODE>
struct EpiLN {
    static constexpr bool PERM = false, AFTER_DRAIN = true;
    const float* X; const float* stin; const float* gin; const float* bin;
    float* Yout; float* stout; bf16_t* HB; const float* g; const float* b;
    unsigned long long* xbuf;
    unsigned* cnt;
    __device__ __forceinline__ void operator()(const f32x4 (&)[2][2][4][2], const Unit&, int, int, int, int) const {}
    __device__ __forceinline__ void fused(f32x4 (&acc)[2][2][4][2], const Unit& u, int wr, int wc, int fr, int fq, PG8_LAS unsigned char* lds, int wid, int lane) const {
        typedef float f32x2v __attribute__((ext_vector_type(2)));
        PG8_LAS f32x2v* P = (PG8_LAS f32x2v*)lds;
        PG8_LAS f32x2v* MS = (PG8_LAS f32x2v*)(lds + 8192);
        const int row0 = u.pm * BM + wr * 64 + fr, col0 = u.pn * BM + wc * 32 + 4 * fq;
        float s1[2][4], s2[2][4], mu[2][4], rs[2][4];
#pragma unroll
        for (int ai = 0; ai < 2; ++ai)
#pragma unroll
            for (int m = 0; m < 4; ++m) { s1[ai][m] = 0.f; s2[ai][m] = 0.f; mu[ai][m] = 0.f; rs[ai][m] = 0.f;
                if (MODE == 1) { const int row = row0 + ai * HALF + m * 16; mu[ai][m] = stin[2 * row]; rs[ai][m] = stin[2 * row + 1]; } }
#pragma unroll
        for (int bj = 0; bj < 2; ++bj)
#pragma unroll
            for (int n = 0; n < 2; ++n) {
                f32x4 gvv = {0.f, 0.f, 0.f, 0.f}, bvv = gvv;
                if (MODE == 1) { gvv = *(const f32x4*)(gin + col0 + bj * HALF + n * 16) * 1.189207115002721f; bvv = *(const f32x4*)(bin + col0 + bj * HALF + n * 16) * 1.189207115002721f; }
#pragma unroll
                for (int ai = 0; ai < 2; ++ai)
#pragma unroll
                    for (int m = 0; m < 4; ++m) { const size_t off = (size_t)(row0 + ai * HALF + m * 16) * 2048 + col0 + bj * HALF + n * 16;
                        const f32x4 xv = *(const f32x4*)(X + off);
                        const f32x4 y = (MODE == 1 ? ((xv - mu[ai][m]) * rs[ai][m]) * gvv + bvv : xv * 1.189207115002721f) + acc[ai][bj][m][n];
                        acc[ai][bj][m][n] = y; *(f32x4*)(Yout + off) = y;
                        s1[ai][m] += (y[0] + y[1]) + (y[2] + y[3]); s2[ai][m] += (y[0] * y[0] + y[1] * y[1]) + (y[2] * y[2] + y[3] * y[3]); }
            }
#pragma unroll
        for (int ai = 0; ai < 2; ++ai)
#pragma unroll
            for (int m = 0; m < 4; ++m) { float a1 = s1[ai][m], a2 = s2[ai][m];
                a1 += __shfl_xor(a1, 16); a1 += __shfl_xor(a1, 32); a2 += __shfl_xor(a2, 16); a2 += __shfl_xor(a2, 32);
                if (fq == 0) P[(ai * HALF + wr * 64 + m * 16 + fr) * 4 + wc] = (f32x2v){a1, a2}; }
        asm volatile("s_waitcnt lgkmcnt(0)" ::: "memory"); __builtin_amdgcn_s_barrier(); asm volatile("" ::: "memory");
        const int t = wid * 64 + lane;
        if (t < 256) { const f32x2v a = P[t * 4 + 0], b2 = P[t * 4 + 1], c = P[t * 4 + 2], d = P[t * 4 + 3];
            const float S1 = (a.x + b2.x) + (c.x + d.x), S2 = (a.y + b2.y) + (c.y + d.y);
            __hip_atomic_store(xbuf + ((size_t)(u.pm * 8 + u.pn) * 256 + t), ((unsigned long long)__float_as_uint(S2) << 32) | __float_as_uint(S1), __ATOMIC_RELAXED, __HIP_MEMORY_SCOPE_AGENT);
            asm volatile("s_waitcnt vmcnt(0)" ::: "memory");
            if (lane == 0) __hip_atomic_fetch_add(cnt + 64 * u.pm, 1u, __ATOMIC_RELAXED, __HIP_MEMORY_SCOPE_AGENT); }
        if (wid == 0) {
            const unsigned long long t0 = __builtin_amdgcn_s_memrealtime();
            while ((unsigned)__builtin_amdgcn_readfirstlane(__hip_atomic_load(cnt + 64 * u.pm, __ATOMIC_RELAXED, __HIP_MEMORY_SCOPE_AGENT)) < 32u) {
                if (__builtin_amdgcn_s_memrealtime() - t0 > 2000000ull) break;
                __builtin_amdgcn_s_sleep(2); }
            __builtin_amdgcn_fence(__ATOMIC_ACQUIRE, "agent");
        }
        asm volatile("s_waitcnt vmcnt(0) lgkmcnt(0)" ::: "memory"); __builtin_amdgcn_s_barrier(); asm volatile("" ::: "memory");
        if (t < 256) { float S1 = 0.f, S2 = 0.f;
#pragma unroll
            for (int j = 0; j < 8; ++j) { const unsigned long long w = __hip_atomic_load(xbuf + ((size_t)(u.pm * 8 + j) * 256 + t), __ATOMIC_RELAXED, __HIP_MEMORY_SCOPE_AGENT); S1 += __uint_as_float((unsigned)w); S2 += __uint_as_float((unsigned)(w >> 32)); }
            const float mean = S1 * (1.f / 2048.f), var = fmaxf(S2 * (1.f / 2048.f) - mean * mean, 0.f), rstd = 1.0f / sqrtf(var + 1e-5f);
            MS[t] = (f32x2v){mean, rstd};
            if (u.pn == 0) { stout[2 * (u.pm * BM + t)] = mean; stout[2 * (u.pm * BM + t) + 1] = rstd; } }
        asm volatile("s_waitcnt lgkmcnt(0)" ::: "memory"); __builtin_amdgcn_s_barrier(); asm volatile("" ::: "memory");
#pragma unroll
        for (int bj = 0; bj < 2; ++bj)
#pragma unroll
            for (int n = 0; n < 2; ++n) { const f32x4 gN = *(const f32x4*)(g + col0 + bj * HALF + n * 16), bN = *(const f32x4*)(b + col0 + bj * HALF + n * 16);
#pragma unroll
                for (int ai = 0; ai < 2; ++ai)
#pragma unroll
                    for (int m = 0; m < 4; ++m) { const int rl = ai * HALF + wr * 64 + m * 16 + fr; const f32x2v ms = MS[rl]; const size_t off = (size_t)(u.pm * BM + rl) * 2048 + col0 + bj * HALF + n * 16;
                        const f32x4 h = ((acc[ai][bj][m][n] - ms.x) * ms.y) * gN + bN;
                        u32x2 w; w.x = cvt_pk_bf16(h[0], h[1]); w.y = cvt_pk_bf16(h[2], h[3]); *(u32x2*)(HB + off) = w; } }
    }
};
template <class Epi, class Sched, bool ALIGN_EPI = false, bool SP2 = false, bool GATHER = false>
__device__ __forceinline__ void gemm_phase(PG8_LAS unsigned char* lds, const Gemm g, const Sched& S, const Epi& E) {
    const int tid = threadIdx.x, wid = __builtin_amdgcn_readfirstlane(tid >> 6), lane = tid & 63, wr = wid >> 2, wc = wid & 3, fr = lane & 15, fq = lane >> 4;
    const int K = g.K, nt = K / BK;
    unsigned voffA[2], voffB[2];
#pragma unroll
    for (int i = 0; i < 2; ++i) { int R, C; stage_rc(tid * 16 + i * 8192, R, C); const int Rb = Epi::PERM ? ((R & ~31) + perm32(R & 31)) : R;
        voffA[i] = (unsigned)(R * K + C) * 2u; voffB[i] = (unsigned)(Rb * K + C) * 2u; }
    unsigned coff[2][2], noff[2][2]; int gR[2], gC[2];
#pragma unroll
    for (int i = 0; i < 2; ++i) { int R, C; stage_rc(tid * 16 + i * 8192, R, C); gR[i] = R; gC[i] = C; coff[0][i] = coff[1][i] = noff[0][i] = noff[1][i] = 0u; }
#define PG8_GOFF(dst, pm_) do { if constexpr (GATHER) { _Pragma("unroll") for (int _h = 0; _h < 2; ++_h) _Pragma("unroll") for (int _i = 0; _i < 2; ++_i) \
        dst[_h][_i] = ((unsigned)g.tok[(pm_) * BM + _h * HALF + gR[_i]] * (unsigned)K + (unsigned)gC[_i]) * 2u; } } while (0)
    const size_t kstep = (size_t)(BK * 2);
    const size_t hstep = (size_t)HALF * K * 2;
    const size_t tstep = 2 * hstep;
    const unsigned ldsw = (unsigned)wid * 1024u;
    const int aoff = lds_byte(wr * 64 + fr, fq * 8), boff = lds_byte(wc * 32 + fr, fq * 8);
#define PG8_SA(b, h) (((b) * 2 + (h)) * HTB)
#define PG8_SB(b, h) ((4 + (b) * 2 + (h)) * HTB)
#define PG8_STAGE(bufoff, gbase, voff) do { _Pragma("unroll") for (int _i = 0; _i < 2; ++_i) \
        __builtin_amdgcn_global_load_lds((const unsigned*)((const char*)(gbase) + (voff)[_i]), (PG8_LAS unsigned*)(lds + (bufoff) + ldsw + _i * 8192), 16, 0, 0); } while (0)
#define PG8_STAGEA(bufoff, gptr, hh, kbytes, usenext) do { if constexpr (GATHER) { _Pragma("unroll") for (int _i = 0; _i < 2; ++_i) { const unsigned _o = (usenext) ? noff[hh][_i] : coff[hh][_i]; \
        __builtin_amdgcn_global_load_lds((const unsigned*)((const char*)g.A + (size_t)(kbytes) + _o), (PG8_LAS unsigned*)(lds + (bufoff) + ldsw + _i * 8192), 16, 0, 0); } } else { PG8_STAGE(bufoff, gptr, voffA); } } while (0)
#define PG8_LDA(dst, b, h) do { _Pragma("unroll") for (int m = 0; m < 4; ++m) _Pragma("unroll") for (int k = 0; k < 2; ++k) dst[m][k] = *(const PG8_LAS bf16x8*)(lds + PG8_SA(b, h) + aoff + m * 2048 + k * 1024); } while (0)
#define PG8_LDB(dst, b, h) do { _Pragma("unroll") for (int n = 0; n < 2; ++n) _Pragma("unroll") for (int k = 0; k < 2; ++k) dst[n][k] = *(const PG8_LAS bf16x8*)(lds + PG8_SB(b, h) + boff + n * 2048 + k * 1024); } while (0)
#define PG8_MMA(ai, bj, At, Bt) do { __builtin_amdgcn_s_setprio(1); _Pragma("unroll") for (int m = 0; m < 4; ++m) _Pragma("unroll") for (int n = 0; n < 2; ++n) _Pragma("unroll") for (int k = 0; k < 2; ++k) \
        acc[ai][bj][m][n] = __builtin_amdgcn_mfma_f32_16x16x32_bf16(Bt[n][k], At[m][k], acc[ai][bj][m][n], 0, 0, 0); __builtin_amdgcn_s_setprio(0); } while (0)
#define PG8_WAIT_V(n) asm volatile("s_waitcnt vmcnt(" #n ")" ::: "memory")
#define PG8_WAIT_L(n) asm volatile("s_waitcnt lgkmcnt(" #n ")" ::: "memory")
#define PG8_BAR __builtin_amdgcn_s_barrier()
#define PG8_SCHED __builtin_amdgcn_sched_barrier(0)
    Unit cur, nxt; int ui = 0;
    if (!S.next(0, cur)) return;
    f32x4 acc[2][2][4][2];
#pragma unroll
    for (int a = 0; a < 2; ++a)
#pragma unroll
        for (int b = 0; b < 2; ++b)
#pragma unroll
            for (int m = 0; m < 4; ++m)
#pragma unroll
                for (int n = 0; n < 2; ++n) acc[a][b][m][n] = (f32x4){0.f, 0.f, 0.f, 0.f};
    bf16x8 At[4][2], B0[2][2], B1[2][2];
    const char* cA = (const char*)g.A + (size_t)cur.pm * tstep; const char* cB = (const char*)g.Bt + (size_t)cur.pn * tstep;
    PG8_GOFF(coff, cur.pm);
    S.a_ready(cur);
    if constexpr (SP2) {
        PG8_STAGE(PG8_SB(0, 0), cB, voffB); PG8_STAGE(PG8_SB(0, 1), cB + hstep, voffB); PG8_STAGEA(PG8_SA(0, 0), cA, 0, 0, false); PG8_STAGEA(PG8_SA(0, 1), cA + hstep, 1, 0, false);
        if (wr == 1) PG8_BAR;
        PG8_WAIT_V(2); PG8_BAR;
        PG8_STAGE(PG8_SB(1, 0), cB + kstep, voffB); PG8_STAGEA(PG8_SA(1, 0), cA + kstep, 0, kstep, false); PG8_STAGE(PG8_SB(1, 1), cB + hstep + kstep, voffB);
        PG8_WAIT_V(6); PG8_BAR;
    } else {
        PG8_STAGE(PG8_SB(0, 0), cB, voffB); PG8_STAGE(PG8_SA(0, 0), cA, voffA); PG8_STAGE(PG8_SB(0, 1), cB + hstep, voffB); PG8_STAGE(PG8_SA(0, 1), cA + hstep, voffA);
        if (wr == 1) PG8_BAR;
        PG8_WAIT_V(4); PG8_BAR;
        PG8_STAGE(PG8_SB(1, 0), cB + kstep, voffB); PG8_STAGE(PG8_SA(1, 0), cA + kstep, voffA); PG8_STAGE(PG8_SB(1, 1), cB + hstep + kstep, voffB);
        PG8_WAIT_V(6); PG8_BAR;
    }
    for (;;) {
        const bool has_next = S.next(ui + 1, nxt);
        const char* nA = has_next ? (const char*)g.A + (size_t)nxt.pm * tstep : cA; const char* nB = has_next ? (const char*)g.Bt + (size_t)nxt.pn * tstep : cB;
        if constexpr (GATHER) { if (has_next) { PG8_GOFF(noff, nxt.pm); } else { _Pragma("unroll") for (int _h = 0; _h < 2; ++_h) _Pragma("unroll") for (int _i = 0; _i < 2; ++_i) noff[_h][_i] = coff[_h][_i]; } }
        for (int t = 0; t < nt; t += 2) {
            const bool last = (t == nt - 2);
            const char* a1 = cA + (size_t)(t + 1) * kstep;
            const char* a2 = last ? nA : cA + (size_t)(t + 2) * kstep; const char* b2 = last ? nB : cB + (size_t)(t + 2) * kstep;
            const char* a3 = a2 + kstep; const char* b3 = b2 + kstep;
            const size_t k1 = (size_t)(t + 1) * kstep, k2 = last ? 0 : (size_t)(t + 2) * kstep, k3 = k2 + kstep;
            if (last && has_next) S.a_ready(nxt);
            if constexpr (SP2) {
            PG8_LDB(B0, 0, 0); PG8_LDB(B1, 0, 1); PG8_SCHED; PG8_LDA(At, 0, 0); PG8_STAGEA(PG8_SA(1, 1), a1 + hstep, 1, k1, false);
            PG8_WAIT_V(8); PG8_WAIT_L(0); PG8_BAR; PG8_MMA(0, 0, At, B0); PG8_MMA(0, 1, At, B1); PG8_BAR; PG8_SCHED;
            PG8_LDA(At, 0, 1); PG8_STAGE(PG8_SB(0, 0), b2, voffB); PG8_STAGE(PG8_SB(0, 1), b2 + hstep, voffB); PG8_STAGEA(PG8_SA(0, 0), a2, 0, k2, last);
            PG8_WAIT_V(8); PG8_WAIT_L(0); PG8_BAR; PG8_MMA(1, 0, At, B0); PG8_MMA(1, 1, At, B1); PG8_BAR; PG8_SCHED;
            PG8_LDB(B0, 1, 0); PG8_LDB(B1, 1, 1); PG8_SCHED; PG8_LDA(At, 1, 0); PG8_STAGEA(PG8_SA(0, 1), a2 + hstep, 1, k2, last);
            PG8_WAIT_V(8); PG8_WAIT_L(0); PG8_BAR; PG8_MMA(0, 0, At, B0); PG8_MMA(0, 1, At, B1); PG8_BAR; PG8_SCHED;
            PG8_LDA(At, 1, 1); PG8_STAGE(PG8_SB(1, 0), b3, voffB); PG8_STAGE(PG8_SB(1, 1), b3 + hstep, voffB); PG8_STAGEA(PG8_SA(1, 0), a3, 0, k3, last);
            PG8_WAIT_V(8); PG8_WAIT_L(0); PG8_BAR; PG8_MMA(1, 0, At, B0); PG8_MMA(1, 1, At, B1); PG8_BAR; PG8_SCHED;
            } else {
            PG8_LDB(B0, 0, 0); PG8_SCHED; PG8_LDA(At, 0, 0); PG8_STAGE(PG8_SA(1, 1), a1 + hstep, voffA);
            PG8_WAIT_L(8); PG8_BAR; PG8_WAIT_L(0); PG8_MMA(0, 0, At, B0); PG8_BAR; PG8_SCHED;
            PG8_LDB(B1, 0, 1); PG8_STAGE(PG8_SB(0, 0), b2, voffB);
            PG8_BAR; PG8_WAIT_L(0); PG8_MMA(0, 1, At, B1); PG8_BAR;
            PG8_LDA(At, 0, 1); PG8_STAGE(PG8_SA(0, 0), a2, voffA);
            PG8_BAR; PG8_WAIT_L(0); PG8_MMA(1, 0, At, B0); PG8_BAR; PG8_SCHED;
            PG8_STAGE(PG8_SB(0, 1), b2 + hstep, voffB);
            PG8_WAIT_V(6); PG8_BAR; PG8_MMA(1, 1, At, B1); PG8_BAR;
            PG8_LDB(B0, 1, 0); PG8_SCHED; PG8_LDA(At, 1, 0); PG8_STAGE(PG8_SA(0, 1), a2 + hstep, voffA);
            PG8_WAIT_L(8); PG8_BAR; PG8_WAIT_L(0); PG8_MMA(0, 0, At, B0); PG8_BAR; PG8_SCHED;
            PG8_LDB(B1, 1, 1); PG8_STAGE(PG8_SB(1, 0), b3, voffB);
            PG8_BAR; PG8_WAIT_L(0); PG8_MMA(0, 1, At, B1); PG8_BAR;
            PG8_LDA(At, 1, 1); PG8_STAGE(PG8_SA(1, 0), a3, voffA);
            PG8_BAR; PG8_WAIT_L(0); PG8_MMA(1, 0, At, B0); PG8_BAR; PG8_SCHED;
            PG8_STAGE(PG8_SB(1, 1), b3 + hstep, voffB);
            PG8_WAIT_V(6); PG8_BAR; PG8_MMA(1, 1, At, B1); PG8_BAR;
            }
        }
        if constexpr (ALIGN_EPI) { if (wr == 0) PG8_BAR; }
        if constexpr (!Epi::AFTER_DRAIN) { E(acc, cur, wr, wc, fr, fq); S.done(cur); }
        if (!has_next) break;
#pragma unroll
        for (int a = 0; a < 2; ++a)
#pragma unroll
            for (int b = 0; b < 2; ++b)
#pragma unroll
                for (int m = 0; m < 4; ++m)
#pragma unroll
                    for (int n = 0; n < 2; ++n) acc[a][b][m][n] = (f32x4){0.f, 0.f, 0.f, 0.f};
        cur = nxt; cA = nA; cB = nB; ++ui;
        if constexpr (GATHER) { _Pragma("unroll") for (int _h = 0; _h < 2; ++_h) _Pragma("unroll") for (int _i = 0; _i < 2; ++_i) coff[_h][_i] = noff[_h][_i]; }
        if constexpr (ALIGN_EPI) { if (wr == 1) PG8_BAR; }
    }
    PG8_WAIT_V(0);
    if constexpr (!ALIGN_EPI) { if (wr == 0) PG8_BAR; }
    PG8_BAR;
    if constexpr (Epi::AFTER_DRAIN) { E.fused(acc, cur, wr, wc, fr, fq, lds, wid, lane); S.done(cur); }
#undef PG8_SA
#undef PG8_SB
#undef PG8_STAGE
#undef PG8_STAGEA
#undef PG8_GOFF
#undef PG8_LDA
#undef PG8_LDB
#undef PG8_MMA
#undef PG8_WAIT_V
#undef PG8_WAIT_L
#undef PG8_BAR
#undef PG8_SCHED
}
constexpr int PBI = 544, SBI_BYTES = 64 * PBI;
template <class Epi, class Sched, bool ALIGN_EPI = false, bool GATHER = false, bool SPLIT = false>
__device__ __forceinline__ void gemm_phase_bf32(PG8_LAS unsigned char* lds, const Gemm g, const Sched& S, const Epi& E) {
    const int tid = threadIdx.x, wid = __builtin_amdgcn_readfirstlane(tid >> 6), lane = tid & 63, wr = wid >> 2, wc = wid & 3, fr = lane & 15, fq = lane >> 4;
    const int K = g.K, nt = K / BK;
    unsigned voffA[2];
#pragma unroll
    for (int i = 0; i < 2; ++i) { int R, C; stage_rc(tid * 16 + i * 8192, R, C); voffA[i] = (unsigned)(R * K + C) * 2u; }
    unsigned coff[2][2], noff[2][2]; int gR[2], gC[2];
#pragma unroll
    for (int i = 0; i < 2; ++i) { int R, C; stage_rc(tid * 16 + i * 8192, R, C); gR[i] = R; gC[i] = C; coff[0][i] = coff[1][i] = noff[0][i] = noff[1][i] = 0u; }
#define PG8_GOFF(dst, pm_) do { if constexpr (GATHER) { _Pragma("unroll") for (int _h = 0; _h < 2; ++_h) _Pragma("unroll") for (int _i = 0; _i < 2; ++_i) \
        dst[_h][_i] = ((unsigned)g.tok[(pm_) * BM + _h * HALF + gR[_i]] * (unsigned)K + (unsigned)gC[_i]) * 2u; } } while (0)
    const size_t kstep = (size_t)(BK * 2), hstep = (size_t)HALF * K * 2, tstep = 2 * hstep;
    const unsigned ldsw = (unsigned)wid * 1024u;
    const int aoff = lds_byte(wr * 64 + fr, fq * 8);
    const int ldb = S.ldb();
    const size_t bkstep = (size_t)BK * ldb;
    const int q4 = (lane >> 2) & 3, p4 = lane & 3;
    const unsigned lo = SPLIT ? (unsigned)((lane >> 5) * ldb + 4 * (lane & 31)) * 4u : (unsigned)lane * 16u;
    const unsigned bwoff = SPLIT ? (unsigned)(8 * wid + (lane >> 5)) * PBI + (unsigned)(((4 * (lane & 31)) ^ ((wid & 1) << 6)) * 2)
                                 : (unsigned)(8 * wid) * PBI + (unsigned)(((4 * lane) ^ ((wid & 1) << 6)) * 2);
    unsigned broff[2][2];
#pragma unroll
    for (int n = 0; n < 2; ++n)
#pragma unroll
        for (int k = 0; k < 2; ++k) { const int row = 32 * k + 8 * fq + q4, col = 32 * wc + (Epi::PERM ? 8 * p4 + 4 * n : 16 * n + 4 * p4);
            broff[n][k] = (unsigned)row * PBI + (unsigned)((col ^ ((row & 8) << 3)) * 2); }
#define PG8_SA(b, h) (((b) * 2 + (h)) * HTB)
#define PG8_SBI(b) (4 * HTB + (b) * SBI_BYTES)
#define PG8_STAGE(bufoff, gbase, voff) do { _Pragma("unroll") for (int _i = 0; _i < 2; ++_i) \
        __builtin_amdgcn_global_load_lds((const unsigned*)((const char*)(gbase) + (voff)[_i]), (PG8_LAS unsigned*)(lds + (bufoff) + ldsw + _i * 8192), 16, 0, 0); } while (0)
#define PG8_STAGEA(bufoff, gptr, hh, kbytes, usenext) do { if constexpr (GATHER) { _Pragma("unroll") for (int _i = 0; _i < 2; ++_i) { const unsigned _o = (usenext) ? noff[hh][_i] : coff[hh][_i]; \
        __builtin_amdgcn_global_load_lds((const unsigned*)((const char*)g.A + (size_t)(kbytes) + _o), (PG8_LAS unsigned*)(lds + (bufoff) + ldsw + _i * 8192), 16, 0, 0); } } else { PG8_STAGE(bufoff, gptr, voffA); } } while (0)
#define PG8_LDA(dst, b, h) do { _Pragma("unroll") for (int m = 0; m < 4; ++m) _Pragma("unroll") for (int k = 0; k < 2; ++k) dst[m][k] = *(const PG8_LAS bf16x8*)(lds + PG8_SA(b, h) + aoff + m * 2048 + k * 1024); } while (0)
#define PG8_LDBT(dst, b, h) do { _Pragma("unroll") for (int n = 0; n < 2; ++n) _Pragma("unroll") for (int k = 0; k < 2; ++k) { \
        const PG8_LAS unsigned char* _a = lds + PG8_SBI(b) + broff[n][k] + (h) * 256; \
        const s16x4 _lo = __builtin_bit_cast(s16x4, __builtin_amdgcn_ds_read_tr16_b64_v4i16((PG8_LAS s16x4*)_a)), _hi = __builtin_bit_cast(s16x4, __builtin_amdgcn_ds_read_tr16_b64_v4i16((PG8_LAS s16x4*)(_a + 4 * PBI))); \
        dst[n][k] = __builtin_shufflevector(_lo, _hi, 0, 1, 2, 3, 4, 5, 6, 7); } } while (0)
#define PG8_BLOAD(p0, p1) do { _Pragma("unroll") for (int _i = 0; _i < 8; ++_i) { \
        const float* _u = SPLIT ? ((_i < 4 ? (p0) : (p1)) + (size_t)(8 * wid + 2 * (_i & 3)) * ldb) : ((p0) + (size_t)(8 * wid + _i) * ldb); \
        breg[_i] = *(const __attribute__((address_space(1))) f32x4*)((const char*)_u + lo); } } while (0)
#define PG8_BWRITE(b) do { _Pragma("unroll") for (int _i = 0; _i < 8; ++_i) { u32x2 _w; _w.x = cvt_pk_bf16(breg[_i][0], breg[_i][1]); _w.y = cvt_pk_bf16(breg[_i][2], breg[_i][3]); \
        *(PG8_LAS u32x2*)(lds + PG8_SBI(b) + bwoff + (SPLIT ? (2 * (_i & 3)) * PBI + (_i >> 2) * 256 : _i * PBI)) = _w; } } while (0)
#define PG8_MMA(ai, bj, At, Bt) do { __builtin_amdgcn_s_setprio(1); _Pragma("unroll") for (int m = 0; m < 4; ++m) _Pragma("unroll") for (int n = 0; n < 2; ++n) _Pragma("unroll") for (int k = 0; k < 2; ++k) \
        acc[ai][bj][m][n] = __builtin_amdgcn_mfma_f32_16x16x32_bf16(Bt[n][k], At[m][k], acc[ai][bj][m][n], 0, 0, 0); __builtin_amdgcn_s_setprio(0); } while (0)
#define PG8_WAIT_V(n) asm volatile("s_waitcnt vmcnt(" #n ")" ::: "memory")
#define PG8_WAIT_L(n) asm volatile("s_waitcnt lgkmcnt(" #n ")" ::: "memory")
#define PG8_BAR __builtin_amdgcn_s_barrier()
#define PG8_SCHED __builtin_amdgcn_sched_barrier(0)
    typedef short s16x4 __attribute__((ext_vector_type(4)));
    typedef unsigned u32x2 __attribute__((ext_vector_type(2)));
    Unit cur, nxt; int ui = 0;
    if (!S.next(0, cur)) return;
    f32x4 acc[2][2][4][2];
#pragma unroll
    for (int a = 0; a < 2; ++a)
#pragma unroll
        for (int b = 0; b < 2; ++b)
#pragma unroll
            for (int m = 0; m < 4; ++m)
#pragma unroll
                for (int n = 0; n < 2; ++n) acc[a][b][m][n] = (f32x4){0.f, 0.f, 0.f, 0.f};
    bf16x8 At[4][2], B0[2][2];
    f32x4 breg[8];
    const char* cA = (const char*)g.A + (size_t)cur.pm * tstep; const float* cB0 = S.bbase(cur, 0); const float* cB1 = S.bbase(cur, 1);
    PG8_GOFF(coff, cur.pm);
    PG8_BLOAD(cB0, cB1); PG8_STAGEA(PG8_SA(0, 0), cA, 0, 0, false); PG8_STAGEA(PG8_SA(0, 1), cA + hstep, 1, 0, false);
    PG8_BWRITE(0); PG8_SCHED;
    if (wr == 1) PG8_BAR;
    PG8_WAIT_V(2); PG8_WAIT_L(0); PG8_BAR;
    PG8_BLOAD(cB0 + bkstep, cB1 + bkstep); PG8_STAGEA(PG8_SA(1, 0), cA + kstep, 0, kstep, false); PG8_SCHED;
    PG8_WAIT_V(10); PG8_BAR;
    for (;;) {
        const bool has_next = S.next(ui + 1, nxt);
        const char* nA = has_next ? (const char*)g.A + (size_t)nxt.pm * tstep : cA; const float* nB0 = has_next ? S.bbase(nxt, 0) : cB0; const float* nB1 = has_next ? S.bbase(nxt, 1) : cB1;
        if constexpr (GATHER) { if (has_next) { PG8_GOFF(noff, nxt.pm); } else { _Pragma("unroll") for (int _h = 0; _h < 2; ++_h) _Pragma("unroll") for (int _i = 0; _i < 2; ++_i) noff[_h][_i] = coff[_h][_i]; } }
        for (int t = 0; t < nt; t += 2) {
            const bool last = (t == nt - 2);
            const char* a1 = cA + (size_t)(t + 1) * kstep;
            const char* a2 = last ? nA : cA + (size_t)(t + 2) * kstep; const float* b20 = last ? nB0 : cB0 + (size_t)(t + 2) * bkstep; const float* b21 = last ? nB1 : cB1 + (size_t)(t + 2) * bkstep;
            const char* a3 = a2 + kstep; const float* b30 = b20 + bkstep; const float* b31 = b21 + bkstep;
            const size_t k1 = (size_t)(t + 1) * kstep, k2 = last ? 0 : (size_t)(t + 2) * kstep, k3 = k2 + kstep;
            PG8_LDBT(B0, 0, 0); PG8_SCHED; PG8_LDA(At, 0, 0); PG8_STAGEA(PG8_SA(1, 1), a1 + hstep, 1, k1, false);
            PG8_WAIT_V(12); PG8_WAIT_L(0); PG8_BAR; PG8_MMA(0, 0, At, B0); PG8_LDBT(B0, 0, 1); PG8_WAIT_L(0); PG8_SCHED; PG8_MMA(0, 1, At, B0); PG8_BAR; PG8_SCHED;
            PG8_BWRITE(1); PG8_BLOAD(b20, b21); PG8_SCHED; PG8_LDBT(B0, 0, 0); PG8_LDA(At, 0, 1); PG8_STAGEA(PG8_SA(0, 0), a2, 0, k2, last);
            PG8_WAIT_V(12); PG8_WAIT_L(0); PG8_BAR; PG8_MMA(1, 0, At, B0); PG8_LDBT(B0, 0, 1); PG8_WAIT_L(0); PG8_SCHED; PG8_MMA(1, 1, At, B0); PG8_BAR; PG8_SCHED;
            PG8_LDBT(B0, 1, 0); PG8_SCHED; PG8_LDA(At, 1, 0); PG8_STAGEA(PG8_SA(0, 1), a2 + hstep, 1, k2, last);
            PG8_WAIT_V(12); PG8_WAIT_L(0); PG8_BAR; PG8_MMA(0, 0, At, B0); PG8_LDBT(B0, 1, 1); PG8_WAIT_L(0); PG8_SCHED; PG8_MMA(0, 1, At, B0); PG8_BAR; PG8_SCHED;
            PG8_BWRITE(0); PG8_BLOAD(b30, b31); PG8_SCHED; PG8_LDBT(B0, 1, 0); PG8_LDA(At, 1, 1); PG8_STAGEA(PG8_SA(1, 0), a3, 0, k3, last);
            PG8_WAIT_V(12); PG8_WAIT_L(0); PG8_BAR; PG8_MMA(1, 0, At, B0); PG8_LDBT(B0, 1, 1); PG8_WAIT_L(0); PG8_SCHED; PG8_MMA(1, 1, At, B0); PG8_BAR; PG8_SCHED;
        }
        if constexpr (ALIGN_EPI) { if (wr == 0) PG8_BAR; }
        E(acc, cur, wr, wc, fr, fq); S.done(cur);
        if (!has_next) break;
#pragma unroll
        for (int a = 0; a < 2; ++a)
#pragma unroll
            for (int b = 0; b < 2; ++b)
#pragma unroll
                for (int m = 0; m < 4; ++m)
#pragma unroll
                    for (int n = 0; n < 2; ++n) acc[a][b][m][n] = (f32x4){0.f, 0.f, 0.f, 0.f};
        cur = nxt; cA = nA; cB0 = nB0; cB1 = nB1; ++ui;
        if constexpr (GATHER) { _Pragma("unroll") for (int _h = 0; _h < 2; ++_h) _Pragma("unroll") for (int _i = 0; _i < 2; ++_i) coff[_h][_i] = noff[_h][_i]; }
        if constexpr (ALIGN_EPI) { if (wr == 1) PG8_BAR; }
    }
    PG8_WAIT_V(0);
    asm volatile("" :: "v"(breg[0]), "v"(breg[1]), "v"(breg[2]), "v"(breg[3]), "v"(breg[4]), "v"(breg[5]), "v"(breg[6]), "v"(breg[7]));
    if constexpr (!ALIGN_EPI) { if (wr == 0) PG8_BAR; }
    PG8_BAR;
#undef PG8_SA
#undef PG8_SBI
#undef PG8_STAGE
#undef PG8_STAGEA
#undef PG8_GOFF
#undef PG8_LDA
#undef PG8_LDBT
#undef PG8_BLOAD
#undef PG8_BWRITE
#undef PG8_MMA
#undef PG8_WAIT_V
#undef PG8_WAIT_L
#undef PG8_BAR
#undef PG8_SCHED
}
}

constexpr int NWAVES = 8, NTHR = 512;
constexpr int T = 8192, D = 2048, HW = 7168, INW = 7184, MEMN = 256;
constexpr float LN_EPS = 1e-5f;
constexpr float ALPHA = 1.189207115002721f;
constexpr int NPH = 16;
constexpr int PMAX = 24576;

constexpr size_t MiB = 1u << 20;
constexpr size_t WS_CTL = 0, CTL_ZERO_BYTES = 64 * 1024;
constexpr size_t WS_WMIX = 2 * MiB, WS_WMQ = 10 * MiB, WS_WIN = 18 * MiB, WS_WKV = 46 * MiB, WS_WMO = 62 * MiB, WS_WGU = 70 * MiB, WS_WD = 198 * MiB;
constexpr size_t WS_XB = 262 * MiB, WS_MEMB = 294 * MiB;
constexpr size_t WS_H = 296 * MiB;
constexpr size_t WS_KVM = 408 * MiB;
constexpr size_t WS_ORAW = 410 * MiB;
constexpr size_t WS_MIXED = WS_XB;
constexpr size_t WS_Y1 = WS_ORAW;
constexpr size_t WS_H1B = WS_H;
constexpr size_t WS_QB = 328 * MiB, WS_ATT = 360 * MiB;
constexpr size_t WS_Y2 = 474 * MiB;
constexpr size_t WS_H2B = WS_H;
constexpr size_t WS_XS = 328 * MiB;
constexpr size_t WS_HID = 424 * MiB;
constexpr size_t WS_YS = WS_XS;
constexpr size_t WS_SMALL = 540 * MiB;
constexpr size_t WS_GLR = WS_SMALL;
constexpr size_t WS_RC = WS_SMALL + 1 * MiB, WS_RS = WS_SMALL + 5 * MiB;
constexpr size_t WS_ST1 = WS_SMALL + 9 * MiB, WS_ST2 = WS_ST1 + 65536;
constexpr size_t WS_EXP = WS_ST2 + 65536, WS_GATE = WS_EXP + 65536, WS_POS = WS_GATE + 65536, WS_SLOT = WS_POS + 65536, WS_TOK = WS_SLOT + 65536;
constexpr size_t WS_XCH1 = WS_SMALL + 10 * MiB, WS_XCH2 = WS_XCH1 + 512 * 1024;
constexpr size_t WS_END = 552 * MiB;
constexpr int CW_CNT = 64, CW_CUR = 128, CW_Q = 192;
constexpr int CW_BAR = 4096;
constexpr int CW_LN1 = 8192, CW_LN2 = 10240;

constexpr int RING_BYTES = 139264, LDSCTL_OFF = RING_BYTES, MISC_OFF = LDSCTL_OFF + 320, LDS_BYTES = 147456;

#define GAS __attribute__((address_space(1)))
#define LAS __attribute__((address_space(3)))
typedef unsigned short bf16;
typedef unsigned v4u __attribute__((ext_vector_type(4)));
typedef unsigned v2u __attribute__((ext_vector_type(2)));
typedef float f32x4 __attribute__((ext_vector_type(4)));
typedef GAS unsigned gu32;
#define RLX_AGENT __ATOMIC_RELAXED, __HIP_MEMORY_SCOPE_AGENT
#define LDS_WAIT() asm volatile("s_waitcnt lgkmcnt(0)" ::: "memory")
__device__ __forceinline__ unsigned f2bf(float f) { unsigned u = __builtin_bit_cast(unsigned, f); return (u + 0x7fffu + ((u >> 16) & 1u)) >> 16; }
__device__ __forceinline__ unsigned pk2(float lo, float hi) { return f2bf(lo) | (f2bf(hi) << 16); }
__device__ __forceinline__ float bf2f(unsigned h) { return __builtin_bit_cast(float, h << 16); }
__device__ __forceinline__ float bflo(unsigned w) { return __builtin_bit_cast(float, w << 16); }
__device__ __forceinline__ float bfhi(unsigned w) { return __builtin_bit_cast(float, w & 0xffff0000u); }
__device__ __forceinline__ float wave_sum(float v) {
#pragma unroll
    for (int o = 1; o < 64; o <<= 1) v += __shfl_xor(v, o);
    return v;
}
__device__ __forceinline__ float wave_max(float v) {
#pragma unroll
    for (int o = 1; o < 64; o <<= 1) v = fmaxf(v, __shfl_xor(v, o));
    return v;
}

struct Frame {
    LAS unsigned char* lds;
    volatile LAS unsigned* MISC;
    gu32* ctl;
    int tid, lane, wave, G, bid;
    unsigned char* ws;
    const float* in[25];
    float* out;
};
#define WSP(T_, off) ((T_*)(F.ws + (off)))

template <bool NTST>
__device__ __forceinline__ void transpose_item(const float* W, int ldw, bf16* WTr, int ldt, LAS float* scr, int lane) {
    float tv[32];
#pragma unroll
    for (int i = 0; i < 32; ++i) tv[i] = __builtin_nontemporal_load(W + (size_t)(2 * i + (lane >> 5)) * ldw + (lane & 31));
#pragma unroll
    for (int i = 0; i < 32; ++i) scr[(2 * i + (lane >> 5)) * 33 + (lane & 31)] = tv[i];
    LDS_WAIT(); asm volatile("" ::: "memory");
    const int c = lane & 7;
#pragma unroll
    for (int j = 0; j < 4; ++j) { const int n = (lane >> 3) + 8 * j; const LAS float* s = scr + (8 * c) * 33 + n;
        v4u o; o.x = pk2(s[0 * 33], s[1 * 33]); o.y = pk2(s[2 * 33], s[3 * 33]); o.z = pk2(s[4 * 33], s[5 * 33]); o.w = pk2(s[6 * 33], s[7 * 33]);
        if (NTST) __builtin_nontemporal_store(o, (GAS v4u*)(WTr + (size_t)n * ldt + 8 * c)); else *(GAS v4u*)(WTr + (size_t)n * ldt + 8 * c) = o; }
    LDS_WAIT(); asm volatile("" ::: "memory");
}
__device__ __forceinline__ void p0_prologue(Frame& F) {
    LAS float* scr = (LAS float*)(F.lds + F.wave * 16384);
    const int gw = F.bid * NWAVES + F.wave, NGW = F.G * NWAVES;
    const float* w_in = F.in[3];
    constexpr int I_IN = 32 * 224, I_SQ = 32 * 64;
    for (int it = gw; it < I_IN + 2 * I_SQ; it += NGW) {
        int r = it;
        if (r < I_IN) { const int kb = r / 224, nb = r % 224; transpose_item<false>(w_in + (size_t)(64 * kb) * INW + 32 * nb, INW, WSP(bf16, WS_WIN) + (size_t)(32 * nb) * 2048 + 64 * kb, 2048, scr, F.lane); continue; }
        r -= I_IN;
        { const int w = r / I_SQ, q = r % I_SQ, kb = q / 64, nb = q % 64;
          const float* src = F.in[11]; if (w) src = F.in[12];
          bf16* dst = WSP(bf16, WS_WKV) + (size_t)w * 2048 * 2048;
          transpose_item<false>(src + (size_t)(64 * kb) * 2048 + 32 * nb, 2048, dst + (size_t)(32 * nb) * 2048 + 64 * kb, 2048, scr, F.lane); }
    }
    const int gt = F.bid * NTHR + F.tid, NGT = F.G * NTHR;
    {
        const float* x = F.in[0]; bf16* xb = WSP(bf16, WS_XB);
        for (int i0 = gt; i0 < T * D / 8; i0 += 4 * NGT) { f32x4 a[4], b[4];
#pragma unroll
            for (int u = 0; u < 4; ++u) { const size_t i = (size_t)i0 + (size_t)u * NGT; a[u] = __builtin_nontemporal_load((const GAS f32x4*)(x + i * 8)); b[u] = __builtin_nontemporal_load((const GAS f32x4*)(x + i * 8 + 4)); }
#pragma unroll
            for (int u = 0; u < 4; ++u) { const size_t i = (size_t)i0 + (size_t)u * NGT;
                v4u o; o.x = pk2(a[u][0], a[u][1]); o.y = pk2(a[u][2], a[u][3]); o.z = pk2(b[u][0], b[u][1]); o.w = pk2(b[u][2], b[u][3]); *(GAS v4u*)(xb + i * 8) = o; } }
        const float* mm = F.in[1]; bf16* mb = WSP(bf16, WS_MEMB);
        for (int i = gt; i < MEMN * D / 8; i += NGT) { const f32x4 a = *(const GAS f32x4*)(mm + (size_t)i * 8), b = *(const GAS f32x4*)(mm + (size_t)i * 8 + 4);
            v4u o; o.x = pk2(a[0], a[1]); o.y = pk2(a[2], a[3]); o.z = pk2(b[0], b[1]); o.w = pk2(b[2], b[3]); *(GAS v4u*)(mb + (size_t)i * 8) = o; }
    }
    {
        const int* pos = (const int*)F.in[2]; float* rc = WSP(float, WS_RC); float* rs = WSP(float, WS_RS);
        for (int i = gt; i < T * 128; i += NGT) { const int t = i >> 7, f = i & 127;
            const float inv = exp2f(-(float)f * (13.287712379549449f / 128.0f));
            const float ang = (float)pos[t] * inv;
            double rev = (double)ang * 0.15915494309189535; rev -= floor(rev);
            const float rf = (float)rev;
            rc[i] = __builtin_amdgcn_cosf(rf); rs[i] = __builtin_amdgcn_sinf(rf); }
    }
    {
        const float* x = F.in[0]; float* glr = WSP(float, WS_GLR);
        const int r16 = F.lane & 15, g4 = F.lane >> 4;
        LAS float* part = (LAS float*)F.lds;
        for (int item = F.bid; item < T / 32; item += F.G) {
            const int tile = 2 * item + (F.wave >> 2), kq = F.wave & 3;
            f32x4 acc = {0.f, 0.f, 0.f, 0.f};
            const float* xr = x + (size_t)(tile * 16 + r16) * D + 512 * kq + 4 * g4;
            const float* wr = w_in + (size_t)(512 * kq + 4 * g4) * INW + HW + r16;
#pragma unroll 8
            for (int k0 = 0; k0 < 512; k0 += 16) {
                const f32x4 a = *(const GAS f32x4*)(xr + k0);
                const float b0 = wr[(size_t)(k0 + 0) * INW], b1 = wr[(size_t)(k0 + 1) * INW], b2 = wr[(size_t)(k0 + 2) * INW], b3 = wr[(size_t)(k0 + 3) * INW];
                acc = __builtin_amdgcn_mfma_f32_16x16x4f32(a[0], b0, acc, 0, 0, 0);
                acc = __builtin_amdgcn_mfma_f32_16x16x4f32(a[1], b1, acc, 0, 0, 0);
                acc = __builtin_amdgcn_mfma_f32_16x16x4f32(a[2], b2, acc, 0, 0, 0);
                acc = __builtin_amdgcn_mfma_f32_16x16x4f32(a[3], b3, acc, 0, 0, 0);
            }
            __syncthreads();
            *(LAS f32x4*)(part + (F.wave * 64 + F.lane) * 4) = acc;
            __syncthreads();
            if (F.tid < 128) { const int tl = F.tid >> 6, ln = F.tid & 63;
                f32x4 s = *(const LAS f32x4*)(part + ((tl * 4 + 0) * 64 + ln) * 4);
#pragma unroll
                for (int q = 1; q < 4; ++q) s += *(const LAS f32x4*)(part + ((tl * 4 + q) * 64 + ln) * 4);
#pragma unroll
                for (int j = 0; j < 4; ++j) glr[(size_t)((2 * item + tl) * 16 + 4 * (ln >> 4) + j) * 16 + (ln & 15)] = s[j]; }
        }
        __syncthreads();
    }
}
__device__ __forceinline__ void transpose_queue(Frame& F, int qsel = 0) {
    LAS float* scr = (LAS float*)(F.lds + F.wave * 16384);
    const float* const i7 = F.in[7]; const float* const i10 = F.in[10]; const float* const i13 = F.in[13]; const float* const i20 = F.in[20]; const float* const i21 = F.in[21]; const float* const i22 = F.in[22];
    constexpr int I_SQ = 32 * 64, I_E = 512, NQ = 3 * I_SQ + (MK_MOE_F32 ? 0 : 3 * 32 * I_E);
    for (;;) {
        unsigned b0 = 0;
        if (F.lane == 0) b0 = __hip_atomic_fetch_add((unsigned*)(F.ctl + CW_Q + 64 * qsel), 16u, __ATOMIC_RELAXED, __HIP_MEMORY_SCOPE_AGENT);
        b0 = __builtin_amdgcn_readfirstlane(b0);
        if (b0 >= (unsigned)NQ) break;
        for (int it = (int)b0; it < (int)b0 + 16 && it < NQ; ++it) {
            int r = it;
            if (r < 3 * I_SQ) { const int w = r / I_SQ, q = r % I_SQ, kb = q / 64, nb = q % 64;
                const float* src = i7; size_t doff = WS_WMIX; if (w == 1) { src = i10; doff = WS_WMQ; } if (w == 2) { src = i13; doff = WS_WMO; }
                bf16* dst = (bf16*)(F.ws + doff);
                transpose_item<true>(src + (size_t)(64 * kb) * 2048 + 32 * nb, 2048, dst + (size_t)(32 * nb) * 2048 + 64 * kb, 2048, scr, F.lane); continue; }
            r -= 3 * I_SQ;
            if (r < 2 * 32 * I_E) {
                const int up = r / (32 * I_E), q = r % (32 * I_E), e = q / I_E, q2 = q % I_E, kb = q2 / 16, nb = q2 % 16, n0 = 32 * nb;
                const float* sb = i20; if (up) sb = i21;
                const float* src = sb + (size_t)e * 2048 * 512 + (size_t)(64 * kb) * 512 + n0;
                bf16* dst = WSP(bf16, WS_WGU) + (size_t)(e * 1024 + (n0 >> 7) * 256 + up * 128 + (n0 & 127)) * 2048 + 64 * kb;
                transpose_item<true>(src, 512, dst, 2048, scr, F.lane); continue; }
            r -= 2 * 32 * I_E;
            {
                const int e = r / I_E, q2 = r % I_E, kb = q2 / 64, nb = q2 % 64;
                const float* src = i22 + (size_t)e * 512 * 2048 + (size_t)(64 * kb) * 2048 + 32 * nb;
                bf16* dst = WSP(bf16, WS_WD) + (size_t)(e * 2048 + 32 * nb) * 512 + 64 * kb;
                transpose_item<true>(src, 2048, dst, 512, scr, F.lane); }
        }
    }
}

__device__ __forceinline__ float log_sigmoid_f(float z) { return fminf(z, 0.f) - log1pf(expf(-fabsf(z))); }
template <bool GLA>
__device__ __forceinline__ void mixer_naive_item(Frame& F, int hh, int eg) {
    constexpr int ND = GLA ? 4 : 8;
    const bf16* H = WSP(bf16, WS_H); float* oraw = WSP(float, WS_ORAW);
    const int ei = F.tid & 15, dp = F.tid >> 4, e = eg * 16 + ei;
    const int qcol = GLA ? 4096 + hh * 128 : hh * 256, kcol = GLA ? 4608 + hh * 128 : 1024 + hh * 256, vcol = (GLA ? 5120 : 2048) + hh * 256 + e;
    const int ocol = (GLA ? 1024 : 0) + hh * 256 + eg * 16;
    LAS float* red = (LAS float*)F.lds;
    float S[ND];
#pragma unroll
    for (int i = 0; i < ND; ++i) S[i] = 0.f;
    float wa[GLA ? 4 : 1][16]; float ba[GLA ? 4 : 1];
    if (GLA) {
#pragma unroll
        for (int i = 0; i < 4; ++i) { const int d = dp + 32 * i; ba[i] = F.in[5][hh * 128 + d];
#pragma unroll
            for (int r = 0; r < 16; ++r) wa[i][r] = F.in[4][r * 512 + hh * 128 + d]; }
    }
    const float gamma = 1.0f - exp2f(-5.0f - (float)hh);
    const float* glr = WSP(float, WS_GLR);
    for (int t0 = 0; t0 < T; t0 += 8) {
        float part[8];
#pragma unroll
        for (int tt = 0; tt < 8; ++tt) {
            const int t = t0 + tt; const bf16* hr = H + (size_t)t * HW;
            const float v = bf2f(hr[vcol]);
            float g16[16];
            if (GLA) {
#pragma unroll
                for (int r = 0; r < 16; ++r) g16[r] = glr[t * 16 + r];
            }
            float p = 0.f;
#pragma unroll
            for (int i = 0; i < ND; ++i) { const int d = dp + 32 * i;
                const float q = bf2f(hr[qcol + d]), k = bf2f(hr[kcol + d]);
                float a = gamma;
                if (GLA) { float z = ba[i];
#pragma unroll
                    for (int r = 0; r < 16; ++r) z += g16[r] * wa[i][r];
                    a = expf(log_sigmoid_f(z) * 0.0625f); }
                S[i] = a * S[i] + k * v; p += q * S[i]; }
            p += __shfl_xor(p, 16); p += __shfl_xor(p, 32);
            part[tt] = p;
        }
        if (F.lane < 16) {
#pragma unroll
            for (int tt = 0; tt < 8; ++tt) red[(F.wave * 8 + tt) * 16 + F.lane] = part[tt];
        }
        __syncthreads();
        if (F.tid < 128) { const int tt = F.tid >> 4, e2 = F.tid & 15; float s = 0.f;
#pragma unroll
            for (int w = 0; w < 8; ++w) s += red[(w * 8 + tt) * 16 + e2];
            oraw[(size_t)(t0 + tt) * D + ocol + e2] = s; }
        __syncthreads();
    }
}
__device__ __forceinline__ void p2_mixer_naive(Frame& F) {
    for (int item = F.bid; item < 128; item += F.G) {
        const int h8 = item >> 4, eg = item & 15;
        if (h8 < 4) mixer_naive_item<false>(F, h8, eg); else mixer_naive_item<true>(F, h8 - 4, eg);
    }
}
__device__ __forceinline__ void p3_normgate(Frame& F) {
    const bf16* H = WSP(bf16, WS_H); const float* oraw = WSP(float, WS_ORAW); bf16* mixed = WSP(bf16, WS_MIXED);
    const int gw = F.bid * NWAVES + F.wave, NGW = F.G * NWAVES;
    const f32x4 gn = *(const f32x4*)(F.in[6] + 4 * F.lane);
    for (int t = gw; t < T; t += NGW) {
#pragma unroll
        for (int h8 = 0; h8 < 8; ++h8) {
            const f32x4 o = *(const GAS f32x4*)(oraw + (size_t)t * D + h8 * 256 + 4 * F.lane);
            const int gcol = (h8 < 4 ? 3072 : 6144) + (h8 & 3) * 256 + 4 * F.lane;
            const v2u gw2 = *(const GAS v2u*)(H + (size_t)t * HW + gcol);
            const f32x4 gt = {bflo(gw2.x), bfhi(gw2.x), bflo(gw2.y), bfhi(gw2.y)};
            f32x4 y;
            if (h8 < 4) {
                const float mu = wave_sum((o[0] + o[1]) + (o[2] + o[3])) * (1.f / 256.f);
                const f32x4 dd = o - mu;
                const float var = wave_sum((dd[0] * dd[0] + dd[1] * dd[1]) + (dd[2] * dd[2] + dd[3] * dd[3])) * (1.f / 256.f);
                y = dd * (1.0f / sqrtf(var + LN_EPS));
            } else {
                const float ms = wave_sum((o[0] * o[0] + o[1] * o[1]) + (o[2] * o[2] + o[3] * o[3])) * (1.f / 256.f);
                y = o * (1.0f / sqrtf(ms + LN_EPS)) * gn;
            }
            float r[4];
#pragma unroll
            for (int i = 0; i < 4; ++i) { const float g = gt[i]; r[i] = g / (1.0f + expf(-g)) * y[i]; }
            v2u w; w.x = pk2(r[0], r[1]); w.y = pk2(r[2], r[3]);
            *(GAS v2u*)(mixed + (size_t)t * D + h8 * 256 + 4 * F.lane) = w;
        }
    }
}
__device__ __forceinline__ void ln_apply_plain(Frame& F, const float* Y, const float* g, const float* b, bf16* HB, float* st) {
    const int gw = F.bid * NWAVES + F.wave, NGW = F.G * NWAVES;
    f32x4 cur[8];
    if (gw < T) { const GAS f32x4* yr = (const GAS f32x4*)(Y + (size_t)gw * D) + F.lane;
#pragma unroll
        for (int j = 0; j < 8; ++j) cur[j] = yr[64 * j]; }
    for (int t = gw; t < T; t += NGW) {
        f32x4 nxt[8];
        { const int tn = t + NGW < T ? t + NGW : t; const GAS f32x4* yr = (const GAS f32x4*)(Y + (size_t)tn * D) + F.lane;
#pragma unroll
          for (int j = 0; j < 8; ++j) nxt[j] = yr[64 * j]; }
        f32x4 v[8]; float s = 0.f;
#pragma unroll
        for (int j = 0; j < 8; ++j) { v[j] = cur[j]; s += (v[j][0] + v[j][1]) + (v[j][2] + v[j][3]); }
        const float mean = wave_sum(s) * (1.f / D); float s2 = 0.f;
#pragma unroll
        for (int j = 0; j < 8; ++j) { v[j] = v[j] - mean; s2 += (v[j][0] * v[j][0] + v[j][1] * v[j][1]) + (v[j][2] * v[j][2] + v[j][3] * v[j][3]); }
        const float rstd = 1.f / sqrtf(wave_sum(s2) * (1.f / D) + LN_EPS);
        if (F.lane == 0) { st[2 * t] = mean; st[2 * t + 1] = rstd; }
        GAS v2u* o8 = (GAS v2u*)(HB + (size_t)t * D) + F.lane;
#pragma unroll
        for (int j = 0; j < 8; ++j) { const f32x4 gv = *(const f32x4*)(g + 4 * F.lane + 256 * j), bv = *(const f32x4*)(b + 4 * F.lane + 256 * j);
            v[j] = v[j] * rstd * gv + bv;
            v2u w; w.x = pk2(v[j][0], v[j][1]); w.y = pk2(v[j][2], v[j][3]); o8[64 * j] = w; }
#pragma unroll
        for (int j = 0; j < 8; ++j) cur[j] = nxt[j];
    }
}
template <bool ROUTER>
__device__ __forceinline__ void ln_apply(Frame& F, const float* Y, const float* g, const float* b, bf16* HB, float* st, bool count = true) {
    const int gw = F.bid * NWAVES + F.wave, NGW = F.G * NWAVES;
    for (int t = gw; t < T; t += NGW) {
        const GAS f32x4* yr = (const GAS f32x4*)(Y + (size_t)t * D) + F.lane;
        f32x4 v[8]; float s = 0.f;
#pragma unroll
        for (int j = 0; j < 8; ++j) { v[j] = yr[64 * j]; s += (v[j][0] + v[j][1]) + (v[j][2] + v[j][3]); }
        const float mean = wave_sum(s) * (1.f / D); float s2 = 0.f;
#pragma unroll
        for (int j = 0; j < 8; ++j) { v[j] = v[j] - mean; s2 += (v[j][0] * v[j][0] + v[j][1] * v[j][1]) + (v[j][2] * v[j][2] + v[j][3] * v[j][3]); }
        const float rstd = 1.f / sqrtf(wave_sum(s2) * (1.f / D) + LN_EPS);
        if (F.lane == 0) { st[2 * t] = mean; st[2 * t + 1] = rstd; }
        GAS v2u* o8 = (GAS v2u*)(HB + (size_t)t * D) + F.lane;
#pragma unroll
        for (int j = 0; j < 8; ++j) { const f32x4 gv = *(const f32x4*)(g + 4 * F.lane + 256 * j), bv = *(const f32x4*)(b + 4 * F.lane + 256 * j);
            v[j] = v[j] * rstd * gv + bv;
            v2u w; w.x = pk2(v[j][0], v[j][1]); w.y = pk2(v[j][2], v[j][3]); o8[64 * j] = w; }
        if (ROUTER) {
            const float* Wg = F.in[16]; const float* We = F.in[18];
            float lg[4], le[32];
#pragma unroll
            for (int i = 0; i < 4; ++i) lg[i] = 0.f;
#pragma unroll
            for (int i = 0; i < 32; ++i) le[i] = 0.f;
#pragma unroll
            for (int j = 0; j < 8; ++j) {
#pragma unroll
                for (int i = 0; i < 4; ++i) { const int c = 4 * F.lane + 256 * j + i; const float hv = v[j][i];
                    const f32x4 wg = *(const GAS f32x4*)(Wg + (size_t)c * 4);
#pragma unroll
                    for (int q = 0; q < 4; ++q) lg[q] += hv * wg[q];
#pragma unroll
                    for (int q8 = 0; q8 < 8; ++q8) { const f32x4 we = *(const GAS f32x4*)(We + (size_t)c * 32 + 4 * q8);
#pragma unroll
                        for (int q = 0; q < 4; ++q) le[4 * q8 + q] += hv * we[q]; } }
            }
#pragma unroll
            for (int i = 0; i < 4; ++i) lg[i] = wave_sum(lg[i]) + F.in[17][i];
#pragma unroll
            for (int i = 0; i < 32; ++i) le[i] = wave_sum(le[i]);
            int grp = 0; float gm = lg[0];
#pragma unroll
            for (int i = 1; i < 4; ++i) if (lg[i] > gm) { gm = lg[i]; grp = i; }
            float gs = 0.f;
#pragma unroll
            for (int i = 0; i < 4; ++i) gs += expf(lg[i] - gm);
            const float pg_sel = 1.0f / gs;
            float fe[8];
#pragma unroll
            for (int j = 0; j < 8; ++j) { const float a = grp == 0 ? le[j] : grp == 1 ? le[8 + j] : grp == 2 ? le[16 + j] : le[24 + j]; fe[j] = a + F.in[19][grp * 8 + j]; }
            int i1 = 0; float m1 = fe[0];
#pragma unroll
            for (int j = 1; j < 8; ++j) if (fe[j] > m1) { m1 = fe[j]; i1 = j; }
            int i2 = -1; float m2 = -3.0e38f;
#pragma unroll
            for (int j = 0; j < 8; ++j) if (j != i1 && fe[j] > m2) { m2 = fe[j]; i2 = j; }
            const float p2 = expf(m2 - m1), den = 1.0f / (1.0f + p2);
            if (F.lane == 0) {
                int* ex = WSP(int, WS_EXP); float* gt = WSP(float, WS_GATE);
                const int e1 = grp * 8 + i1, e2 = grp * 8 + i2;
                ex[2 * t] = e1; ex[2 * t + 1] = e2; gt[2 * t] = pg_sel * den; gt[2 * t + 1] = pg_sel * p2 * den;
                if (count) { atomicAdd((unsigned*)(F.ctl + CW_CNT) + e1, 1u); atomicAdd((unsigned*)(F.ctl + CW_CNT) + e2, 1u); }
            }
        }
    }
}
__device__ __forceinline__ void p7_attn_naive(Frame& F) {
    const bf16* Q = WSP(bf16, WS_QB); const bf16* KVM = WSP(bf16, WS_KVM); bf16* att = WSP(bf16, WS_ATT);
    LAS float* qs = (LAS float*)F.lds;
    LAS float* sc = (LAS float*)(F.lds + 16384);
    for (int item = F.bid; item < (T / 8) * 4; item += F.G) {
        const int h = item & 3, t0 = (item >> 2) * 8;
        for (int i = F.tid; i < 8 * 512; i += NTHR) { const int tt = i >> 9, d = i & 511; qs[i] = bf2f(Q[(size_t)(t0 + tt) * D + h * 512 + d]); }
        __syncthreads();
        {
            const int j = F.tid & 255, th = F.tid >> 8;
            const bf16* kr = KVM + (size_t)j * 4096 + h * 512;
            float a0 = 0.f, a1 = 0.f, a2 = 0.f, a3 = 0.f;
            for (int d = 0; d < 512; d += 8) {
                const v4u kw = *(const GAS v4u*)(kr + d);
                const float kf[8] = {bflo(kw.x), bfhi(kw.x), bflo(kw.y), bfhi(kw.y), bflo(kw.z), bfhi(kw.z), bflo(kw.w), bfhi(kw.w)};
#pragma unroll
                for (int i = 0; i < 8; ++i) { a0 += kf[i] * qs[(th * 4 + 0) * 512 + d + i]; a1 += kf[i] * qs[(th * 4 + 1) * 512 + d + i]; a2 += kf[i] * qs[(th * 4 + 2) * 512 + d + i]; a3 += kf[i] * qs[(th * 4 + 3) * 512 + d + i]; }
            }
            const float scl = 0.04419417382415922f;
            sc[(th * 4 + 0) * 256 + j] = a0 * scl; sc[(th * 4 + 1) * 256 + j] = a1 * scl; sc[(th * 4 + 2) * 256 + j] = a2 * scl; sc[(th * 4 + 3) * 256 + j] = a3 * scl;
        }
        __syncthreads();
        {
            float v[4]; float mx = -3.0e38f;
#pragma unroll
            for (int i = 0; i < 4; ++i) { v[i] = sc[F.wave * 256 + F.lane + 64 * i]; mx = fmaxf(mx, v[i]); }
            mx = wave_max(mx); float sm = 0.f;
#pragma unroll
            for (int i = 0; i < 4; ++i) { v[i] = expf(v[i] - mx); sm += v[i]; }
            sm = 1.0f / wave_sum(sm);
#pragma unroll
            for (int i = 0; i < 4; ++i) sc[F.wave * 256 + F.lane + 64 * i] = v[i] * sm;
        }
        __syncthreads();
        {
            const int d = F.tid; const bf16* vr = KVM + 2048 + h * 512 + d;
            float o[8];
#pragma unroll
            for (int i = 0; i < 8; ++i) o[i] = 0.f;
            for (int j = 0; j < 256; ++j) { const float vv = bf2f(vr[(size_t)j * 4096]);
#pragma unroll
                for (int i = 0; i < 8; ++i) o[i] += sc[i * 256 + j] * vv; }
#pragma unroll
            for (int i = 0; i < 8; ++i) att[(size_t)(t0 + i) * D + h * 512 + d] = (bf16)f2bf(o[i]);
        }
        __syncthreads();
    }
}
__device__ __forceinline__ void moe_tile_starts(Frame& F, LAS int* ts) {
    if (F.tid < 64) {
        const unsigned c = F.lane < 32 ? __hip_atomic_load(F.ctl + CW_CUR + (F.lane & 31), RLX_AGENT) : 0u;
        int v = (int)((c + 255u) >> 8);
#pragma unroll
        for (int o = 1; o < 32; o <<= 1) { const int n = __shfl_up(v, o); if (F.lane >= o) v += n; }
        if (F.lane < 32) ts[F.lane + 1] = v;
        if (F.lane == 0) ts[0] = 0;
    }
    __syncthreads();
}
__device__ __forceinline__ void p10_dispatch(Frame& F, LAS int* ts) {
    const int gt = F.bid * NTHR + F.tid, NGT = F.G * NTHR;
    const int* ex = WSP(int, WS_EXP); const int* sl = WSP(int, WS_SLOT); int* pos = WSP(int, WS_POS); int* tok = WSP(int, WS_TOK);
    for (int a = gt; a < 2 * T; a += NGT) { const int p = ts[ex[a]] * 256 + sl[a]; pos[a] = p; tok[p] = a >> 1; }
}
__device__ __forceinline__ void p13_combine(Frame& F) {
    const int gw = F.bid * NWAVES + F.wave, NGW = F.G * NWAVES;
    const float* Y2 = WSP(float, WS_Y2); const float* st2 = WSP(float, WS_ST2); const bf16* ys = WSP(bf16, WS_YS);
    const int* pos = WSP(int, WS_POS); const float* gt = WSP(float, WS_GATE);
    const float* g2 = F.in[14]; const float* b2 = F.in[15]; const float* g3 = F.in[23]; const float* b3 = F.in[24];
    constexpr int R = 2;
    for (int t0 = gw; t0 < T; t0 += R * NGW) {
        f32x4 yv[R][8]; v2u ya[R][8], yc[R][8]; float mu2[R], rs2[R], w0[R], w1[R];
#pragma unroll
        for (int r = 0; r < R; ++r) { const int t = (t0 + r * NGW < T) ? t0 + r * NGW : t0;
            mu2[r] = st2[2 * t]; rs2[r] = st2[2 * t + 1]; w0[r] = gt[2 * t]; w1[r] = gt[2 * t + 1];
            const int p0 = pos[2 * t], p1 = pos[2 * t + 1];
            const GAS f32x4* yr = (const GAS f32x4*)(Y2 + (size_t)t * D) + F.lane;
            const GAS v2u* y0 = (const GAS v2u*)(ys + (size_t)p0 * D) + F.lane; const GAS v2u* y1 = (const GAS v2u*)(ys + (size_t)p1 * D) + F.lane;
#pragma unroll
            for (int j = 0; j < 8; ++j) { yv[r][j] = yr[64 * j]; ya[r][j] = y0[64 * j]; yc[r][j] = y1[64 * j]; } }
#pragma unroll
        for (int r = 0; r < R; ++r) { const int t = t0 + r * NGW; if (t >= T) break;
            f32x4 v[8]; float s = 0.f;
#pragma unroll
            for (int j = 0; j < 8; ++j) { const f32x4 gv = *(const f32x4*)(g2 + 4 * F.lane + 256 * j), bv = *(const f32x4*)(b2 + 4 * F.lane + 256 * j);
                const f32x4 h = (yv[r][j] - mu2[r]) * rs2[r] * gv + bv;
                const v2u a = ya[r][j], c = yc[r][j];
                const f32x4 fa = {bflo(a.x), bfhi(a.x), bflo(a.y), bfhi(a.y)}, fc = {bflo(c.x), bfhi(c.x), bflo(c.y), bfhi(c.y)};
                v[j] = h * ALPHA + fa * w0[r] + fc * w1[r]; s += (v[j][0] + v[j][1]) + (v[j][2] + v[j][3]); }
            const float mean = wave_sum(s) * (1.f / D); float s2 = 0.f;
#pragma unroll
            for (int j = 0; j < 8; ++j) { v[j] = v[j] - mean; s2 += (v[j][0] * v[j][0] + v[j][1] * v[j][1]) + (v[j][2] * v[j][2] + v[j][3] * v[j][3]); }
            const float rstd = 1.f / sqrtf(wave_sum(s2) * (1.f / D) + LN_EPS);
            GAS f32x4* orow = (GAS f32x4*)(F.out + (size_t)t * D) + F.lane;
#pragma unroll
            for (int j = 0; j < 8; ++j) { const f32x4 gv = *(const f32x4*)(g3 + 4 * F.lane + 256 * j), bv = *(const f32x4*)(b3 + 4 * F.lane + 256 * j);
                orow[64 * j] = v[j] * rstd * gv + bv; }
        }
    }
}

constexpr int CS = 128, NB = CS / 64, NS = T / CS;
constexpr size_t WS_BCUM = WS_ORAW;
constexpr size_t WS_KVR = WS_ORAW + 16 * MiB;
constexpr size_t WS_KVG = WS_KVR + 32 * MiB;
typedef short bf16x8_t __attribute__((ext_vector_type(8)));
typedef short s16x4_t __attribute__((ext_vector_type(4)));
__device__ __forceinline__ s16x4_t lds_tr(const LAS unsigned char* p) { return __builtin_bit_cast(s16x4_t, __builtin_amdgcn_ds_read_tr16_b64_v4i16((LAS s16x4_t*)p)); }
__device__ __forceinline__ bf16x8_t frag_tr(const LAS unsigned char* X, int pitch, int k0, int n0, int lane) {
    const int fq = lane >> 4, q = (lane >> 2) & 3, p = lane & 3;
    const LAS unsigned char* a = X + ((k0 + 8 * fq + q) * pitch + n0 + 4 * p) * 2;
    const s16x4_t lo = lds_tr(a), hi = lds_tr(a + 4 * pitch * 2);
    return __builtin_shufflevector(lo, hi, 0, 1, 2, 3, 4, 5, 6, 7);
}
__device__ __forceinline__ bf16x8_t frag_row(const LAS unsigned char* X, int pitch, int r0, int k0, int lane) {
    return *(const LAS bf16x8_t*)(X + ((r0 + (lane & 15)) * pitch + k0 + 8 * (lane >> 4)) * 2);
}
#define MFMA16(a, b, c) __builtin_amdgcn_mfma_f32_16x16x32_bf16((a), (b), (c), 0, 0, 0)
__device__ __forceinline__ float fexp(float x) { return __builtin_amdgcn_exp2f(x * 1.4426950408889634f); }
__device__ __forceinline__ float silu_g(float g) { return g * __builtin_amdgcn_rcpf(1.0f + __builtin_amdgcn_exp2f(-1.4426950408889634f * g)); }

__device__ __forceinline__ void bcum_item(Frame& F, int s, int h) {
    const int c = F.tid & 127, tq = F.tid >> 7;
    LAS float* tot = (LAS float*)F.lds;
    LAS float* gl = (LAS float*)(F.lds + 2048);
    const float* glr = WSP(float, WS_GLR); float* bc = WSP(float, WS_BCUM);
    __syncthreads();
    *(LAS f32x4*)(gl + 4 * F.tid) = *(const GAS f32x4*)(glr + (size_t)s * CS * 16 + 4 * F.tid);
    float w[16];
#pragma unroll
    for (int r = 0; r < 16; ++r) w[r] = F.in[4][r * 512 + h * 128 + c];
    const float bias = F.in[5][h * 128 + c];
    __syncthreads();
    float vals[32]; float run = 0.f;
    const int tb = s * CS + tq * 32;
#pragma unroll
    for (int i = 0; i < 32; ++i) { const LAS float* gr = gl + (tq * 32 + i) * 16; float z = bias;
#pragma unroll
        for (int r = 0; r < 16; ++r) z += gr[r] * w[r];
        run += log_sigmoid_f(z) * 0.0625f; vals[i] = run; }
    tot[tq * 128 + c] = run;
    __syncthreads();
    float off = 0.f;
#pragma unroll
    for (int q = 0; q < 3; ++q) off += (q < tq) ? tot[q * 128 + c] : 0.f;
#pragma unroll
    for (int i = 0; i < 32; ++i) bc[(size_t)(tb + i) * 512 + h * 128 + c] = vals[i] + off;
}
__device__ __forceinline__ void p1_bcum(Frame& F, int first, int stride) { for (int it = first; it < NS * 4; it += stride) bcum_item(F, it >> 2, it & 3); __syncthreads(); }

__device__ __forceinline__ void unit_sh(int u, int& s, int& h8) { s = (u >> 3) & (NS - 1); h8 = ((u & 7) + 4 * (u >> 8)) & 7; }

template <bool GLA, int MODE>
__device__ __forceinline__ void stage_qk(Frame& F, LAS unsigned char* dst, int s, int jb, int hh, int col0, float lg2gamma) {
    constexpr int DK = GLA ? 128 : 256, PK = DK + 8, CPR = DK / 8, NIT = 64 * CPR / NTHR;
    const bf16* H = WSP(bf16, WS_H); const float* bc = WSP(float, WS_BCUM);
    v4u wv[NIT]; f32x4 b0[GLA ? NIT : 1], b1[GLA ? NIT : 1], l0[(GLA && MODE == 2) ? NIT : 1], l1[(GLA && MODE == 2) ? NIT : 1];
#pragma unroll
    for (int it = 0; it < NIT; ++it) {
        const int ch = F.tid + NTHR * it, r = ch / CPR, cc = ch % CPR, t = s * CS + jb * 64 + r;
        wv[it] = *(const GAS v4u*)(H + (size_t)t * HW + col0 + 8 * cc);
        if (GLA) { b0[it] = *(const GAS f32x4*)(bc + (size_t)t * 512 + hh * 128 + 8 * cc); b1[it] = *(const GAS f32x4*)(bc + (size_t)t * 512 + hh * 128 + 8 * cc + 4);
            if (MODE == 2) { const size_t tl_ = (size_t)(s * CS + CS - 1) * 512 + hh * 128 + 8 * cc; l0[it] = *(const GAS f32x4*)(bc + tl_); l1[it] = *(const GAS f32x4*)(bc + tl_ + 4); } }
    }
#pragma unroll
    for (int it = 0; it < NIT; ++it) {
        const int ch = F.tid + NTHR * it, r = ch / CPR, cc = ch % CPR, tl = jb * 64 + r;
        const v4u w = wv[it];
        float f[8] = {bflo(w.x), bfhi(w.x), bflo(w.y), bfhi(w.y), bflo(w.z), bfhi(w.z), bflo(w.w), bfhi(w.w)};
        if (GLA) {
            float e[8] = {b0[it][0], b0[it][1], b0[it][2], b0[it][3], b1[it][0], b1[it][1], b1[it][2], b1[it][3]};
            if (MODE == 2) { const float l[8] = {l0[it][0], l0[it][1], l0[it][2], l0[it][3], l1[it][0], l1[it][1], l1[it][2], l1[it][3]};
#pragma unroll
                for (int i = 0; i < 8; ++i) e[i] = l[i] - e[i]; }
            else if (MODE == 1) {
#pragma unroll
                for (int i = 0; i < 8; ++i) e[i] = -e[i]; }
#pragma unroll
            for (int i = 0; i < 8; ++i) f[i] *= fexp(e[i]);
        } else {
            const float ex = MODE == 0 ? (float)(tl + 1) : MODE == 1 ? -(float)(tl + 1) : (float)(CS - 1 - tl);
            const float fac = __builtin_amdgcn_exp2f(ex * lg2gamma);
#pragma unroll
            for (int i = 0; i < 8; ++i) f[i] *= fac;
        }
        v4u o; o.x = pk2(f[0], f[1]); o.y = pk2(f[2], f[3]); o.z = pk2(f[4], f[5]); o.w = pk2(f[6], f[7]);
        *(LAS v4u*)(dst + (r * PK + 8 * cc) * 2) = o;
    }
}
__device__ __forceinline__ void stage_v(Frame& F, LAS unsigned char* dst, int s, int jb, int col0) {
    const bf16* H = WSP(bf16, WS_H);
    v4u wv[4];
#pragma unroll
    for (int it = 0; it < 4; ++it) { const int ch = F.tid + NTHR * it, r = ch >> 5, cc = ch & 31, t = s * CS + jb * 64 + r; wv[it] = *(const GAS v4u*)(H + (size_t)t * HW + col0 + 8 * cc); }
#pragma unroll
    for (int it = 0; it < 4; ++it) { const int ch = F.tid + NTHR * it, r = ch >> 5, cc = ch & 31; *(LAS v4u*)(dst + (r * 264 + 8 * cc) * 2) = wv[it]; }
}

template <bool GLA>
__device__ __forceinline__ void kv_unit(Frame& F, int s, int hh) {
    constexpr int DK = GLA ? 128 : 256, PK = DK + 8, NDT = DK / 16;
    LAS unsigned char* Ks = F.lds; LAS unsigned char* Vs = F.lds + 34816;
    const int kcol = GLA ? 4608 + hh * 128 : 1024 + hh * 256, vcol = (GLA ? 5120 : 2048) + hh * 256;
    const float lg2g = log2f(1.0f - exp2f(-5.0f - (float)hh));
    f32x4 acc[2][NDT];
#pragma unroll
    for (int a = 0; a < 2; ++a)
#pragma unroll
        for (int d = 0; d < NDT; ++d) acc[a][d] = (f32x4){0.f, 0.f, 0.f, 0.f};
    for (int jb = 0; jb < NB; ++jb) {
        __syncthreads();
        stage_qk<GLA, 2>(F, Ks, s, jb, hh, kcol, lg2g);
        stage_v(F, Vs, s, jb, vcol);
        __syncthreads();
#pragma unroll
        for (int ks = 0; ks < 2; ++ks) {
            bf16x8_t vf[2];
#pragma unroll
            for (int et = 0; et < 2; ++et) vf[et] = frag_tr(Vs, 264, 32 * ks, 32 * F.wave + 16 * et, F.lane);
#pragma unroll
            for (int dt = 0; dt < NDT; ++dt) { const bf16x8_t kf = frag_tr(Ks, PK, 32 * ks, 16 * dt, F.lane);
#pragma unroll
                for (int et = 0; et < 2; ++et) acc[et][dt] = MFMA16(kf, vf[et], acc[et][dt]); }
        }
    }
    bf16* kv = GLA ? (WSP(bf16, WS_KVG) + (size_t)(s * 4 + hh) * 256 * 128) : (WSP(bf16, WS_KVR) + (size_t)(s * 4 + hh) * 256 * 256);
    const int fr = F.lane & 15, fq = F.lane >> 4;
#pragma unroll
    for (int et = 0; et < 2; ++et)
#pragma unroll
        for (int dt = 0; dt < NDT; ++dt) { v2u w; w.x = pk2(acc[et][dt][0], acc[et][dt][1]); w.y = pk2(acc[et][dt][2], acc[et][dt][3]);
            *(GAS v2u*)(kv + (size_t)(32 * F.wave + 16 * et + fr) * DK + 16 * dt + 4 * fq) = w; }
}
__device__ __forceinline__ void p2_kv(Frame& F) {
    for (int u = F.bid; u < 8 * NS; u += F.G) { int s, h8; unit_sh(u, s, h8);
        if (s == NS - 1) continue;
        if (h8 < 4) kv_unit<false>(F, s, h8); else kv_unit<true>(F, s, h8 - 4); }
    __syncthreads();
}
__device__ __forceinline__ void p3_scan(Frame& F) {
    constexpr int NR = 4 * 256 * 64, NG = 4 * 256 * 32, NITEM = NR + NG;
    const float* bc = WSP(float, WS_BCUM);
    const int per = (NITEM + F.G - 1) / F.G;
    for (int k0 = F.tid; k0 < per; k0 += NTHR) {
      const int it = F.bid * per + k0;
      if (it < NITEM) {
        const bool gla = it >= NR; const int r = gla ? it - NR : it;
        const int sh = gla ? 5 : 6, dk = gla ? 128 : 256;
        const int cc = r & ((1 << sh) - 1), e = (r >> sh) & 255, hh = r >> (sh + 8);
        bf16* base = (gla ? WSP(bf16, WS_KVG) : WSP(bf16, WS_KVR)) + ((size_t)hh * 256 + e) * dk + 4 * cc;
        const size_t sstride = (size_t)4 * 256 * dk;
        const float dret = __builtin_amdgcn_exp2f((float)CS * log2f(1.0f - exp2f(-5.0f - (float)hh)));
        float S[4] = {0.f, 0.f, 0.f, 0.f};
#pragma unroll 16
        for (int s = 0; s < NS - 1; ++s) {
            GAS v2u* p = (GAS v2u*)(base + (size_t)s * sstride);
            const v2u w = *p;
            v2u o; o.x = pk2(S[0], S[1]); o.y = pk2(S[2], S[3]);
            *p = o;
            const float f[4] = {bflo(w.x), bfhi(w.x), bflo(w.y), bfhi(w.y)};
            float dec[4] = {dret, dret, dret, dret};
            if (gla) { const f32x4 l0 = *(const GAS f32x4*)(bc + (size_t)(s * CS + CS - 1) * 512 + hh * 128 + 4 * cc);
                dec[0] = fexp(l0[0]); dec[1] = fexp(l0[1]); dec[2] = fexp(l0[2]); dec[3] = fexp(l0[3]); }
#pragma unroll
            for (int i = 0; i < 4; ++i) S[i] = dec[i] * S[i] + f[i];
        }
        { GAS v2u* p = (GAS v2u*)(base + (size_t)(NS - 1) * sstride); v2u o; o.x = pk2(S[0], S[1]); o.y = pk2(S[2], S[3]); *p = o; }
      }
    }
}
template <bool GLA>
__device__ __forceinline__ void out_unit(Frame& F, int s, int hh) {
    constexpr int DK = GLA ? 128 : 256, PK = DK + 8, NKS = DK / 32;
    LAS unsigned char* Qs = F.lds; LAS unsigned char* Ks = F.lds + 33792; LAS unsigned char* Vs = F.lds + 67584; LAS unsigned char* Ps = F.lds + 101376;
    LAS float* red = (LAS float*)(F.lds + 110592);
    const int qcol = GLA ? 4096 + hh * 128 : hh * 256, kcol = GLA ? 4608 + hh * 128 : 1024 + hh * 256, vcol = (GLA ? 5120 : 2048) + hh * 256;
    const int gcol = (GLA ? 6144 : 3072) + hh * 256, ocol = (GLA ? 1024 : 0) + hh * 256;
    const float lg2g = log2f(1.0f - exp2f(-5.0f - (float)hh));
    const bf16* H = WSP(bf16, WS_H); bf16* mixed = WSP(bf16, WS_MIXED);
    const bf16* st = GLA ? (WSP(bf16, WS_KVG) + (size_t)(s * 4 + hh) * 256 * 128) : (WSP(bf16, WS_KVR) + (size_t)(s * 4 + hh) * 256 * 256);
    const int fr = F.lane & 15, fq = F.lane >> 4, w = F.wave, mt = w >> 1, nt0 = 2 * (w & 1);
    static_assert(NB == 2, "the step program below is written for two 64-token sub-blocks");
    f32x4 accO[4][2]; bf16x8_t sfa[NKS][2]; v2u gpre[4][2];
#pragma unroll 1
    for (int step = 0; step < 3; ++step) {
        const int i = step > 0 ? 1 : 0, j = step > 1 ? 1 : 0;
        {
            __syncthreads();
            if (step < 2) stage_qk<GLA, 0>(F, Qs, s, i, hh, qcol, lg2g);
            if (step != 1) { stage_qk<GLA, 1>(F, Ks, s, j, hh, kcol, lg2g); stage_v(F, Vs, s, j, vcol); }
            if (step < 2) {
#pragma unroll
                for (int m = 0; m < 4; ++m)
#pragma unroll
                    for (int n = 0; n < 2; ++n) accO[m][n] = (f32x4){0.f, 0.f, 0.f, 0.f};
            }
            if (step != 1) {
                if (s > 0) {
#pragma unroll
                    for (int ks = 0; ks < NKS; ++ks)
#pragma unroll
                        for (int n = 0; n < 2; ++n) sfa[ks][n] = *(const GAS bf16x8_t*)(st + (size_t)(32 * w + 16 * n + fr) * DK + 32 * ks + 8 * fq);
                }
#pragma unroll
                for (int m2 = 0; m2 < 4; ++m2)
#pragma unroll
                    for (int n = 0; n < 2; ++n) gpre[m2][n] = *(const GAS v2u*)(H + (size_t)(s * CS + i * 64 + 16 * m2 + fr) * HW + gcol + 32 * w + 16 * n + 4 * fq);
            }
            __syncthreads();
            f32x4 accS[2] = {(f32x4){0.f, 0.f, 0.f, 0.f}, (f32x4){0.f, 0.f, 0.f, 0.f}};
#pragma unroll
            for (int ks = 0; ks < NKS; ++ks) { const bf16x8_t qf = frag_row(Qs, PK, 16 * mt, 32 * ks, F.lane);
#pragma unroll
                for (int n2 = 0; n2 < 2; ++n2) { const bf16x8_t kf = frag_row(Ks, PK, 16 * (nt0 + n2), 32 * ks, F.lane); accS[n2] = MFMA16(kf, qf, accS[n2]); } }
#pragma unroll
            for (int n2 = 0; n2 < 2; ++n2) { const int row = 16 * mt + fr, c0 = 16 * (nt0 + n2) + 4 * fq; float pv[4];
#pragma unroll
                for (int jj = 0; jj < 4; ++jj) pv[jj] = (i == j && c0 + jj > row) ? 0.f : accS[n2][jj];
                v2u pw; pw.x = pk2(pv[0], pv[1]); pw.y = pk2(pv[2], pv[3]);
                *(LAS v2u*)(Ps + (row * 72 + c0) * 2) = pw; }
            __syncthreads();
#pragma unroll
            for (int ks = 0; ks < 2; ++ks) {
                bf16x8_t vf[2];
#pragma unroll
                for (int n = 0; n < 2; ++n) vf[n] = frag_tr(Vs, 264, 32 * ks, 32 * w + 16 * n, F.lane);
#pragma unroll
                for (int m = 0; m < 4; ++m) { const bf16x8_t pf = frag_row(Ps, 72, 16 * m, 32 * ks, F.lane);
#pragma unroll
                    for (int n = 0; n < 2; ++n) accO[m][n] = MFMA16(vf[n], pf, accO[m][n]); }
            }
        }
        if (step == 1) continue;
        if (s > 0) {
#pragma unroll
            for (int ks = 0; ks < NKS; ++ks) {
#pragma unroll
                for (int m = 0; m < 4; ++m) { const bf16x8_t qf = frag_row(Qs, PK, 16 * m, 32 * ks, F.lane);
#pragma unroll
                    for (int n = 0; n < 2; ++n) accO[m][n] = MFMA16(sfa[ks][n], qf, accO[m][n]); }
            }
        }
#pragma unroll
        for (int m = 0; m < 4; ++m) { float s1 = 0.f, s2 = 0.f;
#pragma unroll
            for (int n = 0; n < 2; ++n)
#pragma unroll
                for (int jj = 0; jj < 4; ++jj) { const float v = accO[m][n][jj]; s1 += v; s2 += v * v; }
            s1 += __shfl_xor(s1, 16); s1 += __shfl_xor(s1, 32); s2 += __shfl_xor(s2, 16); s2 += __shfl_xor(s2, 32);
            if (fq == 0) { red[(w * 64 + 16 * m + fr) * 2] = s1; red[(w * 64 + 16 * m + fr) * 2 + 1] = s2; } }
        __syncthreads();
#pragma unroll
        for (int m = 0; m < 4; ++m) { const int row = 16 * m + fr; float s1 = 0.f, s2 = 0.f;
#pragma unroll
            for (int ww = 0; ww < 8; ++ww) { s1 += red[(ww * 64 + row) * 2]; s2 += red[(ww * 64 + row) * 2 + 1]; }
            const float mean = s1 * (1.f / 256.f), ex2 = s2 * (1.f / 256.f);
            const float mu = GLA ? 0.f : mean, var = GLA ? ex2 : fmaxf(ex2 - mean * mean, 0.f);
            const float rstd = 1.0f / sqrtf(var + LN_EPS);
            const int t = s * CS + i * 64 + row;
#pragma unroll
            for (int n = 0; n < 2; ++n) { const int e = 32 * w + 16 * n + 4 * fq;
                const v2u gw2 = gpre[m][n];
                const float gt[4] = {bflo(gw2.x), bfhi(gw2.x), bflo(gw2.y), bfhi(gw2.y)};
                f32x4 gn = {1.f, 1.f, 1.f, 1.f}; if (GLA) gn = *(const f32x4*)(F.in[6] + e);
                float r4[4];
#pragma unroll
                for (int jj = 0; jj < 4; ++jj) { const float y = (accO[m][n][jj] - mu) * rstd * gn[jj]; r4[jj] = silu_g(gt[jj]) * y; }
                v2u ow; ow.x = pk2(r4[0], r4[1]); ow.y = pk2(r4[2], r4[3]);
                *(GAS v2u*)(mixed + (size_t)t * D + ocol + e) = ow; } }
    }
}
__device__ __forceinline__ void p4_out(Frame& F) {
    for (int u = F.bid; u < 8 * NS; u += F.G) { int s, h8; unit_sh(u, s, h8);
        if (h8 < 4) out_unit<false>(F, s, h8); else out_unit<true>(F, s, h8 - 4); }
    __syncthreads();
}

__device__ __forceinline__ void kv_chunk_load(Frame& F, v4u (&R)[8], const bf16* src  ) {
#pragma unroll
    for (int it = 0; it < 8; ++it) { const int ch = F.tid + NTHR * it, r = ch >> 4, cc = ch & 15; R[it] = *(const GAS v4u*)(src + (size_t)r * 4096 + 8 * cc); }
}
__device__ __forceinline__ void kv_chunk_store(Frame& F, const v4u (&R)[8], LAS unsigned char* dst) {
#pragma unroll
    for (int it = 0; it < 8; ++it) { const int ch = F.tid + NTHR * it, r = ch >> 4, cc = ch & 15; *(LAS v4u*)(dst + (r * 136 + 8 * cc) * 2) = R[it]; }
}
__device__ __forceinline__ void p8_attn(Frame& F) {
    const bf16* Q = WSP(bf16, WS_QB); const bf16* KVM = WSP(bf16, WS_KVM); bf16* att = WSP(bf16, WS_ATT);
    constexpr int CB = 256 * 136 * 2;
    const int fr = F.lane & 15, fq = F.lane >> 4, q4 = (F.lane >> 2) & 3, p4 = F.lane & 3;
    for (int u = F.bid; u < (T / 128) * 4; u += F.G) {
        const int h = u & 3, r0 = (u >> 2) * 128 + 16 * F.wave;
        v4u R[8];
        __syncthreads();
        kv_chunk_load(F, R, KVM + h * 512); kv_chunk_store(F, R, F.lds);
        __syncthreads();
        f32x4 accS[16];
#pragma unroll
        for (int i = 0; i < 16; ++i) accS[i] = (f32x4){0.f, 0.f, 0.f, 0.f};
#pragma unroll 1
        for (int dc = 0; dc < 4; ++dc) {
            kv_chunk_load(F, R, dc < 3 ? KVM + h * 512 + (dc + 1) * 128 : KVM + 2048 + h * 512);
            const LAS unsigned char* Cs = F.lds + (dc & 1) * CB;
            bf16x8_t qf[4];
#pragma unroll
            for (int ks = 0; ks < 4; ++ks) qf[ks] = *(const GAS bf16x8_t*)(Q + (size_t)(r0 + fr) * D + h * 512 + dc * 128 + 32 * ks + 8 * fq);
#pragma unroll
            for (int ks = 0; ks < 4; ++ks)
#pragma unroll
                for (int nt = 0; nt < 16; ++nt) accS[nt] = MFMA16(frag_row(Cs, 136, 16 * nt, 32 * ks, F.lane), qf[ks], accS[nt]);
            kv_chunk_store(F, R, F.lds + ((dc + 1) & 1) * CB);
            __syncthreads();
        }
        float mx = -3.0e38f;
#pragma unroll
        for (int nt = 0; nt < 16; ++nt)
#pragma unroll
            for (int jj = 0; jj < 4; ++jj) mx = fmaxf(mx, accS[nt][jj]);
        mx = fmaxf(mx, __shfl_xor(mx, 16)); mx = fmaxf(mx, __shfl_xor(mx, 32));
        const float sl2 = 0.04419417382415922f * 1.4426950408889634f;
        float sm = 0.f;
#pragma unroll
        for (int nt = 0; nt < 16; ++nt)
#pragma unroll
            for (int jj = 0; jj < 4; ++jj) { const float p = __builtin_amdgcn_exp2f((accS[nt][jj] - mx) * sl2); accS[nt][jj] = p; sm += p; }
        sm += __shfl_xor(sm, 16); sm += __shfl_xor(sm, 32);
        const float inv = 1.0f / sm;
        bf16x8_t pf[8];
#pragma unroll
        for (int ks2 = 0; ks2 < 8; ++ks2) { v4u w; w.x = pk2(accS[2 * ks2][0] * inv, accS[2 * ks2][1] * inv); w.y = pk2(accS[2 * ks2][2] * inv, accS[2 * ks2][3] * inv);
            w.z = pk2(accS[2 * ks2 + 1][0] * inv, accS[2 * ks2 + 1][1] * inv); w.w = pk2(accS[2 * ks2 + 1][2] * inv, accS[2 * ks2 + 1][3] * inv); pf[ks2] = __builtin_bit_cast(bf16x8_t, w); }
#pragma unroll 1
        for (int ec = 0; ec < 4; ++ec) {
            if (ec < 3) kv_chunk_load(F, R, KVM + 2048 + h * 512 + (ec + 1) * 128);
            const LAS unsigned char* Cs = F.lds + (ec & 1) * CB;
            f32x4 accO[8];
#pragma unroll
            for (int i = 0; i < 8; ++i) accO[i] = (f32x4){0.f, 0.f, 0.f, 0.f};
#pragma unroll
            for (int ks2 = 0; ks2 < 8; ++ks2)
#pragma unroll
                for (int et = 0; et < 8; ++et) { const LAS unsigned char* a = Cs + ((32 * ks2 + 4 * fq + q4) * 136 + 16 * et + 4 * p4) * 2;
                    const s16x4_t lo = lds_tr(a), hi = lds_tr(a + 16 * 136 * 2);
                    accO[et] = MFMA16(__builtin_shufflevector(lo, hi, 0, 1, 2, 3, 4, 5, 6, 7), pf[ks2], accO[et]); }
#pragma unroll
            for (int et = 0; et < 8; ++et) { v2u w; w.x = pk2(accO[et][0], accO[et][1]); w.y = pk2(accO[et][2], accO[et][3]);
                *(GAS v2u*)(att + (size_t)(r0 + fr) * D + h * 512 + ec * 128 + 16 * et + 4 * fq) = w; }
            if (ec < 3) kv_chunk_store(F, R, F.lds + ((ec + 1) & 1) * CB);
            __syncthreads();
        }
    }
}

__device__ __forceinline__ void p10_ln_router(Frame& F) {
    const float* Y = WSP(float, WS_Y2); const float* g = F.in[14]; const float* b = F.in[15]; bf16* HB = WSP(bf16, WS_H2B); float* st = WSP(float, WS_ST2);
    const float* Wg = F.in[16]; const float* We = F.in[18];
    LAS float* stl = (LAS float*)F.lds;
    LAS float* part = (LAS float*)(F.lds + 1024);
    LAS int* lcnt = (LAS int*)(F.lds + 1024 + 24576);
    LAS int* lbase = lcnt + 32;
    if (F.tid < 32) lcnt[F.tid] = 0;
    { int* tok = WSP(int, WS_TOK); for (int i = F.bid * NTHR + F.tid; i < PMAX; i += F.G * NTHR) tok[i] = 0; }
    __syncthreads();
    const int fr = F.lane & 15, fq = F.lane >> 4;
    for (int item = F.bid; item < T / 32; item += F.G) {
        const int row0 = item * 32;
#pragma unroll
        for (int i = 0; i < 4; ++i) {
            const int t = row0 + 4 * F.wave + i;
            const GAS f32x4* yr = (const GAS f32x4*)(Y + (size_t)t * D) + F.lane;
            f32x4 v[8]; float s = 0.f;
#pragma unroll
            for (int j = 0; j < 8; ++j) { v[j] = yr[64 * j]; s += (v[j][0] + v[j][1]) + (v[j][2] + v[j][3]); }
            const float mean = wave_sum(s) * (1.f / D); float s2 = 0.f;
#pragma unroll
            for (int j = 0; j < 8; ++j) { v[j] = v[j] - mean; s2 += (v[j][0] * v[j][0] + v[j][1] * v[j][1]) + (v[j][2] * v[j][2] + v[j][3] * v[j][3]); }
            const float rstd = 1.f / sqrtf(wave_sum(s2) * (1.f / D) + LN_EPS);
            if (F.lane == 0) { st[2 * t] = mean; st[2 * t + 1] = rstd; stl[2 * (4 * F.wave + i)] = mean; stl[2 * (4 * F.wave + i) + 1] = rstd; }
            GAS v2u* o8 = (GAS v2u*)(HB + (size_t)t * D) + F.lane;
#pragma unroll
            for (int j = 0; j < 8; ++j) { const f32x4 gv = *(const f32x4*)(g + 4 * F.lane + 256 * j), bv = *(const f32x4*)(b + 4 * F.lane + 256 * j);
                const f32x4 hv = v[j] * rstd * gv + bv;
                v2u w; w.x = pk2(hv[0], hv[1]); w.y = pk2(hv[2], hv[3]); o8[64 * j] = w; }
        }
        __syncthreads();
        {
            const int rt = F.wave >> 2, kq = F.wave & 3;
            const int r = row0 + 16 * rt + fr;
            const float mu = stl[2 * (16 * rt + fr)], rstd = stl[2 * (16 * rt + fr) + 1];
            f32x4 acc0 = {0.f, 0.f, 0.f, 0.f}, acc1 = acc0, acc2 = acc0;
            const float* yp = Y + (size_t)r * D + 512 * kq + 4 * fq;
            const float* wep = We + (size_t)(512 * kq + 4 * fq) * 32 + fr;
            const float* wgp = Wg + (size_t)(512 * kq + 4 * fq) * 4 + (fr & 3);
            const float gm = fr < 4 ? 1.f : 0.f;
#pragma unroll 8
            for (int it = 0; it < 32; ++it) {
                const int k0 = 16 * it;
                const f32x4 y4 = *(const GAS f32x4*)(yp + k0), g4 = *(const f32x4*)(g + 512 * kq + 4 * fq + k0), b4 = *(const f32x4*)(b + 512 * kq + 4 * fq + k0);
                const f32x4 a = (y4 - mu) * rstd * g4 + b4;
#pragma unroll
                for (int s = 0; s < 4; ++s) {
                    const float b0 = wep[(size_t)(k0 + s) * 32], b1 = wep[(size_t)(k0 + s) * 32 + 16], b2 = wgp[(size_t)(k0 + s) * 4] * gm;
                    acc0 = __builtin_amdgcn_mfma_f32_16x16x4f32(a[s], b0, acc0, 0, 0, 0);
                    acc1 = __builtin_amdgcn_mfma_f32_16x16x4f32(a[s], b1, acc1, 0, 0, 0);
                    acc2 = __builtin_amdgcn_mfma_f32_16x16x4f32(a[s], b2, acc2, 0, 0, 0);
                }
            }
            LAS float* pw = part + F.wave * 768;
#pragma unroll
            for (int jj = 0; jj < 4; ++jj) { pw[(4 * fq + jj) * 48 + fr] = acc0[jj]; pw[(4 * fq + jj) * 48 + 16 + fr] = acc1[jj]; pw[(4 * fq + jj) * 48 + 32 + fr] = acc2[jj]; }
        }
        __syncthreads();
        int e1 = 0, e2 = 0, r1 = 0, r2 = 0; float g1 = 0.f, g2 = 0.f;
        if (F.tid < 32) {
            const int rt = F.tid >> 4, rr = F.tid & 15;
            float le[32], lg[4];
#pragma unroll
            for (int c = 0; c < 32; ++c) { float s = 0.f;
#pragma unroll
                for (int kq = 0; kq < 4; ++kq) s += part[(rt * 4 + kq) * 768 + rr * 48 + c]; le[c] = s; }
#pragma unroll
            for (int c = 0; c < 4; ++c) { float s = 0.f;
#pragma unroll
                for (int kq = 0; kq < 4; ++kq) s += part[(rt * 4 + kq) * 768 + rr * 48 + 32 + c]; lg[c] = s + F.in[17][c]; }
            int grp = 0; float gmx = lg[0];
#pragma unroll
            for (int i = 1; i < 4; ++i) if (lg[i] > gmx) { gmx = lg[i]; grp = i; }
            float gs = 0.f;
#pragma unroll
            for (int i = 0; i < 4; ++i) gs += expf(lg[i] - gmx);
            const float pg_sel = 1.0f / gs;
            float fe[8];
#pragma unroll
            for (int j = 0; j < 8; ++j) { const float a = grp == 0 ? le[j] : grp == 1 ? le[8 + j] : grp == 2 ? le[16 + j] : le[24 + j]; fe[j] = a + F.in[19][grp * 8 + j]; }
            int i1 = 0; float m1 = fe[0];
#pragma unroll
            for (int j = 1; j < 8; ++j) if (fe[j] > m1) { m1 = fe[j]; i1 = j; }
            int i2 = -1; float m2 = -3.0e38f;
#pragma unroll
            for (int j = 0; j < 8; ++j) if (j != i1 && fe[j] > m2) { m2 = fe[j]; i2 = j; }
            const float p2 = expf(m2 - m1), den = 1.0f / (1.0f + p2);
            e1 = grp * 8 + i1; e2 = grp * 8 + i2; g1 = pg_sel * den; g2 = pg_sel * p2 * den;
            r1 = __hip_atomic_fetch_add((int*)(lcnt + e1), 1, __ATOMIC_RELAXED, __HIP_MEMORY_SCOPE_WORKGROUP); r2 = __hip_atomic_fetch_add((int*)(lcnt + e2), 1, __ATOMIC_RELAXED, __HIP_MEMORY_SCOPE_WORKGROUP);
        }
        __syncthreads();
        if (F.tid < 32) { const int c = lcnt[F.tid];
            lbase[F.tid] = c ? (int)__hip_atomic_fetch_add((unsigned*)(F.ctl + CW_CUR) + F.tid, (unsigned)c, __ATOMIC_RELAXED, __HIP_MEMORY_SCOPE_AGENT) : 0; }
        __syncthreads();
        if (F.tid < 32) {
            const int t = row0 + F.tid;
            int* ex = WSP(int, WS_EXP); float* gt = WSP(float, WS_GATE); int* sl = WSP(int, WS_SLOT);
            ex[2 * t] = e1; ex[2 * t + 1] = e2; gt[2 * t] = g1; gt[2 * t + 1] = g2;
            sl[2 * t] = lbase[e1] + r1; sl[2 * t + 1] = lbase[e2] + r2;
            lcnt[F.tid] = 0;
        }
        __syncthreads();
    }
}


#define XB_TMO      128
#define XB_XCNT(j)  (256  + 64 * (j))
#define XB_XSUB(j)  (1280 + 64 * (j))
#define XB_XGEN(j)  (2304 + 64 * (j))
#define XB_TOP      3328
#define XB_TOPGEN   3392
#define XCD_BAR_WORDS 3456
#define XB_SPIN_CAP (1u << 22)
__device__ __forceinline__ unsigned xb_ld(unsigned* p)              { return __hip_atomic_load(p, __ATOMIC_RELAXED, __HIP_MEMORY_SCOPE_AGENT); }
__device__ __forceinline__ unsigned xb_add(unsigned* p, unsigned v) { return __hip_atomic_fetch_add(p, v, __ATOMIC_RELAXED, __HIP_MEMORY_SCOPE_AGENT); }
__device__ __forceinline__ unsigned xb_xcc_id() { return (unsigned)__builtin_amdgcn_s_getreg((3 << 11) | 20) & 0xFu; }
#define XB_SPIN(cond, bar) do { unsigned _sp = 0; while (cond) { __builtin_amdgcn_s_sleep(1); \
    if ((++_sp & 255u) == 0u) { if (xb_ld(&(bar)[XB_TMO])) break; if (_sp > XB_SPIN_CAP) { atomicAdd(&(bar)[XB_TMO], 1u); break; } } } } while (0)
struct XcdBarrier { unsigned* bar; unsigned x; volatile LAS unsigned* st; };
__device__ __forceinline__ XcdBarrier xcd_barrier_post(unsigned* bar, volatile LAS unsigned* st) {
    XcdBarrier b; b.bar = bar; b.x = xb_xcc_id(); b.st = st;
    if (threadIdx.x == 0) (void)xb_add(&bar[XB_XCNT(b.x)], 1u);
    return b;
}
__device__ __forceinline__ void xcd_barrier_complete(unsigned* bar, unsigned x, unsigned& nloc, unsigned& nx) {
    const unsigned G = gridDim.x * gridDim.y * gridDim.z;
    unsigned sum, cnt, mine, sp = 0u;
    for (;;) {
        sum = 0u; cnt = 0u; mine = 0u;
#pragma unroll
        for (unsigned j = 0; j < 16; ++j) { const unsigned c = xb_ld(&bar[XB_XCNT(j)]); sum += c; cnt += (c > 0u) ? 1u : 0u; mine = (j == x) ? c : mine; }
        if (sum == G) break;
        __builtin_amdgcn_s_sleep(1);
        if ((++sp & 255u) == 0u) { if (xb_ld(&bar[XB_TMO])) break; if (sp > XB_SPIN_CAP) { atomicAdd(&bar[XB_TMO], 1u); break; } }
    }
    nloc = mine > 0u ? mine : 1u; nx = cnt > 0u ? cnt : 1u;
}
__device__ __forceinline__ void xcd_barrier(const XcdBarrier& b) {
    asm volatile("s_waitcnt vmcnt(0)" ::: "memory");
    __syncthreads();
    if (threadIdx.x == 0) {
        unsigned* bar = b.bar;
        __builtin_amdgcn_s_waitcnt(0);
        unsigned nloc = b.st[0], nx = b.st[1];
        if (nloc == 0u) { xcd_barrier_complete(bar, b.x, nloc, nx); b.st[0] = nloc; b.st[1] = nx; }
        const unsigned old = xb_add(&bar[XB_XSUB(b.x)], 1u);
        const unsigned gen = old / nloc;
        if (old + 1u == (gen + 1u) * nloc) {
            __builtin_amdgcn_fence(__ATOMIC_RELEASE, "agent");
            asm volatile("s_waitcnt vmcnt(0)" ::: "memory");
            const unsigned og = xb_add(&bar[XB_TOP], 1u);
            const unsigned tg = og / nx;
            if (og + 1u == (tg + 1u) * nx) xb_add(&bar[XB_TOPGEN], 1u);
            else XB_SPIN(xb_ld(&bar[XB_TOPGEN]) == tg, bar);
            __builtin_amdgcn_fence(__ATOMIC_ACQUIRE, "agent");
            xb_add(&bar[XB_XGEN(b.x)], 1u);
            asm volatile("s_waitcnt vmcnt(0)" ::: "memory");
        } else {
            XB_SPIN(xb_ld(&bar[XB_XGEN(b.x)]) == gen, bar);
            __builtin_amdgcn_fence(__ATOMIC_ACQUIRE, "agent");
            asm volatile("s_waitcnt vmcnt(0)" ::: "memory");
        }
    }
    __syncthreads();
}

struct Args { const float* in[25]; float* out; unsigned char* ws; int ph_lo, ph_hi, use_bar, pad; };
__global__ void __launch_bounds__(NTHR, 2) mega(Args args) {
    extern __shared__ __attribute__((aligned(16))) unsigned char lds[];
    Frame F;
    F.lds = (LAS unsigned char*)lds;
    F.MISC = (volatile LAS unsigned*)(F.lds + MISC_OFF);
    F.tid = threadIdx.x; F.lane = F.tid & 63; F.wave = __builtin_amdgcn_readfirstlane(F.tid >> 6);
    F.G = gridDim.x; F.bid = blockIdx.x;
    F.ws = args.ws; F.ctl = (gu32*)(args.ws + WS_CTL);
#pragma unroll
    for (int i = 0; i < 25; ++i) F.in[i] = args.in[i];
    F.out = args.out;
    for (int u = F.tid; u < (LDS_BYTES - LDSCTL_OFF) / 4; u += NTHR) ((LAS unsigned*)(F.lds + LDSCTL_OFF))[u] = 0u;
    __syncthreads();
    LAS int* ts = (LAS int*)(F.lds + MISC_OFF + 64);
    XcdBarrier bar; bar.bar = (unsigned*)(F.ctl + CW_BAR); bar.x = 0; bar.st = nullptr;
    if (args.use_bar) bar = xcd_barrier_post((unsigned*)(F.ctl + CW_BAR), F.MISC + 8);
    const int lo = args.ph_lo, hi = args.ph_hi;
#if MK_CG_SYNC == 2
    if (args.use_bar == 2) cooperative_groups::this_grid().sync();
#endif
#define IN(k) (lo <= (k) && (k) < hi)
#define REPS(k) for (int _r = 0; _r < ((k) == PROBE_PH ? PROBE_N : 1); ++_r)
#define SEAM(k) do { if (IN(k) && IN((k) + 1)) { if (MK_CG_SYNC == 1 && (k) == 0) cooperative_groups::this_grid().sync(); else { xcd_barrier(bar); if (PROBE_PH == 100) for (int _b = 1; _b < PROBE_N; ++_b) xcd_barrier(bar); } } } while (0)

    if (IN(0)) { REPS(0) p0_prologue(F); SEAM(0); }
    if (IN(1)) {
        p1_bcum(F, F.bid, F.G);
        const int g8 = F.bid >> 3, nsb = (g8 * 9) >> 5; const bool streamer = (F.G == 256) && ((((g8 + 1) * 9) >> 5) != nsb);
        if (!streamer) {
            pg8::Gemm g{WSP(pg8::bf16_t, WS_XB), WSP(pg8::bf16_t, WS_WIN), T + MEMN, HW + 4096, D}; pg8::OrderG1 S;
            if (F.G == 256) S.init(F.G - 72, F.bid - 8 * nsb); else S.init(F.G, F.bid);
            pg8::EpiH E{WSP(pg8::bf16_t, WS_H), WSP(pg8::bf16_t, WS_KVM), WSP(float, WS_RC), WSP(float, WS_RS)};
            pg8::gemm_phase<pg8::EpiH, pg8::OrderG1, true, true>(F.lds, g, S, E);
        }
        transpose_queue(F);
        if (PROBE_PH == 102) for (int _q = 1; _q < PROBE_N; ++_q) transpose_queue(F, _q);
        SEAM(1);
    }
#if PROBE_PH == 101
    if (IN(1)) {
        pg8::Gemm g{WSP(pg8::bf16_t, WS_XB), WSP(pg8::bf16_t, WS_WIN), T + MEMN, HW + 4096, D}; pg8::OrderG1 S; S.init(F.G, F.bid);
        pg8::EpiH E{WSP(pg8::bf16_t, WS_H), WSP(pg8::bf16_t, WS_KVM), WSP(float, WS_RC), WSP(float, WS_RS)};
        pg8::gemm_phase<pg8::EpiH, pg8::OrderG1, true, true>(F.lds, g, S, E);
        xcd_barrier(bar);
    }
#endif
    if (IN(2)) { REPS(2) p2_kv(F); SEAM(2); }
    if (IN(3)) { p3_scan(F); SEAM(3); }
#if PROBE_PH == 103
    if (IN(3)) { p2_kv(F); xcd_barrier(bar); p3_scan(F); xcd_barrier(bar); }
#endif
    if (IN(4)) { REPS(4) p4_out(F); SEAM(4); }
    if (IN(5)) {
        pg8::Gemm g{WSP(pg8::bf16_t, WS_MIXED), WSP(pg8::bf16_t, WS_WMIX), T, D, D}; pg8::StaticOrder S; S.init(T, D, F.G, F.bid);
        pg8::EpiResX E{F.in[0], WSP(float, WS_Y1), ALPHA};
        REPS(5) pg8::gemm_phase<pg8::EpiResX, pg8::StaticOrder, true, true>(F.lds, g, S, E);
        SEAM(5);
    }
    if (IN(6)) { REPS(6) ln_apply_plain(F, WSP(float, WS_Y1), F.in[8], F.in[9], WSP(bf16, WS_H1B), WSP(float, WS_ST1)); SEAM(6); }
    if (IN(7)) {
        pg8::Gemm g{WSP(pg8::bf16_t, WS_H1B), WSP(pg8::bf16_t, WS_WMQ), T, D, D}; pg8::StaticOrder S; S.init(T, D, F.G, F.bid);
        pg8::EpiB E{WSP(pg8::bf16_t, WS_QB), D, -1, 8192u * 2048u * 2u};
        REPS(7) pg8::gemm_phase<pg8::EpiB, pg8::StaticOrder, true, true>(F.lds, g, S, E);
        SEAM(7);
    }
    if (IN(8)) { REPS(8) p8_attn(F); SEAM(8); }
    if (IN(9)) {
        pg8::Gemm g{WSP(pg8::bf16_t, WS_ATT), WSP(pg8::bf16_t, WS_WMO), T, D, D}; pg8::StaticOrder S; S.init(T, D, F.G, F.bid);
        pg8::EpiResLN E{WSP(float, WS_Y1), WSP(float, WS_ST1), F.in[8], F.in[9], WSP(float, WS_Y2), ALPHA};
        REPS(9) pg8::gemm_phase<pg8::EpiResLN, pg8::StaticOrder, true, true>(F.lds, g, S, E);
        SEAM(9);
    }
    if (IN(10)) { p10_ln_router(F); SEAM(10); }
    if (IN(11)) { moe_tile_starts(F, ts); p10_dispatch(F, ts); SEAM(11); }
#if MK_MOE_F32
#define MOE_GEMM_GU(l, g, S, E) pg8::gemm_phase_bf32<pg8::EpiSwi, pg8::MoeOrder, true, true, true>(l, g, S, E)
#define MOE_GEMM_DN(l, g, S, E) pg8::gemm_phase_bf32<pg8::EpiB, pg8::MoeOrder, true, false, false>(l, g, S, E)
#else
#define MOE_GEMM_GU(l, g, S, E) pg8::gemm_phase<pg8::EpiSwi, pg8::MoeOrder, true, true, true>(l, g, S, E)
#define MOE_GEMM_DN(l, g, S, E) pg8::gemm_phase<pg8::EpiB, pg8::MoeOrder, true, true>(l, g, S, E)
#endif
    if (IN(12)) {
        moe_tile_starts(F, ts);
        const int U = ts[32] * 4;
        pg8::Gemm g{WSP(pg8::bf16_t, WS_H2B), WSP(pg8::bf16_t, WS_WGU), PMAX, 32 * 1024, D, WSP(int, WS_TOK)};
        pg8::MoeOrder S{(const PG8_LAS int*)ts, F.G, F.bid, 4, U < F.G ? U : F.G, F.in[20], F.in[21], 2048, 512, 0};
        pg8::EpiSwi E{WSP(pg8::bf16_t, WS_HID)};
        MOE_GEMM_GU(F.lds, g, S, E);
        SEAM(12);
    }
    if (IN(13)) {
        moe_tile_starts(F, ts);
        const int RT = ts[32], U = RT * 4, nbg = U > F.G ? U - F.G : 0, R1 = (F.G / 4) < RT ? (F.G / 4) : RT;
        {
            pg8::Gemm g{WSP(pg8::bf16_t, WS_H2B), WSP(pg8::bf16_t, WS_WGU), PMAX, 32 * 1024, D, WSP(int, WS_TOK)};
            pg8::MoeOrder S{(const PG8_LAS int*)ts, F.G, F.bid, 4, U, F.in[20], F.in[21], 2048, 512, F.G};
            pg8::EpiSwi E{WSP(pg8::bf16_t, WS_HID)};
            MOE_GEMM_GU(F.lds, g, S, E);
        }
        {
            pg8::Gemm g{WSP(pg8::bf16_t, WS_HID), WSP(pg8::bf16_t, WS_WD), PMAX, 32 * 2048, 512};
            pg8::MoeOrder S{(const PG8_LAS int*)ts, F.G - nbg, F.bid >= nbg ? F.bid - nbg : -1, 8, R1 * 8, F.in[22], nullptr, 512, 2048, 0};
            pg8::EpiB E{WSP(pg8::bf16_t, WS_YS), D, 7, 24576u * 2048u * 2u};
            MOE_GEMM_DN(F.lds, g, S, E);
        }
        SEAM(13);
    }
    if (IN(14)) {
        moe_tile_starts(F, ts);
        const int RT = ts[32], R1 = (F.G / 4) < RT ? (F.G / 4) : RT;
        pg8::Gemm g{WSP(pg8::bf16_t, WS_HID), WSP(pg8::bf16_t, WS_WD), PMAX, 32 * 2048, 512};
        pg8::MoeOrder S{(const PG8_LAS int*)ts, F.G, F.bid, 8, RT * 8, F.in[22], nullptr, 512, 2048, R1 * 8};
        pg8::EpiB E{WSP(pg8::bf16_t, WS_YS), D, 7, 24576u * 2048u * 2u};
        MOE_GEMM_DN(F.lds, g, S, E);
        SEAM(14);
    }
    if (IN(15)) { REPS(15) p13_combine(F); }
#undef IN
#undef SEAM
#undef REPS
}

extern "C" void kernel_launch(void* const* d_in, const int* in_sizes, int n_in, void* d_out, int out_size, void* d_ws, size_t ws_size, hipStream_t stream) {
    static int grid = 0;
    if (grid == 0) {
        if (n_in != 25 || in_sizes[0] != T * D || out_size != T * D || ws_size < WS_END) { fprintf(stderr, "kernel_launch: unexpected shapes / workspace (%d inputs, ws %zu)\n", n_in, ws_size); grid = -1; return; }
        int dev = 0, cus = 0;
        if (hipGetDevice(&dev) != hipSuccess || hipDeviceGetAttribute(&cus, hipDeviceAttributeMultiprocessorCount, dev) != hipSuccess) { grid = -1; return; }
        if (hipFuncSetAttribute((const void*)mega, hipFuncAttributeMaxDynamicSharedMemorySize, LDS_BYTES) != hipSuccess) { fprintf(stderr, "kernel_launch: hipFuncSetAttribute failed\n"); grid = -1; return; }
        int per_cu = 0;
        if (hipOccupancyMaxActiveBlocksPerMultiprocessor(&per_cu, (const void*)mega, NTHR, LDS_BYTES) != hipSuccess || per_cu < 1) { fprintf(stderr, "kernel_launch: occupancy query failed / 0 blocks per CU\n"); grid = -1; return; }
        (void)hipGetLastError();
        grid = cus;
    }
    if (grid < 0) return;
    if (hipMemsetAsync((char*)d_ws + WS_CTL, 0, CTL_ZERO_BYTES, stream) != hipSuccess) return;
    Args a{};
    for (int i = 0; i < 25; ++i) a.in[i] = (const float*)d_in[i];
    a.out = (float*)d_out; a.ws = (unsigned char*)d_ws;
#if MK_ONE_LAUNCH
    a.ph_lo = 0; a.ph_hi = NPH; a.use_bar = 1;
#if MK_CG_SYNC
    { void* kargs[] = {(void*)&a};
      hipError_t e = hipLaunchCooperativeKernel((const void*)mega, dim3(grid), dim3(NTHR), kargs, LDS_BYTES, stream);
      if (e != hipSuccess) fprintf(stderr, "cooperative launch failed: %s (grid %d)\n", hipGetErrorString(e), grid); }
#else
    hipLaunchKernelGGL(mega, dim3(grid), dim3(NTHR), LDS_BYTES, stream, a);
#endif
#else
    for (int p = 0; p < NPH; ++p) { a.ph_lo = p; a.ph_hi = p + 1; a.use_bar = 0;
        hipLaunchKernelGGL(mega, dim3(grid), dim3(NTHR), LDS_BYTES, stream, a); }
#endif
}
```

```cpp
#include <hip/hip_runtime.h>
#include <hip/hip_cooperative_groups.h>
#include <cstdio>
#include <cstdint>
#include <cmath>
#ifndef MK_ONE_LAUNCH
#define MK_ONE_LAUNCH 1
#endif
#ifndef MK_CG_SYNC
#define MK_CG_SYNC 2
#endif
#ifndef MK_WT_STORES
#define MK_WT_STORES 0
#endif
#ifndef MK_MOE_F32
#define MK_MOE_F32 0
#endif
#define PROBE_PH -1
#define PROBE_N 1
namespace pg8 {
#define PG8_LAS __attribute__((address_space(3)))
typedef unsigned short bf16_t;
typedef short bf16x8 __attribute__((ext_vector_type(8)));
typedef float f32x4 __attribute__((ext_vector_type(4)));
typedef unsigned u32x4 __attribute__((ext_vector_type(4)));
constexpr int BM = 256, BK = 64, HALF = 128, HTB = HALF * BK * 2  , STAGE_BYTES = 8 * HTB, NXCD = 8, WGM = 8;

__host__ __device__ __forceinline__ int lds_byte(int r, int c) { const int st = (r >> 4) * 2 + (c >> 5), rr = r & 15, cc = c & 31, ob = rr * 64 + cc * 2; return st * 1024 + (ob ^ (((ob >> 9) & 1) << 5)); }
__host__ __device__ __forceinline__ void stage_rc(int b, int& R, int& C) { const int st = b / 1024, sb = b % 1024, swz = sb ^ (((sb >> 9) & 1) << 5); R = (st >> 1) * 16 + swz / 64; C = (st & 1) * 32 + (swz % 64) / 2; }
__host__ __device__ __forceinline__ int perm32(int rho) { const int n = rho >> 4, i = rho & 15; return 8 * (i >> 2) + 4 * n + (i & 3); }

struct Unit { int pm, pn; };
struct Gemm { const bf16_t* A; const bf16_t* Bt; int M, N, K; const int* tok; };

struct StaticOrder {
    int nM, nN, nwg, G, c;
    __host__ __device__ void init(int M, int N, int G_, int c_) { nM = M / BM; nN = N / BM; nwg = nM * nN; G = G_; c = c_; }
    __host__ __device__ bool next(int i, Unit& u) const {
        const long L = (long)i * G + c; if (L >= nwg) return false;
        int wgid = (int)L; { const int q = nwg / NXCD, r = nwg % NXCD, xcd = wgid % NXCD, off = wgid / NXCD; wgid = (xcd < r ? xcd * (q + 1) : r * (q + 1) + (xcd - r) * q) + off; }
        const int nig = WGM * nN, gid = wgid / nig, fm = gid * WGM, gsz = (nM - fm) < WGM ? (nM - fm) : WGM;
        u.pm = fm + ((wgid % nig) % gsz); u.pn = (wgid % nig) / gsz; return true;
    }
    __device__ __forceinline__ void a_ready(const Unit&) const {}
    __device__ __forceinline__ void done(const Unit&) const {}
};


typedef unsigned u32x2 __attribute__((ext_vector_type(2)));
__device__ __forceinline__ unsigned cvt_pk_bf16(float lo, float hi) { unsigned r; asm volatile("v_cvt_pk_bf16_f32 %0, %1, %2" : "=v"(r) : "v"(lo), "v"(hi)); return r; }
__device__ __forceinline__ u32x4 pack8(const f32x4 a, const f32x4 b) { u32x4 w; w.x = cvt_pk_bf16(a[0], a[1]); w.y = cvt_pk_bf16(a[2], a[3]); w.z = cvt_pk_bf16(b[0], b[1]); w.w = cvt_pk_bf16(b[2], b[3]); return w; }
#if MK_WT_STORES
#define PG8_RSRC(base, bytes) __builtin_amdgcn_make_buffer_rsrc((void*)(base), 0, (int)(bytes), 0x00020000)
#define PG8_ST16(rs, base, byteoff, val) __builtin_amdgcn_raw_buffer_store_b128(__builtin_bit_cast(u32x4, (val)), (rs), (unsigned)(byteoff), 0, 16)
#else
#define PG8_RSRC(base, bytes) 0
#define PG8_ST16(rs, base, byteoff, val) (*(u32x4*)((char*)(base) + (size_t)(byteoff)) = __builtin_bit_cast(u32x4, (val)))
#endif
__device__ __forceinline__ float silu_f(float x) { return x * __builtin_amdgcn_rcpf(1.0f + __builtin_amdgcn_exp2f(-1.4426950408889634f * x)); }

struct EpiH {
    static constexpr bool PERM = true, AFTER_DRAIN = false;
    bf16_t* H; bf16_t* KVM; const float* rc; const float* rs;
    __device__ __forceinline__ void operator()(const f32x4 (&acc)[2][2][4][2], const Unit& u, int wr, int wc, int fr, int fq) const {
        const int cb = wc * 32 + 8 * fq;
        const auto rsH = PG8_RSRC(H, 8192u * 7168u * 2u); (void)rsH;
        if (u.pm >= 32) {
#pragma unroll
            for (int ai = 0; ai < 2; ++ai)
#pragma unroll
                for (int m = 0; m < 4; ++m) { bf16_t* rowp = KVM + (size_t)(wr * 64 + fr + ai * HALF + m * 16) * 4096 + (u.pn - 28) * BM + cb;
#pragma unroll
                    for (int bj = 0; bj < 2; ++bj) *(u32x4*)(rowp + bj * HALF) = pack8(acc[ai][bj][m][0], acc[ai][bj][m][1]); }
            return;
        }
        const int row0 = u.pm * BM + wr * 64 + fr;
        if (u.pn < 8) {
            const float sc = u.pn >= 4 ? 0.0625f : 1.0f;
#pragma unroll
            for (int ai = 0; ai < 2; ++ai)
#pragma unroll
                for (int m = 0; m < 4; ++m) { const int row = row0 + ai * HALF + m * 16;
                    const float* cr = rc + (size_t)row * 128 + cb; const float* sr = rs + (size_t)row * 128 + cb;
                    const f32x4 c0 = *(const f32x4*)cr * sc, c1 = *(const f32x4*)(cr + 4) * sc, s0 = *(const f32x4*)sr * sc, s1 = *(const f32x4*)(sr + 4) * sc;
                    const f32x4 t1a = acc[ai][0][m][0], t1b = acc[ai][0][m][1], t2a = acc[ai][1][m][0], t2b = acc[ai][1][m][1];
                    bf16_t* rowp = H + (size_t)row * 7168 + u.pn * BM + cb;
                    const unsigned bo = (unsigned)((size_t)row * 7168 + u.pn * BM + cb) * 2u; (void)rowp;
                    PG8_ST16(rsH, H, bo, pack8(t1a * c0 - t2a * s0, t1b * c1 - t2b * s1));
                    PG8_ST16(rsH, H, bo + 2 * HALF, pack8(t1a * s0 + t2a * c0, t1b * s1 + t2b * c1)); }
        } else {
            const float sc = (u.pn == 16 || u.pn == 17) ? 0.08838834764831845f : 1.0f;
#pragma unroll
            for (int ai = 0; ai < 2; ++ai)
#pragma unroll
                for (int m = 0; m < 4; ++m) { const unsigned bo = (unsigned)((size_t)(row0 + ai * HALF + m * 16) * 7168 + u.pn * BM + cb) * 2u;
#pragma unroll
                    for (int bj = 0; bj < 2; ++bj) PG8_ST16(rsH, H, bo + bj * 2 * HALF, pack8(acc[ai][bj][m][0] * sc, acc[ai][bj][m][1] * sc)); }
        }
    }
};
struct EpiB {
    static constexpr bool PERM = true, AFTER_DRAIN = false;
    bf16_t* O; int ldc; int pmask; unsigned obytes;
    __device__ __forceinline__ void operator()(const f32x4 (&acc)[2][2][4][2], const Unit& u, int wr, int wc, int fr, int fq) const {
        const int row0 = u.pm * BM + wr * 64 + fr, col0 = (u.pn & pmask) * BM + wc * 32 + 8 * fq;
        const auto rsO = PG8_RSRC(O, obytes); (void)rsO;
#pragma unroll
        for (int ai = 0; ai < 2; ++ai)
#pragma unroll
            for (int m = 0; m < 4; ++m) { const unsigned bo = (unsigned)((size_t)(row0 + ai * HALF + m * 16) * ldc + col0) * 2u;
#pragma unroll
                for (int bj = 0; bj < 2; ++bj) PG8_ST16(rsO, O, bo + bj * 2 * HALF, pack8(acc[ai][bj][m][0], acc[ai][bj][m][1])); }
    }
};
struct EpiSwi {
    static constexpr bool PERM = true, AFTER_DRAIN = false;
    bf16_t* O;
    __device__ __forceinline__ void operator()(const f32x4 (&acc)[2][2][4][2], const Unit& u, int wr, int wc, int fr, int fq) const {
        const int row0 = u.pm * BM + wr * 64 + fr, col0 = (u.pn & 3) * HALF + wc * 32 + 8 * fq;
        const auto rsO = PG8_RSRC(O, 24576u * 512u * 2u); (void)rsO;
#pragma unroll
        for (int ai = 0; ai < 2; ++ai)
#pragma unroll
            for (int m = 0; m < 4; ++m) { const unsigned bo = (unsigned)((size_t)(row0 + ai * HALF + m * 16) * 512 + col0) * 2u;
                f32x4 h0, h1;
#pragma unroll
                for (int i = 0; i < 4; ++i) { h0[i] = silu_f(acc[ai][0][m][0][i]) * acc[ai][1][m][0][i]; h1[i] = silu_f(acc[ai][0][m][1][i]) * acc[ai][1][m][1][i]; }
                PG8_ST16(rsO, O, bo, pack8(h0, h1)); }
    }
};
struct EpiResX {
    static constexpr bool PERM = false, AFTER_DRAIN = false;
    const float* X; float* Y; float alpha;
    __device__ __forceinline__ void operator()(const f32x4 (&acc)[2][2][4][2], const Unit& u, int wr, int wc, int fr, int fq) const {
        const int row0 = u.pm * BM + wr * 64 + fr, col0 = u.pn * BM + wc * 32 + 4 * fq;
        const auto rsY = PG8_RSRC(Y, 8192u * 2048u * 4u); (void)rsY;
#pragma unroll
        for (int ai = 0; ai < 2; ++ai)
#pragma unroll
            for (int m = 0; m < 4; ++m) { const size_t off = (size_t)(row0 + ai * HALF + m * 16) * 2048 + col0;
#pragma unroll
                for (int bj = 0; bj < 2; ++bj)
#pragma unroll
                    for (int n = 0; n < 2; ++n) { const f32x4 xv = *(const f32x4*)(X + off + bj * HALF + n * 16); const f32x4 yv = xv * alpha + acc[ai][bj][m][n]; PG8_ST16(rsY, Y, (off + bj * HALF + n * 16) * 4, yv); } }
    }
};
struct EpiResLN {
    static constexpr bool PERM = false, AFTER_DRAIN = false;
    const float* Yin; const float* st; const float* g; const float* b; float* Y; float alpha;
    __device__ __forceinline__ void operator()(const f32x4 (&acc)[2][2][4][2], const Unit& u, int wr, int wc, int fr, int fq) const {
        const int row0 = u.pm * BM + wr * 64 + fr, col0 = u.pn * BM + wc * 32 + 4 * fq;
        const auto rsY = PG8_RSRC(Y, 8192u * 2048u * 4u); (void)rsY;
        f32x4 gv[2][2], bv[2][2];
#pragma unroll
        for (int bj = 0; bj < 2; ++bj)
#pragma unroll
            for (int n = 0; n < 2; ++n) { gv[bj][n] = *(const f32x4*)(g + col0 + bj * HALF + n * 16) * alpha; bv[bj][n] = *(const f32x4*)(b + col0 + bj * HALF + n * 16) * alpha; }
#pragma unroll
        for (int ai = 0; ai < 2; ++ai)
#pragma unroll
            for (int m = 0; m < 4; ++m) { const int row = row0 + ai * HALF + m * 16; const size_t off = (size_t)row * 2048 + col0;
                const float mu = st[2 * row], rstd = st[2 * row + 1];
#pragma unroll
                for (int bj = 0; bj < 2; ++bj)
#pragma unroll
                    for (int n = 0; n < 2; ++n) { const f32x4 yv = *(const f32x4*)(Yin + off + bj * HALF + n * 16);
                        const f32x4 yo = ((yv - mu) * rstd) * gv[bj][n] + bv[bj][n] + acc[ai][bj][m][n]; PG8_ST16(rsY, Y, (off + bj * HALF + n * 16) * 4, yo); } }
    }
};

struct OrderG1 {
    StaticOrder so; int G, c;
    __device__ void init(int G_, int c_) { so.init(8192, 7168, G_, c_); G = G_; c = c_; }
    __device__ bool next(int i, Unit& u) const {
        const int L = i * G + c;
        if (L < 896) return so.next(i, u);
        if (L >= 912) return false;
        u.pm = 32; u.pn = 28 + (L - 896); return true;
    }
    __device__ __forceinline__ void a_ready(const Unit&) const {}
    __device__ __forceinline__ void done(const Unit&) const {}
};
struct MoeOrder {
    const PG8_LAS int* ts; int G, c, npn, total; const float* W0; const float* W1; int kdim, ncols; int L0;
    __device__ bool next(int i, Unit& u) const {
        if (c < 0) return false;
        const int L = L0 + i * G + c; if (L >= total) return false;
        const int rt = L / npn, pl = L - rt * npn; int e = 0;
        for (int j = 1; j < 32; ++j) e += (ts[j] <= rt) ? 1 : 0;
        u.pm = rt; u.pn = e * npn + pl; return true;
    }
    __device__ __forceinline__ int ldb() const { return ncols; }
    __device__ __forceinline__ const float* bbase(const Unit& u, int which) const {
        const int e = u.pn / npn, pl = u.pn - e * npn; const size_t eo = (size_t)e * kdim * ncols;
        if (W1) return (which ? W1 : W0) + eo + 128 * pl;
        return W0 + eo + 256 * pl;
    }
    __device__ __forceinline__ void a_ready(const Unit&) const {}
    __device__ __forceinline__ void done(const Unit&) const {}
};

template <int MODE>
struct EpiLN {
    static constexpr bool PERM = false, AFTER_DRAIN = true;
    const float* X; const float* stin; const float* gin; const float* bin;
    float* Yout; float* stout; bf16_t* HB; const float* g; const float* b;
    unsigned long long* xbuf;
    unsigned* cnt;
    __device__ __forceinline__ void operator()(const f32x4 (&)[2][2][4][2], const Unit&, int, int, int, int) const {}
    __device__ __forceinline__ void fused(f32x4 (&acc)[2][2][4][2], const Unit& u, int wr, int wc, int fr, int fq, PG8_LAS unsigned char* lds, int wid, int lane) const {
        typedef float f32x2v __attribute__((ext_vector_type(2)));
        PG8_LAS f32x2v* P = (PG8_LAS f32x2v*)lds;
        PG8_LAS f32x2v* MS = (PG8_LAS f32x2v*)(lds + 8192);
        const int row0 = u.pm * BM + wr * 64 + fr, col0 = u.pn * BM + wc * 32 + 4 * fq;
        float s1[2][4], s2[2][4], mu[2][4], rs[2][4];
#pragma unroll
        for (int ai = 0; ai < 2; ++ai)
#pragma unroll
            for (int m = 0; m < 4; ++m) { s1[ai][m] = 0.f; s2[ai][m] = 0.f; mu[ai][m] = 0.f; rs[ai][m] = 0.f;
                if (MODE == 1) { const int row = row0 + ai * HALF + m * 16; mu[ai][m] = stin[2 * row]; rs[ai][m] = stin[2 * row + 1]; } }
#pragma unroll
        for (int bj = 0; bj < 2; ++bj)
#pragma unroll
            for (int n = 0; n < 2; ++n) {
                f32x4 gvv = {0.f, 0.f, 0.f, 0.f}, bvv = gvv;
                if (MODE == 1) { gvv = *(const f32x4*)(gin + col0 + bj * HALF + n * 16) * 1.189207115002721f; bvv = *(const f32x4*)(bin + col0 + bj * HALF + n * 16) * 1.189207115002721f; }
#pragma unroll
                for (int ai = 0; ai < 2; ++ai)
#pragma unroll
                    for (int m = 0; m < 4; ++m) { const size_t off = (size_t)(row0 + ai * HALF + m * 16) * 2048 + col0 + bj * HALF + n * 16;
                        const f32x4 xv = *(const f32x4*)(X + off);
                        const f32x4 y = (MODE == 1 ? ((xv - mu[ai][m]) * rs[ai][m]) * gvv + bvv : xv * 1.189207115002721f) + acc[ai][bj][m][n];
                        acc[ai][bj][m][n] = y; *(f32x4*)(Yout + off) = y;
                        s1[ai][m] += (y[0] + y[1]) + (y[2] + y[3]); s2[ai][m] += (y[0] * y[0] + y[1] * y[1]) + (y[2] * y[2] + y[3] * y[3]); }
            }
#pragma unroll
        for (int ai = 0; ai < 2; ++ai)
#pragma unroll
            for (int m = 0; m < 4; ++m) { float a1 = s1[ai][m], a2 = s2[ai][m];
                a1 += __shfl_xor(a1, 16); a1 += __shfl_xor(a1, 32); a2 += __shfl_xor(a2, 16); a2 += __shfl_xor(a2, 32);
                if (fq == 0) P[(ai * HALF + wr * 64 + m * 16 + fr) * 4 + wc] = (f32x2v){a1, a2}; }
        asm volatile("s_waitcnt lgkmcnt(0)" ::: "memory"); __builtin_amdgcn_s_barrier(); asm volatile("" ::: "memory");
        const int t = wid * 64 + lane;
        if (t < 256) { const f32x2v a = P[t * 4 + 0], b2 = P[t * 4 + 1], c = P[t * 4 + 2], d = P[t * 4 + 3];
            const float S1 = (a.x + b2.x) + (c.x + d.x), S2 = (a.y + b2.y) + (c.y + d.y);
            __hip_atomic_store(xbuf + ((size_t)(u.pm * 8 + u.pn) * 256 + t), ((unsigned long long)__float_as_uint(S2) << 32) | __float_as_uint(S1), __ATOMIC_RELAXED, __HIP_MEMORY_SCOPE_AGENT);
            asm volatile("s_waitcnt vmcnt(0)" ::: "memory");
            if (lane == 0) __hip_atomic_fetch_add(cnt + 64 * u.pm, 1u, __ATOMIC_RELAXED, __HIP_MEMORY_SCOPE_AGENT); }
        if (wid == 0) {
            const unsigned long long t0 = __builtin_amdgcn_s_memrealtime();
            while ((unsigned)__builtin_amdgcn_readfirstlane(__hip_atomic_load(cnt + 64 * u.pm, __ATOMIC_RELAXED, __HIP_MEMORY_SCOPE_AGENT)) < 32u) {
                if (__builtin_amdgcn_s_memrealtime() - t0 > 2000000ull) break;
                __builtin_amdgcn_s_sleep(2); }
            __builtin_amdgcn_fence(__ATOMIC_ACQUIRE, "agent");
        }
        asm volatile("s_waitcnt vmcnt(0) lgkmcnt(0)" ::: "memory"); __builtin_amdgcn_s_barrier(); asm volatile("" ::: "memory");
        if (t < 256) { float S1 = 0.f, S2 = 0.f;
#pragma unroll
            for (int j = 0; j < 8; ++j) { const unsigned long long w = __hip_atomic_load(xbuf + ((size_t)(u.pm * 8 + j) * 256 + t), __ATOMIC_RELAXED, __HIP_MEMORY_SCOPE_AGENT); S1 += __uint_as_float((unsigned)w); S2 += __uint_as_float((unsigned)(w >> 32)); }
            const float mean = S1 * (1.f / 2048.f), var = fmaxf(S2 * (1.f / 2048.f) - mean * mean, 0.f), rstd = 1.0f / sqrtf(var + 1e-5f);
            MS[t] = (f32x2v){mean, rstd};
            if (u.pn == 0) { stout[2 * (u.pm * BM + t)] = mean; stout[2 * (u.pm * BM + t) + 1] = rstd; } }
        asm volatile("s_waitcnt lgkmcnt(0)" ::: "memory"); __builtin_amdgcn_s_barrier(); asm volatile("" ::: "memory");
#pragma unroll
        for (int bj = 0; bj < 2; ++bj)
#pragma unroll
            for (int n = 0; n < 2; ++n) { const f32x4 gN = *(const f32x4*)(g + col0 + bj * HALF + n * 16), bN = *(const f32x4*)(b + col0 + bj * HALF + n * 16);
#pragma unroll
                for (int ai = 0; ai < 2; ++ai)
#pragma unroll
                    for (int m = 0; m < 4; ++m) { const int rl = ai * HALF + wr * 64 + m * 16 + fr; const f32x2v ms = MS[rl]; const size_t off = (size_t)(u.pm * BM + rl) * 2048 + col0 + bj * HALF + n * 16;
                        const f32x4 h = ((acc[ai][bj][m][n] - ms.x) * ms.y) * gN + bN;
                        u32x2 w; w.x = cvt_pk_bf16(h[0], h[1]); w.y = cvt_pk_bf16(h[2], h[3]); *(u32x2*)(HB + off) = w; } }
    }
};
template <class Epi, class Sched, bool ALIGN_EPI = false, bool SP2 = false, bool GATHER = false>
__device__ __forceinline__ void gemm_phase(PG8_LAS unsigned char* lds, const Gemm g, const Sched& S, const Epi& E) {
    const int tid = threadIdx.x, wid = __builtin_amdgcn_readfirstlane(tid >> 6), lane = tid & 63, wr = wid >> 2, wc = wid & 3, fr = lane & 15, fq = lane >> 4;
    const int K = g.K, nt = K / BK;
    unsigned voffA[2], voffB[2];
#pragma unroll
    for (int i = 0; i < 2; ++i) { int R, C; stage_rc(tid * 16 + i * 8192, R, C); const int Rb = Epi::PERM ? ((R & ~31) + perm32(R & 31)) : R;
        voffA[i] = (unsigned)(R * K + C) * 2u; voffB[i] = (unsigned)(Rb * K + C) * 2u; }
    unsigned coff[2][2], noff[2][2]; int gR[2], gC[2];
#pragma unroll
    for (int i = 0; i < 2; ++i) { int R, C; stage_rc(tid * 16 + i * 8192, R, C); gR[i] = R; gC[i] = C; coff[0][i] = coff[1][i] = noff[0][i] = noff[1][i] = 0u; }
#define PG8_GOFF(dst, pm_) do { if constexpr (GATHER) { _Pragma("unroll") for (int _h = 0; _h < 2; ++_h) _Pragma("unroll") for (int _i = 0; _i < 2; ++_i) \
        dst[_h][_i] = ((unsigned)g.tok[(pm_) * BM + _h * HALF + gR[_i]] * (unsigned)K + (unsigned)gC[_i]) * 2u; } } while (0)
    const size_t kstep = (size_t)(BK * 2);
    const size_t hstep = (size_t)HALF * K * 2;
    const size_t tstep = 2 * hstep;
    const unsigned ldsw = (unsigned)wid * 1024u;
    const int aoff = lds_byte(wr * 64 + fr, fq * 8), boff = lds_byte(wc * 32 + fr, fq * 8);
#define PG8_SA(b, h) (((b) * 2 + (h)) * HTB)
#define PG8_SB(b, h) ((4 + (b) * 2 + (h)) * HTB)
#define PG8_STAGE(bufoff, gbase, voff) do { _Pragma("unroll") for (int _i = 0; _i < 2; ++_i) \
        __builtin_amdgcn_global_load_lds((const unsigned*)((const char*)(gbase) + (voff)[_i]), (PG8_LAS unsigned*)(lds + (bufoff) + ldsw + _i * 8192), 16, 0, 0); } while (0)
#define PG8_STAGEA(bufoff, gptr, hh, kbytes, usenext) do { if constexpr (GATHER) { _Pragma("unroll") for (int _i = 0; _i < 2; ++_i) { const unsigned _o = (usenext) ? noff[hh][_i] : coff[hh][_i]; \
        __builtin_amdgcn_global_load_lds((const unsigned*)((const char*)g.A + (size_t)(kbytes) + _o), (PG8_LAS unsigned*)(lds + (bufoff) + ldsw + _i * 8192), 16, 0, 0); } } else { PG8_STAGE(bufoff, gptr, voffA); } } while (0)
#define PG8_LDA(dst, b, h) do { _Pragma("unroll") for (int m = 0; m < 4; ++m) _Pragma("unroll") for (int k = 0; k < 2; ++k) dst[m][k] = *(const PG8_LAS bf16x8*)(lds + PG8_SA(b, h) + aoff + m * 2048 + k * 1024); } while (0)
#define PG8_LDB(dst, b, h) do { _Pragma("unroll") for (int n = 0; n < 2; ++n) _Pragma("unroll") for (int k = 0; k < 2; ++k) dst[n][k] = *(const PG8_LAS bf16x8*)(lds + PG8_SB(b, h) + boff + n * 2048 + k * 1024); } while (0)
#define PG8_MMA(ai, bj, At, Bt) do { __builtin_amdgcn_s_setprio(1); _Pragma("unroll") for (int m = 0; m < 4; ++m) _Pragma("unroll") for (int n = 0; n < 2; ++n) _Pragma("unroll") for (int k = 0; k < 2; ++k) \
        acc[ai][bj][m][n] = __builtin_amdgcn_mfma_f32_16x16x32_bf16(Bt[n][k], At[m][k], acc[ai][bj][m][n], 0, 0, 0); __builtin_amdgcn_s_setprio(0); } while (0)
#define PG8_WAIT_V(n) asm volatile("s_waitcnt vmcnt(" #n ")" ::: "memory")
#define PG8_WAIT_L(n) asm volatile("s_waitcnt lgkmcnt(" #n ")" ::: "memory")
#define PG8_BAR __builtin_amdgcn_s_barrier()
#define PG8_SCHED __builtin_amdgcn_sched_barrier(0)
    Unit cur, nxt; int ui = 0;
    if (!S.next(0, cur)) return;
    f32x4 acc[2][2][4][2];
#pragma unroll
    for (int a = 0; a < 2; ++a)
#pragma unroll
        for (int b = 0; b < 2; ++b)
#pragma unroll
            for (int m = 0; m < 4; ++m)
#pragma unroll
                for (int n = 0; n < 2; ++n) acc[a][b][m][n] = (f32x4){0.f, 0.f, 0.f, 0.f};
    bf16x8 At[4][2], B0[2][2], B1[2][2];
    const char* cA = (const char*)g.A + (size_t)cur.pm * tstep; const char* cB = (const char*)g.Bt + (size_t)cur.pn * tstep;
    PG8_GOFF(coff, cur.pm);
    S.a_ready(cur);
    if constexpr (SP2) {
        PG8_STAGE(PG8_SB(0, 0), cB, voffB); PG8_STAGE(PG8_SB(0, 1), cB + hstep, voffB); PG8_STAGEA(PG8_SA(0, 0), cA, 0, 0, false); PG8_STAGEA(PG8_SA(0, 1), cA + hstep, 1, 0, false);
        if (wr == 1) PG8_BAR;
        PG8_WAIT_V(2); PG8_BAR;
        PG8_STAGE(PG8_SB(1, 0), cB + kstep, voffB); PG8_STAGEA(PG8_SA(1, 0), cA + kstep, 0, kstep, false); PG8_STAGE(PG8_SB(1, 1), cB + hstep + kstep, voffB);
        PG8_WAIT_V(6); PG8_BAR;
    } else {
        PG8_STAGE(PG8_SB(0, 0), cB, voffB); PG8_STAGE(PG8_SA(0, 0), cA, voffA); PG8_STAGE(PG8_SB(0, 1), cB + hstep, voffB); PG8_STAGE(PG8_SA(0, 1), cA + hstep, voffA);
        if (wr == 1) PG8_BAR;
        PG8_WAIT_V(4); PG8_BAR;
        PG8_STAGE(PG8_SB(1, 0), cB + kstep, voffB); PG8_STAGE(PG8_SA(1, 0), cA + kstep, voffA); PG8_STAGE(PG8_SB(1, 1), cB + hstep + kstep, voffB);
        PG8_WAIT_V(6); PG8_BAR;
    }
    for (;;) {
        const bool has_next = S.next(ui + 1, nxt);
        const char* nA = has_next ? (const char*)g.A + (size_t)nxt.pm * tstep : cA; const char* nB = has_next ? (const char*)g.Bt + (size_t)nxt.pn * tstep : cB;
        if constexpr (GATHER) { if (has_next) { PG8_GOFF(noff, nxt.pm); } else { _Pragma("unroll") for (int _h = 0; _h < 2; ++_h) _Pragma("unroll") for (int _i = 0; _i < 2; ++_i) noff[_h][_i] = coff[_h][_i]; } }
        for (int t = 0; t < nt; t += 2) {
            const bool last = (t == nt - 2);
            const char* a1 = cA + (size_t)(t + 1) * kstep;
            const char* a2 = last ? nA : cA + (size_t)(t + 2) * kstep; const char* b2 = last ? nB : cB + (size_t)(t + 2) * kstep;
            const char* a3 = a2 + kstep; const char* b3 = b2 + kstep;
            const size_t k1 = (size_t)(t + 1) * kstep, k2 = last ? 0 : (size_t)(t + 2) * kstep, k3 = k2 + kstep;
            if (last && has_next) S.a_ready(nxt);
            if constexpr (SP2) {
            PG8_LDB(B0, 0, 0); PG8_LDB(B1, 0, 1); PG8_SCHED; PG8_LDA(At, 0, 0); PG8_STAGEA(PG8_SA(1, 1), a1 + hstep, 1, k1, false);
            PG8_WAIT_V(8); PG8_WAIT_L(0); PG8_BAR; PG8_MMA(0, 0, At, B0); PG8_MMA(0, 1, At, B1); PG8_BAR; PG8_SCHED;
            PG8_LDA(At, 0, 1); PG8_STAGE(PG8_SB(0, 0), b2, voffB); PG8_STAGE(PG8_SB(0, 1), b2 + hstep, voffB); PG8_STAGEA(PG8_SA(0, 0), a2, 0, k2, last);
            PG8_WAIT_V(8); PG8_WAIT_L(0); PG8_BAR; PG8_MMA(1, 0, At, B0); PG8_MMA(1, 1, At, B1); PG8_BAR; PG8_SCHED;
            PG8_LDB(B0, 1, 0); PG8_LDB(B1, 1, 1); PG8_SCHED; PG8_LDA(At, 1, 0); PG8_STAGEA(PG8_SA(0, 1), a2 + hstep, 1, k2, last);
            PG8_WAIT_V(8); PG8_WAIT_L(0); PG8_BAR; PG8_MMA(0, 0, At, B0); PG8_MMA(0, 1, At, B1); PG8_BAR; PG8_SCHED;
            PG8_LDA(At, 1, 1); PG8_STAGE(PG8_SB(1, 0), b3, voffB); PG8_STAGE(PG8_SB(1, 1), b3 + hstep, voffB); PG8_STAGEA(PG8_SA(1, 0), a3, 0, k3, last);
            PG8_WAIT_V(8); PG8_WAIT_L(0); PG8_BAR; PG8_MMA(1, 0, At, B0); PG8_MMA(1, 1, At, B1); PG8_BAR; PG8_SCHED;
            } else {
            PG8_LDB(B0, 0, 0); PG8_SCHED; PG8_LDA(At, 0, 0); PG8_STAGE(PG8_SA(1, 1), a1 + hstep, voffA);
            PG8_WAIT_L(8); PG8_BAR; PG8_WAIT_L(0); PG8_MMA(0, 0, At, B0); PG8_BAR; PG8_SCHED;
            PG8_LDB(B1, 0, 1); PG8_STAGE(PG8_SB(0, 0), b2, voffB);
            PG8_BAR; PG8_WAIT_L(0); PG8_MMA(0, 1, At, B1); PG8_BAR;
            PG8_LDA(At, 0, 1); PG8_STAGE(PG8_SA(0, 0), a2, voffA);
            PG8_BAR; PG8_WAIT_L(0); PG8_MMA(1, 0, At, B0); PG8_BAR; PG8_SCHED;
            PG8_STAGE(PG8_SB(0, 1), b2 + hstep, voffB);
            PG8_WAIT_V(6); PG8_BAR; PG8_MMA(1, 1, At, B1); PG8_BAR;
            PG8_LDB(B0, 1, 0); PG8_SCHED; PG8_LDA(At, 1, 0); PG8_STAGE(PG8_SA(0, 1), a2 + hstep, voffA);
            PG8_WAIT_L(8); PG8_BAR; PG8_WAIT_L(0); PG8_MMA(0, 0, At, B0); PG8_BAR; PG8_SCHED;
            PG8_LDB(B1, 1, 1); PG8_STAGE(PG8_SB(1, 0), b3, voffB);
            PG8_BAR; PG8_WAIT_L(0); PG8_MMA(0, 1, At, B1); PG8_BAR;
            PG8_LDA(At, 1, 1); PG8_STAGE(PG8_SA(1, 0), a3, voffA);
            PG8_BAR; PG8_WAIT_L(0); PG8_MMA(1, 0, At, B0); PG8_BAR; PG8_SCHED;
            PG8_STAGE(PG8_SB(1, 1), b3 + hstep, voffB);
            PG8_WAIT_V(6); PG8_BAR; PG8_MMA(1, 1, At, B1); PG8_BAR;
            }
        }
        if constexpr (ALIGN_EPI) { if (wr == 0) PG8_BAR; }
        if constexpr (!Epi::AFTER_DRAIN) { E(acc, cur, wr, wc, fr, fq); S.done(cur); }
        if (!has_next) break;
#pragma unroll
        for (int a = 0; a < 2; ++a)
#pragma unroll
            for (int b = 0; b < 2; ++b)
#pragma unroll
                for (int m = 0; m < 4; ++m)
#pragma unroll
                    for (int n = 0; n < 2; ++n) acc[a][b][m][n] = (f32x4){0.f, 0.f, 0.f, 0.f};
        cur = nxt; cA = nA; cB = nB; ++ui;
        if constexpr (GATHER) { _Pragma("unroll") for (int _h = 0; _h < 2; ++_h) _Pragma("unroll") for (int _i = 0; _i < 2; ++_i) coff[_h][_i] = noff[_h][_i]; }
        if constexpr (ALIGN_EPI) { if (wr == 1) PG8_BAR; }
    }
    PG8_WAIT_V(0);
    if constexpr (!ALIGN_EPI) { if (wr == 0) PG8_BAR; }
    PG8_BAR;
    if constexpr (Epi::AFTER_DRAIN) { E.fused(acc, cur, wr, wc, fr, fq, lds, wid, lane); S.done(cur); }
#undef PG8_SA
#undef PG8_SB
#undef PG8_STAGE
#undef PG8_STAGEA
#undef PG8_GOFF
#undef PG8_LDA
#undef PG8_LDB
#undef PG8_MMA
#undef PG8_WAIT_V
#undef PG8_WAIT_L
#undef PG8_BAR
#undef PG8_SCHED
}
constexpr int PBI = 544, SBI_BYTES = 64 * PBI;
template <class Epi, class Sched, bool ALIGN_EPI = false, bool GATHER = false, bool SPLIT = false>
__device__ __forceinline__ void gemm_phase_bf32(PG8_LAS unsigned char* lds, const Gemm g, const Sched& S, const Epi& E) {
    const int tid = threadIdx.x, wid = __builtin_amdgcn_readfirstlane(tid >> 6), lane = tid & 63, wr = wid >> 2, wc = wid & 3, fr = lane & 15, fq = lane >> 4;
    const int K = g.K, nt = K / BK;
    unsigned voffA[2];
#pragma unroll
    for (int i = 0; i < 2; ++i) { int R, C; stage_rc(tid * 16 + i * 8192, R, C); voffA[i] = (unsigned)(R * K + C) * 2u; }
    unsigned coff[2][2], noff[2][2]; int gR[2], gC[2];
#pragma unroll
    for (int i = 0; i < 2; ++i) { int R, C; stage_rc(tid * 16 + i * 8192, R, C); gR[i] = R; gC[i] = C; coff[0][i] = coff[1][i] = noff[0][i] = noff[1][i] = 0u; }
#define PG8_GOFF(dst, pm_) do { if constexpr (GATHER) { _Pragma("unroll") for (int _h = 0; _h < 2; ++_h) _Pragma("unroll") for (int _i = 0; _i < 2; ++_i) \
        dst[_h][_i] = ((unsigned)g.tok[(pm_) * BM + _h * HALF + gR[_i]] * (unsigned)K + (unsigned)gC[_i]) * 2u; } } while (0)
    const size_t kstep = (size_t)(BK * 2), hstep = (size_t)HALF * K * 2, tstep = 2 * hstep;
    const unsigned ldsw = (unsigned)wid * 1024u;
    const int aoff = lds_byte(wr * 64 + fr, fq * 8);
    const int ldb = S.ldb();
    const size_t bkstep = (size_t)BK * ldb;
    const int q4 = (lane >> 2) & 3, p4 = lane & 3;
    const unsigned lo = SPLIT ? (unsigned)((lane >> 5) * ldb + 4 * (lane & 31)) * 4u : (unsigned)lane * 16u;
    const unsigned bwoff = SPLIT ? (unsigned)(8 * wid + (lane >> 5)) * PBI + (unsigned)(((4 * (lane & 31)) ^ ((wid & 1) << 6)) * 2)
                                 : (unsigned)(8 * wid) * PBI + (unsigned)(((4 * lane) ^ ((wid & 1) << 6)) * 2);
    unsigned broff[2][2];
#pragma unroll
    for (int n = 0; n < 2; ++n)
#pragma unroll
        for (int k = 0; k < 2; ++k) { const int row = 32 * k + 8 * fq + q4, col = 32 * wc + (Epi::PERM ? 8 * p4 + 4 * n : 16 * n + 4 * p4);
            broff[n][k] = (unsigned)row * PBI + (unsigned)((col ^ ((row & 8) << 3)) * 2); }
#define PG8_SA(b, h) (((b) * 2 + (h)) * HTB)
#define PG8_SBI(b) (4 * HTB + (b) * SBI_BYTES)
#define PG8_STAGE(bufoff, gbase, voff) do { _Pragma("unroll") for (int _i = 0; _i < 2; ++_i) \
        __builtin_amdgcn_global_load_lds((const unsigned*)((const char*)(gbase) + (voff)[_i]), (PG8_LAS unsigned*)(lds + (bufoff) + ldsw + _i * 8192), 16, 0, 0); } while (0)
#define PG8_STAGEA(bufoff, gptr, hh, kbytes, usenext) do { if constexpr (GATHER) { _Pragma("unroll") for (int _i = 0; _i < 2; ++_i) { const unsigned _o = (usenext) ? noff[hh][_i] : coff[hh][_i]; \
        __builtin_amdgcn_global_load_lds((const unsigned*)((const char*)g.A + (size_t)(kbytes) + _o), (PG8_LAS unsigned*)(lds + (bufoff) + ldsw + _i * 8192), 16, 0, 0); } } else { PG8_STAGE(bufoff, gptr, voffA); } } while (0)
#define PG8_LDA(dst, b, h) do { _Pragma("unroll") for (int m = 0; m < 4; ++m) _Pragma("unroll") for (int k = 0; k < 2; ++k) dst[m][k] = *(const PG8_LAS bf16x8*)(lds + PG8_SA(b, h) + aoff + m * 2048 + k * 1024); } while (0)
#define PG8_LDBT(dst, b, h) do { _Pragma("unroll") for (int n = 0; n < 2; ++n) _Pragma("unroll") for (int k = 0; k < 2; ++k) { \
        const PG8_LAS unsigned char* _a = lds + PG8_SBI(b) + broff[n][k] + (h) * 256; \
        const s16x4 _lo = __builtin_bit_cast(s16x4, __builtin_amdgcn_ds_read_tr16_b64_v4i16((PG8_LAS s16x4*)_a)), _hi = __builtin_bit_cast(s16x4, __builtin_amdgcn_ds_read_tr16_b64_v4i16((PG8_LAS s16x4*)(_a + 4 * PBI))); \
        dst[n][k] = __builtin_shufflevector(_lo, _hi, 0, 1, 2, 3, 4, 5, 6, 7); } } while (0)
#define PG8_BLOAD(p0, p1) do { _Pragma("unroll") for (int _i = 0; _i < 8; ++_i) { \
        const float* _u = SPLIT ? ((_i < 4 ? (p0) : (p1)) + (size_t)(8 * wid + 2 * (_i & 3)) * ldb) : ((p0) + (size_t)(8 * wid + _i) * ldb); \
        breg[_i] = *(const __attribute__((address_space(1))) f32x4*)((const char*)_u + lo); } } while (0)
#define PG8_BWRITE(b) do { _Pragma("unroll") for (int _i = 0; _i < 8; ++_i) { u32x2 _w; _w.x = cvt_pk_bf16(breg[_i][0], breg[_i][1]); _w.y = cvt_pk_bf16(breg[_i][2], breg[_i][3]); \
        *(PG8_LAS u32x2*)(lds + PG8_SBI(b) + bwoff + (SPLIT ? (2 * (_i & 3)) * PBI + (_i >> 2) * 256 : _i * PBI)) = _w; } } while (0)
#define PG8_MMA(ai, bj, At, Bt) do { __builtin_amdgcn_s_setprio(1); _Pragma("unroll") for (int m = 0; m < 4; ++m) _Pragma("unroll") for (int n = 0; n < 2; ++n) _Pragma("unroll") for (int k = 0; k < 2; ++k) \
        acc[ai][bj][m][n] = __builtin_amdgcn_mfma_f32_16x16x32_bf16(Bt[n][k], At[m][k], acc[ai][bj][m][n], 0, 0, 0); __builtin_amdgcn_s_setprio(0); } while (0)
#define PG8_WAIT_V(n) asm volatile("s_waitcnt vmcnt(" #n ")" ::: "memory")
#define PG8_WAIT_L(n) asm volatile("s_waitcnt lgkmcnt(" #n ")" ::: "memory")
#define PG8_BAR __builtin_amdgcn_s_barrier()
#define PG8_SCHED __builtin_amdgcn_sched_barrier(0)
    typedef short s16x4 __attribute__((ext_vector_type(4)));
    typedef unsigned u32x2 __attribute__((ext_vector_type(2)));
    Unit cur, nxt; int ui = 0;
    if (!S.next(0, cur)) return;
    f32x4 acc[2][2][4][2];
#pragma unroll
    for (int a = 0; a < 2; ++a)
#pragma unroll
        for (int b = 0; b < 2; ++b)
#pragma unroll
            for (int m = 0; m < 4; ++m)
#pragma unroll
                for (int n = 0; n < 2; ++n) acc[a][b][m][n] = (f32x4){0.f, 0.f, 0.f, 0.f};
    bf16x8 At[4][2], B0[2][2];
    f32x4 breg[8];
    const char* cA = (const char*)g.A + (size_t)cur.pm * tstep; const float* cB0 = S.bbase(cur, 0); const float* cB1 = S.bbase(cur, 1);
    PG8_GOFF(coff, cur.pm);
    PG8_BLOAD(cB0, cB1); PG8_STAGEA(PG8_SA(0, 0), cA, 0, 0, false); PG8_STAGEA(PG8_SA(0, 1), cA + hstep, 1, 0, false);
    PG8_BWRITE(0); PG8_SCHED;
    if (wr == 1) PG8_BAR;
    PG8_WAIT_V(2); PG8_WAIT_L(0); PG8_BAR;
    PG8_BLOAD(cB0 + bkstep, cB1 + bkstep); PG8_STAGEA(PG8_SA(1, 0), cA + kstep, 0, kstep, false); PG8_SCHED;
    PG8_WAIT_V(10); PG8_BAR;
    for (;;) {
        const bool has_next = S.next(ui + 1, nxt);
        const char* nA = has_next ? (const char*)g.A + (size_t)nxt.pm * tstep : cA; const float* nB0 = has_next ? S.bbase(nxt, 0) : cB0; const float* nB1 = has_next ? S.bbase(nxt, 1) : cB1;
        if constexpr (GATHER) { if (has_next) { PG8_GOFF(noff, nxt.pm); } else { _Pragma("unroll") for (int _h = 0; _h < 2; ++_h) _Pragma("unroll") for (int _i = 0; _i < 2; ++_i) noff[_h][_i] = coff[_h][_i]; } }
        for (int t = 0; t < nt; t += 2) {
            const bool last = (t == nt - 2);
            const char* a1 = cA + (size_t)(t + 1) * kstep;
            const char* a2 = last ? nA : cA + (size_t)(t + 2) * kstep; const float* b20 = last ? nB0 : cB0 + (size_t)(t + 2) * bkstep; const float* b21 = last ? nB1 : cB1 + (size_t)(t + 2) * bkstep;
            const char* a3 = a2 + kstep; const float* b30 = b20 + bkstep; const float* b31 = b21 + bkstep;
            const size_t k1 = (size_t)(t + 1) * kstep, k2 = last ? 0 : (size_t)(t + 2) * kstep, k3 = k2 + kstep;
            PG8_LDBT(B0, 0, 0); PG8_SCHED; PG8_LDA(At, 0, 0); PG8_STAGEA(PG8_SA(1, 1), a1 + hstep, 1, k1, false);
            PG8_WAIT_V(12); PG8_WAIT_L(0); PG8_BAR; PG8_MMA(0, 0, At, B0); PG8_LDBT(B0, 0, 1); PG8_WAIT_L(0); PG8_SCHED; PG8_MMA(0, 1, At, B0); PG8_BAR; PG8_SCHED;
            PG8_BWRITE(1); PG8_BLOAD(b20, b21); PG8_SCHED; PG8_LDBT(B0, 0, 0); PG8_LDA(At, 0, 1); PG8_STAGEA(PG8_SA(0, 0), a2, 0, k2, last);
            PG8_WAIT_V(12); PG8_WAIT_L(0); PG8_BAR; PG8_MMA(1, 0, At, B0); PG8_LDBT(B0, 0, 1); PG8_WAIT_L(0); PG8_SCHED; PG8_MMA(1, 1, At, B0); PG8_BAR; PG8_SCHED;
            PG8_LDBT(B0, 1, 0); PG8_SCHED; PG8_LDA(At, 1, 0); PG8_STAGEA(PG8_SA(0, 1), a2 + hstep, 1, k2, last);
            PG8_WAIT_V(12); PG8_WAIT_L(0); PG8_BAR; PG8_MMA(0, 0, At, B0); PG8_LDBT(B0, 1, 1); PG8_WAIT_L(0); PG8_SCHED; PG8_MMA(0, 1, At, B0); PG8_BAR; PG8_SCHED;
            PG8_BWRITE(0); PG8_BLOAD(b30, b31); PG8_SCHED; PG8_LDBT(B0, 1, 0); PG8_LDA(At, 1, 1); PG8_STAGEA(PG8_SA(1, 0), a3, 0, k3, last);
            PG8_WAIT_V(12); PG8_WAIT_L(0); PG8_BAR; PG8_MMA(1, 0, At, B0); PG8_LDBT(B0, 1, 1); PG8_WAIT_L(0); PG8_SCHED; PG8_MMA(1, 1, At, B0); PG8_BAR; PG8_SCHED;
        }
        if constexpr (ALIGN_EPI) { if (wr == 0) PG8_BAR; }
        E(acc, cur, wr, wc, fr, fq); S.done(cur);
        if (!has_next) break;
#pragma unroll
        for (int a = 0; a < 2; ++a)
#pragma unroll
            for (int b = 0; b < 2; ++b)
#pragma unroll
                for (int m = 0; m < 4; ++m)
#pragma unroll
                    for (int n = 0; n < 2; ++n) acc[a][b][m][n] = (f32x4){0.f, 0.f, 0.f, 0.f};
        cur = nxt; cA = nA; cB0 = nB0; cB1 = nB1; ++ui;
        if constexpr (GATHER) { _Pragma("unroll") for (int _h = 0; _h < 2; ++_h) _Pragma("unroll") for (int _i = 0; _i < 2; ++_i) coff[_h][_i] = noff[_h][_i]; }
        if constexpr (ALIGN_EPI) { if (wr == 1) PG8_BAR; }
    }
    PG8_WAIT_V(0);
    asm volatile("" :: "v"(breg[0]), "v"(breg[1]), "v"(breg[2]), "v"(breg[3]), "v"(breg[4]), "v"(breg[5]), "v"(breg[6]), "v"(breg[7]));
    if constexpr (!ALIGN_EPI) { if (wr == 0) PG8_BAR; }
    PG8_BAR;
#undef PG8_SA
#undef PG8_SBI
#undef PG8_STAGE
#undef PG8_STAGEA
#undef PG8_GOFF
#undef PG8_LDA
#undef PG8_LDBT
#undef PG8_BLOAD
#undef PG8_BWRITE
#undef PG8_MMA
#undef PG8_WAIT_V
#undef PG8_WAIT_L
#undef PG8_BAR
#undef PG8_SCHED
}
}

constexpr int NWAVES = 8, NTHR = 512;
constexpr int T = 8192, D = 2048, HW = 7168, INW = 7184, MEMN = 256;
constexpr float LN_EPS = 1e-5f;
constexpr float ALPHA = 1.189207115002721f;
constexpr int NPH = 16;
#ifndef MK_NSG
#define MK_NSG 9
#endif
constexpr int NSG = MK_NSG;
constexpr int PMAX = 24576;

constexpr size_t MiB = 1u << 20;
constexpr size_t WS_CTL = 0, CTL_ZERO_BYTES = 64 * 1024;
constexpr size_t WS_WMIX = 2 * MiB, WS_WMQ = 10 * MiB, WS_WIN = 18 * MiB, WS_WKV = 46 * MiB, WS_WMO = 62 * MiB, WS_WGU = 70 * MiB, WS_WD = 198 * MiB;
constexpr size_t WS_XB = 262 * MiB, WS_MEMB = 294 * MiB;
constexpr size_t WS_H = 296 * MiB;
constexpr size_t WS_KVM = 408 * MiB;
constexpr size_t WS_ORAW = 410 * MiB;
constexpr size_t WS_MIXED = WS_XB;
constexpr size_t WS_Y1 = WS_ORAW;
constexpr size_t WS_H1B = WS_H;
constexpr size_t WS_QB = 328 * MiB, WS_ATT = 360 * MiB;
constexpr size_t WS_Y2 = 474 * MiB;
constexpr size_t WS_H2B = WS_H;
constexpr size_t WS_XS = 328 * MiB;
constexpr size_t WS_HID = 424 * MiB;
constexpr size_t WS_YS = WS_XS;
constexpr size_t WS_SMALL = 540 * MiB;
constexpr size_t WS_GLR = WS_SMALL;
constexpr size_t WS_RC = WS_SMALL + 1 * MiB, WS_RS = WS_SMALL + 5 * MiB;
constexpr size_t WS_ST1 = WS_SMALL + 9 * MiB, WS_ST2 = WS_ST1 + 65536;
constexpr size_t WS_EXP = WS_ST2 + 65536, WS_GATE = WS_EXP + 65536, WS_POS = WS_GATE + 65536, WS_SLOT = WS_POS + 65536, WS_TOK = WS_SLOT + 65536;
constexpr size_t WS_XCH1 = WS_SMALL + 10 * MiB, WS_XCH2 = WS_XCH1 + 512 * 1024;
constexpr size_t WS_END = 552 * MiB;
constexpr int CW_CNT = 64, CW_CUR = 128, CW_Q = 192;
constexpr int CW_BAR = 4096;
constexpr int CW_LN1 = 8192, CW_LN2 = 10240;

constexpr int RING_BYTES = 139264, LDSCTL_OFF = RING_BYTES, MISC_OFF = LDSCTL_OFF + 320, LDS_BYTES = 147456;

#define GAS __attribute__((address_space(1)))
#define LAS __attribute__((address_space(3)))
typedef unsigned short bf16;
typedef unsigned v4u __attribute__((ext_vector_type(4)));
typedef unsigned v2u __attribute__((ext_vector_type(2)));
typedef float f32x4 __attribute__((ext_vector_type(4)));
typedef GAS unsigned gu32;
#define RLX_AGENT __ATOMIC_RELAXED, __HIP_MEMORY_SCOPE_AGENT
#define LDS_WAIT() asm volatile("s_waitcnt lgkmcnt(0)" ::: "memory")
__device__ __forceinline__ unsigned f2bf(float f) { unsigned u = __builtin_bit_cast(unsigned, f); return (u + 0x7fffu + ((u >> 16) & 1u)) >> 16; }
__device__ __forceinline__ unsigned pk2(float lo, float hi) { return f2bf(lo) | (f2bf(hi) << 16); }
__device__ __forceinline__ float bf2f(unsigned h) { return __builtin_bit_cast(float, h << 16); }
__device__ __forceinline__ float bflo(unsigned w) { return __builtin_bit_cast(float, w << 16); }
__device__ __forceinline__ float bfhi(unsigned w) { return __builtin_bit_cast(float, w & 0xffff0000u); }
__device__ __forceinline__ float wave_sum(float v) {
#pragma unroll
    for (int o = 1; o < 64; o <<= 1) v += __shfl_xor(v, o);
    return v;
}
__device__ __forceinline__ float wave_max(float v) {
#pragma unroll
    for (int o = 1; o < 64; o <<= 1) v = fmaxf(v, __shfl_xor(v, o));
    return v;
}

struct Frame {
    LAS unsigned char* lds;
    volatile LAS unsigned* MISC;
    gu32* ctl;
    int tid, lane, wave, G, bid;
    unsigned char* ws;
    const float* in[25];
    float* out;
};
#define WSP(T_, off) ((T_*)(F.ws + (off)))

template <bool NTST>
__device__ __forceinline__ void transpose_item(const float* W, int ldw, bf16* WTr, int ldt, LAS float* scr, int lane) {
    float tv[32];
#pragma unroll
    for (int i = 0; i < 32; ++i) tv[i] = __builtin_nontemporal_load(W + (size_t)(2 * i + (lane >> 5)) * ldw + (lane & 31));
#pragma unroll
    for (int i = 0; i < 32; ++i) scr[(2 * i + (lane >> 5)) * 33 + (lane & 31)] = tv[i];
    LDS_WAIT(); asm volatile("" ::: "memory");
    const int c = lane & 7;
#pragma unroll
    for (int j = 0; j < 4; ++j) { const int n = (lane >> 3) + 8 * j; const LAS float* s = scr + (8 * c) * 33 + n;
        v4u o; o.x = pk2(s[0 * 33], s[1 * 33]); o.y = pk2(s[2 * 33], s[3 * 33]); o.z = pk2(s[4 * 33], s[5 * 33]); o.w = pk2(s[6 * 33], s[7 * 33]);
        if (NTST) __builtin_nontemporal_store(o, (GAS v4u*)(WTr + (size_t)n * ldt + 8 * c)); else *(GAS v4u*)(WTr + (size_t)n * ldt + 8 * c) = o; }
    LDS_WAIT(); asm volatile("" ::: "memory");
}
__device__ __forceinline__ void p0_prologue(Frame& F) {
    LAS float* scr = (LAS float*)(F.lds + F.wave * 16384);
    const int gw = F.bid * NWAVES + F.wave, NGW = F.G * NWAVES;
    const float* w_in = F.in[3];
    constexpr int I_IN = 32 * 224, I_SQ = 32 * 64;
    for (int it = gw; it < I_IN + 2 * I_SQ; it += NGW) {
        int r = it;
        if (r < I_IN) { const int kb = r / 224, nb = r % 224; transpose_item<false>(w_in + (size_t)(64 * kb) * INW + 32 * nb, INW, WSP(bf16, WS_WIN) + (size_t)(32 * nb) * 2048 + 64 * kb, 2048, scr, F.lane); continue; }
        r -= I_IN;
        { const int w = r / I_SQ, q = r % I_SQ, kb = q / 64, nb = q % 64;
          const float* src = F.in[11]; if (w) src = F.in[12];
          bf16* dst = WSP(bf16, WS_WKV) + (size_t)w * 2048 * 2048;
          transpose_item<false>(src + (size_t)(64 * kb) * 2048 + 32 * nb, 2048, dst + (size_t)(32 * nb) * 2048 + 64 * kb, 2048, scr, F.lane); }
    }
    const int gt = F.bid * NTHR + F.tid, NGT = F.G * NTHR;
    {
        const float* x = F.in[0]; bf16* xb = WSP(bf16, WS_XB);
        for (int item = F.bid; item < T / 32; item += F.G) {
            const size_t base = (size_t)item * 32 * D / 8;
#pragma unroll 1
            for (int c0 = 0; c0 < 16; c0 += 4) { f32x4 a[4], b[4];
#pragma unroll
                for (int u = 0; u < 4; ++u) { const size_t i = base + (size_t)(c0 + u) * NTHR + F.tid; a[u] = *(const GAS f32x4*)(x + i * 8); b[u] = *(const GAS f32x4*)(x + i * 8 + 4); }
#pragma unroll
                for (int u = 0; u < 4; ++u) { const size_t i = base + (size_t)(c0 + u) * NTHR + F.tid;
                    v4u o; o.x = pk2(a[u][0], a[u][1]); o.y = pk2(a[u][2], a[u][3]); o.z = pk2(b[u][0], b[u][1]); o.w = pk2(b[u][2], b[u][3]); *(GAS v4u*)(xb + i * 8) = o; } }
        }
        const float* mm = F.in[1]; bf16* mb = WSP(bf16, WS_MEMB);
        for (int i = gt; i < MEMN * D / 8; i += NGT) { const f32x4 a = *(const GAS f32x4*)(mm + (size_t)i * 8), b = *(const GAS f32x4*)(mm + (size_t)i * 8 + 4);
            v4u o; o.x = pk2(a[0], a[1]); o.y = pk2(a[2], a[3]); o.z = pk2(b[0], b[1]); o.w = pk2(b[2], b[3]); *(GAS v4u*)(mb + (size_t)i * 8) = o; }
    }
    {
        const int* pos = (const int*)F.in[2]; float* rc = WSP(float, WS_RC); float* rs = WSP(float, WS_RS);
        for (int i = gt; i < T * 128; i += NGT) { const int t = i >> 7, f = i & 127;
            const float inv = exp2f(-(float)f * (13.287712379549449f / 128.0f));
            const float ang = (float)pos[t] * inv;
            double rev = (double)ang * 0.15915494309189535; rev -= floor(rev);
            const float rf = (float)rev;
            rc[i] = __builtin_amdgcn_cosf(rf); rs[i] = __builtin_amdgcn_sinf(rf); }
    }
    {
        const float* x = F.in[0]; float* glr = WSP(float, WS_GLR);
        const int r16 = F.lane & 15, g4 = F.lane >> 4;
        LAS float* part = (LAS float*)F.lds;
        for (int item = F.bid; item < T / 32; item += F.G) {
            const int tile = 2 * item + (F.wave >> 2), kq = F.wave & 3;
            f32x4 acc = {0.f, 0.f, 0.f, 0.f};
            const float* xr = x + (size_t)(tile * 16 + r16) * D + 512 * kq + 4 * g4;
            const float* wr = w_in + (size_t)(512 * kq + 4 * g4) * INW + HW + r16;
#pragma unroll 8
            for (int k0 = 0; k0 < 512; k0 += 16) {
                const f32x4 a = *(const GAS f32x4*)(xr + k0);
                const float b0 = wr[(size_t)(k0 + 0) * INW], b1 = wr[(size_t)(k0 + 1) * INW], b2 = wr[(size_t)(k0 + 2) * INW], b3 = wr[(size_t)(k0 + 3) * INW];
                acc = __builtin_amdgcn_mfma_f32_16x16x4f32(a[0], b0, acc, 0, 0, 0);
                acc = __builtin_amdgcn_mfma_f32_16x16x4f32(a[1], b1, acc, 0, 0, 0);
                acc = __builtin_amdgcn_mfma_f32_16x16x4f32(a[2], b2, acc, 0, 0, 0);
                acc = __builtin_amdgcn_mfma_f32_16x16x4f32(a[3], b3, acc, 0, 0, 0);
            }
            __syncthreads();
            *(LAS f32x4*)(part + (F.wave * 64 + F.lane) * 4) = acc;
            __syncthreads();
            if (F.tid < 128) { const int tl = F.tid >> 6, ln = F.tid & 63;
                f32x4 s = *(const LAS f32x4*)(part + ((tl * 4 + 0) * 64 + ln) * 4);
#pragma unroll
                for (int q = 1; q < 4; ++q) s += *(const LAS f32x4*)(part + ((tl * 4 + q) * 64 + ln) * 4);
#pragma unroll
                for (int j = 0; j < 4; ++j) glr[(size_t)((2 * item + tl) * 16 + 4 * (ln >> 4) + j) * 16 + (ln & 15)] = s[j]; }
        }
        __syncthreads();
    }
}
__device__ __forceinline__ void transpose_queue(Frame& F, int qsel = 0) {
    LAS float* scr = (LAS float*)(F.lds + F.wave * 16384);
    const float* const i7 = F.in[7]; const float* const i10 = F.in[10]; const float* const i13 = F.in[13]; const float* const i20 = F.in[20]; const float* const i21 = F.in[21]; const float* const i22 = F.in[22];
    constexpr int I_SQ = 32 * 64, I_E = 512, NQ = 3 * I_SQ + (MK_MOE_F32 ? 0 : 3 * 32 * I_E);
    for (;;) {
        unsigned b0 = 0;
        if (F.lane == 0) b0 = __hip_atomic_fetch_add((unsigned*)(F.ctl + CW_Q + 64 * qsel), 16u, __ATOMIC_RELAXED, __HIP_MEMORY_SCOPE_AGENT);
        b0 = __builtin_amdgcn_readfirstlane(b0);
        if (b0 >= (unsigned)NQ) break;
        for (int it = (int)b0; it < (int)b0 + 16 && it < NQ; ++it) {
            int r = it;
            if (r < 3 * I_SQ) { const int w = r / I_SQ, q = r % I_SQ, kb = q / 64, nb = q % 64;
                const float* src = i7; size_t doff = WS_WMIX; if (w == 1) { src = i10; doff = WS_WMQ; } if (w == 2) { src = i13; doff = WS_WMO; }
                bf16* dst = (bf16*)(F.ws + doff);
                transpose_item<true>(src + (size_t)(64 * kb) * 2048 + 32 * nb, 2048, dst + (size_t)(32 * nb) * 2048 + 64 * kb, 2048, scr, F.lane); continue; }
            r -= 3 * I_SQ;
            if (r < 2 * 32 * I_E) {
                const int up = r / (32 * I_E), q = r % (32 * I_E), e = q / I_E, q2 = q % I_E, kb = q2 / 16, nb = q2 % 16, n0 = 32 * nb;
                const float* sb = i20; if (up) sb = i21;
                const float* src = sb + (size_t)e * 2048 * 512 + (size_t)(64 * kb) * 512 + n0;
                bf16* dst = WSP(bf16, WS_WGU) + (size_t)(e * 1024 + (n0 >> 7) * 256 + up * 128 + (n0 & 127)) * 2048 + 64 * kb;
                transpose_item<true>(src, 512, dst, 2048, scr, F.lane); continue; }
            r -= 2 * 32 * I_E;
            {
                const int e = r / I_E, q2 = r % I_E, kb = q2 / 64, nb = q2 % 64;
                const float* src = i22 + (size_t)e * 512 * 2048 + (size_t)(64 * kb) * 2048 + 32 * nb;
                bf16* dst = WSP(bf16, WS_WD) + (size_t)(e * 2048 + 32 * nb) * 512 + 64 * kb;
                transpose_item<true>(src, 2048, dst, 512, scr, F.lane); }
        }
    }
}

__device__ __forceinline__ float log_sigmoid_f(float z) { return fminf(z, 0.f) - log1pf(expf(-fabsf(z))); }
template <bool GLA>
__device__ __forceinline__ void mixer_naive_item(Frame& F, int hh, int eg) {
    constexpr int ND = GLA ? 4 : 8;
    const bf16* H = WSP(bf16, WS_H); float* oraw = WSP(float, WS_ORAW);
    const int ei = F.tid & 15, dp = F.tid >> 4, e = eg * 16 + ei;
    const int qcol = GLA ? 4096 + hh * 128 : hh * 256, kcol = GLA ? 4608 + hh * 128 : 1024 + hh * 256, vcol = (GLA ? 5120 : 2048) + hh * 256 + e;
    const int ocol = (GLA ? 1024 : 0) + hh * 256 + eg * 16;
    LAS float* red = (LAS float*)F.lds;
    float S[ND];
#pragma unroll
    for (int i = 0; i < ND; ++i) S[i] = 0.f;
    float wa[GLA ? 4 : 1][16]; float ba[GLA ? 4 : 1];
    if (GLA) {
#pragma unroll
        for (int i = 0; i < 4; ++i) { const int d = dp + 32 * i; ba[i] = F.in[5][hh * 128 + d];
#pragma unroll
            for (int r = 0; r < 16; ++r) wa[i][r] = F.in[4][r * 512 + hh * 128 + d]; }
    }
    const float gamma = 1.0f - exp2f(-5.0f - (float)hh);
    const float* glr = WSP(float, WS_GLR);
    for (int t0 = 0; t0 < T; t0 += 8) {
        float part[8];
#pragma unroll
        for (int tt = 0; tt < 8; ++tt) {
            const int t = t0 + tt; const bf16* hr = H + (size_t)t * HW;
            const float v = bf2f(hr[vcol]);
            float g16[16];
            if (GLA) {
#pragma unroll
                for (int r = 0; r < 16; ++r) g16[r] = glr[t * 16 + r];
            }
            float p = 0.f;
#pragma unroll
            for (int i = 0; i < ND; ++i) { const int d = dp + 32 * i;
                const float q = bf2f(hr[qcol + d]), k = bf2f(hr[kcol + d]);
                float a = gamma;
                if (GLA) { float z = ba[i];
#pragma unroll
                    for (int r = 0; r < 16; ++r) z += g16[r] * wa[i][r];
                    a = expf(log_sigmoid_f(z) * 0.0625f); }
                S[i] = a * S[i] + k * v; p += q * S[i]; }
            p += __shfl_xor(p, 16); p += __shfl_xor(p, 32);
            part[tt] = p;
        }
        if (F.lane < 16) {
#pragma unroll
            for (int tt = 0; tt < 8; ++tt) red[(F.wave * 8 + tt) * 16 + F.lane] = part[tt];
        }
        __syncthreads();
        if (F.tid < 128) { const int tt = F.tid >> 4, e2 = F.tid & 15; float s = 0.f;
#pragma unroll
            for (int w = 0; w < 8; ++w) s += red[(w * 8 + tt) * 16 + e2];
            oraw[(size_t)(t0 + tt) * D + ocol + e2] = s; }
        __syncthreads();
    }
}
__device__ __forceinline__ void p2_mixer_naive(Frame& F) {
    for (int item = F.bid; item < 128; item += F.G) {
        const int h8 = item >> 4, eg = item & 15;
        if (h8 < 4) mixer_naive_item<false>(F, h8, eg); else mixer_naive_item<true>(F, h8 - 4, eg);
    }
}
__device__ __forceinline__ void p3_normgate(Frame& F) {
    const bf16* H = WSP(bf16, WS_H); const float* oraw = WSP(float, WS_ORAW); bf16* mixed = WSP(bf16, WS_MIXED);
    const int gw = F.bid * NWAVES + F.wave, NGW = F.G * NWAVES;
    const f32x4 gn = *(const f32x4*)(F.in[6] + 4 * F.lane);
    for (int t = gw; t < T; t += NGW) {
#pragma unroll
        for (int h8 = 0; h8 < 8; ++h8) {
            const f32x4 o = *(const GAS f32x4*)(oraw + (size_t)t * D + h8 * 256 + 4 * F.lane);
            const int gcol = (h8 < 4 ? 3072 : 6144) + (h8 & 3) * 256 + 4 * F.lane;
            const v2u gw2 = *(const GAS v2u*)(H + (size_t)t * HW + gcol);
            const f32x4 gt = {bflo(gw2.x), bfhi(gw2.x), bflo(gw2.y), bfhi(gw2.y)};
            f32x4 y;
            if (h8 < 4) {
                const float mu = wave_sum((o[0] + o[1]) + (o[2] + o[3])) * (1.f / 256.f);
                const f32x4 dd = o - mu;
                const float var = wave_sum((dd[0] * dd[0] + dd[1] * dd[1]) + (dd[2] * dd[2] + dd[3] * dd[3])) * (1.f / 256.f);
                y = dd * (1.0f / sqrtf(var + LN_EPS));
            } else {
                const float ms = wave_sum((o[0] * o[0] + o[1] * o[1]) + (o[2] * o[2] + o[3] * o[3])) * (1.f / 256.f);
                y = o * (1.0f / sqrtf(ms + LN_EPS)) * gn;
            }
            float r[4];
#pragma unroll
            for (int i = 0; i < 4; ++i) { const float g = gt[i]; r[i] = g / (1.0f + expf(-g)) * y[i]; }
            v2u w; w.x = pk2(r[0], r[1]); w.y = pk2(r[2], r[3]);
            *(GAS v2u*)(mixed + (size_t)t * D + h8 * 256 + 4 * F.lane) = w;
        }
    }
}
__device__ __forceinline__ void ln_apply_plain(Frame& F, const float* Y, const float* g, const float* b, bf16* HB, float* st) {
    const int gw = F.bid * NWAVES + F.wave, NGW = F.G * NWAVES;
    f32x4 cur[8];
    if (gw < T) { const GAS f32x4* yr = (const GAS f32x4*)(Y + (size_t)gw * D) + F.lane;
#pragma unroll
        for (int j = 0; j < 8; ++j) cur[j] = yr[64 * j]; }
    for (int t = gw; t < T; t += NGW) {
        f32x4 nxt[8];
        { const int tn = t + NGW < T ? t + NGW : t; const GAS f32x4* yr = (const GAS f32x4*)(Y + (size_t)tn * D) + F.lane;
#pragma unroll
          for (int j = 0; j < 8; ++j) nxt[j] = yr[64 * j]; }
        f32x4 v[8]; float s = 0.f;
#pragma unroll
        for (int j = 0; j < 8; ++j) { v[j] = cur[j]; s += (v[j][0] + v[j][1]) + (v[j][2] + v[j][3]); }
        const float mean = wave_sum(s) * (1.f / D); float s2 = 0.f;
#pragma unroll
        for (int j = 0; j < 8; ++j) { v[j] = v[j] - mean; s2 += (v[j][0] * v[j][0] + v[j][1] * v[j][1]) + (v[j][2] * v[j][2] + v[j][3] * v[j][3]); }
        const float rstd = 1.f / sqrtf(wave_sum(s2) * (1.f / D) + LN_EPS);
        if (F.lane == 0) { st[2 * t] = mean; st[2 * t + 1] = rstd; }
        GAS v2u* o8 = (GAS v2u*)(HB + (size_t)t * D) + F.lane;
#pragma unroll
        for (int j = 0; j < 8; ++j) { const f32x4 gv = *(const f32x4*)(g + 4 * F.lane + 256 * j), bv = *(const f32x4*)(b + 4 * F.lane + 256 * j);
            v[j] = v[j] * rstd * gv + bv;
            v2u w; w.x = pk2(v[j][0], v[j][1]); w.y = pk2(v[j][2], v[j][3]); o8[64 * j] = w; }
#pragma unroll
        for (int j = 0; j < 8; ++j) cur[j] = nxt[j];
    }
}
template <bool ROUTER>
__device__ __forceinline__ void ln_apply(Frame& F, const float* Y, const float* g, const float* b, bf16* HB, float* st, bool count = true) {
    const int gw = F.bid * NWAVES + F.wave, NGW = F.G * NWAVES;
    for (int t = gw; t < T; t += NGW) {
        const GAS f32x4* yr = (const GAS f32x4*)(Y + (size_t)t * D) + F.lane;
        f32x4 v[8]; float s = 0.f;
#pragma unroll
        for (int j = 0; j < 8; ++j) { v[j] = yr[64 * j]; s += (v[j][0] + v[j][1]) + (v[j][2] + v[j][3]); }
        const float mean = wave_sum(s) * (1.f / D); float s2 = 0.f;
#pragma unroll
        for (int j = 0; j < 8; ++j) { v[j] = v[j] - mean; s2 += (v[j][0] * v[j][0] + v[j][1] * v[j][1]) + (v[j][2] * v[j][2] + v[j][3] * v[j][3]); }
        const float rstd = 1.f / sqrtf(wave_sum(s2) * (1.f / D) + LN_EPS);
        if (F.lane == 0) { st[2 * t] = mean; st[2 * t + 1] = rstd; }
        GAS v2u* o8 = (GAS v2u*)(HB + (size_t)t * D) + F.lane;
#pragma unroll
        for (int j = 0; j < 8; ++j) { const f32x4 gv = *(const f32x4*)(g + 4 * F.lane + 256 * j), bv = *(const f32x4*)(b + 4 * F.lane + 256 * j);
            v[j] = v[j] * rstd * gv + bv;
            v2u w; w.x = pk2(v[j][0], v[j][1]); w.y = pk2(v[j][2], v[j][3]); o8[64 * j] = w; }
        if (ROUTER) {
            const float* Wg = F.in[16]; const float* We = F.in[18];
            float lg[4], le[32];
#pragma unroll
            for (int i = 0; i < 4; ++i) lg[i] = 0.f;
#pragma unroll
            for (int i = 0; i < 32; ++i) le[i] = 0.f;
#pragma unroll
            for (int j = 0; j < 8; ++j) {
#pragma unroll
                for (int i = 0; i < 4; ++i) { const int c = 4 * F.lane + 256 * j + i; const float hv = v[j][i];
                    const f32x4 wg = *(const GAS f32x4*)(Wg + (size_t)c * 4);
#pragma unroll
                    for (int q = 0; q < 4; ++q) lg[q] += hv * wg[q];
#pragma unroll
                    for (int q8 = 0; q8 < 8; ++q8) { const f32x4 we = *(const GAS f32x4*)(We + (size_t)c * 32 + 4 * q8);
#pragma unroll
                        for (int q = 0; q < 4; ++q) le[4 * q8 + q] += hv * we[q]; } }
            }
#pragma unroll
            for (int i = 0; i < 4; ++i) lg[i] = wave_sum(lg[i]) + F.in[17][i];
#pragma unroll
            for (int i = 0; i < 32; ++i) le[i] = wave_sum(le[i]);
            int grp = 0; float gm = lg[0];
#pragma unroll
            for (int i = 1; i < 4; ++i) if (lg[i] > gm) { gm = lg[i]; grp = i; }
            float gs = 0.f;
#pragma unroll
            for (int i = 0; i < 4; ++i) gs += expf(lg[i] - gm);
            const float pg_sel = 1.0f / gs;
            float fe[8];
#pragma unroll
            for (int j = 0; j < 8; ++j) { const float a = grp == 0 ? le[j] : grp == 1 ? le[8 + j] : grp == 2 ? le[16 + j] : le[24 + j]; fe[j] = a + F.in[19][grp * 8 + j]; }
            int i1 = 0; float m1 = fe[0];
#pragma unroll
            for (int j = 1; j < 8; ++j) if (fe[j] > m1) { m1 = fe[j]; i1 = j; }
            int i2 = -1; float m2 = -3.0e38f;
#pragma unroll
            for (int j = 0; j < 8; ++j) if (j != i1 && fe[j] > m2) { m2 = fe[j]; i2 = j; }
            const float p2 = expf(m2 - m1), den = 1.0f / (1.0f + p2);
            if (F.lane == 0) {
                int* ex = WSP(int, WS_EXP); float* gt = WSP(float, WS_GATE);
                const int e1 = grp * 8 + i1, e2 = grp * 8 + i2;
                ex[2 * t] = e1; ex[2 * t + 1] = e2; gt[2 * t] = pg_sel * den; gt[2 * t + 1] = pg_sel * p2 * den;
                if (count) { atomicAdd((unsigned*)(F.ctl + CW_CNT) + e1, 1u); atomicAdd((unsigned*)(F.ctl + CW_CNT) + e2, 1u); }
            }
        }
    }
}
__device__ __forceinline__ void p7_attn_naive(Frame& F) {
    const bf16* Q = WSP(bf16, WS_QB); const bf16* KVM = WSP(bf16, WS_KVM); bf16* att = WSP(bf16, WS_ATT);
    LAS float* qs = (LAS float*)F.lds;
    LAS float* sc = (LAS float*)(F.lds + 16384);
    for (int item = F.bid; item < (T / 8) * 4; item += F.G) {
        const int h = item & 3, t0 = (item >> 2) * 8;
        for (int i = F.tid; i < 8 * 512; i += NTHR) { const int tt = i >> 9, d = i & 511; qs[i] = bf2f(Q[(size_t)(t0 + tt) * D + h * 512 + d]); }
        __syncthreads();
        {
            const int j = F.tid & 255, th = F.tid >> 8;
            const bf16* kr = KVM + (size_t)j * 4096 + h * 512;
            float a0 = 0.f, a1 = 0.f, a2 = 0.f, a3 = 0.f;
            for (int d = 0; d < 512; d += 8) {
                const v4u kw = *(const GAS v4u*)(kr + d);
                const float kf[8] = {bflo(kw.x), bfhi(kw.x), bflo(kw.y), bfhi(kw.y), bflo(kw.z), bfhi(kw.z), bflo(kw.w), bfhi(kw.w)};
#pragma unroll
                for (int i = 0; i < 8; ++i) { a0 += kf[i] * qs[(th * 4 + 0) * 512 + d + i]; a1 += kf[i] * qs[(th * 4 + 1) * 512 + d + i]; a2 += kf[i] * qs[(th * 4 + 2) * 512 + d + i]; a3 += kf[i] * qs[(th * 4 + 3) * 512 + d + i]; }
            }
            const float scl = 0.04419417382415922f;
            sc[(th * 4 + 0) * 256 + j] = a0 * scl; sc[(th * 4 + 1) * 256 + j] = a1 * scl; sc[(th * 4 + 2) * 256 + j] = a2 * scl; sc[(th * 4 + 3) * 256 + j] = a3 * scl;
        }
        __syncthreads();
        {
            float v[4]; float mx = -3.0e38f;
#pragma unroll
            for (int i = 0; i < 4; ++i) { v[i] = sc[F.wave * 256 + F.lane + 64 * i]; mx = fmaxf(mx, v[i]); }
            mx = wave_max(mx); float sm = 0.f;
#pragma unroll
            for (int i = 0; i < 4; ++i) { v[i] = expf(v[i] - mx); sm += v[i]; }
            sm = 1.0f / wave_sum(sm);
#pragma unroll
            for (int i = 0; i < 4; ++i) sc[F.wave * 256 + F.lane + 64 * i] = v[i] * sm;
        }
        __syncthreads();
        {
            const int d = F.tid; const bf16* vr = KVM + 2048 + h * 512 + d;
            float o[8];
#pragma unroll
            for (int i = 0; i < 8; ++i) o[i] = 0.f;
            for (int j = 0; j < 256; ++j) { const float vv = bf2f(vr[(size_t)j * 4096]);
#pragma unroll
                for (int i = 0; i < 8; ++i) o[i] += sc[i * 256 + j] * vv; }
#pragma unroll
            for (int i = 0; i < 8; ++i) att[(size_t)(t0 + i) * D + h * 512 + d] = (bf16)f2bf(o[i]);
        }
        __syncthreads();
    }
}
__device__ __forceinline__ void moe_tile_starts(Frame& F, LAS int* ts) {
    if (F.tid < 64) {
        const unsigned c = F.lane < 32 ? __hip_atomic_load(F.ctl + CW_CUR + (F.lane & 31), RLX_AGENT) : 0u;
        int v = (int)((c + 255u) >> 8);
#pragma unroll
        for (int o = 1; o < 32; o <<= 1) { const int n = __shfl_up(v, o); if (F.lane >= o) v += n; }
        if (F.lane < 32) ts[F.lane + 1] = v;
        if (F.lane == 0) ts[0] = 0;
    }
    __syncthreads();
}
__device__ __forceinline__ void p10_dispatch(Frame& F, LAS int* ts) {
    const int gt = F.bid * NTHR + F.tid, NGT = F.G * NTHR;
    const int* ex = WSP(int, WS_EXP); const int* sl = WSP(int, WS_SLOT); int* pos = WSP(int, WS_POS); int* tok = WSP(int, WS_TOK);
    for (int a = gt; a < 2 * T; a += NGT) { const int p = ts[ex[a]] * 256 + sl[a]; pos[a] = p; tok[p] = a >> 1; }
}
__device__ __forceinline__ void p13_combine(Frame& F) {
    const int gw = F.bid * NWAVES + F.wave, NGW = F.G * NWAVES;
    const float* Y2 = WSP(float, WS_Y2); const float* st2 = WSP(float, WS_ST2); const bf16* ys = WSP(bf16, WS_YS);
    const int* pos = WSP(int, WS_POS); const float* gt = WSP(float, WS_GATE);
    const float* g2 = F.in[14]; const float* b2 = F.in[15]; const float* g3 = F.in[23]; const float* b3 = F.in[24];
    constexpr int R = 2;
    for (int t0 = gw; t0 < T; t0 += R * NGW) {
        f32x4 yv[R][8]; v2u ya[R][8], yc[R][8]; float mu2[R], rs2[R], w0[R], w1[R];
#pragma unroll
        for (int r = 0; r < R; ++r) { const int t = (t0 + r * NGW < T) ? t0 + r * NGW : t0;
            mu2[r] = st2[2 * t]; rs2[r] = st2[2 * t + 1]; w0[r] = gt[2 * t]; w1[r] = gt[2 * t + 1];
            const int p0 = pos[2 * t], p1 = pos[2 * t + 1];
            const GAS f32x4* yr = (const GAS f32x4*)(Y2 + (size_t)t * D) + F.lane;
            const GAS v2u* y0 = (const GAS v2u*)(ys + (size_t)p0 * D) + F.lane; const GAS v2u* y1 = (const GAS v2u*)(ys + (size_t)p1 * D) + F.lane;
#pragma unroll
            for (int j = 0; j < 8; ++j) { yv[r][j] = yr[64 * j]; ya[r][j] = y0[64 * j]; yc[r][j] = y1[64 * j]; } }
#pragma unroll
        for (int r = 0; r < R; ++r) { const int t = t0 + r * NGW; if (t >= T) break;
            f32x4 v[8]; float s = 0.f;
#pragma unroll
            for (int j = 0; j < 8; ++j) { const f32x4 gv = *(const f32x4*)(g2 + 4 * F.lane + 256 * j), bv = *(const f32x4*)(b2 + 4 * F.lane + 256 * j);
                const f32x4 h = (yv[r][j] - mu2[r]) * rs2[r] * gv + bv;
                const v2u a = ya[r][j], c = yc[r][j];
                const f32x4 fa = {bflo(a.x), bfhi(a.x), bflo(a.y), bfhi(a.y)}, fc = {bflo(c.x), bfhi(c.x), bflo(c.y), bfhi(c.y)};
                v[j] = h * ALPHA + fa * w0[r] + fc * w1[r]; s += (v[j][0] + v[j][1]) + (v[j][2] + v[j][3]); }
            const float mean = wave_sum(s) * (1.f / D); float s2 = 0.f;
#pragma unroll
            for (int j = 0; j < 8; ++j) { v[j] = v[j] - mean; s2 += (v[j][0] * v[j][0] + v[j][1] * v[j][1]) + (v[j][2] * v[j][2] + v[j][3] * v[j][3]); }
            const float rstd = 1.f / sqrtf(wave_sum(s2) * (1.f / D) + LN_EPS);
            GAS f32x4* orow = (GAS f32x4*)(F.out + (size_t)t * D) + F.lane;
#pragma unroll
            for (int j = 0; j < 8; ++j) { const f32x4 gv = *(const f32x4*)(g3 + 4 * F.lane + 256 * j), bv = *(const f32x4*)(b3 + 4 * F.lane + 256 * j);
                orow[64 * j] = v[j] * rstd * gv + bv; }
        }
    }
}

constexpr int CS = 128, NB = CS / 64, NS = T / CS;
constexpr size_t WS_BCUM = WS_ORAW;
constexpr size_t WS_KVR = WS_ORAW + 16 * MiB;
constexpr size_t WS_KVG = WS_KVR + 32 * MiB;
typedef short bf16x8_t __attribute__((ext_vector_type(8)));
typedef short s16x4_t __attribute__((ext_vector_type(4)));
__device__ __forceinline__ s16x4_t lds_tr(const LAS unsigned char* p) { return __builtin_bit_cast(s16x4_t, __builtin_amdgcn_ds_read_tr16_b64_v4i16((LAS s16x4_t*)p)); }
__device__ __forceinline__ bf16x8_t frag_tr(const LAS unsigned char* X, int pitch, int k0, int n0, int lane) {
    const int fq = lane >> 4, q = (lane >> 2) & 3, p = lane & 3;
    const LAS unsigned char* a = X + ((k0 + 8 * fq + q) * pitch + n0 + 4 * p) * 2;
    const s16x4_t lo = lds_tr(a), hi = lds_tr(a + 4 * pitch * 2);
    return __builtin_shufflevector(lo, hi, 0, 1, 2, 3, 4, 5, 6, 7);
}
__device__ __forceinline__ bf16x8_t frag_row(const LAS unsigned char* X, int pitch, int r0, int k0, int lane) {
    return *(const LAS bf16x8_t*)(X + ((r0 + (lane & 15)) * pitch + k0 + 8 * (lane >> 4)) * 2);
}
#define MFMA16(a, b, c) __builtin_amdgcn_mfma_f32_16x16x32_bf16((a), (b), (c), 0, 0, 0)
__device__ __forceinline__ float fexp(float x) { return __builtin_amdgcn_exp2f(x * 1.4426950408889634f); }
__device__ __forceinline__ float silu_g(float g) { return g * __builtin_amdgcn_rcpf(1.0f + __builtin_amdgcn_exp2f(-1.4426950408889634f * g)); }

__device__ __forceinline__ void bcum_item(Frame& F, int s, int h) {
    const int c = F.tid & 127, tq = F.tid >> 7;
    LAS float* tot = (LAS float*)F.lds;
    LAS float* gl = (LAS float*)(F.lds + 2048);
    const float* glr = WSP(float, WS_GLR); float* bc = WSP(float, WS_BCUM);
    __syncthreads();
    *(LAS f32x4*)(gl + 4 * F.tid) = *(const GAS f32x4*)(glr + (size_t)s * CS * 16 + 4 * F.tid);
    float w[16];
#pragma unroll
    for (int r = 0; r < 16; ++r) w[r] = F.in[4][r * 512 + h * 128 + c];
    const float bias = F.in[5][h * 128 + c];
    __syncthreads();
    float vals[32]; float run = 0.f;
    const int tb = s * CS + tq * 32;
#pragma unroll
    for (int i = 0; i < 32; ++i) { const LAS float* gr = gl + (tq * 32 + i) * 16; float z = bias;
#pragma unroll
        for (int r = 0; r < 16; ++r) z += gr[r] * w[r];
        run += log_sigmoid_f(z) * 0.0625f; vals[i] = run; }
    tot[tq * 128 + c] = run;
    __syncthreads();
    float off = 0.f;
#pragma unroll
    for (int q = 0; q < 3; ++q) off += (q < tq) ? tot[q * 128 + c] : 0.f;
#pragma unroll
    for (int i = 0; i < 32; ++i) bc[(size_t)(tb + i) * 512 + h * 128 + c] = vals[i] + off;
}
__device__ __forceinline__ void p1_bcum(Frame& F, int first, int stride) { for (int it = first; it < NS * 4; it += stride) bcum_item(F, it >> 2, it & 3); __syncthreads(); }

__device__ __forceinline__ void unit_sh(int u, int& s, int& h8) { s = (u >> 3) & (NS - 1); h8 = ((u & 7) + 4 * (u >> 8)) & 7; }

template <bool GLA, int MODE>
__device__ __forceinline__ void stage_qk(Frame& F, LAS unsigned char* dst, int s, int jb, int hh, int col0, float lg2gamma) {
    constexpr int DK = GLA ? 128 : 256, PK = DK + 8, CPR = DK / 8, NIT = 64 * CPR / NTHR;
    const bf16* H = WSP(bf16, WS_H); const float* bc = WSP(float, WS_BCUM);
    v4u wv[NIT]; f32x4 b0[GLA ? NIT : 1], b1[GLA ? NIT : 1], l0[(GLA && MODE == 2) ? NIT : 1], l1[(GLA && MODE == 2) ? NIT : 1];
#pragma unroll
    for (int it = 0; it < NIT; ++it) {
        const int ch = F.tid + NTHR * it, r = ch / CPR, cc = ch % CPR, t = s * CS + jb * 64 + r;
        wv[it] = *(const GAS v4u*)(H + (size_t)t * HW + col0 + 8 * cc);
        if (GLA) { b0[it] = *(const GAS f32x4*)(bc + (size_t)t * 512 + hh * 128 + 8 * cc); b1[it] = *(const GAS f32x4*)(bc + (size_t)t * 512 + hh * 128 + 8 * cc + 4);
            if (MODE == 2) { const size_t tl_ = (size_t)(s * CS + CS - 1) * 512 + hh * 128 + 8 * cc; l0[it] = *(const GAS f32x4*)(bc + tl_); l1[it] = *(const GAS f32x4*)(bc + tl_ + 4); } }
    }
#pragma unroll
    for (int it = 0; it < NIT; ++it) {
        const int ch = F.tid + NTHR * it, r = ch / CPR, cc = ch % CPR, tl = jb * 64 + r;
        const v4u w = wv[it];
        float f[8] = {bflo(w.x), bfhi(w.x), bflo(w.y), bfhi(w.y), bflo(w.z), bfhi(w.z), bflo(w.w), bfhi(w.w)};
        if (GLA) {
            float e[8] = {b0[it][0], b0[it][1], b0[it][2], b0[it][3], b1[it][0], b1[it][1], b1[it][2], b1[it][3]};
            if (MODE == 2) { const float l[8] = {l0[it][0], l0[it][1], l0[it][2], l0[it][3], l1[it][0], l1[it][1], l1[it][2], l1[it][3]};
#pragma unroll
                for (int i = 0; i < 8; ++i) e[i] = l[i] - e[i]; }
            else if (MODE == 1) {
#pragma unroll
                for (int i = 0; i < 8; ++i) e[i] = -e[i]; }
#pragma unroll
            for (int i = 0; i < 8; ++i) f[i] *= fexp(e[i]);
        } else {
            const float ex = MODE == 0 ? (float)(tl + 1) : MODE == 1 ? -(float)(tl + 1) : (float)(CS - 1 - tl);
            const float fac = __builtin_amdgcn_exp2f(ex * lg2gamma);
#pragma unroll
            for (int i = 0; i < 8; ++i) f[i] *= fac;
        }
        v4u o; o.x = pk2(f[0], f[1]); o.y = pk2(f[2], f[3]); o.z = pk2(f[4], f[5]); o.w = pk2(f[6], f[7]);
        *(LAS v4u*)(dst + (r * PK + 8 * cc) * 2) = o;
    }
}
__device__ __forceinline__ void stage_v(Frame& F, LAS unsigned char* dst, int s, int jb, int col0) {
    const bf16* H = WSP(bf16, WS_H);
    v4u wv[4];
#pragma unroll
    for (int it = 0; it < 4; ++it) { const int ch = F.tid + NTHR * it, r = ch >> 5, cc = ch & 31, t = s * CS + jb * 64 + r; wv[it] = *(const GAS v4u*)(H + (size_t)t * HW + col0 + 8 * cc); }
#pragma unroll
    for (int it = 0; it < 4; ++it) { const int ch = F.tid + NTHR * it, r = ch >> 5, cc = ch & 31; *(LAS v4u*)(dst + (r * 264 + 8 * cc) * 2) = wv[it]; }
}

template <bool GLA>
__device__ __forceinline__ void kv_unit(Frame& F, int s, int hh) {
    constexpr int DK = GLA ? 128 : 256, PK = DK + 8, NDT = DK / 16;
    LAS unsigned char* Ks = F.lds; LAS unsigned char* Vs = F.lds + 34816;
    const int kcol = GLA ? 4608 + hh * 128 : 1024 + hh * 256, vcol = (GLA ? 5120 : 2048) + hh * 256;
    const float lg2g = log2f(1.0f - exp2f(-5.0f - (float)hh));
    f32x4 acc[2][NDT];
#pragma unroll
    for (int a = 0; a < 2; ++a)
#pragma unroll
        for (int d = 0; d < NDT; ++d) acc[a][d] = (f32x4){0.f, 0.f, 0.f, 0.f};
    for (int jb = 0; jb < NB; ++jb) {
        __syncthreads();
        stage_qk<GLA, 2>(F, Ks, s, jb, hh, kcol, lg2g);
        stage_v(F, Vs, s, jb, vcol);
        __syncthreads();
#pragma unroll
        for (int ks = 0; ks < 2; ++ks) {
            bf16x8_t vf[2];
#pragma unroll
            for (int et = 0; et < 2; ++et) vf[et] = frag_tr(Vs, 264, 32 * ks, 32 * F.wave + 16 * et, F.lane);
#pragma unroll
            for (int dt = 0; dt < NDT; ++dt) { const bf16x8_t kf = frag_tr(Ks, PK, 32 * ks, 16 * dt, F.lane);
#pragma unroll
                for (int et = 0; et < 2; ++et) acc[et][dt] = MFMA16(kf, vf[et], acc[et][dt]); }
        }
    }
    bf16* kv = GLA ? (WSP(bf16, WS_KVG) + (size_t)(s * 4 + hh) * 256 * 128) : (WSP(bf16, WS_KVR) + (size_t)(s * 4 + hh) * 256 * 256);
    const int fr = F.lane & 15, fq = F.lane >> 4;
#pragma unroll
    for (int et = 0; et < 2; ++et)
#pragma unroll
        for (int dt = 0; dt < NDT; ++dt) { v2u w; w.x = pk2(acc[et][dt][0], acc[et][dt][1]); w.y = pk2(acc[et][dt][2], acc[et][dt][3]);
            *(GAS v2u*)(kv + (size_t)(32 * F.wave + 16 * et + fr) * DK + 16 * dt + 4 * fq) = w; }
}
__device__ __forceinline__ void p2_kv(Frame& F) {
    for (int u = F.bid; u < 8 * NS; u += F.G) { int s, h8; unit_sh(u, s, h8);
        if (s == NS - 1) continue;
        if (h8 < 4) kv_unit<false>(F, s, h8); else kv_unit<true>(F, s, h8 - 4); }
    __syncthreads();
}
__device__ __forceinline__ void p3_scan(Frame& F) {
    constexpr int NR = 4 * 256 * 64, NG = 4 * 256 * 32, NITEM = NR + NG;
    const float* bc = WSP(float, WS_BCUM);
    const int per = (NITEM + F.G - 1) / F.G;
    for (int k0 = F.tid; k0 < per; k0 += NTHR) {
      const int it = F.bid * per + k0;
      if (it < NITEM) {
        const bool gla = it >= NR; const int r = gla ? it - NR : it;
        const int sh = gla ? 5 : 6, dk = gla ? 128 : 256;
        const int cc = r & ((1 << sh) - 1), e = (r >> sh) & 255, hh = r >> (sh + 8);
        bf16* base = (gla ? WSP(bf16, WS_KVG) : WSP(bf16, WS_KVR)) + ((size_t)hh * 256 + e) * dk + 4 * cc;
        const size_t sstride = (size_t)4 * 256 * dk;
        const float dret = __builtin_amdgcn_exp2f((float)CS * log2f(1.0f - exp2f(-5.0f - (float)hh)));
        float S[4] = {0.f, 0.f, 0.f, 0.f};
#pragma unroll 16
        for (int s = 0; s < NS - 1; ++s) {
            GAS v2u* p = (GAS v2u*)(base + (size_t)s * sstride);
            const v2u w = *p;
            v2u o; o.x = pk2(S[0], S[1]); o.y = pk2(S[2], S[3]);
            *p = o;
            const float f[4] = {bflo(w.x), bfhi(w.x), bflo(w.y), bfhi(w.y)};
            float dec[4] = {dret, dret, dret, dret};
            if (gla) { const f32x4 l0 = *(const GAS f32x4*)(bc + (size_t)(s * CS + CS - 1) * 512 + hh * 128 + 4 * cc);
                dec[0] = fexp(l0[0]); dec[1] = fexp(l0[1]); dec[2] = fexp(l0[2]); dec[3] = fexp(l0[3]); }
#pragma unroll
            for (int i = 0; i < 4; ++i) S[i] = dec[i] * S[i] + f[i];
        }
        { GAS v2u* p = (GAS v2u*)(base + (size_t)(NS - 1) * sstride); v2u o; o.x = pk2(S[0], S[1]); o.y = pk2(S[2], S[3]); *p = o; }
      }
    }
}
template <bool GLA>
__device__ __forceinline__ void out_unit(Frame& F, int s, int hh) {
    constexpr int DK = GLA ? 128 : 256, PK = DK + 8, NKS = DK / 32;
    LAS unsigned char* Qs = F.lds; LAS unsigned char* Ks = F.lds + 33792; LAS unsigned char* Vs = F.lds + 67584; LAS unsigned char* Ps = F.lds + 101376;
    LAS float* red = (LAS float*)(F.lds + 110592);
    const int qcol = GLA ? 4096 + hh * 128 : hh * 256, kcol = GLA ? 4608 + hh * 128 : 1024 + hh * 256, vcol = (GLA ? 5120 : 2048) + hh * 256;
    const int gcol = (GLA ? 6144 : 3072) + hh * 256, ocol = (GLA ? 1024 : 0) + hh * 256;
    const float lg2g = log2f(1.0f - exp2f(-5.0f - (float)hh));
    const bf16* H = WSP(bf16, WS_H); bf16* mixed = WSP(bf16, WS_MIXED);
    const bf16* st = GLA ? (WSP(bf16, WS_KVG) + (size_t)(s * 4 + hh) * 256 * 128) : (WSP(bf16, WS_KVR) + (size_t)(s * 4 + hh) * 256 * 256);
    const int fr = F.lane & 15, fq = F.lane >> 4, w = F.wave, mt = w >> 1, nt0 = 2 * (w & 1);
    static_assert(NB == 2, "the step program below is written for two 64-token sub-blocks");
    f32x4 accO[4][2]; bf16x8_t sfa[NKS][2]; v2u gpre[4][2];
#pragma unroll 1
    for (int step = 0; step < 3; ++step) {
        const int i = step > 0 ? 1 : 0, j = step > 1 ? 1 : 0;
        {
            __syncthreads();
            if (step < 2) stage_qk<GLA, 0>(F, Qs, s, i, hh, qcol, lg2g);
            if (step != 1) { stage_qk<GLA, 1>(F, Ks, s, j, hh, kcol, lg2g); stage_v(F, Vs, s, j, vcol); }
            if (step < 2) {
#pragma unroll
                for (int m = 0; m < 4; ++m)
#pragma unroll
                    for (int n = 0; n < 2; ++n) accO[m][n] = (f32x4){0.f, 0.f, 0.f, 0.f};
            }
            if (step != 1) {
                if (s > 0) {
#pragma unroll
                    for (int ks = 0; ks < NKS; ++ks)
#pragma unroll
                        for (int n = 0; n < 2; ++n) sfa[ks][n] = *(const GAS bf16x8_t*)(st + (size_t)(32 * w + 16 * n + fr) * DK + 32 * ks + 8 * fq);
                }
#pragma unroll
                for (int m2 = 0; m2 < 4; ++m2)
#pragma unroll
                    for (int n = 0; n < 2; ++n) gpre[m2][n] = *(const GAS v2u*)(H + (size_t)(s * CS + i * 64 + 16 * m2 + fr) * HW + gcol + 32 * w + 16 * n + 4 * fq);
            }
            __syncthreads();
            f32x4 accS[2] = {(f32x4){0.f, 0.f, 0.f, 0.f}, (f32x4){0.f, 0.f, 0.f, 0.f}};
#pragma unroll
            for (int ks = 0; ks < NKS; ++ks) { const bf16x8_t qf = frag_row(Qs, PK, 16 * mt, 32 * ks, F.lane);
#pragma unroll
                for (int n2 = 0; n2 < 2; ++n2) { const bf16x8_t kf = frag_row(Ks, PK, 16 * (nt0 + n2), 32 * ks, F.lane); accS[n2] = MFMA16(kf, qf, accS[n2]); } }
#pragma unroll
            for (int n2 = 0; n2 < 2; ++n2) { const int row = 16 * mt + fr, c0 = 16 * (nt0 + n2) + 4 * fq; float pv[4];
#pragma unroll
                for (int jj = 0; jj < 4; ++jj) pv[jj] = (i == j && c0 + jj > row) ? 0.f : accS[n2][jj];
                v2u pw; pw.x = pk2(pv[0], pv[1]); pw.y = pk2(pv[2], pv[3]);
                *(LAS v2u*)(Ps + (row * 72 + c0) * 2) = pw; }
            __syncthreads();
#pragma unroll
            for (int ks = 0; ks < 2; ++ks) {
                bf16x8_t vf[2];
#pragma unroll
                for (int n = 0; n < 2; ++n) vf[n] = frag_tr(Vs, 264, 32 * ks, 32 * w + 16 * n, F.lane);
#pragma unroll
                for (int m = 0; m < 4; ++m) { const bf16x8_t pf = frag_row(Ps, 72, 16 * m, 32 * ks, F.lane);
#pragma unroll
                    for (int n = 0; n < 2; ++n) accO[m][n] = MFMA16(vf[n], pf, accO[m][n]); }
            }
        }
        if (step == 1) continue;
        if (s > 0) {
#pragma unroll
            for (int ks = 0; ks < NKS; ++ks) {
#pragma unroll
                for (int m = 0; m < 4; ++m) { const bf16x8_t qf = frag_row(Qs, PK, 16 * m, 32 * ks, F.lane);
#pragma unroll
                    for (int n = 0; n < 2; ++n) accO[m][n] = MFMA16(sfa[ks][n], qf, accO[m][n]); }
            }
        }
#pragma unroll
        for (int m = 0; m < 4; ++m) { float s1 = 0.f, s2 = 0.f;
#pragma unroll
            for (int n = 0; n < 2; ++n)
#pragma unroll
                for (int jj = 0; jj < 4; ++jj) { const float v = accO[m][n][jj]; s1 += v; s2 += v * v; }
            s1 += __shfl_xor(s1, 16); s1 += __shfl_xor(s1, 32); s2 += __shfl_xor(s2, 16); s2 += __shfl_xor(s2, 32);
            if (fq == 0) { red[(w * 64 + 16 * m + fr) * 2] = s1; red[(w * 64 + 16 * m + fr) * 2 + 1] = s2; } }
        __syncthreads();
#pragma unroll
        for (int m = 0; m < 4; ++m) { const int row = 16 * m + fr; float s1 = 0.f, s2 = 0.f;
#pragma unroll
            for (int ww = 0; ww < 8; ++ww) { s1 += red[(ww * 64 + row) * 2]; s2 += red[(ww * 64 + row) * 2 + 1]; }
            const float mean = s1 * (1.f / 256.f), ex2 = s2 * (1.f / 256.f);
            const float mu = GLA ? 0.f : mean, var = GLA ? ex2 : fmaxf(ex2 - mean * mean, 0.f);
            const float rstd = 1.0f / sqrtf(var + LN_EPS);
            const int t = s * CS + i * 64 + row;
#pragma unroll
            for (int n = 0; n < 2; ++n) { const int e = 32 * w + 16 * n + 4 * fq;
                const v2u gw2 = gpre[m][n];
                const float gt[4] = {bflo(gw2.x), bfhi(gw2.x), bflo(gw2.y), bfhi(gw2.y)};
                f32x4 gn = {1.f, 1.f, 1.f, 1.f}; if (GLA) gn = *(const f32x4*)(F.in[6] + e);
                float r4[4];
#pragma unroll
                for (int jj = 0; jj < 4; ++jj) { const float y = (accO[m][n][jj] - mu) * rstd * gn[jj]; r4[jj] = silu_g(gt[jj]) * y; }
                v2u ow; ow.x = pk2(r4[0], r4[1]); ow.y = pk2(r4[2], r4[3]);
                *(GAS v2u*)(mixed + (size_t)t * D + ocol + e) = ow; } }
    }
}
__device__ __forceinline__ void p4_out(Frame& F) {
    for (int u = F.bid; u < 8 * NS; u += F.G) { int s, h8; unit_sh(u, s, h8);
        if (h8 < 4) out_unit<false>(F, s, h8); else out_unit<true>(F, s, h8 - 4); }
    __syncthreads();
}

__device__ __forceinline__ void kv_chunk_load(Frame& F, v4u (&R)[8], const bf16* src  ) {
#pragma unroll
    for (int it = 0; it < 8; ++it) { const int ch = F.tid + NTHR * it, r = ch >> 4, cc = ch & 15; R[it] = *(const GAS v4u*)(src + (size_t)r * 4096 + 8 * cc); }
}
__device__ __forceinline__ void kv_chunk_store(Frame& F, const v4u (&R)[8], LAS unsigned char* dst) {
#pragma unroll
    for (int it = 0; it < 8; ++it) { const int ch = F.tid + NTHR * it, r = ch >> 4, cc = ch & 15; *(LAS v4u*)(dst + (r * 136 + 8 * cc) * 2) = R[it]; }
}
__device__ __forceinline__ void p8_attn(Frame& F) {
    const bf16* Q = WSP(bf16, WS_QB); const bf16* KVM = WSP(bf16, WS_KVM); bf16* att = WSP(bf16, WS_ATT);
    constexpr int CB = 256 * 136 * 2;
    const int fr = F.lane & 15, fq = F.lane >> 4, q4 = (F.lane >> 2) & 3, p4 = F.lane & 3;
    for (int u = F.bid; u < (T / 128) * 4; u += F.G) {
        const int h = u & 3, r0 = (u >> 2) * 128 + 16 * F.wave;
        v4u R[8];
        __syncthreads();
        kv_chunk_load(F, R, KVM + h * 512); kv_chunk_store(F, R, F.lds);
        __syncthreads();
        f32x4 accS[16];
#pragma unroll
        for (int i = 0; i < 16; ++i) accS[i] = (f32x4){0.f, 0.f, 0.f, 0.f};
#pragma unroll 1
        for (int dc = 0; dc < 4; ++dc) {
            kv_chunk_load(F, R, dc < 3 ? KVM + h * 512 + (dc + 1) * 128 : KVM + 2048 + h * 512);
            const LAS unsigned char* Cs = F.lds + (dc & 1) * CB;
            bf16x8_t qf[4];
#pragma unroll
            for (int ks = 0; ks < 4; ++ks) qf[ks] = *(const GAS bf16x8_t*)(Q + (size_t)(r0 + fr) * D + h * 512 + dc * 128 + 32 * ks + 8 * fq);
#pragma unroll
            for (int ks = 0; ks < 4; ++ks)
#pragma unroll
                for (int nt = 0; nt < 16; ++nt) accS[nt] = MFMA16(frag_row(Cs, 136, 16 * nt, 32 * ks, F.lane), qf[ks], accS[nt]);
            kv_chunk_store(F, R, F.lds + ((dc + 1) & 1) * CB);
            __syncthreads();
        }
        float mx = -3.0e38f;
#pragma unroll
        for (int nt = 0; nt < 16; ++nt)
#pragma unroll
            for (int jj = 0; jj < 4; ++jj) mx = fmaxf(mx, accS[nt][jj]);
        mx = fmaxf(mx, __shfl_xor(mx, 16)); mx = fmaxf(mx, __shfl_xor(mx, 32));
        const float sl2 = 0.04419417382415922f * 1.4426950408889634f;
        float sm = 0.f;
#pragma unroll
        for (int nt = 0; nt < 16; ++nt)
#pragma unroll
            for (int jj = 0; jj < 4; ++jj) { const float p = __builtin_amdgcn_exp2f((accS[nt][jj] - mx) * sl2); accS[nt][jj] = p; sm += p; }
        sm += __shfl_xor(sm, 16); sm += __shfl_xor(sm, 32);
        const float inv = 1.0f / sm;
        bf16x8_t pf[8];
#pragma unroll
        for (int ks2 = 0; ks2 < 8; ++ks2) { v4u w; w.x = pk2(accS[2 * ks2][0] * inv, accS[2 * ks2][1] * inv); w.y = pk2(accS[2 * ks2][2] * inv, accS[2 * ks2][3] * inv);
            w.z = pk2(accS[2 * ks2 + 1][0] * inv, accS[2 * ks2 + 1][1] * inv); w.w = pk2(accS[2 * ks2 + 1][2] * inv, accS[2 * ks2 + 1][3] * inv); pf[ks2] = __builtin_bit_cast(bf16x8_t, w); }
#pragma unroll 1
        for (int ec = 0; ec < 4; ++ec) {
            if (ec < 3) kv_chunk_load(F, R, KVM + 2048 + h * 512 + (ec + 1) * 128);
            const LAS unsigned char* Cs = F.lds + (ec & 1) * CB;
            f32x4 accO[8];
#pragma unroll
            for (int i = 0; i < 8; ++i) accO[i] = (f32x4){0.f, 0.f, 0.f, 0.f};
#pragma unroll
            for (int ks2 = 0; ks2 < 8; ++ks2)
#pragma unroll
                for (int et = 0; et < 8; ++et) { const LAS unsigned char* a = Cs + ((32 * ks2 + 4 * fq + q4) * 136 + 16 * et + 4 * p4) * 2;
                    const s16x4_t lo = lds_tr(a), hi = lds_tr(a + 16 * 136 * 2);
                    accO[et] = MFMA16(__builtin_shufflevector(lo, hi, 0, 1, 2, 3, 4, 5, 6, 7), pf[ks2], accO[et]); }
#pragma unroll
            for (int et = 0; et < 8; ++et) { v2u w; w.x = pk2(accO[et][0], accO[et][1]); w.y = pk2(accO[et][2], accO[et][3]);
                *(GAS v2u*)(att + (size_t)(r0 + fr) * D + h * 512 + ec * 128 + 16 * et + 4 * fq) = w; }
            if (ec < 3) kv_chunk_store(F, R, F.lds + ((ec + 1) & 1) * CB);
            __syncthreads();
        }
    }
}

__device__ __forceinline__ void p10_ln_router(Frame& F) {
    const float* Y = WSP(float, WS_Y2); const float* g = F.in[14]; const float* b = F.in[15]; bf16* HB = WSP(bf16, WS_H2B); float* st = WSP(float, WS_ST2);
    const float* Wg = F.in[16]; const float* We = F.in[18];
    LAS float* stl = (LAS float*)F.lds;
    LAS float* part = (LAS float*)(F.lds + 1024);
    LAS int* lcnt = (LAS int*)(F.lds + 1024 + 24576);
    LAS int* lbase = lcnt + 32;
    if (F.tid < 32) lcnt[F.tid] = 0;
    { int* tok = WSP(int, WS_TOK); for (int i = F.bid * NTHR + F.tid; i < PMAX; i += F.G * NTHR) tok[i] = 0; }
    __syncthreads();
    const int fr = F.lane & 15, fq = F.lane >> 4;
    for (int item = F.bid; item < T / 32; item += F.G) {
        const int row0 = item * 32;
#pragma unroll
        for (int i = 0; i < 4; ++i) {
            const int t = row0 + 4 * F.wave + i;
            const GAS f32x4* yr = (const GAS f32x4*)(Y + (size_t)t * D) + F.lane;
            f32x4 v[8]; float s = 0.f;
#pragma unroll
            for (int j = 0; j < 8; ++j) { v[j] = yr[64 * j]; s += (v[j][0] + v[j][1]) + (v[j][2] + v[j][3]); }
            const float mean = wave_sum(s) * (1.f / D); float s2 = 0.f;
#pragma unroll
            for (int j = 0; j < 8; ++j) { v[j] = v[j] - mean; s2 += (v[j][0] * v[j][0] + v[j][1] * v[j][1]) + (v[j][2] * v[j][2] + v[j][3] * v[j][3]); }
            const float rstd = 1.f / sqrtf(wave_sum(s2) * (1.f / D) + LN_EPS);
            if (F.lane == 0) { st[2 * t] = mean; st[2 * t + 1] = rstd; stl[2 * (4 * F.wave + i)] = mean; stl[2 * (4 * F.wave + i) + 1] = rstd; }
            GAS v2u* o8 = (GAS v2u*)(HB + (size_t)t * D) + F.lane;
#pragma unroll
            for (int j = 0; j < 8; ++j) { const f32x4 gv = *(const f32x4*)(g + 4 * F.lane + 256 * j), bv = *(const f32x4*)(b + 4 * F.lane + 256 * j);
                const f32x4 hv = v[j] * rstd * gv + bv;
                v2u w; w.x = pk2(hv[0], hv[1]); w.y = pk2(hv[2], hv[3]); o8[64 * j] = w; }
        }
        __syncthreads();
        {
            const int rt = F.wave >> 2, kq = F.wave & 3;
            const int r = row0 + 16 * rt + fr;
            const float mu = stl[2 * (16 * rt + fr)], rstd = stl[2 * (16 * rt + fr) + 1];
            f32x4 acc0 = {0.f, 0.f, 0.f, 0.f}, acc1 = acc0, acc2 = acc0;
            const float* yp = Y + (size_t)r * D + 512 * kq + 4 * fq;
            const float* wep = We + (size_t)(512 * kq + 4 * fq) * 32 + fr;
            const float* wgp = Wg + (size_t)(512 * kq + 4 * fq) * 4 + (fr & 3);
            const float gm = fr < 4 ? 1.f : 0.f;
#pragma unroll 8
            for (int it = 0; it < 32; ++it) {
                const int k0 = 16 * it;
                const f32x4 y4 = *(const GAS f32x4*)(yp + k0), g4 = *(const f32x4*)(g + 512 * kq + 4 * fq + k0), b4 = *(const f32x4*)(b + 512 * kq + 4 * fq + k0);
                const f32x4 a = (y4 - mu) * rstd * g4 + b4;
#pragma unroll
                for (int s = 0; s < 4; ++s) {
                    const float b0 = wep[(size_t)(k0 + s) * 32], b1 = wep[(size_t)(k0 + s) * 32 + 16], b2 = wgp[(size_t)(k0 + s) * 4] * gm;
                    acc0 = __builtin_amdgcn_mfma_f32_16x16x4f32(a[s], b0, acc0, 0, 0, 0);
                    acc1 = __builtin_amdgcn_mfma_f32_16x16x4f32(a[s], b1, acc1, 0, 0, 0);
                    acc2 = __builtin_amdgcn_mfma_f32_16x16x4f32(a[s], b2, acc2, 0, 0, 0);
                }
            }
            LAS float* pw = part + F.wave * 768;
#pragma unroll
            for (int jj = 0; jj < 4; ++jj) { pw[(4 * fq + jj) * 48 + fr] = acc0[jj]; pw[(4 * fq + jj) * 48 + 16 + fr] = acc1[jj]; pw[(4 * fq + jj) * 48 + 32 + fr] = acc2[jj]; }
        }
        __syncthreads();
        int e1 = 0, e2 = 0, r1 = 0, r2 = 0; float g1 = 0.f, g2 = 0.f;
        if (F.tid < 32) {
            const int rt = F.tid >> 4, rr = F.tid & 15;
            float le[32], lg[4];
#pragma unroll
            for (int c = 0; c < 32; ++c) { float s = 0.f;
#pragma unroll
                for (int kq = 0; kq < 4; ++kq) s += part[(rt * 4 + kq) * 768 + rr * 48 + c]; le[c] = s; }
#pragma unroll
            for (int c = 0; c < 4; ++c) { float s = 0.f;
#pragma unroll
                for (int kq = 0; kq < 4; ++kq) s += part[(rt * 4 + kq) * 768 + rr * 48 + 32 + c]; lg[c] = s + F.in[17][c]; }
            int grp = 0; float gmx = lg[0];
#pragma unroll
            for (int i = 1; i < 4; ++i) if (lg[i] > gmx) { gmx = lg[i]; grp = i; }
            float gs = 0.f;
#pragma unroll
            for (int i = 0; i < 4; ++i) gs += expf(lg[i] - gmx);
            const float pg_sel = 1.0f / gs;
            float fe[8];
#pragma unroll
            for (int j = 0; j < 8; ++j) { const float a = grp == 0 ? le[j] : grp == 1 ? le[8 + j] : grp == 2 ? le[16 + j] : le[24 + j]; fe[j] = a + F.in[19][grp * 8 + j]; }
            int i1 = 0; float m1 = fe[0];
#pragma unroll
            for (int j = 1; j < 8; ++j) if (fe[j] > m1) { m1 = fe[j]; i1 = j; }
            int i2 = -1; float m2 = -3.0e38f;
#pragma unroll
            for (int j = 0; j < 8; ++j) if (j != i1 && fe[j] > m2) { m2 = fe[j]; i2 = j; }
            const float p2 = expf(m2 - m1), den = 1.0f / (1.0f + p2);
            e1 = grp * 8 + i1; e2 = grp * 8 + i2; g1 = pg_sel * den; g2 = pg_sel * p2 * den;
            r1 = __hip_atomic_fetch_add((int*)(lcnt + e1), 1, __ATOMIC_RELAXED, __HIP_MEMORY_SCOPE_WORKGROUP); r2 = __hip_atomic_fetch_add((int*)(lcnt + e2), 1, __ATOMIC_RELAXED, __HIP_MEMORY_SCOPE_WORKGROUP);
        }
        __syncthreads();
        if (F.tid < 32) { const int c = lcnt[F.tid];
            lbase[F.tid] = c ? (int)__hip_atomic_fetch_add((unsigned*)(F.ctl + CW_CUR) + F.tid, (unsigned)c, __ATOMIC_RELAXED, __HIP_MEMORY_SCOPE_AGENT) : 0; }
        __syncthreads();
        if (F.tid < 32) {
            const int t = row0 + F.tid;
            int* ex = WSP(int, WS_EXP); float* gt = WSP(float, WS_GATE); int* sl = WSP(int, WS_SLOT);
            ex[2 * t] = e1; ex[2 * t + 1] = e2; gt[2 * t] = g1; gt[2 * t + 1] = g2;
            sl[2 * t] = lbase[e1] + r1; sl[2 * t + 1] = lbase[e2] + r2;
            lcnt[F.tid] = 0;
        }
        __syncthreads();
    }
}


#define XB_TMO      128
#define XB_XCNT(j)  (256  + 64 * (j))
#define XB_XSUB(j)  (1280 + 64 * (j))
#define XB_XGEN(j)  (2304 + 64 * (j))
#define XB_TOP      3328
#define XB_TOPGEN   3392
#define XCD_BAR_WORDS 3456
#define XB_SPIN_CAP (1u << 22)
__device__ __forceinline__ unsigned xb_ld(unsigned* p)              { return __hip_atomic_load(p, __ATOMIC_RELAXED, __HIP_MEMORY_SCOPE_AGENT); }
__device__ __forceinline__ unsigned xb_add(unsigned* p, unsigned v) { return __hip_atomic_fetch_add(p, v, __ATOMIC_RELAXED, __HIP_MEMORY_SCOPE_AGENT); }
__device__ __forceinline__ unsigned xb_xcc_id() { return (unsigned)__builtin_amdgcn_s_getreg((3 << 11) | 20) & 0xFu; }
#define XB_SPIN(cond, bar) do { unsigned _sp = 0; while (cond) { __builtin_amdgcn_s_sleep(1); \
    if ((++_sp & 255u) == 0u) { if (xb_ld(&(bar)[XB_TMO])) break; if (_sp > XB_SPIN_CAP) { atomicAdd(&(bar)[XB_TMO], 1u); break; } } } } while (0)
struct XcdBarrier { unsigned* bar; unsigned x; volatile LAS unsigned* st; };
__device__ __forceinline__ XcdBarrier xcd_barrier_post(unsigned* bar, volatile LAS unsigned* st) {
    XcdBarrier b; b.bar = bar; b.x = xb_xcc_id(); b.st = st;
    if (threadIdx.x == 0) (void)xb_add(&bar[XB_XCNT(b.x)], 1u);
    return b;
}
__device__ __forceinline__ void xcd_barrier_complete(unsigned* bar, unsigned x, unsigned& nloc, unsigned& nx) {
    const unsigned G = gridDim.x * gridDim.y * gridDim.z;
    unsigned sum, cnt, mine, sp = 0u;
    for (;;) {
        sum = 0u; cnt = 0u; mine = 0u;
#pragma unroll
        for (unsigned j = 0; j < 16; ++j) { const unsigned c = xb_ld(&bar[XB_XCNT(j)]); sum += c; cnt += (c > 0u) ? 1u : 0u; mine = (j == x) ? c : mine; }
        if (sum == G) break;
        __builtin_amdgcn_s_sleep(1);
        if ((++sp & 255u) == 0u) { if (xb_ld(&bar[XB_TMO])) break; if (sp > XB_SPIN_CAP) { atomicAdd(&bar[XB_TMO], 1u); break; } }
    }
    nloc = mine > 0u ? mine : 1u; nx = cnt > 0u ? cnt : 1u;
}
__device__ __forceinline__ void xcd_barrier(const XcdBarrier& b) {
    asm volatile("s_waitcnt vmcnt(0)" ::: "memory");
    __syncthreads();
    if (threadIdx.x == 0) {
        unsigned* bar = b.bar;
        __builtin_amdgcn_s_waitcnt(0);
        unsigned nloc = b.st[0], nx = b.st[1];
        if (nloc == 0u) { xcd_barrier_complete(bar, b.x, nloc, nx); b.st[0] = nloc; b.st[1] = nx; }
        const unsigned old = xb_add(&bar[XB_XSUB(b.x)], 1u);
        const unsigned gen = old / nloc;
        if (old + 1u == (gen + 1u) * nloc) {
            __builtin_amdgcn_fence(__ATOMIC_RELEASE, "agent");
            asm volatile("s_waitcnt vmcnt(0)" ::: "memory");
            const unsigned og = xb_add(&bar[XB_TOP], 1u);
            const unsigned tg = og / nx;
            if (og + 1u == (tg + 1u) * nx) xb_add(&bar[XB_TOPGEN], 1u);
            else XB_SPIN(xb_ld(&bar[XB_TOPGEN]) == tg, bar);
            __builtin_amdgcn_fence(__ATOMIC_ACQUIRE, "agent");
            xb_add(&bar[XB_XGEN(b.x)], 1u);
            asm volatile("s_waitcnt vmcnt(0)" ::: "memory");
        } else {
            XB_SPIN(xb_ld(&bar[XB_XGEN(b.x)]) == gen, bar);
            __builtin_amdgcn_fence(__ATOMIC_ACQUIRE, "agent");
            asm volatile("s_waitcnt vmcnt(0)" ::: "memory");
        }
    }
    __syncthreads();
}

struct Args { const float* in[25]; float* out; unsigned char* ws; int ph_lo, ph_hi, use_bar, pad; };
__global__ void __launch_bounds__(NTHR, 2) mega(Args args) {
    extern __shared__ __attribute__((aligned(16))) unsigned char lds[];
    Frame F;
    F.lds = (LAS unsigned char*)lds;
    F.MISC = (volatile LAS unsigned*)(F.lds + MISC_OFF);
    F.tid = threadIdx.x; F.lane = F.tid & 63; F.wave = __builtin_amdgcn_readfirstlane(F.tid >> 6);
    F.G = gridDim.x; F.bid = blockIdx.x;
    F.ws = args.ws; F.ctl = (gu32*)(args.ws + WS_CTL);
#pragma unroll
    for (int i = 0; i < 25; ++i) F.in[i] = args.in[i];
    F.out = args.out;
    for (int u = F.tid; u < (LDS_BYTES - LDSCTL_OFF) / 4; u += NTHR) ((LAS unsigned*)(F.lds + LDSCTL_OFF))[u] = 0u;
    __syncthreads();
    LAS int* ts = (LAS int*)(F.lds + MISC_OFF + 64);
    XcdBarrier bar; bar.bar = (unsigned*)(F.ctl + CW_BAR); bar.x = 0; bar.st = nullptr;
    if (args.use_bar) bar = xcd_barrier_post((unsigned*)(F.ctl + CW_BAR), F.MISC + 8);
    const int lo = args.ph_lo, hi = args.ph_hi;
#if MK_CG_SYNC == 2
    if (args.use_bar == 2) cooperative_groups::this_grid().sync();
#endif
#define IN(k) (lo <= (k) && (k) < hi)
#define REPS(k) for (int _r = 0; _r < ((k) == PROBE_PH ? PROBE_N : 1); ++_r)
#define SEAM(k) do { if (IN(k) && IN((k) + 1)) { if (MK_CG_SYNC == 1 && (k) == 0) cooperative_groups::this_grid().sync(); else { xcd_barrier(bar); if (PROBE_PH == 100) for (int _b = 1; _b < PROBE_N; ++_b) xcd_barrier(bar); } } } while (0)

    if (IN(0)) { REPS(0) p0_prologue(F); SEAM(0); }
    if (IN(1)) {
        p1_bcum(F, F.bid, F.G);
        const int g8 = F.bid >> 3, nsb = (g8 * NSG) >> 5; const bool streamer = (F.G == 256) && ((((g8 + 1) * NSG) >> 5) != nsb);
        if (!streamer) {
            pg8::Gemm g{WSP(pg8::bf16_t, WS_XB), WSP(pg8::bf16_t, WS_WIN), T + MEMN, HW + 4096, D}; pg8::OrderG1 S;
            if (F.G == 256) S.init(F.G - 8 * NSG, F.bid - 8 * nsb); else S.init(F.G, F.bid);
            pg8::EpiH E{WSP(pg8::bf16_t, WS_H), WSP(pg8::bf16_t, WS_KVM), WSP(float, WS_RC), WSP(float, WS_RS)};
            pg8::gemm_phase<pg8::EpiH, pg8::OrderG1, true, true>(F.lds, g, S, E);
        }
        transpose_queue(F);
        if (PROBE_PH == 102) for (int _q = 1; _q < PROBE_N; ++_q) transpose_queue(F, _q);
        SEAM(1);
    }
#if PROBE_PH == 101
    if (IN(1)) {
        pg8::Gemm g{WSP(pg8::bf16_t, WS_XB), WSP(pg8::bf16_t, WS_WIN), T + MEMN, HW + 4096, D}; pg8::OrderG1 S; S.init(F.G, F.bid);
        pg8::EpiH E{WSP(pg8::bf16_t, WS_H), WSP(pg8::bf16_t, WS_KVM), WSP(float, WS_RC), WSP(float, WS_RS)};
        pg8::gemm_phase<pg8::EpiH, pg8::OrderG1, true, true>(F.lds, g, S, E);
        xcd_barrier(bar);
    }
#endif
    if (IN(2)) { REPS(2) p2_kv(F); SEAM(2); }
    if (IN(3)) { p3_scan(F); SEAM(3); }
#if PROBE_PH == 103
    if (IN(3)) { p2_kv(F); xcd_barrier(bar); p3_scan(F); xcd_barrier(bar); }
#endif
    if (IN(4)) { REPS(4) p4_out(F); SEAM(4); }
    if (IN(5)) {
        pg8::Gemm g{WSP(pg8::bf16_t, WS_MIXED), WSP(pg8::bf16_t, WS_WMIX), T, D, D}; pg8::StaticOrder S; S.init(T, D, F.G, F.bid);
        pg8::EpiResX E{F.in[0], WSP(float, WS_Y1), ALPHA};
        REPS(5) pg8::gemm_phase<pg8::EpiResX, pg8::StaticOrder, true, true>(F.lds, g, S, E);
        SEAM(5);
    }
    if (IN(6)) { REPS(6) ln_apply_plain(F, WSP(float, WS_Y1), F.in[8], F.in[9], WSP(bf16, WS_H1B), WSP(float, WS_ST1)); SEAM(6); }
    if (IN(7)) {
        pg8::Gemm g{WSP(pg8::bf16_t, WS_H1B), WSP(pg8::bf16_t, WS_WMQ), T, D, D}; pg8::StaticOrder S; S.init(T, D, F.G, F.bid);
        pg8::EpiB E{WSP(pg8::bf16_t, WS_QB), D, -1, 8192u * 2048u * 2u};
        REPS(7) pg8::gemm_phase<pg8::EpiB, pg8::StaticOrder, true, true>(F.lds, g, S, E);
        SEAM(7);
    }
    if (IN(8)) { REPS(8) p8_attn(F); SEAM(8); }
    if (IN(9)) {
        pg8::Gemm g{WSP(pg8::bf16_t, WS_ATT), WSP(pg8::bf16_t, WS_WMO), T, D, D}; pg8::StaticOrder S; S.init(T, D, F.G, F.bid);
        pg8::EpiResLN E{WSP(float, WS_Y1), WSP(float, WS_ST1), F.in[8], F.in[9], WSP(float, WS_Y2), ALPHA};
        REPS(9) pg8::gemm_phase<pg8::EpiResLN, pg8::StaticOrder, true, true>(F.lds, g, S, E);
        SEAM(9);
    }
    if (IN(10)) { p10_ln_router(F); SEAM(10); }
    if (IN(11)) { moe_tile_starts(F, ts); p10_dispatch(F, ts); SEAM(11); }
#if MK_MOE_F32
#define MOE_GEMM_GU(l, g, S, E) pg8::gemm_phase_bf32<pg8::EpiSwi, pg8::MoeOrder, true, true, true>(l, g, S, E)
#define MOE_GEMM_DN(l, g, S, E) pg8::gemm_phase_bf32<pg8::EpiB, pg8::MoeOrder, true, false, false>(l, g, S, E)
#else
#define MOE_GEMM_GU(l, g, S, E) pg8::gemm_phase<pg8::EpiSwi, pg8::MoeOrder, true, true, true>(l, g, S, E)
#define MOE_GEMM_DN(l, g, S, E) pg8::gemm_phase<pg8::EpiB, pg8::MoeOrder, true, true>(l, g, S, E)
#endif
    if (IN(12)) {
        moe_tile_starts(F, ts);
        const int U = ts[32] * 4;
        pg8::Gemm g{WSP(pg8::bf16_t, WS_H2B), WSP(pg8::bf16_t, WS_WGU), PMAX, 32 * 1024, D, WSP(int, WS_TOK)};
        pg8::MoeOrder S{(const PG8_LAS int*)ts, F.G, F.bid, 4, U < F.G ? U : F.G, F.in[20], F.in[21], 2048, 512, 0};
        pg8::EpiSwi E{WSP(pg8::bf16_t, WS_HID)};
        MOE_GEMM_GU(F.lds, g, S, E);
        SEAM(12);
    }
    if (IN(13)) {
        moe_tile_starts(F, ts);
        const int RT = ts[32], U = RT * 4, nbg = U > F.G ? U - F.G : 0, R1 = (F.G / 4) < RT ? (F.G / 4) : RT;
        {
            pg8::Gemm g{WSP(pg8::bf16_t, WS_H2B), WSP(pg8::bf16_t, WS_WGU), PMAX, 32 * 1024, D, WSP(int, WS_TOK)};
            pg8::MoeOrder S{(const PG8_LAS int*)ts, F.G, F.bid, 4, U, F.in[20], F.in[21], 2048, 512, F.G};
            pg8::EpiSwi E{WSP(pg8::bf16_t, WS_HID)};
            MOE_GEMM_GU(F.lds, g, S, E);
        }
        {
            pg8::Gemm g{WSP(pg8::bf16_t, WS_HID), WSP(pg8::bf16_t, WS_WD), PMAX, 32 * 2048, 512};
            pg8::MoeOrder S{(const PG8_LAS int*)ts, F.G - nbg, F.bid >= nbg ? F.bid - nbg : -1, 8, R1 * 8, F.in[22], nullptr, 512, 2048, 0};
            pg8::EpiB E{WSP(pg8::bf16_t, WS_YS), D, 7, 24576u * 2048u * 2u};
            MOE_GEMM_DN(F.lds, g, S, E);
        }
        SEAM(13);
    }
    if (IN(14)) {
        moe_tile_starts(F, ts);
        const int RT = ts[32], R1 = (F.G / 4) < RT ? (F.G / 4) : RT;
        pg8::Gemm g{WSP(pg8::bf16_t, WS_HID), WSP(pg8::bf16_t, WS_WD), PMAX, 32 * 2048, 512};
        pg8::MoeOrder S{(const PG8_LAS int*)ts, F.G, F.bid, 8, RT * 8, F.in[22], nullptr, 512, 2048, R1 * 8};
        pg8::EpiB E{WSP(pg8::bf16_t, WS_YS), D, 7, 24576u * 2048u * 2u};
        MOE_GEMM_DN(F.lds, g, S, E);
        SEAM(14);
    }
    if (IN(15)) { REPS(15) p13_combine(F); }
#undef IN
#undef SEAM
#undef REPS
}

extern "C" void kernel_launch(void* const* d_in, const int* in_sizes, int n_in, void* d_out, int out_size, void* d_ws, size_t ws_size, hipStream_t stream) {
    static int grid = 0;
    if (grid == 0) {
        if (n_in != 25 || in_sizes[0] != T * D || out_size != T * D || ws_size < WS_END) { fprintf(stderr, "kernel_launch: unexpected shapes / workspace (%d inputs, ws %zu)\n", n_in, ws_size); grid = -1; return; }
        int dev = 0, cus = 0;
        if (hipGetDevice(&dev) != hipSuccess || hipDeviceGetAttribute(&cus, hipDeviceAttributeMultiprocessorCount, dev) != hipSuccess) { grid = -1; return; }
        if (hipFuncSetAttribute((const void*)mega, hipFuncAttributeMaxDynamicSharedMemorySize, LDS_BYTES) != hipSuccess) { fprintf(stderr, "kernel_launch: hipFuncSetAttribute failed\n"); grid = -1; return; }
        int per_cu = 0;
        if (hipOccupancyMaxActiveBlocksPerMultiprocessor(&per_cu, (const void*)mega, NTHR, LDS_BYTES) != hipSuccess || per_cu < 1) { fprintf(stderr, "kernel_launch: occupancy query failed / 0 blocks per CU\n"); grid = -1; return; }
        (void)hipGetLastError();
        grid = cus;
    }
    if (grid < 0) return;
    if (hipMemsetAsync((char*)d_ws + WS_CTL, 0, CTL_ZERO_BYTES, stream) != hipSuccess) return;
    Args a{};
    for (int i = 0; i < 25; ++i) a.in[i] = (const float*)d_in[i];
    a.out = (float*)d_out; a.ws = (unsigned char*)d_ws;
#if MK_ONE_LAUNCH
    a.ph_lo = 0; a.ph_hi = NPH; a.use_bar = 1;
#if MK_CG_SYNC
    { void* kargs[] = {(void*)&a};
      hipError_t e = hipLaunchCooperativeKernel((const void*)mega, dim3(grid), dim3(NTHR), kargs, LDS_BYTES, stream);
      if (e != hipSuccess) fprintf(stderr, "cooperative launch failed: %s (grid %d)\n", hipGetErrorString(e), grid); }
#else
    hipLaunchKernelGGL(mega, dim3(grid), dim3(NTHR), LDS_BYTES, stream, a);
#endif
#else
    for (int p = 0; p < NPH; ++p) { a.ph_lo = p; a.ph_hi = p + 1; a.use_bar = 0;
        hipLaunchKernelGGL(mega, dim3(grid), dim3(NTHR), LDS_BYTES, stream, a); }
#endif
}
```

```cpp
#include <hip/hip_runtime.h>
#include <hip/hip_cooperative_groups.h>
#include <cstdio>
#include <cstdint>
#include <cmath>
#ifndef MK_ONE_LAUNCH
#define MK_ONE_LAUNCH 1
#endif
#ifndef MK_CG_SYNC
#define MK_CG_SYNC 2
#endif
#ifndef MK_WT_STORES
#define MK_WT_STORES 0
#endif
#ifndef MK_MOE_F32
#define MK_MOE_F32 0
#endif
#define PROBE_PH -1
#define PROBE_N 1
#define PROBE_T -1
namespace pg8 {
#define PG8_LAS __attribute__((address_space(3)))
typedef unsigned short bf16_t;
typedef short bf16x8 __attribute__((ext_vector_type(8)));
typedef float f32x4 __attribute__((ext_vector_type(4)));
typedef unsigned u32x4 __attribute__((ext_vector_type(4)));
constexpr int BM = 256, BK = 64, HALF = 128, HTB = HALF * BK * 2  , STAGE_BYTES = 8 * HTB, NXCD = 8, WGM = 8;

__host__ __device__ __forceinline__ int lds_byte(int r, int c) { const int st = (r >> 4) * 2 + (c >> 5), rr = r & 15, cc = c & 31, ob = rr * 64 + cc * 2; return st * 1024 + (ob ^ (((ob >> 9) & 1) << 5)); }
__host__ __device__ __forceinline__ void stage_rc(int b, int& R, int& C) { const int st = b / 1024, sb = b % 1024, swz = sb ^ (((sb >> 9) & 1) << 5); R = (st >> 1) * 16 + swz / 64; C = (st & 1) * 32 + (swz % 64) / 2; }
__host__ __device__ __forceinline__ int perm32(int rho) { const int n = rho >> 4, i = rho & 15; return 8 * (i >> 2) + 4 * n + (i & 3); }

struct Unit { int pm, pn; };
struct Gemm { const bf16_t* A; const bf16_t* Bt; int M, N, K; const int* tok; };

struct StaticOrder {
    int nM, nN, nwg, G, c;
    __host__ __device__ void init(int M, int N, int G_, int c_) { nM = M / BM; nN = N / BM; nwg = nM * nN; G = G_; c = c_; }
    __host__ __device__ bool next(int i, Unit& u) const {
        const long L = (long)i * G + c; if (L >= nwg) return false;
        int wgid = (int)L; { const int q = nwg / NXCD, r = nwg % NXCD, xcd = wgid % NXCD, off = wgid / NXCD; wgid = (xcd < r ? xcd * (q + 1) : r * (q + 1) + (xcd - r) * q) + off; }
        const int nig = WGM * nN, gid = wgid / nig, fm = gid * WGM, gsz = (nM - fm) < WGM ? (nM - fm) : WGM;
        u.pm = fm + ((wgid % nig) % gsz); u.pn = (wgid % nig) / gsz; return true;
    }
    __device__ __forceinline__ void a_ready(const Unit&) const {}
    __device__ __forceinline__ void done(const Unit&) const {}
};


typedef unsigned u32x2 __attribute__((ext_vector_type(2)));
__device__ __forceinline__ unsigned cvt_pk_bf16(float lo, float hi) { unsigned r; asm volatile("v_cvt_pk_bf16_f32 %0, %1, %2" : "=v"(r) : "v"(lo), "v"(hi)); return r; }
__device__ __forceinline__ u32x4 pack8(const f32x4 a, const f32x4 b) { u32x4 w; w.x = cvt_pk_bf16(a[0], a[1]); w.y = cvt_pk_bf16(a[2], a[3]); w.z = cvt_pk_bf16(b[0], b[1]); w.w = cvt_pk_bf16(b[2], b[3]); return w; }
#if MK_WT_STORES
#define PG8_RSRC(base, bytes) __builtin_amdgcn_make_buffer_rsrc((void*)(base), 0, (int)(bytes), 0x00020000)
#define PG8_ST16(rs, base, byteoff, val) __builtin_amdgcn_raw_buffer_store_b128(__builtin_bit_cast(u32x4, (val)), (rs), (unsigned)(byteoff), 0, 16)
#else
#define PG8_RSRC(base, bytes) 0
#define PG8_ST16(rs, base, byteoff, val) (*(u32x4*)((char*)(base) + (size_t)(byteoff)) = __builtin_bit_cast(u32x4, (val)))
#endif
__device__ __forceinline__ float silu_f(float x) { return x * __builtin_amdgcn_rcpf(1.0f + __builtin_amdgcn_exp2f(-1.4426950408889634f * x)); }

struct EpiH {
    static constexpr bool PERM = true, AFTER_DRAIN = false;
    bf16_t* H; bf16_t* KVM; const float* rc; const float* rs;
    __device__ __forceinline__ void operator()(const f32x4 (&acc)[2][2][4][2], const Unit& u, int wr, int wc, int fr, int fq) const {
        const int cb = wc * 32 + 8 * fq;
        const auto rsH = PG8_RSRC(H, 8192u * 7168u * 2u); (void)rsH;
        if (u.pm >= 32) {
#pragma unroll
            for (int ai = 0; ai < 2; ++ai)
#pragma unroll
                for (int m = 0; m < 4; ++m) { bf16_t* rowp = KVM + (size_t)(wr * 64 + fr + ai * HALF + m * 16) * 4096 + (u.pn - 28) * BM + cb;
#pragma unroll
                    for (int bj = 0; bj < 2; ++bj) *(u32x4*)(rowp + bj * HALF) = pack8(acc[ai][bj][m][0], acc[ai][bj][m][1]); }
            return;
        }
        const int row0 = u.pm * BM + wr * 64 + fr;
        if (u.pn < 8) {
            const float sc = u.pn >= 4 ? 0.0625f : 1.0f;
#pragma unroll
            for (int ai = 0; ai < 2; ++ai)
#pragma unroll
                for (int m = 0; m < 4; ++m) { const int row = row0 + ai * HALF + m * 16;
                    const float* cr = rc + (size_t)row * 128 + cb; const float* sr = rs + (size_t)row * 128 + cb;
                    const f32x4 c0 = *(const f32x4*)cr * sc, c1 = *(const f32x4*)(cr + 4) * sc, s0 = *(const f32x4*)sr * sc, s1 = *(const f32x4*)(sr + 4) * sc;
                    const f32x4 t1a = acc[ai][0][m][0], t1b = acc[ai][0][m][1], t2a = acc[ai][1][m][0], t2b = acc[ai][1][m][1];
                    const unsigned bo = (unsigned)(((size_t)u.pn * 8192 + row) * BM + cb) * 2u;
                    PG8_ST16(rsH, H, bo, pack8(t1a * c0 - t2a * s0, t1b * c1 - t2b * s1));
                    PG8_ST16(rsH, H, bo + 2 * HALF, pack8(t1a * s0 + t2a * c0, t1b * s1 + t2b * c1)); }
        } else {
            const float sc = (u.pn == 16 || u.pn == 17) ? 0.08838834764831845f : 1.0f;
#pragma unroll
            for (int ai = 0; ai < 2; ++ai)
#pragma unroll
                for (int m = 0; m < 4; ++m) { const unsigned bo = (unsigned)(((size_t)u.pn * 8192 + row0 + ai * HALF + m * 16) * BM + cb) * 2u;
#pragma unroll
                    for (int bj = 0; bj < 2; ++bj) PG8_ST16(rsH, H, bo + bj * 2 * HALF, pack8(acc[ai][bj][m][0] * sc, acc[ai][bj][m][1] * sc)); }
        }
    }
};
struct EpiB {
    static constexpr bool PERM = true, AFTER_DRAIN = false;
    bf16_t* O; int ldc; int pmask; unsigned obytes;
    __device__ __forceinline__ void operator()(const f32x4 (&acc)[2][2][4][2], const Unit& u, int wr, int wc, int fr, int fq) const {
        const int row0 = u.pm * BM + wr * 64 + fr, col0 = (u.pn & pmask) * BM + wc * 32 + 8 * fq;
        const auto rsO = PG8_RSRC(O, obytes); (void)rsO;
#pragma unroll
        for (int ai = 0; ai < 2; ++ai)
#pragma unroll
            for (int m = 0; m < 4; ++m) { const unsigned bo = (unsigned)((size_t)(row0 + ai * HALF + m * 16) * ldc + col0) * 2u;
#pragma unroll
                for (int bj = 0; bj < 2; ++bj) PG8_ST16(rsO, O, bo + bj * 2 * HALF, pack8(acc[ai][bj][m][0], acc[ai][bj][m][1])); }
    }
};
struct EpiSwi {
    static constexpr bool PERM = true, AFTER_DRAIN = false;
    bf16_t* O;
    __device__ __forceinline__ void operator()(const f32x4 (&acc)[2][2][4][2], const Unit& u, int wr, int wc, int fr, int fq) const {
        const int row0 = u.pm * BM + wr * 64 + fr, col0 = (u.pn & 3) * HALF + wc * 32 + 8 * fq;
        const auto rsO = PG8_RSRC(O, 24576u * 512u * 2u); (void)rsO;
#pragma unroll
        for (int ai = 0; ai < 2; ++ai)
#pragma unroll
            for (int m = 0; m < 4; ++m) { const unsigned bo = (unsigned)((size_t)(row0 + ai * HALF + m * 16) * 512 + col0) * 2u;
                f32x4 h0, h1;
#pragma unroll
                for (int i = 0; i < 4; ++i) { h0[i] = silu_f(acc[ai][0][m][0][i]) * acc[ai][1][m][0][i]; h1[i] = silu_f(acc[ai][0][m][1][i]) * acc[ai][1][m][1][i]; }
                PG8_ST16(rsO, O, bo, pack8(h0, h1)); }
    }
};
struct EpiResX {
    static constexpr bool PERM = false, AFTER_DRAIN = false;
    const float* X; float* Y; float alpha;
    __device__ __forceinline__ void operator()(const f32x4 (&acc)[2][2][4][2], const Unit& u, int wr, int wc, int fr, int fq) const {
        const int row0 = u.pm * BM + wr * 64 + fr, col0 = u.pn * BM + wc * 32 + 4 * fq;
        const auto rsY = PG8_RSRC(Y, 8192u * 2048u * 4u); (void)rsY;
#pragma unroll
        for (int ai = 0; ai < 2; ++ai)
#pragma unroll
            for (int m = 0; m < 4; ++m) { const size_t off = (size_t)(row0 + ai * HALF + m * 16) * 2048 + col0;
#pragma unroll
                for (int bj = 0; bj < 2; ++bj)
#pragma unroll
                    for (int n = 0; n < 2; ++n) { const f32x4 xv = *(const f32x4*)(X + off + bj * HALF + n * 16); const f32x4 yv = xv * alpha + acc[ai][bj][m][n]; PG8_ST16(rsY, Y, (off + bj * HALF + n * 16) * 4, yv); } }
    }
};
struct EpiResLN {
    static constexpr bool PERM = false, AFTER_DRAIN = false;
    const float* Yin; const float* st; const float* g; const float* b; float* Y; float alpha;
    __device__ __forceinline__ void operator()(const f32x4 (&acc)[2][2][4][2], const Unit& u, int wr, int wc, int fr, int fq) const {
        const int row0 = u.pm * BM + wr * 64 + fr, col0 = u.pn * BM + wc * 32 + 4 * fq;
        const auto rsY = PG8_RSRC(Y, 8192u * 2048u * 4u); (void)rsY;
        f32x4 gv[2][2], bv[2][2];
#pragma unroll
        for (int bj = 0; bj < 2; ++bj)
#pragma unroll
            for (int n = 0; n < 2; ++n) { gv[bj][n] = *(const f32x4*)(g + col0 + bj * HALF + n * 16) * alpha; bv[bj][n] = *(const f32x4*)(b + col0 + bj * HALF + n * 16) * alpha; }
#pragma unroll
        for (int ai = 0; ai < 2; ++ai)
#pragma unroll
            for (int m = 0; m < 4; ++m) { const int row = row0 + ai * HALF + m * 16; const size_t off = (size_t)row * 2048 + col0;
                const float mu = st[2 * row], rstd = st[2 * row + 1];
#pragma unroll
                for (int bj = 0; bj < 2; ++bj)
#pragma unroll
                    for (int n = 0; n < 2; ++n) { const f32x4 yv = *(const f32x4*)(Yin + off + bj * HALF + n * 16);
                        const f32x4 yo = ((yv - mu) * rstd) * gv[bj][n] + bv[bj][n] + acc[ai][bj][m][n]; PG8_ST16(rsY, Y, (off + bj * HALF + n * 16) * 4, yo); } }
    }
};

struct OrderG1 {
    StaticOrder so; int G, c;
    __device__ void init(int G_, int c_) { so.init(8192, 7168, G_, c_); G = G_; c = c_; }
    __device__ bool next(int i, Unit& u) const {
        const int L = i * G + c;
        if (L < 896) return so.next(i, u);
        if (L >= 912) return false;
        u.pm = 32; u.pn = 28 + (L - 896); return true;
    }
    __device__ __forceinline__ void a_ready(const Unit&) const {}
    __device__ __forceinline__ void done(const Unit&) const {}
};
struct MoeOrder {
    const PG8_LAS int* ts; int G, c, npn, total; const float* W0; const float* W1; int kdim, ncols; int L0;
    __device__ bool next(int i, Unit& u) const {
        if (c < 0) return false;
        const int L = L0 + i * G + c; if (L >= total) return false;
        const int rt = L / npn, pl = L - rt * npn; int e = 0;
        for (int j = 1; j < 32; ++j) e += (ts[j] <= rt) ? 1 : 0;
        u.pm = rt; u.pn = e * npn + pl; return true;
    }
    __device__ __forceinline__ int ldb() const { return ncols; }
    __device__ __forceinline__ const float* bbase(const Unit& u, int which) const {
        const int e = u.pn / npn, pl = u.pn - e * npn; const size_t eo = (size_t)e * kdim * ncols;
        if (W1) return (which ? W1 : W0) + eo + 128 * pl;
        return W0 + eo + 256 * pl;
    }
    __device__ __forceinline__ void a_ready(const Unit&) const {}
    __device__ __forceinline__ void done(const Unit&) const {}
};

template <int MODE>
struct EpiLN {
    static constexpr bool PERM = false, AFTER_DRAIN = true;
    const float* X; const float* stin; const float* gin; const float* bin;
    float* Yout; float* stout; bf16_t* HB; const float* g; const float* b;
    unsigned long long* xbuf;
    unsigned* cnt;
    __device__ __forceinline__ void operator()(const f32x4 (&)[2][2][4][2], const Unit&, int, int, int, int) const {}
    __device__ __forceinline__ void fused(f32x4 (&acc)[2][2][4][2], const Unit& u, int wr, int wc, int fr, int fq, PG8_LAS unsigned char* lds, int wid, int lane) const {
        typedef float f32x2v __attribute__((ext_vector_type(2)));
        PG8_LAS f32x2v* P = (PG8_LAS f32x2v*)lds;
        PG8_LAS f32x2v* MS = (PG8_LAS f32x2v*)(lds + 8192);
        const int row0 = u.pm * BM + wr * 64 + fr, col0 = u.pn * BM + wc * 32 + 4 * fq;
        float s1[2][4], s2[2][4], mu[2][4], rs[2][4];
#pragma unroll
        for (int ai = 0; ai < 2; ++ai)
#pragma unroll
            for (int m = 0; m < 4; ++m) { s1[ai][m] = 0.f; s2[ai][m] = 0.f; mu[ai][m] = 0.f; rs[ai][m] = 0.f;
                if (MODE == 1) { const int row = row0 + ai * HALF + m * 16; mu[ai][m] = stin[2 * row]; rs[ai][m] = stin[2 * row + 1]; } }
#pragma unroll
        for (int bj = 0; bj < 2; ++bj)
#pragma unroll
            for (int n = 0; n < 2; ++n) {
                f32x4 gvv = {0.f, 0.f, 0.f, 0.f}, bvv = gvv;
                if (MODE == 1) { gvv = *(const f32x4*)(gin + col0 + bj * HALF + n * 16) * 1.189207115002721f; bvv = *(const f32x4*)(bin + col0 + bj * HALF + n * 16) * 1.189207115002721f; }
#pragma unroll
                for (int ai = 0; ai < 2; ++ai)
#pragma unroll
                    for (int m = 0; m < 4; ++m) { const size_t off = (size_t)(row0 + ai * HALF + m * 16) * 2048 + col0 + bj * HALF + n * 16;
                        const f32x4 xv = *(const f32x4*)(X + off);
                        const f32x4 y = (MODE == 1 ? ((xv - mu[ai][m]) * rs[ai][m]) * gvv + bvv : xv * 1.189207115002721f) + acc[ai][bj][m][n];
                        acc[ai][bj][m][n] = y; *(f32x4*)(Yout + off) = y;
                        s1[ai][m] += (y[0] + y[1]) + (y[2] + y[3]); s2[ai][m] += (y[0] * y[0] + y[1] * y[1]) + (y[2] * y[2] + y[3] * y[3]); }
            }
#pragma unroll
        for (int ai = 0; ai < 2; ++ai)
#pragma unroll
            for (int m = 0; m < 4; ++m) { float a1 = s1[ai][m], a2 = s2[ai][m];
                a1 += __shfl_xor(a1, 16); a1 += __shfl_xor(a1, 32); a2 += __shfl_xor(a2, 16); a2 += __shfl_xor(a2, 32);
                if (fq == 0) P[(ai * HALF + wr * 64 + m * 16 + fr) * 4 + wc] = (f32x2v){a1, a2}; }
        asm volatile("s_waitcnt lgkmcnt(0)" ::: "memory"); __builtin_amdgcn_s_barrier(); asm volatile("" ::: "memory");
        const int t = wid * 64 + lane;
        if (t < 256) { const f32x2v a = P[t * 4 + 0], b2 = P[t * 4 + 1], c = P[t * 4 + 2], d = P[t * 4 + 3];
            const float S1 = (a.x + b2.x) + (c.x + d.x), S2 = (a.y + b2.y) + (c.y + d.y);
            __hip_atomic_store(xbuf + ((size_t)(u.pm * 8 + u.pn) * 256 + t), ((unsigned long long)__float_as_uint(S2) << 32) | __float_as_uint(S1), __ATOMIC_RELAXED, __HIP_MEMORY_SCOPE_AGENT);
            asm volatile("s_waitcnt vmcnt(0)" ::: "memory");
            if (lane == 0) __hip_atomic_fetch_add(cnt + 64 * u.pm, 1u, __ATOMIC_RELAXED, __HIP_MEMORY_SCOPE_AGENT); }
        if (wid == 0) {
            const unsigned long long t0 = __builtin_amdgcn_s_memrealtime();
            while ((unsigned)__builtin_amdgcn_readfirstlane(__hip_atomic_load(cnt + 64 * u.pm, __ATOMIC_RELAXED, __HIP_MEMORY_SCOPE_AGENT)) < 32u) {
                if (__builtin_amdgcn_s_memrealtime() - t0 > 2000000ull) break;
                __builtin_amdgcn_s_sleep(2); }
            __builtin_amdgcn_fence(__ATOMIC_ACQUIRE, "agent");
        }
        asm volatile("s_waitcnt vmcnt(0) lgkmcnt(0)" ::: "memory"); __builtin_amdgcn_s_barrier(); asm volatile("" ::: "memory");
        if (t < 256) { float S1 = 0.f, S2 = 0.f;
#pragma unroll
            for (int j = 0; j < 8; ++j) { const unsigned long long w = __hip_atomic_load(xbuf + ((size_t)(u.pm * 8 + j) * 256 + t), __ATOMIC_RELAXED, __HIP_MEMORY_SCOPE_AGENT); S1 += __uint_as_float((unsigned)w); S2 += __uint_as_float((unsigned)(w >> 32)); }
            const float mean = S1 * (1.f / 2048.f), var = fmaxf(S2 * (1.f / 2048.f) - mean * mean, 0.f), rstd = 1.0f / sqrtf(var + 1e-5f);
            MS[t] = (f32x2v){mean, rstd};
            if (u.pn == 0) { stout[2 * (u.pm * BM + t)] = mean; stout[2 * (u.pm * BM + t) + 1] = rstd; } }
        asm volatile("s_waitcnt lgkmcnt(0)" ::: "memory"); __builtin_amdgcn_s_barrier(); asm volatile("" ::: "memory");
#pragma unroll
        for (int bj = 0; bj < 2; ++bj)
#pragma unroll
            for (int n = 0; n < 2; ++n) { const f32x4 gN = *(const f32x4*)(g + col0 + bj * HALF + n * 16), bN = *(const f32x4*)(b + col0 + bj * HALF + n * 16);
#pragma unroll
                for (int ai = 0; ai < 2; ++ai)
#pragma unroll
                    for (int m = 0; m < 4; ++m) { const int rl = ai * HALF + wr * 64 + m * 16 + fr; const f32x2v ms = MS[rl]; const size_t off = (size_t)(u.pm * BM + rl) * 2048 + col0 + bj * HALF + n * 16;
                        const f32x4 h = ((acc[ai][bj][m][n] - ms.x) * ms.y) * gN + bN;
                        u32x2 w; w.x = cvt_pk_bf16(h[0], h[1]); w.y = cvt_pk_bf16(h[2], h[3]); *(u32x2*)(HB + off) = w; } }
    }
};
template <class Epi, class Sched, bool ALIGN_EPI = false, bool SP2 = false, bool GATHER = false>
__device__ __forceinline__ void gemm_phase(PG8_LAS unsigned char* lds, const Gemm g, const Sched& S, const Epi& E) {
    const int tid = threadIdx.x, wid = __builtin_amdgcn_readfirstlane(tid >> 6), lane = tid & 63, wr = wid >> 2, wc = wid & 3, fr = lane & 15, fq = lane >> 4;
    const int K = g.K, nt = K / BK;
    unsigned voffA[2], voffB[2];
#pragma unroll
    for (int i = 0; i < 2; ++i) { int R, C; stage_rc(tid * 16 + i * 8192, R, C); const int Rb = Epi::PERM ? ((R & ~31) + perm32(R & 31)) : R;
        voffA[i] = (unsigned)(R * K + C) * 2u; voffB[i] = (unsigned)(Rb * K + C) * 2u; }
    unsigned coff[2][2], noff[2][2]; int gR[2], gC[2];
#pragma unroll
    for (int i = 0; i < 2; ++i) { int R, C; stage_rc(tid * 16 + i * 8192, R, C); gR[i] = R; gC[i] = C; coff[0][i] = coff[1][i] = noff[0][i] = noff[1][i] = 0u; }
#define PG8_GOFF(dst, pm_) do { if constexpr (GATHER) { _Pragma("unroll") for (int _h = 0; _h < 2; ++_h) _Pragma("unroll") for (int _i = 0; _i < 2; ++_i) \
        dst[_h][_i] = ((unsigned)g.tok[(pm_) * BM + _h * HALF + gR[_i]] * (unsigned)K + (unsigned)gC[_i]) * 2u; } } while (0)
    const size_t kstep = (size_t)(BK * 2);
    const size_t hstep = (size_t)HALF * K * 2;
    const size_t tstep = 2 * hstep;
    const unsigned ldsw = (unsigned)wid * 1024u;
    const int aoff = lds_byte(wr * 64 + fr, fq * 8), boff = lds_byte(wc * 32 + fr, fq * 8);
#define PG8_SA(b, h) (((b) * 2 + (h)) * HTB)
#define PG8_SB(b, h) ((4 + (b) * 2 + (h)) * HTB)
#define PG8_STAGE(bufoff, gbase, voff) do { _Pragma("unroll") for (int _i = 0; _i < 2; ++_i) \
        __builtin_amdgcn_global_load_lds((const unsigned*)((const char*)(gbase) + (voff)[_i]), (PG8_LAS unsigned*)(lds + (bufoff) + ldsw + _i * 8192), 16, 0, 0); } while (0)
#define PG8_STAGEA(bufoff, gptr, hh, kbytes, usenext) do { if constexpr (GATHER) { _Pragma("unroll") for (int _i = 0; _i < 2; ++_i) { const unsigned _o = (usenext) ? noff[hh][_i] : coff[hh][_i]; \
        __builtin_amdgcn_global_load_lds((const unsigned*)((const char*)g.A + (size_t)(kbytes) + _o), (PG8_LAS unsigned*)(lds + (bufoff) + ldsw + _i * 8192), 16, 0, 0); } } else { PG8_STAGE(bufoff, gptr, voffA); } } while (0)
#define PG8_LDA(dst, b, h) do { _Pragma("unroll") for (int m = 0; m < 4; ++m) _Pragma("unroll") for (int k = 0; k < 2; ++k) dst[m][k] = *(const PG8_LAS bf16x8*)(lds + PG8_SA(b, h) + aoff + m * 2048 + k * 1024); } while (0)
#define PG8_LDB(dst, b, h) do { _Pragma("unroll") for (int n = 0; n < 2; ++n) _Pragma("unroll") for (int k = 0; k < 2; ++k) dst[n][k] = *(const PG8_LAS bf16x8*)(lds + PG8_SB(b, h) + boff + n * 2048 + k * 1024); } while (0)
#define PG8_MMA(ai, bj, At, Bt) do { __builtin_amdgcn_s_setprio(1); _Pragma("unroll") for (int m = 0; m < 4; ++m) _Pragma("unroll") for (int n = 0; n < 2; ++n) _Pragma("unroll") for (int k = 0; k < 2; ++k) \
        acc[ai][bj][m][n] = __builtin_amdgcn_mfma_f32_16x16x32_bf16(Bt[n][k], At[m][k], acc[ai][bj][m][n], 0, 0, 0); __builtin_amdgcn_s_setprio(0); } while (0)
#define PG8_WAIT_V(n) asm volatile("s_waitcnt vmcnt(" #n ")" ::: "memory")
#define PG8_WAIT_L(n) asm volatile("s_waitcnt lgkmcnt(" #n ")" ::: "memory")
#define PG8_BAR __builtin_amdgcn_s_barrier()
#define PG8_SCHED __builtin_amdgcn_sched_barrier(0)
    Unit cur, nxt; int ui = 0;
    if (!S.next(0, cur)) return;
    f32x4 acc[2][2][4][2];
#pragma unroll
    for (int a = 0; a < 2; ++a)
#pragma unroll
        for (int b = 0; b < 2; ++b)
#pragma unroll
            for (int m = 0; m < 4; ++m)
#pragma unroll
                for (int n = 0; n < 2; ++n) acc[a][b][m][n] = (f32x4){0.f, 0.f, 0.f, 0.f};
    bf16x8 At[4][2], B0[2][2], B1[2][2];
    const char* cA = (const char*)g.A + (size_t)cur.pm * tstep; const char* cB = (const char*)g.Bt + (size_t)cur.pn * tstep;
    PG8_GOFF(coff, cur.pm);
    S.a_ready(cur);
    if constexpr (SP2) {
        PG8_STAGE(PG8_SB(0, 0), cB, voffB); PG8_STAGE(PG8_SB(0, 1), cB + hstep, voffB); PG8_STAGEA(PG8_SA(0, 0), cA, 0, 0, false); PG8_STAGEA(PG8_SA(0, 1), cA + hstep, 1, 0, false);
        if (wr == 1) PG8_BAR;
        PG8_WAIT_V(2); PG8_BAR;
        PG8_STAGE(PG8_SB(1, 0), cB + kstep, voffB); PG8_STAGEA(PG8_SA(1, 0), cA + kstep, 0, kstep, false); PG8_STAGE(PG8_SB(1, 1), cB + hstep + kstep, voffB);
        PG8_WAIT_V(6); PG8_BAR;
    } else {
        PG8_STAGE(PG8_SB(0, 0), cB, voffB); PG8_STAGE(PG8_SA(0, 0), cA, voffA); PG8_STAGE(PG8_SB(0, 1), cB + hstep, voffB); PG8_STAGE(PG8_SA(0, 1), cA + hstep, voffA);
        if (wr == 1) PG8_BAR;
        PG8_WAIT_V(4); PG8_BAR;
        PG8_STAGE(PG8_SB(1, 0), cB + kstep, voffB); PG8_STAGE(PG8_SA(1, 0), cA + kstep, voffA); PG8_STAGE(PG8_SB(1, 1), cB + hstep + kstep, voffB);
        PG8_WAIT_V(6); PG8_BAR;
    }
    for (;;) {
        const bool has_next = S.next(ui + 1, nxt);
        const char* nA = has_next ? (const char*)g.A + (size_t)nxt.pm * tstep : cA; const char* nB = has_next ? (const char*)g.Bt + (size_t)nxt.pn * tstep : cB;
        if constexpr (GATHER) { if (has_next) { PG8_GOFF(noff, nxt.pm); } else { _Pragma("unroll") for (int _h = 0; _h < 2; ++_h) _Pragma("unroll") for (int _i = 0; _i < 2; ++_i) noff[_h][_i] = coff[_h][_i]; } }
        for (int t = 0; t < nt; t += 2) {
            const bool last = (t == nt - 2);
            const char* a1 = cA + (size_t)(t + 1) * kstep;
            const char* a2 = last ? nA : cA + (size_t)(t + 2) * kstep; const char* b2 = last ? nB : cB + (size_t)(t + 2) * kstep;
            const char* a3 = a2 + kstep; const char* b3 = b2 + kstep;
            const size_t k1 = (size_t)(t + 1) * kstep, k2 = last ? 0 : (size_t)(t + 2) * kstep, k3 = k2 + kstep;
            if (last && has_next) S.a_ready(nxt);
            if constexpr (SP2) {
            PG8_LDB(B0, 0, 0); PG8_LDB(B1, 0, 1); PG8_SCHED; PG8_LDA(At, 0, 0); PG8_STAGEA(PG8_SA(1, 1), a1 + hstep, 1, k1, false);
            PG8_WAIT_V(8); PG8_WAIT_L(0); PG8_BAR; PG8_MMA(0, 0, At, B0); PG8_MMA(0, 1, At, B1); PG8_BAR; PG8_SCHED;
            PG8_LDA(At, 0, 1); PG8_STAGE(PG8_SB(0, 0), b2, voffB); PG8_STAGE(PG8_SB(0, 1), b2 + hstep, voffB); PG8_STAGEA(PG8_SA(0, 0), a2, 0, k2, last);
            PG8_WAIT_V(8); PG8_WAIT_L(0); PG8_BAR; PG8_MMA(1, 0, At, B0); PG8_MMA(1, 1, At, B1); PG8_BAR; PG8_SCHED;
            PG8_LDB(B0, 1, 0); PG8_LDB(B1, 1, 1); PG8_SCHED; PG8_LDA(At, 1, 0); PG8_STAGEA(PG8_SA(0, 1), a2 + hstep, 1, k2, last);
            PG8_WAIT_V(8); PG8_WAIT_L(0); PG8_BAR; PG8_MMA(0, 0, At, B0); PG8_MMA(0, 1, At, B1); PG8_BAR; PG8_SCHED;
            PG8_LDA(At, 1, 1); PG8_STAGE(PG8_SB(1, 0), b3, voffB); PG8_STAGE(PG8_SB(1, 1), b3 + hstep, voffB); PG8_STAGEA(PG8_SA(1, 0), a3, 0, k3, last);
            PG8_WAIT_V(8); PG8_WAIT_L(0); PG8_BAR; PG8_MMA(1, 0, At, B0); PG8_MMA(1, 1, At, B1); PG8_BAR; PG8_SCHED;
            } else {
            PG8_LDB(B0, 0, 0); PG8_SCHED; PG8_LDA(At, 0, 0); PG8_STAGE(PG8_SA(1, 1), a1 + hstep, voffA);
            PG8_WAIT_L(8); PG8_BAR; PG8_WAIT_L(0); PG8_MMA(0, 0, At, B0); PG8_BAR; PG8_SCHED;
            PG8_LDB(B1, 0, 1); PG8_STAGE(PG8_SB(0, 0), b2, voffB);
            PG8_BAR; PG8_WAIT_L(0); PG8_MMA(0, 1, At, B1); PG8_BAR;
            PG8_LDA(At, 0, 1); PG8_STAGE(PG8_SA(0, 0), a2, voffA);
            PG8_BAR; PG8_WAIT_L(0); PG8_MMA(1, 0, At, B0); PG8_BAR; PG8_SCHED;
            PG8_STAGE(PG8_SB(0, 1), b2 + hstep, voffB);
            PG8_WAIT_V(6); PG8_BAR; PG8_MMA(1, 1, At, B1); PG8_BAR;
            PG8_LDB(B0, 1, 0); PG8_SCHED; PG8_LDA(At, 1, 0); PG8_STAGE(PG8_SA(0, 1), a2 + hstep, voffA);
            PG8_WAIT_L(8); PG8_BAR; PG8_WAIT_L(0); PG8_MMA(0, 0, At, B0); PG8_BAR; PG8_SCHED;
            PG8_LDB(B1, 1, 1); PG8_STAGE(PG8_SB(1, 0), b3, voffB);
            PG8_BAR; PG8_WAIT_L(0); PG8_MMA(0, 1, At, B1); PG8_BAR;
            PG8_LDA(At, 1, 1); PG8_STAGE(PG8_SA(1, 0), a3, voffA);
            PG8_BAR; PG8_WAIT_L(0); PG8_MMA(1, 0, At, B0); PG8_BAR; PG8_SCHED;
            PG8_STAGE(PG8_SB(1, 1), b3 + hstep, voffB);
            PG8_WAIT_V(6); PG8_BAR; PG8_MMA(1, 1, At, B1); PG8_BAR;
            }
        }
        if constexpr (ALIGN_EPI) { if (wr == 0) PG8_BAR; }
        if constexpr (!Epi::AFTER_DRAIN) { E(acc, cur, wr, wc, fr, fq); S.done(cur); }
        if (!has_next) break;
#pragma unroll
        for (int a = 0; a < 2; ++a)
#pragma unroll
            for (int b = 0; b < 2; ++b)
#pragma unroll
                for (int m = 0; m < 4; ++m)
#pragma unroll
                    for (int n = 0; n < 2; ++n) acc[a][b][m][n] = (f32x4){0.f, 0.f, 0.f, 0.f};
        cur = nxt; cA = nA; cB = nB; ++ui;
        if constexpr (GATHER) { _Pragma("unroll") for (int _h = 0; _h < 2; ++_h) _Pragma("unroll") for (int _i = 0; _i < 2; ++_i) coff[_h][_i] = noff[_h][_i]; }
        if constexpr (ALIGN_EPI) { if (wr == 1) PG8_BAR; }
    }
    PG8_WAIT_V(0);
    if constexpr (!ALIGN_EPI) { if (wr == 0) PG8_BAR; }
    PG8_BAR;
    if constexpr (Epi::AFTER_DRAIN) { E.fused(acc, cur, wr, wc, fr, fq, lds, wid, lane); S.done(cur); }
#undef PG8_SA
#undef PG8_SB
#undef PG8_STAGE
#undef PG8_STAGEA
#undef PG8_GOFF
#undef PG8_LDA
#undef PG8_LDB
#undef PG8_MMA
#undef PG8_WAIT_V
#undef PG8_WAIT_L
#undef PG8_BAR
#undef PG8_SCHED
}
constexpr int PBI = 544, SBI_BYTES = 64 * PBI;
template <class Epi, class Sched, bool ALIGN_EPI = false, bool GATHER = false, bool SPLIT = false>
__device__ __forceinline__ void gemm_phase_bf32(PG8_LAS unsigned char* lds, const Gemm g, const Sched& S, const Epi& E) {
    const int tid = threadIdx.x, wid = __builtin_amdgcn_readfirstlane(tid >> 6), lane = tid & 63, wr = wid >> 2, wc = wid & 3, fr = lane & 15, fq = lane >> 4;
    const int K = g.K, nt = K / BK;
    unsigned voffA[2];
#pragma unroll
    for (int i = 0; i < 2; ++i) { int R, C; stage_rc(tid * 16 + i * 8192, R, C); voffA[i] = (unsigned)(R * K + C) * 2u; }
    unsigned coff[2][2], noff[2][2]; int gR[2], gC[2];
#pragma unroll
    for (int i = 0; i < 2; ++i) { int R, C; stage_rc(tid * 16 + i * 8192, R, C); gR[i] = R; gC[i] = C; coff[0][i] = coff[1][i] = noff[0][i] = noff[1][i] = 0u; }
#define PG8_GOFF(dst, pm_) do { if constexpr (GATHER) { _Pragma("unroll") for (int _h = 0; _h < 2; ++_h) _Pragma("unroll") for (int _i = 0; _i < 2; ++_i) \
        dst[_h][_i] = ((unsigned)g.tok[(pm_) * BM + _h * HALF + gR[_i]] * (unsigned)K + (unsigned)gC[_i]) * 2u; } } while (0)
    const size_t kstep = (size_t)(BK * 2), hstep = (size_t)HALF * K * 2, tstep = 2 * hstep;
    const unsigned ldsw = (unsigned)wid * 1024u;
    const int aoff = lds_byte(wr * 64 + fr, fq * 8);
    const int ldb = S.ldb();
    const size_t bkstep = (size_t)BK * ldb;
    const int q4 = (lane >> 2) & 3, p4 = lane & 3;
    const unsigned lo = SPLIT ? (unsigned)((lane >> 5) * ldb + 4 * (lane & 31)) * 4u : (unsigned)lane * 16u;
    const unsigned bwoff = SPLIT ? (unsigned)(8 * wid + (lane >> 5)) * PBI + (unsigned)(((4 * (lane & 31)) ^ ((wid & 1) << 6)) * 2)
                                 : (unsigned)(8 * wid) * PBI + (unsigned)(((4 * lane) ^ ((wid & 1) << 6)) * 2);
    unsigned broff[2][2];
#pragma unroll
    for (int n = 0; n < 2; ++n)
#pragma unroll
        for (int k = 0; k < 2; ++k) { const int row = 32 * k + 8 * fq + q4, col = 32 * wc + (Epi::PERM ? 8 * p4 + 4 * n : 16 * n + 4 * p4);
            broff[n][k] = (unsigned)row * PBI + (unsigned)((col ^ ((row & 8) << 3)) * 2); }
#define PG8_SA(b, h) (((b) * 2 + (h)) * HTB)
#define PG8_SBI(b) (4 * HTB + (b) * SBI_BYTES)
#define PG8_STAGE(bufoff, gbase, voff) do { _Pragma("unroll") for (int _i = 0; _i < 2; ++_i) \
        __builtin_amdgcn_global_load_lds((const unsigned*)((const char*)(gbase) + (voff)[_i]), (PG8_LAS unsigned*)(lds + (bufoff) + ldsw + _i * 8192), 16, 0, 0); } while (0)
#define PG8_STAGEA(bufoff, gptr, hh, kbytes, usenext) do { if constexpr (GATHER) { _Pragma("unroll") for (int _i = 0; _i < 2; ++_i) { const unsigned _o = (usenext) ? noff[hh][_i] : coff[hh][_i]; \
        __builtin_amdgcn_global_load_lds((const unsigned*)((const char*)g.A + (size_t)(kbytes) + _o), (PG8_LAS unsigned*)(lds + (bufoff) + ldsw + _i * 8192), 16, 0, 0); } } else { PG8_STAGE(bufoff, gptr, voffA); } } while (0)
#define PG8_LDA(dst, b, h) do { _Pragma("unroll") for (int m = 0; m < 4; ++m) _Pragma("unroll") for (int k = 0; k < 2; ++k) dst[m][k] = *(const PG8_LAS bf16x8*)(lds + PG8_SA(b, h) + aoff + m * 2048 + k * 1024); } while (0)
#define PG8_LDBT(dst, b, h) do { _Pragma("unroll") for (int n = 0; n < 2; ++n) _Pragma("unroll") for (int k = 0; k < 2; ++k) { \
        const PG8_LAS unsigned char* _a = lds + PG8_SBI(b) + broff[n][k] + (h) * 256; \
        const s16x4 _lo = __builtin_bit_cast(s16x4, __builtin_amdgcn_ds_read_tr16_b64_v4i16((PG8_LAS s16x4*)_a)), _hi = __builtin_bit_cast(s16x4, __builtin_amdgcn_ds_read_tr16_b64_v4i16((PG8_LAS s16x4*)(_a + 4 * PBI))); \
        dst[n][k] = __builtin_shufflevector(_lo, _hi, 0, 1, 2, 3, 4, 5, 6, 7); } } while (0)
#define PG8_BLOAD(p0, p1) do { _Pragma("unroll") for (int _i = 0; _i < 8; ++_i) { \
        const float* _u = SPLIT ? ((_i < 4 ? (p0) : (p1)) + (size_t)(8 * wid + 2 * (_i & 3)) * ldb) : ((p0) + (size_t)(8 * wid + _i) * ldb); \
        breg[_i] = *(const __attribute__((address_space(1))) f32x4*)((const char*)_u + lo); } } while (0)
#define PG8_BWRITE(b) do { _Pragma("unroll") for (int _i = 0; _i < 8; ++_i) { u32x2 _w; _w.x = cvt_pk_bf16(breg[_i][0], breg[_i][1]); _w.y = cvt_pk_bf16(breg[_i][2], breg[_i][3]); \
        *(PG8_LAS u32x2*)(lds + PG8_SBI(b) + bwoff + (SPLIT ? (2 * (_i & 3)) * PBI + (_i >> 2) * 256 : _i * PBI)) = _w; } } while (0)
#define PG8_MMA(ai, bj, At, Bt) do { __builtin_amdgcn_s_setprio(1); _Pragma("unroll") for (int m = 0; m < 4; ++m) _Pragma("unroll") for (int n = 0; n < 2; ++n) _Pragma("unroll") for (int k = 0; k < 2; ++k) \
        acc[ai][bj][m][n] = __builtin_amdgcn_mfma_f32_16x16x32_bf16(Bt[n][k], At[m][k], acc[ai][bj][m][n], 0, 0, 0); __builtin_amdgcn_s_setprio(0); } while (0)
#define PG8_WAIT_V(n) asm volatile("s_waitcnt vmcnt(" #n ")" ::: "memory")
#define PG8_WAIT_L(n) asm volatile("s_waitcnt lgkmcnt(" #n ")" ::: "memory")
#define PG8_BAR __builtin_amdgcn_s_barrier()
#define PG8_SCHED __builtin_amdgcn_sched_barrier(0)
    typedef short s16x4 __attribute__((ext_vector_type(4)));
    typedef unsigned u32x2 __attribute__((ext_vector_type(2)));
    Unit cur, nxt; int ui = 0;
    if (!S.next(0, cur)) return;
    f32x4 acc[2][2][4][2];
#pragma unroll
    for (int a = 0; a < 2; ++a)
#pragma unroll
        for (int b = 0; b < 2; ++b)
#pragma unroll
            for (int m = 0; m < 4; ++m)
#pragma unroll
                for (int n = 0; n < 2; ++n) acc[a][b][m][n] = (f32x4){0.f, 0.f, 0.f, 0.f};
    bf16x8 At[4][2], B0[2][2];
    f32x4 breg[8];
    const char* cA = (const char*)g.A + (size_t)cur.pm * tstep; const float* cB0 = S.bbase(cur, 0); const float* cB1 = S.bbase(cur, 1);
    PG8_GOFF(coff, cur.pm);
    PG8_BLOAD(cB0, cB1); PG8_STAGEA(PG8_SA(0, 0), cA, 0, 0, false); PG8_STAGEA(PG8_SA(0, 1), cA + hstep, 1, 0, false);
    PG8_BWRITE(0); PG8_SCHED;
    if (wr == 1) PG8_BAR;
    PG8_WAIT_V(2); PG8_WAIT_L(0); PG8_BAR;
    PG8_BLOAD(cB0 + bkstep, cB1 + bkstep); PG8_STAGEA(PG8_SA(1, 0), cA + kstep, 0, kstep, false); PG8_SCHED;
    PG8_WAIT_V(10); PG8_BAR;
    for (;;) {
        const bool has_next = S.next(ui + 1, nxt);
        const char* nA = has_next ? (const char*)g.A + (size_t)nxt.pm * tstep : cA; const float* nB0 = has_next ? S.bbase(nxt, 0) : cB0; const float* nB1 = has_next ? S.bbase(nxt, 1) : cB1;
        if constexpr (GATHER) { if (has_next) { PG8_GOFF(noff, nxt.pm); } else { _Pragma("unroll") for (int _h = 0; _h < 2; ++_h) _Pragma("unroll") for (int _i = 0; _i < 2; ++_i) noff[_h][_i] = coff[_h][_i]; } }
        for (int t = 0; t < nt; t += 2) {
            const bool last = (t == nt - 2);
            const char* a1 = cA + (size_t)(t + 1) * kstep;
            const char* a2 = last ? nA : cA + (size_t)(t + 2) * kstep; const float* b20 = last ? nB0 : cB0 + (size_t)(t + 2) * bkstep; const float* b21 = last ? nB1 : cB1 + (size_t)(t + 2) * bkstep;
            const char* a3 = a2 + kstep; const float* b30 = b20 + bkstep; const float* b31 = b21 + bkstep;
            const size_t k1 = (size_t)(t + 1) * kstep, k2 = last ? 0 : (size_t)(t + 2) * kstep, k3 = k2 + kstep;
            PG8_LDBT(B0, 0, 0); PG8_SCHED; PG8_LDA(At, 0, 0); PG8_STAGEA(PG8_SA(1, 1), a1 + hstep, 1, k1, false);
            PG8_WAIT_V(12); PG8_WAIT_L(0); PG8_BAR; PG8_MMA(0, 0, At, B0); PG8_LDBT(B0, 0, 1); PG8_WAIT_L(0); PG8_SCHED; PG8_MMA(0, 1, At, B0); PG8_BAR; PG8_SCHED;
            PG8_BWRITE(1); PG8_BLOAD(b20, b21); PG8_SCHED; PG8_LDBT(B0, 0, 0); PG8_LDA(At, 0, 1); PG8_STAGEA(PG8_SA(0, 0), a2, 0, k2, last);
            PG8_WAIT_V(12); PG8_WAIT_L(0); PG8_BAR; PG8_MMA(1, 0, At, B0); PG8_LDBT(B0, 0, 1); PG8_WAIT_L(0); PG8_SCHED; PG8_MMA(1, 1, At, B0); PG8_BAR; PG8_SCHED;
            PG8_LDBT(B0, 1, 0); PG8_SCHED; PG8_LDA(At, 1, 0); PG8_STAGEA(PG8_SA(0, 1), a2 + hstep, 1, k2, last);
            PG8_WAIT_V(12); PG8_WAIT_L(0); PG8_BAR; PG8_MMA(0, 0, At, B0); PG8_LDBT(B0, 1, 1); PG8_WAIT_L(0); PG8_SCHED; PG8_MMA(0, 1, At, B0); PG8_BAR; PG8_SCHED;
            PG8_BWRITE(0); PG8_BLOAD(b30, b31); PG8_SCHED; PG8_LDBT(B0, 1, 0); PG8_LDA(At, 1, 1); PG8_STAGEA(PG8_SA(1, 0), a3, 0, k3, last);
            PG8_WAIT_V(12); PG8_WAIT_L(0); PG8_BAR; PG8_MMA(1, 0, At, B0); PG8_LDBT(B0, 1, 1); PG8_WAIT_L(0); PG8_SCHED; PG8_MMA(1, 1, At, B0); PG8_BAR; PG8_SCHED;
        }
        if constexpr (ALIGN_EPI) { if (wr == 0) PG8_BAR; }
        E(acc, cur, wr, wc, fr, fq); S.done(cur);
        if (!has_next) break;
#pragma unroll
        for (int a = 0; a < 2; ++a)
#pragma unroll
            for (int b = 0; b < 2; ++b)
#pragma unroll
                for (int m = 0; m < 4; ++m)
#pragma unroll
                    for (int n = 0; n < 2; ++n) acc[a][b][m][n] = (f32x4){0.f, 0.f, 0.f, 0.f};
        cur = nxt; cA = nA; cB0 = nB0; cB1 = nB1; ++ui;
        if constexpr (GATHER) { _Pragma("unroll") for (int _h = 0; _h < 2; ++_h) _Pragma("unroll") for (int _i = 0; _i < 2; ++_i) coff[_h][_i] = noff[_h][_i]; }
        if constexpr (ALIGN_EPI) { if (wr == 1) PG8_BAR; }
    }
    PG8_WAIT_V(0);
    asm volatile("" :: "v"(breg[0]), "v"(breg[1]), "v"(breg[2]), "v"(breg[3]), "v"(breg[4]), "v"(breg[5]), "v"(breg[6]), "v"(breg[7]));
    if constexpr (!ALIGN_EPI) { if (wr == 0) PG8_BAR; }
    PG8_BAR;
#undef PG8_SA
#undef PG8_SBI
#undef PG8_STAGE
#undef PG8_STAGEA
#undef PG8_GOFF
#undef PG8_LDA
#undef PG8_LDBT
#undef PG8_BLOAD
#undef PG8_BWRITE
#undef PG8_MMA
#undef PG8_WAIT_V
#undef PG8_WAIT_L
#undef PG8_BAR
#undef PG8_SCHED
}
}

constexpr int NWAVES = 8, NTHR = 512;
constexpr int T = 8192, D = 2048, HW = 7168, INW = 7184, MEMN = 256;
constexpr float LN_EPS = 1e-5f;
constexpr float ALPHA = 1.189207115002721f;
constexpr int NPH = 16;
#ifndef MK_NSG
#define MK_NSG 9
#endif
constexpr int NSG = MK_NSG;
constexpr int PMAX = 24576;

constexpr size_t MiB = 1u << 20;
constexpr size_t WS_CTL = 0, CTL_ZERO_BYTES = 64 * 1024;
constexpr size_t WS_WMIX = 2 * MiB, WS_WMQ = 10 * MiB, WS_WIN = 18 * MiB, WS_WKV = 46 * MiB, WS_WMO = 62 * MiB, WS_WGU = 70 * MiB, WS_WD = 198 * MiB;
constexpr size_t WS_XB = 262 * MiB, WS_MEMB = 294 * MiB;
constexpr size_t WS_H = 296 * MiB;
constexpr size_t WS_KVM = 408 * MiB;
constexpr size_t WS_ORAW = 410 * MiB;
constexpr size_t WS_MIXED = WS_XB;
constexpr size_t WS_Y1 = WS_ORAW;
constexpr size_t WS_H1B = WS_H;
constexpr size_t WS_QB = 328 * MiB, WS_ATT = 360 * MiB;
constexpr size_t WS_Y2 = 474 * MiB;
constexpr size_t WS_H2B = WS_H;
constexpr size_t WS_XS = 328 * MiB;
constexpr size_t WS_HID = 424 * MiB;
constexpr size_t WS_YS = WS_XS;
constexpr size_t WS_SMALL = 540 * MiB;
constexpr size_t WS_GLR = WS_SMALL;
constexpr size_t WS_RC = WS_SMALL + 1 * MiB, WS_RS = WS_SMALL + 5 * MiB;
constexpr size_t WS_ST1 = WS_SMALL + 9 * MiB, WS_ST2 = WS_ST1 + 65536;
constexpr size_t WS_EXP = WS_ST2 + 65536, WS_GATE = WS_EXP + 65536, WS_POS = WS_GATE + 65536, WS_SLOT = WS_POS + 65536, WS_TOK = WS_SLOT + 65536;
constexpr size_t WS_XCH1 = WS_SMALL + 10 * MiB, WS_XCH2 = WS_XCH1 + 512 * 1024;
constexpr size_t WS_END = 552 * MiB;
constexpr int CW_CNT = 64, CW_CUR = 128, CW_Q = 192;
constexpr int CW_BAR = 4096;
constexpr int CW_LN1 = 8192, CW_LN2 = 10240;

constexpr int RING_BYTES = 139264, LDSCTL_OFF = RING_BYTES, MISC_OFF = LDSCTL_OFF + 320, LDS_BYTES = 147456;

#define GAS __attribute__((address_space(1)))
#define LAS __attribute__((address_space(3)))
typedef unsigned short bf16;
typedef unsigned v4u __attribute__((ext_vector_type(4)));
typedef unsigned v2u __attribute__((ext_vector_type(2)));
typedef float f32x4 __attribute__((ext_vector_type(4)));
typedef GAS unsigned gu32;
#define RLX_AGENT __ATOMIC_RELAXED, __HIP_MEMORY_SCOPE_AGENT
#define LDS_WAIT() asm volatile("s_waitcnt lgkmcnt(0)" ::: "memory")
__device__ __forceinline__ unsigned f2bf(float f) { unsigned u = __builtin_bit_cast(unsigned, f); return (u + 0x7fffu + ((u >> 16) & 1u)) >> 16; }
__device__ __forceinline__ unsigned pk2(float lo, float hi) { return f2bf(lo) | (f2bf(hi) << 16); }
__device__ __forceinline__ float bf2f(unsigned h) { return __builtin_bit_cast(float, h << 16); }
__device__ __forceinline__ float bflo(unsigned w) { return __builtin_bit_cast(float, w << 16); }
__device__ __forceinline__ float bfhi(unsigned w) { return __builtin_bit_cast(float, w & 0xffff0000u); }
__device__ __forceinline__ float wave_sum(float v) {
#pragma unroll
    for (int o = 1; o < 64; o <<= 1) v += __shfl_xor(v, o);
    return v;
}
__device__ __forceinline__ float wave_max(float v) {
#pragma unroll
    for (int o = 1; o < 64; o <<= 1) v = fmaxf(v, __shfl_xor(v, o));
    return v;
}

struct Frame {
    LAS unsigned char* lds;
    volatile LAS unsigned* MISC;
    gu32* ctl;
    int tid, lane, wave, G, bid;
    unsigned char* ws;
    const float* in[25];
    float* out;
};
#define WSP(T_, off) ((T_*)(F.ws + (off)))

template <bool NTST>
__device__ __forceinline__ void transpose_item(const float* W, int ldw, bf16* WTr, int ldt, LAS float* scr, int lane) {
    float tv[32];
#pragma unroll
    for (int i = 0; i < 32; ++i) tv[i] = __builtin_nontemporal_load(W + (size_t)(2 * i + (lane >> 5)) * ldw + (lane & 31));
#pragma unroll
    for (int i = 0; i < 32; ++i) scr[(2 * i + (lane >> 5)) * 33 + (lane & 31)] = tv[i];
    LDS_WAIT(); asm volatile("" ::: "memory");
    const int c = lane & 7;
#pragma unroll
    for (int j = 0; j < 4; ++j) { const int n = (lane >> 3) + 8 * j; const LAS float* s = scr + (8 * c) * 33 + n;
        v4u o; o.x = pk2(s[0 * 33], s[1 * 33]); o.y = pk2(s[2 * 33], s[3 * 33]); o.z = pk2(s[4 * 33], s[5 * 33]); o.w = pk2(s[6 * 33], s[7 * 33]);
        if (NTST) __builtin_nontemporal_store(o, (GAS v4u*)(WTr + (size_t)n * ldt + 8 * c)); else *(GAS v4u*)(WTr + (size_t)n * ldt + 8 * c) = o; }
    LDS_WAIT(); asm volatile("" ::: "memory");
}
__device__ __forceinline__ void p0_prologue(Frame& F) {
    LAS float* scr = (LAS float*)(F.lds + F.wave * 16384);
    const int gw = F.bid * NWAVES + F.wave, NGW = F.G * NWAVES;
    const float* w_in = F.in[3];
    constexpr int I_IN = 32 * 224, I_SQ = 32 * 64;
    for (int it = gw; it < I_IN + 2 * I_SQ; it += NGW) {
        int r = it;
        if (r < I_IN) { const int kb = r / 224, nb = r % 224; transpose_item<false>(w_in + (size_t)(64 * kb) * INW + 32 * nb, INW, WSP(bf16, WS_WIN) + (size_t)(32 * nb) * 2048 + 64 * kb, 2048, scr, F.lane); continue; }
        r -= I_IN;
        { const int w = r / I_SQ, q = r % I_SQ, kb = q / 64, nb = q % 64;
          const float* src = F.in[11]; if (w) src = F.in[12];
          bf16* dst = WSP(bf16, WS_WKV) + (size_t)w * 2048 * 2048;
          transpose_item<false>(src + (size_t)(64 * kb) * 2048 + 32 * nb, 2048, dst + (size_t)(32 * nb) * 2048 + 64 * kb, 2048, scr, F.lane); }
    }
    const int gt = F.bid * NTHR + F.tid, NGT = F.G * NTHR;
    {
        const float* x = F.in[0]; bf16* xb = WSP(bf16, WS_XB);
        for (int item = F.bid; item < T / 32; item += F.G) {
            const size_t base = (size_t)item * 32 * D / 8;
#pragma unroll 1
            for (int c0 = 0; c0 < 16; c0 += 4) { f32x4 a[4], b[4];
#pragma unroll
                for (int u = 0; u < 4; ++u) { const size_t i = base + (size_t)(c0 + u) * NTHR + F.tid; a[u] = *(const GAS f32x4*)(x + i * 8); b[u] = *(const GAS f32x4*)(x + i * 8 + 4); }
#pragma unroll
                for (int u = 0; u < 4; ++u) { const size_t i = base + (size_t)(c0 + u) * NTHR + F.tid;
                    v4u o; o.x = pk2(a[u][0], a[u][1]); o.y = pk2(a[u][2], a[u][3]); o.z = pk2(b[u][0], b[u][1]); o.w = pk2(b[u][2], b[u][3]); *(GAS v4u*)(xb + i * 8) = o; } }
        }
        const float* mm = F.in[1]; bf16* mb = WSP(bf16, WS_MEMB);
        for (int i = gt; i < MEMN * D / 8; i += NGT) { const f32x4 a = *(const GAS f32x4*)(mm + (size_t)i * 8), b = *(const GAS f32x4*)(mm + (size_t)i * 8 + 4);
            v4u o; o.x = pk2(a[0], a[1]); o.y = pk2(a[2], a[3]); o.z = pk2(b[0], b[1]); o.w = pk2(b[2], b[3]); *(GAS v4u*)(mb + (size_t)i * 8) = o; }
    }
    {
        const int* pos = (const int*)F.in[2]; float* rc = WSP(float, WS_RC); float* rs = WSP(float, WS_RS);
        for (int i = gt; i < T * 128; i += NGT) { const int t = i >> 7, f = i & 127;
            const float inv = exp2f(-(float)f * (13.287712379549449f / 128.0f));
            const float ang = (float)pos[t] * inv;
            double rev = (double)ang * 0.15915494309189535; rev -= floor(rev);
            const float rf = (float)rev;
            rc[i] = __builtin_amdgcn_cosf(rf); rs[i] = __builtin_amdgcn_sinf(rf); }
    }
    {
        const float* x = F.in[0]; float* glr = WSP(float, WS_GLR);
        const int r16 = F.lane & 15, g4 = F.lane >> 4;
        LAS float* part = (LAS float*)F.lds;
        for (int item = F.bid; item < T / 32; item += F.G) {
            const int tile = 2 * item + (F.wave >> 2), kq = F.wave & 3;
            f32x4 acc = {0.f, 0.f, 0.f, 0.f};
            const float* xr = x + (size_t)(tile * 16 + r16) * D + 512 * kq + 4 * g4;
            const float* wr = w_in + (size_t)(512 * kq + 4 * g4) * INW + HW + r16;
#pragma unroll 8
            for (int k0 = 0; k0 < 512; k0 += 16) {
                const f32x4 a = *(const GAS f32x4*)(xr + k0);
                const float b0 = wr[(size_t)(k0 + 0) * INW], b1 = wr[(size_t)(k0 + 1) * INW], b2 = wr[(size_t)(k0 + 2) * INW], b3 = wr[(size_t)(k0 + 3) * INW];
                acc = __builtin_amdgcn_mfma_f32_16x16x4f32(a[0], b0, acc, 0, 0, 0);
                acc = __builtin_amdgcn_mfma_f32_16x16x4f32(a[1], b1, acc, 0, 0, 0);
                acc = __builtin_amdgcn_mfma_f32_16x16x4f32(a[2], b2, acc, 0, 0, 0);
                acc = __builtin_amdgcn_mfma_f32_16x16x4f32(a[3], b3, acc, 0, 0, 0);
            }
            __syncthreads();
            *(LAS f32x4*)(part + (F.wave * 64 + F.lane) * 4) = acc;
            __syncthreads();
            if (F.tid < 128) { const int tl = F.tid >> 6, ln = F.tid & 63;
                f32x4 s = *(const LAS f32x4*)(part + ((tl * 4 + 0) * 64 + ln) * 4);
#pragma unroll
                for (int q = 1; q < 4; ++q) s += *(const LAS f32x4*)(part + ((tl * 4 + q) * 64 + ln) * 4);
#pragma unroll
                for (int j = 0; j < 4; ++j) glr[(size_t)((2 * item + tl) * 16 + 4 * (ln >> 4) + j) * 16 + (ln & 15)] = s[j]; }
        }
        __syncthreads();
    }
}
__device__ __forceinline__ void transpose_queue(Frame& F, int qsel = 0) {
    LAS float* scr = (LAS float*)(F.lds + F.wave * 16384);
    const float* const i7 = F.in[7]; const float* const i10 = F.in[10]; const float* const i13 = F.in[13]; const float* const i20 = F.in[20]; const float* const i21 = F.in[21]; const float* const i22 = F.in[22];
    constexpr int I_SQ = 32 * 64, I_E = 512, NQ = 3 * I_SQ + (MK_MOE_F32 ? 0 : 3 * 32 * I_E);
    for (;;) {
        unsigned b0 = 0;
        if (F.lane == 0) b0 = __hip_atomic_fetch_add((unsigned*)(F.ctl + CW_Q + 64 * qsel), 16u, __ATOMIC_RELAXED, __HIP_MEMORY_SCOPE_AGENT);
        b0 = __builtin_amdgcn_readfirstlane(b0);
        if (b0 >= (unsigned)NQ) break;
        for (int it = (int)b0; it < (int)b0 + 16 && it < NQ; ++it) {
            int r = it;
            if (r < 3 * I_SQ) { const int w = r / I_SQ, q = r % I_SQ, kb = q / 64, nb = q % 64;
                const float* src = i7; size_t doff = WS_WMIX; if (w == 1) { src = i10; doff = WS_WMQ; } if (w == 2) { src = i13; doff = WS_WMO; }
                bf16* dst = (bf16*)(F.ws + doff);
                transpose_item<true>(src + (size_t)(64 * kb) * 2048 + 32 * nb, 2048, dst + (size_t)(32 * nb) * 2048 + 64 * kb, 2048, scr, F.lane); continue; }
            r -= 3 * I_SQ;
            if (r < 2 * 32 * I_E) {
                const int up = r / (32 * I_E), q = r % (32 * I_E), e = q / I_E, q2 = q % I_E, kb = q2 / 16, nb = q2 % 16, n0 = 32 * nb;
                const float* sb = i20; if (up) sb = i21;
                const float* src = sb + (size_t)e * 2048 * 512 + (size_t)(64 * kb) * 512 + n0;
                bf16* dst = WSP(bf16, WS_WGU) + (size_t)(e * 1024 + (n0 >> 7) * 256 + up * 128 + (n0 & 127)) * 2048 + 64 * kb;
                transpose_item<true>(src, 512, dst, 2048, scr, F.lane); continue; }
            r -= 2 * 32 * I_E;
            {
                const int e = r / I_E, q2 = r % I_E, kb = q2 / 64, nb = q2 % 64;
                const float* src = i22 + (size_t)e * 512 * 2048 + (size_t)(64 * kb) * 2048 + 32 * nb;
                bf16* dst = WSP(bf16, WS_WD) + (size_t)(e * 2048 + 32 * nb) * 512 + 64 * kb;
                transpose_item<true>(src, 2048, dst, 512, scr, F.lane); }
        }
    }
}

__device__ __forceinline__ float log_sigmoid_f(float z) { return fminf(z, 0.f) - log1pf(expf(-fabsf(z))); }
template <bool GLA>
__device__ __forceinline__ void mixer_naive_item(Frame& F, int hh, int eg) {
    constexpr int ND = GLA ? 4 : 8;
    const bf16* H = WSP(bf16, WS_H); float* oraw = WSP(float, WS_ORAW);
    const int ei = F.tid & 15, dp = F.tid >> 4, e = eg * 16 + ei;
    const int qcol = GLA ? 4096 + hh * 128 : hh * 256, kcol = GLA ? 4608 + hh * 128 : 1024 + hh * 256, vcol = (GLA ? 5120 : 2048) + hh * 256 + e;
    const int ocol = (GLA ? 1024 : 0) + hh * 256 + eg * 16;
    LAS float* red = (LAS float*)F.lds;
    float S[ND];
#pragma unroll
    for (int i = 0; i < ND; ++i) S[i] = 0.f;
    float wa[GLA ? 4 : 1][16]; float ba[GLA ? 4 : 1];
    if (GLA) {
#pragma unroll
        for (int i = 0; i < 4; ++i) { const int d = dp + 32 * i; ba[i] = F.in[5][hh * 128 + d];
#pragma unroll
            for (int r = 0; r < 16; ++r) wa[i][r] = F.in[4][r * 512 + hh * 128 + d]; }
    }
    const float gamma = 1.0f - exp2f(-5.0f - (float)hh);
    const float* glr = WSP(float, WS_GLR);
    for (int t0 = 0; t0 < T; t0 += 8) {
        float part[8];
#pragma unroll
        for (int tt = 0; tt < 8; ++tt) {
            const int t = t0 + tt; const bf16* hr = H + (size_t)t * HW;
            const float v = bf2f(hr[vcol]);
            float g16[16];
            if (GLA) {
#pragma unroll
                for (int r = 0; r < 16; ++r) g16[r] = glr[t * 16 + r];
            }
            float p = 0.f;
#pragma unroll
            for (int i = 0; i < ND; ++i) { const int d = dp + 32 * i;
                const float q = bf2f(hr[qcol + d]), k = bf2f(hr[kcol + d]);
                float a = gamma;
                if (GLA) { float z = ba[i];
#pragma unroll
                    for (int r = 0; r < 16; ++r) z += g16[r] * wa[i][r];
                    a = expf(log_sigmoid_f(z) * 0.0625f); }
                S[i] = a * S[i] + k * v; p += q * S[i]; }
            p += __shfl_xor(p, 16); p += __shfl_xor(p, 32);
            part[tt] = p;
        }
        if (F.lane < 16) {
#pragma unroll
            for (int tt = 0; tt < 8; ++tt) red[(F.wave * 8 + tt) * 16 + F.lane] = part[tt];
        }
        __syncthreads();
        if (F.tid < 128) { const int tt = F.tid >> 4, e2 = F.tid & 15; float s = 0.f;
#pragma unroll
            for (int w = 0; w < 8; ++w) s += red[(w * 8 + tt) * 16 + e2];
            oraw[(size_t)(t0 + tt) * D + ocol + e2] = s; }
        __syncthreads();
    }
}
__device__ __forceinline__ void p2_mixer_naive(Frame& F) {
    for (int item = F.bid; item < 128; item += F.G) {
        const int h8 = item >> 4, eg = item & 15;
        if (h8 < 4) mixer_naive_item<false>(F, h8, eg); else mixer_naive_item<true>(F, h8 - 4, eg);
    }
}
__device__ __forceinline__ void p3_normgate(Frame& F) {
    const bf16* H = WSP(bf16, WS_H); const float* oraw = WSP(float, WS_ORAW); bf16* mixed = WSP(bf16, WS_MIXED);
    const int gw = F.bid * NWAVES + F.wave, NGW = F.G * NWAVES;
    const f32x4 gn = *(const f32x4*)(F.in[6] + 4 * F.lane);
    for (int t = gw; t < T; t += NGW) {
#pragma unroll
        for (int h8 = 0; h8 < 8; ++h8) {
            const f32x4 o = *(const GAS f32x4*)(oraw + (size_t)t * D + h8 * 256 + 4 * F.lane);
            const int gcol = (h8 < 4 ? 3072 : 6144) + (h8 & 3) * 256 + 4 * F.lane;
            const v2u gw2 = *(const GAS v2u*)(H + (size_t)t * HW + gcol);
            const f32x4 gt = {bflo(gw2.x), bfhi(gw2.x), bflo(gw2.y), bfhi(gw2.y)};
            f32x4 y;
            if (h8 < 4) {
                const float mu = wave_sum((o[0] + o[1]) + (o[2] + o[3])) * (1.f / 256.f);
                const f32x4 dd = o - mu;
                const float var = wave_sum((dd[0] * dd[0] + dd[1] * dd[1]) + (dd[2] * dd[2] + dd[3] * dd[3])) * (1.f / 256.f);
                y = dd * (1.0f / sqrtf(var + LN_EPS));
            } else {
                const float ms = wave_sum((o[0] * o[0] + o[1] * o[1]) + (o[2] * o[2] + o[3] * o[3])) * (1.f / 256.f);
                y = o * (1.0f / sqrtf(ms + LN_EPS)) * gn;
            }
            float r[4];
#pragma unroll
            for (int i = 0; i < 4; ++i) { const float g = gt[i]; r[i] = g / (1.0f + expf(-g)) * y[i]; }
            v2u w; w.x = pk2(r[0], r[1]); w.y = pk2(r[2], r[3]);
            *(GAS v2u*)(mixed + (size_t)t * D + h8 * 256 + 4 * F.lane) = w;
        }
    }
}
__device__ __forceinline__ void ln_apply_plain(Frame& F, const float* Y, const float* g, const float* b, bf16* HB, float* st) {
    const int gw = F.bid * NWAVES + F.wave, NGW = F.G * NWAVES;
    f32x4 cur[8];
    if (gw < T) { const GAS f32x4* yr = (const GAS f32x4*)(Y + (size_t)gw * D) + F.lane;
#pragma unroll
        for (int j = 0; j < 8; ++j) cur[j] = yr[64 * j]; }
    for (int t = gw; t < T; t += NGW) {
        f32x4 nxt[8];
        { const int tn = t + NGW < T ? t + NGW : t; const GAS f32x4* yr = (const GAS f32x4*)(Y + (size_t)tn * D) + F.lane;
#pragma unroll
          for (int j = 0; j < 8; ++j) nxt[j] = yr[64 * j]; }
        f32x4 v[8]; float s = 0.f;
#pragma unroll
        for (int j = 0; j < 8; ++j) { v[j] = cur[j]; s += (v[j][0] + v[j][1]) + (v[j][2] + v[j][3]); }
        const float mean = wave_sum(s) * (1.f / D); float s2 = 0.f;
#pragma unroll
        for (int j = 0; j < 8; ++j) { v[j] = v[j] - mean; s2 += (v[j][0] * v[j][0] + v[j][1] * v[j][1]) + (v[j][2] * v[j][2] + v[j][3] * v[j][3]); }
        const float rstd = 1.f / sqrtf(wave_sum(s2) * (1.f / D) + LN_EPS);
        if (F.lane == 0) { st[2 * t] = mean; st[2 * t + 1] = rstd; }
        GAS v2u* o8 = (GAS v2u*)(HB + (size_t)t * D) + F.lane;
#pragma unroll
        for (int j = 0; j < 8; ++j) { const f32x4 gv = *(const f32x4*)(g + 4 * F.lane + 256 * j), bv = *(const f32x4*)(b + 4 * F.lane + 256 * j);
            v[j] = v[j] * rstd * gv + bv;
            v2u w; w.x = pk2(v[j][0], v[j][1]); w.y = pk2(v[j][2], v[j][3]); o8[64 * j] = w; }
#pragma unroll
        for (int j = 0; j < 8; ++j) cur[j] = nxt[j];
    }
}
template <bool ROUTER>
__device__ __forceinline__ void ln_apply(Frame& F, const float* Y, const float* g, const float* b, bf16* HB, float* st, bool count = true) {
    const int gw = F.bid * NWAVES + F.wave, NGW = F.G * NWAVES;
    for (int t = gw; t < T; t += NGW) {
        const GAS f32x4* yr = (const GAS f32x4*)(Y + (size_t)t * D) + F.lane;
        f32x4 v[8]; float s = 0.f;
#pragma unroll
        for (int j = 0; j < 8; ++j) { v[j] = yr[64 * j]; s += (v[j][0] + v[j][1]) + (v[j][2] + v[j][3]); }
        const float mean = wave_sum(s) * (1.f / D); float s2 = 0.f;
#pragma unroll
        for (int j = 0; j < 8; ++j) { v[j] = v[j] - mean; s2 += (v[j][0] * v[j][0] + v[j][1] * v[j][1]) + (v[j][2] * v[j][2] + v[j][3] * v[j][3]); }
        const float rstd = 1.f / sqrtf(wave_sum(s2) * (1.f / D) + LN_EPS);
        if (F.lane == 0) { st[2 * t] = mean; st[2 * t + 1] = rstd; }
        GAS v2u* o8 = (GAS v2u*)(HB + (size_t)t * D) + F.lane;
#pragma unroll
        for (int j = 0; j < 8; ++j) { const f32x4 gv = *(const f32x4*)(g + 4 * F.lane + 256 * j), bv = *(const f32x4*)(b + 4 * F.lane + 256 * j);
            v[j] = v[j] * rstd * gv + bv;
            v2u w; w.x = pk2(v[j][0], v[j][1]); w.y = pk2(v[j][2], v[j][3]); o8[64 * j] = w; }
        if (ROUTER) {
            const float* Wg = F.in[16]; const float* We = F.in[18];
            float lg[4], le[32];
#pragma unroll
            for (int i = 0; i < 4; ++i) lg[i] = 0.f;
#pragma unroll
            for (int i = 0; i < 32; ++i) le[i] = 0.f;
#pragma unroll
            for (int j = 0; j < 8; ++j) {
#pragma unroll
                for (int i = 0; i < 4; ++i) { const int c = 4 * F.lane + 256 * j + i; const float hv = v[j][i];
                    const f32x4 wg = *(const GAS f32x4*)(Wg + (size_t)c * 4);
#pragma unroll
                    for (int q = 0; q < 4; ++q) lg[q] += hv * wg[q];
#pragma unroll
                    for (int q8 = 0; q8 < 8; ++q8) { const f32x4 we = *(const GAS f32x4*)(We + (size_t)c * 32 + 4 * q8);
#pragma unroll
                        for (int q = 0; q < 4; ++q) le[4 * q8 + q] += hv * we[q]; } }
            }
#pragma unroll
            for (int i = 0; i < 4; ++i) lg[i] = wave_sum(lg[i]) + F.in[17][i];
#pragma unroll
            for (int i = 0; i < 32; ++i) le[i] = wave_sum(le[i]);
            int grp = 0; float gm = lg[0];
#pragma unroll
            for (int i = 1; i < 4; ++i) if (lg[i] > gm) { gm = lg[i]; grp = i; }
            float gs = 0.f;
#pragma unroll
            for (int i = 0; i < 4; ++i) gs += expf(lg[i] - gm);
            const float pg_sel = 1.0f / gs;
            float fe[8];
#pragma unroll
            for (int j = 0; j < 8; ++j) { const float a = grp == 0 ? le[j] : grp == 1 ? le[8 + j] : grp == 2 ? le[16 + j] : le[24 + j]; fe[j] = a + F.in[19][grp * 8 + j]; }
            int i1 = 0; float m1 = fe[0];
#pragma unroll
            for (int j = 1; j < 8; ++j) if (fe[j] > m1) { m1 = fe[j]; i1 = j; }
            int i2 = -1; float m2 = -3.0e38f;
#pragma unroll
            for (int j = 0; j < 8; ++j) if (j != i1 && fe[j] > m2) { m2 = fe[j]; i2 = j; }
            const float p2 = expf(m2 - m1), den = 1.0f / (1.0f + p2);
            if (F.lane == 0) {
                int* ex = WSP(int, WS_EXP); float* gt = WSP(float, WS_GATE);
                const int e1 = grp * 8 + i1, e2 = grp * 8 + i2;
                ex[2 * t] = e1; ex[2 * t + 1] = e2; gt[2 * t] = pg_sel * den; gt[2 * t + 1] = pg_sel * p2 * den;
                if (count) { atomicAdd((unsigned*)(F.ctl + CW_CNT) + e1, 1u); atomicAdd((unsigned*)(F.ctl + CW_CNT) + e2, 1u); }
            }
        }
    }
}
__device__ __forceinline__ void p7_attn_naive(Frame& F) {
    const bf16* Q = WSP(bf16, WS_QB); const bf16* KVM = WSP(bf16, WS_KVM); bf16* att = WSP(bf16, WS_ATT);
    LAS float* qs = (LAS float*)F.lds;
    LAS float* sc = (LAS float*)(F.lds + 16384);
    for (int item = F.bid; item < (T / 8) * 4; item += F.G) {
        const int h = item & 3, t0 = (item >> 2) * 8;
        for (int i = F.tid; i < 8 * 512; i += NTHR) { const int tt = i >> 9, d = i & 511; qs[i] = bf2f(Q[(size_t)(t0 + tt) * D + h * 512 + d]); }
        __syncthreads();
        {
            const int j = F.tid & 255, th = F.tid >> 8;
            const bf16* kr = KVM + (size_t)j * 4096 + h * 512;
            float a0 = 0.f, a1 = 0.f, a2 = 0.f, a3 = 0.f;
            for (int d = 0; d < 512; d += 8) {
                const v4u kw = *(const GAS v4u*)(kr + d);
                const float kf[8] = {bflo(kw.x), bfhi(kw.x), bflo(kw.y), bfhi(kw.y), bflo(kw.z), bfhi(kw.z), bflo(kw.w), bfhi(kw.w)};
#pragma unroll
                for (int i = 0; i < 8; ++i) { a0 += kf[i] * qs[(th * 4 + 0) * 512 + d + i]; a1 += kf[i] * qs[(th * 4 + 1) * 512 + d + i]; a2 += kf[i] * qs[(th * 4 + 2) * 512 + d + i]; a3 += kf[i] * qs[(th * 4 + 3) * 512 + d + i]; }
            }
            const float scl = 0.04419417382415922f;
            sc[(th * 4 + 0) * 256 + j] = a0 * scl; sc[(th * 4 + 1) * 256 + j] = a1 * scl; sc[(th * 4 + 2) * 256 + j] = a2 * scl; sc[(th * 4 + 3) * 256 + j] = a3 * scl;
        }
        __syncthreads();
        {
            float v[4]; float mx = -3.0e38f;
#pragma unroll
            for (int i = 0; i < 4; ++i) { v[i] = sc[F.wave * 256 + F.lane + 64 * i]; mx = fmaxf(mx, v[i]); }
            mx = wave_max(mx); float sm = 0.f;
#pragma unroll
            for (int i = 0; i < 4; ++i) { v[i] = expf(v[i] - mx); sm += v[i]; }
            sm = 1.0f / wave_sum(sm);
#pragma unroll
            for (int i = 0; i < 4; ++i) sc[F.wave * 256 + F.lane + 64 * i] = v[i] * sm;
        }
        __syncthreads();
        {
            const int d = F.tid; const bf16* vr = KVM + 2048 + h * 512 + d;
            float o[8];
#pragma unroll
            for (int i = 0; i < 8; ++i) o[i] = 0.f;
            for (int j = 0; j < 256; ++j) { const float vv = bf2f(vr[(size_t)j * 4096]);
#pragma unroll
                for (int i = 0; i < 8; ++i) o[i] += sc[i * 256 + j] * vv; }
#pragma unroll
            for (int i = 0; i < 8; ++i) att[(size_t)(t0 + i) * D + h * 512 + d] = (bf16)f2bf(o[i]);
        }
        __syncthreads();
    }
}
__device__ __forceinline__ void moe_tile_starts(Frame& F, LAS int* ts) {
    if (F.tid < 64) {
        const unsigned c = F.lane < 32 ? __hip_atomic_load(F.ctl + CW_CUR + (F.lane & 31), RLX_AGENT) : 0u;
        int v = (int)((c + 255u) >> 8);
#pragma unroll
        for (int o = 1; o < 32; o <<= 1) { const int n = __shfl_up(v, o); if (F.lane >= o) v += n; }
        if (F.lane < 32) ts[F.lane + 1] = v;
        if (F.lane == 0) ts[0] = 0;
    }
    __syncthreads();
}
__device__ __forceinline__ void p10_dispatch(Frame& F, LAS int* ts) {
    const int gt = F.bid * NTHR + F.tid, NGT = F.G * NTHR;
    const int* ex = WSP(int, WS_EXP); const int* sl = WSP(int, WS_SLOT); int* pos = WSP(int, WS_POS); int* tok = WSP(int, WS_TOK);
    for (int a = gt; a < 2 * T; a += NGT) { const int p = ts[ex[a]] * 256 + sl[a]; pos[a] = p; tok[p] = a >> 1; }
}
__device__ __forceinline__ void p13_combine(Frame& F) {
    const int gw = F.bid * NWAVES + F.wave, NGW = F.G * NWAVES;
    const float* Y2 = WSP(float, WS_Y2); const float* st2 = WSP(float, WS_ST2); const bf16* ys = WSP(bf16, WS_YS);
    const int* pos = WSP(int, WS_POS); const float* gt = WSP(float, WS_GATE);
    const float* g2 = F.in[14]; const float* b2 = F.in[15]; const float* g3 = F.in[23]; const float* b3 = F.in[24];
    constexpr int R = 2;
    for (int t0 = gw; t0 < T; t0 += R * NGW) {
        f32x4 yv[R][8]; v2u ya[R][8], yc[R][8]; float mu2[R], rs2[R], w0[R], w1[R];
#pragma unroll
        for (int r = 0; r < R; ++r) { const int t = (t0 + r * NGW < T) ? t0 + r * NGW : t0;
            mu2[r] = st2[2 * t]; rs2[r] = st2[2 * t + 1]; w0[r] = gt[2 * t]; w1[r] = gt[2 * t + 1];
            const int p0 = pos[2 * t], p1 = pos[2 * t + 1];
            const GAS f32x4* yr = (const GAS f32x4*)(Y2 + (size_t)t * D) + F.lane;
            const GAS v2u* y0 = (const GAS v2u*)(ys + (size_t)p0 * D) + F.lane; const GAS v2u* y1 = (const GAS v2u*)(ys + (size_t)p1 * D) + F.lane;
#pragma unroll
            for (int j = 0; j < 8; ++j) { yv[r][j] = yr[64 * j]; ya[r][j] = y0[64 * j]; yc[r][j] = y1[64 * j]; } }
#pragma unroll
        for (int r = 0; r < R; ++r) { const int t = t0 + r * NGW; if (t >= T) break;
            f32x4 v[8]; float s = 0.f;
#pragma unroll
            for (int j = 0; j < 8; ++j) { const f32x4 gv = *(const f32x4*)(g2 + 4 * F.lane + 256 * j), bv = *(const f32x4*)(b2 + 4 * F.lane + 256 * j);
                const f32x4 h = (yv[r][j] - mu2[r]) * rs2[r] * gv + bv;
                const v2u a = ya[r][j], c = yc[r][j];
                const f32x4 fa = {bflo(a.x), bfhi(a.x), bflo(a.y), bfhi(a.y)}, fc = {bflo(c.x), bfhi(c.x), bflo(c.y), bfhi(c.y)};
                v[j] = h * ALPHA + fa * w0[r] + fc * w1[r]; s += (v[j][0] + v[j][1]) + (v[j][2] + v[j][3]); }
            const float mean = wave_sum(s) * (1.f / D); float s2 = 0.f;
#pragma unroll
            for (int j = 0; j < 8; ++j) { v[j] = v[j] - mean; s2 += (v[j][0] * v[j][0] + v[j][1] * v[j][1]) + (v[j][2] * v[j][2] + v[j][3] * v[j][3]); }
            const float rstd = 1.f / sqrtf(wave_sum(s2) * (1.f / D) + LN_EPS);
            GAS f32x4* orow = (GAS f32x4*)(F.out + (size_t)t * D) + F.lane;
#pragma unroll
            for (int j = 0; j < 8; ++j) { const f32x4 gv = *(const f32x4*)(g3 + 4 * F.lane + 256 * j), bv = *(const f32x4*)(b3 + 4 * F.lane + 256 * j);
                orow[64 * j] = v[j] * rstd * gv + bv; }
        }
    }
}

constexpr int CS = 128, NB = CS / 64, NS = T / CS;
#define HIDX(t_, c_) ((((size_t)((c_) >> 8)) * 8192 + (size_t)(t_)) * 256 + ((c_) & 255))
constexpr size_t WS_BCUM = WS_ORAW;
constexpr size_t WS_KVR = WS_ORAW + 16 * MiB;
constexpr size_t WS_KVG = WS_KVR + 32 * MiB;
typedef short bf16x8_t __attribute__((ext_vector_type(8)));
typedef short s16x4_t __attribute__((ext_vector_type(4)));
__device__ __forceinline__ s16x4_t lds_tr(const LAS unsigned char* p) { return __builtin_bit_cast(s16x4_t, __builtin_amdgcn_ds_read_tr16_b64_v4i16((LAS s16x4_t*)p)); }
__device__ __forceinline__ bf16x8_t frag_tr(const LAS unsigned char* X, int pitch, int k0, int n0, int lane) {
    const int fq = lane >> 4, q = (lane >> 2) & 3, p = lane & 3;
    const LAS unsigned char* a = X + ((k0 + 8 * fq + q) * pitch + n0 + 4 * p) * 2;
    const s16x4_t lo = lds_tr(a), hi = lds_tr(a + 4 * pitch * 2);
    return __builtin_shufflevector(lo, hi, 0, 1, 2, 3, 4, 5, 6, 7);
}
__device__ __forceinline__ bf16x8_t frag_row(const LAS unsigned char* X, int pitch, int r0, int k0, int lane) {
    return *(const LAS bf16x8_t*)(X + ((r0 + (lane & 15)) * pitch + k0 + 8 * (lane >> 4)) * 2);
}
#define MFMA16(a, b, c) __builtin_amdgcn_mfma_f32_16x16x32_bf16((a), (b), (c), 0, 0, 0)
__device__ __forceinline__ float fexp(float x) { return __builtin_amdgcn_exp2f(x * 1.4426950408889634f); }
__device__ __forceinline__ float silu_g(float g) { return g * __builtin_amdgcn_rcpf(1.0f + __builtin_amdgcn_exp2f(-1.4426950408889634f * g)); }

__device__ __forceinline__ void bcum_item(Frame& F, int s, int h) {
    const int c = F.tid & 127, tq = F.tid >> 7;
    LAS float* tot = (LAS float*)F.lds;
    LAS float* gl = (LAS float*)(F.lds + 2048);
    const float* glr = WSP(float, WS_GLR); float* bc = WSP(float, WS_BCUM);
    __syncthreads();
    *(LAS f32x4*)(gl + 4 * F.tid) = *(const GAS f32x4*)(glr + (size_t)s * CS * 16 + 4 * F.tid);
    float w[16];
#pragma unroll
    for (int r = 0; r < 16; ++r) w[r] = F.in[4][r * 512 + h * 128 + c];
    const float bias = F.in[5][h * 128 + c];
    __syncthreads();
    float vals[32]; float run = 0.f;
    const int tb = s * CS + tq * 32;
#pragma unroll
    for (int i = 0; i < 32; ++i) { const LAS float* gr = gl + (tq * 32 + i) * 16; float z = bias;
#pragma unroll
        for (int r = 0; r < 16; ++r) z += gr[r] * w[r];
        run += log_sigmoid_f(z) * 0.0625f; vals[i] = run; }
    tot[tq * 128 + c] = run;
    __syncthreads();
    float off = 0.f;
#pragma unroll
    for (int q = 0; q < 3; ++q) off += (q < tq) ? tot[q * 128 + c] : 0.f;
#pragma unroll
    for (int i = 0; i < 32; ++i) bc[(size_t)(tb + i) * 512 + h * 128 + c] = vals[i] + off;
}
__device__ __forceinline__ void p1_bcum(Frame& F, int first, int stride) { for (int it = first; it < NS * 4; it += stride) bcum_item(F, it >> 2, it & 3); __syncthreads(); }

__device__ __forceinline__ void unit_sh(int u, int& s, int& h8) { s = (u >> 3) & (NS - 1); h8 = ((u & 7) + 4 * (u >> 8)) & 7; }

template <bool GLA, int MODE>
__device__ __forceinline__ void stage_qk(Frame& F, LAS unsigned char* dst, int s, int jb, int hh, int col0, float lg2gamma) {
    constexpr int DK = GLA ? 128 : 256, PK = DK + 8, CPR = DK / 8, NIT = 64 * CPR / NTHR;
    const bf16* H = WSP(bf16, WS_H); const float* bc = WSP(float, WS_BCUM);
    v4u wv[NIT]; f32x4 b0[GLA ? NIT : 1], b1[GLA ? NIT : 1], l0[(GLA && MODE == 2) ? NIT : 1], l1[(GLA && MODE == 2) ? NIT : 1];
#pragma unroll
    for (int it = 0; it < NIT; ++it) {
        const int ch = F.tid + NTHR * it, r = ch / CPR, cc = ch % CPR, t = s * CS + jb * 64 + r;
        wv[it] = *(const GAS v4u*)(H + HIDX(t, col0 + 8 * cc));
        if (GLA) { b0[it] = *(const GAS f32x4*)(bc + (size_t)t * 512 + hh * 128 + 8 * cc); b1[it] = *(const GAS f32x4*)(bc + (size_t)t * 512 + hh * 128 + 8 * cc + 4);
            if (MODE == 2) { const size_t tl_ = (size_t)(s * CS + CS - 1) * 512 + hh * 128 + 8 * cc; l0[it] = *(const GAS f32x4*)(bc + tl_); l1[it] = *(const GAS f32x4*)(bc + tl_ + 4); } }
    }
#pragma unroll
    for (int it = 0; it < NIT; ++it) {
        const int ch = F.tid + NTHR * it, r = ch / CPR, cc = ch % CPR, tl = jb * 64 + r;
        const v4u w = wv[it];
        float f[8] = {bflo(w.x), bfhi(w.x), bflo(w.y), bfhi(w.y), bflo(w.z), bfhi(w.z), bflo(w.w), bfhi(w.w)};
        if (GLA) {
            float e[8] = {b0[it][0], b0[it][1], b0[it][2], b0[it][3], b1[it][0], b1[it][1], b1[it][2], b1[it][3]};
            if (MODE == 2) { const float l[8] = {l0[it][0], l0[it][1], l0[it][2], l0[it][3], l1[it][0], l1[it][1], l1[it][2], l1[it][3]};
#pragma unroll
                for (int i = 0; i < 8; ++i) e[i] = l[i] - e[i]; }
            else if (MODE == 1) {
#pragma unroll
                for (int i = 0; i < 8; ++i) e[i] = -e[i]; }
#pragma unroll
            for (int i = 0; i < 8; ++i) f[i] *= fexp(e[i]);
        } else {
            const float ex = MODE == 0 ? (float)(tl + 1) : MODE == 1 ? -(float)(tl + 1) : (float)(CS - 1 - tl);
            const float fac = __builtin_amdgcn_exp2f(ex * lg2gamma);
#pragma unroll
            for (int i = 0; i < 8; ++i) f[i] *= fac;
        }
        v4u o; o.x = pk2(f[0], f[1]); o.y = pk2(f[2], f[3]); o.z = pk2(f[4], f[5]); o.w = pk2(f[6], f[7]);
        *(LAS v4u*)(dst + (r * PK + 8 * cc) * 2) = o;
    }
}
__device__ __forceinline__ void stage_v(Frame& F, LAS unsigned char* dst, int s, int jb, int col0) {
    const bf16* H = WSP(bf16, WS_H);
    v4u wv[4];
#pragma unroll
    for (int it = 0; it < 4; ++it) { const int ch = F.tid + NTHR * it, r = ch >> 5, cc = ch & 31, t = s * CS + jb * 64 + r; wv[it] = *(const GAS v4u*)(H + HIDX(t, col0 + 8 * cc)); }
#pragma unroll
    for (int it = 0; it < 4; ++it) { const int ch = F.tid + NTHR * it, r = ch >> 5, cc = ch & 31; *(LAS v4u*)(dst + (r * 264 + 8 * cc) * 2) = wv[it]; }
}

template <bool GLA>
__device__ __forceinline__ void kv_unit(Frame& F, int s, int hh) {
    constexpr int DK = GLA ? 128 : 256, PK = DK + 8, NDT = DK / 16;
    LAS unsigned char* Ks = F.lds; LAS unsigned char* Vs = F.lds + 34816;
    const int kcol = GLA ? 4608 + hh * 128 : 1024 + hh * 256, vcol = (GLA ? 5120 : 2048) + hh * 256;
    const float lg2g = log2f(1.0f - exp2f(-5.0f - (float)hh));
    f32x4 acc[2][NDT];
#pragma unroll
    for (int a = 0; a < 2; ++a)
#pragma unroll
        for (int d = 0; d < NDT; ++d) acc[a][d] = (f32x4){0.f, 0.f, 0.f, 0.f};
    for (int jb = 0; jb < NB; ++jb) {
        __syncthreads();
        stage_qk<GLA, 2>(F, Ks, s, jb, hh, kcol, lg2g);
        stage_v(F, Vs, s, jb, vcol);
        __syncthreads();
#pragma unroll
        for (int ks = 0; ks < 2; ++ks) {
            bf16x8_t vf[2];
#pragma unroll
            for (int et = 0; et < 2; ++et) vf[et] = frag_tr(Vs, 264, 32 * ks, 32 * F.wave + 16 * et, F.lane);
#pragma unroll
            for (int dt = 0; dt < NDT; ++dt) { const bf16x8_t kf = frag_tr(Ks, PK, 32 * ks, 16 * dt, F.lane);
#pragma unroll
                for (int et = 0; et < 2; ++et) acc[et][dt] = MFMA16(kf, vf[et], acc[et][dt]); }
        }
    }
    bf16* kv = GLA ? (WSP(bf16, WS_KVG) + (size_t)(s * 4 + hh) * 256 * 128) : (WSP(bf16, WS_KVR) + (size_t)(s * 4 + hh) * 256 * 256);
    const int fr = F.lane & 15, fq = F.lane >> 4;
#pragma unroll
    for (int et = 0; et < 2; ++et)
#pragma unroll
        for (int dt = 0; dt < NDT; ++dt) { v2u w; w.x = pk2(acc[et][dt][0], acc[et][dt][1]); w.y = pk2(acc[et][dt][2], acc[et][dt][3]);
            *(GAS v2u*)(kv + (size_t)(32 * F.wave + 16 * et + fr) * DK + 16 * dt + 4 * fq) = w; }
}
__device__ __forceinline__ void p2_kv(Frame& F) {
    for (int u = F.bid; u < 8 * NS; u += F.G) { int s, h8; unit_sh(u, s, h8);
        if (s == NS - 1) continue;
        if (h8 < 4) kv_unit<false>(F, s, h8); else kv_unit<true>(F, s, h8 - 4); }
    __syncthreads();
}
__device__ __forceinline__ void p3_scan(Frame& F) {
    constexpr int NR = 4 * 256 * 64, NG = 4 * 256 * 32, NITEM = NR + NG;
    const float* bc = WSP(float, WS_BCUM);
    const int per = (NITEM + F.G - 1) / F.G;
    for (int k0 = F.tid; k0 < per; k0 += NTHR) {
      const int it = F.bid * per + k0;
      if (it < NITEM) {
        const bool gla = it >= NR; const int r = gla ? it - NR : it;
        const int sh = gla ? 5 : 6, dk = gla ? 128 : 256;
        const int cc = r & ((1 << sh) - 1), e = (r >> sh) & 255, hh = r >> (sh + 8);
        bf16* base = (gla ? WSP(bf16, WS_KVG) : WSP(bf16, WS_KVR)) + ((size_t)hh * 256 + e) * dk + 4 * cc;
        const size_t sstride = (size_t)4 * 256 * dk;
        const float dret = __builtin_amdgcn_exp2f((float)CS * log2f(1.0f - exp2f(-5.0f - (float)hh)));
        float S[4] = {0.f, 0.f, 0.f, 0.f};
#pragma unroll 16
        for (int s = 0; s < NS - 1; ++s) {
            GAS v2u* p = (GAS v2u*)(base + (size_t)s * sstride);
            const v2u w = *p;
            v2u o; o.x = pk2(S[0], S[1]); o.y = pk2(S[2], S[3]);
            *p = o;
            const float f[4] = {bflo(w.x), bfhi(w.x), bflo(w.y), bfhi(w.y)};
            float dec[4] = {dret, dret, dret, dret};
            if (gla) { const f32x4 l0 = *(const GAS f32x4*)(bc + (size_t)(s * CS + CS - 1) * 512 + hh * 128 + 4 * cc);
                dec[0] = fexp(l0[0]); dec[1] = fexp(l0[1]); dec[2] = fexp(l0[2]); dec[3] = fexp(l0[3]); }
#pragma unroll
            for (int i = 0; i < 4; ++i) S[i] = dec[i] * S[i] + f[i];
        }
        { GAS v2u* p = (GAS v2u*)(base + (size_t)(NS - 1) * sstride); v2u o; o.x = pk2(S[0], S[1]); o.y = pk2(S[2], S[3]); *p = o; }
      }
    }
}
template <bool GLA>
__device__ __forceinline__ void out_unit(Frame& F, int s, int hh) {
    constexpr int DK = GLA ? 128 : 256, PK = DK + 8, NKS = DK / 32;
    LAS unsigned char* Qs = F.lds; LAS unsigned char* Ks = F.lds + 33792; LAS unsigned char* Vs = F.lds + 67584; LAS unsigned char* Ps = F.lds + 101376;
    LAS float* red = (LAS float*)(F.lds + 110592);
    const int qcol = GLA ? 4096 + hh * 128 : hh * 256, kcol = GLA ? 4608 + hh * 128 : 1024 + hh * 256, vcol = (GLA ? 5120 : 2048) + hh * 256;
    const int gcol = (GLA ? 6144 : 3072) + hh * 256, ocol = (GLA ? 1024 : 0) + hh * 256;
    const float lg2g = log2f(1.0f - exp2f(-5.0f - (float)hh));
    const bf16* H = WSP(bf16, WS_H); bf16* mixed = WSP(bf16, WS_MIXED);
    const bf16* st = GLA ? (WSP(bf16, WS_KVG) + (size_t)(s * 4 + hh) * 256 * 128) : (WSP(bf16, WS_KVR) + (size_t)(s * 4 + hh) * 256 * 256);
    const int fr = F.lane & 15, fq = F.lane >> 4, w = F.wave, mt = w >> 1, nt0 = 2 * (w & 1);
    static_assert(NB == 2, "the step program below is written for two 64-token sub-blocks");
    f32x4 accO[4][2]; bf16x8_t sfa[NKS][2]; v2u gpre[4][2];
#pragma unroll 1
    for (int step = 0; step < 3; ++step) {
        const int i = step > 0 ? 1 : 0, j = step > 1 ? 1 : 0;
        {
            __syncthreads();
            if (step < 2) stage_qk<GLA, 0>(F, Qs, s, i, hh, qcol, lg2g);
            if (step != 1) { stage_qk<GLA, 1>(F, Ks, s, j, hh, kcol, lg2g); stage_v(F, Vs, s, j, vcol); }
            if (step < 2) {
#pragma unroll
                for (int m = 0; m < 4; ++m)
#pragma unroll
                    for (int n = 0; n < 2; ++n) accO[m][n] = (f32x4){0.f, 0.f, 0.f, 0.f};
            }
            if (step != 1) {
                if (s > 0) {
#pragma unroll
                    for (int ks = 0; ks < NKS; ++ks)
#pragma unroll
                        for (int n = 0; n < 2; ++n) sfa[ks][n] = *(const GAS bf16x8_t*)(st + (size_t)(32 * w + 16 * n + fr) * DK + 32 * ks + 8 * fq);
                }
#pragma unroll
                for (int m2 = 0; m2 < 4; ++m2)
#pragma unroll
                    for (int n = 0; n < 2; ++n) gpre[m2][n] = *(const GAS v2u*)(H + HIDX(s * CS + i * 64 + 16 * m2 + fr, gcol + 32 * w + 16 * n + 4 * fq));
            }
            __syncthreads();
            f32x4 accS[2] = {(f32x4){0.f, 0.f, 0.f, 0.f}, (f32x4){0.f, 0.f, 0.f, 0.f}};
#pragma unroll
            for (int ks = 0; ks < NKS; ++ks) { const bf16x8_t qf = frag_row(Qs, PK, 16 * mt, 32 * ks, F.lane);
#pragma unroll
                for (int n2 = 0; n2 < 2; ++n2) { const bf16x8_t kf = frag_row(Ks, PK, 16 * (nt0 + n2), 32 * ks, F.lane); accS[n2] = MFMA16(kf, qf, accS[n2]); } }
#pragma unroll
            for (int n2 = 0; n2 < 2; ++n2) { const int row = 16 * mt + fr, c0 = 16 * (nt0 + n2) + 4 * fq; float pv[4];
#pragma unroll
                for (int jj = 0; jj < 4; ++jj) pv[jj] = (i == j && c0 + jj > row) ? 0.f : accS[n2][jj];
                v2u pw; pw.x = pk2(pv[0], pv[1]); pw.y = pk2(pv[2], pv[3]);
                *(LAS v2u*)(Ps + (row * 72 + c0) * 2) = pw; }
            __syncthreads();
#pragma unroll
            for (int ks = 0; ks < 2; ++ks) {
                bf16x8_t vf[2];
#pragma unroll
                for (int n = 0; n < 2; ++n) vf[n] = frag_tr(Vs, 264, 32 * ks, 32 * w + 16 * n, F.lane);
#pragma unroll
                for (int m = 0; m < 4; ++m) { const bf16x8_t pf = frag_row(Ps, 72, 16 * m, 32 * ks, F.lane);
#pragma unroll
                    for (int n = 0; n < 2; ++n) accO[m][n] = MFMA16(vf[n], pf, accO[m][n]); }
            }
        }
        if (step == 1) continue;
        if (s > 0) {
#pragma unroll
            for (int ks = 0; ks < NKS; ++ks) {
#pragma unroll
                for (int m = 0; m < 4; ++m) { const bf16x8_t qf = frag_row(Qs, PK, 16 * m, 32 * ks, F.lane);
#pragma unroll
                    for (int n = 0; n < 2; ++n) accO[m][n] = MFMA16(sfa[ks][n], qf, accO[m][n]); }
            }
        }
#pragma unroll
        for (int m = 0; m < 4; ++m) { float s1 = 0.f, s2 = 0.f;
#pragma unroll
            for (int n = 0; n < 2; ++n)
#pragma unroll
                for (int jj = 0; jj < 4; ++jj) { const float v = accO[m][n][jj]; s1 += v; s2 += v * v; }
            s1 += __shfl_xor(s1, 16); s1 += __shfl_xor(s1, 32); s2 += __shfl_xor(s2, 16); s2 += __shfl_xor(s2, 32);
            if (fq == 0) { red[(w * 64 + 16 * m + fr) * 2] = s1; red[(w * 64 + 16 * m + fr) * 2 + 1] = s2; } }
        __syncthreads();
#pragma unroll
        for (int m = 0; m < 4; ++m) { const int row = 16 * m + fr; float s1 = 0.f, s2 = 0.f;
#pragma unroll
            for (int ww = 0; ww < 8; ++ww) { s1 += red[(ww * 64 + row) * 2]; s2 += red[(ww * 64 + row) * 2 + 1]; }
            const float mean = s1 * (1.f / 256.f), ex2 = s2 * (1.f / 256.f);
            const float mu = GLA ? 0.f : mean, var = GLA ? ex2 : fmaxf(ex2 - mean * mean, 0.f);
            const float rstd = 1.0f / sqrtf(var + LN_EPS);
            const int t = s * CS + i * 64 + row;
#pragma unroll
            for (int n = 0; n < 2; ++n) { const int e = 32 * w + 16 * n + 4 * fq;
                const v2u gw2 = gpre[m][n];
                const float gt[4] = {bflo(gw2.x), bfhi(gw2.x), bflo(gw2.y), bfhi(gw2.y)};
                f32x4 gn = {1.f, 1.f, 1.f, 1.f}; if (GLA) gn = *(const f32x4*)(F.in[6] + e);
                float r4[4];
#pragma unroll
                for (int jj = 0; jj < 4; ++jj) { const float y = (accO[m][n][jj] - mu) * rstd * gn[jj]; r4[jj] = silu_g(gt[jj]) * y; }
                v2u ow; ow.x = pk2(r4[0], r4[1]); ow.y = pk2(r4[2], r4[3]);
                *(GAS v2u*)(mixed + (size_t)t * D + ocol + e) = ow; } }
    }
}
__device__ __forceinline__ void p4_out(Frame& F) {
    for (int u = F.bid; u < 8 * NS; u += F.G) { int s, h8; unit_sh(u, s, h8);
        if (h8 < 4) out_unit<false>(F, s, h8); else out_unit<true>(F, s, h8 - 4); }
    __syncthreads();
}

__device__ __forceinline__ void kv_chunk_load(Frame& F, v4u (&R)[8], const bf16* src  ) {
#pragma unroll
    for (int it = 0; it < 8; ++it) { const int ch = F.tid + NTHR * it, r = ch >> 4, cc = ch & 15; R[it] = *(const GAS v4u*)(src + (size_t)r * 4096 + 8 * cc); }
}
__device__ __forceinline__ void kv_chunk_store(Frame& F, const v4u (&R)[8], LAS unsigned char* dst) {
#pragma unroll
    for (int it = 0; it < 8; ++it) { const int ch = F.tid + NTHR * it, r = ch >> 4, cc = ch & 15; *(LAS v4u*)(dst + (r * 136 + 8 * cc) * 2) = R[it]; }
}
__device__ __forceinline__ void p8_attn(Frame& F) {
    const bf16* Q = WSP(bf16, WS_QB); const bf16* KVM = WSP(bf16, WS_KVM); bf16* att = WSP(bf16, WS_ATT);
    constexpr int CB = 256 * 136 * 2;
    const int fr = F.lane & 15, fq = F.lane >> 4, q4 = (F.lane >> 2) & 3, p4 = F.lane & 3;
    for (int u = F.bid; u < (T / 128) * 4; u += F.G) {
        const int h = u & 3, r0 = (u >> 2) * 128 + 16 * F.wave;
        v4u R[8];
        __syncthreads();
        kv_chunk_load(F, R, KVM + h * 512); kv_chunk_store(F, R, F.lds);
        __syncthreads();
        f32x4 accS[16];
#pragma unroll
        for (int i = 0; i < 16; ++i) accS[i] = (f32x4){0.f, 0.f, 0.f, 0.f};
#pragma unroll 1
        for (int dc = 0; dc < 4; ++dc) {
            kv_chunk_load(F, R, dc < 3 ? KVM + h * 512 + (dc + 1) * 128 : KVM + 2048 + h * 512);
            const LAS unsigned char* Cs = F.lds + (dc & 1) * CB;
            bf16x8_t qf[4];
#pragma unroll
            for (int ks = 0; ks < 4; ++ks) qf[ks] = *(const GAS bf16x8_t*)(Q + (size_t)(r0 + fr) * D + h * 512 + dc * 128 + 32 * ks + 8 * fq);
#pragma unroll
            for (int ks = 0; ks < 4; ++ks)
#pragma unroll
                for (int nt = 0; nt < 16; ++nt) accS[nt] = MFMA16(frag_row(Cs, 136, 16 * nt, 32 * ks, F.lane), qf[ks], accS[nt]);
            kv_chunk_store(F, R, F.lds + ((dc + 1) & 1) * CB);
            __syncthreads();
        }
        float mx = -3.0e38f;
#pragma unroll
        for (int nt = 0; nt < 16; ++nt)
#pragma unroll
            for (int jj = 0; jj < 4; ++jj) mx = fmaxf(mx, accS[nt][jj]);
        mx = fmaxf(mx, __shfl_xor(mx, 16)); mx = fmaxf(mx, __shfl_xor(mx, 32));
        const float sl2 = 0.04419417382415922f * 1.4426950408889634f;
        float sm = 0.f;
#pragma unroll
        for (int nt = 0; nt < 16; ++nt)
#pragma unroll
            for (int jj = 0; jj < 4; ++jj) { const float p = __builtin_amdgcn_exp2f((accS[nt][jj] - mx) * sl2); accS[nt][jj] = p; sm += p; }
        sm += __shfl_xor(sm, 16); sm += __shfl_xor(sm, 32);
        const float inv = 1.0f / sm;
        bf16x8_t pf[8];
#pragma unroll
        for (int ks2 = 0; ks2 < 8; ++ks2) { v4u w; w.x = pk2(accS[2 * ks2][0] * inv, accS[2 * ks2][1] * inv); w.y = pk2(accS[2 * ks2][2] * inv, accS[2 * ks2][3] * inv);
            w.z = pk2(accS[2 * ks2 + 1][0] * inv, accS[2 * ks2 + 1][1] * inv); w.w = pk2(accS[2 * ks2 + 1][2] * inv, accS[2 * ks2 + 1][3] * inv); pf[ks2] = __builtin_bit_cast(bf16x8_t, w); }
#pragma unroll 1
        for (int ec = 0; ec < 4; ++ec) {
            if (ec < 3) kv_chunk_load(F, R, KVM + 2048 + h * 512 + (ec + 1) * 128);
            const LAS unsigned char* Cs = F.lds + (ec & 1) * CB;
            f32x4 accO[8];
#pragma unroll
            for (int i = 0; i < 8; ++i) accO[i] = (f32x4){0.f, 0.f, 0.f, 0.f};
#pragma unroll
            for (int ks2 = 0; ks2 < 8; ++ks2)
#pragma unroll
                for (int et = 0; et < 8; ++et) { const LAS unsigned char* a = Cs + ((32 * ks2 + 4 * fq + q4) * 136 + 16 * et + 4 * p4) * 2;
                    const s16x4_t lo = lds_tr(a), hi = lds_tr(a + 16 * 136 * 2);
                    accO[et] = MFMA16(__builtin_shufflevector(lo, hi, 0, 1, 2, 3, 4, 5, 6, 7), pf[ks2], accO[et]); }
#pragma unroll
            for (int et = 0; et < 8; ++et) { v2u w; w.x = pk2(accO[et][0], accO[et][1]); w.y = pk2(accO[et][2], accO[et][3]);
                *(GAS v2u*)(att + (size_t)(r0 + fr) * D + h * 512 + ec * 128 + 16 * et + 4 * fq) = w; }
            if (ec < 3) kv_chunk_store(F, R, F.lds + ((ec + 1) & 1) * CB);
            __syncthreads();
        }
    }
}

__device__ __forceinline__ void p10_ln_router(Frame& F) {
    const float* Y = WSP(float, WS_Y2); const float* g = F.in[14]; const float* b = F.in[15]; bf16* HB = WSP(bf16, WS_H2B); float* st = WSP(float, WS_ST2);
    const float* Wg = F.in[16]; const float* We = F.in[18];
    LAS float* stl = (LAS float*)F.lds;
    LAS float* part = (LAS float*)(F.lds + 1024);
    LAS int* lcnt = (LAS int*)(F.lds + 1024 + 24576);
    LAS int* lbase = lcnt + 32;
    if (F.tid < 32) lcnt[F.tid] = 0;
    { int* tok = WSP(int, WS_TOK); for (int i = F.bid * NTHR + F.tid; i < PMAX; i += F.G * NTHR) tok[i] = 0; }
    __syncthreads();
    const int fr = F.lane & 15, fq = F.lane >> 4;
    for (int item = F.bid; item < T / 32; item += F.G) {
        const int row0 = item * 32;
#pragma unroll
        for (int i = 0; i < 4; ++i) {
            const int t = row0 + 4 * F.wave + i;
            const GAS f32x4* yr = (const GAS f32x4*)(Y + (size_t)t * D) + F.lane;
            f32x4 v[8]; float s = 0.f;
#pragma unroll
            for (int j = 0; j < 8; ++j) { v[j] = yr[64 * j]; s += (v[j][0] + v[j][1]) + (v[j][2] + v[j][3]); }
            const float mean = wave_sum(s) * (1.f / D); float s2 = 0.f;
#pragma unroll
            for (int j = 0; j < 8; ++j) { v[j] = v[j] - mean; s2 += (v[j][0] * v[j][0] + v[j][1] * v[j][1]) + (v[j][2] * v[j][2] + v[j][3] * v[j][3]); }
            const float rstd = 1.f / sqrtf(wave_sum(s2) * (1.f / D) + LN_EPS);
            if (F.lane == 0) { st[2 * t] = mean; st[2 * t + 1] = rstd; stl[2 * (4 * F.wave + i)] = mean; stl[2 * (4 * F.wave + i) + 1] = rstd; }
            GAS v2u* o8 = (GAS v2u*)(HB + (size_t)t * D) + F.lane;
#pragma unroll
            for (int j = 0; j < 8; ++j) { const f32x4 gv = *(const f32x4*)(g + 4 * F.lane + 256 * j), bv = *(const f32x4*)(b + 4 * F.lane + 256 * j);
                const f32x4 hv = v[j] * rstd * gv + bv;
                v2u w; w.x = pk2(hv[0], hv[1]); w.y = pk2(hv[2], hv[3]); o8[64 * j] = w; }
        }
        __syncthreads();
        {
            const int rt = F.wave >> 2, kq = F.wave & 3;
            const int r = row0 + 16 * rt + fr;
            const float mu = stl[2 * (16 * rt + fr)], rstd = stl[2 * (16 * rt + fr) + 1];
            f32x4 acc0 = {0.f, 0.f, 0.f, 0.f}, acc1 = acc0, acc2 = acc0;
            const float* yp = Y + (size_t)r * D + 512 * kq + 4 * fq;
            const float* wep = We + (size_t)(512 * kq + 4 * fq) * 32 + fr;
            const float* wgp = Wg + (size_t)(512 * kq + 4 * fq) * 4 + (fr & 3);
            const float gm = fr < 4 ? 1.f : 0.f;
#pragma unroll 8
            for (int it = 0; it < 32; ++it) {
                const int k0 = 16 * it;
                const f32x4 y4 = *(const GAS f32x4*)(yp + k0), g4 = *(const f32x4*)(g + 512 * kq + 4 * fq + k0), b4 = *(const f32x4*)(b + 512 * kq + 4 * fq + k0);
                const f32x4 a = (y4 - mu) * rstd * g4 + b4;
#pragma unroll
                for (int s = 0; s < 4; ++s) {
                    const float b0 = wep[(size_t)(k0 + s) * 32], b1 = wep[(size_t)(k0 + s) * 32 + 16], b2 = wgp[(size_t)(k0 + s) * 4] * gm;
                    acc0 = __builtin_amdgcn_mfma_f32_16x16x4f32(a[s], b0, acc0, 0, 0, 0);
                    acc1 = __builtin_amdgcn_mfma_f32_16x16x4f32(a[s], b1, acc1, 0, 0, 0);
                    acc2 = __builtin_amdgcn_mfma_f32_16x16x4f32(a[s], b2, acc2, 0, 0, 0);
                }
            }
            LAS float* pw = part + F.wave * 768;
#pragma unroll
            for (int jj = 0; jj < 4; ++jj) { pw[(4 * fq + jj) * 48 + fr] = acc0[jj]; pw[(4 * fq + jj) * 48 + 16 + fr] = acc1[jj]; pw[(4 * fq + jj) * 48 + 32 + fr] = acc2[jj]; }
        }
        __syncthreads();
        int e1 = 0, e2 = 0, r1 = 0, r2 = 0; float g1 = 0.f, g2 = 0.f;
        if (F.tid < 32) {
            const int rt = F.tid >> 4, rr = F.tid & 15;
            float le[32], lg[4];
#pragma unroll
            for (int c = 0; c < 32; ++c) { float s = 0.f;
#pragma unroll
                for (int kq = 0; kq < 4; ++kq) s += part[(rt * 4 + kq) * 768 + rr * 48 + c]; le[c] = s; }
#pragma unroll
            for (int c = 0; c < 4; ++c) { float s = 0.f;
#pragma unroll
                for (int kq = 0; kq < 4; ++kq) s += part[(rt * 4 + kq) * 768 + rr * 48 + 32 + c]; lg[c] = s + F.in[17][c]; }
            int grp = 0; float gmx = lg[0];
#pragma unroll
            for (int i = 1; i < 4; ++i) if (lg[i] > gmx) { gmx = lg[i]; grp = i; }
            float gs = 0.f;
#pragma unroll
            for (int i = 0; i < 4; ++i) gs += expf(lg[i] - gmx);
            const float pg_sel = 1.0f / gs;
            float fe[8];
#pragma unroll
            for (int j = 0; j < 8; ++j) { const float a = grp == 0 ? le[j] : grp == 1 ? le[8 + j] : grp == 2 ? le[16 + j] : le[24 + j]; fe[j] = a + F.in[19][grp * 8 + j]; }
            int i1 = 0; float m1 = fe[0];
#pragma unroll
            for (int j = 1; j < 8; ++j) if (fe[j] > m1) { m1 = fe[j]; i1 = j; }
            int i2 = -1; float m2 = -3.0e38f;
#pragma unroll
            for (int j = 0; j < 8; ++j) if (j != i1 && fe[j] > m2) { m2 = fe[j]; i2 = j; }
            const float p2 = expf(m2 - m1), den = 1.0f / (1.0f + p2);
            e1 = grp * 8 + i1; e2 = grp * 8 + i2; g1 = pg_sel * den; g2 = pg_sel * p2 * den;
            r1 = __hip_atomic_fetch_add((int*)(lcnt + e1), 1, __ATOMIC_RELAXED, __HIP_MEMORY_SCOPE_WORKGROUP); r2 = __hip_atomic_fetch_add((int*)(lcnt + e2), 1, __ATOMIC_RELAXED, __HIP_MEMORY_SCOPE_WORKGROUP);
        }
        __syncthreads();
        if (F.tid < 32) { const int c = lcnt[F.tid];
            lbase[F.tid] = c ? (int)__hip_atomic_fetch_add((unsigned*)(F.ctl + CW_CUR) + F.tid, (unsigned)c, __ATOMIC_RELAXED, __HIP_MEMORY_SCOPE_AGENT) : 0; }
        __syncthreads();
        if (F.tid < 32) {
            const int t = row0 + F.tid;
            int* ex = WSP(int, WS_EXP); float* gt = WSP(float, WS_GATE); int* sl = WSP(int, WS_SLOT);
            ex[2 * t] = e1; ex[2 * t + 1] = e2; gt[2 * t] = g1; gt[2 * t + 1] = g2;
            sl[2 * t] = lbase[e1] + r1; sl[2 * t + 1] = lbase[e2] + r2;
            lcnt[F.tid] = 0;
        }
        __syncthreads();
    }
}


#define XB_TMO      128
#define XB_XCNT(j)  (256  + 64 * (j))
#define XB_XSUB(j)  (1280 + 64 * (j))
#define XB_XGEN(j)  (2304 + 64 * (j))
#define XB_TOP      3328
#define XB_TOPGEN   3392
#define XCD_BAR_WORDS 3456
#define XB_SPIN_CAP (1u << 22)
__device__ __forceinline__ unsigned xb_ld(unsigned* p)              { return __hip_atomic_load(p, __ATOMIC_RELAXED, __HIP_MEMORY_SCOPE_AGENT); }
__device__ __forceinline__ unsigned xb_add(unsigned* p, unsigned v) { return __hip_atomic_fetch_add(p, v, __ATOMIC_RELAXED, __HIP_MEMORY_SCOPE_AGENT); }
__device__ __forceinline__ unsigned xb_xcc_id() { return (unsigned)__builtin_amdgcn_s_getreg((3 << 11) | 20) & 0xFu; }
#define XB_SPIN(cond, bar) do { unsigned _sp = 0; while (cond) { __builtin_amdgcn_s_sleep(1); \
    if ((++_sp & 255u) == 0u) { if (xb_ld(&(bar)[XB_TMO])) break; if (_sp > XB_SPIN_CAP) { atomicAdd(&(bar)[XB_TMO], 1u); break; } } } } while (0)
struct XcdBarrier { unsigned* bar; unsigned x; volatile LAS unsigned* st; };
__device__ __forceinline__ XcdBarrier xcd_barrier_post(unsigned* bar, volatile LAS unsigned* st) {
    XcdBarrier b; b.bar = bar; b.x = xb_xcc_id(); b.st = st;
    if (threadIdx.x == 0) (void)xb_add(&bar[XB_XCNT(b.x)], 1u);
    return b;
}
__device__ __forceinline__ void xcd_barrier_complete(unsigned* bar, unsigned x, unsigned& nloc, unsigned& nx) {
    const unsigned G = gridDim.x * gridDim.y * gridDim.z;
    unsigned sum, cnt, mine, sp = 0u;
    for (;;) {
        sum = 0u; cnt = 0u; mine = 0u;
#pragma unroll
        for (unsigned j = 0; j < 16; ++j) { const unsigned c = xb_ld(&bar[XB_XCNT(j)]); sum += c; cnt += (c > 0u) ? 1u : 0u; mine = (j == x) ? c : mine; }
        if (sum == G) break;
        __builtin_amdgcn_s_sleep(1);
        if ((++sp & 255u) == 0u) { if (xb_ld(&bar[XB_TMO])) break; if (sp > XB_SPIN_CAP) { atomicAdd(&bar[XB_TMO], 1u); break; } }
    }
    nloc = mine > 0u ? mine : 1u; nx = cnt > 0u ? cnt : 1u;
}
__device__ __forceinline__ void xcd_barrier(const XcdBarrier& b) {
    asm volatile("s_waitcnt vmcnt(0)" ::: "memory");
    __syncthreads();
    if (threadIdx.x == 0) {
        unsigned* bar = b.bar;
        __builtin_amdgcn_s_waitcnt(0);
        unsigned nloc = b.st[0], nx = b.st[1];
        if (nloc == 0u) { xcd_barrier_complete(bar, b.x, nloc, nx); b.st[0] = nloc; b.st[1] = nx; }
        const unsigned old = xb_add(&bar[XB_XSUB(b.x)], 1u);
        const unsigned gen = old / nloc;
        if (old + 1u == (gen + 1u) * nloc) {
            __builtin_amdgcn_fence(__ATOMIC_RELEASE, "agent");
            asm volatile("s_waitcnt vmcnt(0)" ::: "memory");
            const unsigned og = xb_add(&bar[XB_TOP], 1u);
            const unsigned tg = og / nx;
            if (og + 1u == (tg + 1u) * nx) xb_add(&bar[XB_TOPGEN], 1u);
            else XB_SPIN(xb_ld(&bar[XB_TOPGEN]) == tg, bar);
            __builtin_amdgcn_fence(__ATOMIC_ACQUIRE, "agent");
            xb_add(&bar[XB_XGEN(b.x)], 1u);
            asm volatile("s_waitcnt vmcnt(0)" ::: "memory");
        } else {
            XB_SPIN(xb_ld(&bar[XB_XGEN(b.x)]) == gen, bar);
            __builtin_amdgcn_fence(__ATOMIC_ACQUIRE, "agent");
            asm volatile("s_waitcnt vmcnt(0)" ::: "memory");
        }
    }
    __syncthreads();
}

struct Args { const float* in[25]; float* out; unsigned char* ws; int ph_lo, ph_hi, use_bar, pad; };
__global__ void __launch_bounds__(NTHR, 2) mega(Args args) {
    extern __shared__ __attribute__((aligned(16))) unsigned char lds[];
    Frame F;
    F.lds = (LAS unsigned char*)lds;
    F.MISC = (volatile LAS unsigned*)(F.lds + MISC_OFF);
    F.tid = threadIdx.x; F.lane = F.tid & 63; F.wave = __builtin_amdgcn_readfirstlane(F.tid >> 6);
    F.G = gridDim.x; F.bid = blockIdx.x;
    F.ws = args.ws; F.ctl = (gu32*)(args.ws + WS_CTL);
#pragma unroll
    for (int i = 0; i < 25; ++i) F.in[i] = args.in[i];
    F.out = args.out;
    for (int u = F.tid; u < (LDS_BYTES - LDSCTL_OFF) / 4; u += NTHR) ((LAS unsigned*)(F.lds + LDSCTL_OFF))[u] = 0u;
    __syncthreads();
    LAS int* ts = (LAS int*)(F.lds + MISC_OFF + 64);
    XcdBarrier bar; bar.bar = (unsigned*)(F.ctl + CW_BAR); bar.x = 0; bar.st = nullptr;
    if (args.use_bar) bar = xcd_barrier_post((unsigned*)(F.ctl + CW_BAR), F.MISC + 8);
    const int lo = args.ph_lo, hi = args.ph_hi;
#if PROBE_T >= 0
    unsigned long long pt0 = __builtin_amdgcn_s_memrealtime(), pdelay = 0ull;
#endif
#if MK_CG_SYNC == 2
    if (args.use_bar == 2) cooperative_groups::this_grid().sync();
#endif
#define IN(k) (lo <= (k) && (k) < hi)
#if PROBE_T >= 0
#define PROBE_STAMP(k) do { if ((k) == PROBE_T) pdelay = __builtin_amdgcn_s_memrealtime() - pt0; } while (0)
#else
#define PROBE_STAMP(k) do { } while (0)
#endif
#define REPS(k) for (int _r = 0; _r < ((k) == PROBE_PH ? PROBE_N : 1); ++_r)
#define SEAM(k) do { if (IN(k) && IN((k) + 1)) { if (MK_CG_SYNC == 1 && (k) == 0) cooperative_groups::this_grid().sync(); else { xcd_barrier(bar); if (PROBE_PH == 100) for (int _b = 1; _b < PROBE_N; ++_b) xcd_barrier(bar); } PROBE_STAMP(k); } } while (0)

    if (IN(0)) { REPS(0) p0_prologue(F); SEAM(0); }
    if (IN(1)) {
        p1_bcum(F, F.bid, F.G);
        const int g8 = F.bid >> 3, nsb = (g8 * NSG) >> 5; const bool streamer = (F.G == 256) && ((((g8 + 1) * NSG) >> 5) != nsb);
        if (!streamer) {
            pg8::Gemm g{WSP(pg8::bf16_t, WS_XB), WSP(pg8::bf16_t, WS_WIN), T + MEMN, HW + 4096, D}; pg8::OrderG1 S;
            if (F.G == 256) S.init(F.G - 8 * NSG, F.bid - 8 * nsb); else S.init(F.G, F.bid);
            pg8::EpiH E{WSP(pg8::bf16_t, WS_H), WSP(pg8::bf16_t, WS_KVM), WSP(float, WS_RC), WSP(float, WS_RS)};
            pg8::gemm_phase<pg8::EpiH, pg8::OrderG1, true, true>(F.lds, g, S, E);
        }
        transpose_queue(F);
        if (PROBE_PH == 102) for (int _q = 1; _q < PROBE_N; ++_q) transpose_queue(F, _q);
        SEAM(1);
    }
#if PROBE_PH == 101
    if (IN(1)) {
        pg8::Gemm g{WSP(pg8::bf16_t, WS_XB), WSP(pg8::bf16_t, WS_WIN), T + MEMN, HW + 4096, D}; pg8::OrderG1 S; S.init(F.G, F.bid);
        pg8::EpiH E{WSP(pg8::bf16_t, WS_H), WSP(pg8::bf16_t, WS_KVM), WSP(float, WS_RC), WSP(float, WS_RS)};
        pg8::gemm_phase<pg8::EpiH, pg8::OrderG1, true, true>(F.lds, g, S, E);
        xcd_barrier(bar);
    }
#endif
    if (IN(2)) { REPS(2) p2_kv(F); SEAM(2); }
    if (IN(3)) { p3_scan(F); SEAM(3); }
#if PROBE_PH == 103
    if (IN(3)) { p2_kv(F); xcd_barrier(bar); p3_scan(F); xcd_barrier(bar); }
#endif
    if (IN(4)) { REPS(4) p4_out(F); SEAM(4); }
    if (IN(5)) {
        pg8::Gemm g{WSP(pg8::bf16_t, WS_MIXED), WSP(pg8::bf16_t, WS_WMIX), T, D, D}; pg8::StaticOrder S; S.init(T, D, F.G, F.bid);
        pg8::EpiResX E{F.in[0], WSP(float, WS_Y1), ALPHA};
        REPS(5) pg8::gemm_phase<pg8::EpiResX, pg8::StaticOrder, true, true>(F.lds, g, S, E);
        SEAM(5);
    }
    if (IN(6)) { REPS(6) ln_apply_plain(F, WSP(float, WS_Y1), F.in[8], F.in[9], WSP(bf16, WS_H1B), WSP(float, WS_ST1)); SEAM(6); }
    if (IN(7)) {
        pg8::Gemm g{WSP(pg8::bf16_t, WS_H1B), WSP(pg8::bf16_t, WS_WMQ), T, D, D}; pg8::StaticOrder S; S.init(T, D, F.G, F.bid);
        pg8::EpiB E{WSP(pg8::bf16_t, WS_QB), D, -1, 8192u * 2048u * 2u};
        REPS(7) pg8::gemm_phase<pg8::EpiB, pg8::StaticOrder, true, true>(F.lds, g, S, E);
        SEAM(7);
    }
    if (IN(8)) { REPS(8) p8_attn(F); SEAM(8); }
    if (IN(9)) {
        pg8::Gemm g{WSP(pg8::bf16_t, WS_ATT), WSP(pg8::bf16_t, WS_WMO), T, D, D}; pg8::StaticOrder S; S.init(T, D, F.G, F.bid);
        pg8::EpiResLN E{WSP(float, WS_Y1), WSP(float, WS_ST1), F.in[8], F.in[9], WSP(float, WS_Y2), ALPHA};
        REPS(9) pg8::gemm_phase<pg8::EpiResLN, pg8::StaticOrder, true, true>(F.lds, g, S, E);
        SEAM(9);
    }
    if (IN(10)) { p10_ln_router(F); SEAM(10); }
    if (IN(11)) { moe_tile_starts(F, ts); p10_dispatch(F, ts); SEAM(11); }
#if MK_MOE_F32
#define MOE_GEMM_GU(l, g, S, E) pg8::gemm_phase_bf32<pg8::EpiSwi, pg8::MoeOrder, true, true, true>(l, g, S, E)
#define MOE_GEMM_DN(l, g, S, E) pg8::gemm_phase_bf32<pg8::EpiB, pg8::MoeOrder, true, false, false>(l, g, S, E)
#else
#define MOE_GEMM_GU(l, g, S, E) pg8::gemm_phase<pg8::EpiSwi, pg8::MoeOrder, true, true, true>(l, g, S, E)
#define MOE_GEMM_DN(l, g, S, E) pg8::gemm_phase<pg8::EpiB, pg8::MoeOrder, true, true>(l, g, S, E)
#endif
    if (IN(12)) {
        moe_tile_starts(F, ts);
        const int U = ts[32] * 4;
        pg8::Gemm g{WSP(pg8::bf16_t, WS_H2B), WSP(pg8::bf16_t, WS_WGU), PMAX, 32 * 1024, D, WSP(int, WS_TOK)};
        pg8::MoeOrder S{(const PG8_LAS int*)ts, F.G, F.bid, 4, U < F.G ? U : F.G, F.in[20], F.in[21], 2048, 512, 0};
        pg8::EpiSwi E{WSP(pg8::bf16_t, WS_HID)};
        MOE_GEMM_GU(F.lds, g, S, E);
        SEAM(12);
    }
    if (IN(13)) {
        moe_tile_starts(F, ts);
        const int RT = ts[32], U = RT * 4, nbg = U > F.G ? U - F.G : 0, R1 = (F.G / 4) < RT ? (F.G / 4) : RT;
        {
            pg8::Gemm g{WSP(pg8::bf16_t, WS_H2B), WSP(pg8::bf16_t, WS_WGU), PMAX, 32 * 1024, D, WSP(int, WS_TOK)};
            pg8::MoeOrder S{(const PG8_LAS int*)ts, F.G, F.bid, 4, U, F.in[20], F.in[21], 2048, 512, F.G};
            pg8::EpiSwi E{WSP(pg8::bf16_t, WS_HID)};
            MOE_GEMM_GU(F.lds, g, S, E);
        }
        {
            pg8::Gemm g{WSP(pg8::bf16_t, WS_HID), WSP(pg8::bf16_t, WS_WD), PMAX, 32 * 2048, 512};
            pg8::MoeOrder S{(const PG8_LAS int*)ts, F.G - nbg, F.bid >= nbg ? F.bid - nbg : -1, 8, R1 * 8, F.in[22], nullptr, 512, 2048, 0};
            pg8::EpiB E{WSP(pg8::bf16_t, WS_YS), D, 7, 24576u * 2048u * 2u};
            MOE_GEMM_DN(F.lds, g, S, E);
        }
        SEAM(13);
    }
    if (IN(14)) {
        moe_tile_starts(F, ts);
        const int RT = ts[32], R1 = (F.G / 4) < RT ? (F.G / 4) : RT;
        pg8::Gemm g{WSP(pg8::bf16_t, WS_HID), WSP(pg8::bf16_t, WS_WD), PMAX, 32 * 2048, 512};
        pg8::MoeOrder S{(const PG8_LAS int*)ts, F.G, F.bid, 8, RT * 8, F.in[22], nullptr, 512, 2048, R1 * 8};
        pg8::EpiB E{WSP(pg8::bf16_t, WS_YS), D, 7, 24576u * 2048u * 2u};
        MOE_GEMM_DN(F.lds, g, S, E);
        SEAM(14);
    }
    if (IN(15)) { REPS(15) p13_combine(F); }
#if PROBE_T >= 0
    if (F.bid == 0 && F.tid == 0) { const unsigned long long te = __builtin_amdgcn_s_memrealtime(); while (__builtin_amdgcn_s_memrealtime() - te < pdelay) __builtin_amdgcn_s_sleep(8); }
#endif
#undef IN
#undef SEAM
#undef REPS
}

extern "C" void kernel_launch(void* const* d_in, const int* in_sizes, int n_in, void* d_out, int out_size, void* d_ws, size_t ws_size, hipStream_t stream) {
    static int grid = 0;
    if (grid == 0) {
        if (n_in != 25 || in_sizes[0] != T * D || out_size != T * D || ws_size < WS_END) { fprintf(stderr, "kernel_launch: unexpected shapes / workspace (%d inputs, ws %zu)\n", n_in, ws_size); grid = -1; return; }
        int dev = 0, cus = 0;
        if (hipGetDevice(&dev) != hipSuccess || hipDeviceGetAttribute(&cus, hipDeviceAttributeMultiprocessorCount, dev) != hipSuccess) { grid = -1; return; }
        if (hipFuncSetAttribute((const void*)mega, hipFuncAttributeMaxDynamicSharedMemorySize, LDS_BYTES) != hipSuccess) { fprintf(stderr, "kernel_launch: hipFuncSetAttribute failed\n"); grid = -1; return; }
        int per_cu = 0;
        if (hipOccupancyMaxActiveBlocksPerMultiprocessor(&per_cu, (const void*)mega, NTHR, LDS_BYTES) != hipSuccess || per_cu < 1) { fprintf(stderr, "kernel_launch: occupancy query failed / 0 blocks per CU\n"); grid = -1; return; }
        (void)hipGetLastError();
        grid = cus;
    }
    if (grid < 0) return;
    if (hipMemsetAsync((char*)d_ws + WS_CTL, 0, CTL_ZERO_BYTES, stream) != hipSuccess) return;
    Args a{};
    for (int i = 0; i < 25; ++i) a.in[i] = (const float*)d_in[i];
    a.out = (float*)d_out; a.ws = (unsigned char*)d_ws;
#if MK_ONE_LAUNCH
    a.ph_lo = 0; a.ph_hi = NPH; a.use_bar = 1;
#if MK_CG_SYNC
    { void* kargs[] = {(void*)&a};
      hipError_t e = hipLaunchCooperativeKernel((const void*)mega, dim3(grid), dim3(NTHR), kargs, LDS_BYTES, stream);
      if (e != hipSuccess) fprintf(stderr, "cooperative launch failed: %s (grid %d)\n", hipGetErrorString(e), grid); }
#else
    hipLaunchKernelGGL(mega, dim3(grid), dim3(NTHR), LDS_BYTES, stream, a);
#endif
#else
    for (int p = 0; p < NPH; ++p) { a.ph_lo = p; a.ph_hi = p + 1; a.use_bar = 0;
        hipLaunchKernelGGL(mega, dim3(grid), dim3(NTHR), LDS_BYTES, stream, a); }
#endif
}
```

```cpp
#include <hip/hip_runtime.h>
#include <hip/hip_cooperative_groups.h>
#include <cstdio>
#include <cstdint>
#include <cmath>
#ifndef MK_ONE_LAUNCH
#define MK_ONE_LAUNCH 1
#endif
#ifndef MK_CG_SYNC
#define MK_CG_SYNC 2
#endif
#ifndef MK_WT_STORES
#define MK_WT_STORES 0
#endif
#ifndef MK_MOE_F32
#define MK_MOE_F32 0
#endif
#define PROBE_PH -1
#define PROBE_N 1
#define PROBE_T -1
namespace pg8 {
#define PG8_LAS __attribute__((address_space(3)))
typedef unsigned short bf16_t;
typedef short bf16x8 __attribute__((ext_vector_type(8)));
typedef float f32x4 __attribute__((ext_vector_type(4)));
typedef unsigned u32x4 __attribute__((ext_vector_type(4)));
constexpr int BM = 256, BK = 64, HALF = 128, HTB = HALF * BK * 2  , STAGE_BYTES = 8 * HTB, NXCD = 8, WGM = 8;

__host__ __device__ __forceinline__ int lds_byte(int r, int c) { const int st = (r >> 4) * 2 + (c >> 5), rr = r & 15, cc = c & 31, ob = rr * 64 + cc * 2; return st * 1024 + (ob ^ (((ob >> 9) & 1) << 5)); }
__host__ __device__ __forceinline__ void stage_rc(int b, int& R, int& C) { const int st = b / 1024, sb = b % 1024, swz = sb ^ (((sb >> 9) & 1) << 5); R = (st >> 1) * 16 + swz / 64; C = (st & 1) * 32 + (swz % 64) / 2; }
__host__ __device__ __forceinline__ int perm32(int rho) { const int n = rho >> 4, i = rho & 15; return 8 * (i >> 2) + 4 * n + (i & 3); }

struct Unit { int pm, pn; };
struct Gemm { const bf16_t* A; const bf16_t* Bt; int M, N, K; const int* tok; };

struct StaticOrder {
    int nM, nN, nwg, G, c;
    __host__ __device__ void init(int M, int N, int G_, int c_) { nM = M / BM; nN = N / BM; nwg = nM * nN; G = G_; c = c_; }
    __host__ __device__ bool next(int i, Unit& u) const {
        const long L = (long)i * G + c; if (L >= nwg) return false;
        int wgid = (int)L; { const int q = nwg / NXCD, r = nwg % NXCD, xcd = wgid % NXCD, off = wgid / NXCD; wgid = (xcd < r ? xcd * (q + 1) : r * (q + 1) + (xcd - r) * q) + off; }
        const int nig = WGM * nN, gid = wgid / nig, fm = gid * WGM, gsz = (nM - fm) < WGM ? (nM - fm) : WGM;
        u.pm = fm + ((wgid % nig) % gsz); u.pn = (wgid % nig) / gsz; return true;
    }
    __device__ __forceinline__ void a_ready(const Unit&) const {}
    __device__ __forceinline__ void done(const Unit&) const {}
};


typedef unsigned u32x2 __attribute__((ext_vector_type(2)));
__device__ __forceinline__ unsigned cvt_pk_bf16(float lo, float hi) { unsigned r; asm volatile("v_cvt_pk_bf16_f32 %0, %1, %2" : "=v"(r) : "v"(lo), "v"(hi)); return r; }
__device__ __forceinline__ u32x4 pack8(const f32x4 a, const f32x4 b) { u32x4 w; w.x = cvt_pk_bf16(a[0], a[1]); w.y = cvt_pk_bf16(a[2], a[3]); w.z = cvt_pk_bf16(b[0], b[1]); w.w = cvt_pk_bf16(b[2], b[3]); return w; }
#if MK_WT_STORES
#define PG8_RSRC(base, bytes) __builtin_amdgcn_make_buffer_rsrc((void*)(base), 0, (int)(bytes), 0x00020000)
#define PG8_ST16(rs, base, byteoff, val) __builtin_amdgcn_raw_buffer_store_b128(__builtin_bit_cast(u32x4, (val)), (rs), (unsigned)(byteoff), 0, 16)
#else
#define PG8_RSRC(base, bytes) 0
#define PG8_ST16(rs, base, byteoff, val) (*(u32x4*)((char*)(base) + (size_t)(byteoff)) = __builtin_bit_cast(u32x4, (val)))
#endif
__device__ __forceinline__ float silu_f(float x) { return x * __builtin_amdgcn_rcpf(1.0f + __builtin_amdgcn_exp2f(-1.4426950408889634f * x)); }

struct EpiH {
    static constexpr bool PERM = true, AFTER_DRAIN = false;
    bf16_t* H; bf16_t* KVM; const float* rc; const float* rs;
    __device__ __forceinline__ void operator()(const f32x4 (&acc)[2][2][4][2], const Unit& u, int wr, int wc, int fr, int fq) const {
        const int cb = wc * 32 + 8 * fq;
        const auto rsH = PG8_RSRC(H, 8192u * 7168u * 2u); (void)rsH;
        if (u.pm >= 32) {
#pragma unroll
            for (int ai = 0; ai < 2; ++ai)
#pragma unroll
                for (int m = 0; m < 4; ++m) { bf16_t* rowp = KVM + (size_t)(wr * 64 + fr + ai * HALF + m * 16) * 4096 + (u.pn - 28) * BM + cb;
#pragma unroll
                    for (int bj = 0; bj < 2; ++bj) *(u32x4*)(rowp + bj * HALF) = pack8(acc[ai][bj][m][0], acc[ai][bj][m][1]); }
            return;
        }
        const int row0 = u.pm * BM + wr * 64 + fr;
        if (u.pn < 8) {
            const float sc = u.pn >= 4 ? 0.0625f : 1.0f;
#pragma unroll
            for (int ai = 0; ai < 2; ++ai)
#pragma unroll
                for (int m = 0; m < 4; ++m) { const int row = row0 + ai * HALF + m * 16;
                    const float* cr = rc + (size_t)row * 128 + cb; const float* sr = rs + (size_t)row * 128 + cb;
                    const f32x4 c0 = *(const f32x4*)cr * sc, c1 = *(const f32x4*)(cr + 4) * sc, s0 = *(const f32x4*)sr * sc, s1 = *(const f32x4*)(sr + 4) * sc;
                    const f32x4 t1a = acc[ai][0][m][0], t1b = acc[ai][0][m][1], t2a = acc[ai][1][m][0], t2b = acc[ai][1][m][1];
                    const unsigned bo = (unsigned)(((size_t)u.pn * 8192 + row) * BM + cb) * 2u;
                    PG8_ST16(rsH, H, bo, pack8(t1a * c0 - t2a * s0, t1b * c1 - t2b * s1));
                    PG8_ST16(rsH, H, bo + 2 * HALF, pack8(t1a * s0 + t2a * c0, t1b * s1 + t2b * c1)); }
        } else {
            const float sc = (u.pn == 16 || u.pn == 17) ? 0.08838834764831845f : 1.0f;
#pragma unroll
            for (int ai = 0; ai < 2; ++ai)
#pragma unroll
                for (int m = 0; m < 4; ++m) { const unsigned bo = (unsigned)(((size_t)u.pn * 8192 + row0 + ai * HALF + m * 16) * BM + cb) * 2u;
#pragma unroll
                    for (int bj = 0; bj < 2; ++bj) PG8_ST16(rsH, H, bo + bj * 2 * HALF, pack8(acc[ai][bj][m][0] * sc, acc[ai][bj][m][1] * sc)); }
        }
    }
};
struct EpiB {
    static constexpr bool PERM = true, AFTER_DRAIN = false;
    bf16_t* O; int ldc; int pmask; unsigned obytes;
    __device__ __forceinline__ void operator()(const f32x4 (&acc)[2][2][4][2], const Unit& u, int wr, int wc, int fr, int fq) const {
        const int row0 = u.pm * BM + wr * 64 + fr, col0 = (u.pn & pmask) * BM + wc * 32 + 8 * fq;
        const auto rsO = PG8_RSRC(O, obytes); (void)rsO;
#pragma unroll
        for (int ai = 0; ai < 2; ++ai)
#pragma unroll
            for (int m = 0; m < 4; ++m) { const unsigned bo = (unsigned)((size_t)(row0 + ai * HALF + m * 16) * ldc + col0) * 2u;
#pragma unroll
                for (int bj = 0; bj < 2; ++bj) PG8_ST16(rsO, O, bo + bj * 2 * HALF, pack8(acc[ai][bj][m][0], acc[ai][bj][m][1])); }
    }
};
struct EpiSwi {
    static constexpr bool PERM = true, AFTER_DRAIN = false;
    bf16_t* O;
    __device__ __forceinline__ void operator()(const f32x4 (&acc)[2][2][4][2], const Unit& u, int wr, int wc, int fr, int fq) const {
        const int row0 = u.pm * BM + wr * 64 + fr, col0 = (u.pn & 3) * HALF + wc * 32 + 8 * fq;
        const auto rsO = PG8_RSRC(O, 24576u * 512u * 2u); (void)rsO;
#pragma unroll
        for (int ai = 0; ai < 2; ++ai)
#pragma unroll
            for (int m = 0; m < 4; ++m) { const unsigned bo = (unsigned)((size_t)(row0 + ai * HALF + m * 16) * 512 + col0) * 2u;
                f32x4 h0, h1;
#pragma unroll
                for (int i = 0; i < 4; ++i) { h0[i] = silu_f(acc[ai][0][m][0][i]) * acc[ai][1][m][0][i]; h1[i] = silu_f(acc[ai][0][m][1][i]) * acc[ai][1][m][1][i]; }
                PG8_ST16(rsO, O, bo, pack8(h0, h1)); }
    }
};
struct EpiResX {
    static constexpr bool PERM = false, AFTER_DRAIN = false;
    const float* X; float* Y; float alpha;
    __device__ __forceinline__ void operator()(const f32x4 (&acc)[2][2][4][2], const Unit& u, int wr, int wc, int fr, int fq) const {
        const int row0 = u.pm * BM + wr * 64 + fr, col0 = u.pn * BM + wc * 32 + 4 * fq;
        const auto rsY = PG8_RSRC(Y, 8192u * 2048u * 4u); (void)rsY;
#pragma unroll
        for (int ai = 0; ai < 2; ++ai)
#pragma unroll
            for (int m = 0; m < 4; ++m) { const size_t off = (size_t)(row0 + ai * HALF + m * 16) * 2048 + col0;
#pragma unroll
                for (int bj = 0; bj < 2; ++bj)
#pragma unroll
                    for (int n = 0; n < 2; ++n) { const f32x4 xv = *(const f32x4*)(X + off + bj * HALF + n * 16); const f32x4 yv = xv * alpha + acc[ai][bj][m][n]; PG8_ST16(rsY, Y, (off + bj * HALF + n * 16) * 4, yv); } }
    }
};
struct EpiResLN {
    static constexpr bool PERM = false, AFTER_DRAIN = false;
    const float* Yin; const float* st; const float* g; const float* b; float* Y; float alpha;
    __device__ __forceinline__ void operator()(const f32x4 (&acc)[2][2][4][2], const Unit& u, int wr, int wc, int fr, int fq) const {
        const int row0 = u.pm * BM + wr * 64 + fr, col0 = u.pn * BM + wc * 32 + 4 * fq;
        const auto rsY = PG8_RSRC(Y, 8192u * 2048u * 4u); (void)rsY;
        f32x4 gv[2][2], bv[2][2];
#pragma unroll
        for (int bj = 0; bj < 2; ++bj)
#pragma unroll
            for (int n = 0; n < 2; ++n) { gv[bj][n] = *(const f32x4*)(g + col0 + bj * HALF + n * 16) * alpha; bv[bj][n] = *(const f32x4*)(b + col0 + bj * HALF + n * 16) * alpha; }
#pragma unroll
        for (int ai = 0; ai < 2; ++ai)
#pragma unroll
            for (int m = 0; m < 4; ++m) { const int row = row0 + ai * HALF + m * 16; const size_t off = (size_t)row * 2048 + col0;
                const float mu = st[2 * row], rstd = st[2 * row + 1];
#pragma unroll
                for (int bj = 0; bj < 2; ++bj)
#pragma unroll
                    for (int n = 0; n < 2; ++n) { const f32x4 yv = *(const f32x4*)(Yin + off + bj * HALF + n * 16);
                        const f32x4 yo = ((yv - mu) * rstd) * gv[bj][n] + bv[bj][n] + acc[ai][bj][m][n]; PG8_ST16(rsY, Y, (off + bj * HALF + n * 16) * 4, yo); } }
    }
};

struct OrderG1 {
    StaticOrder so; int G, c;
    __device__ void init(int G_, int c_) { so.init(8192, 7168, G_, c_); G = G_; c = c_; }
    __device__ bool next(int i, Unit& u) const {
        const int L = i * G + c;
        if (L < 896) return so.next(i, u);
        if (L >= 912) return false;
        u.pm = 32; u.pn = 28 + (L - 896); return true;
    }
    __device__ __forceinline__ void a_ready(const Unit&) const {}
    __device__ __forceinline__ void done(const Unit&) const {}
};
struct MoeOrder {
    const PG8_LAS int* ts; int G, c, npn, total; const float* W0; const float* W1; int kdim, ncols; int L0;
    __device__ bool next(int i, Unit& u) const {
        if (c < 0) return false;
        const int L = L0 + i * G + c; if (L >= total) return false;
        const int rt = L / npn, pl = L - rt * npn; int e = 0;
        for (int j = 1; j < 32; ++j) e += (ts[j] <= rt) ? 1 : 0;
        u.pm = rt; u.pn = e * npn + pl; return true;
    }
    __device__ __forceinline__ int ldb() const { return ncols; }
    __device__ __forceinline__ const float* bbase(const Unit& u, int which) const {
        const int e = u.pn / npn, pl = u.pn - e * npn; const size_t eo = (size_t)e * kdim * ncols;
        if (W1) return (which ? W1 : W0) + eo + 128 * pl;
        return W0 + eo + 256 * pl;
    }
    __device__ __forceinline__ void a_ready(const Unit&) const {}
    __device__ __forceinline__ void done(const Unit&) const {}
};

template <int MODE>
struct EpiLN {
    static constexpr bool PERM = false, AFTER_DRAIN = true;
    const float* X; const float* stin; const float* gin; const float* bin;
    float* Yout; float* stout; bf16_t* HB; const float* g; const float* b;
    unsigned long long* xbuf;
    unsigned* cnt;
    __device__ __forceinline__ void operator()(const f32x4 (&)[2][2][4][2], const Unit&, int, int, int, int) const {}
    __device__ __forceinline__ void fused(f32x4 (&acc)[2][2][4][2], const Unit& u, int wr, int wc, int fr, int fq, PG8_LAS unsigned char* lds, int wid, int lane) const {
        typedef float f32x2v __attribute__((ext_vector_type(2)));
        PG8_LAS f32x2v* P = (PG8_LAS f32x2v*)lds;
        PG8_LAS f32x2v* MS = (PG8_LAS f32x2v*)(lds + 8192);
        const int row0 = u.pm * BM + wr * 64 + fr, col0 = u.pn * BM + wc * 32 + 4 * fq;
        float s1[2][4], s2[2][4], mu[2][4], rs[2][4];
#pragma unroll
        for (int ai = 0; ai < 2; ++ai)
#pragma unroll
            for (int m = 0; m < 4; ++m) { s1[ai][m] = 0.f; s2[ai][m] = 0.f; mu[ai][m] = 0.f; rs[ai][m] = 0.f;
                if (MODE == 1) { const int row = row0 + ai * HALF + m * 16; mu[ai][m] = stin[2 * row]; rs[ai][m] = stin[2 * row + 1]; } }
#pragma unroll
        for (int bj = 0; bj < 2; ++bj)
#pragma unroll
            for (int n = 0; n < 2; ++n) {
                f32x4 gvv = {0.f, 0.f, 0.f, 0.f}, bvv = gvv;
                if (MODE == 1) { gvv = *(const f32x4*)(gin + col0 + bj * HALF + n * 16) * 1.189207115002721f; bvv = *(const f32x4*)(bin + col0 + bj * HALF + n * 16) * 1.189207115002721f; }
#pragma unroll
                for (int ai = 0; ai < 2; ++ai)
#pragma unroll
                    for (int m = 0; m < 4; ++m) { const size_t off = (size_t)(row0 + ai * HALF + m * 16) * 2048 + col0 + bj * HALF + n * 16;
                        const f32x4 xv = *(const f32x4*)(X + off);
                        const f32x4 y = (MODE == 1 ? ((xv - mu[ai][m]) * rs[ai][m]) * gvv + bvv : xv * 1.189207115002721f) + acc[ai][bj][m][n];
                        acc[ai][bj][m][n] = y; *(f32x4*)(Yout + off) = y;
                        s1[ai][m] += (y[0] + y[1]) + (y[2] + y[3]); s2[ai][m] += (y[0] * y[0] + y[1] * y[1]) + (y[2] * y[2] + y[3] * y[3]); }
            }
#pragma unroll
        for (int ai = 0; ai < 2; ++ai)
#pragma unroll
            for (int m = 0; m < 4; ++m) { float a1 = s1[ai][m], a2 = s2[ai][m];
                a1 += __shfl_xor(a1, 16); a1 += __shfl_xor(a1, 32); a2 += __shfl_xor(a2, 16); a2 += __shfl_xor(a2, 32);
                if (fq == 0) P[(ai * HALF + wr * 64 + m * 16 + fr) * 4 + wc] = (f32x2v){a1, a2}; }
        asm volatile("s_waitcnt lgkmcnt(0)" ::: "memory"); __builtin_amdgcn_s_barrier(); asm volatile("" ::: "memory");
        const int t = wid * 64 + lane;
        if (t < 256) { const f32x2v a = P[t * 4 + 0], b2 = P[t * 4 + 1], c = P[t * 4 + 2], d = P[t * 4 + 3];
            const float S1 = (a.x + b2.x) + (c.x + d.x), S2 = (a.y + b2.y) + (c.y + d.y);
            __hip_atomic_store(xbuf + ((size_t)(u.pm * 8 + u.pn) * 256 + t), ((unsigned long long)__float_as_uint(S2) << 32) | __float_as_uint(S1), __ATOMIC_RELAXED, __HIP_MEMORY_SCOPE_AGENT);
            asm volatile("s_waitcnt vmcnt(0)" ::: "memory");
            if (lane == 0) __hip_atomic_fetch_add(cnt + 64 * u.pm, 1u, __ATOMIC_RELAXED, __HIP_MEMORY_SCOPE_AGENT); }
        if (wid == 0) {
            const unsigned long long t0 = __builtin_amdgcn_s_memrealtime();
            while ((unsigned)__builtin_amdgcn_readfirstlane(__hip_atomic_load(cnt + 64 * u.pm, __ATOMIC_RELAXED, __HIP_MEMORY_SCOPE_AGENT)) < 32u) {
                if (__builtin_amdgcn_s_memrealtime() - t0 > 2000000ull) break;
                __builtin_amdgcn_s_sleep(2); }
            __builtin_amdgcn_fence(__ATOMIC_ACQUIRE, "agent");
        }
        asm volatile("s_waitcnt vmcnt(0) lgkmcnt(0)" ::: "memory"); __builtin_amdgcn_s_barrier(); asm volatile("" ::: "memory");
        if (t < 256) { float S1 = 0.f, S2 = 0.f;
#pragma unroll
            for (int j = 0; j < 8; ++j) { const unsigned long long w = __hip_atomic_load(xbuf + ((size_t)(u.pm * 8 + j) * 256 + t), __ATOMIC_RELAXED, __HIP_MEMORY_SCOPE_AGENT); S1 += __uint_as_float((unsigned)w); S2 += __uint_as_float((unsigned)(w >> 32)); }
            const float mean = S1 * (1.f / 2048.f), var = fmaxf(S2 * (1.f / 2048.f) - mean * mean, 0.f), rstd = 1.0f / sqrtf(var + 1e-5f);
            MS[t] = (f32x2v){mean, rstd};
            if (u.pn == 0) { stout[2 * (u.pm * BM + t)] = mean; stout[2 * (u.pm * BM + t) + 1] = rstd; } }
        asm volatile("s_waitcnt lgkmcnt(0)" ::: "memory"); __builtin_amdgcn_s_barrier(); asm volatile("" ::: "memory");
#pragma unroll
        for (int bj = 0; bj < 2; ++bj)
#pragma unroll
            for (int n = 0; n < 2; ++n) { const f32x4 gN = *(const f32x4*)(g + col0 + bj * HALF + n * 16), bN = *(const f32x4*)(b + col0 + bj * HALF + n * 16);
#pragma unroll
                for (int ai = 0; ai < 2; ++ai)
#pragma unroll
                    for (int m = 0; m < 4; ++m) { const int rl = ai * HALF + wr * 64 + m * 16 + fr; const f32x2v ms = MS[rl]; const size_t off = (size_t)(u.pm * BM + rl) * 2048 + col0 + bj * HALF + n * 16;
                        const f32x4 h = ((acc[ai][bj][m][n] - ms.x) * ms.y) * gN + bN;
                        u32x2 w; w.x = cvt_pk_bf16(h[0], h[1]); w.y = cvt_pk_bf16(h[2], h[3]); *(u32x2*)(HB + off) = w; } }
    }
};
template <class Epi, class Sched, bool ALIGN_EPI = false, bool SP2 = false, bool GATHER = false>
__device__ __forceinline__ void gemm_phase(PG8_LAS unsigned char* lds, const Gemm g, const Sched& S, const Epi& E) {
    const int tid = threadIdx.x, wid = __builtin_amdgcn_readfirstlane(tid >> 6), lane = tid & 63, wr = wid >> 2, wc = wid & 3, fr = lane & 15, fq = lane >> 4;
    const int K = g.K, nt = K / BK;
    unsigned voffA[2], voffB[2];
#pragma unroll
    for (int i = 0; i < 2; ++i) { int R, C; stage_rc(tid * 16 + i * 8192, R, C); const int Rb = Epi::PERM ? ((R & ~31) + perm32(R & 31)) : R;
        voffA[i] = (unsigned)(R * K + C) * 2u; voffB[i] = (unsigned)(Rb * K + C) * 2u; }
    unsigned coff[2][2], noff[2][2]; int gR[2], gC[2];
#pragma unroll
    for (int i = 0; i < 2; ++i) { int R, C; stage_rc(tid * 16 + i * 8192, R, C); gR[i] = R; gC[i] = C; coff[0][i] = coff[1][i] = noff[0][i] = noff[1][i] = 0u; }
#define PG8_GOFF(dst, pm_) do { if constexpr (GATHER) { _Pragma("unroll") for (int _h = 0; _h < 2; ++_h) _Pragma("unroll") for (int _i = 0; _i < 2; ++_i) \
        dst[_h][_i] = ((unsigned)g.tok[(pm_) * BM + _h * HALF + gR[_i]] * (unsigned)K + (unsigned)gC[_i]) * 2u; } } while (0)
    const size_t kstep = (size_t)(BK * 2);
    const size_t hstep = (size_t)HALF * K * 2;
    const size_t tstep = 2 * hstep;
    const unsigned ldsw = (unsigned)wid * 1024u;
    const int aoff = lds_byte(wr * 64 + fr, fq * 8), boff = lds_byte(wc * 32 + fr, fq * 8);
#define PG8_SA(b, h) (((b) * 2 + (h)) * HTB)
#define PG8_SB(b, h) ((4 + (b) * 2 + (h)) * HTB)
#define PG8_STAGE(bufoff, gbase, voff) do { _Pragma("unroll") for (int _i = 0; _i < 2; ++_i) \
        __builtin_amdgcn_global_load_lds((const unsigned*)((const char*)(gbase) + (voff)[_i]), (PG8_LAS unsigned*)(lds + (bufoff) + ldsw + _i * 8192), 16, 0, 0); } while (0)
#define PG8_STAGEA(bufoff, gptr, hh, kbytes, usenext) do { if constexpr (GATHER) { _Pragma("unroll") for (int _i = 0; _i < 2; ++_i) { const unsigned _o = (usenext) ? noff[hh][_i] : coff[hh][_i]; \
        __builtin_amdgcn_global_load_lds((const unsigned*)((const char*)g.A + (size_t)(kbytes) + _o), (PG8_LAS unsigned*)(lds + (bufoff) + ldsw + _i * 8192), 16, 0, 0); } } else { PG8_STAGE(bufoff, gptr, voffA); } } while (0)
#define PG8_LDA(dst, b, h) do { _Pragma("unroll") for (int m = 0; m < 4; ++m) _Pragma("unroll") for (int k = 0; k < 2; ++k) dst[m][k] = *(const PG8_LAS bf16x8*)(lds + PG8_SA(b, h) + aoff + m * 2048 + k * 1024); } while (0)
#define PG8_LDB(dst, b, h) do { _Pragma("unroll") for (int n = 0; n < 2; ++n) _Pragma("unroll") for (int k = 0; k < 2; ++k) dst[n][k] = *(const PG8_LAS bf16x8*)(lds + PG8_SB(b, h) + boff + n * 2048 + k * 1024); } while (0)
#define PG8_MMA(ai, bj, At, Bt) do { __builtin_amdgcn_s_setprio(1); _Pragma("unroll") for (int m = 0; m < 4; ++m) _Pragma("unroll") for (int n = 0; n < 2; ++n) _Pragma("unroll") for (int k = 0; k < 2; ++k) \
        acc[ai][bj][m][n] = __builtin_amdgcn_mfma_f32_16x16x32_bf16(Bt[n][k], At[m][k], acc[ai][bj][m][n], 0, 0, 0); __builtin_amdgcn_s_setprio(0); } while (0)
#define PG8_WAIT_V(n) asm volatile("s_waitcnt vmcnt(" #n ")" ::: "memory")
#define PG8_WAIT_L(n) asm volatile("s_waitcnt lgkmcnt(" #n ")" ::: "memory")
#define PG8_BAR __builtin_amdgcn_s_barrier()
#define PG8_SCHED __builtin_amdgcn_sched_barrier(0)
    Unit cur, nxt; int ui = 0;
    if (!S.next(0, cur)) return;
    f32x4 acc[2][2][4][2];
#pragma unroll
    for (int a = 0; a < 2; ++a)
#pragma unroll
        for (int b = 0; b < 2; ++b)
#pragma unroll
            for (int m = 0; m < 4; ++m)
#pragma unroll
                for (int n = 0; n < 2; ++n) acc[a][b][m][n] = (f32x4){0.f, 0.f, 0.f, 0.f};
    bf16x8 At[4][2], B0[2][2], B1[2][2];
    const char* cA = (const char*)g.A + (size_t)cur.pm * tstep; const char* cB = (const char*)g.Bt + (size_t)cur.pn * tstep;
    PG8_GOFF(coff, cur.pm);
    S.a_ready(cur);
    if constexpr (SP2) {
        PG8_STAGE(PG8_SB(0, 0), cB, voffB); PG8_STAGE(PG8_SB(0, 1), cB + hstep, voffB); PG8_STAGEA(PG8_SA(0, 0), cA, 0, 0, false); PG8_STAGEA(PG8_SA(0, 1), cA + hstep, 1, 0, false);
        if (wr == 1) PG8_BAR;
        PG8_WAIT_V(2); PG8_BAR;
        PG8_STAGE(PG8_SB(1, 0), cB + kstep, voffB); PG8_STAGEA(PG8_SA(1, 0), cA + kstep, 0, kstep, false); PG8_STAGE(PG8_SB(1, 1), cB + hstep + kstep, voffB);
        PG8_WAIT_V(6); PG8_BAR;
    } else {
        PG8_STAGE(PG8_SB(0, 0), cB, voffB); PG8_STAGE(PG8_SA(0, 0), cA, voffA); PG8_STAGE(PG8_SB(0, 1), cB + hstep, voffB); PG8_STAGE(PG8_SA(0, 1), cA + hstep, voffA);
        if (wr == 1) PG8_BAR;
        PG8_WAIT_V(4); PG8_BAR;
        PG8_STAGE(PG8_SB(1, 0), cB + kstep, voffB); PG8_STAGE(PG8_SA(1, 0), cA + kstep, voffA); PG8_STAGE(PG8_SB(1, 1), cB + hstep + kstep, voffB);
        PG8_WAIT_V(6); PG8_BAR;
    }
    for (;;) {
        const bool has_next = S.next(ui + 1, nxt);
        const char* nA = has_next ? (const char*)g.A + (size_t)nxt.pm * tstep : cA; const char* nB = has_next ? (const char*)g.Bt + (size_t)nxt.pn * tstep : cB;
        if constexpr (GATHER) { if (has_next) { PG8_GOFF(noff, nxt.pm); } else { _Pragma("unroll") for (int _h = 0; _h < 2; ++_h) _Pragma("unroll") for (int _i = 0; _i < 2; ++_i) noff[_h][_i] = coff[_h][_i]; } }
        for (int t = 0; t < nt; t += 2) {
            const bool last = (t == nt - 2);
            const char* a1 = cA + (size_t)(t + 1) * kstep;
            const char* a2 = last ? nA : cA + (size_t)(t + 2) * kstep; const char* b2 = last ? nB : cB + (size_t)(t + 2) * kstep;
            const char* a3 = a2 + kstep; const char* b3 = b2 + kstep;
            const size_t k1 = (size_t)(t + 1) * kstep, k2 = last ? 0 : (size_t)(t + 2) * kstep, k3 = k2 + kstep;
            if (last && has_next) S.a_ready(nxt);
            if constexpr (SP2) {
            PG8_LDB(B0, 0, 0); PG8_LDB(B1, 0, 1); PG8_SCHED; PG8_LDA(At, 0, 0); PG8_STAGEA(PG8_SA(1, 1), a1 + hstep, 1, k1, false);
            PG8_WAIT_V(8); PG8_WAIT_L(0); PG8_BAR; PG8_MMA(0, 0, At, B0); PG8_MMA(0, 1, At, B1); PG8_BAR; PG8_SCHED;
            PG8_LDA(At, 0, 1); PG8_STAGE(PG8_SB(0, 0), b2, voffB); PG8_STAGE(PG8_SB(0, 1), b2 + hstep, voffB); PG8_STAGEA(PG8_SA(0, 0), a2, 0, k2, last);
            PG8_WAIT_V(8); PG8_WAIT_L(0); PG8_BAR; PG8_MMA(1, 0, At, B0); PG8_MMA(1, 1, At, B1); PG8_BAR; PG8_SCHED;
            PG8_LDB(B0, 1, 0); PG8_LDB(B1, 1, 1); PG8_SCHED; PG8_LDA(At, 1, 0); PG8_STAGEA(PG8_SA(0, 1), a2 + hstep, 1, k2, last);
            PG8_WAIT_V(8); PG8_WAIT_L(0); PG8_BAR; PG8_MMA(0, 0, At, B0); PG8_MMA(0, 1, At, B1); PG8_BAR; PG8_SCHED;
            PG8_LDA(At, 1, 1); PG8_STAGE(PG8_SB(1, 0), b3, voffB); PG8_STAGE(PG8_SB(1, 1), b3 + hstep, voffB); PG8_STAGEA(PG8_SA(1, 0), a3, 0, k3, last);
            PG8_WAIT_V(8); PG8_WAIT_L(0); PG8_BAR; PG8_MMA(1, 0, At, B0); PG8_MMA(1, 1, At, B1); PG8_BAR; PG8_SCHED;
            } else {
            PG8_LDB(B0, 0, 0); PG8_SCHED; PG8_LDA(At, 0, 0); PG8_STAGE(PG8_SA(1, 1), a1 + hstep, voffA);
            PG8_WAIT_L(8); PG8_BAR; PG8_WAIT_L(0); PG8_MMA(0, 0, At, B0); PG8_BAR; PG8_SCHED;
            PG8_LDB(B1, 0, 1); PG8_STAGE(PG8_SB(0, 0), b2, voffB);
            PG8_BAR; PG8_WAIT_L(0); PG8_MMA(0, 1, At, B1); PG8_BAR;
            PG8_LDA(At, 0, 1); PG8_STAGE(PG8_SA(0, 0), a2, voffA);
            PG8_BAR; PG8_WAIT_L(0); PG8_MMA(1, 0, At, B0); PG8_BAR; PG8_SCHED;
            PG8_STAGE(PG8_SB(0, 1), b2 + hstep, voffB);
            PG8_WAIT_V(6); PG8_BAR; PG8_MMA(1, 1, At, B1); PG8_BAR;
            PG8_LDB(B0, 1, 0); PG8_SCHED; PG8_LDA(At, 1, 0); PG8_STAGE(PG8_SA(0, 1), a2 + hstep, voffA);
            PG8_WAIT_L(8); PG8_BAR; PG8_WAIT_L(0); PG8_MMA(0, 0, At, B0); PG8_BAR; PG8_SCHED;
            PG8_LDB(B1, 1, 1); PG8_STAGE(PG8_SB(1, 0), b3, voffB);
            PG8_BAR; PG8_WAIT_L(0); PG8_MMA(0, 1, At, B1); PG8_BAR;
            PG8_LDA(At, 1, 1); PG8_STAGE(PG8_SA(1, 0), a3, voffA);
            PG8_BAR; PG8_WAIT_L(0); PG8_MMA(1, 0, At, B0); PG8_BAR; PG8_SCHED;
            PG8_STAGE(PG8_SB(1, 1), b3 + hstep, voffB);
            PG8_WAIT_V(6); PG8_BAR; PG8_MMA(1, 1, At, B1); PG8_BAR;
            }
        }
        if constexpr (ALIGN_EPI) { if (wr == 0) PG8_BAR; }
        if constexpr (!Epi::AFTER_DRAIN) { E(acc, cur, wr, wc, fr, fq); S.done(cur); }
        if (!has_next) break;
#pragma unroll
        for (int a = 0; a < 2; ++a)
#pragma unroll
            for (int b = 0; b < 2; ++b)
#pragma unroll
                for (int m = 0; m < 4; ++m)
#pragma unroll
                    for (int n = 0; n < 2; ++n) acc[a][b][m][n] = (f32x4){0.f, 0.f, 0.f, 0.f};
        cur = nxt; cA = nA; cB = nB; ++ui;
        if constexpr (GATHER) { _Pragma("unroll") for (int _h = 0; _h < 2; ++_h) _Pragma("unroll") for (int _i = 0; _i < 2; ++_i) coff[_h][_i] = noff[_h][_i]; }
        if constexpr (ALIGN_EPI) { if (wr == 1) PG8_BAR; }
    }
    PG8_WAIT_V(0);
    if constexpr (!ALIGN_EPI) { if (wr == 0) PG8_BAR; }
    PG8_BAR;
    if constexpr (Epi::AFTER_DRAIN) { E.fused(acc, cur, wr, wc, fr, fq, lds, wid, lane); S.done(cur); }
#undef PG8_SA
#undef PG8_SB
#undef PG8_STAGE
#undef PG8_STAGEA
#undef PG8_GOFF
#undef PG8_LDA
#undef PG8_LDB
#undef PG8_MMA
#undef PG8_WAIT_V
#undef PG8_WAIT_L
#undef PG8_BAR
#undef PG8_SCHED
}
constexpr int PBI = 544, SBI_BYTES = 64 * PBI;
template <class Epi, class Sched, bool ALIGN_EPI = false, bool GATHER = false, bool SPLIT = false>
__device__ __forceinline__ void gemm_phase_bf32(PG8_LAS unsigned char* lds, const Gemm g, const Sched& S, const Epi& E) {
    const int tid = threadIdx.x, wid = __builtin_amdgcn_readfirstlane(tid >> 6), lane = tid & 63, wr = wid >> 2, wc = wid & 3, fr = lane & 15, fq = lane >> 4;
    const int K = g.K, nt = K / BK;
    unsigned voffA[2];
#pragma unroll
    for (int i = 0; i < 2; ++i) { int R, C; stage_rc(tid * 16 + i * 8192, R, C); voffA[i] = (unsigned)(R * K + C) * 2u; }
    unsigned coff[2][2], noff[2][2]; int gR[2], gC[2];
#pragma unroll
    for (int i = 0; i < 2; ++i) { int R, C; stage_rc(tid * 16 + i * 8192, R, C); gR[i] = R; gC[i] = C; coff[0][i] = coff[1][i] = noff[0][i] = noff[1][i] = 0u; }
#define PG8_GOFF(dst, pm_) do { if constexpr (GATHER) { _Pragma("unroll") for (int _h = 0; _h < 2; ++_h) _Pragma("unroll") for (int _i = 0; _i < 2; ++_i) \
        dst[_h][_i] = ((unsigned)g.tok[(pm_) * BM + _h * HALF + gR[_i]] * (unsigned)K + (unsigned)gC[_i]) * 2u; } } while (0)
    const size_t kstep = (size_t)(BK * 2), hstep = (size_t)HALF * K * 2, tstep = 2 * hstep;
    const unsigned ldsw = (unsigned)wid * 1024u;
    const int aoff = lds_byte(wr * 64 + fr, fq * 8);
    const int ldb = S.ldb();
    const size_t bkstep = (size_t)BK * ldb;
    const int q4 = (lane >> 2) & 3, p4 = lane & 3;
    const unsigned lo = SPLIT ? (unsigned)((lane >> 5) * ldb + 4 * (lane & 31)) * 4u : (unsigned)lane * 16u;
    const unsigned bwoff = SPLIT ? (unsigned)(8 * wid + (lane >> 5)) * PBI + (unsigned)(((4 * (lane & 31)) ^ ((wid & 1) << 6)) * 2)
                                 : (unsigned)(8 * wid) * PBI + (unsigned)(((4 * lane) ^ ((wid & 1) << 6)) * 2);
    unsigned broff[2][2];
#pragma unroll
    for (int n = 0; n < 2; ++n)
#pragma unroll
        for (int k = 0; k < 2; ++k) { const int row = 32 * k + 8 * fq + q4, col = 32 * wc + (Epi::PERM ? 8 * p4 + 4 * n : 16 * n + 4 * p4);
            broff[n][k] = (unsigned)row * PBI + (unsigned)((col ^ ((row & 8) << 3)) * 2); }
#define PG8_SA(b, h) (((b) * 2 + (h)) * HTB)
#define PG8_SBI(b) (4 * HTB + (b) * SBI_BYTES)
#define PG8_STAGE(bufoff, gbase, voff) do { _Pragma("unroll") for (int _i = 0; _i < 2; ++_i) \
        __builtin_amdgcn_global_load_lds((const unsigned*)((const char*)(gbase) + (voff)[_i]), (PG8_LAS unsigned*)(lds + (bufoff) + ldsw + _i * 8192), 16, 0, 0); } while (0)
#define PG8_STAGEA(bufoff, gptr, hh, kbytes, usenext) do { if constexpr (GATHER) { _Pragma("unroll") for (int _i = 0; _i < 2; ++_i) { const unsigned _o = (usenext) ? noff[hh][_i] : coff[hh][_i]; \
        __builtin_amdgcn_global_load_lds((const unsigned*)((const char*)g.A + (size_t)(kbytes) + _o), (PG8_LAS unsigned*)(lds + (bufoff) + ldsw + _i * 8192), 16, 0, 0); } } else { PG8_STAGE(bufoff, gptr, voffA); } } while (0)
#define PG8_LDA(dst, b, h) do { _Pragma("unroll") for (int m = 0; m < 4; ++m) _Pragma("unroll") for (int k = 0; k < 2; ++k) dst[m][k] = *(const PG8_LAS bf16x8*)(lds + PG8_SA(b, h) + aoff + m * 2048 + k * 1024); } while (0)
#define PG8_LDBT(dst, b, h) do { _Pragma("unroll") for (int n = 0; n < 2; ++n) _Pragma("unroll") for (int k = 0; k < 2; ++k) { \
        const PG8_LAS unsigned char* _a = lds + PG8_SBI(b) + broff[n][k] + (h) * 256; \
        const s16x4 _lo = __builtin_bit_cast(s16x4, __builtin_amdgcn_ds_read_tr16_b64_v4i16((PG8_LAS s16x4*)_a)), _hi = __builtin_bit_cast(s16x4, __builtin_amdgcn_ds_read_tr16_b64_v4i16((PG8_LAS s16x4*)(_a + 4 * PBI))); \
        dst[n][k] = __builtin_shufflevector(_lo, _hi, 0, 1, 2, 3, 4, 5, 6, 7); } } while (0)
#define PG8_BLOAD(p0, p1) do { _Pragma("unroll") for (int _i = 0; _i < 8; ++_i) { \
        const float* _u = SPLIT ? ((_i < 4 ? (p0) : (p1)) + (size_t)(8 * wid + 2 * (_i & 3)) * ldb) : ((p0) + (size_t)(8 * wid + _i) * ldb); \
        breg[_i] = *(const __attribute__((address_space(1))) f32x4*)((const char*)_u + lo); } } while (0)
#define PG8_BWRITE(b) do { _Pragma("unroll") for (int _i = 0; _i < 8; ++_i) { u32x2 _w; _w.x = cvt_pk_bf16(breg[_i][0], breg[_i][1]); _w.y = cvt_pk_bf16(breg[_i][2], breg[_i][3]); \
        *(PG8_LAS u32x2*)(lds + PG8_SBI(b) + bwoff + (SPLIT ? (2 * (_i & 3)) * PBI + (_i >> 2) * 256 : _i * PBI)) = _w; } } while (0)
#define PG8_MMA(ai, bj, At, Bt) do { __builtin_amdgcn_s_setprio(1); _Pragma("unroll") for (int m = 0; m < 4; ++m) _Pragma("unroll") for (int n = 0; n < 2; ++n) _Pragma("unroll") for (int k = 0; k < 2; ++k) \
        acc[ai][bj][m][n] = __builtin_amdgcn_mfma_f32_16x16x32_bf16(Bt[n][k], At[m][k], acc[ai][bj][m][n], 0, 0, 0); __builtin_amdgcn_s_setprio(0); } while (0)
#define PG8_WAIT_V(n) asm volatile("s_waitcnt vmcnt(" #n ")" ::: "memory")
#define PG8_WAIT_L(n) asm volatile("s_waitcnt lgkmcnt(" #n ")" ::: "memory")
#define PG8_BAR __builtin_amdgcn_s_barrier()
#define PG8_SCHED __builtin_amdgcn_sched_barrier(0)
    typedef short s16x4 __attribute__((ext_vector_type(4)));
    typedef unsigned u32x2 __attribute__((ext_vector_type(2)));
    Unit cur, nxt; int ui = 0;
    if (!S.next(0, cur)) return;
    f32x4 acc[2][2][4][2];
#pragma unroll
    for (int a = 0; a < 2; ++a)
#pragma unroll
        for (int b = 0; b < 2; ++b)
#pragma unroll
            for (int m = 0; m < 4; ++m)
#pragma unroll
                for (int n = 0; n < 2; ++n) acc[a][b][m][n] = (f32x4){0.f, 0.f, 0.f, 0.f};
    bf16x8 At[4][2], B0[2][2];
    f32x4 breg[8];
    const char* cA = (const char*)g.A + (size_t)cur.pm * tstep; const float* cB0 = S.bbase(cur, 0); const float* cB1 = S.bbase(cur, 1);
    PG8_GOFF(coff, cur.pm);
    PG8_BLOAD(cB0, cB1); PG8_STAGEA(PG8_SA(0, 0), cA, 0, 0, false); PG8_STAGEA(PG8_SA(0, 1), cA + hstep, 1, 0, false);
    PG8_BWRITE(0); PG8_SCHED;
    if (wr == 1) PG8_BAR;
    PG8_WAIT_V(2); PG8_WAIT_L(0); PG8_BAR;
    PG8_BLOAD(cB0 + bkstep, cB1 + bkstep); PG8_STAGEA(PG8_SA(1, 0), cA + kstep, 0, kstep, false); PG8_SCHED;
    PG8_WAIT_V(10); PG8_BAR;
    for (;;) {
        const bool has_next = S.next(ui + 1, nxt);
        const char* nA = has_next ? (const char*)g.A + (size_t)nxt.pm * tstep : cA; const float* nB0 = has_next ? S.bbase(nxt, 0) : cB0; const float* nB1 = has_next ? S.bbase(nxt, 1) : cB1;
        if constexpr (GATHER) { if (has_next) { PG8_GOFF(noff, nxt.pm); } else { _Pragma("unroll") for (int _h = 0; _h < 2; ++_h) _Pragma("unroll") for (int _i = 0; _i < 2; ++_i) noff[_h][_i] = coff[_h][_i]; } }
        for (int t = 0; t < nt; t += 2) {
            const bool last = (t == nt - 2);
            const char* a1 = cA + (size_t)(t + 1) * kstep;
            const char* a2 = last ? nA : cA + (size_t)(t + 2) * kstep; const float* b20 = last ? nB0 : cB0 + (size_t)(t + 2) * bkstep; const float* b21 = last ? nB1 : cB1 + (size_t)(t + 2) * bkstep;
            const char* a3 = a2 + kstep; const float* b30 = b20 + bkstep; const float* b31 = b21 + bkstep;
            const size_t k1 = (size_t)(t + 1) * kstep, k2 = last ? 0 : (size_t)(t + 2) * kstep, k3 = k2 + kstep;
            PG8_LDBT(B0, 0, 0); PG8_SCHED; PG8_LDA(At, 0, 0); PG8_STAGEA(PG8_SA(1, 1), a1 + hstep, 1, k1, false);
            PG8_WAIT_V(12); PG8_WAIT_L(0); PG8_BAR; PG8_MMA(0, 0, At, B0); PG8_LDBT(B0, 0, 1); PG8_WAIT_L(0); PG8_SCHED; PG8_MMA(0, 1, At, B0); PG8_BAR; PG8_SCHED;
            PG8_BWRITE(1); PG8_BLOAD(b20, b21); PG8_SCHED; PG8_LDBT(B0, 0, 0); PG8_LDA(At, 0, 1); PG8_STAGEA(PG8_SA(0, 0), a2, 0, k2, last);
            PG8_WAIT_V(12); PG8_WAIT_L(0); PG8_BAR; PG8_MMA(1, 0, At, B0); PG8_LDBT(B0, 0, 1); PG8_WAIT_L(0); PG8_SCHED; PG8_MMA(1, 1, At, B0); PG8_BAR; PG8_SCHED;
            PG8_LDBT(B0, 1, 0); PG8_SCHED; PG8_LDA(At, 1, 0); PG8_STAGEA(PG8_SA(0, 1), a2 + hstep, 1, k2, last);
            PG8_WAIT_V(12); PG8_WAIT_L(0); PG8_BAR; PG8_MMA(0, 0, At, B0); PG8_LDBT(B0, 1, 1); PG8_WAIT_L(0); PG8_SCHED; PG8_MMA(0, 1, At, B0); PG8_BAR; PG8_SCHED;
            PG8_BWRITE(0); PG8_BLOAD(b30, b31); PG8_SCHED; PG8_LDBT(B0, 1, 0); PG8_LDA(At, 1, 1); PG8_STAGEA(PG8_SA(1, 0), a3, 0, k3, last);
            PG8_WAIT_V(12); PG8_WAIT_L(0); PG8_BAR; PG8_MMA(1, 0, At, B0); PG8_LDBT(B0, 1, 1); PG8_WAIT_L(0); PG8_SCHED; PG8_MMA(1, 1, At, B0); PG8_BAR; PG8_SCHED;
        }
        if constexpr (ALIGN_EPI) { if (wr == 0) PG8_BAR; }
        E(acc, cur, wr, wc, fr, fq); S.done(cur);
        if (!has_next) break;
#pragma unroll
        for (int a = 0; a < 2; ++a)
#pragma unroll
            for (int b = 0; b < 2; ++b)
#pragma unroll
                for (int m = 0; m < 4; ++m)
#pragma unroll
                    for (int n = 0; n < 2; ++n) acc[a][b][m][n] = (f32x4){0.f, 0.f, 0.f, 0.f};
        cur = nxt; cA = nA; cB0 = nB0; cB1 = nB1; ++ui;
        if constexpr (GATHER) { _Pragma("unroll") for (int _h = 0; _h < 2; ++_h) _Pragma("unroll") for (int _i = 0; _i < 2; ++_i) coff[_h][_i] = noff[_h][_i]; }
        if constexpr (ALIGN_EPI) { if (wr == 1) PG8_BAR; }
    }
    PG8_WAIT_V(0);
    asm volatile("" :: "v"(breg[0]), "v"(breg[1]), "v"(breg[2]), "v"(breg[3]), "v"(breg[4]), "v"(breg[5]), "v"(breg[6]), "v"(breg[7]));
    if constexpr (!ALIGN_EPI) { if (wr == 0) PG8_BAR; }
    PG8_BAR;
#undef PG8_SA
#undef PG8_SBI
#undef PG8_STAGE
#undef PG8_STAGEA
#undef PG8_GOFF
#undef PG8_LDA
#undef PG8_LDBT
#undef PG8_BLOAD
#undef PG8_BWRITE
#undef PG8_MMA
#undef PG8_WAIT_V
#undef PG8_WAIT_L
#undef PG8_BAR
#undef PG8_SCHED
}
}

constexpr int NWAVES = 8, NTHR = 512;
constexpr int T = 8192, D = 2048, HW = 7168, INW = 7184, MEMN = 256;
constexpr float LN_EPS = 1e-5f;
constexpr float ALPHA = 1.189207115002721f;
constexpr int NPH = 16;
#ifndef MK_NSG
#define MK_NSG 9
#endif
constexpr int NSG = MK_NSG;
constexpr int PMAX = 24576;

constexpr size_t MiB = 1u << 20;
constexpr size_t WS_CTL = 0, CTL_ZERO_BYTES = 64 * 1024;
constexpr size_t WS_WMIX = 2 * MiB, WS_WMQ = 10 * MiB, WS_WIN = 18 * MiB, WS_WKV = 46 * MiB, WS_WMO = 62 * MiB, WS_WGU = 70 * MiB, WS_WD = 198 * MiB;
constexpr size_t WS_XB = 262 * MiB, WS_MEMB = 294 * MiB;
constexpr size_t WS_H = 296 * MiB;
constexpr size_t WS_KVM = 408 * MiB;
constexpr size_t WS_ORAW = 410 * MiB;
constexpr size_t WS_MIXED = WS_XB;
constexpr size_t WS_Y1 = WS_ORAW;
constexpr size_t WS_H1B = WS_H;
constexpr size_t WS_QB = 328 * MiB, WS_ATT = 360 * MiB;
constexpr size_t WS_Y2 = 474 * MiB;
constexpr size_t WS_H2B = WS_H;
constexpr size_t WS_XS = 328 * MiB;
constexpr size_t WS_HID = 424 * MiB;
constexpr size_t WS_YS = WS_XS;
constexpr size_t WS_SMALL = 540 * MiB;
constexpr size_t WS_GLR = WS_SMALL;
constexpr size_t WS_RC = WS_SMALL + 1 * MiB, WS_RS = WS_SMALL + 5 * MiB;
constexpr size_t WS_ST1 = WS_SMALL + 9 * MiB, WS_ST2 = WS_ST1 + 65536;
constexpr size_t WS_EXP = WS_ST2 + 65536, WS_GATE = WS_EXP + 65536, WS_POS = WS_GATE + 65536, WS_SLOT = WS_POS + 65536, WS_TOK = WS_SLOT + 65536;
constexpr size_t WS_XCH1 = WS_SMALL + 10 * MiB, WS_XCH2 = WS_XCH1 + 512 * 1024;
constexpr size_t WS_END = 552 * MiB;
constexpr int CW_CNT = 64, CW_CUR = 128, CW_Q = 192;
constexpr int CW_BAR = 4096;
constexpr int CW_LN1 = 8192, CW_LN2 = 10240;

constexpr int RING_BYTES = 139264, LDSCTL_OFF = RING_BYTES, MISC_OFF = LDSCTL_OFF + 320, LDS_BYTES = 147456;

#define GAS __attribute__((address_space(1)))
#define LAS __attribute__((address_space(3)))
typedef unsigned short bf16;
typedef unsigned v4u __attribute__((ext_vector_type(4)));
typedef unsigned v2u __attribute__((ext_vector_type(2)));
typedef float f32x4 __attribute__((ext_vector_type(4)));
typedef GAS unsigned gu32;
#define RLX_AGENT __ATOMIC_RELAXED, __HIP_MEMORY_SCOPE_AGENT
#define LDS_WAIT() asm volatile("s_waitcnt lgkmcnt(0)" ::: "memory")
__device__ __forceinline__ unsigned f2bf(float f) { unsigned u = __builtin_bit_cast(unsigned, f); return (u + 0x7fffu + ((u >> 16) & 1u)) >> 16; }
__device__ __forceinline__ unsigned pk2(float lo, float hi) { return f2bf(lo) | (f2bf(hi) << 16); }
__device__ __forceinline__ float bf2f(unsigned h) { return __builtin_bit_cast(float, h << 16); }
__device__ __forceinline__ float bflo(unsigned w) { return __builtin_bit_cast(float, w << 16); }
__device__ __forceinline__ float bfhi(unsigned w) { return __builtin_bit_cast(float, w & 0xffff0000u); }
__device__ __forceinline__ float wave_sum(float v) {
#pragma unroll
    for (int o = 1; o < 64; o <<= 1) v += __shfl_xor(v, o);
    return v;
}
__device__ __forceinline__ float wave_max(float v) {
#pragma unroll
    for (int o = 1; o < 64; o <<= 1) v = fmaxf(v, __shfl_xor(v, o));
    return v;
}

struct Frame {
    LAS unsigned char* lds;
    volatile LAS unsigned* MISC;
    gu32* ctl;
    int tid, lane, wave, G, bid;
    unsigned char* ws;
    const float* in[25];
    float* out;
};
#define WSP(T_, off) ((T_*)(F.ws + (off)))

template <bool NTST>
__device__ __forceinline__ void transpose_item(const float* W, int ldw, bf16* WTr, int ldt, LAS float* scr, int lane) {
    float tv[32];
#pragma unroll
    for (int i = 0; i < 32; ++i) tv[i] = __builtin_nontemporal_load(W + (size_t)(2 * i + (lane >> 5)) * ldw + (lane & 31));
#pragma unroll
    for (int i = 0; i < 32; ++i) scr[(2 * i + (lane >> 5)) * 33 + (lane & 31)] = tv[i];
    LDS_WAIT(); asm volatile("" ::: "memory");
    const int c = lane & 7;
#pragma unroll
    for (int j = 0; j < 4; ++j) { const int n = (lane >> 3) + 8 * j; const LAS float* s = scr + (8 * c) * 33 + n;
        v4u o; o.x = pk2(s[0 * 33], s[1 * 33]); o.y = pk2(s[2 * 33], s[3 * 33]); o.z = pk2(s[4 * 33], s[5 * 33]); o.w = pk2(s[6 * 33], s[7 * 33]);
        if (NTST) __builtin_nontemporal_store(o, (GAS v4u*)(WTr + (size_t)n * ldt + 8 * c)); else *(GAS v4u*)(WTr + (size_t)n * ldt + 8 * c) = o; }
    LDS_WAIT(); asm volatile("" ::: "memory");
}
__device__ __forceinline__ void p0_prologue(Frame& F) {
    LAS float* scr = (LAS float*)(F.lds + F.wave * 16384);
    const int gw = F.bid * NWAVES + F.wave, NGW = F.G * NWAVES;
    const float* w_in = F.in[3];
    constexpr int I_IN = 32 * 224, I_SQ = 32 * 64;
    for (int it = gw; it < I_IN + 2 * I_SQ; it += NGW) {
        int r = it;
        if (r < I_IN) { const int kb = r / 224, nb = r % 224; transpose_item<false>(w_in + (size_t)(64 * kb) * INW + 32 * nb, INW, WSP(bf16, WS_WIN) + (size_t)(32 * nb) * 2048 + 64 * kb, 2048, scr, F.lane); continue; }
        r -= I_IN;
        { const int w = r / I_SQ, q = r % I_SQ, kb = q / 64, nb = q % 64;
          const float* src = F.in[11]; if (w) src = F.in[12];
          bf16* dst = WSP(bf16, WS_WKV) + (size_t)w * 2048 * 2048;
          transpose_item<false>(src + (size_t)(64 * kb) * 2048 + 32 * nb, 2048, dst + (size_t)(32 * nb) * 2048 + 64 * kb, 2048, scr, F.lane); }
    }
    const int gt = F.bid * NTHR + F.tid, NGT = F.G * NTHR;
    {
        const float* x = F.in[0]; bf16* xb = WSP(bf16, WS_XB);
        for (int item = F.bid; item < T / 32; item += F.G) {
            const size_t base = (size_t)item * 32 * D / 8;
#pragma unroll 1
            for (int c0 = 0; c0 < 16; c0 += 4) { f32x4 a[4], b[4];
#pragma unroll
                for (int u = 0; u < 4; ++u) { const size_t i = base + (size_t)(c0 + u) * NTHR + F.tid; a[u] = *(const GAS f32x4*)(x + i * 8); b[u] = *(const GAS f32x4*)(x + i * 8 + 4); }
#pragma unroll
                for (int u = 0; u < 4; ++u) { const size_t i = base + (size_t)(c0 + u) * NTHR + F.tid;
                    v4u o; o.x = pk2(a[u][0], a[u][1]); o.y = pk2(a[u][2], a[u][3]); o.z = pk2(b[u][0], b[u][1]); o.w = pk2(b[u][2], b[u][3]); *(GAS v4u*)(xb + i * 8) = o; } }
        }
        const float* mm = F.in[1]; bf16* mb = WSP(bf16, WS_MEMB);
        for (int i = gt; i < MEMN * D / 8; i += NGT) { const f32x4 a = *(const GAS f32x4*)(mm + (size_t)i * 8), b = *(const GAS f32x4*)(mm + (size_t)i * 8 + 4);
            v4u o; o.x = pk2(a[0], a[1]); o.y = pk2(a[2], a[3]); o.z = pk2(b[0], b[1]); o.w = pk2(b[2], b[3]); *(GAS v4u*)(mb + (size_t)i * 8) = o; }
    }
    {
        const int* pos = (const int*)F.in[2]; float* rc = WSP(float, WS_RC); float* rs = WSP(float, WS_RS);
        for (int i = gt; i < T * 128; i += NGT) { const int t = i >> 7, f = i & 127;
            const float inv = exp2f(-(float)f * (13.287712379549449f / 128.0f));
            const float ang = (float)pos[t] * inv;
            double rev = (double)ang * 0.15915494309189535; rev -= floor(rev);
            const float rf = (float)rev;
            rc[i] = __builtin_amdgcn_cosf(rf); rs[i] = __builtin_amdgcn_sinf(rf); }
    }
    {
        const float* x = F.in[0]; float* glr = WSP(float, WS_GLR);
        const int r16 = F.lane & 15, g4 = F.lane >> 4;
        LAS float* part = (LAS float*)F.lds;
        for (int item = F.bid; item < T / 32; item += F.G) {
            const int tile = 2 * item + (F.wave >> 2), kq = F.wave & 3;
            f32x4 acc = {0.f, 0.f, 0.f, 0.f};
            const float* xr = x + (size_t)(tile * 16 + r16) * D + 512 * kq + 4 * g4;
            const float* wr = w_in + (size_t)(512 * kq + 4 * g4) * INW + HW + r16;
#pragma unroll 8
            for (int k0 = 0; k0 < 512; k0 += 16) {
                const f32x4 a = *(const GAS f32x4*)(xr + k0);
                const float b0 = wr[(size_t)(k0 + 0) * INW], b1 = wr[(size_t)(k0 + 1) * INW], b2 = wr[(size_t)(k0 + 2) * INW], b3 = wr[(size_t)(k0 + 3) * INW];
                acc = __builtin_amdgcn_mfma_f32_16x16x4f32(a[0], b0, acc, 0, 0, 0);
                acc = __builtin_amdgcn_mfma_f32_16x16x4f32(a[1], b1, acc, 0, 0, 0);
                acc = __builtin_amdgcn_mfma_f32_16x16x4f32(a[2], b2, acc, 0, 0, 0);
                acc = __builtin_amdgcn_mfma_f32_16x16x4f32(a[3], b3, acc, 0, 0, 0);
            }
            __syncthreads();
            *(LAS f32x4*)(part + (F.wave * 64 + F.lane) * 4) = acc;
            __syncthreads();
            if (F.tid < 128) { const int tl = F.tid >> 6, ln = F.tid & 63;
                f32x4 s = *(const LAS f32x4*)(part + ((tl * 4 + 0) * 64 + ln) * 4);
#pragma unroll
                for (int q = 1; q < 4; ++q) s += *(const LAS f32x4*)(part + ((tl * 4 + q) * 64 + ln) * 4);
#pragma unroll
                for (int j = 0; j < 4; ++j) glr[(size_t)((2 * item + tl) * 16 + 4 * (ln >> 4) + j) * 16 + (ln & 15)] = s[j]; }
        }
        __syncthreads();
    }
}
__device__ __forceinline__ void transpose_queue(Frame& F, int qsel = 0) {
    LAS float* scr = (LAS float*)(F.lds + F.wave * 16384);
    const float* const i7 = F.in[7]; const float* const i10 = F.in[10]; const float* const i13 = F.in[13]; const float* const i20 = F.in[20]; const float* const i21 = F.in[21]; const float* const i22 = F.in[22];
    constexpr int I_SQ = 32 * 64, I_E = 512, NQ = 3 * I_SQ + (MK_MOE_F32 ? 0 : 3 * 32 * I_E);
    for (;;) {
        unsigned b0 = 0;
        if (F.lane == 0) b0 = __hip_atomic_fetch_add((unsigned*)(F.ctl + CW_Q + 64 * qsel), 16u, __ATOMIC_RELAXED, __HIP_MEMORY_SCOPE_AGENT);
        b0 = __builtin_amdgcn_readfirstlane(b0);
        if (b0 >= (unsigned)NQ) break;
        for (int it = (int)b0; it < (int)b0 + 16 && it < NQ; ++it) {
            int r = it;
            if (r < 3 * I_SQ) { const int w = r / I_SQ, q = r % I_SQ, kb = q / 64, nb = q % 64;
                const float* src = i7; size_t doff = WS_WMIX; if (w == 1) { src = i10; doff = WS_WMQ; } if (w == 2) { src = i13; doff = WS_WMO; }
                bf16* dst = (bf16*)(F.ws + doff);
                transpose_item<true>(src + (size_t)(64 * kb) * 2048 + 32 * nb, 2048, dst + (size_t)(32 * nb) * 2048 + 64 * kb, 2048, scr, F.lane); continue; }
            r -= 3 * I_SQ;
            if (r < 2 * 32 * I_E) {
                const int up = r / (32 * I_E), q = r % (32 * I_E), e = q / I_E, q2 = q % I_E, kb = q2 / 16, nb = q2 % 16, n0 = 32 * nb;
                const float* sb = i20; if (up) sb = i21;
                const float* src = sb + (size_t)e * 2048 * 512 + (size_t)(64 * kb) * 512 + n0;
                bf16* dst = WSP(bf16, WS_WGU) + (size_t)(e * 1024 + (n0 >> 7) * 256 + up * 128 + (n0 & 127)) * 2048 + 64 * kb;
                transpose_item<true>(src, 512, dst, 2048, scr, F.lane); continue; }
            r -= 2 * 32 * I_E;
            {
                const int e = r / I_E, q2 = r % I_E, kb = q2 / 64, nb = q2 % 64;
                const float* src = i22 + (size_t)e * 512 * 2048 + (size_t)(64 * kb) * 2048 + 32 * nb;
                bf16* dst = WSP(bf16, WS_WD) + (size_t)(e * 2048 + 32 * nb) * 512 + 64 * kb;
                transpose_item<true>(src, 2048, dst, 512, scr, F.lane); }
        }
    }
}

__device__ __forceinline__ float log_sigmoid_f(float z) { return fminf(z, 0.f) - log1pf(expf(-fabsf(z))); }
template <bool GLA>
__device__ __forceinline__ void mixer_naive_item(Frame& F, int hh, int eg) {
    constexpr int ND = GLA ? 4 : 8;
    const bf16* H = WSP(bf16, WS_H); float* oraw = WSP(float, WS_ORAW);
    const int ei = F.tid & 15, dp = F.tid >> 4, e = eg * 16 + ei;
    const int qcol = GLA ? 4096 + hh * 128 : hh * 256, kcol = GLA ? 4608 + hh * 128 : 1024 + hh * 256, vcol = (GLA ? 5120 : 2048) + hh * 256 + e;
    const int ocol = (GLA ? 1024 : 0) + hh * 256 + eg * 16;
    LAS float* red = (LAS float*)F.lds;
    float S[ND];
#pragma unroll
    for (int i = 0; i < ND; ++i) S[i] = 0.f;
    float wa[GLA ? 4 : 1][16]; float ba[GLA ? 4 : 1];
    if (GLA) {
#pragma unroll
        for (int i = 0; i < 4; ++i) { const int d = dp + 32 * i; ba[i] = F.in[5][hh * 128 + d];
#pragma unroll
            for (int r = 0; r < 16; ++r) wa[i][r] = F.in[4][r * 512 + hh * 128 + d]; }
    }
    const float gamma = 1.0f - exp2f(-5.0f - (float)hh);
    const float* glr = WSP(float, WS_GLR);
    for (int t0 = 0; t0 < T; t0 += 8) {
        float part[8];
#pragma unroll
        for (int tt = 0; tt < 8; ++tt) {
            const int t = t0 + tt; const bf16* hr = H + (size_t)t * HW;
            const float v = bf2f(hr[vcol]);
            float g16[16];
            if (GLA) {
#pragma unroll
                for (int r = 0; r < 16; ++r) g16[r] = glr[t * 16 + r];
            }
            float p = 0.f;
#pragma unroll
            for (int i = 0; i < ND; ++i) { const int d = dp + 32 * i;
                const float q = bf2f(hr[qcol + d]), k = bf2f(hr[kcol + d]);
                float a = gamma;
                if (GLA) { float z = ba[i];
#pragma unroll
                    for (int r = 0; r < 16; ++r) z += g16[r] * wa[i][r];
                    a = expf(log_sigmoid_f(z) * 0.0625f); }
                S[i] = a * S[i] + k * v; p += q * S[i]; }
            p += __shfl_xor(p, 16); p += __shfl_xor(p, 32);
            part[tt] = p;
        }
        if (F.lane < 16) {
#pragma unroll
            for (int tt = 0; tt < 8; ++tt) red[(F.wave * 8 + tt) * 16 + F.lane] = part[tt];
        }
        __syncthreads();
        if (F.tid < 128) { const int tt = F.tid >> 4, e2 = F.tid & 15; float s = 0.f;
#pragma unroll
            for (int w = 0; w < 8; ++w) s += red[(w * 8 + tt) * 16 + e2];
            oraw[(size_t)(t0 + tt) * D + ocol + e2] = s; }
        __syncthreads();
    }
}
__device__ __forceinline__ void p2_mixer_naive(Frame& F) {
    for (int item = F.bid; item < 128; item += F.G) {
        const int h8 = item >> 4, eg = item & 15;
        if (h8 < 4) mixer_naive_item<false>(F, h8, eg); else mixer_naive_item<true>(F, h8 - 4, eg);
    }
}
__device__ __forceinline__ void p3_normgate(Frame& F) {
    const bf16* H = WSP(bf16, WS_H); const float* oraw = WSP(float, WS_ORAW); bf16* mixed = WSP(bf16, WS_MIXED);
    const int gw = F.bid * NWAVES + F.wave, NGW = F.G * NWAVES;
    const f32x4 gn = *(const f32x4*)(F.in[6] + 4 * F.lane);
    for (int t = gw; t < T; t += NGW) {
#pragma unroll
        for (int h8 = 0; h8 < 8; ++h8) {
            const f32x4 o = *(const GAS f32x4*)(oraw + (size_t)t * D + h8 * 256 + 4 * F.lane);
            const int gcol = (h8 < 4 ? 3072 : 6144) + (h8 & 3) * 256 + 4 * F.lane;
            const v2u gw2 = *(const GAS v2u*)(H + (size_t)t * HW + gcol);
            const f32x4 gt = {bflo(gw2.x), bfhi(gw2.x), bflo(gw2.y), bfhi(gw2.y)};
            f32x4 y;
            if (h8 < 4) {
                const float mu = wave_sum((o[0] + o[1]) + (o[2] + o[3])) * (1.f / 256.f);
                const f32x4 dd = o - mu;
                const float var = wave_sum((dd[0] * dd[0] + dd[1] * dd[1]) + (dd[2] * dd[2] + dd[3] * dd[3])) * (1.f / 256.f);
                y = dd * (1.0f / sqrtf(var + LN_EPS));
            } else {
                const float ms = wave_sum((o[0] * o[0] + o[1] * o[1]) + (o[2] * o[2] + o[3] * o[3])) * (1.f / 256.f);
                y = o * (1.0f / sqrtf(ms + LN_EPS)) * gn;
            }
            float r[4];
#pragma unroll
            for (int i = 0; i < 4; ++i) { const float g = gt[i]; r[i] = g / (1.0f + expf(-g)) * y[i]; }
            v2u w; w.x = pk2(r[0], r[1]); w.y = pk2(r[2], r[3]);
            *(GAS v2u*)(mixed + (size_t)t * D + h8 * 256 + 4 * F.lane) = w;
        }
    }
}
__device__ __forceinline__ void ln_apply_plain(Frame& F, const float* Y, const float* g, const float* b, bf16* HB, float* st) {
    const int gw = F.bid * NWAVES + F.wave, NGW = F.G * NWAVES;
    f32x4 cur[8];
    if (gw < T) { const GAS f32x4* yr = (const GAS f32x4*)(Y + (size_t)gw * D) + F.lane;
#pragma unroll
        for (int j = 0; j < 8; ++j) cur[j] = yr[64 * j]; }
    for (int t = gw; t < T; t += NGW) {
        f32x4 nxt[8];
        { const int tn = t + NGW < T ? t + NGW : t; const GAS f32x4* yr = (const GAS f32x4*)(Y + (size_t)tn * D) + F.lane;
#pragma unroll
          for (int j = 0; j < 8; ++j) nxt[j] = yr[64 * j]; }
        f32x4 v[8]; float s = 0.f;
#pragma unroll
        for (int j = 0; j < 8; ++j) { v[j] = cur[j]; s += (v[j][0] + v[j][1]) + (v[j][2] + v[j][3]); }
        const float mean = wave_sum(s) * (1.f / D); float s2 = 0.f;
#pragma unroll
        for (int j = 0; j < 8; ++j) { v[j] = v[j] - mean; s2 += (v[j][0] * v[j][0] + v[j][1] * v[j][1]) + (v[j][2] * v[j][2] + v[j][3] * v[j][3]); }
        const float rstd = 1.f / sqrtf(wave_sum(s2) * (1.f / D) + LN_EPS);
        if (F.lane == 0) { st[2 * t] = mean; st[2 * t + 1] = rstd; }
        GAS v2u* o8 = (GAS v2u*)(HB + (size_t)t * D) + F.lane;
#pragma unroll
        for (int j = 0; j < 8; ++j) { const f32x4 gv = *(const f32x4*)(g + 4 * F.lane + 256 * j), bv = *(const f32x4*)(b + 4 * F.lane + 256 * j);
            v[j] = v[j] * rstd * gv + bv;
            v2u w; w.x = pk2(v[j][0], v[j][1]); w.y = pk2(v[j][2], v[j][3]); o8[64 * j] = w; }
#pragma unroll
        for (int j = 0; j < 8; ++j) cur[j] = nxt[j];
    }
}
template <bool ROUTER>
__device__ __forceinline__ void ln_apply(Frame& F, const float* Y, const float* g, const float* b, bf16* HB, float* st, bool count = true) {
    const int gw = F.bid * NWAVES + F.wave, NGW = F.G * NWAVES;
    for (int t = gw; t < T; t += NGW) {
        const GAS f32x4* yr = (const GAS f32x4*)(Y + (size_t)t * D) + F.lane;
        f32x4 v[8]; float s = 0.f;
#pragma unroll
        for (int j = 0; j < 8; ++j) { v[j] = yr[64 * j]; s += (v[j][0] + v[j][1]) + (v[j][2] + v[j][3]); }
        const float mean = wave_sum(s) * (1.f / D); float s2 = 0.f;
#pragma unroll
        for (int j = 0; j < 8; ++j) { v[j] = v[j] - mean; s2 += (v[j][0] * v[j][0] + v[j][1] * v[j][1]) + (v[j][2] * v[j][2] + v[j][3] * v[j][3]); }
        const float rstd = 1.f / sqrtf(wave_sum(s2) * (1.f / D) + LN_EPS);
        if (F.lane == 0) { st[2 * t] = mean; st[2 * t + 1] = rstd; }
        GAS v2u* o8 = (GAS v2u*)(HB + (size_t)t * D) + F.lane;
#pragma unroll
        for (int j = 0; j < 8; ++j) { const f32x4 gv = *(const f32x4*)(g + 4 * F.lane + 256 * j), bv = *(const f32x4*)(b + 4 * F.lane + 256 * j);
            v[j] = v[j] * rstd * gv + bv;
            v2u w; w.x = pk2(v[j][0], v[j][1]); w.y = pk2(v[j][2], v[j][3]); o8[64 * j] = w; }
        if (ROUTER) {
            const float* Wg = F.in[16]; const float* We = F.in[18];
            float lg[4], le[32];
#pragma unroll
            for (int i = 0; i < 4; ++i) lg[i] = 0.f;
#pragma unroll
            for (int i = 0; i < 32; ++i) le[i] = 0.f;
#pragma unroll
            for (int j = 0; j < 8; ++j) {
#pragma unroll
                for (int i = 0; i < 4; ++i) { const int c = 4 * F.lane + 256 * j + i; const float hv = v[j][i];
                    const f32x4 wg = *(const GAS f32x4*)(Wg + (size_t)c * 4);
#pragma unroll
                    for (int q = 0; q < 4; ++q) lg[q] += hv * wg[q];
#pragma unroll
                    for (int q8 = 0; q8 < 8; ++q8) { const f32x4 we = *(const GAS f32x4*)(We + (size_t)c * 32 + 4 * q8);
#pragma unroll
                        for (int q = 0; q < 4; ++q) le[4 * q8 + q] += hv * we[q]; } }
            }
#pragma unroll
            for (int i = 0; i < 4; ++i) lg[i] = wave_sum(lg[i]) + F.in[17][i];
#pragma unroll
            for (int i = 0; i < 32; ++i) le[i] = wave_sum(le[i]);
            int grp = 0; float gm = lg[0];
#pragma unroll
            for (int i = 1; i < 4; ++i) if (lg[i] > gm) { gm = lg[i]; grp = i; }
            float gs = 0.f;
#pragma unroll
            for (int i = 0; i < 4; ++i) gs += expf(lg[i] - gm);
            const float pg_sel = 1.0f / gs;
            float fe[8];
#pragma unroll
            for (int j = 0; j < 8; ++j) { const float a = grp == 0 ? le[j] : grp == 1 ? le[8 + j] : grp == 2 ? le[16 + j] : le[24 + j]; fe[j] = a + F.in[19][grp * 8 + j]; }
            int i1 = 0; float m1 = fe[0];
#pragma unroll
            for (int j = 1; j < 8; ++j) if (fe[j] > m1) { m1 = fe[j]; i1 = j; }
            int i2 = -1; float m2 = -3.0e38f;
#pragma unroll
            for (int j = 0; j < 8; ++j) if (j != i1 && fe[j] > m2) { m2 = fe[j]; i2 = j; }
            const float p2 = expf(m2 - m1), den = 1.0f / (1.0f + p2);
            if (F.lane == 0) {
                int* ex = WSP(int, WS_EXP); float* gt = WSP(float, WS_GATE);
                const int e1 = grp * 8 + i1, e2 = grp * 8 + i2;
                ex[2 * t] = e1; ex[2 * t + 1] = e2; gt[2 * t] = pg_sel * den; gt[2 * t + 1] = pg_sel * p2 * den;
                if (count) { atomicAdd((unsigned*)(F.ctl + CW_CNT) + e1, 1u); atomicAdd((unsigned*)(F.ctl + CW_CNT) + e2, 1u); }
            }
        }
    }
}
__device__ __forceinline__ void p7_attn_naive(Frame& F) {
    const bf16* Q = WSP(bf16, WS_QB); const bf16* KVM = WSP(bf16, WS_KVM); bf16* att = WSP(bf16, WS_ATT);
    LAS float* qs = (LAS float*)F.lds;
    LAS float* sc = (LAS float*)(F.lds + 16384);
    for (int item = F.bid; item < (T / 8) * 4; item += F.G) {
        const int h = item & 3, t0 = (item >> 2) * 8;
        for (int i = F.tid; i < 8 * 512; i += NTHR) { const int tt = i >> 9, d = i & 511; qs[i] = bf2f(Q[(size_t)(t0 + tt) * D + h * 512 + d]); }
        __syncthreads();
        {
            const int j = F.tid & 255, th = F.tid >> 8;
            const bf16* kr = KVM + (size_t)j * 4096 + h * 512;
            float a0 = 0.f, a1 = 0.f, a2 = 0.f, a3 = 0.f;
            for (int d = 0; d < 512; d += 8) {
                const v4u kw = *(const GAS v4u*)(kr + d);
                const float kf[8] = {bflo(kw.x), bfhi(kw.x), bflo(kw.y), bfhi(kw.y), bflo(kw.z), bfhi(kw.z), bflo(kw.w), bfhi(kw.w)};
#pragma unroll
                for (int i = 0; i < 8; ++i) { a0 += kf[i] * qs[(th * 4 + 0) * 512 + d + i]; a1 += kf[i] * qs[(th * 4 + 1) * 512 + d + i]; a2 += kf[i] * qs[(th * 4 + 2) * 512 + d + i]; a3 += kf[i] * qs[(th * 4 + 3) * 512 + d + i]; }
            }
            const float scl = 0.04419417382415922f;
            sc[(th * 4 + 0) * 256 + j] = a0 * scl; sc[(th * 4 + 1) * 256 + j] = a1 * scl; sc[(th * 4 + 2) * 256 + j] = a2 * scl; sc[(th * 4 + 3) * 256 + j] = a3 * scl;
        }
        __syncthreads();
        {
            float v[4]; float mx = -3.0e38f;
#pragma unroll
            for (int i = 0; i < 4; ++i) { v[i] = sc[F.wave * 256 + F.lane + 64 * i]; mx = fmaxf(mx, v[i]); }
            mx = wave_max(mx); float sm = 0.f;
#pragma unroll
            for (int i = 0; i < 4; ++i) { v[i] = expf(v[i] - mx); sm += v[i]; }
            sm = 1.0f / wave_sum(sm);
#pragma unroll
            for (int i = 0; i < 4; ++i) sc[F.wave * 256 + F.lane + 64 * i] = v[i] * sm;
        }
        __syncthreads();
        {
            const int d = F.tid; const bf16* vr = KVM + 2048 + h * 512 + d;
            float o[8];
#pragma unroll
            for (int i = 0; i < 8; ++i) o[i] = 0.f;
            for (int j = 0; j < 256; ++j) { const float vv = bf2f(vr[(size_t)j * 4096]);
#pragma unroll
                for (int i = 0; i < 8; ++i) o[i] += sc[i * 256 + j] * vv; }
#pragma unroll
            for (int i = 0; i < 8; ++i) att[(size_t)(t0 + i) * D + h * 512 + d] = (bf16)f2bf(o[i]);
        }
        __syncthreads();
    }
}
__device__ __forceinline__ void moe_tile_starts(Frame& F, LAS int* ts) {
    if (F.tid < 64) {
        const unsigned c = F.lane < 32 ? __hip_atomic_load(F.ctl + CW_CUR + (F.lane & 31), RLX_AGENT) : 0u;
        int v = (int)((c + 255u) >> 8);
#pragma unroll
        for (int o = 1; o < 32; o <<= 1) { const int n = __shfl_up(v, o); if (F.lane >= o) v += n; }
        if (F.lane < 32) ts[F.lane + 1] = v;
        if (F.lane == 0) ts[0] = 0;
    }
    __syncthreads();
}
__device__ __forceinline__ void p10_dispatch(Frame& F, LAS int* ts) {
    const int gt = F.bid * NTHR + F.tid, NGT = F.G * NTHR;
    const int* ex = WSP(int, WS_EXP); const int* sl = WSP(int, WS_SLOT); int* pos = WSP(int, WS_POS); int* tok = WSP(int, WS_TOK);
    for (int a = gt; a < 2 * T; a += NGT) { const int p = ts[ex[a]] * 256 + sl[a]; pos[a] = p; tok[p] = a >> 1; }
}
__device__ __forceinline__ void p13_combine(Frame& F) {
    const int gw = F.bid * NWAVES + F.wave, NGW = F.G * NWAVES;
    const float* Y2 = WSP(float, WS_Y2); const float* st2 = WSP(float, WS_ST2); const bf16* ys = WSP(bf16, WS_YS);
    const int* pos = WSP(int, WS_POS); const float* gt = WSP(float, WS_GATE);
    const float* g2 = F.in[14]; const float* b2 = F.in[15]; const float* g3 = F.in[23]; const float* b3 = F.in[24];
    constexpr int R = 2;
    for (int t0 = gw; t0 < T; t0 += R * NGW) {
        f32x4 yv[R][8]; v2u ya[R][8], yc[R][8]; float mu2[R], rs2[R], w0[R], w1[R];
#pragma unroll
        for (int r = 0; r < R; ++r) { const int t = (t0 + r * NGW < T) ? t0 + r * NGW : t0;
            mu2[r] = st2[2 * t]; rs2[r] = st2[2 * t + 1]; w0[r] = gt[2 * t]; w1[r] = gt[2 * t + 1];
            const int p0 = pos[2 * t], p1 = pos[2 * t + 1];
            const GAS f32x4* yr = (const GAS f32x4*)(Y2 + (size_t)t * D) + F.lane;
            const GAS v2u* y0 = (const GAS v2u*)(ys + (size_t)p0 * D) + F.lane; const GAS v2u* y1 = (const GAS v2u*)(ys + (size_t)p1 * D) + F.lane;
#pragma unroll
            for (int j = 0; j < 8; ++j) { yv[r][j] = yr[64 * j]; ya[r][j] = y0[64 * j]; yc[r][j] = y1[64 * j]; } }
#pragma unroll
        for (int r = 0; r < R; ++r) { const int t = t0 + r * NGW; if (t >= T) break;
            f32x4 v[8]; float s = 0.f;
#pragma unroll
            for (int j = 0; j < 8; ++j) { const f32x4 gv = *(const f32x4*)(g2 + 4 * F.lane + 256 * j), bv = *(const f32x4*)(b2 + 4 * F.lane + 256 * j);
                const f32x4 h = (yv[r][j] - mu2[r]) * rs2[r] * gv + bv;
                const v2u a = ya[r][j], c = yc[r][j];
                const f32x4 fa = {bflo(a.x), bfhi(a.x), bflo(a.y), bfhi(a.y)}, fc = {bflo(c.x), bfhi(c.x), bflo(c.y), bfhi(c.y)};
                v[j] = h * ALPHA + fa * w0[r] + fc * w1[r]; s += (v[j][0] + v[j][1]) + (v[j][2] + v[j][3]); }
            const float mean = wave_sum(s) * (1.f / D); float s2 = 0.f;
#pragma unroll
            for (int j = 0; j < 8; ++j) { v[j] = v[j] - mean; s2 += (v[j][0] * v[j][0] + v[j][1] * v[j][1]) + (v[j][2] * v[j][2] + v[j][3] * v[j][3]); }
            const float rstd = 1.f / sqrtf(wave_sum(s2) * (1.f / D) + LN_EPS);
            GAS f32x4* orow = (GAS f32x4*)(F.out + (size_t)t * D) + F.lane;
#pragma unroll
            for (int j = 0; j < 8; ++j) { const f32x4 gv = *(const f32x4*)(g3 + 4 * F.lane + 256 * j), bv = *(const f32x4*)(b3 + 4 * F.lane + 256 * j);
                orow[64 * j] = v[j] * rstd * gv + bv; }
        }
    }
}

constexpr int CS = 128, NB = CS / 64, NS = T / CS;
#define HIDX(t_, c_) ((((size_t)((c_) >> 8)) * 8192 + (size_t)(t_)) * 256 + ((c_) & 255))
constexpr size_t WS_BCUM = WS_ORAW;
constexpr size_t WS_KVR = WS_ORAW + 16 * MiB;
constexpr size_t WS_KVG = WS_KVR + 32 * MiB;
typedef short bf16x8_t __attribute__((ext_vector_type(8)));
typedef short s16x4_t __attribute__((ext_vector_type(4)));
__device__ __forceinline__ s16x4_t lds_tr(const LAS unsigned char* p) { return __builtin_bit_cast(s16x4_t, __builtin_amdgcn_ds_read_tr16_b64_v4i16((LAS s16x4_t*)p)); }
__device__ __forceinline__ bf16x8_t frag_tr(const LAS unsigned char* X, int pitch, int k0, int n0, int lane) {
    const int fq = lane >> 4, q = (lane >> 2) & 3, p = lane & 3;
    const LAS unsigned char* a = X + ((k0 + 8 * fq + q) * pitch + n0 + 4 * p) * 2;
    const s16x4_t lo = lds_tr(a), hi = lds_tr(a + 4 * pitch * 2);
    return __builtin_shufflevector(lo, hi, 0, 1, 2, 3, 4, 5, 6, 7);
}
__device__ __forceinline__ bf16x8_t frag_row(const LAS unsigned char* X, int pitch, int r0, int k0, int lane) {
    return *(const LAS bf16x8_t*)(X + ((r0 + (lane & 15)) * pitch + k0 + 8 * (lane >> 4)) * 2);
}
#define MFMA16(a, b, c) __builtin_amdgcn_mfma_f32_16x16x32_bf16((a), (b), (c), 0, 0, 0)
__device__ __forceinline__ float fexp(float x) { return __builtin_amdgcn_exp2f(x * 1.4426950408889634f); }
__device__ __forceinline__ float silu_g(float g) { return g * __builtin_amdgcn_rcpf(1.0f + __builtin_amdgcn_exp2f(-1.4426950408889634f * g)); }

__device__ __forceinline__ void bcum_item(Frame& F, int s, int h) {
    const int c = F.tid & 127, tq = F.tid >> 7;
    LAS float* tot = (LAS float*)F.lds;
    LAS float* gl = (LAS float*)(F.lds + 2048);
    const float* glr = WSP(float, WS_GLR); float* bc = WSP(float, WS_BCUM);
    __syncthreads();
    *(LAS f32x4*)(gl + 4 * F.tid) = *(const GAS f32x4*)(glr + (size_t)s * CS * 16 + 4 * F.tid);
    float w[16];
#pragma unroll
    for (int r = 0; r < 16; ++r) w[r] = F.in[4][r * 512 + h * 128 + c];
    const float bias = F.in[5][h * 128 + c];
    __syncthreads();
    float vals[32]; float run = 0.f;
    const int tb = s * CS + tq * 32;
#pragma unroll
    for (int i = 0; i < 32; ++i) { const LAS float* gr = gl + (tq * 32 + i) * 16; float z = bias;
#pragma unroll
        for (int r = 0; r < 16; ++r) z += gr[r] * w[r];
        run += log_sigmoid_f(z) * 0.0625f; vals[i] = run; }
    tot[tq * 128 + c] = run;
    __syncthreads();
    float off = 0.f;
#pragma unroll
    for (int q = 0; q < 3; ++q) off += (q < tq) ? tot[q * 128 + c] : 0.f;
#pragma unroll
    for (int i = 0; i < 32; ++i) bc[(size_t)(tb + i) * 512 + h * 128 + c] = vals[i] + off;
}
__device__ __forceinline__ void p1_bcum(Frame& F, int first, int stride) { for (int it = first; it < NS * 4; it += stride) bcum_item(F, it >> 2, it & 3); __syncthreads(); }

__device__ __forceinline__ void unit_sh(int u, int& s, int& h8) { s = (u >> 3) & (NS - 1); h8 = ((u & 7) + 4 * (u >> 8)) & 7; }

template <bool GLA, int MODE>
__device__ __forceinline__ void stage_qk(Frame& F, LAS unsigned char* dst, int s, int jb, int hh, int col0, float lg2gamma) {
    constexpr int DK = GLA ? 128 : 256, PK = DK + 8, CPR = DK / 8, NIT = 64 * CPR / NTHR;
    const bf16* H = WSP(bf16, WS_H); const float* bc = WSP(float, WS_BCUM);
    v4u wv[NIT]; f32x4 b0[GLA ? NIT : 1], b1[GLA ? NIT : 1], l0[(GLA && MODE == 2) ? NIT : 1], l1[(GLA && MODE == 2) ? NIT : 1];
#pragma unroll
    for (int it = 0; it < NIT; ++it) {
        const int ch = F.tid + NTHR * it, r = ch / CPR, cc = ch % CPR, t = s * CS + jb * 64 + r;
        wv[it] = *(const GAS v4u*)(H + HIDX(t, col0 + 8 * cc));
        if (GLA) { b0[it] = *(const GAS f32x4*)(bc + (size_t)t * 512 + hh * 128 + 8 * cc); b1[it] = *(const GAS f32x4*)(bc + (size_t)t * 512 + hh * 128 + 8 * cc + 4);
            if (MODE == 2) { const size_t tl_ = (size_t)(s * CS + CS - 1) * 512 + hh * 128 + 8 * cc; l0[it] = *(const GAS f32x4*)(bc + tl_); l1[it] = *(const GAS f32x4*)(bc + tl_ + 4); } }
    }
#pragma unroll
    for (int it = 0; it < NIT; ++it) {
        const int ch = F.tid + NTHR * it, r = ch / CPR, cc = ch % CPR, tl = jb * 64 + r;
        const v4u w = wv[it];
        float f[8] = {bflo(w.x), bfhi(w.x), bflo(w.y), bfhi(w.y), bflo(w.z), bfhi(w.z), bflo(w.w), bfhi(w.w)};
        if (GLA) {
            float e[8] = {b0[it][0], b0[it][1], b0[it][2], b0[it][3], b1[it][0], b1[it][1], b1[it][2], b1[it][3]};
            if (MODE == 2) { const float l[8] = {l0[it][0], l0[it][1], l0[it][2], l0[it][3], l1[it][0], l1[it][1], l1[it][2], l1[it][3]};
#pragma unroll
                for (int i = 0; i < 8; ++i) e[i] = l[i] - e[i]; }
            else if (MODE == 1) {
#pragma unroll
                for (int i = 0; i < 8; ++i) e[i] = -e[i]; }
#pragma unroll
            for (int i = 0; i < 8; ++i) f[i] *= fexp(e[i]);
        } else {
            const float ex = MODE == 0 ? (float)(tl + 1) : MODE == 1 ? -(float)(tl + 1) : (float)(CS - 1 - tl);
            const float fac = __builtin_amdgcn_exp2f(ex * lg2gamma);
#pragma unroll
            for (int i = 0; i < 8; ++i) f[i] *= fac;
        }
        v4u o; o.x = pk2(f[0], f[1]); o.y = pk2(f[2], f[3]); o.z = pk2(f[4], f[5]); o.w = pk2(f[6], f[7]);
        *(LAS v4u*)(dst + (r * PK + 8 * cc) * 2) = o;
    }
}
__device__ __forceinline__ void stage_v(Frame& F, LAS unsigned char* dst, int s, int jb, int col0) {
    const bf16* H = WSP(bf16, WS_H);
    v4u wv[4];
#pragma unroll
    for (int it = 0; it < 4; ++it) { const int ch = F.tid + NTHR * it, r = ch >> 5, cc = ch & 31, t = s * CS + jb * 64 + r; wv[it] = *(const GAS v4u*)(H + HIDX(t, col0 + 8 * cc)); }
#pragma unroll
    for (int it = 0; it < 4; ++it) { const int ch = F.tid + NTHR * it, r = ch >> 5, cc = ch & 31; *(LAS v4u*)(dst + (r * 264 + 8 * cc) * 2) = wv[it]; }
}

template <bool GLA>
__device__ __forceinline__ void kv_unit(Frame& F, int s, int hh) {
    constexpr int DK = GLA ? 128 : 256, PK = DK + 8, NDT = DK / 16;
    LAS unsigned char* Ks = F.lds; LAS unsigned char* Vs = F.lds + 34816;
    const int kcol = GLA ? 4608 + hh * 128 : 1024 + hh * 256, vcol = (GLA ? 5120 : 2048) + hh * 256;
    const float lg2g = log2f(1.0f - exp2f(-5.0f - (float)hh));
    f32x4 acc[2][NDT];
#pragma unroll
    for (int a = 0; a < 2; ++a)
#pragma unroll
        for (int d = 0; d < NDT; ++d) acc[a][d] = (f32x4){0.f, 0.f, 0.f, 0.f};
    for (int jb = 0; jb < NB; ++jb) {
        __syncthreads();
        stage_qk<GLA, 2>(F, Ks, s, jb, hh, kcol, lg2g);
        stage_v(F, Vs, s, jb, vcol);
        __syncthreads();
#pragma unroll
        for (int ks = 0; ks < 2; ++ks) {
            bf16x8_t vf[2];
#pragma unroll
            for (int et = 0; et < 2; ++et) vf[et] = frag_tr(Vs, 264, 32 * ks, 32 * F.wave + 16 * et, F.lane);
#pragma unroll
            for (int dt = 0; dt < NDT; ++dt) { const bf16x8_t kf = frag_tr(Ks, PK, 32 * ks, 16 * dt, F.lane);
#pragma unroll
                for (int et = 0; et < 2; ++et) acc[et][dt] = MFMA16(kf, vf[et], acc[et][dt]); }
        }
    }
    bf16* kv = GLA ? (WSP(bf16, WS_KVG) + (size_t)(s * 4 + hh) * 256 * 128) : (WSP(bf16, WS_KVR) + (size_t)(s * 4 + hh) * 256 * 256);
    const int fr = F.lane & 15, fq = F.lane >> 4;
#pragma unroll
    for (int et = 0; et < 2; ++et)
#pragma unroll
        for (int dt = 0; dt < NDT; ++dt) { v2u w; w.x = pk2(acc[et][dt][0], acc[et][dt][1]); w.y = pk2(acc[et][dt][2], acc[et][dt][3]);
            *(GAS v2u*)(kv + (size_t)(32 * F.wave + 16 * et + fr) * DK + 16 * dt + 4 * fq) = w; }
}
__device__ __forceinline__ void p2_kv(Frame& F) {
    for (int u = F.bid; u < 8 * NS; u += F.G) { int s, h8; unit_sh(u, s, h8);
        if (s == NS - 1) continue;
        if (h8 < 4) kv_unit<false>(F, s, h8); else kv_unit<true>(F, s, h8 - 4); }
    __syncthreads();
}
__device__ __forceinline__ void p3_scan(Frame& F) {
    constexpr int NR = 4 * 256 * 64, NG = 4 * 256 * 32, NITEM = NR + NG;
    const float* bc = WSP(float, WS_BCUM);
    const int per = (NITEM + F.G - 1) / F.G;
    for (int k0 = F.tid; k0 < per; k0 += NTHR) {
      const int it = F.bid * per + k0;
      if (it < NITEM) {
        const bool gla = it >= NR; const int r = gla ? it - NR : it;
        const int sh = gla ? 5 : 6, dk = gla ? 128 : 256;
        const int cc = r & ((1 << sh) - 1), e = (r >> sh) & 255, hh = r >> (sh + 8);
        bf16* base = (gla ? WSP(bf16, WS_KVG) : WSP(bf16, WS_KVR)) + ((size_t)hh * 256 + e) * dk + 4 * cc;
        const size_t sstride = (size_t)4 * 256 * dk;
        const float dret = __builtin_amdgcn_exp2f((float)CS * log2f(1.0f - exp2f(-5.0f - (float)hh)));
        float S[4] = {0.f, 0.f, 0.f, 0.f};
        static_assert(NS - 1 == 63, "batching below assumes 63 steps");
#pragma unroll 1
        for (int s0 = 0; s0 < NS - 1; s0 += 21) {
            v2u wv[21]; f32x4 lv[21];
#pragma unroll
            for (int j = 0; j < 21; ++j) { wv[j] = *(const GAS v2u*)(base + (size_t)(s0 + j) * sstride);
                if (gla) lv[j] = *(const GAS f32x4*)(bc + (size_t)((s0 + j) * CS + CS - 1) * 512 + hh * 128 + 4 * cc); else lv[j] = (f32x4){0.f, 0.f, 0.f, 0.f}; }
#pragma unroll
            for (int j = 0; j < 21; ++j) {
                v2u o; o.x = pk2(S[0], S[1]); o.y = pk2(S[2], S[3]);
                *(GAS v2u*)(base + (size_t)(s0 + j) * sstride) = o;
                const float f[4] = {bflo(wv[j].x), bfhi(wv[j].x), bflo(wv[j].y), bfhi(wv[j].y)};
                float dec[4] = {dret, dret, dret, dret};
                if (gla) { dec[0] = fexp(lv[j][0]); dec[1] = fexp(lv[j][1]); dec[2] = fexp(lv[j][2]); dec[3] = fexp(lv[j][3]); }
#pragma unroll
                for (int i = 0; i < 4; ++i) S[i] = dec[i] * S[i] + f[i];
            }
        }
        { GAS v2u* p = (GAS v2u*)(base + (size_t)(NS - 1) * sstride); v2u o; o.x = pk2(S[0], S[1]); o.y = pk2(S[2], S[3]); *p = o; }
      }
    }
}
template <bool GLA>
__device__ __forceinline__ void out_unit(Frame& F, int s, int hh) {
    constexpr int DK = GLA ? 128 : 256, PK = DK + 8, NKS = DK / 32;
    LAS unsigned char* Qs = F.lds; LAS unsigned char* Ks = F.lds + 33792; LAS unsigned char* Vs = F.lds + 67584; LAS unsigned char* Ps = F.lds + 101376;
    LAS float* red = (LAS float*)(F.lds + 110592);
    const int qcol = GLA ? 4096 + hh * 128 : hh * 256, kcol = GLA ? 4608 + hh * 128 : 1024 + hh * 256, vcol = (GLA ? 5120 : 2048) + hh * 256;
    const int gcol = (GLA ? 6144 : 3072) + hh * 256, ocol = (GLA ? 1024 : 0) + hh * 256;
    const float lg2g = log2f(1.0f - exp2f(-5.0f - (float)hh));
    const bf16* H = WSP(bf16, WS_H); bf16* mixed = WSP(bf16, WS_MIXED);
    const bf16* st = GLA ? (WSP(bf16, WS_KVG) + (size_t)(s * 4 + hh) * 256 * 128) : (WSP(bf16, WS_KVR) + (size_t)(s * 4 + hh) * 256 * 256);
    const int fr = F.lane & 15, fq = F.lane >> 4, w = F.wave, mt = w >> 1, nt0 = 2 * (w & 1);
    static_assert(NB == 2, "the step program below is written for two 64-token sub-blocks");
    f32x4 accO[4][2]; bf16x8_t sfa[NKS][2]; v2u gpre[4][2];
#pragma unroll 1
    for (int step = 0; step < 3; ++step) {
        const int i = step > 0 ? 1 : 0, j = step > 1 ? 1 : 0;
        {
            __syncthreads();
            if (step < 2) stage_qk<GLA, 0>(F, Qs, s, i, hh, qcol, lg2g);
            if (step != 1) { stage_qk<GLA, 1>(F, Ks, s, j, hh, kcol, lg2g); stage_v(F, Vs, s, j, vcol); }
            if (step < 2) {
#pragma unroll
                for (int m = 0; m < 4; ++m)
#pragma unroll
                    for (int n = 0; n < 2; ++n) accO[m][n] = (f32x4){0.f, 0.f, 0.f, 0.f};
            }
            if (step != 1) {
                if (s > 0) {
#pragma unroll
                    for (int ks = 0; ks < NKS; ++ks)
#pragma unroll
                        for (int n = 0; n < 2; ++n) sfa[ks][n] = *(const GAS bf16x8_t*)(st + (size_t)(32 * w + 16 * n + fr) * DK + 32 * ks + 8 * fq);
                }
#pragma unroll
                for (int m2 = 0; m2 < 4; ++m2)
#pragma unroll
                    for (int n = 0; n < 2; ++n) gpre[m2][n] = *(const GAS v2u*)(H + HIDX(s * CS + i * 64 + 16 * m2 + fr, gcol + 32 * w + 16 * n + 4 * fq));
            }
            __syncthreads();
            f32x4 accS[2] = {(f32x4){0.f, 0.f, 0.f, 0.f}, (f32x4){0.f, 0.f, 0.f, 0.f}};
#pragma unroll
            for (int ks = 0; ks < NKS; ++ks) { const bf16x8_t qf = frag_row(Qs, PK, 16 * mt, 32 * ks, F.lane);
#pragma unroll
                for (int n2 = 0; n2 < 2; ++n2) { const bf16x8_t kf = frag_row(Ks, PK, 16 * (nt0 + n2), 32 * ks, F.lane); accS[n2] = MFMA16(kf, qf, accS[n2]); } }
#pragma unroll
            for (int n2 = 0; n2 < 2; ++n2) { const int row = 16 * mt + fr, c0 = 16 * (nt0 + n2) + 4 * fq; float pv[4];
#pragma unroll
                for (int jj = 0; jj < 4; ++jj) pv[jj] = (i == j && c0 + jj > row) ? 0.f : accS[n2][jj];
                v2u pw; pw.x = pk2(pv[0], pv[1]); pw.y = pk2(pv[2], pv[3]);
                *(LAS v2u*)(Ps + (row * 72 + c0) * 2) = pw; }
            __syncthreads();
#pragma unroll
            for (int ks = 0; ks < 2; ++ks) {
                bf16x8_t vf[2];
#pragma unroll
                for (int n = 0; n < 2; ++n) vf[n] = frag_tr(Vs, 264, 32 * ks, 32 * w + 16 * n, F.lane);
#pragma unroll
                for (int m = 0; m < 4; ++m) { const bf16x8_t pf = frag_row(Ps, 72, 16 * m, 32 * ks, F.lane);
#pragma unroll
                    for (int n = 0; n < 2; ++n) accO[m][n] = MFMA16(vf[n], pf, accO[m][n]); }
            }
        }
        if (step == 1) continue;
        if (s > 0) {
#pragma unroll
            for (int ks = 0; ks < NKS; ++ks) {
#pragma unroll
                for (int m = 0; m < 4; ++m) { const bf16x8_t qf = frag_row(Qs, PK, 16 * m, 32 * ks, F.lane);
#pragma unroll
                    for (int n = 0; n < 2; ++n) accO[m][n] = MFMA16(sfa[ks][n], qf, accO[m][n]); }
            }
        }
#pragma unroll
        for (int m = 0; m < 4; ++m) { float s1 = 0.f, s2 = 0.f;
#pragma unroll
            for (int n = 0; n < 2; ++n)
#pragma unroll
                for (int jj = 0; jj < 4; ++jj) { const float v = accO[m][n][jj]; s1 += v; s2 += v * v; }
            s1 += __shfl_xor(s1, 16); s1 += __shfl_xor(s1, 32); s2 += __shfl_xor(s2, 16); s2 += __shfl_xor(s2, 32);
            if (fq == 0) { red[(w * 64 + 16 * m + fr) * 2] = s1; red[(w * 64 + 16 * m + fr) * 2 + 1] = s2; } }
        __syncthreads();
#pragma unroll
        for (int m = 0; m < 4; ++m) { const int row = 16 * m + fr; float s1 = 0.f, s2 = 0.f;
#pragma unroll
            for (int ww = 0; ww < 8; ++ww) { s1 += red[(ww * 64 + row) * 2]; s2 += red[(ww * 64 + row) * 2 + 1]; }
            const float mean = s1 * (1.f / 256.f), ex2 = s2 * (1.f / 256.f);
            const float mu = GLA ? 0.f : mean, var = GLA ? ex2 : fmaxf(ex2 - mean * mean, 0.f);
            const float rstd = 1.0f / sqrtf(var + LN_EPS);
            const int t = s * CS + i * 64 + row;
#pragma unroll
            for (int n = 0; n < 2; ++n) { const int e = 32 * w + 16 * n + 4 * fq;
                const v2u gw2 = gpre[m][n];
                const float gt[4] = {bflo(gw2.x), bfhi(gw2.x), bflo(gw2.y), bfhi(gw2.y)};
                f32x4 gn = {1.f, 1.f, 1.f, 1.f}; if (GLA) gn = *(const f32x4*)(F.in[6] + e);
                float r4[4];
#pragma unroll
                for (int jj = 0; jj < 4; ++jj) { const float y = (accO[m][n][jj] - mu) * rstd * gn[jj]; r4[jj] = silu_g(gt[jj]) * y; }
                v2u ow; ow.x = pk2(r4[0], r4[1]); ow.y = pk2(r4[2], r4[3]);
                *(GAS v2u*)(mixed + (size_t)t * D + ocol + e) = ow; } }
    }
}
__device__ __forceinline__ void p4_out(Frame& F) {
    for (int u = F.bid; u < 8 * NS; u += F.G) { int s, h8; unit_sh(u, s, h8);
        if (h8 < 4) out_unit<false>(F, s, h8); else out_unit<true>(F, s, h8 - 4); }
    __syncthreads();
}

__device__ __forceinline__ void kv_chunk_load(Frame& F, v4u (&R)[8], const bf16* src  ) {
#pragma unroll
    for (int it = 0; it < 8; ++it) { const int ch = F.tid + NTHR * it, r = ch >> 4, cc = ch & 15; R[it] = *(const GAS v4u*)(src + (size_t)r * 4096 + 8 * cc); }
}
__device__ __forceinline__ void kv_chunk_store(Frame& F, const v4u (&R)[8], LAS unsigned char* dst) {
#pragma unroll
    for (int it = 0; it < 8; ++it) { const int ch = F.tid + NTHR * it, r = ch >> 4, cc = ch & 15; *(LAS v4u*)(dst + (r * 136 + 8 * cc) * 2) = R[it]; }
}
__device__ __forceinline__ void p8_attn(Frame& F) {
    const bf16* Q = WSP(bf16, WS_QB); const bf16* KVM = WSP(bf16, WS_KVM); bf16* att = WSP(bf16, WS_ATT);
    constexpr int CB = 256 * 136 * 2;
    const int fr = F.lane & 15, fq = F.lane >> 4, q4 = (F.lane >> 2) & 3, p4 = F.lane & 3;
    for (int u = F.bid; u < (T / 128) * 4; u += F.G) {
        const int h = u & 3, r0 = (u >> 2) * 128 + 16 * F.wave;
        v4u R[8];
        bf16x8_t qa[16];
#pragma unroll
        for (int ks = 0; ks < 16; ++ks) qa[ks] = *(const GAS bf16x8_t*)(Q + (size_t)(r0 + fr) * D + h * 512 + 32 * ks + 8 * fq);
        __syncthreads();
        kv_chunk_load(F, R, KVM + h * 512); kv_chunk_store(F, R, F.lds);
        __syncthreads();
        f32x4 accS[16];
#pragma unroll
        for (int i = 0; i < 16; ++i) accS[i] = (f32x4){0.f, 0.f, 0.f, 0.f};
#pragma unroll
        for (int dc = 0; dc < 4; ++dc) {
            kv_chunk_load(F, R, dc < 3 ? KVM + h * 512 + (dc + 1) * 128 : KVM + 2048 + h * 512);
            const LAS unsigned char* Cs = F.lds + (dc & 1) * CB;
#pragma unroll
            for (int ks = 0; ks < 4; ++ks)
#pragma unroll
                for (int nt = 0; nt < 16; ++nt) accS[nt] = MFMA16(frag_row(Cs, 136, 16 * nt, 32 * ks, F.lane), qa[4 * dc + ks], accS[nt]);
            kv_chunk_store(F, R, F.lds + ((dc + 1) & 1) * CB);
            __syncthreads();
        }
        float mx = -3.0e38f;
#pragma unroll
        for (int nt = 0; nt < 16; ++nt)
#pragma unroll
            for (int jj = 0; jj < 4; ++jj) mx = fmaxf(mx, accS[nt][jj]);
        mx = fmaxf(mx, __shfl_xor(mx, 16)); mx = fmaxf(mx, __shfl_xor(mx, 32));
        const float sl2 = 0.04419417382415922f * 1.4426950408889634f;
        float sm = 0.f;
#pragma unroll
        for (int nt = 0; nt < 16; ++nt)
#pragma unroll
            for (int jj = 0; jj < 4; ++jj) { const float p = __builtin_amdgcn_exp2f((accS[nt][jj] - mx) * sl2); accS[nt][jj] = p; sm += p; }
        sm += __shfl_xor(sm, 16); sm += __shfl_xor(sm, 32);
        const float inv = 1.0f / sm;
        bf16x8_t pf[8];
#pragma unroll
        for (int ks2 = 0; ks2 < 8; ++ks2) { v4u w; w.x = pk2(accS[2 * ks2][0] * inv, accS[2 * ks2][1] * inv); w.y = pk2(accS[2 * ks2][2] * inv, accS[2 * ks2][3] * inv);
            w.z = pk2(accS[2 * ks2 + 1][0] * inv, accS[2 * ks2 + 1][1] * inv); w.w = pk2(accS[2 * ks2 + 1][2] * inv, accS[2 * ks2 + 1][3] * inv); pf[ks2] = __builtin_bit_cast(bf16x8_t, w); }
#pragma unroll 1
        for (int ec = 0; ec < 4; ++ec) {
            if (ec < 3) kv_chunk_load(F, R, KVM + 2048 + h * 512 + (ec + 1) * 128);
            const LAS unsigned char* Cs = F.lds + (ec & 1) * CB;
            f32x4 accO[8];
#pragma unroll
            for (int i = 0; i < 8; ++i) accO[i] = (f32x4){0.f, 0.f, 0.f, 0.f};
#pragma unroll
            for (int ks2 = 0; ks2 < 8; ++ks2)
#pragma unroll
                for (int et = 0; et < 8; ++et) { const LAS unsigned char* a = Cs + ((32 * ks2 + 4 * fq + q4) * 136 + 16 * et + 4 * p4) * 2;
                    const s16x4_t lo = lds_tr(a), hi = lds_tr(a + 16 * 136 * 2);
                    accO[et] = MFMA16(__builtin_shufflevector(lo, hi, 0, 1, 2, 3, 4, 5, 6, 7), pf[ks2], accO[et]); }
#pragma unroll
            for (int et = 0; et < 8; ++et) { v2u w; w.x = pk2(accO[et][0], accO[et][1]); w.y = pk2(accO[et][2], accO[et][3]);
                *(GAS v2u*)(att + (size_t)(r0 + fr) * D + h * 512 + ec * 128 + 16 * et + 4 * fq) = w; }
            if (ec < 3) kv_chunk_store(F, R, F.lds + ((ec + 1) & 1) * CB);
            __syncthreads();
        }
    }
}

__device__ __forceinline__ void p10_ln_router(Frame& F) {
    const float* Y = WSP(float, WS_Y2); const float* g = F.in[14]; const float* b = F.in[15]; bf16* HB = WSP(bf16, WS_H2B); float* st = WSP(float, WS_ST2);
    const float* Wg = F.in[16]; const float* We = F.in[18];
    LAS float* stl = (LAS float*)F.lds;
    LAS float* part = (LAS float*)(F.lds + 1024);
    LAS int* lcnt = (LAS int*)(F.lds + 1024 + 24576);
    LAS int* lbase = lcnt + 32;
    if (F.tid < 32) lcnt[F.tid] = 0;
    { int* tok = WSP(int, WS_TOK); for (int i = F.bid * NTHR + F.tid; i < PMAX; i += F.G * NTHR) tok[i] = 0; }
    __syncthreads();
    const int fr = F.lane & 15, fq = F.lane >> 4;
    for (int item = F.bid; item < T / 32; item += F.G) {
        const int row0 = item * 32;
#pragma unroll
        for (int i = 0; i < 4; ++i) {
            const int t = row0 + 4 * F.wave + i;
            const GAS f32x4* yr = (const GAS f32x4*)(Y + (size_t)t * D) + F.lane;
            f32x4 v[8]; float s = 0.f;
#pragma unroll
            for (int j = 0; j < 8; ++j) { v[j] = yr[64 * j]; s += (v[j][0] + v[j][1]) + (v[j][2] + v[j][3]); }
            const float mean = wave_sum(s) * (1.f / D); float s2 = 0.f;
#pragma unroll
            for (int j = 0; j < 8; ++j) { v[j] = v[j] - mean; s2 += (v[j][0] * v[j][0] + v[j][1] * v[j][1]) + (v[j][2] * v[j][2] + v[j][3] * v[j][3]); }
            const float rstd = 1.f / sqrtf(wave_sum(s2) * (1.f / D) + LN_EPS);
            if (F.lane == 0) { st[2 * t] = mean; st[2 * t + 1] = rstd; stl[2 * (4 * F.wave + i)] = mean; stl[2 * (4 * F.wave + i) + 1] = rstd; }
            GAS v2u* o8 = (GAS v2u*)(HB + (size_t)t * D) + F.lane;
#pragma unroll
            for (int j = 0; j < 8; ++j) { const f32x4 gv = *(const f32x4*)(g + 4 * F.lane + 256 * j), bv = *(const f32x4*)(b + 4 * F.lane + 256 * j);
                const f32x4 hv = v[j] * rstd * gv + bv;
                v2u w; w.x = pk2(hv[0], hv[1]); w.y = pk2(hv[2], hv[3]); o8[64 * j] = w; }
        }
        __syncthreads();
        {
            const int rt = F.wave >> 2, kq = F.wave & 3;
            const int r = row0 + 16 * rt + fr;
            const float mu = stl[2 * (16 * rt + fr)], rstd = stl[2 * (16 * rt + fr) + 1];
            f32x4 acc0 = {0.f, 0.f, 0.f, 0.f}, acc1 = acc0, acc2 = acc0;
            const float* yp = Y + (size_t)r * D + 512 * kq + 4 * fq;
            const float* wep = We + (size_t)(512 * kq + 4 * fq) * 32 + fr;
            const float* wgp = Wg + (size_t)(512 * kq + 4 * fq) * 4 + (fr & 3);
            const float gm = fr < 4 ? 1.f : 0.f;
#pragma unroll 8
            for (int it = 0; it < 32; ++it) {
                const int k0 = 16 * it;
                const f32x4 y4 = *(const GAS f32x4*)(yp + k0), g4 = *(const f32x4*)(g + 512 * kq + 4 * fq + k0), b4 = *(const f32x4*)(b + 512 * kq + 4 * fq + k0);
                const f32x4 a = (y4 - mu) * rstd * g4 + b4;
#pragma unroll
                for (int s = 0; s < 4; ++s) {
                    const float b0 = wep[(size_t)(k0 + s) * 32], b1 = wep[(size_t)(k0 + s) * 32 + 16], b2 = wgp[(size_t)(k0 + s) * 4] * gm;
                    acc0 = __builtin_amdgcn_mfma_f32_16x16x4f32(a[s], b0, acc0, 0, 0, 0);
                    acc1 = __builtin_amdgcn_mfma_f32_16x16x4f32(a[s], b1, acc1, 0, 0, 0);
                    acc2 = __builtin_amdgcn_mfma_f32_16x16x4f32(a[s], b2, acc2, 0, 0, 0);
                }
            }
            LAS float* pw = part + F.wave * 768;
#pragma unroll
            for (int jj = 0; jj < 4; ++jj) { pw[(4 * fq + jj) * 48 + fr] = acc0[jj]; pw[(4 * fq + jj) * 48 + 16 + fr] = acc1[jj]; pw[(4 * fq + jj) * 48 + 32 + fr] = acc2[jj]; }
        }
        __syncthreads();
        int e1 = 0, e2 = 0, r1 = 0, r2 = 0; float g1 = 0.f, g2 = 0.f;
        if (F.tid < 32) {
            const int rt = F.tid >> 4, rr = F.tid & 15;
            float le[32], lg[4];
#pragma unroll
            for (int c = 0; c < 32; ++c) { float s = 0.f;
#pragma unroll
                for (int kq = 0; kq < 4; ++kq) s += part[(rt * 4 + kq) * 768 + rr * 48 + c]; le[c] = s; }
#pragma unroll
            for (int c = 0; c < 4; ++c) { float s = 0.f;
#pragma unroll
                for (int kq = 0; kq < 4; ++kq) s += part[(rt * 4 + kq) * 768 + rr * 48 + 32 + c]; lg[c] = s + F.in[17][c]; }
            int grp = 0; float gmx = lg[0];
#pragma unroll
            for (int i = 1; i < 4; ++i) if (lg[i] > gmx) { gmx = lg[i]; grp = i; }
            float gs = 0.f;
#pragma unroll
            for (int i = 0; i < 4; ++i) gs += expf(lg[i] - gmx);
            const float pg_sel = 1.0f / gs;
            float fe[8];
#pragma unroll
            for (int j = 0; j < 8; ++j) { const float a = grp == 0 ? le[j] : grp == 1 ? le[8 + j] : grp == 2 ? le[16 + j] : le[24 + j]; fe[j] = a + F.in[19][grp * 8 + j]; }
            int i1 = 0; float m1 = fe[0];
#pragma unroll
            for (int j = 1; j < 8; ++j) if (fe[j] > m1) { m1 = fe[j]; i1 = j; }
            int i2 = -1; float m2 = -3.0e38f;
#pragma unroll
            for (int j = 0; j < 8; ++j) if (j != i1 && fe[j] > m2) { m2 = fe[j]; i2 = j; }
            const float p2 = expf(m2 - m1), den = 1.0f / (1.0f + p2);
            e1 = grp * 8 + i1; e2 = grp * 8 + i2; g1 = pg_sel * den; g2 = pg_sel * p2 * den;
            r1 = __hip_atomic_fetch_add((int*)(lcnt + e1), 1, __ATOMIC_RELAXED, __HIP_MEMORY_SCOPE_WORKGROUP); r2 = __hip_atomic_fetch_add((int*)(lcnt + e2), 1, __ATOMIC_RELAXED, __HIP_MEMORY_SCOPE_WORKGROUP);
        }
        __syncthreads();
        if (F.tid < 32) { const int c = lcnt[F.tid];
            lbase[F.tid] = c ? (int)__hip_atomic_fetch_add((unsigned*)(F.ctl + CW_CUR) + F.tid, (unsigned)c, __ATOMIC_RELAXED, __HIP_MEMORY_SCOPE_AGENT) : 0; }
        __syncthreads();
        if (F.tid < 32) {
            const int t = row0 + F.tid;
            int* ex = WSP(int, WS_EXP); float* gt = WSP(float, WS_GATE); int* sl = WSP(int, WS_SLOT);
            ex[2 * t] = e1; ex[2 * t + 1] = e2; gt[2 * t] = g1; gt[2 * t + 1] = g2;
            sl[2 * t] = lbase[e1] + r1; sl[2 * t + 1] = lbase[e2] + r2;
            lcnt[F.tid] = 0;
        }
        __syncthreads();
    }
}


#define XB_TMO      128
#define XB_XCNT(j)  (256  + 64 * (j))
#define XB_XSUB(j)  (1280 + 64 * (j))
#define XB_XGEN(j)  (2304 + 64 * (j))
#define XB_TOP      3328
#define XB_TOPGEN   3392
#define XCD_BAR_WORDS 3456
#define XB_SPIN_CAP (1u << 22)
__device__ __forceinline__ unsigned xb_ld(unsigned* p)              { return __hip_atomic_load(p, __ATOMIC_RELAXED, __HIP_MEMORY_SCOPE_AGENT); }
__device__ __forceinline__ unsigned xb_add(unsigned* p, unsigned v) { return __hip_atomic_fetch_add(p, v, __ATOMIC_RELAXED, __HIP_MEMORY_SCOPE_AGENT); }
__device__ __forceinline__ unsigned xb_xcc_id() { return (unsigned)__builtin_amdgcn_s_getreg((3 << 11) | 20) & 0xFu; }
#define XB_SPIN(cond, bar) do { unsigned _sp = 0; while (cond) { __builtin_amdgcn_s_sleep(1); \
    if ((++_sp & 255u) == 0u) { if (xb_ld(&(bar)[XB_TMO])) break; if (_sp > XB_SPIN_CAP) { atomicAdd(&(bar)[XB_TMO], 1u); break; } } } } while (0)
struct XcdBarrier { unsigned* bar; unsigned x; volatile LAS unsigned* st; };
__device__ __forceinline__ XcdBarrier xcd_barrier_post(unsigned* bar, volatile LAS unsigned* st) {
    XcdBarrier b; b.bar = bar; b.x = xb_xcc_id(); b.st = st;
    if (threadIdx.x == 0) (void)xb_add(&bar[XB_XCNT(b.x)], 1u);
    return b;
}
__device__ __forceinline__ void xcd_barrier_complete(unsigned* bar, unsigned x, unsigned& nloc, unsigned& nx) {
    const unsigned G = gridDim.x * gridDim.y * gridDim.z;
    unsigned sum, cnt, mine, sp = 0u;
    for (;;) {
        sum = 0u; cnt = 0u; mine = 0u;
#pragma unroll
        for (unsigned j = 0; j < 16; ++j) { const unsigned c = xb_ld(&bar[XB_XCNT(j)]); sum += c; cnt += (c > 0u) ? 1u : 0u; mine = (j == x) ? c : mine; }
        if (sum == G) break;
        __builtin_amdgcn_s_sleep(1);
        if ((++sp & 255u) == 0u) { if (xb_ld(&bar[XB_TMO])) break; if (sp > XB_SPIN_CAP) { atomicAdd(&bar[XB_TMO], 1u); break; } }
    }
    nloc = mine > 0u ? mine : 1u; nx = cnt > 0u ? cnt : 1u;
}
__device__ __forceinline__ void xcd_barrier(const XcdBarrier& b) {
    asm volatile("s_waitcnt vmcnt(0)" ::: "memory");
    __syncthreads();
    if (threadIdx.x == 0) {
        unsigned* bar = b.bar;
        __builtin_amdgcn_s_waitcnt(0);
        unsigned nloc = b.st[0], nx = b.st[1];
        if (nloc == 0u) { xcd_barrier_complete(bar, b.x, nloc, nx); b.st[0] = nloc; b.st[1] = nx; }
        const unsigned old = xb_add(&bar[XB_XSUB(b.x)], 1u);
        const unsigned gen = old / nloc;
        if (old + 1u == (gen + 1u) * nloc) {
            __builtin_amdgcn_fence(__ATOMIC_RELEASE, "agent");
            asm volatile("s_waitcnt vmcnt(0)" ::: "memory");
            const unsigned og = xb_add(&bar[XB_TOP], 1u);
            const unsigned tg = og / nx;
            if (og + 1u == (tg + 1u) * nx) xb_add(&bar[XB_TOPGEN], 1u);
            else XB_SPIN(xb_ld(&bar[XB_TOPGEN]) == tg, bar);
            __builtin_amdgcn_fence(__ATOMIC_ACQUIRE, "agent");
            xb_add(&bar[XB_XGEN(b.x)], 1u);
            asm volatile("s_waitcnt vmcnt(0)" ::: "memory");
        } else {
            XB_SPIN(xb_ld(&bar[XB_XGEN(b.x)]) == gen, bar);
            __builtin_amdgcn_fence(__ATOMIC_ACQUIRE, "agent");
            asm volatile("s_waitcnt vmcnt(0)" ::: "memory");
        }
    }
    __syncthreads();
}

struct Args { const float* in[25]; float* out; unsigned char* ws; int ph_lo, ph_hi, use_bar, pad; };
__global__ void __launch_bounds__(NTHR, 2) mega(Args args) {
    extern __shared__ __attribute__((aligned(16))) unsigned char lds[];
    Frame F;
    F.lds = (LAS unsigned char*)lds;
    F.MISC = (volatile LAS unsigned*)(F.lds + MISC_OFF);
    F.tid = threadIdx.x; F.lane = F.tid & 63; F.wave = __builtin_amdgcn_readfirstlane(F.tid >> 6);
    F.G = gridDim.x; F.bid = blockIdx.x;
    F.ws = args.ws; F.ctl = (gu32*)(args.ws + WS_CTL);
#pragma unroll
    for (int i = 0; i < 25; ++i) F.in[i] = args.in[i];
    F.out = args.out;
    for (int u = F.tid; u < (LDS_BYTES - LDSCTL_OFF) / 4; u += NTHR) ((LAS unsigned*)(F.lds + LDSCTL_OFF))[u] = 0u;
    __syncthreads();
    LAS int* ts = (LAS int*)(F.lds + MISC_OFF + 64);
    XcdBarrier bar; bar.bar = (unsigned*)(F.ctl + CW_BAR); bar.x = 0; bar.st = nullptr;
    if (args.use_bar) bar = xcd_barrier_post((unsigned*)(F.ctl + CW_BAR), F.MISC + 8);
    const int lo = args.ph_lo, hi = args.ph_hi;
#if PROBE_T >= 0
    unsigned long long pt0 = __builtin_amdgcn_s_memrealtime(), pdelay = 0ull;
#endif
#if MK_CG_SYNC == 2
    if (args.use_bar == 2) cooperative_groups::this_grid().sync();
#endif
#define IN(k) (lo <= (k) && (k) < hi)
#if PROBE_T >= 0
#define PROBE_STAMP(k) do { if ((k) == PROBE_T) pdelay = __builtin_amdgcn_s_memrealtime() - pt0; } while (0)
#else
#define PROBE_STAMP(k) do { } while (0)
#endif
#define REPS(k) for (int _r = 0; _r < ((k) == PROBE_PH ? PROBE_N : 1); ++_r)
#define SEAM(k) do { if (IN(k) && IN((k) + 1)) { if (MK_CG_SYNC == 1 && (k) == 0) cooperative_groups::this_grid().sync(); else { xcd_barrier(bar); if (PROBE_PH == 100) for (int _b = 1; _b < PROBE_N; ++_b) xcd_barrier(bar); } PROBE_STAMP(k); } } while (0)

    if (IN(0)) { REPS(0) p0_prologue(F); SEAM(0); }
    if (IN(1)) {
        p1_bcum(F, F.bid, F.G);
        const int g8 = F.bid >> 3, nsb = (g8 * NSG) >> 5; const bool streamer = (F.G == 256) && ((((g8 + 1) * NSG) >> 5) != nsb);
        if (!streamer) {
            pg8::Gemm g{WSP(pg8::bf16_t, WS_XB), WSP(pg8::bf16_t, WS_WIN), T + MEMN, HW + 4096, D}; pg8::OrderG1 S;
            if (F.G == 256) S.init(F.G - 8 * NSG, F.bid - 8 * nsb); else S.init(F.G, F.bid);
            pg8::EpiH E{WSP(pg8::bf16_t, WS_H), WSP(pg8::bf16_t, WS_KVM), WSP(float, WS_RC), WSP(float, WS_RS)};
            pg8::gemm_phase<pg8::EpiH, pg8::OrderG1, true, true>(F.lds, g, S, E);
        }
        transpose_queue(F);
        if (PROBE_PH == 102) for (int _q = 1; _q < PROBE_N; ++_q) transpose_queue(F, _q);
        SEAM(1);
    }
#if PROBE_PH == 101
    if (IN(1)) {
        pg8::Gemm g{WSP(pg8::bf16_t, WS_XB), WSP(pg8::bf16_t, WS_WIN), T + MEMN, HW + 4096, D}; pg8::OrderG1 S; S.init(F.G, F.bid);
        pg8::EpiH E{WSP(pg8::bf16_t, WS_H), WSP(pg8::bf16_t, WS_KVM), WSP(float, WS_RC), WSP(float, WS_RS)};
        pg8::gemm_phase<pg8::EpiH, pg8::OrderG1, true, true>(F.lds, g, S, E);
        xcd_barrier(bar);
    }
#endif
    if (IN(2)) { REPS(2) p2_kv(F); SEAM(2); }
    if (IN(3)) { p3_scan(F); SEAM(3); }
#if PROBE_PH == 103
    if (IN(3)) { p2_kv(F); xcd_barrier(bar); p3_scan(F); xcd_barrier(bar); }
#endif
    if (IN(4)) { REPS(4) p4_out(F); SEAM(4); }
    if (IN(5)) {
        pg8::Gemm g{WSP(pg8::bf16_t, WS_MIXED), WSP(pg8::bf16_t, WS_WMIX), T, D, D}; pg8::StaticOrder S; S.init(T, D, F.G, F.bid);
        pg8::EpiResX E{F.in[0], WSP(float, WS_Y1), ALPHA};
        REPS(5) pg8::gemm_phase<pg8::EpiResX, pg8::StaticOrder, true, true>(F.lds, g, S, E);
        SEAM(5);
    }
    if (IN(6)) { REPS(6) ln_apply_plain(F, WSP(float, WS_Y1), F.in[8], F.in[9], WSP(bf16, WS_H1B), WSP(float, WS_ST1)); SEAM(6); }
    if (IN(7)) {
        pg8::Gemm g{WSP(pg8::bf16_t, WS_H1B), WSP(pg8::bf16_t, WS_WMQ), T, D, D}; pg8::StaticOrder S; S.init(T, D, F.G, F.bid);
        pg8::EpiB E{WSP(pg8::bf16_t, WS_QB), D, -1, 8192u * 2048u * 2u};
        REPS(7) pg8::gemm_phase<pg8::EpiB, pg8::StaticOrder, true, true>(F.lds, g, S, E);
        SEAM(7);
    }
    if (IN(8)) { REPS(8) p8_attn(F); SEAM(8); }
    if (IN(9)) {
        pg8::Gemm g{WSP(pg8::bf16_t, WS_ATT), WSP(pg8::bf16_t, WS_WMO), T, D, D}; pg8::StaticOrder S; S.init(T, D, F.G, F.bid);
        pg8::EpiResLN E{WSP(float, WS_Y1), WSP(float, WS_ST1), F.in[8], F.in[9], WSP(float, WS_Y2), ALPHA};
        REPS(9) pg8::gemm_phase<pg8::EpiResLN, pg8::StaticOrder, true, true>(F.lds, g, S, E);
        SEAM(9);
    }
    if (IN(10)) { p10_ln_router(F); SEAM(10); }
    if (IN(11)) { moe_tile_starts(F, ts); p10_dispatch(F, ts); SEAM(11); }
#if MK_MOE_F32
#define MOE_GEMM_GU(l, g, S, E) pg8::gemm_phase_bf32<pg8::EpiSwi, pg8::MoeOrder, true, true, true>(l, g, S, E)
#define MOE_GEMM_DN(l, g, S, E) pg8::gemm_phase_bf32<pg8::EpiB, pg8::MoeOrder, true, false, false>(l, g, S, E)
#else
#define MOE_GEMM_GU(l, g, S, E) pg8::gemm_phase<pg8::EpiSwi, pg8::MoeOrder, true, true, true>(l, g, S, E)
#define MOE_GEMM_DN(l, g, S, E) pg8::gemm_phase<pg8::EpiB, pg8::MoeOrder, true, true>(l, g, S, E)
#endif
    if (IN(12)) {
        moe_tile_starts(F, ts);
        const int U = ts[32] * 4;
        pg8::Gemm g{WSP(pg8::bf16_t, WS_H2B), WSP(pg8::bf16_t, WS_WGU), PMAX, 32 * 1024, D, WSP(int, WS_TOK)};
        pg8::MoeOrder S{(const PG8_LAS int*)ts, F.G, F.bid, 4, U < F.G ? U : F.G, F.in[20], F.in[21], 2048, 512, 0};
        pg8::EpiSwi E{WSP(pg8::bf16_t, WS_HID)};
        MOE_GEMM_GU(F.lds, g, S, E);
        SEAM(12);
    }
    if (IN(13)) {
        moe_tile_starts(F, ts);
        const int RT = ts[32], U = RT * 4, nbg = U > F.G ? U - F.G : 0, R1 = (F.G / 4) < RT ? (F.G / 4) : RT;
        {
            pg8::Gemm g{WSP(pg8::bf16_t, WS_H2B), WSP(pg8::bf16_t, WS_WGU), PMAX, 32 * 1024, D, WSP(int, WS_TOK)};
            pg8::MoeOrder S{(const PG8_LAS int*)ts, F.G, F.bid, 4, U, F.in[20], F.in[21], 2048, 512, F.G};
            pg8::EpiSwi E{WSP(pg8::bf16_t, WS_HID)};
            MOE_GEMM_GU(F.lds, g, S, E);
        }
        {
            pg8::Gemm g{WSP(pg8::bf16_t, WS_HID), WSP(pg8::bf16_t, WS_WD), PMAX, 32 * 2048, 512};
            pg8::MoeOrder S{(const PG8_LAS int*)ts, F.G - nbg, F.bid >= nbg ? F.bid - nbg : -1, 8, R1 * 8, F.in[22], nullptr, 512, 2048, 0};
            pg8::EpiB E{WSP(pg8::bf16_t, WS_YS), D, 7, 24576u * 2048u * 2u};
            MOE_GEMM_DN(F.lds, g, S, E);
        }
        SEAM(13);
    }
    if (IN(14)) {
        moe_tile_starts(F, ts);
        const int RT = ts[32], R1 = (F.G / 4) < RT ? (F.G / 4) : RT;
        pg8::Gemm g{WSP(pg8::bf16_t, WS_HID), WSP(pg8::bf16_t, WS_WD), PMAX, 32 * 2048, 512};
        pg8::MoeOrder S{(const PG8_LAS int*)ts, F.G, F.bid, 8, RT * 8, F.in[22], nullptr, 512, 2048, R1 * 8};
        pg8::EpiB E{WSP(pg8::bf16_t, WS_YS), D, 7, 24576u * 2048u * 2u};
        MOE_GEMM_DN(F.lds, g, S, E);
        SEAM(14);
    }
    if (IN(15)) { REPS(15) p13_combine(F); }
#if PROBE_T >= 0
    if (F.bid == 0 && F.tid == 0) { const unsigned long long te = __builtin_amdgcn_s_memrealtime(); while (__builtin_amdgcn_s_memrealtime() - te < pdelay) __builtin_amdgcn_s_sleep(8); }
#endif
#undef IN
#undef SEAM
#undef REPS
}

extern "C" void kernel_launch(void* const* d_in, const int* in_sizes, int n_in, void* d_out, int out_size, void* d_ws, size_t ws_size, hipStream_t stream) {
    static int grid = 0;
    if (grid == 0) {
        if (n_in != 25 || in_sizes[0] != T * D || out_size != T * D || ws_size < WS_END) { fprintf(stderr, "kernel_launch: unexpected shapes / workspace (%d inputs, ws %zu)\n", n_in, ws_size); grid = -1; return; }
        int dev = 0, cus = 0;
        if (hipGetDevice(&dev) != hipSuccess || hipDeviceGetAttribute(&cus, hipDeviceAttributeMultiprocessorCount, dev) != hipSuccess) { grid = -1; return; }
        if (hipFuncSetAttribute((const void*)mega, hipFuncAttributeMaxDynamicSharedMemorySize, LDS_BYTES) != hipSuccess) { fprintf(stderr, "kernel_launch: hipFuncSetAttribute failed\n"); grid = -1; return; }
        int per_cu = 0;
        if (hipOccupancyMaxActiveBlocksPerMultiprocessor(&per_cu, (const void*)mega, NTHR, LDS_BYTES) != hipSuccess || per_cu < 1) { fprintf(stderr, "kernel_launch: occupancy query failed / 0 blocks per CU\n"); grid = -1; return; }
        (void)hipGetLastError();
        grid = cus;
    }
    if (grid < 0) return;
    if (hipMemsetAsync((char*)d_ws + WS_CTL, 0, CTL_ZERO_BYTES, stream) != hipSuccess) return;
    Args a{};
    for (int i = 0; i < 25; ++i) a.in[i] = (const float*)d_in[i];
    a.out = (float*)d_out; a.ws = (unsigned char*)d_ws;
#if MK_ONE_LAUNCH
    a.ph_lo = 0; a.ph_hi = NPH; a.use_bar = 1;
#if MK_CG_SYNC
    { void* kargs[] = {(void*)&a};
      hipError_t e = hipLaunchCooperativeKernel((const void*)mega, dim3(grid), dim3(NTHR), kargs, LDS_BYTES, stream);
      if (e != hipSuccess) fprintf(stderr, "cooperative launch failed: %s (grid %d)\n", hipGetErrorString(e), grid); }
#else
    hipLaunchKernelGGL(mega, dim3(grid), dim3(NTHR), LDS_BYTES, stream, a);
#endif
#else
    for (int p = 0; p < NPH; ++p) { a.ph_lo = p; a.ph_hi = p + 1; a.use_bar = 0;
        hipLaunchKernelGGL(mega, dim3(grid), dim3(NTHR), LDS_BYTES, stream, a); }
#endif
}
```

```cpp
#include <hip/hip_runtime.h>
#include <hip/hip_cooperative_groups.h>
#include <cstdio>
#include <cstdint>
#include <cmath>
#ifndef MK_ONE_LAUNCH
#define MK_ONE_LAUNCH 1
#endif
#ifndef MK_CG_SYNC
#define MK_CG_SYNC 2
#endif
#ifndef MK_WT_STORES
#define MK_WT_STORES 0
#endif
#ifndef MK_MOE_F32
#define MK_MOE_F32 0
#endif
#define PROBE_PH -1
#define PROBE_N 1
#define PROBE_T -1
namespace pg8 {
#define PG8_LAS __attribute__((address_space(3)))
typedef unsigned short bf16_t;
typedef short bf16x8 __attribute__((ext_vector_type(8)));
typedef float f32x4 __attribute__((ext_vector_type(4)));
typedef unsigned u32x4 __attribute__((ext_vector_type(4)));
constexpr int BM = 256, BK = 64, HALF = 128, HTB = HALF * BK * 2  , STAGE_BYTES = 8 * HTB, NXCD = 8, WGM = 8;

__host__ __device__ __forceinline__ int lds_byte(int r, int c) { const int st = (r >> 4) * 2 + (c >> 5), rr = r & 15, cc = c & 31, ob = rr * 64 + cc * 2; return st * 1024 + (ob ^ (((ob >> 9) & 1) << 5)); }
__host__ __device__ __forceinline__ void stage_rc(int b, int& R, int& C) { const int st = b / 1024, sb = b % 1024, swz = sb ^ (((sb >> 9) & 1) << 5); R = (st >> 1) * 16 + swz / 64; C = (st & 1) * 32 + (swz % 64) / 2; }
__host__ __device__ __forceinline__ int perm32(int rho) { const int n = rho >> 4, i = rho & 15; return 8 * (i >> 2) + 4 * n + (i & 3); }

struct Unit { int pm, pn; };
struct Gemm { const bf16_t* A; const bf16_t* Bt; int M, N, K; const int* tok; };

struct StaticOrder {
    int nM, nN, nwg, G, c;
    __host__ __device__ void init(int M, int N, int G_, int c_) { nM = M / BM; nN = N / BM; nwg = nM * nN; G = G_; c = c_; }
    __host__ __device__ bool next(int i, Unit& u) const {
        const long L = (long)i * G + c; if (L >= nwg) return false;
        int wgid = (int)L; { const int q = nwg / NXCD, r = nwg % NXCD, xcd = wgid % NXCD, off = wgid / NXCD; wgid = (xcd < r ? xcd * (q + 1) : r * (q + 1) + (xcd - r) * q) + off; }
        const int nig = WGM * nN, gid = wgid / nig, fm = gid * WGM, gsz = (nM - fm) < WGM ? (nM - fm) : WGM;
        u.pm = fm + ((wgid % nig) % gsz); u.pn = (wgid % nig) / gsz; return true;
    }
    __device__ __forceinline__ void a_ready(const Unit&) const {}
    __device__ __forceinline__ void done(const Unit&) const {}
};


typedef unsigned u32x2 __attribute__((ext_vector_type(2)));
__device__ __forceinline__ unsigned cvt_pk_bf16(float lo, float hi) { unsigned r; asm volatile("v_cvt_pk_bf16_f32 %0, %1, %2" : "=v"(r) : "v"(lo), "v"(hi)); return r; }
__device__ __forceinline__ u32x4 pack8(const f32x4 a, const f32x4 b) { u32x4 w; w.x = cvt_pk_bf16(a[0], a[1]); w.y = cvt_pk_bf16(a[2], a[3]); w.z = cvt_pk_bf16(b[0], b[1]); w.w = cvt_pk_bf16(b[2], b[3]); return w; }
#if MK_WT_STORES
#define PG8_RSRC(base, bytes) __builtin_amdgcn_make_buffer_rsrc((void*)(base), 0, (int)(bytes), 0x00020000)
#define PG8_ST16(rs, base, byteoff, val) __builtin_amdgcn_raw_buffer_store_b128(__builtin_bit_cast(u32x4, (val)), (rs), (unsigned)(byteoff), 0, 16)
#else
#define PG8_RSRC(base, bytes) 0
#define PG8_ST16(rs, base, byteoff, val) (*(u32x4*)((char*)(base) + (size_t)(byteoff)) = __builtin_bit_cast(u32x4, (val)))
#endif
__device__ __forceinline__ float silu_f(float x) { return x * __builtin_amdgcn_rcpf(1.0f + __builtin_amdgcn_exp2f(-1.4426950408889634f * x)); }

struct EpiH {
    static constexpr bool PERM = true, AFTER_DRAIN = false;
    bf16_t* H; bf16_t* KVM; const float* rc; const float* rs;
    __device__ __forceinline__ void operator()(const f32x4 (&acc)[2][2][4][2], const Unit& u, int wr, int wc, int fr, int fq) const {
        const int cb = wc * 32 + 8 * fq;
        const auto rsH = PG8_RSRC(H, 8192u * 7168u * 2u); (void)rsH;
        if (u.pm >= 32) {
#pragma unroll
            for (int ai = 0; ai < 2; ++ai)
#pragma unroll
                for (int m = 0; m < 4; ++m) { bf16_t* rowp = KVM + (size_t)(wr * 64 + fr + ai * HALF + m * 16) * 4096 + (u.pn - 28) * BM + cb;
#pragma unroll
                    for (int bj = 0; bj < 2; ++bj) *(u32x4*)(rowp + bj * HALF) = pack8(acc[ai][bj][m][0], acc[ai][bj][m][1]); }
            return;
        }
        const int row0 = u.pm * BM + wr * 64 + fr;
        if (u.pn < 8) {
            const float sc = u.pn >= 4 ? 0.0625f : 1.0f;
#pragma unroll
            for (int ai = 0; ai < 2; ++ai)
#pragma unroll
                for (int m = 0; m < 4; ++m) { const int row = row0 + ai * HALF + m * 16;
                    const float* cr = rc + (size_t)row * 128 + cb; const float* sr = rs + (size_t)row * 128 + cb;
                    const f32x4 c0 = *(const f32x4*)cr * sc, c1 = *(const f32x4*)(cr + 4) * sc, s0 = *(const f32x4*)sr * sc, s1 = *(const f32x4*)(sr + 4) * sc;
                    const f32x4 t1a = acc[ai][0][m][0], t1b = acc[ai][0][m][1], t2a = acc[ai][1][m][0], t2b = acc[ai][1][m][1];
                    const unsigned bo = (unsigned)(((size_t)u.pn * 8192 + row) * BM + cb) * 2u;
                    PG8_ST16(rsH, H, bo, pack8(t1a * c0 - t2a * s0, t1b * c1 - t2b * s1));
                    PG8_ST16(rsH, H, bo + 2 * HALF, pack8(t1a * s0 + t2a * c0, t1b * s1 + t2b * c1)); }
        } else {
            const float sc = (u.pn == 16 || u.pn == 17) ? 0.08838834764831845f : 1.0f;
#pragma unroll
            for (int ai = 0; ai < 2; ++ai)
#pragma unroll
                for (int m = 0; m < 4; ++m) { const unsigned bo = (unsigned)(((size_t)u.pn * 8192 + row0 + ai * HALF + m * 16) * BM + cb) * 2u;
#pragma unroll
                    for (int bj = 0; bj < 2; ++bj) PG8_ST16(rsH, H, bo + bj * 2 * HALF, pack8(acc[ai][bj][m][0] * sc, acc[ai][bj][m][1] * sc)); }
        }
    }
};
struct EpiB {
    static constexpr bool PERM = true, AFTER_DRAIN = false;
    bf16_t* O; int ldc; int pmask; unsigned obytes;
    __device__ __forceinline__ void operator()(const f32x4 (&acc)[2][2][4][2], const Unit& u, int wr, int wc, int fr, int fq) const {
        const int row0 = u.pm * BM + wr * 64 + fr, col0 = (u.pn & pmask) * BM + wc * 32 + 8 * fq;
        const auto rsO = PG8_RSRC(O, obytes); (void)rsO;
#pragma unroll
        for (int ai = 0; ai < 2; ++ai)
#pragma unroll
            for (int m = 0; m < 4; ++m) { const unsigned bo = (unsigned)((size_t)(row0 + ai * HALF + m * 16) * ldc + col0) * 2u;
#pragma unroll
                for (int bj = 0; bj < 2; ++bj) PG8_ST16(rsO, O, bo + bj * 2 * HALF, pack8(acc[ai][bj][m][0], acc[ai][bj][m][1])); }
    }
};
struct EpiSwi {
    static constexpr bool PERM = true, AFTER_DRAIN = false;
    bf16_t* O;
    __device__ __forceinline__ void operator()(const f32x4 (&acc)[2][2][4][2], const Unit& u, int wr, int wc, int fr, int fq) const {
        const int row0 = u.pm * BM + wr * 64 + fr, col0 = (u.pn & 3) * HALF + wc * 32 + 8 * fq;
        const auto rsO = PG8_RSRC(O, 24576u * 512u * 2u); (void)rsO;
#pragma unroll
        for (int ai = 0; ai < 2; ++ai)
#pragma unroll
            for (int m = 0; m < 4; ++m) { const unsigned bo = (unsigned)((size_t)(row0 + ai * HALF + m * 16) * 512 + col0) * 2u;
                f32x4 h0, h1;
#pragma unroll
                for (int i = 0; i < 4; ++i) { h0[i] = silu_f(acc[ai][0][m][0][i]) * acc[ai][1][m][0][i]; h1[i] = silu_f(acc[ai][0][m][1][i]) * acc[ai][1][m][1][i]; }
                PG8_ST16(rsO, O, bo, pack8(h0, h1)); }
    }
};
struct EpiResX {
    static constexpr bool PERM = false, AFTER_DRAIN = false;
    const float* X; float* Y; float alpha;
    __device__ __forceinline__ void operator()(const f32x4 (&acc)[2][2][4][2], const Unit& u, int wr, int wc, int fr, int fq) const {
        const int row0 = u.pm * BM + wr * 64 + fr, col0 = u.pn * BM + wc * 32 + 4 * fq;
        const auto rsY = PG8_RSRC(Y, 8192u * 2048u * 4u); (void)rsY;
#pragma unroll
        for (int ai = 0; ai < 2; ++ai)
#pragma unroll
            for (int m = 0; m < 4; ++m) { const size_t off = (size_t)(row0 + ai * HALF + m * 16) * 2048 + col0;
#pragma unroll
                for (int bj = 0; bj < 2; ++bj)
#pragma unroll
                    for (int n = 0; n < 2; ++n) { const f32x4 xv = *(const f32x4*)(X + off + bj * HALF + n * 16); const f32x4 yv = xv * alpha + acc[ai][bj][m][n]; PG8_ST16(rsY, Y, (off + bj * HALF + n * 16) * 4, yv); } }
    }
};
struct EpiResLN {
    static constexpr bool PERM = false, AFTER_DRAIN = false;
    const float* Yin; const float* st; const float* g; const float* b; float* Y; float alpha;
    __device__ __forceinline__ void operator()(const f32x4 (&acc)[2][2][4][2], const Unit& u, int wr, int wc, int fr, int fq) const {
        const int row0 = u.pm * BM + wr * 64 + fr, col0 = u.pn * BM + wc * 32 + 4 * fq;
        const auto rsY = PG8_RSRC(Y, 8192u * 2048u * 4u); (void)rsY;
        f32x4 gv[2][2], bv[2][2];
#pragma unroll
        for (int bj = 0; bj < 2; ++bj)
#pragma unroll
            for (int n = 0; n < 2; ++n) { gv[bj][n] = *(const f32x4*)(g + col0 + bj * HALF + n * 16) * alpha; bv[bj][n] = *(const f32x4*)(b + col0 + bj * HALF + n * 16) * alpha; }
#pragma unroll
        for (int ai = 0; ai < 2; ++ai)
#pragma unroll
            for (int m = 0; m < 4; ++m) { const int row = row0 + ai * HALF + m * 16; const size_t off = (size_t)row * 2048 + col0;
                const float mu = st[2 * row], rstd = st[2 * row + 1];
#pragma unroll
                for (int bj = 0; bj < 2; ++bj)
#pragma unroll
                    for (int n = 0; n < 2; ++n) { const f32x4 yv = *(const f32x4*)(Yin + off + bj * HALF + n * 16);
                        const f32x4 yo = ((yv - mu) * rstd) * gv[bj][n] + bv[bj][n] + acc[ai][bj][m][n]; PG8_ST16(rsY, Y, (off + bj * HALF + n * 16) * 4, yo); } }
    }
};

struct OrderG1 {
    StaticOrder so; int G, c;
    __device__ void init(int G_, int c_) { so.init(8192, 7168, G_, c_); G = G_; c = c_; }
    __device__ bool next(int i, Unit& u) const {
        const int L = i * G + c;
        if (L < 896) return so.next(i, u);
        if (L >= 912) return false;
        u.pm = 32; u.pn = 28 + (L - 896); return true;
    }
    __device__ __forceinline__ void a_ready(const Unit&) const {}
    __device__ __forceinline__ void done(const Unit&) const {}
};
struct MoeOrder {
    const PG8_LAS int* ts; int G, c, npn, total; const float* W0; const float* W1; int kdim, ncols; int L0;
    __device__ bool next(int i, Unit& u) const {
        if (c < 0) return false;
        const int L = L0 + i * G + c; if (L >= total) return false;
        const int rt = L / npn, pl = L - rt * npn; int e = 0;
        for (int j = 1; j < 32; ++j) e += (ts[j] <= rt) ? 1 : 0;
        u.pm = rt; u.pn = e * npn + pl; return true;
    }
    __device__ __forceinline__ int ldb() const { return ncols; }
    __device__ __forceinline__ const float* bbase(const Unit& u, int which) const {
        const int e = u.pn / npn, pl = u.pn - e * npn; const size_t eo = (size_t)e * kdim * ncols;
        if (W1) return (which ? W1 : W0) + eo + 128 * pl;
        return W0 + eo + 256 * pl;
    }
    __device__ __forceinline__ void a_ready(const Unit&) const {}
    __device__ __forceinline__ void done(const Unit&) const {}
};

template <int MODE>
struct EpiLN {
    static constexpr bool PERM = false, AFTER_DRAIN = true;
    const float* X; const float* stin; const float* gin; const float* bin;
    float* Yout; float* stout; bf16_t* HB; const float* g; const float* b;
    unsigned long long* xbuf;
    unsigned* cnt;
    __device__ __forceinline__ void operator()(const f32x4 (&)[2][2][4][2], const Unit&, int, int, int, int) const {}
    __device__ __forceinline__ void fused(f32x4 (&acc)[2][2][4][2], const Unit& u, int wr, int wc, int fr, int fq, PG8_LAS unsigned char* lds, int wid, int lane) const {
        typedef float f32x2v __attribute__((ext_vector_type(2)));
        PG8_LAS f32x2v* P = (PG8_LAS f32x2v*)lds;
        PG8_LAS f32x2v* MS = (PG8_LAS f32x2v*)(lds + 8192);
        const int row0 = u.pm * BM + wr * 64 + fr, col0 = u.pn * BM + wc * 32 + 4 * fq;
        float s1[2][4], s2[2][4], mu[2][4], rs[2][4];
#pragma unroll
        for (int ai = 0; ai < 2; ++ai)
#pragma unroll
            for (int m = 0; m < 4; ++m) { s1[ai][m] = 0.f; s2[ai][m] = 0.f; mu[ai][m] = 0.f; rs[ai][m] = 0.f;
                if (MODE == 1) { const int row = row0 + ai * HALF + m * 16; mu[ai][m] = stin[2 * row]; rs[ai][m] = stin[2 * row + 1]; } }
#pragma unroll
        for (int bj = 0; bj < 2; ++bj)
#pragma unroll
            for (int n = 0; n < 2; ++n) {
                f32x4 gvv = {0.f, 0.f, 0.f, 0.f}, bvv = gvv;
                if (MODE == 1) { gvv = *(const f32x4*)(gin + col0 + bj * HALF + n * 16) * 1.189207115002721f; bvv = *(const f32x4*)(bin + col0 + bj * HALF + n * 16) * 1.189207115002721f; }
#pragma unroll
                for (int ai = 0; ai < 2; ++ai)
#pragma unroll
                    for (int m = 0; m < 4; ++m) { const size_t off = (size_t)(row0 + ai * HALF + m * 16) * 2048 + col0 + bj * HALF + n * 16;
                        const f32x4 xv = *(const f32x4*)(X + off);
                        const f32x4 y = (MODE == 1 ? ((xv - mu[ai][m]) * rs[ai][m]) * gvv + bvv : xv * 1.189207115002721f) + acc[ai][bj][m][n];
                        acc[ai][bj][m][n] = y; *(f32x4*)(Yout + off) = y;
                        s1[ai][m] += (y[0] + y[1]) + (y[2] + y[3]); s2[ai][m] += (y[0] * y[0] + y[1] * y[1]) + (y[2] * y[2] + y[3] * y[3]); }
            }
#pragma unroll
        for (int ai = 0; ai < 2; ++ai)
#pragma unroll
            for (int m = 0; m < 4; ++m) { float a1 = s1[ai][m], a2 = s2[ai][m];
                a1 += __shfl_xor(a1, 16); a1 += __shfl_xor(a1, 32); a2 += __shfl_xor(a2, 16); a2 += __shfl_xor(a2, 32);
                if (fq == 0) P[(ai * HALF + wr * 64 + m * 16 + fr) * 4 + wc] = (f32x2v){a1, a2}; }
        asm volatile("s_waitcnt lgkmcnt(0)" ::: "memory"); __builtin_amdgcn_s_barrier(); asm volatile("" ::: "memory");
        const int t = wid * 64 + lane;
        if (t < 256) { const f32x2v a = P[t * 4 + 0], b2 = P[t * 4 + 1], c = P[t * 4 + 2], d = P[t * 4 + 3];
            const float S1 = (a.x + b2.x) + (c.x + d.x), S2 = (a.y + b2.y) + (c.y + d.y);
            __hip_atomic_store(xbuf + ((size_t)(u.pm * 8 + u.pn) * 256 + t), ((unsigned long long)__float_as_uint(S2) << 32) | __float_as_uint(S1), __ATOMIC_RELAXED, __HIP_MEMORY_SCOPE_AGENT);
            asm volatile("s_waitcnt vmcnt(0)" ::: "memory");
            if (lane == 0) __hip_atomic_fetch_add(cnt + 64 * u.pm, 1u, __ATOMIC_RELAXED, __HIP_MEMORY_SCOPE_AGENT); }
        if (wid == 0) {
            const unsigned long long t0 = __builtin_amdgcn_s_memrealtime();
            while ((unsigned)__builtin_amdgcn_readfirstlane(__hip_atomic_load(cnt + 64 * u.pm, __ATOMIC_RELAXED, __HIP_MEMORY_SCOPE_AGENT)) < 32u) {
                if (__builtin_amdgcn_s_memrealtime() - t0 > 2000000ull) break;
                __builtin_amdgcn_s_sleep(2); }
            __builtin_amdgcn_fence(__ATOMIC_ACQUIRE, "agent");
        }
        asm volatile("s_waitcnt vmcnt(0) lgkmcnt(0)" ::: "memory"); __builtin_amdgcn_s_barrier(); asm volatile("" ::: "memory");
        if (t < 256) { float S1 = 0.f, S2 = 0.f;
#pragma unroll
            for (int j = 0; j < 8; ++j) { const unsigned long long w = __hip_atomic_load(xbuf + ((size_t)(u.pm * 8 + j) * 256 + t), __ATOMIC_RELAXED, __HIP_MEMORY_SCOPE_AGENT); S1 += __uint_as_float((unsigned)w); S2 += __uint_as_float((unsigned)(w >> 32)); }
            const float mean = S1 * (1.f / 2048.f), var = fmaxf(S2 * (1.f / 2048.f) - mean * mean, 0.f), rstd = 1.0f / sqrtf(var + 1e-5f);
            MS[t] = (f32x2v){mean, rstd};
            if (u.pn == 0) { stout[2 * (u.pm * BM + t)] = mean; stout[2 * (u.pm * BM + t) + 1] = rstd; } }
        asm volatile("s_waitcnt lgkmcnt(0)" ::: "memory"); __builtin_amdgcn_s_barrier(); asm volatile("" ::: "memory");
#pragma unroll
        for (int bj = 0; bj < 2; ++bj)
#pragma unroll
            for (int n = 0; n < 2; ++n) { const f32x4 gN = *(const f32x4*)(g + col0 + bj * HALF + n * 16), bN = *(const f32x4*)(b + col0 + bj * HALF + n * 16);
#pragma unroll
                for (int ai = 0; ai < 2; ++ai)
#pragma unroll
                    for (int m = 0; m < 4; ++m) { const int rl = ai * HALF + wr * 64 + m * 16 + fr; const f32x2v ms = MS[rl]; const size_t off = (size_t)(u.pm * BM + rl) * 2048 + col0 + bj * HALF + n * 16;
                        const f32x4 h = ((acc[ai][bj][m][n] - ms.x) * ms.y) * gN + bN;
                        u32x2 w; w.x = cvt_pk_bf16(h[0], h[1]); w.y = cvt_pk_bf16(h[2], h[3]); *(u32x2*)(HB + off) = w; } }
    }
};
template <class Epi, class Sched, bool ALIGN_EPI = false, bool SP2 = false, bool GATHER = false, bool BNT = false>
__device__ __forceinline__ void gemm_phase(PG8_LAS unsigned char* lds, const Gemm g, const Sched& S, const Epi& E) {
    const int tid = threadIdx.x, wid = __builtin_amdgcn_readfirstlane(tid >> 6), lane = tid & 63, wr = wid >> 2, wc = wid & 3, fr = lane & 15, fq = lane >> 4;
    const int K = g.K, nt = K / BK;
    unsigned voffA[2], voffB[2];
#pragma unroll
    for (int i = 0; i < 2; ++i) { int R, C; stage_rc(tid * 16 + i * 8192, R, C); const int Rb = Epi::PERM ? ((R & ~31) + perm32(R & 31)) : R;
        voffA[i] = (unsigned)(R * K + C) * 2u; voffB[i] = (unsigned)(Rb * K + C) * 2u; }
    unsigned coff[2][2], noff[2][2]; int gR[2], gC[2];
#pragma unroll
    for (int i = 0; i < 2; ++i) { int R, C; stage_rc(tid * 16 + i * 8192, R, C); gR[i] = R; gC[i] = C; coff[0][i] = coff[1][i] = noff[0][i] = noff[1][i] = 0u; }
#define PG8_GOFF(dst, pm_) do { if constexpr (GATHER) { _Pragma("unroll") for (int _h = 0; _h < 2; ++_h) _Pragma("unroll") for (int _i = 0; _i < 2; ++_i) \
        dst[_h][_i] = ((unsigned)g.tok[(pm_) * BM + _h * HALF + gR[_i]] * (unsigned)K + (unsigned)gC[_i]) * 2u; } } while (0)
    const size_t kstep = (size_t)(BK * 2);
    const size_t hstep = (size_t)HALF * K * 2;
    const size_t tstep = 2 * hstep;
    const unsigned ldsw = (unsigned)wid * 1024u;
    const int aoff = lds_byte(wr * 64 + fr, fq * 8), boff = lds_byte(wc * 32 + fr, fq * 8);
#define PG8_SA(b, h) (((b) * 2 + (h)) * HTB)
#define PG8_SB(b, h) ((4 + (b) * 2 + (h)) * HTB)
#define PG8_STAGE(bufoff, gbase, voff) do { _Pragma("unroll") for (int _i = 0; _i < 2; ++_i) \
        __builtin_amdgcn_global_load_lds((const unsigned*)((const char*)(gbase) + (voff)[_i]), (PG8_LAS unsigned*)(lds + (bufoff) + ldsw + _i * 8192), 16, 0, 0); } while (0)
#define PG8_STAGEB(bufoff, gbase, voff) do { if constexpr (BNT) { _Pragma("unroll") for (int _i = 0; _i < 2; ++_i) \
        __builtin_amdgcn_global_load_lds((const unsigned*)((const char*)(gbase) + (voff)[_i]), (PG8_LAS unsigned*)(lds + (bufoff) + ldsw + _i * 8192), 16, 0, 2); } else { PG8_STAGE(bufoff, gbase, voff); } } while (0)
#define PG8_STAGEA(bufoff, gptr, hh, kbytes, usenext) do { if constexpr (GATHER) { _Pragma("unroll") for (int _i = 0; _i < 2; ++_i) { const unsigned _o = (usenext) ? noff[hh][_i] : coff[hh][_i]; \
        __builtin_amdgcn_global_load_lds((const unsigned*)((const char*)g.A + (size_t)(kbytes) + _o), (PG8_LAS unsigned*)(lds + (bufoff) + ldsw + _i * 8192), 16, 0, 0); } } else { PG8_STAGE(bufoff, gptr, voffA); } } while (0)
#define PG8_LDA(dst, b, h) do { _Pragma("unroll") for (int m = 0; m < 4; ++m) _Pragma("unroll") for (int k = 0; k < 2; ++k) dst[m][k] = *(const PG8_LAS bf16x8*)(lds + PG8_SA(b, h) + aoff + m * 2048 + k * 1024); } while (0)
#define PG8_LDB(dst, b, h) do { _Pragma("unroll") for (int n = 0; n < 2; ++n) _Pragma("unroll") for (int k = 0; k < 2; ++k) dst[n][k] = *(const PG8_LAS bf16x8*)(lds + PG8_SB(b, h) + boff + n * 2048 + k * 1024); } while (0)
#define PG8_MMA(ai, bj, At, Bt) do { __builtin_amdgcn_s_setprio(1); _Pragma("unroll") for (int m = 0; m < 4; ++m) _Pragma("unroll") for (int n = 0; n < 2; ++n) _Pragma("unroll") for (int k = 0; k < 2; ++k) \
        acc[ai][bj][m][n] = __builtin_amdgcn_mfma_f32_16x16x32_bf16(Bt[n][k], At[m][k], acc[ai][bj][m][n], 0, 0, 0); __builtin_amdgcn_s_setprio(0); } while (0)
#define PG8_WAIT_V(n) asm volatile("s_waitcnt vmcnt(" #n ")" ::: "memory")
#define PG8_WAIT_L(n) asm volatile("s_waitcnt lgkmcnt(" #n ")" ::: "memory")
#define PG8_BAR __builtin_amdgcn_s_barrier()
#define PG8_SCHED __builtin_amdgcn_sched_barrier(0)
    Unit cur, nxt; int ui = 0;
    if (!S.next(0, cur)) return;
    f32x4 acc[2][2][4][2];
#pragma unroll
    for (int a = 0; a < 2; ++a)
#pragma unroll
        for (int b = 0; b < 2; ++b)
#pragma unroll
            for (int m = 0; m < 4; ++m)
#pragma unroll
                for (int n = 0; n < 2; ++n) acc[a][b][m][n] = (f32x4){0.f, 0.f, 0.f, 0.f};
    bf16x8 At[4][2], B0[2][2], B1[2][2];
    const char* cA = (const char*)g.A + (size_t)cur.pm * tstep; const char* cB = (const char*)g.Bt + (size_t)cur.pn * tstep;
    PG8_GOFF(coff, cur.pm);
    S.a_ready(cur);
    if constexpr (SP2) {
        PG8_STAGEB(PG8_SB(0, 0), cB, voffB); PG8_STAGEB(PG8_SB(0, 1), cB + hstep, voffB); PG8_STAGEA(PG8_SA(0, 0), cA, 0, 0, false); PG8_STAGEA(PG8_SA(0, 1), cA + hstep, 1, 0, false);
        if (wr == 1) PG8_BAR;
        PG8_WAIT_V(2); PG8_BAR;
        PG8_STAGEB(PG8_SB(1, 0), cB + kstep, voffB); PG8_STAGEA(PG8_SA(1, 0), cA + kstep, 0, kstep, false); PG8_STAGEB(PG8_SB(1, 1), cB + hstep + kstep, voffB);
        PG8_WAIT_V(6); PG8_BAR;
    } else {
        PG8_STAGEB(PG8_SB(0, 0), cB, voffB); PG8_STAGE(PG8_SA(0, 0), cA, voffA); PG8_STAGEB(PG8_SB(0, 1), cB + hstep, voffB); PG8_STAGE(PG8_SA(0, 1), cA + hstep, voffA);
        if (wr == 1) PG8_BAR;
        PG8_WAIT_V(4); PG8_BAR;
        PG8_STAGEB(PG8_SB(1, 0), cB + kstep, voffB); PG8_STAGE(PG8_SA(1, 0), cA + kstep, voffA); PG8_STAGEB(PG8_SB(1, 1), cB + hstep + kstep, voffB);
        PG8_WAIT_V(6); PG8_BAR;
    }
    for (;;) {
        const bool has_next = S.next(ui + 1, nxt);
        const char* nA = has_next ? (const char*)g.A + (size_t)nxt.pm * tstep : cA; const char* nB = has_next ? (const char*)g.Bt + (size_t)nxt.pn * tstep : cB;
        if constexpr (GATHER) { if (has_next) { PG8_GOFF(noff, nxt.pm); } else { _Pragma("unroll") for (int _h = 0; _h < 2; ++_h) _Pragma("unroll") for (int _i = 0; _i < 2; ++_i) noff[_h][_i] = coff[_h][_i]; } }
        for (int t = 0; t < nt; t += 2) {
            const bool last = (t == nt - 2);
            const char* a1 = cA + (size_t)(t + 1) * kstep;
            const char* a2 = last ? nA : cA + (size_t)(t + 2) * kstep; const char* b2 = last ? nB : cB + (size_t)(t + 2) * kstep;
            const char* a3 = a2 + kstep; const char* b3 = b2 + kstep;
            const size_t k1 = (size_t)(t + 1) * kstep, k2 = last ? 0 : (size_t)(t + 2) * kstep, k3 = k2 + kstep;
            if (last && has_next) S.a_ready(nxt);
            if constexpr (SP2) {
            PG8_LDB(B0, 0, 0); PG8_LDB(B1, 0, 1); PG8_SCHED; PG8_LDA(At, 0, 0); PG8_STAGEA(PG8_SA(1, 1), a1 + hstep, 1, k1, false);
            PG8_WAIT_V(8); PG8_WAIT_L(0); PG8_BAR; PG8_MMA(0, 0, At, B0); PG8_MMA(0, 1, At, B1); PG8_BAR; PG8_SCHED;
            PG8_LDA(At, 0, 1); PG8_STAGEB(PG8_SB(0, 0), b2, voffB); PG8_STAGEB(PG8_SB(0, 1), b2 + hstep, voffB); PG8_STAGEA(PG8_SA(0, 0), a2, 0, k2, last);
            PG8_WAIT_V(8); PG8_WAIT_L(0); PG8_BAR; PG8_MMA(1, 0, At, B0); PG8_MMA(1, 1, At, B1); PG8_BAR; PG8_SCHED;
            PG8_LDB(B0, 1, 0); PG8_LDB(B1, 1, 1); PG8_SCHED; PG8_LDA(At, 1, 0); PG8_STAGEA(PG8_SA(0, 1), a2 + hstep, 1, k2, last);
            PG8_WAIT_V(8); PG8_WAIT_L(0); PG8_BAR; PG8_MMA(0, 0, At, B0); PG8_MMA(0, 1, At, B1); PG8_BAR; PG8_SCHED;
            PG8_LDA(At, 1, 1); PG8_STAGEB(PG8_SB(1, 0), b3, voffB); PG8_STAGEB(PG8_SB(1, 1), b3 + hstep, voffB); PG8_STAGEA(PG8_SA(1, 0), a3, 0, k3, last);
            PG8_WAIT_V(8); PG8_WAIT_L(0); PG8_BAR; PG8_MMA(1, 0, At, B0); PG8_MMA(1, 1, At, B1); PG8_BAR; PG8_SCHED;
            } else {
            PG8_LDB(B0, 0, 0); PG8_SCHED; PG8_LDA(At, 0, 0); PG8_STAGE(PG8_SA(1, 1), a1 + hstep, voffA);
            PG8_WAIT_L(8); PG8_BAR; PG8_WAIT_L(0); PG8_MMA(0, 0, At, B0); PG8_BAR; PG8_SCHED;
            PG8_LDB(B1, 0, 1); PG8_STAGEB(PG8_SB(0, 0), b2, voffB);
            PG8_BAR; PG8_WAIT_L(0); PG8_MMA(0, 1, At, B1); PG8_BAR;
            PG8_LDA(At, 0, 1); PG8_STAGE(PG8_SA(0, 0), a2, voffA);
            PG8_BAR; PG8_WAIT_L(0); PG8_MMA(1, 0, At, B0); PG8_BAR; PG8_SCHED;
            PG8_STAGEB(PG8_SB(0, 1), b2 + hstep, voffB);
            PG8_WAIT_V(6); PG8_BAR; PG8_MMA(1, 1, At, B1); PG8_BAR;
            PG8_LDB(B0, 1, 0); PG8_SCHED; PG8_LDA(At, 1, 0); PG8_STAGE(PG8_SA(0, 1), a2 + hstep, voffA);
            PG8_WAIT_L(8); PG8_BAR; PG8_WAIT_L(0); PG8_MMA(0, 0, At, B0); PG8_BAR; PG8_SCHED;
            PG8_LDB(B1, 1, 1); PG8_STAGEB(PG8_SB(1, 0), b3, voffB);
            PG8_BAR; PG8_WAIT_L(0); PG8_MMA(0, 1, At, B1); PG8_BAR;
            PG8_LDA(At, 1, 1); PG8_STAGE(PG8_SA(1, 0), a3, voffA);
            PG8_BAR; PG8_WAIT_L(0); PG8_MMA(1, 0, At, B0); PG8_BAR; PG8_SCHED;
            PG8_STAGEB(PG8_SB(1, 1), b3 + hstep, voffB);
            PG8_WAIT_V(6); PG8_BAR; PG8_MMA(1, 1, At, B1); PG8_BAR;
            }
        }
        if constexpr (ALIGN_EPI) { if (wr == 0) PG8_BAR; }
        if constexpr (!Epi::AFTER_DRAIN) { E(acc, cur, wr, wc, fr, fq); S.done(cur); }
        if (!has_next) break;
#pragma unroll
        for (int a = 0; a < 2; ++a)
#pragma unroll
            for (int b = 0; b < 2; ++b)
#pragma unroll
                for (int m = 0; m < 4; ++m)
#pragma unroll
                    for (int n = 0; n < 2; ++n) acc[a][b][m][n] = (f32x4){0.f, 0.f, 0.f, 0.f};
        cur = nxt; cA = nA; cB = nB; ++ui;
        if constexpr (GATHER) { _Pragma("unroll") for (int _h = 0; _h < 2; ++_h) _Pragma("unroll") for (int _i = 0; _i < 2; ++_i) coff[_h][_i] = noff[_h][_i]; }
        if constexpr (ALIGN_EPI) { if (wr == 1) PG8_BAR; }
    }
    PG8_WAIT_V(0);
    if constexpr (!ALIGN_EPI) { if (wr == 0) PG8_BAR; }
    PG8_BAR;
    if constexpr (Epi::AFTER_DRAIN) { E.fused(acc, cur, wr, wc, fr, fq, lds, wid, lane); S.done(cur); }
#undef PG8_SA
#undef PG8_SB
#undef PG8_STAGE
#undef PG8_STAGEB
#undef PG8_STAGEA
#undef PG8_GOFF
#undef PG8_LDA
#undef PG8_LDB
#undef PG8_MMA
#undef PG8_WAIT_V
#undef PG8_WAIT_L
#undef PG8_BAR
#undef PG8_SCHED
}
constexpr int PBI = 544, SBI_BYTES = 64 * PBI;
template <class Epi, class Sched, bool ALIGN_EPI = false, bool GATHER = false, bool SPLIT = false>
__device__ __forceinline__ void gemm_phase_bf32(PG8_LAS unsigned char* lds, const Gemm g, const Sched& S, const Epi& E) {
    const int tid = threadIdx.x, wid = __builtin_amdgcn_readfirstlane(tid >> 6), lane = tid & 63, wr = wid >> 2, wc = wid & 3, fr = lane & 15, fq = lane >> 4;
    const int K = g.K, nt = K / BK;
    unsigned voffA[2];
#pragma unroll
    for (int i = 0; i < 2; ++i) { int R, C; stage_rc(tid * 16 + i * 8192, R, C); voffA[i] = (unsigned)(R * K + C) * 2u; }
    unsigned coff[2][2], noff[2][2]; int gR[2], gC[2];
#pragma unroll
    for (int i = 0; i < 2; ++i) { int R, C; stage_rc(tid * 16 + i * 8192, R, C); gR[i] = R; gC[i] = C; coff[0][i] = coff[1][i] = noff[0][i] = noff[1][i] = 0u; }
#define PG8_GOFF(dst, pm_) do { if constexpr (GATHER) { _Pragma("unroll") for (int _h = 0; _h < 2; ++_h) _Pragma("unroll") for (int _i = 0; _i < 2; ++_i) \
        dst[_h][_i] = ((unsigned)g.tok[(pm_) * BM + _h * HALF + gR[_i]] * (unsigned)K + (unsigned)gC[_i]) * 2u; } } while (0)
    const size_t kstep = (size_t)(BK * 2), hstep = (size_t)HALF * K * 2, tstep = 2 * hstep;
    const unsigned ldsw = (unsigned)wid * 1024u;
    const int aoff = lds_byte(wr * 64 + fr, fq * 8);
    const int ldb = S.ldb();
    const size_t bkstep = (size_t)BK * ldb;
    const int q4 = (lane >> 2) & 3, p4 = lane & 3;
    const unsigned lo = SPLIT ? (unsigned)((lane >> 5) * ldb + 4 * (lane & 31)) * 4u : (unsigned)lane * 16u;
    const unsigned bwoff = SPLIT ? (unsigned)(8 * wid + (lane >> 5)) * PBI + (unsigned)(((4 * (lane & 31)) ^ ((wid & 1) << 6)) * 2)
                                 : (unsigned)(8 * wid) * PBI + (unsigned)(((4 * lane) ^ ((wid & 1) << 6)) * 2);
    unsigned broff[2][2];
#pragma unroll
    for (int n = 0; n < 2; ++n)
#pragma unroll
        for (int k = 0; k < 2; ++k) { const int row = 32 * k + 8 * fq + q4, col = 32 * wc + (Epi::PERM ? 8 * p4 + 4 * n : 16 * n + 4 * p4);
            broff[n][k] = (unsigned)row * PBI + (unsigned)((col ^ ((row & 8) << 3)) * 2); }
#define PG8_SA(b, h) (((b) * 2 + (h)) * HTB)
#define PG8_SBI(b) (4 * HTB + (b) * SBI_BYTES)
#define PG8_STAGE(bufoff, gbase, voff) do { _Pragma("unroll") for (int _i = 0; _i < 2; ++_i) \
        __builtin_amdgcn_global_load_lds((const unsigned*)((const char*)(gbase) + (voff)[_i]), (PG8_LAS unsigned*)(lds + (bufoff) + ldsw + _i * 8192), 16, 0, 0); } while (0)
#define PG8_STAGEA(bufoff, gptr, hh, kbytes, usenext) do { if constexpr (GATHER) { _Pragma("unroll") for (int _i = 0; _i < 2; ++_i) { const unsigned _o = (usenext) ? noff[hh][_i] : coff[hh][_i]; \
        __builtin_amdgcn_global_load_lds((const unsigned*)((const char*)g.A + (size_t)(kbytes) + _o), (PG8_LAS unsigned*)(lds + (bufoff) + ldsw + _i * 8192), 16, 0, 0); } } else { PG8_STAGE(bufoff, gptr, voffA); } } while (0)
#define PG8_LDA(dst, b, h) do { _Pragma("unroll") for (int m = 0; m < 4; ++m) _Pragma("unroll") for (int k = 0; k < 2; ++k) dst[m][k] = *(const PG8_LAS bf16x8*)(lds + PG8_SA(b, h) + aoff + m * 2048 + k * 1024); } while (0)
#define PG8_LDBT(dst, b, h) do { _Pragma("unroll") for (int n = 0; n < 2; ++n) _Pragma("unroll") for (int k = 0; k < 2; ++k) { \
        const PG8_LAS unsigned char* _a = lds + PG8_SBI(b) + broff[n][k] + (h) * 256; \
        const s16x4 _lo = __builtin_bit_cast(s16x4, __builtin_amdgcn_ds_read_tr16_b64_v4i16((PG8_LAS s16x4*)_a)), _hi = __builtin_bit_cast(s16x4, __builtin_amdgcn_ds_read_tr16_b64_v4i16((PG8_LAS s16x4*)(_a + 4 * PBI))); \
        dst[n][k] = __builtin_shufflevector(_lo, _hi, 0, 1, 2, 3, 4, 5, 6, 7); } } while (0)
#define PG8_BLOAD(p0, p1) do { _Pragma("unroll") for (int _i = 0; _i < 8; ++_i) { \
        const float* _u = SPLIT ? ((_i < 4 ? (p0) : (p1)) + (size_t)(8 * wid + 2 * (_i & 3)) * ldb) : ((p0) + (size_t)(8 * wid + _i) * ldb); \
        breg[_i] = *(const __attribute__((address_space(1))) f32x4*)((const char*)_u + lo); } } while (0)
#define PG8_BWRITE(b) do { _Pragma("unroll") for (int _i = 0; _i < 8; ++_i) { u32x2 _w; _w.x = cvt_pk_bf16(breg[_i][0], breg[_i][1]); _w.y = cvt_pk_bf16(breg[_i][2], breg[_i][3]); \
        *(PG8_LAS u32x2*)(lds + PG8_SBI(b) + bwoff + (SPLIT ? (2 * (_i & 3)) * PBI + (_i >> 2) * 256 : _i * PBI)) = _w; } } while (0)
#define PG8_MMA(ai, bj, At, Bt) do { __builtin_amdgcn_s_setprio(1); _Pragma("unroll") for (int m = 0; m < 4; ++m) _Pragma("unroll") for (int n = 0; n < 2; ++n) _Pragma("unroll") for (int k = 0; k < 2; ++k) \
        acc[ai][bj][m][n] = __builtin_amdgcn_mfma_f32_16x16x32_bf16(Bt[n][k], At[m][k], acc[ai][bj][m][n], 0, 0, 0); __builtin_amdgcn_s_setprio(0); } while (0)
#define PG8_WAIT_V(n) asm volatile("s_waitcnt vmcnt(" #n ")" ::: "memory")
#define PG8_WAIT_L(n) asm volatile("s_waitcnt lgkmcnt(" #n ")" ::: "memory")
#define PG8_BAR __builtin_amdgcn_s_barrier()
#define PG8_SCHED __builtin_amdgcn_sched_barrier(0)
    typedef short s16x4 __attribute__((ext_vector_type(4)));
    typedef unsigned u32x2 __attribute__((ext_vector_type(2)));
    Unit cur, nxt; int ui = 0;
    if (!S.next(0, cur)) return;
    f32x4 acc[2][2][4][2];
#pragma unroll
    for (int a = 0; a < 2; ++a)
#pragma unroll
        for (int b = 0; b < 2; ++b)
#pragma unroll
            for (int m = 0; m < 4; ++m)
#pragma unroll
                for (int n = 0; n < 2; ++n) acc[a][b][m][n] = (f32x4){0.f, 0.f, 0.f, 0.f};
    bf16x8 At[4][2], B0[2][2];
    f32x4 breg[8];
    const char* cA = (const char*)g.A + (size_t)cur.pm * tstep; const float* cB0 = S.bbase(cur, 0); const float* cB1 = S.bbase(cur, 1);
    PG8_GOFF(coff, cur.pm);
    PG8_BLOAD(cB0, cB1); PG8_STAGEA(PG8_SA(0, 0), cA, 0, 0, false); PG8_STAGEA(PG8_SA(0, 1), cA + hstep, 1, 0, false);
    PG8_BWRITE(0); PG8_SCHED;
    if (wr == 1) PG8_BAR;
    PG8_WAIT_V(2); PG8_WAIT_L(0); PG8_BAR;
    PG8_BLOAD(cB0 + bkstep, cB1 + bkstep); PG8_STAGEA(PG8_SA(1, 0), cA + kstep, 0, kstep, false); PG8_SCHED;
    PG8_WAIT_V(10); PG8_BAR;
    for (;;) {
        const bool has_next = S.next(ui + 1, nxt);
        const char* nA = has_next ? (const char*)g.A + (size_t)nxt.pm * tstep : cA; const float* nB0 = has_next ? S.bbase(nxt, 0) : cB0; const float* nB1 = has_next ? S.bbase(nxt, 1) : cB1;
        if constexpr (GATHER) { if (has_next) { PG8_GOFF(noff, nxt.pm); } else { _Pragma("unroll") for (int _h = 0; _h < 2; ++_h) _Pragma("unroll") for (int _i = 0; _i < 2; ++_i) noff[_h][_i] = coff[_h][_i]; } }
        for (int t = 0; t < nt; t += 2) {
            const bool last = (t == nt - 2);
            const char* a1 = cA + (size_t)(t + 1) * kstep;
            const char* a2 = last ? nA : cA + (size_t)(t + 2) * kstep; const float* b20 = last ? nB0 : cB0 + (size_t)(t + 2) * bkstep; const float* b21 = last ? nB1 : cB1 + (size_t)(t + 2) * bkstep;
            const char* a3 = a2 + kstep; const float* b30 = b20 + bkstep; const float* b31 = b21 + bkstep;
            const size_t k1 = (size_t)(t + 1) * kstep, k2 = last ? 0 : (size_t)(t + 2) * kstep, k3 = k2 + kstep;
            PG8_LDBT(B0, 0, 0); PG8_SCHED; PG8_LDA(At, 0, 0); PG8_STAGEA(PG8_SA(1, 1), a1 + hstep, 1, k1, false);
            PG8_WAIT_V(12); PG8_WAIT_L(0); PG8_BAR; PG8_MMA(0, 0, At, B0); PG8_LDBT(B0, 0, 1); PG8_WAIT_L(0); PG8_SCHED; PG8_MMA(0, 1, At, B0); PG8_BAR; PG8_SCHED;
            PG8_BWRITE(1); PG8_BLOAD(b20, b21); PG8_SCHED; PG8_LDBT(B0, 0, 0); PG8_LDA(At, 0, 1); PG8_STAGEA(PG8_SA(0, 0), a2, 0, k2, last);
            PG8_WAIT_V(12); PG8_WAIT_L(0); PG8_BAR; PG8_MMA(1, 0, At, B0); PG8_LDBT(B0, 0, 1); PG8_WAIT_L(0); PG8_SCHED; PG8_MMA(1, 1, At, B0); PG8_BAR; PG8_SCHED;
            PG8_LDBT(B0, 1, 0); PG8_SCHED; PG8_LDA(At, 1, 0); PG8_STAGEA(PG8_SA(0, 1), a2 + hstep, 1, k2, last);
            PG8_WAIT_V(12); PG8_WAIT_L(0); PG8_BAR; PG8_MMA(0, 0, At, B0); PG8_LDBT(B0, 1, 1); PG8_WAIT_L(0); PG8_SCHED; PG8_MMA(0, 1, At, B0); PG8_BAR; PG8_SCHED;
            PG8_BWRITE(0); PG8_BLOAD(b30, b31); PG8_SCHED; PG8_LDBT(B0, 1, 0); PG8_LDA(At, 1, 1); PG8_STAGEA(PG8_SA(1, 0), a3, 0, k3, last);
            PG8_WAIT_V(12); PG8_WAIT_L(0); PG8_BAR; PG8_MMA(1, 0, At, B0); PG8_LDBT(B0, 1, 1); PG8_WAIT_L(0); PG8_SCHED; PG8_MMA(1, 1, At, B0); PG8_BAR; PG8_SCHED;
        }
        if constexpr (ALIGN_EPI) { if (wr == 0) PG8_BAR; }
        E(acc, cur, wr, wc, fr, fq); S.done(cur);
        if (!has_next) break;
#pragma unroll
        for (int a = 0; a < 2; ++a)
#pragma unroll
            for (int b = 0; b < 2; ++b)
#pragma unroll
                for (int m = 0; m < 4; ++m)
#pragma unroll
                    for (int n = 0; n < 2; ++n) acc[a][b][m][n] = (f32x4){0.f, 0.f, 0.f, 0.f};
        cur = nxt; cA = nA; cB0 = nB0; cB1 = nB1; ++ui;
        if constexpr (GATHER) { _Pragma("unroll") for (int _h = 0; _h < 2; ++_h) _Pragma("unroll") for (int _i = 0; _i < 2; ++_i) coff[_h][_i] = noff[_h][_i]; }
        if constexpr (ALIGN_EPI) { if (wr == 1) PG8_BAR; }
    }
    PG8_WAIT_V(0);
    asm volatile("" :: "v"(breg[0]), "v"(breg[1]), "v"(breg[2]), "v"(breg[3]), "v"(breg[4]), "v"(breg[5]), "v"(breg[6]), "v"(breg[7]));
    if constexpr (!ALIGN_EPI) { if (wr == 0) PG8_BAR; }
    PG8_BAR;
#undef PG8_SA
#undef PG8_SBI
#undef PG8_STAGE
#undef PG8_STAGEA
#undef PG8_GOFF
#undef PG8_LDA
#undef PG8_LDBT
#undef PG8_BLOAD
#undef PG8_BWRITE
#undef PG8_MMA
#undef PG8_WAIT_V
#undef PG8_WAIT_L
#undef PG8_BAR
#undef PG8_SCHED
}
}

constexpr int NWAVES = 8, NTHR = 512;
constexpr int T = 8192, D = 2048, HW = 7168, INW = 7184, MEMN = 256;
constexpr float LN_EPS = 1e-5f;
constexpr float ALPHA = 1.189207115002721f;
constexpr int NPH = 16;
#ifndef MK_MOE_BNT
#define MK_MOE_BNT false
#endif
#ifndef MK_ALIGN1
#define MK_ALIGN1 true
#endif
#ifndef MK_NSG
#define MK_NSG 9
#endif
constexpr int NSG = MK_NSG;
constexpr int PMAX = 24576;

constexpr size_t MiB = 1u << 20;
constexpr size_t WS_CTL = 0, CTL_ZERO_BYTES = 64 * 1024;
constexpr size_t WS_WMIX = 2 * MiB, WS_WMQ = 10 * MiB, WS_WIN = 18 * MiB, WS_WKV = 46 * MiB, WS_WMO = 62 * MiB, WS_WGU = 70 * MiB, WS_WD = 198 * MiB;
constexpr size_t WS_XB = 262 * MiB, WS_MEMB = 294 * MiB;
constexpr size_t WS_H = 296 * MiB;
constexpr size_t WS_KVM = 408 * MiB;
constexpr size_t WS_ORAW = 410 * MiB;
constexpr size_t WS_MIXED = WS_XB;
constexpr size_t WS_Y1 = WS_ORAW;
constexpr size_t WS_H1B = WS_H;
constexpr size_t WS_QB = 328 * MiB, WS_ATT = 360 * MiB;
constexpr size_t WS_Y2 = 474 * MiB;
constexpr size_t WS_H2B = WS_H;
constexpr size_t WS_XS = 328 * MiB;
constexpr size_t WS_HID = 424 * MiB;
constexpr size_t WS_YS = WS_XS;
constexpr size_t WS_SMALL = 540 * MiB;
constexpr size_t WS_GLR = WS_SMALL;
constexpr size_t WS_RC = WS_SMALL + 1 * MiB, WS_RS = WS_SMALL + 5 * MiB;
constexpr size_t WS_ST1 = WS_SMALL + 9 * MiB, WS_ST2 = WS_ST1 + 65536;
constexpr size_t WS_EXP = WS_ST2 + 65536, WS_GATE = WS_EXP + 65536, WS_POS = WS_GATE + 65536, WS_SLOT = WS_POS + 65536, WS_TOK = WS_SLOT + 65536;
constexpr size_t WS_XCH1 = WS_SMALL + 10 * MiB, WS_XCH2 = WS_XCH1 + 512 * 1024;
constexpr size_t WS_END = 552 * MiB;
constexpr int CW_CNT = 64, CW_CUR = 128, CW_Q = 192;
constexpr int CW_BAR = 4096;
constexpr int CW_LN1 = 8192, CW_LN2 = 10240;

constexpr int RING_BYTES = 139264, LDSCTL_OFF = RING_BYTES, MISC_OFF = LDSCTL_OFF + 320, LDS_BYTES = 147456;

#define GAS __attribute__((address_space(1)))
#define LAS __attribute__((address_space(3)))
typedef unsigned short bf16;
typedef unsigned v4u __attribute__((ext_vector_type(4)));
typedef unsigned v2u __attribute__((ext_vector_type(2)));
typedef float f32x4 __attribute__((ext_vector_type(4)));
typedef GAS unsigned gu32;
#define RLX_AGENT __ATOMIC_RELAXED, __HIP_MEMORY_SCOPE_AGENT
#define LDS_WAIT() asm volatile("s_waitcnt lgkmcnt(0)" ::: "memory")
__device__ __forceinline__ unsigned f2bf(float f) { unsigned u = __builtin_bit_cast(unsigned, f); return (u + 0x7fffu + ((u >> 16) & 1u)) >> 16; }
__device__ __forceinline__ unsigned pk2(float lo, float hi) { return f2bf(lo) | (f2bf(hi) << 16); }
__device__ __forceinline__ float bf2f(unsigned h) { return __builtin_bit_cast(float, h << 16); }
__device__ __forceinline__ float bflo(unsigned w) { return __builtin_bit_cast(float, w << 16); }
__device__ __forceinline__ float bfhi(unsigned w) { return __builtin_bit_cast(float, w & 0xffff0000u); }
__device__ __forceinline__ float wave_sum(float v) {
#pragma unroll
    for (int o = 1; o < 64; o <<= 1) v += __shfl_xor(v, o);
    return v;
}
__device__ __forceinline__ float wave_max(float v) {
#pragma unroll
    for (int o = 1; o < 64; o <<= 1) v = fmaxf(v, __shfl_xor(v, o));
    return v;
}

struct Frame {
    LAS unsigned char* lds;
    volatile LAS unsigned* MISC;
    gu32* ctl;
    int tid, lane, wave, G, bid;
    unsigned char* ws;
    const float* in[25];
    float* out;
};
#define WSP(T_, off) ((T_*)(F.ws + (off)))

template <bool NTST>
__device__ __forceinline__ void transpose_item(const float* W, int ldw, bf16* WTr, int ldt, LAS float* scr, int lane) {
    float tv[32];
#pragma unroll
    for (int i = 0; i < 32; ++i) tv[i] = __builtin_nontemporal_load(W + (size_t)(2 * i + (lane >> 5)) * ldw + (lane & 31));
#pragma unroll
    for (int i = 0; i < 32; ++i) scr[(2 * i + (lane >> 5)) * 33 + (lane & 31)] = tv[i];
    LDS_WAIT(); asm volatile("" ::: "memory");
    const int c = lane & 7;
#pragma unroll
    for (int j = 0; j < 4; ++j) { const int n = (lane >> 3) + 8 * j; const LAS float* s = scr + (8 * c) * 33 + n;
        v4u o; o.x = pk2(s[0 * 33], s[1 * 33]); o.y = pk2(s[2 * 33], s[3 * 33]); o.z = pk2(s[4 * 33], s[5 * 33]); o.w = pk2(s[6 * 33], s[7 * 33]);
        if (NTST) __builtin_nontemporal_store(o, (GAS v4u*)(WTr + (size_t)n * ldt + 8 * c)); else *(GAS v4u*)(WTr + (size_t)n * ldt + 8 * c) = o; }
    LDS_WAIT(); asm volatile("" ::: "memory");
}
__device__ __forceinline__ void p0_prologue(Frame& F) {
    LAS float* scr = (LAS float*)(F.lds + F.wave * 16384);
    const int gw = F.bid * NWAVES + F.wave, NGW = F.G * NWAVES;
    const float* w_in = F.in[3];
    constexpr int I_IN = 32 * 224, I_SQ = 32 * 64;
    for (int it = gw; it < I_IN + 2 * I_SQ; it += NGW) {
        int r = it;
        if (r < I_IN) { const int kb = r / 224, nb = r % 224; transpose_item<false>(w_in + (size_t)(64 * kb) * INW + 32 * nb, INW, WSP(bf16, WS_WIN) + (size_t)(32 * nb) * 2048 + 64 * kb, 2048, scr, F.lane); continue; }
        r -= I_IN;
        { const int w = r / I_SQ, q = r % I_SQ, kb = q / 64, nb = q % 64;
          const float* src = F.in[11]; if (w) src = F.in[12];
          bf16* dst = WSP(bf16, WS_WKV) + (size_t)w * 2048 * 2048;
          transpose_item<false>(src + (size_t)(64 * kb) * 2048 + 32 * nb, 2048, dst + (size_t)(32 * nb) * 2048 + 64 * kb, 2048, scr, F.lane); }
    }
    const int gt = F.bid * NTHR + F.tid, NGT = F.G * NTHR;
    {
        const float* x = F.in[0]; bf16* xb = WSP(bf16, WS_XB);
        for (int item = F.bid; item < T / 32; item += F.G) {
            const size_t base = (size_t)item * 32 * D / 8;
#pragma unroll 1
            for (int c0 = 0; c0 < 16; c0 += 4) { f32x4 a[4], b[4];
#pragma unroll
                for (int u = 0; u < 4; ++u) { const size_t i = base + (size_t)(c0 + u) * NTHR + F.tid; a[u] = *(const GAS f32x4*)(x + i * 8); b[u] = *(const GAS f32x4*)(x + i * 8 + 4); }
#pragma unroll
                for (int u = 0; u < 4; ++u) { const size_t i = base + (size_t)(c0 + u) * NTHR + F.tid;
                    v4u o; o.x = pk2(a[u][0], a[u][1]); o.y = pk2(a[u][2], a[u][3]); o.z = pk2(b[u][0], b[u][1]); o.w = pk2(b[u][2], b[u][3]); *(GAS v4u*)(xb + i * 8) = o; } }
        }
        const float* mm = F.in[1]; bf16* mb = WSP(bf16, WS_MEMB);
        for (int i = gt; i < MEMN * D / 8; i += NGT) { const f32x4 a = *(const GAS f32x4*)(mm + (size_t)i * 8), b = *(const GAS f32x4*)(mm + (size_t)i * 8 + 4);
            v4u o; o.x = pk2(a[0], a[1]); o.y = pk2(a[2], a[3]); o.z = pk2(b[0], b[1]); o.w = pk2(b[2], b[3]); *(GAS v4u*)(mb + (size_t)i * 8) = o; }
    }
    {
        const int* pos = (const int*)F.in[2]; float* rc = WSP(float, WS_RC); float* rs = WSP(float, WS_RS);
        for (int i = gt; i < T * 128; i += NGT) { const int t = i >> 7, f = i & 127;
            const float inv = exp2f(-(float)f * (13.287712379549449f / 128.0f));
            const float ang = (float)pos[t] * inv;
            double rev = (double)ang * 0.15915494309189535; rev -= floor(rev);
            const float rf = (float)rev;
            rc[i] = __builtin_amdgcn_cosf(rf); rs[i] = __builtin_amdgcn_sinf(rf); }
    }
    {
        const float* x = F.in[0]; float* glr = WSP(float, WS_GLR);
        const int r16 = F.lane & 15, g4 = F.lane >> 4;
        LAS float* part = (LAS float*)F.lds;
        for (int item = F.bid; item < T / 32; item += F.G) {
            const int tile = 2 * item + (F.wave >> 2), kq = F.wave & 3;
            f32x4 acc = {0.f, 0.f, 0.f, 0.f};
            const float* xr = x + (size_t)(tile * 16 + r16) * D + 512 * kq + 4 * g4;
            const float* wr = w_in + (size_t)(512 * kq + 4 * g4) * INW + HW + r16;
#pragma unroll 8
            for (int k0 = 0; k0 < 512; k0 += 16) {
                const f32x4 a = *(const GAS f32x4*)(xr + k0);
                const float b0 = wr[(size_t)(k0 + 0) * INW], b1 = wr[(size_t)(k0 + 1) * INW], b2 = wr[(size_t)(k0 + 2) * INW], b3 = wr[(size_t)(k0 + 3) * INW];
                acc = __builtin_amdgcn_mfma_f32_16x16x4f32(a[0], b0, acc, 0, 0, 0);
                acc = __builtin_amdgcn_mfma_f32_16x16x4f32(a[1], b1, acc, 0, 0, 0);
                acc = __builtin_amdgcn_mfma_f32_16x16x4f32(a[2], b2, acc, 0, 0, 0);
                acc = __builtin_amdgcn_mfma_f32_16x16x4f32(a[3], b3, acc, 0, 0, 0);
            }
            __syncthreads();
            *(LAS f32x4*)(part + (F.wave * 64 + F.lane) * 4) = acc;
            __syncthreads();
            if (F.tid < 128) { const int tl = F.tid >> 6, ln = F.tid & 63;
                f32x4 s = *(const LAS f32x4*)(part + ((tl * 4 + 0) * 64 + ln) * 4);
#pragma unroll
                for (int q = 1; q < 4; ++q) s += *(const LAS f32x4*)(part + ((tl * 4 + q) * 64 + ln) * 4);
#pragma unroll
                for (int j = 0; j < 4; ++j) glr[(size_t)((2 * item + tl) * 16 + 4 * (ln >> 4) + j) * 16 + (ln & 15)] = s[j]; }
        }
        __syncthreads();
    }
}
__device__ __forceinline__ void transpose_queue(Frame& F, int qsel = 0) {
    LAS float* scr = (LAS float*)(F.lds + F.wave * 16384);
    const float* const i7 = F.in[7]; const float* const i10 = F.in[10]; const float* const i13 = F.in[13]; const float* const i20 = F.in[20]; const float* const i21 = F.in[21]; const float* const i22 = F.in[22];
    constexpr int I_SQ = 32 * 64, I_E = 512, NQ = 3 * I_SQ + (MK_MOE_F32 ? 0 : 3 * 32 * I_E);
    for (;;) {
        unsigned b0 = 0;
        if (F.lane == 0) b0 = __hip_atomic_fetch_add((unsigned*)(F.ctl + CW_Q + 64 * qsel), 16u, __ATOMIC_RELAXED, __HIP_MEMORY_SCOPE_AGENT);
        b0 = __builtin_amdgcn_readfirstlane(b0);
        if (b0 >= (unsigned)NQ) break;
        for (int it = (int)b0; it < (int)b0 + 16 && it < NQ; ++it) {
            int r = it;
            if (r < 3 * I_SQ) { const int w = r / I_SQ, q = r % I_SQ, kb = q / 64, nb = q % 64;
                const float* src = i7; size_t doff = WS_WMIX; if (w == 1) { src = i10; doff = WS_WMQ; } if (w == 2) { src = i13; doff = WS_WMO; }
                bf16* dst = (bf16*)(F.ws + doff);
                transpose_item<true>(src + (size_t)(64 * kb) * 2048 + 32 * nb, 2048, dst + (size_t)(32 * nb) * 2048 + 64 * kb, 2048, scr, F.lane); continue; }
            r -= 3 * I_SQ;
            if (r < 2 * 32 * I_E) {
                const int up = r / (32 * I_E), q = r % (32 * I_E), e = q / I_E, q2 = q % I_E, kb = q2 / 16, nb = q2 % 16, n0 = 32 * nb;
                const float* sb = i20; if (up) sb = i21;
                const float* src = sb + (size_t)e * 2048 * 512 + (size_t)(64 * kb) * 512 + n0;
                bf16* dst = WSP(bf16, WS_WGU) + (size_t)(e * 1024 + (n0 >> 7) * 256 + up * 128 + (n0 & 127)) * 2048 + 64 * kb;
                transpose_item<true>(src, 512, dst, 2048, scr, F.lane); continue; }
            r -= 2 * 32 * I_E;
            {
                const int e = r / I_E, q2 = r % I_E, kb = q2 / 64, nb = q2 % 64;
                const float* src = i22 + (size_t)e * 512 * 2048 + (size_t)(64 * kb) * 2048 + 32 * nb;
                bf16* dst = WSP(bf16, WS_WD) + (size_t)(e * 2048 + 32 * nb) * 512 + 64 * kb;
                transpose_item<true>(src, 2048, dst, 512, scr, F.lane); }
        }
    }
}

__device__ __forceinline__ float log_sigmoid_f(float z) { return fminf(z, 0.f) - log1pf(expf(-fabsf(z))); }
template <bool GLA>
__device__ __forceinline__ void mixer_naive_item(Frame& F, int hh, int eg) {
    constexpr int ND = GLA ? 4 : 8;
    const bf16* H = WSP(bf16, WS_H); float* oraw = WSP(float, WS_ORAW);
    const int ei = F.tid & 15, dp = F.tid >> 4, e = eg * 16 + ei;
    const int qcol = GLA ? 4096 + hh * 128 : hh * 256, kcol = GLA ? 4608 + hh * 128 : 1024 + hh * 256, vcol = (GLA ? 5120 : 2048) + hh * 256 + e;
    const int ocol = (GLA ? 1024 : 0) + hh * 256 + eg * 16;
    LAS float* red = (LAS float*)F.lds;
    float S[ND];
#pragma unroll
    for (int i = 0; i < ND; ++i) S[i] = 0.f;
    float wa[GLA ? 4 : 1][16]; float ba[GLA ? 4 : 1];
    if (GLA) {
#pragma unroll
        for (int i = 0; i < 4; ++i) { const int d = dp + 32 * i; ba[i] = F.in[5][hh * 128 + d];
#pragma unroll
            for (int r = 0; r < 16; ++r) wa[i][r] = F.in[4][r * 512 + hh * 128 + d]; }
    }
    const float gamma = 1.0f - exp2f(-5.0f - (float)hh);
    const float* glr = WSP(float, WS_GLR);
    for (int t0 = 0; t0 < T; t0 += 8) {
        float part[8];
#pragma unroll
        for (int tt = 0; tt < 8; ++tt) {
            const int t = t0 + tt; const bf16* hr = H + (size_t)t * HW;
            const float v = bf2f(hr[vcol]);
            float g16[16];
            if (GLA) {
#pragma unroll
                for (int r = 0; r < 16; ++r) g16[r] = glr[t * 16 + r];
            }
            float p = 0.f;
#pragma unroll
            for (int i = 0; i < ND; ++i) { const int d = dp + 32 * i;
                const float q = bf2f(hr[qcol + d]), k = bf2f(hr[kcol + d]);
                float a = gamma;
                if (GLA) { float z = ba[i];
#pragma unroll
                    for (int r = 0; r < 16; ++r) z += g16[r] * wa[i][r];
                    a = expf(log_sigmoid_f(z) * 0.0625f); }
                S[i] = a * S[i] + k * v; p += q * S[i]; }
            p += __shfl_xor(p, 16); p += __shfl_xor(p, 32);
            part[tt] = p;
        }
        if (F.lane < 16) {
#pragma unroll
            for (int tt = 0; tt < 8; ++tt) red[(F.wave * 8 + tt) * 16 + F.lane] = part[tt];
        }
        __syncthreads();
        if (F.tid < 128) { const int tt = F.tid >> 4, e2 = F.tid & 15; float s = 0.f;
#pragma unroll
            for (int w = 0; w < 8; ++w) s += red[(w * 8 + tt) * 16 + e2];
            oraw[(size_t)(t0 + tt) * D + ocol + e2] = s; }
        __syncthreads();
    }
}
__device__ __forceinline__ void p2_mixer_naive(Frame& F) {
    for (int item = F.bid; item < 128; item += F.G) {
        const int h8 = item >> 4, eg = item & 15;
        if (h8 < 4) mixer_naive_item<false>(F, h8, eg); else mixer_naive_item<true>(F, h8 - 4, eg);
    }
}
__device__ __forceinline__ void p3_normgate(Frame& F) {
    const bf16* H = WSP(bf16, WS_H); const float* oraw = WSP(float, WS_ORAW); bf16* mixed = WSP(bf16, WS_MIXED);
    const int gw = F.bid * NWAVES + F.wave, NGW = F.G * NWAVES;
    const f32x4 gn = *(const f32x4*)(F.in[6] + 4 * F.lane);
    for (int t = gw; t < T; t += NGW) {
#pragma unroll
        for (int h8 = 0; h8 < 8; ++h8) {
            const f32x4 o = *(const GAS f32x4*)(oraw + (size_t)t * D + h8 * 256 + 4 * F.lane);
            const int gcol = (h8 < 4 ? 3072 : 6144) + (h8 & 3) * 256 + 4 * F.lane;
            const v2u gw2 = *(const GAS v2u*)(H + (size_t)t * HW + gcol);
            const f32x4 gt = {bflo(gw2.x), bfhi(gw2.x), bflo(gw2.y), bfhi(gw2.y)};
            f32x4 y;
            if (h8 < 4) {
                const float mu = wave_sum((o[0] + o[1]) + (o[2] + o[3])) * (1.f / 256.f);
                const f32x4 dd = o - mu;
                const float var = wave_sum((dd[0] * dd[0] + dd[1] * dd[1]) + (dd[2] * dd[2] + dd[3] * dd[3])) * (1.f / 256.f);
                y = dd * (1.0f / sqrtf(var + LN_EPS));
            } else {
                const float ms = wave_sum((o[0] * o[0] + o[1] * o[1]) + (o[2] * o[2] + o[3] * o[3])) * (1.f / 256.f);
                y = o * (1.0f / sqrtf(ms + LN_EPS)) * gn;
            }
            float r[4];
#pragma unroll
            for (int i = 0; i < 4; ++i) { const float g = gt[i]; r[i] = g / (1.0f + expf(-g)) * y[i]; }
            v2u w; w.x = pk2(r[0], r[1]); w.y = pk2(r[2], r[3]);
            *(GAS v2u*)(mixed + (size_t)t * D + h8 * 256 + 4 * F.lane) = w;
        }
    }
}
__device__ __forceinline__ void ln_apply_plain(Frame& F, const float* Y, const float* g, const float* b, bf16* HB, float* st) {
    const int gw = F.bid * NWAVES + F.wave, NGW = F.G * NWAVES;
    f32x4 cur[8];
    if (gw < T) { const GAS f32x4* yr = (const GAS f32x4*)(Y + (size_t)gw * D) + F.lane;
#pragma unroll
        for (int j = 0; j < 8; ++j) cur[j] = yr[64 * j]; }
    for (int t = gw; t < T; t += NGW) {
        f32x4 nxt[8];
        { const int tn = t + NGW < T ? t + NGW : t; const GAS f32x4* yr = (const GAS f32x4*)(Y + (size_t)tn * D) + F.lane;
#pragma unroll
          for (int j = 0; j < 8; ++j) nxt[j] = yr[64 * j]; }
        f32x4 v[8]; float s = 0.f;
#pragma unroll
        for (int j = 0; j < 8; ++j) { v[j] = cur[j]; s += (v[j][0] + v[j][1]) + (v[j][2] + v[j][3]); }
        const float mean = wave_sum(s) * (1.f / D); float s2 = 0.f;
#pragma unroll
        for (int j = 0; j < 8; ++j) { v[j] = v[j] - mean; s2 += (v[j][0] * v[j][0] + v[j][1] * v[j][1]) + (v[j][2] * v[j][2] + v[j][3] * v[j][3]); }
        const float rstd = 1.f / sqrtf(wave_sum(s2) * (1.f / D) + LN_EPS);
        if (F.lane == 0) { st[2 * t] = mean; st[2 * t + 1] = rstd; }
        GAS v2u* o8 = (GAS v2u*)(HB + (size_t)t * D) + F.lane;
#pragma unroll
        for (int j = 0; j < 8; ++j) { const f32x4 gv = *(const f32x4*)(g + 4 * F.lane + 256 * j), bv = *(const f32x4*)(b + 4 * F.lane + 256 * j);
            v[j] = v[j] * rstd * gv + bv;
            v2u w; w.x = pk2(v[j][0], v[j][1]); w.y = pk2(v[j][2], v[j][3]); o8[64 * j] = w; }
#pragma unroll
        for (int j = 0; j < 8; ++j) cur[j] = nxt[j];
    }
}
template <bool ROUTER>
__device__ __forceinline__ void ln_apply(Frame& F, const float* Y, const float* g, const float* b, bf16* HB, float* st, bool count = true) {
    const int gw = F.bid * NWAVES + F.wave, NGW = F.G * NWAVES;
    for (int t = gw; t < T; t += NGW) {
        const GAS f32x4* yr = (const GAS f32x4*)(Y + (size_t)t * D) + F.lane;
        f32x4 v[8]; float s = 0.f;
#pragma unroll
        for (int j = 0; j < 8; ++j) { v[j] = yr[64 * j]; s += (v[j][0] + v[j][1]) + (v[j][2] + v[j][3]); }
        const float mean = wave_sum(s) * (1.f / D); float s2 = 0.f;
#pragma unroll
        for (int j = 0; j < 8; ++j) { v[j] = v[j] - mean; s2 += (v[j][0] * v[j][0] + v[j][1] * v[j][1]) + (v[j][2] * v[j][2] + v[j][3] * v[j][3]); }
        const float rstd = 1.f / sqrtf(wave_sum(s2) * (1.f / D) + LN_EPS);
        if (F.lane == 0) { st[2 * t] = mean; st[2 * t + 1] = rstd; }
        GAS v2u* o8 = (GAS v2u*)(HB + (size_t)t * D) + F.lane;
#pragma unroll
        for (int j = 0; j < 8; ++j) { const f32x4 gv = *(const f32x4*)(g + 4 * F.lane + 256 * j), bv = *(const f32x4*)(b + 4 * F.lane + 256 * j);
            v[j] = v[j] * rstd * gv + bv;
            v2u w; w.x = pk2(v[j][0], v[j][1]); w.y = pk2(v[j][2], v[j][3]); o8[64 * j] = w; }
        if (ROUTER) {
            const float* Wg = F.in[16]; const float* We = F.in[18];
            float lg[4], le[32];
#pragma unroll
            for (int i = 0; i < 4; ++i) lg[i] = 0.f;
#pragma unroll
            for (int i = 0; i < 32; ++i) le[i] = 0.f;
#pragma unroll
            for (int j = 0; j < 8; ++j) {
#pragma unroll
                for (int i = 0; i < 4; ++i) { const int c = 4 * F.lane + 256 * j + i; const float hv = v[j][i];
                    const f32x4 wg = *(const GAS f32x4*)(Wg + (size_t)c * 4);
#pragma unroll
                    for (int q = 0; q < 4; ++q) lg[q] += hv * wg[q];
#pragma unroll
                    for (int q8 = 0; q8 < 8; ++q8) { const f32x4 we = *(const GAS f32x4*)(We + (size_t)c * 32 + 4 * q8);
#pragma unroll
                        for (int q = 0; q < 4; ++q) le[4 * q8 + q] += hv * we[q]; } }
            }
#pragma unroll
            for (int i = 0; i < 4; ++i) lg[i] = wave_sum(lg[i]) + F.in[17][i];
#pragma unroll
            for (int i = 0; i < 32; ++i) le[i] = wave_sum(le[i]);
            int grp = 0; float gm = lg[0];
#pragma unroll
            for (int i = 1; i < 4; ++i) if (lg[i] > gm) { gm = lg[i]; grp = i; }
            float gs = 0.f;
#pragma unroll
            for (int i = 0; i < 4; ++i) gs += expf(lg[i] - gm);
            const float pg_sel = 1.0f / gs;
            float fe[8];
#pragma unroll
            for (int j = 0; j < 8; ++j) { const float a = grp == 0 ? le[j] : grp == 1 ? le[8 + j] : grp == 2 ? le[16 + j] : le[24 + j]; fe[j] = a + F.in[19][grp * 8 + j]; }
            int i1 = 0; float m1 = fe[0];
#pragma unroll
            for (int j = 1; j < 8; ++j) if (fe[j] > m1) { m1 = fe[j]; i1 = j; }
            int i2 = -1; float m2 = -3.0e38f;
#pragma unroll
            for (int j = 0; j < 8; ++j) if (j != i1 && fe[j] > m2) { m2 = fe[j]; i2 = j; }
            const float p2 = expf(m2 - m1), den = 1.0f / (1.0f + p2);
            if (F.lane == 0) {
                int* ex = WSP(int, WS_EXP); float* gt = WSP(float, WS_GATE);
                const int e1 = grp * 8 + i1, e2 = grp * 8 + i2;
                ex[2 * t] = e1; ex[2 * t + 1] = e2; gt[2 * t] = pg_sel * den; gt[2 * t + 1] = pg_sel * p2 * den;
                if (count) { atomicAdd((unsigned*)(F.ctl + CW_CNT) + e1, 1u); atomicAdd((unsigned*)(F.ctl + CW_CNT) + e2, 1u); }
            }
        }
    }
}
__device__ __forceinline__ void p7_attn_naive(Frame& F) {
    const bf16* Q = WSP(bf16, WS_QB); const bf16* KVM = WSP(bf16, WS_KVM); bf16* att = WSP(bf16, WS_ATT);
    LAS float* qs = (LAS float*)F.lds;
    LAS float* sc = (LAS float*)(F.lds + 16384);
    for (int item = F.bid; item < (T / 8) * 4; item += F.G) {
        const int h = item & 3, t0 = (item >> 2) * 8;
        for (int i = F.tid; i < 8 * 512; i += NTHR) { const int tt = i >> 9, d = i & 511; qs[i] = bf2f(Q[(size_t)(t0 + tt) * D + h * 512 + d]); }
        __syncthreads();
        {
            const int j = F.tid & 255, th = F.tid >> 8;
            const bf16* kr = KVM + (size_t)j * 4096 + h * 512;
            float a0 = 0.f, a1 = 0.f, a2 = 0.f, a3 = 0.f;
            for (int d = 0; d < 512; d += 8) {
                const v4u kw = *(const GAS v4u*)(kr + d);
                const float kf[8] = {bflo(kw.x), bfhi(kw.x), bflo(kw.y), bfhi(kw.y), bflo(kw.z), bfhi(kw.z), bflo(kw.w), bfhi(kw.w)};
#pragma unroll
                for (int i = 0; i < 8; ++i) { a0 += kf[i] * qs[(th * 4 + 0) * 512 + d + i]; a1 += kf[i] * qs[(th * 4 + 1) * 512 + d + i]; a2 += kf[i] * qs[(th * 4 + 2) * 512 + d + i]; a3 += kf[i] * qs[(th * 4 + 3) * 512 + d + i]; }
            }
            const float scl = 0.04419417382415922f;
            sc[(th * 4 + 0) * 256 + j] = a0 * scl; sc[(th * 4 + 1) * 256 + j] = a1 * scl; sc[(th * 4 + 2) * 256 + j] = a2 * scl; sc[(th * 4 + 3) * 256 + j] = a3 * scl;
        }
        __syncthreads();
        {
            float v[4]; float mx = -3.0e38f;
#pragma unroll
            for (int i = 0; i < 4; ++i) { v[i] = sc[F.wave * 256 + F.lane + 64 * i]; mx = fmaxf(mx, v[i]); }
            mx = wave_max(mx); float sm = 0.f;
#pragma unroll
            for (int i = 0; i < 4; ++i) { v[i] = expf(v[i] - mx); sm += v[i]; }
            sm = 1.0f / wave_sum(sm);
#pragma unroll
            for (int i = 0; i < 4; ++i) sc[F.wave * 256 + F.lane + 64 * i] = v[i] * sm;
        }
        __syncthreads();
        {
            const int d = F.tid; const bf16* vr = KVM + 2048 + h * 512 + d;
            float o[8];
#pragma unroll
            for (int i = 0; i < 8; ++i) o[i] = 0.f;
            for (int j = 0; j < 256; ++j) { const float vv = bf2f(vr[(size_t)j * 4096]);
#pragma unroll
                for (int i = 0; i < 8; ++i) o[i] += sc[i * 256 + j] * vv; }
#pragma unroll
            for (int i = 0; i < 8; ++i) att[(size_t)(t0 + i) * D + h * 512 + d] = (bf16)f2bf(o[i]);
        }
        __syncthreads();
    }
}
__device__ __forceinline__ void moe_tile_starts(Frame& F, LAS int* ts) {
    if (F.tid < 64) {
        const unsigned c = F.lane < 32 ? __hip_atomic_load(F.ctl + CW_CUR + (F.lane & 31), RLX_AGENT) : 0u;
        int v = (int)((c + 255u) >> 8);
#pragma unroll
        for (int o = 1; o < 32; o <<= 1) { const int n = __shfl_up(v, o); if (F.lane >= o) v += n; }
        if (F.lane < 32) ts[F.lane + 1] = v;
        if (F.lane == 0) ts[0] = 0;
    }
    __syncthreads();
}
__device__ __forceinline__ void p10_dispatch(Frame& F, LAS int* ts) {
    const int gt = F.bid * NTHR + F.tid, NGT = F.G * NTHR;
    const int* ex = WSP(int, WS_EXP); const int* sl = WSP(int, WS_SLOT); int* pos = WSP(int, WS_POS); int* tok = WSP(int, WS_TOK);
    for (int a = gt; a < 2 * T; a += NGT) { const int p = ts[ex[a]] * 256 + sl[a]; pos[a] = p; tok[p] = a >> 1; }
}
__device__ __forceinline__ void p13_combine(Frame& F) {
    const int gw = F.bid * NWAVES + F.wave, NGW = F.G * NWAVES;
    const bf16* h2 = WSP(bf16, WS_H2B); const bf16* ys = WSP(bf16, WS_YS);
    const int* pos = WSP(int, WS_POS); const float* gt = WSP(float, WS_GATE);
    const float* g3 = F.in[23]; const float* b3 = F.in[24];
    constexpr int R = 2;
    for (int t0 = gw; t0 < T; t0 += R * NGW) {
        v2u yh[R][8], ya[R][8], yc[R][8]; float w0[R], w1[R];
#pragma unroll
        for (int r = 0; r < R; ++r) { const int t = (t0 + r * NGW < T) ? t0 + r * NGW : t0;
            w0[r] = gt[2 * t]; w1[r] = gt[2 * t + 1];
            const int p0 = pos[2 * t], p1 = pos[2 * t + 1];
            const GAS v2u* hr = (const GAS v2u*)(h2 + (size_t)t * D) + F.lane;
            const GAS v2u* y0 = (const GAS v2u*)(ys + (size_t)p0 * D) + F.lane; const GAS v2u* y1 = (const GAS v2u*)(ys + (size_t)p1 * D) + F.lane;
#pragma unroll
            for (int j = 0; j < 8; ++j) { yh[r][j] = hr[64 * j]; ya[r][j] = y0[64 * j]; yc[r][j] = y1[64 * j]; } }
#pragma unroll
        for (int r = 0; r < R; ++r) { const int t = t0 + r * NGW; if (t >= T) break;
            f32x4 v[8]; float s = 0.f;
#pragma unroll
            for (int j = 0; j < 8; ++j) { const v2u hw = yh[r][j], a = ya[r][j], c = yc[r][j];
                const f32x4 h = {bflo(hw.x), bfhi(hw.x), bflo(hw.y), bfhi(hw.y)};
                const f32x4 fa = {bflo(a.x), bfhi(a.x), bflo(a.y), bfhi(a.y)}, fc = {bflo(c.x), bfhi(c.x), bflo(c.y), bfhi(c.y)};
                v[j] = h * ALPHA + fa * w0[r] + fc * w1[r]; s += (v[j][0] + v[j][1]) + (v[j][2] + v[j][3]); }
            const float mean = wave_sum(s) * (1.f / D); float s2 = 0.f;
#pragma unroll
            for (int j = 0; j < 8; ++j) { v[j] = v[j] - mean; s2 += (v[j][0] * v[j][0] + v[j][1] * v[j][1]) + (v[j][2] * v[j][2] + v[j][3] * v[j][3]); }
            const float rstd = 1.f / sqrtf(wave_sum(s2) * (1.f / D) + LN_EPS);
            GAS f32x4* orow = (GAS f32x4*)(F.out + (size_t)t * D) + F.lane;
#pragma unroll
            for (int j = 0; j < 8; ++j) { const f32x4 gv = *(const f32x4*)(g3 + 4 * F.lane + 256 * j), bv = *(const f32x4*)(b3 + 4 * F.lane + 256 * j);
                orow[64 * j] = v[j] * rstd * gv + bv; }
        }
    }
}

constexpr int CS = 128, NB = CS / 64, NS = T / CS;
#define HIDX(t_, c_) ((((size_t)((c_) >> 8)) * 8192 + (size_t)(t_)) * 256 + ((c_) & 255))
constexpr size_t WS_BCUM = WS_ORAW;
constexpr size_t WS_KVR = WS_ORAW + 16 * MiB;
constexpr size_t WS_KVG = WS_KVR + 32 * MiB;
typedef short bf16x8_t __attribute__((ext_vector_type(8)));
typedef short s16x4_t __attribute__((ext_vector_type(4)));
__device__ __forceinline__ s16x4_t lds_tr(const LAS unsigned char* p) { return __builtin_bit_cast(s16x4_t, __builtin_amdgcn_ds_read_tr16_b64_v4i16((LAS s16x4_t*)p)); }
__device__ __forceinline__ bf16x8_t frag_tr(const LAS unsigned char* X, int pitch, int k0, int n0, int lane) {
    const int fq = lane >> 4, q = (lane >> 2) & 3, p = lane & 3;
    const LAS unsigned char* a = X + ((k0 + 8 * fq + q) * pitch + n0 + 4 * p) * 2;
    const s16x4_t lo = lds_tr(a), hi = lds_tr(a + 4 * pitch * 2);
    return __builtin_shufflevector(lo, hi, 0, 1, 2, 3, 4, 5, 6, 7);
}
__device__ __forceinline__ bf16x8_t frag_row(const LAS unsigned char* X, int pitch, int r0, int k0, int lane) {
    return *(const LAS bf16x8_t*)(X + ((r0 + (lane & 15)) * pitch + k0 + 8 * (lane >> 4)) * 2);
}
#define MFMA16(a, b, c) __builtin_amdgcn_mfma_f32_16x16x32_bf16((a), (b), (c), 0, 0, 0)
__device__ __forceinline__ float fexp(float x) { return __builtin_amdgcn_exp2f(x * 1.4426950408889634f); }
__device__ __forceinline__ float silu_g(float g) { return g * __builtin_amdgcn_rcpf(1.0f + __builtin_amdgcn_exp2f(-1.4426950408889634f * g)); }

__device__ __forceinline__ void bcum_item(Frame& F, int s, int h) {
    const int c = F.tid & 127, tq = F.tid >> 7;
    LAS float* tot = (LAS float*)F.lds;
    LAS float* gl = (LAS float*)(F.lds + 2048);
    const float* glr = WSP(float, WS_GLR); float* bc = WSP(float, WS_BCUM);
    __syncthreads();
    *(LAS f32x4*)(gl + 4 * F.tid) = *(const GAS f32x4*)(glr + (size_t)s * CS * 16 + 4 * F.tid);
    float w[16];
#pragma unroll
    for (int r = 0; r < 16; ++r) w[r] = F.in[4][r * 512 + h * 128 + c];
    const float bias = F.in[5][h * 128 + c];
    __syncthreads();
    float vals[32]; float run = 0.f;
    const int tb = s * CS + tq * 32;
#pragma unroll
    for (int i = 0; i < 32; ++i) { const LAS float* gr = gl + (tq * 32 + i) * 16; float z = bias;
#pragma unroll
        for (int r = 0; r < 16; ++r) z += gr[r] * w[r];
        run += log_sigmoid_f(z) * 0.0625f; vals[i] = run; }
    tot[tq * 128 + c] = run;
    __syncthreads();
    float off = 0.f;
#pragma unroll
    for (int q = 0; q < 3; ++q) off += (q < tq) ? tot[q * 128 + c] : 0.f;
#pragma unroll
    for (int i = 0; i < 32; ++i) bc[(size_t)(tb + i) * 512 + h * 128 + c] = vals[i] + off;
}
__device__ __forceinline__ void p1_bcum(Frame& F, int first, int stride) { for (int it = first; it < NS * 4; it += stride) bcum_item(F, it >> 2, it & 3); __syncthreads(); }

__device__ __forceinline__ void unit_sh(int u, int& s, int& h8) { s = (u >> 3) & (NS - 1); h8 = ((u & 7) + 4 * (u >> 8)) & 7; }

template <bool GLA, int MODE>
__device__ __forceinline__ void stage_qk(Frame& F, LAS unsigned char* dst, int s, int jb, int hh, int col0, float lg2gamma) {
    constexpr int DK = GLA ? 128 : 256, PK = DK + 8, CPR = DK / 8, NIT = 64 * CPR / NTHR;
    const bf16* H = WSP(bf16, WS_H); const float* bc = WSP(float, WS_BCUM);
    v4u wv[NIT]; f32x4 b0[GLA ? NIT : 1], b1[GLA ? NIT : 1], l0[(GLA && MODE == 2) ? NIT : 1], l1[(GLA && MODE == 2) ? NIT : 1];
#pragma unroll
    for (int it = 0; it < NIT; ++it) {
        const int ch = F.tid + NTHR * it, r = ch / CPR, cc = ch % CPR, t = s * CS + jb * 64 + r;
        wv[it] = *(const GAS v4u*)(H + HIDX(t, col0 + 8 * cc));
        if (GLA) { b0[it] = *(const GAS f32x4*)(bc + (size_t)t * 512 + hh * 128 + 8 * cc); b1[it] = *(const GAS f32x4*)(bc + (size_t)t * 512 + hh * 128 + 8 * cc + 4);
            if (MODE == 2) { const size_t tl_ = (size_t)(s * CS + CS - 1) * 512 + hh * 128 + 8 * cc; l0[it] = *(const GAS f32x4*)(bc + tl_); l1[it] = *(const GAS f32x4*)(bc + tl_ + 4); } }
    }
#pragma unroll
    for (int it = 0; it < NIT; ++it) {
        const int ch = F.tid + NTHR * it, r = ch / CPR, cc = ch % CPR, tl = jb * 64 + r;
        const v4u w = wv[it];
        float f[8] = {bflo(w.x), bfhi(w.x), bflo(w.y), bfhi(w.y), bflo(w.z), bfhi(w.z), bflo(w.w), bfhi(w.w)};
        if (GLA) {
            float e[8] = {b0[it][0], b0[it][1], b0[it][2], b0[it][3], b1[it][0], b1[it][1], b1[it][2], b1[it][3]};
            if (MODE == 2) { const float l[8] = {l0[it][0], l0[it][1], l0[it][2], l0[it][3], l1[it][0], l1[it][1], l1[it][2], l1[it][3]};
#pragma unroll
                for (int i = 0; i < 8; ++i) e[i] = l[i] - e[i]; }
            else if (MODE == 1) {
#pragma unroll
                for (int i = 0; i < 8; ++i) e[i] = -e[i]; }
#pragma unroll
            for (int i = 0; i < 8; ++i) f[i] *= fexp(e[i]);
        } else {
            const float ex = MODE == 0 ? (float)(tl + 1) : MODE == 1 ? -(float)(tl + 1) : (float)(CS - 1 - tl);
            const float fac = __builtin_amdgcn_exp2f(ex * lg2gamma);
#pragma unroll
            for (int i = 0; i < 8; ++i) f[i] *= fac;
        }
        v4u o; o.x = pk2(f[0], f[1]); o.y = pk2(f[2], f[3]); o.z = pk2(f[4], f[5]); o.w = pk2(f[6], f[7]);
        *(LAS v4u*)(dst + (r * PK + 8 * cc) * 2) = o;
    }
}
__device__ __forceinline__ void stage_v(Frame& F, LAS unsigned char* dst, int s, int jb, int col0) {
    const bf16* H = WSP(bf16, WS_H);
    v4u wv[4];
#pragma unroll
    for (int it = 0; it < 4; ++it) { const int ch = F.tid + NTHR * it, r = ch >> 5, cc = ch & 31, t = s * CS + jb * 64 + r; wv[it] = *(const GAS v4u*)(H + HIDX(t, col0 + 8 * cc)); }
#pragma unroll
    for (int it = 0; it < 4; ++it) { const int ch = F.tid + NTHR * it, r = ch >> 5, cc = ch & 31; *(LAS v4u*)(dst + (r * 264 + 8 * cc) * 2) = wv[it]; }
}

template <bool GLA>
__device__ __forceinline__ void kv_unit(Frame& F, int s, int hh) {
    constexpr int DK = GLA ? 128 : 256, PK = DK + 8, NDT = DK / 16;
    LAS unsigned char* Ks = F.lds; LAS unsigned char* Vs = F.lds + 34816;
    const int kcol = GLA ? 4608 + hh * 128 : 1024 + hh * 256, vcol = (GLA ? 5120 : 2048) + hh * 256;
    const float lg2g = log2f(1.0f - exp2f(-5.0f - (float)hh));
    f32x4 acc[2][NDT];
#pragma unroll
    for (int a = 0; a < 2; ++a)
#pragma unroll
        for (int d = 0; d < NDT; ++d) acc[a][d] = (f32x4){0.f, 0.f, 0.f, 0.f};
    for (int jb = 0; jb < NB; ++jb) {
        __syncthreads();
        stage_qk<GLA, 2>(F, Ks, s, jb, hh, kcol, lg2g);
        stage_v(F, Vs, s, jb, vcol);
        __syncthreads();
#pragma unroll
        for (int ks = 0; ks < 2; ++ks) {
            bf16x8_t vf[2];
#pragma unroll
            for (int et = 0; et < 2; ++et) vf[et] = frag_tr(Vs, 264, 32 * ks, 32 * F.wave + 16 * et, F.lane);
#pragma unroll
            for (int dt = 0; dt < NDT; ++dt) { const bf16x8_t kf = frag_tr(Ks, PK, 32 * ks, 16 * dt, F.lane);
#pragma unroll
                for (int et = 0; et < 2; ++et) acc[et][dt] = MFMA16(kf, vf[et], acc[et][dt]); }
        }
    }
    bf16* kv = GLA ? (WSP(bf16, WS_KVG) + (size_t)(s * 4 + hh) * 256 * 128) : (WSP(bf16, WS_KVR) + (size_t)(s * 4 + hh) * 256 * 256);
    const int fr = F.lane & 15, fq = F.lane >> 4;
#pragma unroll
    for (int et = 0; et < 2; ++et)
#pragma unroll
        for (int dt = 0; dt < NDT; ++dt) { v2u w; w.x = pk2(acc[et][dt][0], acc[et][dt][1]); w.y = pk2(acc[et][dt][2], acc[et][dt][3]);
            *(GAS v2u*)(kv + (size_t)(32 * F.wave + 16 * et + fr) * DK + 16 * dt + 4 * fq) = w; }
}
__device__ __forceinline__ void p2_kv(Frame& F) {
    for (int u = F.bid; u < 8 * NS; u += F.G) { int s, h8; unit_sh(u, s, h8);
        if (s == NS - 1) continue;
        if (h8 < 4) kv_unit<false>(F, s, h8); else kv_unit<true>(F, s, h8 - 4); }
    __syncthreads();
}
__device__ __forceinline__ void p3_scan(Frame& F) {
    constexpr int NR = 4 * 256 * 64, NG = 4 * 256 * 32, NITEM = NR + NG;
    const float* bc = WSP(float, WS_BCUM);
    const int per = (NITEM + F.G - 1) / F.G;
    for (int k0 = F.tid; k0 < per; k0 += NTHR) {
      const int it = F.bid * per + k0;
      if (it < NITEM) {
        const bool gla = it >= NR; const int r = gla ? it - NR : it;
        const int sh = gla ? 5 : 6, dk = gla ? 128 : 256;
        const int cc = r & ((1 << sh) - 1), e = (r >> sh) & 255, hh = r >> (sh + 8);
        bf16* base = (gla ? WSP(bf16, WS_KVG) : WSP(bf16, WS_KVR)) + ((size_t)hh * 256 + e) * dk + 4 * cc;
        const size_t sstride = (size_t)4 * 256 * dk;
        const float dret = __builtin_amdgcn_exp2f((float)CS * log2f(1.0f - exp2f(-5.0f - (float)hh)));
        float S[4] = {0.f, 0.f, 0.f, 0.f};
        static_assert(NS - 1 == 63, "batching below assumes 63 steps");
#pragma unroll 1
        for (int s0 = 0; s0 < NS - 1; s0 += 21) {
            v2u wv[21]; f32x4 lv[21];
#pragma unroll
            for (int j = 0; j < 21; ++j) { wv[j] = *(const GAS v2u*)(base + (size_t)(s0 + j) * sstride);
                if (gla) lv[j] = *(const GAS f32x4*)(bc + (size_t)((s0 + j) * CS + CS - 1) * 512 + hh * 128 + 4 * cc); else lv[j] = (f32x4){0.f, 0.f, 0.f, 0.f}; }
#pragma unroll
            for (int j = 0; j < 21; ++j) {
                v2u o; o.x = pk2(S[0], S[1]); o.y = pk2(S[2], S[3]);
                *(GAS v2u*)(base + (size_t)(s0 + j) * sstride) = o;
                const float f[4] = {bflo(wv[j].x), bfhi(wv[j].x), bflo(wv[j].y), bfhi(wv[j].y)};
                float dec[4] = {dret, dret, dret, dret};
                if (gla) { dec[0] = fexp(lv[j][0]); dec[1] = fexp(lv[j][1]); dec[2] = fexp(lv[j][2]); dec[3] = fexp(lv[j][3]); }
#pragma unroll
                for (int i = 0; i < 4; ++i) S[i] = dec[i] * S[i] + f[i];
            }
        }
        { GAS v2u* p = (GAS v2u*)(base + (size_t)(NS - 1) * sstride); v2u o; o.x = pk2(S[0], S[1]); o.y = pk2(S[2], S[3]); *p = o; }
      }
    }
}
template <bool GLA>
__device__ __forceinline__ void out_unit(Frame& F, int s, int hh) {
    constexpr int DK = GLA ? 128 : 256, PK = DK + 8, NKS = DK / 32;
    LAS unsigned char* Qs = F.lds; LAS unsigned char* Ks = F.lds + 33792; LAS unsigned char* Vs = F.lds + 67584; LAS unsigned char* Ps = F.lds + 101376;
    LAS float* red = (LAS float*)(F.lds + 110592);
    const int qcol = GLA ? 4096 + hh * 128 : hh * 256, kcol = GLA ? 4608 + hh * 128 : 1024 + hh * 256, vcol = (GLA ? 5120 : 2048) + hh * 256;
    const int gcol = (GLA ? 6144 : 3072) + hh * 256, ocol = (GLA ? 1024 : 0) + hh * 256;
    const float lg2g = log2f(1.0f - exp2f(-5.0f - (float)hh));
    const bf16* H = WSP(bf16, WS_H); bf16* mixed = WSP(bf16, WS_MIXED);
    const bf16* st = GLA ? (WSP(bf16, WS_KVG) + (size_t)(s * 4 + hh) * 256 * 128) : (WSP(bf16, WS_KVR) + (size_t)(s * 4 + hh) * 256 * 256);
    const int fr = F.lane & 15, fq = F.lane >> 4, w = F.wave, mt = w >> 1, nt0 = 2 * (w & 1);
    static_assert(NB == 2, "the step program below is written for two 64-token sub-blocks");
    f32x4 accO[4][2]; bf16x8_t sfa[NKS][2]; v2u gpre[4][2];
#pragma unroll 1
    for (int step = 0; step < 3; ++step) {
        const int i = step > 0 ? 1 : 0, j = step > 1 ? 1 : 0;
        {
            __syncthreads();
            if (step < 2) stage_qk<GLA, 0>(F, Qs, s, i, hh, qcol, lg2g);
            if (step != 1) { stage_qk<GLA, 1>(F, Ks, s, j, hh, kcol, lg2g); stage_v(F, Vs, s, j, vcol); }
            if (step < 2) {
#pragma unroll
                for (int m = 0; m < 4; ++m)
#pragma unroll
                    for (int n = 0; n < 2; ++n) accO[m][n] = (f32x4){0.f, 0.f, 0.f, 0.f};
            }
            if (step != 1) {
                if (s > 0) {
#pragma unroll
                    for (int ks = 0; ks < NKS; ++ks)
#pragma unroll
                        for (int n = 0; n < 2; ++n) sfa[ks][n] = *(const GAS bf16x8_t*)(st + (size_t)(32 * w + 16 * n + fr) * DK + 32 * ks + 8 * fq);
                }
#pragma unroll
                for (int m2 = 0; m2 < 4; ++m2)
#pragma unroll
                    for (int n = 0; n < 2; ++n) gpre[m2][n] = *(const GAS v2u*)(H + HIDX(s * CS + i * 64 + 16 * m2 + fr, gcol + 32 * w + 16 * n + 4 * fq));
            }
            __syncthreads();
            f32x4 accS[2] = {(f32x4){0.f, 0.f, 0.f, 0.f}, (f32x4){0.f, 0.f, 0.f, 0.f}};
#pragma unroll
            for (int ks = 0; ks < NKS; ++ks) { const bf16x8_t qf = frag_row(Qs, PK, 16 * mt, 32 * ks, F.lane);
#pragma unroll
                for (int n2 = 0; n2 < 2; ++n2) { const bf16x8_t kf = frag_row(Ks, PK, 16 * (nt0 + n2), 32 * ks, F.lane); accS[n2] = MFMA16(kf, qf, accS[n2]); } }
#pragma unroll
            for (int n2 = 0; n2 < 2; ++n2) { const int row = 16 * mt + fr, c0 = 16 * (nt0 + n2) + 4 * fq; float pv[4];
#pragma unroll
                for (int jj = 0; jj < 4; ++jj) pv[jj] = (i == j && c0 + jj > row) ? 0.f : accS[n2][jj];
                v2u pw; pw.x = pk2(pv[0], pv[1]); pw.y = pk2(pv[2], pv[3]);
                *(LAS v2u*)(Ps + (row * 72 + c0) * 2) = pw; }
            __syncthreads();
#pragma unroll
            for (int ks = 0; ks < 2; ++ks) {
                bf16x8_t vf[2];
#pragma unroll
                for (int n = 0; n < 2; ++n) vf[n] = frag_tr(Vs, 264, 32 * ks, 32 * w + 16 * n, F.lane);
#pragma unroll
                for (int m = 0; m < 4; ++m) { const bf16x8_t pf = frag_row(Ps, 72, 16 * m, 32 * ks, F.lane);
#pragma unroll
                    for (int n = 0; n < 2; ++n) accO[m][n] = MFMA16(vf[n], pf, accO[m][n]); }
            }
        }
        if (step == 1) continue;
        if (s > 0) {
#pragma unroll
            for (int ks = 0; ks < NKS; ++ks) {
#pragma unroll
                for (int m = 0; m < 4; ++m) { const bf16x8_t qf = frag_row(Qs, PK, 16 * m, 32 * ks, F.lane);
#pragma unroll
                    for (int n = 0; n < 2; ++n) accO[m][n] = MFMA16(sfa[ks][n], qf, accO[m][n]); }
            }
        }
#pragma unroll
        for (int m = 0; m < 4; ++m) { float s1 = 0.f, s2 = 0.f;
#pragma unroll
            for (int n = 0; n < 2; ++n)
#pragma unroll
                for (int jj = 0; jj < 4; ++jj) { const float v = accO[m][n][jj]; s1 += v; s2 += v * v; }
            s1 += __shfl_xor(s1, 16); s1 += __shfl_xor(s1, 32); s2 += __shfl_xor(s2, 16); s2 += __shfl_xor(s2, 32);
            if (fq == 0) { red[(w * 64 + 16 * m + fr) * 2] = s1; red[(w * 64 + 16 * m + fr) * 2 + 1] = s2; } }
        __syncthreads();
#pragma unroll
        for (int m = 0; m < 4; ++m) { const int row = 16 * m + fr; float s1 = 0.f, s2 = 0.f;
#pragma unroll
            for (int ww = 0; ww < 8; ++ww) { s1 += red[(ww * 64 + row) * 2]; s2 += red[(ww * 64 + row) * 2 + 1]; }
            const float mean = s1 * (1.f / 256.f), ex2 = s2 * (1.f / 256.f);
            const float mu = GLA ? 0.f : mean, var = GLA ? ex2 : fmaxf(ex2 - mean * mean, 0.f);
            const float rstd = 1.0f / sqrtf(var + LN_EPS);
            const int t = s * CS + i * 64 + row;
#pragma unroll
            for (int n = 0; n < 2; ++n) { const int e = 32 * w + 16 * n + 4 * fq;
                const v2u gw2 = gpre[m][n];
                const float gt[4] = {bflo(gw2.x), bfhi(gw2.x), bflo(gw2.y), bfhi(gw2.y)};
                f32x4 gn = {1.f, 1.f, 1.f, 1.f}; if (GLA) gn = *(const f32x4*)(F.in[6] + e);
                float r4[4];
#pragma unroll
                for (int jj = 0; jj < 4; ++jj) { const float y = (accO[m][n][jj] - mu) * rstd * gn[jj]; r4[jj] = silu_g(gt[jj]) * y; }
                v2u ow; ow.x = pk2(r4[0], r4[1]); ow.y = pk2(r4[2], r4[3]);
                *(GAS v2u*)(mixed + (size_t)t * D + ocol + e) = ow; } }
    }
}
__device__ __forceinline__ void p4_out(Frame& F) {
    for (int u = F.bid; u < 8 * NS; u += F.G) { int s, h8; unit_sh(u, s, h8);
        if (h8 < 4) out_unit<false>(F, s, h8); else out_unit<true>(F, s, h8 - 4); }
    __syncthreads();
}

__device__ __forceinline__ void kv_chunk_load(Frame& F, v4u (&R)[8], const bf16* src  ) {
#pragma unroll
    for (int it = 0; it < 8; ++it) { const int ch = F.tid + NTHR * it, r = ch >> 4, cc = ch & 15; R[it] = *(const GAS v4u*)(src + (size_t)r * 4096 + 8 * cc); }
}
__device__ __forceinline__ void kv_chunk_store(Frame& F, const v4u (&R)[8], LAS unsigned char* dst) {
#pragma unroll
    for (int it = 0; it < 8; ++it) { const int ch = F.tid + NTHR * it, r = ch >> 4, cc = ch & 15; *(LAS v4u*)(dst + (r * 136 + 8 * cc) * 2) = R[it]; }
}
__device__ __forceinline__ void p8_attn(Frame& F) {
    const bf16* Q = WSP(bf16, WS_QB); const bf16* KVM = WSP(bf16, WS_KVM); bf16* att = WSP(bf16, WS_ATT);
    constexpr int CB = 256 * 136 * 2;
    const int fr = F.lane & 15, fq = F.lane >> 4, q4 = (F.lane >> 2) & 3, p4 = F.lane & 3;
    for (int u = F.bid; u < (T / 128) * 4; u += F.G) {
        const int h = u & 3, r0 = (u >> 2) * 128 + 16 * F.wave;
        v4u R[8];
        bf16x8_t qa[16];
#pragma unroll
        for (int ks = 0; ks < 16; ++ks) qa[ks] = *(const GAS bf16x8_t*)(Q + (size_t)(r0 + fr) * D + h * 512 + 32 * ks + 8 * fq);
        __syncthreads();
        kv_chunk_load(F, R, KVM + h * 512); kv_chunk_store(F, R, F.lds);
        __syncthreads();
        f32x4 accS[16];
#pragma unroll
        for (int i = 0; i < 16; ++i) accS[i] = (f32x4){0.f, 0.f, 0.f, 0.f};
#pragma unroll
        for (int dc = 0; dc < 4; ++dc) {
            kv_chunk_load(F, R, dc < 3 ? KVM + h * 512 + (dc + 1) * 128 : KVM + 2048 + h * 512);
            const LAS unsigned char* Cs = F.lds + (dc & 1) * CB;
#pragma unroll
            for (int ks = 0; ks < 4; ++ks)
#pragma unroll
                for (int nt = 0; nt < 16; ++nt) accS[nt] = MFMA16(frag_row(Cs, 136, 16 * nt, 32 * ks, F.lane), qa[4 * dc + ks], accS[nt]);
            kv_chunk_store(F, R, F.lds + ((dc + 1) & 1) * CB);
            __syncthreads();
        }
        float mx = -3.0e38f;
#pragma unroll
        for (int nt = 0; nt < 16; ++nt)
#pragma unroll
            for (int jj = 0; jj < 4; ++jj) mx = fmaxf(mx, accS[nt][jj]);
        mx = fmaxf(mx, __shfl_xor(mx, 16)); mx = fmaxf(mx, __shfl_xor(mx, 32));
        const float sl2 = 0.04419417382415922f * 1.4426950408889634f;
        float sm = 0.f;
#pragma unroll
        for (int nt = 0; nt < 16; ++nt)
#pragma unroll
            for (int jj = 0; jj < 4; ++jj) { const float p = __builtin_amdgcn_exp2f((accS[nt][jj] - mx) * sl2); accS[nt][jj] = p; sm += p; }
        sm += __shfl_xor(sm, 16); sm += __shfl_xor(sm, 32);
        const float inv = 1.0f / sm;
        bf16x8_t pf[8];
#pragma unroll
        for (int ks2 = 0; ks2 < 8; ++ks2) { v4u w; w.x = pk2(accS[2 * ks2][0] * inv, accS[2 * ks2][1] * inv); w.y = pk2(accS[2 * ks2][2] * inv, accS[2 * ks2][3] * inv);
            w.z = pk2(accS[2 * ks2 + 1][0] * inv, accS[2 * ks2 + 1][1] * inv); w.w = pk2(accS[2 * ks2 + 1][2] * inv, accS[2 * ks2 + 1][3] * inv); pf[ks2] = __builtin_bit_cast(bf16x8_t, w); }
#pragma unroll 1
        for (int ec = 0; ec < 4; ++ec) {
            if (ec < 3) kv_chunk_load(F, R, KVM + 2048 + h * 512 + (ec + 1) * 128);
            const LAS unsigned char* Cs = F.lds + (ec & 1) * CB;
            f32x4 accO[8];
#pragma unroll
            for (int i = 0; i < 8; ++i) accO[i] = (f32x4){0.f, 0.f, 0.f, 0.f};
#pragma unroll
            for (int ks2 = 0; ks2 < 8; ++ks2)
#pragma unroll
                for (int et = 0; et < 8; ++et) { const LAS unsigned char* a = Cs + ((32 * ks2 + 4 * fq + q4) * 136 + 16 * et + 4 * p4) * 2;
                    const s16x4_t lo = lds_tr(a), hi = lds_tr(a + 16 * 136 * 2);
                    accO[et] = MFMA16(__builtin_shufflevector(lo, hi, 0, 1, 2, 3, 4, 5, 6, 7), pf[ks2], accO[et]); }
#pragma unroll
            for (int et = 0; et < 8; ++et) { v2u w; w.x = pk2(accO[et][0], accO[et][1]); w.y = pk2(accO[et][2], accO[et][3]);
                *(GAS v2u*)(att + (size_t)(r0 + fr) * D + h * 512 + ec * 128 + 16 * et + 4 * fq) = w; }
            if (ec < 3) kv_chunk_store(F, R, F.lds + ((ec + 1) & 1) * CB);
            __syncthreads();
        }
    }
}

__device__ __forceinline__ void p10_ln_router(Frame& F) {
    const float* Y = WSP(float, WS_Y2); const float* g = F.in[14]; const float* b = F.in[15]; bf16* HB = WSP(bf16, WS_H2B); float* st = WSP(float, WS_ST2);
    const float* Wg = F.in[16]; const float* We = F.in[18];
    LAS float* stl = (LAS float*)F.lds;
    LAS float* part = (LAS float*)(F.lds + 1024);
    LAS int* lcnt = (LAS int*)(F.lds + 1024 + 24576);
    LAS int* lbase = lcnt + 32;
    if (F.tid < 32) lcnt[F.tid] = 0;
    { int* tok = WSP(int, WS_TOK); for (int i = F.bid * NTHR + F.tid; i < PMAX; i += F.G * NTHR) tok[i] = 0; }
    __syncthreads();
    const int fr = F.lane & 15, fq = F.lane >> 4;
    for (int item = F.bid; item < T / 32; item += F.G) {
        const int row0 = item * 32;
#pragma unroll
        for (int i = 0; i < 4; ++i) {
            const int t = row0 + 4 * F.wave + i;
            const GAS f32x4* yr = (const GAS f32x4*)(Y + (size_t)t * D) + F.lane;
            f32x4 v[8]; float s = 0.f;
#pragma unroll
            for (int j = 0; j < 8; ++j) { v[j] = yr[64 * j]; s += (v[j][0] + v[j][1]) + (v[j][2] + v[j][3]); }
            const float mean = wave_sum(s) * (1.f / D); float s2 = 0.f;
#pragma unroll
            for (int j = 0; j < 8; ++j) { v[j] = v[j] - mean; s2 += (v[j][0] * v[j][0] + v[j][1] * v[j][1]) + (v[j][2] * v[j][2] + v[j][3] * v[j][3]); }
            const float rstd = 1.f / sqrtf(wave_sum(s2) * (1.f / D) + LN_EPS);
            if (F.lane == 0) { st[2 * t] = mean; st[2 * t + 1] = rstd; stl[2 * (4 * F.wave + i)] = mean; stl[2 * (4 * F.wave + i) + 1] = rstd; }
            GAS v2u* o8 = (GAS v2u*)(HB + (size_t)t * D) + F.lane;
#pragma unroll
            for (int j = 0; j < 8; ++j) { const f32x4 gv = *(const f32x4*)(g + 4 * F.lane + 256 * j), bv = *(const f32x4*)(b + 4 * F.lane + 256 * j);
                const f32x4 hv = v[j] * rstd * gv + bv;
                v2u w; w.x = pk2(hv[0], hv[1]); w.y = pk2(hv[2], hv[3]); o8[64 * j] = w; }
        }
        __syncthreads();
        {
            const int rt = F.wave >> 2, kq = F.wave & 3;
            const int r = row0 + 16 * rt + fr;
            const float mu = stl[2 * (16 * rt + fr)], rstd = stl[2 * (16 * rt + fr) + 1];
            f32x4 acc0 = {0.f, 0.f, 0.f, 0.f}, acc1 = acc0, acc2 = acc0;
            const float* yp = Y + (size_t)r * D + 512 * kq + 4 * fq;
            const float* wep = We + (size_t)(512 * kq + 4 * fq) * 32 + fr;
            const float* wgp = Wg + (size_t)(512 * kq + 4 * fq) * 4 + (fr & 3);
            const float gm = fr < 4 ? 1.f : 0.f;
#pragma unroll 8
            for (int it = 0; it < 32; ++it) {
                const int k0 = 16 * it;
                const f32x4 y4 = *(const GAS f32x4*)(yp + k0), g4 = *(const f32x4*)(g + 512 * kq + 4 * fq + k0), b4 = *(const f32x4*)(b + 512 * kq + 4 * fq + k0);
                const f32x4 a = (y4 - mu) * rstd * g4 + b4;
#pragma unroll
                for (int s = 0; s < 4; ++s) {
                    const float b0 = wep[(size_t)(k0 + s) * 32], b1 = wep[(size_t)(k0 + s) * 32 + 16], b2 = wgp[(size_t)(k0 + s) * 4] * gm;
                    acc0 = __builtin_amdgcn_mfma_f32_16x16x4f32(a[s], b0, acc0, 0, 0, 0);
                    acc1 = __builtin_amdgcn_mfma_f32_16x16x4f32(a[s], b1, acc1, 0, 0, 0);
                    acc2 = __builtin_amdgcn_mfma_f32_16x16x4f32(a[s], b2, acc2, 0, 0, 0);
                }
            }
            LAS float* pw = part + F.wave * 768;
#pragma unroll
            for (int jj = 0; jj < 4; ++jj) { pw[(4 * fq + jj) * 48 + fr] = acc0[jj]; pw[(4 * fq + jj) * 48 + 16 + fr] = acc1[jj]; pw[(4 * fq + jj) * 48 + 32 + fr] = acc2[jj]; }
        }
        __syncthreads();
        int e1 = 0, e2 = 0, r1 = 0, r2 = 0; float g1 = 0.f, g2 = 0.f;
        if (F.tid < 32) {
            const int rt = F.tid >> 4, rr = F.tid & 15;
            float le[32], lg[4];
#pragma unroll
            for (int c = 0; c < 32; ++c) { float s = 0.f;
#pragma unroll
                for (int kq = 0; kq < 4; ++kq) s += part[(rt * 4 + kq) * 768 + rr * 48 + c]; le[c] = s; }
#pragma unroll
            for (int c = 0; c < 4; ++c) { float s = 0.f;
#pragma unroll
                for (int kq = 0; kq < 4; ++kq) s += part[(rt * 4 + kq) * 768 + rr * 48 + 32 + c]; lg[c] = s + F.in[17][c]; }
            int grp = 0; float gmx = lg[0];
#pragma unroll
            for (int i = 1; i < 4; ++i) if (lg[i] > gmx) { gmx = lg[i]; grp = i; }
            float gs = 0.f;
#pragma unroll
            for (int i = 0; i < 4; ++i) gs += expf(lg[i] - gmx);
            const float pg_sel = 1.0f / gs;
            float fe[8];
#pragma unroll
            for (int j = 0; j < 8; ++j) { const float a = grp == 0 ? le[j] : grp == 1 ? le[8 + j] : grp == 2 ? le[16 + j] : le[24 + j]; fe[j] = a + F.in[19][grp * 8 + j]; }
            int i1 = 0; float m1 = fe[0];
#pragma unroll
            for (int j = 1; j < 8; ++j) if (fe[j] > m1) { m1 = fe[j]; i1 = j; }
            int i2 = -1; float m2 = -3.0e38f;
#pragma unroll
            for (int j = 0; j < 8; ++j) if (j != i1 && fe[j] > m2) { m2 = fe[j]; i2 = j; }
            const float p2 = expf(m2 - m1), den = 1.0f / (1.0f + p2);
            e1 = grp * 8 + i1; e2 = grp * 8 + i2; g1 = pg_sel * den; g2 = pg_sel * p2 * den;
            r1 = __hip_atomic_fetch_add((int*)(lcnt + e1), 1, __ATOMIC_RELAXED, __HIP_MEMORY_SCOPE_WORKGROUP); r2 = __hip_atomic_fetch_add((int*)(lcnt + e2), 1, __ATOMIC_RELAXED, __HIP_MEMORY_SCOPE_WORKGROUP);
        }
        __syncthreads();
        if (F.tid < 32) { const int c = lcnt[F.tid];
            lbase[F.tid] = c ? (int)__hip_atomic_fetch_add((unsigned*)(F.ctl + CW_CUR) + F.tid, (unsigned)c, __ATOMIC_RELAXED, __HIP_MEMORY_SCOPE_AGENT) : 0; }
        __syncthreads();
        if (F.tid < 32) {
            const int t = row0 + F.tid;
            int* ex = WSP(int, WS_EXP); float* gt = WSP(float, WS_GATE); int* sl = WSP(int, WS_SLOT);
            ex[2 * t] = e1; ex[2 * t + 1] = e2; gt[2 * t] = g1; gt[2 * t + 1] = g2;
            sl[2 * t] = lbase[e1] + r1; sl[2 * t + 1] = lbase[e2] + r2;
            lcnt[F.tid] = 0;
        }
        __syncthreads();
    }
}


#define XB_TMO      128
#define XB_XCNT(j)  (256  + 64 * (j))
#define XB_XSUB(j)  (1280 + 64 * (j))
#define XB_XGEN(j)  (2304 + 64 * (j))
#define XB_TOP      3328
#define XB_TOPGEN   3392
#define XCD_BAR_WORDS 3456
#define XB_SPIN_CAP (1u << 22)
__device__ __forceinline__ unsigned xb_ld(unsigned* p)              { return __hip_atomic_load(p, __ATOMIC_RELAXED, __HIP_MEMORY_SCOPE_AGENT); }
__device__ __forceinline__ unsigned xb_add(unsigned* p, unsigned v) { return __hip_atomic_fetch_add(p, v, __ATOMIC_RELAXED, __HIP_MEMORY_SCOPE_AGENT); }
__device__ __forceinline__ unsigned xb_xcc_id() { return (unsigned)__builtin_amdgcn_s_getreg((3 << 11) | 20) & 0xFu; }
#define XB_SPIN(cond, bar) do { unsigned _sp = 0; while (cond) { __builtin_amdgcn_s_sleep(1); \
    if ((++_sp & 255u) == 0u) { if (xb_ld(&(bar)[XB_TMO])) break; if (_sp > XB_SPIN_CAP) { atomicAdd(&(bar)[XB_TMO], 1u); break; } } } } while (0)
struct XcdBarrier { unsigned* bar; unsigned x; volatile LAS unsigned* st; };
__device__ __forceinline__ XcdBarrier xcd_barrier_post(unsigned* bar, volatile LAS unsigned* st) {
    XcdBarrier b; b.bar = bar; b.x = xb_xcc_id(); b.st = st;
    if (threadIdx.x == 0) (void)xb_add(&bar[XB_XCNT(b.x)], 1u);
    return b;
}
__device__ __forceinline__ void xcd_barrier_complete(unsigned* bar, unsigned x, unsigned& nloc, unsigned& nx) {
    const unsigned G = gridDim.x * gridDim.y * gridDim.z;
    unsigned sum, cnt, mine, sp = 0u;
    for (;;) {
        sum = 0u; cnt = 0u; mine = 0u;
#pragma unroll
        for (unsigned j = 0; j < 16; ++j) { const unsigned c = xb_ld(&bar[XB_XCNT(j)]); sum += c; cnt += (c > 0u) ? 1u : 0u; mine = (j == x) ? c : mine; }
        if (sum == G) break;
        __builtin_amdgcn_s_sleep(1);
        if ((++sp & 255u) == 0u) { if (xb_ld(&bar[XB_TMO])) break; if (sp > XB_SPIN_CAP) { atomicAdd(&bar[XB_TMO], 1u); break; } }
    }
    nloc = mine > 0u ? mine : 1u; nx = cnt > 0u ? cnt : 1u;
}
__device__ __forceinline__ void xcd_barrier(const XcdBarrier& b) {
    asm volatile("s_waitcnt vmcnt(0)" ::: "memory");
    __syncthreads();
    if (threadIdx.x == 0) {
        unsigned* bar = b.bar;
        __builtin_amdgcn_s_waitcnt(0);
        unsigned nloc = b.st[0], nx = b.st[1];
        if (nloc == 0u) { xcd_barrier_complete(bar, b.x, nloc, nx); b.st[0] = nloc; b.st[1] = nx; }
        const unsigned old = xb_add(&bar[XB_XSUB(b.x)], 1u);
        const unsigned gen = old / nloc;
        if (old + 1u == (gen + 1u) * nloc) {
            __builtin_amdgcn_fence(__ATOMIC_RELEASE, "agent");
            asm volatile("s_waitcnt vmcnt(0)" ::: "memory");
            const unsigned og = xb_add(&bar[XB_TOP], 1u);
            const unsigned tg = og / nx;
            if (og + 1u == (tg + 1u) * nx) xb_add(&bar[XB_TOPGEN], 1u);
            else XB_SPIN(xb_ld(&bar[XB_TOPGEN]) == tg, bar);
            __builtin_amdgcn_fence(__ATOMIC_ACQUIRE, "agent");
            xb_add(&bar[XB_XGEN(b.x)], 1u);
            asm volatile("s_waitcnt vmcnt(0)" ::: "memory");
        } else {
            XB_SPIN(xb_ld(&bar[XB_XGEN(b.x)]) == gen, bar);
            __builtin_amdgcn_fence(__ATOMIC_ACQUIRE, "agent");
            asm volatile("s_waitcnt vmcnt(0)" ::: "memory");
        }
    }
    __syncthreads();
}

struct Args { const float* in[25]; float* out; unsigned char* ws; int ph_lo, ph_hi, use_bar, pad; };
__global__ void __launch_bounds__(NTHR, 2) mega(Args args) {
    extern __shared__ __attribute__((aligned(16))) unsigned char lds[];
    Frame F;
    F.lds = (LAS unsigned char*)lds;
    F.MISC = (volatile LAS unsigned*)(F.lds + MISC_OFF);
    F.tid = threadIdx.x; F.lane = F.tid & 63; F.wave = __builtin_amdgcn_readfirstlane(F.tid >> 6);
    F.G = gridDim.x; F.bid = blockIdx.x;
    F.ws = args.ws; F.ctl = (gu32*)(args.ws + WS_CTL);
#pragma unroll
    for (int i = 0; i < 25; ++i) F.in[i] = args.in[i];
    F.out = args.out;
    for (int u = F.tid; u < (LDS_BYTES - LDSCTL_OFF) / 4; u += NTHR) ((LAS unsigned*)(F.lds + LDSCTL_OFF))[u] = 0u;
    __syncthreads();
    LAS int* ts = (LAS int*)(F.lds + MISC_OFF + 64);
    XcdBarrier bar; bar.bar = (unsigned*)(F.ctl + CW_BAR); bar.x = 0; bar.st = nullptr;
    if (args.use_bar) bar = xcd_barrier_post((unsigned*)(F.ctl + CW_BAR), F.MISC + 8);
    const int lo = args.ph_lo, hi = args.ph_hi;
#if PROBE_T == 100
    if (F.tid == 0) __hip_atomic_store(F.ctl + CW_LN1 + F.bid, xb_xcc_id() + 1u, RLX_AGENT);
#endif
#if PROBE_T >= 0
    unsigned long long pt0 = __builtin_amdgcn_s_memrealtime(), pdelay = 0ull;
#endif
#if MK_CG_SYNC == 2
    if (args.use_bar == 2) cooperative_groups::this_grid().sync();
#endif
#define IN(k) (lo <= (k) && (k) < hi)
#if PROBE_T >= 0
#if PROBE_T == 100
#define PROBE_STAMP(k) do { if ((k) == 0 && F.bid == 0 && F.tid == 0) { unsigned mm = 0; for (int b_ = 0; b_ < 256; ++b_) mm += (__hip_atomic_load(F.ctl + CW_LN1 + b_, RLX_AGENT) != __hip_atomic_load(F.ctl + CW_LN1 + (b_ & 7), RLX_AGENT)) ? 1u : 0u; pdelay = 100ull * mm; } } while (0)
#else
#define PROBE_STAMP(k) do { if ((k) == PROBE_T) pdelay = __builtin_amdgcn_s_memrealtime() - pt0; } while (0)
#endif
#else
#define PROBE_STAMP(k) do { } while (0)
#endif
#define REPS(k) for (int _r = 0; _r < ((k) == PROBE_PH ? PROBE_N : 1); ++_r)
#define SEAM(k) do { if (IN(k) && IN((k) + 1)) { if (MK_CG_SYNC == 1 && (k) == 0) cooperative_groups::this_grid().sync(); else { xcd_barrier(bar); if (PROBE_PH == 100) for (int _b = 1; _b < PROBE_N; ++_b) xcd_barrier(bar); } PROBE_STAMP(k); } } while (0)

    if (IN(0)) { REPS(0) p0_prologue(F); SEAM(0); }
    if (IN(1)) {
        p1_bcum(F, F.bid, F.G);
        const int g8 = F.bid >> 3, nsb = (g8 * NSG) >> 5; const bool streamer = (F.G == 256) && ((((g8 + 1) * NSG) >> 5) != nsb);
        if (!streamer) {
            pg8::Gemm g{WSP(pg8::bf16_t, WS_XB), WSP(pg8::bf16_t, WS_WIN), T + MEMN, HW + 4096, D}; pg8::OrderG1 S;
            if (F.G == 256) S.init(F.G - 8 * NSG, F.bid - 8 * nsb); else S.init(F.G, F.bid);
            pg8::EpiH E{WSP(pg8::bf16_t, WS_H), WSP(pg8::bf16_t, WS_KVM), WSP(float, WS_RC), WSP(float, WS_RS)};
            pg8::gemm_phase<pg8::EpiH, pg8::OrderG1, true, true>(F.lds, g, S, E);
        }
        transpose_queue(F);
        if (PROBE_PH == 102) for (int _q = 1; _q < PROBE_N; ++_q) transpose_queue(F, _q);
        SEAM(1);
    }
#if PROBE_PH == 101
    if (IN(1)) {
        pg8::Gemm g{WSP(pg8::bf16_t, WS_XB), WSP(pg8::bf16_t, WS_WIN), T + MEMN, HW + 4096, D}; pg8::OrderG1 S; S.init(F.G, F.bid);
        pg8::EpiH E{WSP(pg8::bf16_t, WS_H), WSP(pg8::bf16_t, WS_KVM), WSP(float, WS_RC), WSP(float, WS_RS)};
        pg8::gemm_phase<pg8::EpiH, pg8::OrderG1, true, true>(F.lds, g, S, E);
        xcd_barrier(bar);
    }
#endif
    if (IN(2)) { REPS(2) p2_kv(F); SEAM(2); }
    if (IN(3)) { p3_scan(F); SEAM(3); }
#if PROBE_PH == 103
    if (IN(3)) { p2_kv(F); xcd_barrier(bar); p3_scan(F); xcd_barrier(bar); }
#endif
    if (IN(4)) { REPS(4) p4_out(F); SEAM(4); }
    if (IN(5)) {
        pg8::Gemm g{WSP(pg8::bf16_t, WS_MIXED), WSP(pg8::bf16_t, WS_WMIX), T, D, D}; pg8::StaticOrder S; S.init(T, D, F.G, F.bid);
        pg8::EpiResX E{F.in[0], WSP(float, WS_Y1), ALPHA};
        REPS(5) pg8::gemm_phase<pg8::EpiResX, pg8::StaticOrder, MK_ALIGN1, true>(F.lds, g, S, E);
        SEAM(5);
    }
    if (IN(6)) { REPS(6) ln_apply_plain(F, WSP(float, WS_Y1), F.in[8], F.in[9], WSP(bf16, WS_H1B), WSP(float, WS_ST1)); SEAM(6); }
    if (IN(7)) {
        pg8::Gemm g{WSP(pg8::bf16_t, WS_H1B), WSP(pg8::bf16_t, WS_WMQ), T, D, D}; pg8::StaticOrder S; S.init(T, D, F.G, F.bid);
        pg8::EpiB E{WSP(pg8::bf16_t, WS_QB), D, -1, 8192u * 2048u * 2u};
        REPS(7) pg8::gemm_phase<pg8::EpiB, pg8::StaticOrder, MK_ALIGN1, true>(F.lds, g, S, E);
        SEAM(7);
    }
    if (IN(8)) { REPS(8) p8_attn(F); SEAM(8); }
    if (IN(9)) {
        pg8::Gemm g{WSP(pg8::bf16_t, WS_ATT), WSP(pg8::bf16_t, WS_WMO), T, D, D}; pg8::StaticOrder S; S.init(T, D, F.G, F.bid);
        pg8::EpiResLN E{WSP(float, WS_Y1), WSP(float, WS_ST1), F.in[8], F.in[9], WSP(float, WS_Y2), ALPHA};
        REPS(9) pg8::gemm_phase<pg8::EpiResLN, pg8::StaticOrder, MK_ALIGN1, true>(F.lds, g, S, E);
        SEAM(9);
    }
    if (IN(10)) { p10_ln_router(F); SEAM(10); }
    if (IN(11)) { moe_tile_starts(F, ts); p10_dispatch(F, ts); SEAM(11); }
#if MK_MOE_F32
#define MOE_GEMM_GU(l, g, S, E) pg8::gemm_phase_bf32<pg8::EpiSwi, pg8::MoeOrder, true, true, true>(l, g, S, E)
#define MOE_GEMM_DN(l, g, S, E) pg8::gemm_phase_bf32<pg8::EpiB, pg8::MoeOrder, true, false, false>(l, g, S, E)
#else
#define MOE_GEMM_GU(l, g, S, E) pg8::gemm_phase<pg8::EpiSwi, pg8::MoeOrder, true, true, true, MK_MOE_BNT>(l, g, S, E)
#define MOE_GEMM_DN(l, g, S, E) pg8::gemm_phase<pg8::EpiB, pg8::MoeOrder, true, true, false, MK_MOE_BNT>(l, g, S, E)
#endif
    if (IN(12)) {
        moe_tile_starts(F, ts);
        const int U = ts[32] * 4;
        pg8::Gemm g{WSP(pg8::bf16_t, WS_H2B), WSP(pg8::bf16_t, WS_WGU), PMAX, 32 * 1024, D, WSP(int, WS_TOK)};
        pg8::MoeOrder S{(const PG8_LAS int*)ts, F.G, F.bid, 4, U < F.G ? U : F.G, F.in[20], F.in[21], 2048, 512, 0};
        pg8::EpiSwi E{WSP(pg8::bf16_t, WS_HID)};
        MOE_GEMM_GU(F.lds, g, S, E);
        SEAM(12);
    }
    if (IN(13)) {
        moe_tile_starts(F, ts);
        const int RT = ts[32], U = RT * 4, nbg = U > F.G ? U - F.G : 0, R1 = (F.G / 4) < RT ? (F.G / 4) : RT;
        {
            pg8::Gemm g{WSP(pg8::bf16_t, WS_H2B), WSP(pg8::bf16_t, WS_WGU), PMAX, 32 * 1024, D, WSP(int, WS_TOK)};
            pg8::MoeOrder S{(const PG8_LAS int*)ts, F.G, F.bid, 4, U, F.in[20], F.in[21], 2048, 512, F.G};
            pg8::EpiSwi E{WSP(pg8::bf16_t, WS_HID)};
            MOE_GEMM_GU(F.lds, g, S, E);
        }
        {
            pg8::Gemm g{WSP(pg8::bf16_t, WS_HID), WSP(pg8::bf16_t, WS_WD), PMAX, 32 * 2048, 512};
            pg8::MoeOrder S{(const PG8_LAS int*)ts, F.G - nbg, F.bid >= nbg ? F.bid - nbg : -1, 8, R1 * 8, F.in[22], nullptr, 512, 2048, 0};
            pg8::EpiB E{WSP(pg8::bf16_t, WS_YS), D, 7, 24576u * 2048u * 2u};
            MOE_GEMM_DN(F.lds, g, S, E);
        }
        SEAM(13);
    }
    if (IN(14)) {
        moe_tile_starts(F, ts);
        const int RT = ts[32], R1 = (F.G / 4) < RT ? (F.G / 4) : RT;
        pg8::Gemm g{WSP(pg8::bf16_t, WS_HID), WSP(pg8::bf16_t, WS_WD), PMAX, 32 * 2048, 512};
        pg8::MoeOrder S{(const PG8_LAS int*)ts, F.G, F.bid, 8, RT * 8, F.in[22], nullptr, 512, 2048, R1 * 8};
        pg8::EpiB E{WSP(pg8::bf16_t, WS_YS), D, 7, 24576u * 2048u * 2u};
        MOE_GEMM_DN(F.lds, g, S, E);
        SEAM(14);
    }
    if (IN(15)) { REPS(15) p13_combine(F); }
#if PROBE_T >= 0
    if (F.bid == 0 && F.tid == 0) { const unsigned long long te = __builtin_amdgcn_s_memrealtime(); while (__builtin_amdgcn_s_memrealtime() - te < pdelay) __builtin_amdgcn_s_sleep(8); }
#endif
#undef IN
#undef SEAM
#undef REPS
}

extern "C" void kernel_launch(void* const* d_in, const int* in_sizes, int n_in, void* d_out, int out_size, void* d_ws, size_t ws_size, hipStream_t stream) {
    static int grid = 0;
    if (grid == 0) {
        if (n_in != 25 || in_sizes[0] != T * D || out_size != T * D || ws_size < WS_END) { fprintf(stderr, "kernel_launch: unexpected shapes / workspace (%d inputs, ws %zu)\n", n_in, ws_size); grid = -1; return; }
        int dev = 0, cus = 0;
        if (hipGetDevice(&dev) != hipSuccess || hipDeviceGetAttribute(&cus, hipDeviceAttributeMultiprocessorCount, dev) != hipSuccess) { grid = -1; return; }
        if (hipFuncSetAttribute((const void*)mega, hipFuncAttributeMaxDynamicSharedMemorySize, LDS_BYTES) != hipSuccess) { fprintf(stderr, "kernel_launch: hipFuncSetAttribute failed\n"); grid = -1; return; }
        int per_cu = 0;
        if (hipOccupancyMaxActiveBlocksPerMultiprocessor(&per_cu, (const void*)mega, NTHR, LDS_BYTES) != hipSuccess || per_cu < 1) { fprintf(stderr, "kernel_launch: occupancy query failed / 0 blocks per CU\n"); grid = -1; return; }
        (void)hipGetLastError();
        grid = cus;
    }
    if (grid < 0) return;
    if (hipMemsetAsync((char*)d_ws + WS_CTL, 0, CTL_ZERO_BYTES, stream) != hipSuccess) return;
    Args a{};
    for (int i = 0; i < 25; ++i) a.in[i] = (const float*)d_in[i];
    a.out = (float*)d_out; a.ws = (unsigned char*)d_ws;
#if MK_ONE_LAUNCH
    a.ph_lo = 0; a.ph_hi = NPH; a.use_bar = 1;
#if MK_CG_SYNC
    { void* kargs[] = {(void*)&a};
      hipError_t e = hipLaunchCooperativeKernel((const void*)mega, dim3(grid), dim3(NTHR), kargs, LDS_BYTES, stream);
      if (e != hipSuccess) fprintf(stderr, "cooperative launch failed: %s (grid %d)\n", hipGetErrorString(e), grid); }
#else
    hipLaunchKernelGGL(mega, dim3(grid), dim3(NTHR), LDS_BYTES, stream, a);
#endif
#else
    for (int p = 0; p < NPH; ++p) { a.ph_lo = p; a.ph_hi = p + 1; a.use_bar = 0;
        hipLaunchKernelGGL(mega, dim3(grid), dim3(NTHR), LDS_BYTES, stream, a); }
#endif
}
```

```cpp
#include <hip/hip_runtime.h>
#include <hip/hip_cooperative_groups.h>
#include <cstdio>
#include <cstdint>
#include <cmath>
#ifndef MK_ONE_LAUNCH
#define MK_ONE_LAUNCH 1
#endif
#ifndef MK_CG_SYNC
#define MK_CG_SYNC 2
#endif
#ifndef MK_WT_STORES
#define MK_WT_STORES 0
#endif
#ifndef MK_MOE_F32
#define MK_MOE_F32 0
#endif
#define PROBE_PH -1
#define PROBE_N 1
#define PROBE_T -1
#define WS_Y1_OFF (410ull << 20)
namespace pg8 {
#define PG8_LAS __attribute__((address_space(3)))
typedef unsigned short bf16_t;
typedef short bf16x8 __attribute__((ext_vector_type(8)));
typedef float f32x4 __attribute__((ext_vector_type(4)));
typedef unsigned u32x4 __attribute__((ext_vector_type(4)));
constexpr int BM = 256, BK = 64, HALF = 128, HTB = HALF * BK * 2  , STAGE_BYTES = 8 * HTB, NXCD = 8, WGM = 8;

__host__ __device__ __forceinline__ int lds_byte(int r, int c) { const int st = (r >> 4) * 2 + (c >> 5), rr = r & 15, cc = c & 31, ob = rr * 64 + cc * 2; return st * 1024 + (ob ^ (((ob >> 9) & 1) << 5)); }
__host__ __device__ __forceinline__ void stage_rc(int b, int& R, int& C) { const int st = b / 1024, sb = b % 1024, swz = sb ^ (((sb >> 9) & 1) << 5); R = (st >> 1) * 16 + swz / 64; C = (st & 1) * 32 + (swz % 64) / 2; }
__host__ __device__ __forceinline__ int perm32(int rho) { const int n = rho >> 4, i = rho & 15; return 8 * (i >> 2) + 4 * n + (i & 3); }

struct Unit { int pm, pn; };
struct Gemm { const bf16_t* A; const bf16_t* Bt; int M, N, K; const int* tok; };

struct StaticOrder {
    int nM, nN, nwg, G, c;
    __host__ __device__ void init(int M, int N, int G_, int c_) { nM = M / BM; nN = N / BM; nwg = nM * nN; G = G_; c = c_; }
    __host__ __device__ bool next(int i, Unit& u) const {
        const long L = (long)i * G + c; if (L >= nwg) return false;
        int wgid = (int)L; { const int q = nwg / NXCD, r = nwg % NXCD, xcd = wgid % NXCD, off = wgid / NXCD; wgid = (xcd < r ? xcd * (q + 1) : r * (q + 1) + (xcd - r) * q) + off; }
        const int nig = WGM * nN, gid = wgid / nig, fm = gid * WGM, gsz = (nM - fm) < WGM ? (nM - fm) : WGM;
        u.pm = fm + ((wgid % nig) % gsz); u.pn = (wgid % nig) / gsz; return true;
    }
    __device__ __forceinline__ void a_ready(const Unit&) const {}
    __device__ __forceinline__ void done(const Unit&) const {}
};


typedef unsigned u32x2 __attribute__((ext_vector_type(2)));
__device__ __forceinline__ unsigned cvt_pk_bf16(float lo, float hi) { unsigned r; asm volatile("v_cvt_pk_bf16_f32 %0, %1, %2" : "=v"(r) : "v"(lo), "v"(hi)); return r; }
__device__ __forceinline__ u32x4 pack8(const f32x4 a, const f32x4 b) { u32x4 w; w.x = cvt_pk_bf16(a[0], a[1]); w.y = cvt_pk_bf16(a[2], a[3]); w.z = cvt_pk_bf16(b[0], b[1]); w.w = cvt_pk_bf16(b[2], b[3]); return w; }
#if MK_WT_STORES
#define PG8_RSRC(base, bytes) __builtin_amdgcn_make_buffer_rsrc((void*)(base), 0, (int)(bytes), 0x00020000)
#define PG8_ST16(rs, base, byteoff, val) __builtin_amdgcn_raw_buffer_store_b128(__builtin_bit_cast(u32x4, (val)), (rs), (unsigned)(byteoff), 0, 16)
#else
#define PG8_RSRC(base, bytes) 0
#define PG8_ST16(rs, base, byteoff, val) (*(u32x4*)((char*)(base) + (size_t)(byteoff)) = __builtin_bit_cast(u32x4, (val)))
#endif
__device__ __forceinline__ float silu_f(float x) { return x * __builtin_amdgcn_rcpf(1.0f + __builtin_amdgcn_exp2f(-1.4426950408889634f * x)); }

struct EpiH {
    static constexpr bool PERM = true, AFTER_DRAIN = false;
    bf16_t* H; bf16_t* KVM; const float* rc; const float* rs;
    __device__ __forceinline__ void operator()(const f32x4 (&acc)[2][2][4][2], const Unit& u, int wr, int wc, int fr, int fq) const {
        const int cb = wc * 32 + 8 * fq;
        const auto rsH = PG8_RSRC(H, 8192u * 7168u * 2u); (void)rsH;
        if (u.pm >= 32) {
#pragma unroll
            for (int ai = 0; ai < 2; ++ai)
#pragma unroll
                for (int m = 0; m < 4; ++m) { bf16_t* rowp = KVM + (size_t)(wr * 64 + fr + ai * HALF + m * 16) * 4096 + (u.pn - 28) * BM + cb;
#pragma unroll
                    for (int bj = 0; bj < 2; ++bj) *(u32x4*)(rowp + bj * HALF) = pack8(acc[ai][bj][m][0], acc[ai][bj][m][1]); }
            return;
        }
        const int row0 = u.pm * BM + wr * 64 + fr;
        if (u.pn < 8) {
            const float sc = u.pn >= 4 ? 0.0625f : 1.0f;
#pragma unroll
            for (int ai = 0; ai < 2; ++ai)
#pragma unroll
                for (int m = 0; m < 4; ++m) { const int row = row0 + ai * HALF + m * 16;
                    const float* cr = rc + (size_t)row * 128 + cb; const float* sr = rs + (size_t)row * 128 + cb;
                    const f32x4 c0 = *(const f32x4*)cr * sc, c1 = *(const f32x4*)(cr + 4) * sc, s0 = *(const f32x4*)sr * sc, s1 = *(const f32x4*)(sr + 4) * sc;
                    const f32x4 t1a = acc[ai][0][m][0], t1b = acc[ai][0][m][1], t2a = acc[ai][1][m][0], t2b = acc[ai][1][m][1];
                    const unsigned bo = (unsigned)(((size_t)u.pn * 8192 + row) * BM + cb) * 2u;
                    PG8_ST16(rsH, H, bo, pack8(t1a * c0 - t2a * s0, t1b * c1 - t2b * s1));
                    PG8_ST16(rsH, H, bo + 2 * HALF, pack8(t1a * s0 + t2a * c0, t1b * s1 + t2b * c1)); }
        } else {
            const float sc = (u.pn == 16 || u.pn == 17) ? 0.08838834764831845f : 1.0f;
#pragma unroll
            for (int ai = 0; ai < 2; ++ai)
#pragma unroll
                for (int m = 0; m < 4; ++m) { const unsigned bo = (unsigned)(((size_t)u.pn * 8192 + row0 + ai * HALF + m * 16) * BM + cb) * 2u;
#pragma unroll
                    for (int bj = 0; bj < 2; ++bj) PG8_ST16(rsH, H, bo + bj * 2 * HALF, pack8(acc[ai][bj][m][0] * sc, acc[ai][bj][m][1] * sc)); }
        }
    }
};
struct EpiB {
    static constexpr bool PERM = true, AFTER_DRAIN = false;
    bf16_t* O; int ldc; int pmask; unsigned obytes;
    __device__ __forceinline__ void operator()(const f32x4 (&acc)[2][2][4][2], const Unit& u, int wr, int wc, int fr, int fq) const {
        const int row0 = u.pm * BM + wr * 64 + fr, col0 = (u.pn & pmask) * BM + wc * 32 + 8 * fq;
        const auto rsO = PG8_RSRC(O, obytes); (void)rsO;
#pragma unroll
        for (int ai = 0; ai < 2; ++ai)
#pragma unroll
            for (int m = 0; m < 4; ++m) { const unsigned bo = (unsigned)((size_t)(row0 + ai * HALF + m * 16) * ldc + col0) * 2u;
#pragma unroll
                for (int bj = 0; bj < 2; ++bj) PG8_ST16(rsO, O, bo + bj * 2 * HALF, pack8(acc[ai][bj][m][0], acc[ai][bj][m][1])); }
    }
};
struct EpiSwi {
    static constexpr bool PERM = true, AFTER_DRAIN = false;
    bf16_t* O;
    __device__ __forceinline__ void operator()(const f32x4 (&acc)[2][2][4][2], const Unit& u, int wr, int wc, int fr, int fq) const {
#if PROBE_T >= 211 && PROBE_T <= 214
        if (blockIdx.x == 0 && threadIdx.x == 0) ((unsigned long long*)((char*)O - (424ull << 20) + 32768))[1] = __builtin_amdgcn_s_memrealtime();
#endif
        const int row0 = u.pm * BM + wr * 64 + fr, col0 = (u.pn & 3) * HALF + wc * 32 + 8 * fq;
        const auto rsO = PG8_RSRC(O, 24576u * 512u * 2u); (void)rsO;
#pragma unroll
        for (int ai = 0; ai < 2; ++ai)
#pragma unroll
            for (int m = 0; m < 4; ++m) { const unsigned bo = (unsigned)((size_t)(row0 + ai * HALF + m * 16) * 512 + col0) * 2u;
                f32x4 h0, h1;
#pragma unroll
                for (int i = 0; i < 4; ++i) { h0[i] = silu_f(acc[ai][0][m][0][i]) * acc[ai][1][m][0][i]; h1[i] = silu_f(acc[ai][0][m][1][i]) * acc[ai][1][m][1][i]; }
                PG8_ST16(rsO, O, bo, pack8(h0, h1)); }
#if PROBE_T >= 211 && PROBE_T <= 214
        asm volatile("s_waitcnt vmcnt(0)" ::: "memory");
        if (blockIdx.x == 0 && threadIdx.x == 0) ((unsigned long long*)((char*)O - (424ull << 20) + 32768))[2] = __builtin_amdgcn_s_memrealtime();
#endif
    }
};
struct EpiResX {
    static constexpr bool PERM = false, AFTER_DRAIN = false;
    const float* X; float* Y; float alpha;
    __device__ __forceinline__ void operator()(const f32x4 (&acc)[2][2][4][2], const Unit& u, int wr, int wc, int fr, int fq) const {
#if PROBE_T >= 201 && PROBE_T <= 203
        if (blockIdx.x == 0 && threadIdx.x == 0) ((unsigned long long*)((char*)Y - WS_Y1_OFF + 32768))[1] = __builtin_amdgcn_s_memrealtime();
#endif
        const int row0 = u.pm * BM + wr * 64 + fr, col0 = u.pn * BM + wc * 32 + 4 * fq;
        const auto rsY = PG8_RSRC(Y, 8192u * 2048u * 4u); (void)rsY;
#pragma unroll
        for (int ai = 0; ai < 2; ++ai)
#pragma unroll
            for (int m = 0; m < 4; ++m) { const size_t off = (size_t)(row0 + ai * HALF + m * 16) * 2048 + col0;
#pragma unroll
                for (int bj = 0; bj < 2; ++bj)
#pragma unroll
                    for (int n = 0; n < 2; ++n) { const f32x4 xv = *(const f32x4*)(X + off + bj * HALF + n * 16); const f32x4 yv = xv * alpha + acc[ai][bj][m][n]; PG8_ST16(rsY, Y, (off + bj * HALF + n * 16) * 4, yv); } }
#if PROBE_T >= 201 && PROBE_T <= 203
        asm volatile("s_waitcnt vmcnt(0)" ::: "memory");
        if (blockIdx.x == 0 && threadIdx.x == 0) ((unsigned long long*)((char*)Y - WS_Y1_OFF + 32768))[2] = __builtin_amdgcn_s_memrealtime();
#endif
    }
};
struct EpiResLN {
    static constexpr bool PERM = false, AFTER_DRAIN = false;
    const float* Yin; const float* st; const float* g; const float* b; float* Y; float alpha;
    __device__ __forceinline__ void operator()(const f32x4 (&acc)[2][2][4][2], const Unit& u, int wr, int wc, int fr, int fq) const {
        const int row0 = u.pm * BM + wr * 64 + fr, col0 = u.pn * BM + wc * 32 + 4 * fq;
        const auto rsY = PG8_RSRC(Y, 8192u * 2048u * 4u); (void)rsY;
        f32x4 gv[2][2], bv[2][2];
#pragma unroll
        for (int bj = 0; bj < 2; ++bj)
#pragma unroll
            for (int n = 0; n < 2; ++n) { gv[bj][n] = *(const f32x4*)(g + col0 + bj * HALF + n * 16) * alpha; bv[bj][n] = *(const f32x4*)(b + col0 + bj * HALF + n * 16) * alpha; }
#pragma unroll
        for (int ai = 0; ai < 2; ++ai)
#pragma unroll
            for (int m = 0; m < 4; ++m) { const int row = row0 + ai * HALF + m * 16; const size_t off = (size_t)row * 2048 + col0;
                const float mu = st[2 * row], rstd = st[2 * row + 1];
#pragma unroll
                for (int bj = 0; bj < 2; ++bj)
#pragma unroll
                    for (int n = 0; n < 2; ++n) { const f32x4 yv = *(const f32x4*)(Yin + off + bj * HALF + n * 16);
                        const f32x4 yo = ((yv - mu) * rstd) * gv[bj][n] + bv[bj][n] + acc[ai][bj][m][n]; PG8_ST16(rsY, Y, (off + bj * HALF + n * 16) * 4, yo); } }
    }
};

struct EpiResB {
    static constexpr bool PERM = false, AFTER_DRAIN = false;
    const bf16_t* HB; float* Y; float alpha;
    __device__ __forceinline__ void operator()(const f32x4 (&acc)[2][2][4][2], const Unit& u, int wr, int wc, int fr, int fq) const {
        const int row0 = u.pm * BM + wr * 64 + fr, col0 = u.pn * BM + wc * 32 + 4 * fq;
        const auto rsY = PG8_RSRC(Y, 8192u * 2048u * 4u); (void)rsY;
#pragma unroll
        for (int ai = 0; ai < 2; ++ai)
#pragma unroll
            for (int m = 0; m < 4; ++m) { const size_t off = (size_t)(row0 + ai * HALF + m * 16) * 2048 + col0;
#pragma unroll
                for (int bj = 0; bj < 2; ++bj)
#pragma unroll
                    for (int n = 0; n < 2; ++n) { const u32x2 hw = *(const u32x2*)(HB + off + bj * HALF + n * 16);
                        const f32x4 hv = {__uint_as_float(hw.x << 16), __uint_as_float(hw.x & 0xffff0000u), __uint_as_float(hw.y << 16), __uint_as_float(hw.y & 0xffff0000u)};
                        const f32x4 yo = hv * alpha + acc[ai][bj][m][n]; PG8_ST16(rsY, Y, (off + bj * HALF + n * 16) * 4, yo); } }
    }
};

struct OrderG1 {
    StaticOrder so; int G, c;
    __device__ void init(int G_, int c_) { so.init(8192, 7168, G_, c_); G = G_; c = c_; }
    __device__ bool next(int i, Unit& u) const {
        const int L = i * G + c;
        if (L < 896) return so.next(i, u);
        if (L >= 912) return false;
        u.pm = 32; u.pn = 28 + (L - 896); return true;
    }
    __device__ __forceinline__ void a_ready(const Unit&) const {}
    __device__ __forceinline__ void done(const Unit&) const {}
};
struct MoeOrder {
    const PG8_LAS int* ts; int G, c, npn, total; const float* W0; const float* W1; int kdim, ncols; int L0;
    __device__ bool next(int i, Unit& u) const {
        if (c < 0) return false;
        const int L = L0 + i * G + c; if (L >= total) return false;
        const int rt = L / npn, pl = L - rt * npn; int e = 0;
        for (int j = 1; j < 32; ++j) e += (ts[j] <= rt) ? 1 : 0;
        u.pm = rt; u.pn = e * npn + pl; return true;
    }
    __device__ __forceinline__ int ldb() const { return ncols; }
    __device__ __forceinline__ const float* bbase(const Unit& u, int which) const {
        const int e = u.pn / npn, pl = u.pn - e * npn; const size_t eo = (size_t)e * kdim * ncols;
        if (W1) return (which ? W1 : W0) + eo + 128 * pl;
        return W0 + eo + 256 * pl;
    }
    __device__ __forceinline__ void a_ready(const Unit&) const {}
    __device__ __forceinline__ void done(const Unit&) const {}
};

template <int MODE>
struct EpiLN {
    static constexpr bool PERM = false, AFTER_DRAIN = true;
    const float* X; const float* stin; const float* gin; const float* bin;
    float* Yout; float* stout; bf16_t* HB; const float* g; const float* b;
    unsigned long long* xbuf;
    unsigned* cnt;
    __device__ __forceinline__ void operator()(const f32x4 (&)[2][2][4][2], const Unit&, int, int, int, int) const {}
    __device__ __forceinline__ void fused(f32x4 (&acc)[2][2][4][2], const Unit& u, int wr, int wc, int fr, int fq, PG8_LAS unsigned char* lds, int wid, int lane) const {
        typedef float f32x2v __attribute__((ext_vector_type(2)));
        PG8_LAS f32x2v* P = (PG8_LAS f32x2v*)lds;
        PG8_LAS f32x2v* MS = (PG8_LAS f32x2v*)(lds + 8192);
        const int row0 = u.pm * BM + wr * 64 + fr, col0 = u.pn * BM + wc * 32 + 4 * fq;
        float s1[2][4], s2[2][4], mu[2][4], rs[2][4];
#pragma unroll
        for (int ai = 0; ai < 2; ++ai)
#pragma unroll
            for (int m = 0; m < 4; ++m) { s1[ai][m] = 0.f; s2[ai][m] = 0.f; mu[ai][m] = 0.f; rs[ai][m] = 0.f;
                if (MODE == 1) { const int row = row0 + ai * HALF + m * 16; mu[ai][m] = stin[2 * row]; rs[ai][m] = stin[2 * row + 1]; } }
#pragma unroll
        for (int bj = 0; bj < 2; ++bj)
#pragma unroll
            for (int n = 0; n < 2; ++n) {
                f32x4 gvv = {0.f, 0.f, 0.f, 0.f}, bvv = gvv;
                if (MODE == 1) { gvv = *(const f32x4*)(gin + col0 + bj * HALF + n * 16) * 1.189207115002721f; bvv = *(const f32x4*)(bin + col0 + bj * HALF + n * 16) * 1.189207115002721f; }
#pragma unroll
                for (int ai = 0; ai < 2; ++ai)
#pragma unroll
                    for (int m = 0; m < 4; ++m) { const size_t off = (size_t)(row0 + ai * HALF + m * 16) * 2048 + col0 + bj * HALF + n * 16;
                        const f32x4 xv = *(const f32x4*)(X + off);
                        const f32x4 y = (MODE == 1 ? ((xv - mu[ai][m]) * rs[ai][m]) * gvv + bvv : xv * 1.189207115002721f) + acc[ai][bj][m][n];
                        acc[ai][bj][m][n] = y; *(f32x4*)(Yout + off) = y;
                        s1[ai][m] += (y[0] + y[1]) + (y[2] + y[3]); s2[ai][m] += (y[0] * y[0] + y[1] * y[1]) + (y[2] * y[2] + y[3] * y[3]); }
            }
#pragma unroll
        for (int ai = 0; ai < 2; ++ai)
#pragma unroll
            for (int m = 0; m < 4; ++m) { float a1 = s1[ai][m], a2 = s2[ai][m];
                a1 += __shfl_xor(a1, 16); a1 += __shfl_xor(a1, 32); a2 += __shfl_xor(a2, 16); a2 += __shfl_xor(a2, 32);
                if (fq == 0) P[(ai * HALF + wr * 64 + m * 16 + fr) * 4 + wc] = (f32x2v){a1, a2}; }
        asm volatile("s_waitcnt lgkmcnt(0)" ::: "memory"); __builtin_amdgcn_s_barrier(); asm volatile("" ::: "memory");
        const int t = wid * 64 + lane;
        if (t < 256) { const f32x2v a = P[t * 4 + 0], b2 = P[t * 4 + 1], c = P[t * 4 + 2], d = P[t * 4 + 3];
            const float S1 = (a.x + b2.x) + (c.x + d.x), S2 = (a.y + b2.y) + (c.y + d.y);
            __hip_atomic_store(xbuf + ((size_t)(u.pm * 8 + u.pn) * 256 + t), ((unsigned long long)__float_as_uint(S2) << 32) | __float_as_uint(S1), __ATOMIC_RELAXED, __HIP_MEMORY_SCOPE_AGENT);
            asm volatile("s_waitcnt vmcnt(0)" ::: "memory");
            if (lane == 0) __hip_atomic_fetch_add(cnt + 64 * u.pm, 1u, __ATOMIC_RELAXED, __HIP_MEMORY_SCOPE_AGENT); }
        if (wid == 0) {
            const unsigned long long t0 = __builtin_amdgcn_s_memrealtime();
            while ((unsigned)__builtin_amdgcn_readfirstlane(__hip_atomic_load(cnt + 64 * u.pm, __ATOMIC_RELAXED, __HIP_MEMORY_SCOPE_AGENT)) < 32u) {
                if (__builtin_amdgcn_s_memrealtime() - t0 > 2000000ull) break;
                __builtin_amdgcn_s_sleep(2); }
            __builtin_amdgcn_fence(__ATOMIC_ACQUIRE, "agent");
        }
        asm volatile("s_waitcnt vmcnt(0) lgkmcnt(0)" ::: "memory"); __builtin_amdgcn_s_barrier(); asm volatile("" ::: "memory");
        if (t < 256) { float S1 = 0.f, S2 = 0.f;
#pragma unroll
            for (int j = 0; j < 8; ++j) { const unsigned long long w = __hip_atomic_load(xbuf + ((size_t)(u.pm * 8 + j) * 256 + t), __ATOMIC_RELAXED, __HIP_MEMORY_SCOPE_AGENT); S1 += __uint_as_float((unsigned)w); S2 += __uint_as_float((unsigned)(w >> 32)); }
            const float mean = S1 * (1.f / 2048.f), var = fmaxf(S2 * (1.f / 2048.f) - mean * mean, 0.f), rstd = 1.0f / sqrtf(var + 1e-5f);
            MS[t] = (f32x2v){mean, rstd};
            if (u.pn == 0) { stout[2 * (u.pm * BM + t)] = mean; stout[2 * (u.pm * BM + t) + 1] = rstd; } }
        asm volatile("s_waitcnt lgkmcnt(0)" ::: "memory"); __builtin_amdgcn_s_barrier(); asm volatile("" ::: "memory");
#pragma unroll
        for (int bj = 0; bj < 2; ++bj)
#pragma unroll
            for (int n = 0; n < 2; ++n) { const f32x4 gN = *(const f32x4*)(g + col0 + bj * HALF + n * 16), bN = *(const f32x4*)(b + col0 + bj * HALF + n * 16);
#pragma unroll
                for (int ai = 0; ai < 2; ++ai)
#pragma unroll
                    for (int m = 0; m < 4; ++m) { const int rl = ai * HALF + wr * 64 + m * 16 + fr; const f32x2v ms = MS[rl]; const size_t off = (size_t)(u.pm * BM + rl) * 2048 + col0 + bj * HALF + n * 16;
                        const f32x4 h = ((acc[ai][bj][m][n] - ms.x) * ms.y) * gN + bN;
                        u32x2 w; w.x = cvt_pk_bf16(h[0], h[1]); w.y = cvt_pk_bf16(h[2], h[3]); *(u32x2*)(HB + off) = w; } }
    }
};
template <class Epi, class Sched, bool ALIGN_EPI = false, bool SP2 = false, bool GATHER = false, bool BNT = false>
__device__ __forceinline__ void gemm_phase(PG8_LAS unsigned char* lds, const Gemm g, const Sched& S, const Epi& E) {
    const int tid = threadIdx.x, wid = __builtin_amdgcn_readfirstlane(tid >> 6), lane = tid & 63, wr = wid >> 2, wc = wid & 3, fr = lane & 15, fq = lane >> 4;
    const int K = g.K, nt = K / BK;
    unsigned voffA[2], voffB[2];
#pragma unroll
    for (int i = 0; i < 2; ++i) { int R, C; stage_rc(tid * 16 + i * 8192, R, C); const int Rb = Epi::PERM ? ((R & ~31) + perm32(R & 31)) : R;
        voffA[i] = (unsigned)(R * K + C) * 2u; voffB[i] = (unsigned)(Rb * K + C) * 2u; }
    unsigned coff[2][2], noff[2][2]; int gR[2], gC[2];
#pragma unroll
    for (int i = 0; i < 2; ++i) { int R, C; stage_rc(tid * 16 + i * 8192, R, C); gR[i] = R; gC[i] = C; coff[0][i] = coff[1][i] = noff[0][i] = noff[1][i] = 0u; }
#define PG8_GOFF(dst, pm_) do { if constexpr (GATHER) { _Pragma("unroll") for (int _h = 0; _h < 2; ++_h) _Pragma("unroll") for (int _i = 0; _i < 2; ++_i) \
        dst[_h][_i] = ((unsigned)g.tok[(pm_) * BM + _h * HALF + gR[_i]] * (unsigned)K + (unsigned)gC[_i]) * 2u; } } while (0)
    const size_t kstep = (size_t)(BK * 2);
    const size_t hstep = (size_t)HALF * K * 2;
    const size_t tstep = 2 * hstep;
    const unsigned ldsw = (unsigned)wid * 1024u;
    const int aoff = lds_byte(wr * 64 + fr, fq * 8), boff = lds_byte(wc * 32 + fr, fq * 8);
#define PG8_SA(b, h) (((b) * 2 + (h)) * HTB)
#define PG8_SB(b, h) ((4 + (b) * 2 + (h)) * HTB)
#define PG8_STAGE(bufoff, gbase, voff) do { _Pragma("unroll") for (int _i = 0; _i < 2; ++_i) \
        __builtin_amdgcn_global_load_lds((const unsigned*)((const char*)(gbase) + (voff)[_i]), (PG8_LAS unsigned*)(lds + (bufoff) + ldsw + _i * 8192), 16, 0, 0); } while (0)
#define PG8_STAGEB(bufoff, gbase, voff) do { if constexpr (BNT) { _Pragma("unroll") for (int _i = 0; _i < 2; ++_i) \
        __builtin_amdgcn_global_load_lds((const unsigned*)((const char*)(gbase) + (voff)[_i]), (PG8_LAS unsigned*)(lds + (bufoff) + ldsw + _i * 8192), 16, 0, 2); } else { PG8_STAGE(bufoff, gbase, voff); } } while (0)
#define PG8_STAGEA(bufoff, gptr, hh, kbytes, usenext) do { if constexpr (GATHER) { _Pragma("unroll") for (int _i = 0; _i < 2; ++_i) { const unsigned _o = (usenext) ? noff[hh][_i] : coff[hh][_i]; \
        __builtin_amdgcn_global_load_lds((const unsigned*)((const char*)g.A + (size_t)(kbytes) + _o), (PG8_LAS unsigned*)(lds + (bufoff) + ldsw + _i * 8192), 16, 0, 0); } } else { PG8_STAGE(bufoff, gptr, voffA); } } while (0)
#define PG8_LDA(dst, b, h) do { _Pragma("unroll") for (int m = 0; m < 4; ++m) _Pragma("unroll") for (int k = 0; k < 2; ++k) dst[m][k] = *(const PG8_LAS bf16x8*)(lds + PG8_SA(b, h) + aoff + m * 2048 + k * 1024); } while (0)
#define PG8_LDB(dst, b, h) do { _Pragma("unroll") for (int n = 0; n < 2; ++n) _Pragma("unroll") for (int k = 0; k < 2; ++k) dst[n][k] = *(const PG8_LAS bf16x8*)(lds + PG8_SB(b, h) + boff + n * 2048 + k * 1024); } while (0)
#define PG8_MMA(ai, bj, At, Bt) do { __builtin_amdgcn_s_setprio(1); _Pragma("unroll") for (int m = 0; m < 4; ++m) _Pragma("unroll") for (int n = 0; n < 2; ++n) _Pragma("unroll") for (int k = 0; k < 2; ++k) \
        acc[ai][bj][m][n] = __builtin_amdgcn_mfma_f32_16x16x32_bf16(Bt[n][k], At[m][k], acc[ai][bj][m][n], 0, 0, 0); __builtin_amdgcn_s_setprio(0); } while (0)
#define PG8_WAIT_V(n) asm volatile("s_waitcnt vmcnt(" #n ")" ::: "memory")
#define PG8_WAIT_L(n) asm volatile("s_waitcnt lgkmcnt(" #n ")" ::: "memory")
#define PG8_BAR __builtin_amdgcn_s_barrier()
#define PG8_SCHED __builtin_amdgcn_sched_barrier(0)
    Unit cur, nxt; int ui = 0;
    if (!S.next(0, cur)) return;
    f32x4 acc[2][2][4][2];
#pragma unroll
    for (int a = 0; a < 2; ++a)
#pragma unroll
        for (int b = 0; b < 2; ++b)
#pragma unroll
            for (int m = 0; m < 4; ++m)
#pragma unroll
                for (int n = 0; n < 2; ++n) acc[a][b][m][n] = (f32x4){0.f, 0.f, 0.f, 0.f};
    bf16x8 At[4][2], B0[2][2], B1[2][2];
    const char* cA = (const char*)g.A + (size_t)cur.pm * tstep; const char* cB = (const char*)g.Bt + (size_t)cur.pn * tstep;
    PG8_GOFF(coff, cur.pm);
    S.a_ready(cur);
    if constexpr (SP2) {
        PG8_STAGEB(PG8_SB(0, 0), cB, voffB); PG8_STAGEB(PG8_SB(0, 1), cB + hstep, voffB); PG8_STAGEA(PG8_SA(0, 0), cA, 0, 0, false); PG8_STAGEA(PG8_SA(0, 1), cA + hstep, 1, 0, false);
        if (wr == 1) PG8_BAR;
        PG8_WAIT_V(2); PG8_BAR;
        PG8_STAGEB(PG8_SB(1, 0), cB + kstep, voffB); PG8_STAGEA(PG8_SA(1, 0), cA + kstep, 0, kstep, false); PG8_STAGEB(PG8_SB(1, 1), cB + hstep + kstep, voffB);
        PG8_WAIT_V(6); PG8_BAR;
    } else {
        PG8_STAGEB(PG8_SB(0, 0), cB, voffB); PG8_STAGE(PG8_SA(0, 0), cA, voffA); PG8_STAGEB(PG8_SB(0, 1), cB + hstep, voffB); PG8_STAGE(PG8_SA(0, 1), cA + hstep, voffA);
        if (wr == 1) PG8_BAR;
        PG8_WAIT_V(4); PG8_BAR;
        PG8_STAGEB(PG8_SB(1, 0), cB + kstep, voffB); PG8_STAGE(PG8_SA(1, 0), cA + kstep, voffA); PG8_STAGEB(PG8_SB(1, 1), cB + hstep + kstep, voffB);
        PG8_WAIT_V(6); PG8_BAR;
    }
    for (;;) {
        const bool has_next = S.next(ui + 1, nxt);
        const char* nA = has_next ? (const char*)g.A + (size_t)nxt.pm * tstep : cA; const char* nB = has_next ? (const char*)g.Bt + (size_t)nxt.pn * tstep : cB;
        if constexpr (GATHER) { if (has_next) { PG8_GOFF(noff, nxt.pm); } else { _Pragma("unroll") for (int _h = 0; _h < 2; ++_h) _Pragma("unroll") for (int _i = 0; _i < 2; ++_i) noff[_h][_i] = coff[_h][_i]; } }
        for (int t = 0; t < nt; t += 2) {
            const bool last = (t == nt - 2);
            const char* a1 = cA + (size_t)(t + 1) * kstep;
            const char* a2 = last ? nA : cA + (size_t)(t + 2) * kstep; const char* b2 = last ? nB : cB + (size_t)(t + 2) * kstep;
            const char* a3 = a2 + kstep; const char* b3 = b2 + kstep;
            const size_t k1 = (size_t)(t + 1) * kstep, k2 = last ? 0 : (size_t)(t + 2) * kstep, k3 = k2 + kstep;
            if (last && has_next) S.a_ready(nxt);
            if constexpr (SP2) {
            PG8_LDB(B0, 0, 0); PG8_LDB(B1, 0, 1); PG8_SCHED; PG8_LDA(At, 0, 0); PG8_STAGEA(PG8_SA(1, 1), a1 + hstep, 1, k1, false);
            PG8_WAIT_V(8); PG8_WAIT_L(0); PG8_BAR; PG8_MMA(0, 0, At, B0); PG8_MMA(0, 1, At, B1); PG8_BAR; PG8_SCHED;
            PG8_LDA(At, 0, 1); PG8_STAGEB(PG8_SB(0, 0), b2, voffB); PG8_STAGEB(PG8_SB(0, 1), b2 + hstep, voffB); PG8_STAGEA(PG8_SA(0, 0), a2, 0, k2, last);
            PG8_WAIT_V(8); PG8_WAIT_L(0); PG8_BAR; PG8_MMA(1, 0, At, B0); PG8_MMA(1, 1, At, B1); PG8_BAR; PG8_SCHED;
            PG8_LDB(B0, 1, 0); PG8_LDB(B1, 1, 1); PG8_SCHED; PG8_LDA(At, 1, 0); PG8_STAGEA(PG8_SA(0, 1), a2 + hstep, 1, k2, last);
            PG8_WAIT_V(8); PG8_WAIT_L(0); PG8_BAR; PG8_MMA(0, 0, At, B0); PG8_MMA(0, 1, At, B1); PG8_BAR; PG8_SCHED;
            PG8_LDA(At, 1, 1); PG8_STAGEB(PG8_SB(1, 0), b3, voffB); PG8_STAGEB(PG8_SB(1, 1), b3 + hstep, voffB); PG8_STAGEA(PG8_SA(1, 0), a3, 0, k3, last);
            PG8_WAIT_V(8); PG8_WAIT_L(0); PG8_BAR; PG8_MMA(1, 0, At, B0); PG8_MMA(1, 1, At, B1); PG8_BAR; PG8_SCHED;
            } else {
            PG8_LDB(B0, 0, 0); PG8_SCHED; PG8_LDA(At, 0, 0); PG8_STAGE(PG8_SA(1, 1), a1 + hstep, voffA);
            PG8_WAIT_L(8); PG8_BAR; PG8_WAIT_L(0); PG8_MMA(0, 0, At, B0); PG8_BAR; PG8_SCHED;
            PG8_LDB(B1, 0, 1); PG8_STAGEB(PG8_SB(0, 0), b2, voffB);
            PG8_BAR; PG8_WAIT_L(0); PG8_MMA(0, 1, At, B1); PG8_BAR;
            PG8_LDA(At, 0, 1); PG8_STAGE(PG8_SA(0, 0), a2, voffA);
            PG8_BAR; PG8_WAIT_L(0); PG8_MMA(1, 0, At, B0); PG8_BAR; PG8_SCHED;
            PG8_STAGEB(PG8_SB(0, 1), b2 + hstep, voffB);
            PG8_WAIT_V(6); PG8_BAR; PG8_MMA(1, 1, At, B1); PG8_BAR;
            PG8_LDB(B0, 1, 0); PG8_SCHED; PG8_LDA(At, 1, 0); PG8_STAGE(PG8_SA(0, 1), a2 + hstep, voffA);
            PG8_WAIT_L(8); PG8_BAR; PG8_WAIT_L(0); PG8_MMA(0, 0, At, B0); PG8_BAR; PG8_SCHED;
            PG8_LDB(B1, 1, 1); PG8_STAGEB(PG8_SB(1, 0), b3, voffB);
            PG8_BAR; PG8_WAIT_L(0); PG8_MMA(0, 1, At, B1); PG8_BAR;
            PG8_LDA(At, 1, 1); PG8_STAGE(PG8_SA(1, 0), a3, voffA);
            PG8_BAR; PG8_WAIT_L(0); PG8_MMA(1, 0, At, B0); PG8_BAR; PG8_SCHED;
            PG8_STAGEB(PG8_SB(1, 1), b3 + hstep, voffB);
            PG8_WAIT_V(6); PG8_BAR; PG8_MMA(1, 1, At, B1); PG8_BAR;
            }
        }
        if constexpr (ALIGN_EPI) { if (wr == 0) PG8_BAR; }
        if constexpr (!Epi::AFTER_DRAIN) { E(acc, cur, wr, wc, fr, fq); S.done(cur); }
        if (!has_next) break;
#pragma unroll
        for (int a = 0; a < 2; ++a)
#pragma unroll
            for (int b = 0; b < 2; ++b)
#pragma unroll
                for (int m = 0; m < 4; ++m)
#pragma unroll
                    for (int n = 0; n < 2; ++n) acc[a][b][m][n] = (f32x4){0.f, 0.f, 0.f, 0.f};
        cur = nxt; cA = nA; cB = nB; ++ui;
        if constexpr (GATHER) { _Pragma("unroll") for (int _h = 0; _h < 2; ++_h) _Pragma("unroll") for (int _i = 0; _i < 2; ++_i) coff[_h][_i] = noff[_h][_i]; }
        if constexpr (ALIGN_EPI) { if (wr == 1) PG8_BAR; }
    }
    PG8_WAIT_V(0);
    if constexpr (!ALIGN_EPI) { if (wr == 0) PG8_BAR; }
    PG8_BAR;
    if constexpr (Epi::AFTER_DRAIN) { E.fused(acc, cur, wr, wc, fr, fq, lds, wid, lane); S.done(cur); }
#undef PG8_SA
#undef PG8_SB
#undef PG8_STAGE
#undef PG8_STAGEB
#undef PG8_STAGEA
#undef PG8_GOFF
#undef PG8_LDA
#undef PG8_LDB
#undef PG8_MMA
#undef PG8_WAIT_V
#undef PG8_WAIT_L
#undef PG8_BAR
#undef PG8_SCHED
}
constexpr int PBI = 544, SBI_BYTES = 64 * PBI;
template <class Epi, class Sched, bool ALIGN_EPI = false, bool GATHER = false, bool SPLIT = false>
__device__ __forceinline__ void gemm_phase_bf32(PG8_LAS unsigned char* lds, const Gemm g, const Sched& S, const Epi& E) {
    const int tid = threadIdx.x, wid = __builtin_amdgcn_readfirstlane(tid >> 6), lane = tid & 63, wr = wid >> 2, wc = wid & 3, fr = lane & 15, fq = lane >> 4;
    const int K = g.K, nt = K / BK;
    unsigned voffA[2];
#pragma unroll
    for (int i = 0; i < 2; ++i) { int R, C; stage_rc(tid * 16 + i * 8192, R, C); voffA[i] = (unsigned)(R * K + C) * 2u; }
    unsigned coff[2][2], noff[2][2]; int gR[2], gC[2];
#pragma unroll
    for (int i = 0; i < 2; ++i) { int R, C; stage_rc(tid * 16 + i * 8192, R, C); gR[i] = R; gC[i] = C; coff[0][i] = coff[1][i] = noff[0][i] = noff[1][i] = 0u; }
#define PG8_GOFF(dst, pm_) do { if constexpr (GATHER) { _Pragma("unroll") for (int _h = 0; _h < 2; ++_h) _Pragma("unroll") for (int _i = 0; _i < 2; ++_i) \
        dst[_h][_i] = ((unsigned)g.tok[(pm_) * BM + _h * HALF + gR[_i]] * (unsigned)K + (unsigned)gC[_i]) * 2u; } } while (0)
    const size_t kstep = (size_t)(BK * 2), hstep = (size_t)HALF * K * 2, tstep = 2 * hstep;
    const unsigned ldsw = (unsigned)wid * 1024u;
    const int aoff = lds_byte(wr * 64 + fr, fq * 8);
    const int ldb = S.ldb();
    const size_t bkstep = (size_t)BK * ldb;
    const int q4 = (lane >> 2) & 3, p4 = lane & 3;
    const unsigned lo = SPLIT ? (unsigned)((lane >> 5) * ldb + 4 * (lane & 31)) * 4u : (unsigned)lane * 16u;
    const unsigned bwoff = SPLIT ? (unsigned)(8 * wid + (lane >> 5)) * PBI + (unsigned)(((4 * (lane & 31)) ^ ((wid & 1) << 6)) * 2)
                                 : (unsigned)(8 * wid) * PBI + (unsigned)(((4 * lane) ^ ((wid & 1) << 6)) * 2);
    unsigned broff[2][2];
#pragma unroll
    for (int n = 0; n < 2; ++n)
#pragma unroll
        for (int k = 0; k < 2; ++k) { const int row = 32 * k + 8 * fq + q4, col = 32 * wc + (Epi::PERM ? 8 * p4 + 4 * n : 16 * n + 4 * p4);
            broff[n][k] = (unsigned)row * PBI + (unsigned)((col ^ ((row & 8) << 3)) * 2); }
#define PG8_SA(b, h) (((b) * 2 + (h)) * HTB)
#define PG8_SBI(b) (4 * HTB + (b) * SBI_BYTES)
#define PG8_STAGE(bufoff, gbase, voff) do { _Pragma("unroll") for (int _i = 0; _i < 2; ++_i) \
        __builtin_amdgcn_global_load_lds((const unsigned*)((const char*)(gbase) + (voff)[_i]), (PG8_LAS unsigned*)(lds + (bufoff) + ldsw + _i * 8192), 16, 0, 0); } while (0)
#define PG8_STAGEA(bufoff, gptr, hh, kbytes, usenext) do { if constexpr (GATHER) { _Pragma("unroll") for (int _i = 0; _i < 2; ++_i) { const unsigned _o = (usenext) ? noff[hh][_i] : coff[hh][_i]; \
        __builtin_amdgcn_global_load_lds((const unsigned*)((const char*)g.A + (size_t)(kbytes) + _o), (PG8_LAS unsigned*)(lds + (bufoff) + ldsw + _i * 8192), 16, 0, 0); } } else { PG8_STAGE(bufoff, gptr, voffA); } } while (0)
#define PG8_LDA(dst, b, h) do { _Pragma("unroll") for (int m = 0; m < 4; ++m) _Pragma("unroll") for (int k = 0; k < 2; ++k) dst[m][k] = *(const PG8_LAS bf16x8*)(lds + PG8_SA(b, h) + aoff + m * 2048 + k * 1024); } while (0)
#define PG8_LDBT(dst, b, h) do { _Pragma("unroll") for (int n = 0; n < 2; ++n) _Pragma("unroll") for (int k = 0; k < 2; ++k) { \
        const PG8_LAS unsigned char* _a = lds + PG8_SBI(b) + broff[n][k] + (h) * 256; \
        const s16x4 _lo = __builtin_bit_cast(s16x4, __builtin_amdgcn_ds_read_tr16_b64_v4i16((PG8_LAS s16x4*)_a)), _hi = __builtin_bit_cast(s16x4, __builtin_amdgcn_ds_read_tr16_b64_v4i16((PG8_LAS s16x4*)(_a + 4 * PBI))); \
        dst[n][k] = __builtin_shufflevector(_lo, _hi, 0, 1, 2, 3, 4, 5, 6, 7); } } while (0)
#define PG8_BLOAD(p0, p1) do { _Pragma("unroll") for (int _i = 0; _i < 8; ++_i) { \
        const float* _u = SPLIT ? ((_i < 4 ? (p0) : (p1)) + (size_t)(8 * wid + 2 * (_i & 3)) * ldb) : ((p0) + (size_t)(8 * wid + _i) * ldb); \
        breg[_i] = *(const __attribute__((address_space(1))) f32x4*)((const char*)_u + lo); } } while (0)
#define PG8_BWRITE(b) do { _Pragma("unroll") for (int _i = 0; _i < 8; ++_i) { u32x2 _w; _w.x = cvt_pk_bf16(breg[_i][0], breg[_i][1]); _w.y = cvt_pk_bf16(breg[_i][2], breg[_i][3]); \
        *(PG8_LAS u32x2*)(lds + PG8_SBI(b) + bwoff + (SPLIT ? (2 * (_i & 3)) * PBI + (_i >> 2) * 256 : _i * PBI)) = _w; } } while (0)
#define PG8_MMA(ai, bj, At, Bt) do { __builtin_amdgcn_s_setprio(1); _Pragma("unroll") for (int m = 0; m < 4; ++m) _Pragma("unroll") for (int n = 0; n < 2; ++n) _Pragma("unroll") for (int k = 0; k < 2; ++k) \
        acc[ai][bj][m][n] = __builtin_amdgcn_mfma_f32_16x16x32_bf16(Bt[n][k], At[m][k], acc[ai][bj][m][n], 0, 0, 0); __builtin_amdgcn_s_setprio(0); } while (0)
#define PG8_WAIT_V(n) asm volatile("s_waitcnt vmcnt(" #n ")" ::: "memory")
#define PG8_WAIT_L(n) asm volatile("s_waitcnt lgkmcnt(" #n ")" ::: "memory")
#define PG8_BAR __builtin_amdgcn_s_barrier()
#define PG8_SCHED __builtin_amdgcn_sched_barrier(0)
    typedef short s16x4 __attribute__((ext_vector_type(4)));
    typedef unsigned u32x2 __attribute__((ext_vector_type(2)));
    Unit cur, nxt; int ui = 0;
    if (!S.next(0, cur)) return;
    f32x4 acc[2][2][4][2];
#pragma unroll
    for (int a = 0; a < 2; ++a)
#pragma unroll
        for (int b = 0; b < 2; ++b)
#pragma unroll
            for (int m = 0; m < 4; ++m)
#pragma unroll
                for (int n = 0; n < 2; ++n) acc[a][b][m][n] = (f32x4){0.f, 0.f, 0.f, 0.f};
    bf16x8 At[4][2], B0[2][2];
    f32x4 breg[8];
    const char* cA = (const char*)g.A + (size_t)cur.pm * tstep; const float* cB0 = S.bbase(cur, 0); const float* cB1 = S.bbase(cur, 1);
    PG8_GOFF(coff, cur.pm);
    PG8_BLOAD(cB0, cB1); PG8_STAGEA(PG8_SA(0, 0), cA, 0, 0, false); PG8_STAGEA(PG8_SA(0, 1), cA + hstep, 1, 0, false);
    PG8_BWRITE(0); PG8_SCHED;
    if (wr == 1) PG8_BAR;
    PG8_WAIT_V(2); PG8_WAIT_L(0); PG8_BAR;
    PG8_BLOAD(cB0 + bkstep, cB1 + bkstep); PG8_STAGEA(PG8_SA(1, 0), cA + kstep, 0, kstep, false); PG8_SCHED;
    PG8_WAIT_V(10); PG8_BAR;
    for (;;) {
        const bool has_next = S.next(ui + 1, nxt);
        const char* nA = has_next ? (const char*)g.A + (size_t)nxt.pm * tstep : cA; const float* nB0 = has_next ? S.bbase(nxt, 0) : cB0; const float* nB1 = has_next ? S.bbase(nxt, 1) : cB1;
        if constexpr (GATHER) { if (has_next) { PG8_GOFF(noff, nxt.pm); } else { _Pragma("unroll") for (int _h = 0; _h < 2; ++_h) _Pragma("unroll") for (int _i = 0; _i < 2; ++_i) noff[_h][_i] = coff[_h][_i]; } }
        for (int t = 0; t < nt; t += 2) {
            const bool last = (t == nt - 2);
            const char* a1 = cA + (size_t)(t + 1) * kstep;
            const char* a2 = last ? nA : cA + (size_t)(t + 2) * kstep; const float* b20 = last ? nB0 : cB0 + (size_t)(t + 2) * bkstep; const float* b21 = last ? nB1 : cB1 + (size_t)(t + 2) * bkstep;
            const char* a3 = a2 + kstep; const float* b30 = b20 + bkstep; const float* b31 = b21 + bkstep;
            const size_t k1 = (size_t)(t + 1) * kstep, k2 = last ? 0 : (size_t)(t + 2) * kstep, k3 = k2 + kstep;
            PG8_LDBT(B0, 0, 0); PG8_SCHED; PG8_LDA(At, 0, 0); PG8_STAGEA(PG8_SA(1, 1), a1 + hstep, 1, k1, false);
            PG8_WAIT_V(12); PG8_WAIT_L(0); PG8_BAR; PG8_MMA(0, 0, At, B0); PG8_LDBT(B0, 0, 1); PG8_WAIT_L(0); PG8_SCHED; PG8_MMA(0, 1, At, B0); PG8_BAR; PG8_SCHED;
            PG8_BWRITE(1); PG8_BLOAD(b20, b21); PG8_SCHED; PG8_LDBT(B0, 0, 0); PG8_LDA(At, 0, 1); PG8_STAGEA(PG8_SA(0, 0), a2, 0, k2, last);
            PG8_WAIT_V(12); PG8_WAIT_L(0); PG8_BAR; PG8_MMA(1, 0, At, B0); PG8_LDBT(B0, 0, 1); PG8_WAIT_L(0); PG8_SCHED; PG8_MMA(1, 1, At, B0); PG8_BAR; PG8_SCHED;
            PG8_LDBT(B0, 1, 0); PG8_SCHED; PG8_LDA(At, 1, 0); PG8_STAGEA(PG8_SA(0, 1), a2 + hstep, 1, k2, last);
            PG8_WAIT_V(12); PG8_WAIT_L(0); PG8_BAR; PG8_MMA(0, 0, At, B0); PG8_LDBT(B0, 1, 1); PG8_WAIT_L(0); PG8_SCHED; PG8_MMA(0, 1, At, B0); PG8_BAR; PG8_SCHED;
            PG8_BWRITE(0); PG8_BLOAD(b30, b31); PG8_SCHED; PG8_LDBT(B0, 1, 0); PG8_LDA(At, 1, 1); PG8_STAGEA(PG8_SA(1, 0), a3, 0, k3, last);
            PG8_WAIT_V(12); PG8_WAIT_L(0); PG8_BAR; PG8_MMA(1, 0, At, B0); PG8_LDBT(B0, 1, 1); PG8_WAIT_L(0); PG8_SCHED; PG8_MMA(1, 1, At, B0); PG8_BAR; PG8_SCHED;
        }
        if constexpr (ALIGN_EPI) { if (wr == 0) PG8_BAR; }
        E(acc, cur, wr, wc, fr, fq); S.done(cur);
        if (!has_next) break;
#pragma unroll
        for (int a = 0; a < 2; ++a)
#pragma unroll
            for (int b = 0; b < 2; ++b)
#pragma unroll
                for (int m = 0; m < 4; ++m)
#pragma unroll
                    for (int n = 0; n < 2; ++n) acc[a][b][m][n] = (f32x4){0.f, 0.f, 0.f, 0.f};
        cur = nxt; cA = nA; cB0 = nB0; cB1 = nB1; ++ui;
        if constexpr (GATHER) { _Pragma("unroll") for (int _h = 0; _h < 2; ++_h) _Pragma("unroll") for (int _i = 0; _i < 2; ++_i) coff[_h][_i] = noff[_h][_i]; }
        if constexpr (ALIGN_EPI) { if (wr == 1) PG8_BAR; }
    }
    PG8_WAIT_V(0);
    asm volatile("" :: "v"(breg[0]), "v"(breg[1]), "v"(breg[2]), "v"(breg[3]), "v"(breg[4]), "v"(breg[5]), "v"(breg[6]), "v"(breg[7]));
    if constexpr (!ALIGN_EPI) { if (wr == 0) PG8_BAR; }
    PG8_BAR;
#undef PG8_SA
#undef PG8_SBI
#undef PG8_STAGE
#undef PG8_STAGEA
#undef PG8_GOFF
#undef PG8_LDA
#undef PG8_LDBT
#undef PG8_BLOAD
#undef PG8_BWRITE
#undef PG8_MMA
#undef PG8_WAIT_V
#undef PG8_WAIT_L
#undef PG8_BAR
#undef PG8_SCHED
}
}

constexpr int NWAVES = 8, NTHR = 512;
constexpr int T = 8192, D = 2048, HW = 7168, INW = 7184, MEMN = 256;
constexpr float LN_EPS = 1e-5f;
constexpr float ALPHA = 1.189207115002721f;
constexpr int NPH = 16;
#ifndef MK_MOE_BNT
#define MK_MOE_BNT false
#endif
#ifndef MK_ALIGN1
#define MK_ALIGN1 true
#endif
#ifndef MK_FUSE_LN1
#define MK_FUSE_LN1 0
#endif
#ifndef MK_NSG
#define MK_NSG 9
#endif
constexpr int NSG = MK_NSG;
constexpr int PMAX = 24576;

constexpr size_t MiB = 1u << 20;
constexpr size_t WS_CTL = 0, CTL_ZERO_BYTES = 64 * 1024;
constexpr size_t WS_WMIX = 2 * MiB, WS_WMQ = 10 * MiB, WS_WIN = 18 * MiB, WS_WKV = 46 * MiB, WS_WMO = 62 * MiB, WS_WGU = 70 * MiB, WS_WD = 198 * MiB;
constexpr size_t WS_XB = 262 * MiB, WS_MEMB = 294 * MiB;
constexpr size_t WS_H = 296 * MiB;
constexpr size_t WS_KVM = 408 * MiB;
constexpr size_t WS_ORAW = 410 * MiB;
constexpr size_t WS_MIXED = WS_XB;
constexpr size_t WS_Y1 = WS_ORAW;
constexpr size_t WS_H1B = WS_H;
constexpr size_t WS_QB = 328 * MiB, WS_ATT = 360 * MiB;
constexpr size_t WS_Y2 = 474 * MiB;
constexpr size_t WS_H2B = WS_H;
constexpr size_t WS_XS = 328 * MiB;
constexpr size_t WS_HID = 424 * MiB;
constexpr size_t WS_YS = WS_XS;
constexpr size_t WS_SMALL = 540 * MiB;
constexpr size_t WS_GLR = WS_SMALL;
constexpr size_t WS_RC = WS_SMALL + 1 * MiB, WS_RS = WS_SMALL + 5 * MiB;
constexpr size_t WS_ST1 = WS_SMALL + 9 * MiB, WS_ST2 = WS_ST1 + 65536;
constexpr size_t WS_EXP = WS_ST2 + 65536, WS_GATE = WS_EXP + 65536, WS_POS = WS_GATE + 65536, WS_SLOT = WS_POS + 65536, WS_TOK = WS_SLOT + 65536;
constexpr size_t WS_XCH1 = WS_SMALL + 10 * MiB, WS_XCH2 = WS_XCH1 + 512 * 1024;
constexpr size_t WS_WRT = WS_SMALL + 11 * MiB;
constexpr size_t WS_END = 552 * MiB;
constexpr int CW_CNT = 64, CW_CUR = 128, CW_Q = 192;
constexpr int CW_BAR = 4096;
constexpr int CW_LN1 = 8192, CW_LN2 = 10240;

constexpr int RING_BYTES = 139264, LDSCTL_OFF = RING_BYTES, MISC_OFF = LDSCTL_OFF + 320, LDS_BYTES = 147456;

#define GAS __attribute__((address_space(1)))
#define LAS __attribute__((address_space(3)))
typedef unsigned short bf16;
typedef unsigned v4u __attribute__((ext_vector_type(4)));
typedef unsigned v2u __attribute__((ext_vector_type(2)));
typedef float f32x4 __attribute__((ext_vector_type(4)));
typedef GAS unsigned gu32;
#define RLX_AGENT __ATOMIC_RELAXED, __HIP_MEMORY_SCOPE_AGENT
#define LDS_WAIT() asm volatile("s_waitcnt lgkmcnt(0)" ::: "memory")
__device__ __forceinline__ unsigned f2bf(float f) { unsigned u = __builtin_bit_cast(unsigned, f); return (u + 0x7fffu + ((u >> 16) & 1u)) >> 16; }
__device__ __forceinline__ unsigned pk2(float lo, float hi) { return f2bf(lo) | (f2bf(hi) << 16); }
__device__ __forceinline__ float bf2f(unsigned h) { return __builtin_bit_cast(float, h << 16); }
__device__ __forceinline__ float bflo(unsigned w) { return __builtin_bit_cast(float, w << 16); }
__device__ __forceinline__ float bfhi(unsigned w) { return __builtin_bit_cast(float, w & 0xffff0000u); }
__device__ __forceinline__ float wave_sum(float v) {
#pragma unroll
    for (int o = 1; o < 64; o <<= 1) v += __shfl_xor(v, o);
    return v;
}
__device__ __forceinline__ float wave_max(float v) {
#pragma unroll
    for (int o = 1; o < 64; o <<= 1) v = fmaxf(v, __shfl_xor(v, o));
    return v;
}

struct Frame {
    LAS unsigned char* lds;
    volatile LAS unsigned* MISC;
    gu32* ctl;
    int tid, lane, wave, G, bid;
    unsigned char* ws;
    const float* in[25];
    float* out;
};
#define WSP(T_, off) ((T_*)(F.ws + (off)))

template <bool NTST>
__device__ __forceinline__ void transpose_item(const float* W, int ldw, bf16* WTr, int ldt, LAS float* scr, int lane) {
    float tv[32];
#pragma unroll
    for (int i = 0; i < 32; ++i) tv[i] = __builtin_nontemporal_load(W + (size_t)(2 * i + (lane >> 5)) * ldw + (lane & 31));
#pragma unroll
    for (int i = 0; i < 32; ++i) scr[(2 * i + (lane >> 5)) * 33 + (lane & 31)] = tv[i];
    LDS_WAIT(); asm volatile("" ::: "memory");
    const int c = lane & 7;
#pragma unroll
    for (int j = 0; j < 4; ++j) { const int n = (lane >> 3) + 8 * j; const LAS float* s = scr + (8 * c) * 33 + n;
        v4u o; o.x = pk2(s[0 * 33], s[1 * 33]); o.y = pk2(s[2 * 33], s[3 * 33]); o.z = pk2(s[4 * 33], s[5 * 33]); o.w = pk2(s[6 * 33], s[7 * 33]);
        if (NTST) __builtin_nontemporal_store(o, (GAS v4u*)(WTr + (size_t)n * ldt + 8 * c)); else *(GAS v4u*)(WTr + (size_t)n * ldt + 8 * c) = o; }
    LDS_WAIT(); asm volatile("" ::: "memory");
}
__device__ __forceinline__ void p0_prologue(Frame& F) {
    LAS float* scr = (LAS float*)(F.lds + F.wave * 16384);
    const int gw = F.bid * NWAVES + F.wave, NGW = F.G * NWAVES;
    const float* w_in = F.in[3];
    constexpr int I_IN = 32 * 224, I_SQ = 32 * 64;
    for (int it = gw; it < I_IN + 2 * I_SQ; it += NGW) {
        int r = it;
        if (r < I_IN) { const int kb = r / 224, nb = r % 224; transpose_item<false>(w_in + (size_t)(64 * kb) * INW + 32 * nb, INW, WSP(bf16, WS_WIN) + (size_t)(32 * nb) * 2048 + 64 * kb, 2048, scr, F.lane); continue; }
        r -= I_IN;
        { const int w = r / I_SQ, q = r % I_SQ, kb = q / 64, nb = q % 64;
          const float* src = F.in[11]; if (w) src = F.in[12];
          bf16* dst = WSP(bf16, WS_WKV) + (size_t)w * 2048 * 2048;
          transpose_item<false>(src + (size_t)(64 * kb) * 2048 + 32 * nb, 2048, dst + (size_t)(32 * nb) * 2048 + 64 * kb, 2048, scr, F.lane); }
    }
    const int gt = F.bid * NTHR + F.tid, NGT = F.G * NTHR;
    {
        const float* x = F.in[0]; bf16* xb = WSP(bf16, WS_XB);
        for (int item = F.bid; item < T / 32; item += F.G) {
            const size_t base = (size_t)item * 32 * D / 8;
#pragma unroll 1
            for (int c0 = 0; c0 < 16; c0 += 4) { f32x4 a[4], b[4];
#pragma unroll
                for (int u = 0; u < 4; ++u) { const size_t i = base + (size_t)(c0 + u) * NTHR + F.tid; a[u] = *(const GAS f32x4*)(x + i * 8); b[u] = *(const GAS f32x4*)(x + i * 8 + 4); }
#pragma unroll
                for (int u = 0; u < 4; ++u) { const size_t i = base + (size_t)(c0 + u) * NTHR + F.tid;
                    v4u o; o.x = pk2(a[u][0], a[u][1]); o.y = pk2(a[u][2], a[u][3]); o.z = pk2(b[u][0], b[u][1]); o.w = pk2(b[u][2], b[u][3]); *(GAS v4u*)(xb + i * 8) = o; } }
        }
        const float* mm = F.in[1]; bf16* mb = WSP(bf16, WS_MEMB);
        for (int i = gt; i < MEMN * D / 8; i += NGT) { const f32x4 a = *(const GAS f32x4*)(mm + (size_t)i * 8), b = *(const GAS f32x4*)(mm + (size_t)i * 8 + 4);
            v4u o; o.x = pk2(a[0], a[1]); o.y = pk2(a[2], a[3]); o.z = pk2(b[0], b[1]); o.w = pk2(b[2], b[3]); *(GAS v4u*)(mb + (size_t)i * 8) = o; }
    }
    {
        const int* pos = (const int*)F.in[2]; float* rc = WSP(float, WS_RC); float* rs = WSP(float, WS_RS);
        for (int i = gt; i < T * 128; i += NGT) { const int t = i >> 7, f = i & 127;
            const float inv = exp2f(-(float)f * (13.287712379549449f / 128.0f));
            const float ang = (float)pos[t] * inv;
            double rev = (double)ang * 0.15915494309189535; rev -= floor(rev);
            const float rf = (float)rev;
            rc[i] = __builtin_amdgcn_cosf(rf); rs[i] = __builtin_amdgcn_sinf(rf); }
    }
    {
        bf16* wrt = WSP(bf16, WS_WRT); const float* Wg_ = F.in[16]; const float* We_ = F.in[18];
        for (int i = gt; i < 48 * 2048; i += NGT) { const int c = (i >> 3) % 48, k = ((i >> 3) / 48) * 8 + (i & 7);
            float w = 0.f; if (c < 32) w = We_[(size_t)k * 32 + c]; else if (c < 36) w = Wg_[(size_t)k * 4 + (c - 32)];
            const unsigned hi = f2bf(w), lo = f2bf(w - bf2f(hi));
            wrt[i] = (bf16)hi; wrt[48 * 2048 + i] = (bf16)lo; }
    }
    {
        const float* x = F.in[0]; float* glr = WSP(float, WS_GLR);
        const int r16 = F.lane & 15, g4 = F.lane >> 4;
        LAS float* part = (LAS float*)F.lds;
        for (int item = F.bid; item < T / 32; item += F.G) {
            const int tile = 2 * item + (F.wave >> 2), kq = F.wave & 3;
            f32x4 acc = {0.f, 0.f, 0.f, 0.f};
            const float* xr = x + (size_t)(tile * 16 + r16) * D + 512 * kq + 4 * g4;
            const float* wr = w_in + (size_t)(512 * kq + 4 * g4) * INW + HW + r16;
#pragma unroll 8
            for (int k0 = 0; k0 < 512; k0 += 16) {
                const f32x4 a = *(const GAS f32x4*)(xr + k0);
                const float b0 = wr[(size_t)(k0 + 0) * INW], b1 = wr[(size_t)(k0 + 1) * INW], b2 = wr[(size_t)(k0 + 2) * INW], b3 = wr[(size_t)(k0 + 3) * INW];
                acc = __builtin_amdgcn_mfma_f32_16x16x4f32(a[0], b0, acc, 0, 0, 0);
                acc = __builtin_amdgcn_mfma_f32_16x16x4f32(a[1], b1, acc, 0, 0, 0);
                acc = __builtin_amdgcn_mfma_f32_16x16x4f32(a[2], b2, acc, 0, 0, 0);
                acc = __builtin_amdgcn_mfma_f32_16x16x4f32(a[3], b3, acc, 0, 0, 0);
            }
            __syncthreads();
            *(LAS f32x4*)(part + (F.wave * 64 + F.lane) * 4) = acc;
            __syncthreads();
            if (F.tid < 128) { const int tl = F.tid >> 6, ln = F.tid & 63;
                f32x4 s = *(const LAS f32x4*)(part + ((tl * 4 + 0) * 64 + ln) * 4);
#pragma unroll
                for (int q = 1; q < 4; ++q) s += *(const LAS f32x4*)(part + ((tl * 4 + q) * 64 + ln) * 4);
#pragma unroll
                for (int j = 0; j < 4; ++j) glr[(size_t)((2 * item + tl) * 16 + 4 * (ln >> 4) + j) * 16 + (ln & 15)] = s[j]; }
        }
        __syncthreads();
    }
}
__device__ __forceinline__ void transpose_queue(Frame& F, int qsel = 0) {
    LAS float* scr = (LAS float*)(F.lds + F.wave * 16384);
    const float* const i7 = F.in[7]; const float* const i10 = F.in[10]; const float* const i13 = F.in[13]; const float* const i20 = F.in[20]; const float* const i21 = F.in[21]; const float* const i22 = F.in[22];
    constexpr int I_SQ = 32 * 64, I_E = 512, NQ = 3 * I_SQ + (MK_MOE_F32 ? 0 : 3 * 32 * I_E);
    for (;;) {
        unsigned b0 = 0;
        if (F.lane == 0) b0 = __hip_atomic_fetch_add((unsigned*)(F.ctl + CW_Q + 64 * qsel), 16u, __ATOMIC_RELAXED, __HIP_MEMORY_SCOPE_AGENT);
        b0 = __builtin_amdgcn_readfirstlane(b0);
        if (b0 >= (unsigned)NQ) break;
        for (int it = (int)b0; it < (int)b0 + 16 && it < NQ; ++it) {
            int r = it;
            if (r < 3 * I_SQ) { const int w = r / I_SQ, q = r % I_SQ, kb = q / 64, nb = q % 64;
                const float* src = i7; size_t doff = WS_WMIX; if (w == 1) { src = i10; doff = WS_WMQ; } if (w == 2) { src = i13; doff = WS_WMO; }
                bf16* dst = (bf16*)(F.ws + doff);
                transpose_item<true>(src + (size_t)(64 * kb) * 2048 + 32 * nb, 2048, dst + (size_t)(32 * nb) * 2048 + 64 * kb, 2048, scr, F.lane); continue; }
            r -= 3 * I_SQ;
            if (r < 2 * 32 * I_E) {
                const int up = r / (32 * I_E), q = r % (32 * I_E), e = q / I_E, q2 = q % I_E, kb = q2 / 16, nb = q2 % 16, n0 = 32 * nb;
                const float* sb = i20; if (up) sb = i21;
                const float* src = sb + (size_t)e * 2048 * 512 + (size_t)(64 * kb) * 512 + n0;
                bf16* dst = WSP(bf16, WS_WGU) + (size_t)(e * 1024 + (n0 >> 7) * 256 + up * 128 + (n0 & 127)) * 2048 + 64 * kb;
                transpose_item<true>(src, 512, dst, 2048, scr, F.lane); continue; }
            r -= 2 * 32 * I_E;
            {
                const int e = r / I_E, q2 = r % I_E, kb = q2 / 64, nb = q2 % 64;
                const float* src = i22 + (size_t)e * 512 * 2048 + (size_t)(64 * kb) * 2048 + 32 * nb;
                bf16* dst = WSP(bf16, WS_WD) + (size_t)(e * 2048 + 32 * nb) * 512 + 64 * kb;
                transpose_item<true>(src, 2048, dst, 512, scr, F.lane); }
        }
    }
}

__device__ __forceinline__ float log_sigmoid_f(float z) { return fminf(z, 0.f) - log1pf(expf(-fabsf(z))); }
template <bool GLA>
__device__ __forceinline__ void mixer_naive_item(Frame& F, int hh, int eg) {
    constexpr int ND = GLA ? 4 : 8;
    const bf16* H = WSP(bf16, WS_H); float* oraw = WSP(float, WS_ORAW);
    const int ei = F.tid & 15, dp = F.tid >> 4, e = eg * 16 + ei;
    const int qcol = GLA ? 4096 + hh * 128 : hh * 256, kcol = GLA ? 4608 + hh * 128 : 1024 + hh * 256, vcol = (GLA ? 5120 : 2048) + hh * 256 + e;
    const int ocol = (GLA ? 1024 : 0) + hh * 256 + eg * 16;
    LAS float* red = (LAS float*)F.lds;
    float S[ND];
#pragma unroll
    for (int i = 0; i < ND; ++i) S[i] = 0.f;
    float wa[GLA ? 4 : 1][16]; float ba[GLA ? 4 : 1];
    if (GLA) {
#pragma unroll
        for (int i = 0; i < 4; ++i) { const int d = dp + 32 * i; ba[i] = F.in[5][hh * 128 + d];
#pragma unroll
            for (int r = 0; r < 16; ++r) wa[i][r] = F.in[4][r * 512 + hh * 128 + d]; }
    }
    const float gamma = 1.0f - exp2f(-5.0f - (float)hh);
    const float* glr = WSP(float, WS_GLR);
    for (int t0 = 0; t0 < T; t0 += 8) {
        float part[8];
#pragma unroll
        for (int tt = 0; tt < 8; ++tt) {
            const int t = t0 + tt; const bf16* hr = H + (size_t)t * HW;
            const float v = bf2f(hr[vcol]);
            float g16[16];
            if (GLA) {
#pragma unroll
                for (int r = 0; r < 16; ++r) g16[r] = glr[t * 16 + r];
            }
            float p = 0.f;
#pragma unroll
            for (int i = 0; i < ND; ++i) { const int d = dp + 32 * i;
                const float q = bf2f(hr[qcol + d]), k = bf2f(hr[kcol + d]);
                float a = gamma;
                if (GLA) { float z = ba[i];
#pragma unroll
                    for (int r = 0; r < 16; ++r) z += g16[r] * wa[i][r];
                    a = expf(log_sigmoid_f(z) * 0.0625f); }
                S[i] = a * S[i] + k * v; p += q * S[i]; }
            p += __shfl_xor(p, 16); p += __shfl_xor(p, 32);
            part[tt] = p;
        }
        if (F.lane < 16) {
#pragma unroll
            for (int tt = 0; tt < 8; ++tt) red[(F.wave * 8 + tt) * 16 + F.lane] = part[tt];
        }
        __syncthreads();
        if (F.tid < 128) { const int tt = F.tid >> 4, e2 = F.tid & 15; float s = 0.f;
#pragma unroll
            for (int w = 0; w < 8; ++w) s += red[(w * 8 + tt) * 16 + e2];
            oraw[(size_t)(t0 + tt) * D + ocol + e2] = s; }
        __syncthreads();
    }
}
__device__ __forceinline__ void p2_mixer_naive(Frame& F) {
    for (int item = F.bid; item < 128; item += F.G) {
        const int h8 = item >> 4, eg = item & 15;
        if (h8 < 4) mixer_naive_item<false>(F, h8, eg); else mixer_naive_item<true>(F, h8 - 4, eg);
    }
}
__device__ __forceinline__ void p3_normgate(Frame& F) {
    const bf16* H = WSP(bf16, WS_H); const float* oraw = WSP(float, WS_ORAW); bf16* mixed = WSP(bf16, WS_MIXED);
    const int gw = F.bid * NWAVES + F.wave, NGW = F.G * NWAVES;
    const f32x4 gn = *(const f32x4*)(F.in[6] + 4 * F.lane);
    for (int t = gw; t < T; t += NGW) {
#pragma unroll
        for (int h8 = 0; h8 < 8; ++h8) {
            const f32x4 o = *(const GAS f32x4*)(oraw + (size_t)t * D + h8 * 256 + 4 * F.lane);
            const int gcol = (h8 < 4 ? 3072 : 6144) + (h8 & 3) * 256 + 4 * F.lane;
            const v2u gw2 = *(const GAS v2u*)(H + (size_t)t * HW + gcol);
            const f32x4 gt = {bflo(gw2.x), bfhi(gw2.x), bflo(gw2.y), bfhi(gw2.y)};
            f32x4 y;
            if (h8 < 4) {
                const float mu = wave_sum((o[0] + o[1]) + (o[2] + o[3])) * (1.f / 256.f);
                const f32x4 dd = o - mu;
                const float var = wave_sum((dd[0] * dd[0] + dd[1] * dd[1]) + (dd[2] * dd[2] + dd[3] * dd[3])) * (1.f / 256.f);
                y = dd * (1.0f / sqrtf(var + LN_EPS));
            } else {
                const float ms = wave_sum((o[0] * o[0] + o[1] * o[1]) + (o[2] * o[2] + o[3] * o[3])) * (1.f / 256.f);
                y = o * (1.0f / sqrtf(ms + LN_EPS)) * gn;
            }
            float r[4];
#pragma unroll
            for (int i = 0; i < 4; ++i) { const float g = gt[i]; r[i] = g / (1.0f + expf(-g)) * y[i]; }
            v2u w; w.x = pk2(r[0], r[1]); w.y = pk2(r[2], r[3]);
            *(GAS v2u*)(mixed + (size_t)t * D + h8 * 256 + 4 * F.lane) = w;
        }
    }
}
__device__ __forceinline__ void ln_apply_plain(Frame& F, const float* Y, const float* g, const float* b, bf16* HB, float* st) {
    const int gw = F.bid * NWAVES + F.wave, NGW = F.G * NWAVES;
    f32x4 cur[8];
    if (gw < T) { const GAS f32x4* yr = (const GAS f32x4*)(Y + (size_t)gw * D) + F.lane;
#pragma unroll
        for (int j = 0; j < 8; ++j) cur[j] = yr[64 * j]; }
    for (int t = gw; t < T; t += NGW) {
        f32x4 nxt[8];
        { const int tn = t + NGW < T ? t + NGW : t; const GAS f32x4* yr = (const GAS f32x4*)(Y + (size_t)tn * D) + F.lane;
#pragma unroll
          for (int j = 0; j < 8; ++j) nxt[j] = yr[64 * j]; }
        f32x4 v[8]; float s = 0.f;
#pragma unroll
        for (int j = 0; j < 8; ++j) { v[j] = cur[j]; s += (v[j][0] + v[j][1]) + (v[j][2] + v[j][3]); }
        const float mean = wave_sum(s) * (1.f / D); float s2 = 0.f;
#pragma unroll
        for (int j = 0; j < 8; ++j) { v[j] = v[j] - mean; s2 += (v[j][0] * v[j][0] + v[j][1] * v[j][1]) + (v[j][2] * v[j][2] + v[j][3] * v[j][3]); }
        const float rstd = 1.f / sqrtf(wave_sum(s2) * (1.f / D) + LN_EPS);
        if (F.lane == 0) { st[2 * t] = mean; st[2 * t + 1] = rstd; }
        GAS v2u* o8 = (GAS v2u*)(HB + (size_t)t * D) + F.lane;
#pragma unroll
        for (int j = 0; j < 8; ++j) { const f32x4 gv = *(const f32x4*)(g + 4 * F.lane + 256 * j), bv = *(const f32x4*)(b + 4 * F.lane + 256 * j);
            v[j] = v[j] * rstd * gv + bv;
            v2u w; w.x = pk2(v[j][0], v[j][1]); w.y = pk2(v[j][2], v[j][3]); o8[64 * j] = w; }
#pragma unroll
        for (int j = 0; j < 8; ++j) cur[j] = nxt[j];
    }
}
template <bool ROUTER>
__device__ __forceinline__ void ln_apply(Frame& F, const float* Y, const float* g, const float* b, bf16* HB, float* st, bool count = true) {
    const int gw = F.bid * NWAVES + F.wave, NGW = F.G * NWAVES;
    for (int t = gw; t < T; t += NGW) {
        const GAS f32x4* yr = (const GAS f32x4*)(Y + (size_t)t * D) + F.lane;
        f32x4 v[8]; float s = 0.f;
#pragma unroll
        for (int j = 0; j < 8; ++j) { v[j] = yr[64 * j]; s += (v[j][0] + v[j][1]) + (v[j][2] + v[j][3]); }
        const float mean = wave_sum(s) * (1.f / D); float s2 = 0.f;
#pragma unroll
        for (int j = 0; j < 8; ++j) { v[j] = v[j] - mean; s2 += (v[j][0] * v[j][0] + v[j][1] * v[j][1]) + (v[j][2] * v[j][2] + v[j][3] * v[j][3]); }
        const float rstd = 1.f / sqrtf(wave_sum(s2) * (1.f / D) + LN_EPS);
        if (F.lane == 0) { st[2 * t] = mean; st[2 * t + 1] = rstd; }
        GAS v2u* o8 = (GAS v2u*)(HB + (size_t)t * D) + F.lane;
#pragma unroll
        for (int j = 0; j < 8; ++j) { const f32x4 gv = *(const f32x4*)(g + 4 * F.lane + 256 * j), bv = *(const f32x4*)(b + 4 * F.lane + 256 * j);
            v[j] = v[j] * rstd * gv + bv;
            v2u w; w.x = pk2(v[j][0], v[j][1]); w.y = pk2(v[j][2], v[j][3]); o8[64 * j] = w; }
        if (ROUTER) {
            const float* Wg = F.in[16]; const float* We = F.in[18];
            float lg[4], le[32];
#pragma unroll
            for (int i = 0; i < 4; ++i) lg[i] = 0.f;
#pragma unroll
            for (int i = 0; i < 32; ++i) le[i] = 0.f;
#pragma unroll
            for (int j = 0; j < 8; ++j) {
#pragma unroll
                for (int i = 0; i < 4; ++i) { const int c = 4 * F.lane + 256 * j + i; const float hv = v[j][i];
                    const f32x4 wg = *(const GAS f32x4*)(Wg + (size_t)c * 4);
#pragma unroll
                    for (int q = 0; q < 4; ++q) lg[q] += hv * wg[q];
#pragma unroll
                    for (int q8 = 0; q8 < 8; ++q8) { const f32x4 we = *(const GAS f32x4*)(We + (size_t)c * 32 + 4 * q8);
#pragma unroll
                        for (int q = 0; q < 4; ++q) le[4 * q8 + q] += hv * we[q]; } }
            }
#pragma unroll
            for (int i = 0; i < 4; ++i) lg[i] = wave_sum(lg[i]) + F.in[17][i];
#pragma unroll
            for (int i = 0; i < 32; ++i) le[i] = wave_sum(le[i]);
            int grp = 0; float gm = lg[0];
#pragma unroll
            for (int i = 1; i < 4; ++i) if (lg[i] > gm) { gm = lg[i]; grp = i; }
            float gs = 0.f;
#pragma unroll
            for (int i = 0; i < 4; ++i) gs += expf(lg[i] - gm);
            const float pg_sel = 1.0f / gs;
            float fe[8];
#pragma unroll
            for (int j = 0; j < 8; ++j) { const float a = grp == 0 ? le[j] : grp == 1 ? le[8 + j] : grp == 2 ? le[16 + j] : le[24 + j]; fe[j] = a + F.in[19][grp * 8 + j]; }
            int i1 = 0; float m1 = fe[0];
#pragma unroll
            for (int j = 1; j < 8; ++j) if (fe[j] > m1) { m1 = fe[j]; i1 = j; }
            int i2 = -1; float m2 = -3.0e38f;
#pragma unroll
            for (int j = 0; j < 8; ++j) if (j != i1 && fe[j] > m2) { m2 = fe[j]; i2 = j; }
            const float p2 = expf(m2 - m1), den = 1.0f / (1.0f + p2);
            if (F.lane == 0) {
                int* ex = WSP(int, WS_EXP); float* gt = WSP(float, WS_GATE);
                const int e1 = grp * 8 + i1, e2 = grp * 8 + i2;
                ex[2 * t] = e1; ex[2 * t + 1] = e2; gt[2 * t] = pg_sel * den; gt[2 * t + 1] = pg_sel * p2 * den;
                if (count) { atomicAdd((unsigned*)(F.ctl + CW_CNT) + e1, 1u); atomicAdd((unsigned*)(F.ctl + CW_CNT) + e2, 1u); }
            }
        }
    }
}
__device__ __forceinline__ void p7_attn_naive(Frame& F) {
    const bf16* Q = WSP(bf16, WS_QB); const bf16* KVM = WSP(bf16, WS_KVM); bf16* att = WSP(bf16, WS_ATT);
    LAS float* qs = (LAS float*)F.lds;
    LAS float* sc = (LAS float*)(F.lds + 16384);
    for (int item = F.bid; item < (T / 8) * 4; item += F.G) {
        const int h = item & 3, t0 = (item >> 2) * 8;
        for (int i = F.tid; i < 8 * 512; i += NTHR) { const int tt = i >> 9, d = i & 511; qs[i] = bf2f(Q[(size_t)(t0 + tt) * D + h * 512 + d]); }
        __syncthreads();
        {
            const int j = F.tid & 255, th = F.tid >> 8;
            const bf16* kr = KVM + (size_t)j * 4096 + h * 512;
            float a0 = 0.f, a1 = 0.f, a2 = 0.f, a3 = 0.f;
            for (int d = 0; d < 512; d += 8) {
                const v4u kw = *(const GAS v4u*)(kr + d);
                const float kf[8] = {bflo(kw.x), bfhi(kw.x), bflo(kw.y), bfhi(kw.y), bflo(kw.z), bfhi(kw.z), bflo(kw.w), bfhi(kw.w)};
#pragma unroll
                for (int i = 0; i < 8; ++i) { a0 += kf[i] * qs[(th * 4 + 0) * 512 + d + i]; a1 += kf[i] * qs[(th * 4 + 1) * 512 + d + i]; a2 += kf[i] * qs[(th * 4 + 2) * 512 + d + i]; a3 += kf[i] * qs[(th * 4 + 3) * 512 + d + i]; }
            }
            const float scl = 0.04419417382415922f;
            sc[(th * 4 + 0) * 256 + j] = a0 * scl; sc[(th * 4 + 1) * 256 + j] = a1 * scl; sc[(th * 4 + 2) * 256 + j] = a2 * scl; sc[(th * 4 + 3) * 256 + j] = a3 * scl;
        }
        __syncthreads();
        {
            float v[4]; float mx = -3.0e38f;
#pragma unroll
            for (int i = 0; i < 4; ++i) { v[i] = sc[F.wave * 256 + F.lane + 64 * i]; mx = fmaxf(mx, v[i]); }
            mx = wave_max(mx); float sm = 0.f;
#pragma unroll
            for (int i = 0; i < 4; ++i) { v[i] = expf(v[i] - mx); sm += v[i]; }
            sm = 1.0f / wave_sum(sm);
#pragma unroll
            for (int i = 0; i < 4; ++i) sc[F.wave * 256 + F.lane + 64 * i] = v[i] * sm;
        }
        __syncthreads();
        {
            const int d = F.tid; const bf16* vr = KVM + 2048 + h * 512 + d;
            float o[8];
#pragma unroll
            for (int i = 0; i < 8; ++i) o[i] = 0.f;
            for (int j = 0; j < 256; ++j) { const float vv = bf2f(vr[(size_t)j * 4096]);
#pragma unroll
                for (int i = 0; i < 8; ++i) o[i] += sc[i * 256 + j] * vv; }
#pragma unroll
            for (int i = 0; i < 8; ++i) att[(size_t)(t0 + i) * D + h * 512 + d] = (bf16)f2bf(o[i]);
        }
        __syncthreads();
    }
}
__device__ __forceinline__ void moe_tile_starts(Frame& F, LAS int* ts) {
    if (F.tid < 64) {
        const unsigned c = F.lane < 32 ? __hip_atomic_load(F.ctl + CW_CUR + (F.lane & 31), RLX_AGENT) : 0u;
        int v = (int)((c + 255u) >> 8);
#pragma unroll
        for (int o = 1; o < 32; o <<= 1) { const int n = __shfl_up(v, o); if (F.lane >= o) v += n; }
        if (F.lane < 32) ts[F.lane + 1] = v;
        if (F.lane == 0) ts[0] = 0;
    }
    __syncthreads();
}
__device__ __forceinline__ void p10_dispatch(Frame& F, LAS int* ts) {
    const int gt = F.bid * NTHR + F.tid, NGT = F.G * NTHR;
    const int* ex = WSP(int, WS_EXP); const int* sl = WSP(int, WS_SLOT); int* pos = WSP(int, WS_POS); int* tok = WSP(int, WS_TOK);
    for (int a = gt; a < 2 * T; a += NGT) { const int p = ts[ex[a]] * 256 + sl[a]; pos[a] = p; tok[p] = a >> 1; }
}
__device__ __forceinline__ void p13_combine(Frame& F) {
    const int gw = F.bid * NWAVES + F.wave, NGW = F.G * NWAVES;
    const bf16* h2 = WSP(bf16, WS_H2B); const bf16* ys = WSP(bf16, WS_YS);
    const int* pos = WSP(int, WS_POS); const float* gt = WSP(float, WS_GATE);
    const float* g3 = F.in[23]; const float* b3 = F.in[24];
    constexpr int R = 2;
    for (int t0 = gw; t0 < T; t0 += R * NGW) {
        v2u yh[R][8], ya[R][8], yc[R][8]; float w0[R], w1[R];
#pragma unroll
        for (int r = 0; r < R; ++r) { const int t = (t0 + r * NGW < T) ? t0 + r * NGW : t0;
            w0[r] = gt[2 * t]; w1[r] = gt[2 * t + 1];
            const int p0 = pos[2 * t], p1 = pos[2 * t + 1];
            const GAS v2u* hr = (const GAS v2u*)(h2 + (size_t)t * D) + F.lane;
            const GAS v2u* y0 = (const GAS v2u*)(ys + (size_t)p0 * D) + F.lane; const GAS v2u* y1 = (const GAS v2u*)(ys + (size_t)p1 * D) + F.lane;
#pragma unroll
            for (int j = 0; j < 8; ++j) { yh[r][j] = hr[64 * j]; ya[r][j] = y0[64 * j]; yc[r][j] = y1[64 * j]; } }
#pragma unroll
        for (int r = 0; r < R; ++r) { const int t = t0 + r * NGW; if (t >= T) break;
            f32x4 v[8]; float s = 0.f;
#pragma unroll
            for (int j = 0; j < 8; ++j) { const v2u hw = yh[r][j], a = ya[r][j], c = yc[r][j];
                const f32x4 h = {bflo(hw.x), bfhi(hw.x), bflo(hw.y), bfhi(hw.y)};
                const f32x4 fa = {bflo(a.x), bfhi(a.x), bflo(a.y), bfhi(a.y)}, fc = {bflo(c.x), bfhi(c.x), bflo(c.y), bfhi(c.y)};
                v[j] = h * ALPHA + fa * w0[r] + fc * w1[r]; s += (v[j][0] + v[j][1]) + (v[j][2] + v[j][3]); }
            const float mean = wave_sum(s) * (1.f / D); float s2 = 0.f;
#pragma unroll
            for (int j = 0; j < 8; ++j) { v[j] = v[j] - mean; s2 += (v[j][0] * v[j][0] + v[j][1] * v[j][1]) + (v[j][2] * v[j][2] + v[j][3] * v[j][3]); }
            const float rstd = 1.f / sqrtf(wave_sum(s2) * (1.f / D) + LN_EPS);
            GAS f32x4* orow = (GAS f32x4*)(F.out + (size_t)t * D) + F.lane;
#pragma unroll
            for (int j = 0; j < 8; ++j) { const f32x4 gv = *(const f32x4*)(g3 + 4 * F.lane + 256 * j), bv = *(const f32x4*)(b3 + 4 * F.lane + 256 * j);
                orow[64 * j] = v[j] * rstd * gv + bv; }
        }
    }
}

constexpr int CS = 128, NB = CS / 64, NS = T / CS;
#define HIDX(t_, c_) ((((size_t)((c_) >> 8)) * 8192 + (size_t)(t_)) * 256 + ((c_) & 255))
constexpr size_t WS_BCUM = WS_ORAW;
constexpr size_t WS_KVR = WS_ORAW + 16 * MiB;
constexpr size_t WS_KVG = WS_KVR + 32 * MiB;
typedef short bf16x8_t __attribute__((ext_vector_type(8)));
typedef short s16x4_t __attribute__((ext_vector_type(4)));
__device__ __forceinline__ s16x4_t lds_tr(const LAS unsigned char* p) { return __builtin_bit_cast(s16x4_t, __builtin_amdgcn_ds_read_tr16_b64_v4i16((LAS s16x4_t*)p)); }
__device__ __forceinline__ bf16x8_t frag_tr(const LAS unsigned char* X, int pitch, int k0, int n0, int lane) {
    const int fq = lane >> 4, q = (lane >> 2) & 3, p = lane & 3;
    const LAS unsigned char* a = X + ((k0 + 8 * fq + q) * pitch + n0 + 4 * p) * 2;
    const s16x4_t lo = lds_tr(a), hi = lds_tr(a + 4 * pitch * 2);
    return __builtin_shufflevector(lo, hi, 0, 1, 2, 3, 4, 5, 6, 7);
}
__device__ __forceinline__ bf16x8_t frag_row(const LAS unsigned char* X, int pitch, int r0, int k0, int lane) {
    return *(const LAS bf16x8_t*)(X + ((r0 + (lane & 15)) * pitch + k0 + 8 * (lane >> 4)) * 2);
}
#define MFMA16(a, b, c) __builtin_amdgcn_mfma_f32_16x16x32_bf16((a), (b), (c), 0, 0, 0)
__device__ __forceinline__ float fexp(float x) { return __builtin_amdgcn_exp2f(x * 1.4426950408889634f); }
__device__ __forceinline__ float silu_g(float g) { return g * __builtin_amdgcn_rcpf(1.0f + __builtin_amdgcn_exp2f(-1.4426950408889634f * g)); }

__device__ __forceinline__ void bcum_item(Frame& F, int s, int h) {
    const int c = F.tid & 127, tq = F.tid >> 7;
    LAS float* tot = (LAS float*)F.lds;
    LAS float* gl = (LAS float*)(F.lds + 2048);
    const float* glr = WSP(float, WS_GLR); float* bc = WSP(float, WS_BCUM);
    __syncthreads();
    *(LAS f32x4*)(gl + 4 * F.tid) = *(const GAS f32x4*)(glr + (size_t)s * CS * 16 + 4 * F.tid);
    float w[16];
#pragma unroll
    for (int r = 0; r < 16; ++r) w[r] = F.in[4][r * 512 + h * 128 + c];
    const float bias = F.in[5][h * 128 + c];
    __syncthreads();
    float vals[32]; float run = 0.f;
    const int tb = s * CS + tq * 32;
#pragma unroll
    for (int i = 0; i < 32; ++i) { const LAS float* gr = gl + (tq * 32 + i) * 16; float z = bias;
#pragma unroll
        for (int r = 0; r < 16; ++r) z += gr[r] * w[r];
        run += log_sigmoid_f(z) * 0.0625f; vals[i] = run; }
    tot[tq * 128 + c] = run;
    __syncthreads();
    float off = 0.f;
#pragma unroll
    for (int q = 0; q < 3; ++q) off += (q < tq) ? tot[q * 128 + c] : 0.f;
#pragma unroll
    for (int i = 0; i < 32; ++i) bc[(size_t)(tb + i) * 512 + h * 128 + c] = vals[i] + off;
}
__device__ __forceinline__ void p1_bcum(Frame& F, int first, int stride) { for (int it = first; it < NS * 4; it += stride) bcum_item(F, it >> 2, it & 3); __syncthreads(); }

__device__ __forceinline__ void unit_sh(int u, int& s, int& h8) { s = (u >> 3) & (NS - 1); h8 = ((u & 7) + 4 * (u >> 8)) & 7; }

template <bool GLA, int MODE>
__device__ __forceinline__ void stage_qk(Frame& F, LAS unsigned char* dst, int s, int jb, int hh, int col0, float lg2gamma) {
    constexpr int DK = GLA ? 128 : 256, PK = DK + 8, CPR = DK / 8, NIT = 64 * CPR / NTHR;
    const bf16* H = WSP(bf16, WS_H); const float* bc = WSP(float, WS_BCUM);
    v4u wv[NIT]; f32x4 b0[GLA ? NIT : 1], b1[GLA ? NIT : 1], l0[(GLA && MODE == 2) ? NIT : 1], l1[(GLA && MODE == 2) ? NIT : 1];
#pragma unroll
    for (int it = 0; it < NIT; ++it) {
        const int ch = F.tid + NTHR * it, r = ch / CPR, cc = ch % CPR, t = s * CS + jb * 64 + r;
        wv[it] = *(const GAS v4u*)(H + HIDX(t, col0 + 8 * cc));
        if (GLA) { b0[it] = *(const GAS f32x4*)(bc + (size_t)t * 512 + hh * 128 + 8 * cc); b1[it] = *(const GAS f32x4*)(bc + (size_t)t * 512 + hh * 128 + 8 * cc + 4);
            if (MODE == 2) { const size_t tl_ = (size_t)(s * CS + CS - 1) * 512 + hh * 128 + 8 * cc; l0[it] = *(const GAS f32x4*)(bc + tl_); l1[it] = *(const GAS f32x4*)(bc + tl_ + 4); } }
    }
#pragma unroll
    for (int it = 0; it < NIT; ++it) {
        const int ch = F.tid + NTHR * it, r = ch / CPR, cc = ch % CPR, tl = jb * 64 + r;
        const v4u w = wv[it];
        float f[8] = {bflo(w.x), bfhi(w.x), bflo(w.y), bfhi(w.y), bflo(w.z), bfhi(w.z), bflo(w.w), bfhi(w.w)};
        if (GLA) {
            float e[8] = {b0[it][0], b0[it][1], b0[it][2], b0[it][3], b1[it][0], b1[it][1], b1[it][2], b1[it][3]};
            if (MODE == 2) { const float l[8] = {l0[it][0], l0[it][1], l0[it][2], l0[it][3], l1[it][0], l1[it][1], l1[it][2], l1[it][3]};
#pragma unroll
                for (int i = 0; i < 8; ++i) e[i] = l[i] - e[i]; }
            else if (MODE == 1) {
#pragma unroll
                for (int i = 0; i < 8; ++i) e[i] = -e[i]; }
#pragma unroll
            for (int i = 0; i < 8; ++i) f[i] *= fexp(e[i]);
        } else {
            const float ex = MODE == 0 ? (float)(tl + 1) : MODE == 1 ? -(float)(tl + 1) : (float)(CS - 1 - tl);
            const float fac = __builtin_amdgcn_exp2f(ex * lg2gamma);
#pragma unroll
            for (int i = 0; i < 8; ++i) f[i] *= fac;
        }
        v4u o; o.x = pk2(f[0], f[1]); o.y = pk2(f[2], f[3]); o.z = pk2(f[4], f[5]); o.w = pk2(f[6], f[7]);
        *(LAS v4u*)(dst + (r * PK + 8 * cc) * 2) = o;
    }
}
__device__ __forceinline__ void stage_v(Frame& F, LAS unsigned char* dst, int s, int jb, int col0) {
    const bf16* H = WSP(bf16, WS_H);
    v4u wv[4];
#pragma unroll
    for (int it = 0; it < 4; ++it) { const int ch = F.tid + NTHR * it, r = ch >> 5, cc = ch & 31, t = s * CS + jb * 64 + r; wv[it] = *(const GAS v4u*)(H + HIDX(t, col0 + 8 * cc)); }
#pragma unroll
    for (int it = 0; it < 4; ++it) { const int ch = F.tid + NTHR * it, r = ch >> 5, cc = ch & 31; *(LAS v4u*)(dst + (r * 264 + 8 * cc) * 2) = wv[it]; }
}

template <bool GLA>
__device__ __forceinline__ void kv_unit(Frame& F, int s, int hh) {
    constexpr int DK = GLA ? 128 : 256, PK = DK + 8, NDT = DK / 16;
    LAS unsigned char* Ks = F.lds; LAS unsigned char* Vs = F.lds + 34816;
    const int kcol = GLA ? 4608 + hh * 128 : 1024 + hh * 256, vcol = (GLA ? 5120 : 2048) + hh * 256;
    const float lg2g = log2f(1.0f - exp2f(-5.0f - (float)hh));
    f32x4 acc[2][NDT];
#pragma unroll
    for (int a = 0; a < 2; ++a)
#pragma unroll
        for (int d = 0; d < NDT; ++d) acc[a][d] = (f32x4){0.f, 0.f, 0.f, 0.f};
    for (int jb = 0; jb < NB; ++jb) {
        __syncthreads();
        stage_qk<GLA, 2>(F, Ks, s, jb, hh, kcol, lg2g);
        stage_v(F, Vs, s, jb, vcol);
        __syncthreads();
#pragma unroll
        for (int ks = 0; ks < 2; ++ks) {
            bf16x8_t vf[2];
#pragma unroll
            for (int et = 0; et < 2; ++et) vf[et] = frag_tr(Vs, 264, 32 * ks, 32 * F.wave + 16 * et, F.lane);
#pragma unroll
            for (int dt = 0; dt < NDT; ++dt) { const bf16x8_t kf = frag_tr(Ks, PK, 32 * ks, 16 * dt, F.lane);
#pragma unroll
                for (int et = 0; et < 2; ++et) acc[et][dt] = MFMA16(kf, vf[et], acc[et][dt]); }
        }
    }
    bf16* kv = GLA ? (WSP(bf16, WS_KVG) + (size_t)(s * 4 + hh) * 256 * 128) : (WSP(bf16, WS_KVR) + (size_t)(s * 4 + hh) * 256 * 256);
    const int fr = F.lane & 15, fq = F.lane >> 4;
#pragma unroll
    for (int et = 0; et < 2; ++et)
#pragma unroll
        for (int dt = 0; dt < NDT; ++dt) { v2u w; w.x = pk2(acc[et][dt][0], acc[et][dt][1]); w.y = pk2(acc[et][dt][2], acc[et][dt][3]);
            *(GAS v2u*)(kv + (size_t)(32 * F.wave + 16 * et + fr) * DK + 16 * dt + 4 * fq) = w; }
}
__device__ __forceinline__ void p2_kv(Frame& F) {
    for (int u = F.bid; u < 8 * NS; u += F.G) { int s, h8; unit_sh(u, s, h8);
        if (s == NS - 1) continue;
        if (h8 < 4) kv_unit<false>(F, s, h8); else kv_unit<true>(F, s, h8 - 4); }
    __syncthreads();
}
__device__ __forceinline__ void p3_scan(Frame& F) {
    constexpr int NR = 4 * 256 * 64, NG = 4 * 256 * 32, NITEM = NR + NG;
    const float* bc = WSP(float, WS_BCUM);
    const int per = (NITEM + F.G - 1) / F.G;
    for (int k0 = F.tid; k0 < per; k0 += NTHR) {
      const int it = F.bid * per + k0;
      if (it < NITEM) {
        const bool gla = it >= NR; const int r = gla ? it - NR : it;
        const int sh = gla ? 5 : 6, dk = gla ? 128 : 256;
        const int cc = r & ((1 << sh) - 1), e = (r >> sh) & 255, hh = r >> (sh + 8);
        bf16* base = (gla ? WSP(bf16, WS_KVG) : WSP(bf16, WS_KVR)) + ((size_t)hh * 256 + e) * dk + 4 * cc;
        const size_t sstride = (size_t)4 * 256 * dk;
        const float dret = __builtin_amdgcn_exp2f((float)CS * log2f(1.0f - exp2f(-5.0f - (float)hh)));
        float S[4] = {0.f, 0.f, 0.f, 0.f};
        static_assert(NS - 1 == 63, "batching below assumes 63 steps");
#pragma unroll 1
        for (int s0 = 0; s0 < NS - 1; s0 += 21) {
            v2u wv[21]; f32x4 lv[21];
#pragma unroll
            for (int j = 0; j < 21; ++j) { wv[j] = *(const GAS v2u*)(base + (size_t)(s0 + j) * sstride);
                if (gla) lv[j] = *(const GAS f32x4*)(bc + (size_t)((s0 + j) * CS + CS - 1) * 512 + hh * 128 + 4 * cc); else lv[j] = (f32x4){0.f, 0.f, 0.f, 0.f}; }
#pragma unroll
            for (int j = 0; j < 21; ++j) {
                v2u o; o.x = pk2(S[0], S[1]); o.y = pk2(S[2], S[3]);
                *(GAS v2u*)(base + (size_t)(s0 + j) * sstride) = o;
                const float f[4] = {bflo(wv[j].x), bfhi(wv[j].x), bflo(wv[j].y), bfhi(wv[j].y)};
                float dec[4] = {dret, dret, dret, dret};
                if (gla) { dec[0] = fexp(lv[j][0]); dec[1] = fexp(lv[j][1]); dec[2] = fexp(lv[j][2]); dec[3] = fexp(lv[j][3]); }
#pragma unroll
                for (int i = 0; i < 4; ++i) S[i] = dec[i] * S[i] + f[i];
            }
        }
        { GAS v2u* p = (GAS v2u*)(base + (size_t)(NS - 1) * sstride); v2u o; o.x = pk2(S[0], S[1]); o.y = pk2(S[2], S[3]); *p = o; }
      }
    }
}
template <bool GLA>
__device__ __forceinline__ void out_unit(Frame& F, int s, int hh) {
    constexpr int DK = GLA ? 128 : 256, PK = DK + 8, NKS = DK / 32;
    LAS unsigned char* Qs = F.lds; LAS unsigned char* Ks = F.lds + 33792; LAS unsigned char* Vs = F.lds + 67584; LAS unsigned char* Ps = F.lds + 101376;
    LAS float* red = (LAS float*)(F.lds + 110592);
    const int qcol = GLA ? 4096 + hh * 128 : hh * 256, kcol = GLA ? 4608 + hh * 128 : 1024 + hh * 256, vcol = (GLA ? 5120 : 2048) + hh * 256;
    const int gcol = (GLA ? 6144 : 3072) + hh * 256, ocol = (GLA ? 1024 : 0) + hh * 256;
    const float lg2g = log2f(1.0f - exp2f(-5.0f - (float)hh));
    const bf16* H = WSP(bf16, WS_H); bf16* mixed = WSP(bf16, WS_MIXED);
    const bf16* st = GLA ? (WSP(bf16, WS_KVG) + (size_t)(s * 4 + hh) * 256 * 128) : (WSP(bf16, WS_KVR) + (size_t)(s * 4 + hh) * 256 * 256);
    const int fr = F.lane & 15, fq = F.lane >> 4, w = F.wave, mt = w >> 1, nt0 = 2 * (w & 1);
    static_assert(NB == 2, "the step program below is written for two 64-token sub-blocks");
    f32x4 accO[4][2]; bf16x8_t sfa[NKS][2]; v2u gpre[4][2];
#pragma unroll 1
    for (int step = 0; step < 3; ++step) {
        const int i = step > 0 ? 1 : 0, j = step > 1 ? 1 : 0;
        {
            __syncthreads();
            if (step < 2) stage_qk<GLA, 0>(F, Qs, s, i, hh, qcol, lg2g);
            if (step != 1) { stage_qk<GLA, 1>(F, Ks, s, j, hh, kcol, lg2g); stage_v(F, Vs, s, j, vcol); }
            if (step < 2) {
#pragma unroll
                for (int m = 0; m < 4; ++m)
#pragma unroll
                    for (int n = 0; n < 2; ++n) accO[m][n] = (f32x4){0.f, 0.f, 0.f, 0.f};
            }
            if (step != 1) {
                if (s > 0) {
#pragma unroll
                    for (int ks = 0; ks < NKS; ++ks)
#pragma unroll
                        for (int n = 0; n < 2; ++n) sfa[ks][n] = *(const GAS bf16x8_t*)(st + (size_t)(32 * w + 16 * n + fr) * DK + 32 * ks + 8 * fq);
                }
#pragma unroll
                for (int m2 = 0; m2 < 4; ++m2)
#pragma unroll
                    for (int n = 0; n < 2; ++n) gpre[m2][n] = *(const GAS v2u*)(H + HIDX(s * CS + i * 64 + 16 * m2 + fr, gcol + 32 * w + 16 * n + 4 * fq));
            }
            __syncthreads();
            f32x4 accS[2] = {(f32x4){0.f, 0.f, 0.f, 0.f}, (f32x4){0.f, 0.f, 0.f, 0.f}};
#pragma unroll
            for (int ks = 0; ks < NKS; ++ks) { const bf16x8_t qf = frag_row(Qs, PK, 16 * mt, 32 * ks, F.lane);
#pragma unroll
                for (int n2 = 0; n2 < 2; ++n2) { const bf16x8_t kf = frag_row(Ks, PK, 16 * (nt0 + n2), 32 * ks, F.lane); accS[n2] = MFMA16(kf, qf, accS[n2]); } }
#pragma unroll
            for (int n2 = 0; n2 < 2; ++n2) { const int row = 16 * mt + fr, c0 = 16 * (nt0 + n2) + 4 * fq; float pv[4];
#pragma unroll
                for (int jj = 0; jj < 4; ++jj) pv[jj] = (i == j && c0 + jj > row) ? 0.f : accS[n2][jj];
                v2u pw; pw.x = pk2(pv[0], pv[1]); pw.y = pk2(pv[2], pv[3]);
                *(LAS v2u*)(Ps + (row * 72 + c0) * 2) = pw; }
            __syncthreads();
#pragma unroll
            for (int ks = 0; ks < 2; ++ks) {
                bf16x8_t vf[2];
#pragma unroll
                for (int n = 0; n < 2; ++n) vf[n] = frag_tr(Vs, 264, 32 * ks, 32 * w + 16 * n, F.lane);
#pragma unroll
                for (int m = 0; m < 4; ++m) { const bf16x8_t pf = frag_row(Ps, 72, 16 * m, 32 * ks, F.lane);
#pragma unroll
                    for (int n = 0; n < 2; ++n) accO[m][n] = MFMA16(vf[n], pf, accO[m][n]); }
            }
        }
        if (step == 1) continue;
        if (s > 0) {
#pragma unroll
            for (int ks = 0; ks < NKS; ++ks) {
#pragma unroll
                for (int m = 0; m < 4; ++m) { const bf16x8_t qf = frag_row(Qs, PK, 16 * m, 32 * ks, F.lane);
#pragma unroll
                    for (int n = 0; n < 2; ++n) accO[m][n] = MFMA16(sfa[ks][n], qf, accO[m][n]); }
            }
        }
#pragma unroll
        for (int m = 0; m < 4; ++m) { float s1 = 0.f, s2 = 0.f;
#pragma unroll
            for (int n = 0; n < 2; ++n)
#pragma unroll
                for (int jj = 0; jj < 4; ++jj) { const float v = accO[m][n][jj]; s1 += v; s2 += v * v; }
            s1 += __shfl_xor(s1, 16); s1 += __shfl_xor(s1, 32); s2 += __shfl_xor(s2, 16); s2 += __shfl_xor(s2, 32);
            if (fq == 0) { red[(w * 64 + 16 * m + fr) * 2] = s1; red[(w * 64 + 16 * m + fr) * 2 + 1] = s2; } }
        __syncthreads();
#pragma unroll
        for (int m = 0; m < 4; ++m) { const int row = 16 * m + fr; float s1 = 0.f, s2 = 0.f;
#pragma unroll
            for (int ww = 0; ww < 8; ++ww) { s1 += red[(ww * 64 + row) * 2]; s2 += red[(ww * 64 + row) * 2 + 1]; }
            const float mean = s1 * (1.f / 256.f), ex2 = s2 * (1.f / 256.f);
            const float mu = GLA ? 0.f : mean, var = GLA ? ex2 : fmaxf(ex2 - mean * mean, 0.f);
            const float rstd = 1.0f / sqrtf(var + LN_EPS);
            const int t = s * CS + i * 64 + row;
#pragma unroll
            for (int n = 0; n < 2; ++n) { const int e = 32 * w + 16 * n + 4 * fq;
                const v2u gw2 = gpre[m][n];
                const float gt[4] = {bflo(gw2.x), bfhi(gw2.x), bflo(gw2.y), bfhi(gw2.y)};
                f32x4 gn = {1.f, 1.f, 1.f, 1.f}; if (GLA) gn = *(const f32x4*)(F.in[6] + e);
                float r4[4];
#pragma unroll
                for (int jj = 0; jj < 4; ++jj) { const float y = (accO[m][n][jj] - mu) * rstd * gn[jj]; r4[jj] = silu_g(gt[jj]) * y; }
                v2u ow; ow.x = pk2(r4[0], r4[1]); ow.y = pk2(r4[2], r4[3]);
                *(GAS v2u*)(mixed + (size_t)t * D + ocol + e) = ow; } }
    }
}
__device__ __forceinline__ void p4_out(Frame& F) {
    for (int u = F.bid; u < 8 * NS; u += F.G) { int s, h8; unit_sh(u, s, h8);
        if (h8 < 4) out_unit<false>(F, s, h8); else out_unit<true>(F, s, h8 - 4); }
    __syncthreads();
}

__device__ __forceinline__ void kv_chunk_load(Frame& F, v4u (&R)[8], const bf16* src  ) {
#pragma unroll
    for (int it = 0; it < 8; ++it) { const int ch = F.tid + NTHR * it, r = ch >> 4, cc = ch & 15; R[it] = *(const GAS v4u*)(src + (size_t)r * 4096 + 8 * cc); }
}
__device__ __forceinline__ void kv_chunk_store(Frame& F, const v4u (&R)[8], LAS unsigned char* dst) {
#pragma unroll
    for (int it = 0; it < 8; ++it) { const int ch = F.tid + NTHR * it, r = ch >> 4, cc = ch & 15; *(LAS v4u*)(dst + (r * 136 + 8 * cc) * 2) = R[it]; }
}
__device__ __forceinline__ void p8_attn(Frame& F) {
    const bf16* Q = WSP(bf16, WS_QB); const bf16* KVM = WSP(bf16, WS_KVM); bf16* att = WSP(bf16, WS_ATT);
    constexpr int CB = 256 * 136 * 2;
    const int fr = F.lane & 15, fq = F.lane >> 4, q4 = (F.lane >> 2) & 3, p4 = F.lane & 3;
    for (int u = F.bid; u < (T / 128) * 4; u += F.G) {
        const int h = u & 3, r0 = (u >> 2) * 128 + 16 * F.wave;
#if PROBE_T >= 221 && PROBE_T <= 224
        if (F.bid == 0 && F.tid == 0) ((unsigned long long*)(F.ws + 32768))[0] = __builtin_amdgcn_s_memrealtime();
#endif
        v4u R[8];
        bf16x8_t qa[16];
#pragma unroll
        for (int ks = 0; ks < 16; ++ks) qa[ks] = *(const GAS bf16x8_t*)(Q + (size_t)(r0 + fr) * D + h * 512 + 32 * ks + 8 * fq);
        __syncthreads();
        kv_chunk_load(F, R, KVM + h * 512); kv_chunk_store(F, R, F.lds);
        __syncthreads();
        f32x4 accS[16];
#pragma unroll
        for (int i = 0; i < 16; ++i) accS[i] = (f32x4){0.f, 0.f, 0.f, 0.f};
#pragma unroll
        for (int dc = 0; dc < 4; ++dc) {
            kv_chunk_load(F, R, dc < 3 ? KVM + h * 512 + (dc + 1) * 128 : KVM + 2048 + h * 512);
            const LAS unsigned char* Cs = F.lds + (dc & 1) * CB;
#pragma unroll
            for (int ks = 0; ks < 4; ++ks)
#pragma unroll
                for (int nt = 0; nt < 16; ++nt) accS[nt] = MFMA16(frag_row(Cs, 136, 16 * nt, 32 * ks, F.lane), qa[4 * dc + ks], accS[nt]);
            kv_chunk_store(F, R, F.lds + ((dc + 1) & 1) * CB);
            __syncthreads();
        }
#if PROBE_T >= 221 && PROBE_T <= 224
        if (F.bid == 0 && F.tid == 0) ((unsigned long long*)(F.ws + 32768))[1] = __builtin_amdgcn_s_memrealtime();
#endif
        float mx = -3.0e38f;
#pragma unroll
        for (int nt = 0; nt < 16; ++nt)
#pragma unroll
            for (int jj = 0; jj < 4; ++jj) mx = fmaxf(mx, accS[nt][jj]);
        mx = fmaxf(mx, __shfl_xor(mx, 16)); mx = fmaxf(mx, __shfl_xor(mx, 32));
        const float sl2 = 0.04419417382415922f * 1.4426950408889634f;
        float sm = 0.f;
#pragma unroll
        for (int nt = 0; nt < 16; ++nt)
#pragma unroll
            for (int jj = 0; jj < 4; ++jj) { const float p = __builtin_amdgcn_exp2f((accS[nt][jj] - mx) * sl2); accS[nt][jj] = p; sm += p; }
        sm += __shfl_xor(sm, 16); sm += __shfl_xor(sm, 32);
        const float inv = 1.0f / sm;
        bf16x8_t pf[8];
#pragma unroll
        for (int ks2 = 0; ks2 < 8; ++ks2) { v4u w; w.x = pk2(accS[2 * ks2][0] * inv, accS[2 * ks2][1] * inv); w.y = pk2(accS[2 * ks2][2] * inv, accS[2 * ks2][3] * inv);
            w.z = pk2(accS[2 * ks2 + 1][0] * inv, accS[2 * ks2 + 1][1] * inv); w.w = pk2(accS[2 * ks2 + 1][2] * inv, accS[2 * ks2 + 1][3] * inv); pf[ks2] = __builtin_bit_cast(bf16x8_t, w); }
#pragma unroll 1
        for (int ec = 0; ec < 4; ++ec) {
            if (ec < 3) kv_chunk_load(F, R, KVM + 2048 + h * 512 + (ec + 1) * 128);
            const LAS unsigned char* Cs = F.lds + (ec & 1) * CB;
            f32x4 accO[8];
#pragma unroll
            for (int i = 0; i < 8; ++i) accO[i] = (f32x4){0.f, 0.f, 0.f, 0.f};
#pragma unroll
            for (int ks2 = 0; ks2 < 8; ++ks2)
#pragma unroll
                for (int et = 0; et < 8; ++et) { const LAS unsigned char* a = Cs + ((32 * ks2 + 4 * fq + q4) * 136 + 16 * et + 4 * p4) * 2;
                    const s16x4_t lo = lds_tr(a), hi = lds_tr(a + 16 * 136 * 2);
                    accO[et] = MFMA16(__builtin_shufflevector(lo, hi, 0, 1, 2, 3, 4, 5, 6, 7), pf[ks2], accO[et]); }
#pragma unroll
            for (int et = 0; et < 8; ++et) { v2u w; w.x = pk2(accO[et][0], accO[et][1]); w.y = pk2(accO[et][2], accO[et][3]);
                *(GAS v2u*)(att + (size_t)(r0 + fr) * D + h * 512 + ec * 128 + 16 * et + 4 * fq) = w; }
            if (ec < 3) kv_chunk_store(F, R, F.lds + ((ec + 1) & 1) * CB);
            __syncthreads();
        }
#if PROBE_T >= 221 && PROBE_T <= 224
        asm volatile("s_waitcnt vmcnt(0)" ::: "memory");
        if (F.bid == 0 && F.tid == 0) ((unsigned long long*)(F.ws + 32768))[2] = __builtin_amdgcn_s_memrealtime();
#endif
    }
}

constexpr int RT_AROW = 2064;
__device__ __forceinline__ void router_stage(const f32x4 (&v)[4][8], const float (&rstd)[4], const int kh, const bool store_h, const float* g, const float* b, bf16* HB, const int t0, const int wave, const int lane, LAS unsigned char* lds) {
#pragma unroll
    for (int jl = 0; jl < 4; ++jl) { const int j = 4 * kh + jl;
        const f32x4 gv = *(const f32x4*)(g + 4 * lane + 256 * j), bv = *(const f32x4*)(b + 4 * lane + 256 * j);
#pragma unroll
        for (int i = 0; i < 4; ++i) { const f32x4 hv = v[i][j] * rstd[i] * gv + bv;
            v2u hi, lo; hi.x = pk2(hv[0], hv[1]); hi.y = pk2(hv[2], hv[3]);
            lo.x = pk2(hv[0] - __builtin_bit_cast(float, hi.x << 16), hv[1] - __builtin_bit_cast(float, hi.x & 0xffff0000u));
            lo.y = pk2(hv[2] - __builtin_bit_cast(float, hi.y << 16), hv[3] - __builtin_bit_cast(float, hi.y & 0xffff0000u));
            if (store_h) ((GAS v2u*)(HB + (size_t)(t0 + i) * D) + lane)[64 * j] = hi;
            LAS unsigned char* p = lds + (4 * wave + i) * RT_AROW + (4 * lane + 256 * jl) * 2;
            *(LAS v2u*)p = hi; *(LAS v2u*)(p + 32 * RT_AROW) = lo; } }
}
__device__ __forceinline__ void router_mma(f32x4& acc0, f32x4& acc1, f32x4& acc2, const int kh, const bf16* wrt, const int wave, const int lane, LAS unsigned char* lds) {
    const int fr = lane & 15, fq = lane >> 4, rt = wave >> 2, kq = wave & 3;
    LAS unsigned char* pa = lds + (16 * rt + fr) * RT_AROW + (256 * kq + 8 * fq) * 2;
    const bf16* whi = wrt + ((size_t)((1024 * kh + 256 * kq) / 8 + fq) * 48 + fr) * 8;
    const bf16* wlo = whi + 48 * 2048;
#pragma unroll 2
    for (int ks = 0; ks < 8; ++ks) {
        const bf16x8_t ah = *(LAS bf16x8_t*)(pa + 64 * ks), al = *(LAS bf16x8_t*)(pa + 32 * RT_AROW + 64 * ks);
        const bf16x8_t b0h = *(const GAS bf16x8_t*)(whi + 1536 * ks), b1h = *(const GAS bf16x8_t*)(whi + 1536 * ks + 128), b2h = *(const GAS bf16x8_t*)(whi + 1536 * ks + 256);
        const bf16x8_t b0l = *(const GAS bf16x8_t*)(wlo + 1536 * ks), b1l = *(const GAS bf16x8_t*)(wlo + 1536 * ks + 128), b2l = *(const GAS bf16x8_t*)(wlo + 1536 * ks + 256);
        acc0 = MFMA16(ah, b0h, acc0); acc0 = MFMA16(ah, b0l, acc0); acc0 = MFMA16(al, b0h, acc0);
        acc1 = MFMA16(ah, b1h, acc1); acc1 = MFMA16(ah, b1l, acc1); acc1 = MFMA16(al, b1h, acc1);
        acc2 = MFMA16(ah, b2h, acc2); acc2 = MFMA16(ah, b2l, acc2); acc2 = MFMA16(al, b2h, acc2);
    }
}
__device__ __forceinline__ void p10_ln_router(Frame& F) {
    const float* Y = WSP(float, WS_Y2); const float* g = F.in[14]; const float* b = F.in[15]; bf16* HB = WSP(bf16, WS_H2B); float* st = WSP(float, WS_ST2);
    LAS float* part = (LAS float*)F.lds;
    LAS float* stl = (LAS float*)(F.lds + 64 * RT_AROW);
    LAS int* lcnt = (LAS int*)(F.lds + 64 * RT_AROW + 256);
    LAS int* lbase = lcnt + 32;
    if (F.tid < 32) lcnt[F.tid] = 0;
    { int* tok = WSP(int, WS_TOK); for (int i = F.bid * NTHR + F.tid; i < PMAX; i += F.G * NTHR) tok[i] = 0; }
    __syncthreads();
    const int fr = F.lane & 15, fq = F.lane >> 4;
    for (int item = F.bid; item < T / 32; item += F.G) {
        const int row0 = item * 32;
#if PROBE_T >= 231 && PROBE_T <= 236
        if (F.bid == 0 && F.tid == 0) ((unsigned long long*)(F.ws + 32768))[0] = __builtin_amdgcn_s_memrealtime();
#endif
        const int t0 = row0 + 4 * F.wave;
        f32x4 v[4][8]; float rstd[4];
        {
            const GAS f32x4* yr = (const GAS f32x4*)(Y + (size_t)t0 * D) + F.lane;
#pragma unroll
            for (int i = 0; i < 4; ++i)
#pragma unroll
                for (int j = 0; j < 8; ++j) v[i][j] = yr[512 * i + 64 * j];
            float mean[4];
#pragma unroll
            for (int i = 0; i < 4; ++i) { float s = 0.f;
#pragma unroll
                for (int j = 0; j < 8; ++j) s += (v[i][j][0] + v[i][j][1]) + (v[i][j][2] + v[i][j][3]);
                mean[i] = wave_sum(s) * (1.f / D); }
#pragma unroll
            for (int i = 0; i < 4; ++i) { float s2 = 0.f;
#pragma unroll
                for (int j = 0; j < 8; ++j) { v[i][j] = v[i][j] - mean[i]; s2 += (v[i][j][0] * v[i][j][0] + v[i][j][1] * v[i][j][1]) + (v[i][j][2] * v[i][j][2] + v[i][j][3] * v[i][j][3]); }
                rstd[i] = 1.f / sqrtf(wave_sum(s2) * (1.f / D) + LN_EPS); }
            if (F.lane < 4) { const float m_ = F.lane == 0 ? mean[0] : F.lane == 1 ? mean[1] : F.lane == 2 ? mean[2] : mean[3], r_ = F.lane == 0 ? rstd[0] : F.lane == 1 ? rstd[1] : F.lane == 2 ? rstd[2] : rstd[3];
                st[2 * (t0 + F.lane)] = m_; st[2 * (t0 + F.lane) + 1] = r_; stl[2 * (4 * F.wave + F.lane)] = m_; stl[2 * (4 * F.wave + F.lane) + 1] = r_; }
        }
        f32x4 acc0 = {0.f, 0.f, 0.f, 0.f}, acc1 = acc0, acc2 = acc0;
        router_stage(v, rstd, 0, true, g, b, HB, t0, F.wave, F.lane, F.lds);
        __syncthreads();
#if PROBE_T >= 231 && PROBE_T <= 236
        if (F.bid == 0 && F.tid == 0) ((unsigned long long*)(F.ws + 32768))[1] = __builtin_amdgcn_s_memrealtime();
#endif
        router_mma(acc0, acc1, acc2, 0, WSP(bf16, WS_WRT), F.wave, F.lane, F.lds);
        __syncthreads();
        router_stage(v, rstd, 1, true, g, b, HB, t0, F.wave, F.lane, F.lds);
        __syncthreads();
        router_mma(acc0, acc1, acc2, 1, WSP(bf16, WS_WRT), F.wave, F.lane, F.lds);
        __syncthreads();
        {
            LAS float* pw = part + F.wave * 768;
#pragma unroll
            for (int jj = 0; jj < 4; ++jj) { pw[(4 * fq + jj) * 48 + fr] = acc0[jj]; pw[(4 * fq + jj) * 48 + 16 + fr] = acc1[jj]; pw[(4 * fq + jj) * 48 + 32 + fr] = acc2[jj]; }
        }
        __syncthreads();
#if PROBE_T >= 231 && PROBE_T <= 236
        if (F.bid == 0 && F.tid == 0) ((unsigned long long*)(F.ws + 32768))[2] = __builtin_amdgcn_s_memrealtime();
#endif
        int e1 = 0, e2 = 0, r1 = 0, r2 = 0; float g1 = 0.f, g2 = 0.f;
        if (F.tid < 32) {
            const int rt = F.tid >> 4, rr = F.tid & 15;
            float le[32], lg[4];
#pragma unroll
            for (int c = 0; c < 32; ++c) { float s = 0.f;
#pragma unroll
                for (int kq = 0; kq < 4; ++kq) s += part[(rt * 4 + kq) * 768 + rr * 48 + c]; le[c] = s; }
#pragma unroll
            for (int c = 0; c < 4; ++c) { float s = 0.f;
#pragma unroll
                for (int kq = 0; kq < 4; ++kq) s += part[(rt * 4 + kq) * 768 + rr * 48 + 32 + c]; lg[c] = s + F.in[17][c]; }
            int grp = 0; float gmx = lg[0];
#pragma unroll
            for (int i = 1; i < 4; ++i) if (lg[i] > gmx) { gmx = lg[i]; grp = i; }
            float gs = 0.f;
#pragma unroll
            for (int i = 0; i < 4; ++i) gs += expf(lg[i] - gmx);
            const float pg_sel = 1.0f / gs;
            float fe[8];
#pragma unroll
            for (int j = 0; j < 8; ++j) { const float a = grp == 0 ? le[j] : grp == 1 ? le[8 + j] : grp == 2 ? le[16 + j] : le[24 + j]; fe[j] = a + F.in[19][grp * 8 + j]; }
            int i1 = 0; float m1 = fe[0];
#pragma unroll
            for (int j = 1; j < 8; ++j) if (fe[j] > m1) { m1 = fe[j]; i1 = j; }
            int i2 = -1; float m2 = -3.0e38f;
#pragma unroll
            for (int j = 0; j < 8; ++j) if (j != i1 && fe[j] > m2) { m2 = fe[j]; i2 = j; }
            const float p2 = expf(m2 - m1), den = 1.0f / (1.0f + p2);
            e1 = grp * 8 + i1; e2 = grp * 8 + i2; g1 = pg_sel * den; g2 = pg_sel * p2 * den;
            r1 = __hip_atomic_fetch_add((int*)(lcnt + e1), 1, __ATOMIC_RELAXED, __HIP_MEMORY_SCOPE_WORKGROUP); r2 = __hip_atomic_fetch_add((int*)(lcnt + e2), 1, __ATOMIC_RELAXED, __HIP_MEMORY_SCOPE_WORKGROUP);
        }
        __syncthreads();
#if PROBE_T >= 231 && PROBE_T <= 236
        if (F.bid == 0 && F.tid == 0) ((unsigned long long*)(F.ws + 32768))[3] = __builtin_amdgcn_s_memrealtime();
#endif
        if (F.tid < 32) { const int c = lcnt[F.tid];
            lbase[F.tid] = c ? (int)__hip_atomic_fetch_add((unsigned*)(F.ctl + CW_CUR) + F.tid, (unsigned)c, __ATOMIC_RELAXED, __HIP_MEMORY_SCOPE_AGENT) : 0; }
        __syncthreads();
#if PROBE_T >= 231 && PROBE_T <= 236
        if (F.bid == 0 && F.tid == 0) ((unsigned long long*)(F.ws + 32768))[4] = __builtin_amdgcn_s_memrealtime();
#endif
        if (F.tid < 32) {
            const int t = row0 + F.tid;
            int* ex = WSP(int, WS_EXP); float* gt = WSP(float, WS_GATE); int* sl = WSP(int, WS_SLOT);
            ex[2 * t] = e1; ex[2 * t + 1] = e2; gt[2 * t] = g1; gt[2 * t + 1] = g2;
            sl[2 * t] = lbase[e1] + r1; sl[2 * t + 1] = lbase[e2] + r2;
            lcnt[F.tid] = 0;
        }
        __syncthreads();
#if PROBE_T >= 231 && PROBE_T <= 236
        if (F.bid == 0 && F.tid == 0) ((unsigned long long*)(F.ws + 32768))[5] = __builtin_amdgcn_s_memrealtime();
#endif
    }
}


#define XB_TMO      128
#define XB_XCNT(j)  (256  + 64 * (j))
#define XB_XSUB(j)  (1280 + 64 * (j))
#define XB_XGEN(j)  (2304 + 64 * (j))
#define XB_TOP      3328
#define XB_TOPGEN   3392
#define XCD_BAR_WORDS 3456
#define XB_SPIN_CAP (1u << 22)
__device__ __forceinline__ unsigned xb_ld(unsigned* p)              { return __hip_atomic_load(p, __ATOMIC_RELAXED, __HIP_MEMORY_SCOPE_AGENT); }
__device__ __forceinline__ unsigned xb_add(unsigned* p, unsigned v) { return __hip_atomic_fetch_add(p, v, __ATOMIC_RELAXED, __HIP_MEMORY_SCOPE_AGENT); }
__device__ __forceinline__ unsigned xb_xcc_id() { return (unsigned)__builtin_amdgcn_s_getreg((3 << 11) | 20) & 0xFu; }
#define XB_SPIN(cond, bar) do { unsigned _sp = 0; while (cond) { __builtin_amdgcn_s_sleep(1); \
    if ((++_sp & 255u) == 0u) { if (xb_ld(&(bar)[XB_TMO])) break; if (_sp > XB_SPIN_CAP) { atomicAdd(&(bar)[XB_TMO], 1u); break; } } } } while (0)
struct XcdBarrier { unsigned* bar; unsigned x; volatile LAS unsigned* st; };
__device__ __forceinline__ XcdBarrier xcd_barrier_post(unsigned* bar, volatile LAS unsigned* st) {
    XcdBarrier b; b.bar = bar; b.x = xb_xcc_id(); b.st = st;
    if (threadIdx.x == 0) (void)xb_add(&bar[XB_XCNT(b.x)], 1u);
    return b;
}
__device__ __forceinline__ void xcd_barrier_complete(unsigned* bar, unsigned x, unsigned& nloc, unsigned& nx) {
    const unsigned G = gridDim.x * gridDim.y * gridDim.z;
    unsigned sum, cnt, mine, sp = 0u;
    for (;;) {
        sum = 0u; cnt = 0u; mine = 0u;
#pragma unroll
        for (unsigned j = 0; j < 16; ++j) { const unsigned c = xb_ld(&bar[XB_XCNT(j)]); sum += c; cnt += (c > 0u) ? 1u : 0u; mine = (j == x) ? c : mine; }
        if (sum == G) break;
        __builtin_amdgcn_s_sleep(1);
        if ((++sp & 255u) == 0u) { if (xb_ld(&bar[XB_TMO])) break; if (sp > XB_SPIN_CAP) { atomicAdd(&bar[XB_TMO], 1u); break; } }
    }
    nloc = mine > 0u ? mine : 1u; nx = cnt > 0u ? cnt : 1u;
}
__device__ __forceinline__ void xcd_barrier(const XcdBarrier& b) {
    asm volatile("s_waitcnt vmcnt(0)" ::: "memory");
    __syncthreads();
    if (threadIdx.x == 0) {
        unsigned* bar = b.bar;
        __builtin_amdgcn_s_waitcnt(0);
        unsigned nloc = b.st[0], nx = b.st[1];
        if (nloc == 0u) { xcd_barrier_complete(bar, b.x, nloc, nx); b.st[0] = nloc; b.st[1] = nx; }
        const unsigned old = xb_add(&bar[XB_XSUB(b.x)], 1u);
        const unsigned gen = old / nloc;
        if (old + 1u == (gen + 1u) * nloc) {
            __builtin_amdgcn_fence(__ATOMIC_RELEASE, "agent");
            asm volatile("s_waitcnt vmcnt(0)" ::: "memory");
            const unsigned og = xb_add(&bar[XB_TOP], 1u);
            const unsigned tg = og / nx;
            if (og + 1u == (tg + 1u) * nx) xb_add(&bar[XB_TOPGEN], 1u);
            else XB_SPIN(xb_ld(&bar[XB_TOPGEN]) == tg, bar);
            __builtin_amdgcn_fence(__ATOMIC_ACQUIRE, "agent");
            xb_add(&bar[XB_XGEN(b.x)], 1u);
            asm volatile("s_waitcnt vmcnt(0)" ::: "memory");
        } else {
            XB_SPIN(xb_ld(&bar[XB_XGEN(b.x)]) == gen, bar);
            __builtin_amdgcn_fence(__ATOMIC_ACQUIRE, "agent");
            asm volatile("s_waitcnt vmcnt(0)" ::: "memory");
        }
    }
    __syncthreads();
}

struct Args { const float* in[25]; float* out; unsigned char* ws; int ph_lo, ph_hi, use_bar, pad; };
__global__ void __launch_bounds__(NTHR, 2) mega(Args args) {
    extern __shared__ __attribute__((aligned(16))) unsigned char lds[];
    Frame F;
    F.lds = (LAS unsigned char*)lds;
    F.MISC = (volatile LAS unsigned*)(F.lds + MISC_OFF);
    F.tid = threadIdx.x; F.lane = F.tid & 63; F.wave = __builtin_amdgcn_readfirstlane(F.tid >> 6);
    F.G = gridDim.x; F.bid = blockIdx.x;
    F.ws = args.ws; F.ctl = (gu32*)(args.ws + WS_CTL);
#pragma unroll
    for (int i = 0; i < 25; ++i) F.in[i] = args.in[i];
    F.out = args.out;
    for (int u = F.tid; u < (LDS_BYTES - LDSCTL_OFF) / 4; u += NTHR) ((LAS unsigned*)(F.lds + LDSCTL_OFF))[u] = 0u;
    __syncthreads();
    LAS int* ts = (LAS int*)(F.lds + MISC_OFF + 64);
    XcdBarrier bar; bar.bar = (unsigned*)(F.ctl + CW_BAR); bar.x = 0; bar.st = nullptr;
    if (args.use_bar) bar = xcd_barrier_post((unsigned*)(F.ctl + CW_BAR), F.MISC + 8);
    const int lo = args.ph_lo, hi = args.ph_hi;
#if PROBE_T == 100
    if (F.tid == 0) __hip_atomic_store(F.ctl + CW_LN1 + F.bid, xb_xcc_id() + 1u, RLX_AGENT);
#endif
#if PROBE_T >= 0
    unsigned long long pt0 = __builtin_amdgcn_s_memrealtime(), pdelay = 0ull;
#endif
#if MK_CG_SYNC == 2
    if (args.use_bar == 2) cooperative_groups::this_grid().sync();
#endif
#define IN(k) (lo <= (k) && (k) < hi)
#if PROBE_T >= 0
#if PROBE_T == 100
#define PROBE_STAMP(k) do { if ((k) == 0 && F.bid == 0 && F.tid == 0) { unsigned mm = 0; for (int b_ = 0; b_ < 256; ++b_) mm += (__hip_atomic_load(F.ctl + CW_LN1 + b_, RLX_AGENT) != __hip_atomic_load(F.ctl + CW_LN1 + (b_ & 7), RLX_AGENT)) ? 1u : 0u; pdelay = 100ull * mm; } } while (0)
#else
#define PROBE_STAMP(k) do { if ((k) == PROBE_T) pdelay = __builtin_amdgcn_s_memrealtime() - pt0; } while (0)
#endif
#else
#define PROBE_STAMP(k) do { } while (0)
#endif
#define REPS(k) for (int _r = 0; _r < ((k) == PROBE_PH ? PROBE_N : 1); ++_r)
#define SEAM(k) do { if (IN(k) && IN((k) + 1)) { if (MK_CG_SYNC == 1 && (k) == 0) cooperative_groups::this_grid().sync(); else { xcd_barrier(bar); if (PROBE_PH == 100) for (int _b = 1; _b < PROBE_N; ++_b) xcd_barrier(bar); } PROBE_STAMP(k); } } while (0)

    if (IN(0)) { REPS(0) p0_prologue(F); SEAM(0); }
    if (IN(1)) {
        p1_bcum(F, F.bid, F.G);
        const int g8 = F.bid >> 3, nsb = (g8 * NSG) >> 5; const bool streamer = (F.G == 256) && ((((g8 + 1) * NSG) >> 5) != nsb);
        if (!streamer) {
            pg8::Gemm g{WSP(pg8::bf16_t, WS_XB), WSP(pg8::bf16_t, WS_WIN), T + MEMN, HW + 4096, D}; pg8::OrderG1 S;
            if (F.G == 256) S.init(F.G - 8 * NSG, F.bid - 8 * nsb); else S.init(F.G, F.bid);
            pg8::EpiH E{WSP(pg8::bf16_t, WS_H), WSP(pg8::bf16_t, WS_KVM), WSP(float, WS_RC), WSP(float, WS_RS)};
            pg8::gemm_phase<pg8::EpiH, pg8::OrderG1, true, true>(F.lds, g, S, E);
        }
        transpose_queue(F);
        if (PROBE_PH == 102) for (int _q = 1; _q < PROBE_N; ++_q) transpose_queue(F, _q);
        SEAM(1);
    }
#if PROBE_PH == 101
    if (IN(1)) {
        pg8::Gemm g{WSP(pg8::bf16_t, WS_XB), WSP(pg8::bf16_t, WS_WIN), T + MEMN, HW + 4096, D}; pg8::OrderG1 S; S.init(F.G, F.bid);
        pg8::EpiH E{WSP(pg8::bf16_t, WS_H), WSP(pg8::bf16_t, WS_KVM), WSP(float, WS_RC), WSP(float, WS_RS)};
        pg8::gemm_phase<pg8::EpiH, pg8::OrderG1, true, true>(F.lds, g, S, E);
        xcd_barrier(bar);
    }
#endif
    if (IN(2)) { REPS(2) p2_kv(F); SEAM(2); }
    if (IN(3)) { p3_scan(F); SEAM(3); }
#if PROBE_PH == 103
    if (IN(3)) { p2_kv(F); xcd_barrier(bar); p3_scan(F); xcd_barrier(bar); }
#endif
    if (IN(4)) { REPS(4) p4_out(F); SEAM(4); }
    if (IN(5)) {
        pg8::Gemm g{WSP(pg8::bf16_t, WS_MIXED), WSP(pg8::bf16_t, WS_WMIX), T, D, D}; pg8::StaticOrder S; S.init(T, D, F.G, F.bid);
#if MK_FUSE_LN1
        pg8::EpiLN<0> E{F.in[0], nullptr, nullptr, nullptr, WSP(float, WS_Y1), WSP(float, WS_ST1), WSP(pg8::bf16_t, WS_H1B), F.in[8], F.in[9], WSP(unsigned long long, WS_XCH1), (unsigned*)(F.ctl + CW_LN1)};
        pg8::gemm_phase<pg8::EpiLN<0>, pg8::StaticOrder, false, true>(F.lds, g, S, E);
        SEAM(5);
    }
#else
        pg8::EpiResX E{F.in[0], WSP(float, WS_Y1), ALPHA};
#if PROBE_T >= 201 && PROBE_T <= 203
        if (F.bid == 0 && F.tid == 0) ((unsigned long long*)(F.ws + 32768))[0] = __builtin_amdgcn_s_memrealtime();
#endif
        REPS(5) pg8::gemm_phase<pg8::EpiResX, pg8::StaticOrder, MK_ALIGN1, true>(F.lds, g, S, E);
        SEAM(5);
#if PROBE_T >= 201 && PROBE_T <= 203
        if (F.bid == 0 && F.tid == 0) { unsigned long long* q_ = (unsigned long long*)(F.ws + 32768); q_[3] = __builtin_amdgcn_s_memrealtime();
            pdelay = PROBE_T == 201 ? q_[1] - q_[0] : PROBE_T == 202 ? q_[2] - q_[1] : q_[3] - q_[2]; }
#endif
    }
    if (IN(6)) { REPS(6) ln_apply_plain(F, WSP(float, WS_Y1), F.in[8], F.in[9], WSP(bf16, WS_H1B), WSP(float, WS_ST1)); SEAM(6); }
#endif
    if (IN(7)) {
        pg8::Gemm g{WSP(pg8::bf16_t, WS_H1B), WSP(pg8::bf16_t, WS_WMQ), T, D, D}; pg8::StaticOrder S; S.init(T, D, F.G, F.bid);
        pg8::EpiB E{WSP(pg8::bf16_t, WS_QB), D, -1, 8192u * 2048u * 2u};
        REPS(7) pg8::gemm_phase<pg8::EpiB, pg8::StaticOrder, MK_ALIGN1, true>(F.lds, g, S, E);
        SEAM(7);
    }
    if (IN(8)) { REPS(8) p8_attn(F); SEAM(8);
#if PROBE_T >= 221 && PROBE_T <= 224
        if (F.bid == 0 && F.tid == 0) { unsigned long long* q_ = (unsigned long long*)(F.ws + 32768); q_[3] = __builtin_amdgcn_s_memrealtime();
            pdelay = PROBE_T == 221 ? q_[1] - q_[0] : PROBE_T == 222 ? q_[2] - q_[1] : q_[3] - q_[2]; }
#endif
    }
    if (IN(9)) {
        pg8::Gemm g{WSP(pg8::bf16_t, WS_ATT), WSP(pg8::bf16_t, WS_WMO), T, D, D}; pg8::StaticOrder S; S.init(T, D, F.G, F.bid);
        pg8::EpiResLN E{WSP(float, WS_Y1), WSP(float, WS_ST1), F.in[8], F.in[9], WSP(float, WS_Y2), ALPHA};
        REPS(9) pg8::gemm_phase<pg8::EpiResLN, pg8::StaticOrder, MK_ALIGN1, true>(F.lds, g, S, E);
        SEAM(9);
    }
    if (IN(10)) { p10_ln_router(F); SEAM(10);
#if PROBE_T >= 231 && PROBE_T <= 236
        if (F.bid == 0 && F.tid == 0) { unsigned long long* q_ = (unsigned long long*)(F.ws + 32768); q_[6] = __builtin_amdgcn_s_memrealtime();
            pdelay = 10ull * (q_[PROBE_T - 230] - q_[PROBE_T - 231]); }
#endif
    }
    if (IN(11)) { moe_tile_starts(F, ts); p10_dispatch(F, ts); SEAM(11); }
#if MK_MOE_F32
#define MOE_GEMM_GU(l, g, S, E) pg8::gemm_phase_bf32<pg8::EpiSwi, pg8::MoeOrder, true, true, true>(l, g, S, E)
#define MOE_GEMM_DN(l, g, S, E) pg8::gemm_phase_bf32<pg8::EpiB, pg8::MoeOrder, true, false, false>(l, g, S, E)
#else
#define MOE_GEMM_GU(l, g, S, E) pg8::gemm_phase<pg8::EpiSwi, pg8::MoeOrder, true, true, true, MK_MOE_BNT>(l, g, S, E)
#define MOE_GEMM_DN(l, g, S, E) pg8::gemm_phase<pg8::EpiB, pg8::MoeOrder, true, true, false, MK_MOE_BNT>(l, g, S, E)
#endif
    if (IN(12)) {
#if PROBE_T >= 211 && PROBE_T <= 214
        if (F.bid == 0 && F.tid == 0) ((unsigned long long*)(F.ws + 32768))[0] = __builtin_amdgcn_s_memrealtime();
#endif
        moe_tile_starts(F, ts);
#if PROBE_T >= 211 && PROBE_T <= 214
        if (F.bid == 0 && F.tid == 0) ((unsigned long long*)(F.ws + 32768))[4] = __builtin_amdgcn_s_memrealtime();
#endif
        const int U = ts[32] * 4;
        pg8::Gemm g{WSP(pg8::bf16_t, WS_H2B), WSP(pg8::bf16_t, WS_WGU), PMAX, 32 * 1024, D, WSP(int, WS_TOK)};
        pg8::MoeOrder S{(const PG8_LAS int*)ts, F.G, F.bid, 4, U < F.G ? U : F.G, F.in[20], F.in[21], 2048, 512, 0};
        pg8::EpiSwi E{WSP(pg8::bf16_t, WS_HID)};
        MOE_GEMM_GU(F.lds, g, S, E);
        SEAM(12);
#if PROBE_T >= 211 && PROBE_T <= 214
        if (F.bid == 0 && F.tid == 0) { unsigned long long* q_ = (unsigned long long*)(F.ws + 32768); q_[3] = __builtin_amdgcn_s_memrealtime();
            pdelay = PROBE_T == 211 ? q_[4] - q_[0] : PROBE_T == 212 ? q_[1] - q_[4] : PROBE_T == 213 ? q_[2] - q_[1] : q_[3] - q_[2]; }
#endif
    }
    if (IN(13)) {
        moe_tile_starts(F, ts);
        const int RT = ts[32], U = RT * 4, nbg = U > F.G ? U - F.G : 0, R1 = (F.G / 4) < RT ? (F.G / 4) : RT;
        {
            pg8::Gemm g{WSP(pg8::bf16_t, WS_H2B), WSP(pg8::bf16_t, WS_WGU), PMAX, 32 * 1024, D, WSP(int, WS_TOK)};
            pg8::MoeOrder S{(const PG8_LAS int*)ts, F.G, F.bid, 4, U, F.in[20], F.in[21], 2048, 512, F.G};
            pg8::EpiSwi E{WSP(pg8::bf16_t, WS_HID)};
            MOE_GEMM_GU(F.lds, g, S, E);
        }
        {
            pg8::Gemm g{WSP(pg8::bf16_t, WS_HID), WSP(pg8::bf16_t, WS_WD), PMAX, 32 * 2048, 512};
            pg8::MoeOrder S{(const PG8_LAS int*)ts, F.G - nbg, F.bid >= nbg ? F.bid - nbg : -1, 8, R1 * 8, F.in[22], nullptr, 512, 2048, 0};
            pg8::EpiB E{WSP(pg8::bf16_t, WS_YS), D, 7, 24576u * 2048u * 2u};
            MOE_GEMM_DN(F.lds, g, S, E);
        }
        SEAM(13);
    }
    if (IN(14)) {
        moe_tile_starts(F, ts);
        const int RT = ts[32], R1 = (F.G / 4) < RT ? (F.G / 4) : RT;
        pg8::Gemm g{WSP(pg8::bf16_t, WS_HID), WSP(pg8::bf16_t, WS_WD), PMAX, 32 * 2048, 512};
        pg8::MoeOrder S{(const PG8_LAS int*)ts, F.G, F.bid, 8, RT * 8, F.in[22], nullptr, 512, 2048, R1 * 8};
        pg8::EpiB E{WSP(pg8::bf16_t, WS_YS), D, 7, 24576u * 2048u * 2u};
        MOE_GEMM_DN(F.lds, g, S, E);
        SEAM(14);
    }
    if (IN(15)) { REPS(15) p13_combine(F); }
#if PROBE_T >= 0
    if (F.bid == 0 && F.tid == 0) { const unsigned long long te = __builtin_amdgcn_s_memrealtime(); while (__builtin_amdgcn_s_memrealtime() - te < pdelay) __builtin_amdgcn_s_sleep(8); }
#endif
#undef IN
#undef SEAM
#undef REPS
}

extern "C" void kernel_launch(void* const* d_in, const int* in_sizes, int n_in, void* d_out, int out_size, void* d_ws, size_t ws_size, hipStream_t stream) {
    static int grid = 0;
    if (grid == 0) {
        if (n_in != 25 || in_sizes[0] != T * D || out_size != T * D || ws_size < WS_END) { fprintf(stderr, "kernel_launch: unexpected shapes / workspace (%d inputs, ws %zu)\n", n_in, ws_size); grid = -1; return; }
        int dev = 0, cus = 0;
        if (hipGetDevice(&dev) != hipSuccess || hipDeviceGetAttribute(&cus, hipDeviceAttributeMultiprocessorCount, dev) != hipSuccess) { grid = -1; return; }
        if (hipFuncSetAttribute((const void*)mega, hipFuncAttributeMaxDynamicSharedMemorySize, LDS_BYTES) != hipSuccess) { fprintf(stderr, "kernel_launch: hipFuncSetAttribute failed\n"); grid = -1; return; }
        int per_cu = 0;
        if (hipOccupancyMaxActiveBlocksPerMultiprocessor(&per_cu, (const void*)mega, NTHR, LDS_BYTES) != hipSuccess || per_cu < 1) { fprintf(stderr, "kernel_launch: occupancy query failed / 0 blocks per CU\n"); grid = -1; return; }
        (void)hipGetLastError();
        grid = cus;
    }
    if (grid < 0) return;
    if (hipMemsetAsync((char*)d_ws + WS_CTL, 0, CTL_ZERO_BYTES, stream) != hipSuccess) return;
    Args a{};
    for (int i = 0; i < 25; ++i) a.in[i] = (const float*)d_in[i];
    a.out = (float*)d_out; a.ws = (unsigned char*)d_ws;
#if MK_ONE_LAUNCH
    a.ph_lo = 0; a.ph_hi = NPH; a.use_bar = 1;
#if MK_CG_SYNC
    { void* kargs[] = {(void*)&a};
      hipError_t e = hipLaunchCooperativeKernel((const void*)mega, dim3(grid), dim3(NTHR), kargs, LDS_BYTES, stream);
      if (e != hipSuccess) fprintf(stderr, "cooperative launch failed: %s (grid %d)\n", hipGetErrorString(e), grid); }
#else
    hipLaunchKernelGGL(mega, dim3(grid), dim3(NTHR), LDS_BYTES, stream, a);
#endif
#else
    for (int p = 0; p < NPH; ++p) { a.ph_lo = p; a.ph_hi = p + 1; a.use_bar = 0;
        hipLaunchKernelGGL(mega, dim3(grid), dim3(NTHR), LDS_BYTES, stream, a); }
#endif
}
```

```cpp
#include <hip/hip_runtime.h>
#include <hip/hip_cooperative_groups.h>
#include <cstdio>
#include <cstdint>
#include <cmath>
#ifndef MK_ONE_LAUNCH
#define MK_ONE_LAUNCH 1
#endif
#ifndef MK_CG_SYNC
#define MK_CG_SYNC 2
#endif
#ifndef MK_WT_STORES
#define MK_WT_STORES 0
#endif
#ifndef MK_MOE_F32
#define MK_MOE_F32 0
#endif
#define PROBE_PH -1
#define PROBE_N 1
#define PROBE_T -1
#define WS_Y1_OFF (410ull << 20)
namespace pg8 {
#define PG8_LAS __attribute__((address_space(3)))
typedef unsigned short bf16_t;
typedef short bf16x8 __attribute__((ext_vector_type(8)));
typedef float f32x4 __attribute__((ext_vector_type(4)));
typedef unsigned u32x4 __attribute__((ext_vector_type(4)));
constexpr int BM = 256, BK = 64, HALF = 128, HTB = HALF * BK * 2  , STAGE_BYTES = 8 * HTB, NXCD = 8, WGM = 8;

__host__ __device__ __forceinline__ int lds_byte(int r, int c) { const int st = (r >> 4) * 2 + (c >> 5), rr = r & 15, cc = c & 31, ob = rr * 64 + cc * 2; return st * 1024 + (ob ^ (((ob >> 9) & 1) << 5)); }
__host__ __device__ __forceinline__ void stage_rc(int b, int& R, int& C) { const int st = b / 1024, sb = b % 1024, swz = sb ^ (((sb >> 9) & 1) << 5); R = (st >> 1) * 16 + swz / 64; C = (st & 1) * 32 + (swz % 64) / 2; }
__host__ __device__ __forceinline__ int perm32(int rho) { const int n = rho >> 4, i = rho & 15; return 8 * (i >> 2) + 4 * n + (i & 3); }

struct Unit { int pm, pn; };
struct Gemm { const bf16_t* A; const bf16_t* Bt; int M, N, K; const int* tok; };

struct StaticOrder {
    int nM, nN, nwg, G, c;
    __host__ __device__ void init(int M, int N, int G_, int c_) { nM = M / BM; nN = N / BM; nwg = nM * nN; G = G_; c = c_; }
    __host__ __device__ bool next(int i, Unit& u) const {
        const long L = (long)i * G + c; if (L >= nwg) return false;
        int wgid = (int)L; { const int q = nwg / NXCD, r = nwg % NXCD, xcd = wgid % NXCD, off = wgid / NXCD; wgid = (xcd < r ? xcd * (q + 1) : r * (q + 1) + (xcd - r) * q) + off; }
        const int nig = WGM * nN, gid = wgid / nig, fm = gid * WGM, gsz = (nM - fm) < WGM ? (nM - fm) : WGM;
        u.pm = fm + ((wgid % nig) % gsz); u.pn = (wgid % nig) / gsz; return true;
    }
    __device__ __forceinline__ void a_ready(const Unit&) const {}
    __device__ __forceinline__ void done(const Unit&) const {}
};


typedef unsigned u32x2 __attribute__((ext_vector_type(2)));
__device__ __forceinline__ unsigned cvt_pk_bf16(float lo, float hi) { unsigned r; asm volatile("v_cvt_pk_bf16_f32 %0, %1, %2" : "=v"(r) : "v"(lo), "v"(hi)); return r; }
__device__ __forceinline__ u32x4 pack8(const f32x4 a, const f32x4 b) { u32x4 w; w.x = cvt_pk_bf16(a[0], a[1]); w.y = cvt_pk_bf16(a[2], a[3]); w.z = cvt_pk_bf16(b[0], b[1]); w.w = cvt_pk_bf16(b[2], b[3]); return w; }
#if MK_WT_STORES
#define PG8_RSRC(base, bytes) __builtin_amdgcn_make_buffer_rsrc((void*)(base), 0, (int)(bytes), 0x00020000)
#define PG8_ST16(rs, base, byteoff, val) __builtin_amdgcn_raw_buffer_store_b128(__builtin_bit_cast(u32x4, (val)), (rs), (unsigned)(byteoff), 0, 16)
#else
#define PG8_RSRC(base, bytes) 0
#define PG8_ST16(rs, base, byteoff, val) (*(u32x4*)((char*)(base) + (size_t)(byteoff)) = __builtin_bit_cast(u32x4, (val)))
#endif
__device__ __forceinline__ float silu_f(float x) { return x * __builtin_amdgcn_rcpf(1.0f + __builtin_amdgcn_exp2f(-1.4426950408889634f * x)); }

struct EpiH {
    static constexpr bool PERM = true, AFTER_DRAIN = false;
    bf16_t* H; bf16_t* KVM; const float* rc; const float* rs;
    __device__ __forceinline__ void operator()(const f32x4 (&acc)[2][2][4][2], const Unit& u, int wr, int wc, int fr, int fq) const {
        const int cb = wc * 32 + 8 * fq;
        const auto rsH = PG8_RSRC(H, 8192u * 7168u * 2u); (void)rsH;
        if (u.pm >= 32) {
#pragma unroll
            for (int ai = 0; ai < 2; ++ai)
#pragma unroll
                for (int m = 0; m < 4; ++m) { bf16_t* rowp = KVM + (size_t)(wr * 64 + fr + ai * HALF + m * 16) * 4096 + (u.pn - 28) * BM + cb;
#pragma unroll
                    for (int bj = 0; bj < 2; ++bj) *(u32x4*)(rowp + bj * HALF) = pack8(acc[ai][bj][m][0], acc[ai][bj][m][1]); }
            return;
        }
        const int row0 = u.pm * BM + wr * 64 + fr;
        if (u.pn < 8) {
            const float sc = u.pn >= 4 ? 0.0625f : 1.0f;
#pragma unroll
            for (int ai = 0; ai < 2; ++ai)
#pragma unroll
                for (int m = 0; m < 4; ++m) { const int row = row0 + ai * HALF + m * 16;
                    const float* cr = rc + (size_t)row * 128 + cb; const float* sr = rs + (size_t)row * 128 + cb;
                    const f32x4 c0 = *(const f32x4*)cr * sc, c1 = *(const f32x4*)(cr + 4) * sc, s0 = *(const f32x4*)sr * sc, s1 = *(const f32x4*)(sr + 4) * sc;
                    const f32x4 t1a = acc[ai][0][m][0], t1b = acc[ai][0][m][1], t2a = acc[ai][1][m][0], t2b = acc[ai][1][m][1];
                    const unsigned bo = (unsigned)(((size_t)u.pn * 8192 + row) * BM + cb) * 2u;
                    PG8_ST16(rsH, H, bo, pack8(t1a * c0 - t2a * s0, t1b * c1 - t2b * s1));
                    PG8_ST16(rsH, H, bo + 2 * HALF, pack8(t1a * s0 + t2a * c0, t1b * s1 + t2b * c1)); }
        } else {
            const float sc = (u.pn == 16 || u.pn == 17) ? 0.08838834764831845f : 1.0f;
#pragma unroll
            for (int ai = 0; ai < 2; ++ai)
#pragma unroll
                for (int m = 0; m < 4; ++m) { const unsigned bo = (unsigned)(((size_t)u.pn * 8192 + row0 + ai * HALF + m * 16) * BM + cb) * 2u;
#pragma unroll
                    for (int bj = 0; bj < 2; ++bj) PG8_ST16(rsH, H, bo + bj * 2 * HALF, pack8(acc[ai][bj][m][0] * sc, acc[ai][bj][m][1] * sc)); }
        }
    }
};
struct EpiB {
    static constexpr bool PERM = true, AFTER_DRAIN = false;
    bf16_t* O; int ldc; int pmask; unsigned obytes;
    __device__ __forceinline__ void operator()(const f32x4 (&acc)[2][2][4][2], const Unit& u, int wr, int wc, int fr, int fq) const {
        const int row0 = u.pm * BM + wr * 64 + fr, col0 = (u.pn & pmask) * BM + wc * 32 + 8 * fq;
        const auto rsO = PG8_RSRC(O, obytes); (void)rsO;
#pragma unroll
        for (int ai = 0; ai < 2; ++ai)
#pragma unroll
            for (int m = 0; m < 4; ++m) { const unsigned bo = (unsigned)((size_t)(row0 + ai * HALF + m * 16) * ldc + col0) * 2u;
#pragma unroll
                for (int bj = 0; bj < 2; ++bj) PG8_ST16(rsO, O, bo + bj * 2 * HALF, pack8(acc[ai][bj][m][0], acc[ai][bj][m][1])); }
    }
};
struct EpiSwi {
    static constexpr bool PERM = true, AFTER_DRAIN = false;
    bf16_t* O;
    __device__ __forceinline__ void operator()(const f32x4 (&acc)[2][2][4][2], const Unit& u, int wr, int wc, int fr, int fq) const {
#if PROBE_T >= 211 && PROBE_T <= 214
        if (blockIdx.x == 0 && threadIdx.x == 0) ((unsigned long long*)((char*)O - (424ull << 20) + 32768))[1] = __builtin_amdgcn_s_memrealtime();
#endif
        const int row0 = u.pm * BM + wr * 64 + fr, col0 = (u.pn & 3) * HALF + wc * 32 + 8 * fq;
        const auto rsO = PG8_RSRC(O, 24576u * 512u * 2u); (void)rsO;
#pragma unroll
        for (int ai = 0; ai < 2; ++ai)
#pragma unroll
            for (int m = 0; m < 4; ++m) { const unsigned bo = (unsigned)((size_t)(row0 + ai * HALF + m * 16) * 512 + col0) * 2u;
                f32x4 h0, h1;
#pragma unroll
                for (int i = 0; i < 4; ++i) { h0[i] = silu_f(acc[ai][0][m][0][i]) * acc[ai][1][m][0][i]; h1[i] = silu_f(acc[ai][0][m][1][i]) * acc[ai][1][m][1][i]; }
                PG8_ST16(rsO, O, bo, pack8(h0, h1)); }
#if PROBE_T >= 211 && PROBE_T <= 214
        asm volatile("s_waitcnt vmcnt(0)" ::: "memory");
        if (blockIdx.x == 0 && threadIdx.x == 0) ((unsigned long long*)((char*)O - (424ull << 20) + 32768))[2] = __builtin_amdgcn_s_memrealtime();
#endif
    }
};
struct EpiResX {
    static constexpr bool PERM = false, AFTER_DRAIN = false;
    const float* X; float* Y; float alpha;
    __device__ __forceinline__ void operator()(const f32x4 (&acc)[2][2][4][2], const Unit& u, int wr, int wc, int fr, int fq) const {
#if PROBE_T >= 201 && PROBE_T <= 203
        if (blockIdx.x == 0 && threadIdx.x == 0) ((unsigned long long*)((char*)Y - WS_Y1_OFF + 32768))[1] = __builtin_amdgcn_s_memrealtime();
#endif
        const int row0 = u.pm * BM + wr * 64 + fr, col0 = u.pn * BM + wc * 32 + 4 * fq;
        const auto rsY = PG8_RSRC(Y, 8192u * 2048u * 4u); (void)rsY;
#pragma unroll
        for (int ai = 0; ai < 2; ++ai)
#pragma unroll
            for (int m = 0; m < 4; ++m) { const size_t off = (size_t)(row0 + ai * HALF + m * 16) * 2048 + col0;
#pragma unroll
                for (int bj = 0; bj < 2; ++bj)
#pragma unroll
                    for (int n = 0; n < 2; ++n) { const f32x4 xv = *(const f32x4*)(X + off + bj * HALF + n * 16); const f32x4 yv = xv * alpha + acc[ai][bj][m][n]; PG8_ST16(rsY, Y, (off + bj * HALF + n * 16) * 4, yv); } }
#if PROBE_T >= 201 && PROBE_T <= 203
        asm volatile("s_waitcnt vmcnt(0)" ::: "memory");
        if (blockIdx.x == 0 && threadIdx.x == 0) ((unsigned long long*)((char*)Y - WS_Y1_OFF + 32768))[2] = __builtin_amdgcn_s_memrealtime();
#endif
    }
};
struct EpiResLN {
    static constexpr bool PERM = false, AFTER_DRAIN = false;
    const float* Yin; const float* st; const float* g; const float* b; float* Y; float alpha;
    __device__ __forceinline__ void operator()(const f32x4 (&acc)[2][2][4][2], const Unit& u, int wr, int wc, int fr, int fq) const {
        const int row0 = u.pm * BM + wr * 64 + fr, col0 = u.pn * BM + wc * 32 + 4 * fq;
        const auto rsY = PG8_RSRC(Y, 8192u * 2048u * 4u); (void)rsY;
        f32x4 gv[2][2], bv[2][2];
#pragma unroll
        for (int bj = 0; bj < 2; ++bj)
#pragma unroll
            for (int n = 0; n < 2; ++n) { gv[bj][n] = *(const f32x4*)(g + col0 + bj * HALF + n * 16) * alpha; bv[bj][n] = *(const f32x4*)(b + col0 + bj * HALF + n * 16) * alpha; }
#pragma unroll
        for (int ai = 0; ai < 2; ++ai)
#pragma unroll
            for (int m = 0; m < 4; ++m) { const int row = row0 + ai * HALF + m * 16; const size_t off = (size_t)row * 2048 + col0;
                const float mu = st[2 * row], rstd = st[2 * row + 1];
#pragma unroll
                for (int bj = 0; bj < 2; ++bj)
#pragma unroll
                    for (int n = 0; n < 2; ++n) { const f32x4 yv = *(const f32x4*)(Yin + off + bj * HALF + n * 16);
                        const f32x4 yo = ((yv - mu) * rstd) * gv[bj][n] + bv[bj][n] + acc[ai][bj][m][n]; PG8_ST16(rsY, Y, (off + bj * HALF + n * 16) * 4, yo); } }
    }
};

struct EpiResB {
    static constexpr bool PERM = false, AFTER_DRAIN = false;
    const bf16_t* HB; float* Y; float alpha;
    __device__ __forceinline__ void operator()(const f32x4 (&acc)[2][2][4][2], const Unit& u, int wr, int wc, int fr, int fq) const {
        const int row0 = u.pm * BM + wr * 64 + fr, col0 = u.pn * BM + wc * 32 + 4 * fq;
        const auto rsY = PG8_RSRC(Y, 8192u * 2048u * 4u); (void)rsY;
#pragma unroll
        for (int ai = 0; ai < 2; ++ai)
#pragma unroll
            for (int m = 0; m < 4; ++m) { const size_t off = (size_t)(row0 + ai * HALF + m * 16) * 2048 + col0;
#pragma unroll
                for (int bj = 0; bj < 2; ++bj)
#pragma unroll
                    for (int n = 0; n < 2; ++n) { const u32x2 hw = *(const u32x2*)(HB + off + bj * HALF + n * 16);
                        const f32x4 hv = {__uint_as_float(hw.x << 16), __uint_as_float(hw.x & 0xffff0000u), __uint_as_float(hw.y << 16), __uint_as_float(hw.y & 0xffff0000u)};
                        const f32x4 yo = hv * alpha + acc[ai][bj][m][n]; PG8_ST16(rsY, Y, (off + bj * HALF + n * 16) * 4, yo); } }
    }
};

struct OrderG1 {
    StaticOrder so; int G, c;
    __device__ void init(int G_, int c_) { so.init(8192, 7168, G_, c_); G = G_; c = c_; }
    __device__ bool next(int i, Unit& u) const {
        const int L = i * G + c;
        if (L < 896) return so.next(i, u);
        if (L >= 912) return false;
        u.pm = 32; u.pn = 28 + (L - 896); return true;
    }
    __device__ __forceinline__ void a_ready(const Unit&) const {}
    __device__ __forceinline__ void done(const Unit&) const {}
};
struct MoeOrder {
    const PG8_LAS int* ts; int G, c, npn, total; const float* W0; const float* W1; int kdim, ncols; int L0;
    __device__ bool next(int i, Unit& u) const {
        if (c < 0) return false;
        const int L = L0 + i * G + c; if (L >= total) return false;
        const int rt = L / npn, pl = L - rt * npn; int e = 0;
        for (int j = 1; j < 32; ++j) e += (ts[j] <= rt) ? 1 : 0;
        u.pm = rt; u.pn = e * npn + pl; return true;
    }
    __device__ __forceinline__ int ldb() const { return ncols; }
    __device__ __forceinline__ int gtile(int pm) const {
        int e = 0; for (int j = 1; j < 32; ++j) e += (ts[j] <= pm) ? 1 : 0;
        return e * 32 + (pm - ts[e]); }
    __device__ __forceinline__ const float* bbase(const Unit& u, int which) const {
        const int e = u.pn / npn, pl = u.pn - e * npn; const size_t eo = (size_t)e * kdim * ncols;
        if (W1) return (which ? W1 : W0) + eo + 128 * pl;
        return W0 + eo + 256 * pl;
    }
    __device__ __forceinline__ void a_ready(const Unit&) const {}
    __device__ __forceinline__ void done(const Unit&) const {}
};

template <int MODE>
struct EpiLN {
    static constexpr bool PERM = false, AFTER_DRAIN = true;
    const float* X; const float* stin; const float* gin; const float* bin;
    float* Yout; float* stout; bf16_t* HB; const float* g; const float* b;
    unsigned long long* xbuf;
    unsigned* cnt;
    __device__ __forceinline__ void operator()(const f32x4 (&)[2][2][4][2], const Unit&, int, int, int, int) const {}
    __device__ __forceinline__ void fused(f32x4 (&acc)[2][2][4][2], const Unit& u, int wr, int wc, int fr, int fq, PG8_LAS unsigned char* lds, int wid, int lane) const {
        typedef float f32x2v __attribute__((ext_vector_type(2)));
        PG8_LAS f32x2v* P = (PG8_LAS f32x2v*)lds;
        PG8_LAS f32x2v* MS = (PG8_LAS f32x2v*)(lds + 8192);
        const int row0 = u.pm * BM + wr * 64 + fr, col0 = u.pn * BM + wc * 32 + 4 * fq;
        float s1[2][4], s2[2][4], mu[2][4], rs[2][4];
#pragma unroll
        for (int ai = 0; ai < 2; ++ai)
#pragma unroll
            for (int m = 0; m < 4; ++m) { s1[ai][m] = 0.f; s2[ai][m] = 0.f; mu[ai][m] = 0.f; rs[ai][m] = 0.f;
                if (MODE == 1) { const int row = row0 + ai * HALF + m * 16; mu[ai][m] = stin[2 * row]; rs[ai][m] = stin[2 * row + 1]; } }
#pragma unroll
        for (int bj = 0; bj < 2; ++bj)
#pragma unroll
            for (int n = 0; n < 2; ++n) {
                f32x4 gvv = {0.f, 0.f, 0.f, 0.f}, bvv = gvv;
                if (MODE == 1) { gvv = *(const f32x4*)(gin + col0 + bj * HALF + n * 16) * 1.189207115002721f; bvv = *(const f32x4*)(bin + col0 + bj * HALF + n * 16) * 1.189207115002721f; }
#pragma unroll
                for (int ai = 0; ai < 2; ++ai)
#pragma unroll
                    for (int m = 0; m < 4; ++m) { const size_t off = (size_t)(row0 + ai * HALF + m * 16) * 2048 + col0 + bj * HALF + n * 16;
                        const f32x4 xv = *(const f32x4*)(X + off);
                        const f32x4 y = (MODE == 1 ? ((xv - mu[ai][m]) * rs[ai][m]) * gvv + bvv : xv * 1.189207115002721f) + acc[ai][bj][m][n];
                        acc[ai][bj][m][n] = y; *(f32x4*)(Yout + off) = y;
                        s1[ai][m] += (y[0] + y[1]) + (y[2] + y[3]); s2[ai][m] += (y[0] * y[0] + y[1] * y[1]) + (y[2] * y[2] + y[3] * y[3]); }
            }
#pragma unroll
        for (int ai = 0; ai < 2; ++ai)
#pragma unroll
            for (int m = 0; m < 4; ++m) { float a1 = s1[ai][m], a2 = s2[ai][m];
                a1 += __shfl_xor(a1, 16); a1 += __shfl_xor(a1, 32); a2 += __shfl_xor(a2, 16); a2 += __shfl_xor(a2, 32);
                if (fq == 0) P[(ai * HALF + wr * 64 + m * 16 + fr) * 4 + wc] = (f32x2v){a1, a2}; }
        asm volatile("s_waitcnt lgkmcnt(0)" ::: "memory"); __builtin_amdgcn_s_barrier(); asm volatile("" ::: "memory");
        const int t = wid * 64 + lane;
        if (t < 256) { const f32x2v a = P[t * 4 + 0], b2 = P[t * 4 + 1], c = P[t * 4 + 2], d = P[t * 4 + 3];
            const float S1 = (a.x + b2.x) + (c.x + d.x), S2 = (a.y + b2.y) + (c.y + d.y);
            __hip_atomic_store(xbuf + ((size_t)(u.pm * 8 + u.pn) * 256 + t), ((unsigned long long)__float_as_uint(S2) << 32) | __float_as_uint(S1), __ATOMIC_RELAXED, __HIP_MEMORY_SCOPE_AGENT);
            asm volatile("s_waitcnt vmcnt(0)" ::: "memory");
            if (lane == 0) __hip_atomic_fetch_add(cnt + 64 * u.pm, 1u, __ATOMIC_RELAXED, __HIP_MEMORY_SCOPE_AGENT); }
        if (wid == 0) {
            const unsigned long long t0 = __builtin_amdgcn_s_memrealtime();
            while ((unsigned)__builtin_amdgcn_readfirstlane(__hip_atomic_load(cnt + 64 * u.pm, __ATOMIC_RELAXED, __HIP_MEMORY_SCOPE_AGENT)) < 32u) {
                if (__builtin_amdgcn_s_memrealtime() - t0 > 2000000ull) break;
                __builtin_amdgcn_s_sleep(2); }
            __builtin_amdgcn_fence(__ATOMIC_ACQUIRE, "agent");
        }
        asm volatile("s_waitcnt vmcnt(0) lgkmcnt(0)" ::: "memory"); __builtin_amdgcn_s_barrier(); asm volatile("" ::: "memory");
        if (t < 256) { float S1 = 0.f, S2 = 0.f;
#pragma unroll
            for (int j = 0; j < 8; ++j) { const unsigned long long w = __hip_atomic_load(xbuf + ((size_t)(u.pm * 8 + j) * 256 + t), __ATOMIC_RELAXED, __HIP_MEMORY_SCOPE_AGENT); S1 += __uint_as_float((unsigned)w); S2 += __uint_as_float((unsigned)(w >> 32)); }
            const float mean = S1 * (1.f / 2048.f), var = fmaxf(S2 * (1.f / 2048.f) - mean * mean, 0.f), rstd = 1.0f / sqrtf(var + 1e-5f);
            MS[t] = (f32x2v){mean, rstd};
            if (u.pn == 0) { stout[2 * (u.pm * BM + t)] = mean; stout[2 * (u.pm * BM + t) + 1] = rstd; } }
        asm volatile("s_waitcnt lgkmcnt(0)" ::: "memory"); __builtin_amdgcn_s_barrier(); asm volatile("" ::: "memory");
#pragma unroll
        for (int bj = 0; bj < 2; ++bj)
#pragma unroll
            for (int n = 0; n < 2; ++n) { const f32x4 gN = *(const f32x4*)(g + col0 + bj * HALF + n * 16), bN = *(const f32x4*)(b + col0 + bj * HALF + n * 16);
#pragma unroll
                for (int ai = 0; ai < 2; ++ai)
#pragma unroll
                    for (int m = 0; m < 4; ++m) { const int rl = ai * HALF + wr * 64 + m * 16 + fr; const f32x2v ms = MS[rl]; const size_t off = (size_t)(u.pm * BM + rl) * 2048 + col0 + bj * HALF + n * 16;
                        const f32x4 h = ((acc[ai][bj][m][n] - ms.x) * ms.y) * gN + bN;
                        u32x2 w; w.x = cvt_pk_bf16(h[0], h[1]); w.y = cvt_pk_bf16(h[2], h[3]); *(u32x2*)(HB + off) = w; } }
    }
};
template <class Epi, class Sched, bool ALIGN_EPI = false, bool SP2 = false, bool GATHER = false, bool BNT = false>
__device__ __forceinline__ void gemm_phase(PG8_LAS unsigned char* lds, const Gemm g, const Sched& S, const Epi& E) {
    const int tid = threadIdx.x, wid = __builtin_amdgcn_readfirstlane(tid >> 6), lane = tid & 63, wr = wid >> 2, wc = wid & 3, fr = lane & 15, fq = lane >> 4;
    const int K = g.K, nt = K / BK;
    unsigned voffA[2], voffB[2];
#pragma unroll
    for (int i = 0; i < 2; ++i) { int R, C; stage_rc(tid * 16 + i * 8192, R, C); const int Rb = Epi::PERM ? ((R & ~31) + perm32(R & 31)) : R;
        voffA[i] = (unsigned)(R * K + C) * 2u; voffB[i] = (unsigned)(Rb * K + C) * 2u; }
    unsigned coff[2][2], noff[2][2]; int gR[2], gC[2];
#pragma unroll
    for (int i = 0; i < 2; ++i) { int R, C; stage_rc(tid * 16 + i * 8192, R, C); gR[i] = R; gC[i] = C; coff[0][i] = coff[1][i] = noff[0][i] = noff[1][i] = 0u; }
#define PG8_GOFF(dst, pm_) do { if constexpr (GATHER) { const int _gt = S.gtile(pm_) * BM; _Pragma("unroll") for (int _h = 0; _h < 2; ++_h) _Pragma("unroll") for (int _i = 0; _i < 2; ++_i) \
        dst[_h][_i] = ((unsigned)g.tok[_gt + _h * HALF + gR[_i]] * (unsigned)K + (unsigned)gC[_i]) * 2u; } } while (0)
    const size_t kstep = (size_t)(BK * 2);
    const size_t hstep = (size_t)HALF * K * 2;
    const size_t tstep = 2 * hstep;
    const unsigned ldsw = (unsigned)wid * 1024u;
    const int aoff = lds_byte(wr * 64 + fr, fq * 8), boff = lds_byte(wc * 32 + fr, fq * 8);
#define PG8_SA(b, h) (((b) * 2 + (h)) * HTB)
#define PG8_SB(b, h) ((4 + (b) * 2 + (h)) * HTB)
#define PG8_STAGE(bufoff, gbase, voff) do { _Pragma("unroll") for (int _i = 0; _i < 2; ++_i) \
        __builtin_amdgcn_global_load_lds((const unsigned*)((const char*)(gbase) + (voff)[_i]), (PG8_LAS unsigned*)(lds + (bufoff) + ldsw + _i * 8192), 16, 0, 0); } while (0)
#define PG8_STAGEB(bufoff, gbase, voff) do { if constexpr (BNT) { _Pragma("unroll") for (int _i = 0; _i < 2; ++_i) \
        __builtin_amdgcn_global_load_lds((const unsigned*)((const char*)(gbase) + (voff)[_i]), (PG8_LAS unsigned*)(lds + (bufoff) + ldsw + _i * 8192), 16, 0, 2); } else { PG8_STAGE(bufoff, gbase, voff); } } while (0)
#define PG8_STAGEA(bufoff, gptr, hh, kbytes, usenext) do { if constexpr (GATHER) { _Pragma("unroll") for (int _i = 0; _i < 2; ++_i) { const unsigned _o = (usenext) ? noff[hh][_i] : coff[hh][_i]; \
        __builtin_amdgcn_global_load_lds((const unsigned*)((const char*)g.A + (size_t)(kbytes) + _o), (PG8_LAS unsigned*)(lds + (bufoff) + ldsw + _i * 8192), 16, 0, 0); } } else { PG8_STAGE(bufoff, gptr, voffA); } } while (0)
#define PG8_LDA(dst, b, h) do { _Pragma("unroll") for (int m = 0; m < 4; ++m) _Pragma("unroll") for (int k = 0; k < 2; ++k) dst[m][k] = *(const PG8_LAS bf16x8*)(lds + PG8_SA(b, h) + aoff + m * 2048 + k * 1024); } while (0)
#define PG8_LDB(dst, b, h) do { _Pragma("unroll") for (int n = 0; n < 2; ++n) _Pragma("unroll") for (int k = 0; k < 2; ++k) dst[n][k] = *(const PG8_LAS bf16x8*)(lds + PG8_SB(b, h) + boff + n * 2048 + k * 1024); } while (0)
#define PG8_MMA(ai, bj, At, Bt) do { __builtin_amdgcn_s_setprio(1); _Pragma("unroll") for (int m = 0; m < 4; ++m) _Pragma("unroll") for (int n = 0; n < 2; ++n) _Pragma("unroll") for (int k = 0; k < 2; ++k) \
        acc[ai][bj][m][n] = __builtin_amdgcn_mfma_f32_16x16x32_bf16(Bt[n][k], At[m][k], acc[ai][bj][m][n], 0, 0, 0); __builtin_amdgcn_s_setprio(0); } while (0)
#define PG8_WAIT_V(n) asm volatile("s_waitcnt vmcnt(" #n ")" ::: "memory")
#define PG8_WAIT_L(n) asm volatile("s_waitcnt lgkmcnt(" #n ")" ::: "memory")
#define PG8_BAR __builtin_amdgcn_s_barrier()
#define PG8_SCHED __builtin_amdgcn_sched_barrier(0)
    Unit cur, nxt; int ui = 0;
    if (!S.next(0, cur)) return;
    f32x4 acc[2][2][4][2];
#pragma unroll
    for (int a = 0; a < 2; ++a)
#pragma unroll
        for (int b = 0; b < 2; ++b)
#pragma unroll
            for (int m = 0; m < 4; ++m)
#pragma unroll
                for (int n = 0; n < 2; ++n) acc[a][b][m][n] = (f32x4){0.f, 0.f, 0.f, 0.f};
    bf16x8 At[4][2], B0[2][2], B1[2][2];
    const char* cA = (const char*)g.A + (size_t)cur.pm * tstep; const char* cB = (const char*)g.Bt + (size_t)cur.pn * tstep;
    PG8_GOFF(coff, cur.pm);
    S.a_ready(cur);
    if constexpr (SP2) {
        PG8_STAGEB(PG8_SB(0, 0), cB, voffB); PG8_STAGEB(PG8_SB(0, 1), cB + hstep, voffB); PG8_STAGEA(PG8_SA(0, 0), cA, 0, 0, false); PG8_STAGEA(PG8_SA(0, 1), cA + hstep, 1, 0, false);
        if (wr == 1) PG8_BAR;
        PG8_WAIT_V(2); PG8_BAR;
        PG8_STAGEB(PG8_SB(1, 0), cB + kstep, voffB); PG8_STAGEA(PG8_SA(1, 0), cA + kstep, 0, kstep, false); PG8_STAGEB(PG8_SB(1, 1), cB + hstep + kstep, voffB);
        PG8_WAIT_V(6); PG8_BAR;
    } else {
        PG8_STAGEB(PG8_SB(0, 0), cB, voffB); PG8_STAGE(PG8_SA(0, 0), cA, voffA); PG8_STAGEB(PG8_SB(0, 1), cB + hstep, voffB); PG8_STAGE(PG8_SA(0, 1), cA + hstep, voffA);
        if (wr == 1) PG8_BAR;
        PG8_WAIT_V(4); PG8_BAR;
        PG8_STAGEB(PG8_SB(1, 0), cB + kstep, voffB); PG8_STAGE(PG8_SA(1, 0), cA + kstep, voffA); PG8_STAGEB(PG8_SB(1, 1), cB + hstep + kstep, voffB);
        PG8_WAIT_V(6); PG8_BAR;
    }
    for (;;) {
        const bool has_next = S.next(ui + 1, nxt);
        const char* nA = has_next ? (const char*)g.A + (size_t)nxt.pm * tstep : cA; const char* nB = has_next ? (const char*)g.Bt + (size_t)nxt.pn * tstep : cB;
        if constexpr (GATHER) { if (has_next) { PG8_GOFF(noff, nxt.pm); } else { _Pragma("unroll") for (int _h = 0; _h < 2; ++_h) _Pragma("unroll") for (int _i = 0; _i < 2; ++_i) noff[_h][_i] = coff[_h][_i]; } }
        for (int t = 0; t < nt; t += 2) {
            const bool last = (t == nt - 2);
            const char* a1 = cA + (size_t)(t + 1) * kstep;
            const char* a2 = last ? nA : cA + (size_t)(t + 2) * kstep; const char* b2 = last ? nB : cB + (size_t)(t + 2) * kstep;
            const char* a3 = a2 + kstep; const char* b3 = b2 + kstep;
            const size_t k1 = (size_t)(t + 1) * kstep, k2 = last ? 0 : (size_t)(t + 2) * kstep, k3 = k2 + kstep;
            if (last && has_next) S.a_ready(nxt);
            if constexpr (SP2) {
            PG8_LDB(B0, 0, 0); PG8_LDB(B1, 0, 1); PG8_SCHED; PG8_LDA(At, 0, 0); PG8_STAGEA(PG8_SA(1, 1), a1 + hstep, 1, k1, false);
            PG8_WAIT_V(8); PG8_WAIT_L(0); PG8_BAR; PG8_MMA(0, 0, At, B0); PG8_MMA(0, 1, At, B1); PG8_BAR; PG8_SCHED;
            PG8_LDA(At, 0, 1); PG8_STAGEB(PG8_SB(0, 0), b2, voffB); PG8_STAGEB(PG8_SB(0, 1), b2 + hstep, voffB); PG8_STAGEA(PG8_SA(0, 0), a2, 0, k2, last);
            PG8_WAIT_V(8); PG8_WAIT_L(0); PG8_BAR; PG8_MMA(1, 0, At, B0); PG8_MMA(1, 1, At, B1); PG8_BAR; PG8_SCHED;
            PG8_LDB(B0, 1, 0); PG8_LDB(B1, 1, 1); PG8_SCHED; PG8_LDA(At, 1, 0); PG8_STAGEA(PG8_SA(0, 1), a2 + hstep, 1, k2, last);
            PG8_WAIT_V(8); PG8_WAIT_L(0); PG8_BAR; PG8_MMA(0, 0, At, B0); PG8_MMA(0, 1, At, B1); PG8_BAR; PG8_SCHED;
            PG8_LDA(At, 1, 1); PG8_STAGEB(PG8_SB(1, 0), b3, voffB); PG8_STAGEB(PG8_SB(1, 1), b3 + hstep, voffB); PG8_STAGEA(PG8_SA(1, 0), a3, 0, k3, last);
            PG8_WAIT_V(8); PG8_WAIT_L(0); PG8_BAR; PG8_MMA(1, 0, At, B0); PG8_MMA(1, 1, At, B1); PG8_BAR; PG8_SCHED;
            } else {
            PG8_LDB(B0, 0, 0); PG8_SCHED; PG8_LDA(At, 0, 0); PG8_STAGE(PG8_SA(1, 1), a1 + hstep, voffA);
            PG8_WAIT_L(8); PG8_BAR; PG8_WAIT_L(0); PG8_MMA(0, 0, At, B0); PG8_BAR; PG8_SCHED;
            PG8_LDB(B1, 0, 1); PG8_STAGEB(PG8_SB(0, 0), b2, voffB);
            PG8_BAR; PG8_WAIT_L(0); PG8_MMA(0, 1, At, B1); PG8_BAR;
            PG8_LDA(At, 0, 1); PG8_STAGE(PG8_SA(0, 0), a2, voffA);
            PG8_BAR; PG8_WAIT_L(0); PG8_MMA(1, 0, At, B0); PG8_BAR; PG8_SCHED;
            PG8_STAGEB(PG8_SB(0, 1), b2 + hstep, voffB);
            PG8_WAIT_V(6); PG8_BAR; PG8_MMA(1, 1, At, B1); PG8_BAR;
            PG8_LDB(B0, 1, 0); PG8_SCHED; PG8_LDA(At, 1, 0); PG8_STAGE(PG8_SA(0, 1), a2 + hstep, voffA);
            PG8_WAIT_L(8); PG8_BAR; PG8_WAIT_L(0); PG8_MMA(0, 0, At, B0); PG8_BAR; PG8_SCHED;
            PG8_LDB(B1, 1, 1); PG8_STAGEB(PG8_SB(1, 0), b3, voffB);
            PG8_BAR; PG8_WAIT_L(0); PG8_MMA(0, 1, At, B1); PG8_BAR;
            PG8_LDA(At, 1, 1); PG8_STAGE(PG8_SA(1, 0), a3, voffA);
            PG8_BAR; PG8_WAIT_L(0); PG8_MMA(1, 0, At, B0); PG8_BAR; PG8_SCHED;
            PG8_STAGEB(PG8_SB(1, 1), b3 + hstep, voffB);
            PG8_WAIT_V(6); PG8_BAR; PG8_MMA(1, 1, At, B1); PG8_BAR;
            }
        }
        if constexpr (ALIGN_EPI) { if (wr == 0) PG8_BAR; }
        if constexpr (!Epi::AFTER_DRAIN) { E(acc, cur, wr, wc, fr, fq); S.done(cur); }
        if (!has_next) break;
#pragma unroll
        for (int a = 0; a < 2; ++a)
#pragma unroll
            for (int b = 0; b < 2; ++b)
#pragma unroll
                for (int m = 0; m < 4; ++m)
#pragma unroll
                    for (int n = 0; n < 2; ++n) acc[a][b][m][n] = (f32x4){0.f, 0.f, 0.f, 0.f};
        cur = nxt; cA = nA; cB = nB; ++ui;
        if constexpr (GATHER) { _Pragma("unroll") for (int _h = 0; _h < 2; ++_h) _Pragma("unroll") for (int _i = 0; _i < 2; ++_i) coff[_h][_i] = noff[_h][_i]; }
        if constexpr (ALIGN_EPI) { if (wr == 1) PG8_BAR; }
    }
    PG8_WAIT_V(0);
    if constexpr (!ALIGN_EPI) { if (wr == 0) PG8_BAR; }
    PG8_BAR;
    if constexpr (Epi::AFTER_DRAIN) { E.fused(acc, cur, wr, wc, fr, fq, lds, wid, lane); S.done(cur); }
#undef PG8_SA
#undef PG8_SB
#undef PG8_STAGE
#undef PG8_STAGEB
#undef PG8_STAGEA
#undef PG8_GOFF
#undef PG8_LDA
#undef PG8_LDB
#undef PG8_MMA
#undef PG8_WAIT_V
#undef PG8_WAIT_L
#undef PG8_BAR
#undef PG8_SCHED
}
constexpr int PBI = 544, SBI_BYTES = 64 * PBI;
template <class Epi, class Sched, bool ALIGN_EPI = false, bool GATHER = false, bool SPLIT = false>
__device__ __forceinline__ void gemm_phase_bf32(PG8_LAS unsigned char* lds, const Gemm g, const Sched& S, const Epi& E) {
    const int tid = threadIdx.x, wid = __builtin_amdgcn_readfirstlane(tid >> 6), lane = tid & 63, wr = wid >> 2, wc = wid & 3, fr = lane & 15, fq = lane >> 4;
    const int K = g.K, nt = K / BK;
    unsigned voffA[2];
#pragma unroll
    for (int i = 0; i < 2; ++i) { int R, C; stage_rc(tid * 16 + i * 8192, R, C); voffA[i] = (unsigned)(R * K + C) * 2u; }
    unsigned coff[2][2], noff[2][2]; int gR[2], gC[2];
#pragma unroll
    for (int i = 0; i < 2; ++i) { int R, C; stage_rc(tid * 16 + i * 8192, R, C); gR[i] = R; gC[i] = C; coff[0][i] = coff[1][i] = noff[0][i] = noff[1][i] = 0u; }
#define PG8_GOFF(dst, pm_) do { if constexpr (GATHER) { _Pragma("unroll") for (int _h = 0; _h < 2; ++_h) _Pragma("unroll") for (int _i = 0; _i < 2; ++_i) \
        dst[_h][_i] = ((unsigned)g.tok[(pm_) * BM + _h * HALF + gR[_i]] * (unsigned)K + (unsigned)gC[_i]) * 2u; } } while (0)
    const size_t kstep = (size_t)(BK * 2), hstep = (size_t)HALF * K * 2, tstep = 2 * hstep;
    const unsigned ldsw = (unsigned)wid * 1024u;
    const int aoff = lds_byte(wr * 64 + fr, fq * 8);
    const int ldb = S.ldb();
    const size_t bkstep = (size_t)BK * ldb;
    const int q4 = (lane >> 2) & 3, p4 = lane & 3;
    const unsigned lo = SPLIT ? (unsigned)((lane >> 5) * ldb + 4 * (lane & 31)) * 4u : (unsigned)lane * 16u;
    const unsigned bwoff = SPLIT ? (unsigned)(8 * wid + (lane >> 5)) * PBI + (unsigned)(((4 * (lane & 31)) ^ ((wid & 1) << 6)) * 2)
                                 : (unsigned)(8 * wid) * PBI + (unsigned)(((4 * lane) ^ ((wid & 1) << 6)) * 2);
    unsigned broff[2][2];
#pragma unroll
    for (int n = 0; n < 2; ++n)
#pragma unroll
        for (int k = 0; k < 2; ++k) { const int row = 32 * k + 8 * fq + q4, col = 32 * wc + (Epi::PERM ? 8 * p4 + 4 * n : 16 * n + 4 * p4);
            broff[n][k] = (unsigned)row * PBI + (unsigned)((col ^ ((row & 8) << 3)) * 2); }
#define PG8_SA(b, h) (((b) * 2 + (h)) * HTB)
#define PG8_SBI(b) (4 * HTB + (b) * SBI_BYTES)
#define PG8_STAGE(bufoff, gbase, voff) do { _Pragma("unroll") for (int _i = 0; _i < 2; ++_i) \
        __builtin_amdgcn_global_load_lds((const unsigned*)((const char*)(gbase) + (voff)[_i]), (PG8_LAS unsigned*)(lds + (bufoff) + ldsw + _i * 8192), 16, 0, 0); } while (0)
#define PG8_STAGEA(bufoff, gptr, hh, kbytes, usenext) do { if constexpr (GATHER) { _Pragma("unroll") for (int _i = 0; _i < 2; ++_i) { const unsigned _o = (usenext) ? noff[hh][_i] : coff[hh][_i]; \
        __builtin_amdgcn_global_load_lds((const unsigned*)((const char*)g.A + (size_t)(kbytes) + _o), (PG8_LAS unsigned*)(lds + (bufoff) + ldsw + _i * 8192), 16, 0, 0); } } else { PG8_STAGE(bufoff, gptr, voffA); } } while (0)
#define PG8_LDA(dst, b, h) do { _Pragma("unroll") for (int m = 0; m < 4; ++m) _Pragma("unroll") for (int k = 0; k < 2; ++k) dst[m][k] = *(const PG8_LAS bf16x8*)(lds + PG8_SA(b, h) + aoff + m * 2048 + k * 1024); } while (0)
#define PG8_LDBT(dst, b, h) do { _Pragma("unroll") for (int n = 0; n < 2; ++n) _Pragma("unroll") for (int k = 0; k < 2; ++k) { \
        const PG8_LAS unsigned char* _a = lds + PG8_SBI(b) + broff[n][k] + (h) * 256; \
        const s16x4 _lo = __builtin_bit_cast(s16x4, __builtin_amdgcn_ds_read_tr16_b64_v4i16((PG8_LAS s16x4*)_a)), _hi = __builtin_bit_cast(s16x4, __builtin_amdgcn_ds_read_tr16_b64_v4i16((PG8_LAS s16x4*)(_a + 4 * PBI))); \
        dst[n][k] = __builtin_shufflevector(_lo, _hi, 0, 1, 2, 3, 4, 5, 6, 7); } } while (0)
#define PG8_BLOAD(p0, p1) do { _Pragma("unroll") for (int _i = 0; _i < 8; ++_i) { \
        const float* _u = SPLIT ? ((_i < 4 ? (p0) : (p1)) + (size_t)(8 * wid + 2 * (_i & 3)) * ldb) : ((p0) + (size_t)(8 * wid + _i) * ldb); \
        breg[_i] = *(const __attribute__((address_space(1))) f32x4*)((const char*)_u + lo); } } while (0)
#define PG8_BWRITE(b) do { _Pragma("unroll") for (int _i = 0; _i < 8; ++_i) { u32x2 _w; _w.x = cvt_pk_bf16(breg[_i][0], breg[_i][1]); _w.y = cvt_pk_bf16(breg[_i][2], breg[_i][3]); \
        *(PG8_LAS u32x2*)(lds + PG8_SBI(b) + bwoff + (SPLIT ? (2 * (_i & 3)) * PBI + (_i >> 2) * 256 : _i * PBI)) = _w; } } while (0)
#define PG8_MMA(ai, bj, At, Bt) do { __builtin_amdgcn_s_setprio(1); _Pragma("unroll") for (int m = 0; m < 4; ++m) _Pragma("unroll") for (int n = 0; n < 2; ++n) _Pragma("unroll") for (int k = 0; k < 2; ++k) \
        acc[ai][bj][m][n] = __builtin_amdgcn_mfma_f32_16x16x32_bf16(Bt[n][k], At[m][k], acc[ai][bj][m][n], 0, 0, 0); __builtin_amdgcn_s_setprio(0); } while (0)
#define PG8_WAIT_V(n) asm volatile("s_waitcnt vmcnt(" #n ")" ::: "memory")
#define PG8_WAIT_L(n) asm volatile("s_waitcnt lgkmcnt(" #n ")" ::: "memory")
#define PG8_BAR __builtin_amdgcn_s_barrier()
#define PG8_SCHED __builtin_amdgcn_sched_barrier(0)
    typedef short s16x4 __attribute__((ext_vector_type(4)));
    typedef unsigned u32x2 __attribute__((ext_vector_type(2)));
    Unit cur, nxt; int ui = 0;
    if (!S.next(0, cur)) return;
    f32x4 acc[2][2][4][2];
#pragma unroll
    for (int a = 0; a < 2; ++a)
#pragma unroll
        for (int b = 0; b < 2; ++b)
#pragma unroll
            for (int m = 0; m < 4; ++m)
#pragma unroll
                for (int n = 0; n < 2; ++n) acc[a][b][m][n] = (f32x4){0.f, 0.f, 0.f, 0.f};
    bf16x8 At[4][2], B0[2][2];
    f32x4 breg[8];
    const char* cA = (const char*)g.A + (size_t)cur.pm * tstep; const float* cB0 = S.bbase(cur, 0); const float* cB1 = S.bbase(cur, 1);
    PG8_GOFF(coff, cur.pm);
    PG8_BLOAD(cB0, cB1); PG8_STAGEA(PG8_SA(0, 0), cA, 0, 0, false); PG8_STAGEA(PG8_SA(0, 1), cA + hstep, 1, 0, false);
    PG8_BWRITE(0); PG8_SCHED;
    if (wr == 1) PG8_BAR;
    PG8_WAIT_V(2); PG8_WAIT_L(0); PG8_BAR;
    PG8_BLOAD(cB0 + bkstep, cB1 + bkstep); PG8_STAGEA(PG8_SA(1, 0), cA + kstep, 0, kstep, false); PG8_SCHED;
    PG8_WAIT_V(10); PG8_BAR;
    for (;;) {
        const bool has_next = S.next(ui + 1, nxt);
        const char* nA = has_next ? (const char*)g.A + (size_t)nxt.pm * tstep : cA; const float* nB0 = has_next ? S.bbase(nxt, 0) : cB0; const float* nB1 = has_next ? S.bbase(nxt, 1) : cB1;
        if constexpr (GATHER) { if (has_next) { PG8_GOFF(noff, nxt.pm); } else { _Pragma("unroll") for (int _h = 0; _h < 2; ++_h) _Pragma("unroll") for (int _i = 0; _i < 2; ++_i) noff[_h][_i] = coff[_h][_i]; } }
        for (int t = 0; t < nt; t += 2) {
            const bool last = (t == nt - 2);
            const char* a1 = cA + (size_t)(t + 1) * kstep;
            const char* a2 = last ? nA : cA + (size_t)(t + 2) * kstep; const float* b20 = last ? nB0 : cB0 + (size_t)(t + 2) * bkstep; const float* b21 = last ? nB1 : cB1 + (size_t)(t + 2) * bkstep;
            const char* a3 = a2 + kstep; const float* b30 = b20 + bkstep; const float* b31 = b21 + bkstep;
            const size_t k1 = (size_t)(t + 1) * kstep, k2 = last ? 0 : (size_t)(t + 2) * kstep, k3 = k2 + kstep;
            PG8_LDBT(B0, 0, 0); PG8_SCHED; PG8_LDA(At, 0, 0); PG8_STAGEA(PG8_SA(1, 1), a1 + hstep, 1, k1, false);
            PG8_WAIT_V(12); PG8_WAIT_L(0); PG8_BAR; PG8_MMA(0, 0, At, B0); PG8_LDBT(B0, 0, 1); PG8_WAIT_L(0); PG8_SCHED; PG8_MMA(0, 1, At, B0); PG8_BAR; PG8_SCHED;
            PG8_BWRITE(1); PG8_BLOAD(b20, b21); PG8_SCHED; PG8_LDBT(B0, 0, 0); PG8_LDA(At, 0, 1); PG8_STAGEA(PG8_SA(0, 0), a2, 0, k2, last);
            PG8_WAIT_V(12); PG8_WAIT_L(0); PG8_BAR; PG8_MMA(1, 0, At, B0); PG8_LDBT(B0, 0, 1); PG8_WAIT_L(0); PG8_SCHED; PG8_MMA(1, 1, At, B0); PG8_BAR; PG8_SCHED;
            PG8_LDBT(B0, 1, 0); PG8_SCHED; PG8_LDA(At, 1, 0); PG8_STAGEA(PG8_SA(0, 1), a2 + hstep, 1, k2, last);
            PG8_WAIT_V(12); PG8_WAIT_L(0); PG8_BAR; PG8_MMA(0, 0, At, B0); PG8_LDBT(B0, 1, 1); PG8_WAIT_L(0); PG8_SCHED; PG8_MMA(0, 1, At, B0); PG8_BAR; PG8_SCHED;
            PG8_BWRITE(0); PG8_BLOAD(b30, b31); PG8_SCHED; PG8_LDBT(B0, 1, 0); PG8_LDA(At, 1, 1); PG8_STAGEA(PG8_SA(1, 0), a3, 0, k3, last);
            PG8_WAIT_V(12); PG8_WAIT_L(0); PG8_BAR; PG8_MMA(1, 0, At, B0); PG8_LDBT(B0, 1, 1); PG8_WAIT_L(0); PG8_SCHED; PG8_MMA(1, 1, At, B0); PG8_BAR; PG8_SCHED;
        }
        if constexpr (ALIGN_EPI) { if (wr == 0) PG8_BAR; }
        E(acc, cur, wr, wc, fr, fq); S.done(cur);
        if (!has_next) break;
#pragma unroll
        for (int a = 0; a < 2; ++a)
#pragma unroll
            for (int b = 0; b < 2; ++b)
#pragma unroll
                for (int m = 0; m < 4; ++m)
#pragma unroll
                    for (int n = 0; n < 2; ++n) acc[a][b][m][n] = (f32x4){0.f, 0.f, 0.f, 0.f};
        cur = nxt; cA = nA; cB0 = nB0; cB1 = nB1; ++ui;
        if constexpr (GATHER) { _Pragma("unroll") for (int _h = 0; _h < 2; ++_h) _Pragma("unroll") for (int _i = 0; _i < 2; ++_i) coff[_h][_i] = noff[_h][_i]; }
        if constexpr (ALIGN_EPI) { if (wr == 1) PG8_BAR; }
    }
    PG8_WAIT_V(0);
    asm volatile("" :: "v"(breg[0]), "v"(breg[1]), "v"(breg[2]), "v"(breg[3]), "v"(breg[4]), "v"(breg[5]), "v"(breg[6]), "v"(breg[7]));
    if constexpr (!ALIGN_EPI) { if (wr == 0) PG8_BAR; }
    PG8_BAR;
#undef PG8_SA
#undef PG8_SBI
#undef PG8_STAGE
#undef PG8_STAGEA
#undef PG8_GOFF
#undef PG8_LDA
#undef PG8_LDBT
#undef PG8_BLOAD
#undef PG8_BWRITE
#undef PG8_MMA
#undef PG8_WAIT_V
#undef PG8_WAIT_L
#undef PG8_BAR
#undef PG8_SCHED
}
}

constexpr int NWAVES = 8, NTHR = 512;
constexpr int T = 8192, D = 2048, HW = 7168, INW = 7184, MEMN = 256;
constexpr float LN_EPS = 1e-5f;
constexpr float ALPHA = 1.189207115002721f;
constexpr int NPH = 16;
#ifndef MK_MOE_BNT
#define MK_MOE_BNT false
#endif
#ifndef MK_ALIGN1
#define MK_ALIGN1 true
#endif
#ifndef MK_FUSE_LN1
#define MK_FUSE_LN1 0
#endif
#ifndef MK_NSG
#define MK_NSG 9
#endif
constexpr int NSG = MK_NSG;
constexpr int PMAX = 24576;

constexpr size_t MiB = 1u << 20;
constexpr size_t WS_CTL = 0, CTL_ZERO_BYTES = 64 * 1024;
constexpr size_t WS_WMIX = 2 * MiB, WS_WMQ = 10 * MiB, WS_WIN = 18 * MiB, WS_WKV = 46 * MiB, WS_WMO = 62 * MiB, WS_WGU = 70 * MiB, WS_WD = 198 * MiB;
constexpr size_t WS_XB = 262 * MiB, WS_MEMB = 294 * MiB;
constexpr size_t WS_H = 296 * MiB;
constexpr size_t WS_KVM = 408 * MiB;
constexpr size_t WS_ORAW = 410 * MiB;
constexpr size_t WS_MIXED = WS_XB;
constexpr size_t WS_Y1 = WS_ORAW;
constexpr size_t WS_H1B = WS_H;
constexpr size_t WS_QB = 328 * MiB, WS_ATT = 360 * MiB;
constexpr size_t WS_Y2 = 474 * MiB;
constexpr size_t WS_H2B = WS_H;
constexpr size_t WS_XS = 328 * MiB;
constexpr size_t WS_HID = 424 * MiB;
constexpr size_t WS_YS = WS_XS;
constexpr size_t WS_SMALL = 540 * MiB;
constexpr size_t WS_GLR = WS_SMALL;
constexpr size_t WS_RC = WS_SMALL + 1 * MiB, WS_RS = WS_SMALL + 5 * MiB;
constexpr size_t WS_ST1 = WS_SMALL + 9 * MiB, WS_ST2 = WS_ST1 + 65536;
constexpr size_t WS_EXP = WS_ST2 + 65536, WS_GATE = WS_EXP + 65536, WS_POS = WS_GATE + 65536, WS_SLOT = WS_POS + 65536, WS_TOK = WS_SLOT + 65536;
constexpr size_t WS_XCH1 = WS_SMALL + 10 * MiB, WS_XCH2 = WS_XCH1 + 512 * 1024;
constexpr size_t WS_TOKS = WS_SMALL + 10 * MiB;
constexpr size_t WS_WRT = WS_SMALL + 11 * MiB;
constexpr size_t WS_END = 552 * MiB;
constexpr int CW_CNT = 64, CW_CUR = 128, CW_Q = 192;
constexpr int CW_BAR = 4096;
constexpr int CW_LN1 = 8192, CW_LN2 = 10240;

constexpr int RING_BYTES = 139264, LDSCTL_OFF = RING_BYTES, MISC_OFF = LDSCTL_OFF + 320, LDS_BYTES = 147456;

#define GAS __attribute__((address_space(1)))
#define LAS __attribute__((address_space(3)))
typedef unsigned short bf16;
typedef unsigned v4u __attribute__((ext_vector_type(4)));
typedef unsigned v2u __attribute__((ext_vector_type(2)));
typedef float f32x4 __attribute__((ext_vector_type(4)));
typedef GAS unsigned gu32;
#define RLX_AGENT __ATOMIC_RELAXED, __HIP_MEMORY_SCOPE_AGENT
#define LDS_WAIT() asm volatile("s_waitcnt lgkmcnt(0)" ::: "memory")
__device__ __forceinline__ unsigned f2bf(float f) { unsigned u = __builtin_bit_cast(unsigned, f); return (u + 0x7fffu + ((u >> 16) & 1u)) >> 16; }
__device__ __forceinline__ unsigned pk2(float lo, float hi) { return f2bf(lo) | (f2bf(hi) << 16); }
__device__ __forceinline__ float bf2f(unsigned h) { return __builtin_bit_cast(float, h << 16); }
__device__ __forceinline__ float bflo(unsigned w) { return __builtin_bit_cast(float, w << 16); }
__device__ __forceinline__ float bfhi(unsigned w) { return __builtin_bit_cast(float, w & 0xffff0000u); }
__device__ __forceinline__ float wave_sum(float v) {
#pragma unroll
    for (int o = 1; o < 64; o <<= 1) v += __shfl_xor(v, o);
    return v;
}
__device__ __forceinline__ float wave_max(float v) {
#pragma unroll
    for (int o = 1; o < 64; o <<= 1) v = fmaxf(v, __shfl_xor(v, o));
    return v;
}

struct Frame {
    LAS unsigned char* lds;
    volatile LAS unsigned* MISC;
    gu32* ctl;
    int tid, lane, wave, G, bid;
    unsigned char* ws;
    const float* in[25];
    float* out;
};
#define WSP(T_, off) ((T_*)(F.ws + (off)))

template <bool NTST>
__device__ __forceinline__ void transpose_item(const float* W, int ldw, bf16* WTr, int ldt, LAS float* scr, int lane) {
    float tv[32];
#pragma unroll
    for (int i = 0; i < 32; ++i) tv[i] = __builtin_nontemporal_load(W + (size_t)(2 * i + (lane >> 5)) * ldw + (lane & 31));
#pragma unroll
    for (int i = 0; i < 32; ++i) scr[(2 * i + (lane >> 5)) * 33 + (lane & 31)] = tv[i];
    LDS_WAIT(); asm volatile("" ::: "memory");
    const int c = lane & 7;
#pragma unroll
    for (int j = 0; j < 4; ++j) { const int n = (lane >> 3) + 8 * j; const LAS float* s = scr + (8 * c) * 33 + n;
        v4u o; o.x = pk2(s[0 * 33], s[1 * 33]); o.y = pk2(s[2 * 33], s[3 * 33]); o.z = pk2(s[4 * 33], s[5 * 33]); o.w = pk2(s[6 * 33], s[7 * 33]);
        if (NTST) __builtin_nontemporal_store(o, (GAS v4u*)(WTr + (size_t)n * ldt + 8 * c)); else *(GAS v4u*)(WTr + (size_t)n * ldt + 8 * c) = o; }
    LDS_WAIT(); asm volatile("" ::: "memory");
}
__device__ __forceinline__ void p0_prologue(Frame& F) {
    LAS float* scr = (LAS float*)(F.lds + F.wave * 16384);
    const int gw = F.bid * NWAVES + F.wave, NGW = F.G * NWAVES;
    const float* w_in = F.in[3];
    constexpr int I_IN = 32 * 224, I_SQ = 32 * 64;
    for (int it = gw; it < I_IN + 2 * I_SQ; it += NGW) {
        int r = it;
        if (r < I_IN) { const int kb = r / 224, nb = r % 224; transpose_item<false>(w_in + (size_t)(64 * kb) * INW + 32 * nb, INW, WSP(bf16, WS_WIN) + (size_t)(32 * nb) * 2048 + 64 * kb, 2048, scr, F.lane); continue; }
        r -= I_IN;
        { const int w = r / I_SQ, q = r % I_SQ, kb = q / 64, nb = q % 64;
          const float* src = F.in[11]; if (w) src = F.in[12];
          bf16* dst = WSP(bf16, WS_WKV) + (size_t)w * 2048 * 2048;
          transpose_item<false>(src + (size_t)(64 * kb) * 2048 + 32 * nb, 2048, dst + (size_t)(32 * nb) * 2048 + 64 * kb, 2048, scr, F.lane); }
    }
    const int gt = F.bid * NTHR + F.tid, NGT = F.G * NTHR;
    {
        const float* x = F.in[0]; bf16* xb = WSP(bf16, WS_XB);
        for (int item = F.bid; item < T / 32; item += F.G) {
            const size_t base = (size_t)item * 32 * D / 8;
#pragma unroll 1
            for (int c0 = 0; c0 < 16; c0 += 4) { f32x4 a[4], b[4];
#pragma unroll
                for (int u = 0; u < 4; ++u) { const size_t i = base + (size_t)(c0 + u) * NTHR + F.tid; a[u] = *(const GAS f32x4*)(x + i * 8); b[u] = *(const GAS f32x4*)(x + i * 8 + 4); }
#pragma unroll
                for (int u = 0; u < 4; ++u) { const size_t i = base + (size_t)(c0 + u) * NTHR + F.tid;
                    v4u o; o.x = pk2(a[u][0], a[u][1]); o.y = pk2(a[u][2], a[u][3]); o.z = pk2(b[u][0], b[u][1]); o.w = pk2(b[u][2], b[u][3]); *(GAS v4u*)(xb + i * 8) = o; } }
        }
        const float* mm = F.in[1]; bf16* mb = WSP(bf16, WS_MEMB);
        for (int i = gt; i < MEMN * D / 8; i += NGT) { const f32x4 a = *(const GAS f32x4*)(mm + (size_t)i * 8), b = *(const GAS f32x4*)(mm + (size_t)i * 8 + 4);
            v4u o; o.x = pk2(a[0], a[1]); o.y = pk2(a[2], a[3]); o.z = pk2(b[0], b[1]); o.w = pk2(b[2], b[3]); *(GAS v4u*)(mb + (size_t)i * 8) = o; }
    }
    {
        const int* pos = (const int*)F.in[2]; float* rc = WSP(float, WS_RC); float* rs = WSP(float, WS_RS);
        for (int i = gt; i < T * 128; i += NGT) { const int t = i >> 7, f = i & 127;
            const float inv = exp2f(-(float)f * (13.287712379549449f / 128.0f));
            const float ang = (float)pos[t] * inv;
            double rev = (double)ang * 0.15915494309189535; rev -= floor(rev);
            const float rf = (float)rev;
            rc[i] = __builtin_amdgcn_cosf(rf); rs[i] = __builtin_amdgcn_sinf(rf); }
    }
    { v4u* tz = WSP(v4u, WS_TOKS); v4u z; z.x = z.y = z.z = z.w = 0u; for (int i = gt; i < 32 * 8192 / 4; i += NGT) tz[i] = z; }
    {
        bf16* wrt = WSP(bf16, WS_WRT); const float* Wg_ = F.in[16]; const float* We_ = F.in[18];
        for (int i = gt; i < 48 * 2048; i += NGT) { const int c = (i >> 3) % 48, k = ((i >> 3) / 48) * 8 + (i & 7);
            float w = 0.f; if (c < 32) w = We_[(size_t)k * 32 + c]; else if (c < 36) w = Wg_[(size_t)k * 4 + (c - 32)];
            const unsigned hi = f2bf(w), lo = f2bf(w - bf2f(hi));
            wrt[i] = (bf16)hi; wrt[48 * 2048 + i] = (bf16)lo; }
    }
    {
        const float* x = F.in[0]; float* glr = WSP(float, WS_GLR);
        const int r16 = F.lane & 15, g4 = F.lane >> 4;
        LAS float* part = (LAS float*)F.lds;
        for (int item = F.bid; item < T / 32; item += F.G) {
            const int tile = 2 * item + (F.wave >> 2), kq = F.wave & 3;
            f32x4 acc = {0.f, 0.f, 0.f, 0.f};
            const float* xr = x + (size_t)(tile * 16 + r16) * D + 512 * kq + 4 * g4;
            const float* wr = w_in + (size_t)(512 * kq + 4 * g4) * INW + HW + r16;
#pragma unroll 8
            for (int k0 = 0; k0 < 512; k0 += 16) {
                const f32x4 a = *(const GAS f32x4*)(xr + k0);
                const float b0 = wr[(size_t)(k0 + 0) * INW], b1 = wr[(size_t)(k0 + 1) * INW], b2 = wr[(size_t)(k0 + 2) * INW], b3 = wr[(size_t)(k0 + 3) * INW];
                acc = __builtin_amdgcn_mfma_f32_16x16x4f32(a[0], b0, acc, 0, 0, 0);
                acc = __builtin_amdgcn_mfma_f32_16x16x4f32(a[1], b1, acc, 0, 0, 0);
                acc = __builtin_amdgcn_mfma_f32_16x16x4f32(a[2], b2, acc, 0, 0, 0);
                acc = __builtin_amdgcn_mfma_f32_16x16x4f32(a[3], b3, acc, 0, 0, 0);
            }
            __syncthreads();
            *(LAS f32x4*)(part + (F.wave * 64 + F.lane) * 4) = acc;
            __syncthreads();
            if (F.tid < 128) { const int tl = F.tid >> 6, ln = F.tid & 63;
                f32x4 s = *(const LAS f32x4*)(part + ((tl * 4 + 0) * 64 + ln) * 4);
#pragma unroll
                for (int q = 1; q < 4; ++q) s += *(const LAS f32x4*)(part + ((tl * 4 + q) * 64 + ln) * 4);
#pragma unroll
                for (int j = 0; j < 4; ++j) glr[(size_t)((2 * item + tl) * 16 + 4 * (ln >> 4) + j) * 16 + (ln & 15)] = s[j]; }
        }
        __syncthreads();
    }
}
__device__ __forceinline__ void transpose_queue(Frame& F, int qsel = 0) {
    LAS float* scr = (LAS float*)(F.lds + F.wave * 16384);
    const float* const i7 = F.in[7]; const float* const i10 = F.in[10]; const float* const i13 = F.in[13]; const float* const i20 = F.in[20]; const float* const i21 = F.in[21]; const float* const i22 = F.in[22];
    constexpr int I_SQ = 32 * 64, I_E = 512, NQ = 3 * I_SQ + (MK_MOE_F32 ? 0 : 3 * 32 * I_E);
    for (;;) {
        unsigned b0 = 0;
        if (F.lane == 0) b0 = __hip_atomic_fetch_add((unsigned*)(F.ctl + CW_Q + 64 * qsel), 16u, __ATOMIC_RELAXED, __HIP_MEMORY_SCOPE_AGENT);
        b0 = __builtin_amdgcn_readfirstlane(b0);
        if (b0 >= (unsigned)NQ) break;
        for (int it = (int)b0; it < (int)b0 + 16 && it < NQ; ++it) {
            int r = it;
            if (r < 3 * I_SQ) { const int w = r / I_SQ, q = r % I_SQ, kb = q / 64, nb = q % 64;
                const float* src = i7; size_t doff = WS_WMIX; if (w == 1) { src = i10; doff = WS_WMQ; } if (w == 2) { src = i13; doff = WS_WMO; }
                bf16* dst = (bf16*)(F.ws + doff);
                transpose_item<true>(src + (size_t)(64 * kb) * 2048 + 32 * nb, 2048, dst + (size_t)(32 * nb) * 2048 + 64 * kb, 2048, scr, F.lane); continue; }
            r -= 3 * I_SQ;
            if (r < 2 * 32 * I_E) {
                const int up = r / (32 * I_E), q = r % (32 * I_E), e = q / I_E, q2 = q % I_E, kb = q2 / 16, nb = q2 % 16, n0 = 32 * nb;
                const float* sb = i20; if (up) sb = i21;
                const float* src = sb + (size_t)e * 2048 * 512 + (size_t)(64 * kb) * 512 + n0;
                bf16* dst = WSP(bf16, WS_WGU) + (size_t)(e * 1024 + (n0 >> 7) * 256 + up * 128 + (n0 & 127)) * 2048 + 64 * kb;
                transpose_item<true>(src, 512, dst, 2048, scr, F.lane); continue; }
            r -= 2 * 32 * I_E;
            {
                const int e = r / I_E, q2 = r % I_E, kb = q2 / 64, nb = q2 % 64;
                const float* src = i22 + (size_t)e * 512 * 2048 + (size_t)(64 * kb) * 2048 + 32 * nb;
                bf16* dst = WSP(bf16, WS_WD) + (size_t)(e * 2048 + 32 * nb) * 512 + 64 * kb;
                transpose_item<true>(src, 2048, dst, 512, scr, F.lane); }
        }
    }
}

__device__ __forceinline__ float log_sigmoid_f(float z) { return fminf(z, 0.f) - log1pf(expf(-fabsf(z))); }
template <bool GLA>
__device__ __forceinline__ void mixer_naive_item(Frame& F, int hh, int eg) {
    constexpr int ND = GLA ? 4 : 8;
    const bf16* H = WSP(bf16, WS_H); float* oraw = WSP(float, WS_ORAW);
    const int ei = F.tid & 15, dp = F.tid >> 4, e = eg * 16 + ei;
    const int qcol = GLA ? 4096 + hh * 128 : hh * 256, kcol = GLA ? 4608 + hh * 128 : 1024 + hh * 256, vcol = (GLA ? 5120 : 2048) + hh * 256 + e;
    const int ocol = (GLA ? 1024 : 0) + hh * 256 + eg * 16;
    LAS float* red = (LAS float*)F.lds;
    float S[ND];
#pragma unroll
    for (int i = 0; i < ND; ++i) S[i] = 0.f;
    float wa[GLA ? 4 : 1][16]; float ba[GLA ? 4 : 1];
    if (GLA) {
#pragma unroll
        for (int i = 0; i < 4; ++i) { const int d = dp + 32 * i; ba[i] = F.in[5][hh * 128 + d];
#pragma unroll
            for (int r = 0; r < 16; ++r) wa[i][r] = F.in[4][r * 512 + hh * 128 + d]; }
    }
    const float gamma = 1.0f - exp2f(-5.0f - (float)hh);
    const float* glr = WSP(float, WS_GLR);
    for (int t0 = 0; t0 < T; t0 += 8) {
        float part[8];
#pragma unroll
        for (int tt = 0; tt < 8; ++tt) {
            const int t = t0 + tt; const bf16* hr = H + (size_t)t * HW;
            const float v = bf2f(hr[vcol]);
            float g16[16];
            if (GLA) {
#pragma unroll
                for (int r = 0; r < 16; ++r) g16[r] = glr[t * 16 + r];
            }
            float p = 0.f;
#pragma unroll
            for (int i = 0; i < ND; ++i) { const int d = dp + 32 * i;
                const float q = bf2f(hr[qcol + d]), k = bf2f(hr[kcol + d]);
                float a = gamma;
                if (GLA) { float z = ba[i];
#pragma unroll
                    for (int r = 0; r < 16; ++r) z += g16[r] * wa[i][r];
                    a = expf(log_sigmoid_f(z) * 0.0625f); }
                S[i] = a * S[i] + k * v; p += q * S[i]; }
            p += __shfl_xor(p, 16); p += __shfl_xor(p, 32);
            part[tt] = p;
        }
        if (F.lane < 16) {
#pragma unroll
            for (int tt = 0; tt < 8; ++tt) red[(F.wave * 8 + tt) * 16 + F.lane] = part[tt];
        }
        __syncthreads();
        if (F.tid < 128) { const int tt = F.tid >> 4, e2 = F.tid & 15; float s = 0.f;
#pragma unroll
            for (int w = 0; w < 8; ++w) s += red[(w * 8 + tt) * 16 + e2];
            oraw[(size_t)(t0 + tt) * D + ocol + e2] = s; }
        __syncthreads();
    }
}
__device__ __forceinline__ void p2_mixer_naive(Frame& F) {
    for (int item = F.bid; item < 128; item += F.G) {
        const int h8 = item >> 4, eg = item & 15;
        if (h8 < 4) mixer_naive_item<false>(F, h8, eg); else mixer_naive_item<true>(F, h8 - 4, eg);
    }
}
__device__ __forceinline__ void p3_normgate(Frame& F) {
    const bf16* H = WSP(bf16, WS_H); const float* oraw = WSP(float, WS_ORAW); bf16* mixed = WSP(bf16, WS_MIXED);
    const int gw = F.bid * NWAVES + F.wave, NGW = F.G * NWAVES;
    const f32x4 gn = *(const f32x4*)(F.in[6] + 4 * F.lane);
    for (int t = gw; t < T; t += NGW) {
#pragma unroll
        for (int h8 = 0; h8 < 8; ++h8) {
            const f32x4 o = *(const GAS f32x4*)(oraw + (size_t)t * D + h8 * 256 + 4 * F.lane);
            const int gcol = (h8 < 4 ? 3072 : 6144) + (h8 & 3) * 256 + 4 * F.lane;
            const v2u gw2 = *(const GAS v2u*)(H + (size_t)t * HW + gcol);
            const f32x4 gt = {bflo(gw2.x), bfhi(gw2.x), bflo(gw2.y), bfhi(gw2.y)};
            f32x4 y;
            if (h8 < 4) {
                const float mu = wave_sum((o[0] + o[1]) + (o[2] + o[3])) * (1.f / 256.f);
                const f32x4 dd = o - mu;
                const float var = wave_sum((dd[0] * dd[0] + dd[1] * dd[1]) + (dd[2] * dd[2] + dd[3] * dd[3])) * (1.f / 256.f);
                y = dd * (1.0f / sqrtf(var + LN_EPS));
            } else {
                const float ms = wave_sum((o[0] * o[0] + o[1] * o[1]) + (o[2] * o[2] + o[3] * o[3])) * (1.f / 256.f);
                y = o * (1.0f / sqrtf(ms + LN_EPS)) * gn;
            }
            float r[4];
#pragma unroll
            for (int i = 0; i < 4; ++i) { const float g = gt[i]; r[i] = g / (1.0f + expf(-g)) * y[i]; }
            v2u w; w.x = pk2(r[0], r[1]); w.y = pk2(r[2], r[3]);
            *(GAS v2u*)(mixed + (size_t)t * D + h8 * 256 + 4 * F.lane) = w;
        }
    }
}
__device__ __forceinline__ void ln_apply_plain(Frame& F, const float* Y, const float* g, const float* b, bf16* HB, float* st) {
    const int gw = F.bid * NWAVES + F.wave, NGW = F.G * NWAVES;
    f32x4 cur[8];
    if (gw < T) { const GAS f32x4* yr = (const GAS f32x4*)(Y + (size_t)gw * D) + F.lane;
#pragma unroll
        for (int j = 0; j < 8; ++j) cur[j] = yr[64 * j]; }
    for (int t = gw; t < T; t += NGW) {
        f32x4 nxt[8];
        { const int tn = t + NGW < T ? t + NGW : t; const GAS f32x4* yr = (const GAS f32x4*)(Y + (size_t)tn * D) + F.lane;
#pragma unroll
          for (int j = 0; j < 8; ++j) nxt[j] = yr[64 * j]; }
        f32x4 v[8]; float s = 0.f;
#pragma unroll
        for (int j = 0; j < 8; ++j) { v[j] = cur[j]; s += (v[j][0] + v[j][1]) + (v[j][2] + v[j][3]); }
        const float mean = wave_sum(s) * (1.f / D); float s2 = 0.f;
#pragma unroll
        for (int j = 0; j < 8; ++j) { v[j] = v[j] - mean; s2 += (v[j][0] * v[j][0] + v[j][1] * v[j][1]) + (v[j][2] * v[j][2] + v[j][3] * v[j][3]); }
        const float rstd = 1.f / sqrtf(wave_sum(s2) * (1.f / D) + LN_EPS);
        if (F.lane == 0) { st[2 * t] = mean; st[2 * t + 1] = rstd; }
        GAS v2u* o8 = (GAS v2u*)(HB + (size_t)t * D) + F.lane;
#pragma unroll
        for (int j = 0; j < 8; ++j) { const f32x4 gv = *(const f32x4*)(g + 4 * F.lane + 256 * j), bv = *(const f32x4*)(b + 4 * F.lane + 256 * j);
            v[j] = v[j] * rstd * gv + bv;
            v2u w; w.x = pk2(v[j][0], v[j][1]); w.y = pk2(v[j][2], v[j][3]); o8[64 * j] = w; }
#pragma unroll
        for (int j = 0; j < 8; ++j) cur[j] = nxt[j];
    }
}
template <bool ROUTER>
__device__ __forceinline__ void ln_apply(Frame& F, const float* Y, const float* g, const float* b, bf16* HB, float* st, bool count = true) {
    const int gw = F.bid * NWAVES + F.wave, NGW = F.G * NWAVES;
    for (int t = gw; t < T; t += NGW) {
        const GAS f32x4* yr = (const GAS f32x4*)(Y + (size_t)t * D) + F.lane;
        f32x4 v[8]; float s = 0.f;
#pragma unroll
        for (int j = 0; j < 8; ++j) { v[j] = yr[64 * j]; s += (v[j][0] + v[j][1]) + (v[j][2] + v[j][3]); }
        const float mean = wave_sum(s) * (1.f / D); float s2 = 0.f;
#pragma unroll
        for (int j = 0; j < 8; ++j) { v[j] = v[j] - mean; s2 += (v[j][0] * v[j][0] + v[j][1] * v[j][1]) + (v[j][2] * v[j][2] + v[j][3] * v[j][3]); }
        const float rstd = 1.f / sqrtf(wave_sum(s2) * (1.f / D) + LN_EPS);
        if (F.lane == 0) { st[2 * t] = mean; st[2 * t + 1] = rstd; }
        GAS v2u* o8 = (GAS v2u*)(HB + (size_t)t * D) + F.lane;
#pragma unroll
        for (int j = 0; j < 8; ++j) { const f32x4 gv = *(const f32x4*)(g + 4 * F.lane + 256 * j), bv = *(const f32x4*)(b + 4 * F.lane + 256 * j);
            v[j] = v[j] * rstd * gv + bv;
            v2u w; w.x = pk2(v[j][0], v[j][1]); w.y = pk2(v[j][2], v[j][3]); o8[64 * j] = w; }
        if (ROUTER) {
            const float* Wg = F.in[16]; const float* We = F.in[18];
            float lg[4], le[32];
#pragma unroll
            for (int i = 0; i < 4; ++i) lg[i] = 0.f;
#pragma unroll
            for (int i = 0; i < 32; ++i) le[i] = 0.f;
#pragma unroll
            for (int j = 0; j < 8; ++j) {
#pragma unroll
                for (int i = 0; i < 4; ++i) { const int c = 4 * F.lane + 256 * j + i; const float hv = v[j][i];
                    const f32x4 wg = *(const GAS f32x4*)(Wg + (size_t)c * 4);
#pragma unroll
                    for (int q = 0; q < 4; ++q) lg[q] += hv * wg[q];
#pragma unroll
                    for (int q8 = 0; q8 < 8; ++q8) { const f32x4 we = *(const GAS f32x4*)(We + (size_t)c * 32 + 4 * q8);
#pragma unroll
                        for (int q = 0; q < 4; ++q) le[4 * q8 + q] += hv * we[q]; } }
            }
#pragma unroll
            for (int i = 0; i < 4; ++i) lg[i] = wave_sum(lg[i]) + F.in[17][i];
#pragma unroll
            for (int i = 0; i < 32; ++i) le[i] = wave_sum(le[i]);
            int grp = 0; float gm = lg[0];
#pragma unroll
            for (int i = 1; i < 4; ++i) if (lg[i] > gm) { gm = lg[i]; grp = i; }
            float gs = 0.f;
#pragma unroll
            for (int i = 0; i < 4; ++i) gs += expf(lg[i] - gm);
            const float pg_sel = 1.0f / gs;
            float fe[8];
#pragma unroll
            for (int j = 0; j < 8; ++j) { const float a = grp == 0 ? le[j] : grp == 1 ? le[8 + j] : grp == 2 ? le[16 + j] : le[24 + j]; fe[j] = a + F.in[19][grp * 8 + j]; }
            int i1 = 0; float m1 = fe[0];
#pragma unroll
            for (int j = 1; j < 8; ++j) if (fe[j] > m1) { m1 = fe[j]; i1 = j; }
            int i2 = -1; float m2 = -3.0e38f;
#pragma unroll
            for (int j = 0; j < 8; ++j) if (j != i1 && fe[j] > m2) { m2 = fe[j]; i2 = j; }
            const float p2 = expf(m2 - m1), den = 1.0f / (1.0f + p2);
            if (F.lane == 0) {
                int* ex = WSP(int, WS_EXP); float* gt = WSP(float, WS_GATE);
                const int e1 = grp * 8 + i1, e2 = grp * 8 + i2;
                ex[2 * t] = e1; ex[2 * t + 1] = e2; gt[2 * t] = pg_sel * den; gt[2 * t + 1] = pg_sel * p2 * den;
                if (count) { atomicAdd((unsigned*)(F.ctl + CW_CNT) + e1, 1u); atomicAdd((unsigned*)(F.ctl + CW_CNT) + e2, 1u); }
            }
        }
    }
}
__device__ __forceinline__ void p7_attn_naive(Frame& F) {
    const bf16* Q = WSP(bf16, WS_QB); const bf16* KVM = WSP(bf16, WS_KVM); bf16* att = WSP(bf16, WS_ATT);
    LAS float* qs = (LAS float*)F.lds;
    LAS float* sc = (LAS float*)(F.lds + 16384);
    for (int item = F.bid; item < (T / 8) * 4; item += F.G) {
        const int h = item & 3, t0 = (item >> 2) * 8;
        for (int i = F.tid; i < 8 * 512; i += NTHR) { const int tt = i >> 9, d = i & 511; qs[i] = bf2f(Q[(size_t)(t0 + tt) * D + h * 512 + d]); }
        __syncthreads();
        {
            const int j = F.tid & 255, th = F.tid >> 8;
            const bf16* kr = KVM + (size_t)j * 4096 + h * 512;
            float a0 = 0.f, a1 = 0.f, a2 = 0.f, a3 = 0.f;
            for (int d = 0; d < 512; d += 8) {
                const v4u kw = *(const GAS v4u*)(kr + d);
                const float kf[8] = {bflo(kw.x), bfhi(kw.x), bflo(kw.y), bfhi(kw.y), bflo(kw.z), bfhi(kw.z), bflo(kw.w), bfhi(kw.w)};
#pragma unroll
                for (int i = 0; i < 8; ++i) { a0 += kf[i] * qs[(th * 4 + 0) * 512 + d + i]; a1 += kf[i] * qs[(th * 4 + 1) * 512 + d + i]; a2 += kf[i] * qs[(th * 4 + 2) * 512 + d + i]; a3 += kf[i] * qs[(th * 4 + 3) * 512 + d + i]; }
            }
            const float scl = 0.04419417382415922f;
            sc[(th * 4 + 0) * 256 + j] = a0 * scl; sc[(th * 4 + 1) * 256 + j] = a1 * scl; sc[(th * 4 + 2) * 256 + j] = a2 * scl; sc[(th * 4 + 3) * 256 + j] = a3 * scl;
        }
        __syncthreads();
        {
            float v[4]; float mx = -3.0e38f;
#pragma unroll
            for (int i = 0; i < 4; ++i) { v[i] = sc[F.wave * 256 + F.lane + 64 * i]; mx = fmaxf(mx, v[i]); }
            mx = wave_max(mx); float sm = 0.f;
#pragma unroll
            for (int i = 0; i < 4; ++i) { v[i] = expf(v[i] - mx); sm += v[i]; }
            sm = 1.0f / wave_sum(sm);
#pragma unroll
            for (int i = 0; i < 4; ++i) sc[F.wave * 256 + F.lane + 64 * i] = v[i] * sm;
        }
        __syncthreads();
        {
            const int d = F.tid; const bf16* vr = KVM + 2048 + h * 512 + d;
            float o[8];
#pragma unroll
            for (int i = 0; i < 8; ++i) o[i] = 0.f;
            for (int j = 0; j < 256; ++j) { const float vv = bf2f(vr[(size_t)j * 4096]);
#pragma unroll
                for (int i = 0; i < 8; ++i) o[i] += sc[i * 256 + j] * vv; }
#pragma unroll
            for (int i = 0; i < 8; ++i) att[(size_t)(t0 + i) * D + h * 512 + d] = (bf16)f2bf(o[i]);
        }
        __syncthreads();
    }
}
__device__ __forceinline__ void moe_tile_starts(Frame& F, LAS int* ts) {
    if (F.tid < 64) {
        const unsigned c = F.lane < 32 ? __hip_atomic_load(F.ctl + CW_CUR + (F.lane & 31), RLX_AGENT) : 0u;
        int v = (int)((c + 255u) >> 8);
#pragma unroll
        for (int o = 1; o < 32; o <<= 1) { const int n = __shfl_up(v, o); if (F.lane >= o) v += n; }
        if (F.lane < 32) ts[F.lane + 1] = v;
        if (F.lane == 0) ts[0] = 0;
    }
    __syncthreads();
}
__device__ __forceinline__ void p10_dispatch(Frame& F, LAS int* ts) {
    const int gt = F.bid * NTHR + F.tid, NGT = F.G * NTHR;
    const int* ex = WSP(int, WS_EXP); const int* sl = WSP(int, WS_SLOT); int* pos = WSP(int, WS_POS); int* tok = WSP(int, WS_TOK);
    for (int a = gt; a < 2 * T; a += NGT) { const int p = ts[ex[a]] * 256 + sl[a]; pos[a] = p; tok[p] = a >> 1; }
}
__device__ __forceinline__ void p13_combine(Frame& F, const LAS int* ts) {
    const int gw = F.bid * NWAVES + F.wave, NGW = F.G * NWAVES;
    const bf16* h2 = WSP(bf16, WS_H2B); const bf16* ys = WSP(bf16, WS_YS);
    const int* ex = WSP(int, WS_EXP); const int* sl = WSP(int, WS_SLOT); const float* gt = WSP(float, WS_GATE);
    const float* g3 = F.in[23]; const float* b3 = F.in[24];
    constexpr int R = 2;
    for (int t0 = gw; t0 < T; t0 += R * NGW) {
        v2u yh[R][8], ya[R][8], yc[R][8]; float w0[R], w1[R];
#pragma unroll
        for (int r = 0; r < R; ++r) { const int t = (t0 + r * NGW < T) ? t0 + r * NGW : t0;
            w0[r] = gt[2 * t]; w1[r] = gt[2 * t + 1];
            const int p0 = ts[ex[2 * t]] * 256 + sl[2 * t], p1 = ts[ex[2 * t + 1]] * 256 + sl[2 * t + 1];
            const GAS v2u* hr = (const GAS v2u*)(h2 + (size_t)t * D) + F.lane;
            const GAS v2u* y0 = (const GAS v2u*)(ys + (size_t)p0 * D) + F.lane; const GAS v2u* y1 = (const GAS v2u*)(ys + (size_t)p1 * D) + F.lane;
#pragma unroll
            for (int j = 0; j < 8; ++j) { yh[r][j] = hr[64 * j]; ya[r][j] = y0[64 * j]; yc[r][j] = y1[64 * j]; } }
#pragma unroll
        for (int r = 0; r < R; ++r) { const int t = t0 + r * NGW; if (t >= T) break;
            f32x4 v[8]; float s = 0.f;
#pragma unroll
            for (int j = 0; j < 8; ++j) { const v2u hw = yh[r][j], a = ya[r][j], c = yc[r][j];
                const f32x4 h = {bflo(hw.x), bfhi(hw.x), bflo(hw.y), bfhi(hw.y)};
                const f32x4 fa = {bflo(a.x), bfhi(a.x), bflo(a.y), bfhi(a.y)}, fc = {bflo(c.x), bfhi(c.x), bflo(c.y), bfhi(c.y)};
                v[j] = h * ALPHA + fa * w0[r] + fc * w1[r]; s += (v[j][0] + v[j][1]) + (v[j][2] + v[j][3]); }
            const float mean = wave_sum(s) * (1.f / D); float s2 = 0.f;
#pragma unroll
            for (int j = 0; j < 8; ++j) { v[j] = v[j] - mean; s2 += (v[j][0] * v[j][0] + v[j][1] * v[j][1]) + (v[j][2] * v[j][2] + v[j][3] * v[j][3]); }
            const float rstd = 1.f / sqrtf(wave_sum(s2) * (1.f / D) + LN_EPS);
            GAS f32x4* orow = (GAS f32x4*)(F.out + (size_t)t * D) + F.lane;
#pragma unroll
            for (int j = 0; j < 8; ++j) { const f32x4 gv = *(const f32x4*)(g3 + 4 * F.lane + 256 * j), bv = *(const f32x4*)(b3 + 4 * F.lane + 256 * j);
                orow[64 * j] = v[j] * rstd * gv + bv; }
        }
    }
}

constexpr int CS = 128, NB = CS / 64, NS = T / CS;
#define HIDX(t_, c_) ((((size_t)((c_) >> 8)) * 8192 + (size_t)(t_)) * 256 + ((c_) & 255))
constexpr size_t WS_BCUM = WS_ORAW;
constexpr size_t WS_KVR = WS_ORAW + 16 * MiB;
constexpr size_t WS_KVG = WS_KVR + 32 * MiB;
typedef short bf16x8_t __attribute__((ext_vector_type(8)));
typedef short s16x4_t __attribute__((ext_vector_type(4)));
__device__ __forceinline__ s16x4_t lds_tr(const LAS unsigned char* p) { return __builtin_bit_cast(s16x4_t, __builtin_amdgcn_ds_read_tr16_b64_v4i16((LAS s16x4_t*)p)); }
__device__ __forceinline__ bf16x8_t frag_tr(const LAS unsigned char* X, int pitch, int k0, int n0, int lane) {
    const int fq = lane >> 4, q = (lane >> 2) & 3, p = lane & 3;
    const LAS unsigned char* a = X + ((k0 + 8 * fq + q) * pitch + n0 + 4 * p) * 2;
    const s16x4_t lo = lds_tr(a), hi = lds_tr(a + 4 * pitch * 2);
    return __builtin_shufflevector(lo, hi, 0, 1, 2, 3, 4, 5, 6, 7);
}
__device__ __forceinline__ bf16x8_t frag_row(const LAS unsigned char* X, int pitch, int r0, int k0, int lane) {
    return *(const LAS bf16x8_t*)(X + ((r0 + (lane & 15)) * pitch + k0 + 8 * (lane >> 4)) * 2);
}
#define MFMA16(a, b, c) __builtin_amdgcn_mfma_f32_16x16x32_bf16((a), (b), (c), 0, 0, 0)
__device__ __forceinline__ float fexp(float x) { return __builtin_amdgcn_exp2f(x * 1.4426950408889634f); }
__device__ __forceinline__ float silu_g(float g) { return g * __builtin_amdgcn_rcpf(1.0f + __builtin_amdgcn_exp2f(-1.4426950408889634f * g)); }

__device__ __forceinline__ void bcum_item(Frame& F, int s, int h) {
    const int c = F.tid & 127, tq = F.tid >> 7;
    LAS float* tot = (LAS float*)F.lds;
    LAS float* gl = (LAS float*)(F.lds + 2048);
    const float* glr = WSP(float, WS_GLR); float* bc = WSP(float, WS_BCUM);
    __syncthreads();
    *(LAS f32x4*)(gl + 4 * F.tid) = *(const GAS f32x4*)(glr + (size_t)s * CS * 16 + 4 * F.tid);
    float w[16];
#pragma unroll
    for (int r = 0; r < 16; ++r) w[r] = F.in[4][r * 512 + h * 128 + c];
    const float bias = F.in[5][h * 128 + c];
    __syncthreads();
    float vals[32]; float run = 0.f;
    const int tb = s * CS + tq * 32;
#pragma unroll
    for (int i = 0; i < 32; ++i) { const LAS float* gr = gl + (tq * 32 + i) * 16; float z = bias;
#pragma unroll
        for (int r = 0; r < 16; ++r) z += gr[r] * w[r];
        run += log_sigmoid_f(z) * 0.0625f; vals[i] = run; }
    tot[tq * 128 + c] = run;
    __syncthreads();
    float off = 0.f;
#pragma unroll
    for (int q = 0; q < 3; ++q) off += (q < tq) ? tot[q * 128 + c] : 0.f;
#pragma unroll
    for (int i = 0; i < 32; ++i) bc[(size_t)(tb + i) * 512 + h * 128 + c] = vals[i] + off;
}
__device__ __forceinline__ void p1_bcum(Frame& F, int first, int stride) { for (int it = first; it < NS * 4; it += stride) bcum_item(F, it >> 2, it & 3); __syncthreads(); }

__device__ __forceinline__ void unit_sh(int u, int& s, int& h8) { s = (u >> 3) & (NS - 1); h8 = ((u & 7) + 4 * (u >> 8)) & 7; }

template <bool GLA, int MODE>
__device__ __forceinline__ void stage_qk(Frame& F, LAS unsigned char* dst, int s, int jb, int hh, int col0, float lg2gamma) {
    constexpr int DK = GLA ? 128 : 256, PK = DK + 8, CPR = DK / 8, NIT = 64 * CPR / NTHR;
    const bf16* H = WSP(bf16, WS_H); const float* bc = WSP(float, WS_BCUM);
    v4u wv[NIT]; f32x4 b0[GLA ? NIT : 1], b1[GLA ? NIT : 1], l0[(GLA && MODE == 2) ? NIT : 1], l1[(GLA && MODE == 2) ? NIT : 1];
#pragma unroll
    for (int it = 0; it < NIT; ++it) {
        const int ch = F.tid + NTHR * it, r = ch / CPR, cc = ch % CPR, t = s * CS + jb * 64 + r;
        wv[it] = *(const GAS v4u*)(H + HIDX(t, col0 + 8 * cc));
        if (GLA) { b0[it] = *(const GAS f32x4*)(bc + (size_t)t * 512 + hh * 128 + 8 * cc); b1[it] = *(const GAS f32x4*)(bc + (size_t)t * 512 + hh * 128 + 8 * cc + 4);
            if (MODE == 2) { const size_t tl_ = (size_t)(s * CS + CS - 1) * 512 + hh * 128 + 8 * cc; l0[it] = *(const GAS f32x4*)(bc + tl_); l1[it] = *(const GAS f32x4*)(bc + tl_ + 4); } }
    }
#pragma unroll
    for (int it = 0; it < NIT; ++it) {
        const int ch = F.tid + NTHR * it, r = ch / CPR, cc = ch % CPR, tl = jb * 64 + r;
        const v4u w = wv[it];
        float f[8] = {bflo(w.x), bfhi(w.x), bflo(w.y), bfhi(w.y), bflo(w.z), bfhi(w.z), bflo(w.w), bfhi(w.w)};
        if (GLA) {
            float e[8] = {b0[it][0], b0[it][1], b0[it][2], b0[it][3], b1[it][0], b1[it][1], b1[it][2], b1[it][3]};
            if (MODE == 2) { const float l[8] = {l0[it][0], l0[it][1], l0[it][2], l0[it][3], l1[it][0], l1[it][1], l1[it][2], l1[it][3]};
#pragma unroll
                for (int i = 0; i < 8; ++i) e[i] = l[i] - e[i]; }
            else if (MODE == 1) {
#pragma unroll
                for (int i = 0; i < 8; ++i) e[i] = -e[i]; }
#pragma unroll
            for (int i = 0; i < 8; ++i) f[i] *= fexp(e[i]);
        } else {
            const float ex = MODE == 0 ? (float)(tl + 1) : MODE == 1 ? -(float)(tl + 1) : (float)(CS - 1 - tl);
            const float fac = __builtin_amdgcn_exp2f(ex * lg2gamma);
#pragma unroll
            for (int i = 0; i < 8; ++i) f[i] *= fac;
        }
        v4u o; o.x = pk2(f[0], f[1]); o.y = pk2(f[2], f[3]); o.z = pk2(f[4], f[5]); o.w = pk2(f[6], f[7]);
        *(LAS v4u*)(dst + (r * PK + 8 * cc) * 2) = o;
    }
}
__device__ __forceinline__ void stage_v(Frame& F, LAS unsigned char* dst, int s, int jb, int col0) {
    const bf16* H = WSP(bf16, WS_H);
    v4u wv[4];
#pragma unroll
    for (int it = 0; it < 4; ++it) { const int ch = F.tid + NTHR * it, r = ch >> 5, cc = ch & 31, t = s * CS + jb * 64 + r; wv[it] = *(const GAS v4u*)(H + HIDX(t, col0 + 8 * cc)); }
#pragma unroll
    for (int it = 0; it < 4; ++it) { const int ch = F.tid + NTHR * it, r = ch >> 5, cc = ch & 31; *(LAS v4u*)(dst + (r * 264 + 8 * cc) * 2) = wv[it]; }
}

template <bool GLA>
__device__ __forceinline__ void kv_unit(Frame& F, int s, int hh) {
    constexpr int DK = GLA ? 128 : 256, PK = DK + 8, NDT = DK / 16;
    LAS unsigned char* Ks = F.lds; LAS unsigned char* Vs = F.lds + 34816;
    const int kcol = GLA ? 4608 + hh * 128 : 1024 + hh * 256, vcol = (GLA ? 5120 : 2048) + hh * 256;
    const float lg2g = log2f(1.0f - exp2f(-5.0f - (float)hh));
    f32x4 acc[2][NDT];
#pragma unroll
    for (int a = 0; a < 2; ++a)
#pragma unroll
        for (int d = 0; d < NDT; ++d) acc[a][d] = (f32x4){0.f, 0.f, 0.f, 0.f};
    for (int jb = 0; jb < NB; ++jb) {
        __syncthreads();
        stage_qk<GLA, 2>(F, Ks, s, jb, hh, kcol, lg2g);
        stage_v(F, Vs, s, jb, vcol);
        __syncthreads();
#pragma unroll
        for (int ks = 0; ks < 2; ++ks) {
            bf16x8_t vf[2];
#pragma unroll
            for (int et = 0; et < 2; ++et) vf[et] = frag_tr(Vs, 264, 32 * ks, 32 * F.wave + 16 * et, F.lane);
#pragma unroll
            for (int dt = 0; dt < NDT; ++dt) { const bf16x8_t kf = frag_tr(Ks, PK, 32 * ks, 16 * dt, F.lane);
#pragma unroll
                for (int et = 0; et < 2; ++et) acc[et][dt] = MFMA16(kf, vf[et], acc[et][dt]); }
        }
    }
    bf16* kv = GLA ? (WSP(bf16, WS_KVG) + (size_t)(s * 4 + hh) * 256 * 128) : (WSP(bf16, WS_KVR) + (size_t)(s * 4 + hh) * 256 * 256);
    const int fr = F.lane & 15, fq = F.lane >> 4;
#pragma unroll
    for (int et = 0; et < 2; ++et)
#pragma unroll
        for (int dt = 0; dt < NDT; ++dt) { v2u w; w.x = pk2(acc[et][dt][0], acc[et][dt][1]); w.y = pk2(acc[et][dt][2], acc[et][dt][3]);
            *(GAS v2u*)(kv + (size_t)(32 * F.wave + 16 * et + fr) * DK + 16 * dt + 4 * fq) = w; }
}
__device__ __forceinline__ void p2_kv(Frame& F) {
    for (int u = F.bid; u < 8 * NS; u += F.G) { int s, h8; unit_sh(u, s, h8);
        if (s == NS - 1) continue;
        if (h8 < 4) kv_unit<false>(F, s, h8); else kv_unit<true>(F, s, h8 - 4); }
    __syncthreads();
}
__device__ __forceinline__ void p3_scan(Frame& F) {
    constexpr int NR = 4 * 256 * 64, NG = 4 * 256 * 32, NITEM = NR + NG;
    const float* bc = WSP(float, WS_BCUM);
    const int per = (NITEM + F.G - 1) / F.G;
    for (int k0 = F.tid; k0 < per; k0 += NTHR) {
      const int it = F.bid * per + k0;
      if (it < NITEM) {
        const bool gla = it >= NR; const int r = gla ? it - NR : it;
        const int sh = gla ? 5 : 6, dk = gla ? 128 : 256;
        const int cc = r & ((1 << sh) - 1), e = (r >> sh) & 255, hh = r >> (sh + 8);
        bf16* base = (gla ? WSP(bf16, WS_KVG) : WSP(bf16, WS_KVR)) + ((size_t)hh * 256 + e) * dk + 4 * cc;
        const size_t sstride = (size_t)4 * 256 * dk;
        const float dret = __builtin_amdgcn_exp2f((float)CS * log2f(1.0f - exp2f(-5.0f - (float)hh)));
        float S[4] = {0.f, 0.f, 0.f, 0.f};
        static_assert(NS - 1 == 63, "batching below assumes 63 steps");
#pragma unroll 1
        for (int s0 = 0; s0 < NS - 1; s0 += 21) {
            v2u wv[21]; f32x4 lv[21];
#pragma unroll
            for (int j = 0; j < 21; ++j) { wv[j] = *(const GAS v2u*)(base + (size_t)(s0 + j) * sstride);
                if (gla) lv[j] = *(const GAS f32x4*)(bc + (size_t)((s0 + j) * CS + CS - 1) * 512 + hh * 128 + 4 * cc); else lv[j] = (f32x4){0.f, 0.f, 0.f, 0.f}; }
#pragma unroll
            for (int j = 0; j < 21; ++j) {
                v2u o; o.x = pk2(S[0], S[1]); o.y = pk2(S[2], S[3]);
                *(GAS v2u*)(base + (size_t)(s0 + j) * sstride) = o;
                const float f[4] = {bflo(wv[j].x), bfhi(wv[j].x), bflo(wv[j].y), bfhi(wv[j].y)};
                float dec[4] = {dret, dret, dret, dret};
                if (gla) { dec[0] = fexp(lv[j][0]); dec[1] = fexp(lv[j][1]); dec[2] = fexp(lv[j][2]); dec[3] = fexp(lv[j][3]); }
#pragma unroll
                for (int i = 0; i < 4; ++i) S[i] = dec[i] * S[i] + f[i];
            }
        }
        { GAS v2u* p = (GAS v2u*)(base + (size_t)(NS - 1) * sstride); v2u o; o.x = pk2(S[0], S[1]); o.y = pk2(S[2], S[3]); *p = o; }
      }
    }
}
template <bool GLA>
__device__ __forceinline__ void out_unit(Frame& F, int s, int hh) {
    constexpr int DK = GLA ? 128 : 256, PK = DK + 8, NKS = DK / 32;
    LAS unsigned char* Qs = F.lds; LAS unsigned char* Ks = F.lds + 33792; LAS unsigned char* Vs = F.lds + 67584; LAS unsigned char* Ps = F.lds + 101376;
    LAS float* red = (LAS float*)(F.lds + 110592);
    const int qcol = GLA ? 4096 + hh * 128 : hh * 256, kcol = GLA ? 4608 + hh * 128 : 1024 + hh * 256, vcol = (GLA ? 5120 : 2048) + hh * 256;
    const int gcol = (GLA ? 6144 : 3072) + hh * 256, ocol = (GLA ? 1024 : 0) + hh * 256;
    const float lg2g = log2f(1.0f - exp2f(-5.0f - (float)hh));
    const bf16* H = WSP(bf16, WS_H); bf16* mixed = WSP(bf16, WS_MIXED);
    const bf16* st = GLA ? (WSP(bf16, WS_KVG) + (size_t)(s * 4 + hh) * 256 * 128) : (WSP(bf16, WS_KVR) + (size_t)(s * 4 + hh) * 256 * 256);
    const int fr = F.lane & 15, fq = F.lane >> 4, w = F.wave, mt = w >> 1, nt0 = 2 * (w & 1);
    static_assert(NB == 2, "the step program below is written for two 64-token sub-blocks");
    f32x4 accO[4][2]; bf16x8_t sfa[NKS][2]; v2u gpre[4][2];
#pragma unroll 1
    for (int step = 0; step < 3; ++step) {
        const int i = step > 0 ? 1 : 0, j = step > 1 ? 1 : 0;
        {
            __syncthreads();
            if (step < 2) stage_qk<GLA, 0>(F, Qs, s, i, hh, qcol, lg2g);
            if (step != 1) { stage_qk<GLA, 1>(F, Ks, s, j, hh, kcol, lg2g); stage_v(F, Vs, s, j, vcol); }
            if (step < 2) {
#pragma unroll
                for (int m = 0; m < 4; ++m)
#pragma unroll
                    for (int n = 0; n < 2; ++n) accO[m][n] = (f32x4){0.f, 0.f, 0.f, 0.f};
            }
            if (step != 1) {
                if (s > 0) {
#pragma unroll
                    for (int ks = 0; ks < NKS; ++ks)
#pragma unroll
                        for (int n = 0; n < 2; ++n) sfa[ks][n] = *(const GAS bf16x8_t*)(st + (size_t)(32 * w + 16 * n + fr) * DK + 32 * ks + 8 * fq);
                }
#pragma unroll
                for (int m2 = 0; m2 < 4; ++m2)
#pragma unroll
                    for (int n = 0; n < 2; ++n) gpre[m2][n] = *(const GAS v2u*)(H + HIDX(s * CS + i * 64 + 16 * m2 + fr, gcol + 32 * w + 16 * n + 4 * fq));
            }
            __syncthreads();
            f32x4 accS[2] = {(f32x4){0.f, 0.f, 0.f, 0.f}, (f32x4){0.f, 0.f, 0.f, 0.f}};
#pragma unroll
            for (int ks = 0; ks < NKS; ++ks) { const bf16x8_t qf = frag_row(Qs, PK, 16 * mt, 32 * ks, F.lane);
#pragma unroll
                for (int n2 = 0; n2 < 2; ++n2) { const bf16x8_t kf = frag_row(Ks, PK, 16 * (nt0 + n2), 32 * ks, F.lane); accS[n2] = MFMA16(kf, qf, accS[n2]); } }
#pragma unroll
            for (int n2 = 0; n2 < 2; ++n2) { const int row = 16 * mt + fr, c0 = 16 * (nt0 + n2) + 4 * fq; float pv[4];
#pragma unroll
                for (int jj = 0; jj < 4; ++jj) pv[jj] = (i == j && c0 + jj > row) ? 0.f : accS[n2][jj];
                v2u pw; pw.x = pk2(pv[0], pv[1]); pw.y = pk2(pv[2], pv[3]);
                *(LAS v2u*)(Ps + (row * 72 + c0) * 2) = pw; }
            __syncthreads();
#pragma unroll
            for (int ks = 0; ks < 2; ++ks) {
                bf16x8_t vf[2];
#pragma unroll
                for (int n = 0; n < 2; ++n) vf[n] = frag_tr(Vs, 264, 32 * ks, 32 * w + 16 * n, F.lane);
#pragma unroll
                for (int m = 0; m < 4; ++m) { const bf16x8_t pf = frag_row(Ps, 72, 16 * m, 32 * ks, F.lane);
#pragma unroll
                    for (int n = 0; n < 2; ++n) accO[m][n] = MFMA16(vf[n], pf, accO[m][n]); }
            }
        }
        if (step == 1) continue;
        if (s > 0) {
#pragma unroll
            for (int ks = 0; ks < NKS; ++ks) {
#pragma unroll
                for (int m = 0; m < 4; ++m) { const bf16x8_t qf = frag_row(Qs, PK, 16 * m, 32 * ks, F.lane);
#pragma unroll
                    for (int n = 0; n < 2; ++n) accO[m][n] = MFMA16(sfa[ks][n], qf, accO[m][n]); }
            }
        }
#pragma unroll
        for (int m = 0; m < 4; ++m) { float s1 = 0.f, s2 = 0.f;
#pragma unroll
            for (int n = 0; n < 2; ++n)
#pragma unroll
                for (int jj = 0; jj < 4; ++jj) { const float v = accO[m][n][jj]; s1 += v; s2 += v * v; }
            s1 += __shfl_xor(s1, 16); s1 += __shfl_xor(s1, 32); s2 += __shfl_xor(s2, 16); s2 += __shfl_xor(s2, 32);
            if (fq == 0) { red[(w * 64 + 16 * m + fr) * 2] = s1; red[(w * 64 + 16 * m + fr) * 2 + 1] = s2; } }
        __syncthreads();
#pragma unroll
        for (int m = 0; m < 4; ++m) { const int row = 16 * m + fr; float s1 = 0.f, s2 = 0.f;
#pragma unroll
            for (int ww = 0; ww < 8; ++ww) { s1 += red[(ww * 64 + row) * 2]; s2 += red[(ww * 64 + row) * 2 + 1]; }
            const float mean = s1 * (1.f / 256.f), ex2 = s2 * (1.f / 256.f);
            const float mu = GLA ? 0.f : mean, var = GLA ? ex2 : fmaxf(ex2 - mean * mean, 0.f);
            const float rstd = 1.0f / sqrtf(var + LN_EPS);
            const int t = s * CS + i * 64 + row;
#pragma unroll
            for (int n = 0; n < 2; ++n) { const int e = 32 * w + 16 * n + 4 * fq;
                const v2u gw2 = gpre[m][n];
                const float gt[4] = {bflo(gw2.x), bfhi(gw2.x), bflo(gw2.y), bfhi(gw2.y)};
                f32x4 gn = {1.f, 1.f, 1.f, 1.f}; if (GLA) gn = *(const f32x4*)(F.in[6] + e);
                float r4[4];
#pragma unroll
                for (int jj = 0; jj < 4; ++jj) { const float y = (accO[m][n][jj] - mu) * rstd * gn[jj]; r4[jj] = silu_g(gt[jj]) * y; }
                v2u ow; ow.x = pk2(r4[0], r4[1]); ow.y = pk2(r4[2], r4[3]);
                *(GAS v2u*)(mixed + (size_t)t * D + ocol + e) = ow; } }
    }
}
__device__ __forceinline__ void p4_out(Frame& F) {
    for (int u = F.bid; u < 8 * NS; u += F.G) { int s, h8; unit_sh(u, s, h8);
        if (h8 < 4) out_unit<false>(F, s, h8); else out_unit<true>(F, s, h8 - 4); }
    __syncthreads();
}

__device__ __forceinline__ void kv_chunk_load(Frame& F, v4u (&R)[8], const bf16* src  ) {
#pragma unroll
    for (int it = 0; it < 8; ++it) { const int ch = F.tid + NTHR * it, r = ch >> 4, cc = ch & 15; R[it] = *(const GAS v4u*)(src + (size_t)r * 4096 + 8 * cc); }
}
__device__ __forceinline__ void kv_chunk_store(Frame& F, const v4u (&R)[8], LAS unsigned char* dst) {
#pragma unroll
    for (int it = 0; it < 8; ++it) { const int ch = F.tid + NTHR * it, r = ch >> 4, cc = ch & 15; *(LAS v4u*)(dst + (r * 136 + 8 * cc) * 2) = R[it]; }
}
__device__ __forceinline__ void p8_attn(Frame& F) {
    const bf16* Q = WSP(bf16, WS_QB); const bf16* KVM = WSP(bf16, WS_KVM); bf16* att = WSP(bf16, WS_ATT);
    constexpr int CB = 256 * 136 * 2;
    const int fr = F.lane & 15, fq = F.lane >> 4, q4 = (F.lane >> 2) & 3, p4 = F.lane & 3;
    for (int u = F.bid; u < (T / 128) * 4; u += F.G) {
        const int h = u & 3, r0 = (u >> 2) * 128 + 16 * F.wave;
#if PROBE_T >= 221 && PROBE_T <= 224
        if (F.bid == 0 && F.tid == 0) ((unsigned long long*)(F.ws + 32768))[0] = __builtin_amdgcn_s_memrealtime();
#endif
        v4u R[8];
        bf16x8_t qa[16];
#pragma unroll
        for (int ks = 0; ks < 16; ++ks) qa[ks] = *(const GAS bf16x8_t*)(Q + (size_t)(r0 + fr) * D + h * 512 + 32 * ks + 8 * fq);
        __syncthreads();
        kv_chunk_load(F, R, KVM + h * 512); kv_chunk_store(F, R, F.lds);
        __syncthreads();
        f32x4 accS[16];
#pragma unroll
        for (int i = 0; i < 16; ++i) accS[i] = (f32x4){0.f, 0.f, 0.f, 0.f};
#pragma unroll
        for (int dc = 0; dc < 4; ++dc) {
            kv_chunk_load(F, R, dc < 3 ? KVM + h * 512 + (dc + 1) * 128 : KVM + 2048 + h * 512);
            const LAS unsigned char* Cs = F.lds + (dc & 1) * CB;
#pragma unroll
            for (int ks = 0; ks < 4; ++ks)
#pragma unroll
                for (int nt = 0; nt < 16; ++nt) accS[nt] = MFMA16(frag_row(Cs, 136, 16 * nt, 32 * ks, F.lane), qa[4 * dc + ks], accS[nt]);
            kv_chunk_store(F, R, F.lds + ((dc + 1) & 1) * CB);
            __syncthreads();
        }
#if PROBE_T >= 221 && PROBE_T <= 224
        if (F.bid == 0 && F.tid == 0) ((unsigned long long*)(F.ws + 32768))[1] = __builtin_amdgcn_s_memrealtime();
#endif
        float mx = -3.0e38f;
#pragma unroll
        for (int nt = 0; nt < 16; ++nt)
#pragma unroll
            for (int jj = 0; jj < 4; ++jj) mx = fmaxf(mx, accS[nt][jj]);
        mx = fmaxf(mx, __shfl_xor(mx, 16)); mx = fmaxf(mx, __shfl_xor(mx, 32));
        const float sl2 = 0.04419417382415922f * 1.4426950408889634f;
        float sm = 0.f;
#pragma unroll
        for (int nt = 0; nt < 16; ++nt)
#pragma unroll
            for (int jj = 0; jj < 4; ++jj) { const float p = __builtin_amdgcn_exp2f((accS[nt][jj] - mx) * sl2); accS[nt][jj] = p; sm += p; }
        sm += __shfl_xor(sm, 16); sm += __shfl_xor(sm, 32);
        const float inv = 1.0f / sm;
        bf16x8_t pf[8];
#pragma unroll
        for (int ks2 = 0; ks2 < 8; ++ks2) { v4u w; w.x = pk2(accS[2 * ks2][0] * inv, accS[2 * ks2][1] * inv); w.y = pk2(accS[2 * ks2][2] * inv, accS[2 * ks2][3] * inv);
            w.z = pk2(accS[2 * ks2 + 1][0] * inv, accS[2 * ks2 + 1][1] * inv); w.w = pk2(accS[2 * ks2 + 1][2] * inv, accS[2 * ks2 + 1][3] * inv); pf[ks2] = __builtin_bit_cast(bf16x8_t, w); }
#pragma unroll 1
        for (int ec = 0; ec < 4; ++ec) {
            if (ec < 3) kv_chunk_load(F, R, KVM + 2048 + h * 512 + (ec + 1) * 128);
            const LAS unsigned char* Cs = F.lds + (ec & 1) * CB;
            f32x4 accO[8];
#pragma unroll
            for (int i = 0; i < 8; ++i) accO[i] = (f32x4){0.f, 0.f, 0.f, 0.f};
#pragma unroll
            for (int ks2 = 0; ks2 < 8; ++ks2)
#pragma unroll
                for (int et = 0; et < 8; ++et) { const LAS unsigned char* a = Cs + ((32 * ks2 + 4 * fq + q4) * 136 + 16 * et + 4 * p4) * 2;
                    const s16x4_t lo = lds_tr(a), hi = lds_tr(a + 16 * 136 * 2);
                    accO[et] = MFMA16(__builtin_shufflevector(lo, hi, 0, 1, 2, 3, 4, 5, 6, 7), pf[ks2], accO[et]); }
#pragma unroll
            for (int et = 0; et < 8; ++et) { v2u w; w.x = pk2(accO[et][0], accO[et][1]); w.y = pk2(accO[et][2], accO[et][3]);
                *(GAS v2u*)(att + (size_t)(r0 + fr) * D + h * 512 + ec * 128 + 16 * et + 4 * fq) = w; }
            if (ec < 3) kv_chunk_store(F, R, F.lds + ((ec + 1) & 1) * CB);
            __syncthreads();
        }
#if PROBE_T >= 221 && PROBE_T <= 224
        asm volatile("s_waitcnt vmcnt(0)" ::: "memory");
        if (F.bid == 0 && F.tid == 0) ((unsigned long long*)(F.ws + 32768))[2] = __builtin_amdgcn_s_memrealtime();
#endif
    }
}

constexpr int RT_AROW = 2064;
__device__ __forceinline__ void router_stage(const f32x4 (&v)[4][8], const float (&rstd)[4], const int kh, const bool store_h, const float* g, const float* b, bf16* HB, const int t0, const int wave, const int lane, LAS unsigned char* lds) {
#pragma unroll
    for (int jl = 0; jl < 4; ++jl) { const int j = 4 * kh + jl;
        const f32x4 gv = *(const f32x4*)(g + 4 * lane + 256 * j), bv = *(const f32x4*)(b + 4 * lane + 256 * j);
#pragma unroll
        for (int i = 0; i < 4; ++i) { const f32x4 hv = v[i][j] * rstd[i] * gv + bv;
            v2u hi, lo; hi.x = pk2(hv[0], hv[1]); hi.y = pk2(hv[2], hv[3]);
            lo.x = pk2(hv[0] - __builtin_bit_cast(float, hi.x << 16), hv[1] - __builtin_bit_cast(float, hi.x & 0xffff0000u));
            lo.y = pk2(hv[2] - __builtin_bit_cast(float, hi.y << 16), hv[3] - __builtin_bit_cast(float, hi.y & 0xffff0000u));
            if (store_h) ((GAS v2u*)(HB + (size_t)(t0 + i) * D) + lane)[64 * j] = hi;
            LAS unsigned char* p = lds + (4 * wave + i) * RT_AROW + (4 * lane + 256 * jl) * 2;
            *(LAS v2u*)p = hi; *(LAS v2u*)(p + 32 * RT_AROW) = lo; } }
}
__device__ __forceinline__ void router_mma(f32x4& acc0, f32x4& acc1, f32x4& acc2, const int kh, const bf16* wrt, const int wave, const int lane, LAS unsigned char* lds) {
    const int fr = lane & 15, fq = lane >> 4, rt = wave >> 2, kq = wave & 3;
    LAS unsigned char* pa = lds + (16 * rt + fr) * RT_AROW + (256 * kq + 8 * fq) * 2;
    const bf16* whi = wrt + ((size_t)((1024 * kh + 256 * kq) / 8 + fq) * 48 + fr) * 8;
    const bf16* wlo = whi + 48 * 2048;
#pragma unroll 2
    for (int ks = 0; ks < 8; ++ks) {
        const bf16x8_t ah = *(LAS bf16x8_t*)(pa + 64 * ks), al = *(LAS bf16x8_t*)(pa + 32 * RT_AROW + 64 * ks);
        const bf16x8_t b0h = *(const GAS bf16x8_t*)(whi + 1536 * ks), b1h = *(const GAS bf16x8_t*)(whi + 1536 * ks + 128), b2h = *(const GAS bf16x8_t*)(whi + 1536 * ks + 256);
        const bf16x8_t b0l = *(const GAS bf16x8_t*)(wlo + 1536 * ks), b1l = *(const GAS bf16x8_t*)(wlo + 1536 * ks + 128), b2l = *(const GAS bf16x8_t*)(wlo + 1536 * ks + 256);
        acc0 = MFMA16(ah, b0h, acc0); acc0 = MFMA16(ah, b0l, acc0); acc0 = MFMA16(al, b0h, acc0);
        acc1 = MFMA16(ah, b1h, acc1); acc1 = MFMA16(ah, b1l, acc1); acc1 = MFMA16(al, b1h, acc1);
        acc2 = MFMA16(ah, b2h, acc2); acc2 = MFMA16(ah, b2l, acc2); acc2 = MFMA16(al, b2h, acc2);
    }
}
__device__ __forceinline__ void p10_ln_router(Frame& F) {
    const float* Y = WSP(float, WS_Y2); const float* g = F.in[14]; const float* b = F.in[15]; bf16* HB = WSP(bf16, WS_H2B); float* st = WSP(float, WS_ST2);
    LAS float* part = (LAS float*)F.lds;
    LAS float* stl = (LAS float*)(F.lds + 64 * RT_AROW);
    LAS int* lcnt = (LAS int*)(F.lds + 64 * RT_AROW + 256);
    LAS int* lbase = lcnt + 32;
    if (F.tid < 32) lcnt[F.tid] = 0;
    __syncthreads();
    const int fr = F.lane & 15, fq = F.lane >> 4;
    for (int item = F.bid; item < T / 32; item += F.G) {
        const int row0 = item * 32;
#if PROBE_T >= 231 && PROBE_T <= 236
        if (F.bid == 0 && F.tid == 0) ((unsigned long long*)(F.ws + 32768))[0] = __builtin_amdgcn_s_memrealtime();
#endif
        const int t0 = row0 + 4 * F.wave;
        f32x4 v[4][8]; float rstd[4];
        {
            const GAS f32x4* yr = (const GAS f32x4*)(Y + (size_t)t0 * D) + F.lane;
#pragma unroll
            for (int i = 0; i < 4; ++i)
#pragma unroll
                for (int j = 0; j < 8; ++j) v[i][j] = yr[512 * i + 64 * j];
            float mean[4];
#pragma unroll
            for (int i = 0; i < 4; ++i) { float s = 0.f;
#pragma unroll
                for (int j = 0; j < 8; ++j) s += (v[i][j][0] + v[i][j][1]) + (v[i][j][2] + v[i][j][3]);
                mean[i] = wave_sum(s) * (1.f / D); }
#pragma unroll
            for (int i = 0; i < 4; ++i) { float s2 = 0.f;
#pragma unroll
                for (int j = 0; j < 8; ++j) { v[i][j] = v[i][j] - mean[i]; s2 += (v[i][j][0] * v[i][j][0] + v[i][j][1] * v[i][j][1]) + (v[i][j][2] * v[i][j][2] + v[i][j][3] * v[i][j][3]); }
                rstd[i] = 1.f / sqrtf(wave_sum(s2) * (1.f / D) + LN_EPS); }
            if (F.lane < 4) { const float m_ = F.lane == 0 ? mean[0] : F.lane == 1 ? mean[1] : F.lane == 2 ? mean[2] : mean[3], r_ = F.lane == 0 ? rstd[0] : F.lane == 1 ? rstd[1] : F.lane == 2 ? rstd[2] : rstd[3];
                st[2 * (t0 + F.lane)] = m_; st[2 * (t0 + F.lane) + 1] = r_; stl[2 * (4 * F.wave + F.lane)] = m_; stl[2 * (4 * F.wave + F.lane) + 1] = r_; }
        }
        f32x4 acc0 = {0.f, 0.f, 0.f, 0.f}, acc1 = acc0, acc2 = acc0;
        router_stage(v, rstd, 0, true, g, b, HB, t0, F.wave, F.lane, F.lds);
        __syncthreads();
#if PROBE_T >= 231 && PROBE_T <= 236
        if (F.bid == 0 && F.tid == 0) ((unsigned long long*)(F.ws + 32768))[1] = __builtin_amdgcn_s_memrealtime();
#endif
        router_mma(acc0, acc1, acc2, 0, WSP(bf16, WS_WRT), F.wave, F.lane, F.lds);
        __syncthreads();
        router_stage(v, rstd, 1, true, g, b, HB, t0, F.wave, F.lane, F.lds);
        __syncthreads();
        router_mma(acc0, acc1, acc2, 1, WSP(bf16, WS_WRT), F.wave, F.lane, F.lds);
        __syncthreads();
        {
            LAS float* pw = part + F.wave * 768;
#pragma unroll
            for (int jj = 0; jj < 4; ++jj) { pw[(4 * fq + jj) * 48 + fr] = acc0[jj]; pw[(4 * fq + jj) * 48 + 16 + fr] = acc1[jj]; pw[(4 * fq + jj) * 48 + 32 + fr] = acc2[jj]; }
        }
        __syncthreads();
#if PROBE_T >= 231 && PROBE_T <= 236
        if (F.bid == 0 && F.tid == 0) ((unsigned long long*)(F.ws + 32768))[2] = __builtin_amdgcn_s_memrealtime();
#endif
        int e1 = 0, e2 = 0, r1 = 0, r2 = 0; float g1 = 0.f, g2 = 0.f;
        if (F.tid < 32) {
            const int rt = F.tid >> 4, rr = F.tid & 15;
            float le[32], lg[4];
#pragma unroll
            for (int c = 0; c < 32; ++c) { float s = 0.f;
#pragma unroll
                for (int kq = 0; kq < 4; ++kq) s += part[(rt * 4 + kq) * 768 + rr * 48 + c]; le[c] = s; }
#pragma unroll
            for (int c = 0; c < 4; ++c) { float s = 0.f;
#pragma unroll
                for (int kq = 0; kq < 4; ++kq) s += part[(rt * 4 + kq) * 768 + rr * 48 + 32 + c]; lg[c] = s + F.in[17][c]; }
            int grp = 0; float gmx = lg[0];
#pragma unroll
            for (int i = 1; i < 4; ++i) if (lg[i] > gmx) { gmx = lg[i]; grp = i; }
            float gs = 0.f;
#pragma unroll
            for (int i = 0; i < 4; ++i) gs += expf(lg[i] - gmx);
            const float pg_sel = 1.0f / gs;
            float fe[8];
#pragma unroll
            for (int j = 0; j < 8; ++j) { const float a = grp == 0 ? le[j] : grp == 1 ? le[8 + j] : grp == 2 ? le[16 + j] : le[24 + j]; fe[j] = a + F.in[19][grp * 8 + j]; }
            int i1 = 0; float m1 = fe[0];
#pragma unroll
            for (int j = 1; j < 8; ++j) if (fe[j] > m1) { m1 = fe[j]; i1 = j; }
            int i2 = -1; float m2 = -3.0e38f;
#pragma unroll
            for (int j = 0; j < 8; ++j) if (j != i1 && fe[j] > m2) { m2 = fe[j]; i2 = j; }
            const float p2 = expf(m2 - m1), den = 1.0f / (1.0f + p2);
            e1 = grp * 8 + i1; e2 = grp * 8 + i2; g1 = pg_sel * den; g2 = pg_sel * p2 * den;
            r1 = __hip_atomic_fetch_add((int*)(lcnt + e1), 1, __ATOMIC_RELAXED, __HIP_MEMORY_SCOPE_WORKGROUP); r2 = __hip_atomic_fetch_add((int*)(lcnt + e2), 1, __ATOMIC_RELAXED, __HIP_MEMORY_SCOPE_WORKGROUP);
        }
        __syncthreads();
#if PROBE_T >= 231 && PROBE_T <= 236
        if (F.bid == 0 && F.tid == 0) ((unsigned long long*)(F.ws + 32768))[3] = __builtin_amdgcn_s_memrealtime();
#endif
        if (F.tid < 32) { const int c = lcnt[F.tid];
            lbase[F.tid] = c ? (int)__hip_atomic_fetch_add((unsigned*)(F.ctl + CW_CUR) + F.tid, (unsigned)c, __ATOMIC_RELAXED, __HIP_MEMORY_SCOPE_AGENT) : 0; }
        __syncthreads();
#if PROBE_T >= 231 && PROBE_T <= 236
        if (F.bid == 0 && F.tid == 0) ((unsigned long long*)(F.ws + 32768))[4] = __builtin_amdgcn_s_memrealtime();
#endif
        if (F.tid < 32) {
            const int t = row0 + F.tid;
            int* ex = WSP(int, WS_EXP); float* gt = WSP(float, WS_GATE); int* sl = WSP(int, WS_SLOT);
            ex[2 * t] = e1; ex[2 * t + 1] = e2; gt[2 * t] = g1; gt[2 * t + 1] = g2;
            const int s1 = lbase[e1] + r1, s2 = lbase[e2] + r2; int* tk = WSP(int, WS_TOKS);
            sl[2 * t] = s1; sl[2 * t + 1] = s2; tk[e1 * 8192 + s1] = t; tk[e2 * 8192 + s2] = t;
            lcnt[F.tid] = 0;
        }
        __syncthreads();
#if PROBE_T >= 231 && PROBE_T <= 236
        if (F.bid == 0 && F.tid == 0) ((unsigned long long*)(F.ws + 32768))[5] = __builtin_amdgcn_s_memrealtime();
#endif
    }
}


#define XB_TMO      128
#define XB_XCNT(j)  (256  + 64 * (j))
#define XB_XSUB(j)  (1280 + 64 * (j))
#define XB_XGEN(j)  (2304 + 64 * (j))
#define XB_TOP      3328
#define XB_TOPGEN   3392
#define XCD_BAR_WORDS 3456
#define XB_SPIN_CAP (1u << 22)
__device__ __forceinline__ unsigned xb_ld(unsigned* p)              { return __hip_atomic_load(p, __ATOMIC_RELAXED, __HIP_MEMORY_SCOPE_AGENT); }
__device__ __forceinline__ unsigned xb_add(unsigned* p, unsigned v) { return __hip_atomic_fetch_add(p, v, __ATOMIC_RELAXED, __HIP_MEMORY_SCOPE_AGENT); }
__device__ __forceinline__ unsigned xb_xcc_id() { return (unsigned)__builtin_amdgcn_s_getreg((3 << 11) | 20) & 0xFu; }
#define XB_SPIN(cond, bar) do { unsigned _sp = 0; while (cond) { __builtin_amdgcn_s_sleep(1); \
    if ((++_sp & 255u) == 0u) { if (xb_ld(&(bar)[XB_TMO])) break; if (_sp > XB_SPIN_CAP) { atomicAdd(&(bar)[XB_TMO], 1u); break; } } } } while (0)
struct XcdBarrier { unsigned* bar; unsigned x; volatile LAS unsigned* st; };
__device__ __forceinline__ XcdBarrier xcd_barrier_post(unsigned* bar, volatile LAS unsigned* st) {
    XcdBarrier b; b.bar = bar; b.x = xb_xcc_id(); b.st = st;
    if (threadIdx.x == 0) (void)xb_add(&bar[XB_XCNT(b.x)], 1u);
    return b;
}
__device__ __forceinline__ void xcd_barrier_complete(unsigned* bar, unsigned x, unsigned& nloc, unsigned& nx) {
    const unsigned G = gridDim.x * gridDim.y * gridDim.z;
    unsigned sum, cnt, mine, sp = 0u;
    for (;;) {
        sum = 0u; cnt = 0u; mine = 0u;
#pragma unroll
        for (unsigned j = 0; j < 16; ++j) { const unsigned c = xb_ld(&bar[XB_XCNT(j)]); sum += c; cnt += (c > 0u) ? 1u : 0u; mine = (j == x) ? c : mine; }
        if (sum == G) break;
        __builtin_amdgcn_s_sleep(1);
        if ((++sp & 255u) == 0u) { if (xb_ld(&bar[XB_TMO])) break; if (sp > XB_SPIN_CAP) { atomicAdd(&bar[XB_TMO], 1u); break; } }
    }
    nloc = mine > 0u ? mine : 1u; nx = cnt > 0u ? cnt : 1u;
}
__device__ __forceinline__ void xcd_barrier(const XcdBarrier& b) {
    asm volatile("s_waitcnt vmcnt(0)" ::: "memory");
    __syncthreads();
    if (threadIdx.x == 0) {
        unsigned* bar = b.bar;
        __builtin_amdgcn_s_waitcnt(0);
        unsigned nloc = b.st[0], nx = b.st[1];
        if (nloc == 0u) { xcd_barrier_complete(bar, b.x, nloc, nx); b.st[0] = nloc; b.st[1] = nx; }
        const unsigned old = xb_add(&bar[XB_XSUB(b.x)], 1u);
        const unsigned gen = old / nloc;
        if (old + 1u == (gen + 1u) * nloc) {
            __builtin_amdgcn_fence(__ATOMIC_RELEASE, "agent");
            asm volatile("s_waitcnt vmcnt(0)" ::: "memory");
            const unsigned og = xb_add(&bar[XB_TOP], 1u);
            const unsigned tg = og / nx;
            if (og + 1u == (tg + 1u) * nx) xb_add(&bar[XB_TOPGEN], 1u);
            else XB_SPIN(xb_ld(&bar[XB_TOPGEN]) == tg, bar);
            __builtin_amdgcn_fence(__ATOMIC_ACQUIRE, "agent");
            xb_add(&bar[XB_XGEN(b.x)], 1u);
            asm volatile("s_waitcnt vmcnt(0)" ::: "memory");
        } else {
            XB_SPIN(xb_ld(&bar[XB_XGEN(b.x)]) == gen, bar);
            __builtin_amdgcn_fence(__ATOMIC_ACQUIRE, "agent");
            asm volatile("s_waitcnt vmcnt(0)" ::: "memory");
        }
    }
    __syncthreads();
}

struct Args { const float* in[25]; float* out; unsigned char* ws; int ph_lo, ph_hi, use_bar, pad; };
__global__ void __launch_bounds__(NTHR, 2) mega(Args args) {
    extern __shared__ __attribute__((aligned(16))) unsigned char lds[];
    Frame F;
    F.lds = (LAS unsigned char*)lds;
    F.MISC = (volatile LAS unsigned*)(F.lds + MISC_OFF);
    F.tid = threadIdx.x; F.lane = F.tid & 63; F.wave = __builtin_amdgcn_readfirstlane(F.tid >> 6);
    F.G = gridDim.x; F.bid = blockIdx.x;
    F.ws = args.ws; F.ctl = (gu32*)(args.ws + WS_CTL);
#pragma unroll
    for (int i = 0; i < 25; ++i) F.in[i] = args.in[i];
    F.out = args.out;
    for (int u = F.tid; u < (LDS_BYTES - LDSCTL_OFF) / 4; u += NTHR) ((LAS unsigned*)(F.lds + LDSCTL_OFF))[u] = 0u;
    __syncthreads();
    LAS int* ts = (LAS int*)(F.lds + MISC_OFF + 64);
    XcdBarrier bar; bar.bar = (unsigned*)(F.ctl + CW_BAR); bar.x = 0; bar.st = nullptr;
    if (args.use_bar) bar = xcd_barrier_post((unsigned*)(F.ctl + CW_BAR), F.MISC + 8);
    const int lo = args.ph_lo, hi = args.ph_hi;
#if PROBE_T == 100
    if (F.tid == 0) __hip_atomic_store(F.ctl + CW_LN1 + F.bid, xb_xcc_id() + 1u, RLX_AGENT);
#endif
#if PROBE_T >= 0
    unsigned long long pt0 = __builtin_amdgcn_s_memrealtime(), pdelay = 0ull;
#endif
#if MK_CG_SYNC == 2
    if (args.use_bar == 2) cooperative_groups::this_grid().sync();
#endif
#define IN(k) (lo <= (k) && (k) < hi)
#if PROBE_T >= 0
#if PROBE_T == 100
#define PROBE_STAMP(k) do { if ((k) == 0 && F.bid == 0 && F.tid == 0) { unsigned mm = 0; for (int b_ = 0; b_ < 256; ++b_) mm += (__hip_atomic_load(F.ctl + CW_LN1 + b_, RLX_AGENT) != __hip_atomic_load(F.ctl + CW_LN1 + (b_ & 7), RLX_AGENT)) ? 1u : 0u; pdelay = 100ull * mm; } } while (0)
#else
#define PROBE_STAMP(k) do { if ((k) == PROBE_T) pdelay = __builtin_amdgcn_s_memrealtime() - pt0; } while (0)
#endif
#else
#define PROBE_STAMP(k) do { } while (0)
#endif
#define REPS(k) for (int _r = 0; _r < ((k) == PROBE_PH ? PROBE_N : 1); ++_r)
#define SEAM(k) do { if (IN(k) && IN((k) + 1)) { if (MK_CG_SYNC == 1 && (k) == 0) cooperative_groups::this_grid().sync(); else { xcd_barrier(bar); if (PROBE_PH == 100) for (int _b = 1; _b < PROBE_N; ++_b) xcd_barrier(bar); } PROBE_STAMP(k); } } while (0)

    if (IN(0)) { REPS(0) p0_prologue(F); SEAM(0); }
    if (IN(1)) {
        p1_bcum(F, F.bid, F.G);
        const int g8 = F.bid >> 3, nsb = (g8 * NSG) >> 5; const bool streamer = (F.G == 256) && ((((g8 + 1) * NSG) >> 5) != nsb);
        if (!streamer) {
            pg8::Gemm g{WSP(pg8::bf16_t, WS_XB), WSP(pg8::bf16_t, WS_WIN), T + MEMN, HW + 4096, D}; pg8::OrderG1 S;
            if (F.G == 256) S.init(F.G - 8 * NSG, F.bid - 8 * nsb); else S.init(F.G, F.bid);
            pg8::EpiH E{WSP(pg8::bf16_t, WS_H), WSP(pg8::bf16_t, WS_KVM), WSP(float, WS_RC), WSP(float, WS_RS)};
            pg8::gemm_phase<pg8::EpiH, pg8::OrderG1, true, true>(F.lds, g, S, E);
        }
        transpose_queue(F);
        if (PROBE_PH == 102) for (int _q = 1; _q < PROBE_N; ++_q) transpose_queue(F, _q);
        SEAM(1);
    }
#if PROBE_PH == 101
    if (IN(1)) {
        pg8::Gemm g{WSP(pg8::bf16_t, WS_XB), WSP(pg8::bf16_t, WS_WIN), T + MEMN, HW + 4096, D}; pg8::OrderG1 S; S.init(F.G, F.bid);
        pg8::EpiH E{WSP(pg8::bf16_t, WS_H), WSP(pg8::bf16_t, WS_KVM), WSP(float, WS_RC), WSP(float, WS_RS)};
        pg8::gemm_phase<pg8::EpiH, pg8::OrderG1, true, true>(F.lds, g, S, E);
        xcd_barrier(bar);
    }
#endif
    if (IN(2)) { REPS(2) p2_kv(F); SEAM(2); }
    if (IN(3)) { p3_scan(F); SEAM(3); }
#if PROBE_PH == 103
    if (IN(3)) { p2_kv(F); xcd_barrier(bar); p3_scan(F); xcd_barrier(bar); }
#endif
    if (IN(4)) { REPS(4) p4_out(F); SEAM(4); }
    if (IN(5)) {
        pg8::Gemm g{WSP(pg8::bf16_t, WS_MIXED), WSP(pg8::bf16_t, WS_WMIX), T, D, D}; pg8::StaticOrder S; S.init(T, D, F.G, F.bid);
#if MK_FUSE_LN1
        pg8::EpiLN<0> E{F.in[0], nullptr, nullptr, nullptr, WSP(float, WS_Y1), WSP(float, WS_ST1), WSP(pg8::bf16_t, WS_H1B), F.in[8], F.in[9], WSP(unsigned long long, WS_XCH1), (unsigned*)(F.ctl + CW_LN1)};
        pg8::gemm_phase<pg8::EpiLN<0>, pg8::StaticOrder, false, true>(F.lds, g, S, E);
        SEAM(5);
    }
#else
        pg8::EpiResX E{F.in[0], WSP(float, WS_Y1), ALPHA};
#if PROBE_T >= 201 && PROBE_T <= 203
        if (F.bid == 0 && F.tid == 0) ((unsigned long long*)(F.ws + 32768))[0] = __builtin_amdgcn_s_memrealtime();
#endif
        REPS(5) pg8::gemm_phase<pg8::EpiResX, pg8::StaticOrder, MK_ALIGN1, true>(F.lds, g, S, E);
        SEAM(5);
#if PROBE_T >= 201 && PROBE_T <= 203
        if (F.bid == 0 && F.tid == 0) { unsigned long long* q_ = (unsigned long long*)(F.ws + 32768); q_[3] = __builtin_amdgcn_s_memrealtime();
            pdelay = PROBE_T == 201 ? q_[1] - q_[0] : PROBE_T == 202 ? q_[2] - q_[1] : q_[3] - q_[2]; }
#endif
    }
    if (IN(6)) { REPS(6) ln_apply_plain(F, WSP(float, WS_Y1), F.in[8], F.in[9], WSP(bf16, WS_H1B), WSP(float, WS_ST1)); SEAM(6); }
#endif
    if (IN(7)) {
        pg8::Gemm g{WSP(pg8::bf16_t, WS_H1B), WSP(pg8::bf16_t, WS_WMQ), T, D, D}; pg8::StaticOrder S; S.init(T, D, F.G, F.bid);
        pg8::EpiB E{WSP(pg8::bf16_t, WS_QB), D, -1, 8192u * 2048u * 2u};
        REPS(7) pg8::gemm_phase<pg8::EpiB, pg8::StaticOrder, MK_ALIGN1, true>(F.lds, g, S, E);
        SEAM(7);
    }
    if (IN(8)) { REPS(8) p8_attn(F); SEAM(8);
#if PROBE_T >= 221 && PROBE_T <= 224
        if (F.bid == 0 && F.tid == 0) { unsigned long long* q_ = (unsigned long long*)(F.ws + 32768); q_[3] = __builtin_amdgcn_s_memrealtime();
            pdelay = PROBE_T == 221 ? q_[1] - q_[0] : PROBE_T == 222 ? q_[2] - q_[1] : q_[3] - q_[2]; }
#endif
    }
    if (IN(9)) {
        pg8::Gemm g{WSP(pg8::bf16_t, WS_ATT), WSP(pg8::bf16_t, WS_WMO), T, D, D}; pg8::StaticOrder S; S.init(T, D, F.G, F.bid);
        pg8::EpiResLN E{WSP(float, WS_Y1), WSP(float, WS_ST1), F.in[8], F.in[9], WSP(float, WS_Y2), ALPHA};
        REPS(9) pg8::gemm_phase<pg8::EpiResLN, pg8::StaticOrder, MK_ALIGN1, true>(F.lds, g, S, E);
        SEAM(9);
    }
    if (IN(10)) { p10_ln_router(F); SEAM(10);
#if PROBE_T >= 231 && PROBE_T <= 236
        if (F.bid == 0 && F.tid == 0) { unsigned long long* q_ = (unsigned long long*)(F.ws + 32768); q_[6] = __builtin_amdgcn_s_memrealtime();
            pdelay = 10ull * (q_[PROBE_T - 230] - q_[PROBE_T - 231]); }
#endif
    }
#if MK_MOE_F32
#define MOE_GEMM_GU(l, g, S, E) pg8::gemm_phase_bf32<pg8::EpiSwi, pg8::MoeOrder, true, true, true>(l, g, S, E)
#define MOE_GEMM_DN(l, g, S, E) pg8::gemm_phase_bf32<pg8::EpiB, pg8::MoeOrder, true, false, false>(l, g, S, E)
#else
#define MOE_GEMM_GU(l, g, S, E) pg8::gemm_phase<pg8::EpiSwi, pg8::MoeOrder, true, true, true, MK_MOE_BNT>(l, g, S, E)
#define MOE_GEMM_DN(l, g, S, E) pg8::gemm_phase<pg8::EpiB, pg8::MoeOrder, true, true, false, MK_MOE_BNT>(l, g, S, E)
#endif
    if (IN(12)) {
#if PROBE_T >= 211 && PROBE_T <= 214
        if (F.bid == 0 && F.tid == 0) ((unsigned long long*)(F.ws + 32768))[0] = __builtin_amdgcn_s_memrealtime();
#endif
        moe_tile_starts(F, ts);
#if PROBE_T >= 211 && PROBE_T <= 214
        if (F.bid == 0 && F.tid == 0) ((unsigned long long*)(F.ws + 32768))[4] = __builtin_amdgcn_s_memrealtime();
#endif
        const int U = ts[32] * 4;
        pg8::Gemm g{WSP(pg8::bf16_t, WS_H2B), WSP(pg8::bf16_t, WS_WGU), PMAX, 32 * 1024, D, WSP(int, WS_TOKS)};
        pg8::MoeOrder S{(const PG8_LAS int*)ts, F.G, F.bid, 4, U < F.G ? U : F.G, F.in[20], F.in[21], 2048, 512, 0};
        pg8::EpiSwi E{WSP(pg8::bf16_t, WS_HID)};
        MOE_GEMM_GU(F.lds, g, S, E);
        SEAM(12);
#if PROBE_T >= 211 && PROBE_T <= 214
        if (F.bid == 0 && F.tid == 0) { unsigned long long* q_ = (unsigned long long*)(F.ws + 32768); q_[3] = __builtin_amdgcn_s_memrealtime();
            pdelay = PROBE_T == 211 ? q_[4] - q_[0] : PROBE_T == 212 ? q_[1] - q_[4] : PROBE_T == 213 ? q_[2] - q_[1] : q_[3] - q_[2]; }
#endif
    }
    if (IN(13)) {
        moe_tile_starts(F, ts);
        const int RT = ts[32], U = RT * 4, nbg = U > F.G ? U - F.G : 0, R1 = (F.G / 4) < RT ? (F.G / 4) : RT;
        {
            pg8::Gemm g{WSP(pg8::bf16_t, WS_H2B), WSP(pg8::bf16_t, WS_WGU), PMAX, 32 * 1024, D, WSP(int, WS_TOKS)};
            pg8::MoeOrder S{(const PG8_LAS int*)ts, F.G, F.bid, 4, U, F.in[20], F.in[21], 2048, 512, F.G};
            pg8::EpiSwi E{WSP(pg8::bf16_t, WS_HID)};
            MOE_GEMM_GU(F.lds, g, S, E);
        }
        {
            pg8::Gemm g{WSP(pg8::bf16_t, WS_HID), WSP(pg8::bf16_t, WS_WD), PMAX, 32 * 2048, 512};
            pg8::MoeOrder S{(const PG8_LAS int*)ts, F.G - nbg, F.bid >= nbg ? F.bid - nbg : -1, 8, R1 * 8, F.in[22], nullptr, 512, 2048, 0};
            pg8::EpiB E{WSP(pg8::bf16_t, WS_YS), D, 7, 24576u * 2048u * 2u};
            MOE_GEMM_DN(F.lds, g, S, E);
        }
        SEAM(13);
    }
    if (IN(14)) {
        moe_tile_starts(F, ts);
        const int RT = ts[32], R1 = (F.G / 4) < RT ? (F.G / 4) : RT;
        pg8::Gemm g{WSP(pg8::bf16_t, WS_HID), WSP(pg8::bf16_t, WS_WD), PMAX, 32 * 2048, 512};
        pg8::MoeOrder S{(const PG8_LAS int*)ts, F.G, F.bid, 8, RT * 8, F.in[22], nullptr, 512, 2048, R1 * 8};
        pg8::EpiB E{WSP(pg8::bf16_t, WS_YS), D, 7, 24576u * 2048u * 2u};
        MOE_GEMM_DN(F.lds, g, S, E);
        SEAM(14);
    }
    if (IN(15)) { moe_tile_starts(F, ts); REPS(15) p13_combine(F, ts); }
#if PROBE_T >= 0
    if (F.bid == 0 && F.tid == 0) { const unsigned long long te = __builtin_amdgcn_s_memrealtime(); while (__builtin_amdgcn_s_memrealtime() - te < pdelay) __builtin_amdgcn_s_sleep(8); }
#endif
#undef IN
#undef SEAM
#undef REPS
}

extern "C" void kernel_launch(void* const* d_in, const int* in_sizes, int n_in, void* d_out, int out_size, void* d_ws, size_t ws_size, hipStream_t stream) {
    static int grid = 0;
    if (grid == 0) {
        if (n_in != 25 || in_sizes[0] != T * D || out_size != T * D || ws_size < WS_END) { fprintf(stderr, "kernel_launch: unexpected shapes / workspace (%d inputs, ws %zu)\n", n_in, ws_size); grid = -1; return; }
        int dev = 0, cus = 0;
        if (hipGetDevice(&dev) != hipSuccess || hipDeviceGetAttribute(&cus, hipDeviceAttributeMultiprocessorCount, dev) != hipSuccess) { grid = -1; return; }
        if (hipFuncSetAttribute((const void*)mega, hipFuncAttributeMaxDynamicSharedMemorySize, LDS_BYTES) != hipSuccess) { fprintf(stderr, "kernel_launch: hipFuncSetAttribute failed\n"); grid = -1; return; }
        int per_cu = 0;
        if (hipOccupancyMaxActiveBlocksPerMultiprocessor(&per_cu, (const void*)mega, NTHR, LDS_BYTES) != hipSuccess || per_cu < 1) { fprintf(stderr, "kernel_launch: occupancy query failed / 0 blocks per CU\n"); grid = -1; return; }
        (void)hipGetLastError();
        grid = cus;
    }
    if (grid < 0) return;
    if (hipMemsetAsync((char*)d_ws + WS_CTL, 0, CTL_ZERO_BYTES, stream) != hipSuccess) return;
    Args a{};
    for (int i = 0; i < 25; ++i) a.in[i] = (const float*)d_in[i];
    a.out = (float*)d_out; a.ws = (unsigned char*)d_ws;
#if MK_ONE_LAUNCH
    a.ph_lo = 0; a.ph_hi = NPH; a.use_bar = 1;
#if MK_CG_SYNC
    { void* kargs[] = {(void*)&a};
      hipError_t e = hipLaunchCooperativeKernel((const void*)mega, dim3(grid), dim3(NTHR), kargs, LDS_BYTES, stream);
      if (e != hipSuccess) fprintf(stderr, "cooperative launch failed: %s (grid %d)\n", hipGetErrorString(e), grid); }
#else
    hipLaunchKernelGGL(mega, dim3(grid), dim3(NTHR), LDS_BYTES, stream, a);
#endif
#else
    for (int p = 0; p < NPH; ++p) { a.ph_lo = p; a.ph_hi = p + 1; a.use_bar = 0;
        hipLaunchKernelGGL(mega, dim3(grid), dim3(NTHR), LDS_BYTES, stream, a); }
#endif
}
```

```cpp
#include <hip/hip_runtime.h>
#include <hip/hip_cooperative_groups.h>
#include <cstdio>
#include <cstdint>
#include <cmath>
#ifndef MK_ONE_LAUNCH
#define MK_ONE_LAUNCH 1
#endif
#ifndef MK_CG_SYNC
#define MK_CG_SYNC 2
#endif
#ifndef MK_WT_STORES
#define MK_WT_STORES 0
#endif
#ifndef MK_MOE_F32
#define MK_MOE_F32 0
#endif
#define PROBE_PH -1
#define PROBE_N 1
#define PROBE_T -1
#define WS_Y1_OFF (410ull << 20)
namespace pg8 {
#define PG8_LAS __attribute__((address_space(3)))
typedef unsigned short bf16_t;
typedef short bf16x8 __attribute__((ext_vector_type(8)));
typedef float f32x4 __attribute__((ext_vector_type(4)));
typedef unsigned u32x4 __attribute__((ext_vector_type(4)));
constexpr int BM = 256, BK = 64, HALF = 128, HTB = HALF * BK * 2  , STAGE_BYTES = 8 * HTB, NXCD = 8, WGM = 8;

__host__ __device__ __forceinline__ int lds_byte(int r, int c) { const int st = (r >> 4) * 2 + (c >> 5), rr = r & 15, cc = c & 31, ob = rr * 64 + cc * 2; return st * 1024 + (ob ^ (((ob >> 9) & 1) << 5)); }
__host__ __device__ __forceinline__ void stage_rc(int b, int& R, int& C) { const int st = b / 1024, sb = b % 1024, swz = sb ^ (((sb >> 9) & 1) << 5); R = (st >> 1) * 16 + swz / 64; C = (st & 1) * 32 + (swz % 64) / 2; }
__host__ __device__ __forceinline__ int perm32(int rho) { const int n = rho >> 4, i = rho & 15; return 8 * (i >> 2) + 4 * n + (i & 3); }

struct Unit { int pm, pn; };
struct Gemm { const bf16_t* A; const bf16_t* Bt; int M, N, K; const int* tok; };

struct StaticOrder {
    int nM, nN, nwg, G, c;
    __host__ __device__ void init(int M, int N, int G_, int c_) { nM = M / BM; nN = N / BM; nwg = nM * nN; G = G_; c = c_; }
    __host__ __device__ bool next(int i, Unit& u) const {
        const long L = (long)i * G + c; if (L >= nwg) return false;
        int wgid = (int)L; { const int q = nwg / NXCD, r = nwg % NXCD, xcd = wgid % NXCD, off = wgid / NXCD; wgid = (xcd < r ? xcd * (q + 1) : r * (q + 1) + (xcd - r) * q) + off; }
        const int nig = WGM * nN, gid = wgid / nig, fm = gid * WGM, gsz = (nM - fm) < WGM ? (nM - fm) : WGM;
        u.pm = fm + ((wgid % nig) % gsz); u.pn = (wgid % nig) / gsz; return true;
    }
    __device__ __forceinline__ void a_ready(const Unit&) const {}
    __device__ __forceinline__ void done(const Unit&) const {}
};


typedef unsigned u32x2 __attribute__((ext_vector_type(2)));
__device__ __forceinline__ unsigned cvt_pk_bf16(float lo, float hi) { unsigned r; asm volatile("v_cvt_pk_bf16_f32 %0, %1, %2" : "=v"(r) : "v"(lo), "v"(hi)); return r; }
__device__ __forceinline__ u32x4 pack8(const f32x4 a, const f32x4 b) { u32x4 w; w.x = cvt_pk_bf16(a[0], a[1]); w.y = cvt_pk_bf16(a[2], a[3]); w.z = cvt_pk_bf16(b[0], b[1]); w.w = cvt_pk_bf16(b[2], b[3]); return w; }
#if MK_WT_STORES
#define PG8_RSRC(base, bytes) __builtin_amdgcn_make_buffer_rsrc((void*)(base), 0, (int)(bytes), 0x00020000)
#define PG8_ST16(rs, base, byteoff, val) __builtin_amdgcn_raw_buffer_store_b128(__builtin_bit_cast(u32x4, (val)), (rs), (unsigned)(byteoff), 0, 16)
#else
#define PG8_RSRC(base, bytes) 0
#define PG8_ST16(rs, base, byteoff, val) (*(u32x4*)((char*)(base) + (size_t)(byteoff)) = __builtin_bit_cast(u32x4, (val)))
#endif
__device__ __forceinline__ float silu_f(float x) { return x * __builtin_amdgcn_rcpf(1.0f + __builtin_amdgcn_exp2f(-1.4426950408889634f * x)); }

struct EpiH {
    static constexpr bool PERM = true, AFTER_DRAIN = false;
    bf16_t* H; bf16_t* KVM; const float* rc; const float* rs;
    __device__ __forceinline__ void operator()(const f32x4 (&acc)[2][2][4][2], const Unit& u, int wr, int wc, int fr, int fq) const {
        const int cb = wc * 32 + 8 * fq;
        const auto rsH = PG8_RSRC(H, 8192u * 7168u * 2u); (void)rsH;
        if (u.pm >= 32) {
#pragma unroll
            for (int ai = 0; ai < 2; ++ai)
#pragma unroll
                for (int m = 0; m < 4; ++m) { bf16_t* rowp = KVM + (size_t)(wr * 64 + fr + ai * HALF + m * 16) * 4096 + (u.pn - 28) * BM + cb;
#pragma unroll
                    for (int bj = 0; bj < 2; ++bj) *(u32x4*)(rowp + bj * HALF) = pack8(acc[ai][bj][m][0], acc[ai][bj][m][1]); }
            return;
        }
        const int row0 = u.pm * BM + wr * 64 + fr;
        if (u.pn < 8) {
            const float sc = u.pn >= 4 ? 0.0625f : 1.0f;
#pragma unroll
            for (int ai = 0; ai < 2; ++ai)
#pragma unroll
                for (int m = 0; m < 4; ++m) { const int row = row0 + ai * HALF + m * 16;
                    const float* cr = rc + (size_t)row * 128 + cb; const float* sr = rs + (size_t)row * 128 + cb;
                    const f32x4 c0 = *(const f32x4*)cr * sc, c1 = *(const f32x4*)(cr + 4) * sc, s0 = *(const f32x4*)sr * sc, s1 = *(const f32x4*)(sr + 4) * sc;
                    const f32x4 t1a = acc[ai][0][m][0], t1b = acc[ai][0][m][1], t2a = acc[ai][1][m][0], t2b = acc[ai][1][m][1];
                    const unsigned bo = (unsigned)(((size_t)u.pn * 8192 + row) * BM + cb) * 2u;
                    PG8_ST16(rsH, H, bo, pack8(t1a * c0 - t2a * s0, t1b * c1 - t2b * s1));
                    PG8_ST16(rsH, H, bo + 2 * HALF, pack8(t1a * s0 + t2a * c0, t1b * s1 + t2b * c1)); }
        } else {
            const float sc = (u.pn == 16 || u.pn == 17) ? 0.08838834764831845f : 1.0f;
#pragma unroll
            for (int ai = 0; ai < 2; ++ai)
#pragma unroll
                for (int m = 0; m < 4; ++m) { const unsigned bo = (unsigned)(((size_t)u.pn * 8192 + row0 + ai * HALF + m * 16) * BM + cb) * 2u;
#pragma unroll
                    for (int bj = 0; bj < 2; ++bj) PG8_ST16(rsH, H, bo + bj * 2 * HALF, pack8(acc[ai][bj][m][0] * sc, acc[ai][bj][m][1] * sc)); }
        }
    }
};
struct EpiB {
    static constexpr bool PERM = true, AFTER_DRAIN = false;
    bf16_t* O; int ldc; int pmask; unsigned obytes;
    __device__ __forceinline__ void operator()(const f32x4 (&acc)[2][2][4][2], const Unit& u, int wr, int wc, int fr, int fq) const {
        const int row0 = u.pm * BM + wr * 64 + fr, col0 = (u.pn & pmask) * BM + wc * 32 + 8 * fq;
        const auto rsO = PG8_RSRC(O, obytes); (void)rsO;
#pragma unroll
        for (int ai = 0; ai < 2; ++ai)
#pragma unroll
            for (int m = 0; m < 4; ++m) { const unsigned bo = (unsigned)((size_t)(row0 + ai * HALF + m * 16) * ldc + col0) * 2u;
#pragma unroll
                for (int bj = 0; bj < 2; ++bj) PG8_ST16(rsO, O, bo + bj * 2 * HALF, pack8(acc[ai][bj][m][0], acc[ai][bj][m][1])); }
    }
};
struct EpiSwi {
    static constexpr bool PERM = true, AFTER_DRAIN = false;
    bf16_t* O;
    __device__ __forceinline__ void operator()(const f32x4 (&acc)[2][2][4][2], const Unit& u, int wr, int wc, int fr, int fq) const {
#if PROBE_T >= 211 && PROBE_T <= 214
        if (blockIdx.x == 0 && threadIdx.x == 0) ((unsigned long long*)((char*)O - (424ull << 20) + 32768))[1] = __builtin_amdgcn_s_memrealtime();
#endif
        const int row0 = u.pm * BM + wr * 64 + fr, col0 = (u.pn & 3) * HALF + wc * 32 + 8 * fq;
        const auto rsO = PG8_RSRC(O, 24576u * 512u * 2u); (void)rsO;
#pragma unroll
        for (int ai = 0; ai < 2; ++ai)
#pragma unroll
            for (int m = 0; m < 4; ++m) { const unsigned bo = (unsigned)((size_t)(row0 + ai * HALF + m * 16) * 512 + col0) * 2u;
                f32x4 h0, h1;
#pragma unroll
                for (int i = 0; i < 4; ++i) { h0[i] = silu_f(acc[ai][0][m][0][i]) * acc[ai][1][m][0][i]; h1[i] = silu_f(acc[ai][0][m][1][i]) * acc[ai][1][m][1][i]; }
                PG8_ST16(rsO, O, bo, pack8(h0, h1)); }
#if PROBE_T >= 211 && PROBE_T <= 214
        asm volatile("s_waitcnt vmcnt(0)" ::: "memory");
        if (blockIdx.x == 0 && threadIdx.x == 0) ((unsigned long long*)((char*)O - (424ull << 20) + 32768))[2] = __builtin_amdgcn_s_memrealtime();
#endif
    }
};
struct EpiResX {
    static constexpr bool PERM = false, AFTER_DRAIN = false;
    const float* X; float* Y; float alpha;
    __device__ __forceinline__ void operator()(const f32x4 (&acc)[2][2][4][2], const Unit& u, int wr, int wc, int fr, int fq) const {
#if PROBE_T >= 201 && PROBE_T <= 203
        if (blockIdx.x == 0 && threadIdx.x == 0) ((unsigned long long*)((char*)Y - WS_Y1_OFF + 32768))[1] = __builtin_amdgcn_s_memrealtime();
#endif
        const int row0 = u.pm * BM + wr * 64 + fr, col0 = u.pn * BM + wc * 32 + 4 * fq;
        const auto rsY = PG8_RSRC(Y, 8192u * 2048u * 4u); (void)rsY;
#pragma unroll
        for (int ai = 0; ai < 2; ++ai)
#pragma unroll
            for (int m = 0; m < 4; ++m) { const size_t off = (size_t)(row0 + ai * HALF + m * 16) * 2048 + col0;
#pragma unroll
                for (int bj = 0; bj < 2; ++bj)
#pragma unroll
                    for (int n = 0; n < 2; ++n) { const f32x4 xv = *(const f32x4*)(X + off + bj * HALF + n * 16); const f32x4 yv = xv * alpha + acc[ai][bj][m][n]; PG8_ST16(rsY, Y, (off + bj * HALF + n * 16) * 4, yv); } }
#if PROBE_T >= 201 && PROBE_T <= 203
        asm volatile("s_waitcnt vmcnt(0)" ::: "memory");
        if (blockIdx.x == 0 && threadIdx.x == 0) ((unsigned long long*)((char*)Y - WS_Y1_OFF + 32768))[2] = __builtin_amdgcn_s_memrealtime();
#endif
    }
};
struct EpiResLN {
    static constexpr bool PERM = false, AFTER_DRAIN = false;
    const float* Yin; const float* st; const float* g; const float* b; float* Y; float alpha;
    __device__ __forceinline__ void operator()(const f32x4 (&acc)[2][2][4][2], const Unit& u, int wr, int wc, int fr, int fq) const {
        const int row0 = u.pm * BM + wr * 64 + fr, col0 = u.pn * BM + wc * 32 + 4 * fq;
        const auto rsY = PG8_RSRC(Y, 8192u * 2048u * 4u); (void)rsY;
        f32x4 gv[2][2], bv[2][2];
#pragma unroll
        for (int bj = 0; bj < 2; ++bj)
#pragma unroll
            for (int n = 0; n < 2; ++n) { gv[bj][n] = *(const f32x4*)(g + col0 + bj * HALF + n * 16) * alpha; bv[bj][n] = *(const f32x4*)(b + col0 + bj * HALF + n * 16) * alpha; }
#pragma unroll
        for (int ai = 0; ai < 2; ++ai)
#pragma unroll
            for (int m = 0; m < 4; ++m) { const int row = row0 + ai * HALF + m * 16; const size_t off = (size_t)row * 2048 + col0;
                const float mu = st[2 * row], rstd = st[2 * row + 1];
#pragma unroll
                for (int bj = 0; bj < 2; ++bj)
#pragma unroll
                    for (int n = 0; n < 2; ++n) { const f32x4 yv = *(const f32x4*)(Yin + off + bj * HALF + n * 16);
                        const f32x4 yo = ((yv - mu) * rstd) * gv[bj][n] + bv[bj][n] + acc[ai][bj][m][n]; PG8_ST16(rsY, Y, (off + bj * HALF + n * 16) * 4, yo); } }
    }
};

struct EpiResB {
    static constexpr bool PERM = false, AFTER_DRAIN = false;
    const bf16_t* HB; float* Y; float alpha;
    __device__ __forceinline__ void operator()(const f32x4 (&acc)[2][2][4][2], const Unit& u, int wr, int wc, int fr, int fq) const {
        const int row0 = u.pm * BM + wr * 64 + fr, col0 = u.pn * BM + wc * 32 + 4 * fq;
        const auto rsY = PG8_RSRC(Y, 8192u * 2048u * 4u); (void)rsY;
#pragma unroll
        for (int ai = 0; ai < 2; ++ai)
#pragma unroll
            for (int m = 0; m < 4; ++m) { const size_t off = (size_t)(row0 + ai * HALF + m * 16) * 2048 + col0;
#pragma unroll
                for (int bj = 0; bj < 2; ++bj)
#pragma unroll
                    for (int n = 0; n < 2; ++n) { const u32x2 hw = *(const u32x2*)(HB + off + bj * HALF + n * 16);
                        const f32x4 hv = {__uint_as_float(hw.x << 16), __uint_as_float(hw.x & 0xffff0000u), __uint_as_float(hw.y << 16), __uint_as_float(hw.y & 0xffff0000u)};
                        const f32x4 yo = hv * alpha + acc[ai][bj][m][n]; PG8_ST16(rsY, Y, (off + bj * HALF + n * 16) * 4, yo); } }
    }
};

struct OrderG1 {
    StaticOrder so; int G, c;
    __device__ void init(int G_, int c_) { so.init(8192, 7168, G_, c_); G = G_; c = c_; }
    __device__ bool next(int i, Unit& u) const {
        const int L = i * G + c;
        if (L < 896) return so.next(i, u);
        if (L >= 912) return false;
        u.pm = 32; u.pn = 28 + (L - 896); return true;
    }
    __device__ __forceinline__ void a_ready(const Unit&) const {}
    __device__ __forceinline__ void done(const Unit&) const {}
};
struct MoeOrder {
    const PG8_LAS int* ts; int G, c, npn, total; const float* W0; const float* W1; int kdim, ncols; int L0;
    __device__ bool next(int i, Unit& u) const {
        if (c < 0) return false;
        const int L = L0 + i * G + c; if (L >= total) return false;
        const int rt = L / npn, pl = L - rt * npn; int e = 0;
        for (int j = 1; j < 32; ++j) e += (ts[j] <= rt) ? 1 : 0;
        u.pm = rt; u.pn = e * npn + pl; return true;
    }
    __device__ __forceinline__ int ldb() const { return ncols; }
    __device__ __forceinline__ int gtile(int pm) const {
        int e = 0; for (int j = 1; j < 32; ++j) e += (ts[j] <= pm) ? 1 : 0;
        return e * 32 + (pm - ts[e]); }
    __device__ __forceinline__ const float* bbase(const Unit& u, int which) const {
        const int e = u.pn / npn, pl = u.pn - e * npn; const size_t eo = (size_t)e * kdim * ncols;
        if (W1) return (which ? W1 : W0) + eo + 128 * pl;
        return W0 + eo + 256 * pl;
    }
    __device__ __forceinline__ void a_ready(const Unit&) const {}
    __device__ __forceinline__ void done(const Unit&) const {}
};

template <int MODE>
struct EpiLN {
    static constexpr bool PERM = false, AFTER_DRAIN = true;
    const float* X; const float* stin; const float* gin; const float* bin;
    float* Yout; float* stout; bf16_t* HB; const float* g; const float* b;
    unsigned long long* xbuf;
    unsigned* cnt;
    __device__ __forceinline__ void operator()(const f32x4 (&)[2][2][4][2], const Unit&, int, int, int, int) const {}
    __device__ __forceinline__ void fused(f32x4 (&acc)[2][2][4][2], const Unit& u, int wr, int wc, int fr, int fq, PG8_LAS unsigned char* lds, int wid, int lane) const {
        typedef float f32x2v __attribute__((ext_vector_type(2)));
        PG8_LAS f32x2v* P = (PG8_LAS f32x2v*)lds;
        PG8_LAS f32x2v* MS = (PG8_LAS f32x2v*)(lds + 8192);
        const int row0 = u.pm * BM + wr * 64 + fr, col0 = u.pn * BM + wc * 32 + 4 * fq;
        float s1[2][4], s2[2][4], mu[2][4], rs[2][4];
#pragma unroll
        for (int ai = 0; ai < 2; ++ai)
#pragma unroll
            for (int m = 0; m < 4; ++m) { s1[ai][m] = 0.f; s2[ai][m] = 0.f; mu[ai][m] = 0.f; rs[ai][m] = 0.f;
                if (MODE == 1) { const int row = row0 + ai * HALF + m * 16; mu[ai][m] = stin[2 * row]; rs[ai][m] = stin[2 * row + 1]; } }
#pragma unroll
        for (int bj = 0; bj < 2; ++bj)
#pragma unroll
            for (int n = 0; n < 2; ++n) {
                f32x4 gvv = {0.f, 0.f, 0.f, 0.f}, bvv = gvv;
                if (MODE == 1) { gvv = *(const f32x4*)(gin + col0 + bj * HALF + n * 16) * 1.189207115002721f; bvv = *(const f32x4*)(bin + col0 + bj * HALF + n * 16) * 1.189207115002721f; }
#pragma unroll
                for (int ai = 0; ai < 2; ++ai)
#pragma unroll
                    for (int m = 0; m < 4; ++m) { const size_t off = (size_t)(row0 + ai * HALF + m * 16) * 2048 + col0 + bj * HALF + n * 16;
                        const f32x4 xv = *(const f32x4*)(X + off);
                        const f32x4 y = (MODE == 1 ? ((xv - mu[ai][m]) * rs[ai][m]) * gvv + bvv : xv * 1.189207115002721f) + acc[ai][bj][m][n];
                        acc[ai][bj][m][n] = y; *(f32x4*)(Yout + off) = y;
                        s1[ai][m] += (y[0] + y[1]) + (y[2] + y[3]); s2[ai][m] += (y[0] * y[0] + y[1] * y[1]) + (y[2] * y[2] + y[3] * y[3]); }
            }
#pragma unroll
        for (int ai = 0; ai < 2; ++ai)
#pragma unroll
            for (int m = 0; m < 4; ++m) { float a1 = s1[ai][m], a2 = s2[ai][m];
                a1 += __shfl_xor(a1, 16); a1 += __shfl_xor(a1, 32); a2 += __shfl_xor(a2, 16); a2 += __shfl_xor(a2, 32);
                if (fq == 0) P[(ai * HALF + wr * 64 + m * 16 + fr) * 4 + wc] = (f32x2v){a1, a2}; }
        asm volatile("s_waitcnt lgkmcnt(0)" ::: "memory"); __builtin_amdgcn_s_barrier(); asm volatile("" ::: "memory");
        const int t = wid * 64 + lane;
        if (t < 256) { const f32x2v a = P[t * 4 + 0], b2 = P[t * 4 + 1], c = P[t * 4 + 2], d = P[t * 4 + 3];
            const float S1 = (a.x + b2.x) + (c.x + d.x), S2 = (a.y + b2.y) + (c.y + d.y);
            __hip_atomic_store(xbuf + ((size_t)(u.pm * 8 + u.pn) * 256 + t), ((unsigned long long)__float_as_uint(S2) << 32) | __float_as_uint(S1), __ATOMIC_RELAXED, __HIP_MEMORY_SCOPE_AGENT);
            asm volatile("s_waitcnt vmcnt(0)" ::: "memory");
            if (lane == 0) __hip_atomic_fetch_add(cnt + 64 * u.pm, 1u, __ATOMIC_RELAXED, __HIP_MEMORY_SCOPE_AGENT); }
        if (wid == 0) {
            const unsigned long long t0 = __builtin_amdgcn_s_memrealtime();
            while ((unsigned)__builtin_amdgcn_readfirstlane(__hip_atomic_load(cnt + 64 * u.pm, __ATOMIC_RELAXED, __HIP_MEMORY_SCOPE_AGENT)) < 32u) {
                if (__builtin_amdgcn_s_memrealtime() - t0 > 2000000ull) break;
                __builtin_amdgcn_s_sleep(2); }
            __builtin_amdgcn_fence(__ATOMIC_ACQUIRE, "agent");
        }
        asm volatile("s_waitcnt vmcnt(0) lgkmcnt(0)" ::: "memory"); __builtin_amdgcn_s_barrier(); asm volatile("" ::: "memory");
        if (t < 256) { float S1 = 0.f, S2 = 0.f;
#pragma unroll
            for (int j = 0; j < 8; ++j) { const unsigned long long w = __hip_atomic_load(xbuf + ((size_t)(u.pm * 8 + j) * 256 + t), __ATOMIC_RELAXED, __HIP_MEMORY_SCOPE_AGENT); S1 += __uint_as_float((unsigned)w); S2 += __uint_as_float((unsigned)(w >> 32)); }
            const float mean = S1 * (1.f / 2048.f), var = fmaxf(S2 * (1.f / 2048.f) - mean * mean, 0.f), rstd = 1.0f / sqrtf(var + 1e-5f);
            MS[t] = (f32x2v){mean, rstd};
            if (u.pn == 0) { stout[2 * (u.pm * BM + t)] = mean; stout[2 * (u.pm * BM + t) + 1] = rstd; } }
        asm volatile("s_waitcnt lgkmcnt(0)" ::: "memory"); __builtin_amdgcn_s_barrier(); asm volatile("" ::: "memory");
#pragma unroll
        for (int bj = 0; bj < 2; ++bj)
#pragma unroll
            for (int n = 0; n < 2; ++n) { const f32x4 gN = *(const f32x4*)(g + col0 + bj * HALF + n * 16), bN = *(const f32x4*)(b + col0 + bj * HALF + n * 16);
#pragma unroll
                for (int ai = 0; ai < 2; ++ai)
#pragma unroll
                    for (int m = 0; m < 4; ++m) { const int rl = ai * HALF + wr * 64 + m * 16 + fr; const f32x2v ms = MS[rl]; const size_t off = (size_t)(u.pm * BM + rl) * 2048 + col0 + bj * HALF + n * 16;
                        const f32x4 h = ((acc[ai][bj][m][n] - ms.x) * ms.y) * gN + bN;
                        u32x2 w; w.x = cvt_pk_bf16(h[0], h[1]); w.y = cvt_pk_bf16(h[2], h[3]); *(u32x2*)(HB + off) = w; } }
    }
};
template <class Epi, class Sched, bool ALIGN_EPI = false, bool SP2 = false, bool GATHER = false, bool BNT = false>
__device__ __forceinline__ void gemm_phase(PG8_LAS unsigned char* lds, const Gemm g, const Sched& S, const Epi& E) {
    const int tid = threadIdx.x, wid = __builtin_amdgcn_readfirstlane(tid >> 6), lane = tid & 63, wr = wid >> 2, wc = wid & 3, fr = lane & 15, fq = lane >> 4;
    const int K = g.K, nt = K / BK;
    unsigned voffA[2], voffB[2];
#pragma unroll
    for (int i = 0; i < 2; ++i) { int R, C; stage_rc(tid * 16 + i * 8192, R, C); const int Rb = Epi::PERM ? ((R & ~31) + perm32(R & 31)) : R;
        voffA[i] = (unsigned)(R * K + C) * 2u; voffB[i] = (unsigned)(Rb * K + C) * 2u; }
    unsigned coff[2][2], noff[2][2]; int gR[2], gC[2];
#pragma unroll
    for (int i = 0; i < 2; ++i) { int R, C; stage_rc(tid * 16 + i * 8192, R, C); gR[i] = R; gC[i] = C; coff[0][i] = coff[1][i] = noff[0][i] = noff[1][i] = 0u; }
#define PG8_GOFF(dst, pm_) do { if constexpr (GATHER) { const int _gt = S.gtile(pm_) * BM; _Pragma("unroll") for (int _h = 0; _h < 2; ++_h) _Pragma("unroll") for (int _i = 0; _i < 2; ++_i) \
        dst[_h][_i] = ((unsigned)g.tok[_gt + _h * HALF + gR[_i]] * (unsigned)K + (unsigned)gC[_i]) * 2u; } } while (0)
    const size_t kstep = (size_t)(BK * 2);
    const size_t hstep = (size_t)HALF * K * 2;
    const size_t tstep = 2 * hstep;
    const unsigned ldsw = (unsigned)wid * 1024u;
    const int aoff = lds_byte(wr * 64 + fr, fq * 8), boff = lds_byte(wc * 32 + fr, fq * 8);
#define PG8_SA(b, h) (((b) * 2 + (h)) * HTB)
#define PG8_SB(b, h) ((4 + (b) * 2 + (h)) * HTB)
#define PG8_STAGE(bufoff, gbase, voff) do { _Pragma("unroll") for (int _i = 0; _i < 2; ++_i) \
        __builtin_amdgcn_global_load_lds((const unsigned*)((const char*)(gbase) + (voff)[_i]), (PG8_LAS unsigned*)(lds + (bufoff) + ldsw + _i * 8192), 16, 0, 0); } while (0)
#define PG8_STAGEB(bufoff, gbase, voff) do { if constexpr (BNT) { _Pragma("unroll") for (int _i = 0; _i < 2; ++_i) \
        __builtin_amdgcn_global_load_lds((const unsigned*)((const char*)(gbase) + (voff)[_i]), (PG8_LAS unsigned*)(lds + (bufoff) + ldsw + _i * 8192), 16, 0, 2); } else { PG8_STAGE(bufoff, gbase, voff); } } while (0)
#define PG8_STAGEA(bufoff, gptr, hh, kbytes, usenext) do { if constexpr (GATHER) { _Pragma("unroll") for (int _i = 0; _i < 2; ++_i) { const unsigned _o = (usenext) ? noff[hh][_i] : coff[hh][_i]; \
        __builtin_amdgcn_global_load_lds((const unsigned*)((const char*)g.A + (size_t)(kbytes) + _o), (PG8_LAS unsigned*)(lds + (bufoff) + ldsw + _i * 8192), 16, 0, 0); } } else { PG8_STAGE(bufoff, gptr, voffA); } } while (0)
#define PG8_LDA(dst, b, h) do { _Pragma("unroll") for (int m = 0; m < 4; ++m) _Pragma("unroll") for (int k = 0; k < 2; ++k) dst[m][k] = *(const PG8_LAS bf16x8*)(lds + PG8_SA(b, h) + aoff + m * 2048 + k * 1024); } while (0)
#define PG8_LDB(dst, b, h) do { _Pragma("unroll") for (int n = 0; n < 2; ++n) _Pragma("unroll") for (int k = 0; k < 2; ++k) dst[n][k] = *(const PG8_LAS bf16x8*)(lds + PG8_SB(b, h) + boff + n * 2048 + k * 1024); } while (0)
#define PG8_MMA(ai, bj, At, Bt) do { __builtin_amdgcn_s_setprio(1); _Pragma("unroll") for (int m = 0; m < 4; ++m) _Pragma("unroll") for (int n = 0; n < 2; ++n) _Pragma("unroll") for (int k = 0; k < 2; ++k) \
        acc[ai][bj][m][n] = __builtin_amdgcn_mfma_f32_16x16x32_bf16(Bt[n][k], At[m][k], acc[ai][bj][m][n], 0, 0, 0); __builtin_amdgcn_s_setprio(0); } while (0)
#define PG8_WAIT_V(n) asm volatile("s_waitcnt vmcnt(" #n ")" ::: "memory")
#define PG8_WAIT_L(n) asm volatile("s_waitcnt lgkmcnt(" #n ")" ::: "memory")
#define PG8_BAR __builtin_amdgcn_s_barrier()
#define PG8_SCHED __builtin_amdgcn_sched_barrier(0)
    Unit cur, nxt; int ui = 0;
    if (!S.next(0, cur)) return;
    f32x4 acc[2][2][4][2];
#pragma unroll
    for (int a = 0; a < 2; ++a)
#pragma unroll
        for (int b = 0; b < 2; ++b)
#pragma unroll
            for (int m = 0; m < 4; ++m)
#pragma unroll
                for (int n = 0; n < 2; ++n) acc[a][b][m][n] = (f32x4){0.f, 0.f, 0.f, 0.f};
    bf16x8 At[4][2], B0[2][2], B1[2][2];
    const char* cA = (const char*)g.A + (size_t)cur.pm * tstep; const char* cB = (const char*)g.Bt + (size_t)cur.pn * tstep;
    PG8_GOFF(coff, cur.pm);
    S.a_ready(cur);
    if constexpr (SP2) {
        PG8_STAGEB(PG8_SB(0, 0), cB, voffB); PG8_STAGEB(PG8_SB(0, 1), cB + hstep, voffB); PG8_STAGEA(PG8_SA(0, 0), cA, 0, 0, false); PG8_STAGEA(PG8_SA(0, 1), cA + hstep, 1, 0, false);
        if (wr == 1) PG8_BAR;
        PG8_WAIT_V(2); PG8_BAR;
        PG8_STAGEB(PG8_SB(1, 0), cB + kstep, voffB); PG8_STAGEA(PG8_SA(1, 0), cA + kstep, 0, kstep, false); PG8_STAGEB(PG8_SB(1, 1), cB + hstep + kstep, voffB);
        PG8_WAIT_V(6); PG8_BAR;
    } else {
        PG8_STAGEB(PG8_SB(0, 0), cB, voffB); PG8_STAGE(PG8_SA(0, 0), cA, voffA); PG8_STAGEB(PG8_SB(0, 1), cB + hstep, voffB); PG8_STAGE(PG8_SA(0, 1), cA + hstep, voffA);
        if (wr == 1) PG8_BAR;
        PG8_WAIT_V(4); PG8_BAR;
        PG8_STAGEB(PG8_SB(1, 0), cB + kstep, voffB); PG8_STAGE(PG8_SA(1, 0), cA + kstep, voffA); PG8_STAGEB(PG8_SB(1, 1), cB + hstep + kstep, voffB);
        PG8_WAIT_V(6); PG8_BAR;
    }
    for (;;) {
        const bool has_next = S.next(ui + 1, nxt);
        const char* nA = has_next ? (const char*)g.A + (size_t)nxt.pm * tstep : cA; const char* nB = has_next ? (const char*)g.Bt + (size_t)nxt.pn * tstep : cB;
        if constexpr (GATHER) { if (has_next) { PG8_GOFF(noff, nxt.pm); } else { _Pragma("unroll") for (int _h = 0; _h < 2; ++_h) _Pragma("unroll") for (int _i = 0; _i < 2; ++_i) noff[_h][_i] = coff[_h][_i]; } }
        for (int t = 0; t < nt; t += 2) {
            const bool last = (t == nt - 2);
            const char* a1 = cA + (size_t)(t + 1) * kstep;
            const char* a2 = last ? nA : cA + (size_t)(t + 2) * kstep; const char* b2 = last ? nB : cB + (size_t)(t + 2) * kstep;
            const char* a3 = a2 + kstep; const char* b3 = b2 + kstep;
            const size_t k1 = (size_t)(t + 1) * kstep, k2 = last ? 0 : (size_t)(t + 2) * kstep, k3 = k2 + kstep;
            if (last && has_next) S.a_ready(nxt);
            if constexpr (SP2) {
            PG8_LDB(B0, 0, 0); PG8_LDB(B1, 0, 1); PG8_SCHED; PG8_LDA(At, 0, 0); PG8_STAGEA(PG8_SA(1, 1), a1 + hstep, 1, k1, false);
            PG8_WAIT_V(8); PG8_WAIT_L(0); PG8_BAR; PG8_MMA(0, 0, At, B0); PG8_MMA(0, 1, At, B1); PG8_BAR; PG8_SCHED;
            PG8_LDA(At, 0, 1); PG8_STAGEB(PG8_SB(0, 0), b2, voffB); PG8_STAGEB(PG8_SB(0, 1), b2 + hstep, voffB); PG8_STAGEA(PG8_SA(0, 0), a2, 0, k2, last);
            PG8_WAIT_V(8); PG8_WAIT_L(0); PG8_BAR; PG8_MMA(1, 0, At, B0); PG8_MMA(1, 1, At, B1); PG8_BAR; PG8_SCHED;
            PG8_LDB(B0, 1, 0); PG8_LDB(B1, 1, 1); PG8_SCHED; PG8_LDA(At, 1, 0); PG8_STAGEA(PG8_SA(0, 1), a2 + hstep, 1, k2, last);
            PG8_WAIT_V(8); PG8_WAIT_L(0); PG8_BAR; PG8_MMA(0, 0, At, B0); PG8_MMA(0, 1, At, B1); PG8_BAR; PG8_SCHED;
            PG8_LDA(At, 1, 1); PG8_STAGEB(PG8_SB(1, 0), b3, voffB); PG8_STAGEB(PG8_SB(1, 1), b3 + hstep, voffB); PG8_STAGEA(PG8_SA(1, 0), a3, 0, k3, last);
            PG8_WAIT_V(8); PG8_WAIT_L(0); PG8_BAR; PG8_MMA(1, 0, At, B0); PG8_MMA(1, 1, At, B1); PG8_BAR; PG8_SCHED;
            } else {
            PG8_LDB(B0, 0, 0); PG8_SCHED; PG8_LDA(At, 0, 0); PG8_STAGE(PG8_SA(1, 1), a1 + hstep, voffA);
            PG8_WAIT_L(8); PG8_BAR; PG8_WAIT_L(0); PG8_MMA(0, 0, At, B0); PG8_BAR; PG8_SCHED;
            PG8_LDB(B1, 0, 1); PG8_STAGEB(PG8_SB(0, 0), b2, voffB);
            PG8_BAR; PG8_WAIT_L(0); PG8_MMA(0, 1, At, B1); PG8_BAR;
            PG8_LDA(At, 0, 1); PG8_STAGE(PG8_SA(0, 0), a2, voffA);
            PG8_BAR; PG8_WAIT_L(0); PG8_MMA(1, 0, At, B0); PG8_BAR; PG8_SCHED;
            PG8_STAGEB(PG8_SB(0, 1), b2 + hstep, voffB);
            PG8_WAIT_V(6); PG8_BAR; PG8_MMA(1, 1, At, B1); PG8_BAR;
            PG8_LDB(B0, 1, 0); PG8_SCHED; PG8_LDA(At, 1, 0); PG8_STAGE(PG8_SA(0, 1), a2 + hstep, voffA);
            PG8_WAIT_L(8); PG8_BAR; PG8_WAIT_L(0); PG8_MMA(0, 0, At, B0); PG8_BAR; PG8_SCHED;
            PG8_LDB(B1, 1, 1); PG8_STAGEB(PG8_SB(1, 0), b3, voffB);
            PG8_BAR; PG8_WAIT_L(0); PG8_MMA(0, 1, At, B1); PG8_BAR;
            PG8_LDA(At, 1, 1); PG8_STAGE(PG8_SA(1, 0), a3, voffA);
            PG8_BAR; PG8_WAIT_L(0); PG8_MMA(1, 0, At, B0); PG8_BAR; PG8_SCHED;
            PG8_STAGEB(PG8_SB(1, 1), b3 + hstep, voffB);
            PG8_WAIT_V(6); PG8_BAR; PG8_MMA(1, 1, At, B1); PG8_BAR;
            }
        }
        if constexpr (ALIGN_EPI) { if (wr == 0) PG8_BAR; }
        if constexpr (!Epi::AFTER_DRAIN) { E(acc, cur, wr, wc, fr, fq); S.done(cur); }
        if (!has_next) break;
#pragma unroll
        for (int a = 0; a < 2; ++a)
#pragma unroll
            for (int b = 0; b < 2; ++b)
#pragma unroll
                for (int m = 0; m < 4; ++m)
#pragma unroll
                    for (int n = 0; n < 2; ++n) acc[a][b][m][n] = (f32x4){0.f, 0.f, 0.f, 0.f};
        cur = nxt; cA = nA; cB = nB; ++ui;
        if constexpr (GATHER) { _Pragma("unroll") for (int _h = 0; _h < 2; ++_h) _Pragma("unroll") for (int _i = 0; _i < 2; ++_i) coff[_h][_i] = noff[_h][_i]; }
        if constexpr (ALIGN_EPI) { if (wr == 1) PG8_BAR; }
    }
    PG8_WAIT_V(0);
    if constexpr (!ALIGN_EPI) { if (wr == 0) PG8_BAR; }
    PG8_BAR;
    if constexpr (Epi::AFTER_DRAIN) { E.fused(acc, cur, wr, wc, fr, fq, lds, wid, lane); S.done(cur); }
#undef PG8_SA
#undef PG8_SB
#undef PG8_STAGE
#undef PG8_STAGEB
#undef PG8_STAGEA
#undef PG8_GOFF
#undef PG8_LDA
#undef PG8_LDB
#undef PG8_MMA
#undef PG8_WAIT_V
#undef PG8_WAIT_L
#undef PG8_BAR
#undef PG8_SCHED
}
constexpr int PBI = 544, SBI_BYTES = 64 * PBI;
template <class Epi, class Sched, bool ALIGN_EPI = false, bool GATHER = false, bool SPLIT = false>
__device__ __forceinline__ void gemm_phase_bf32(PG8_LAS unsigned char* lds, const Gemm g, const Sched& S, const Epi& E) {
    const int tid = threadIdx.x, wid = __builtin_amdgcn_readfirstlane(tid >> 6), lane = tid & 63, wr = wid >> 2, wc = wid & 3, fr = lane & 15, fq = lane >> 4;
    const int K = g.K, nt = K / BK;
    unsigned voffA[2];
#pragma unroll
    for (int i = 0; i < 2; ++i) { int R, C; stage_rc(tid * 16 + i * 8192, R, C); voffA[i] = (unsigned)(R * K + C) * 2u; }
    unsigned coff[2][2], noff[2][2]; int gR[2], gC[2];
#pragma unroll
    for (int i = 0; i < 2; ++i) { int R, C; stage_rc(tid * 16 + i * 8192, R, C); gR[i] = R; gC[i] = C; coff[0][i] = coff[1][i] = noff[0][i] = noff[1][i] = 0u; }
#define PG8_GOFF(dst, pm_) do { if constexpr (GATHER) { _Pragma("unroll") for (int _h = 0; _h < 2; ++_h) _Pragma("unroll") for (int _i = 0; _i < 2; ++_i) \
        dst[_h][_i] = ((unsigned)g.tok[(pm_) * BM + _h * HALF + gR[_i]] * (unsigned)K + (unsigned)gC[_i]) * 2u; } } while (0)
    const size_t kstep = (size_t)(BK * 2), hstep = (size_t)HALF * K * 2, tstep = 2 * hstep;
    const unsigned ldsw = (unsigned)wid * 1024u;
    const int aoff = lds_byte(wr * 64 + fr, fq * 8);
    const int ldb = S.ldb();
    const size_t bkstep = (size_t)BK * ldb;
    const int q4 = (lane >> 2) & 3, p4 = lane & 3;
    const unsigned lo = SPLIT ? (unsigned)((lane >> 5) * ldb + 4 * (lane & 31)) * 4u : (unsigned)lane * 16u;
    const unsigned bwoff = SPLIT ? (unsigned)(8 * wid + (lane >> 5)) * PBI + (unsigned)(((4 * (lane & 31)) ^ ((wid & 1) << 6)) * 2)
                                 : (unsigned)(8 * wid) * PBI + (unsigned)(((4 * lane) ^ ((wid & 1) << 6)) * 2);
    unsigned broff[2][2];
#pragma unroll
    for (int n = 0; n < 2; ++n)
#pragma unroll
        for (int k = 0; k < 2; ++k) { const int row = 32 * k + 8 * fq + q4, col = 32 * wc + (Epi::PERM ? 8 * p4 + 4 * n : 16 * n + 4 * p4);
            broff[n][k] = (unsigned)row * PBI + (unsigned)((col ^ ((row & 8) << 3)) * 2); }
#define PG8_SA(b, h) (((b) * 2 + (h)) * HTB)
#define PG8_SBI(b) (4 * HTB + (b) * SBI_BYTES)
#define PG8_STAGE(bufoff, gbase, voff) do { _Pragma("unroll") for (int _i = 0; _i < 2; ++_i) \
        __builtin_amdgcn_global_load_lds((const unsigned*)((const char*)(gbase) + (voff)[_i]), (PG8_LAS unsigned*)(lds + (bufoff) + ldsw + _i * 8192), 16, 0, 0); } while (0)
#define PG8_STAGEA(bufoff, gptr, hh, kbytes, usenext) do { if constexpr (GATHER) { _Pragma("unroll") for (int _i = 0; _i < 2; ++_i) { const unsigned _o = (usenext) ? noff[hh][_i] : coff[hh][_i]; \
        __builtin_amdgcn_global_load_lds((const unsigned*)((const char*)g.A + (size_t)(kbytes) + _o), (PG8_LAS unsigned*)(lds + (bufoff) + ldsw + _i * 8192), 16, 0, 0); } } else { PG8_STAGE(bufoff, gptr, voffA); } } while (0)
#define PG8_LDA(dst, b, h) do { _Pragma("unroll") for (int m = 0; m < 4; ++m) _Pragma("unroll") for (int k = 0; k < 2; ++k) dst[m][k] = *(const PG8_LAS bf16x8*)(lds + PG8_SA(b, h) + aoff + m * 2048 + k * 1024); } while (0)
#define PG8_LDBT(dst, b, h) do { _Pragma("unroll") for (int n = 0; n < 2; ++n) _Pragma("unroll") for (int k = 0; k < 2; ++k) { \
        const PG8_LAS unsigned char* _a = lds + PG8_SBI(b) + broff[n][k] + (h) * 256; \
        const s16x4 _lo = __builtin_bit_cast(s16x4, __builtin_amdgcn_ds_read_tr16_b64_v4i16((PG8_LAS s16x4*)_a)), _hi = __builtin_bit_cast(s16x4, __builtin_amdgcn_ds_read_tr16_b64_v4i16((PG8_LAS s16x4*)(_a + 4 * PBI))); \
        dst[n][k] = __builtin_shufflevector(_lo, _hi, 0, 1, 2, 3, 4, 5, 6, 7); } } while (0)
#define PG8_BLOAD(p0, p1) do { _Pragma("unroll") for (int _i = 0; _i < 8; ++_i) { \
        const float* _u = SPLIT ? ((_i < 4 ? (p0) : (p1)) + (size_t)(8 * wid + 2 * (_i & 3)) * ldb) : ((p0) + (size_t)(8 * wid + _i) * ldb); \
        breg[_i] = *(const __attribute__((address_space(1))) f32x4*)((const char*)_u + lo); } } while (0)
#define PG8_BWRITE(b) do { _Pragma("unroll") for (int _i = 0; _i < 8; ++_i) { u32x2 _w; _w.x = cvt_pk_bf16(breg[_i][0], breg[_i][1]); _w.y = cvt_pk_bf16(breg[_i][2], breg[_i][3]); \
        *(PG8_LAS u32x2*)(lds + PG8_SBI(b) + bwoff + (SPLIT ? (2 * (_i & 3)) * PBI + (_i >> 2) * 256 : _i * PBI)) = _w; } } while (0)
#define PG8_MMA(ai, bj, At, Bt) do { __builtin_amdgcn_s_setprio(1); _Pragma("unroll") for (int m = 0; m < 4; ++m) _Pragma("unroll") for (int n = 0; n < 2; ++n) _Pragma("unroll") for (int k = 0; k < 2; ++k) \
        acc[ai][bj][m][n] = __builtin_amdgcn_mfma_f32_16x16x32_bf16(Bt[n][k], At[m][k], acc[ai][bj][m][n], 0, 0, 0); __builtin_amdgcn_s_setprio(0); } while (0)
#define PG8_WAIT_V(n) asm volatile("s_waitcnt vmcnt(" #n ")" ::: "memory")
#define PG8_WAIT_L(n) asm volatile("s_waitcnt lgkmcnt(" #n ")" ::: "memory")
#define PG8_BAR __builtin_amdgcn_s_barrier()
#define PG8_SCHED __builtin_amdgcn_sched_barrier(0)
    typedef short s16x4 __attribute__((ext_vector_type(4)));
    typedef unsigned u32x2 __attribute__((ext_vector_type(2)));
    Unit cur, nxt; int ui = 0;
    if (!S.next(0, cur)) return;
    f32x4 acc[2][2][4][2];
#pragma unroll
    for (int a = 0; a < 2; ++a)
#pragma unroll
        for (int b = 0; b < 2; ++b)
#pragma unroll
            for (int m = 0; m < 4; ++m)
#pragma unroll
                for (int n = 0; n < 2; ++n) acc[a][b][m][n] = (f32x4){0.f, 0.f, 0.f, 0.f};
    bf16x8 At[4][2], B0[2][2];
    f32x4 breg[8];
    const char* cA = (const char*)g.A + (size_t)cur.pm * tstep; const float* cB0 = S.bbase(cur, 0); const float* cB1 = S.bbase(cur, 1);
    PG8_GOFF(coff, cur.pm);
    PG8_BLOAD(cB0, cB1); PG8_STAGEA(PG8_SA(0, 0), cA, 0, 0, false); PG8_STAGEA(PG8_SA(0, 1), cA + hstep, 1, 0, false);
    PG8_BWRITE(0); PG8_SCHED;
    if (wr == 1) PG8_BAR;
    PG8_WAIT_V(2); PG8_WAIT_L(0); PG8_BAR;
    PG8_BLOAD(cB0 + bkstep, cB1 + bkstep); PG8_STAGEA(PG8_SA(1, 0), cA + kstep, 0, kstep, false); PG8_SCHED;
    PG8_WAIT_V(10); PG8_BAR;
    for (;;) {
        const bool has_next = S.next(ui + 1, nxt);
        const char* nA = has_next ? (const char*)g.A + (size_t)nxt.pm * tstep : cA; const float* nB0 = has_next ? S.bbase(nxt, 0) : cB0; const float* nB1 = has_next ? S.bbase(nxt, 1) : cB1;
        if constexpr (GATHER) { if (has_next) { PG8_GOFF(noff, nxt.pm); } else { _Pragma("unroll") for (int _h = 0; _h < 2; ++_h) _Pragma("unroll") for (int _i = 0; _i < 2; ++_i) noff[_h][_i] = coff[_h][_i]; } }
        for (int t = 0; t < nt; t += 2) {
            const bool last = (t == nt - 2);
            const char* a1 = cA + (size_t)(t + 1) * kstep;
            const char* a2 = last ? nA : cA + (size_t)(t + 2) * kstep; const float* b20 = last ? nB0 : cB0 + (size_t)(t + 2) * bkstep; const float* b21 = last ? nB1 : cB1 + (size_t)(t + 2) * bkstep;
            const char* a3 = a2 + kstep; const float* b30 = b20 + bkstep; const float* b31 = b21 + bkstep;
            const size_t k1 = (size_t)(t + 1) * kstep, k2 = last ? 0 : (size_t)(t + 2) * kstep, k3 = k2 + kstep;
            PG8_LDBT(B0, 0, 0); PG8_SCHED; PG8_LDA(At, 0, 0); PG8_STAGEA(PG8_SA(1, 1), a1 + hstep, 1, k1, false);
            PG8_WAIT_V(12); PG8_WAIT_L(0); PG8_BAR; PG8_MMA(0, 0, At, B0); PG8_LDBT(B0, 0, 1); PG8_WAIT_L(0); PG8_SCHED; PG8_MMA(0, 1, At, B0); PG8_BAR; PG8_SCHED;
            PG8_BWRITE(1); PG8_BLOAD(b20, b21); PG8_SCHED; PG8_LDBT(B0, 0, 0); PG8_LDA(At, 0, 1); PG8_STAGEA(PG8_SA(0, 0), a2, 0, k2, last);
            PG8_WAIT_V(12); PG8_WAIT_L(0); PG8_BAR; PG8_MMA(1, 0, At, B0); PG8_LDBT(B0, 0, 1); PG8_WAIT_L(0); PG8_SCHED; PG8_MMA(1, 1, At, B0); PG8_BAR; PG8_SCHED;
            PG8_LDBT(B0, 1, 0); PG8_SCHED; PG8_LDA(At, 1, 0); PG8_STAGEA(PG8_SA(0, 1), a2 + hstep, 1, k2, last);
            PG8_WAIT_V(12); PG8_WAIT_L(0); PG8_BAR; PG8_MMA(0, 0, At, B0); PG8_LDBT(B0, 1, 1); PG8_WAIT_L(0); PG8_SCHED; PG8_MMA(0, 1, At, B0); PG8_BAR; PG8_SCHED;
            PG8_BWRITE(0); PG8_BLOAD(b30, b31); PG8_SCHED; PG8_LDBT(B0, 1, 0); PG8_LDA(At, 1, 1); PG8_STAGEA(PG8_SA(1, 0), a3, 0, k3, last);
            PG8_WAIT_V(12); PG8_WAIT_L(0); PG8_BAR; PG8_MMA(1, 0, At, B0); PG8_LDBT(B0, 1, 1); PG8_WAIT_L(0); PG8_SCHED; PG8_MMA(1, 1, At, B0); PG8_BAR; PG8_SCHED;
        }
        if constexpr (ALIGN_EPI) { if (wr == 0) PG8_BAR; }
        E(acc, cur, wr, wc, fr, fq); S.done(cur);
        if (!has_next) break;
#pragma unroll
        for (int a = 0; a < 2; ++a)
#pragma unroll
            for (int b = 0; b < 2; ++b)
#pragma unroll
                for (int m = 0; m < 4; ++m)
#pragma unroll
                    for (int n = 0; n < 2; ++n) acc[a][b][m][n] = (f32x4){0.f, 0.f, 0.f, 0.f};
        cur = nxt; cA = nA; cB0 = nB0; cB1 = nB1; ++ui;
        if constexpr (GATHER) { _Pragma("unroll") for (int _h = 0; _h < 2; ++_h) _Pragma("unroll") for (int _i = 0; _i < 2; ++_i) coff[_h][_i] = noff[_h][_i]; }
        if constexpr (ALIGN_EPI) { if (wr == 1) PG8_BAR; }
    }
    PG8_WAIT_V(0);
    asm volatile("" :: "v"(breg[0]), "v"(breg[1]), "v"(breg[2]), "v"(breg[3]), "v"(breg[4]), "v"(breg[5]), "v"(breg[6]), "v"(breg[7]));
    if constexpr (!ALIGN_EPI) { if (wr == 0) PG8_BAR; }
    PG8_BAR;
#undef PG8_SA
#undef PG8_SBI
#undef PG8_STAGE
#undef PG8_STAGEA
#undef PG8_GOFF
#undef PG8_LDA
#undef PG8_LDBT
#undef PG8_BLOAD
#undef PG8_BWRITE
#undef PG8_MMA
#undef PG8_WAIT_V
#undef PG8_WAIT_L
#undef PG8_BAR
#undef PG8_SCHED
}
}

constexpr int NWAVES = 8, NTHR = 512;
constexpr int T = 8192, D = 2048, HW = 7168, INW = 7184, MEMN = 256;
constexpr float LN_EPS = 1e-5f;
constexpr float ALPHA = 1.189207115002721f;
constexpr int NPH = 16;
#ifndef MK_MOE_BNT
#define MK_MOE_BNT false
#endif
#ifndef MK_ALIGN1
#define MK_ALIGN1 true
#endif
#ifndef MK_FUSE_LN1
#define MK_FUSE_LN1 0
#endif
#ifndef MK_NSG
#define MK_NSG 9
#endif
constexpr int NSG = MK_NSG;
constexpr int PMAX = 24576;

constexpr size_t MiB = 1u << 20;
constexpr size_t WS_CTL = 0, CTL_ZERO_BYTES = 64 * 1024;
constexpr size_t WS_WMIX = 2 * MiB, WS_WMQ = 10 * MiB, WS_WIN = 18 * MiB, WS_WKV = 46 * MiB, WS_WMO = 62 * MiB, WS_WGU = 70 * MiB, WS_WD = 198 * MiB;
constexpr size_t WS_XB = 262 * MiB, WS_MEMB = 294 * MiB;
constexpr size_t WS_H = 296 * MiB;
constexpr size_t WS_KVM = 408 * MiB;
constexpr size_t WS_ORAW = 410 * MiB;
constexpr size_t WS_MIXED = WS_XB;
constexpr size_t WS_Y1 = WS_ORAW;
constexpr size_t WS_H1B = WS_H;
constexpr size_t WS_QB = 328 * MiB, WS_ATT = 360 * MiB;
constexpr size_t WS_Y2 = 474 * MiB;
constexpr size_t WS_H2B = WS_H;
constexpr size_t WS_XS = 328 * MiB;
constexpr size_t WS_HID = 424 * MiB;
constexpr size_t WS_YS = WS_XS;
constexpr size_t WS_SMALL = 540 * MiB;
constexpr size_t WS_GLR = WS_SMALL;
constexpr size_t WS_RC = WS_SMALL + 1 * MiB, WS_RS = WS_SMALL + 5 * MiB;
constexpr size_t WS_ST1 = WS_SMALL + 9 * MiB, WS_ST2 = WS_ST1 + 65536;
constexpr size_t WS_EXP = WS_ST2 + 65536, WS_GATE = WS_EXP + 65536, WS_POS = WS_GATE + 65536, WS_SLOT = WS_POS + 65536, WS_TOK = WS_SLOT + 65536;
constexpr size_t WS_XCH1 = WS_SMALL + 10 * MiB, WS_XCH2 = WS_XCH1 + 512 * 1024;
constexpr size_t WS_TOKS = WS_SMALL + 10 * MiB;
constexpr size_t WS_WRT = WS_SMALL + 11 * MiB;
constexpr size_t WS_END = 552 * MiB;
constexpr int CW_CNT = 64, CW_CUR = 128, CW_Q = 192;
constexpr int CW_BAR = 4096;
constexpr int CW_LN1 = 8192, CW_LN2 = 10240;

constexpr int RING_BYTES = 139264, LDSCTL_OFF = RING_BYTES, MISC_OFF = LDSCTL_OFF + 320, LDS_BYTES = 147456;

#define GAS __attribute__((address_space(1)))
#define LAS __attribute__((address_space(3)))
typedef unsigned short bf16;
typedef unsigned v4u __attribute__((ext_vector_type(4)));
typedef unsigned v2u __attribute__((ext_vector_type(2)));
typedef float f32x4 __attribute__((ext_vector_type(4)));
typedef GAS unsigned gu32;
#define RLX_AGENT __ATOMIC_RELAXED, __HIP_MEMORY_SCOPE_AGENT
#define LDS_WAIT() asm volatile("s_waitcnt lgkmcnt(0)" ::: "memory")
__device__ __forceinline__ unsigned f2bf(float f) { unsigned u = __builtin_bit_cast(unsigned, f); return (u + 0x7fffu + ((u >> 16) & 1u)) >> 16; }
__device__ __forceinline__ unsigned pk2s(float lo, float hi) { return f2bf(lo) | (f2bf(hi) << 16); }
typedef __bf16 hwbf16x2 __attribute__((ext_vector_type(2)));
typedef float f32x2c __attribute__((ext_vector_type(2)));
__device__ __forceinline__ unsigned pk2(float lo, float hi) { const f32x2c v = {lo, hi}; return __builtin_bit_cast(unsigned, __builtin_convertvector(v, hwbf16x2)); }
__device__ __forceinline__ float bf2f(unsigned h) { return __builtin_bit_cast(float, h << 16); }
__device__ __forceinline__ float bflo(unsigned w) { return __builtin_bit_cast(float, w << 16); }
__device__ __forceinline__ float bfhi(unsigned w) { return __builtin_bit_cast(float, w & 0xffff0000u); }
__device__ __forceinline__ float wave_sum(float v) {
#pragma unroll
    for (int o = 1; o < 64; o <<= 1) v += __shfl_xor(v, o);
    return v;
}
__device__ __forceinline__ float wave_max(float v) {
#pragma unroll
    for (int o = 1; o < 64; o <<= 1) v = fmaxf(v, __shfl_xor(v, o));
    return v;
}

struct Frame {
    LAS unsigned char* lds;
    volatile LAS unsigned* MISC;
    gu32* ctl;
    int tid, lane, wave, G, bid;
    unsigned char* ws;
    const float* in[25];
    float* out;
};
#define WSP(T_, off) ((T_*)(F.ws + (off)))

template <bool NTST>
__device__ __forceinline__ void transpose_item(const float* W, int ldw, bf16* WTr, int ldt, LAS float* scr, int lane) {
    float tv[32];
#pragma unroll
    for (int i = 0; i < 32; ++i) tv[i] = __builtin_nontemporal_load(W + (size_t)(2 * i + (lane >> 5)) * ldw + (lane & 31));
#pragma unroll
    for (int i = 0; i < 32; ++i) scr[(2 * i + (lane >> 5)) * 33 + (lane & 31)] = tv[i];
    LDS_WAIT(); asm volatile("" ::: "memory");
    const int c = lane & 7;
#pragma unroll
    for (int j = 0; j < 4; ++j) { const int n = (lane >> 3) + 8 * j; const LAS float* s = scr + (8 * c) * 33 + n;
        v4u o; o.x = pk2(s[0 * 33], s[1 * 33]); o.y = pk2(s[2 * 33], s[3 * 33]); o.z = pk2(s[4 * 33], s[5 * 33]); o.w = pk2(s[6 * 33], s[7 * 33]);
        if (NTST) __builtin_nontemporal_store(o, (GAS v4u*)(WTr + (size_t)n * ldt + 8 * c)); else *(GAS v4u*)(WTr + (size_t)n * ldt + 8 * c) = o; }
    LDS_WAIT(); asm volatile("" ::: "memory");
}
__device__ __forceinline__ void p0_prologue(Frame& F) {
    LAS float* scr = (LAS float*)(F.lds + F.wave * 16384);
    const int gw = F.bid * NWAVES + F.wave, NGW = F.G * NWAVES;
    const float* w_in = F.in[3];
    constexpr int I_IN = 32 * 224, I_SQ = 32 * 64;
    for (int it = gw; it < I_IN + 2 * I_SQ; it += NGW) {
        int r = it;
        if (r < I_IN) { const int kb = r / 224, nb = r % 224; transpose_item<false>(w_in + (size_t)(64 * kb) * INW + 32 * nb, INW, WSP(bf16, WS_WIN) + (size_t)(32 * nb) * 2048 + 64 * kb, 2048, scr, F.lane); continue; }
        r -= I_IN;
        { const int w = r / I_SQ, q = r % I_SQ, kb = q / 64, nb = q % 64;
          const float* src = F.in[11]; if (w) src = F.in[12];
          bf16* dst = WSP(bf16, WS_WKV) + (size_t)w * 2048 * 2048;
          transpose_item<false>(src + (size_t)(64 * kb) * 2048 + 32 * nb, 2048, dst + (size_t)(32 * nb) * 2048 + 64 * kb, 2048, scr, F.lane); }
    }
    const int gt = F.bid * NTHR + F.tid, NGT = F.G * NTHR;
    {
        const float* x = F.in[0]; bf16* xb = WSP(bf16, WS_XB);
        for (int item = F.bid; item < T / 32; item += F.G) {
            const size_t base = (size_t)item * 32 * D / 8;
#pragma unroll 1
            for (int c0 = 0; c0 < 16; c0 += 4) { f32x4 a[4], b[4];
#pragma unroll
                for (int u = 0; u < 4; ++u) { const size_t i = base + (size_t)(c0 + u) * NTHR + F.tid; a[u] = *(const GAS f32x4*)(x + i * 8); b[u] = *(const GAS f32x4*)(x + i * 8 + 4); }
#pragma unroll
                for (int u = 0; u < 4; ++u) { const size_t i = base + (size_t)(c0 + u) * NTHR + F.tid;
                    v4u o; o.x = pk2(a[u][0], a[u][1]); o.y = pk2(a[u][2], a[u][3]); o.z = pk2(b[u][0], b[u][1]); o.w = pk2(b[u][2], b[u][3]); *(GAS v4u*)(xb + i * 8) = o; } }
        }
        const float* mm = F.in[1]; bf16* mb = WSP(bf16, WS_MEMB);
        for (int i = gt; i < MEMN * D / 8; i += NGT) { const f32x4 a = *(const GAS f32x4*)(mm + (size_t)i * 8), b = *(const GAS f32x4*)(mm + (size_t)i * 8 + 4);
            v4u o; o.x = pk2(a[0], a[1]); o.y = pk2(a[2], a[3]); o.z = pk2(b[0], b[1]); o.w = pk2(b[2], b[3]); *(GAS v4u*)(mb + (size_t)i * 8) = o; }
    }
    {
        const int* pos = (const int*)F.in[2]; float* rc = WSP(float, WS_RC); float* rs = WSP(float, WS_RS);
        for (int i = gt; i < T * 128; i += NGT) { const int t = i >> 7, f = i & 127;
            const float inv = exp2f(-(float)f * (13.287712379549449f / 128.0f));
            const float ang = (float)pos[t] * inv;
            double rev = (double)ang * 0.15915494309189535; rev -= floor(rev);
            const float rf = (float)rev;
            rc[i] = __builtin_amdgcn_cosf(rf); rs[i] = __builtin_amdgcn_sinf(rf); }
    }
    { v4u* tz = WSP(v4u, WS_TOKS); v4u z; z.x = z.y = z.z = z.w = 0u; for (int i = gt; i < 32 * 8192 / 4; i += NGT) tz[i] = z; }
    {
        bf16* wrt = WSP(bf16, WS_WRT); const float* Wg_ = F.in[16]; const float* We_ = F.in[18];
        for (int i = gt; i < 48 * 2048; i += NGT) { const int c = (i >> 3) % 48, k = ((i >> 3) / 48) * 8 + (i & 7);
            float w = 0.f; if (c < 32) w = We_[(size_t)k * 32 + c]; else if (c < 36) w = Wg_[(size_t)k * 4 + (c - 32)];
            const unsigned hi = f2bf(w), lo = f2bf(w - bf2f(hi));
            wrt[i] = (bf16)hi; wrt[48 * 2048 + i] = (bf16)lo; }
    }
    {
        const float* x = F.in[0]; float* glr = WSP(float, WS_GLR);
        const int r16 = F.lane & 15, g4 = F.lane >> 4;
        LAS float* part = (LAS float*)F.lds;
        for (int item = F.bid; item < T / 32; item += F.G) {
            const int tile = 2 * item + (F.wave >> 2), kq = F.wave & 3;
            f32x4 acc = {0.f, 0.f, 0.f, 0.f};
            const float* xr = x + (size_t)(tile * 16 + r16) * D + 512 * kq + 4 * g4;
            const float* wr = w_in + (size_t)(512 * kq + 4 * g4) * INW + HW + r16;
#pragma unroll 8
            for (int k0 = 0; k0 < 512; k0 += 16) {
                const f32x4 a = *(const GAS f32x4*)(xr + k0);
                const float b0 = wr[(size_t)(k0 + 0) * INW], b1 = wr[(size_t)(k0 + 1) * INW], b2 = wr[(size_t)(k0 + 2) * INW], b3 = wr[(size_t)(k0 + 3) * INW];
                acc = __builtin_amdgcn_mfma_f32_16x16x4f32(a[0], b0, acc, 0, 0, 0);
                acc = __builtin_amdgcn_mfma_f32_16x16x4f32(a[1], b1, acc, 0, 0, 0);
                acc = __builtin_amdgcn_mfma_f32_16x16x4f32(a[2], b2, acc, 0, 0, 0);
                acc = __builtin_amdgcn_mfma_f32_16x16x4f32(a[3], b3, acc, 0, 0, 0);
            }
            __syncthreads();
            *(LAS f32x4*)(part + (F.wave * 64 + F.lane) * 4) = acc;
            __syncthreads();
            if (F.tid < 128) { const int tl = F.tid >> 6, ln = F.tid & 63;
                f32x4 s = *(const LAS f32x4*)(part + ((tl * 4 + 0) * 64 + ln) * 4);
#pragma unroll
                for (int q = 1; q < 4; ++q) s += *(const LAS f32x4*)(part + ((tl * 4 + q) * 64 + ln) * 4);
#pragma unroll
                for (int j = 0; j < 4; ++j) glr[(size_t)((2 * item + tl) * 16 + 4 * (ln >> 4) + j) * 16 + (ln & 15)] = s[j]; }
        }
        __syncthreads();
    }
}
__device__ __forceinline__ void transpose_queue(Frame& F, int qsel = 0) {
    LAS float* scr = (LAS float*)(F.lds + F.wave * 16384);
    const float* const i7 = F.in[7]; const float* const i10 = F.in[10]; const float* const i13 = F.in[13]; const float* const i20 = F.in[20]; const float* const i21 = F.in[21]; const float* const i22 = F.in[22];
    constexpr int I_SQ = 32 * 64, I_E = 512, NQ = 3 * I_SQ + (MK_MOE_F32 ? 0 : 3 * 32 * I_E);
    for (;;) {
        unsigned b0 = 0;
        if (F.lane == 0) b0 = __hip_atomic_fetch_add((unsigned*)(F.ctl + CW_Q + 64 * qsel), 16u, __ATOMIC_RELAXED, __HIP_MEMORY_SCOPE_AGENT);
        b0 = __builtin_amdgcn_readfirstlane(b0);
        if (b0 >= (unsigned)NQ) break;
        for (int it = (int)b0; it < (int)b0 + 16 && it < NQ; ++it) {
            int r = it;
            if (r < 3 * I_SQ) { const int w = r / I_SQ, q = r % I_SQ, kb = q / 64, nb = q % 64;
                const float* src = i7; size_t doff = WS_WMIX; if (w == 1) { src = i10; doff = WS_WMQ; } if (w == 2) { src = i13; doff = WS_WMO; }
                bf16* dst = (bf16*)(F.ws + doff);
                transpose_item<true>(src + (size_t)(64 * kb) * 2048 + 32 * nb, 2048, dst + (size_t)(32 * nb) * 2048 + 64 * kb, 2048, scr, F.lane); continue; }
            r -= 3 * I_SQ;
            if (r < 2 * 32 * I_E) {
                const int up = r / (32 * I_E), q = r % (32 * I_E), e = q / I_E, q2 = q % I_E, kb = q2 / 16, nb = q2 % 16, n0 = 32 * nb;
                const float* sb = i20; if (up) sb = i21;
                const float* src = sb + (size_t)e * 2048 * 512 + (size_t)(64 * kb) * 512 + n0;
                bf16* dst = WSP(bf16, WS_WGU) + (size_t)(e * 1024 + (n0 >> 7) * 256 + up * 128 + (n0 & 127)) * 2048 + 64 * kb;
                transpose_item<true>(src, 512, dst, 2048, scr, F.lane); continue; }
            r -= 2 * 32 * I_E;
            {
                const int e = r / I_E, q2 = r % I_E, kb = q2 / 64, nb = q2 % 64;
                const float* src = i22 + (size_t)e * 512 * 2048 + (size_t)(64 * kb) * 2048 + 32 * nb;
                bf16* dst = WSP(bf16, WS_WD) + (size_t)(e * 2048 + 32 * nb) * 512 + 64 * kb;
                transpose_item<true>(src, 2048, dst, 512, scr, F.lane); }
        }
    }
}


__device__ __forceinline__ float log_sigmoid_f(float z) { return fminf(z, 0.f) - log1pf(expf(-fabsf(z))); }
template <bool GLA>
__device__ __forceinline__ void mixer_naive_item(Frame& F, int hh, int eg) {
    constexpr int ND = GLA ? 4 : 8;
    const bf16* H = WSP(bf16, WS_H); float* oraw = WSP(float, WS_ORAW);
    const int ei = F.tid & 15, dp = F.tid >> 4, e = eg * 16 + ei;
    const int qcol = GLA ? 4096 + hh * 128 : hh * 256, kcol = GLA ? 4608 + hh * 128 : 1024 + hh * 256, vcol = (GLA ? 5120 : 2048) + hh * 256 + e;
    const int ocol = (GLA ? 1024 : 0) + hh * 256 + eg * 16;
    LAS float* red = (LAS float*)F.lds;
    float S[ND];
#pragma unroll
    for (int i = 0; i < ND; ++i) S[i] = 0.f;
    float wa[GLA ? 4 : 1][16]; float ba[GLA ? 4 : 1];
    if (GLA) {
#pragma unroll
        for (int i = 0; i < 4; ++i) { const int d = dp + 32 * i; ba[i] = F.in[5][hh * 128 + d];
#pragma unroll
            for (int r = 0; r < 16; ++r) wa[i][r] = F.in[4][r * 512 + hh * 128 + d]; }
    }
    const float gamma = 1.0f - exp2f(-5.0f - (float)hh);
    const float* glr = WSP(float, WS_GLR);
    for (int t0 = 0; t0 < T; t0 += 8) {
        float part[8];
#pragma unroll
        for (int tt = 0; tt < 8; ++tt) {
            const int t = t0 + tt; const bf16* hr = H + (size_t)t * HW;
            const float v = bf2f(hr[vcol]);
            float g16[16];
            if (GLA) {
#pragma unroll
                for (int r = 0; r < 16; ++r) g16[r] = glr[t * 16 + r];
            }
            float p = 0.f;
#pragma unroll
            for (int i = 0; i < ND; ++i) { const int d = dp + 32 * i;
                const float q = bf2f(hr[qcol + d]), k = bf2f(hr[kcol + d]);
                float a = gamma;
                if (GLA) { float z = ba[i];
#pragma unroll
                    for (int r = 0; r < 16; ++r) z += g16[r] * wa[i][r];
                    a = expf(log_sigmoid_f(z) * 0.0625f); }
                S[i] = a * S[i] + k * v; p += q * S[i]; }
            p += __shfl_xor(p, 16); p += __shfl_xor(p, 32);
            part[tt] = p;
        }
        if (F.lane < 16) {
#pragma unroll
            for (int tt = 0; tt < 8; ++tt) red[(F.wave * 8 + tt) * 16 + F.lane] = part[tt];
        }
        __syncthreads();
        if (F.tid < 128) { const int tt = F.tid >> 4, e2 = F.tid & 15; float s = 0.f;
#pragma unroll
            for (int w = 0; w < 8; ++w) s += red[(w * 8 + tt) * 16 + e2];
            oraw[(size_t)(t0 + tt) * D + ocol + e2] = s; }
        __syncthreads();
    }
}
__device__ __forceinline__ void p2_mixer_naive(Frame& F) {
    for (int item = F.bid; item < 128; item += F.G) {
        const int h8 = item >> 4, eg = item & 15;
        if (h8 < 4) mixer_naive_item<false>(F, h8, eg); else mixer_naive_item<true>(F, h8 - 4, eg);
    }
}
__device__ __forceinline__ void p3_normgate(Frame& F) {
    const bf16* H = WSP(bf16, WS_H); const float* oraw = WSP(float, WS_ORAW); bf16* mixed = WSP(bf16, WS_MIXED);
    const int gw = F.bid * NWAVES + F.wave, NGW = F.G * NWAVES;
    const f32x4 gn = *(const f32x4*)(F.in[6] + 4 * F.lane);
    for (int t = gw; t < T; t += NGW) {
#pragma unroll
        for (int h8 = 0; h8 < 8; ++h8) {
            const f32x4 o = *(const GAS f32x4*)(oraw + (size_t)t * D + h8 * 256 + 4 * F.lane);
            const int gcol = (h8 < 4 ? 3072 : 6144) + (h8 & 3) * 256 + 4 * F.lane;
            const v2u gw2 = *(const GAS v2u*)(H + (size_t)t * HW + gcol);
            const f32x4 gt = {bflo(gw2.x), bfhi(gw2.x), bflo(gw2.y), bfhi(gw2.y)};
            f32x4 y;
            if (h8 < 4) {
                const float mu = wave_sum((o[0] + o[1]) + (o[2] + o[3])) * (1.f / 256.f);
                const f32x4 dd = o - mu;
                const float var = wave_sum((dd[0] * dd[0] + dd[1] * dd[1]) + (dd[2] * dd[2] + dd[3] * dd[3])) * (1.f / 256.f);
                y = dd * (1.0f / sqrtf(var + LN_EPS));
            } else {
                const float ms = wave_sum((o[0] * o[0] + o[1] * o[1]) + (o[2] * o[2] + o[3] * o[3])) * (1.f / 256.f);
                y = o * (1.0f / sqrtf(ms + LN_EPS)) * gn;
            }
            float r[4];
#pragma unroll
            for (int i = 0; i < 4; ++i) { const float g = gt[i]; r[i] = g / (1.0f + expf(-g)) * y[i]; }
            v2u w; w.x = pk2(r[0], r[1]); w.y = pk2(r[2], r[3]);
            *(GAS v2u*)(mixed + (size_t)t * D + h8 * 256 + 4 * F.lane) = w;
        }
    }
}
__device__ __forceinline__ void ln_apply_plain(Frame& F, const float* Y, const float* g, const float* b, bf16* HB, float* st) {
    const int gw = F.bid * NWAVES + F.wave, NGW = F.G * NWAVES;
    f32x4 cur[8];
    if (gw < T) { const GAS f32x4* yr = (const GAS f32x4*)(Y + (size_t)gw * D) + F.lane;
#pragma unroll
        for (int j = 0; j < 8; ++j) cur[j] = yr[64 * j]; }
    for (int t = gw; t < T; t += NGW) {
        f32x4 nxt[8];
        { const int tn = t + NGW < T ? t + NGW : t; const GAS f32x4* yr = (const GAS f32x4*)(Y + (size_t)tn * D) + F.lane;
#pragma unroll
          for (int j = 0; j < 8; ++j) nxt[j] = yr[64 * j]; }
        f32x4 v[8]; float s = 0.f;
#pragma unroll
        for (int j = 0; j < 8; ++j) { v[j] = cur[j]; s += (v[j][0] + v[j][1]) + (v[j][2] + v[j][3]); }
        const float mean = wave_sum(s) * (1.f / D); float s2 = 0.f;
#pragma unroll
        for (int j = 0; j < 8; ++j) { v[j] = v[j] - mean; s2 += (v[j][0] * v[j][0] + v[j][1] * v[j][1]) + (v[j][2] * v[j][2] + v[j][3] * v[j][3]); }
        const float rstd = 1.f / sqrtf(wave_sum(s2) * (1.f / D) + LN_EPS);
        if (F.lane == 0) { st[2 * t] = mean; st[2 * t + 1] = rstd; }
        GAS v2u* o8 = (GAS v2u*)(HB + (size_t)t * D) + F.lane;
#pragma unroll
        for (int j = 0; j < 8; ++j) { const f32x4 gv = *(const f32x4*)(g + 4 * F.lane + 256 * j), bv = *(const f32x4*)(b + 4 * F.lane + 256 * j);
            v[j] = v[j] * rstd * gv + bv;
            v2u w; w.x = pk2(v[j][0], v[j][1]); w.y = pk2(v[j][2], v[j][3]); o8[64 * j] = w; }
#pragma unroll
        for (int j = 0; j < 8; ++j) cur[j] = nxt[j];
    }
}
template <bool ROUTER>
__device__ __forceinline__ void ln_apply(Frame& F, const float* Y, const float* g, const float* b, bf16* HB, float* st, bool count = true) {
    const int gw = F.bid * NWAVES + F.wave, NGW = F.G * NWAVES;
    for (int t = gw; t < T; t += NGW) {
        const GAS f32x4* yr = (const GAS f32x4*)(Y + (size_t)t * D) + F.lane;
        f32x4 v[8]; float s = 0.f;
#pragma unroll
        for (int j = 0; j < 8; ++j) { v[j] = yr[64 * j]; s += (v[j][0] + v[j][1]) + (v[j][2] + v[j][3]); }
        const float mean = wave_sum(s) * (1.f / D); float s2 = 0.f;
#pragma unroll
        for (int j = 0; j < 8; ++j) { v[j] = v[j] - mean; s2 += (v[j][0] * v[j][0] + v[j][1] * v[j][1]) + (v[j][2] * v[j][2] + v[j][3] * v[j][3]); }
        const float rstd = 1.f / sqrtf(wave_sum(s2) * (1.f / D) + LN_EPS);
        if (F.lane == 0) { st[2 * t] = mean; st[2 * t + 1] = rstd; }
        GAS v2u* o8 = (GAS v2u*)(HB + (size_t)t * D) + F.lane;
#pragma unroll
        for (int j = 0; j < 8; ++j) { const f32x4 gv = *(const f32x4*)(g + 4 * F.lane + 256 * j), bv = *(const f32x4*)(b + 4 * F.lane + 256 * j);
            v[j] = v[j] * rstd * gv + bv;
            v2u w; w.x = pk2(v[j][0], v[j][1]); w.y = pk2(v[j][2], v[j][3]); o8[64 * j] = w; }
        if (ROUTER) {
            const float* Wg = F.in[16]; const float* We = F.in[18];
            float lg[4], le[32];
#pragma unroll
            for (int i = 0; i < 4; ++i) lg[i] = 0.f;
#pragma unroll
            for (int i = 0; i < 32; ++i) le[i] = 0.f;
#pragma unroll
            for (int j = 0; j < 8; ++j) {
#pragma unroll
                for (int i = 0; i < 4; ++i) { const int c = 4 * F.lane + 256 * j + i; const float hv = v[j][i];
                    const f32x4 wg = *(const GAS f32x4*)(Wg + (size_t)c * 4);
#pragma unroll
                    for (int q = 0; q < 4; ++q) lg[q] += hv * wg[q];
#pragma unroll
                    for (int q8 = 0; q8 < 8; ++q8) { const f32x4 we = *(const GAS f32x4*)(We + (size_t)c * 32 + 4 * q8);
#pragma unroll
                        for (int q = 0; q < 4; ++q) le[4 * q8 + q] += hv * we[q]; } }
            }
#pragma unroll
            for (int i = 0; i < 4; ++i) lg[i] = wave_sum(lg[i]) + F.in[17][i];
#pragma unroll
            for (int i = 0; i < 32; ++i) le[i] = wave_sum(le[i]);
            int grp = 0; float gm = lg[0];
#pragma unroll
            for (int i = 1; i < 4; ++i) if (lg[i] > gm) { gm = lg[i]; grp = i; }
            float gs = 0.f;
#pragma unroll
            for (int i = 0; i < 4; ++i) gs += expf(lg[i] - gm);
            const float pg_sel = 1.0f / gs;
            float fe[8];
#pragma unroll
            for (int j = 0; j < 8; ++j) { const float a = grp == 0 ? le[j] : grp == 1 ? le[8 + j] : grp == 2 ? le[16 + j] : le[24 + j]; fe[j] = a + F.in[19][grp * 8 + j]; }
            int i1 = 0; float m1 = fe[0];
#pragma unroll
            for (int j = 1; j < 8; ++j) if (fe[j] > m1) { m1 = fe[j]; i1 = j; }
            int i2 = -1; float m2 = -3.0e38f;
#pragma unroll
            for (int j = 0; j < 8; ++j) if (j != i1 && fe[j] > m2) { m2 = fe[j]; i2 = j; }
            const float p2 = expf(m2 - m1), den = 1.0f / (1.0f + p2);
            if (F.lane == 0) {
                int* ex = WSP(int, WS_EXP); float* gt = WSP(float, WS_GATE);
                const int e1 = grp * 8 + i1, e2 = grp * 8 + i2;
                ex[2 * t] = e1; ex[2 * t + 1] = e2; gt[2 * t] = pg_sel * den; gt[2 * t + 1] = pg_sel * p2 * den;
                if (count) { atomicAdd((unsigned*)(F.ctl + CW_CNT) + e1, 1u); atomicAdd((unsigned*)(F.ctl + CW_CNT) + e2, 1u); }
            }
        }
    }
}
__device__ __forceinline__ void p7_attn_naive(Frame& F) {
    const bf16* Q = WSP(bf16, WS_QB); const bf16* KVM = WSP(bf16, WS_KVM); bf16* att = WSP(bf16, WS_ATT);
    LAS float* qs = (LAS float*)F.lds;
    LAS float* sc = (LAS float*)(F.lds + 16384);
    for (int item = F.bid; item < (T / 8) * 4; item += F.G) {
        const int h = item & 3, t0 = (item >> 2) * 8;
        for (int i = F.tid; i < 8 * 512; i += NTHR) { const int tt = i >> 9, d = i & 511; qs[i] = bf2f(Q[(size_t)(t0 + tt) * D + h * 512 + d]); }
        __syncthreads();
        {
            const int j = F.tid & 255, th = F.tid >> 8;
            const bf16* kr = KVM + (size_t)j * 4096 + h * 512;
            float a0 = 0.f, a1 = 0.f, a2 = 0.f, a3 = 0.f;
            for (int d = 0; d < 512; d += 8) {
                const v4u kw = *(const GAS v4u*)(kr + d);
                const float kf[8] = {bflo(kw.x), bfhi(kw.x), bflo(kw.y), bfhi(kw.y), bflo(kw.z), bfhi(kw.z), bflo(kw.w), bfhi(kw.w)};
#pragma unroll
                for (int i = 0; i < 8; ++i) { a0 += kf[i] * qs[(th * 4 + 0) * 512 + d + i]; a1 += kf[i] * qs[(th * 4 + 1) * 512 + d + i]; a2 += kf[i] * qs[(th * 4 + 2) * 512 + d + i]; a3 += kf[i] * qs[(th * 4 + 3) * 512 + d + i]; }
            }
            const float scl = 0.04419417382415922f;
            sc[(th * 4 + 0) * 256 + j] = a0 * scl; sc[(th * 4 + 1) * 256 + j] = a1 * scl; sc[(th * 4 + 2) * 256 + j] = a2 * scl; sc[(th * 4 + 3) * 256 + j] = a3 * scl;
        }
        __syncthreads();
        {
            float v[4]; float mx = -3.0e38f;
#pragma unroll
            for (int i = 0; i < 4; ++i) { v[i] = sc[F.wave * 256 + F.lane + 64 * i]; mx = fmaxf(mx, v[i]); }
            mx = wave_max(mx); float sm = 0.f;
#pragma unroll
            for (int i = 0; i < 4; ++i) { v[i] = expf(v[i] - mx); sm += v[i]; }
            sm = 1.0f / wave_sum(sm);
#pragma unroll
            for (int i = 0; i < 4; ++i) sc[F.wave * 256 + F.lane + 64 * i] = v[i] * sm;
        }
        __syncthreads();
        {
            const int d = F.tid; const bf16* vr = KVM + 2048 + h * 512 + d;
            float o[8];
#pragma unroll
            for (int i = 0; i < 8; ++i) o[i] = 0.f;
            for (int j = 0; j < 256; ++j) { const float vv = bf2f(vr[(size_t)j * 4096]);
#pragma unroll
                for (int i = 0; i < 8; ++i) o[i] += sc[i * 256 + j] * vv; }
#pragma unroll
            for (int i = 0; i < 8; ++i) att[(size_t)(t0 + i) * D + h * 512 + d] = (bf16)f2bf(o[i]);
        }
        __syncthreads();
    }
}
__device__ __forceinline__ void moe_tile_starts(Frame& F, LAS int* ts) {
    if (F.tid < 64) {
        const unsigned c = F.lane < 32 ? __hip_atomic_load(F.ctl + CW_CUR + (F.lane & 31), RLX_AGENT) : 0u;
        int v = (int)((c + 255u) >> 8);
#pragma unroll
        for (int o = 1; o < 32; o <<= 1) { const int n = __shfl_up(v, o); if (F.lane >= o) v += n; }
        if (F.lane < 32) ts[F.lane + 1] = v;
        if (F.lane == 0) ts[0] = 0;
    }
    __syncthreads();
}
__device__ __forceinline__ void p10_dispatch(Frame& F, LAS int* ts) {
    const int gt = F.bid * NTHR + F.tid, NGT = F.G * NTHR;
    const int* ex = WSP(int, WS_EXP); const int* sl = WSP(int, WS_SLOT); int* pos = WSP(int, WS_POS); int* tok = WSP(int, WS_TOK);
    for (int a = gt; a < 2 * T; a += NGT) { const int p = ts[ex[a]] * 256 + sl[a]; pos[a] = p; tok[p] = a >> 1; }
}
__device__ __forceinline__ void p13_combine(Frame& F, const LAS int* ts) {
    const int gw = F.bid * NWAVES + F.wave, NGW = F.G * NWAVES;
    const bf16* h2 = WSP(bf16, WS_H2B); const bf16* ys = WSP(bf16, WS_YS);
    const int* ex = WSP(int, WS_EXP); const int* sl = WSP(int, WS_SLOT); const float* gt = WSP(float, WS_GATE);
    const float* g3 = F.in[23]; const float* b3 = F.in[24];
    constexpr int R = 2;
    for (int t0 = gw; t0 < T; t0 += R * NGW) {
        v2u yh[R][8], ya[R][8], yc[R][8]; float w0[R], w1[R];
#pragma unroll
        for (int r = 0; r < R; ++r) { const int t = (t0 + r * NGW < T) ? t0 + r * NGW : t0;
            w0[r] = gt[2 * t]; w1[r] = gt[2 * t + 1];
            const int p0 = ts[ex[2 * t]] * 256 + sl[2 * t], p1 = ts[ex[2 * t + 1]] * 256 + sl[2 * t + 1];
            const GAS v2u* hr = (const GAS v2u*)(h2 + (size_t)t * D) + F.lane;
            const GAS v2u* y0 = (const GAS v2u*)(ys + (size_t)p0 * D) + F.lane; const GAS v2u* y1 = (const GAS v2u*)(ys + (size_t)p1 * D) + F.lane;
#pragma unroll
            for (int j = 0; j < 8; ++j) { yh[r][j] = hr[64 * j]; ya[r][j] = y0[64 * j]; yc[r][j] = y1[64 * j]; } }
#pragma unroll
        for (int r = 0; r < R; ++r) { const int t = t0 + r * NGW; if (t >= T) break;
            f32x4 v[8]; float s = 0.f;
#pragma unroll
            for (int j = 0; j < 8; ++j) { const v2u hw = yh[r][j], a = ya[r][j], c = yc[r][j];
                const f32x4 h = {bflo(hw.x), bfhi(hw.x), bflo(hw.y), bfhi(hw.y)};
                const f32x4 fa = {bflo(a.x), bfhi(a.x), bflo(a.y), bfhi(a.y)}, fc = {bflo(c.x), bfhi(c.x), bflo(c.y), bfhi(c.y)};
                v[j] = h * ALPHA + fa * w0[r] + fc * w1[r]; s += (v[j][0] + v[j][1]) + (v[j][2] + v[j][3]); }
            const float mean = wave_sum(s) * (1.f / D); float s2 = 0.f;
#pragma unroll
            for (int j = 0; j < 8; ++j) { v[j] = v[j] - mean; s2 += (v[j][0] * v[j][0] + v[j][1] * v[j][1]) + (v[j][2] * v[j][2] + v[j][3] * v[j][3]); }
            const float rstd = 1.f / sqrtf(wave_sum(s2) * (1.f / D) + LN_EPS);
            GAS f32x4* orow = (GAS f32x4*)(F.out + (size_t)t * D) + F.lane;
#pragma unroll
            for (int j = 0; j < 8; ++j) { const f32x4 gv = *(const f32x4*)(g3 + 4 * F.lane + 256 * j), bv = *(const f32x4*)(b3 + 4 * F.lane + 256 * j);
                orow[64 * j] = v[j] * rstd * gv + bv; }
        }
    }
}

constexpr int CS = 128, NB = CS / 64, NS = T / CS;
#define HIDX(t_, c_) ((((size_t)((c_) >> 8)) * 8192 + (size_t)(t_)) * 256 + ((c_) & 255))
constexpr size_t WS_BCUM = WS_ORAW;
constexpr size_t WS_KVR = WS_ORAW + 16 * MiB;
constexpr size_t WS_KVG = WS_KVR + 32 * MiB;
typedef short bf16x8_t __attribute__((ext_vector_type(8)));
typedef short s16x4_t __attribute__((ext_vector_type(4)));
__device__ __forceinline__ s16x4_t lds_tr(const LAS unsigned char* p) { return __builtin_bit_cast(s16x4_t, __builtin_amdgcn_ds_read_tr16_b64_v4i16((LAS s16x4_t*)p)); }
__device__ __forceinline__ bf16x8_t frag_tr(const LAS unsigned char* X, int pitch, int k0, int n0, int lane) {
    const int fq = lane >> 4, q = (lane >> 2) & 3, p = lane & 3;
    const LAS unsigned char* a = X + ((k0 + 8 * fq + q) * pitch + n0 + 4 * p) * 2;
    const s16x4_t lo = lds_tr(a), hi = lds_tr(a + 4 * pitch * 2);
    return __builtin_shufflevector(lo, hi, 0, 1, 2, 3, 4, 5, 6, 7);
}
__device__ __forceinline__ bf16x8_t frag_row(const LAS unsigned char* X, int pitch, int r0, int k0, int lane) {
    return *(const LAS bf16x8_t*)(X + ((r0 + (lane & 15)) * pitch + k0 + 8 * (lane >> 4)) * 2);
}
#define MFMA16(a, b, c) __builtin_amdgcn_mfma_f32_16x16x32_bf16((a), (b), (c), 0, 0, 0)
__device__ __forceinline__ float fexp(float x) { return __builtin_amdgcn_exp2f(x * 1.4426950408889634f); }
__device__ __forceinline__ float silu_g(float g) { return g * __builtin_amdgcn_rcpf(1.0f + __builtin_amdgcn_exp2f(-1.4426950408889634f * g)); }

__device__ __forceinline__ void bcum_item(Frame& F, int s, int h) {
    const int c = F.tid & 127, tq = F.tid >> 7;
    LAS float* tot = (LAS float*)F.lds;
    LAS float* gl = (LAS float*)(F.lds + 2048);
    const float* glr = WSP(float, WS_GLR); float* bc = WSP(float, WS_BCUM);
    __syncthreads();
    *(LAS f32x4*)(gl + 4 * F.tid) = *(const GAS f32x4*)(glr + (size_t)s * CS * 16 + 4 * F.tid);
    float w[16];
#pragma unroll
    for (int r = 0; r < 16; ++r) w[r] = F.in[4][r * 512 + h * 128 + c];
    const float bias = F.in[5][h * 128 + c];
    __syncthreads();
    float vals[32]; float run = 0.f;
    const int tb = s * CS + tq * 32;
#pragma unroll
    for (int i = 0; i < 32; ++i) { const LAS float* gr = gl + (tq * 32 + i) * 16; float z = bias;
#pragma unroll
        for (int r = 0; r < 16; ++r) z += gr[r] * w[r];
        run += log_sigmoid_f(z) * 0.0625f; vals[i] = run; }
    tot[tq * 128 + c] = run;
    __syncthreads();
    float off = 0.f;
#pragma unroll
    for (int q = 0; q < 3; ++q) off += (q < tq) ? tot[q * 128 + c] : 0.f;
#pragma unroll
    for (int i = 0; i < 32; ++i) bc[(size_t)(tb + i) * 512 + h * 128 + c] = vals[i] + off;
}
__device__ __forceinline__ void p1_bcum(Frame& F, int first, int stride) { for (int it = first; it < NS * 4; it += stride) bcum_item(F, it >> 2, it & 3); __syncthreads(); }

__device__ __forceinline__ void unit_sh(int u, int& s, int& h8) { s = (u >> 3) & (NS - 1); h8 = ((u & 7) + 4 * (u >> 8)) & 7; }

template <bool GLA, int MODE>
__device__ __forceinline__ void stage_qk(Frame& F, LAS unsigned char* dst, int s, int jb, int hh, int col0, float lg2gamma) {
    constexpr int DK = GLA ? 128 : 256, PK = DK + 8, CPR = DK / 8, NIT = 64 * CPR / NTHR;
    const bf16* H = WSP(bf16, WS_H); const float* bc = WSP(float, WS_BCUM);
    asm volatile("" : "+s"(bc));
    v4u wv[NIT]; f32x4 b0[GLA ? NIT : 1], b1[GLA ? NIT : 1], l0[(GLA && MODE == 2) ? NIT : 1], l1[(GLA && MODE == 2) ? NIT : 1];
#pragma unroll
    for (int it = 0; it < NIT; ++it) {
        const int ch = F.tid + NTHR * it, r = ch / CPR, cc = ch % CPR, t = s * CS + jb * 64 + r;
        wv[it] = *(const GAS v4u*)(H + HIDX(t, col0 + 8 * cc));
        if (GLA) { b0[it] = *(const GAS f32x4*)(bc + (size_t)t * 512 + hh * 128 + 8 * cc); b1[it] = *(const GAS f32x4*)(bc + (size_t)t * 512 + hh * 128 + 8 * cc + 4);
            if (MODE == 2) { const size_t tl_ = (size_t)(s * CS + CS - 1) * 512 + hh * 128 + 8 * cc; l0[it] = *(const GAS f32x4*)(bc + tl_); l1[it] = *(const GAS f32x4*)(bc + tl_ + 4); } }
    }
#pragma unroll
    for (int it = 0; it < NIT; ++it) {
        const int ch = F.tid + NTHR * it, r = ch / CPR, cc = ch % CPR, tl = jb * 64 + r;
        const v4u w = wv[it];
        float f[8] = {bflo(w.x), bfhi(w.x), bflo(w.y), bfhi(w.y), bflo(w.z), bfhi(w.z), bflo(w.w), bfhi(w.w)};
        if (GLA) {
            float e[8] = {b0[it][0], b0[it][1], b0[it][2], b0[it][3], b1[it][0], b1[it][1], b1[it][2], b1[it][3]};
            if (MODE == 2) { const float l[8] = {l0[it][0], l0[it][1], l0[it][2], l0[it][3], l1[it][0], l1[it][1], l1[it][2], l1[it][3]};
#pragma unroll
                for (int i = 0; i < 8; ++i) e[i] = l[i] - e[i]; }
            else if (MODE == 1) {
#pragma unroll
                for (int i = 0; i < 8; ++i) e[i] = -e[i]; }
#pragma unroll
            for (int i = 0; i < 8; ++i) f[i] *= fexp(e[i]);
        } else {
            const float ex = MODE == 0 ? (float)(tl + 1) : MODE == 1 ? -(float)(tl + 1) : (float)(CS - 1 - tl);
            const float fac = __builtin_amdgcn_exp2f(ex * lg2gamma);
#pragma unroll
            for (int i = 0; i < 8; ++i) f[i] *= fac;
        }
        v4u o;
        if (MODE == 2) { o.x = pk2(f[0], f[1]); o.y = pk2(f[2], f[3]); o.z = pk2(f[4], f[5]); o.w = pk2(f[6], f[7]); }
        else { o.x = pk2(f[0], f[1]); o.y = pk2(f[2], f[3]); o.z = pk2(f[4], f[5]); o.w = pk2(f[6], f[7]); }
        *(LAS v4u*)(dst + (r * PK + 8 * cc) * 2) = o;
    }
}
__device__ __forceinline__ void stage_v(Frame& F, LAS unsigned char* dst, int s, int jb, int col0) {
    const bf16* H = WSP(bf16, WS_H);
    v4u wv[4];
#pragma unroll
    for (int it = 0; it < 4; ++it) { const int ch = F.tid + NTHR * it, r = ch >> 5, cc = ch & 31, t = s * CS + jb * 64 + r; wv[it] = *(const GAS v4u*)(H + HIDX(t, col0 + 8 * cc)); }
#pragma unroll
    for (int it = 0; it < 4; ++it) { const int ch = F.tid + NTHR * it, r = ch >> 5, cc = ch & 31; *(LAS v4u*)(dst + (r * 264 + 8 * cc) * 2) = wv[it]; }
}

template <bool GLA>
__device__ __forceinline__ void kv_unit(Frame& F, int s, int hh) {
    constexpr int DK = GLA ? 128 : 256, PK = DK + 8, NDT = DK / 16;
    LAS unsigned char* Ks = F.lds; LAS unsigned char* Vs = F.lds + 34816;
    const int kcol = GLA ? 4608 + hh * 128 : 1024 + hh * 256, vcol = (GLA ? 5120 : 2048) + hh * 256;
    const float lg2g = log2f(1.0f - exp2f(-5.0f - (float)hh));
    f32x4 acc[2][NDT];
#pragma unroll
    for (int a = 0; a < 2; ++a)
#pragma unroll
        for (int d = 0; d < NDT; ++d) acc[a][d] = (f32x4){0.f, 0.f, 0.f, 0.f};
    for (int jb = 0; jb < NB; ++jb) {
        __syncthreads();
        stage_qk<GLA, 2>(F, Ks, s, jb, hh, kcol, lg2g);
        stage_v(F, Vs, s, jb, vcol);
        __syncthreads();
#pragma unroll
        for (int ks = 0; ks < 2; ++ks) {
            bf16x8_t vf[2];
#pragma unroll
            for (int et = 0; et < 2; ++et) vf[et] = frag_tr(Vs, 264, 32 * ks, 32 * F.wave + 16 * et, F.lane);
#pragma unroll
            for (int dt = 0; dt < NDT; ++dt) { const bf16x8_t kf = frag_tr(Ks, PK, 32 * ks, 16 * dt, F.lane);
#pragma unroll
                for (int et = 0; et < 2; ++et) acc[et][dt] = MFMA16(kf, vf[et], acc[et][dt]); }
        }
    }
    bf16* kv = GLA ? (WSP(bf16, WS_KVG) + (size_t)(s * 4 + hh) * 256 * 128) : (WSP(bf16, WS_KVR) + (size_t)(s * 4 + hh) * 256 * 256);
    const int fr = F.lane & 15, fq = F.lane >> 4;
#pragma unroll
    for (int et = 0; et < 2; ++et)
#pragma unroll
        for (int dt = 0; dt < NDT; ++dt) { v2u w; w.x = pk2(acc[et][dt][0], acc[et][dt][1]); w.y = pk2(acc[et][dt][2], acc[et][dt][3]);
            *(GAS v2u*)(kv + (size_t)(32 * F.wave + 16 * et + fr) * DK + 16 * dt + 4 * fq) = w; }
}
__device__ __forceinline__ void p2_kv(Frame& F) {
    for (int u = F.bid; u < 8 * NS; u += F.G) { int s, h8; unit_sh(u, s, h8);
        if (s == NS - 1) continue;
        if (h8 < 4) kv_unit<false>(F, s, h8); else kv_unit<true>(F, s, h8 - 4); }
    __syncthreads();
}
__device__ __forceinline__ void p3_scan(Frame& F) {
    constexpr int NR = 4 * 256 * 64, NG = 4 * 256 * 32, NITEM = NR + NG;
    const float* bc = WSP(float, WS_BCUM);
    const int per = (NITEM + F.G - 1) / F.G;
    for (int k0 = F.tid; k0 < per; k0 += NTHR) {
      const int it = F.bid * per + k0;
      if (it < NITEM) {
        const bool gla = it >= NR; const int r = gla ? it - NR : it;
        const int sh = gla ? 5 : 6, dk = gla ? 128 : 256;
        const int cc = r & ((1 << sh) - 1), e = (r >> sh) & 255, hh = r >> (sh + 8);
        bf16* base = (gla ? WSP(bf16, WS_KVG) : WSP(bf16, WS_KVR)) + ((size_t)hh * 256 + e) * dk + 4 * cc;
        const size_t sstride = (size_t)4 * 256 * dk;
        const float dret = __builtin_amdgcn_exp2f((float)CS * log2f(1.0f - exp2f(-5.0f - (float)hh)));
        float S[4] = {0.f, 0.f, 0.f, 0.f};
        static_assert(NS - 1 == 63, "batching below assumes 63 steps");
#pragma unroll 1
        for (int s0 = 0; s0 < NS - 1; s0 += 9) {
            v2u wv[9]; f32x4 lv[9];
#pragma unroll
            for (int j = 0; j < 9; ++j) { wv[j] = *(const GAS v2u*)(base + (size_t)(s0 + j) * sstride);
                if (gla) lv[j] = *(const GAS f32x4*)(bc + (size_t)((s0 + j) * CS + CS - 1) * 512 + hh * 128 + 4 * cc); else lv[j] = (f32x4){0.f, 0.f, 0.f, 0.f}; }
#pragma unroll
            for (int j = 0; j < 9; ++j) {
                v2u o; o.x = pk2(S[0], S[1]); o.y = pk2(S[2], S[3]);
                *(GAS v2u*)(base + (size_t)(s0 + j) * sstride) = o;
                const float f[4] = {bflo(wv[j].x), bfhi(wv[j].x), bflo(wv[j].y), bfhi(wv[j].y)};
                float dec[4] = {dret, dret, dret, dret};
                if (gla) { dec[0] = fexp(lv[j][0]); dec[1] = fexp(lv[j][1]); dec[2] = fexp(lv[j][2]); dec[3] = fexp(lv[j][3]); }
#pragma unroll
                for (int i = 0; i < 4; ++i) S[i] = dec[i] * S[i] + f[i];
            }
        }
        { GAS v2u* p = (GAS v2u*)(base + (size_t)(NS - 1) * sstride); v2u o; o.x = pk2(S[0], S[1]); o.y = pk2(S[2], S[3]); *p = o; }
      }
    }
}
template <bool GLA>
__device__ __forceinline__ void out_unit(Frame& F, int s, int hh) {
    constexpr int DK = GLA ? 128 : 256, PK = DK + 8, NKS = DK / 32;
    LAS unsigned char* Qs = F.lds; LAS unsigned char* Ks = F.lds + 33792; LAS unsigned char* Vs = F.lds + 67584; LAS unsigned char* Ps = F.lds + 101376;
    LAS float* red = (LAS float*)(F.lds + 110592);
    const int qcol = GLA ? 4096 + hh * 128 : hh * 256, kcol = GLA ? 4608 + hh * 128 : 1024 + hh * 256, vcol = (GLA ? 5120 : 2048) + hh * 256;
    const int gcol = (GLA ? 6144 : 3072) + hh * 256, ocol = (GLA ? 1024 : 0) + hh * 256;
    const float lg2g = log2f(1.0f - exp2f(-5.0f - (float)hh));
    const bf16* H = WSP(bf16, WS_H); bf16* mixed = WSP(bf16, WS_MIXED);
    const bf16* st = GLA ? (WSP(bf16, WS_KVG) + (size_t)(s * 4 + hh) * 256 * 128) : (WSP(bf16, WS_KVR) + (size_t)(s * 4 + hh) * 256 * 256);
    const int fr = F.lane & 15, fq = F.lane >> 4, w = F.wave, mt = w >> 1, nt0 = 2 * (w & 1);
    static_assert(NB == 2, "the step program below is written for two 64-token sub-blocks");
    f32x4 accO[4][2]; bf16x8_t sfa[NKS][2]; v2u gpre[4][2];
#pragma unroll 1
    for (int step = 0; step < 3; ++step) {
        const int i = step > 0 ? 1 : 0, j = step > 1 ? 1 : 0;
        {
            __syncthreads();
            if (step < 2) stage_qk<GLA, 0>(F, Qs, s, i, hh, qcol, lg2g);
            if (step != 1) { stage_qk<GLA, 1>(F, Ks, s, j, hh, kcol, lg2g); stage_v(F, Vs, s, j, vcol); }
            if (step < 2) {
#pragma unroll
                for (int m = 0; m < 4; ++m)
#pragma unroll
                    for (int n = 0; n < 2; ++n) accO[m][n] = (f32x4){0.f, 0.f, 0.f, 0.f};
            }
            if (step != 1) {
                if (s > 0) {
#pragma unroll
                    for (int ks = 0; ks < NKS; ++ks)
#pragma unroll
                        for (int n = 0; n < 2; ++n) sfa[ks][n] = *(const GAS bf16x8_t*)(st + (size_t)(32 * w + 16 * n + fr) * DK + 32 * ks + 8 * fq);
                }
#pragma unroll
                for (int m2 = 0; m2 < 4; ++m2)
#pragma unroll
                    for (int n = 0; n < 2; ++n) gpre[m2][n] = *(const GAS v2u*)(H + HIDX(s * CS + i * 64 + 16 * m2 + fr, gcol + 32 * w + 16 * n + 4 * fq));
            }
            __syncthreads();
            f32x4 accS[2] = {(f32x4){0.f, 0.f, 0.f, 0.f}, (f32x4){0.f, 0.f, 0.f, 0.f}};
#pragma unroll
            for (int ks = 0; ks < NKS; ++ks) { const bf16x8_t qf = frag_row(Qs, PK, 16 * mt, 32 * ks, F.lane);
#pragma unroll
                for (int n2 = 0; n2 < 2; ++n2) { const bf16x8_t kf = frag_row(Ks, PK, 16 * (nt0 + n2), 32 * ks, F.lane); accS[n2] = MFMA16(kf, qf, accS[n2]); } }
#pragma unroll
            for (int n2 = 0; n2 < 2; ++n2) { const int row = 16 * mt + fr, c0 = 16 * (nt0 + n2) + 4 * fq; float pv[4];
#pragma unroll
                for (int jj = 0; jj < 4; ++jj) pv[jj] = (i == j && c0 + jj > row) ? 0.f : accS[n2][jj];
                v2u pw; pw.x = pk2(pv[0], pv[1]); pw.y = pk2(pv[2], pv[3]);
                *(LAS v2u*)(Ps + (row * 72 + c0) * 2) = pw; }
            __syncthreads();
#pragma unroll
            for (int ks = 0; ks < 2; ++ks) {
                bf16x8_t vf[2];
#pragma unroll
                for (int n = 0; n < 2; ++n) vf[n] = frag_tr(Vs, 264, 32 * ks, 32 * w + 16 * n, F.lane);
#pragma unroll
                for (int m = 0; m < 4; ++m) { const bf16x8_t pf = frag_row(Ps, 72, 16 * m, 32 * ks, F.lane);
#pragma unroll
                    for (int n = 0; n < 2; ++n) accO[m][n] = MFMA16(vf[n], pf, accO[m][n]); }
            }
        }
        if (step == 1) continue;
        if (s > 0) {
#pragma unroll
            for (int ks = 0; ks < NKS; ++ks) {
#pragma unroll
                for (int m = 0; m < 4; ++m) { const bf16x8_t qf = frag_row(Qs, PK, 16 * m, 32 * ks, F.lane);
#pragma unroll
                    for (int n = 0; n < 2; ++n) accO[m][n] = MFMA16(sfa[ks][n], qf, accO[m][n]); }
            }
        }
#pragma unroll
        for (int m = 0; m < 4; ++m) { float s1 = 0.f, s2 = 0.f;
#pragma unroll
            for (int n = 0; n < 2; ++n)
#pragma unroll
                for (int jj = 0; jj < 4; ++jj) { const float v = accO[m][n][jj]; s1 += v; s2 += v * v; }
            s1 += __shfl_xor(s1, 16); s1 += __shfl_xor(s1, 32); s2 += __shfl_xor(s2, 16); s2 += __shfl_xor(s2, 32);
            if (fq == 0) { red[(w * 64 + 16 * m + fr) * 2] = s1; red[(w * 64 + 16 * m + fr) * 2 + 1] = s2; } }
        __syncthreads();
#pragma unroll
        for (int m = 0; m < 4; ++m) { const int row = 16 * m + fr; float s1 = 0.f, s2 = 0.f;
#pragma unroll
            for (int ww = 0; ww < 8; ++ww) { s1 += red[(ww * 64 + row) * 2]; s2 += red[(ww * 64 + row) * 2 + 1]; }
            const float mean = s1 * (1.f / 256.f), ex2 = s2 * (1.f / 256.f);
            const float mu = GLA ? 0.f : mean, var = GLA ? ex2 : fmaxf(ex2 - mean * mean, 0.f);
            const float rstd = 1.0f / sqrtf(var + LN_EPS);
            const int t = s * CS + i * 64 + row;
#pragma unroll
            for (int n = 0; n < 2; ++n) { const int e = 32 * w + 16 * n + 4 * fq;
                const v2u gw2 = gpre[m][n];
                const float gt[4] = {bflo(gw2.x), bfhi(gw2.x), bflo(gw2.y), bfhi(gw2.y)};
                f32x4 gn = {1.f, 1.f, 1.f, 1.f}; if (GLA) gn = *(const f32x4*)(F.in[6] + e);
                float r4[4];
#pragma unroll
                for (int jj = 0; jj < 4; ++jj) { const float y = (accO[m][n][jj] - mu) * rstd * gn[jj]; r4[jj] = silu_g(gt[jj]) * y; }
                v2u ow; ow.x = pk2(r4[0], r4[1]); ow.y = pk2(r4[2], r4[3]);
                *(GAS v2u*)(mixed + (size_t)t * D + ocol + e) = ow; } }
    }
}
__device__ __forceinline__ void p4_out(Frame& F) {
    for (int u = F.bid; u < 8 * NS; u += F.G) { int s, h8; unit_sh(u, s, h8);
        if (h8 < 4) out_unit<false>(F, s, h8); else out_unit<true>(F, s, h8 - 4); }
    __syncthreads();
}

__device__ __forceinline__ void kv_chunk_load(Frame& F, v4u (&R)[8], const bf16* src  ) {
#pragma unroll
    for (int it = 0; it < 8; ++it) { const int ch = F.tid + NTHR * it, r = ch >> 4, cc = ch & 15; R[it] = *(const GAS v4u*)(src + (size_t)r * 4096 + 8 * cc); }
}
__device__ __forceinline__ void kv_chunk_store(Frame& F, const v4u (&R)[8], LAS unsigned char* dst) {
#pragma unroll
    for (int it = 0; it < 8; ++it) { const int ch = F.tid + NTHR * it, r = ch >> 4, cc = ch & 15; *(LAS v4u*)(dst + (r * 136 + 8 * cc) * 2) = R[it]; }
}
__device__ __forceinline__ void p8_attn(Frame& F) {
    const bf16* Q = WSP(bf16, WS_QB); const bf16* KVM = WSP(bf16, WS_KVM); bf16* att = WSP(bf16, WS_ATT);
    constexpr int CB = 256 * 136 * 2;
    const int fr = F.lane & 15, fq = F.lane >> 4, q4 = (F.lane >> 2) & 3, p4 = F.lane & 3;
    for (int u = F.bid; u < (T / 128) * 4; u += F.G) {
        const int h = u & 3, r0 = (u >> 2) * 128 + 16 * F.wave;
#if PROBE_T >= 221 && PROBE_T <= 224
        if (F.bid == 0 && F.tid == 0) ((unsigned long long*)(F.ws + 32768))[0] = __builtin_amdgcn_s_memrealtime();
#endif
        v4u R[8];
        bf16x8_t qa[16];
#pragma unroll
        for (int ks = 0; ks < 16; ++ks) qa[ks] = *(const GAS bf16x8_t*)(Q + (size_t)(r0 + fr) * D + h * 512 + 32 * ks + 8 * fq);
        __syncthreads();
        kv_chunk_load(F, R, KVM + h * 512); kv_chunk_store(F, R, F.lds);
        __syncthreads();
        f32x4 accS[16];
#pragma unroll
        for (int i = 0; i < 16; ++i) accS[i] = (f32x4){0.f, 0.f, 0.f, 0.f};
#pragma unroll
        for (int dc = 0; dc < 4; ++dc) {
            kv_chunk_load(F, R, dc < 3 ? KVM + h * 512 + (dc + 1) * 128 : KVM + 2048 + h * 512);
            const LAS unsigned char* Cs = F.lds + (dc & 1) * CB;
#pragma unroll
            for (int ks = 0; ks < 4; ++ks)
#pragma unroll
                for (int nt = 0; nt < 16; ++nt) accS[nt] = MFMA16(frag_row(Cs, 136, 16 * nt, 32 * ks, F.lane), qa[4 * dc + ks], accS[nt]);
            kv_chunk_store(F, R, F.lds + ((dc + 1) & 1) * CB);
            __syncthreads();
        }
#if PROBE_T >= 221 && PROBE_T <= 224
        if (F.bid == 0 && F.tid == 0) ((unsigned long long*)(F.ws + 32768))[1] = __builtin_amdgcn_s_memrealtime();
#endif
        float mx = -3.0e38f;
#pragma unroll
        for (int nt = 0; nt < 16; ++nt)
#pragma unroll
            for (int jj = 0; jj < 4; ++jj) mx = fmaxf(mx, accS[nt][jj]);
        mx = fmaxf(mx, __shfl_xor(mx, 16)); mx = fmaxf(mx, __shfl_xor(mx, 32));
        const float sl2 = 0.04419417382415922f * 1.4426950408889634f;
        float sm = 0.f;
#pragma unroll
        for (int nt = 0; nt < 16; ++nt)
#pragma unroll
            for (int jj = 0; jj < 4; ++jj) { const float p = __builtin_amdgcn_exp2f((accS[nt][jj] - mx) * sl2); accS[nt][jj] = p; sm += p; }
        sm += __shfl_xor(sm, 16); sm += __shfl_xor(sm, 32);
        const float inv = 1.0f / sm;
        bf16x8_t pf[8];
#pragma unroll
        for (int ks2 = 0; ks2 < 8; ++ks2) { v4u w; w.x = pk2(accS[2 * ks2][0] * inv, accS[2 * ks2][1] * inv); w.y = pk2(accS[2 * ks2][2] * inv, accS[2 * ks2][3] * inv);
            w.z = pk2(accS[2 * ks2 + 1][0] * inv, accS[2 * ks2 + 1][1] * inv); w.w = pk2(accS[2 * ks2 + 1][2] * inv, accS[2 * ks2 + 1][3] * inv); pf[ks2] = __builtin_bit_cast(bf16x8_t, w); }
#pragma unroll 1
        for (int ec = 0; ec < 4; ++ec) {
            if (ec < 3) kv_chunk_load(F, R, KVM + 2048 + h * 512 + (ec + 1) * 128);
            const LAS unsigned char* Cs = F.lds + (ec & 1) * CB;
            f32x4 accO[8];
#pragma unroll
            for (int i = 0; i < 8; ++i) accO[i] = (f32x4){0.f, 0.f, 0.f, 0.f};
#pragma unroll
            for (int ks2 = 0; ks2 < 8; ++ks2)
#pragma unroll
                for (int et = 0; et < 8; ++et) { const LAS unsigned char* a = Cs + ((32 * ks2 + 4 * fq + q4) * 136 + 16 * et + 4 * p4) * 2;
                    const s16x4_t lo = lds_tr(a), hi = lds_tr(a + 16 * 136 * 2);
                    accO[et] = MFMA16(__builtin_shufflevector(lo, hi, 0, 1, 2, 3, 4, 5, 6, 7), pf[ks2], accO[et]); }
#pragma unroll
            for (int et = 0; et < 8; ++et) { v2u w; w.x = pk2(accO[et][0], accO[et][1]); w.y = pk2(accO[et][2], accO[et][3]);
                *(GAS v2u*)(att + (size_t)(r0 + fr) * D + h * 512 + ec * 128 + 16 * et + 4 * fq) = w; }
            if (ec < 3) kv_chunk_store(F, R, F.lds + ((ec + 1) & 1) * CB);
            __syncthreads();
        }
#if PROBE_T >= 221 && PROBE_T <= 224
        asm volatile("s_waitcnt vmcnt(0)" ::: "memory");
        if (F.bid == 0 && F.tid == 0) ((unsigned long long*)(F.ws + 32768))[2] = __builtin_amdgcn_s_memrealtime();
#endif
    }
}

constexpr int RT_AROW = 2064;
__device__ __forceinline__ void router_stage(const f32x4 (&v)[4][8], const float (&rstd)[4], const int kh, const bool store_h, const float* g, const float* b, bf16* HB, const int t0, const int wave, const int lane, LAS unsigned char* lds) {
#pragma unroll
    for (int jl = 0; jl < 4; ++jl) { const int j = 4 * kh + jl;
        const f32x4 gv = *(const f32x4*)(g + 4 * lane + 256 * j), bv = *(const f32x4*)(b + 4 * lane + 256 * j);
#pragma unroll
        for (int i = 0; i < 4; ++i) { const f32x4 hv = v[i][j] * rstd[i] * gv + bv;
            v2u hi, lo; hi.x = pk2(hv[0], hv[1]); hi.y = pk2(hv[2], hv[3]);
            lo.x = pk2(hv[0] - __builtin_bit_cast(float, hi.x << 16), hv[1] - __builtin_bit_cast(float, hi.x & 0xffff0000u));
            lo.y = pk2(hv[2] - __builtin_bit_cast(float, hi.y << 16), hv[3] - __builtin_bit_cast(float, hi.y & 0xffff0000u));
            if (store_h) ((GAS v2u*)(HB + (size_t)(t0 + i) * D) + lane)[64 * j] = hi;
            LAS unsigned char* p = lds + (4 * wave + i) * RT_AROW + (4 * lane + 256 * jl) * 2;
            *(LAS v2u*)p = hi; *(LAS v2u*)(p + 32 * RT_AROW) = lo; } }
}
__device__ __forceinline__ void router_mma(f32x4& acc0, f32x4& acc1, f32x4& acc2, const int kh, const bf16* wrt, const int wave, const int lane, LAS unsigned char* lds) {
    const int fr = lane & 15, fq = lane >> 4, rt = wave >> 2, kq = wave & 3;
    LAS unsigned char* pa = lds + (16 * rt + fr) * RT_AROW + (256 * kq + 8 * fq) * 2;
    const bf16* whi = wrt + ((size_t)((1024 * kh + 256 * kq) / 8 + fq) * 48 + fr) * 8;
    const bf16* wlo = whi + 48 * 2048;
#pragma unroll 2
    for (int ks = 0; ks < 8; ++ks) {
        const bf16x8_t ah = *(LAS bf16x8_t*)(pa + 64 * ks), al = *(LAS bf16x8_t*)(pa + 32 * RT_AROW + 64 * ks);
        const bf16x8_t b0h = *(const GAS bf16x8_t*)(whi + 1536 * ks), b1h = *(const GAS bf16x8_t*)(whi + 1536 * ks + 128), b2h = *(const GAS bf16x8_t*)(whi + 1536 * ks + 256);
        const bf16x8_t b0l = *(const GAS bf16x8_t*)(wlo + 1536 * ks), b1l = *(const GAS bf16x8_t*)(wlo + 1536 * ks + 128), b2l = *(const GAS bf16x8_t*)(wlo + 1536 * ks + 256);
        acc0 = MFMA16(ah, b0h, acc0); acc0 = MFMA16(ah, b0l, acc0); acc0 = MFMA16(al, b0h, acc0);
        acc1 = MFMA16(ah, b1h, acc1); acc1 = MFMA16(ah, b1l, acc1); acc1 = MFMA16(al, b1h, acc1);
        acc2 = MFMA16(ah, b2h, acc2); acc2 = MFMA16(ah, b2l, acc2); acc2 = MFMA16(al, b2h, acc2);
    }
}
__device__ __forceinline__ void p10_ln_router(Frame& F) {
    const float* Y = WSP(float, WS_Y2); const float* g = F.in[14]; const float* b = F.in[15]; bf16* HB = WSP(bf16, WS_H2B); float* st = WSP(float, WS_ST2);
    LAS float* part = (LAS float*)F.lds;
    LAS float* stl = (LAS float*)(F.lds + 64 * RT_AROW);
    LAS int* lcnt = (LAS int*)(F.lds + 64 * RT_AROW + 256);
    LAS int* lbase = lcnt + 32;
    if (F.tid < 32) lcnt[F.tid] = 0;
    __syncthreads();
    const int fr = F.lane & 15, fq = F.lane >> 4;
    for (int item = F.bid; item < T / 32; item += F.G) {
        const int row0 = item * 32;
#if PROBE_T >= 231 && PROBE_T <= 236
        if (F.bid == 0 && F.tid == 0) ((unsigned long long*)(F.ws + 32768))[0] = __builtin_amdgcn_s_memrealtime();
#endif
        const int t0 = row0 + 4 * F.wave;
        f32x4 v[4][8]; float rstd[4];
        {
            const GAS f32x4* yr = (const GAS f32x4*)(Y + (size_t)t0 * D) + F.lane;
#pragma unroll
            for (int i = 0; i < 4; ++i)
#pragma unroll
                for (int j = 0; j < 8; ++j) v[i][j] = yr[512 * i + 64 * j];
            float mean[4];
#pragma unroll
            for (int i = 0; i < 4; ++i) { float s = 0.f;
#pragma unroll
                for (int j = 0; j < 8; ++j) s += (v[i][j][0] + v[i][j][1]) + (v[i][j][2] + v[i][j][3]);
                mean[i] = wave_sum(s) * (1.f / D); }
#pragma unroll
            for (int i = 0; i < 4; ++i) { float s2 = 0.f;
#pragma unroll
                for (int j = 0; j < 8; ++j) { v[i][j] = v[i][j] - mean[i]; s2 += (v[i][j][0] * v[i][j][0] + v[i][j][1] * v[i][j][1]) + (v[i][j][2] * v[i][j][2] + v[i][j][3] * v[i][j][3]); }
                rstd[i] = 1.f / sqrtf(wave_sum(s2) * (1.f / D) + LN_EPS); }
            if (F.lane < 4) { const float m_ = F.lane == 0 ? mean[0] : F.lane == 1 ? mean[1] : F.lane == 2 ? mean[2] : mean[3], r_ = F.lane == 0 ? rstd[0] : F.lane == 1 ? rstd[1] : F.lane == 2 ? rstd[2] : rstd[3];
                st[2 * (t0 + F.lane)] = m_; st[2 * (t0 + F.lane) + 1] = r_; stl[2 * (4 * F.wave + F.lane)] = m_; stl[2 * (4 * F.wave + F.lane) + 1] = r_; }
        }
        f32x4 acc0 = {0.f, 0.f, 0.f, 0.f}, acc1 = acc0, acc2 = acc0;
        router_stage(v, rstd, 0, true, g, b, HB, t0, F.wave, F.lane, F.lds);
        __syncthreads();
#if PROBE_T >= 231 && PROBE_T <= 236
        if (F.bid == 0 && F.tid == 0) ((unsigned long long*)(F.ws + 32768))[1] = __builtin_amdgcn_s_memrealtime();
#endif
        router_mma(acc0, acc1, acc2, 0, WSP(bf16, WS_WRT), F.wave, F.lane, F.lds);
        __syncthreads();
        router_stage(v, rstd, 1, true, g, b, HB, t0, F.wave, F.lane, F.lds);
        __syncthreads();
        router_mma(acc0, acc1, acc2, 1, WSP(bf16, WS_WRT), F.wave, F.lane, F.lds);
        __syncthreads();
        {
            LAS float* pw = part + F.wave * 768;
#pragma unroll
            for (int jj = 0; jj < 4; ++jj) { pw[(4 * fq + jj) * 48 + fr] = acc0[jj]; pw[(4 * fq + jj) * 48 + 16 + fr] = acc1[jj]; pw[(4 * fq + jj) * 48 + 32 + fr] = acc2[jj]; }
        }
        __syncthreads();
#if PROBE_T >= 231 && PROBE_T <= 236
        if (F.bid == 0 && F.tid == 0) ((unsigned long long*)(F.ws + 32768))[2] = __builtin_amdgcn_s_memrealtime();
#endif
        int e1 = 0, e2 = 0, r1 = 0, r2 = 0; float g1 = 0.f, g2 = 0.f;
        if (F.tid < 32) {
            const int rt = F.tid >> 4, rr = F.tid & 15;
            float le[32], lg[4];
#pragma unroll
            for (int c = 0; c < 32; ++c) { float s = 0.f;
#pragma unroll
                for (int kq = 0; kq < 4; ++kq) s += part[(rt * 4 + kq) * 768 + rr * 48 + c]; le[c] = s; }
#pragma unroll
            for (int c = 0; c < 4; ++c) { float s = 0.f;
#pragma unroll
                for (int kq = 0; kq < 4; ++kq) s += part[(rt * 4 + kq) * 768 + rr * 48 + 32 + c]; lg[c] = s + F.in[17][c]; }
            int grp = 0; float gmx = lg[0];
#pragma unroll
            for (int i = 1; i < 4; ++i) if (lg[i] > gmx) { gmx = lg[i]; grp = i; }
            float gs = 0.f;
#pragma unroll
            for (int i = 0; i < 4; ++i) gs += expf(lg[i] - gmx);
            const float pg_sel = 1.0f / gs;
            float fe[8];
#pragma unroll
            for (int j = 0; j < 8; ++j) { const float a = grp == 0 ? le[j] : grp == 1 ? le[8 + j] : grp == 2 ? le[16 + j] : le[24 + j]; fe[j] = a + F.in[19][grp * 8 + j]; }
            int i1 = 0; float m1 = fe[0];
#pragma unroll
            for (int j = 1; j < 8; ++j) if (fe[j] > m1) { m1 = fe[j]; i1 = j; }
            int i2 = -1; float m2 = -3.0e38f;
#pragma unroll
            for (int j = 0; j < 8; ++j) if (j != i1 && fe[j] > m2) { m2 = fe[j]; i2 = j; }
            const float p2 = expf(m2 - m1), den = 1.0f / (1.0f + p2);
            e1 = grp * 8 + i1; e2 = grp * 8 + i2; g1 = pg_sel * den; g2 = pg_sel * p2 * den;
            r1 = __hip_atomic_fetch_add((int*)(lcnt + e1), 1, __ATOMIC_RELAXED, __HIP_MEMORY_SCOPE_WORKGROUP); r2 = __hip_atomic_fetch_add((int*)(lcnt + e2), 1, __ATOMIC_RELAXED, __HIP_MEMORY_SCOPE_WORKGROUP);
        }
        __syncthreads();
#if PROBE_T >= 231 && PROBE_T <= 236
        if (F.bid == 0 && F.tid == 0) ((unsigned long long*)(F.ws + 32768))[3] = __builtin_amdgcn_s_memrealtime();
#endif
        if (F.tid < 32) { const int c = lcnt[F.tid];
            lbase[F.tid] = c ? (int)__hip_atomic_fetch_add((unsigned*)(F.ctl + CW_CUR) + F.tid, (unsigned)c, __ATOMIC_RELAXED, __HIP_MEMORY_SCOPE_AGENT) : 0; }
        __syncthreads();
#if PROBE_T >= 231 && PROBE_T <= 236
        if (F.bid == 0 && F.tid == 0) ((unsigned long long*)(F.ws + 32768))[4] = __builtin_amdgcn_s_memrealtime();
#endif
        if (F.tid < 32) {
            const int t = row0 + F.tid;
            int* ex = WSP(int, WS_EXP); float* gt = WSP(float, WS_GATE); int* sl = WSP(int, WS_SLOT);
            ex[2 * t] = e1; ex[2 * t + 1] = e2; gt[2 * t] = g1; gt[2 * t + 1] = g2;
            const int s1 = lbase[e1] + r1, s2 = lbase[e2] + r2; int* tk = WSP(int, WS_TOKS);
            sl[2 * t] = s1; sl[2 * t + 1] = s2; tk[e1 * 8192 + s1] = t; tk[e2 * 8192 + s2] = t;
            lcnt[F.tid] = 0;
        }
        __syncthreads();
#if PROBE_T >= 231 && PROBE_T <= 236
        if (F.bid == 0 && F.tid == 0) ((unsigned long long*)(F.ws + 32768))[5] = __builtin_amdgcn_s_memrealtime();
#endif
    }
}


#define XB_TMO      128
#define XB_XCNT(j)  (256  + 64 * (j))
#define XB_XSUB(j)  (1280 + 64 * (j))
#define XB_XGEN(j)  (2304 + 64 * (j))
#define XB_TOP      3328
#define XB_TOPGEN   3392
#define XCD_BAR_WORDS 3456
#define XB_SPIN_CAP (1u << 22)
__device__ __forceinline__ unsigned xb_ld(unsigned* p)              { return __hip_atomic_load(p, __ATOMIC_RELAXED, __HIP_MEMORY_SCOPE_AGENT); }
__device__ __forceinline__ unsigned xb_add(unsigned* p, unsigned v) { return __hip_atomic_fetch_add(p, v, __ATOMIC_RELAXED, __HIP_MEMORY_SCOPE_AGENT); }
__device__ __forceinline__ unsigned xb_xcc_id() { return (unsigned)__builtin_amdgcn_s_getreg((3 << 11) | 20) & 0xFu; }
#define XB_SPIN(cond, bar) do { unsigned _sp = 0; while (cond) { __builtin_amdgcn_s_sleep(1); \
    if ((++_sp & 255u) == 0u) { if (xb_ld(&(bar)[XB_TMO])) break; if (_sp > XB_SPIN_CAP) { atomicAdd(&(bar)[XB_TMO], 1u); break; } } } } while (0)
struct XcdBarrier { unsigned* bar; unsigned x; volatile LAS unsigned* st; };
__device__ __forceinline__ XcdBarrier xcd_barrier_post(unsigned* bar, volatile LAS unsigned* st) {
    XcdBarrier b; b.bar = bar; b.x = xb_xcc_id(); b.st = st;
    if (threadIdx.x == 0) (void)xb_add(&bar[XB_XCNT(b.x)], 1u);
    return b;
}
__device__ __forceinline__ void xcd_barrier_complete(unsigned* bar, unsigned x, unsigned& nloc, unsigned& nx) {
    const unsigned G = gridDim.x * gridDim.y * gridDim.z;
    unsigned sum, cnt, mine, sp = 0u;
    for (;;) {
        sum = 0u; cnt = 0u; mine = 0u;
#pragma unroll
        for (unsigned j = 0; j < 16; ++j) { const unsigned c = xb_ld(&bar[XB_XCNT(j)]); sum += c; cnt += (c > 0u) ? 1u : 0u; mine = (j == x) ? c : mine; }
        if (sum == G) break;
        __builtin_amdgcn_s_sleep(1);
        if ((++sp & 255u) == 0u) { if (xb_ld(&bar[XB_TMO])) break; if (sp > XB_SPIN_CAP) { atomicAdd(&bar[XB_TMO], 1u); break; } }
    }
    nloc = mine > 0u ? mine : 1u; nx = cnt > 0u ? cnt : 1u;
}
__device__ __forceinline__ void xcd_barrier(const XcdBarrier& b) {
    asm volatile("s_waitcnt vmcnt(0)" ::: "memory");
    __syncthreads();
    if (threadIdx.x == 0) {
        unsigned* bar = b.bar;
        __builtin_amdgcn_s_waitcnt(0);
        unsigned nloc = b.st[0], nx = b.st[1];
        if (nloc == 0u) { xcd_barrier_complete(bar, b.x, nloc, nx); b.st[0] = nloc; b.st[1] = nx; }
        const unsigned old = xb_add(&bar[XB_XSUB(b.x)], 1u);
        const unsigned gen = old / nloc;
        if (old + 1u == (gen + 1u) * nloc) {
            __builtin_amdgcn_fence(__ATOMIC_RELEASE, "agent");
            asm volatile("s_waitcnt vmcnt(0)" ::: "memory");
            const unsigned og = xb_add(&bar[XB_TOP], 1u);
            const unsigned tg = og / nx;
            if (og + 1u == (tg + 1u) * nx) xb_add(&bar[XB_TOPGEN], 1u);
            else XB_SPIN(xb_ld(&bar[XB_TOPGEN]) == tg, bar);
            __builtin_amdgcn_fence(__ATOMIC_ACQUIRE, "agent");
            xb_add(&bar[XB_XGEN(b.x)], 1u);
            asm volatile("s_waitcnt vmcnt(0)" ::: "memory");
        } else {
            XB_SPIN(xb_ld(&bar[XB_XGEN(b.x)]) == gen, bar);
            __builtin_amdgcn_fence(__ATOMIC_ACQUIRE, "agent");
            asm volatile("s_waitcnt vmcnt(0)" ::: "memory");
        }
    }
    __syncthreads();
}

struct Args { const float* in[25]; float* out; unsigned char* ws; int ph_lo, ph_hi, use_bar, pad; };
__global__ void __launch_bounds__(NTHR, 2) mega(Args args) {
    extern __shared__ __attribute__((aligned(16))) unsigned char lds[];
    Frame F;
    F.lds = (LAS unsigned char*)lds;
    F.MISC = (volatile LAS unsigned*)(F.lds + MISC_OFF);
    F.tid = threadIdx.x; F.lane = F.tid & 63; F.wave = __builtin_amdgcn_readfirstlane(F.tid >> 6);
    F.G = gridDim.x; F.bid = blockIdx.x;
    F.ws = args.ws; F.ctl = (gu32*)(args.ws + WS_CTL);
#pragma unroll
    for (int i = 0; i < 25; ++i) F.in[i] = args.in[i];
    F.out = args.out;
    for (int u = F.tid; u < (LDS_BYTES - LDSCTL_OFF) / 4; u += NTHR) ((LAS unsigned*)(F.lds + LDSCTL_OFF))[u] = 0u;
    __syncthreads();
    LAS int* ts = (LAS int*)(F.lds + MISC_OFF + 64);
    XcdBarrier bar; bar.bar = (unsigned*)(F.ctl + CW_BAR); bar.x = 0; bar.st = nullptr;
    if (args.use_bar) bar = xcd_barrier_post((unsigned*)(F.ctl + CW_BAR), F.MISC + 8);
    const int lo = args.ph_lo, hi = args.ph_hi;
#if PROBE_T == 100
    if (F.tid == 0) __hip_atomic_store(F.ctl + CW_LN1 + F.bid, xb_xcc_id() + 1u, RLX_AGENT);
#endif
#if PROBE_T >= 0
    unsigned long long pt0 = __builtin_amdgcn_s_memrealtime(), pdelay = 0ull;
#endif
#if MK_CG_SYNC == 2
    if (args.use_bar == 2) cooperative_groups::this_grid().sync();
#endif
#define IN(k) (lo <= (k) && (k) < hi)
#if PROBE_T >= 0
#if PROBE_T == 100
#define PROBE_STAMP(k) do { if ((k) == 0 && F.bid == 0 && F.tid == 0) { unsigned mm = 0; for (int b_ = 0; b_ < 256; ++b_) mm += (__hip_atomic_load(F.ctl + CW_LN1 + b_, RLX_AGENT) != __hip_atomic_load(F.ctl + CW_LN1 + (b_ & 7), RLX_AGENT)) ? 1u : 0u; pdelay = 100ull * mm; } } while (0)
#else
#define PROBE_STAMP(k) do { if ((k) == PROBE_T) pdelay = __builtin_amdgcn_s_memrealtime() - pt0; } while (0)
#endif
#else
#define PROBE_STAMP(k) do { } while (0)
#endif
#define REPS(k) for (int _r = 0; _r < ((k) == PROBE_PH ? PROBE_N : 1); ++_r)
#define SEAM(k) do { if (IN(k) && IN((k) + 1)) { if (MK_CG_SYNC == 1 && (k) == 0) cooperative_groups::this_grid().sync(); else { xcd_barrier(bar); if (PROBE_PH == 100) for (int _b = 1; _b < PROBE_N; ++_b) xcd_barrier(bar); } PROBE_STAMP(k); } } while (0)

    if (IN(0)) { REPS(0) p0_prologue(F); SEAM(0);
#if PROBE_T >= 241 && PROBE_T <= 246
        if (F.bid == 0 && F.tid == 0) { unsigned long long* q_ = (unsigned long long*)(F.ws + 32768); q_[5] = __builtin_amdgcn_s_memrealtime();
            pdelay = 4ull * (q_[PROBE_T - 240] - q_[PROBE_T - 241]); }
#endif
    }
    if (IN(1)) {
        p1_bcum(F, F.bid, F.G);
        const int g8 = F.bid >> 3, nsb = (g8 * NSG) >> 5; const bool streamer = (F.G == 256) && ((((g8 + 1) * NSG) >> 5) != nsb);
        if (!streamer) {
            pg8::Gemm g{WSP(pg8::bf16_t, WS_XB), WSP(pg8::bf16_t, WS_WIN), T + MEMN, HW + 4096, D}; pg8::OrderG1 S;
            if (F.G == 256) S.init(F.G - 8 * NSG, F.bid - 8 * nsb); else S.init(F.G, F.bid);
            pg8::EpiH E{WSP(pg8::bf16_t, WS_H), WSP(pg8::bf16_t, WS_KVM), WSP(float, WS_RC), WSP(float, WS_RS)};
            pg8::gemm_phase<pg8::EpiH, pg8::OrderG1, true, true>(F.lds, g, S, E);
        }
        transpose_queue(F);
        if (PROBE_PH == 102) for (int _q = 1; _q < PROBE_N; ++_q) transpose_queue(F, _q);
        SEAM(1);
    }
#if PROBE_PH == 101
    if (IN(1)) {
        pg8::Gemm g{WSP(pg8::bf16_t, WS_XB), WSP(pg8::bf16_t, WS_WIN), T + MEMN, HW + 4096, D}; pg8::OrderG1 S; S.init(F.G, F.bid);
        pg8::EpiH E{WSP(pg8::bf16_t, WS_H), WSP(pg8::bf16_t, WS_KVM), WSP(float, WS_RC), WSP(float, WS_RS)};
        pg8::gemm_phase<pg8::EpiH, pg8::OrderG1, true, true>(F.lds, g, S, E);
        xcd_barrier(bar);
    }
#endif
    if (IN(2)) { REPS(2) p2_kv(F); SEAM(2); }
    if (IN(3)) { p3_scan(F); SEAM(3); }
#if PROBE_PH == 103
    if (IN(3)) { p2_kv(F); xcd_barrier(bar); p3_scan(F); xcd_barrier(bar); }
#endif
    if (IN(4)) { REPS(4) p4_out(F); SEAM(4); }
#if PROBE_T >= 261 && PROBE_T <= 262
        if (F.bid == 0 && F.tid == 0) { unsigned long long* q_ = (unsigned long long*)(F.ws + 32768); pdelay = 4ull * (PROBE_T == 261 ? q_[1] - q_[0] : q_[3] - q_[2]); }
#endif
    if (IN(5)) {
        pg8::Gemm g{WSP(pg8::bf16_t, WS_MIXED), WSP(pg8::bf16_t, WS_WMIX), T, D, D}; pg8::StaticOrder S; S.init(T, D, F.G, F.bid);
#if MK_FUSE_LN1
        pg8::EpiLN<0> E{F.in[0], nullptr, nullptr, nullptr, WSP(float, WS_Y1), WSP(float, WS_ST1), WSP(pg8::bf16_t, WS_H1B), F.in[8], F.in[9], WSP(unsigned long long, WS_XCH1), (unsigned*)(F.ctl + CW_LN1)};
        pg8::gemm_phase<pg8::EpiLN<0>, pg8::StaticOrder, false, true>(F.lds, g, S, E);
        SEAM(5);
    }
#else
        pg8::EpiResX E{F.in[0], WSP(float, WS_Y1), ALPHA};
#if PROBE_T >= 201 && PROBE_T <= 203
        if (F.bid == 0 && F.tid == 0) ((unsigned long long*)(F.ws + 32768))[0] = __builtin_amdgcn_s_memrealtime();
#endif
        REPS(5) pg8::gemm_phase<pg8::EpiResX, pg8::StaticOrder, MK_ALIGN1, true>(F.lds, g, S, E);
        SEAM(5);
#if PROBE_T >= 201 && PROBE_T <= 203
        if (F.bid == 0 && F.tid == 0) { unsigned long long* q_ = (unsigned long long*)(F.ws + 32768); q_[3] = __builtin_amdgcn_s_memrealtime();
            pdelay = PROBE_T == 201 ? q_[1] - q_[0] : PROBE_T == 202 ? q_[2] - q_[1] : q_[3] - q_[2]; }
#endif
    }
    if (IN(6)) { REPS(6) ln_apply_plain(F, WSP(float, WS_Y1), F.in[8], F.in[9], WSP(bf16, WS_H1B), WSP(float, WS_ST1)); SEAM(6); }
#endif
    if (IN(7)) {
        pg8::Gemm g{WSP(pg8::bf16_t, WS_H1B), WSP(pg8::bf16_t, WS_WMQ), T, D, D}; pg8::StaticOrder S; S.init(T, D, F.G, F.bid);
        pg8::EpiB E{WSP(pg8::bf16_t, WS_QB), D, -1, 8192u * 2048u * 2u};
        REPS(7) pg8::gemm_phase<pg8::EpiB, pg8::StaticOrder, MK_ALIGN1, true>(F.lds, g, S, E);
        SEAM(7);
    }
    if (IN(8)) { REPS(8) p8_attn(F); SEAM(8);
#if PROBE_T >= 221 && PROBE_T <= 224
        if (F.bid == 0 && F.tid == 0) { unsigned long long* q_ = (unsigned long long*)(F.ws + 32768); q_[3] = __builtin_amdgcn_s_memrealtime();
            pdelay = PROBE_T == 221 ? q_[1] - q_[0] : PROBE_T == 222 ? q_[2] - q_[1] : q_[3] - q_[2]; }
#endif
    }
    if (IN(9)) {
        pg8::Gemm g{WSP(pg8::bf16_t, WS_ATT), WSP(pg8::bf16_t, WS_WMO), T, D, D}; pg8::StaticOrder S; S.init(T, D, F.G, F.bid);
        pg8::EpiResLN E{WSP(float, WS_Y1), WSP(float, WS_ST1), F.in[8], F.in[9], WSP(float, WS_Y2), ALPHA};
        REPS(9) pg8::gemm_phase<pg8::EpiResLN, pg8::StaticOrder, MK_ALIGN1, true>(F.lds, g, S, E);
        SEAM(9);
    }
    if (IN(10)) { p10_ln_router(F); SEAM(10);
#if PROBE_T >= 231 && PROBE_T <= 236
        if (F.bid == 0 && F.tid == 0) { unsigned long long* q_ = (unsigned long long*)(F.ws + 32768); q_[6] = __builtin_amdgcn_s_memrealtime();
            pdelay = 10ull * (q_[PROBE_T - 230] - q_[PROBE_T - 231]); }
#endif
    }
#if MK_MOE_F32
#define MOE_GEMM_GU(l, g, S, E) pg8::gemm_phase_bf32<pg8::EpiSwi, pg8::MoeOrder, true, true, true>(l, g, S, E)
#define MOE_GEMM_DN(l, g, S, E) pg8::gemm_phase_bf32<pg8::EpiB, pg8::MoeOrder, true, false, false>(l, g, S, E)
#else
#define MOE_GEMM_GU(l, g, S, E) pg8::gemm_phase<pg8::EpiSwi, pg8::MoeOrder, true, true, true, MK_MOE_BNT>(l, g, S, E)
#define MOE_GEMM_DN(l, g, S, E) pg8::gemm_phase<pg8::EpiB, pg8::MoeOrder, true, true, false, MK_MOE_BNT>(l, g, S, E)
#endif
    if (IN(12)) {
#if PROBE_T >= 211 && PROBE_T <= 214
        if (F.bid == 0 && F.tid == 0) ((unsigned long long*)(F.ws + 32768))[0] = __builtin_amdgcn_s_memrealtime();
#endif
        moe_tile_starts(F, ts);
#if PROBE_T >= 211 && PROBE_T <= 214
        if (F.bid == 0 && F.tid == 0) ((unsigned long long*)(F.ws + 32768))[4] = __builtin_amdgcn_s_memrealtime();
#endif
        const int U = ts[32] * 4;
        pg8::Gemm g{WSP(pg8::bf16_t, WS_H2B), WSP(pg8::bf16_t, WS_WGU), PMAX, 32 * 1024, D, WSP(int, WS_TOKS)};
        pg8::MoeOrder S{(const PG8_LAS int*)ts, F.G, F.bid, 4, U < F.G ? U : F.G, F.in[20], F.in[21], 2048, 512, 0};
        pg8::EpiSwi E{WSP(pg8::bf16_t, WS_HID)};
        MOE_GEMM_GU(F.lds, g, S, E);
        SEAM(12);
#if PROBE_T >= 211 && PROBE_T <= 214
        if (F.bid == 0 && F.tid == 0) { unsigned long long* q_ = (unsigned long long*)(F.ws + 32768); q_[3] = __builtin_amdgcn_s_memrealtime();
            pdelay = PROBE_T == 211 ? q_[4] - q_[0] : PROBE_T == 212 ? q_[1] - q_[4] : PROBE_T == 213 ? q_[2] - q_[1] : q_[3] - q_[2]; }
#endif
    }
    if (IN(13)) {
        moe_tile_starts(F, ts);
        const int RT = ts[32], U = RT * 4, nbg = U > F.G ? U - F.G : 0, R1 = (F.G / 4) < RT ? (F.G / 4) : RT;
        {
            pg8::Gemm g{WSP(pg8::bf16_t, WS_H2B), WSP(pg8::bf16_t, WS_WGU), PMAX, 32 * 1024, D, WSP(int, WS_TOKS)};
            pg8::MoeOrder S{(const PG8_LAS int*)ts, F.G, F.bid, 4, U, F.in[20], F.in[21], 2048, 512, F.G};
            pg8::EpiSwi E{WSP(pg8::bf16_t, WS_HID)};
            MOE_GEMM_GU(F.lds, g, S, E);
        }
        {
            pg8::Gemm g{WSP(pg8::bf16_t, WS_HID), WSP(pg8::bf16_t, WS_WD), PMAX, 32 * 2048, 512};
            pg8::MoeOrder S{(const PG8_LAS int*)ts, F.G - nbg, F.bid >= nbg ? F.bid - nbg : -1, 8, R1 * 8, F.in[22], nullptr, 512, 2048, 0};
            pg8::EpiB E{WSP(pg8::bf16_t, WS_YS), D, 7, 24576u * 2048u * 2u};
            MOE_GEMM_DN(F.lds, g, S, E);
        }
        SEAM(13);
    }
    if (IN(14)) {
        moe_tile_starts(F, ts);
        const int RT = ts[32], R1 = (F.G / 4) < RT ? (F.G / 4) : RT;
        pg8::Gemm g{WSP(pg8::bf16_t, WS_HID), WSP(pg8::bf16_t, WS_WD), PMAX, 32 * 2048, 512};
        pg8::MoeOrder S{(const PG8_LAS int*)ts, F.G, F.bid, 8, RT * 8, F.in[22], nullptr, 512, 2048, R1 * 8};
        pg8::EpiB E{WSP(pg8::bf16_t, WS_YS), D, 7, 24576u * 2048u * 2u};
        MOE_GEMM_DN(F.lds, g, S, E);
        SEAM(14);
    }
    if (IN(15)) {
#if PROBE_T == 251
        const unsigned long long q15 = __builtin_amdgcn_s_memrealtime();
#endif
        moe_tile_starts(F, ts); REPS(15) p13_combine(F, ts);
#if PROBE_T == 251
        pdelay = 4ull * (__builtin_amdgcn_s_memrealtime() - q15);
#endif
    }
#if PROBE_T >= 0
    if (F.bid == 0 && F.tid == 0) { const unsigned long long te = __builtin_amdgcn_s_memrealtime(); while (__builtin_amdgcn_s_memrealtime() - te < pdelay) __builtin_amdgcn_s_sleep(8); }
#endif
#undef IN
#undef SEAM
#undef REPS
}

extern "C" void kernel_launch(void* const* d_in, const int* in_sizes, int n_in, void* d_out, int out_size, void* d_ws, size_t ws_size, hipStream_t stream) {
    static int grid = 0;
    if (grid == 0) {
        if (n_in != 25 || in_sizes[0] != T * D || out_size != T * D || ws_size < WS_END) { fprintf(stderr, "kernel_launch: unexpected shapes / workspace (%d inputs, ws %zu)\n", n_in, ws_size); grid = -1; return; }
        int dev = 0, cus = 0;
        if (hipGetDevice(&dev) != hipSuccess || hipDeviceGetAttribute(&cus, hipDeviceAttributeMultiprocessorCount, dev) != hipSuccess) { grid = -1; return; }
        if (hipFuncSetAttribute((const void*)mega, hipFuncAttributeMaxDynamicSharedMemorySize, LDS_BYTES) != hipSuccess) { fprintf(stderr, "kernel_launch: hipFuncSetAttribute failed\n"); grid = -1; return; }
        int per_cu = 0;
        if (hipOccupancyMaxActiveBlocksPerMultiprocessor(&per_cu, (const void*)mega, NTHR, LDS_BYTES) != hipSuccess || per_cu < 1) { fprintf(stderr, "kernel_launch: occupancy query failed / 0 blocks per CU\n"); grid = -1; return; }
        (void)hipGetLastError();
        grid = cus;
    }
    if (grid < 0) return;
    if (hipMemsetAsync((char*)d_ws + WS_CTL, 0, CTL_ZERO_BYTES, stream) != hipSuccess) return;
    Args a{};
    for (int i = 0; i < 25; ++i) a.in[i] = (const float*)d_in[i];
    a.out = (float*)d_out; a.ws = (unsigned char*)d_ws;
#if MK_ONE_LAUNCH
    a.ph_lo = 0; a.ph_hi = NPH; a.use_bar = 1;
#if MK_CG_SYNC
    { void* kargs[] = {(void*)&a};
      hipError_t e = hipLaunchCooperativeKernel((const void*)mega, dim3(grid), dim3(NTHR), kargs, LDS_BYTES, stream);
      if (e != hipSuccess) fprintf(stderr, "cooperative launch failed: %s (grid %d)\n", hipGetErrorString(e), grid); }
#else
    hipLaunchKernelGGL(mega, dim3(grid), dim3(NTHR), LDS_BYTES, stream, a);
#endif
#else
    for (int p = 0; p < NPH; ++p) { a.ph_lo = p; a.ph_hi = p + 1; a.use_bar = 0;
        hipLaunchKernelGGL(mega, dim3(grid), dim3(NTHR), LDS_BYTES, stream, a); }
#endif
}
```
